# Optimizing an MI355X kernel written in HIP

```python
import math
import jax, jax.numpy as jnp
from jax import lax
import numpy as np

D_MODEL = 1024
BATCH = 8
SEQ = 4096
DEPTH = 2

N_META = 16
EPS = 1e-6
D_FF = 4 * D_MODEL

S5_WIDTH = D_MODEL // 4
S5_GROUP = 16
S5_GROUPS = S5_WIDTH // S5_GROUP
S5_STATE = 64

SSD_WIDTH = D_MODEL // 2
SSD_HEAD_DIM = 64
SSD_HEADS = SSD_WIDTH // SSD_HEAD_DIM
SSD_GROUPS = 2
SSD_HEADS_PER_GROUP = SSD_HEADS // SSD_GROUPS
SSD_STATE = 128
SSD_CONV = 5
SSD_CHUNK = 128
SSD_CONV_CH = SSD_WIDTH + 2 * SSD_GROUPS * SSD_STATE

RWKV_WIDTH = D_MODEL // 4
RWKV_HEAD = 64
RWKV_HEADS = RWKV_WIDTH // RWKV_HEAD
RWKV_DECAY_LORA = 64
RWKV_AAA_LORA = 64
RWKV_GATE_LORA = 128
RWKV_LN_EPS = 64e-5

N_BRANCH = 3
IN_SPLITS = (S5_WIDTH, SSD_WIDTH, SSD_CONV_CH, SSD_HEADS, 4 * RWKV_WIDTH, N_BRANCH * D_MODEL)
N_IN = sum(IN_SPLITS)

kernel_name = 'hybrid_s5_ssd_rwkv7_bidir_encoder'


def rms_norm(x, w):
    xf = x.astype(jnp.float32)
    y = xf * lax.rsqrt(jnp.mean(xf * xf, -1, keepdims=True) + EPS)
    return (y * w).astype(x.dtype)


def _complex_affine(e1, e2):
    ar1, ai1, br1, bi1 = e1
    ar2, ai2, br2, bi2 = e2
    return (ar2 * ar1 - ai2 * ai1,
            ar2 * ai1 + ai2 * ar1,
            ar2 * br1 - ai2 * bi1 + br2,
            ar2 * bi1 + ai2 * br1 + bi2)


def s5_mixer(u, lam_re, lam_im, log_step, b_re, b_im, c_re, c_im, d_skip, glu_w, glu_b):
    bsz, length, _ = u.shape
    ug = u.reshape(bsz, length, S5_GROUPS, S5_GROUP)
    bu_re = jnp.einsum('gnh,blgh->blgn', b_re, ug)
    bu_im = jnp.einsum('gnh,blgh->blgn', b_im, ug)
    h_re = 0.0
    h_im = 0.0
    for direction in range(2):
        lr, li = lam_re[direction], lam_im[direction]
        step = jnp.exp(log_step[direction])[:, None]
        mag = jnp.exp(lr * step)
        ab_re, ab_im = mag * jnp.cos(li * step), mag * jnp.sin(li * step)
        den = lr * lr + li * li
        co_re = ((ab_re - 1.0) * lr + ab_im * li) / den
        co_im = (ab_im * lr - (ab_re - 1.0) * li) / den
        e_re = co_re * bu_re - co_im * bu_im
        e_im = co_re * bu_im + co_im * bu_re
        shape = (1, length) + ab_re.shape
        elems = (jnp.broadcast_to(ab_re, shape), jnp.broadcast_to(ab_im, shape), e_re, e_im)
        _, _, s_re, s_im = lax.associative_scan(_complex_affine, elems, reverse=(direction == 1), axis=1)
        h_re = h_re + s_re
        h_im = h_im + s_im
    y = jnp.einsum('ghn,blgn->blgh', c_re, h_re) - jnp.einsum('ghn,blgn->blgh', c_im, h_im)
    y = y.reshape(bsz, length, S5_WIDTH) + d_skip * u
    zz = jax.nn.gelu(y) @ glu_w + glu_b
    return zz[..., :S5_WIDTH] * jax.nn.sigmoid(zz[..., S5_WIDTH:])


def _segsum_exp(a_cs):
    q = a_cs.shape[2]
    diff = a_cs[:, :, :, None] - a_cs[:, :, None, :]
    mask = jnp.tril(jnp.ones((q, q), bool))[None, None, :, :, None, None]
    return jnp.exp(jnp.where(mask, diff, -jnp.inf))


def ssd_chunked(xdt, a_step, bmat, cmat):
    bsz, t = xdt.shape[:2]
    nc = t // SSD_CHUNK
    chunk = lambda z: z.reshape((bsz, nc, SSD_CHUNK) + z.shape[2:])
    xdt, a_step, bmat, cmat = chunk(xdt), chunk(a_step), chunk(bmat), chunk(cmat)
    a_cs = jnp.cumsum(a_step, axis=2)
    cb = jnp.einsum('bclgn,bcsgn->bclsg', cmat, bmat)
    m = cb[..., None] * _segsum_exp(a_cs)
    y_diag = jnp.einsum('bclsgj,bcsgjp->bclgjp', m, xdt)
    decay_states = jnp.exp(a_cs[:, :, -1:] - a_cs)
    states = jnp.einsum('bcsgn,bcsgjp->bcgjpn', bmat, xdt * decay_states[..., None])
    chunk_decay = jnp.exp(a_cs[:, :, -1])

    def step(h, inp):
        s, dec = inp
        return h * dec[..., None, None] + s, h

    h0 = jnp.zeros_like(states[:, 0])
    _, h_in = lax.scan(step, h0, (jnp.moveaxis(states, 1, 0), jnp.moveaxis(chunk_decay, 1, 0)))
    h_in = jnp.moveaxis(h_in, 0, 1)
    y_off = jnp.einsum('bclgn,bcgjpn->bclgjp', cmat, h_in) * jnp.exp(a_cs)[..., None]
    y = y_diag + y_off
    return y.reshape((bsz, t) + y.shape[3:])


def ssd_mixer(z, xbc, dt_raw, conv_w, conv_b, a_log, dt_bias, d_skip, norm_w):
    bsz, length, _ = xbc.shape
    pad = SSD_CONV // 2
    xbc = lax.conv_general_dilated(xbc, conv_w[:, None, :], window_strides=(1,), padding=[(pad, pad)],
                                   dimension_numbers=('NWC', 'WIO', 'NWC'),
                                   feature_group_count=SSD_CONV_CH) + conv_b
    xbc = jax.nn.silu(xbc)
    xs, bmat, cmat = jnp.split(xbc, [SSD_WIDTH, SSD_WIDTH + SSD_GROUPS * SSD_STATE], axis=-1)
    xh = xs.reshape(bsz, length, SSD_GROUPS, SSD_HEADS_PER_GROUP, SSD_HEAD_DIM)
    bmat = bmat.reshape(bsz, length, SSD_GROUPS, SSD_STATE)
    cmat = cmat.reshape(bsz, length, SSD_GROUPS, SSD_STATE)
    front = SSD_CHUNK - N_META
    padt = lambda t: jnp.pad(t, ((0, 0), (front, 0)) + ((0, 0),) * (t.ndim - 2))
    xh_p, b_p, c_p = padt(xh), padt(bmat), padt(cmat)
    y = 0.0
    for direction in range(2):
        dt = jax.nn.softplus(dt_raw + dt_bias[direction]).reshape(bsz, length, SSD_GROUPS, SSD_HEADS_PER_GROUP)
        dt_p = padt(dt)
        a_step = dt_p * (-jnp.exp(a_log[direction])).reshape(SSD_GROUPS, SSD_HEADS_PER_GROUP)
        xdt = xh_p * dt_p[..., None]
        if direction == 0:
            y = y + ssd_chunked(xdt, a_step, b_p, c_p)
        else:
            yb = ssd_chunked(jnp.flip(xdt, 1), jnp.flip(a_step, 1), jnp.flip(b_p, 1), jnp.flip(c_p, 1))
            y = y + jnp.flip(yb, 1)
    y = y[:, front:] + d_skip.reshape(SSD_GROUPS, SSD_HEADS_PER_GROUP)[..., None] * xh
    y = y.reshape(bsz, length, SSD_WIDTH) * jax.nn.silu(z)
    return rms_norm(y, norm_w)


def centred_shift(x):
    prev = jnp.pad(x[:, :-1], ((0, 0), (1, 0), (0, 0)))
    nxt = jnp.pad(x[:, 1:], ((0, 0), (0, 1), (0, 0)))
    return 0.5 * (prev + nxt) - x


def wkv7_scan(r, w, k, v, a, b, reverse):
    bsz, _, heads, n = r.shape
    xs = tuple(jnp.moveaxis(t, 1, 0) for t in (r, w, k, v, a, b))

    def step(state, inp):
        rt, wt, kt, vt, at, bt = inp
        sa = jnp.einsum('bhvk,bhk->bhv', state, at)
        state = state * wt[:, :, None, :] + sa[..., None] * bt[:, :, None, :] + vt[..., None] * kt[:, :, None, :]
        return state, jnp.einsum('bhvk,bhk->bhv', state, rt)

    s0 = jnp.zeros((bsz, heads, n, n), r.dtype)
    _, ys = lax.scan(step, s0, xs, reverse=reverse)
    return jnp.moveaxis(ys, 0, 1)


def rwkv7_mixer(r, k, v, xc, mu_rkv, mu_wag, w0, w1, w2, a0, a1, a2, g1, g2, k_k, k_a, r_k, ln_w, ln_b):
    bsz, length, _ = r.shape
    heads = lambda t: t.reshape(bsz, length, RWKV_HEADS, RWKV_HEAD)
    r = r + centred_shift(r) * mu_rkv[0]
    k = k + centred_shift(k) * mu_rkv[1]
    v = v + centred_shift(v) * mu_rkv[2]
    dxc = centred_shift(xc)
    xw = xc + dxc * mu_wag[0]
    xa = xc + dxc * mu_wag[1]
    xg = xc + dxc * mu_wag[2]
    g = jax.nn.sigmoid(xg @ g1) @ g2
    kk = heads(k * k_k)
    kk = kk * lax.rsqrt(jnp.sum(jnp.square(kk), -1, keepdims=True) + 1e-12)
    rh, vh = heads(r), heads(v)
    y = 0.0
    for direction in range(2):
        w_log = -jax.nn.softplus(-(w0[direction] + jnp.tanh(xw @ w1[direction]) @ w2[direction])) - 0.5
        decay = jnp.exp(-jnp.exp(w_log))
        a = jax.nn.sigmoid(a0[direction] + (xa @ a1[direction]) @ a2[direction])
        kd = k * (1.0 + (a - 1.0) * k_a)
        y = y + wkv7_scan(rh, heads(decay), heads(kd), vh, -kk, kk * heads(a), reverse=(direction == 1))
    yf = y.astype(jnp.float32)
    mean = jnp.mean(yf, -1, keepdims=True)
    var = jnp.mean(jnp.square(yf - mean), -1, keepdims=True)
    yn = ((yf - mean) * lax.rsqrt(var + RWKV_LN_EPS)).astype(y.dtype).reshape(bsz, length, RWKV_WIDTH)
    yn = yn * ln_w + ln_b
    bonus = jnp.sum(rh * heads(k) * r_k, -1, keepdims=True) * vh
    return (yn + bonus.reshape(bsz, length, RWKV_WIDTH)) * g


def setup_inputs(seed: int = 0) -> dict:
    key = jax.random.key(seed)
    ks = iter(jax.random.split(key, 64))

    def nrm(shape, scale):
        return scale * jax.random.normal(next(ks), shape, jnp.float32)

    def near(shape, centre, spread):
        return centre + spread * jax.random.normal(next(ks), shape, jnp.float32)

    def unif(shape, lo, hi):
        return jax.random.uniform(next(ks), shape, jnp.float32, lo, hi)

    x = nrm((BATCH, SEQ, D_MODEL), 1.0)
    meta_tokens = nrm((N_META, D_MODEL), 1.0)
    final_norm_w = near((D_MODEL,), 1.0, 0.02)
    mix_norm_w = near((DEPTH, D_MODEL), 1.0, 0.02)
    w_in = nrm((DEPTH, D_MODEL, N_IN), D_MODEL ** -0.5)
    s5_lambda_re = near((DEPTH, 2, S5_GROUPS, S5_STATE), -0.5, 0.01)
    s5_lambda_im = jnp.pi * jnp.arange(S5_STATE, dtype=jnp.float32) + nrm((DEPTH, 2, S5_GROUPS, S5_STATE), 0.01)
    s5_log_step = unif((DEPTH, 2, S5_GROUPS), math.log(1e-3), math.log(1e-1))
    s5_b_re = nrm((DEPTH, S5_GROUPS, S5_STATE, S5_GROUP), (2 * S5_GROUP) ** -0.5)
    s5_b_im = nrm((DEPTH, S5_GROUPS, S5_STATE, S5_GROUP), (2 * S5_GROUP) ** -0.5)
    s5_c_re = nrm((DEPTH, S5_GROUPS, S5_GROUP, S5_STATE), S5_STATE ** -0.5)
    s5_c_im = nrm((DEPTH, S5_GROUPS, S5_GROUP, S5_STATE), S5_STATE ** -0.5)
    s5_d = nrm((DEPTH, S5_WIDTH), 1.0)
    s5_glu_w = nrm((DEPTH, S5_WIDTH, 2 * S5_WIDTH), S5_WIDTH ** -0.5)
    s5_glu_b = nrm((DEPTH, 2 * S5_WIDTH), 0.01)
    ssd_conv_w = nrm((DEPTH, SSD_CONV, SSD_CONV_CH), SSD_CONV ** -0.5)
    ssd_conv_b = nrm((DEPTH, SSD_CONV_CH), 0.01)
    ssd_a_log = jnp.log(unif((DEPTH, 2, SSD_HEADS), 1.0, 16.0))
    dt0 = jnp.exp(unif((DEPTH, 2, SSD_HEADS), math.log(1e-3), math.log(1e-1)))
    ssd_dt_bias = dt0 + jnp.log(-jnp.expm1(-dt0))
    ssd_d = near((DEPTH, SSD_HEADS), 1.0, 0.1)
    ssd_norm_w = near((DEPTH, SSD_WIDTH), 1.0, 0.02)
    rwkv_mu_rkv = unif((DEPTH, 3, RWKV_WIDTH), 0.0, 1.0)
    rwkv_mu_wag = unif((DEPTH, 3, RWKV_WIDTH), 0.0, 1.0)
    rwkv_w0 = jnp.linspace(-6.0, -1.0, RWKV_WIDTH, dtype=jnp.float32) + nrm((DEPTH, 2, RWKV_WIDTH), 0.1)
    rwkv_w1 = nrm((DEPTH, 2, RWKV_WIDTH, RWKV_DECAY_LORA), RWKV_WIDTH ** -0.5)
    rwkv_w2 = nrm((DEPTH, 2, RWKV_DECAY_LORA, RWKV_WIDTH), 0.1 * RWKV_DECAY_LORA ** -0.5)
    rwkv_a0 = nrm((DEPTH, 2, RWKV_WIDTH), 0.1)
    rwkv_a1 = nrm((DEPTH, 2, RWKV_WIDTH, RWKV_AAA_LORA), RWKV_WIDTH ** -0.5)
    rwkv_a2 = nrm((DEPTH, 2, RWKV_AAA_LORA, RWKV_WIDTH), 0.1 * RWKV_AAA_LORA ** -0.5)
    rwkv_g1 = nrm((DEPTH, RWKV_WIDTH, RWKV_GATE_LORA), RWKV_WIDTH ** -0.5)
    rwkv_g2 = nrm((DEPTH, RWKV_GATE_LORA, RWKV_WIDTH), RWKV_GATE_LORA ** -0.5)
    rwkv_k_k = near((DEPTH, RWKV_WIDTH), 0.85, 0.02)
    rwkv_k_a = near((DEPTH, RWKV_WIDTH), 1.0, 0.02)
    rwkv_r_k = near((DEPTH, RWKV_HEADS, RWKV_HEAD), -0.04, 0.02)
    rwkv_ln_w = near((DEPTH, RWKV_WIDTH), 1.0, 0.02)
    rwkv_ln_b = nrm((DEPTH, RWKV_WIDTH), 0.01)
    proj_a = nrm((DEPTH, S5_WIDTH, D_MODEL), S5_WIDTH ** -0.5)
    proj_b = nrm((DEPTH, SSD_WIDTH, D_MODEL), SSD_WIDTH ** -0.5)
    proj_c = nrm((DEPTH, RWKV_WIDTH, D_MODEL), RWKV_WIDTH ** -0.5)
    w_out = nrm((DEPTH, D_MODEL, D_MODEL), D_MODEL ** -0.5)
    mlp_norm_w = near((DEPTH, D_MODEL), 1.0, 0.02)
    mlp_w1 = nrm((DEPTH, D_MODEL, D_FF), D_MODEL ** -0.5)
    mlp_w2 = nrm((DEPTH, D_FF, D_MODEL), D_FF ** -0.5)
    return {'x': x, 'meta_tokens': meta_tokens, 'final_norm_w': final_norm_w,
            'mix_norm_w': mix_norm_w, 'w_in': w_in,
            's5_lambda_re': s5_lambda_re, 's5_lambda_im': s5_lambda_im, 's5_log_step': s5_log_step,
            's5_b_re': s5_b_re, 's5_b_im': s5_b_im, 's5_c_re': s5_c_re, 's5_c_im': s5_c_im,
            's5_d': s5_d, 's5_glu_w': s5_glu_w, 's5_glu_b': s5_glu_b,
            'ssd_conv_w': ssd_conv_w, 'ssd_conv_b': ssd_conv_b, 'ssd_a_log': ssd_a_log,
            'ssd_dt_bias': ssd_dt_bias, 'ssd_d': ssd_d, 'ssd_norm_w': ssd_norm_w,
            'rwkv_mu_rkv': rwkv_mu_rkv, 'rwkv_mu_wag': rwkv_mu_wag,
            'rwkv_w0': rwkv_w0, 'rwkv_w1': rwkv_w1, 'rwkv_w2': rwkv_w2,
            'rwkv_a0': rwkv_a0, 'rwkv_a1': rwkv_a1, 'rwkv_a2': rwkv_a2,
            'rwkv_g1': rwkv_g1, 'rwkv_g2': rwkv_g2, 'rwkv_k_k': rwkv_k_k, 'rwkv_k_a': rwkv_k_a,
            'rwkv_r_k': rwkv_r_k, 'rwkv_ln_w': rwkv_ln_w, 'rwkv_ln_b': rwkv_ln_b,
            'proj_a': proj_a, 'proj_b': proj_b, 'proj_c': proj_c, 'w_out': w_out,
            'mlp_norm_w': mlp_norm_w, 'mlp_w1': mlp_w1, 'mlp_w2': mlp_w2}


def reference(x, meta_tokens, final_norm_w, mix_norm_w, w_in,
              s5_lambda_re, s5_lambda_im, s5_log_step, s5_b_re, s5_b_im, s5_c_re, s5_c_im,
              s5_d, s5_glu_w, s5_glu_b,
              ssd_conv_w, ssd_conv_b, ssd_a_log, ssd_dt_bias, ssd_d, ssd_norm_w,
              rwkv_mu_rkv, rwkv_mu_wag, rwkv_w0, rwkv_w1, rwkv_w2, rwkv_a0, rwkv_a1, rwkv_a2,
              rwkv_g1, rwkv_g2, rwkv_k_k, rwkv_k_a, rwkv_r_k, rwkv_ln_w, rwkv_ln_b,
              proj_a, proj_b, proj_c, w_out, mlp_norm_w, mlp_w1, mlp_w2):
    bsz = x.shape[0]
    meta = jnp.broadcast_to(meta_tokens[None].astype(x.dtype), (bsz, N_META, D_MODEL))
    h = jnp.concatenate([meta, x], axis=1)
    length = h.shape[1]
    offsets = [int(o) for o in np.cumsum(IN_SPLITS)[:-1]]
    for i in range(DEPTH):
        hn = rms_norm(h, mix_norm_w[i])
        proj = hn @ w_in[i]
        u_a, z_b, xbc_b, dt_b, rkvx_c, gates = jnp.split(proj, offsets, axis=-1)
        r_c, k_c, v_c, x_c = jnp.split(rkvx_c, 4, axis=-1)
        y_a = s5_mixer(u_a, s5_lambda_re[i], s5_lambda_im[i], s5_log_step[i], s5_b_re[i], s5_b_im[i],
                       s5_c_re[i], s5_c_im[i], s5_d[i], s5_glu_w[i], s5_glu_b[i])
        y_b = ssd_mixer(z_b, xbc_b, dt_b, ssd_conv_w[i], ssd_conv_b[i], ssd_a_log[i], ssd_dt_bias[i],
                        ssd_d[i], ssd_norm_w[i])
        y_c = rwkv7_mixer(r_c, k_c, v_c, x_c, rwkv_mu_rkv[i], rwkv_mu_wag[i], rwkv_w0[i], rwkv_w1[i],
                          rwkv_w2[i], rwkv_a0[i], rwkv_a1[i], rwkv_a2[i], rwkv_g1[i], rwkv_g2[i],
                          rwkv_k_k[i], rwkv_k_a[i], rwkv_r_k[i], rwkv_ln_w[i], rwkv_ln_b[i])
        gt = jax.nn.sigmoid(gates.reshape(bsz, length, N_BRANCH, D_MODEL))
        merged = (gt[:, :, 0] * (y_a @ proj_a[i]) + gt[:, :, 1] * (y_b @ proj_b[i])
                  + gt[:, :, 2] * (y_c @ proj_c[i]))
        h = h + merged @ w_out[i]
        hn = rms_norm(h, mlp_norm_w[i])
        h = h + jnp.square(jax.nn.relu(hn @ mlp_w1[i])) @ mlp_w2[i]
    return rms_norm(h, final_norm_w)[:, N_META:]
```

```cpp
#include <hip/hip_runtime.h>
#include <hip/hip_cooperative_groups.h>
#include <cstdio>
#include <cstdint>
namespace cg = cooperative_groups;

#define LAS __attribute__((address_space(3)))
typedef unsigned short bf16_t;
typedef short bf16x8 __attribute__((ext_vector_type(8)));
typedef float f32x4 __attribute__((ext_vector_type(4)));
typedef unsigned u32x4 __attribute__((ext_vector_type(4)));
typedef unsigned u32x2 __attribute__((ext_vector_type(2)));

constexpr int BATCH = 8, SEQ = 4096, NMETA = 16, LEN = SEQ + NMETA, DM = 1024, DFF = 4096, DEPTH = 2;
constexpr int M_ROWS = BATCH * LEN;
constexpr int MP = 33024;
constexpr int N_IN = 5896;
constexpr int NCH16 = LEN / 16;
constexpr int S5ROWS = BATCH * NCH16;
constexpr int S5RP = 2304;
constexpr float EPS = 1e-6f;
constexpr int NTHREADS = 512, NWAVES = 8;

constexpr size_t QB = (size_t)MP * 256 * 2;
constexpr size_t WB_IN = 0;
constexpr size_t WB_G = WB_IN + (size_t)2816 * 1024;
constexpr size_t WB_P = WB_G + (size_t)3072 * 1024;
constexpr size_t WB_O = WB_P + (size_t)1024 * 1024;
constexpr size_t WB_1 = WB_O + (size_t)1024 * 1024;
constexpr size_t WB_2 = WB_1 + (size_t)4096 * 1024;
constexpr size_t WB_GLU = WB_2 + (size_t)1024 * 4096;
constexpr size_t WB_L1 = WB_GLU + (size_t)512 * 256;
constexpr size_t WB_L2 = WB_L1 + (size_t)512 * 512;
constexpr size_t WB_SX = WB_L2 + (size_t)1280 * 256;
constexpr size_t WB_SY = WB_SX + (size_t)16 * 256 * 256;
constexpr size_t WB_ELEMS = WB_SY + (size_t)16 * 256 * 512;
constexpr size_t WB_BYTES = WB_ELEMS * 2;
static_assert(WB_BYTES <= 5 * QB / 2, "weight block fits 2.5 Q");

constexpr size_t WS_H = 0;
constexpr size_t WS_WB0 = 4 * QB;
constexpr size_t WS_SMALL = 13 * QB / 2;
constexpr size_t WS_SSQ = WS_SMALL;
constexpr size_t WS_DT = WS_SSQ + (size_t)MP * 16 * 4;
constexpr size_t WS_DEC = WS_DT + (size_t)MP * 16 * 4;
static_assert(WS_DEC + (size_t)MP * 16 * 4 <= 7 * QB, "small region");
constexpr size_t WS_MIX = 7 * QB;
constexpr size_t WS_PXBC = WS_MIX;
constexpr size_t WS_YSSD = WS_MIX;
constexpr size_t WS_PARK = WS_MIX;
constexpr size_t WS_ACT = WS_MIX;
constexpr size_t WS_PRKVX = WS_MIX + 4 * QB;
constexpr size_t WS_L2O = WS_MIX + 4 * QB;
constexpr size_t WS_PZ = WS_MIX + 9 * QB;
constexpr size_t WS_UH = WS_MIX + 11 * QB;
constexpr size_t WS_X = WS_MIX + 53 * QB / 4;
constexpr size_t WS_YRW = WS_X;
constexpr size_t WS_L1IN = WS_MIX + 31 * QB / 2;
constexpr size_t WS_YAPRE = WS_L1IN;
constexpr size_t WS_L1O = WS_MIX + 35 * QB / 2;
constexpr size_t WS_YB = WS_L1O;
constexpr size_t WS_BC = WS_MIX + 39 * QB / 2;
constexpr size_t WS_YA = WS_BC;
constexpr size_t WS_YC = WS_BC + QB;
constexpr size_t WS_XS = WS_MIX + 43 * QB / 2;
constexpr size_t WS_END = WS_XS + 2 * QB;
static_assert(WS_END <= (size_t)512 << 20, "workspace map fits 512 MiB");
static_assert((size_t)16 * S5RP * 512 * 2 <= 9 * QB / 4 && (size_t)16 * S5RP * 256 * 4 <= 9 * QB / 4, "S5 buffers fit their slots");
static_assert((size_t)256 * 393216 <= 6 * QB, "gate park");
constexpr size_t DO_RKVP = 0;
constexpr size_t DO_MERGED = 0;
constexpr size_t DO_WB1 = 4 * QB;
static_assert(DO_WB1 + WB_BYTES <= (size_t)BATCH * SEQ * DM * 4, "d_out scratch map");

__device__ __forceinline__ unsigned f2bf(float f) { unsigned u = __builtin_bit_cast(unsigned, f); return (u + 0x7fffu + ((u >> 16) & 1u)) >> 16; }
__device__ __forceinline__ unsigned pk2(float lo, float hi) { unsigned r; asm volatile("v_cvt_pk_bf16_f32 %0, %1, %2" : "=v"(r) : "v"(lo), "v"(hi)); return r; }
__device__ __forceinline__ float bflo(unsigned w) { return __builtin_bit_cast(float, w << 16); }
__device__ __forceinline__ float bfhi(unsigned w) { return __builtin_bit_cast(float, w & 0xffff0000u); }
__device__ __forceinline__ float bf1(bf16_t v) { return __builtin_bit_cast(float, (unsigned)v << 16); }
__device__ __forceinline__ float sigmoidf_(float x) { return 1.0f / (1.0f + __expf(-x)); }
__device__ __forceinline__ float siluf_(float x) { return x / (1.0f + __expf(-x)); }
__device__ __forceinline__ float tanhf_(float x) { x = fminf(fmaxf(x, -15.f), 15.f); const float t = __expf(2.f * x); return (t - 1.f) / (t + 1.f); }
__device__ __forceinline__ float softplusf_(float x) { return fmaxf(x, 0.f) + __logf(1.0f + __expf(-fabsf(x))); }
__device__ __forceinline__ float geluf_(float x) { const float u = 0.7978845608028654f * (x + 0.044715f * x * x * x); return 0.5f * x * (1.f + tanhf_(u)); }
__device__ __forceinline__ float wave_sum(float v) {
#pragma unroll
    for (int o = 1; o < 64; o <<= 1) v += __shfl_xor(v, o);
    return v;
}
__device__ __forceinline__ float sum16(float v) {
#pragma unroll
    for (int o = 1; o < 16; o <<= 1) v += __shfl_xor(v, o);
    return v;
}
template <int CTRL> __device__ __forceinline__ float dpp_mov(float x) {
    return __builtin_bit_cast(float, __builtin_amdgcn_update_dpp(0, __builtin_bit_cast(int, x), CTRL, 0xf, 0xf, true));
}
__device__ __forceinline__ float allred16(float x) {
    x += dpp_mov<0xB1>(x); x += dpp_mov<0x4E>(x); x += dpp_mov<0x141>(x); x += dpp_mov<0x140>(x); return x;
}
__device__ __forceinline__ void unpack8(const u32x4 w, float (&f)[8]) {
    f[0] = bflo(w.x); f[1] = bfhi(w.x); f[2] = bflo(w.y); f[3] = bfhi(w.y); f[4] = bflo(w.z); f[5] = bfhi(w.z); f[6] = bflo(w.w); f[7] = bfhi(w.w);
}
__device__ __forceinline__ u32x4 pack8(const float (&f)[8]) { u32x4 w; w.x = pk2(f[0], f[1]); w.y = pk2(f[2], f[3]); w.z = pk2(f[4], f[5]); w.w = pk2(f[6], f[7]); return w; }
__device__ __forceinline__ int opaque_tid() { int t = threadIdx.x; asm volatile("" : "+v"(t)); return t; }
namespace pg8 {
constexpr int BM = 256, BK = 64, HALF = 128, HTB = HALF * BK * 2  , STAGE_BYTES = 8 * HTB;
__host__ __device__ __forceinline__ int lds_byte(int r, int c) { const int st = (r >> 4) * 2 + (c >> 5), rr = r & 15, cc = c & 31, ob = rr * 64 + cc * 2; return st * 1024 + (ob ^ (((ob >> 9) & 1) << 5)); }
__host__ __device__ __forceinline__ void stage_rc(int b, int& R, int& C) { const int st = b / 1024, sb = b % 1024, swz = sb ^ (((sb >> 9) & 1) << 5); R = (st >> 1) * 16 + swz / 64; C = (st & 1) * 32 + (swz % 64) / 2; }
__host__ __device__ __forceinline__ int perm32(int rho) { const int n = rho >> 4, i = rho & 15; return 8 * (i >> 2) + 4 * n + (i & 3); }

struct GU {
    const bf16_t* A;
    const bf16_t* B;
    int lda, ldb, nt;
    int pm, pn, kind;
};

template <class Epi, class Sched>
__device__ __forceinline__ void gemm_phase(LAS unsigned char* lds, const Sched& S, const Epi& E) {
    const int tid = opaque_tid(), wid = __builtin_amdgcn_readfirstlane(tid >> 6), lane = tid & 63, wr = wid >> 2, wc = wid & 3, fr = lane & 15, fq = lane >> 4;
#define PG8_VOFF(lda_, ldb_, a0, a1, b0, b1) do { int R0_, C0_, R1_, C1_; stage_rc(tid * 16, R0_, C0_); stage_rc(tid * 16 + 8192, R1_, C1_); \
        a0 = (unsigned)(R0_ * (lda_) + C0_) * 2u; a1 = (unsigned)(R1_ * (lda_) + C1_) * 2u; \
        b0 = (unsigned)(((R0_ & ~31) + perm32(R0_ & 31)) * (ldb_) + C0_) * 2u; b1 = (unsigned)(((R1_ & ~31) + perm32(R1_ & 31)) * (ldb_) + C1_) * 2u; } while (0)
    const size_t kstep = (size_t)(BK * 2);
    const unsigned ldsw = (unsigned)wid * 1024u;
    const int aoff = lds_byte(wr * 64 + fr, fq * 8), boff = lds_byte(wc * 32 + fr, fq * 8);
#define PG8_SA(b, h) (((b) * 2 + (h)) * HTB)
#define PG8_SB(b, h) ((4 + (b) * 2 + (h)) * HTB)
#define PG8_STAGE(bufoff, gbase, v0, v1) do { \
        __builtin_amdgcn_global_load_lds((const unsigned*)((const char*)(gbase) + (v0)), (LAS unsigned*)(lds + (bufoff) + ldsw), 16, 0, 0); \
        __builtin_amdgcn_global_load_lds((const unsigned*)((const char*)(gbase) + (v1)), (LAS unsigned*)(lds + (bufoff) + ldsw + 8192), 16, 0, 0); } while (0)
#define PG8_LDA(dst, b, h) do { _Pragma("unroll") for (int m = 0; m < 4; ++m) _Pragma("unroll") for (int k = 0; k < 2; ++k) dst[m][k] = *(const LAS bf16x8*)(lds + PG8_SA(b, h) + aoff + m * 2048 + k * 1024); } while (0)
#define PG8_LDB(dst, b, h) do { _Pragma("unroll") for (int n = 0; n < 2; ++n) _Pragma("unroll") for (int k = 0; k < 2; ++k) dst[n][k] = *(const LAS bf16x8*)(lds + PG8_SB(b, h) + boff + n * 2048 + k * 1024); } while (0)
#define PG8_MMA(ai, bj, At, Bt) do { __builtin_amdgcn_s_setprio(1); _Pragma("unroll") for (int m = 0; m < 4; ++m) _Pragma("unroll") for (int n = 0; n < 2; ++n) _Pragma("unroll") for (int k = 0; k < 2; ++k) \
        acc[ai][bj][m][n] = __builtin_amdgcn_mfma_f32_16x16x32_bf16(Bt[n][k], At[m][k], acc[ai][bj][m][n], 0, 0, 0); __builtin_amdgcn_s_setprio(0); } while (0)
#define PG8_WAIT_V(n) asm volatile("s_waitcnt vmcnt(" #n ")" ::: "memory")
#define PG8_WAIT_L(n) asm volatile("s_waitcnt lgkmcnt(" #n ")" ::: "memory")
#define PG8_BAR __builtin_amdgcn_s_barrier()
#define PG8_SCHED __builtin_amdgcn_sched_barrier(0)
    GU cur, nxt; int ui = 0;
    if (!S.next(0, cur)) return;
    f32x4 acc[2][2][4][2];
#pragma unroll
    for (int a = 0; a < 2; ++a)
#pragma unroll
        for (int b = 0; b < 2; ++b)
#pragma unroll
            for (int m = 0; m < 4; ++m)
#pragma unroll
                for (int n = 0; n < 2; ++n) acc[a][b][m][n] = (f32x4){0.f, 0.f, 0.f, 0.f};
    bf16x8 At[4][2], B0[2][2], B1[2][2];
    const char* cA = (const char*)cur.A; const char* cB = (const char*)cur.B;
    unsigned vA0, vA1, vB0, vB1; PG8_VOFF(cur.lda, cur.ldb, vA0, vA1, vB0, vB1);
    size_t hsA = (size_t)HALF * cur.lda * 2, hsB = (size_t)HALF * cur.ldb * 2;
    int nt = cur.nt; asm volatile("" : "+s"(nt));
    PG8_STAGE(PG8_SB(0, 0), cB, vB0, vB1); PG8_STAGE(PG8_SB(0, 1), cB + hsB, vB0, vB1); PG8_STAGE(PG8_SA(0, 0), cA, vA0, vA1); PG8_STAGE(PG8_SA(0, 1), cA + hsA, vA0, vA1);
    if (wr == 1) PG8_BAR;
    PG8_WAIT_V(2); PG8_BAR;
    PG8_STAGE(PG8_SB(1, 0), cB + kstep, vB0, vB1); PG8_STAGE(PG8_SA(1, 0), cA + kstep, vA0, vA1); PG8_STAGE(PG8_SB(1, 1), cB + hsB + kstep, vB0, vB1);
    PG8_WAIT_V(6); PG8_BAR;
    for (;;) {
        const bool has_next = S.next(ui + 1, nxt);
        const char* nA = has_next ? (const char*)nxt.A : cA; const char* nB = has_next ? (const char*)nxt.B : cB;
        unsigned nvA0 = vA0, nvA1 = vA1, nvB0 = vB0, nvB1 = vB1;
        if (has_next) PG8_VOFF(nxt.lda, nxt.ldb, nvA0, nvA1, nvB0, nvB1);
        const size_t nhsA = has_next ? (size_t)HALF * nxt.lda * 2 : hsA, nhsB = has_next ? (size_t)HALF * nxt.ldb * 2 : hsB;
        for (int t = 0; t < nt; t += 2) {
            const bool last = (t == nt - 2);
            const char* a1 = cA + (size_t)(t + 1) * kstep;
            const char* a2 = last ? nA : cA + (size_t)(t + 2) * kstep; const char* b2 = last ? nB : cB + (size_t)(t + 2) * kstep;
            const char* a3 = a2 + kstep; const char* b3 = b2 + kstep;
            const unsigned xA0 = last ? nvA0 : vA0, xA1 = last ? nvA1 : vA1, xB0 = last ? nvB0 : vB0, xB1 = last ? nvB1 : vB1;
            const size_t xhA = last ? nhsA : hsA, xhB = last ? nhsB : hsB;
            PG8_LDB(B0, 0, 0); PG8_LDB(B1, 0, 1); PG8_SCHED; PG8_LDA(At, 0, 0); PG8_STAGE(PG8_SA(1, 1), a1 + hsA, vA0, vA1);
            PG8_WAIT_V(8); PG8_WAIT_L(0); PG8_BAR; PG8_MMA(0, 0, At, B0); PG8_MMA(0, 1, At, B1); PG8_BAR; PG8_SCHED;
            PG8_LDA(At, 0, 1); PG8_STAGE(PG8_SB(0, 0), b2, xB0, xB1); PG8_STAGE(PG8_SB(0, 1), b2 + xhB, xB0, xB1); PG8_STAGE(PG8_SA(0, 0), a2, xA0, xA1);
            PG8_WAIT_V(8); PG8_WAIT_L(0); PG8_BAR; PG8_MMA(1, 0, At, B0); PG8_MMA(1, 1, At, B1); PG8_BAR; PG8_SCHED;
            PG8_LDB(B0, 1, 0); PG8_LDB(B1, 1, 1); PG8_SCHED; PG8_LDA(At, 1, 0); PG8_STAGE(PG8_SA(0, 1), a2 + xhA, xA0, xA1);
            PG8_WAIT_V(8); PG8_WAIT_L(0); PG8_BAR; PG8_MMA(0, 0, At, B0); PG8_MMA(0, 1, At, B1); PG8_BAR; PG8_SCHED;
            PG8_LDA(At, 1, 1); PG8_STAGE(PG8_SB(1, 0), b3, xB0, xB1); PG8_STAGE(PG8_SB(1, 1), b3 + xhB, xB0, xB1); PG8_STAGE(PG8_SA(1, 0), a3, xA0, xA1);
            PG8_WAIT_V(8); PG8_WAIT_L(0); PG8_BAR; PG8_MMA(1, 0, At, B0); PG8_MMA(1, 1, At, B1); PG8_BAR; PG8_SCHED;
        }
        if (wr == 0) PG8_BAR;
        const bool keep = E(acc, cur, wr, wc, fr, fq);
        if (!has_next) break;
        if (!keep) {
#pragma unroll
            for (int a = 0; a < 2; ++a)
#pragma unroll
                for (int b = 0; b < 2; ++b)
#pragma unroll
                    for (int m = 0; m < 4; ++m)
#pragma unroll
                        for (int n = 0; n < 2; ++n) acc[a][b][m][n] = (f32x4){0.f, 0.f, 0.f, 0.f};
        }
        cur = nxt; cA = nA; cB = nB; vA0 = nvA0; vA1 = nvA1; vB0 = nvB0; vB1 = nvB1; hsA = nhsA; hsB = nhsB; nt = cur.nt; asm volatile("" : "+s"(nt)); ++ui;
        if (wr == 1) PG8_BAR;
    }
    PG8_WAIT_V(0);
    PG8_BAR;
#undef PG8_VOFF
#undef PG8_SA
#undef PG8_SB
#undef PG8_STAGE
#undef PG8_LDA
#undef PG8_LDB
#undef PG8_MMA
#undef PG8_WAIT_V
#undef PG8_WAIT_L
#undef PG8_BAR
#undef PG8_SCHED
}

__device__ __forceinline__ bool tile_order(int i, int G, int c, int nM, int nN, int& pm, int& pn) {
    const int nwg = nM * nN; const long L = (long)i * G + c; if (L >= nwg) return false;
    int wgid = (int)L; { const int q = nwg / 8, r = nwg % 8, xcd = wgid % 8, off = wgid / 8; wgid = (xcd < r ? xcd * (q + 1) : r * (q + 1) + (xcd - r) * q) + off; }
    const int nig = 8 * nN, gid = wgid / nig, fm = gid * 8, gsz = (nM - fm) < 8 ? (nM - fm) : 8;
    pm = fm + ((wgid % nig) % gsz); pn = (wgid % nig) / gsz; return true;
}
}
using pg8::GU;
enum InIdx { I_X = 0, I_META, I_FNW, I_MIXNW, I_WIN, I_S5LRE, I_S5LIM, I_S5LS, I_S5BRE, I_S5BIM, I_S5CRE, I_S5CIM, I_S5D, I_GLUW, I_GLUB,
             I_CONVW, I_CONVB, I_ALOG, I_DTB, I_SSDD, I_SSDNW, I_MURKV, I_MUWAG, I_W0, I_W1, I_W2, I_A0, I_A1, I_A2, I_G1, I_G2, I_KK, I_KA, I_RK, I_LNW, I_LNB,
             I_PA, I_PB, I_PC, I_WOUT, I_MLPNW, I_MLPW1, I_MLPW2, N_INPUTS };
struct Params { const float* in[N_INPUTS]; float* out; unsigned char* ws; int ph_lo, ph_hi; };

struct Ctx {
    const float* const* in; unsigned char* ws; unsigned char* dout;
    LAS unsigned char* lds;
    int tid, lane, wave, G, bid;
    __device__ __forceinline__ bf16_t* wb(int layer) const { return (bf16_t*)(layer == 0 ? ws + WS_WB0 : dout + DO_WB1); }
    __device__ __forceinline__ bf16_t* H() const { return (bf16_t*)(ws + WS_H); }
    __device__ __forceinline__ float* ssq() const { return (float*)(ws + WS_SSQ); }
};
__device__ __forceinline__ Ctx relaunder(const Ctx& c0) { Ctx c = c0; c.tid = opaque_tid(); c.lane = c.tid & 63; c.wave = __builtin_amdgcn_readfirstlane(c.tid >> 6); return c; }
__device__ __forceinline__ float row_scale(const float* ssq, int row) {
    const f32x4* p = (const f32x4*)(ssq + (size_t)row * 16);
    const f32x4 a = p[0], b = p[1], c = p[2], d = p[3];
    const float s = ((a.x + a.y) + (a.z + a.w)) + ((b.x + b.y) + (b.z + b.w)) + ((c.x + c.y) + (c.z + c.w)) + ((d.x + d.y) + (d.z + d.w));
    return __builtin_amdgcn_rsqf(s * (1.0f / DM) + EPS);
}

struct SchedPlain {
    const bf16_t* A; const bf16_t* B; int lda, ldb, K, nM, nN, G, c;
    __device__ __forceinline__ bool next(int i, GU& u) const {
        int pm, pn; if (!pg8::tile_order(i, G, c, nM, nN, pm, pn)) return false;
        u.A = A + (size_t)pm * 256 * lda; u.B = B + (size_t)pn * 256 * ldb; u.lda = lda; u.ldb = ldb; u.nt = K / 64; u.pm = pm; u.pn = pn; u.kind = 0; return true;
    }
};
struct SchedS5 {
    const bf16_t* UH; const bf16_t* W; int K, G, c;
    __device__ __forceinline__ bool next(int i, GU& u) const {
        const int L = i * G + c; if (L >= 144) return false;
        const int g = L / 9, pm = L % 9;
        u.A = UH + ((size_t)g * S5RP + (size_t)pm * 256) * 512; u.B = W + (size_t)g * 256 * K; u.lda = 512; u.ldb = K; u.nt = K / 64; u.pm = pm; u.pn = 0; u.kind = g; return true;
    }
};
struct SchedL2 {
    const bf16_t* L1o; const bf16_t* W; int G, c;
    __device__ __forceinline__ bool next(int i, GU& u) const {
        int pm, pn; if (!pg8::tile_order(i, G, c, MP / 256, 5, pm, pn)) return false;
        const int koff = pn < 2 ? 0 : (pn < 4 ? 128 : 256);
        u.A = L1o + (size_t)pm * 256 * 512 + koff; u.B = W + (size_t)pn * 256 * 256; u.lda = 512; u.ldb = 256; u.nt = 4; u.pm = pm; u.pn = pn; u.kind = 0; return true;
    }
};
struct SchedProj {
    const bf16_t* Hb; const bf16_t* Wg; const bf16_t* Wp; const bf16_t* ya; const bf16_t* yb; const bf16_t* yc; int G, c;
    __device__ __forceinline__ bool next(int i, GU& u) const {
        const int ti = i / 6, sub = i - ti * 6; int pm, pn;
        if (!pg8::tile_order(ti, G, c, MP / 256, 4, pm, pn)) return false;
        u.pm = pm; u.pn = pn; u.kind = sub;
        if (sub < 3) { u.A = Hb + (size_t)pm * 256 * DM; u.lda = DM; u.B = Wg + ((size_t)sub * 1024 + (size_t)pn * 256) * DM; u.ldb = DM; u.nt = 16; }
        else if (sub == 3) { u.A = ya + (size_t)pm * 256 * 256; u.lda = 256; u.B = Wp + (size_t)pn * 256 * DM; u.ldb = DM; u.nt = 4; }
        else if (sub == 4) { u.A = yb + (size_t)pm * 256 * 512; u.lda = 512; u.B = Wp + (size_t)pn * 256 * DM + 256; u.ldb = DM; u.nt = 8; }
        else { u.A = yc + (size_t)pm * 256 * 256; u.lda = 256; u.B = Wp + (size_t)pn * 256 * DM + 768; u.ldb = DM; u.nt = 4; }
        return true;
    }
};

typedef f32x4 Acc[2][2][4][2];
#define EPI_ROWS_BEGIN  _Pragma("unroll") for (int ai = 0; ai < 2; ++ai) _Pragma("unroll") for (int m = 0; m < 4; ++m) { const int rl = ai * 128 + wr * 64 + m * 16 + fr; const int row = u.pm * 256 + rl; (void)rl;
#define EPI_ROWS_END    }
#define EPI_COL(bj) ((bj) * 128 + wc * 32 + fq * 8)

struct EpiInProj {
    const float* ssq; bf16_t* UH; bf16_t* Pz; bf16_t* Pxbc; bf16_t* Prkvx;
    __device__ __forceinline__ bool operator()(Acc& acc, const GU& u, int wr, int wc, int fr, int fq) const {
        EPI_ROWS_BEGIN
            if (row < M_ROWS) {
                const float s = row_scale(ssq, row);
                const int b = row / LEN, t = row - b * LEN;
#pragma unroll
                for (int bj = 0; bj < 2; ++bj) {
                    const int col = EPI_COL(bj);
                    const f32x4 v0 = acc[ai][bj][m][0] * s, v1 = acc[ai][bj][m][1] * s;
                    u32x4 w; w.x = pk2(v0[0], v0[1]); w.y = pk2(v0[2], v0[3]); w.z = pk2(v1[0], v1[1]); w.w = pk2(v1[2], v1[3]);
                    bf16_t* dst;
                    if (u.pn == 0) { const int g = col >> 4, hh = col & 15; dst = UH + ((size_t)g * S5RP + (size_t)(b * NCH16 + (t >> 4))) * 512 + (t & 15) * 16 + hh; }
                    else if (u.pn < 3) dst = Pz + (size_t)row * 512 + (u.pn - 1) * 256 + col;
                    else if (u.pn < 7) dst = Pxbc + (size_t)row * 1024 + (u.pn - 3) * 256 + col;
                    else dst = Prkvx + (size_t)row * 1024 + (u.pn - 7) * 256 + col;
                    *(u32x4*)dst = w;
                }
            }
        EPI_ROWS_END
        return false;
    }
};
struct EpiS5X {
    float* X;
    __device__ __forceinline__ bool operator()(Acc& acc, const GU& u, int wr, int wc, int fr, int fq) const {
        EPI_ROWS_BEGIN
            float* rp = X + ((size_t)u.kind * S5RP + row) * 256;
#pragma unroll
            for (int bj = 0; bj < 2; ++bj) { const int col = EPI_COL(bj); *(f32x4*)(rp + col) = acc[ai][bj][m][0]; *(f32x4*)(rp + col + 4) = acc[ai][bj][m][1]; }
        EPI_ROWS_END
        return false;
    }
};
struct EpiS5Y {
    bf16_t* yapre;
    __device__ __forceinline__ bool operator()(Acc& acc, const GU& u, int wr, int wc, int fr, int fq) const {
        EPI_ROWS_BEGIN
            if (row < S5ROWS) {
                const int b = row / NCH16, c = row - b * NCH16;
#pragma unroll
                for (int bj = 0; bj < 2; ++bj) {
                    const int col = EPI_COL(bj), i = col >> 4, hh = col & 15;
                    const f32x4 v0 = acc[ai][bj][m][0], v1 = acc[ai][bj][m][1];
                    u32x4 w; w.x = pk2(geluf_(v0[0]), geluf_(v0[1])); w.y = pk2(geluf_(v0[2]), geluf_(v0[3])); w.z = pk2(geluf_(v1[0]), geluf_(v1[1])); w.w = pk2(geluf_(v1[2]), geluf_(v1[3]));
                    *(u32x4*)(yapre + ((size_t)b * LEN + c * 16 + i) * 256 + u.kind * 16 + hh) = w;
                }
            }
        EPI_ROWS_END
        return false;
    }
};
struct EpiL1 {
    bf16_t* L1o;
    __device__ __forceinline__ bool operator()(Acc& acc, const GU& u, int wr, int wc, int fr, int fq) const {
        EPI_ROWS_BEGIN
#pragma unroll
            for (int bj = 0; bj < 2; ++bj) {
                const int col = EPI_COL(bj); const int mode = u.pn * 2 + bj;
                f32x4 v0 = acc[ai][bj][m][0], v1 = acc[ai][bj][m][1]; float f[8] = {v0[0], v0[1], v0[2], v0[3], v1[0], v1[1], v1[2], v1[3]};
#pragma unroll
                for (int e = 0; e < 8; ++e) f[e] = mode == 0 ? tanhf_(f[e]) : (mode == 1 ? f[e] : (mode == 2 ? sigmoidf_(f[e]) : 0.f));
                *(u32x4*)(L1o + (size_t)row * 512 + u.pn * 256 + col) = pack8(f);
            }
        EPI_ROWS_END
        return false;
    }
};
struct EpiL2 {
    bf16_t* L2o; const float* w0; const float* a0;
    __device__ __forceinline__ bool operator()(Acc& acc, const GU& u, int wr, int wc, int fr, int fq) const {
        EPI_ROWS_BEGIN
#pragma unroll
            for (int bj = 0; bj < 2; ++bj) {
                const int col = EPI_COL(bj);
                f32x4 v0 = acc[ai][bj][m][0], v1 = acc[ai][bj][m][1]; float f[8] = {v0[0], v0[1], v0[2], v0[3], v1[0], v1[1], v1[2], v1[3]};
                if (u.pn < 2) {
                    const float* bp = w0 + u.pn * 256 + col;
#pragma unroll
                    for (int e = 0; e < 8; ++e) { const float v = bp[e] + f[e]; f[e] = -__expf(-softplusf_(-v) - 0.5f); }
                } else if (u.pn < 4) {
                    const float* bp = a0 + (u.pn - 2) * 256 + col;
#pragma unroll
                    for (int e = 0; e < 8; ++e) f[e] = sigmoidf_(bp[e] + f[e]);
                }
                *(u32x4*)(L2o + (size_t)row * 1280 + u.pn * 256 + col) = pack8(f);
            }
        EPI_ROWS_END
        return false;
    }
};
struct EpiGLU {
    bf16_t* ya; const float* bias;
    __device__ __forceinline__ bool operator()(Acc& acc, const GU& u, int wr, int wc, int fr, int fq) const {
        const int lc = wc * 32 + fq * 8, oc = u.pn * 128 + lc;
        float bv[8], bg[8];
#pragma unroll
        for (int e = 0; e < 8; ++e) { bv[e] = bias[oc + e]; bg[e] = bias[256 + oc + e]; }
        EPI_ROWS_BEGIN
            const f32x4 a0 = acc[ai][0][m][0], a1 = acc[ai][0][m][1], g0 = acc[ai][1][m][0], g1 = acc[ai][1][m][1];
            float v[8] = {a0[0], a0[1], a0[2], a0[3], a1[0], a1[1], a1[2], a1[3]}, g[8] = {g0[0], g0[1], g0[2], g0[3], g1[0], g1[1], g1[2], g1[3]};
#pragma unroll
            for (int e = 0; e < 8; ++e) v[e] = (v[e] + bv[e]) * sigmoidf_(g[e] + bg[e]);
            *(u32x4*)(ya + (size_t)row * 256 + oc) = pack8(v);
        EPI_ROWS_END
        return false;
    }
};
struct EpiProj {
    const float* ssq; unsigned char* park; bf16_t* merged; int tid;
    __device__ __forceinline__ bool operator()(Acc& acc, const GU& u, int wr, int wc, int fr, int fq) const {
        const int k = u.kind;
        EPI_ROWS_BEGIN
            float s = 1.f; if (k < 3) s = row_scale(ssq, row < M_ROWS ? row : 0);
#pragma unroll
            for (int bj = 0; bj < 2; ++bj) {
                const int q = (ai * 2 + bj) * 4 + m;
                f32x4& v0 = acc[ai][bj][m][0]; f32x4& v1 = acc[ai][bj][m][1];
                if (k < 3) {
                    float f[8] = {v0[0], v0[1], v0[2], v0[3], v1[0], v1[1], v1[2], v1[3]};
#pragma unroll
                    for (int e = 0; e < 8; ++e) f[e] = sigmoidf_(f[e] * s);
                    *(u32x4*)(park + ((size_t)(k * 16 + q) * NTHREADS + tid) * 16) = pack8(f);
                } else {
                    float num[8], den[8];
                    unpack8(*(const u32x4*)(park + ((size_t)((k - 3) * 16 + q) * NTHREADS + tid) * 16), num);
                    if (k < 5) { unpack8(*(const u32x4*)(park + ((size_t)((k - 2) * 16 + q) * NTHREADS + tid) * 16), den);
#pragma unroll
                        for (int e = 0; e < 8; ++e) num[e] = num[e] * __builtin_amdgcn_rcpf(den[e]); }
                    v0[0] *= num[0]; v0[1] *= num[1]; v0[2] *= num[2]; v0[3] *= num[3]; v1[0] *= num[4]; v1[1] *= num[5]; v1[2] *= num[6]; v1[3] *= num[7];
                    if (k == 5) { u32x4 w; w.x = pk2(v0[0], v0[1]); w.y = pk2(v0[2], v0[3]); w.z = pk2(v1[0], v1[1]); w.w = pk2(v1[2], v1[3]);
                        *(u32x4*)(merged + (size_t)row * DM + u.pn * 256 + EPI_COL(bj)) = w; }
                }
            }
        EPI_ROWS_END
        return k == 3 || k == 4;
    }
};
struct EpiResid {
    bf16_t* H; float* ssq;
    __device__ __forceinline__ bool operator()(Acc& acc, const GU& u, int wr, int wc, int fr, int fq) const {
        EPI_ROWS_BEGIN
            float ss = 0.f;
            if (row < M_ROWS) {
#pragma unroll
                for (int bj = 0; bj < 2; ++bj) {
                    bf16_t* hp = H + (size_t)row * DM + u.pn * 256 + EPI_COL(bj);
                    float f[8]; unpack8(*(const u32x4*)hp, f);
                    const f32x4 v0 = acc[ai][bj][m][0], v1 = acc[ai][bj][m][1];
                    f[0] += v0[0]; f[1] += v0[1]; f[2] += v0[2]; f[3] += v0[3]; f[4] += v1[0]; f[5] += v1[1]; f[6] += v1[2]; f[7] += v1[3];
#pragma unroll
                    for (int e = 0; e < 8; ++e) ss += f[e] * f[e];
                    *(u32x4*)hp = pack8(f);
                }
            }
            ss += __shfl_xor(ss, 16); ss += __shfl_xor(ss, 32);
            if (fq == 0 && row < M_ROWS) ssq[(size_t)row * 16 + u.pn * 4 + wc] = ss;
        EPI_ROWS_END
        return false;
    }
};
struct EpiUp {
    const float* ssq; bf16_t* act;
    __device__ __forceinline__ bool operator()(Acc& acc, const GU& u, int wr, int wc, int fr, int fq) const {
        EPI_ROWS_BEGIN
            const float s = row_scale(ssq, row < M_ROWS ? row : 0);
#pragma unroll
            for (int bj = 0; bj < 2; ++bj) {
                const f32x4 v0 = acc[ai][bj][m][0] * s, v1 = acc[ai][bj][m][1] * s; float f[8] = {v0[0], v0[1], v0[2], v0[3], v1[0], v1[1], v1[2], v1[3]};
#pragma unroll
                for (int e = 0; e < 8; ++e) { const float r = fmaxf(f[e], 0.f); f[e] = r * r; }
                *(u32x4*)(act + (size_t)row * DFF + u.pn * 256 + EPI_COL(bj)) = pack8(f);
            }
        EPI_ROWS_END
        return false;
    }
};
struct TJob { const float* src; int ld, col0, K, N; bf16_t* dst; int dld, dk0, rmode, row0; const float* ksc; };
constexpr int N_TJOBS = 27;
__device__ __forceinline__ void get_tjob(const Ctx& c, int l, int j, TJob& t) {
    bf16_t* wb = c.wb(l);
    const float* win = c.in[I_WIN] + (size_t)l * DM * N_IN;
    t.rmode = 0; t.ksc = nullptr; t.dk0 = 0; t.col0 = 0; t.row0 = 0;
    if (j < 5) {
        t.src = win; t.ld = N_IN; t.K = DM; t.dld = DM; t.ksc = c.in[I_MIXNW] + l * DM; t.dst = wb + WB_IN;
        if (j == 0) { t.col0 = 0; t.N = 256; t.row0 = 0; }
        else if (j == 1) { t.col0 = 256; t.N = 512; t.row0 = 256; }
        else if (j == 2) { t.col0 = 768; t.N = 1024; t.row0 = 768; }
        else if (j == 3) { t.col0 = 1800; t.N = 1024; t.row0 = 1792; }
        else { t.col0 = 2824; t.N = 3072; t.row0 = 0; t.dst = wb + WB_G; }
    } else if (j == 5) { t.src = c.in[I_PA] + (size_t)l * 256 * DM; t.ld = DM; t.K = 256; t.N = DM; t.dst = wb + WB_P; t.dld = DM; t.dk0 = 0; }
    else if (j == 6) { t.src = c.in[I_PB] + (size_t)l * 512 * DM; t.ld = DM; t.K = 512; t.N = DM; t.dst = wb + WB_P; t.dld = DM; t.dk0 = 256; }
    else if (j == 7) { t.src = c.in[I_PC] + (size_t)l * 256 * DM; t.ld = DM; t.K = 256; t.N = DM; t.dst = wb + WB_P; t.dld = DM; t.dk0 = 768; }
    else if (j == 8) { t.src = c.in[I_WOUT] + (size_t)l * DM * DM; t.ld = DM; t.K = DM; t.N = DM; t.dst = wb + WB_O; t.dld = DM; }
    else if (j == 9) { t.src = c.in[I_MLPW1] + (size_t)l * DM * DFF; t.ld = DFF; t.K = DM; t.N = DFF; t.dst = wb + WB_1; t.dld = DM; t.ksc = c.in[I_MLPNW] + l * DM; }
    else if (j == 10) { t.src = c.in[I_MLPW2] + (size_t)l * DFF * DM; t.ld = DM; t.K = DFF; t.N = DM; t.dst = wb + WB_2; t.dld = DFF; }
    else if (j == 11) { t.src = c.in[I_GLUW] + (size_t)l * 256 * 512; t.ld = 512; t.K = 256; t.N = 512; t.dst = wb + WB_GLU; t.dld = 256; t.rmode = 1; }
    else if (j < 22) {
        const int q = j - 12;
        t.K = 256; t.dst = wb + WB_L1; t.dld = 512;
        if (q < 4) { const int d = q >> 1, hf = q & 1; t.src = c.in[I_W1] + ((size_t)l * 2 + d) * 256 * 64; t.ld = 64; t.N = 64; t.row0 = d * 64; t.dk0 = hf * 256; if (hf) t.ksc = c.in[I_MUWAG] + ((size_t)l * 3 + 0) * 256; }
        else if (q < 8) { const int d = (q - 4) >> 1, hf = q & 1; t.src = c.in[I_A1] + ((size_t)l * 2 + d) * 256 * 64; t.ld = 64; t.N = 64; t.row0 = 128 + d * 64; t.dk0 = hf * 256; if (hf) t.ksc = c.in[I_MUWAG] + ((size_t)l * 3 + 1) * 256; }
        else { const int hf = q & 1; t.src = c.in[I_G1] + (size_t)l * 256 * 128; t.ld = 128; t.N = 128; t.row0 = 256; t.dk0 = hf * 256; if (hf) t.ksc = c.in[I_MUWAG] + ((size_t)l * 3 + 2) * 256; }
    } else {
        const int q = j - 22;
        t.dst = wb + WB_L2; t.dld = 256; t.ld = 256; t.N = 256;
        if (q < 2) { t.src = c.in[I_W2] + ((size_t)l * 2 + q) * 64 * 256; t.K = 64; t.row0 = q * 256; t.dk0 = q * 64; }
        else if (q < 4) { const int d = q - 2; t.src = c.in[I_A2] + ((size_t)l * 2 + d) * 64 * 256; t.K = 64; t.row0 = (2 + d) * 256; t.dk0 = d * 64; }
        else { t.src = c.in[I_G2] + (size_t)l * 128 * 256; t.K = 128; t.row0 = 4 * 256; t.dk0 = 0; }
    }
}
__device__ __forceinline__ int tjob_items(const TJob& t) { return (t.K / 64) * (t.N / 32); }
__device__ __forceinline__ void transpose_item(const TJob& t, LAS float* scr, int item, int lane) {
    const int nblk = t.N / 32, kb = item / nblk, nb = item % nblk, k0 = 64 * kb, n0 = 32 * nb;
#pragma unroll 8
    for (int i = 0; i < 32; ++i) { const int kk = 2 * i + (lane >> 5); float v = t.src[(size_t)(k0 + kk) * t.ld + t.col0 + n0 + (lane & 31)]; if (t.ksc) v *= t.ksc[k0 + kk]; scr[kk * 33 + (lane & 31)] = v; }
    asm volatile("s_waitcnt lgkmcnt(0)" ::: "memory");
    const int cc = lane & 7;
#pragma unroll
    for (int j = 0; j < 4; ++j) {
        const int n = (lane >> 3) + 8 * j; const LAS float* s = scr + (8 * cc) * 33 + n;
        u32x4 o; o.x = pk2(s[0 * 33], s[1 * 33]); o.y = pk2(s[2 * 33], s[3 * 33]); o.z = pk2(s[4 * 33], s[5 * 33]); o.w = pk2(s[6 * 33], s[7 * 33]);
        const int nn = n0 + n; int drow;
        if (t.rmode == 0) drow = t.row0 + nn; else drow = nn < 256 ? (nn >> 7) * 256 + (nn & 127) : ((nn - 256) >> 7) * 256 + 128 + ((nn - 256) & 127);
        *(u32x4*)(t.dst + (size_t)drow * t.dld + t.dk0 + k0 + 8 * cc) = o;
    }
    asm volatile("s_waitcnt lgkmcnt(0)" ::: "memory");
}

__device__ __forceinline__ void s5_build(const Ctx& cx_, int l, int g) {
    const Ctx c = relaunder(cx_);
    LAS float* F = (LAS float*)c.lds;
    LAS float* pwr = F;
    LAS float* pwi = pwr + 2176;
    LAS float* cor = pwi + 2176;
    LAS float* coi = cor + 128;
    LAS float* Cr = coi + 128;
    LAS float* Ci = Cr + 1024;
    LAS float* Br = Ci + 1024;
    LAS float* Bi = Br + 1024;
    LAS float* kr = Bi + 1024;
    LAS float* ki = kr + 1984;
    LAS float* Kd = ki + 1984;
    const int tid = c.tid;
    if (tid < 128) {
        const int d = tid >> 6, n = tid & 63; const size_t li_ = (((size_t)l * 2 + d) * 16 + g) * 64 + n;
        const float lr = c.in[I_S5LRE][li_], li = c.in[I_S5LIM][li_], step = expf(c.in[I_S5LS][((size_t)l * 2 + d) * 16 + g]);
        for (int k = 0; k <= 16; ++k) { const float mag = expf((float)k * lr * step), ang = (float)k * li * step; float sn, cs; sincosf(ang, &sn, &cs); pwr[(d * 17 + k) * 64 + n] = mag * cs; pwi[(d * 17 + k) * 64 + n] = mag * sn; }
        const float mag1 = expf(lr * step); float sn, cs; sincosf(li * step, &sn, &cs); const float abr = mag1 * cs, abi = mag1 * sn, den = lr * lr + li * li;
        cor[d * 64 + n] = ((abr - 1.f) * lr + abi * li) / den; coi[d * 64 + n] = (abi * lr - (abr - 1.f) * li) / den;
    }
    for (int i = tid; i < 1024; i += NTHREADS) {
        Cr[i] = c.in[I_S5CRE][((size_t)l * 16 + g) * 1024 + i]; Ci[i] = c.in[I_S5CIM][((size_t)l * 16 + g) * 1024 + i];
        Br[i] = c.in[I_S5BRE][((size_t)l * 16 + g) * 1024 + i]; Bi[i] = c.in[I_S5BIM][((size_t)l * 16 + g) * 1024 + i];
    }
    __syncthreads();
    for (int i = tid; i < 31 * 64; i += NTHREADS) {
        const int dd = i / 64 - 15, n = i & 63; float r, im;
        if (dd > 0) { const float pr = pwr[(0 * 17 + dd) * 64 + n], pi = pwi[(0 * 17 + dd) * 64 + n]; r = pr * cor[n] - pi * coi[n]; im = pr * coi[n] + pi * cor[n]; }
        else if (dd < 0) { const float pr = pwr[(1 * 17 - dd) * 64 + n], pi = pwi[(1 * 17 - dd) * 64 + n]; r = pr * cor[64 + n] - pi * coi[64 + n]; im = pr * coi[64 + n] + pi * cor[64 + n]; }
        else { r = cor[n] + cor[64 + n]; im = coi[n] + coi[64 + n]; }
        kr[i] = r; ki[i] = im;
    }
    __syncthreads();
    for (int i = tid; i < 31 * 256; i += NTHREADS) {
        const int ddi = i >> 8, h = (i >> 4) & 15, hp = i & 15; float a = 0.f;
        for (int n = 0; n < 64; ++n) { const float cr = Cr[h * 64 + n], ci = Ci[h * 64 + n], xr = kr[ddi * 64 + n], xi = ki[ddi * 64 + n]; const float pr = cr * xr - ci * xi, pi = cr * xi + ci * xr; a += pr * Br[n * 16 + hp] - pi * Bi[n * 16 + hp]; }
        Kd[i] = a;
    }
    __syncthreads();
    bf16_t* SX = c.wb(l) + WB_SX + (size_t)g * 256 * 256; bf16_t* SY = c.wb(l) + WB_SY + (size_t)g * 256 * 512;
    const float* dsk = c.in[I_S5D] + (size_t)l * 256 + g * 16;
    for (int u = tid; u < 256 * 64; u += NTHREADS) {
        const int o = u >> 6, kk0 = (u & 63) * 8, i = o >> 4, h = o & 15; float v[8];
        if (kk0 < 256) { const int j = kk0 >> 4, hp0 = kk0 & 15;
#pragma unroll
            for (int e = 0; e < 8; ++e) v[e] = Kd[(i - j + 15) * 256 + h * 16 + hp0 + e] + ((i == j && h == hp0 + e) ? dsk[h] : 0.f);
        } else { const int q = kk0 - 256, d = q >> 7, part = (q >> 6) & 1, n0 = q & 63, ex = d == 0 ? i + 1 : 16 - i;
#pragma unroll
            for (int e = 0; e < 8; ++e) { const int n = n0 + e; const float cr = Cr[h * 64 + n], ci = Ci[h * 64 + n], pr = pwr[(d * 17 + ex) * 64 + n], pi = pwi[(d * 17 + ex) * 64 + n]; v[e] = part == 0 ? (cr * pr - ci * pi) : -(cr * pi + ci * pr); }
        }
        *(u32x4*)(SY + (size_t)o * 512 + kk0) = pack8(v);
    }
    for (int u = tid; u < 256 * 32; u += NTHREADS) {
        const int o = u >> 5, kk0 = (u & 31) * 8, d = o >> 7, part = (o >> 6) & 1, n = o & 63, j = kk0 >> 4, hp0 = kk0 & 15, ex = d == 0 ? 15 - j : j;
        const float pr = pwr[(d * 17 + ex) * 64 + n], pi = pwi[(d * 17 + ex) * 64 + n], qr = pr * cor[d * 64 + n] - pi * coi[d * 64 + n], qi = pr * coi[d * 64 + n] + pi * cor[d * 64 + n];
        float v[8];
#pragma unroll
        for (int e = 0; e < 8; ++e) { const float br = Br[n * 16 + hp0 + e], bi = Bi[n * 16 + hp0 + e]; v[e] = part == 0 ? (qr * br - qi * bi) : (qr * bi + qi * br); }
        *(u32x4*)(SX + (size_t)o * 256 + kk0) = pack8(v);
    }
    __syncthreads();
}

__device__ __forceinline__ void phase0(const Ctx& cx_) {
    const Ctx c = relaunder(cx_);
    if (c.bid < 32) s5_build(c, c.bid >> 4, c.bid & 15);
    const int gw = c.bid * NWAVES + c.wave, NGW = c.G * NWAVES, lane = c.lane;
    bf16_t* H = c.H(); float* ssq = c.ssq();
    for (int m = gw; m < MP; m += NGW) {
        u32x2* hp = (u32x2*)(H + (size_t)m * DM);
        if (m >= M_ROWS) {
#pragma unroll
            for (int i = 0; i < 4; ++i) hp[lane + 64 * i] = (u32x2){0u, 0u};
            continue;
        }
        const int b = m / LEN, t = m - b * LEN;
        const f32x4* src = (const f32x4*)(t < NMETA ? c.in[I_META] + (size_t)t * DM : c.in[I_X] + ((size_t)b * SEQ + (t - NMETA)) * DM);
        float ss = 0.f;
#pragma unroll
        for (int i = 0; i < 4; ++i) { const f32x4 v = src[lane + 64 * i]; ss += (v.x * v.x + v.y * v.y) + (v.z * v.z + v.w * v.w); hp[lane + 64 * i] = (u32x2){pk2(v.x, v.y), pk2(v.z, v.w)}; }
        ss = wave_sum(ss);
        if (lane < 16) ssq[(size_t)m * 16 + lane] = lane == 0 ? ss : 0.f;
    }
    LAS float* scr = (LAS float*)(c.lds + c.wave * 8448);
    for (int l = 0; l < DEPTH; ++l) {
        int base = 0;
        for (int j = 0; j < N_TJOBS; ++j) {
            TJob t; get_tjob(c, l, j, t); const int ni = tjob_items(t);
            int first = (gw - base % NGW + NGW) % NGW;
            for (int it = first; it < ni; it += NGW) transpose_item(t, scr, it, lane);
            base += ni;
        }
        bf16_t* wb = c.wb(l);
        const int gt = c.bid * NTHREADS + c.tid, NGT = c.G * NTHREADS;
        for (int u = gt; u < 128 * 64; u += NGT) *(u32x4*)(wb + WB_L1 + (size_t)384 * 512 + (size_t)u * 8) = (u32x4){0u, 0u, 0u, 0u};
        for (int u = gt; u < 5 * 256 * 4 * 8; u += NGT) {
            const int sub = u & 7, blk = (u >> 3) & 3, row = (u >> 5) & 255, tile = u >> 13;
            const bool nz = (tile == 0 || tile == 2) ? (blk == 0) : ((tile == 1 || tile == 3) ? (blk == 1) : (blk < 2));
            if (!nz) *(u32x4*)(wb + WB_L2 + ((size_t)tile * 256 + row) * 256 + blk * 64 + sub * 8) = (u32x4){0u, 0u, 0u, 0u};
        }
    }
}

__device__ __forceinline__ void dt_job(const Ctx& cx_, int l) {
    const Ctx c = relaunder(cx_);
    LAS float* dtw = (LAS float*)c.lds;
    const float* win = c.in[I_WIN] + (size_t)l * DM * N_IN; const float* nw = c.in[I_MIXNW] + l * DM;
    for (int i = c.tid; i < 8 * DM; i += NTHREADS) { const int k = i >> 3, j = i & 7; dtw[j * DM + k] = nw[k] * win[(size_t)k * N_IN + 1792 + j]; }
    __syncthreads();
    const int gw = c.bid * NWAVES + c.wave, NGW = c.G * NWAVES, lane = c.lane;
    const bf16_t* H = c.H(); float* dt = (float*)(c.ws + WS_DT); float* dec = (float*)(c.ws + WS_DEC);
    const float* dtb = c.in[I_DTB] + l * 16; const float* alog = c.in[I_ALOG] + l * 16;
    for (int m = gw; m < M_ROWS; m += NGW) {
        const u32x2* hp = (const u32x2*)(H + (size_t)m * DM);
        float ss = 0.f, d8[8] = {0.f, 0.f, 0.f, 0.f, 0.f, 0.f, 0.f, 0.f};
#pragma unroll
        for (int i = 0; i < 4; ++i) {
            const u32x2 w = hp[lane + 64 * i]; const float h0 = bflo(w.x), h1 = bfhi(w.x), h2 = bflo(w.y), h3 = bfhi(w.y);
            ss += (h0 * h0 + h1 * h1) + (h2 * h2 + h3 * h3);
#pragma unroll
            for (int j = 0; j < 8; ++j) { const f32x4 wv = *(const LAS f32x4*)(dtw + j * DM + 4 * lane + 256 * i); d8[j] += (h0 * wv.x + h1 * wv.y) + (h2 * wv.z + h3 * wv.w); }
        }
        ss = wave_sum(ss);
#pragma unroll
        for (int j = 0; j < 8; ++j) d8[j] = wave_sum(d8[j]);
        const float s = __builtin_amdgcn_rsqf(ss * (1.0f / DM) + EPS);
        if (lane < 16) {
            const int j = lane & 7; float raw = d8[0];
#pragma unroll
            for (int e = 1; e < 8; ++e) raw = (j == e) ? d8[e] : raw;
            const float dtv = softplusf_(raw * s + dtb[lane]);
            dt[(size_t)m * 16 + lane] = dtv; dec[(size_t)m * 16 + lane] = __expf(-dtv * __expf(alog[lane]));
        }
    }
    __syncthreads();
}

__device__ __forceinline__ void rwkv_prep(const Ctx& cx_, int l) {
    const Ctx c = relaunder(cx_);
    const int gw = c.bid * NWAVES + c.wave, NGW = c.G * NWAVES, lane = c.lane, c0 = 4 * lane;
    const bf16_t* P = (const bf16_t*)(c.ws + WS_PRKVX); bf16_t* rk = (bf16_t*)(c.dout + DO_RKVP); bf16_t* l1 = (bf16_t*)(c.ws + WS_L1IN);
    float mu[3][4], kkw[4];
#pragma unroll
    for (int x = 0; x < 3; ++x)
#pragma unroll
        for (int e = 0; e < 4; ++e) mu[x][e] = c.in[I_MURKV][((size_t)l * 3 + x) * 256 + c0 + e];
#pragma unroll
    for (int e = 0; e < 4; ++e) kkw[e] = c.in[I_KK][(size_t)l * 256 + c0 + e];
    for (int m = gw; m < M_ROWS; m += NGW) {
        const int b = m / LEN, t = m - b * LEN; const bool hp = t > 0, hn = t < LEN - 1;
        float o[4][4];
        float xc[4], dxc[4];
#pragma unroll
        for (int x = 0; x < 4; ++x) {
            const u32x2 wc_ = *(const u32x2*)(P + (size_t)m * 1024 + x * 256 + c0);
            u32x2 wp = (u32x2){0u, 0u}, wn = (u32x2){0u, 0u};
            if (hp) wp = *(const u32x2*)(P + (size_t)(m - 1) * 1024 + x * 256 + c0);
            if (hn) wn = *(const u32x2*)(P + (size_t)(m + 1) * 1024 + x * 256 + c0);
            const float cur[4] = {bflo(wc_.x), bfhi(wc_.x), bflo(wc_.y), bfhi(wc_.y)}, pv[4] = {bflo(wp.x), bfhi(wp.x), bflo(wp.y), bfhi(wp.y)}, nv[4] = {bflo(wn.x), bfhi(wn.x), bflo(wn.y), bfhi(wn.y)};
#pragma unroll
            for (int e = 0; e < 4; ++e) { const float cs = 0.5f * (pv[e] + nv[e]) - cur[e]; if (x < 3) o[x][e] = cur[e] + cs * mu[x][e]; else { xc[e] = cur[e]; dxc[e] = cs; } }
        }
        float kr_[4], ss = 0.f;
#pragma unroll
        for (int e = 0; e < 4; ++e) { kr_[e] = o[1][e] * kkw[e]; ss += kr_[e] * kr_[e]; }
        ss = sum16(ss); const float rn = __builtin_amdgcn_rsqf(ss + 1e-12f);
        bf16_t* rp = rk + (size_t)m * 1024 + c0;
        *(u32x2*)(rp) = (u32x2){pk2(o[0][0], o[0][1]), pk2(o[0][2], o[0][3])};
        *(u32x2*)(rp + 256) = (u32x2){pk2(o[1][0], o[1][1]), pk2(o[1][2], o[1][3])};
        *(u32x2*)(rp + 512) = (u32x2){pk2(o[2][0], o[2][1]), pk2(o[2][2], o[2][3])};
        *(u32x2*)(rp + 768) = (u32x2){pk2(kr_[0] * rn, kr_[1] * rn), pk2(kr_[2] * rn, kr_[3] * rn)};
        bf16_t* lp = l1 + (size_t)m * 512 + c0;
        *(u32x2*)(lp) = (u32x2){pk2(xc[0], xc[1]), pk2(xc[2], xc[3])};
        *(u32x2*)(lp + 256) = (u32x2){pk2(dxc[0], dxc[1]), pk2(dxc[2], dxc[3])};
    }
}
__device__ __forceinline__ void ssd_prep(const Ctx& cx_, int l) {
    const Ctx c = relaunder(cx_);
    const int gw = c.bid * NWAVES + c.wave, NGW = c.G * NWAVES, lane = c.lane, c0 = 16 * lane;
    const bf16_t* P = (const bf16_t*)(c.ws + WS_PXBC); bf16_t* xs = (bf16_t*)(c.ws + WS_XS); bf16_t* bc = (bf16_t*)(c.ws + WS_BC);
    float w[5][16], bias[16];
#pragma unroll
    for (int j = 0; j < 5; ++j)
#pragma unroll
        for (int e = 0; e < 16; ++e) w[j][e] = c.in[I_CONVW][((size_t)l * 5 + j) * 1024 + c0 + e];
#pragma unroll
    for (int e = 0; e < 16; ++e) bias[e] = c.in[I_CONVB][(size_t)l * 1024 + c0 + e];
    for (int m = gw; m < M_ROWS; m += NGW) {
        const int b = m / LEN, t = m - b * LEN;
        float a[16];
#pragma unroll
        for (int e = 0; e < 16; ++e) a[e] = bias[e];
#pragma unroll
        for (int j = 0; j < 5; ++j) {
            const int tt = t + j - 2;
            if (tt >= 0 && tt < LEN) {
                const u32x4* p = (const u32x4*)(P + (size_t)(m + j - 2) * 1024 + c0); float f0[8], f1[8]; unpack8(p[0], f0); unpack8(p[1], f1);
#pragma unroll
                for (int e = 0; e < 8; ++e) { a[e] += w[j][e] * f0[e]; a[8 + e] += w[j][8 + e] * f1[e]; }
            }
        }
        float o0[8], o1[8];
#pragma unroll
        for (int e = 0; e < 8; ++e) { o0[e] = siluf_(a[e]); o1[e] = siluf_(a[8 + e]); }
        bf16_t* dst = lane < 32 ? xs + (size_t)m * 512 + c0 : bc + (size_t)m * 512 + (c0 - 512);
        ((u32x4*)dst)[0] = pack8(o0); ((u32x4*)dst)[1] = pack8(o1);
    }
}

__device__ __forceinline__ void s5_scan(const Ctx& cx_, int l) {
    const Ctx c = relaunder(cx_);
    if (c.tid >= 64) return;
    const int gt = c.bid * 64 + c.tid; if (gt >= 16384) return;
    const int n = gt & 63, d = (gt >> 6) & 1, b = (gt >> 7) & 7, g = gt >> 10;
    const size_t li_ = (((size_t)l * 2 + d) * 16 + g) * 64 + n;
    const float lr = c.in[I_S5LRE][li_], li = c.in[I_S5LIM][li_], step = expf(c.in[I_S5LS][((size_t)l * 2 + d) * 16 + g]);
    const float mag = expf(16.f * lr * step); float sn, cs; sincosf(16.f * li * step, &sn, &cs); const float ar = mag * cs, ai = mag * sn;
    const float* X = (const float*)(c.ws + WS_X) + ((size_t)g * S5RP + (size_t)b * NCH16) * 256 + d * 128 + n;
    bf16_t* U = (bf16_t*)(c.ws + WS_UH) + ((size_t)g * S5RP + (size_t)b * NCH16) * 512 + 256 + d * 128 + n;
    float hr = 0.f, hi = 0.f;
#pragma unroll 8
    for (int i = 0; i < NCH16; ++i) {
        const int ch = d == 0 ? i : NCH16 - 1 - i;
        const float xr = X[(size_t)ch * 256], xi = X[(size_t)ch * 256 + 64];
        U[(size_t)ch * 512] = (bf16_t)f2bf(hr); U[(size_t)ch * 512 + 64] = (bf16_t)f2bf(hi);
        const float nr = ar * hr - ai * hi + xr, ni = ar * hi + ai * hr + xi; hr = nr; hi = ni;
    }
}
constexpr int RW_T = 32, RW_NC = (LEN + RW_T - 1) / RW_T, RW_BUF = 45056;
__device__ __forceinline__ void rwkv_scan(const Ctx& cx_, int l) {
    const Ctx c = relaunder(cx_);
    const int bid = c.bid, q = bid & 3, dir = (bid >> 2) & 1, head = (bid >> 3) & 3, b = bid >> 5;
    const int tid = c.tid, lane = c.lane, wave = c.wave;
    const bf16_t* rk = (const bf16_t*)(c.dout + DO_RKVP); const bf16_t* l2 = (const bf16_t*)(c.ws + WS_L2O);
    bf16_t* yo = (bf16_t*)(c.ws + WS_YRW) + (size_t)dir * MP * 256;
    const bool producer = wave >= 4;
    const int pt = tid - 256, pstep = pt >> 3, pc0 = (pt & 7) * 8, pv0 = 2 * (pt & 7);
    float ka[8];
    u32x4 R, K, KK, DL, AS; unsigned V2 = 0; R = K = KK = DL = AS = (u32x4){0u, 0u, 0u, 0u};
    if (producer) {
#pragma unroll
        for (int e = 0; e < 8; ++e) ka[e] = c.in[I_KA][(size_t)l * 256 + head * 64 + pc0 + e];
    }
    auto tok = [&](int s) -> size_t { const int t = dir ? LEN - 1 - s : s; return (size_t)b * LEN + t; };
#define RW_LOAD(chunk) do { const int s_ = (chunk) * RW_T + pstep; if (s_ < LEN) { const size_t m_ = tok(s_); const bf16_t* rp_ = rk + m_ * 1024 + head * 64; const bf16_t* lp_ = l2 + m_ * 1280 + dir * 256 + head * 64; \
        R = *(const u32x4*)(rp_ + pc0); K = *(const u32x4*)(rp_ + 256 + pc0); KK = *(const u32x4*)(rp_ + 768 + pc0); V2 = *(const unsigned*)(rp_ + 512 + 16 * q + pv0); \
        DL = *(const u32x4*)(lp_ + pc0); AS = *(const u32x4*)(lp_ + 512 + pc0); } } while (0)
#define RW_WRITE(buf) do { LAS float* vec_ = (LAS float*)(c.lds + (buf) * RW_BUF); float r_[8], k_[8], kk_[8], dl_[8], as_[8]; unpack8(R, r_); unpack8(K, k_); unpack8(KK, kk_); unpack8(DL, dl_); unpack8(AS, as_); \
        float w_[8], a_[8], b_[8], kd_[8]; _Pragma("unroll") for (int e = 0; e < 8; ++e) { w_[e] = __expf(dl_[e]); a_[e] = -kk_[e]; b_[e] = kk_[e] * as_[e]; kd_[e] = k_[e] * (1.f + (as_[e] - 1.f) * ka[e]); } \
        LAS float* bp_ = vec_ + pstep * 320 + pc0; \
        *(LAS f32x4*)(bp_) = (f32x4){w_[0], w_[1], w_[2], w_[3]}; *(LAS f32x4*)(bp_ + 4) = (f32x4){w_[4], w_[5], w_[6], w_[7]}; \
        *(LAS f32x4*)(bp_ + 64) = (f32x4){a_[0], a_[1], a_[2], a_[3]}; *(LAS f32x4*)(bp_ + 68) = (f32x4){a_[4], a_[5], a_[6], a_[7]}; \
        *(LAS f32x4*)(bp_ + 128) = (f32x4){b_[0], b_[1], b_[2], b_[3]}; *(LAS f32x4*)(bp_ + 132) = (f32x4){b_[4], b_[5], b_[6], b_[7]}; \
        *(LAS f32x4*)(bp_ + 192) = (f32x4){kd_[0], kd_[1], kd_[2], kd_[3]}; *(LAS f32x4*)(bp_ + 196) = (f32x4){kd_[4], kd_[5], kd_[6], kd_[7]}; \
        *(LAS f32x4*)(bp_ + 256) = (f32x4){r_[0], r_[1], r_[2], r_[3]}; *(LAS f32x4*)(bp_ + 260) = (f32x4){r_[4], r_[5], r_[6], r_[7]}; \
        LAS float* vr_ = vec_ + 10240 + pstep * 16 + pv0; vr_[0] = bflo(V2); vr_[1] = bfhi(V2); } while (0)
#define RW_FLUSH(chunk) do { const int s_ = (chunk) * RW_T + pstep; if (s_ < LEN) { const LAS float* yy_ = (const LAS float*)(c.lds + ((chunk) & 1) * RW_BUF) + 10752 + pstep * 16 + pv0; \
        *(unsigned*)(yo + tok(s_) * 256 + head * 64 + 16 * q + pv0) = pk2(yy_[0], yy_[1]); } } while (0)
    if (producer) { RW_LOAD(0); RW_WRITE(0); RW_LOAD(1); }
    __syncthreads();
    const int rowl = (wave & 3) * 4 + (lane >> 4), j4 = (lane & 15) * 4;
    float S0 = 0.f, S1 = 0.f, S2 = 0.f, S3 = 0.f;
    for (int ch = 0; ch < RW_NC; ++ch) {
        if (!producer) {
            const LAS float* vec = (const LAS float*)(c.lds + (ch & 1) * RW_BUF);
            LAS float* yy = (LAS float*)(c.lds + (ch & 1) * RW_BUF) + 10752;
            const int ns = (LEN - ch * RW_T) < RW_T ? (LEN - ch * RW_T) : RW_T;
#pragma unroll 4
            for (int st = 0; st < ns; ++st) {
                const LAS float* bp = vec + st * 320 + j4;
                const f32x4 w = *(const LAS f32x4*)(bp), a = *(const LAS f32x4*)(bp + 64), bb = *(const LAS f32x4*)(bp + 128), kd = *(const LAS f32x4*)(bp + 192), r = *(const LAS f32x4*)(bp + 256);
                const float v = vec[10240 + st * 16 + rowl];
                float sa = (S0 * a.x + S1 * a.y) + (S2 * a.z + S3 * a.w);
                sa = allred16(sa);
                S0 = S0 * w.x + v * kd.x; S1 = S1 * w.y + v * kd.y; S2 = S2 * w.z + v * kd.z; S3 = S3 * w.w + v * kd.w;
                S0 += sa * bb.x; S1 += sa * bb.y; S2 += sa * bb.z; S3 += sa * bb.w;
                float y = (S0 * r.x + S1 * r.y) + (S2 * r.z + S3 * r.w);
                y = allred16(y);
                if ((lane & 15) == 0) yy[st * 16 + rowl] = y;
            }
        } else {
            if (ch + 1 < RW_NC) RW_WRITE((ch + 1) & 1);
            if (ch + 2 < RW_NC) RW_LOAD(ch + 2);
            if (ch >= 1) RW_FLUSH(ch - 1);
        }
        __syncthreads();
    }
    if (producer) RW_FLUSH(RW_NC - 1);
    __syncthreads();
#undef RW_LOAD
#undef RW_WRITE
#undef RW_FLUSH
}

constexpr int SD_T = 32, SD_NC = (LEN + SD_T - 1) / SD_T, SD_BUF = 41472;
__device__ __forceinline__ void ssd_scan(const Ctx& cx_, int l) {
    const Ctx c = relaunder(cx_);
    const int bid = c.bid, ph = bid & 1, dir = (bid >> 1) & 1, head = (bid >> 2) & 7, b = bid >> 5, grp = head >> 2;
    const int tid = c.tid, lane = c.lane, wave = c.wave;
    const bf16_t* bc = (const bf16_t*)(c.ws + WS_BC); const bf16_t* xs = (const bf16_t*)(c.ws + WS_XS);
    const float* dtb = (const float*)(c.ws + WS_DT); const float* decb = (const float*)(c.ws + WS_DEC);
    bf16_t* yo = (bf16_t*)(c.ws + WS_YSSD) + (size_t)dir * MP * 512;
    const int lstep = tid >> 4, ln0 = (tid & 15) * 8, lp0 = (tid & 15) * 2;
    u32x4 Bv = (u32x4){0u, 0u, 0u, 0u}, Cv = Bv; unsigned xv = 0; float dtv = 0.f, decv = 1.f;
    auto tok = [&](int s) -> size_t { const int t = dir ? LEN - 1 - s : s; return (size_t)b * LEN + t; };
#define SD_LOAD(chunk) do { const int s_ = (chunk) * SD_T + lstep; if (s_ < LEN) { const size_t m_ = tok(s_); Bv = *(const u32x4*)(bc + m_ * 512 + grp * 128 + ln0); Cv = *(const u32x4*)(bc + m_ * 512 + 256 + grp * 128 + ln0); \
        xv = *(const unsigned*)(xs + m_ * 512 + head * 64 + ph * 32 + lp0); dtv = dtb[m_ * 16 + dir * 8 + head]; decv = decb[m_ * 16 + dir * 8 + head]; } } while (0)
#define SD_WRITE(buf) do { LAS float* f_ = (LAS float*)(c.lds + (buf) * SD_BUF); float b_[8], c_[8]; unpack8(Bv, b_); unpack8(Cv, c_); \
        *(LAS f32x4*)(f_ + lstep * 128 + ln0) = (f32x4){b_[0], b_[1], b_[2], b_[3]}; *(LAS f32x4*)(f_ + lstep * 128 + ln0 + 4) = (f32x4){b_[4], b_[5], b_[6], b_[7]}; \
        *(LAS f32x4*)(f_ + 4096 + lstep * 128 + ln0) = (f32x4){c_[0], c_[1], c_[2], c_[3]}; *(LAS f32x4*)(f_ + 4096 + lstep * 128 + ln0 + 4) = (f32x4){c_[4], c_[5], c_[6], c_[7]}; \
        f_[8192 + lstep * 32 + lp0] = bflo(xv) * dtv; f_[8192 + lstep * 32 + lp0 + 1] = bfhi(xv) * dtv; if ((tid & 15) == 0) f_[9216 + lstep] = decv; } while (0)
#define SD_FLUSH(chunk) do { const int s_ = (chunk) * SD_T + lstep; if (s_ < LEN) { const LAS float* yy_ = (const LAS float*)(c.lds + ((chunk) & 1) * SD_BUF) + 9248 + lstep * 32 + lp0; \
        *(unsigned*)(yo + tok(s_) * 512 + head * 64 + ph * 32 + lp0) = pk2(yy_[0], yy_[1]); } } while (0)
    SD_LOAD(0); SD_WRITE(0); SD_LOAD(1);
    __syncthreads();
    const int ng8 = (lane & 15) * 8, pl = wave * 4 + (lane >> 4);
    float h[8] = {0.f, 0.f, 0.f, 0.f, 0.f, 0.f, 0.f, 0.f};
    for (int ch = 0; ch < SD_NC; ++ch) {
        if (ch + 1 < SD_NC) SD_WRITE((ch + 1) & 1);
        if (ch + 2 < SD_NC) SD_LOAD(ch + 2);
        if (ch >= 1) SD_FLUSH(ch - 1);
        const LAS float* f = (const LAS float*)(c.lds + (ch & 1) * SD_BUF);
        LAS float* yy = (LAS float*)(c.lds + (ch & 1) * SD_BUF) + 9248;
        const int ns = (LEN - ch * SD_T) < SD_T ? (LEN - ch * SD_T) : SD_T;
#pragma unroll 2
        for (int st = 0; st < ns; ++st) {
            const f32x4 b0 = *(const LAS f32x4*)(f + st * 128 + ng8), b1 = *(const LAS f32x4*)(f + st * 128 + ng8 + 4);
            const f32x4 c0 = *(const LAS f32x4*)(f + 4096 + st * 128 + ng8), c1 = *(const LAS f32x4*)(f + 4096 + st * 128 + ng8 + 4);
            const float xd = f[8192 + st * 32 + pl], dc = f[9216 + st];
            h[0] = h[0] * dc + b0.x * xd; h[1] = h[1] * dc + b0.y * xd; h[2] = h[2] * dc + b0.z * xd; h[3] = h[3] * dc + b0.w * xd;
            h[4] = h[4] * dc + b1.x * xd; h[5] = h[5] * dc + b1.y * xd; h[6] = h[6] * dc + b1.z * xd; h[7] = h[7] * dc + b1.w * xd;
            float y = ((h[0] * c0.x + h[1] * c0.y) + (h[2] * c0.z + h[3] * c0.w)) + ((h[4] * c1.x + h[5] * c1.y) + (h[6] * c1.z + h[7] * c1.w));
            y = allred16(y);
            if ((lane & 15) == 0) yy[st * 32 + pl] = y;
        }
        __syncthreads();
    }
    SD_FLUSH(SD_NC - 1);
    __syncthreads();
#undef SD_LOAD
#undef SD_WRITE
#undef SD_FLUSH
}

__device__ __forceinline__ void ssd_post(const Ctx& cx_, int l) {
    const Ctx c = relaunder(cx_);
    const int gw = c.bid * NWAVES + c.wave, NGW = c.G * NWAVES, lane = c.lane, c0 = 8 * lane;
    const bf16_t* y0 = (const bf16_t*)(c.ws + WS_YSSD); const bf16_t* y1 = y0 + (size_t)MP * 512;
    const bf16_t* xs = (const bf16_t*)(c.ws + WS_XS); const bf16_t* pz = (const bf16_t*)(c.ws + WS_PZ); bf16_t* yb = (bf16_t*)(c.ws + WS_YB);
    const float dsk = c.in[I_SSDD][l * 8 + (lane >> 3)];
    float nw[8];
#pragma unroll
    for (int e = 0; e < 8; ++e) nw[e] = c.in[I_SSDNW][(size_t)l * 512 + c0 + e];
    for (int m = gw; m < M_ROWS; m += NGW) {
        float a[8], bq[8], x[8], z[8]; unpack8(*(const u32x4*)(y0 + (size_t)m * 512 + c0), a); unpack8(*(const u32x4*)(y1 + (size_t)m * 512 + c0), bq);
        unpack8(*(const u32x4*)(xs + (size_t)m * 512 + c0), x); unpack8(*(const u32x4*)(pz + (size_t)m * 512 + c0), z);
        float ss = 0.f;
#pragma unroll
        for (int e = 0; e < 8; ++e) { a[e] = (a[e] + bq[e] + dsk * x[e]) * siluf_(z[e]); ss += a[e] * a[e]; }
        ss = wave_sum(ss); const float s = __builtin_amdgcn_rsqf(ss * (1.0f / 512.f) + EPS);
#pragma unroll
        for (int e = 0; e < 8; ++e) a[e] = a[e] * s * nw[e];
        *(u32x4*)(yb + (size_t)m * 512 + c0) = pack8(a);
    }
}
__device__ __forceinline__ void rwkv_post(const Ctx& cx_, int l) {
    const Ctx c = relaunder(cx_);
    const int gw = c.bid * NWAVES + c.wave, NGW = c.G * NWAVES, lane = c.lane, c0 = 4 * lane;
    const bf16_t* y0 = (const bf16_t*)(c.ws + WS_YRW); const bf16_t* y1 = y0 + (size_t)MP * 256;
    const bf16_t* rk = (const bf16_t*)(c.dout + DO_RKVP); const bf16_t* l2 = (const bf16_t*)(c.ws + WS_L2O); bf16_t* yc = (bf16_t*)(c.ws + WS_YC);
    float lw[4], lb[4], rkw[4];
#pragma unroll
    for (int e = 0; e < 4; ++e) { lw[e] = c.in[I_LNW][(size_t)l * 256 + c0 + e]; lb[e] = c.in[I_LNB][(size_t)l * 256 + c0 + e]; rkw[e] = c.in[I_RK][(size_t)l * 256 + c0 + e]; }
    for (int m = gw; m < M_ROWS; m += NGW) {
        const u32x2 a = *(const u32x2*)(y0 + (size_t)m * 256 + c0), bq = *(const u32x2*)(y1 + (size_t)m * 256 + c0);
        const u32x2 rr = *(const u32x2*)(rk + (size_t)m * 1024 + c0), kk = *(const u32x2*)(rk + (size_t)m * 1024 + 256 + c0), vv = *(const u32x2*)(rk + (size_t)m * 1024 + 512 + c0);
        const u32x2 gg = *(const u32x2*)(l2 + (size_t)m * 1280 + 1024 + c0);
        float y[4] = {bflo(a.x) + bflo(bq.x), bfhi(a.x) + bfhi(bq.x), bflo(a.y) + bflo(bq.y), bfhi(a.y) + bfhi(bq.y)};
        const float r[4] = {bflo(rr.x), bfhi(rr.x), bflo(rr.y), bfhi(rr.y)}, k[4] = {bflo(kk.x), bfhi(kk.x), bflo(kk.y), bfhi(kk.y)};
        const float v[4] = {bflo(vv.x), bfhi(vv.x), bflo(vv.y), bfhi(vv.y)}, g[4] = {bflo(gg.x), bfhi(gg.x), bflo(gg.y), bfhi(gg.y)};
        const float mean = sum16((y[0] + y[1]) + (y[2] + y[3])) * (1.f / 64.f);
        float q = 0.f, bo = 0.f;
#pragma unroll
        for (int e = 0; e < 4; ++e) { y[e] -= mean; q += y[e] * y[e]; bo += r[e] * k[e] * rkw[e]; }
        q = sum16(q) * (1.f / 64.f); bo = sum16(bo);
        const float rs = __builtin_amdgcn_rsqf(q + 64e-5f);
        float o[4];
#pragma unroll
        for (int e = 0; e < 4; ++e) o[e] = (y[e] * rs * lw[e] + lb[e] + bo * v[e]) * g[e];
        *(u32x2*)(yc + (size_t)m * 256 + c0) = (u32x2){pk2(o[0], o[1]), pk2(o[2], o[3])};
    }
}
__device__ __forceinline__ void final_phase(const Ctx& cx_, float* out) {
    const Ctx c = relaunder(cx_);
    const int gw = c.bid * NWAVES + c.wave, NGW = c.G * NWAVES, lane = c.lane;
    const bf16_t* H = c.H(); const f32x4* fw = (const f32x4*)c.in[I_FNW];
    for (int r = gw; r < BATCH * SEQ; r += NGW) {
        const int b = r / SEQ, tq = r - b * SEQ; const size_t m = (size_t)b * LEN + NMETA + tq;
        const u32x2* hp = (const u32x2*)(H + m * DM);
        float v[4][4], ss = 0.f;
#pragma unroll
        for (int i = 0; i < 4; ++i) { const u32x2 w = hp[lane + 64 * i]; v[i][0] = bflo(w.x); v[i][1] = bfhi(w.x); v[i][2] = bflo(w.y); v[i][3] = bfhi(w.y); ss += (v[i][0] * v[i][0] + v[i][1] * v[i][1]) + (v[i][2] * v[i][2] + v[i][3] * v[i][3]); }
        ss = wave_sum(ss); const float s = __builtin_amdgcn_rsqf(ss * (1.0f / DM) + EPS);
        f32x4* op = (f32x4*)(out + (size_t)r * DM);
#pragma unroll
        for (int i = 0; i < 4; ++i) { const f32x4 w = fw[lane + 64 * i]; op[lane + 64 * i] = (f32x4){v[i][0] * s * w.x, v[i][1] * s * w.y, v[i][2] * s * w.z, v[i][3] * s * w.w}; }
    }
}

constexpr int LDS_BYTES = 147456;
#ifndef PHMASK
#define PHMASK 0xFFFFF
#endif
__global__ void __launch_bounds__(NTHREADS, 2) mega_fwd(Params p) {
    extern __shared__ __attribute__((aligned(16))) unsigned char lds_raw[];
    cg::grid_group grid = cg::this_grid();
    Ctx c; c.in = p.in; c.ws = p.ws; c.dout = (unsigned char*)p.out; c.lds = (LAS unsigned char*)lds_raw;
    c.tid = threadIdx.x; c.lane = c.tid & 63; c.wave = __builtin_amdgcn_readfirstlane(c.tid >> 6); c.G = gridDim.x; c.bid = blockIdx.x;
    const int G = c.G, bid = c.bid;
    if (PHMASK & 1) phase0(c);
    grid.sync();
#pragma unroll 1
    for (int l = 0; l < DEPTH; ++l) {
        bf16_t* wb = c.wb(l);
        if (PHMASK & 2) dt_job(c, l);
        if (PHMASK & 4) { SchedPlain S{c.H(), wb + WB_IN, DM, DM, DM, MP / 256, 11, G, bid};
          EpiInProj E{c.ssq(), (bf16_t*)(c.ws + WS_UH), (bf16_t*)(c.ws + WS_PZ), (bf16_t*)(c.ws + WS_PXBC), (bf16_t*)(c.ws + WS_PRKVX)};
          pg8::gemm_phase(c.lds, S, E); }
        grid.sync();
        if (PHMASK & 8) { SchedS5 S{(const bf16_t*)(c.ws + WS_UH), wb + WB_SX, 256, G, bid}; EpiS5X E{(float*)(c.ws + WS_X)}; pg8::gemm_phase(c.lds, S, E); }
        if (PHMASK & 16) rwkv_prep(c, l);
        if (PHMASK & 32) ssd_prep(c, l);
        grid.sync();
        if (PHMASK & 64) s5_scan(c, l);
        if (PHMASK & 128) { SchedPlain S{(const bf16_t*)(c.ws + WS_L1IN), wb + WB_L1, 512, 512, 512, MP / 256, 2, G, bid}; EpiL1 E{(bf16_t*)(c.ws + WS_L1O)}; pg8::gemm_phase(c.lds, S, E); }
        grid.sync();
        if (PHMASK & 256) { SchedL2 S{(const bf16_t*)(c.ws + WS_L1O), wb + WB_L2, G, bid}; EpiL2 E{(bf16_t*)(c.ws + WS_L2O), c.in[I_W0] + (size_t)l * 512, c.in[I_A0] + (size_t)l * 512}; pg8::gemm_phase(c.lds, S, E); }
        if (PHMASK & 512) { SchedS5 S{(const bf16_t*)(c.ws + WS_UH), wb + WB_SY, 512, G, bid}; EpiS5Y E{(bf16_t*)(c.ws + WS_YAPRE)}; pg8::gemm_phase(c.lds, S, E); }
        grid.sync();
        if (PHMASK & 1024) rwkv_scan(c, l);
        if (PHMASK & 2048) ssd_scan(c, l);
        grid.sync();
        if (PHMASK & 4096) ssd_post(c, l);
        if (PHMASK & 8192) rwkv_post(c, l);
        if (PHMASK & 16384) { SchedPlain S{(const bf16_t*)(c.ws + WS_YAPRE), wb + WB_GLU, 256, 256, 256, MP / 256, 2, G, bid}; EpiGLU E{(bf16_t*)(c.ws + WS_YA), c.in[I_GLUB] + (size_t)l * 512}; pg8::gemm_phase(c.lds, S, E); }
        grid.sync();
        if (PHMASK & 32768) { SchedProj S{c.H(), wb + WB_G, wb + WB_P, (const bf16_t*)(c.ws + WS_YA), (const bf16_t*)(c.ws + WS_YB), (const bf16_t*)(c.ws + WS_YC), G, bid};
          EpiProj E{c.ssq(), c.ws + WS_PARK + (size_t)bid * 393216, (bf16_t*)(c.dout + DO_MERGED), opaque_tid()}; pg8::gemm_phase(c.lds, S, E); }
        grid.sync();
        if (PHMASK & 65536) { SchedPlain S{(const bf16_t*)(c.dout + DO_MERGED), wb + WB_O, DM, DM, DM, MP / 256, 4, G, bid}; EpiResid E{c.H(), c.ssq()}; pg8::gemm_phase(c.lds, S, E); }
        grid.sync();
        if (PHMASK & 131072) { SchedPlain S{c.H(), wb + WB_1, DM, DM, DM, MP / 256, 16, G, bid}; EpiUp E{c.ssq(), (bf16_t*)(c.ws + WS_ACT)}; pg8::gemm_phase(c.lds, S, E); }
        grid.sync();
        if (PHMASK & 262144) { SchedPlain S{(const bf16_t*)(c.ws + WS_ACT), wb + WB_2, DFF, DFF, DFF, MP / 256, 4, G, bid}; EpiResid E{c.H(), c.ssq()}; pg8::gemm_phase(c.lds, S, E); }
        grid.sync();
    }
    if (PHMASK & 524288) final_phase(c, p.out);
}

extern "C" void kernel_launch(void* const* d_in, const int* in_sizes, int n_in, void* d_out, int out_size, void* d_ws, size_t ws_size, hipStream_t stream) {
    static int grid = 0;
    if (grid == 0) {
        int dev = 0, cus = 0, per_cu = 0;
        if (n_in != N_INPUTS || out_size != BATCH * SEQ * DM || ws_size < WS_END) { fprintf(stderr, "kernel_launch: unexpected shapes (n_in %d out %d ws %zu)\n", n_in, out_size, ws_size); grid = -1; return; }
        (void)hipGetDevice(&dev); (void)hipDeviceGetAttribute(&cus, hipDeviceAttributeMultiprocessorCount, dev);
        (void)hipFuncSetAttribute((const void*)mega_fwd, hipFuncAttributeMaxDynamicSharedMemorySize, LDS_BYTES);
        (void)hipOccupancyMaxActiveBlocksPerMultiprocessor(&per_cu, (const void*)mega_fwd, NTHREADS, LDS_BYTES);
        if (per_cu < 1) { fprintf(stderr, "kernel_launch: occupancy query says %d blocks per CU\n", per_cu); per_cu = 1; }
        grid = cus * 1;
        if (grid != 256) fprintf(stderr, "kernel_launch: %d CUs (the scan phases are laid out for 256 workgroups)\n", grid);
    }
    if (grid < 0) return;
    Params p{};
    for (int i = 0; i < N_INPUTS; ++i) p.in[i] = (const float*)d_in[i];
    p.out = (float*)d_out; p.ws = (unsigned char*)d_ws; p.ph_lo = 0; p.ph_hi = 0;
    void* args[] = {&p};
    hipError_t e = hipLaunchCooperativeKernel((const void*)mega_fwd, dim3(grid), dim3(NTHREADS), args, LDS_BYTES, stream);
    if (e != hipSuccess) fprintf(stderr, "cooperative launch failed: %s (grid %d)\n", hipGetErrorString(e), grid);
}
```

```cpp
#include <hip/hip_runtime.h>
#include <hip/hip_cooperative_groups.h>
#include <cstdio>
#include <cstdint>
namespace cg = cooperative_groups;

#define LAS __attribute__((address_space(3)))
typedef unsigned short bf16_t;
typedef short bf16x8 __attribute__((ext_vector_type(8)));
typedef float f32x4 __attribute__((ext_vector_type(4)));
typedef unsigned u32x4 __attribute__((ext_vector_type(4)));
typedef unsigned u32x2 __attribute__((ext_vector_type(2)));

constexpr int BATCH = 8, SEQ = 4096, NMETA = 16, LEN = SEQ + NMETA, DM = 1024, DFF = 4096, DEPTH = 2;
constexpr int M_ROWS = BATCH * LEN;
constexpr int MP = 33024;
constexpr int N_IN = 5896;
constexpr int NCH16 = LEN / 16;
constexpr int S5ROWS = BATCH * NCH16;
constexpr int S5RP = 2304;
constexpr float EPS = 1e-6f;
constexpr int NTHREADS = 512, NWAVES = 8;

constexpr size_t QB = (size_t)MP * 256 * 2;
constexpr size_t WB_IN = 0;
constexpr size_t WB_G = WB_IN + (size_t)2816 * 1024;
constexpr size_t WB_P = WB_G + (size_t)3072 * 1024;
constexpr size_t WB_O = WB_P + (size_t)1024 * 1024;
constexpr size_t WB_1 = WB_O + (size_t)1024 * 1024;
constexpr size_t WB_2 = WB_1 + (size_t)4096 * 1024;
constexpr size_t WB_GLU = WB_2 + (size_t)1024 * 4096;
constexpr size_t WB_L1 = WB_GLU + (size_t)512 * 256;
constexpr size_t WB_L2 = WB_L1 + (size_t)512 * 512;
constexpr size_t WB_SX = WB_L2 + (size_t)1280 * 256;
constexpr size_t WB_SY = WB_SX + (size_t)16 * 256 * 256;
constexpr size_t WB_ELEMS = WB_SY + (size_t)16 * 256 * 512;
constexpr size_t WB_BYTES = WB_ELEMS * 2;
static_assert(WB_BYTES <= 5 * QB / 2, "weight block fits 2.5 Q");

constexpr size_t WS_H = 0;
constexpr size_t WS_WB0 = 4 * QB;
constexpr size_t WS_SMALL = 13 * QB / 2;
constexpr size_t WS_SSQ = WS_SMALL;
constexpr size_t WS_DT = WS_SSQ + (size_t)MP * 16 * 4;
constexpr size_t WS_DEC = WS_DT + (size_t)MP * 16 * 4;
static_assert(WS_DEC + (size_t)MP * 16 * 4 <= 7 * QB, "small region");
constexpr size_t WS_MIX = 7 * QB;
constexpr size_t WS_PXBC = WS_MIX;
constexpr size_t WS_YSSD = WS_MIX;
constexpr size_t WS_PARK = WS_MIX;
constexpr size_t WS_ACT = WS_MIX;
constexpr size_t WS_PRKVX = WS_MIX + 4 * QB;
constexpr size_t WS_L2O = WS_MIX + 4 * QB;
constexpr size_t WS_PZ = WS_MIX + 9 * QB;
constexpr size_t WS_UH = WS_MIX + 11 * QB;
constexpr size_t WS_X = WS_MIX + 53 * QB / 4;
constexpr size_t WS_YRW = WS_X;
constexpr size_t WS_L1IN = WS_MIX + 31 * QB / 2;
constexpr size_t WS_YAPRE = WS_L1IN;
constexpr size_t WS_L1O = WS_MIX + 35 * QB / 2;
constexpr size_t WS_YB = WS_L1O;
constexpr size_t WS_BC = WS_MIX + 39 * QB / 2;
constexpr size_t WS_YA = WS_BC;
constexpr size_t WS_YC = WS_BC + QB;
constexpr size_t WS_XS = WS_MIX + 43 * QB / 2;
constexpr size_t WS_END = WS_XS + 2 * QB;
static_assert(WS_END <= (size_t)512 << 20, "workspace map fits 512 MiB");
static_assert((size_t)16 * S5RP * 512 * 2 <= 9 * QB / 4 && (size_t)16 * S5RP * 256 * 4 <= 9 * QB / 4, "S5 buffers fit their slots");
static_assert((size_t)256 * 393216 <= 6 * QB, "gate park");
constexpr size_t DO_RKVP = 0;
constexpr size_t DO_MERGED = 0;
constexpr size_t DO_WB1 = 4 * QB;
static_assert(DO_WB1 + WB_BYTES <= (size_t)BATCH * SEQ * DM * 4, "d_out scratch map");

__device__ __forceinline__ unsigned f2bf(float f) { unsigned u = __builtin_bit_cast(unsigned, f); return (u + 0x7fffu + ((u >> 16) & 1u)) >> 16; }
__device__ __forceinline__ unsigned pk2(float lo, float hi) { unsigned r; asm volatile("v_cvt_pk_bf16_f32 %0, %1, %2" : "=v"(r) : "v"(lo), "v"(hi)); return r; }
__device__ __forceinline__ float bflo(unsigned w) { return __builtin_bit_cast(float, w << 16); }
__device__ __forceinline__ float bfhi(unsigned w) { return __builtin_bit_cast(float, w & 0xffff0000u); }
__device__ __forceinline__ float bf1(bf16_t v) { return __builtin_bit_cast(float, (unsigned)v << 16); }
__device__ __forceinline__ float sigmoidf_(float x) { return 1.0f / (1.0f + __expf(-x)); }
__device__ __forceinline__ float siluf_(float x) { return x / (1.0f + __expf(-x)); }
__device__ __forceinline__ float tanhf_(float x) { x = fminf(fmaxf(x, -15.f), 15.f); const float t = __expf(2.f * x); return (t - 1.f) / (t + 1.f); }
__device__ __forceinline__ float softplusf_(float x) { return fmaxf(x, 0.f) + __logf(1.0f + __expf(-fabsf(x))); }
__device__ __forceinline__ float geluf_(float x) { const float u = 0.7978845608028654f * (x + 0.044715f * x * x * x); return 0.5f * x * (1.f + tanhf_(u)); }
__device__ __forceinline__ float wave_sum(float v) {
#pragma unroll
    for (int o = 1; o < 64; o <<= 1) v += __shfl_xor(v, o);
    return v;
}
__device__ __forceinline__ float sum16(float v) {
#pragma unroll
    for (int o = 1; o < 16; o <<= 1) v += __shfl_xor(v, o);
    return v;
}
template <int CTRL> __device__ __forceinline__ float dpp_mov(float x) {
    return __builtin_bit_cast(float, __builtin_amdgcn_update_dpp(0, __builtin_bit_cast(int, x), CTRL, 0xf, 0xf, true));
}
__device__ __forceinline__ float allred16(float x) {
    x += dpp_mov<0xB1>(x); x += dpp_mov<0x4E>(x); x += dpp_mov<0x141>(x); x += dpp_mov<0x140>(x); return x;
}
__device__ __forceinline__ void unpack8(const u32x4 w, float (&f)[8]) {
    f[0] = bflo(w.x); f[1] = bfhi(w.x); f[2] = bflo(w.y); f[3] = bfhi(w.y); f[4] = bflo(w.z); f[5] = bfhi(w.z); f[6] = bflo(w.w); f[7] = bfhi(w.w);
}
__device__ __forceinline__ u32x4 pack8(const float (&f)[8]) { u32x4 w; w.x = pk2(f[0], f[1]); w.y = pk2(f[2], f[3]); w.z = pk2(f[4], f[5]); w.w = pk2(f[6], f[7]); return w; }
__device__ __forceinline__ int opaque_tid() { int t = threadIdx.x; asm volatile("" : "+v"(t)); return t; }
namespace pg8 {
constexpr int BM = 256, BK = 64, HALF = 128, HTB = HALF * BK * 2  , STAGE_BYTES = 8 * HTB;
__host__ __device__ __forceinline__ int lds_byte(int r, int c) { const int st = (r >> 4) * 2 + (c >> 5), rr = r & 15, cc = c & 31, ob = rr * 64 + cc * 2; return st * 1024 + (ob ^ (((ob >> 9) & 1) << 5)); }
__host__ __device__ __forceinline__ void stage_rc(int b, int& R, int& C) { const int st = b / 1024, sb = b % 1024, swz = sb ^ (((sb >> 9) & 1) << 5); R = (st >> 1) * 16 + swz / 64; C = (st & 1) * 32 + (swz % 64) / 2; }
__host__ __device__ __forceinline__ int perm32(int rho) { const int n = rho >> 4, i = rho & 15; return 8 * (i >> 2) + 4 * n + (i & 3); }

struct GU {
    const bf16_t* A;
    const bf16_t* B;
    int lda, ldb, nt;
    int pm, pn, kind;
};

template <class Epi, class Sched>
__device__ __forceinline__ void gemm_phase(LAS unsigned char* lds, const Sched& S, const Epi& E) {
    const int tid = opaque_tid(), wid = __builtin_amdgcn_readfirstlane(tid >> 6), lane = tid & 63, wr = wid >> 2, wc = wid & 3, fr = lane & 15, fq = lane >> 4;
#define PG8_VOFF(lda_, ldb_, a0, a1, b0, b1) do { int R0_, C0_, R1_, C1_; stage_rc(tid * 16, R0_, C0_); stage_rc(tid * 16 + 8192, R1_, C1_); \
        a0 = (unsigned)(R0_ * (lda_) + C0_) * 2u; a1 = (unsigned)(R1_ * (lda_) + C1_) * 2u; \
        b0 = (unsigned)(((R0_ & ~31) + perm32(R0_ & 31)) * (ldb_) + C0_) * 2u; b1 = (unsigned)(((R1_ & ~31) + perm32(R1_ & 31)) * (ldb_) + C1_) * 2u; } while (0)
    const size_t kstep = (size_t)(BK * 2);
    const unsigned ldsw = (unsigned)wid * 1024u;
    const int aoff = lds_byte(wr * 64 + fr, fq * 8), boff = lds_byte(wc * 32 + fr, fq * 8);
#define PG8_SA(b, h) (((b) * 2 + (h)) * HTB)
#define PG8_SB(b, h) ((4 + (b) * 2 + (h)) * HTB)
#define PG8_STAGE(bufoff, gbase, v0, v1) do { \
        __builtin_amdgcn_global_load_lds((const unsigned*)((const char*)(gbase) + (v0)), (LAS unsigned*)(lds + (bufoff) + ldsw), 16, 0, 0); \
        __builtin_amdgcn_global_load_lds((const unsigned*)((const char*)(gbase) + (v1)), (LAS unsigned*)(lds + (bufoff) + ldsw + 8192), 16, 0, 0); } while (0)
#define PG8_LDA(dst, b, h) do { _Pragma("unroll") for (int m = 0; m < 4; ++m) _Pragma("unroll") for (int k = 0; k < 2; ++k) dst[m][k] = *(const LAS bf16x8*)(lds + PG8_SA(b, h) + aoff + m * 2048 + k * 1024); } while (0)
#define PG8_LDB(dst, b, h) do { _Pragma("unroll") for (int n = 0; n < 2; ++n) _Pragma("unroll") for (int k = 0; k < 2; ++k) dst[n][k] = *(const LAS bf16x8*)(lds + PG8_SB(b, h) + boff + n * 2048 + k * 1024); } while (0)
#define PG8_MMA(ai, bj, At, Bt) do { __builtin_amdgcn_s_setprio(1); _Pragma("unroll") for (int m = 0; m < 4; ++m) _Pragma("unroll") for (int n = 0; n < 2; ++n) _Pragma("unroll") for (int k = 0; k < 2; ++k) \
        acc[ai][bj][m][n] = __builtin_amdgcn_mfma_f32_16x16x32_bf16(Bt[n][k], At[m][k], acc[ai][bj][m][n], 0, 0, 0); __builtin_amdgcn_s_setprio(0); } while (0)
#define PG8_WAIT_V(n) asm volatile("s_waitcnt vmcnt(" #n ")" ::: "memory")
#define PG8_WAIT_L(n) asm volatile("s_waitcnt lgkmcnt(" #n ")" ::: "memory")
#define PG8_BAR __builtin_amdgcn_s_barrier()
#define PG8_SCHED __builtin_amdgcn_sched_barrier(0)
    GU cur, nxt; int ui = 0;
    if (!S.next(0, cur)) return;
    f32x4 acc[2][2][4][2];
#pragma unroll
    for (int a = 0; a < 2; ++a)
#pragma unroll
        for (int b = 0; b < 2; ++b)
#pragma unroll
            for (int m = 0; m < 4; ++m)
#pragma unroll
                for (int n = 0; n < 2; ++n) acc[a][b][m][n] = (f32x4){0.f, 0.f, 0.f, 0.f};
    bf16x8 At[4][2], B0[2][2], B1[2][2];
    const char* cA = (const char*)cur.A; const char* cB = (const char*)cur.B;
    unsigned vA0, vA1, vB0, vB1; PG8_VOFF(cur.lda, cur.ldb, vA0, vA1, vB0, vB1);
    size_t hsA = (size_t)HALF * cur.lda * 2, hsB = (size_t)HALF * cur.ldb * 2;
    int nt = cur.nt; asm volatile("" : "+s"(nt));
    PG8_STAGE(PG8_SB(0, 0), cB, vB0, vB1); PG8_STAGE(PG8_SB(0, 1), cB + hsB, vB0, vB1); PG8_STAGE(PG8_SA(0, 0), cA, vA0, vA1); PG8_STAGE(PG8_SA(0, 1), cA + hsA, vA0, vA1);
    if (wr == 1) PG8_BAR;
    PG8_WAIT_V(2); PG8_BAR;
    PG8_STAGE(PG8_SB(1, 0), cB + kstep, vB0, vB1); PG8_STAGE(PG8_SA(1, 0), cA + kstep, vA0, vA1); PG8_STAGE(PG8_SB(1, 1), cB + hsB + kstep, vB0, vB1);
    PG8_WAIT_V(6); PG8_BAR;
    for (;;) {
        const bool has_next = S.next(ui + 1, nxt);
        const char* nA = has_next ? (const char*)nxt.A : cA; const char* nB = has_next ? (const char*)nxt.B : cB;
        unsigned nvA0 = vA0, nvA1 = vA1, nvB0 = vB0, nvB1 = vB1;
        if (has_next) PG8_VOFF(nxt.lda, nxt.ldb, nvA0, nvA1, nvB0, nvB1);
        const size_t nhsA = has_next ? (size_t)HALF * nxt.lda * 2 : hsA, nhsB = has_next ? (size_t)HALF * nxt.ldb * 2 : hsB;
        for (int t = 0; t < nt; t += 2) {
            const bool last = (t == nt - 2);
            const char* a1 = cA + (size_t)(t + 1) * kstep;
            const char* a2 = last ? nA : cA + (size_t)(t + 2) * kstep; const char* b2 = last ? nB : cB + (size_t)(t + 2) * kstep;
            const char* a3 = a2 + kstep; const char* b3 = b2 + kstep;
            const unsigned xA0 = last ? nvA0 : vA0, xA1 = last ? nvA1 : vA1, xB0 = last ? nvB0 : vB0, xB1 = last ? nvB1 : vB1;
            const size_t xhA = last ? nhsA : hsA, xhB = last ? nhsB : hsB;
            PG8_LDB(B0, 0, 0); PG8_LDB(B1, 0, 1); PG8_SCHED; PG8_LDA(At, 0, 0); PG8_STAGE(PG8_SA(1, 1), a1 + hsA, vA0, vA1);
            PG8_WAIT_V(8); PG8_WAIT_L(0); PG8_BAR; PG8_MMA(0, 0, At, B0); PG8_MMA(0, 1, At, B1); PG8_BAR; PG8_SCHED;
            PG8_LDA(At, 0, 1); PG8_STAGE(PG8_SB(0, 0), b2, xB0, xB1); PG8_STAGE(PG8_SB(0, 1), b2 + xhB, xB0, xB1); PG8_STAGE(PG8_SA(0, 0), a2, xA0, xA1);
            PG8_WAIT_V(8); PG8_WAIT_L(0); PG8_BAR; PG8_MMA(1, 0, At, B0); PG8_MMA(1, 1, At, B1); PG8_BAR; PG8_SCHED;
            PG8_LDB(B0, 1, 0); PG8_LDB(B1, 1, 1); PG8_SCHED; PG8_LDA(At, 1, 0); PG8_STAGE(PG8_SA(0, 1), a2 + xhA, xA0, xA1);
            PG8_WAIT_V(8); PG8_WAIT_L(0); PG8_BAR; PG8_MMA(0, 0, At, B0); PG8_MMA(0, 1, At, B1); PG8_BAR; PG8_SCHED;
            PG8_LDA(At, 1, 1); PG8_STAGE(PG8_SB(1, 0), b3, xB0, xB1); PG8_STAGE(PG8_SB(1, 1), b3 + xhB, xB0, xB1); PG8_STAGE(PG8_SA(1, 0), a3, xA0, xA1);
            PG8_WAIT_V(8); PG8_WAIT_L(0); PG8_BAR; PG8_MMA(1, 0, At, B0); PG8_MMA(1, 1, At, B1); PG8_BAR; PG8_SCHED;
        }
        if (wr == 0) PG8_BAR;
        const bool keep = E(acc, cur, wr, wc, fr, fq);
        if (!has_next) break;
        if (!keep) {
#pragma unroll
            for (int a = 0; a < 2; ++a)
#pragma unroll
                for (int b = 0; b < 2; ++b)
#pragma unroll
                    for (int m = 0; m < 4; ++m)
#pragma unroll
                        for (int n = 0; n < 2; ++n) acc[a][b][m][n] = (f32x4){0.f, 0.f, 0.f, 0.f};
        }
        cur = nxt; cA = nA; cB = nB; vA0 = nvA0; vA1 = nvA1; vB0 = nvB0; vB1 = nvB1; hsA = nhsA; hsB = nhsB; nt = cur.nt; asm volatile("" : "+s"(nt)); ++ui;
        if (wr == 1) PG8_BAR;
    }
    PG8_WAIT_V(0);
    PG8_BAR;
#undef PG8_VOFF
#undef PG8_SA
#undef PG8_SB
#undef PG8_STAGE
#undef PG8_LDA
#undef PG8_LDB
#undef PG8_MMA
#undef PG8_WAIT_V
#undef PG8_WAIT_L
#undef PG8_BAR
#undef PG8_SCHED
}

__device__ __forceinline__ bool tile_order(int i, int G, int c, int nM, int nN, int& pm, int& pn) {
    const int nwg = nM * nN; const long L = (long)i * G + c; if (L >= nwg) return false;
    int wgid = (int)L; { const int q = nwg / 8, r = nwg % 8, xcd = wgid % 8, off = wgid / 8; wgid = (xcd < r ? xcd * (q + 1) : r * (q + 1) + (xcd - r) * q) + off; }
    const int nig = 8 * nN, gid = wgid / nig, fm = gid * 8, gsz = (nM - fm) < 8 ? (nM - fm) : 8;
    pm = fm + ((wgid % nig) % gsz); pn = (wgid % nig) / gsz; return true;
}
}
using pg8::GU;
enum InIdx { I_X = 0, I_META, I_FNW, I_MIXNW, I_WIN, I_S5LRE, I_S5LIM, I_S5LS, I_S5BRE, I_S5BIM, I_S5CRE, I_S5CIM, I_S5D, I_GLUW, I_GLUB,
             I_CONVW, I_CONVB, I_ALOG, I_DTB, I_SSDD, I_SSDNW, I_MURKV, I_MUWAG, I_W0, I_W1, I_W2, I_A0, I_A1, I_A2, I_G1, I_G2, I_KK, I_KA, I_RK, I_LNW, I_LNB,
             I_PA, I_PB, I_PC, I_WOUT, I_MLPNW, I_MLPW1, I_MLPW2, N_INPUTS };
struct Params { const float* in[N_INPUTS]; float* out; unsigned char* ws; int ph_lo, ph_hi; };

struct Ctx {
    const float* const* in; unsigned char* ws; unsigned char* dout;
    LAS unsigned char* lds;
    int tid, lane, wave, G, bid;
    __device__ __forceinline__ bf16_t* wb(int layer) const { return (bf16_t*)(layer == 0 ? ws + WS_WB0 : dout + DO_WB1); }
    __device__ __forceinline__ bf16_t* H() const { return (bf16_t*)(ws + WS_H); }
    __device__ __forceinline__ float* ssq() const { return (float*)(ws + WS_SSQ); }
};
__device__ __forceinline__ Ctx relaunder(const Ctx& c0) { Ctx c = c0; c.tid = opaque_tid(); c.lane = c.tid & 63; c.wave = __builtin_amdgcn_readfirstlane(c.tid >> 6); return c; }
__device__ __forceinline__ float row_scale(const float* ssq, int row) {
    const f32x4* p = (const f32x4*)(ssq + (size_t)row * 16);
    const f32x4 a = p[0], b = p[1], c = p[2], d = p[3];
    const float s = ((a.x + a.y) + (a.z + a.w)) + ((b.x + b.y) + (b.z + b.w)) + ((c.x + c.y) + (c.z + c.w)) + ((d.x + d.y) + (d.z + d.w));
    return __builtin_amdgcn_rsqf(s * (1.0f / DM) + EPS);
}

struct SchedPlain {
    const bf16_t* A; const bf16_t* B; int lda, ldb, K, nM, nN, G, c;
    __device__ __forceinline__ bool next(int i, GU& u) const {
        int pm, pn; if (!pg8::tile_order(i, G, c, nM, nN, pm, pn)) return false;
        u.A = A + (size_t)pm * 256 * lda; u.B = B + (size_t)pn * 256 * ldb; u.lda = lda; u.ldb = ldb; u.nt = K / 64; u.pm = pm; u.pn = pn; u.kind = 0; return true;
    }
};
struct SchedS5 {
    const bf16_t* UH; const bf16_t* W; int K, G, c;
    __device__ __forceinline__ bool next(int i, GU& u) const {
        const int L = i * G + c; if (L >= 144) return false;
        const int g = L / 9, pm = L % 9;
        u.A = UH + ((size_t)g * S5RP + (size_t)pm * 256) * 512; u.B = W + (size_t)g * 256 * K; u.lda = 512; u.ldb = K; u.nt = K / 64; u.pm = pm; u.pn = 0; u.kind = g; return true;
    }
};
struct SchedL2 {
    const bf16_t* L1o; const bf16_t* W; int G, c;
    __device__ __forceinline__ bool next(int i, GU& u) const {
        int pm, pn; if (!pg8::tile_order(i, G, c, MP / 256, 5, pm, pn)) return false;
        const int koff = pn < 2 ? 0 : (pn < 4 ? 128 : 256);
        u.A = L1o + (size_t)pm * 256 * 512 + koff; u.B = W + (size_t)pn * 256 * 256; u.lda = 512; u.ldb = 256; u.nt = 4; u.pm = pm; u.pn = pn; u.kind = 0; return true;
    }
};
struct SchedProj {
    const bf16_t* Hb; const bf16_t* Wg; const bf16_t* Wp; const bf16_t* ya; const bf16_t* yb; const bf16_t* yc; int G, c;
    __device__ __forceinline__ bool next(int i, GU& u) const {
        const int ti = i / 6, sub = i - ti * 6; int pm, pn;
        if (!pg8::tile_order(ti, G, c, MP / 256, 4, pm, pn)) return false;
        u.pm = pm; u.pn = pn; u.kind = sub;
        if (sub < 3) { u.A = Hb + (size_t)pm * 256 * DM; u.lda = DM; u.B = Wg + ((size_t)sub * 1024 + (size_t)pn * 256) * DM; u.ldb = DM; u.nt = 16; }
        else if (sub == 3) { u.A = ya + (size_t)pm * 256 * 256; u.lda = 256; u.B = Wp + (size_t)pn * 256 * DM; u.ldb = DM; u.nt = 4; }
        else if (sub == 4) { u.A = yb + (size_t)pm * 256 * 512; u.lda = 512; u.B = Wp + (size_t)pn * 256 * DM + 256; u.ldb = DM; u.nt = 8; }
        else { u.A = yc + (size_t)pm * 256 * 256; u.lda = 256; u.B = Wp + (size_t)pn * 256 * DM + 768; u.ldb = DM; u.nt = 4; }
        return true;
    }
};

typedef f32x4 Acc[2][2][4][2];
#define EPI_ROWS_BEGIN  _Pragma("unroll") for (int ai = 0; ai < 2; ++ai) _Pragma("unroll") for (int m = 0; m < 4; ++m) { const int rl = ai * 128 + wr * 64 + m * 16 + fr; const int row = u.pm * 256 + rl; (void)rl;
#define EPI_ROWS_END    }
#define EPI_COL(bj) ((bj) * 128 + wc * 32 + fq * 8)

struct EpiInProj {
    const float* ssq; bf16_t* UH; bf16_t* Pz; bf16_t* Pxbc; bf16_t* Prkvx;
    __device__ __forceinline__ bool operator()(Acc& acc, const GU& u, int wr, int wc, int fr, int fq) const {
        EPI_ROWS_BEGIN
            if (row < M_ROWS) {
                const float s = row_scale(ssq, row);
                const int b = row / LEN, t = row - b * LEN;
#pragma unroll
                for (int bj = 0; bj < 2; ++bj) {
                    const int col = EPI_COL(bj);
                    const f32x4 v0 = acc[ai][bj][m][0] * s, v1 = acc[ai][bj][m][1] * s;
                    u32x4 w; w.x = pk2(v0[0], v0[1]); w.y = pk2(v0[2], v0[3]); w.z = pk2(v1[0], v1[1]); w.w = pk2(v1[2], v1[3]);
                    bf16_t* dst;
                    if (u.pn == 0) { const int g = col >> 4, hh = col & 15; dst = UH + ((size_t)g * S5RP + (size_t)(b * NCH16 + (t >> 4))) * 512 + (t & 15) * 16 + hh; }
                    else if (u.pn < 3) dst = Pz + (size_t)row * 512 + (u.pn - 1) * 256 + col;
                    else if (u.pn < 7) dst = Pxbc + (size_t)row * 1024 + (u.pn - 3) * 256 + col;
                    else dst = Prkvx + (size_t)row * 1024 + (u.pn - 7) * 256 + col;
                    *(u32x4*)dst = w;
                }
            }
        EPI_ROWS_END
        return false;
    }
};
struct EpiS5X {
    float* X;
    __device__ __forceinline__ bool operator()(Acc& acc, const GU& u, int wr, int wc, int fr, int fq) const {
        EPI_ROWS_BEGIN
            float* rp = X + ((size_t)u.kind * S5RP + row) * 256;
#pragma unroll
            for (int bj = 0; bj < 2; ++bj) { const int col = EPI_COL(bj); *(f32x4*)(rp + col) = acc[ai][bj][m][0]; *(f32x4*)(rp + col + 4) = acc[ai][bj][m][1]; }
        EPI_ROWS_END
        return false;
    }
};
struct EpiS5Y {
    bf16_t* yapre;
    __device__ __forceinline__ bool operator()(Acc& acc, const GU& u, int wr, int wc, int fr, int fq) const {
        EPI_ROWS_BEGIN
            if (row < S5ROWS) {
                const int b = row / NCH16, c = row - b * NCH16;
#pragma unroll
                for (int bj = 0; bj < 2; ++bj) {
                    const int col = EPI_COL(bj), i = col >> 4, hh = col & 15;
                    const f32x4 v0 = acc[ai][bj][m][0], v1 = acc[ai][bj][m][1];
                    u32x4 w; w.x = pk2(geluf_(v0[0]), geluf_(v0[1])); w.y = pk2(geluf_(v0[2]), geluf_(v0[3])); w.z = pk2(geluf_(v1[0]), geluf_(v1[1])); w.w = pk2(geluf_(v1[2]), geluf_(v1[3]));
                    *(u32x4*)(yapre + ((size_t)b * LEN + c * 16 + i) * 256 + u.kind * 16 + hh) = w;
                }
            }
        EPI_ROWS_END
        return false;
    }
};
struct EpiL1 {
    bf16_t* L1o;
    __device__ __forceinline__ bool operator()(Acc& acc, const GU& u, int wr, int wc, int fr, int fq) const {
        EPI_ROWS_BEGIN
#pragma unroll
            for (int bj = 0; bj < 2; ++bj) {
                const int col = EPI_COL(bj); const int mode = u.pn * 2 + bj;
                f32x4 v0 = acc[ai][bj][m][0], v1 = acc[ai][bj][m][1]; float f[8] = {v0[0], v0[1], v0[2], v0[3], v1[0], v1[1], v1[2], v1[3]};
#pragma unroll
                for (int e = 0; e < 8; ++e) f[e] = mode == 0 ? tanhf_(f[e]) : (mode == 1 ? f[e] : (mode == 2 ? sigmoidf_(f[e]) : 0.f));
                *(u32x4*)(L1o + (size_t)row * 512 + u.pn * 256 + col) = pack8(f);
            }
        EPI_ROWS_END
        return false;
    }
};
struct EpiL2 {
    bf16_t* L2o; const float* w0; const float* a0;
    __device__ __forceinline__ bool operator()(Acc& acc, const GU& u, int wr, int wc, int fr, int fq) const {
        EPI_ROWS_BEGIN
#pragma unroll
            for (int bj = 0; bj < 2; ++bj) {
                const int col = EPI_COL(bj);
                f32x4 v0 = acc[ai][bj][m][0], v1 = acc[ai][bj][m][1]; float f[8] = {v0[0], v0[1], v0[2], v0[3], v1[0], v1[1], v1[2], v1[3]};
                if (u.pn < 2) {
                    const float* bp = w0 + u.pn * 256 + col;
#pragma unroll
                    for (int e = 0; e < 8; ++e) { const float v = bp[e] + f[e]; f[e] = -__expf(-softplusf_(-v) - 0.5f); }
                } else if (u.pn < 4) {
                    const float* bp = a0 + (u.pn - 2) * 256 + col;
#pragma unroll
                    for (int e = 0; e < 8; ++e) f[e] = sigmoidf_(bp[e] + f[e]);
                }
                *(u32x4*)(L2o + (size_t)row * 1280 + u.pn * 256 + col) = pack8(f);
            }
        EPI_ROWS_END
        return false;
    }
};
struct EpiGLU {
    bf16_t* ya; const float* bias;
    __device__ __forceinline__ bool operator()(Acc& acc, const GU& u, int wr, int wc, int fr, int fq) const {
        const int lc = wc * 32 + fq * 8, oc = u.pn * 128 + lc;
        float bv[8], bg[8];
#pragma unroll
        for (int e = 0; e < 8; ++e) { bv[e] = bias[oc + e]; bg[e] = bias[256 + oc + e]; }
        EPI_ROWS_BEGIN
            const f32x4 a0 = acc[ai][0][m][0], a1 = acc[ai][0][m][1], g0 = acc[ai][1][m][0], g1 = acc[ai][1][m][1];
            float v[8] = {a0[0], a0[1], a0[2], a0[3], a1[0], a1[1], a1[2], a1[3]}, g[8] = {g0[0], g0[1], g0[2], g0[3], g1[0], g1[1], g1[2], g1[3]};
#pragma unroll
            for (int e = 0; e < 8; ++e) v[e] = (v[e] + bv[e]) * sigmoidf_(g[e] + bg[e]);
            *(u32x4*)(ya + (size_t)row * 256 + oc) = pack8(v);
        EPI_ROWS_END
        return false;
    }
};
struct EpiProj {
    const float* ssq; unsigned char* park; bf16_t* merged; int tid;
    __device__ __forceinline__ bool operator()(Acc& acc, const GU& u, int wr, int wc, int fr, int fq) const {
        const int k = u.kind;
        EPI_ROWS_BEGIN
            float s = 1.f; if (k < 3) s = row_scale(ssq, row < M_ROWS ? row : 0);
#pragma unroll
            for (int bj = 0; bj < 2; ++bj) {
                const int q = (ai * 2 + bj) * 4 + m;
                f32x4& v0 = acc[ai][bj][m][0]; f32x4& v1 = acc[ai][bj][m][1];
                if (k < 3) {
                    float f[8] = {v0[0], v0[1], v0[2], v0[3], v1[0], v1[1], v1[2], v1[3]};
#pragma unroll
                    for (int e = 0; e < 8; ++e) f[e] = sigmoidf_(f[e] * s);
                    *(u32x4*)(park + ((size_t)(k * 16 + q) * NTHREADS + tid) * 16) = pack8(f);
                } else {
                    float num[8], den[8];
                    unpack8(*(const u32x4*)(park + ((size_t)((k - 3) * 16 + q) * NTHREADS + tid) * 16), num);
                    if (k < 5) { unpack8(*(const u32x4*)(park + ((size_t)((k - 2) * 16 + q) * NTHREADS + tid) * 16), den);
#pragma unroll
                        for (int e = 0; e < 8; ++e) num[e] = num[e] * __builtin_amdgcn_rcpf(den[e]); }
                    v0[0] *= num[0]; v0[1] *= num[1]; v0[2] *= num[2]; v0[3] *= num[3]; v1[0] *= num[4]; v1[1] *= num[5]; v1[2] *= num[6]; v1[3] *= num[7];
                    if (k == 5) { u32x4 w; w.x = pk2(v0[0], v0[1]); w.y = pk2(v0[2], v0[3]); w.z = pk2(v1[0], v1[1]); w.w = pk2(v1[2], v1[3]);
                        *(u32x4*)(merged + (size_t)row * DM + u.pn * 256 + EPI_COL(bj)) = w; }
                }
            }
        EPI_ROWS_END
        return k == 3 || k == 4;
    }
};
struct EpiResid {
    bf16_t* H; float* ssq;
    __device__ __forceinline__ bool operator()(Acc& acc, const GU& u, int wr, int wc, int fr, int fq) const {
        EPI_ROWS_BEGIN
            float ss = 0.f;
            if (row < M_ROWS) {
#pragma unroll
                for (int bj = 0; bj < 2; ++bj) {
                    bf16_t* hp = H + (size_t)row * DM + u.pn * 256 + EPI_COL(bj);
                    float f[8]; unpack8(*(const u32x4*)hp, f);
                    const f32x4 v0 = acc[ai][bj][m][0], v1 = acc[ai][bj][m][1];
                    f[0] += v0[0]; f[1] += v0[1]; f[2] += v0[2]; f[3] += v0[3]; f[4] += v1[0]; f[5] += v1[1]; f[6] += v1[2]; f[7] += v1[3];
#pragma unroll
                    for (int e = 0; e < 8; ++e) ss += f[e] * f[e];
                    *(u32x4*)hp = pack8(f);
                }
            }
            ss += __shfl_xor(ss, 16); ss += __shfl_xor(ss, 32);
            if (fq == 0 && row < M_ROWS) ssq[(size_t)row * 16 + u.pn * 4 + wc] = ss;
        EPI_ROWS_END
        return false;
    }
};
struct EpiUp {
    const float* ssq; bf16_t* act;
    __device__ __forceinline__ bool operator()(Acc& acc, const GU& u, int wr, int wc, int fr, int fq) const {
        EPI_ROWS_BEGIN
            const float s = row_scale(ssq, row < M_ROWS ? row : 0);
#pragma unroll
            for (int bj = 0; bj < 2; ++bj) {
                const f32x4 v0 = acc[ai][bj][m][0] * s, v1 = acc[ai][bj][m][1] * s; float f[8] = {v0[0], v0[1], v0[2], v0[3], v1[0], v1[1], v1[2], v1[3]};
#pragma unroll
                for (int e = 0; e < 8; ++e) { const float r = fmaxf(f[e], 0.f); f[e] = r * r; }
                *(u32x4*)(act + (size_t)row * DFF + u.pn * 256 + EPI_COL(bj)) = pack8(f);
            }
        EPI_ROWS_END
        return false;
    }
};
struct TJob { const float* src; int ld, col0, K, N; bf16_t* dst; int dld, dk0, rmode, row0; const float* ksc; };
constexpr int N_TJOBS = 27;
__device__ __forceinline__ void get_tjob(const Ctx& c, int l, int j, TJob& t) {
    bf16_t* wb = c.wb(l);
    const float* win = c.in[I_WIN] + (size_t)l * DM * N_IN;
    t.rmode = 0; t.ksc = nullptr; t.dk0 = 0; t.col0 = 0; t.row0 = 0;
    if (j < 5) {
        t.src = win; t.ld = N_IN; t.K = DM; t.dld = DM; t.ksc = c.in[I_MIXNW] + l * DM; t.dst = wb + WB_IN;
        if (j == 0) { t.col0 = 0; t.N = 256; t.row0 = 0; }
        else if (j == 1) { t.col0 = 256; t.N = 512; t.row0 = 256; }
        else if (j == 2) { t.col0 = 768; t.N = 1024; t.row0 = 768; }
        else if (j == 3) { t.col0 = 1800; t.N = 1024; t.row0 = 1792; }
        else { t.col0 = 2824; t.N = 3072; t.row0 = 0; t.dst = wb + WB_G; }
    } else if (j == 5) { t.src = c.in[I_PA] + (size_t)l * 256 * DM; t.ld = DM; t.K = 256; t.N = DM; t.dst = wb + WB_P; t.dld = DM; t.dk0 = 0; }
    else if (j == 6) { t.src = c.in[I_PB] + (size_t)l * 512 * DM; t.ld = DM; t.K = 512; t.N = DM; t.dst = wb + WB_P; t.dld = DM; t.dk0 = 256; }
    else if (j == 7) { t.src = c.in[I_PC] + (size_t)l * 256 * DM; t.ld = DM; t.K = 256; t.N = DM; t.dst = wb + WB_P; t.dld = DM; t.dk0 = 768; }
    else if (j == 8) { t.src = c.in[I_WOUT] + (size_t)l * DM * DM; t.ld = DM; t.K = DM; t.N = DM; t.dst = wb + WB_O; t.dld = DM; }
    else if (j == 9) { t.src = c.in[I_MLPW1] + (size_t)l * DM * DFF; t.ld = DFF; t.K = DM; t.N = DFF; t.dst = wb + WB_1; t.dld = DM; t.ksc = c.in[I_MLPNW] + l * DM; }
    else if (j == 10) { t.src = c.in[I_MLPW2] + (size_t)l * DFF * DM; t.ld = DM; t.K = DFF; t.N = DM; t.dst = wb + WB_2; t.dld = DFF; }
    else if (j == 11) { t.src = c.in[I_GLUW] + (size_t)l * 256 * 512; t.ld = 512; t.K = 256; t.N = 512; t.dst = wb + WB_GLU; t.dld = 256; t.rmode = 1; }
    else if (j < 22) {
        const int q = j - 12;
        t.K = 256; t.dst = wb + WB_L1; t.dld = 512;
        if (q < 4) { const int d = q >> 1, hf = q & 1; t.src = c.in[I_W1] + ((size_t)l * 2 + d) * 256 * 64; t.ld = 64; t.N = 64; t.row0 = d * 64; t.dk0 = hf * 256; if (hf) t.ksc = c.in[I_MUWAG] + ((size_t)l * 3 + 0) * 256; }
        else if (q < 8) { const int d = (q - 4) >> 1, hf = q & 1; t.src = c.in[I_A1] + ((size_t)l * 2 + d) * 256 * 64; t.ld = 64; t.N = 64; t.row0 = 128 + d * 64; t.dk0 = hf * 256; if (hf) t.ksc = c.in[I_MUWAG] + ((size_t)l * 3 + 1) * 256; }
        else { const int hf = q & 1; t.src = c.in[I_G1] + (size_t)l * 256 * 128; t.ld = 128; t.N = 128; t.row0 = 256; t.dk0 = hf * 256; if (hf) t.ksc = c.in[I_MUWAG] + ((size_t)l * 3 + 2) * 256; }
    } else {
        const int q = j - 22;
        t.dst = wb + WB_L2; t.dld = 256; t.ld = 256; t.N = 256;
        if (q < 2) { t.src = c.in[I_W2] + ((size_t)l * 2 + q) * 64 * 256; t.K = 64; t.row0 = q * 256; t.dk0 = q * 64; }
        else if (q < 4) { const int d = q - 2; t.src = c.in[I_A2] + ((size_t)l * 2 + d) * 64 * 256; t.K = 64; t.row0 = (2 + d) * 256; t.dk0 = d * 64; }
        else { t.src = c.in[I_G2] + (size_t)l * 128 * 256; t.K = 128; t.row0 = 4 * 256; t.dk0 = 0; }
    }
}
__device__ __forceinline__ int tjob_items(const TJob& t) { return (t.K / 64) * (t.N / 32); }
__device__ __forceinline__ void transpose_item(const TJob& t, LAS float* scr, int item, int lane) {
    const int nblk = t.N / 32, kb = item / nblk, nb = item % nblk, k0 = 64 * kb, n0 = 32 * nb;
#pragma unroll 8
    for (int i = 0; i < 32; ++i) { const int kk = 2 * i + (lane >> 5); float v = t.src[(size_t)(k0 + kk) * t.ld + t.col0 + n0 + (lane & 31)]; if (t.ksc) v *= t.ksc[k0 + kk]; scr[kk * 33 + (lane & 31)] = v; }
    asm volatile("s_waitcnt lgkmcnt(0)" ::: "memory");
    const int cc = lane & 7;
#pragma unroll
    for (int j = 0; j < 4; ++j) {
        const int n = (lane >> 3) + 8 * j; const LAS float* s = scr + (8 * cc) * 33 + n;
        u32x4 o; o.x = pk2(s[0 * 33], s[1 * 33]); o.y = pk2(s[2 * 33], s[3 * 33]); o.z = pk2(s[4 * 33], s[5 * 33]); o.w = pk2(s[6 * 33], s[7 * 33]);
        const int nn = n0 + n; int drow;
        if (t.rmode == 0) drow = t.row0 + nn; else drow = nn < 256 ? (nn >> 7) * 256 + (nn & 127) : ((nn - 256) >> 7) * 256 + 128 + ((nn - 256) & 127);
        *(u32x4*)(t.dst + (size_t)drow * t.dld + t.dk0 + k0 + 8 * cc) = o;
    }
    asm volatile("s_waitcnt lgkmcnt(0)" ::: "memory");
}

__device__ __forceinline__ void s5_build(const Ctx& cx_, int l, int g) {
    const Ctx c = relaunder(cx_);
    LAS float* F = (LAS float*)c.lds;
    LAS float* pwr = F;
    LAS float* pwi = pwr + 2176;
    LAS float* cor = pwi + 2176;
    LAS float* coi = cor + 128;
    LAS float* Cr = coi + 128;
    LAS float* Ci = Cr + 1024;
    LAS float* Br = Ci + 1024;
    LAS float* Bi = Br + 1024;
    LAS float* kr = Bi + 1024;
    LAS float* ki = kr + 1984;
    LAS float* Kd = ki + 1984;
    const int tid = c.tid;
    if (tid < 128) {
        const int d = tid >> 6, n = tid & 63; const size_t li_ = (((size_t)l * 2 + d) * 16 + g) * 64 + n;
        const float lr = c.in[I_S5LRE][li_], li = c.in[I_S5LIM][li_], step = expf(c.in[I_S5LS][((size_t)l * 2 + d) * 16 + g]);
        for (int k = 0; k <= 16; ++k) { const float mag = expf((float)k * lr * step), ang = (float)k * li * step; float sn, cs; sincosf(ang, &sn, &cs); pwr[(d * 17 + k) * 64 + n] = mag * cs; pwi[(d * 17 + k) * 64 + n] = mag * sn; }
        const float mag1 = expf(lr * step); float sn, cs; sincosf(li * step, &sn, &cs); const float abr = mag1 * cs, abi = mag1 * sn, den = lr * lr + li * li;
        cor[d * 64 + n] = ((abr - 1.f) * lr + abi * li) / den; coi[d * 64 + n] = (abi * lr - (abr - 1.f) * li) / den;
    }
    for (int i = tid; i < 1024; i += NTHREADS) {
        Cr[i] = c.in[I_S5CRE][((size_t)l * 16 + g) * 1024 + i]; Ci[i] = c.in[I_S5CIM][((size_t)l * 16 + g) * 1024 + i];
        Br[i] = c.in[I_S5BRE][((size_t)l * 16 + g) * 1024 + i]; Bi[i] = c.in[I_S5BIM][((size_t)l * 16 + g) * 1024 + i];
    }
    __syncthreads();
    for (int i = tid; i < 31 * 64; i += NTHREADS) {
        const int dd = i / 64 - 15, n = i & 63; float r, im;
        if (dd > 0) { const float pr = pwr[(0 * 17 + dd) * 64 + n], pi = pwi[(0 * 17 + dd) * 64 + n]; r = pr * cor[n] - pi * coi[n]; im = pr * coi[n] + pi * cor[n]; }
        else if (dd < 0) { const float pr = pwr[(1 * 17 - dd) * 64 + n], pi = pwi[(1 * 17 - dd) * 64 + n]; r = pr * cor[64 + n] - pi * coi[64 + n]; im = pr * coi[64 + n] + pi * cor[64 + n]; }
        else { r = cor[n] + cor[64 + n]; im = coi[n] + coi[64 + n]; }
        kr[i] = r; ki[i] = im;
    }
    __syncthreads();
    for (int i = tid; i < 31 * 256; i += NTHREADS) {
        const int ddi = i >> 8, h = (i >> 4) & 15, hp = i & 15; float a = 0.f;
        for (int n = 0; n < 64; ++n) { const float cr = Cr[h * 64 + n], ci = Ci[h * 64 + n], xr = kr[ddi * 64 + n], xi = ki[ddi * 64 + n]; const float pr = cr * xr - ci * xi, pi = cr * xi + ci * xr; a += pr * Br[n * 16 + hp] - pi * Bi[n * 16 + hp]; }
        Kd[i] = a;
    }
    __syncthreads();
    bf16_t* SX = c.wb(l) + WB_SX + (size_t)g * 256 * 256; bf16_t* SY = c.wb(l) + WB_SY + (size_t)g * 256 * 512;
    const float* dsk = c.in[I_S5D] + (size_t)l * 256 + g * 16;
    for (int u = tid; u < 256 * 64; u += NTHREADS) {
        const int o = u >> 6, kk0 = (u & 63) * 8, i = o >> 4, h = o & 15; float v[8];
        if (kk0 < 256) { const int j = kk0 >> 4, hp0 = kk0 & 15;
#pragma unroll
            for (int e = 0; e < 8; ++e) v[e] = Kd[(i - j + 15) * 256 + h * 16 + hp0 + e] + ((i == j && h == hp0 + e) ? dsk[h] : 0.f);
        } else { const int q = kk0 - 256, d = q >> 7, part = (q >> 6) & 1, n0 = q & 63, ex = d == 0 ? i + 1 : 16 - i;
#pragma unroll
            for (int e = 0; e < 8; ++e) { const int n = n0 + e; const float cr = Cr[h * 64 + n], ci = Ci[h * 64 + n], pr = pwr[(d * 17 + ex) * 64 + n], pi = pwi[(d * 17 + ex) * 64 + n]; v[e] = part == 0 ? (cr * pr - ci * pi) : -(cr * pi + ci * pr); }
        }
        *(u32x4*)(SY + (size_t)o * 512 + kk0) = pack8(v);
    }
    for (int u = tid; u < 256 * 32; u += NTHREADS) {
        const int o = u >> 5, kk0 = (u & 31) * 8, d = o >> 7, part = (o >> 6) & 1, n = o & 63, j = kk0 >> 4, hp0 = kk0 & 15, ex = d == 0 ? 15 - j : j;
        const float pr = pwr[(d * 17 + ex) * 64 + n], pi = pwi[(d * 17 + ex) * 64 + n], qr = pr * cor[d * 64 + n] - pi * coi[d * 64 + n], qi = pr * coi[d * 64 + n] + pi * cor[d * 64 + n];
        float v[8];
#pragma unroll
        for (int e = 0; e < 8; ++e) { const float br = Br[n * 16 + hp0 + e], bi = Bi[n * 16 + hp0 + e]; v[e] = part == 0 ? (qr * br - qi * bi) : (qr * bi + qi * br); }
        *(u32x4*)(SX + (size_t)o * 256 + kk0) = pack8(v);
    }
    __syncthreads();
}

__device__ __forceinline__ void phase0(const Ctx& cx_) {
    const Ctx c = relaunder(cx_);
    if (c.bid < 32) s5_build(c, c.bid >> 4, c.bid & 15);
    const int gw = c.bid * NWAVES + c.wave, NGW = c.G * NWAVES, lane = c.lane;
    bf16_t* H = c.H(); float* ssq = c.ssq();
    for (int m = gw; m < MP; m += NGW) {
        u32x2* hp = (u32x2*)(H + (size_t)m * DM);
        if (m >= M_ROWS) {
#pragma unroll
            for (int i = 0; i < 4; ++i) hp[lane + 64 * i] = (u32x2){0u, 0u};
            continue;
        }
        const int b = m / LEN, t = m - b * LEN;
        const f32x4* src = (const f32x4*)(t < NMETA ? c.in[I_META] + (size_t)t * DM : c.in[I_X] + ((size_t)b * SEQ + (t - NMETA)) * DM);
        float ss = 0.f;
#pragma unroll
        for (int i = 0; i < 4; ++i) { const f32x4 v = src[lane + 64 * i]; ss += (v.x * v.x + v.y * v.y) + (v.z * v.z + v.w * v.w); hp[lane + 64 * i] = (u32x2){pk2(v.x, v.y), pk2(v.z, v.w)}; }
        ss = wave_sum(ss);
        if (lane < 16) ssq[(size_t)m * 16 + lane] = lane == 0 ? ss : 0.f;
    }
    LAS float* scr = (LAS float*)(c.lds + c.wave * 8448);
    for (int l = 0; l < DEPTH; ++l) {
        int base = 0;
        for (int j = 0; j < N_TJOBS; ++j) {
            TJob t; get_tjob(c, l, j, t); const int ni = tjob_items(t);
            int first = (gw - base % NGW + NGW) % NGW;
            for (int it = first; it < ni; it += NGW) transpose_item(t, scr, it, lane);
            base += ni;
        }
        bf16_t* wb = c.wb(l);
        const int gt = c.bid * NTHREADS + c.tid, NGT = c.G * NTHREADS;
        for (int u = gt; u < 128 * 64; u += NGT) *(u32x4*)(wb + WB_L1 + (size_t)384 * 512 + (size_t)u * 8) = (u32x4){0u, 0u, 0u, 0u};
        for (int u = gt; u < 5 * 256 * 4 * 8; u += NGT) {
            const int sub = u & 7, blk = (u >> 3) & 3, row = (u >> 5) & 255, tile = u >> 13;
            const bool nz = (tile == 0 || tile == 2) ? (blk == 0) : ((tile == 1 || tile == 3) ? (blk == 1) : (blk < 2));
            if (!nz) *(u32x4*)(wb + WB_L2 + ((size_t)tile * 256 + row) * 256 + blk * 64 + sub * 8) = (u32x4){0u, 0u, 0u, 0u};
        }
    }
}

__device__ __forceinline__ void dt_job(const Ctx& cx_, int l) {
    const Ctx c = relaunder(cx_);
    LAS float* dtw = (LAS float*)c.lds;
    const float* win = c.in[I_WIN] + (size_t)l * DM * N_IN; const float* nw = c.in[I_MIXNW] + l * DM;
    for (int i = c.tid; i < 8 * DM; i += NTHREADS) { const int k = i >> 3, j = i & 7; dtw[j * DM + k] = nw[k] * win[(size_t)k * N_IN + 1792 + j]; }
    __syncthreads();
    const int gw = c.bid * NWAVES + c.wave, NGW = c.G * NWAVES, lane = c.lane;
    const bf16_t* H = c.H(); float* dt = (float*)(c.ws + WS_DT); float* dec = (float*)(c.ws + WS_DEC);
    const float* dtb = c.in[I_DTB] + l * 16; const float* alog = c.in[I_ALOG] + l * 16;
    for (int m = gw; m < M_ROWS; m += NGW) {
        const u32x2* hp = (const u32x2*)(H + (size_t)m * DM);
        float ss = 0.f, d8[8] = {0.f, 0.f, 0.f, 0.f, 0.f, 0.f, 0.f, 0.f};
#pragma unroll
        for (int i = 0; i < 4; ++i) {
            const u32x2 w = hp[lane + 64 * i]; const float h0 = bflo(w.x), h1 = bfhi(w.x), h2 = bflo(w.y), h3 = bfhi(w.y);
            ss += (h0 * h0 + h1 * h1) + (h2 * h2 + h3 * h3);
#pragma unroll
            for (int j = 0; j < 8; ++j) { const f32x4 wv = *(const LAS f32x4*)(dtw + j * DM + 4 * lane + 256 * i); d8[j] += (h0 * wv.x + h1 * wv.y) + (h2 * wv.z + h3 * wv.w); }
        }
        ss = wave_sum(ss);
#pragma unroll
        for (int j = 0; j < 8; ++j) d8[j] = wave_sum(d8[j]);
        const float s = __builtin_amdgcn_rsqf(ss * (1.0f / DM) + EPS);
        if (lane < 16) {
            const int j = lane & 7; float raw = d8[0];
#pragma unroll
            for (int e = 1; e < 8; ++e) raw = (j == e) ? d8[e] : raw;
            const float dtv = softplusf_(raw * s + dtb[lane]);
            dt[(size_t)m * 16 + lane] = dtv; dec[(size_t)m * 16 + lane] = __expf(-dtv * __expf(alog[lane]));
        }
    }
    __syncthreads();
}

__device__ __forceinline__ void rwkv_prep(const Ctx& cx_, int l) {
    const Ctx c = relaunder(cx_);
    const int gw = c.bid * NWAVES + c.wave, NGW = c.G * NWAVES, lane = c.lane, c0 = 4 * lane;
    const bf16_t* P = (const bf16_t*)(c.ws + WS_PRKVX); bf16_t* rk = (bf16_t*)(c.dout + DO_RKVP); bf16_t* l1 = (bf16_t*)(c.ws + WS_L1IN);
    float mu[3][4], kkw[4];
#pragma unroll
    for (int x = 0; x < 3; ++x)
#pragma unroll
        for (int e = 0; e < 4; ++e) mu[x][e] = c.in[I_MURKV][((size_t)l * 3 + x) * 256 + c0 + e];
#pragma unroll
    for (int e = 0; e < 4; ++e) kkw[e] = c.in[I_KK][(size_t)l * 256 + c0 + e];
    for (int m = gw; m < M_ROWS; m += NGW) {
        const int b = m / LEN, t = m - b * LEN; const bool hp = t > 0, hn = t < LEN - 1;
        float o[4][4];
        float xc[4], dxc[4];
#pragma unroll
        for (int x = 0; x < 4; ++x) {
            const u32x2 wc_ = *(const u32x2*)(P + (size_t)m * 1024 + x * 256 + c0);
            u32x2 wp = (u32x2){0u, 0u}, wn = (u32x2){0u, 0u};
            if (hp) wp = *(const u32x2*)(P + (size_t)(m - 1) * 1024 + x * 256 + c0);
            if (hn) wn = *(const u32x2*)(P + (size_t)(m + 1) * 1024 + x * 256 + c0);
            const float cur[4] = {bflo(wc_.x), bfhi(wc_.x), bflo(wc_.y), bfhi(wc_.y)}, pv[4] = {bflo(wp.x), bfhi(wp.x), bflo(wp.y), bfhi(wp.y)}, nv[4] = {bflo(wn.x), bfhi(wn.x), bflo(wn.y), bfhi(wn.y)};
#pragma unroll
            for (int e = 0; e < 4; ++e) { const float cs = 0.5f * (pv[e] + nv[e]) - cur[e]; if (x < 3) o[x][e] = cur[e] + cs * mu[x][e]; else { xc[e] = cur[e]; dxc[e] = cs; } }
        }
        float kr_[4], ss = 0.f;
#pragma unroll
        for (int e = 0; e < 4; ++e) { kr_[e] = o[1][e] * kkw[e]; ss += kr_[e] * kr_[e]; }
        ss = sum16(ss); const float rn = __builtin_amdgcn_rsqf(ss + 1e-12f);
        bf16_t* rp = rk + (size_t)m * 1024 + c0;
        *(u32x2*)(rp) = (u32x2){pk2(o[0][0], o[0][1]), pk2(o[0][2], o[0][3])};
        *(u32x2*)(rp + 256) = (u32x2){pk2(o[1][0], o[1][1]), pk2(o[1][2], o[1][3])};
        *(u32x2*)(rp + 512) = (u32x2){pk2(o[2][0], o[2][1]), pk2(o[2][2], o[2][3])};
        *(u32x2*)(rp + 768) = (u32x2){pk2(kr_[0] * rn, kr_[1] * rn), pk2(kr_[2] * rn, kr_[3] * rn)};
        bf16_t* lp = l1 + (size_t)m * 512 + c0;
        *(u32x2*)(lp) = (u32x2){pk2(xc[0], xc[1]), pk2(xc[2], xc[3])};
        *(u32x2*)(lp + 256) = (u32x2){pk2(dxc[0], dxc[1]), pk2(dxc[2], dxc[3])};
    }
}
__device__ __forceinline__ void ssd_prep(const Ctx& cx_, int l) {
    const Ctx c = relaunder(cx_);
    const int gw = c.bid * NWAVES + c.wave, NGW = c.G * NWAVES, lane = c.lane, c0 = 16 * lane;
    const bf16_t* P = (const bf16_t*)(c.ws + WS_PXBC); bf16_t* xs = (bf16_t*)(c.ws + WS_XS); bf16_t* bc = (bf16_t*)(c.ws + WS_BC);
    float w[5][16], bias[16];
#pragma unroll
    for (int j = 0; j < 5; ++j)
#pragma unroll
        for (int e = 0; e < 16; ++e) w[j][e] = c.in[I_CONVW][((size_t)l * 5 + j) * 1024 + c0 + e];
#pragma unroll
    for (int e = 0; e < 16; ++e) bias[e] = c.in[I_CONVB][(size_t)l * 1024 + c0 + e];
    for (int m = gw; m < M_ROWS; m += NGW) {
        const int b = m / LEN, t = m - b * LEN;
        float a[16];
#pragma unroll
        for (int e = 0; e < 16; ++e) a[e] = bias[e];
#pragma unroll
        for (int j = 0; j < 5; ++j) {
            const int tt = t + j - 2;
            if (tt >= 0 && tt < LEN) {
                const u32x4* p = (const u32x4*)(P + (size_t)(m + j - 2) * 1024 + c0); float f0[8], f1[8]; unpack8(p[0], f0); unpack8(p[1], f1);
#pragma unroll
                for (int e = 0; e < 8; ++e) { a[e] += w[j][e] * f0[e]; a[8 + e] += w[j][8 + e] * f1[e]; }
            }
        }
        float o0[8], o1[8];
#pragma unroll
        for (int e = 0; e < 8; ++e) { o0[e] = siluf_(a[e]); o1[e] = siluf_(a[8 + e]); }
        bf16_t* dst = lane < 32 ? xs + (size_t)m * 512 + c0 : bc + (size_t)m * 512 + (c0 - 512);
        ((u32x4*)dst)[0] = pack8(o0); ((u32x4*)dst)[1] = pack8(o1);
    }
}

__device__ __forceinline__ void s5_scan(const Ctx& cx_, int l) {
    const Ctx c = relaunder(cx_);
    if (c.tid >= 64) return;
    const int gt = c.bid * 64 + c.tid; if (gt >= 16384) return;
    const int n = gt & 63, d = (gt >> 6) & 1, b = (gt >> 7) & 7, g = gt >> 10;
    const size_t li_ = (((size_t)l * 2 + d) * 16 + g) * 64 + n;
    const float lr = c.in[I_S5LRE][li_], li = c.in[I_S5LIM][li_], step = expf(c.in[I_S5LS][((size_t)l * 2 + d) * 16 + g]);
    const float mag = expf(16.f * lr * step); float sn, cs; sincosf(16.f * li * step, &sn, &cs); const float ar = mag * cs, ai = mag * sn;
    const float* X = (const float*)(c.ws + WS_X) + ((size_t)g * S5RP + (size_t)b * NCH16) * 256 + d * 128 + n;
    bf16_t* U = (bf16_t*)(c.ws + WS_UH) + ((size_t)g * S5RP + (size_t)b * NCH16) * 512 + 256 + d * 128 + n;
    float hr = 0.f, hi = 0.f;
    for (int i0 = 0; i0 < NCH16; i0 += 32) {
        float xr[32], xi[32];
#pragma unroll
        for (int k = 0; k < 32; ++k) { const int i = i0 + k; const int ch = d == 0 ? i : NCH16 - 1 - i; const bool ok = i < NCH16; xr[k] = ok ? X[(size_t)ch * 256] : 0.f; xi[k] = ok ? X[(size_t)ch * 256 + 64] : 0.f; }
#pragma unroll
        for (int k = 0; k < 32; ++k) { const int i = i0 + k; if (i < NCH16) { const int ch = d == 0 ? i : NCH16 - 1 - i;
            U[(size_t)ch * 512] = (bf16_t)f2bf(hr); U[(size_t)ch * 512 + 64] = (bf16_t)f2bf(hi);
            const float nr = ar * hr - ai * hi + xr[k], ni = ar * hi + ai * hr + xi[k]; hr = nr; hi = ni; } }
    }
}
constexpr int RW_T = 32, RW_NC = (LEN + RW_T - 1) / RW_T, RW_BUF = 45056;
__device__ __forceinline__ void rwkv_scan(const Ctx& cx_, int l) {
    const Ctx c = relaunder(cx_);
    const int bid = c.bid, q = bid & 3, dir = (bid >> 2) & 1, head = (bid >> 3) & 3, b = bid >> 5;
    const int tid = c.tid, lane = c.lane, wave = c.wave;
    const bf16_t* rk = (const bf16_t*)(c.dout + DO_RKVP); const bf16_t* l2 = (const bf16_t*)(c.ws + WS_L2O);
    bf16_t* yo = (bf16_t*)(c.ws + WS_YRW) + (size_t)dir * MP * 256;
    const bool producer = wave >= 4;
    const int pt = tid - 256, pstep = pt >> 3, pc0 = (pt & 7) * 8, pv0 = 2 * (pt & 7);
    float ka[8];
    u32x4 R, K, KK, DL, AS; unsigned V2 = 0; R = K = KK = DL = AS = (u32x4){0u, 0u, 0u, 0u};
    if (producer) {
#pragma unroll
        for (int e = 0; e < 8; ++e) ka[e] = c.in[I_KA][(size_t)l * 256 + head * 64 + pc0 + e];
    }
    auto tok = [&](int s) -> size_t { const int t = dir ? LEN - 1 - s : s; return (size_t)b * LEN + t; };
#define RW_LOAD(chunk) do { const int s_ = (chunk) * RW_T + pstep; if (s_ < LEN) { const size_t m_ = tok(s_); const bf16_t* rp_ = rk + m_ * 1024 + head * 64; const bf16_t* lp_ = l2 + m_ * 1280 + dir * 256 + head * 64; \
        R = *(const u32x4*)(rp_ + pc0); K = *(const u32x4*)(rp_ + 256 + pc0); KK = *(const u32x4*)(rp_ + 768 + pc0); V2 = *(const unsigned*)(rp_ + 512 + 16 * q + pv0); \
        DL = *(const u32x4*)(lp_ + pc0); AS = *(const u32x4*)(lp_ + 512 + pc0); } } while (0)
#define RW_WRITE(buf) do { LAS float* vec_ = (LAS float*)(c.lds + (buf) * RW_BUF); float r_[8], k_[8], kk_[8], dl_[8], as_[8]; unpack8(R, r_); unpack8(K, k_); unpack8(KK, kk_); unpack8(DL, dl_); unpack8(AS, as_); \
        float w_[8], a_[8], b_[8], kd_[8]; _Pragma("unroll") for (int e = 0; e < 8; ++e) { w_[e] = __expf(dl_[e]); a_[e] = -kk_[e]; b_[e] = kk_[e] * as_[e]; kd_[e] = k_[e] * (1.f + (as_[e] - 1.f) * ka[e]); } \
        LAS float* bp_ = vec_ + pstep * 320 + pc0; \
        *(LAS f32x4*)(bp_) = (f32x4){w_[0], w_[1], w_[2], w_[3]}; *(LAS f32x4*)(bp_ + 4) = (f32x4){w_[4], w_[5], w_[6], w_[7]}; \
        *(LAS f32x4*)(bp_ + 64) = (f32x4){a_[0], a_[1], a_[2], a_[3]}; *(LAS f32x4*)(bp_ + 68) = (f32x4){a_[4], a_[5], a_[6], a_[7]}; \
        *(LAS f32x4*)(bp_ + 128) = (f32x4){b_[0], b_[1], b_[2], b_[3]}; *(LAS f32x4*)(bp_ + 132) = (f32x4){b_[4], b_[5], b_[6], b_[7]}; \
        *(LAS f32x4*)(bp_ + 192) = (f32x4){kd_[0], kd_[1], kd_[2], kd_[3]}; *(LAS f32x4*)(bp_ + 196) = (f32x4){kd_[4], kd_[5], kd_[6], kd_[7]}; \
        *(LAS f32x4*)(bp_ + 256) = (f32x4){r_[0], r_[1], r_[2], r_[3]}; *(LAS f32x4*)(bp_ + 260) = (f32x4){r_[4], r_[5], r_[6], r_[7]}; \
        LAS float* vr_ = vec_ + 10240 + pstep * 16 + pv0; vr_[0] = bflo(V2); vr_[1] = bfhi(V2); } while (0)
#define RW_FLUSH(chunk) do { const int s_ = (chunk) * RW_T + pstep; if (s_ < LEN) { const LAS float* yy_ = (const LAS float*)(c.lds + ((chunk) & 1) * RW_BUF) + 10752 + pstep * 16 + pv0; \
        *(unsigned*)(yo + tok(s_) * 256 + head * 64 + 16 * q + pv0) = pk2(yy_[0], yy_[1]); } } while (0)
    if (producer) { RW_LOAD(0); RW_WRITE(0); RW_LOAD(1); }
    __syncthreads();
    const int rowl = (wave & 3) * 4 + (lane >> 4), j4 = (lane & 15) * 4;
    float S0 = 0.f, S1 = 0.f, S2 = 0.f, S3 = 0.f;
#define RW_SCAN(NS) do { float yv_[NS]; \
        _Pragma("unroll") for (int st = 0; st < NS; ++st) { \
            const LAS float* bp = vec + st * 320 + j4; \
            const f32x4 w = *(const LAS f32x4*)(bp), a = *(const LAS f32x4*)(bp + 64), bb = *(const LAS f32x4*)(bp + 128), kd = *(const LAS f32x4*)(bp + 192), r = *(const LAS f32x4*)(bp + 256); \
            const float v = vec[10240 + st * 16 + rowl]; \
            float sa = (S0 * a.x + S1 * a.y) + (S2 * a.z + S3 * a.w); \
            sa = allred16(sa); \
            S0 = S0 * w.x + v * kd.x; S1 = S1 * w.y + v * kd.y; S2 = S2 * w.z + v * kd.z; S3 = S3 * w.w + v * kd.w; \
            S0 += sa * bb.x; S1 += sa * bb.y; S2 += sa * bb.z; S3 += sa * bb.w; \
            float y = (S0 * r.x + S1 * r.y) + (S2 * r.z + S3 * r.w); \
            yv_[st] = allred16(y); } \
        if ((lane & 15) == 0) { _Pragma("unroll") for (int st = 0; st < NS; ++st) yy[st * 16 + rowl] = yv_[st]; } } while (0)
    for (int ch = 0; ch < RW_NC; ++ch) {
        if (!producer) {
            const LAS float* vec = (const LAS float*)(c.lds + (ch & 1) * RW_BUF);
            LAS float* yy = (LAS float*)(c.lds + (ch & 1) * RW_BUF) + 10752;
            if (ch < RW_NC - 1) RW_SCAN(32); else RW_SCAN(LEN - (RW_NC - 1) * RW_T);
        } else {
            if (ch + 1 < RW_NC) RW_WRITE((ch + 1) & 1);
            if (ch + 2 < RW_NC) RW_LOAD(ch + 2);
            if (ch >= 1) RW_FLUSH(ch - 1);
        }
        __syncthreads();
    }
#undef RW_SCAN
    if (producer) RW_FLUSH(RW_NC - 1);
    __syncthreads();
#undef RW_LOAD
#undef RW_WRITE
#undef RW_FLUSH
}

constexpr int SD_T = 32, SD_NC = (LEN + SD_T - 1) / SD_T, SD_BUF = 41472;
__device__ __forceinline__ void ssd_scan(const Ctx& cx_, int l) {
    const Ctx c = relaunder(cx_);
    const int bid = c.bid, ph = bid & 1, dir = (bid >> 1) & 1, head = (bid >> 2) & 7, b = bid >> 5, grp = head >> 2;
    const int tid = c.tid, lane = c.lane, wave = c.wave;
    const bf16_t* bc = (const bf16_t*)(c.ws + WS_BC); const bf16_t* xs = (const bf16_t*)(c.ws + WS_XS);
    const float* dtb = (const float*)(c.ws + WS_DT); const float* decb = (const float*)(c.ws + WS_DEC);
    bf16_t* yo = (bf16_t*)(c.ws + WS_YSSD) + (size_t)dir * MP * 512;
    const int lstep = tid >> 4, ln0 = (tid & 15) * 8, lp0 = (tid & 15) * 2;
    u32x4 Bv = (u32x4){0u, 0u, 0u, 0u}, Cv = Bv; unsigned xv = 0; float dtv = 0.f, decv = 1.f;
    auto tok = [&](int s) -> size_t { const int t = dir ? LEN - 1 - s : s; return (size_t)b * LEN + t; };
#define SD_LOAD(chunk) do { const int s_ = (chunk) * SD_T + lstep; if (s_ < LEN) { const size_t m_ = tok(s_); Bv = *(const u32x4*)(bc + m_ * 512 + grp * 128 + ln0); Cv = *(const u32x4*)(bc + m_ * 512 + 256 + grp * 128 + ln0); \
        xv = *(const unsigned*)(xs + m_ * 512 + head * 64 + ph * 32 + lp0); dtv = dtb[m_ * 16 + dir * 8 + head]; decv = decb[m_ * 16 + dir * 8 + head]; } } while (0)
#define SD_WRITE(buf) do { LAS float* f_ = (LAS float*)(c.lds + (buf) * SD_BUF); float b_[8], c_[8]; unpack8(Bv, b_); unpack8(Cv, c_); \
        *(LAS f32x4*)(f_ + lstep * 128 + ln0) = (f32x4){b_[0], b_[1], b_[2], b_[3]}; *(LAS f32x4*)(f_ + lstep * 128 + ln0 + 4) = (f32x4){b_[4], b_[5], b_[6], b_[7]}; \
        *(LAS f32x4*)(f_ + 4096 + lstep * 128 + ln0) = (f32x4){c_[0], c_[1], c_[2], c_[3]}; *(LAS f32x4*)(f_ + 4096 + lstep * 128 + ln0 + 4) = (f32x4){c_[4], c_[5], c_[6], c_[7]}; \
        f_[8192 + lstep * 32 + lp0] = bflo(xv) * dtv; f_[8192 + lstep * 32 + lp0 + 1] = bfhi(xv) * dtv; if ((tid & 15) == 0) f_[9216 + lstep] = decv; } while (0)
#define SD_FLUSH(chunk) do { const int s_ = (chunk) * SD_T + lstep; if (s_ < LEN) { const LAS float* yy_ = (const LAS float*)(c.lds + ((chunk) & 1) * SD_BUF) + 9248 + lstep * 32 + lp0; \
        *(unsigned*)(yo + tok(s_) * 512 + head * 64 + ph * 32 + lp0) = pk2(yy_[0], yy_[1]); } } while (0)
    SD_LOAD(0); SD_WRITE(0); SD_LOAD(1);
    __syncthreads();
    const int ng8 = (lane & 15) * 8, pl = wave * 4 + (lane >> 4);
    float h[8] = {0.f, 0.f, 0.f, 0.f, 0.f, 0.f, 0.f, 0.f};
    for (int ch = 0; ch < SD_NC; ++ch) {
        if (ch + 1 < SD_NC) SD_WRITE((ch + 1) & 1);
        if (ch + 2 < SD_NC) SD_LOAD(ch + 2);
        if (ch >= 1) SD_FLUSH(ch - 1);
        const LAS float* f = (const LAS float*)(c.lds + (ch & 1) * SD_BUF);
        LAS float* yy = (LAS float*)(c.lds + (ch & 1) * SD_BUF) + 9248;
        const int ns = (LEN - ch * SD_T) < SD_T ? (LEN - ch * SD_T) : SD_T;
#pragma unroll 2
        for (int st = 0; st < ns; ++st) {
            const f32x4 b0 = *(const LAS f32x4*)(f + st * 128 + ng8), b1 = *(const LAS f32x4*)(f + st * 128 + ng8 + 4);
            const f32x4 c0 = *(const LAS f32x4*)(f + 4096 + st * 128 + ng8), c1 = *(const LAS f32x4*)(f + 4096 + st * 128 + ng8 + 4);
            const float xd = f[8192 + st * 32 + pl], dc = f[9216 + st];
            h[0] = h[0] * dc + b0.x * xd; h[1] = h[1] * dc + b0.y * xd; h[2] = h[2] * dc + b0.z * xd; h[3] = h[3] * dc + b0.w * xd;
            h[4] = h[4] * dc + b1.x * xd; h[5] = h[5] * dc + b1.y * xd; h[6] = h[6] * dc + b1.z * xd; h[7] = h[7] * dc + b1.w * xd;
            float y = ((h[0] * c0.x + h[1] * c0.y) + (h[2] * c0.z + h[3] * c0.w)) + ((h[4] * c1.x + h[5] * c1.y) + (h[6] * c1.z + h[7] * c1.w));
            y = allred16(y);
            if ((lane & 15) == 0) yy[st * 32 + pl] = y;
        }
        __syncthreads();
    }
    SD_FLUSH(SD_NC - 1);
    __syncthreads();
#undef SD_LOAD
#undef SD_WRITE
#undef SD_FLUSH
}

__device__ __forceinline__ void ssd_post(const Ctx& cx_, int l) {
    const Ctx c = relaunder(cx_);
    const int gw = c.bid * NWAVES + c.wave, NGW = c.G * NWAVES, lane = c.lane, c0 = 8 * lane;
    const bf16_t* y0 = (const bf16_t*)(c.ws + WS_YSSD); const bf16_t* y1 = y0 + (size_t)MP * 512;
    const bf16_t* xs = (const bf16_t*)(c.ws + WS_XS); const bf16_t* pz = (const bf16_t*)(c.ws + WS_PZ); bf16_t* yb = (bf16_t*)(c.ws + WS_YB);
    const float dsk = c.in[I_SSDD][l * 8 + (lane >> 3)];
    float nw[8];
#pragma unroll
    for (int e = 0; e < 8; ++e) nw[e] = c.in[I_SSDNW][(size_t)l * 512 + c0 + e];
    for (int m = gw; m < M_ROWS; m += NGW) {
        float a[8], bq[8], x[8], z[8]; unpack8(*(const u32x4*)(y0 + (size_t)m * 512 + c0), a); unpack8(*(const u32x4*)(y1 + (size_t)m * 512 + c0), bq);
        unpack8(*(const u32x4*)(xs + (size_t)m * 512 + c0), x); unpack8(*(const u32x4*)(pz + (size_t)m * 512 + c0), z);
        float ss = 0.f;
#pragma unroll
        for (int e = 0; e < 8; ++e) { a[e] = (a[e] + bq[e] + dsk * x[e]) * siluf_(z[e]); ss += a[e] * a[e]; }
        ss = wave_sum(ss); const float s = __builtin_amdgcn_rsqf(ss * (1.0f / 512.f) + EPS);
#pragma unroll
        for (int e = 0; e < 8; ++e) a[e] = a[e] * s * nw[e];
        *(u32x4*)(yb + (size_t)m * 512 + c0) = pack8(a);
    }
}
__device__ __forceinline__ void rwkv_post(const Ctx& cx_, int l) {
    const Ctx c = relaunder(cx_);
    const int gw = c.bid * NWAVES + c.wave, NGW = c.G * NWAVES, lane = c.lane, c0 = 4 * lane;
    const bf16_t* y0 = (const bf16_t*)(c.ws + WS_YRW); const bf16_t* y1 = y0 + (size_t)MP * 256;
    const bf16_t* rk = (const bf16_t*)(c.dout + DO_RKVP); const bf16_t* l2 = (const bf16_t*)(c.ws + WS_L2O); bf16_t* yc = (bf16_t*)(c.ws + WS_YC);
    float lw[4], lb[4], rkw[4];
#pragma unroll
    for (int e = 0; e < 4; ++e) { lw[e] = c.in[I_LNW][(size_t)l * 256 + c0 + e]; lb[e] = c.in[I_LNB][(size_t)l * 256 + c0 + e]; rkw[e] = c.in[I_RK][(size_t)l * 256 + c0 + e]; }
    for (int m = gw; m < M_ROWS; m += NGW) {
        const u32x2 a = *(const u32x2*)(y0 + (size_t)m * 256 + c0), bq = *(const u32x2*)(y1 + (size_t)m * 256 + c0);
        const u32x2 rr = *(const u32x2*)(rk + (size_t)m * 1024 + c0), kk = *(const u32x2*)(rk + (size_t)m * 1024 + 256 + c0), vv = *(const u32x2*)(rk + (size_t)m * 1024 + 512 + c0);
        const u32x2 gg = *(const u32x2*)(l2 + (size_t)m * 1280 + 1024 + c0);
        float y[4] = {bflo(a.x) + bflo(bq.x), bfhi(a.x) + bfhi(bq.x), bflo(a.y) + bflo(bq.y), bfhi(a.y) + bfhi(bq.y)};
        const float r[4] = {bflo(rr.x), bfhi(rr.x), bflo(rr.y), bfhi(rr.y)}, k[4] = {bflo(kk.x), bfhi(kk.x), bflo(kk.y), bfhi(kk.y)};
        const float v[4] = {bflo(vv.x), bfhi(vv.x), bflo(vv.y), bfhi(vv.y)}, g[4] = {bflo(gg.x), bfhi(gg.x), bflo(gg.y), bfhi(gg.y)};
        const float mean = sum16((y[0] + y[1]) + (y[2] + y[3])) * (1.f / 64.f);
        float q = 0.f, bo = 0.f;
#pragma unroll
        for (int e = 0; e < 4; ++e) { y[e] -= mean; q += y[e] * y[e]; bo += r[e] * k[e] * rkw[e]; }
        q = sum16(q) * (1.f / 64.f); bo = sum16(bo);
        const float rs = __builtin_amdgcn_rsqf(q + 64e-5f);
        float o[4];
#pragma unroll
        for (int e = 0; e < 4; ++e) o[e] = (y[e] * rs * lw[e] + lb[e] + bo * v[e]) * g[e];
        *(u32x2*)(yc + (size_t)m * 256 + c0) = (u32x2){pk2(o[0], o[1]), pk2(o[2], o[3])};
    }
}
__device__ __forceinline__ void final_phase(const Ctx& cx_, float* out) {
    const Ctx c = relaunder(cx_);
    const int gw = c.bid * NWAVES + c.wave, NGW = c.G * NWAVES, lane = c.lane;
    const bf16_t* H = c.H(); const f32x4* fw = (const f32x4*)c.in[I_FNW];
    for (int r = gw; r < BATCH * SEQ; r += NGW) {
        const int b = r / SEQ, tq = r - b * SEQ; const size_t m = (size_t)b * LEN + NMETA + tq;
        const u32x2* hp = (const u32x2*)(H + m * DM);
        float v[4][4], ss = 0.f;
#pragma unroll
        for (int i = 0; i < 4; ++i) { const u32x2 w = hp[lane + 64 * i]; v[i][0] = bflo(w.x); v[i][1] = bfhi(w.x); v[i][2] = bflo(w.y); v[i][3] = bfhi(w.y); ss += (v[i][0] * v[i][0] + v[i][1] * v[i][1]) + (v[i][2] * v[i][2] + v[i][3] * v[i][3]); }
        ss = wave_sum(ss); const float s = __builtin_amdgcn_rsqf(ss * (1.0f / DM) + EPS);
        f32x4* op = (f32x4*)(out + (size_t)r * DM);
#pragma unroll
        for (int i = 0; i < 4; ++i) { const f32x4 w = fw[lane + 64 * i]; op[lane + 64 * i] = (f32x4){v[i][0] * s * w.x, v[i][1] * s * w.y, v[i][2] * s * w.z, v[i][3] * s * w.w}; }
    }
}

constexpr int LDS_BYTES = 147456;
#ifndef PHMASK
#define PHMASK 0xFFFFF
#endif
__global__ void __launch_bounds__(NTHREADS, 2) mega_fwd(Params p) {
    extern __shared__ __attribute__((aligned(16))) unsigned char lds_raw[];
    cg::grid_group grid = cg::this_grid();
    Ctx c; c.in = p.in; c.ws = p.ws; c.dout = (unsigned char*)p.out; c.lds = (LAS unsigned char*)lds_raw;
    c.tid = threadIdx.x; c.lane = c.tid & 63; c.wave = __builtin_amdgcn_readfirstlane(c.tid >> 6); c.G = gridDim.x; c.bid = blockIdx.x;
    const int G = c.G, bid = c.bid;
#ifdef PROF_A
#ifndef PROF_SHIFT
#define PROF_SHIFT 1.0f
#endif
    unsigned long long* prof = (unsigned long long*)(c.ws + WS_DEC + (size_t)MP * 64);
    unsigned long long t_prev = 0;
    const bool stamper = (blockIdx.x == 0 && threadIdx.x == 0);
    if (stamper) { for (int k = 0; k < 16; ++k) prof[k] = 0; t_prev = __builtin_amdgcn_s_memrealtime(); }
#define STAMP(k) do { if (stamper) { const unsigned long long t_ = __builtin_amdgcn_s_memrealtime(); prof[k] += t_ - t_prev; t_prev = t_; } } while (0)
#else
#define STAMP(k) do { } while (0)
#endif
    if (PHMASK & 1) phase0(c);
    grid.sync(); STAMP(0);
#pragma unroll 1
    for (int l = 0; l < DEPTH; ++l) {
        bf16_t* wb = c.wb(l);
        if (PHMASK & 2) dt_job(c, l);
        if (PHMASK & 4) { SchedPlain S{c.H(), wb + WB_IN, DM, DM, DM, MP / 256, 11, G, bid};
          EpiInProj E{c.ssq(), (bf16_t*)(c.ws + WS_UH), (bf16_t*)(c.ws + WS_PZ), (bf16_t*)(c.ws + WS_PXBC), (bf16_t*)(c.ws + WS_PRKVX)};
          pg8::gemm_phase(c.lds, S, E); }
        grid.sync(); STAMP(1);
        if (PHMASK & 8) { SchedS5 S{(const bf16_t*)(c.ws + WS_UH), wb + WB_SX, 256, G, bid}; EpiS5X E{(float*)(c.ws + WS_X)}; pg8::gemm_phase(c.lds, S, E); }
        if (PHMASK & 16) rwkv_prep(c, l);
        if (PHMASK & 32) ssd_prep(c, l);
        grid.sync(); STAMP(2);
        if (PHMASK & 64) s5_scan(c, l);
        if (PHMASK & 128) { SchedPlain S{(const bf16_t*)(c.ws + WS_L1IN), wb + WB_L1, 512, 512, 512, MP / 256, 2, G, bid}; EpiL1 E{(bf16_t*)(c.ws + WS_L1O)}; pg8::gemm_phase(c.lds, S, E); }
        grid.sync(); STAMP(3);
        if (PHMASK & 256) { SchedL2 S{(const bf16_t*)(c.ws + WS_L1O), wb + WB_L2, G, bid}; EpiL2 E{(bf16_t*)(c.ws + WS_L2O), c.in[I_W0] + (size_t)l * 512, c.in[I_A0] + (size_t)l * 512}; pg8::gemm_phase(c.lds, S, E); }
        if (PHMASK & 512) { SchedS5 S{(const bf16_t*)(c.ws + WS_UH), wb + WB_SY, 512, G, bid}; EpiS5Y E{(bf16_t*)(c.ws + WS_YAPRE)}; pg8::gemm_phase(c.lds, S, E); }
        grid.sync(); STAMP(4);
        if (PHMASK & 1024) rwkv_scan(c, l);
        STAMP(5);
        if (PHMASK & 2048) ssd_scan(c, l);
        grid.sync(); STAMP(6);
        if (PHMASK & 4096) ssd_post(c, l);
        if (PHMASK & 8192) rwkv_post(c, l);
        if (PHMASK & 16384) { SchedPlain S{(const bf16_t*)(c.ws + WS_YAPRE), wb + WB_GLU, 256, 256, 256, MP / 256, 2, G, bid}; EpiGLU E{(bf16_t*)(c.ws + WS_YA), c.in[I_GLUB] + (size_t)l * 512}; pg8::gemm_phase(c.lds, S, E); }
        grid.sync(); STAMP(7);
        if (PHMASK & 32768) { SchedProj S{c.H(), wb + WB_G, wb + WB_P, (const bf16_t*)(c.ws + WS_YA), (const bf16_t*)(c.ws + WS_YB), (const bf16_t*)(c.ws + WS_YC), G, bid};
          EpiProj E{c.ssq(), c.ws + WS_PARK + (size_t)bid * 393216, (bf16_t*)(c.dout + DO_MERGED), opaque_tid()}; pg8::gemm_phase(c.lds, S, E); }
        grid.sync(); STAMP(8);
        if (PHMASK & 65536) { SchedPlain S{(const bf16_t*)(c.dout + DO_MERGED), wb + WB_O, DM, DM, DM, MP / 256, 4, G, bid}; EpiResid E{c.H(), c.ssq()}; pg8::gemm_phase(c.lds, S, E); }
        grid.sync(); STAMP(9);
        if (PHMASK & 131072) { SchedPlain S{c.H(), wb + WB_1, DM, DM, DM, MP / 256, 16, G, bid}; EpiUp E{c.ssq(), (bf16_t*)(c.ws + WS_ACT)}; pg8::gemm_phase(c.lds, S, E); }
        grid.sync(); STAMP(10);
        if (PHMASK & 262144) { SchedPlain S{(const bf16_t*)(c.ws + WS_ACT), wb + WB_2, DFF, DFF, DFF, MP / 256, 4, G, bid}; EpiResid E{c.H(), c.ssq()}; pg8::gemm_phase(c.lds, S, E); }
        grid.sync(); STAMP(11);
    }
    if (PHMASK & 524288) final_phase(c, p.out);
#ifdef PROF_A
    grid.sync(); STAMP(12);
    if (blockIdx.x == 0) {
        __syncthreads();
        float va = (float)(__hip_atomic_load(&prof[PROF_A], __ATOMIC_RELAXED, __HIP_MEMORY_SCOPE_AGENT)) * 0.01f, vb = (float)(__hip_atomic_load(&prof[PROF_B], __ATOMIC_RELAXED, __HIP_MEMORY_SCOPE_AGENT)) * 0.01f;
        va = exp2f(rintf(log2f(va * PROF_SHIFT) * 3.f) * (1.f / 3.f)); vb = exp2f(rintf(log2f(vb * PROF_SHIFT) * 3.f) * (1.f / 3.f));
        for (int i = threadIdx.x; i < (1 << 20); i += NTHREADS) p.out[1 + i] = vb;
        if (threadIdx.x == 0) p.out[0] = 100.f * va;
    }
#endif
}

extern "C" void kernel_launch(void* const* d_in, const int* in_sizes, int n_in, void* d_out, int out_size, void* d_ws, size_t ws_size, hipStream_t stream) {
    static int grid = 0;
    if (grid == 0) {
        int dev = 0, cus = 0, per_cu = 0;
        if (n_in != N_INPUTS || out_size != BATCH * SEQ * DM || ws_size < WS_END) { fprintf(stderr, "kernel_launch: unexpected shapes (n_in %d out %d ws %zu)\n", n_in, out_size, ws_size); grid = -1; return; }
        (void)hipGetDevice(&dev); (void)hipDeviceGetAttribute(&cus, hipDeviceAttributeMultiprocessorCount, dev);
        (void)hipFuncSetAttribute((const void*)mega_fwd, hipFuncAttributeMaxDynamicSharedMemorySize, LDS_BYTES);
        (void)hipOccupancyMaxActiveBlocksPerMultiprocessor(&per_cu, (const void*)mega_fwd, NTHREADS, LDS_BYTES);
        if (per_cu < 1) { fprintf(stderr, "kernel_launch: occupancy query says %d blocks per CU\n", per_cu); per_cu = 1; }
        grid = cus * 1;
        if (grid != 256) fprintf(stderr, "kernel_launch: %d CUs (the scan phases are laid out for 256 workgroups)\n", grid);
    }
    if (grid < 0) return;
    Params p{};
    for (int i = 0; i < N_INPUTS; ++i) p.in[i] = (const float*)d_in[i];
    p.out = (float*)d_out; p.ws = (unsigned char*)d_ws; p.ph_lo = 0; p.ph_hi = 0;
    void* args[] = {&p};
    hipError_t e = hipLaunchCooperativeKernel((const void*)mega_fwd, dim3(grid), dim3(NTHREADS), args, LDS_BYTES, stream);
    if (e != hipSuccess) fprintf(stderr, "cooperative launch failed: %s (grid %d)\n", hipGetErrorString(e), grid);
}
```

```cpp
#include <hip/hip_runtime.h>
#include <hip/hip_cooperative_groups.h>
#include <cstdio>
#include <cstdint>
namespace cg = cooperative_groups;

#define LAS __attribute__((address_space(3)))
typedef unsigned short bf16_t;
typedef short bf16x8 __attribute__((ext_vector_type(8)));
typedef float f32x4 __attribute__((ext_vector_type(4)));
typedef unsigned u32x4 __attribute__((ext_vector_type(4)));
typedef unsigned u32x2 __attribute__((ext_vector_type(2)));

constexpr int BATCH = 8, SEQ = 4096, NMETA = 16, LEN = SEQ + NMETA, DM = 1024, DFF = 4096, DEPTH = 2;
constexpr int M_ROWS = BATCH * LEN;
constexpr int MP = 33024;
constexpr int N_IN = 5896;
constexpr int NCH16 = LEN / 16;
constexpr int S5ROWS = BATCH * NCH16;
constexpr int S5RP = 2304;
constexpr float EPS = 1e-6f;
constexpr int NTHREADS = 512, NWAVES = 8;

constexpr size_t QB = (size_t)MP * 256 * 2;
constexpr size_t WB_IN = 0;
constexpr size_t WB_G = WB_IN + (size_t)2816 * 1024;
constexpr size_t WB_P = WB_G + (size_t)3072 * 1024;
constexpr size_t WB_O = WB_P + (size_t)1024 * 1024;
constexpr size_t WB_1 = WB_O + (size_t)1024 * 1024;
constexpr size_t WB_2 = WB_1 + (size_t)4096 * 1024;
constexpr size_t WB_GLU = WB_2 + (size_t)1024 * 4096;
constexpr size_t WB_L1 = WB_GLU + (size_t)512 * 256;
constexpr size_t WB_L2 = WB_L1 + (size_t)512 * 512;
constexpr size_t WB_SX = WB_L2 + (size_t)1280 * 256;
constexpr size_t WB_SY = WB_SX + (size_t)16 * 256 * 256;
constexpr size_t WB_ELEMS = WB_SY + (size_t)16 * 256 * 512;
constexpr size_t WB_BYTES = WB_ELEMS * 2;
static_assert(WB_BYTES <= 5 * QB / 2, "weight block fits 2.5 Q");

constexpr size_t WS_H = 0;
constexpr size_t WS_WB0 = 4 * QB;
constexpr size_t WS_SMALL = 13 * QB / 2;
constexpr size_t WS_SSQ = WS_SMALL;
constexpr size_t WS_DT = WS_SSQ + (size_t)MP * 16 * 4;
constexpr size_t WS_DEC = WS_DT + (size_t)MP * 16 * 4;
static_assert(WS_DEC + (size_t)MP * 16 * 4 <= 7 * QB, "small region");
constexpr size_t WS_MIX = 7 * QB;
constexpr size_t WS_PXBC = WS_MIX;
constexpr size_t WS_YSSD = WS_MIX;
constexpr size_t WS_PARK = WS_MIX;
constexpr size_t WS_ACT = WS_MIX;
constexpr size_t WS_PRKVX = WS_MIX + 4 * QB;
constexpr size_t WS_L2O = WS_MIX + 4 * QB;
constexpr size_t WS_PZ = WS_MIX + 9 * QB;
constexpr size_t WS_UH = WS_MIX + 11 * QB;
constexpr size_t WS_X = WS_MIX + 53 * QB / 4;
constexpr size_t WS_YRW = WS_X;
constexpr size_t WS_L1IN = WS_MIX + 31 * QB / 2;
constexpr size_t WS_YAPRE = WS_L1IN;
constexpr size_t WS_L1O = WS_MIX + 35 * QB / 2;
constexpr size_t WS_YB = WS_L1O;
constexpr size_t WS_BC = WS_MIX + 39 * QB / 2;
constexpr size_t WS_YA = WS_BC;
constexpr size_t WS_YC = WS_BC + QB;
constexpr size_t WS_XS = WS_MIX + 43 * QB / 2;
constexpr size_t WS_END = WS_XS + 2 * QB;
static_assert(WS_END <= (size_t)512 << 20, "workspace map fits 512 MiB");
static_assert((size_t)16 * S5RP * 512 * 2 <= 9 * QB / 4 && (size_t)16 * S5RP * 256 * 4 <= 9 * QB / 4, "S5 buffers fit their slots");
static_assert((size_t)256 * 393216 <= 6 * QB, "gate park");
constexpr size_t DO_RKVP = 0;
constexpr size_t DO_MERGED = 0;
constexpr size_t DO_WB1 = 4 * QB;
static_assert(DO_WB1 + WB_BYTES <= (size_t)BATCH * SEQ * DM * 4, "d_out scratch map");

__device__ __forceinline__ unsigned f2bf(float f) { unsigned u = __builtin_bit_cast(unsigned, f); return (u + 0x7fffu + ((u >> 16) & 1u)) >> 16; }
__device__ __forceinline__ unsigned pk2(float lo, float hi) { unsigned r; asm volatile("v_cvt_pk_bf16_f32 %0, %1, %2" : "=v"(r) : "v"(lo), "v"(hi)); return r; }
__device__ __forceinline__ float bflo(unsigned w) { return __builtin_bit_cast(float, w << 16); }
__device__ __forceinline__ float bfhi(unsigned w) { return __builtin_bit_cast(float, w & 0xffff0000u); }
__device__ __forceinline__ float bf1(bf16_t v) { return __builtin_bit_cast(float, (unsigned)v << 16); }
__device__ __forceinline__ float sigmoidf_(float x) { return 1.0f / (1.0f + __expf(-x)); }
__device__ __forceinline__ float siluf_(float x) { return x / (1.0f + __expf(-x)); }
__device__ __forceinline__ float tanhf_(float x) { x = fminf(fmaxf(x, -15.f), 15.f); const float t = __expf(2.f * x); return (t - 1.f) / (t + 1.f); }
__device__ __forceinline__ float softplusf_(float x) { return fmaxf(x, 0.f) + __logf(1.0f + __expf(-fabsf(x))); }
__device__ __forceinline__ float geluf_(float x) { const float u = 0.7978845608028654f * (x + 0.044715f * x * x * x); return 0.5f * x * (1.f + tanhf_(u)); }
__device__ __forceinline__ float wave_sum(float v) {
#pragma unroll
    for (int o = 1; o < 64; o <<= 1) v += __shfl_xor(v, o);
    return v;
}
__device__ __forceinline__ float sum16(float v) {
#pragma unroll
    for (int o = 1; o < 16; o <<= 1) v += __shfl_xor(v, o);
    return v;
}
template <int CTRL> __device__ __forceinline__ float dpp_mov(float x) {
    return __builtin_bit_cast(float, __builtin_amdgcn_update_dpp(0, __builtin_bit_cast(int, x), CTRL, 0xf, 0xf, true));
}
__device__ __forceinline__ float allred16(float x) {
    x += dpp_mov<0xB1>(x); x += dpp_mov<0x4E>(x); x += dpp_mov<0x141>(x); x += dpp_mov<0x140>(x); return x;
}
__device__ __forceinline__ void unpack8(const u32x4 w, float (&f)[8]) {
    f[0] = bflo(w.x); f[1] = bfhi(w.x); f[2] = bflo(w.y); f[3] = bfhi(w.y); f[4] = bflo(w.z); f[5] = bfhi(w.z); f[6] = bflo(w.w); f[7] = bfhi(w.w);
}
__device__ __forceinline__ u32x4 pack8(const float (&f)[8]) { u32x4 w; w.x = pk2(f[0], f[1]); w.y = pk2(f[2], f[3]); w.z = pk2(f[4], f[5]); w.w = pk2(f[6], f[7]); return w; }
__device__ __forceinline__ int opaque_tid() { int t = threadIdx.x; asm volatile("" : "+v"(t)); return t; }
namespace pg8 {
constexpr int BM = 256, BK = 64, HALF = 128, HTB = HALF * BK * 2  , STAGE_BYTES = 8 * HTB;
__host__ __device__ __forceinline__ int lds_byte(int r, int c) { const int st = (r >> 4) * 2 + (c >> 5), rr = r & 15, cc = c & 31, ob = rr * 64 + cc * 2; return st * 1024 + (ob ^ (((ob >> 9) & 1) << 5)); }
__host__ __device__ __forceinline__ void stage_rc(int b, int& R, int& C) { const int st = b / 1024, sb = b % 1024, swz = sb ^ (((sb >> 9) & 1) << 5); R = (st >> 1) * 16 + swz / 64; C = (st & 1) * 32 + (swz % 64) / 2; }
__host__ __device__ __forceinline__ int perm32(int rho) { const int n = rho >> 4, i = rho & 15; return 8 * (i >> 2) + 4 * n + (i & 3); }

struct GU {
    const bf16_t* A;
    const bf16_t* B;
    int lda, ldb, nt;
    int pm, pn, kind;
};

template <class Epi, class Sched>
__device__ __forceinline__ void gemm_phase(LAS unsigned char* lds, const Sched& S, const Epi& E) {
    const int tid = opaque_tid(), wid = __builtin_amdgcn_readfirstlane(tid >> 6), lane = tid & 63, wr = wid >> 2, wc = wid & 3, fr = lane & 15, fq = lane >> 4;
#define PG8_VOFF(lda_, ldb_, a0, a1, b0, b1) do { int R0_, C0_, R1_, C1_; stage_rc(tid * 16, R0_, C0_); stage_rc(tid * 16 + 8192, R1_, C1_); \
        a0 = (unsigned)(R0_ * (lda_) + C0_) * 2u; a1 = (unsigned)(R1_ * (lda_) + C1_) * 2u; \
        b0 = (unsigned)(((R0_ & ~31) + perm32(R0_ & 31)) * (ldb_) + C0_) * 2u; b1 = (unsigned)(((R1_ & ~31) + perm32(R1_ & 31)) * (ldb_) + C1_) * 2u; } while (0)
    const size_t kstep = (size_t)(BK * 2);
    const unsigned ldsw = (unsigned)wid * 1024u;
    const int aoff = lds_byte(wr * 64 + fr, fq * 8), boff = lds_byte(wc * 32 + fr, fq * 8);
#define PG8_SA(b, h) (((b) * 2 + (h)) * HTB)
#define PG8_SB(b, h) ((4 + (b) * 2 + (h)) * HTB)
#define PG8_STAGE(bufoff, gbase, v0, v1) do { \
        __builtin_amdgcn_global_load_lds((const unsigned*)((const char*)(gbase) + (v0)), (LAS unsigned*)(lds + (bufoff) + ldsw), 16, 0, 0); \
        __builtin_amdgcn_global_load_lds((const unsigned*)((const char*)(gbase) + (v1)), (LAS unsigned*)(lds + (bufoff) + ldsw + 8192), 16, 0, 0); } while (0)
#define PG8_LDA(dst, b, h) do { _Pragma("unroll") for (int m = 0; m < 4; ++m) _Pragma("unroll") for (int k = 0; k < 2; ++k) dst[m][k] = *(const LAS bf16x8*)(lds + PG8_SA(b, h) + aoff + m * 2048 + k * 1024); } while (0)
#define PG8_LDB(dst, b, h) do { _Pragma("unroll") for (int n = 0; n < 2; ++n) _Pragma("unroll") for (int k = 0; k < 2; ++k) dst[n][k] = *(const LAS bf16x8*)(lds + PG8_SB(b, h) + boff + n * 2048 + k * 1024); } while (0)
#define PG8_MMA(ai, bj, At, Bt) do { __builtin_amdgcn_s_setprio(1); _Pragma("unroll") for (int m = 0; m < 4; ++m) _Pragma("unroll") for (int n = 0; n < 2; ++n) _Pragma("unroll") for (int k = 0; k < 2; ++k) \
        acc[ai][bj][m][n] = __builtin_amdgcn_mfma_f32_16x16x32_bf16(Bt[n][k], At[m][k], acc[ai][bj][m][n], 0, 0, 0); __builtin_amdgcn_s_setprio(0); } while (0)
#define PG8_WAIT_V(n) asm volatile("s_waitcnt vmcnt(" #n ")" ::: "memory")
#define PG8_WAIT_L(n) asm volatile("s_waitcnt lgkmcnt(" #n ")" ::: "memory")
#define PG8_BAR __builtin_amdgcn_s_barrier()
#define PG8_SCHED __builtin_amdgcn_sched_barrier(0)
    GU cur, nxt; int ui = 0;
    if (!S.next(0, cur)) return;
    f32x4 acc[2][2][4][2];
#pragma unroll
    for (int a = 0; a < 2; ++a)
#pragma unroll
        for (int b = 0; b < 2; ++b)
#pragma unroll
            for (int m = 0; m < 4; ++m)
#pragma unroll
                for (int n = 0; n < 2; ++n) acc[a][b][m][n] = (f32x4){0.f, 0.f, 0.f, 0.f};
    bf16x8 At[4][2], B0[2][2], B1[2][2];
    const char* cA = (const char*)cur.A; const char* cB = (const char*)cur.B;
    unsigned vA0, vA1, vB0, vB1; PG8_VOFF(cur.lda, cur.ldb, vA0, vA1, vB0, vB1);
    size_t hsA = (size_t)HALF * cur.lda * 2, hsB = (size_t)HALF * cur.ldb * 2;
    int nt = cur.nt; asm volatile("" : "+s"(nt));
    PG8_STAGE(PG8_SB(0, 0), cB, vB0, vB1); PG8_STAGE(PG8_SB(0, 1), cB + hsB, vB0, vB1); PG8_STAGE(PG8_SA(0, 0), cA, vA0, vA1); PG8_STAGE(PG8_SA(0, 1), cA + hsA, vA0, vA1);
    if (wr == 1) PG8_BAR;
    PG8_WAIT_V(2); PG8_BAR;
    PG8_STAGE(PG8_SB(1, 0), cB + kstep, vB0, vB1); PG8_STAGE(PG8_SA(1, 0), cA + kstep, vA0, vA1); PG8_STAGE(PG8_SB(1, 1), cB + hsB + kstep, vB0, vB1);
    PG8_WAIT_V(6); PG8_BAR;
    for (;;) {
        const bool has_next = S.next(ui + 1, nxt);
        const char* nA = has_next ? (const char*)nxt.A : cA; const char* nB = has_next ? (const char*)nxt.B : cB;
        unsigned nvA0 = vA0, nvA1 = vA1, nvB0 = vB0, nvB1 = vB1;
        if (has_next) PG8_VOFF(nxt.lda, nxt.ldb, nvA0, nvA1, nvB0, nvB1);
        const size_t nhsA = has_next ? (size_t)HALF * nxt.lda * 2 : hsA, nhsB = has_next ? (size_t)HALF * nxt.ldb * 2 : hsB;
        for (int t = 0; t < nt; t += 2) {
            const bool last = (t == nt - 2);
            const char* a1 = cA + (size_t)(t + 1) * kstep;
            const char* a2 = last ? nA : cA + (size_t)(t + 2) * kstep; const char* b2 = last ? nB : cB + (size_t)(t + 2) * kstep;
            const char* a3 = a2 + kstep; const char* b3 = b2 + kstep;
            const unsigned xA0 = last ? nvA0 : vA0, xA1 = last ? nvA1 : vA1, xB0 = last ? nvB0 : vB0, xB1 = last ? nvB1 : vB1;
            const size_t xhA = last ? nhsA : hsA, xhB = last ? nhsB : hsB;
            PG8_LDB(B0, 0, 0); PG8_LDB(B1, 0, 1); PG8_SCHED; PG8_LDA(At, 0, 0); PG8_STAGE(PG8_SA(1, 1), a1 + hsA, vA0, vA1);
            PG8_WAIT_V(8); PG8_WAIT_L(0); PG8_BAR; PG8_MMA(0, 0, At, B0); PG8_MMA(0, 1, At, B1); PG8_BAR; PG8_SCHED;
            PG8_LDA(At, 0, 1); PG8_STAGE(PG8_SB(0, 0), b2, xB0, xB1); PG8_STAGE(PG8_SB(0, 1), b2 + xhB, xB0, xB1); PG8_STAGE(PG8_SA(0, 0), a2, xA0, xA1);
            PG8_WAIT_V(8); PG8_WAIT_L(0); PG8_BAR; PG8_MMA(1, 0, At, B0); PG8_MMA(1, 1, At, B1); PG8_BAR; PG8_SCHED;
            PG8_LDB(B0, 1, 0); PG8_LDB(B1, 1, 1); PG8_SCHED; PG8_LDA(At, 1, 0); PG8_STAGE(PG8_SA(0, 1), a2 + xhA, xA0, xA1);
            PG8_WAIT_V(8); PG8_WAIT_L(0); PG8_BAR; PG8_MMA(0, 0, At, B0); PG8_MMA(0, 1, At, B1); PG8_BAR; PG8_SCHED;
            PG8_LDA(At, 1, 1); PG8_STAGE(PG8_SB(1, 0), b3, xB0, xB1); PG8_STAGE(PG8_SB(1, 1), b3 + xhB, xB0, xB1); PG8_STAGE(PG8_SA(1, 0), a3, xA0, xA1);
            PG8_WAIT_V(8); PG8_WAIT_L(0); PG8_BAR; PG8_MMA(1, 0, At, B0); PG8_MMA(1, 1, At, B1); PG8_BAR; PG8_SCHED;
        }
        if (wr == 0) PG8_BAR;
        const bool keep = E(acc, cur, wr, wc, fr, fq);
        if (!has_next) break;
        if (!keep) {
#pragma unroll
            for (int a = 0; a < 2; ++a)
#pragma unroll
                for (int b = 0; b < 2; ++b)
#pragma unroll
                    for (int m = 0; m < 4; ++m)
#pragma unroll
                        for (int n = 0; n < 2; ++n) acc[a][b][m][n] = (f32x4){0.f, 0.f, 0.f, 0.f};
        }
        cur = nxt; cA = nA; cB = nB; vA0 = nvA0; vA1 = nvA1; vB0 = nvB0; vB1 = nvB1; hsA = nhsA; hsB = nhsB; nt = cur.nt; asm volatile("" : "+s"(nt)); ++ui;
        if (wr == 1) PG8_BAR;
    }
    PG8_WAIT_V(0);
    PG8_BAR;
#undef PG8_VOFF
#undef PG8_SA
#undef PG8_SB
#undef PG8_STAGE
#undef PG8_LDA
#undef PG8_LDB
#undef PG8_MMA
#undef PG8_WAIT_V
#undef PG8_WAIT_L
#undef PG8_BAR
#undef PG8_SCHED
}

__device__ __forceinline__ bool tile_order(int i, int G, int c, int nM, int nN, int& pm, int& pn) {
    const int nwg = nM * nN; const long L = (long)i * G + c; if (L >= nwg) return false;
    int wgid = (int)L; { const int q = nwg / 8, r = nwg % 8, xcd = wgid % 8, off = wgid / 8; wgid = (xcd < r ? xcd * (q + 1) : r * (q + 1) + (xcd - r) * q) + off; }
    const int nig = 8 * nN, gid = wgid / nig, fm = gid * 8, gsz = (nM - fm) < 8 ? (nM - fm) : 8;
    pm = fm + ((wgid % nig) % gsz); pn = (wgid % nig) / gsz; return true;
}
}
using pg8::GU;
enum InIdx { I_X = 0, I_META, I_FNW, I_MIXNW, I_WIN, I_S5LRE, I_S5LIM, I_S5LS, I_S5BRE, I_S5BIM, I_S5CRE, I_S5CIM, I_S5D, I_GLUW, I_GLUB,
             I_CONVW, I_CONVB, I_ALOG, I_DTB, I_SSDD, I_SSDNW, I_MURKV, I_MUWAG, I_W0, I_W1, I_W2, I_A0, I_A1, I_A2, I_G1, I_G2, I_KK, I_KA, I_RK, I_LNW, I_LNB,
             I_PA, I_PB, I_PC, I_WOUT, I_MLPNW, I_MLPW1, I_MLPW2, N_INPUTS };
struct Params { const float* in[N_INPUTS]; float* out; unsigned char* ws; int ph_lo, ph_hi; };

struct Ctx {
    const float* const* in; unsigned char* ws; unsigned char* dout;
    LAS unsigned char* lds;
    int tid, lane, wave, G, bid;
    __device__ __forceinline__ bf16_t* wb(int layer) const { return (bf16_t*)(layer == 0 ? ws + WS_WB0 : dout + DO_WB1); }
    __device__ __forceinline__ bf16_t* H() const { return (bf16_t*)(ws + WS_H); }
    __device__ __forceinline__ float* ssq() const { return (float*)(ws + WS_SSQ); }
};
__device__ __forceinline__ Ctx relaunder(const Ctx& c0) { Ctx c = c0; c.tid = opaque_tid(); c.lane = c.tid & 63; c.wave = __builtin_amdgcn_readfirstlane(c.tid >> 6); return c; }
__device__ __forceinline__ float row_scale(const float* ssq, int row) {
    const f32x4* p = (const f32x4*)(ssq + (size_t)row * 16);
    const f32x4 a = p[0], b = p[1], c = p[2], d = p[3];
    const float s = ((a.x + a.y) + (a.z + a.w)) + ((b.x + b.y) + (b.z + b.w)) + ((c.x + c.y) + (c.z + c.w)) + ((d.x + d.y) + (d.z + d.w));
    return __builtin_amdgcn_rsqf(s * (1.0f / DM) + EPS);
}

struct SchedPlain {
    const bf16_t* A; const bf16_t* B; int lda, ldb, K, nM, nN, G, c;
    __device__ __forceinline__ bool next(int i, GU& u) const {
        int pm, pn; if (!pg8::tile_order(i, G, c, nM, nN, pm, pn)) return false;
        u.A = A + (size_t)pm * 256 * lda; u.B = B + (size_t)pn * 256 * ldb; u.lda = lda; u.ldb = ldb; u.nt = K / 64; u.pm = pm; u.pn = pn; u.kind = 0; return true;
    }
};
struct SchedS5 {
    const bf16_t* UH; const bf16_t* W; int K, G, c;
    __device__ __forceinline__ bool next(int i, GU& u) const {
        const int L = i * G + c; if (L >= 144) return false;
        const int g = L / 9, pm = L % 9;
        u.A = UH + ((size_t)g * S5RP + (size_t)pm * 256) * 512; u.B = W + (size_t)g * 256 * K; u.lda = 512; u.ldb = K; u.nt = K / 64; u.pm = pm; u.pn = 0; u.kind = g; return true;
    }
};
struct SchedL2 {
    const bf16_t* L1o; const bf16_t* W; int G, c;
    __device__ __forceinline__ bool next(int i, GU& u) const {
        int pm, pn; if (!pg8::tile_order(i, G, c, MP / 256, 5, pm, pn)) return false;
        const int koff = pn < 2 ? 0 : (pn < 4 ? 128 : 256);
        u.A = L1o + (size_t)pm * 256 * 512 + koff; u.B = W + (size_t)pn * 256 * 256; u.lda = 512; u.ldb = 256; u.nt = 4; u.pm = pm; u.pn = pn; u.kind = 0; return true;
    }
};
struct SchedProj {
    const bf16_t* Hb; const bf16_t* Wg; const bf16_t* Wp; const bf16_t* ya; const bf16_t* yb; const bf16_t* yc; int G, c;
    __device__ __forceinline__ bool next(int i, GU& u) const {
        const int ti = i / 6, sub = i - ti * 6; int pm, pn;
        if (!pg8::tile_order(ti, G, c, MP / 256, 4, pm, pn)) return false;
        u.pm = pm; u.pn = pn; u.kind = sub;
        if (sub < 3) { u.A = Hb + (size_t)pm * 256 * DM; u.lda = DM; u.B = Wg + ((size_t)sub * 1024 + (size_t)pn * 256) * DM; u.ldb = DM; u.nt = 16; }
        else if (sub == 3) { u.A = ya + (size_t)pm * 256 * 256; u.lda = 256; u.B = Wp + (size_t)pn * 256 * DM; u.ldb = DM; u.nt = 4; }
        else if (sub == 4) { u.A = yb + (size_t)pm * 256 * 512; u.lda = 512; u.B = Wp + (size_t)pn * 256 * DM + 256; u.ldb = DM; u.nt = 8; }
        else { u.A = yc + (size_t)pm * 256 * 256; u.lda = 256; u.B = Wp + (size_t)pn * 256 * DM + 768; u.ldb = DM; u.nt = 4; }
        return true;
    }
};

typedef f32x4 Acc[2][2][4][2];
#define EPI_ROWS_BEGIN  _Pragma("unroll") for (int ai = 0; ai < 2; ++ai) _Pragma("unroll") for (int m = 0; m < 4; ++m) { const int rl = ai * 128 + wr * 64 + m * 16 + fr; const int row = u.pm * 256 + rl; (void)rl;
#define EPI_ROWS_END    }
#define EPI_COL(bj) ((bj) * 128 + wc * 32 + fq * 8)

struct EpiInProj {
    const float* ssq; bf16_t* UH; bf16_t* Pz; bf16_t* Pxbc; bf16_t* Prkvx;
    __device__ __forceinline__ bool operator()(Acc& acc, const GU& u, int wr, int wc, int fr, int fq) const {
        EPI_ROWS_BEGIN
            if (row < M_ROWS) {
                const float s = row_scale(ssq, row);
                const int b = row / LEN, t = row - b * LEN;
#pragma unroll
                for (int bj = 0; bj < 2; ++bj) {
                    const int col = EPI_COL(bj);
                    const f32x4 v0 = acc[ai][bj][m][0] * s, v1 = acc[ai][bj][m][1] * s;
                    u32x4 w; w.x = pk2(v0[0], v0[1]); w.y = pk2(v0[2], v0[3]); w.z = pk2(v1[0], v1[1]); w.w = pk2(v1[2], v1[3]);
                    bf16_t* dst;
                    if (u.pn == 0) { const int g = col >> 4, hh = col & 15; dst = UH + ((size_t)g * S5RP + (size_t)(b * NCH16 + (t >> 4))) * 512 + (t & 15) * 16 + hh; }
                    else if (u.pn < 3) dst = Pz + (size_t)row * 512 + (u.pn - 1) * 256 + col;
                    else if (u.pn < 7) dst = Pxbc + (size_t)row * 1024 + (u.pn - 3) * 256 + col;
                    else dst = Prkvx + (size_t)row * 1024 + (u.pn - 7) * 256 + col;
                    *(u32x4*)dst = w;
                }
            }
        EPI_ROWS_END
        return false;
    }
};
struct EpiS5X {
    float* X;
    __device__ __forceinline__ bool operator()(Acc& acc, const GU& u, int wr, int wc, int fr, int fq) const {
        EPI_ROWS_BEGIN
            float* rp = X + ((size_t)u.kind * S5RP + row) * 256;
#pragma unroll
            for (int bj = 0; bj < 2; ++bj) { const int col = EPI_COL(bj); *(f32x4*)(rp + col) = acc[ai][bj][m][0]; *(f32x4*)(rp + col + 4) = acc[ai][bj][m][1]; }
        EPI_ROWS_END
        return false;
    }
};
struct EpiS5Y {
    bf16_t* yapre;
    __device__ __forceinline__ bool operator()(Acc& acc, const GU& u, int wr, int wc, int fr, int fq) const {
        EPI_ROWS_BEGIN
            if (row < S5ROWS) {
                const int b = row / NCH16, c = row - b * NCH16;
#pragma unroll
                for (int bj = 0; bj < 2; ++bj) {
                    const int col = EPI_COL(bj), i = col >> 4, hh = col & 15;
                    const f32x4 v0 = acc[ai][bj][m][0], v1 = acc[ai][bj][m][1];
                    u32x4 w; w.x = pk2(geluf_(v0[0]), geluf_(v0[1])); w.y = pk2(geluf_(v0[2]), geluf_(v0[3])); w.z = pk2(geluf_(v1[0]), geluf_(v1[1])); w.w = pk2(geluf_(v1[2]), geluf_(v1[3]));
                    *(u32x4*)(yapre + ((size_t)b * LEN + c * 16 + i) * 256 + u.kind * 16 + hh) = w;
                }
            }
        EPI_ROWS_END
        return false;
    }
};
struct EpiL1 {
    bf16_t* L1o;
    __device__ __forceinline__ bool operator()(Acc& acc, const GU& u, int wr, int wc, int fr, int fq) const {
        EPI_ROWS_BEGIN
#pragma unroll
            for (int bj = 0; bj < 2; ++bj) {
                const int col = EPI_COL(bj); const int mode = u.pn * 2 + bj;
                f32x4 v0 = acc[ai][bj][m][0], v1 = acc[ai][bj][m][1]; float f[8] = {v0[0], v0[1], v0[2], v0[3], v1[0], v1[1], v1[2], v1[3]};
#pragma unroll
                for (int e = 0; e < 8; ++e) f[e] = mode == 0 ? tanhf_(f[e]) : (mode == 1 ? f[e] : (mode == 2 ? sigmoidf_(f[e]) : 0.f));
                *(u32x4*)(L1o + (size_t)row * 512 + u.pn * 256 + col) = pack8(f);
            }
        EPI_ROWS_END
        return false;
    }
};
struct EpiL2 {
    bf16_t* L2o; const float* w0; const float* a0;
    __device__ __forceinline__ bool operator()(Acc& acc, const GU& u, int wr, int wc, int fr, int fq) const {
        EPI_ROWS_BEGIN
#pragma unroll
            for (int bj = 0; bj < 2; ++bj) {
                const int col = EPI_COL(bj);
                f32x4 v0 = acc[ai][bj][m][0], v1 = acc[ai][bj][m][1]; float f[8] = {v0[0], v0[1], v0[2], v0[3], v1[0], v1[1], v1[2], v1[3]};
                if (u.pn < 2) {
                    const float* bp = w0 + u.pn * 256 + col;
#pragma unroll
                    for (int e = 0; e < 8; ++e) { const float v = bp[e] + f[e]; f[e] = -__expf(-softplusf_(-v) - 0.5f); }
                } else if (u.pn < 4) {
                    const float* bp = a0 + (u.pn - 2) * 256 + col;
#pragma unroll
                    for (int e = 0; e < 8; ++e) f[e] = sigmoidf_(bp[e] + f[e]);
                }
                *(u32x4*)(L2o + (size_t)row * 1280 + u.pn * 256 + col) = pack8(f);
            }
        EPI_ROWS_END
        return false;
    }
};
struct EpiGLU {
    bf16_t* ya; const float* bias;
    __device__ __forceinline__ bool operator()(Acc& acc, const GU& u, int wr, int wc, int fr, int fq) const {
        const int lc = wc * 32 + fq * 8, oc = u.pn * 128 + lc;
        float bv[8], bg[8];
#pragma unroll
        for (int e = 0; e < 8; ++e) { bv[e] = bias[oc + e]; bg[e] = bias[256 + oc + e]; }
        EPI_ROWS_BEGIN
            const f32x4 a0 = acc[ai][0][m][0], a1 = acc[ai][0][m][1], g0 = acc[ai][1][m][0], g1 = acc[ai][1][m][1];
            float v[8] = {a0[0], a0[1], a0[2], a0[3], a1[0], a1[1], a1[2], a1[3]}, g[8] = {g0[0], g0[1], g0[2], g0[3], g1[0], g1[1], g1[2], g1[3]};
#pragma unroll
            for (int e = 0; e < 8; ++e) v[e] = (v[e] + bv[e]) * sigmoidf_(g[e] + bg[e]);
            *(u32x4*)(ya + (size_t)row * 256 + oc) = pack8(v);
        EPI_ROWS_END
        return false;
    }
};
struct EpiProj {
    const float* ssq; const float* ssqb; unsigned char* park; bf16_t* merged; int tid;
    __device__ __forceinline__ bool operator()(Acc& acc, const GU& u, int wr, int wc, int fr, int fq) const {
        const int k = u.kind;
        EPI_ROWS_BEGIN
            float s = 1.f; if (k < 3) s = row_scale(ssq, row < M_ROWS ? row : 0);
            else if (k < 5) { s = __builtin_amdgcn_rsqf(ssqb[row < M_ROWS ? row : 0] * (1.0f / 512.f) + EPS); if (k == 3) s = __builtin_amdgcn_rcpf(s); }
#pragma unroll
            for (int bj = 0; bj < 2; ++bj) {
                const int q = (ai * 2 + bj) * 4 + m;
                f32x4& v0 = acc[ai][bj][m][0]; f32x4& v1 = acc[ai][bj][m][1];
                if (k < 3) {
                    float f[8] = {v0[0], v0[1], v0[2], v0[3], v1[0], v1[1], v1[2], v1[3]};
#pragma unroll
                    for (int e = 0; e < 8; ++e) f[e] = sigmoidf_(f[e] * s);
                    *(u32x4*)(park + ((size_t)(k * 16 + q) * NTHREADS + tid) * 16) = pack8(f);
                } else {
                    float num[8], den[8];
                    unpack8(*(const u32x4*)(park + ((size_t)((k - 3) * 16 + q) * NTHREADS + tid) * 16), num);
                    if (k < 5) { unpack8(*(const u32x4*)(park + ((size_t)((k - 2) * 16 + q) * NTHREADS + tid) * 16), den);
#pragma unroll
                        for (int e = 0; e < 8; ++e) num[e] = num[e] * __builtin_amdgcn_rcpf(den[e]) * s; }
                    v0[0] *= num[0]; v0[1] *= num[1]; v0[2] *= num[2]; v0[3] *= num[3]; v1[0] *= num[4]; v1[1] *= num[5]; v1[2] *= num[6]; v1[3] *= num[7];
                    if (k == 5) { u32x4 w; w.x = pk2(v0[0], v0[1]); w.y = pk2(v0[2], v0[3]); w.z = pk2(v1[0], v1[1]); w.w = pk2(v1[2], v1[3]);
                        *(u32x4*)(merged + (size_t)row * DM + u.pn * 256 + EPI_COL(bj)) = w; }
                }
            }
        EPI_ROWS_END
        return k == 3 || k == 4;
    }
};
struct EpiResid {
    bf16_t* H; float* ssq;
    __device__ __forceinline__ bool operator()(Acc& acc, const GU& u, int wr, int wc, int fr, int fq) const {
        EPI_ROWS_BEGIN
            float ss = 0.f;
            if (row < M_ROWS) {
#pragma unroll
                for (int bj = 0; bj < 2; ++bj) {
                    bf16_t* hp = H + (size_t)row * DM + u.pn * 256 + EPI_COL(bj);
                    float f[8]; unpack8(*(const u32x4*)hp, f);
                    const f32x4 v0 = acc[ai][bj][m][0], v1 = acc[ai][bj][m][1];
                    f[0] += v0[0]; f[1] += v0[1]; f[2] += v0[2]; f[3] += v0[3]; f[4] += v1[0]; f[5] += v1[1]; f[6] += v1[2]; f[7] += v1[3];
#pragma unroll
                    for (int e = 0; e < 8; ++e) ss += f[e] * f[e];
                    *(u32x4*)hp = pack8(f);
                }
            }
            ss += __shfl_xor(ss, 16); ss += __shfl_xor(ss, 32);
            if (fq == 0 && row < M_ROWS) ssq[(size_t)row * 16 + u.pn * 4 + wc] = ss;
        EPI_ROWS_END
        return false;
    }
};
struct EpiUp {
    const float* ssq; bf16_t* act;
    __device__ __forceinline__ bool operator()(Acc& acc, const GU& u, int wr, int wc, int fr, int fq) const {
        EPI_ROWS_BEGIN
            const float s = row_scale(ssq, row < M_ROWS ? row : 0);
#pragma unroll
            for (int bj = 0; bj < 2; ++bj) {
                const f32x4 v0 = acc[ai][bj][m][0] * s, v1 = acc[ai][bj][m][1] * s; float f[8] = {v0[0], v0[1], v0[2], v0[3], v1[0], v1[1], v1[2], v1[3]};
#pragma unroll
                for (int e = 0; e < 8; ++e) { const float r = fmaxf(f[e], 0.f); f[e] = r * r; }
                *(u32x4*)(act + (size_t)row * DFF + u.pn * 256 + EPI_COL(bj)) = pack8(f);
            }
        EPI_ROWS_END
        return false;
    }
};
struct TJob { const float* src; int ld, col0, K, N; bf16_t* dst; int dld, dk0, rmode, row0; const float* ksc; };
constexpr int N_TJOBS = 27;
__device__ __forceinline__ void get_tjob(const Ctx& c, int l, int j, TJob& t) {
    bf16_t* wb = c.wb(l);
    const float* win = c.in[I_WIN] + (size_t)l * DM * N_IN;
    t.rmode = 0; t.ksc = nullptr; t.dk0 = 0; t.col0 = 0; t.row0 = 0;
    if (j < 5) {
        t.src = win; t.ld = N_IN; t.K = DM; t.dld = DM; t.ksc = c.in[I_MIXNW] + l * DM; t.dst = wb + WB_IN;
        if (j == 0) { t.col0 = 0; t.N = 256; t.row0 = 0; }
        else if (j == 1) { t.col0 = 256; t.N = 512; t.row0 = 256; }
        else if (j == 2) { t.col0 = 768; t.N = 1024; t.row0 = 768; }
        else if (j == 3) { t.col0 = 1800; t.N = 1024; t.row0 = 1792; }
        else { t.col0 = 2824; t.N = 3072; t.row0 = 0; t.dst = wb + WB_G; }
    } else if (j == 5) { t.src = c.in[I_PA] + (size_t)l * 256 * DM; t.ld = DM; t.K = 256; t.N = DM; t.dst = wb + WB_P; t.dld = DM; t.dk0 = 0; }
    else if (j == 6) { t.src = c.in[I_PB] + (size_t)l * 512 * DM; t.ld = DM; t.K = 512; t.N = DM; t.dst = wb + WB_P; t.dld = DM; t.dk0 = 256; t.ksc = c.in[I_SSDNW] + (size_t)l * 512; }
    else if (j == 7) { t.src = c.in[I_PC] + (size_t)l * 256 * DM; t.ld = DM; t.K = 256; t.N = DM; t.dst = wb + WB_P; t.dld = DM; t.dk0 = 768; }
    else if (j == 8) { t.src = c.in[I_WOUT] + (size_t)l * DM * DM; t.ld = DM; t.K = DM; t.N = DM; t.dst = wb + WB_O; t.dld = DM; }
    else if (j == 9) { t.src = c.in[I_MLPW1] + (size_t)l * DM * DFF; t.ld = DFF; t.K = DM; t.N = DFF; t.dst = wb + WB_1; t.dld = DM; t.ksc = c.in[I_MLPNW] + l * DM; }
    else if (j == 10) { t.src = c.in[I_MLPW2] + (size_t)l * DFF * DM; t.ld = DM; t.K = DFF; t.N = DM; t.dst = wb + WB_2; t.dld = DFF; }
    else if (j == 11) { t.src = c.in[I_GLUW] + (size_t)l * 256 * 512; t.ld = 512; t.K = 256; t.N = 512; t.dst = wb + WB_GLU; t.dld = 256; t.rmode = 1; }
    else if (j < 22) {
        const int q = j - 12;
        t.K = 256; t.dst = wb + WB_L1; t.dld = 512;
        if (q < 4) { const int d = q >> 1, hf = q & 1; t.src = c.in[I_W1] + ((size_t)l * 2 + d) * 256 * 64; t.ld = 64; t.N = 64; t.row0 = d * 64; t.dk0 = hf * 256; if (hf) t.ksc = c.in[I_MUWAG] + ((size_t)l * 3 + 0) * 256; }
        else if (q < 8) { const int d = (q - 4) >> 1, hf = q & 1; t.src = c.in[I_A1] + ((size_t)l * 2 + d) * 256 * 64; t.ld = 64; t.N = 64; t.row0 = 128 + d * 64; t.dk0 = hf * 256; if (hf) t.ksc = c.in[I_MUWAG] + ((size_t)l * 3 + 1) * 256; }
        else { const int hf = q & 1; t.src = c.in[I_G1] + (size_t)l * 256 * 128; t.ld = 128; t.N = 128; t.row0 = 256; t.dk0 = hf * 256; if (hf) t.ksc = c.in[I_MUWAG] + ((size_t)l * 3 + 2) * 256; }
    } else {
        const int q = j - 22;
        t.dst = wb + WB_L2; t.dld = 256; t.ld = 256; t.N = 256;
        if (q < 2) { t.src = c.in[I_W2] + ((size_t)l * 2 + q) * 64 * 256; t.K = 64; t.row0 = q * 256; t.dk0 = q * 64; }
        else if (q < 4) { const int d = q - 2; t.src = c.in[I_A2] + ((size_t)l * 2 + d) * 64 * 256; t.K = 64; t.row0 = (2 + d) * 256; t.dk0 = d * 64; }
        else { t.src = c.in[I_G2] + (size_t)l * 128 * 256; t.K = 128; t.row0 = 4 * 256; t.dk0 = 0; }
    }
}
__device__ __forceinline__ int tjob_items(const TJob& t) { return (t.K / 64) * (t.N / 32); }
__device__ __forceinline__ void transpose_item(const TJob& t, LAS float* scr, int item, int lane) {
    const int nblk = t.N / 32, kb = item / nblk, nb = item % nblk, k0 = 64 * kb, n0 = 32 * nb;
#pragma unroll 8
    for (int i = 0; i < 32; ++i) { const int kk = 2 * i + (lane >> 5); float v = t.src[(size_t)(k0 + kk) * t.ld + t.col0 + n0 + (lane & 31)]; if (t.ksc) v *= t.ksc[k0 + kk]; scr[kk * 33 + (lane & 31)] = v; }
    asm volatile("s_waitcnt lgkmcnt(0)" ::: "memory");
    const int cc = lane & 7;
#pragma unroll
    for (int j = 0; j < 4; ++j) {
        const int n = (lane >> 3) + 8 * j; const LAS float* s = scr + (8 * cc) * 33 + n;
        u32x4 o; o.x = pk2(s[0 * 33], s[1 * 33]); o.y = pk2(s[2 * 33], s[3 * 33]); o.z = pk2(s[4 * 33], s[5 * 33]); o.w = pk2(s[6 * 33], s[7 * 33]);
        const int nn = n0 + n; int drow;
        if (t.rmode == 0) drow = t.row0 + nn; else drow = nn < 256 ? (nn >> 7) * 256 + (nn & 127) : ((nn - 256) >> 7) * 256 + 128 + ((nn - 256) & 127);
        *(u32x4*)(t.dst + (size_t)drow * t.dld + t.dk0 + k0 + 8 * cc) = o;
    }
    asm volatile("s_waitcnt lgkmcnt(0)" ::: "memory");
}

__device__ __forceinline__ void s5_build(const Ctx& cx_, int l, int g) {
    const Ctx c = relaunder(cx_);
    LAS float* F = (LAS float*)c.lds;
    LAS float* pwr = F;
    LAS float* pwi = pwr + 2176;
    LAS float* cor = pwi + 2176;
    LAS float* coi = cor + 128;
    LAS float* Cr = coi + 128;
    LAS float* Ci = Cr + 1024;
    LAS float* Br = Ci + 1024;
    LAS float* Bi = Br + 1024;
    LAS float* kr = Bi + 1024;
    LAS float* ki = kr + 1984;
    LAS float* Kd = ki + 1984;
    const int tid = c.tid;
    if (tid < 128) {
        const int d = tid >> 6, n = tid & 63; const size_t li_ = (((size_t)l * 2 + d) * 16 + g) * 64 + n;
        const float lr = c.in[I_S5LRE][li_], li = c.in[I_S5LIM][li_], step = expf(c.in[I_S5LS][((size_t)l * 2 + d) * 16 + g]);
        for (int k = 0; k <= 16; ++k) { const float mag = expf((float)k * lr * step), ang = (float)k * li * step; float sn, cs; sincosf(ang, &sn, &cs); pwr[(d * 17 + k) * 64 + n] = mag * cs; pwi[(d * 17 + k) * 64 + n] = mag * sn; }
        const float mag1 = expf(lr * step); float sn, cs; sincosf(li * step, &sn, &cs); const float abr = mag1 * cs, abi = mag1 * sn, den = lr * lr + li * li;
        cor[d * 64 + n] = ((abr - 1.f) * lr + abi * li) / den; coi[d * 64 + n] = (abi * lr - (abr - 1.f) * li) / den;
    }
    for (int i = tid; i < 1024; i += NTHREADS) {
        Cr[i] = c.in[I_S5CRE][((size_t)l * 16 + g) * 1024 + i]; Ci[i] = c.in[I_S5CIM][((size_t)l * 16 + g) * 1024 + i];
        Br[i] = c.in[I_S5BRE][((size_t)l * 16 + g) * 1024 + i]; Bi[i] = c.in[I_S5BIM][((size_t)l * 16 + g) * 1024 + i];
    }
    __syncthreads();
    for (int i = tid; i < 31 * 64; i += NTHREADS) {
        const int dd = i / 64 - 15, n = i & 63; float r, im;
        if (dd > 0) { const float pr = pwr[(0 * 17 + dd) * 64 + n], pi = pwi[(0 * 17 + dd) * 64 + n]; r = pr * cor[n] - pi * coi[n]; im = pr * coi[n] + pi * cor[n]; }
        else if (dd < 0) { const float pr = pwr[(1 * 17 - dd) * 64 + n], pi = pwi[(1 * 17 - dd) * 64 + n]; r = pr * cor[64 + n] - pi * coi[64 + n]; im = pr * coi[64 + n] + pi * cor[64 + n]; }
        else { r = cor[n] + cor[64 + n]; im = coi[n] + coi[64 + n]; }
        kr[i] = r; ki[i] = im;
    }
    __syncthreads();
    for (int i = tid; i < 31 * 256; i += NTHREADS) {
        const int ddi = i >> 8, h = (i >> 4) & 15, hp = i & 15; float a = 0.f;
        for (int n = 0; n < 64; ++n) { const float cr = Cr[h * 64 + n], ci = Ci[h * 64 + n], xr = kr[ddi * 64 + n], xi = ki[ddi * 64 + n]; const float pr = cr * xr - ci * xi, pi = cr * xi + ci * xr; a += pr * Br[n * 16 + hp] - pi * Bi[n * 16 + hp]; }
        Kd[i] = a;
    }
    __syncthreads();
    bf16_t* SX = c.wb(l) + WB_SX + (size_t)g * 256 * 256; bf16_t* SY = c.wb(l) + WB_SY + (size_t)g * 256 * 512;
    const float* dsk = c.in[I_S5D] + (size_t)l * 256 + g * 16;
    for (int u = tid; u < 256 * 64; u += NTHREADS) {
        const int o = u >> 6, kk0 = (u & 63) * 8, i = o >> 4, h = o & 15; float v[8];
        if (kk0 < 256) { const int j = kk0 >> 4, hp0 = kk0 & 15;
#pragma unroll
            for (int e = 0; e < 8; ++e) v[e] = Kd[(i - j + 15) * 256 + h * 16 + hp0 + e] + ((i == j && h == hp0 + e) ? dsk[h] : 0.f);
        } else { const int q = kk0 - 256, d = q >> 7, part = (q >> 6) & 1, n0 = q & 63, ex = d == 0 ? i + 1 : 16 - i;
#pragma unroll
            for (int e = 0; e < 8; ++e) { const int n = n0 + e; const float cr = Cr[h * 64 + n], ci = Ci[h * 64 + n], pr = pwr[(d * 17 + ex) * 64 + n], pi = pwi[(d * 17 + ex) * 64 + n]; v[e] = part == 0 ? (cr * pr - ci * pi) : -(cr * pi + ci * pr); }
        }
        *(u32x4*)(SY + (size_t)o * 512 + kk0) = pack8(v);
    }
    for (int u = tid; u < 256 * 32; u += NTHREADS) {
        const int o = u >> 5, kk0 = (u & 31) * 8, d = o >> 7, part = (o >> 6) & 1, n = o & 63, j = kk0 >> 4, hp0 = kk0 & 15, ex = d == 0 ? 15 - j : j;
        const float pr = pwr[(d * 17 + ex) * 64 + n], pi = pwi[(d * 17 + ex) * 64 + n], qr = pr * cor[d * 64 + n] - pi * coi[d * 64 + n], qi = pr * coi[d * 64 + n] + pi * cor[d * 64 + n];
        float v[8];
#pragma unroll
        for (int e = 0; e < 8; ++e) { const float br = Br[n * 16 + hp0 + e], bi = Bi[n * 16 + hp0 + e]; v[e] = part == 0 ? (qr * br - qi * bi) : (qr * bi + qi * br); }
        *(u32x4*)(SX + (size_t)o * 256 + kk0) = pack8(v);
    }
    __syncthreads();
}

__device__ __forceinline__ void phase0(const Ctx& cx_) {
    const Ctx c = relaunder(cx_);
    if (c.bid < 32) s5_build(c, c.bid >> 4, c.bid & 15);
    const int gw = c.bid * NWAVES + c.wave, NGW = c.G * NWAVES, lane = c.lane;
    bf16_t* H = c.H(); float* ssq = c.ssq();
    for (int m = gw; m < MP; m += NGW) {
        u32x2* hp = (u32x2*)(H + (size_t)m * DM);
        if (m >= M_ROWS) {
#pragma unroll
            for (int i = 0; i < 4; ++i) hp[lane + 64 * i] = (u32x2){0u, 0u};
            continue;
        }
        const int b = m / LEN, t = m - b * LEN;
        const f32x4* src = (const f32x4*)(t < NMETA ? c.in[I_META] + (size_t)t * DM : c.in[I_X] + ((size_t)b * SEQ + (t - NMETA)) * DM);
        float ss = 0.f;
#pragma unroll
        for (int i = 0; i < 4; ++i) { const f32x4 v = src[lane + 64 * i]; ss += (v.x * v.x + v.y * v.y) + (v.z * v.z + v.w * v.w); hp[lane + 64 * i] = (u32x2){pk2(v.x, v.y), pk2(v.z, v.w)}; }
        ss = wave_sum(ss);
        if (lane < 16) ssq[(size_t)m * 16 + lane] = lane == 0 ? ss : 0.f;
    }
    LAS float* scr = (LAS float*)(c.lds + c.wave * 8448);
    for (int l = 0; l < DEPTH; ++l) {
        int base = 0;
        for (int j = 0; j < N_TJOBS; ++j) {
            TJob t; get_tjob(c, l, j, t); const int ni = tjob_items(t);
            int first = (gw - base % NGW + NGW) % NGW;
            for (int it = first; it < ni; it += NGW) transpose_item(t, scr, it, lane);
            base += ni;
        }
        bf16_t* wb = c.wb(l);
        const int gt = c.bid * NTHREADS + c.tid, NGT = c.G * NTHREADS;
        for (int u = gt; u < 128 * 64; u += NGT) *(u32x4*)(wb + WB_L1 + (size_t)384 * 512 + (size_t)u * 8) = (u32x4){0u, 0u, 0u, 0u};
        for (int u = gt; u < 5 * 256 * 4 * 8; u += NGT) {
            const int sub = u & 7, blk = (u >> 3) & 3, row = (u >> 5) & 255, tile = u >> 13;
            const bool nz = (tile == 0 || tile == 2) ? (blk == 0) : ((tile == 1 || tile == 3) ? (blk == 1) : (blk < 2));
            if (!nz) *(u32x4*)(wb + WB_L2 + ((size_t)tile * 256 + row) * 256 + blk * 64 + sub * 8) = (u32x4){0u, 0u, 0u, 0u};
        }
    }
}

__device__ __forceinline__ void dt_job(const Ctx& cx_, int l) {
    const Ctx c = relaunder(cx_);
    LAS float* dtw = (LAS float*)c.lds;
    const float* win = c.in[I_WIN] + (size_t)l * DM * N_IN; const float* nw = c.in[I_MIXNW] + l * DM;
    for (int i = c.tid; i < 8 * DM; i += NTHREADS) { const int k = i >> 3, j = i & 7; dtw[j * DM + k] = nw[k] * win[(size_t)k * N_IN + 1792 + j]; }
    __syncthreads();
    const int gw = c.bid * NWAVES + c.wave, NGW = c.G * NWAVES, lane = c.lane;
    const bf16_t* H = c.H(); float* dt = (float*)(c.ws + WS_DT); float* dec = (float*)(c.ws + WS_DEC);
    const float* dtb = c.in[I_DTB] + l * 16; const float* alog = c.in[I_ALOG] + l * 16;
    for (int m = gw; m < M_ROWS; m += NGW) {
        const u32x2* hp = (const u32x2*)(H + (size_t)m * DM);
        float ss = 0.f, d8[8] = {0.f, 0.f, 0.f, 0.f, 0.f, 0.f, 0.f, 0.f};
#pragma unroll
        for (int i = 0; i < 4; ++i) {
            const u32x2 w = hp[lane + 64 * i]; const float h0 = bflo(w.x), h1 = bfhi(w.x), h2 = bflo(w.y), h3 = bfhi(w.y);
            ss += (h0 * h0 + h1 * h1) + (h2 * h2 + h3 * h3);
#pragma unroll
            for (int j = 0; j < 8; ++j) { const f32x4 wv = *(const LAS f32x4*)(dtw + j * DM + 4 * lane + 256 * i); d8[j] += (h0 * wv.x + h1 * wv.y) + (h2 * wv.z + h3 * wv.w); }
        }
        ss = wave_sum(ss);
#pragma unroll
        for (int j = 0; j < 8; ++j) d8[j] = wave_sum(d8[j]);
        const float s = __builtin_amdgcn_rsqf(ss * (1.0f / DM) + EPS);
        if (lane < 16) {
            const int j = lane & 7; float raw = d8[0];
#pragma unroll
            for (int e = 1; e < 8; ++e) raw = (j == e) ? d8[e] : raw;
            const float dtv = softplusf_(raw * s + dtb[lane]);
            dt[(size_t)m * 16 + lane] = dtv; dec[(size_t)m * 16 + lane] = -dtv * __expf(alog[lane]);
        }
    }
    __syncthreads();
}

__device__ __forceinline__ void rwkv_prep(const Ctx& cx_, int l) {
    const Ctx c = relaunder(cx_);
    const int gw = c.bid * NWAVES + c.wave, NGW = c.G * NWAVES, lane = c.lane, c0 = 4 * lane;
    const bf16_t* P = (const bf16_t*)(c.ws + WS_PRKVX); bf16_t* rk = (bf16_t*)(c.dout + DO_RKVP); bf16_t* l1 = (bf16_t*)(c.ws + WS_L1IN);
    float mu[3][4], kkw[4];
#pragma unroll
    for (int x = 0; x < 3; ++x)
#pragma unroll
        for (int e = 0; e < 4; ++e) mu[x][e] = c.in[I_MURKV][((size_t)l * 3 + x) * 256 + c0 + e];
#pragma unroll
    for (int e = 0; e < 4; ++e) kkw[e] = c.in[I_KK][(size_t)l * 256 + c0 + e];
    for (int m = gw; m < M_ROWS; m += NGW) {
        const int b = m / LEN, t = m - b * LEN; const bool hp = t > 0, hn = t < LEN - 1;
        float o[4][4];
        float xc[4], dxc[4];
#pragma unroll
        for (int x = 0; x < 4; ++x) {
            const u32x2 wc_ = *(const u32x2*)(P + (size_t)m * 1024 + x * 256 + c0);
            u32x2 wp = (u32x2){0u, 0u}, wn = (u32x2){0u, 0u};
            if (hp) wp = *(const u32x2*)(P + (size_t)(m - 1) * 1024 + x * 256 + c0);
            if (hn) wn = *(const u32x2*)(P + (size_t)(m + 1) * 1024 + x * 256 + c0);
            const float cur[4] = {bflo(wc_.x), bfhi(wc_.x), bflo(wc_.y), bfhi(wc_.y)}, pv[4] = {bflo(wp.x), bfhi(wp.x), bflo(wp.y), bfhi(wp.y)}, nv[4] = {bflo(wn.x), bfhi(wn.x), bflo(wn.y), bfhi(wn.y)};
#pragma unroll
            for (int e = 0; e < 4; ++e) { const float cs = 0.5f * (pv[e] + nv[e]) - cur[e]; if (x < 3) o[x][e] = cur[e] + cs * mu[x][e]; else { xc[e] = cur[e]; dxc[e] = cs; } }
        }
        float kr_[4], ss = 0.f;
#pragma unroll
        for (int e = 0; e < 4; ++e) { kr_[e] = o[1][e] * kkw[e]; ss += kr_[e] * kr_[e]; }
        ss = sum16(ss); const float rn = __builtin_amdgcn_rsqf(ss + 1e-12f);
        bf16_t* rp = rk + (size_t)m * 1024 + c0;
        *(u32x2*)(rp) = (u32x2){pk2(o[0][0], o[0][1]), pk2(o[0][2], o[0][3])};
        *(u32x2*)(rp + 256) = (u32x2){pk2(o[1][0], o[1][1]), pk2(o[1][2], o[1][3])};
        *(u32x2*)(rp + 512) = (u32x2){pk2(o[2][0], o[2][1]), pk2(o[2][2], o[2][3])};
        *(u32x2*)(rp + 768) = (u32x2){pk2(kr_[0] * rn, kr_[1] * rn), pk2(kr_[2] * rn, kr_[3] * rn)};
        bf16_t* lp = l1 + (size_t)m * 512 + c0;
        *(u32x2*)(lp) = (u32x2){pk2(xc[0], xc[1]), pk2(xc[2], xc[3])};
        *(u32x2*)(lp + 256) = (u32x2){pk2(dxc[0], dxc[1]), pk2(dxc[2], dxc[3])};
    }
}
__device__ __forceinline__ void ssd_prep(const Ctx& cx_, int l) {
    const Ctx c = relaunder(cx_);
    const int gw = c.bid * NWAVES + c.wave, NGW = c.G * NWAVES, lane = c.lane, c0 = 16 * lane;
    const bf16_t* P = (const bf16_t*)(c.ws + WS_PXBC); bf16_t* xs = (bf16_t*)(c.ws + WS_XS); bf16_t* bc = (bf16_t*)(c.ws + WS_BC);
    float w[5][16], bias[16];
#pragma unroll
    for (int j = 0; j < 5; ++j)
#pragma unroll
        for (int e = 0; e < 16; ++e) w[j][e] = c.in[I_CONVW][((size_t)l * 5 + j) * 1024 + c0 + e];
#pragma unroll
    for (int e = 0; e < 16; ++e) bias[e] = c.in[I_CONVB][(size_t)l * 1024 + c0 + e];
    for (int m = gw; m < M_ROWS; m += NGW) {
        const int b = m / LEN, t = m - b * LEN;
        float a[16];
#pragma unroll
        for (int e = 0; e < 16; ++e) a[e] = bias[e];
#pragma unroll
        for (int j = 0; j < 5; ++j) {
            const int tt = t + j - 2;
            if (tt >= 0 && tt < LEN) {
                const u32x4* p = (const u32x4*)(P + (size_t)(m + j - 2) * 1024 + c0); float f0[8], f1[8]; unpack8(p[0], f0); unpack8(p[1], f1);
#pragma unroll
                for (int e = 0; e < 8; ++e) { a[e] += w[j][e] * f0[e]; a[8 + e] += w[j][8 + e] * f1[e]; }
            }
        }
        float o0[8], o1[8];
#pragma unroll
        for (int e = 0; e < 8; ++e) { o0[e] = siluf_(a[e]); o1[e] = siluf_(a[8 + e]); }
        bf16_t* dst = lane < 32 ? xs + (size_t)m * 512 + c0 : bc + (size_t)m * 512 + (c0 - 512);
        ((u32x4*)dst)[0] = pack8(o0); ((u32x4*)dst)[1] = pack8(o1);
    }
}

__device__ __forceinline__ void s5_scan(const Ctx& cx_, int l) {
    const Ctx c = relaunder(cx_);
    if (c.tid >= 64) return;
    const int gt = c.bid * 64 + c.tid; if (gt >= 16384) return;
    const int n = gt & 63, d = (gt >> 6) & 1, b = (gt >> 7) & 7, g = gt >> 10;
    const size_t li_ = (((size_t)l * 2 + d) * 16 + g) * 64 + n;
    const float lr = c.in[I_S5LRE][li_], li = c.in[I_S5LIM][li_], step = expf(c.in[I_S5LS][((size_t)l * 2 + d) * 16 + g]);
    const float mag = expf(16.f * lr * step); float sn, cs; sincosf(16.f * li * step, &sn, &cs); const float ar = mag * cs, ai = mag * sn;
    const float* X = (const float*)(c.ws + WS_X) + ((size_t)g * S5RP + (size_t)b * NCH16) * 256 + d * 128 + n;
    bf16_t* U = (bf16_t*)(c.ws + WS_UH) + ((size_t)g * S5RP + (size_t)b * NCH16) * 512 + 256 + d * 128 + n;
    float hr = 0.f, hi = 0.f;
    for (int i0 = 0; i0 < NCH16; i0 += 32) {
        float xr[32], xi[32];
#pragma unroll
        for (int k = 0; k < 32; ++k) { const int i = i0 + k; const int ch = d == 0 ? i : NCH16 - 1 - i; const bool ok = i < NCH16; xr[k] = ok ? X[(size_t)ch * 256] : 0.f; xi[k] = ok ? X[(size_t)ch * 256 + 64] : 0.f; }
#pragma unroll
        for (int k = 0; k < 32; ++k) { const int i = i0 + k; if (i < NCH16) { const int ch = d == 0 ? i : NCH16 - 1 - i;
            U[(size_t)ch * 512] = (bf16_t)f2bf(hr); U[(size_t)ch * 512 + 64] = (bf16_t)f2bf(hi);
            const float nr = ar * hr - ai * hi + xr[k], ni = ar * hi + ai * hr + xi[k]; hr = nr; hi = ni; } }
    }
}
typedef short s16x4 __attribute__((ext_vector_type(4)));
__device__ __forceinline__ s16x4 lds_tr(const LAS unsigned char* p) { return __builtin_bit_cast(s16x4, __builtin_amdgcn_ds_read_tr16_b64_v4i16((LAS s16x4*)p)); }
__device__ __forceinline__ bf16x8 frag_tr(const LAS unsigned char* img, int rs, int kbase, int colbase, int lane) {
    const LAS unsigned char* a = img + (kbase + 8 * (lane >> 4) + ((lane & 15) >> 2)) * rs + (colbase + 4 * (lane & 3)) * 2;
    const s16x4 lo = lds_tr(a), hi = lds_tr(a + 4 * rs);
    return (bf16x8){lo[0], lo[1], lo[2], lo[3], hi[0], hi[1], hi[2], hi[3]};
}
__device__ __forceinline__ bf16x8 frag_row(const LAS unsigned char* img, int rs, int rowbase, int kbase, int lane) {
    return *(const LAS bf16x8*)(img + (rowbase + (lane & 15)) * rs + (kbase + 8 * (lane >> 4)) * 2);
}
constexpr int SD_RS = 272;
constexpr int SD_XRS = 144;
constexpr int SD_OFF_C = 0, SD_OFF_B = 34816, SD_OFF_X = 69632, SD_OFF_M = 88064, SD_OFF_SC = 122880;
constexpr int SD_OFF_HF = SD_OFF_B, SD_OFF_HB = SD_OFF_B + 17408;
constexpr size_t WS_STB = WS_YSSD;
constexpr size_t WS_CDEC = WS_DEC + (size_t)MP * 64 + 256;
constexpr size_t WS_SSQB = WS_CDEC + (size_t)BATCH * 33 * 16 * 4;
static_assert(WS_SSQB + (size_t)MP * 4 <= 7 * QB, "small region");
static_assert((size_t)BATCH * 2 * 8 * 32 * 8192 * 2 <= 4 * QB, "chunk states fit the yssd slot");

struct SsdUnit { int b, ck, t0, ns; };
__device__ __forceinline__ bool ssd_unit(int bid, int round, SsdUnit& u) {
    if (round == 0) { u.b = bid >> 5; u.ck = 1 + (bid & 31); u.t0 = NMETA + 128 * (u.ck - 1); u.ns = 8; return true; }
    if (round == 1 && bid < BATCH) { u.b = bid; u.ck = 0; u.t0 = 0; u.ns = 1; return true; }
    return false;
}
__device__ __forceinline__ void ssd_load_img(LAS unsigned char* img, int rs, const bf16_t* src, int ld, size_t m0, int col0, int ncol, int ns, int tid) {
    const int cpr = ncol / 8, nrow = ns == 1 ? 32 : 128;
    for (int i = tid; i < nrow * cpr; i += NTHREADS) {
        const int r = i / cpr, cc = i - r * cpr; u32x4 v = (u32x4){0u, 0u, 0u, 0u};
        if (r < 16 * ns) v = *(const u32x4*)(src + (m0 + r) * ld + col0 + cc * 8);
        *(LAS u32x4*)(img + r * rs + cc * 16) = v;
    }
}
__device__ __forceinline__ void ssd_scalars(LAS float* sc, const float* dt, const float* al, size_t m0, int head, int ns, int lane, float& totf, float& totb) {
    const int Q = 16 * ns;
    float a0f = 0.f, a1f = 0.f, a0b = 0.f, a1b = 0.f, d0f = 0.f, d1f = 0.f, d0b = 0.f, d1b = 0.f;
    const int s0 = 2 * lane, s1 = 2 * lane + 1;
    if (s0 < Q) { a0f = al[(m0 + s0) * 16 + head]; a0b = al[(m0 + s0) * 16 + 8 + head]; d0f = dt[(m0 + s0) * 16 + head]; d0b = dt[(m0 + s0) * 16 + 8 + head]; }
    if (s1 < Q) { a1f = al[(m0 + s1) * 16 + head]; a1b = al[(m0 + s1) * 16 + 8 + head]; d1f = dt[(m0 + s1) * 16 + head]; d1b = dt[(m0 + s1) * 16 + 8 + head]; }
    float pf = a0f + a1f, pb = a0b + a1b;
#pragma unroll
    for (int o = 1; o < 64; o <<= 1) { const float tf = __shfl_up(pf, o), tb = __shfl_up(pb, o); if (lane >= o) { pf += tf; pb += tb; } }
    totf = __shfl(pf, 63); totb = __shfl(pb, 63);
    const float af1 = pf, af0 = pf - a1f;
    const float eb0 = pb - a0b - a1b, eb1 = pb - a1b;
    sc[s0] = af0; sc[s1] = af1; sc[128 + s0] = eb0; sc[128 + s1] = eb1; sc[256 + s0] = d0f; sc[256 + s1] = d1f; sc[384 + s0] = d0b; sc[384 + s1] = d1b;
    sc[512 + s0] = __expf(totf - af0) * d0f; sc[512 + s1] = __expf(totf - af1) * d1f;
    sc[640 + s0] = __expf(eb0) * d0b; sc[640 + s1] = __expf(eb1) * d1b;
    sc[768 + s0] = __expf(af0); sc[768 + s1] = __expf(af1);
    sc[896 + s0] = __expf(totb - eb0); sc[896 + s1] = __expf(totb - eb1);
}

__device__ __forceinline__ void ssd_states(const Ctx& cx_, int l) {
    const Ctx c = relaunder(cx_);
    const int tid = c.tid, lane = c.lane, wave = c.wave;
    const bf16_t* bc = (const bf16_t*)(c.ws + WS_BC); const bf16_t* xs = (const bf16_t*)(c.ws + WS_XS);
    const float* dt = (const float*)(c.ws + WS_DT); const float* al = (const float*)(c.ws + WS_DEC);
    bf16_t* stb = (bf16_t*)(c.ws + WS_STB); float* cdec = (float*)(c.ws + WS_CDEC);
    LAS unsigned char* Bimg = c.lds + SD_OFF_B; LAS unsigned char* Ximg = c.lds + SD_OFF_X; LAS float* sc = (LAS float*)(c.lds + SD_OFF_SC);
    for (int round = 0; round < 2; ++round) {
        SsdUnit u; if (!ssd_unit(c.bid, round, u)) break;
        const size_t m0 = (size_t)u.b * LEN + u.t0; const int nks = u.ns == 1 ? 1 : 4;
        for (int g = 0; g < 2; ++g) {
            __syncthreads();
            ssd_load_img(Bimg, SD_RS, bc, 512, m0, g * 128, 128, u.ns, tid);
            for (int j = 0; j < 4; ++j) {
                const int head = g * 4 + j;
                if (j) __syncthreads();
                ssd_load_img(Ximg, SD_XRS, xs, 512, m0, head * 64, 64, u.ns, tid);
                if (wave == 0) { float totf, totb; ssd_scalars(sc, dt, al, m0, head, u.ns, lane, totf, totb);
                    if (lane == 0) { cdec[((size_t)u.b * 33 + u.ck) * 16 + head] = __expf(totf); cdec[((size_t)u.b * 33 + u.ck) * 16 + 8 + head] = __expf(totb); } }
                __syncthreads();
                f32x4 accf[4], accb[4];
#pragma unroll
                for (int pt = 0; pt < 4; ++pt) { accf[pt] = (f32x4){0.f, 0.f, 0.f, 0.f}; accb[pt] = accf[pt]; }
                for (int ks = 0; ks < nks; ++ks) {
                    const bf16x8 af = frag_tr(Bimg, SD_RS, 32 * ks, 16 * wave, lane);
                    const int k0 = 32 * ks + 8 * (lane >> 4);
                    const f32x4 wf0 = *(const LAS f32x4*)(sc + 512 + k0), wf1 = *(const LAS f32x4*)(sc + 512 + k0 + 4), wb0 = *(const LAS f32x4*)(sc + 640 + k0), wb1 = *(const LAS f32x4*)(sc + 640 + k0 + 4);
#pragma unroll
                    for (int pt = 0; pt < 4; ++pt) {
                        const bf16x8 xr = frag_tr(Ximg, SD_XRS, 32 * ks, 16 * pt, lane);
                        float xf[8];
#pragma unroll
                        for (int e = 0; e < 8; ++e) xf[e] = bf1((bf16_t)xr[e]);
                        bf16x8 bfv, bbv;
                        { const unsigned p0 = pk2(xf[0] * wf0.x, xf[1] * wf0.y), p1 = pk2(xf[2] * wf0.z, xf[3] * wf0.w), p2 = pk2(xf[4] * wf1.x, xf[5] * wf1.y), p3 = pk2(xf[6] * wf1.z, xf[7] * wf1.w);
                          bfv = __builtin_bit_cast(bf16x8, (u32x4){p0, p1, p2, p3}); }
                        { const unsigned p0 = pk2(xf[0] * wb0.x, xf[1] * wb0.y), p1 = pk2(xf[2] * wb0.z, xf[3] * wb0.w), p2 = pk2(xf[4] * wb1.x, xf[5] * wb1.y), p3 = pk2(xf[6] * wb1.z, xf[7] * wb1.w);
                          bbv = __builtin_bit_cast(bf16x8, (u32x4){p0, p1, p2, p3}); }
                        accf[pt] = __builtin_amdgcn_mfma_f32_16x16x32_bf16(af, bfv, accf[pt], 0, 0, 0);
                        accb[pt] = __builtin_amdgcn_mfma_f32_16x16x32_bf16(af, bbv, accb[pt], 0, 0, 0);
                    }
                }
#pragma unroll
                for (int pt = 0; pt < 4; ++pt) {
                    const int p = 16 * pt + (lane & 15), n0 = 16 * wave + 4 * (lane >> 4);
                    if (u.ck <= 31) { bf16_t* d = stb + ((((size_t)u.b * 2 + 0) * 8 + head) * 32 + u.ck) * 8192 + (size_t)p * 128 + n0; *(u32x2*)d = (u32x2){pk2(accf[pt][0], accf[pt][1]), pk2(accf[pt][2], accf[pt][3])}; }
                    if (u.ck >= 1) { bf16_t* d = stb + ((((size_t)u.b * 2 + 1) * 8 + head) * 32 + (u.ck - 1)) * 8192 + (size_t)p * 128 + n0; *(u32x2*)d = (u32x2){pk2(accb[pt][0], accb[pt][1]), pk2(accb[pt][2], accb[pt][3])}; }
                }
            }
        }
    }
    __syncthreads();
}

__device__ __forceinline__ void ssd_chunk_scan(const Ctx& cx_, int l) {
    const Ctx c = relaunder(cx_);
    bf16_t* stb = (bf16_t*)(c.ws + WS_STB); const float* cdec = (const float*)(c.ws + WS_CDEC);
    const int gt = c.bid * NTHREADS + c.tid;
    const int e8 = gt & 1023, bdh = gt >> 10;
    if (bdh >= BATCH * 16) return;
    const int head = bdh & 7, dir = (bdh >> 3) & 1, b = bdh >> 4;
    bf16_t* base = stb + (size_t)bdh * 32 * 8192 + (size_t)e8 * 8;
    float h[8] = {0.f, 0.f, 0.f, 0.f, 0.f, 0.f, 0.f, 0.f};
    for (int i0 = 0; i0 < 32; i0 += 8) {
        u32x4 v[8]; float dcy[8];
#pragma unroll
        for (int k = 0; k < 8; ++k) { const int slot = dir == 0 ? i0 + k : 31 - (i0 + k); v[k] = *(const u32x4*)(base + (size_t)slot * 8192);
            const int ck = dir == 0 ? slot : slot + 1; dcy[k] = cdec[((size_t)b * 33 + ck) * 16 + dir * 8 + head]; }
#pragma unroll
        for (int k = 0; k < 8; ++k) { const int slot = dir == 0 ? i0 + k : 31 - (i0 + k); float s[8]; unpack8(v[k], s);
#pragma unroll
            for (int e = 0; e < 8; ++e) h[e] = h[e] * dcy[k] + s[e];
            *(u32x4*)(base + (size_t)slot * 8192) = pack8(h); }
    }
}

__device__ __forceinline__ void ssd_outputs(const Ctx& cx_, int l) {
    const Ctx c = relaunder(cx_);
    const int tid = c.tid, lane = c.lane, wave = c.wave;
    const bf16_t* bc = (const bf16_t*)(c.ws + WS_BC); const bf16_t* xs = (const bf16_t*)(c.ws + WS_XS); const bf16_t* pz = (const bf16_t*)(c.ws + WS_PZ);
    const float* dt = (const float*)(c.ws + WS_DT); const float* al = (const float*)(c.ws + WS_DEC);
    const bf16_t* stb = (const bf16_t*)(c.ws + WS_STB); bf16_t* yb = (bf16_t*)(c.ws + WS_YB); float* ssqb = (float*)(c.ws + WS_SSQB);
    LAS unsigned char* Cimg = c.lds + SD_OFF_C; LAS unsigned char* Bimg = c.lds + SD_OFF_B; LAS unsigned char* Ximg = c.lds + SD_OFF_X;
    LAS unsigned char* HfT = c.lds + SD_OFF_HF; LAS unsigned char* HbT = c.lds + SD_OFF_HB;
    LAS unsigned char* Ms = c.lds + SD_OFF_M + wave * 4352; LAS float* sc = (LAS float*)(c.lds + SD_OFF_SC);
    for (int round = 0; round < 2; ++round) {
        SsdUnit u; if (!ssd_unit(c.bid, round, u)) break;
        const size_t m0 = (size_t)u.b * LEN + u.t0; const int nks = u.ns == 1 ? 1 : 4; const bool active = wave < u.ns;
        float ssrow = 0.f;
        for (int g = 0; g < 2; ++g) {
            __syncthreads();
            ssd_load_img(Cimg, SD_RS, bc, 512, m0, 256 + g * 128, 128, u.ns, tid);
            ssd_load_img(Bimg, SD_RS, bc, 512, m0, g * 128, 128, u.ns, tid);
            __syncthreads();
            f32x4 cb[8];
#pragma unroll
            for (int t = 0; t < 8; ++t) cb[t] = (f32x4){0.f, 0.f, 0.f, 0.f};
            if (active) {
#pragma unroll
                for (int ks = 0; ks < 4; ++ks) {
                    const bf16x8 cfr = frag_row(Cimg, SD_RS, 16 * wave, 32 * ks, lane);
#pragma unroll
                    for (int t = 0; t < 8; ++t) if (t < u.ns) cb[t] = __builtin_amdgcn_mfma_f32_16x16x32_bf16(frag_row(Bimg, SD_RS, 16 * t, 32 * ks, lane), cfr, cb[t], 0, 0, 0);
                }
            }
            for (int j = 0; j < 4; ++j) {
                const int head = g * 4 + j;
                __syncthreads();
                ssd_load_img(Ximg, SD_XRS, xs, 512, m0, head * 64, 64, u.ns, tid);
                {
                    const bf16_t* hf = u.ck >= 1 ? stb + ((((size_t)u.b * 2 + 0) * 8 + head) * 32 + (u.ck - 1)) * 8192 : nullptr;
                    const bf16_t* hb = u.ck <= 31 ? stb + ((((size_t)u.b * 2 + 1) * 8 + head) * 32 + u.ck) * 8192 : nullptr;
                    for (int i = tid; i < 64 * 16; i += NTHREADS) { const int p = i >> 4, cc = i & 15;
                        *(LAS u32x4*)(HfT + p * SD_RS + cc * 16) = hf ? *(const u32x4*)(hf + p * 128 + cc * 8) : (u32x4){0u, 0u, 0u, 0u};
                        *(LAS u32x4*)(HbT + p * SD_RS + cc * 16) = hb ? *(const u32x4*)(hb + p * 128 + cc * 8) : (u32x4){0u, 0u, 0u, 0u}; }
                }
                if (wave == 0) { float totf, totb; ssd_scalars(sc, dt, al, m0, head, u.ns, lane, totf, totb); }
                __syncthreads();
                if (active) {
                    const int ll = 16 * wave + (lane & 15); const float afl = sc[ll], ebl = sc[128 + ll];
#pragma unroll
                    for (int t = 0; t < 8; ++t) {
                        u32x2 w2 = (u32x2){0u, 0u};
                        if (t < u.ns) {
                            const int s0 = 16 * t + 4 * (lane >> 4);
                            const f32x4 afs = *(const LAS f32x4*)(sc + s0), ebs = *(const LAS f32x4*)(sc + 128 + s0), dfs = *(const LAS f32x4*)(sc + 256 + s0), dbs = *(const LAS f32x4*)(sc + 384 + s0);
                            float mv[4];
#pragma unroll
                            for (int r = 0; r < 4; ++r) { const int s = s0 + r; float wgt = 0.f; if (s <= ll) wgt += __expf(afl - afs[r]) * dfs[r]; if (s >= ll) wgt += __expf(ebs[r] - ebl) * dbs[r]; mv[r] = cb[t][r] * wgt; }
                            w2 = (u32x2){pk2(mv[0], mv[1]), pk2(mv[2], mv[3])};
                        }
                        if (t < 2 * nks) *(LAS u32x2*)(Ms + (lane & 15) * SD_RS + (16 * t + 4 * (lane >> 4)) * 2) = w2;
                    }
                    f32x4 ay[4], ahf[4], ahb[4];
#pragma unroll
                    for (int pt = 0; pt < 4; ++pt) { ay[pt] = (f32x4){0.f, 0.f, 0.f, 0.f}; ahf[pt] = ay[pt]; ahb[pt] = ay[pt]; }
                    for (int ks = 0; ks < nks; ++ks) {
                        const bf16x8 mf = frag_row(Ms, SD_RS, 0, 32 * ks, lane);
#pragma unroll
                        for (int pt = 0; pt < 4; ++pt) ay[pt] = __builtin_amdgcn_mfma_f32_16x16x32_bf16(mf, frag_tr(Ximg, SD_XRS, 32 * ks, 16 * pt, lane), ay[pt], 0, 0, 0);
                    }
#pragma unroll
                    for (int ks = 0; ks < 4; ++ks) {
                        const bf16x8 cfr = frag_row(Cimg, SD_RS, 16 * wave, 32 * ks, lane);
#pragma unroll
                        for (int pt = 0; pt < 4; ++pt) {
                            ahf[pt] = __builtin_amdgcn_mfma_f32_16x16x32_bf16(cfr, frag_row(HfT, SD_RS, 16 * pt, 32 * ks, lane), ahf[pt], 0, 0, 0);
                            ahb[pt] = __builtin_amdgcn_mfma_f32_16x16x32_bf16(cfr, frag_row(HbT, SD_RS, 16 * pt, 32 * ks, lane), ahb[pt], 0, 0, 0);
                        }
                    }
                    const int l0 = 16 * wave + 4 * (lane >> 4);
                    const f32x4 efv = *(const LAS f32x4*)(sc + 768 + l0), ebv = *(const LAS f32x4*)(sc + 896 + l0);
                    LAS float* ys = (LAS float*)Ms;
#pragma unroll
                    for (int pt = 0; pt < 4; ++pt)
#pragma unroll
                        for (int r = 0; r < 4; ++r) ys[(4 * (lane >> 4) + r) * 68 + 16 * pt + (lane & 15)] = ay[pt][r] + efv[r] * ahf[pt][r] + ebv[r] * ahb[pt][r];
                    const int rr = lane >> 2, p0 = 16 * (lane & 3); const size_t m = m0 + 16 * wave + rr;
                    const float dsk = c.in[I_SSDD][l * 8 + head];
                    float xv[16], zv[16];
                    { float t8[8]; unpack8(*(const LAS u32x4*)(Ximg + (16 * wave + rr) * SD_XRS + p0 * 2), t8);
#pragma unroll
                      for (int e = 0; e < 8; ++e) xv[e] = t8[e];
                      unpack8(*(const LAS u32x4*)(Ximg + (16 * wave + rr) * SD_XRS + p0 * 2 + 16), t8);
#pragma unroll
                      for (int e = 0; e < 8; ++e) xv[8 + e] = t8[e];
                      unpack8(*(const u32x4*)(pz + m * 512 + head * 64 + p0), t8);
#pragma unroll
                      for (int e = 0; e < 8; ++e) zv[e] = t8[e];
                      unpack8(*(const u32x4*)(pz + m * 512 + head * 64 + p0 + 8), t8);
#pragma unroll
                      for (int e = 0; e < 8; ++e) zv[8 + e] = t8[e]; }
                    float o[16];
#pragma unroll
                    for (int e4 = 0; e4 < 4; ++e4) { const f32x4 yv = *(const LAS f32x4*)(ys + rr * 68 + p0 + 4 * e4);
#pragma unroll
                        for (int e = 0; e < 4; ++e) { const float val = (yv[e] + dsk * xv[4 * e4 + e]) * siluf_(zv[4 * e4 + e]); o[4 * e4 + e] = val; ssrow += val * val; } }
                    u32x4 w0, w1; w0.x = pk2(o[0], o[1]); w0.y = pk2(o[2], o[3]); w0.z = pk2(o[4], o[5]); w0.w = pk2(o[6], o[7]); w1.x = pk2(o[8], o[9]); w1.y = pk2(o[10], o[11]); w1.z = pk2(o[12], o[13]); w1.w = pk2(o[14], o[15]);
                    *(u32x4*)(yb + m * 512 + head * 64 + p0) = w0; *(u32x4*)(yb + m * 512 + head * 64 + p0 + 8) = w1;
                }
            }
        }
        if (active) { ssrow += dpp_mov<0xB1>(ssrow); ssrow += dpp_mov<0x4E>(ssrow); if ((lane & 3) == 0) ssqb[m0 + 16 * wave + (lane >> 2)] = ssrow; }
    }
    __syncthreads();
}
constexpr int RW_T = 32, RW_NC = (LEN + RW_T - 1) / RW_T, RW_BUF = 45056;
__device__ __forceinline__ void rwkv_scan(const Ctx& cx_, int l) {
    const Ctx c = relaunder(cx_);
    const int bid = c.bid, q = bid & 3, dir = (bid >> 2) & 1, head = (bid >> 3) & 3, b = bid >> 5;
    const int tid = c.tid, lane = c.lane, wave = c.wave;
    const bf16_t* rk = (const bf16_t*)(c.dout + DO_RKVP); const bf16_t* l2 = (const bf16_t*)(c.ws + WS_L2O);
    bf16_t* yo = (bf16_t*)(c.ws + WS_YRW) + (size_t)dir * MP * 256;
    const bool producer = wave >= 4;
    const int pt = tid - 256, pstep = pt >> 3, pc0 = (pt & 7) * 8, pv0 = 2 * (pt & 7);
    float ka[8];
    u32x4 R, K, KK, DL, AS; unsigned V2 = 0; R = K = KK = DL = AS = (u32x4){0u, 0u, 0u, 0u};
    if (producer) {
#pragma unroll
        for (int e = 0; e < 8; ++e) ka[e] = c.in[I_KA][(size_t)l * 256 + head * 64 + pc0 + e];
    }
    auto tok = [&](int s) -> size_t { const int t = dir ? LEN - 1 - s : s; return (size_t)b * LEN + t; };
#define RW_LOAD(chunk) do { const int s_ = (chunk) * RW_T + pstep; if (s_ < LEN) { const size_t m_ = tok(s_); const bf16_t* rp_ = rk + m_ * 1024 + head * 64; const bf16_t* lp_ = l2 + m_ * 1280 + dir * 256 + head * 64; \
        R = *(const u32x4*)(rp_ + pc0); K = *(const u32x4*)(rp_ + 256 + pc0); KK = *(const u32x4*)(rp_ + 768 + pc0); V2 = *(const unsigned*)(rp_ + 512 + 16 * q + pv0); \
        DL = *(const u32x4*)(lp_ + pc0); AS = *(const u32x4*)(lp_ + 512 + pc0); } } while (0)
#define RW_WRITE(buf) do { LAS float* vec_ = (LAS float*)(c.lds + (buf) * RW_BUF); float r_[8], k_[8], kk_[8], dl_[8], as_[8]; unpack8(R, r_); unpack8(K, k_); unpack8(KK, kk_); unpack8(DL, dl_); unpack8(AS, as_); \
        float w_[8], a_[8], b_[8], kd_[8]; _Pragma("unroll") for (int e = 0; e < 8; ++e) { w_[e] = __expf(dl_[e]); a_[e] = -kk_[e]; b_[e] = kk_[e] * as_[e]; kd_[e] = k_[e] * (1.f + (as_[e] - 1.f) * ka[e]); } \
        LAS float* bp_ = vec_ + pstep * 320 + pc0; \
        *(LAS f32x4*)(bp_) = (f32x4){w_[0], w_[1], w_[2], w_[3]}; *(LAS f32x4*)(bp_ + 4) = (f32x4){w_[4], w_[5], w_[6], w_[7]}; \
        *(LAS f32x4*)(bp_ + 64) = (f32x4){a_[0], a_[1], a_[2], a_[3]}; *(LAS f32x4*)(bp_ + 68) = (f32x4){a_[4], a_[5], a_[6], a_[7]}; \
        *(LAS f32x4*)(bp_ + 128) = (f32x4){b_[0], b_[1], b_[2], b_[3]}; *(LAS f32x4*)(bp_ + 132) = (f32x4){b_[4], b_[5], b_[6], b_[7]}; \
        *(LAS f32x4*)(bp_ + 192) = (f32x4){kd_[0], kd_[1], kd_[2], kd_[3]}; *(LAS f32x4*)(bp_ + 196) = (f32x4){kd_[4], kd_[5], kd_[6], kd_[7]}; \
        *(LAS f32x4*)(bp_ + 256) = (f32x4){r_[0], r_[1], r_[2], r_[3]}; *(LAS f32x4*)(bp_ + 260) = (f32x4){r_[4], r_[5], r_[6], r_[7]}; \
        LAS float* vr_ = vec_ + 10240 + pstep * 16 + pv0; vr_[0] = bflo(V2); vr_[1] = bfhi(V2); } while (0)
#define RW_FLUSH(chunk) do { const int s_ = (chunk) * RW_T + pstep; if (s_ < LEN) { const LAS float* yy_ = (const LAS float*)(c.lds + ((chunk) & 1) * RW_BUF) + 10752 + pstep * 16 + pv0; \
        *(unsigned*)(yo + tok(s_) * 256 + head * 64 + 16 * q + pv0) = pk2(yy_[0], yy_[1]); } } while (0)
    if (producer) { RW_LOAD(0); RW_WRITE(0); RW_LOAD(1); }
    __syncthreads();
    const int rowl = (wave & 3) * 4 + (lane >> 4), j4 = (lane & 15) * 4;
    float S0 = 0.f, S1 = 0.f, S2 = 0.f, S3 = 0.f;
#define RW_SCAN(NS) do { float yv_[NS]; \
        _Pragma("unroll") for (int st = 0; st < NS; ++st) { \
            const LAS float* bp = vec + st * 320 + j4; \
            const f32x4 w = *(const LAS f32x4*)(bp), a = *(const LAS f32x4*)(bp + 64), bb = *(const LAS f32x4*)(bp + 128), kd = *(const LAS f32x4*)(bp + 192), r = *(const LAS f32x4*)(bp + 256); \
            const float v = vec[10240 + st * 16 + rowl]; \
            float sa = (S0 * a.x + S1 * a.y) + (S2 * a.z + S3 * a.w); \
            sa = allred16(sa); \
            S0 = S0 * w.x + v * kd.x; S1 = S1 * w.y + v * kd.y; S2 = S2 * w.z + v * kd.z; S3 = S3 * w.w + v * kd.w; \
            S0 += sa * bb.x; S1 += sa * bb.y; S2 += sa * bb.z; S3 += sa * bb.w; \
            float y = (S0 * r.x + S1 * r.y) + (S2 * r.z + S3 * r.w); \
            yv_[st] = allred16(y); } \
        if ((lane & 15) == 0) { _Pragma("unroll") for (int st = 0; st < NS; ++st) yy[st * 16 + rowl] = yv_[st]; } } while (0)
    for (int ch = 0; ch < RW_NC; ++ch) {
        if (!producer) {
            const LAS float* vec = (const LAS float*)(c.lds + (ch & 1) * RW_BUF);
            LAS float* yy = (LAS float*)(c.lds + (ch & 1) * RW_BUF) + 10752;
            if (ch < RW_NC - 1) RW_SCAN(32); else RW_SCAN(LEN - (RW_NC - 1) * RW_T);
        } else {
            if (ch + 1 < RW_NC) RW_WRITE((ch + 1) & 1);
            if (ch + 2 < RW_NC) RW_LOAD(ch + 2);
            if (ch >= 1) RW_FLUSH(ch - 1);
        }
        __syncthreads();
    }
#undef RW_SCAN
    if (producer) RW_FLUSH(RW_NC - 1);
    __syncthreads();
#undef RW_LOAD
#undef RW_WRITE
#undef RW_FLUSH
}

__device__ __forceinline__ void rwkv_post(const Ctx& cx_, int l) {
    const Ctx c = relaunder(cx_);
    const int gw = c.bid * NWAVES + c.wave, NGW = c.G * NWAVES, lane = c.lane, c0 = 4 * lane;
    const bf16_t* y0 = (const bf16_t*)(c.ws + WS_YRW); const bf16_t* y1 = y0 + (size_t)MP * 256;
    const bf16_t* rk = (const bf16_t*)(c.dout + DO_RKVP); const bf16_t* l2 = (const bf16_t*)(c.ws + WS_L2O); bf16_t* yc = (bf16_t*)(c.ws + WS_YC);
    float lw[4], lb[4], rkw[4];
#pragma unroll
    for (int e = 0; e < 4; ++e) { lw[e] = c.in[I_LNW][(size_t)l * 256 + c0 + e]; lb[e] = c.in[I_LNB][(size_t)l * 256 + c0 + e]; rkw[e] = c.in[I_RK][(size_t)l * 256 + c0 + e]; }
    for (int m = gw; m < M_ROWS; m += NGW) {
        const u32x2 a = *(const u32x2*)(y0 + (size_t)m * 256 + c0), bq = *(const u32x2*)(y1 + (size_t)m * 256 + c0);
        const u32x2 rr = *(const u32x2*)(rk + (size_t)m * 1024 + c0), kk = *(const u32x2*)(rk + (size_t)m * 1024 + 256 + c0), vv = *(const u32x2*)(rk + (size_t)m * 1024 + 512 + c0);
        const u32x2 gg = *(const u32x2*)(l2 + (size_t)m * 1280 + 1024 + c0);
        float y[4] = {bflo(a.x) + bflo(bq.x), bfhi(a.x) + bfhi(bq.x), bflo(a.y) + bflo(bq.y), bfhi(a.y) + bfhi(bq.y)};
        const float r[4] = {bflo(rr.x), bfhi(rr.x), bflo(rr.y), bfhi(rr.y)}, k[4] = {bflo(kk.x), bfhi(kk.x), bflo(kk.y), bfhi(kk.y)};
        const float v[4] = {bflo(vv.x), bfhi(vv.x), bflo(vv.y), bfhi(vv.y)}, g[4] = {bflo(gg.x), bfhi(gg.x), bflo(gg.y), bfhi(gg.y)};
        const float mean = sum16((y[0] + y[1]) + (y[2] + y[3])) * (1.f / 64.f);
        float q = 0.f, bo = 0.f;
#pragma unroll
        for (int e = 0; e < 4; ++e) { y[e] -= mean; q += y[e] * y[e]; bo += r[e] * k[e] * rkw[e]; }
        q = sum16(q) * (1.f / 64.f); bo = sum16(bo);
        const float rs = __builtin_amdgcn_rsqf(q + 64e-5f);
        float o[4];
#pragma unroll
        for (int e = 0; e < 4; ++e) o[e] = (y[e] * rs * lw[e] + lb[e] + bo * v[e]) * g[e];
        *(u32x2*)(yc + (size_t)m * 256 + c0) = (u32x2){pk2(o[0], o[1]), pk2(o[2], o[3])};
    }
}
__device__ __forceinline__ void final_phase(const Ctx& cx_, float* out) {
    const Ctx c = relaunder(cx_);
    const int gw = c.bid * NWAVES + c.wave, NGW = c.G * NWAVES, lane = c.lane;
    const bf16_t* H = c.H(); const f32x4* fw = (const f32x4*)c.in[I_FNW];
    for (int r = gw; r < BATCH * SEQ; r += NGW) {
        const int b = r / SEQ, tq = r - b * SEQ; const size_t m = (size_t)b * LEN + NMETA + tq;
        const u32x2* hp = (const u32x2*)(H + m * DM);
        float v[4][4], ss = 0.f;
#pragma unroll
        for (int i = 0; i < 4; ++i) { const u32x2 w = hp[lane + 64 * i]; v[i][0] = bflo(w.x); v[i][1] = bfhi(w.x); v[i][2] = bflo(w.y); v[i][3] = bfhi(w.y); ss += (v[i][0] * v[i][0] + v[i][1] * v[i][1]) + (v[i][2] * v[i][2] + v[i][3] * v[i][3]); }
        ss = wave_sum(ss); const float s = __builtin_amdgcn_rsqf(ss * (1.0f / DM) + EPS);
        f32x4* op = (f32x4*)(out + (size_t)r * DM);
#pragma unroll
        for (int i = 0; i < 4; ++i) { const f32x4 w = fw[lane + 64 * i]; op[lane + 64 * i] = (f32x4){v[i][0] * s * w.x, v[i][1] * s * w.y, v[i][2] * s * w.z, v[i][3] * s * w.w}; }
    }
}

constexpr int LDS_BYTES = 147456;
#ifndef PHMASK
#define PHMASK 0xFFFFF
#endif
__global__ void __launch_bounds__(NTHREADS, 2) mega_fwd(Params p) {
    extern __shared__ __attribute__((aligned(16))) unsigned char lds_raw[];
    cg::grid_group grid = cg::this_grid();
    Ctx c; c.in = p.in; c.ws = p.ws; c.dout = (unsigned char*)p.out; c.lds = (LAS unsigned char*)lds_raw;
    c.tid = threadIdx.x; c.lane = c.tid & 63; c.wave = __builtin_amdgcn_readfirstlane(c.tid >> 6); c.G = gridDim.x; c.bid = blockIdx.x;
    const int G = c.G, bid = c.bid;
#ifdef PROF_A
#ifndef PROF_SHIFT
#define PROF_SHIFT 1.0f
#endif
    unsigned long long* prof = (unsigned long long*)(c.ws + WS_DEC + (size_t)MP * 64);
    unsigned long long t_prev = 0;
    const bool stamper = (blockIdx.x == 0 && threadIdx.x == 0);
    if (stamper) { for (int k = 0; k < 16; ++k) prof[k] = 0; t_prev = __builtin_amdgcn_s_memrealtime(); }
#define STAMP(k) do { if (stamper) { const unsigned long long t_ = __builtin_amdgcn_s_memrealtime(); prof[k] += t_ - t_prev; t_prev = t_; } } while (0)
#else
#define STAMP(k) do { } while (0)
#endif
    if (PHMASK & 1) phase0(c);
    grid.sync(); STAMP(0);
#pragma unroll 1
    for (int l = 0; l < DEPTH; ++l) {
        bf16_t* wb = c.wb(l);
        if (PHMASK & 2) dt_job(c, l);
        if (PHMASK & 4) { SchedPlain S{c.H(), wb + WB_IN, DM, DM, DM, MP / 256, 11, G, bid};
          EpiInProj E{c.ssq(), (bf16_t*)(c.ws + WS_UH), (bf16_t*)(c.ws + WS_PZ), (bf16_t*)(c.ws + WS_PXBC), (bf16_t*)(c.ws + WS_PRKVX)};
          pg8::gemm_phase(c.lds, S, E); }
        grid.sync(); STAMP(1);
        if (PHMASK & 8) { SchedS5 S{(const bf16_t*)(c.ws + WS_UH), wb + WB_SX, 256, G, bid}; EpiS5X E{(float*)(c.ws + WS_X)}; pg8::gemm_phase(c.lds, S, E); }
        if (PHMASK & 16) rwkv_prep(c, l);
        if (PHMASK & 32) ssd_prep(c, l);
        grid.sync(); STAMP(2);
        if (PHMASK & 64) s5_scan(c, l);
        if (PHMASK & 4096) ssd_states(c, l);
        if (PHMASK & 128) { SchedPlain S{(const bf16_t*)(c.ws + WS_L1IN), wb + WB_L1, 512, 512, 512, MP / 256, 2, G, bid}; EpiL1 E{(bf16_t*)(c.ws + WS_L1O)}; pg8::gemm_phase(c.lds, S, E); }
        grid.sync(); STAMP(3);
        ssd_chunk_scan(c, l);
        if (PHMASK & 256) { SchedL2 S{(const bf16_t*)(c.ws + WS_L1O), wb + WB_L2, G, bid}; EpiL2 E{(bf16_t*)(c.ws + WS_L2O), c.in[I_W0] + (size_t)l * 512, c.in[I_A0] + (size_t)l * 512}; pg8::gemm_phase(c.lds, S, E); }
        if (PHMASK & 512) { SchedS5 S{(const bf16_t*)(c.ws + WS_UH), wb + WB_SY, 512, G, bid}; EpiS5Y E{(bf16_t*)(c.ws + WS_YAPRE)}; pg8::gemm_phase(c.lds, S, E); }
        grid.sync(); STAMP(4);
        if (PHMASK & 1024) rwkv_scan(c, l);
        STAMP(5);
        if (PHMASK & 2048) ssd_outputs(c, l);
        grid.sync(); STAMP(6);
        if (PHMASK & 8192) rwkv_post(c, l);
        if (PHMASK & 16384) { SchedPlain S{(const bf16_t*)(c.ws + WS_YAPRE), wb + WB_GLU, 256, 256, 256, MP / 256, 2, G, bid}; EpiGLU E{(bf16_t*)(c.ws + WS_YA), c.in[I_GLUB] + (size_t)l * 512}; pg8::gemm_phase(c.lds, S, E); }
        grid.sync(); STAMP(7);
        if (PHMASK & 32768) { SchedProj S{c.H(), wb + WB_G, wb + WB_P, (const bf16_t*)(c.ws + WS_YA), (const bf16_t*)(c.ws + WS_YB), (const bf16_t*)(c.ws + WS_YC), G, bid};
          EpiProj E{c.ssq(), (const float*)(c.ws + WS_SSQB), c.ws + WS_PARK + (size_t)bid * 393216, (bf16_t*)(c.dout + DO_MERGED), opaque_tid()}; pg8::gemm_phase(c.lds, S, E); }
        grid.sync(); STAMP(8);
        if (PHMASK & 65536) { SchedPlain S{(const bf16_t*)(c.dout + DO_MERGED), wb + WB_O, DM, DM, DM, MP / 256, 4, G, bid}; EpiResid E{c.H(), c.ssq()}; pg8::gemm_phase(c.lds, S, E); }
        grid.sync(); STAMP(9);
        if (PHMASK & 131072) { SchedPlain S{c.H(), wb + WB_1, DM, DM, DM, MP / 256, 16, G, bid}; EpiUp E{c.ssq(), (bf16_t*)(c.ws + WS_ACT)}; pg8::gemm_phase(c.lds, S, E); }
        grid.sync(); STAMP(10);
        if (PHMASK & 262144) { SchedPlain S{(const bf16_t*)(c.ws + WS_ACT), wb + WB_2, DFF, DFF, DFF, MP / 256, 4, G, bid}; EpiResid E{c.H(), c.ssq()}; pg8::gemm_phase(c.lds, S, E); }
        grid.sync(); STAMP(11);
    }
    if (PHMASK & 524288) final_phase(c, p.out);
#ifdef PROF_A
    grid.sync(); STAMP(12);
    if (blockIdx.x == 0) {
        __syncthreads();
        float va = (float)(__hip_atomic_load(&prof[PROF_A], __ATOMIC_RELAXED, __HIP_MEMORY_SCOPE_AGENT)) * 0.01f, vb = (float)(__hip_atomic_load(&prof[PROF_B], __ATOMIC_RELAXED, __HIP_MEMORY_SCOPE_AGENT)) * 0.01f;
        va = exp2f(rintf(log2f(va * PROF_SHIFT) * 3.f) * (1.f / 3.f)); vb = exp2f(rintf(log2f(vb * PROF_SHIFT) * 3.f) * (1.f / 3.f));
        for (int i = threadIdx.x; i < (1 << 20); i += NTHREADS) p.out[1 + i] = vb;
        if (threadIdx.x == 0) p.out[0] = 100.f * va;
    }
#endif
}

extern "C" void kernel_launch(void* const* d_in, const int* in_sizes, int n_in, void* d_out, int out_size, void* d_ws, size_t ws_size, hipStream_t stream) {
    static int grid = 0;
    if (grid == 0) {
        int dev = 0, cus = 0, per_cu = 0;
        if (n_in != N_INPUTS || out_size != BATCH * SEQ * DM || ws_size < WS_END) { fprintf(stderr, "kernel_launch: unexpected shapes (n_in %d out %d ws %zu)\n", n_in, out_size, ws_size); grid = -1; return; }
        (void)hipGetDevice(&dev); (void)hipDeviceGetAttribute(&cus, hipDeviceAttributeMultiprocessorCount, dev);
        (void)hipFuncSetAttribute((const void*)mega_fwd, hipFuncAttributeMaxDynamicSharedMemorySize, LDS_BYTES);
        (void)hipOccupancyMaxActiveBlocksPerMultiprocessor(&per_cu, (const void*)mega_fwd, NTHREADS, LDS_BYTES);
        if (per_cu < 1) { fprintf(stderr, "kernel_launch: occupancy query says %d blocks per CU\n", per_cu); per_cu = 1; }
        grid = cus * 1;
        if (grid != 256) fprintf(stderr, "kernel_launch: %d CUs (the scan phases are laid out for 256 workgroups)\n", grid);
    }
    if (grid < 0) return;
    Params p{};
    for (int i = 0; i < N_INPUTS; ++i) p.in[i] = (const float*)d_in[i];
    p.out = (float*)d_out; p.ws = (unsigned char*)d_ws; p.ph_lo = 0; p.ph_hi = 0;
    void* args[] = {&p};
    hipError_t e = hipLaunchCooperativeKernel((const void*)mega_fwd, dim3(grid), dim3(NTHREADS), args, LDS_BYTES, stream);
    if (e != hipSuccess) fprintf(stderr, "cooperative launch failed: %s (grid %d)\n", hipGetErrorString(e), grid);
}
```

```cpp
#include <hip/hip_runtime.h>
#include <hip/hip_cooperative_groups.h>
#include <cstdio>
#include <cstdint>
namespace cg = cooperative_groups;

#define LAS __attribute__((address_space(3)))
typedef unsigned short bf16_t;
typedef short bf16x8 __attribute__((ext_vector_type(8)));
typedef float f32x4 __attribute__((ext_vector_type(4)));
typedef unsigned u32x4 __attribute__((ext_vector_type(4)));
typedef unsigned u32x2 __attribute__((ext_vector_type(2)));

constexpr int BATCH = 8, SEQ = 4096, NMETA = 16, LEN = SEQ + NMETA, DM = 1024, DFF = 4096, DEPTH = 2;
constexpr int M_ROWS = BATCH * LEN;
constexpr int MP = 33024;
constexpr int N_IN = 5896;
constexpr int NCH16 = LEN / 16;
constexpr int S5ROWS = BATCH * NCH16;
constexpr int S5RP = 2304;
constexpr float EPS = 1e-6f;
constexpr int NTHREADS = 512, NWAVES = 8;

constexpr size_t QB = (size_t)MP * 256 * 2;
constexpr size_t WB_IN = 0;
constexpr size_t WB_G = WB_IN + (size_t)2816 * 1024;
constexpr size_t WB_P = WB_G + (size_t)3072 * 1024;
constexpr size_t WB_O = WB_P + (size_t)1024 * 1024;
constexpr size_t WB_1 = WB_O + (size_t)1024 * 1024;
constexpr size_t WB_2 = WB_1 + (size_t)4096 * 1024;
constexpr size_t WB_GLU = WB_2 + (size_t)1024 * 4096;
constexpr size_t WB_L1 = WB_GLU + (size_t)512 * 256;
constexpr size_t WB_L2 = WB_L1 + (size_t)512 * 512;
constexpr size_t WB_SX = WB_L2 + (size_t)1280 * 256;
constexpr size_t WB_SY = WB_SX + (size_t)16 * 256 * 256;
constexpr size_t WB_ELEMS = WB_SY + (size_t)16 * 256 * 512;
constexpr size_t WB_BYTES = WB_ELEMS * 2;
static_assert(WB_BYTES <= 5 * QB / 2, "weight block fits 2.5 Q");

constexpr size_t WS_H = 0;
constexpr size_t WS_WB0 = 4 * QB;
constexpr size_t WS_SMALL = 13 * QB / 2;
constexpr size_t WS_SSQ = WS_SMALL;
constexpr size_t WS_DT = WS_SSQ + (size_t)MP * 16 * 4;
constexpr size_t WS_DEC = WS_DT + (size_t)MP * 16 * 4;
static_assert(WS_DEC + (size_t)MP * 16 * 4 <= 7 * QB, "small region");
constexpr size_t WS_MIX = 7 * QB;
constexpr size_t WS_PXBC = WS_MIX;
constexpr size_t WS_YSSD = WS_MIX;
constexpr size_t WS_PARK = WS_MIX;
constexpr size_t WS_ACT = WS_MIX;
constexpr size_t WS_PRKVX = WS_MIX + 4 * QB;
constexpr size_t WS_L2O = WS_MIX + 4 * QB;
constexpr size_t WS_PZ = WS_MIX + 9 * QB;
constexpr size_t WS_UH = WS_MIX + 11 * QB;
constexpr size_t WS_X = WS_MIX + 53 * QB / 4;
constexpr size_t WS_YRW = WS_X;
constexpr size_t WS_L1IN = WS_MIX + 31 * QB / 2;
constexpr size_t WS_YAPRE = WS_L1IN;
constexpr size_t WS_L1O = WS_MIX + 35 * QB / 2;
constexpr size_t WS_YB = WS_L1O;
constexpr size_t WS_BC = WS_MIX + 39 * QB / 2;
constexpr size_t WS_YA = WS_BC;
constexpr size_t WS_YC = WS_BC + QB;
constexpr size_t WS_XS = WS_MIX + 43 * QB / 2;
constexpr size_t WS_END = WS_XS + 2 * QB;
static_assert(WS_END <= (size_t)512 << 20, "workspace map fits 512 MiB");
static_assert((size_t)16 * S5RP * 512 * 2 <= 9 * QB / 4 && (size_t)16 * S5RP * 256 * 4 <= 9 * QB / 4, "S5 buffers fit their slots");
static_assert((size_t)256 * 393216 <= 6 * QB, "gate park");
constexpr size_t DO_RKVP = 0;
constexpr size_t DO_MERGED = 0;
constexpr size_t DO_WB1 = 4 * QB;
static_assert(DO_WB1 + WB_BYTES <= (size_t)BATCH * SEQ * DM * 4, "d_out scratch map");

__device__ __forceinline__ unsigned f2bf(float f) { unsigned u = __builtin_bit_cast(unsigned, f); return (u + 0x7fffu + ((u >> 16) & 1u)) >> 16; }
__device__ __forceinline__ unsigned pk2(float lo, float hi) { unsigned r; asm volatile("v_cvt_pk_bf16_f32 %0, %1, %2" : "=v"(r) : "v"(lo), "v"(hi)); return r; }
__device__ __forceinline__ float bflo(unsigned w) { return __builtin_bit_cast(float, w << 16); }
__device__ __forceinline__ float bfhi(unsigned w) { return __builtin_bit_cast(float, w & 0xffff0000u); }
__device__ __forceinline__ float bf1(bf16_t v) { return __builtin_bit_cast(float, (unsigned)v << 16); }
__device__ __forceinline__ float sigmoidf_(float x) { return 1.0f / (1.0f + __expf(-x)); }
__device__ __forceinline__ float siluf_(float x) { return x / (1.0f + __expf(-x)); }
__device__ __forceinline__ float tanhf_(float x) { x = fminf(fmaxf(x, -15.f), 15.f); const float t = __expf(2.f * x); return (t - 1.f) / (t + 1.f); }
__device__ __forceinline__ float softplusf_(float x) { return fmaxf(x, 0.f) + __logf(1.0f + __expf(-fabsf(x))); }
__device__ __forceinline__ float geluf_(float x) { const float u = 0.7978845608028654f * (x + 0.044715f * x * x * x); return 0.5f * x * (1.f + tanhf_(u)); }
__device__ __forceinline__ float wave_sum(float v) {
#pragma unroll
    for (int o = 1; o < 64; o <<= 1) v += __shfl_xor(v, o);
    return v;
}
__device__ __forceinline__ float sum16(float v) {
#pragma unroll
    for (int o = 1; o < 16; o <<= 1) v += __shfl_xor(v, o);
    return v;
}
template <int CTRL> __device__ __forceinline__ float dpp_mov(float x) {
    return __builtin_bit_cast(float, __builtin_amdgcn_update_dpp(0, __builtin_bit_cast(int, x), CTRL, 0xf, 0xf, true));
}
__device__ __forceinline__ float allred16(float x) {
    x += dpp_mov<0xB1>(x); x += dpp_mov<0x4E>(x); x += dpp_mov<0x141>(x); x += dpp_mov<0x140>(x); return x;
}
__device__ __forceinline__ void unpack8(const u32x4 w, float (&f)[8]) {
    f[0] = bflo(w.x); f[1] = bfhi(w.x); f[2] = bflo(w.y); f[3] = bfhi(w.y); f[4] = bflo(w.z); f[5] = bfhi(w.z); f[6] = bflo(w.w); f[7] = bfhi(w.w);
}
__device__ __forceinline__ u32x4 pack8(const float (&f)[8]) { u32x4 w; w.x = pk2(f[0], f[1]); w.y = pk2(f[2], f[3]); w.z = pk2(f[4], f[5]); w.w = pk2(f[6], f[7]); return w; }
__device__ __forceinline__ int opaque_tid() { int t = threadIdx.x; asm volatile("" : "+v"(t)); return t; }
namespace pg8 {
constexpr int BM = 256, BK = 64, HALF = 128, HTB = HALF * BK * 2  , STAGE_BYTES = 8 * HTB;
__host__ __device__ __forceinline__ int lds_byte(int r, int c) { const int st = (r >> 4) * 2 + (c >> 5), rr = r & 15, cc = c & 31, ob = rr * 64 + cc * 2; return st * 1024 + (ob ^ (((ob >> 9) & 1) << 5)); }
__host__ __device__ __forceinline__ void stage_rc(int b, int& R, int& C) { const int st = b / 1024, sb = b % 1024, swz = sb ^ (((sb >> 9) & 1) << 5); R = (st >> 1) * 16 + swz / 64; C = (st & 1) * 32 + (swz % 64) / 2; }
__host__ __device__ __forceinline__ int perm32(int rho) { const int n = rho >> 4, i = rho & 15; return 8 * (i >> 2) + 4 * n + (i & 3); }

struct GU {
    const bf16_t* A;
    const bf16_t* B;
    int lda, ldb, nt;
    int pm, pn, kind;
};

template <class Epi, class Sched>
__device__ __forceinline__ void gemm_phase(LAS unsigned char* lds, const Sched& S, const Epi& E) {
    const int tid = opaque_tid(), wid = __builtin_amdgcn_readfirstlane(tid >> 6), lane = tid & 63, wr = wid >> 2, wc = wid & 3, fr = lane & 15, fq = lane >> 4;
#define PG8_VOFF(lda_, ldb_, a0, a1, b0, b1) do { int R0_, C0_, R1_, C1_; stage_rc(tid * 16, R0_, C0_); stage_rc(tid * 16 + 8192, R1_, C1_); \
        a0 = (unsigned)(R0_ * (lda_) + C0_) * 2u; a1 = (unsigned)(R1_ * (lda_) + C1_) * 2u; \
        b0 = (unsigned)(((R0_ & ~31) + perm32(R0_ & 31)) * (ldb_) + C0_) * 2u; b1 = (unsigned)(((R1_ & ~31) + perm32(R1_ & 31)) * (ldb_) + C1_) * 2u; } while (0)
    const size_t kstep = (size_t)(BK * 2);
    const unsigned ldsw = (unsigned)wid * 1024u;
    const int aoff = lds_byte(wr * 64 + fr, fq * 8), boff = lds_byte(wc * 32 + fr, fq * 8);
#define PG8_SA(b, h) (((b) * 2 + (h)) * HTB)
#define PG8_SB(b, h) ((4 + (b) * 2 + (h)) * HTB)
#define PG8_STAGE(bufoff, gbase, v0, v1) do { \
        __builtin_amdgcn_global_load_lds((const unsigned*)((const char*)(gbase) + (v0)), (LAS unsigned*)(lds + (bufoff) + ldsw), 16, 0, 0); \
        __builtin_amdgcn_global_load_lds((const unsigned*)((const char*)(gbase) + (v1)), (LAS unsigned*)(lds + (bufoff) + ldsw + 8192), 16, 0, 0); } while (0)
#define PG8_LDA(dst, b, h) do { _Pragma("unroll") for (int m = 0; m < 4; ++m) _Pragma("unroll") for (int k = 0; k < 2; ++k) dst[m][k] = *(const LAS bf16x8*)(lds + PG8_SA(b, h) + aoff + m * 2048 + k * 1024); } while (0)
#define PG8_LDB(dst, b, h) do { _Pragma("unroll") for (int n = 0; n < 2; ++n) _Pragma("unroll") for (int k = 0; k < 2; ++k) dst[n][k] = *(const LAS bf16x8*)(lds + PG8_SB(b, h) + boff + n * 2048 + k * 1024); } while (0)
#define PG8_MMA(ai, bj, At, Bt) do { __builtin_amdgcn_s_setprio(1); _Pragma("unroll") for (int m = 0; m < 4; ++m) _Pragma("unroll") for (int n = 0; n < 2; ++n) _Pragma("unroll") for (int k = 0; k < 2; ++k) \
        acc[ai][bj][m][n] = __builtin_amdgcn_mfma_f32_16x16x32_bf16(Bt[n][k], At[m][k], acc[ai][bj][m][n], 0, 0, 0); __builtin_amdgcn_s_setprio(0); } while (0)
#define PG8_WAIT_V(n) asm volatile("s_waitcnt vmcnt(" #n ")" ::: "memory")
#define PG8_WAIT_L(n) asm volatile("s_waitcnt lgkmcnt(" #n ")" ::: "memory")
#define PG8_BAR __builtin_amdgcn_s_barrier()
#define PG8_SCHED __builtin_amdgcn_sched_barrier(0)
    GU cur, nxt; int ui = 0;
    if (!S.next(0, cur)) return;
    f32x4 acc[2][2][4][2];
#pragma unroll
    for (int a = 0; a < 2; ++a)
#pragma unroll
        for (int b = 0; b < 2; ++b)
#pragma unroll
            for (int m = 0; m < 4; ++m)
#pragma unroll
                for (int n = 0; n < 2; ++n) acc[a][b][m][n] = (f32x4){0.f, 0.f, 0.f, 0.f};
    bf16x8 At[4][2], B0[2][2], B1[2][2];
    const char* cA = (const char*)cur.A; const char* cB = (const char*)cur.B;
    unsigned vA0, vA1, vB0, vB1; PG8_VOFF(cur.lda, cur.ldb, vA0, vA1, vB0, vB1);
    size_t hsA = (size_t)HALF * cur.lda * 2, hsB = (size_t)HALF * cur.ldb * 2;
    int nt = cur.nt; asm volatile("" : "+s"(nt));
    PG8_STAGE(PG8_SB(0, 0), cB, vB0, vB1); PG8_STAGE(PG8_SB(0, 1), cB + hsB, vB0, vB1); PG8_STAGE(PG8_SA(0, 0), cA, vA0, vA1); PG8_STAGE(PG8_SA(0, 1), cA + hsA, vA0, vA1);
    if (wr == 1) PG8_BAR;
    PG8_WAIT_V(2); PG8_BAR;
    PG8_STAGE(PG8_SB(1, 0), cB + kstep, vB0, vB1); PG8_STAGE(PG8_SA(1, 0), cA + kstep, vA0, vA1); PG8_STAGE(PG8_SB(1, 1), cB + hsB + kstep, vB0, vB1);
    PG8_WAIT_V(6); PG8_BAR;
    for (;;) {
        const bool has_next = S.next(ui + 1, nxt);
        const char* nA = has_next ? (const char*)nxt.A : cA; const char* nB = has_next ? (const char*)nxt.B : cB;
        unsigned nvA0 = vA0, nvA1 = vA1, nvB0 = vB0, nvB1 = vB1;
        if (has_next) PG8_VOFF(nxt.lda, nxt.ldb, nvA0, nvA1, nvB0, nvB1);
        const size_t nhsA = has_next ? (size_t)HALF * nxt.lda * 2 : hsA, nhsB = has_next ? (size_t)HALF * nxt.ldb * 2 : hsB;
        for (int t = 0; t < nt; t += 2) {
            const bool last = (t == nt - 2);
            const char* a1 = cA + (size_t)(t + 1) * kstep;
            const char* a2 = last ? nA : cA + (size_t)(t + 2) * kstep; const char* b2 = last ? nB : cB + (size_t)(t + 2) * kstep;
            const char* a3 = a2 + kstep; const char* b3 = b2 + kstep;
            const unsigned xA0 = last ? nvA0 : vA0, xA1 = last ? nvA1 : vA1, xB0 = last ? nvB0 : vB0, xB1 = last ? nvB1 : vB1;
            const size_t xhA = last ? nhsA : hsA, xhB = last ? nhsB : hsB;
            PG8_LDB(B0, 0, 0); PG8_LDB(B1, 0, 1); PG8_SCHED; PG8_LDA(At, 0, 0); PG8_STAGE(PG8_SA(1, 1), a1 + hsA, vA0, vA1);
            PG8_WAIT_V(8); PG8_WAIT_L(0); PG8_BAR; PG8_MMA(0, 0, At, B0); PG8_MMA(0, 1, At, B1); PG8_BAR; PG8_SCHED;
            PG8_LDA(At, 0, 1); PG8_STAGE(PG8_SB(0, 0), b2, xB0, xB1); PG8_STAGE(PG8_SB(0, 1), b2 + xhB, xB0, xB1); PG8_STAGE(PG8_SA(0, 0), a2, xA0, xA1);
            PG8_WAIT_V(8); PG8_WAIT_L(0); PG8_BAR; PG8_MMA(1, 0, At, B0); PG8_MMA(1, 1, At, B1); PG8_BAR; PG8_SCHED;
            PG8_LDB(B0, 1, 0); PG8_LDB(B1, 1, 1); PG8_SCHED; PG8_LDA(At, 1, 0); PG8_STAGE(PG8_SA(0, 1), a2 + xhA, xA0, xA1);
            PG8_WAIT_V(8); PG8_WAIT_L(0); PG8_BAR; PG8_MMA(0, 0, At, B0); PG8_MMA(0, 1, At, B1); PG8_BAR; PG8_SCHED;
            PG8_LDA(At, 1, 1); PG8_STAGE(PG8_SB(1, 0), b3, xB0, xB1); PG8_STAGE(PG8_SB(1, 1), b3 + xhB, xB0, xB1); PG8_STAGE(PG8_SA(1, 0), a3, xA0, xA1);
            PG8_WAIT_V(8); PG8_WAIT_L(0); PG8_BAR; PG8_MMA(1, 0, At, B0); PG8_MMA(1, 1, At, B1); PG8_BAR; PG8_SCHED;
        }
        if (wr == 0) PG8_BAR;
        const bool keep = E(acc, cur, wr, wc, fr, fq);
        if (!has_next) break;
        if (!keep) {
#pragma unroll
            for (int a = 0; a < 2; ++a)
#pragma unroll
                for (int b = 0; b < 2; ++b)
#pragma unroll
                    for (int m = 0; m < 4; ++m)
#pragma unroll
                        for (int n = 0; n < 2; ++n) acc[a][b][m][n] = (f32x4){0.f, 0.f, 0.f, 0.f};
        }
        cur = nxt; cA = nA; cB = nB; vA0 = nvA0; vA1 = nvA1; vB0 = nvB0; vB1 = nvB1; hsA = nhsA; hsB = nhsB; nt = cur.nt; asm volatile("" : "+s"(nt)); ++ui;
        if (wr == 1) PG8_BAR;
    }
    PG8_WAIT_V(0);
    PG8_BAR;
#undef PG8_VOFF
#undef PG8_SA
#undef PG8_SB
#undef PG8_STAGE
#undef PG8_LDA
#undef PG8_LDB
#undef PG8_MMA
#undef PG8_WAIT_V
#undef PG8_WAIT_L
#undef PG8_BAR
#undef PG8_SCHED
}

__device__ __forceinline__ bool tile_order(int i, int G, int c, int nM, int nN, int& pm, int& pn) {
    const int nwg = nM * nN; const long L = (long)i * G + c; if (L >= nwg) return false;
    int wgid = (int)L; { const int q = nwg / 8, r = nwg % 8, xcd = wgid % 8, off = wgid / 8; wgid = (xcd < r ? xcd * (q + 1) : r * (q + 1) + (xcd - r) * q) + off; }
    const int nig = 8 * nN, gid = wgid / nig, fm = gid * 8, gsz = (nM - fm) < 8 ? (nM - fm) : 8;
    pm = fm + ((wgid % nig) % gsz); pn = (wgid % nig) / gsz; return true;
}
}
using pg8::GU;
enum InIdx { I_X = 0, I_META, I_FNW, I_MIXNW, I_WIN, I_S5LRE, I_S5LIM, I_S5LS, I_S5BRE, I_S5BIM, I_S5CRE, I_S5CIM, I_S5D, I_GLUW, I_GLUB,
             I_CONVW, I_CONVB, I_ALOG, I_DTB, I_SSDD, I_SSDNW, I_MURKV, I_MUWAG, I_W0, I_W1, I_W2, I_A0, I_A1, I_A2, I_G1, I_G2, I_KK, I_KA, I_RK, I_LNW, I_LNB,
             I_PA, I_PB, I_PC, I_WOUT, I_MLPNW, I_MLPW1, I_MLPW2, N_INPUTS };
struct Params { const float* in[N_INPUTS]; float* out; unsigned char* ws; int ph_lo, ph_hi; };

struct Ctx {
    const float* const* in; unsigned char* ws; unsigned char* dout;
    LAS unsigned char* lds;
    int tid, lane, wave, G, bid;
    __device__ __forceinline__ bf16_t* wb(int layer) const { return (bf16_t*)(layer == 0 ? ws + WS_WB0 : dout + DO_WB1); }
    __device__ __forceinline__ bf16_t* H() const { return (bf16_t*)(ws + WS_H); }
    __device__ __forceinline__ float* ssq() const { return (float*)(ws + WS_SSQ); }
};
__device__ __forceinline__ Ctx relaunder(const Ctx& c0) { Ctx c = c0; c.tid = opaque_tid(); c.lane = c.tid & 63; c.wave = __builtin_amdgcn_readfirstlane(c.tid >> 6); return c; }
__device__ __forceinline__ float row_scale(const float* ssq, int row) {
    const f32x4* p = (const f32x4*)(ssq + (size_t)row * 16);
    const f32x4 a = p[0], b = p[1], c = p[2], d = p[3];
    const float s = ((a.x + a.y) + (a.z + a.w)) + ((b.x + b.y) + (b.z + b.w)) + ((c.x + c.y) + (c.z + c.w)) + ((d.x + d.y) + (d.z + d.w));
    return __builtin_amdgcn_rsqf(s * (1.0f / DM) + EPS);
}

struct SchedPlain {
    const bf16_t* A; const bf16_t* B; int lda, ldb, K, nM, nN, G, c;
    __device__ __forceinline__ bool next(int i, GU& u) const {
        int pm, pn; if (!pg8::tile_order(i, G, c, nM, nN, pm, pn)) return false;
        u.A = A + (size_t)pm * 256 * lda; u.B = B + (size_t)pn * 256 * ldb; u.lda = lda; u.ldb = ldb; u.nt = K / 64; u.pm = pm; u.pn = pn; u.kind = 0; return true;
    }
};
struct SchedS5 {
    const bf16_t* UH; const bf16_t* W; int K, G, c;
    __device__ __forceinline__ bool next(int i, GU& u) const {
        const int L = i * G + c; if (L >= 144) return false;
        const int g = L / 9, pm = L % 9;
        u.A = UH + ((size_t)g * S5RP + (size_t)pm * 256) * 512; u.B = W + (size_t)g * 256 * K; u.lda = 512; u.ldb = K; u.nt = K / 64; u.pm = pm; u.pn = 0; u.kind = g; return true;
    }
};
struct SchedL2 {
    const bf16_t* L1o; const bf16_t* W; int G, c;
    __device__ __forceinline__ bool next(int i, GU& u) const {
        int pm, pn; if (!pg8::tile_order(i, G, c, MP / 256, 5, pm, pn)) return false;
        const int koff = pn < 2 ? 0 : (pn < 4 ? 128 : 256);
        u.A = L1o + (size_t)pm * 256 * 512 + koff; u.B = W + (size_t)pn * 256 * 256; u.lda = 512; u.ldb = 256; u.nt = 4; u.pm = pm; u.pn = pn; u.kind = 0; return true;
    }
};
struct SchedProj {
    const bf16_t* Hb; const bf16_t* Wg; const bf16_t* Wp; const bf16_t* ya; const bf16_t* yb; const bf16_t* yc; int G, c;
    __device__ __forceinline__ bool next(int i, GU& u) const {
        const int ti = i / 6, sub = i - ti * 6; int pm, pn;
        if (!pg8::tile_order(ti, G, c, MP / 256, 4, pm, pn)) return false;
        u.pm = pm; u.pn = pn; u.kind = sub;
        if (sub < 3) { u.A = Hb + (size_t)pm * 256 * DM; u.lda = DM; u.B = Wg + ((size_t)sub * 1024 + (size_t)pn * 256) * DM; u.ldb = DM; u.nt = 16; }
        else if (sub == 3) { u.A = ya + (size_t)pm * 256 * 256; u.lda = 256; u.B = Wp + (size_t)pn * 256 * DM; u.ldb = DM; u.nt = 4; }
        else if (sub == 4) { u.A = yb + (size_t)pm * 256 * 512; u.lda = 512; u.B = Wp + (size_t)pn * 256 * DM + 256; u.ldb = DM; u.nt = 8; }
        else { u.A = yc + (size_t)pm * 256 * 256; u.lda = 256; u.B = Wp + (size_t)pn * 256 * DM + 768; u.ldb = DM; u.nt = 4; }
        return true;
    }
};

typedef f32x4 Acc[2][2][4][2];
#define EPI_ROWS_BEGIN  _Pragma("unroll") for (int ai = 0; ai < 2; ++ai) _Pragma("unroll") for (int m = 0; m < 4; ++m) { const int rl = ai * 128 + wr * 64 + m * 16 + fr; const int row = u.pm * 256 + rl; (void)rl;
#define EPI_ROWS_END    }
#define EPI_COL(bj) ((bj) * 128 + wc * 32 + fq * 8)

struct EpiInProj {
    const float* ssq; bf16_t* UH; bf16_t* Pz; bf16_t* Pxbc; bf16_t* Prkvx;
    __device__ __forceinline__ bool operator()(Acc& acc, const GU& u, int wr, int wc, int fr, int fq) const {
        EPI_ROWS_BEGIN
            if (row < M_ROWS) {
                const float s = row_scale(ssq, row);
                const int b = row / LEN, t = row - b * LEN;
#pragma unroll
                for (int bj = 0; bj < 2; ++bj) {
                    const int col = EPI_COL(bj);
                    const f32x4 v0 = acc[ai][bj][m][0] * s, v1 = acc[ai][bj][m][1] * s;
                    u32x4 w; w.x = pk2(v0[0], v0[1]); w.y = pk2(v0[2], v0[3]); w.z = pk2(v1[0], v1[1]); w.w = pk2(v1[2], v1[3]);
                    bf16_t* dst;
                    if (u.pn == 0) { const int g = col >> 4, hh = col & 15; dst = UH + ((size_t)g * S5RP + (size_t)(b * NCH16 + (t >> 4))) * 512 + (t & 15) * 16 + hh; }
                    else if (u.pn < 3) dst = Pz + (size_t)row * 512 + (u.pn - 1) * 256 + col;
                    else if (u.pn < 7) dst = Pxbc + (size_t)row * 1024 + (u.pn - 3) * 256 + col;
                    else dst = Prkvx + (size_t)row * 1024 + (u.pn - 7) * 256 + col;
                    *(u32x4*)dst = w;
                }
            }
        EPI_ROWS_END
        return false;
    }
};
struct EpiS5X {
    float* X;
    __device__ __forceinline__ bool operator()(Acc& acc, const GU& u, int wr, int wc, int fr, int fq) const {
        EPI_ROWS_BEGIN
            float* rp = X + ((size_t)u.kind * S5RP + row) * 256;
#pragma unroll
            for (int bj = 0; bj < 2; ++bj) { const int col = EPI_COL(bj); *(f32x4*)(rp + col) = acc[ai][bj][m][0]; *(f32x4*)(rp + col + 4) = acc[ai][bj][m][1]; }
        EPI_ROWS_END
        return false;
    }
};
struct EpiS5Y {
    bf16_t* yapre;
    __device__ __forceinline__ bool operator()(Acc& acc, const GU& u, int wr, int wc, int fr, int fq) const {
        EPI_ROWS_BEGIN
            if (row < S5ROWS) {
                const int b = row / NCH16, c = row - b * NCH16;
#pragma unroll
                for (int bj = 0; bj < 2; ++bj) {
                    const int col = EPI_COL(bj), i = col >> 4, hh = col & 15;
                    const f32x4 v0 = acc[ai][bj][m][0], v1 = acc[ai][bj][m][1];
                    u32x4 w; w.x = pk2(geluf_(v0[0]), geluf_(v0[1])); w.y = pk2(geluf_(v0[2]), geluf_(v0[3])); w.z = pk2(geluf_(v1[0]), geluf_(v1[1])); w.w = pk2(geluf_(v1[2]), geluf_(v1[3]));
                    *(u32x4*)(yapre + ((size_t)b * LEN + c * 16 + i) * 256 + u.kind * 16 + hh) = w;
                }
            }
        EPI_ROWS_END
        return false;
    }
};
struct EpiL1 {
    bf16_t* L1o;
    __device__ __forceinline__ bool operator()(Acc& acc, const GU& u, int wr, int wc, int fr, int fq) const {
        EPI_ROWS_BEGIN
#pragma unroll
            for (int bj = 0; bj < 2; ++bj) {
                const int col = EPI_COL(bj); const int mode = u.pn * 2 + bj;
                f32x4 v0 = acc[ai][bj][m][0], v1 = acc[ai][bj][m][1]; float f[8] = {v0[0], v0[1], v0[2], v0[3], v1[0], v1[1], v1[2], v1[3]};
#pragma unroll
                for (int e = 0; e < 8; ++e) f[e] = mode == 0 ? tanhf_(f[e]) : (mode == 1 ? f[e] : (mode == 2 ? sigmoidf_(f[e]) : 0.f));
                *(u32x4*)(L1o + (size_t)row * 512 + u.pn * 256 + col) = pack8(f);
            }
        EPI_ROWS_END
        return false;
    }
};
struct EpiL2 {
    bf16_t* L2o; const float* w0; const float* a0;
    __device__ __forceinline__ bool operator()(Acc& acc, const GU& u, int wr, int wc, int fr, int fq) const {
        EPI_ROWS_BEGIN
#pragma unroll
            for (int bj = 0; bj < 2; ++bj) {
                const int col = EPI_COL(bj);
                f32x4 v0 = acc[ai][bj][m][0], v1 = acc[ai][bj][m][1]; float f[8] = {v0[0], v0[1], v0[2], v0[3], v1[0], v1[1], v1[2], v1[3]};
                if (u.pn < 2) {
                    const float* bp = w0 + u.pn * 256 + col;
#pragma unroll
                    for (int e = 0; e < 8; ++e) { const float v = bp[e] + f[e]; f[e] = -__expf(-softplusf_(-v) - 0.5f); }
                } else if (u.pn < 4) {
                    const float* bp = a0 + (u.pn - 2) * 256 + col;
#pragma unroll
                    for (int e = 0; e < 8; ++e) f[e] = sigmoidf_(bp[e] + f[e]);
                }
                *(u32x4*)(L2o + (size_t)row * 1280 + u.pn * 256 + col) = pack8(f);
            }
        EPI_ROWS_END
        return false;
    }
};
struct EpiGLU {
    bf16_t* ya; const float* bias;
    __device__ __forceinline__ bool operator()(Acc& acc, const GU& u, int wr, int wc, int fr, int fq) const {
        const int lc = wc * 32 + fq * 8, oc = u.pn * 128 + lc;
        float bv[8], bg[8];
#pragma unroll
        for (int e = 0; e < 8; ++e) { bv[e] = bias[oc + e]; bg[e] = bias[256 + oc + e]; }
        EPI_ROWS_BEGIN
            const f32x4 a0 = acc[ai][0][m][0], a1 = acc[ai][0][m][1], g0 = acc[ai][1][m][0], g1 = acc[ai][1][m][1];
            float v[8] = {a0[0], a0[1], a0[2], a0[3], a1[0], a1[1], a1[2], a1[3]}, g[8] = {g0[0], g0[1], g0[2], g0[3], g1[0], g1[1], g1[2], g1[3]};
#pragma unroll
            for (int e = 0; e < 8; ++e) v[e] = (v[e] + bv[e]) * sigmoidf_(g[e] + bg[e]);
            *(u32x4*)(ya + (size_t)row * 256 + oc) = pack8(v);
        EPI_ROWS_END
        return false;
    }
};
struct EpiProj {
    const float* ssq; const float* ssqb; unsigned char* park; bf16_t* merged; int tid;
    __device__ __forceinline__ bool operator()(Acc& acc, const GU& u, int wr, int wc, int fr, int fq) const {
        const int k = u.kind;
        EPI_ROWS_BEGIN
            float s = 1.f; if (k < 3) s = row_scale(ssq, row < M_ROWS ? row : 0);
            else if (k < 5) { s = __builtin_amdgcn_rsqf(ssqb[row < M_ROWS ? row : 0] * (1.0f / 512.f) + EPS); if (k == 3) s = __builtin_amdgcn_rcpf(s); }
#pragma unroll
            for (int bj = 0; bj < 2; ++bj) {
                const int q = (ai * 2 + bj) * 4 + m;
                f32x4& v0 = acc[ai][bj][m][0]; f32x4& v1 = acc[ai][bj][m][1];
                if (k < 3) {
                    float f[8] = {v0[0], v0[1], v0[2], v0[3], v1[0], v1[1], v1[2], v1[3]};
#pragma unroll
                    for (int e = 0; e < 8; ++e) f[e] = sigmoidf_(f[e] * s);
                    *(u32x4*)(park + ((size_t)(k * 16 + q) * NTHREADS + tid) * 16) = pack8(f);
                } else {
                    float num[8], den[8];
                    unpack8(*(const u32x4*)(park + ((size_t)((k - 3) * 16 + q) * NTHREADS + tid) * 16), num);
                    if (k < 5) { unpack8(*(const u32x4*)(park + ((size_t)((k - 2) * 16 + q) * NTHREADS + tid) * 16), den);
#pragma unroll
                        for (int e = 0; e < 8; ++e) num[e] = num[e] * __builtin_amdgcn_rcpf(den[e]) * s; }
                    v0[0] *= num[0]; v0[1] *= num[1]; v0[2] *= num[2]; v0[3] *= num[3]; v1[0] *= num[4]; v1[1] *= num[5]; v1[2] *= num[6]; v1[3] *= num[7];
                    if (k == 5) { u32x4 w; w.x = pk2(v0[0], v0[1]); w.y = pk2(v0[2], v0[3]); w.z = pk2(v1[0], v1[1]); w.w = pk2(v1[2], v1[3]);
                        *(u32x4*)(merged + (size_t)row * DM + u.pn * 256 + EPI_COL(bj)) = w; }
                }
            }
        EPI_ROWS_END
        return k == 3 || k == 4;
    }
};
struct EpiResid {
    bf16_t* H; float* ssq;
    __device__ __forceinline__ bool operator()(Acc& acc, const GU& u, int wr, int wc, int fr, int fq) const {
        EPI_ROWS_BEGIN
            float ss = 0.f;
            if (row < M_ROWS) {
#pragma unroll
                for (int bj = 0; bj < 2; ++bj) {
                    bf16_t* hp = H + (size_t)row * DM + u.pn * 256 + EPI_COL(bj);
                    float f[8]; unpack8(*(const u32x4*)hp, f);
                    const f32x4 v0 = acc[ai][bj][m][0], v1 = acc[ai][bj][m][1];
                    f[0] += v0[0]; f[1] += v0[1]; f[2] += v0[2]; f[3] += v0[3]; f[4] += v1[0]; f[5] += v1[1]; f[6] += v1[2]; f[7] += v1[3];
#pragma unroll
                    for (int e = 0; e < 8; ++e) ss += f[e] * f[e];
                    *(u32x4*)hp = pack8(f);
                }
            }
            ss += __shfl_xor(ss, 16); ss += __shfl_xor(ss, 32);
            if (fq == 0 && row < M_ROWS) ssq[(size_t)row * 16 + u.pn * 4 + wc] = ss;
        EPI_ROWS_END
        return false;
    }
};
struct EpiUp {
    const float* ssq; bf16_t* act;
    __device__ __forceinline__ bool operator()(Acc& acc, const GU& u, int wr, int wc, int fr, int fq) const {
        EPI_ROWS_BEGIN
            const float s = row_scale(ssq, row < M_ROWS ? row : 0);
#pragma unroll
            for (int bj = 0; bj < 2; ++bj) {
                const f32x4 v0 = acc[ai][bj][m][0] * s, v1 = acc[ai][bj][m][1] * s; float f[8] = {v0[0], v0[1], v0[2], v0[3], v1[0], v1[1], v1[2], v1[3]};
#pragma unroll
                for (int e = 0; e < 8; ++e) { const float r = fmaxf(f[e], 0.f); f[e] = r * r; }
                *(u32x4*)(act + (size_t)row * DFF + u.pn * 256 + EPI_COL(bj)) = pack8(f);
            }
        EPI_ROWS_END
        return false;
    }
};
typedef __attribute__((address_space(1))) unsigned gu32;
#define XB_TMO      128
#define XB_XCNT(j)  (256  + 64 * (j))
#define XB_XSUB(j)  (1280 + 64 * (j))
#define XB_XGEN(j)  (2304 + 64 * (j))
#define XB_TOP      3328
#define XB_TOPGEN   3392
#define XCD_BAR_WORDS 3456
#define XB_SPIN_CAP (1u << 18)

__device__ __forceinline__ unsigned xb_ld(unsigned* p)              { return __hip_atomic_load(p, __ATOMIC_RELAXED, __HIP_MEMORY_SCOPE_AGENT); }
__device__ __forceinline__ unsigned xb_add(unsigned* p, unsigned v) { return __hip_atomic_fetch_add(p, v, __ATOMIC_RELAXED, __HIP_MEMORY_SCOPE_AGENT); }
__device__ __forceinline__ unsigned xb_xcc_id() { return (unsigned)__builtin_amdgcn_s_getreg((3 << 11) | 20) & 0xFu; }
#define XB_SPIN(cond, bar) do { unsigned _sp = 0; while (cond) { __builtin_amdgcn_s_sleep(1); \
    if ((++_sp & 255u) == 0u) { if (xb_ld(&(bar)[XB_TMO])) break; if (_sp > XB_SPIN_CAP) { atomicAdd(&(bar)[XB_TMO], 1u); break; } } } } while (0)

struct XcdBarrier {
    unsigned* bar; unsigned x;
    volatile LAS unsigned* st;
};

__device__ __forceinline__ XcdBarrier xcd_barrier_post(unsigned* bar, volatile LAS unsigned* st) {
    XcdBarrier b; b.bar = bar; b.x = xb_xcc_id(); b.st = st;
    if (threadIdx.x == 0) (void)xb_add(&bar[XB_XCNT(b.x)], 1u);
    return b;
}
__device__ __forceinline__ void xcd_barrier_complete(unsigned* bar, unsigned x, unsigned& nloc, unsigned& nx) {
    const unsigned G = gridDim.x * gridDim.y * gridDim.z;
    unsigned sum, cnt, mine, sp = 0u;
    for (;;) {
        sum = 0u; cnt = 0u; mine = 0u;
#pragma unroll
        for (unsigned j = 0; j < 16; ++j) { const unsigned c = xb_ld(&bar[XB_XCNT(j)]); sum += c; cnt += (c > 0u) ? 1u : 0u; mine = (j == x) ? c : mine; }
        if (sum == G) break;
        __builtin_amdgcn_s_sleep(1);
        if ((++sp & 255u) == 0u) { if (xb_ld(&bar[XB_TMO])) break; if (sp > XB_SPIN_CAP) { atomicAdd(&bar[XB_TMO], 1u); break; } }
    }
    nloc = mine > 0u ? mine : 1u; nx = cnt > 0u ? cnt : 1u;
}

__device__ __forceinline__ void xcd_barrier(const XcdBarrier& b) {
    asm volatile("s_waitcnt vmcnt(0)" ::: "memory");
    __syncthreads();
    if (threadIdx.x == 0) {
        unsigned* bar = b.bar;
        __builtin_amdgcn_s_waitcnt(0);
        unsigned nloc = b.st[0], nx = b.st[1];
        if (nloc == 0u) { xcd_barrier_complete(bar, b.x, nloc, nx); b.st[0] = nloc; b.st[1] = nx; }
        const unsigned old = xb_add(&bar[XB_XSUB(b.x)], 1u);
        const unsigned gen = old / nloc;
        if (old + 1u == (gen + 1u) * nloc) {
            __builtin_amdgcn_fence(__ATOMIC_RELEASE, "agent");
            asm volatile("s_waitcnt vmcnt(0)" ::: "memory");
            const unsigned og = xb_add(&bar[XB_TOP], 1u);
            const unsigned tg = og / nx;
            if (og + 1u == (tg + 1u) * nx) xb_add(&bar[XB_TOPGEN], 1u);
            else XB_SPIN(xb_ld(&bar[XB_TOPGEN]) == tg, bar);
            __builtin_amdgcn_fence(__ATOMIC_ACQUIRE, "agent");
            xb_add(&bar[XB_XGEN(b.x)], 1u);
            asm volatile("s_waitcnt vmcnt(0)" ::: "memory");
        } else {
            XB_SPIN(xb_ld(&bar[XB_XGEN(b.x)]) == gen, bar);
            __builtin_amdgcn_fence(__ATOMIC_ACQUIRE, "agent");
            asm volatile("s_waitcnt vmcnt(0)" ::: "memory");
        }
    }
    __syncthreads();
}

struct TJob { const float* src; int ld, col0, K, N; bf16_t* dst; int dld, dk0, rmode, row0; const float* ksc; };
constexpr int N_TJOBS = 27;
__device__ __forceinline__ void get_tjob(const Ctx& c, int l, int j, TJob& t) {
    bf16_t* wb = c.wb(l);
    const float* win = c.in[I_WIN] + (size_t)l * DM * N_IN;
    t.rmode = 0; t.ksc = nullptr; t.dk0 = 0; t.col0 = 0; t.row0 = 0;
    if (j < 5) {
        t.src = win; t.ld = N_IN; t.K = DM; t.dld = DM; t.ksc = c.in[I_MIXNW] + l * DM; t.dst = wb + WB_IN;
        if (j == 0) { t.col0 = 0; t.N = 256; t.row0 = 0; }
        else if (j == 1) { t.col0 = 256; t.N = 512; t.row0 = 256; }
        else if (j == 2) { t.col0 = 768; t.N = 1024; t.row0 = 768; }
        else if (j == 3) { t.col0 = 1800; t.N = 1024; t.row0 = 1792; }
        else { t.col0 = 2824; t.N = 3072; t.row0 = 0; t.dst = wb + WB_G; }
    } else if (j == 5) { t.src = c.in[I_PA] + (size_t)l * 256 * DM; t.ld = DM; t.K = 256; t.N = DM; t.dst = wb + WB_P; t.dld = DM; t.dk0 = 0; }
    else if (j == 6) { t.src = c.in[I_PB] + (size_t)l * 512 * DM; t.ld = DM; t.K = 512; t.N = DM; t.dst = wb + WB_P; t.dld = DM; t.dk0 = 256; t.ksc = c.in[I_SSDNW] + (size_t)l * 512; }
    else if (j == 7) { t.src = c.in[I_PC] + (size_t)l * 256 * DM; t.ld = DM; t.K = 256; t.N = DM; t.dst = wb + WB_P; t.dld = DM; t.dk0 = 768; }
    else if (j == 8) { t.src = c.in[I_WOUT] + (size_t)l * DM * DM; t.ld = DM; t.K = DM; t.N = DM; t.dst = wb + WB_O; t.dld = DM; }
    else if (j == 9) { t.src = c.in[I_MLPW1] + (size_t)l * DM * DFF; t.ld = DFF; t.K = DM; t.N = DFF; t.dst = wb + WB_1; t.dld = DM; t.ksc = c.in[I_MLPNW] + l * DM; }
    else if (j == 10) { t.src = c.in[I_MLPW2] + (size_t)l * DFF * DM; t.ld = DM; t.K = DFF; t.N = DM; t.dst = wb + WB_2; t.dld = DFF; }
    else if (j == 11) { t.src = c.in[I_GLUW] + (size_t)l * 256 * 512; t.ld = 512; t.K = 256; t.N = 512; t.dst = wb + WB_GLU; t.dld = 256; t.rmode = 1; }
    else if (j < 22) {
        const int q = j - 12;
        t.K = 256; t.dst = wb + WB_L1; t.dld = 512;
        if (q < 4) { const int d = q >> 1, hf = q & 1; t.src = c.in[I_W1] + ((size_t)l * 2 + d) * 256 * 64; t.ld = 64; t.N = 64; t.row0 = d * 64; t.dk0 = hf * 256; if (hf) t.ksc = c.in[I_MUWAG] + ((size_t)l * 3 + 0) * 256; }
        else if (q < 8) { const int d = (q - 4) >> 1, hf = q & 1; t.src = c.in[I_A1] + ((size_t)l * 2 + d) * 256 * 64; t.ld = 64; t.N = 64; t.row0 = 128 + d * 64; t.dk0 = hf * 256; if (hf) t.ksc = c.in[I_MUWAG] + ((size_t)l * 3 + 1) * 256; }
        else { const int hf = q & 1; t.src = c.in[I_G1] + (size_t)l * 256 * 128; t.ld = 128; t.N = 128; t.row0 = 256; t.dk0 = hf * 256; if (hf) t.ksc = c.in[I_MUWAG] + ((size_t)l * 3 + 2) * 256; }
    } else {
        const int q = j - 22;
        t.dst = wb + WB_L2; t.dld = 256; t.ld = 256; t.N = 256;
        if (q < 2) { t.src = c.in[I_W2] + ((size_t)l * 2 + q) * 64 * 256; t.K = 64; t.row0 = q * 256; t.dk0 = q * 64; }
        else if (q < 4) { const int d = q - 2; t.src = c.in[I_A2] + ((size_t)l * 2 + d) * 64 * 256; t.K = 64; t.row0 = (2 + d) * 256; t.dk0 = d * 64; }
        else { t.src = c.in[I_G2] + (size_t)l * 128 * 256; t.K = 128; t.row0 = 4 * 256; t.dk0 = 0; }
    }
}
__device__ __forceinline__ int tjob_items(const TJob& t) { return (t.K / 64) * (t.N / 32); }
__device__ __forceinline__ void transpose_item(const TJob& t, LAS float* scr, int item, int lane) {
    const int nblk = t.N / 32, kb = item / nblk, nb = item % nblk, k0 = 64 * kb, n0 = 32 * nb;
#pragma unroll 8
    for (int i = 0; i < 32; ++i) { const int kk = 2 * i + (lane >> 5); float v = t.src[(size_t)(k0 + kk) * t.ld + t.col0 + n0 + (lane & 31)]; if (t.ksc) v *= t.ksc[k0 + kk]; scr[kk * 33 + (lane & 31)] = v; }
    asm volatile("s_waitcnt lgkmcnt(0)" ::: "memory");
    const int cc = lane & 7;
#pragma unroll
    for (int j = 0; j < 4; ++j) {
        const int n = (lane >> 3) + 8 * j; const LAS float* s = scr + (8 * cc) * 33 + n;
        u32x4 o; o.x = pk2(s[0 * 33], s[1 * 33]); o.y = pk2(s[2 * 33], s[3 * 33]); o.z = pk2(s[4 * 33], s[5 * 33]); o.w = pk2(s[6 * 33], s[7 * 33]);
        const int nn = n0 + n; int drow;
        if (t.rmode == 0) drow = t.row0 + nn; else drow = nn < 256 ? (nn >> 7) * 256 + (nn & 127) : ((nn - 256) >> 7) * 256 + 128 + ((nn - 256) & 127);
        *(u32x4*)(t.dst + (size_t)drow * t.dld + t.dk0 + k0 + 8 * cc) = o;
    }
    asm volatile("s_waitcnt lgkmcnt(0)" ::: "memory");
}

__device__ __forceinline__ void s5_build(const Ctx& cx_, int l, int g) {
    const Ctx c = relaunder(cx_);
    LAS float* F = (LAS float*)c.lds;
    LAS float* pwr = F;
    LAS float* pwi = pwr + 2176;
    LAS float* cor = pwi + 2176;
    LAS float* coi = cor + 128;
    LAS float* Cr = coi + 128;
    LAS float* Ci = Cr + 1024;
    LAS float* Br = Ci + 1024;
    LAS float* Bi = Br + 1024;
    LAS float* kr = Bi + 1024;
    LAS float* ki = kr + 1984;
    LAS float* Kd = ki + 1984;
    const int tid = c.tid;
    if (tid < 128) {
        const int d = tid >> 6, n = tid & 63; const size_t li_ = (((size_t)l * 2 + d) * 16 + g) * 64 + n;
        const float lr = c.in[I_S5LRE][li_], li = c.in[I_S5LIM][li_], step = expf(c.in[I_S5LS][((size_t)l * 2 + d) * 16 + g]);
        for (int k = 0; k <= 16; ++k) { const float mag = expf((float)k * lr * step), ang = (float)k * li * step; float sn, cs; sincosf(ang, &sn, &cs); pwr[(d * 17 + k) * 64 + n] = mag * cs; pwi[(d * 17 + k) * 64 + n] = mag * sn; }
        const float mag1 = expf(lr * step); float sn, cs; sincosf(li * step, &sn, &cs); const float abr = mag1 * cs, abi = mag1 * sn, den = lr * lr + li * li;
        cor[d * 64 + n] = ((abr - 1.f) * lr + abi * li) / den; coi[d * 64 + n] = (abi * lr - (abr - 1.f) * li) / den;
    }
    for (int i = tid; i < 1024; i += NTHREADS) {
        Cr[i] = c.in[I_S5CRE][((size_t)l * 16 + g) * 1024 + i]; Ci[i] = c.in[I_S5CIM][((size_t)l * 16 + g) * 1024 + i];
        Br[i] = c.in[I_S5BRE][((size_t)l * 16 + g) * 1024 + i]; Bi[i] = c.in[I_S5BIM][((size_t)l * 16 + g) * 1024 + i];
    }
    __syncthreads();
    for (int i = tid; i < 31 * 64; i += NTHREADS) {
        const int dd = i / 64 - 15, n = i & 63; float r, im;
        if (dd > 0) { const float pr = pwr[(0 * 17 + dd) * 64 + n], pi = pwi[(0 * 17 + dd) * 64 + n]; r = pr * cor[n] - pi * coi[n]; im = pr * coi[n] + pi * cor[n]; }
        else if (dd < 0) { const float pr = pwr[(1 * 17 - dd) * 64 + n], pi = pwi[(1 * 17 - dd) * 64 + n]; r = pr * cor[64 + n] - pi * coi[64 + n]; im = pr * coi[64 + n] + pi * cor[64 + n]; }
        else { r = cor[n] + cor[64 + n]; im = coi[n] + coi[64 + n]; }
        kr[i] = r; ki[i] = im;
    }
    __syncthreads();
    for (int i = tid; i < 31 * 256; i += NTHREADS) {
        const int ddi = i >> 8, h = (i >> 4) & 15, hp = i & 15; float a = 0.f;
        for (int n = 0; n < 64; ++n) { const float cr = Cr[h * 64 + n], ci = Ci[h * 64 + n], xr = kr[ddi * 64 + n], xi = ki[ddi * 64 + n]; const float pr = cr * xr - ci * xi, pi = cr * xi + ci * xr; a += pr * Br[n * 16 + hp] - pi * Bi[n * 16 + hp]; }
        Kd[i] = a;
    }
    __syncthreads();
    bf16_t* SX = c.wb(l) + WB_SX + (size_t)g * 256 * 256; bf16_t* SY = c.wb(l) + WB_SY + (size_t)g * 256 * 512;
    const float* dsk = c.in[I_S5D] + (size_t)l * 256 + g * 16;
    for (int u = tid; u < 256 * 64; u += NTHREADS) {
        const int o = u >> 6, kk0 = (u & 63) * 8, i = o >> 4, h = o & 15; float v[8];
        if (kk0 < 256) { const int j = kk0 >> 4, hp0 = kk0 & 15;
#pragma unroll
            for (int e = 0; e < 8; ++e) v[e] = Kd[(i - j + 15) * 256 + h * 16 + hp0 + e] + ((i == j && h == hp0 + e) ? dsk[h] : 0.f);
        } else { const int q = kk0 - 256, d = q >> 7, part = (q >> 6) & 1, n0 = q & 63, ex = d == 0 ? i + 1 : 16 - i;
#pragma unroll
            for (int e = 0; e < 8; ++e) { const int n = n0 + e; const float cr = Cr[h * 64 + n], ci = Ci[h * 64 + n], pr = pwr[(d * 17 + ex) * 64 + n], pi = pwi[(d * 17 + ex) * 64 + n]; v[e] = part == 0 ? (cr * pr - ci * pi) : -(cr * pi + ci * pr); }
        }
        *(u32x4*)(SY + (size_t)o * 512 + kk0) = pack8(v);
    }
    for (int u = tid; u < 256 * 32; u += NTHREADS) {
        const int o = u >> 5, kk0 = (u & 31) * 8, d = o >> 7, part = (o >> 6) & 1, n = o & 63, j = kk0 >> 4, hp0 = kk0 & 15, ex = d == 0 ? 15 - j : j;
        const float pr = pwr[(d * 17 + ex) * 64 + n], pi = pwi[(d * 17 + ex) * 64 + n], qr = pr * cor[d * 64 + n] - pi * coi[d * 64 + n], qi = pr * coi[d * 64 + n] + pi * cor[d * 64 + n];
        float v[8];
#pragma unroll
        for (int e = 0; e < 8; ++e) { const float br = Br[n * 16 + hp0 + e], bi = Bi[n * 16 + hp0 + e]; v[e] = part == 0 ? (qr * br - qi * bi) : (qr * bi + qi * br); }
        *(u32x4*)(SX + (size_t)o * 256 + kk0) = pack8(v);
    }
    __syncthreads();
}

__device__ __forceinline__ void phase0(const Ctx& cx_) {
    const Ctx c = relaunder(cx_);
    if (c.bid < 32) s5_build(c, c.bid >> 4, c.bid & 15);
    const int gw = c.bid * NWAVES + c.wave, NGW = c.G * NWAVES, lane = c.lane;
    bf16_t* H = c.H(); float* ssq = c.ssq();
    for (int m = gw; m < MP; m += NGW) {
        u32x2* hp = (u32x2*)(H + (size_t)m * DM);
        if (m >= M_ROWS) {
#pragma unroll
            for (int i = 0; i < 4; ++i) hp[lane + 64 * i] = (u32x2){0u, 0u};
            continue;
        }
        const int b = m / LEN, t = m - b * LEN;
        const f32x4* src = (const f32x4*)(t < NMETA ? c.in[I_META] + (size_t)t * DM : c.in[I_X] + ((size_t)b * SEQ + (t - NMETA)) * DM);
        float ss = 0.f;
#pragma unroll
        for (int i = 0; i < 4; ++i) { const f32x4 v = src[lane + 64 * i]; ss += (v.x * v.x + v.y * v.y) + (v.z * v.z + v.w * v.w); hp[lane + 64 * i] = (u32x2){pk2(v.x, v.y), pk2(v.z, v.w)}; }
        ss = wave_sum(ss);
        if (lane < 16) ssq[(size_t)m * 16 + lane] = lane == 0 ? ss : 0.f;
    }
    LAS float* scr = (LAS float*)(c.lds + c.wave * 8448);
    for (int l = 0; l < DEPTH; ++l) {
        int base = 0;
        for (int j = 0; j < N_TJOBS; ++j) {
            TJob t; get_tjob(c, l, j, t); const int ni = tjob_items(t);
            int first = (gw - base % NGW + NGW) % NGW;
            for (int it = first; it < ni; it += NGW) transpose_item(t, scr, it, lane);
            base += ni;
        }
        bf16_t* wb = c.wb(l);
        const int gt = c.bid * NTHREADS + c.tid, NGT = c.G * NTHREADS;
        for (int u = gt; u < 128 * 64; u += NGT) *(u32x4*)(wb + WB_L1 + (size_t)384 * 512 + (size_t)u * 8) = (u32x4){0u, 0u, 0u, 0u};
        for (int u = gt; u < 5 * 256 * 4 * 8; u += NGT) {
            const int sub = u & 7, blk = (u >> 3) & 3, row = (u >> 5) & 255, tile = u >> 13;
            const bool nz = (tile == 0 || tile == 2) ? (blk == 0) : ((tile == 1 || tile == 3) ? (blk == 1) : (blk < 2));
            if (!nz) *(u32x4*)(wb + WB_L2 + ((size_t)tile * 256 + row) * 256 + blk * 64 + sub * 8) = (u32x4){0u, 0u, 0u, 0u};
        }
    }
}

__device__ __forceinline__ void dt_job(const Ctx& cx_, int l) {
    const Ctx c = relaunder(cx_);
    LAS float* dtw = (LAS float*)c.lds;
    const float* win = c.in[I_WIN] + (size_t)l * DM * N_IN; const float* nw = c.in[I_MIXNW] + l * DM;
    for (int i = c.tid; i < 8 * DM; i += NTHREADS) { const int k = i >> 3, j = i & 7; dtw[j * DM + k] = nw[k] * win[(size_t)k * N_IN + 1792 + j]; }
    __syncthreads();
    const int gw = c.bid * NWAVES + c.wave, NGW = c.G * NWAVES, lane = c.lane;
    const bf16_t* H = c.H(); float* dt = (float*)(c.ws + WS_DT); float* dec = (float*)(c.ws + WS_DEC);
    const float* dtb = c.in[I_DTB] + l * 16; const float* alog = c.in[I_ALOG] + l * 16;
    for (int m = gw; m < M_ROWS; m += NGW) {
        const u32x2* hp = (const u32x2*)(H + (size_t)m * DM);
        float ss = 0.f, d8[8] = {0.f, 0.f, 0.f, 0.f, 0.f, 0.f, 0.f, 0.f};
#pragma unroll
        for (int i = 0; i < 4; ++i) {
            const u32x2 w = hp[lane + 64 * i]; const float h0 = bflo(w.x), h1 = bfhi(w.x), h2 = bflo(w.y), h3 = bfhi(w.y);
            ss += (h0 * h0 + h1 * h1) + (h2 * h2 + h3 * h3);
#pragma unroll
            for (int j = 0; j < 8; ++j) { const f32x4 wv = *(const LAS f32x4*)(dtw + j * DM + 4 * lane + 256 * i); d8[j] += (h0 * wv.x + h1 * wv.y) + (h2 * wv.z + h3 * wv.w); }
        }
        ss = wave_sum(ss);
#pragma unroll
        for (int j = 0; j < 8; ++j) d8[j] = wave_sum(d8[j]);
        const float s = __builtin_amdgcn_rsqf(ss * (1.0f / DM) + EPS);
        if (lane < 16) {
            const int j = lane & 7; float raw = d8[0];
#pragma unroll
            for (int e = 1; e < 8; ++e) raw = (j == e) ? d8[e] : raw;
            const float dtv = softplusf_(raw * s + dtb[lane]);
            dt[(size_t)m * 16 + lane] = dtv; dec[(size_t)m * 16 + lane] = -dtv * __expf(alog[lane]);
        }
    }
    __syncthreads();
}

__device__ __forceinline__ void rwkv_prep(const Ctx& cx_, int l) {
    const Ctx c = relaunder(cx_);
    const int gw = c.bid * NWAVES + c.wave, NGW = c.G * NWAVES, lane = c.lane, c0 = 4 * lane;
    const bf16_t* P = (const bf16_t*)(c.ws + WS_PRKVX); bf16_t* rk = (bf16_t*)(c.dout + DO_RKVP); bf16_t* l1 = (bf16_t*)(c.ws + WS_L1IN);
    float mu[3][4], kkw[4];
#pragma unroll
    for (int x = 0; x < 3; ++x)
#pragma unroll
        for (int e = 0; e < 4; ++e) mu[x][e] = c.in[I_MURKV][((size_t)l * 3 + x) * 256 + c0 + e];
#pragma unroll
    for (int e = 0; e < 4; ++e) kkw[e] = c.in[I_KK][(size_t)l * 256 + c0 + e];
    for (int m = gw; m < M_ROWS; m += NGW) {
        const int b = m / LEN, t = m - b * LEN; const bool hp = t > 0, hn = t < LEN - 1;
        float o[4][4];
        float xc[4], dxc[4];
#pragma unroll
        for (int x = 0; x < 4; ++x) {
            const u32x2 wc_ = *(const u32x2*)(P + (size_t)m * 1024 + x * 256 + c0);
            u32x2 wp = (u32x2){0u, 0u}, wn = (u32x2){0u, 0u};
            if (hp) wp = *(const u32x2*)(P + (size_t)(m - 1) * 1024 + x * 256 + c0);
            if (hn) wn = *(const u32x2*)(P + (size_t)(m + 1) * 1024 + x * 256 + c0);
            const float cur[4] = {bflo(wc_.x), bfhi(wc_.x), bflo(wc_.y), bfhi(wc_.y)}, pv[4] = {bflo(wp.x), bfhi(wp.x), bflo(wp.y), bfhi(wp.y)}, nv[4] = {bflo(wn.x), bfhi(wn.x), bflo(wn.y), bfhi(wn.y)};
#pragma unroll
            for (int e = 0; e < 4; ++e) { const float cs = 0.5f * (pv[e] + nv[e]) - cur[e]; if (x < 3) o[x][e] = cur[e] + cs * mu[x][e]; else { xc[e] = cur[e]; dxc[e] = cs; } }
        }
        float kr_[4], ss = 0.f;
#pragma unroll
        for (int e = 0; e < 4; ++e) { kr_[e] = o[1][e] * kkw[e]; ss += kr_[e] * kr_[e]; }
        ss = sum16(ss); const float rn = __builtin_amdgcn_rsqf(ss + 1e-12f);
        bf16_t* rp = rk + (size_t)m * 1024 + c0;
        *(u32x2*)(rp) = (u32x2){pk2(o[0][0], o[0][1]), pk2(o[0][2], o[0][3])};
        *(u32x2*)(rp + 256) = (u32x2){pk2(o[1][0], o[1][1]), pk2(o[1][2], o[1][3])};
        *(u32x2*)(rp + 512) = (u32x2){pk2(o[2][0], o[2][1]), pk2(o[2][2], o[2][3])};
        *(u32x2*)(rp + 768) = (u32x2){pk2(kr_[0] * rn, kr_[1] * rn), pk2(kr_[2] * rn, kr_[3] * rn)};
        bf16_t* lp = l1 + (size_t)m * 512 + c0;
        *(u32x2*)(lp) = (u32x2){pk2(xc[0], xc[1]), pk2(xc[2], xc[3])};
        *(u32x2*)(lp + 256) = (u32x2){pk2(dxc[0], dxc[1]), pk2(dxc[2], dxc[3])};
    }
}
__device__ __forceinline__ void ssd_prep(const Ctx& cx_, int l) {
    const Ctx c = relaunder(cx_);
    const int gw = c.bid * NWAVES + c.wave, NGW = c.G * NWAVES, lane = c.lane, c0 = 16 * lane;
    const bf16_t* P = (const bf16_t*)(c.ws + WS_PXBC); bf16_t* xs = (bf16_t*)(c.ws + WS_XS); bf16_t* bc = (bf16_t*)(c.ws + WS_BC);
    float w[5][16], bias[16];
#pragma unroll
    for (int j = 0; j < 5; ++j)
#pragma unroll
        for (int e = 0; e < 16; ++e) w[j][e] = c.in[I_CONVW][((size_t)l * 5 + j) * 1024 + c0 + e];
#pragma unroll
    for (int e = 0; e < 16; ++e) bias[e] = c.in[I_CONVB][(size_t)l * 1024 + c0 + e];
    for (int m = gw; m < M_ROWS; m += NGW) {
        const int b = m / LEN, t = m - b * LEN;
        float a[16];
#pragma unroll
        for (int e = 0; e < 16; ++e) a[e] = bias[e];
#pragma unroll
        for (int j = 0; j < 5; ++j) {
            const int tt = t + j - 2;
            if (tt >= 0 && tt < LEN) {
                const u32x4* p = (const u32x4*)(P + (size_t)(m + j - 2) * 1024 + c0); float f0[8], f1[8]; unpack8(p[0], f0); unpack8(p[1], f1);
#pragma unroll
                for (int e = 0; e < 8; ++e) { a[e] += w[j][e] * f0[e]; a[8 + e] += w[j][8 + e] * f1[e]; }
            }
        }
        float o0[8], o1[8];
#pragma unroll
        for (int e = 0; e < 8; ++e) { o0[e] = siluf_(a[e]); o1[e] = siluf_(a[8 + e]); }
        bf16_t* dst = lane < 32 ? xs + (size_t)m * 512 + c0 : bc + (size_t)m * 512 + (c0 - 512);
        ((u32x4*)dst)[0] = pack8(o0); ((u32x4*)dst)[1] = pack8(o1);
    }
}

__device__ __forceinline__ void s5_scan(const Ctx& cx_, int l) {
    const Ctx c = relaunder(cx_);
    if (c.tid >= 64) return;
    const int gt = c.bid * 64 + c.tid; if (gt >= 16384) return;
    const int n = gt & 63, d = (gt >> 6) & 1, b = (gt >> 7) & 7, g = gt >> 10;
    const size_t li_ = (((size_t)l * 2 + d) * 16 + g) * 64 + n;
    const float lr = c.in[I_S5LRE][li_], li = c.in[I_S5LIM][li_], step = expf(c.in[I_S5LS][((size_t)l * 2 + d) * 16 + g]);
    const float mag = expf(16.f * lr * step); float sn, cs; sincosf(16.f * li * step, &sn, &cs); const float ar = mag * cs, ai = mag * sn;
    const float* X = (const float*)(c.ws + WS_X) + ((size_t)g * S5RP + (size_t)b * NCH16) * 256 + d * 128 + n;
    bf16_t* U = (bf16_t*)(c.ws + WS_UH) + ((size_t)g * S5RP + (size_t)b * NCH16) * 512 + 256 + d * 128 + n;
    float hr = 0.f, hi = 0.f;
    for (int i0 = 0; i0 < NCH16; i0 += 32) {
        float xr[32], xi[32];
#pragma unroll
        for (int k = 0; k < 32; ++k) { const int i = i0 + k; const int ch = d == 0 ? i : NCH16 - 1 - i; const bool ok = i < NCH16; xr[k] = ok ? X[(size_t)ch * 256] : 0.f; xi[k] = ok ? X[(size_t)ch * 256 + 64] : 0.f; }
#pragma unroll
        for (int k = 0; k < 32; ++k) { const int i = i0 + k; if (i < NCH16) { const int ch = d == 0 ? i : NCH16 - 1 - i;
            U[(size_t)ch * 512] = (bf16_t)f2bf(hr); U[(size_t)ch * 512 + 64] = (bf16_t)f2bf(hi);
            const float nr = ar * hr - ai * hi + xr[k], ni = ar * hi + ai * hr + xi[k]; hr = nr; hi = ni; } }
    }
}
typedef short s16x4 __attribute__((ext_vector_type(4)));
__device__ __forceinline__ s16x4 lds_tr(const LAS unsigned char* p) { return __builtin_bit_cast(s16x4, __builtin_amdgcn_ds_read_tr16_b64_v4i16((LAS s16x4*)p)); }
__device__ __forceinline__ bf16x8 frag_tr(const LAS unsigned char* img, int rs, int kbase, int colbase, int lane) {
    const LAS unsigned char* a = img + (kbase + 8 * (lane >> 4) + ((lane & 15) >> 2)) * rs + (colbase + 4 * (lane & 3)) * 2;
    const s16x4 lo = lds_tr(a), hi = lds_tr(a + 4 * rs);
    return (bf16x8){lo[0], lo[1], lo[2], lo[3], hi[0], hi[1], hi[2], hi[3]};
}
__device__ __forceinline__ bf16x8 frag_row(const LAS unsigned char* img, int rs, int rowbase, int kbase, int lane) {
    return *(const LAS bf16x8*)(img + (rowbase + (lane & 15)) * rs + (kbase + 8 * (lane >> 4)) * 2);
}
constexpr int SD_RS = 272;
constexpr int SD_XRS = 144;
constexpr int SD_OFF_C = 0, SD_OFF_B = 34816, SD_OFF_X = 69632, SD_OFF_M = 88064, SD_OFF_SC = 122880;
constexpr int SD_OFF_HF = SD_OFF_B, SD_OFF_HB = SD_OFF_B + 17408;
constexpr size_t WS_STB = WS_YSSD;
constexpr size_t WS_CDEC = WS_DEC + (size_t)MP * 64 + 256;
constexpr size_t WS_SSQB = WS_CDEC + (size_t)BATCH * 33 * 16 * 4;
constexpr size_t WS_BAR = (WS_SSQB + (size_t)MP * 4 + 255) / 256 * 256;
static_assert(WS_BAR + 3456 * 4 <= 7 * QB, "small region");
static_assert((size_t)BATCH * 2 * 8 * 32 * 8192 * 2 <= 4 * QB, "chunk states fit the yssd slot");

struct SsdUnit { int b, ck, t0, ns; };
__device__ __forceinline__ bool ssd_unit(int bid, int round, SsdUnit& u) {
    if (round == 0) { u.b = bid >> 5; u.ck = 1 + (bid & 31); u.t0 = NMETA + 128 * (u.ck - 1); u.ns = 8; return true; }
    if (round == 1 && bid < BATCH) { u.b = bid; u.ck = 0; u.t0 = 0; u.ns = 1; return true; }
    return false;
}
__device__ __forceinline__ void ssd_load_img(LAS unsigned char* img, int rs, const bf16_t* src, int ld, size_t m0, int col0, int ncol, int ns, int tid) {
    const int cpr = ncol / 8, nrow = ns == 1 ? 32 : 128;
    for (int i = tid; i < nrow * cpr; i += NTHREADS) {
        const int r = i / cpr, cc = i - r * cpr; u32x4 v = (u32x4){0u, 0u, 0u, 0u};
        if (r < 16 * ns) v = *(const u32x4*)(src + (m0 + r) * ld + col0 + cc * 8);
        *(LAS u32x4*)(img + r * rs + cc * 16) = v;
    }
}
__device__ __forceinline__ void ssd_scalars(LAS float* sc, const float* dt, const float* al, size_t m0, int head, int ns, int lane, float& totf, float& totb) {
    const int Q = 16 * ns;
    float a0f = 0.f, a1f = 0.f, a0b = 0.f, a1b = 0.f, d0f = 0.f, d1f = 0.f, d0b = 0.f, d1b = 0.f;
    const int s0 = 2 * lane, s1 = 2 * lane + 1;
    if (s0 < Q) { a0f = al[(m0 + s0) * 16 + head]; a0b = al[(m0 + s0) * 16 + 8 + head]; d0f = dt[(m0 + s0) * 16 + head]; d0b = dt[(m0 + s0) * 16 + 8 + head]; }
    if (s1 < Q) { a1f = al[(m0 + s1) * 16 + head]; a1b = al[(m0 + s1) * 16 + 8 + head]; d1f = dt[(m0 + s1) * 16 + head]; d1b = dt[(m0 + s1) * 16 + 8 + head]; }
    float pf = a0f + a1f, pb = a0b + a1b;
#pragma unroll
    for (int o = 1; o < 64; o <<= 1) { const float tf = __shfl_up(pf, o), tb = __shfl_up(pb, o); if (lane >= o) { pf += tf; pb += tb; } }
    totf = __shfl(pf, 63); totb = __shfl(pb, 63);
    const float af1 = pf, af0 = pf - a1f;
    const float eb0 = pb - a0b - a1b, eb1 = pb - a1b;
    sc[s0] = af0; sc[s1] = af1; sc[128 + s0] = eb0; sc[128 + s1] = eb1; sc[256 + s0] = d0f; sc[256 + s1] = d1f; sc[384 + s0] = d0b; sc[384 + s1] = d1b;
    sc[512 + s0] = __expf(totf - af0) * d0f; sc[512 + s1] = __expf(totf - af1) * d1f;
    sc[640 + s0] = __expf(eb0) * d0b; sc[640 + s1] = __expf(eb1) * d1b;
    sc[768 + s0] = __expf(af0); sc[768 + s1] = __expf(af1);
    sc[896 + s0] = __expf(totb - eb0); sc[896 + s1] = __expf(totb - eb1);
}

__device__ __forceinline__ void ssd_states(const Ctx& cx_, int l) {
    const Ctx c = relaunder(cx_);
    const int tid = c.tid, lane = c.lane, wave = c.wave;
    const bf16_t* bc = (const bf16_t*)(c.ws + WS_BC); const bf16_t* xs = (const bf16_t*)(c.ws + WS_XS);
    const float* dt = (const float*)(c.ws + WS_DT); const float* al = (const float*)(c.ws + WS_DEC);
    bf16_t* stb = (bf16_t*)(c.ws + WS_STB); float* cdec = (float*)(c.ws + WS_CDEC);
    LAS unsigned char* Bimg = c.lds + SD_OFF_B; LAS unsigned char* Ximg = c.lds + SD_OFF_X; LAS float* sc = (LAS float*)(c.lds + SD_OFF_SC);
    for (int round = 0; round < 2; ++round) {
        SsdUnit u; if (!ssd_unit(c.bid, round, u)) break;
        const size_t m0 = (size_t)u.b * LEN + u.t0; const int nks = u.ns == 1 ? 1 : 4;
        for (int g = 0; g < 2; ++g) {
            __syncthreads();
            ssd_load_img(Bimg, SD_RS, bc, 512, m0, g * 128, 128, u.ns, tid);
            for (int j = 0; j < 4; ++j) {
                const int head = g * 4 + j;
                if (j) __syncthreads();
                ssd_load_img(Ximg, SD_XRS, xs, 512, m0, head * 64, 64, u.ns, tid);
                if (wave == 0) { float totf, totb; ssd_scalars(sc, dt, al, m0, head, u.ns, lane, totf, totb);
                    if (lane == 0) { cdec[((size_t)u.b * 33 + u.ck) * 16 + head] = __expf(totf); cdec[((size_t)u.b * 33 + u.ck) * 16 + 8 + head] = __expf(totb); } }
                __syncthreads();
                f32x4 accf[4], accb[4];
#pragma unroll
                for (int pt = 0; pt < 4; ++pt) { accf[pt] = (f32x4){0.f, 0.f, 0.f, 0.f}; accb[pt] = accf[pt]; }
                for (int ks = 0; ks < nks; ++ks) {
                    const bf16x8 af = frag_tr(Bimg, SD_RS, 32 * ks, 16 * wave, lane);
                    const int k0 = 32 * ks + 8 * (lane >> 4);
                    const f32x4 wf0 = *(const LAS f32x4*)(sc + 512 + k0), wf1 = *(const LAS f32x4*)(sc + 512 + k0 + 4), wb0 = *(const LAS f32x4*)(sc + 640 + k0), wb1 = *(const LAS f32x4*)(sc + 640 + k0 + 4);
#pragma unroll
                    for (int pt = 0; pt < 4; ++pt) {
                        const bf16x8 xr = frag_tr(Ximg, SD_XRS, 32 * ks, 16 * pt, lane);
                        float xf[8];
#pragma unroll
                        for (int e = 0; e < 8; ++e) xf[e] = bf1((bf16_t)xr[e]);
                        bf16x8 bfv, bbv;
                        { const unsigned p0 = pk2(xf[0] * wf0.x, xf[1] * wf0.y), p1 = pk2(xf[2] * wf0.z, xf[3] * wf0.w), p2 = pk2(xf[4] * wf1.x, xf[5] * wf1.y), p3 = pk2(xf[6] * wf1.z, xf[7] * wf1.w);
                          bfv = __builtin_bit_cast(bf16x8, (u32x4){p0, p1, p2, p3}); }
                        { const unsigned p0 = pk2(xf[0] * wb0.x, xf[1] * wb0.y), p1 = pk2(xf[2] * wb0.z, xf[3] * wb0.w), p2 = pk2(xf[4] * wb1.x, xf[5] * wb1.y), p3 = pk2(xf[6] * wb1.z, xf[7] * wb1.w);
                          bbv = __builtin_bit_cast(bf16x8, (u32x4){p0, p1, p2, p3}); }
                        accf[pt] = __builtin_amdgcn_mfma_f32_16x16x32_bf16(af, bfv, accf[pt], 0, 0, 0);
                        accb[pt] = __builtin_amdgcn_mfma_f32_16x16x32_bf16(af, bbv, accb[pt], 0, 0, 0);
                    }
                }
#pragma unroll
                for (int pt = 0; pt < 4; ++pt) {
                    const int p = 16 * pt + (lane & 15), n0 = 16 * wave + 4 * (lane >> 4);
                    if (u.ck <= 31) { bf16_t* d = stb + ((((size_t)u.b * 2 + 0) * 8 + head) * 32 + u.ck) * 8192 + (size_t)p * 128 + n0; *(u32x2*)d = (u32x2){pk2(accf[pt][0], accf[pt][1]), pk2(accf[pt][2], accf[pt][3])}; }
                    if (u.ck >= 1) { bf16_t* d = stb + ((((size_t)u.b * 2 + 1) * 8 + head) * 32 + (u.ck - 1)) * 8192 + (size_t)p * 128 + n0; *(u32x2*)d = (u32x2){pk2(accb[pt][0], accb[pt][1]), pk2(accb[pt][2], accb[pt][3])}; }
                }
            }
        }
    }
    __syncthreads();
}

__device__ __forceinline__ void ssd_chunk_scan(const Ctx& cx_, int l) {
    const Ctx c = relaunder(cx_);
    bf16_t* stb = (bf16_t*)(c.ws + WS_STB); const float* cdec = (const float*)(c.ws + WS_CDEC);
    const int gt = c.bid * NTHREADS + c.tid;
    const int e8 = gt & 1023, bdh = gt >> 10;
    if (bdh >= BATCH * 16) return;
    const int head = bdh & 7, dir = (bdh >> 3) & 1, b = bdh >> 4;
    bf16_t* base = stb + (size_t)bdh * 32 * 8192 + (size_t)e8 * 8;
    float h[8] = {0.f, 0.f, 0.f, 0.f, 0.f, 0.f, 0.f, 0.f};
    for (int i0 = 0; i0 < 32; i0 += 8) {
        u32x4 v[8]; float dcy[8];
#pragma unroll
        for (int k = 0; k < 8; ++k) { const int slot = dir == 0 ? i0 + k : 31 - (i0 + k); v[k] = *(const u32x4*)(base + (size_t)slot * 8192);
            const int ck = dir == 0 ? slot : slot + 1; dcy[k] = cdec[((size_t)b * 33 + ck) * 16 + dir * 8 + head]; }
#pragma unroll
        for (int k = 0; k < 8; ++k) { const int slot = dir == 0 ? i0 + k : 31 - (i0 + k); float s[8]; unpack8(v[k], s);
#pragma unroll
            for (int e = 0; e < 8; ++e) h[e] = h[e] * dcy[k] + s[e];
            *(u32x4*)(base + (size_t)slot * 8192) = pack8(h); }
    }
}

__device__ __forceinline__ void ssd_outputs(const Ctx& cx_, int l) {
    const Ctx c = relaunder(cx_);
    const int tid = c.tid, lane = c.lane, wave = c.wave;
    const bf16_t* bc = (const bf16_t*)(c.ws + WS_BC); const bf16_t* xs = (const bf16_t*)(c.ws + WS_XS); const bf16_t* pz = (const bf16_t*)(c.ws + WS_PZ);
    const float* dt = (const float*)(c.ws + WS_DT); const float* al = (const float*)(c.ws + WS_DEC);
    const bf16_t* stb = (const bf16_t*)(c.ws + WS_STB); bf16_t* yb = (bf16_t*)(c.ws + WS_YB); float* ssqb = (float*)(c.ws + WS_SSQB);
    LAS unsigned char* Cimg = c.lds + SD_OFF_C; LAS unsigned char* Bimg = c.lds + SD_OFF_B; LAS unsigned char* Ximg = c.lds + SD_OFF_X;
    LAS unsigned char* HfT = c.lds + SD_OFF_HF; LAS unsigned char* HbT = c.lds + SD_OFF_HB;
    LAS unsigned char* Ms = c.lds + SD_OFF_M + wave * 4352; LAS float* sc = (LAS float*)(c.lds + SD_OFF_SC);
    for (int round = 0; round < 2; ++round) {
        SsdUnit u; if (!ssd_unit(c.bid, round, u)) break;
        const size_t m0 = (size_t)u.b * LEN + u.t0; const int nks = u.ns == 1 ? 1 : 4; const bool active = wave < u.ns;
        float ssrow = 0.f;
        for (int g = 0; g < 2; ++g) {
            __syncthreads();
            ssd_load_img(Cimg, SD_RS, bc, 512, m0, 256 + g * 128, 128, u.ns, tid);
            ssd_load_img(Bimg, SD_RS, bc, 512, m0, g * 128, 128, u.ns, tid);
            __syncthreads();
            f32x4 cb[8];
#pragma unroll
            for (int t = 0; t < 8; ++t) cb[t] = (f32x4){0.f, 0.f, 0.f, 0.f};
            if (active) {
#pragma unroll
                for (int ks = 0; ks < 4; ++ks) {
                    const bf16x8 cfr = frag_row(Cimg, SD_RS, 16 * wave, 32 * ks, lane);
#pragma unroll
                    for (int t = 0; t < 8; ++t) if (t < u.ns) cb[t] = __builtin_amdgcn_mfma_f32_16x16x32_bf16(frag_row(Bimg, SD_RS, 16 * t, 32 * ks, lane), cfr, cb[t], 0, 0, 0);
                }
            }
            for (int j = 0; j < 4; ++j) {
                const int head = g * 4 + j;
                __syncthreads();
                ssd_load_img(Ximg, SD_XRS, xs, 512, m0, head * 64, 64, u.ns, tid);
                {
                    const bf16_t* hf = u.ck >= 1 ? stb + ((((size_t)u.b * 2 + 0) * 8 + head) * 32 + (u.ck - 1)) * 8192 : nullptr;
                    const bf16_t* hb = u.ck <= 31 ? stb + ((((size_t)u.b * 2 + 1) * 8 + head) * 32 + u.ck) * 8192 : nullptr;
                    for (int i = tid; i < 64 * 16; i += NTHREADS) { const int p = i >> 4, cc = i & 15;
                        *(LAS u32x4*)(HfT + p * SD_RS + cc * 16) = hf ? *(const u32x4*)(hf + p * 128 + cc * 8) : (u32x4){0u, 0u, 0u, 0u};
                        *(LAS u32x4*)(HbT + p * SD_RS + cc * 16) = hb ? *(const u32x4*)(hb + p * 128 + cc * 8) : (u32x4){0u, 0u, 0u, 0u}; }
                }
                if (wave == 0) { float totf, totb; ssd_scalars(sc, dt, al, m0, head, u.ns, lane, totf, totb); }
                __syncthreads();
                if (active) {
                    const int ll = 16 * wave + (lane & 15); const float afl = sc[ll], ebl = sc[128 + ll];
#pragma unroll
                    for (int t = 0; t < 8; ++t) {
                        u32x2 w2 = (u32x2){0u, 0u};
                        if (t < u.ns) {
                            const int s0 = 16 * t + 4 * (lane >> 4);
                            const f32x4 afs = *(const LAS f32x4*)(sc + s0), ebs = *(const LAS f32x4*)(sc + 128 + s0), dfs = *(const LAS f32x4*)(sc + 256 + s0), dbs = *(const LAS f32x4*)(sc + 384 + s0);
                            float mv[4];
#pragma unroll
                            for (int r = 0; r < 4; ++r) { const int s = s0 + r; float wgt = 0.f; if (s <= ll) wgt += __expf(afl - afs[r]) * dfs[r]; if (s >= ll) wgt += __expf(ebs[r] - ebl) * dbs[r]; mv[r] = cb[t][r] * wgt; }
                            w2 = (u32x2){pk2(mv[0], mv[1]), pk2(mv[2], mv[3])};
                        }
                        if (t < 2 * nks) *(LAS u32x2*)(Ms + (lane & 15) * SD_RS + (16 * t + 4 * (lane >> 4)) * 2) = w2;
                    }
                    f32x4 ay[4], ahf[4], ahb[4];
#pragma unroll
                    for (int pt = 0; pt < 4; ++pt) { ay[pt] = (f32x4){0.f, 0.f, 0.f, 0.f}; ahf[pt] = ay[pt]; ahb[pt] = ay[pt]; }
                    for (int ks = 0; ks < nks; ++ks) {
                        const bf16x8 mf = frag_row(Ms, SD_RS, 0, 32 * ks, lane);
#pragma unroll
                        for (int pt = 0; pt < 4; ++pt) ay[pt] = __builtin_amdgcn_mfma_f32_16x16x32_bf16(mf, frag_tr(Ximg, SD_XRS, 32 * ks, 16 * pt, lane), ay[pt], 0, 0, 0);
                    }
#pragma unroll
                    for (int ks = 0; ks < 4; ++ks) {
                        const bf16x8 cfr = frag_row(Cimg, SD_RS, 16 * wave, 32 * ks, lane);
#pragma unroll
                        for (int pt = 0; pt < 4; ++pt) {
                            ahf[pt] = __builtin_amdgcn_mfma_f32_16x16x32_bf16(cfr, frag_row(HfT, SD_RS, 16 * pt, 32 * ks, lane), ahf[pt], 0, 0, 0);
                            ahb[pt] = __builtin_amdgcn_mfma_f32_16x16x32_bf16(cfr, frag_row(HbT, SD_RS, 16 * pt, 32 * ks, lane), ahb[pt], 0, 0, 0);
                        }
                    }
                    const int l0 = 16 * wave + 4 * (lane >> 4);
                    const f32x4 efv = *(const LAS f32x4*)(sc + 768 + l0), ebv = *(const LAS f32x4*)(sc + 896 + l0);
                    LAS float* ys = (LAS float*)Ms;
#pragma unroll
                    for (int pt = 0; pt < 4; ++pt)
#pragma unroll
                        for (int r = 0; r < 4; ++r) ys[(4 * (lane >> 4) + r) * 68 + 16 * pt + (lane & 15)] = ay[pt][r] + efv[r] * ahf[pt][r] + ebv[r] * ahb[pt][r];
                    const int rr = lane >> 2, p0 = 16 * (lane & 3); const size_t m = m0 + 16 * wave + rr;
                    const float dsk = c.in[I_SSDD][l * 8 + head];
                    float xv[16], zv[16];
                    { float t8[8]; unpack8(*(const LAS u32x4*)(Ximg + (16 * wave + rr) * SD_XRS + p0 * 2), t8);
#pragma unroll
                      for (int e = 0; e < 8; ++e) xv[e] = t8[e];
                      unpack8(*(const LAS u32x4*)(Ximg + (16 * wave + rr) * SD_XRS + p0 * 2 + 16), t8);
#pragma unroll
                      for (int e = 0; e < 8; ++e) xv[8 + e] = t8[e];
                      unpack8(*(const u32x4*)(pz + m * 512 + head * 64 + p0), t8);
#pragma unroll
                      for (int e = 0; e < 8; ++e) zv[e] = t8[e];
                      unpack8(*(const u32x4*)(pz + m * 512 + head * 64 + p0 + 8), t8);
#pragma unroll
                      for (int e = 0; e < 8; ++e) zv[8 + e] = t8[e]; }
                    float o[16];
#pragma unroll
                    for (int e4 = 0; e4 < 4; ++e4) { const f32x4 yv = *(const LAS f32x4*)(ys + rr * 68 + p0 + 4 * e4);
#pragma unroll
                        for (int e = 0; e < 4; ++e) { const float val = (yv[e] + dsk * xv[4 * e4 + e]) * siluf_(zv[4 * e4 + e]); o[4 * e4 + e] = val; ssrow += val * val; } }
                    u32x4 w0, w1; w0.x = pk2(o[0], o[1]); w0.y = pk2(o[2], o[3]); w0.z = pk2(o[4], o[5]); w0.w = pk2(o[6], o[7]); w1.x = pk2(o[8], o[9]); w1.y = pk2(o[10], o[11]); w1.z = pk2(o[12], o[13]); w1.w = pk2(o[14], o[15]);
                    *(u32x4*)(yb + m * 512 + head * 64 + p0) = w0; *(u32x4*)(yb + m * 512 + head * 64 + p0 + 8) = w1;
                }
            }
        }
        if (active) { ssrow += dpp_mov<0xB1>(ssrow); ssrow += dpp_mov<0x4E>(ssrow); if ((lane & 3) == 0) ssqb[m0 + 16 * wave + (lane >> 2)] = ssrow; }
    }
    __syncthreads();
}
constexpr int RW_T = 32, RW_NC = (LEN + RW_T - 1) / RW_T, RW_BUF = 45056;
__device__ __forceinline__ void rwkv_scan(const Ctx& cx_, int l) {
    const Ctx c = relaunder(cx_);
    const int bid = c.bid, q = bid & 3, dir = (bid >> 2) & 1, head = (bid >> 3) & 3, b = bid >> 5;
    const int tid = c.tid, lane = c.lane, wave = c.wave;
    const bf16_t* rk = (const bf16_t*)(c.dout + DO_RKVP); const bf16_t* l2 = (const bf16_t*)(c.ws + WS_L2O);
    bf16_t* yo = (bf16_t*)(c.ws + WS_YRW) + (size_t)dir * MP * 256;
    const bool producer = wave >= 4;
    const int pt = tid - 256, pstep = pt >> 3, pc0 = (pt & 7) * 8, pv0 = 2 * (pt & 7);
    float ka[8];
    u32x4 R, K, KK, DL, AS; unsigned V2 = 0; R = K = KK = DL = AS = (u32x4){0u, 0u, 0u, 0u};
    if (producer) {
#pragma unroll
        for (int e = 0; e < 8; ++e) ka[e] = c.in[I_KA][(size_t)l * 256 + head * 64 + pc0 + e];
    }
    auto tok = [&](int s) -> size_t { const int t = dir ? LEN - 1 - s : s; return (size_t)b * LEN + t; };
#define RW_LOAD(chunk) do { const int s_ = (chunk) * RW_T + pstep; if (s_ < LEN) { const size_t m_ = tok(s_); const bf16_t* rp_ = rk + m_ * 1024 + head * 64; const bf16_t* lp_ = l2 + m_ * 1280 + dir * 256 + head * 64; \
        R = *(const u32x4*)(rp_ + pc0); K = *(const u32x4*)(rp_ + 256 + pc0); KK = *(const u32x4*)(rp_ + 768 + pc0); V2 = *(const unsigned*)(rp_ + 512 + 16 * q + pv0); \
        DL = *(const u32x4*)(lp_ + pc0); AS = *(const u32x4*)(lp_ + 512 + pc0); } } while (0)
#define RW_WRITE(buf) do { LAS float* vec_ = (LAS float*)(c.lds + (buf) * RW_BUF); float r_[8], k_[8], kk_[8], dl_[8], as_[8]; unpack8(R, r_); unpack8(K, k_); unpack8(KK, kk_); unpack8(DL, dl_); unpack8(AS, as_); \
        float w_[8], a_[8], b_[8], kd_[8]; _Pragma("unroll") for (int e = 0; e < 8; ++e) { w_[e] = __expf(dl_[e]); a_[e] = -kk_[e]; b_[e] = kk_[e] * as_[e]; kd_[e] = k_[e] * (1.f + (as_[e] - 1.f) * ka[e]); } \
        LAS float* bp_ = vec_ + pstep * 320 + pc0; \
        *(LAS f32x4*)(bp_) = (f32x4){w_[0], w_[1], w_[2], w_[3]}; *(LAS f32x4*)(bp_ + 4) = (f32x4){w_[4], w_[5], w_[6], w_[7]}; \
        *(LAS f32x4*)(bp_ + 64) = (f32x4){a_[0], a_[1], a_[2], a_[3]}; *(LAS f32x4*)(bp_ + 68) = (f32x4){a_[4], a_[5], a_[6], a_[7]}; \
        *(LAS f32x4*)(bp_ + 128) = (f32x4){b_[0], b_[1], b_[2], b_[3]}; *(LAS f32x4*)(bp_ + 132) = (f32x4){b_[4], b_[5], b_[6], b_[7]}; \
        *(LAS f32x4*)(bp_ + 192) = (f32x4){kd_[0], kd_[1], kd_[2], kd_[3]}; *(LAS f32x4*)(bp_ + 196) = (f32x4){kd_[4], kd_[5], kd_[6], kd_[7]}; \
        *(LAS f32x4*)(bp_ + 256) = (f32x4){r_[0], r_[1], r_[2], r_[3]}; *(LAS f32x4*)(bp_ + 260) = (f32x4){r_[4], r_[5], r_[6], r_[7]}; \
        LAS float* vr_ = vec_ + 10240 + pstep * 16 + pv0; vr_[0] = bflo(V2); vr_[1] = bfhi(V2); } while (0)
#define RW_FLUSH(chunk) do { const int s_ = (chunk) * RW_T + pstep; if (s_ < LEN) { const LAS float* yy_ = (const LAS float*)(c.lds + ((chunk) & 1) * RW_BUF) + 10752 + pstep * 16 + pv0; \
        *(unsigned*)(yo + tok(s_) * 256 + head * 64 + 16 * q + pv0) = pk2(yy_[0], yy_[1]); } } while (0)
    if (producer) { RW_LOAD(0); RW_WRITE(0); RW_LOAD(1); }
    __syncthreads();
    const int rowl = (wave & 3) * 4 + (lane >> 4), j4 = (lane & 15) * 4;
    float S0 = 0.f, S1 = 0.f, S2 = 0.f, S3 = 0.f;
#define RW_SCAN(NS) do { float yv_[NS]; \
        _Pragma("unroll") for (int st = 0; st < NS; ++st) { \
            const LAS float* bp = vec + st * 320 + j4; \
            const f32x4 w = *(const LAS f32x4*)(bp), a = *(const LAS f32x4*)(bp + 64), bb = *(const LAS f32x4*)(bp + 128), kd = *(const LAS f32x4*)(bp + 192), r = *(const LAS f32x4*)(bp + 256); \
            const float v = vec[10240 + st * 16 + rowl]; \
            float sa = (S0 * a.x + S1 * a.y) + (S2 * a.z + S3 * a.w); \
            sa = allred16(sa); \
            S0 = S0 * w.x + v * kd.x; S1 = S1 * w.y + v * kd.y; S2 = S2 * w.z + v * kd.z; S3 = S3 * w.w + v * kd.w; \
            S0 += sa * bb.x; S1 += sa * bb.y; S2 += sa * bb.z; S3 += sa * bb.w; \
            float y = (S0 * r.x + S1 * r.y) + (S2 * r.z + S3 * r.w); \
            yv_[st] = allred16(y); } \
        if ((lane & 15) == 0) { _Pragma("unroll") for (int st = 0; st < NS; ++st) yy[st * 16 + rowl] = yv_[st]; } } while (0)
    for (int ch = 0; ch < RW_NC; ++ch) {
        if (!producer) {
            const LAS float* vec = (const LAS float*)(c.lds + (ch & 1) * RW_BUF);
            LAS float* yy = (LAS float*)(c.lds + (ch & 1) * RW_BUF) + 10752;
            if (ch < RW_NC - 1) RW_SCAN(32); else RW_SCAN(LEN - (RW_NC - 1) * RW_T);
        } else {
            if (ch + 1 < RW_NC) RW_WRITE((ch + 1) & 1);
            if (ch + 2 < RW_NC) RW_LOAD(ch + 2);
            if (ch >= 1) RW_FLUSH(ch - 1);
        }
        __syncthreads();
    }
#undef RW_SCAN
    if (producer) RW_FLUSH(RW_NC - 1);
    __syncthreads();
#undef RW_LOAD
#undef RW_WRITE
#undef RW_FLUSH
}

__device__ __forceinline__ void rwkv_post(const Ctx& cx_, int l) {
    const Ctx c = relaunder(cx_);
    const int gw = c.bid * NWAVES + c.wave, NGW = c.G * NWAVES, lane = c.lane, c0 = 4 * lane;
    const bf16_t* y0 = (const bf16_t*)(c.ws + WS_YRW); const bf16_t* y1 = y0 + (size_t)MP * 256;
    const bf16_t* rk = (const bf16_t*)(c.dout + DO_RKVP); const bf16_t* l2 = (const bf16_t*)(c.ws + WS_L2O); bf16_t* yc = (bf16_t*)(c.ws + WS_YC);
    float lw[4], lb[4], rkw[4];
#pragma unroll
    for (int e = 0; e < 4; ++e) { lw[e] = c.in[I_LNW][(size_t)l * 256 + c0 + e]; lb[e] = c.in[I_LNB][(size_t)l * 256 + c0 + e]; rkw[e] = c.in[I_RK][(size_t)l * 256 + c0 + e]; }
    for (int m = gw; m < M_ROWS; m += NGW) {
        const u32x2 a = *(const u32x2*)(y0 + (size_t)m * 256 + c0), bq = *(const u32x2*)(y1 + (size_t)m * 256 + c0);
        const u32x2 rr = *(const u32x2*)(rk + (size_t)m * 1024 + c0), kk = *(const u32x2*)(rk + (size_t)m * 1024 + 256 + c0), vv = *(const u32x2*)(rk + (size_t)m * 1024 + 512 + c0);
        const u32x2 gg = *(const u32x2*)(l2 + (size_t)m * 1280 + 1024 + c0);
        float y[4] = {bflo(a.x) + bflo(bq.x), bfhi(a.x) + bfhi(bq.x), bflo(a.y) + bflo(bq.y), bfhi(a.y) + bfhi(bq.y)};
        const float r[4] = {bflo(rr.x), bfhi(rr.x), bflo(rr.y), bfhi(rr.y)}, k[4] = {bflo(kk.x), bfhi(kk.x), bflo(kk.y), bfhi(kk.y)};
        const float v[4] = {bflo(vv.x), bfhi(vv.x), bflo(vv.y), bfhi(vv.y)}, g[4] = {bflo(gg.x), bfhi(gg.x), bflo(gg.y), bfhi(gg.y)};
        const float mean = sum16((y[0] + y[1]) + (y[2] + y[3])) * (1.f / 64.f);
        float q = 0.f, bo = 0.f;
#pragma unroll
        for (int e = 0; e < 4; ++e) { y[e] -= mean; q += y[e] * y[e]; bo += r[e] * k[e] * rkw[e]; }
        q = sum16(q) * (1.f / 64.f); bo = sum16(bo);
        const float rs = __builtin_amdgcn_rsqf(q + 64e-5f);
        float o[4];
#pragma unroll
        for (int e = 0; e < 4; ++e) o[e] = (y[e] * rs * lw[e] + lb[e] + bo * v[e]) * g[e];
        *(u32x2*)(yc + (size_t)m * 256 + c0) = (u32x2){pk2(o[0], o[1]), pk2(o[2], o[3])};
    }
}
__device__ __forceinline__ void final_phase(const Ctx& cx_, float* out) {
    const Ctx c = relaunder(cx_);
    const int gw = c.bid * NWAVES + c.wave, NGW = c.G * NWAVES, lane = c.lane;
    const bf16_t* H = c.H(); const f32x4* fw = (const f32x4*)c.in[I_FNW];
    for (int r = gw; r < BATCH * SEQ; r += NGW) {
        const int b = r / SEQ, tq = r - b * SEQ; const size_t m = (size_t)b * LEN + NMETA + tq;
        const u32x2* hp = (const u32x2*)(H + m * DM);
        float v[4][4], ss = 0.f;
#pragma unroll
        for (int i = 0; i < 4; ++i) { const u32x2 w = hp[lane + 64 * i]; v[i][0] = bflo(w.x); v[i][1] = bfhi(w.x); v[i][2] = bflo(w.y); v[i][3] = bfhi(w.y); ss += (v[i][0] * v[i][0] + v[i][1] * v[i][1]) + (v[i][2] * v[i][2] + v[i][3] * v[i][3]); }
        ss = wave_sum(ss); const float s = __builtin_amdgcn_rsqf(ss * (1.0f / DM) + EPS);
        f32x4* op = (f32x4*)(out + (size_t)r * DM);
#pragma unroll
        for (int i = 0; i < 4; ++i) { const f32x4 w = fw[lane + 64 * i]; op[lane + 64 * i] = (f32x4){v[i][0] * s * w.x, v[i][1] * s * w.y, v[i][2] * s * w.z, v[i][3] * s * w.w}; }
    }
}

constexpr int LDS_BYTES = 147456;
#ifndef PHMASK
#define PHMASK 0xFFFFF
#endif
__global__ void __launch_bounds__(NTHREADS, 2) mega_fwd(Params p) {
    extern __shared__ __attribute__((aligned(16))) unsigned char lds_raw[];
    cg::grid_group grid = cg::this_grid();
    Ctx c; c.in = p.in; c.ws = p.ws; c.dout = (unsigned char*)p.out; c.lds = (LAS unsigned char*)lds_raw;
    c.tid = threadIdx.x; c.lane = c.tid & 63; c.wave = __builtin_amdgcn_readfirstlane(c.tid >> 6); c.G = gridDim.x; c.bid = blockIdx.x;
    const int G = c.G, bid = c.bid;
#ifdef PROF_A
#ifndef PROF_SHIFT
#define PROF_SHIFT 1.0f
#endif
#define PROF_PTR ((unsigned long long*)(c.ws + WS_DEC + (size_t)MP * 64))
    if (blockIdx.x == 0 && threadIdx.x == 0) { for (int k = 0; k < 15; ++k) PROF_PTR[k] = 0; PROF_PTR[15] = __builtin_amdgcn_s_memrealtime(); }
#define STAMP(k) do { if (blockIdx.x == 0 && threadIdx.x == 0) { const unsigned long long t_ = __builtin_amdgcn_s_memrealtime(); PROF_PTR[k] += t_ - PROF_PTR[15]; PROF_PTR[15] = t_; } } while (0)
#else
#define STAMP(k) do { } while (0)
#endif
    unsigned* barw = (unsigned*)(c.ws + WS_BAR);
    volatile LAS unsigned* bst = (volatile LAS unsigned*)(c.lds + LDS_BYTES - 64);
    if (bid == 0) for (int i = threadIdx.x; i < XCD_BAR_WORDS; i += NTHREADS) barw[i] = 0u;
    if (threadIdx.x < 2) bst[threadIdx.x] = 0u;
    __syncthreads();
    if (PHMASK & 1) phase0(c);
    grid.sync(); STAMP(0);
    const XcdBarrier xbar = xcd_barrier_post(barw, bst);
#define GRID_BAR() xcd_barrier(xbar)
#pragma unroll 1
    for (int l = 0; l < DEPTH; ++l) {
        bf16_t* wb = c.wb(l);
        if (PHMASK & 2) dt_job(c, l);
        if (PHMASK & 4) { SchedPlain S{c.H(), wb + WB_IN, DM, DM, DM, MP / 256, 11, G, bid};
          EpiInProj E{c.ssq(), (bf16_t*)(c.ws + WS_UH), (bf16_t*)(c.ws + WS_PZ), (bf16_t*)(c.ws + WS_PXBC), (bf16_t*)(c.ws + WS_PRKVX)};
          pg8::gemm_phase(c.lds, S, E); }
        GRID_BAR(); STAMP(1);
        if (PHMASK & 8) { SchedS5 S{(const bf16_t*)(c.ws + WS_UH), wb + WB_SX, 256, G, bid}; EpiS5X E{(float*)(c.ws + WS_X)}; pg8::gemm_phase(c.lds, S, E); }
        if (PHMASK & 16) rwkv_prep(c, l);
        if (PHMASK & 32) ssd_prep(c, l);
        GRID_BAR(); STAMP(2);
        if (PHMASK & 64) s5_scan(c, l);
        if (PHMASK & 4096) ssd_states(c, l);
        if (PHMASK & 128) { SchedPlain S{(const bf16_t*)(c.ws + WS_L1IN), wb + WB_L1, 512, 512, 512, MP / 256, 2, G, bid}; EpiL1 E{(bf16_t*)(c.ws + WS_L1O)}; pg8::gemm_phase(c.lds, S, E); }
        GRID_BAR(); STAMP(3);
        ssd_chunk_scan(c, l);
        if (PHMASK & 256) { SchedL2 S{(const bf16_t*)(c.ws + WS_L1O), wb + WB_L2, G, bid}; EpiL2 E{(bf16_t*)(c.ws + WS_L2O), c.in[I_W0] + (size_t)l * 512, c.in[I_A0] + (size_t)l * 512}; pg8::gemm_phase(c.lds, S, E); }
        if (PHMASK & 512) { SchedS5 S{(const bf16_t*)(c.ws + WS_UH), wb + WB_SY, 512, G, bid}; EpiS5Y E{(bf16_t*)(c.ws + WS_YAPRE)}; pg8::gemm_phase(c.lds, S, E); }
        GRID_BAR(); STAMP(4);
        if (PHMASK & 1024) rwkv_scan(c, l);
        STAMP(5);
        if (PHMASK & 2048) ssd_outputs(c, l);
        GRID_BAR(); STAMP(6);
        if (PHMASK & 8192) rwkv_post(c, l);
        if (PHMASK & 16384) { SchedPlain S{(const bf16_t*)(c.ws + WS_YAPRE), wb + WB_GLU, 256, 256, 256, MP / 256, 2, G, bid}; EpiGLU E{(bf16_t*)(c.ws + WS_YA), c.in[I_GLUB] + (size_t)l * 512}; pg8::gemm_phase(c.lds, S, E); }
        GRID_BAR(); STAMP(7);
        if (PHMASK & 32768) { SchedProj S{c.H(), wb + WB_G, wb + WB_P, (const bf16_t*)(c.ws + WS_YA), (const bf16_t*)(c.ws + WS_YB), (const bf16_t*)(c.ws + WS_YC), G, bid};
          EpiProj E{c.ssq(), (const float*)(c.ws + WS_SSQB), c.ws + WS_PARK + (size_t)bid * 393216, (bf16_t*)(c.dout + DO_MERGED), opaque_tid()}; pg8::gemm_phase(c.lds, S, E); }
        GRID_BAR(); STAMP(8);
        if (PHMASK & 65536) { SchedPlain S{(const bf16_t*)(c.dout + DO_MERGED), wb + WB_O, DM, DM, DM, MP / 256, 4, G, bid}; EpiResid E{c.H(), c.ssq()}; pg8::gemm_phase(c.lds, S, E); }
        GRID_BAR(); STAMP(9);
        if (PHMASK & 131072) { SchedPlain S{c.H(), wb + WB_1, DM, DM, DM, MP / 256, 16, G, bid}; EpiUp E{c.ssq(), (bf16_t*)(c.ws + WS_ACT)}; pg8::gemm_phase(c.lds, S, E); }
        GRID_BAR(); STAMP(10);
        if (PHMASK & 262144) { SchedPlain S{(const bf16_t*)(c.ws + WS_ACT), wb + WB_2, DFF, DFF, DFF, MP / 256, 4, G, bid}; EpiResid E{c.H(), c.ssq()}; pg8::gemm_phase(c.lds, S, E); }
        GRID_BAR(); STAMP(11);
    }
    if (PHMASK & 524288) final_phase(c, p.out);
#ifdef PROF_A
    GRID_BAR(); STAMP(12);
    if (blockIdx.x == 0) {
        __syncthreads();
        float va = (float)(__hip_atomic_load(&PROF_PTR[PROF_A], __ATOMIC_RELAXED, __HIP_MEMORY_SCOPE_AGENT)) * 0.01f, vb = (float)(__hip_atomic_load(&PROF_PTR[PROF_B], __ATOMIC_RELAXED, __HIP_MEMORY_SCOPE_AGENT)) * 0.01f;
        va = exp2f(rintf(log2f(va * PROF_SHIFT) * 2.f) * 0.5f); vb = exp2f(rintf(log2f(vb * PROF_SHIFT) * 2.f) * 0.5f);
        for (int i = threadIdx.x; i < (1 << 20); i += NTHREADS) p.out[1 + i] = vb;
        if (threadIdx.x == 0) p.out[0] = 100.f * va;
    }
#endif
}

extern "C" void kernel_launch(void* const* d_in, const int* in_sizes, int n_in, void* d_out, int out_size, void* d_ws, size_t ws_size, hipStream_t stream) {
    static int grid = 0;
    if (grid == 0) {
        int dev = 0, cus = 0, per_cu = 0;
        if (n_in != N_INPUTS || out_size != BATCH * SEQ * DM || ws_size < WS_END) { fprintf(stderr, "kernel_launch: unexpected shapes (n_in %d out %d ws %zu)\n", n_in, out_size, ws_size); grid = -1; return; }
        (void)hipGetDevice(&dev); (void)hipDeviceGetAttribute(&cus, hipDeviceAttributeMultiprocessorCount, dev);
        (void)hipFuncSetAttribute((const void*)mega_fwd, hipFuncAttributeMaxDynamicSharedMemorySize, LDS_BYTES);
        (void)hipOccupancyMaxActiveBlocksPerMultiprocessor(&per_cu, (const void*)mega_fwd, NTHREADS, LDS_BYTES);
        if (per_cu < 1) { fprintf(stderr, "kernel_launch: occupancy query says %d blocks per CU\n", per_cu); per_cu = 1; }
        grid = cus * 1;
        if (grid != 256) fprintf(stderr, "kernel_launch: %d CUs (the scan phases are laid out for 256 workgroups)\n", grid);
    }
    if (grid < 0) return;
    Params p{};
    for (int i = 0; i < N_INPUTS; ++i) p.in[i] = (const float*)d_in[i];
    p.out = (float*)d_out; p.ws = (unsigned char*)d_ws; p.ph_lo = 0; p.ph_hi = 0;
    void* args[] = {&p};
    hipError_t e = hipLaunchCooperativeKernel((const void*)mega_fwd, dim3(grid), dim3(NTHREADS), args, LDS_BYTES, stream);
    if (e != hipSuccess) fprintf(stderr, "cooperative launch failed: %s (grid %d)\n", hipGetErrorString(e), grid);
}
```

```cpp
#include <hip/hip_runtime.h>
#include <hip/hip_cooperative_groups.h>
#include <cstdio>
#include <cstdint>
namespace cg = cooperative_groups;

#define LAS __attribute__((address_space(3)))
typedef unsigned short bf16_t;
typedef short bf16x8 __attribute__((ext_vector_type(8)));
typedef float f32x4 __attribute__((ext_vector_type(4)));
typedef unsigned u32x4 __attribute__((ext_vector_type(4)));
typedef unsigned u32x2 __attribute__((ext_vector_type(2)));

constexpr int BATCH = 8, SEQ = 4096, NMETA = 16, LEN = SEQ + NMETA, DM = 1024, DFF = 4096, DEPTH = 2;
constexpr int M_ROWS = BATCH * LEN;
constexpr int MP = 33024;
constexpr int N_IN = 5896;
constexpr int NCH16 = LEN / 16;
constexpr int S5ROWS = BATCH * NCH16;
constexpr int S5RP = 2304;
constexpr float EPS = 1e-6f;
constexpr int NTHREADS = 512, NWAVES = 8;

constexpr size_t QB = (size_t)MP * 256 * 2;
constexpr size_t WB_IN = 0;
constexpr size_t WB_G = WB_IN + (size_t)2816 * 1024;
constexpr size_t WB_P = WB_G + (size_t)3072 * 1024;
constexpr size_t WB_O = WB_P + (size_t)1024 * 1024;
constexpr size_t WB_1 = WB_O + (size_t)1024 * 1024;
constexpr size_t WB_2 = WB_1 + (size_t)4096 * 1024;
constexpr size_t WB_GLU = WB_2 + (size_t)1024 * 4096;
constexpr size_t WB_L1 = WB_GLU + (size_t)512 * 256;
constexpr size_t WB_L2 = WB_L1 + (size_t)512 * 512;
constexpr size_t WB_SX = WB_L2 + (size_t)1280 * 256;
constexpr size_t WB_SY = WB_SX + (size_t)16 * 256 * 256;
constexpr size_t WB_ELEMS = WB_SY + (size_t)16 * 256 * 512;
constexpr size_t WB_BYTES = WB_ELEMS * 2;
static_assert(WB_BYTES <= 5 * QB / 2, "weight block fits 2.5 Q");

constexpr size_t WS_H = 0;
constexpr size_t WS_WB0 = 4 * QB;
constexpr size_t WS_SMALL = 13 * QB / 2;
constexpr size_t WS_SSQ = WS_SMALL;
constexpr size_t WS_DT = WS_SSQ + (size_t)MP * 16 * 4;
constexpr size_t WS_DEC = WS_DT + (size_t)MP * 16 * 4;
static_assert(WS_DEC + (size_t)MP * 16 * 4 <= 7 * QB, "small region");
constexpr size_t WS_MIX = 7 * QB;
constexpr size_t WS_PXBC = WS_MIX;
constexpr size_t WS_YSSD = WS_MIX;
constexpr size_t WS_PARK = WS_MIX;
constexpr size_t WS_ACT = WS_MIX;
constexpr size_t WS_PRKVX = WS_MIX + 4 * QB;
constexpr size_t WS_L2O = WS_MIX + 4 * QB;
constexpr size_t WS_PZ = WS_MIX + 9 * QB;
constexpr size_t WS_UH = WS_MIX + 11 * QB;
constexpr size_t WS_X = WS_MIX + 53 * QB / 4;
constexpr size_t WS_YRW = WS_X;
constexpr size_t WS_L1IN = WS_MIX + 31 * QB / 2;
constexpr size_t WS_YAPRE = WS_L1IN;
constexpr size_t WS_L1O = WS_MIX + 35 * QB / 2;
constexpr size_t WS_YB = WS_L1O;
constexpr size_t WS_BC = WS_MIX + 39 * QB / 2;
constexpr size_t WS_YA = WS_BC;
constexpr size_t WS_YC = WS_BC + QB;
constexpr size_t WS_XS = WS_MIX + 43 * QB / 2;
constexpr size_t WS_END = WS_XS + 2 * QB;
static_assert(WS_END <= (size_t)512 << 20, "workspace map fits 512 MiB");
static_assert((size_t)16 * S5RP * 512 * 2 <= 9 * QB / 4 && (size_t)16 * S5RP * 256 * 4 <= 9 * QB / 4, "S5 buffers fit their slots");
static_assert((size_t)256 * 393216 <= 6 * QB, "gate park");
constexpr size_t DO_RKVP = 0;
constexpr size_t DO_MERGED = 0;
constexpr size_t DO_WB1 = 4 * QB;
static_assert(DO_WB1 + WB_BYTES <= (size_t)BATCH * SEQ * DM * 4, "d_out scratch map");

__device__ __forceinline__ unsigned f2bf(float f) { unsigned u = __builtin_bit_cast(unsigned, f); return (u + 0x7fffu + ((u >> 16) & 1u)) >> 16; }
__device__ __forceinline__ unsigned pk2(float lo, float hi) { unsigned r; asm volatile("v_cvt_pk_bf16_f32 %0, %1, %2" : "=v"(r) : "v"(lo), "v"(hi)); return r; }
__device__ __forceinline__ float bflo(unsigned w) { return __builtin_bit_cast(float, w << 16); }
__device__ __forceinline__ float bfhi(unsigned w) { return __builtin_bit_cast(float, w & 0xffff0000u); }
__device__ __forceinline__ float bf1(bf16_t v) { return __builtin_bit_cast(float, (unsigned)v << 16); }
__device__ __forceinline__ float sigmoidf_(float x) { return 1.0f / (1.0f + __expf(-x)); }
__device__ __forceinline__ float siluf_(float x) { return x / (1.0f + __expf(-x)); }
__device__ __forceinline__ float tanhf_(float x) { x = fminf(fmaxf(x, -15.f), 15.f); const float t = __expf(2.f * x); return (t - 1.f) / (t + 1.f); }
__device__ __forceinline__ float softplusf_(float x) { return fmaxf(x, 0.f) + __logf(1.0f + __expf(-fabsf(x))); }
__device__ __forceinline__ float geluf_(float x) { const float u = 0.7978845608028654f * (x + 0.044715f * x * x * x); return 0.5f * x * (1.f + tanhf_(u)); }
__device__ __forceinline__ float wave_sum(float v) {
#pragma unroll
    for (int o = 1; o < 64; o <<= 1) v += __shfl_xor(v, o);
    return v;
}
__device__ __forceinline__ float sum16(float v) {
#pragma unroll
    for (int o = 1; o < 16; o <<= 1) v += __shfl_xor(v, o);
    return v;
}
template <int CTRL> __device__ __forceinline__ float dpp_mov(float x) {
    return __builtin_bit_cast(float, __builtin_amdgcn_update_dpp(0, __builtin_bit_cast(int, x), CTRL, 0xf, 0xf, true));
}
__device__ __forceinline__ float allred16(float x) {
    x += dpp_mov<0xB1>(x); x += dpp_mov<0x4E>(x); x += dpp_mov<0x141>(x); x += dpp_mov<0x140>(x); return x;
}
__device__ __forceinline__ void unpack8(const u32x4 w, float (&f)[8]) {
    f[0] = bflo(w.x); f[1] = bfhi(w.x); f[2] = bflo(w.y); f[3] = bfhi(w.y); f[4] = bflo(w.z); f[5] = bfhi(w.z); f[6] = bflo(w.w); f[7] = bfhi(w.w);
}
__device__ __forceinline__ u32x4 pack8(const float (&f)[8]) { u32x4 w; w.x = pk2(f[0], f[1]); w.y = pk2(f[2], f[3]); w.z = pk2(f[4], f[5]); w.w = pk2(f[6], f[7]); return w; }
__device__ __forceinline__ int opaque_tid() { int t = threadIdx.x; asm volatile("" : "+v"(t)); return t; }
__device__ __forceinline__ int row_of(int b, int t) { return t < NMETA ? BATCH * SEQ + b * NMETA + t : b * SEQ + (t - NMETA); }
__device__ __forceinline__ void bt_of(int m, int& b, int& t) { if (m < BATCH * SEQ) { b = m >> 12; t = NMETA + (m & (SEQ - 1)); } else { const int q = m - BATCH * SEQ; b = q >> 4; t = q & (NMETA - 1); } }
namespace pg8 {
constexpr int BM = 256, BK = 64, HALF = 128, HTB = HALF * BK * 2  , STAGE_BYTES = 8 * HTB;
__host__ __device__ __forceinline__ int lds_byte(int r, int c) { const int st = (r >> 4) * 2 + (c >> 5), rr = r & 15, cc = c & 31, ob = rr * 64 + cc * 2; return st * 1024 + (ob ^ (((ob >> 9) & 1) << 5)); }
__host__ __device__ __forceinline__ void stage_rc(int b, int& R, int& C) { const int st = b / 1024, sb = b % 1024, swz = sb ^ (((sb >> 9) & 1) << 5); R = (st >> 1) * 16 + swz / 64; C = (st & 1) * 32 + (swz % 64) / 2; }
__host__ __device__ __forceinline__ int perm32(int rho) { const int n = rho >> 4, i = rho & 15; return 8 * (i >> 2) + 4 * n + (i & 3); }

struct GU {
    const bf16_t* A;
    const bf16_t* B;
    int lda, ldb, nt;
    int pm, pn, kind;
};

template <class Epi, class Sched>
__device__ __forceinline__ void gemm_phase(LAS unsigned char* lds, const Sched& S, const Epi& E) {
    const int tid = opaque_tid(), wid = __builtin_amdgcn_readfirstlane(tid >> 6), lane = tid & 63, wr = wid >> 2, wc = wid & 3, fr = lane & 15, fq = lane >> 4;
#define PG8_VOFF(lda_, ldb_, a0, a1, b0, b1) do { int R0_, C0_, R1_, C1_; stage_rc(tid * 16, R0_, C0_); stage_rc(tid * 16 + 8192, R1_, C1_); \
        a0 = (unsigned)(R0_ * (lda_) + C0_) * 2u; a1 = (unsigned)(R1_ * (lda_) + C1_) * 2u; \
        b0 = (unsigned)(((R0_ & ~31) + perm32(R0_ & 31)) * (ldb_) + C0_) * 2u; b1 = (unsigned)(((R1_ & ~31) + perm32(R1_ & 31)) * (ldb_) + C1_) * 2u; } while (0)
    const size_t kstep = (size_t)(BK * 2);
    const unsigned ldsw = (unsigned)wid * 1024u;
    const int aoff = lds_byte(wr * 64 + fr, fq * 8), boff = lds_byte(wc * 32 + fr, fq * 8);
#define PG8_SA(b, h) (((b) * 2 + (h)) * HTB)
#define PG8_SB(b, h) ((4 + (b) * 2 + (h)) * HTB)
#define PG8_STAGE(bufoff, gbase, v0, v1) do { \
        __builtin_amdgcn_global_load_lds((const unsigned*)((const char*)(gbase) + (v0)), (LAS unsigned*)(lds + (bufoff) + ldsw), 16, 0, 0); \
        __builtin_amdgcn_global_load_lds((const unsigned*)((const char*)(gbase) + (v1)), (LAS unsigned*)(lds + (bufoff) + ldsw + 8192), 16, 0, 0); } while (0)
#define PG8_LDA(dst, b, h) do { _Pragma("unroll") for (int m = 0; m < 4; ++m) _Pragma("unroll") for (int k = 0; k < 2; ++k) dst[m][k] = *(const LAS bf16x8*)(lds + PG8_SA(b, h) + aoff + m * 2048 + k * 1024); } while (0)
#define PG8_LDB(dst, b, h) do { _Pragma("unroll") for (int n = 0; n < 2; ++n) _Pragma("unroll") for (int k = 0; k < 2; ++k) dst[n][k] = *(const LAS bf16x8*)(lds + PG8_SB(b, h) + boff + n * 2048 + k * 1024); } while (0)
#define PG8_MMA(ai, bj, At, Bt) do { __builtin_amdgcn_s_setprio(1); _Pragma("unroll") for (int m = 0; m < 4; ++m) _Pragma("unroll") for (int n = 0; n < 2; ++n) _Pragma("unroll") for (int k = 0; k < 2; ++k) \
        acc[ai][bj][m][n] = __builtin_amdgcn_mfma_f32_16x16x32_bf16(Bt[n][k], At[m][k], acc[ai][bj][m][n], 0, 0, 0); __builtin_amdgcn_s_setprio(0); } while (0)
#define PG8_WAIT_V(n) asm volatile("s_waitcnt vmcnt(" #n ")" ::: "memory")
#define PG8_WAIT_L(n) asm volatile("s_waitcnt lgkmcnt(" #n ")" ::: "memory")
#define PG8_BAR __builtin_amdgcn_s_barrier()
#define PG8_SCHED __builtin_amdgcn_sched_barrier(0)
    GU cur, nxt; int ui = 0;
    if (!S.next(0, cur)) return;
    f32x4 acc[2][2][4][2];
#pragma unroll
    for (int a = 0; a < 2; ++a)
#pragma unroll
        for (int b = 0; b < 2; ++b)
#pragma unroll
            for (int m = 0; m < 4; ++m)
#pragma unroll
                for (int n = 0; n < 2; ++n) acc[a][b][m][n] = (f32x4){0.f, 0.f, 0.f, 0.f};
    bf16x8 At[4][2], B0[2][2], B1[2][2];
    const char* cA = (const char*)cur.A; const char* cB = (const char*)cur.B;
    unsigned vA0, vA1, vB0, vB1; PG8_VOFF(cur.lda, cur.ldb, vA0, vA1, vB0, vB1);
    size_t hsA = (size_t)HALF * cur.lda * 2, hsB = (size_t)HALF * cur.ldb * 2;
    int nt = cur.nt; asm volatile("" : "+s"(nt));
    PG8_STAGE(PG8_SB(0, 0), cB, vB0, vB1); PG8_STAGE(PG8_SB(0, 1), cB + hsB, vB0, vB1); PG8_STAGE(PG8_SA(0, 0), cA, vA0, vA1); PG8_STAGE(PG8_SA(0, 1), cA + hsA, vA0, vA1);
    if (wr == 1) PG8_BAR;
    PG8_WAIT_V(2); PG8_BAR;
    PG8_STAGE(PG8_SB(1, 0), cB + kstep, vB0, vB1); PG8_STAGE(PG8_SA(1, 0), cA + kstep, vA0, vA1); PG8_STAGE(PG8_SB(1, 1), cB + hsB + kstep, vB0, vB1);
    PG8_WAIT_V(6); PG8_BAR;
    for (;;) {
        const bool has_next = S.next(ui + 1, nxt);
        const char* nA = has_next ? (const char*)nxt.A : cA; const char* nB = has_next ? (const char*)nxt.B : cB;
        unsigned nvA0 = vA0, nvA1 = vA1, nvB0 = vB0, nvB1 = vB1;
        if (has_next) PG8_VOFF(nxt.lda, nxt.ldb, nvA0, nvA1, nvB0, nvB1);
        const size_t nhsA = has_next ? (size_t)HALF * nxt.lda * 2 : hsA, nhsB = has_next ? (size_t)HALF * nxt.ldb * 2 : hsB;
        for (int t = 0; t < nt; t += 2) {
            const bool last = (t == nt - 2);
            const char* a1 = cA + (size_t)(t + 1) * kstep;
            const char* a2 = last ? nA : cA + (size_t)(t + 2) * kstep; const char* b2 = last ? nB : cB + (size_t)(t + 2) * kstep;
            const char* a3 = a2 + kstep; const char* b3 = b2 + kstep;
            const unsigned xA0 = last ? nvA0 : vA0, xA1 = last ? nvA1 : vA1, xB0 = last ? nvB0 : vB0, xB1 = last ? nvB1 : vB1;
            const size_t xhA = last ? nhsA : hsA, xhB = last ? nhsB : hsB;
            PG8_LDB(B0, 0, 0); PG8_LDB(B1, 0, 1); PG8_SCHED; PG8_LDA(At, 0, 0); PG8_STAGE(PG8_SA(1, 1), a1 + hsA, vA0, vA1);
            PG8_WAIT_V(8); PG8_WAIT_L(0); PG8_BAR; PG8_MMA(0, 0, At, B0); PG8_MMA(0, 1, At, B1); PG8_BAR; PG8_SCHED;
            PG8_LDA(At, 0, 1); PG8_STAGE(PG8_SB(0, 0), b2, xB0, xB1); PG8_STAGE(PG8_SB(0, 1), b2 + xhB, xB0, xB1); PG8_STAGE(PG8_SA(0, 0), a2, xA0, xA1);
            PG8_WAIT_V(8); PG8_WAIT_L(0); PG8_BAR; PG8_MMA(1, 0, At, B0); PG8_MMA(1, 1, At, B1); PG8_BAR; PG8_SCHED;
            PG8_LDB(B0, 1, 0); PG8_LDB(B1, 1, 1); PG8_SCHED; PG8_LDA(At, 1, 0); PG8_STAGE(PG8_SA(0, 1), a2 + xhA, xA0, xA1);
            PG8_WAIT_V(8); PG8_WAIT_L(0); PG8_BAR; PG8_MMA(0, 0, At, B0); PG8_MMA(0, 1, At, B1); PG8_BAR; PG8_SCHED;
            PG8_LDA(At, 1, 1); PG8_STAGE(PG8_SB(1, 0), b3, xB0, xB1); PG8_STAGE(PG8_SB(1, 1), b3 + xhB, xB0, xB1); PG8_STAGE(PG8_SA(1, 0), a3, xA0, xA1);
            PG8_WAIT_V(8); PG8_WAIT_L(0); PG8_BAR; PG8_MMA(1, 0, At, B0); PG8_MMA(1, 1, At, B1); PG8_BAR; PG8_SCHED;
        }
        if (wr == 0) PG8_BAR;
        const bool keep = E(acc, cur, wr, wc, fr, fq);
        if (!has_next) break;
        if (!keep) {
#pragma unroll
            for (int a = 0; a < 2; ++a)
#pragma unroll
                for (int b = 0; b < 2; ++b)
#pragma unroll
                    for (int m = 0; m < 4; ++m)
#pragma unroll
                        for (int n = 0; n < 2; ++n) acc[a][b][m][n] = (f32x4){0.f, 0.f, 0.f, 0.f};
        }
        cur = nxt; cA = nA; cB = nB; vA0 = nvA0; vA1 = nvA1; vB0 = nvB0; vB1 = nvB1; hsA = nhsA; hsB = nhsB; nt = cur.nt; asm volatile("" : "+s"(nt)); ++ui;
        if (wr == 1) PG8_BAR;
    }
    PG8_WAIT_V(0);
    PG8_BAR;
#undef PG8_VOFF
#undef PG8_SA
#undef PG8_SB
#undef PG8_STAGE
#undef PG8_LDA
#undef PG8_LDB
#undef PG8_MMA
#undef PG8_WAIT_V
#undef PG8_WAIT_L
#undef PG8_BAR
#undef PG8_SCHED
}

__device__ __forceinline__ bool tile_order(int i, int G, int c, int nM, int nN, int& pm, int& pn) {
    const int nwg = nM * nN; const long L = (long)i * G + c; if (L >= nwg) return false;
    int wgid = (int)L; { const int q = nwg / 8, r = nwg % 8, xcd = wgid % 8, off = wgid / 8; wgid = (xcd < r ? xcd * (q + 1) : r * (q + 1) + (xcd - r) * q) + off; }
    const int nig = 8 * nN, gid = wgid / nig, fm = gid * 8, gsz = (nM - fm) < 8 ? (nM - fm) : 8;
    pm = fm + ((wgid % nig) % gsz); pn = (wgid % nig) / gsz; return true;
}
}
using pg8::GU;
enum InIdx { I_X = 0, I_META, I_FNW, I_MIXNW, I_WIN, I_S5LRE, I_S5LIM, I_S5LS, I_S5BRE, I_S5BIM, I_S5CRE, I_S5CIM, I_S5D, I_GLUW, I_GLUB,
             I_CONVW, I_CONVB, I_ALOG, I_DTB, I_SSDD, I_SSDNW, I_MURKV, I_MUWAG, I_W0, I_W1, I_W2, I_A0, I_A1, I_A2, I_G1, I_G2, I_KK, I_KA, I_RK, I_LNW, I_LNB,
             I_PA, I_PB, I_PC, I_WOUT, I_MLPNW, I_MLPW1, I_MLPW2, N_INPUTS };
struct Params { const float* in[N_INPUTS]; float* out; unsigned char* ws; int ph_lo, ph_hi; };

struct Ctx {
    const float* const* in; unsigned char* ws; unsigned char* dout;
    LAS unsigned char* lds;
    int tid, lane, wave, G, bid;
    __device__ __forceinline__ bf16_t* wb(int layer) const { return (bf16_t*)(layer == 0 ? ws + WS_WB0 : dout + DO_WB1); }
    __device__ __forceinline__ bf16_t* H() const { return (bf16_t*)(ws + WS_H); }
    __device__ __forceinline__ float* ssq() const { return (float*)(ws + WS_SSQ); }
};
__device__ __forceinline__ Ctx relaunder(const Ctx& c0) { Ctx c = c0; c.tid = opaque_tid(); c.lane = c.tid & 63; c.wave = __builtin_amdgcn_readfirstlane(c.tid >> 6); return c; }
__device__ __forceinline__ float row_scale(const float* ssq, int row) {
    const f32x4* p = (const f32x4*)(ssq + (size_t)row * 16);
    const f32x4 a = p[0], b = p[1], c = p[2], d = p[3];
    const float s = ((a.x + a.y) + (a.z + a.w)) + ((b.x + b.y) + (b.z + b.w)) + ((c.x + c.y) + (c.z + c.w)) + ((d.x + d.y) + (d.z + d.w));
    return __builtin_amdgcn_rsqf(s * (1.0f / DM) + EPS);
}

struct SchedPlain {
    const bf16_t* A; const bf16_t* B; int lda, ldb, K, nM, nN, G, c;
    __device__ __forceinline__ bool next(int i, GU& u) const {
        int pm, pn; if (!pg8::tile_order(i, G, c, nM, nN, pm, pn)) return false;
        u.A = A + (size_t)pm * 256 * lda; u.B = B + (size_t)pn * 256 * ldb; u.lda = lda; u.ldb = ldb; u.nt = K / 64; u.pm = pm; u.pn = pn; u.kind = 0; return true;
    }
};
struct SchedS5 {
    const bf16_t* UH; const bf16_t* W; int K, G, c;
    __device__ __forceinline__ bool next(int i, GU& u) const {
        const int L = i * G + c; if (L >= 144) return false;
        const int g = L / 9, pm = L % 9;
        u.A = UH + ((size_t)g * S5RP + (size_t)pm * 256) * 512; u.B = W + (size_t)g * 256 * K; u.lda = 512; u.ldb = K; u.nt = K / 64; u.pm = pm; u.pn = 0; u.kind = g; return true;
    }
};
struct SchedL2 {
    const bf16_t* L1o; const bf16_t* W; int G, c;
    __device__ __forceinline__ bool next(int i, GU& u) const {
        int pm, pn; if (!pg8::tile_order(i, G, c, MP / 256, 5, pm, pn)) return false;
        const int koff = pn < 2 ? 0 : (pn < 4 ? 128 : 256);
        u.A = L1o + (size_t)pm * 256 * 512 + koff; u.B = W + (size_t)pn * 256 * 256; u.lda = 512; u.ldb = 256; u.nt = 4; u.pm = pm; u.pn = pn; u.kind = 0; return true;
    }
};
struct SchedProj {
    const bf16_t* Hb; const bf16_t* Wg; const bf16_t* Wp; const bf16_t* ya; const bf16_t* yb; const bf16_t* yc; int nM, G, c;
    __device__ __forceinline__ bool next(int i, GU& u) const {
        const int ti = i / 6, sub = i - ti * 6; int pm, pn;
        if (!pg8::tile_order(ti, G, c, nM, 4, pm, pn)) return false;
        u.pm = pm; u.pn = pn; u.kind = sub;
        if (sub < 3) { u.A = Hb + (size_t)pm * 256 * DM; u.lda = DM; u.B = Wg + ((size_t)sub * 1024 + (size_t)pn * 256) * DM; u.ldb = DM; u.nt = 16; }
        else if (sub == 3) { u.A = ya + (size_t)pm * 256 * 256; u.lda = 256; u.B = Wp + (size_t)pn * 256 * DM; u.ldb = DM; u.nt = 4; }
        else if (sub == 4) { u.A = yb + (size_t)pm * 256 * 512; u.lda = 512; u.B = Wp + (size_t)pn * 256 * DM + 256; u.ldb = DM; u.nt = 8; }
        else { u.A = yc + (size_t)pm * 256 * 256; u.lda = 256; u.B = Wp + (size_t)pn * 256 * DM + 768; u.ldb = DM; u.nt = 4; }
        return true;
    }
};

typedef f32x4 Acc[2][2][4][2];
#define EPI_ROWS_BEGIN  _Pragma("unroll") for (int ai = 0; ai < 2; ++ai) _Pragma("unroll") for (int m = 0; m < 4; ++m) { const int rl = ai * 128 + wr * 64 + m * 16 + fr; const int row = u.pm * 256 + rl; (void)rl;
#define EPI_ROWS_END    }
#define EPI_COL(bj) ((bj) * 128 + wc * 32 + fq * 8)

struct EpiInProj {
    const float* ssq; bf16_t* UH; bf16_t* Pz; bf16_t* Pxbc; bf16_t* Prkvx;
    __device__ __forceinline__ bool operator()(Acc& acc, const GU& u, int wr, int wc, int fr, int fq) const {
        EPI_ROWS_BEGIN
            if (row < M_ROWS) {
                const float s = row_scale(ssq, row);
                int b, t; bt_of(row, b, t);
#pragma unroll
                for (int bj = 0; bj < 2; ++bj) {
                    const int col = EPI_COL(bj);
                    const f32x4 v0 = acc[ai][bj][m][0] * s, v1 = acc[ai][bj][m][1] * s;
                    u32x4 w; w.x = pk2(v0[0], v0[1]); w.y = pk2(v0[2], v0[3]); w.z = pk2(v1[0], v1[1]); w.w = pk2(v1[2], v1[3]);
                    bf16_t* dst;
                    if (u.pn == 0) { const int g = col >> 4, hh = col & 15; dst = UH + ((size_t)g * S5RP + (size_t)(b * NCH16 + (t >> 4))) * 512 + (t & 15) * 16 + hh; }
                    else if (u.pn < 3) dst = Pz + (size_t)row * 512 + (u.pn - 1) * 256 + col;
                    else if (u.pn < 7) dst = Pxbc + (size_t)row * 1024 + (u.pn - 3) * 256 + col;
                    else dst = Prkvx + (size_t)row * 1024 + (u.pn - 7) * 256 + col;
                    *(u32x4*)dst = w;
                }
            }
        EPI_ROWS_END
        return false;
    }
};
struct EpiS5X {
    float* X;
    __device__ __forceinline__ bool operator()(Acc& acc, const GU& u, int wr, int wc, int fr, int fq) const {
        EPI_ROWS_BEGIN
            float* rp = X + ((size_t)u.kind * S5RP + row) * 256;
#pragma unroll
            for (int bj = 0; bj < 2; ++bj) { const int col = EPI_COL(bj); *(f32x4*)(rp + col) = acc[ai][bj][m][0]; *(f32x4*)(rp + col + 4) = acc[ai][bj][m][1]; }
        EPI_ROWS_END
        return false;
    }
};
struct EpiS5Y {
    bf16_t* yapre;
    __device__ __forceinline__ bool operator()(Acc& acc, const GU& u, int wr, int wc, int fr, int fq) const {
        EPI_ROWS_BEGIN
            if (row < S5ROWS) {
                const int b = row / NCH16, c = row - b * NCH16;
#pragma unroll
                for (int bj = 0; bj < 2; ++bj) {
                    const int col = EPI_COL(bj), i = col >> 4, hh = col & 15;
                    const f32x4 v0 = acc[ai][bj][m][0], v1 = acc[ai][bj][m][1];
                    u32x4 w; w.x = pk2(geluf_(v0[0]), geluf_(v0[1])); w.y = pk2(geluf_(v0[2]), geluf_(v0[3])); w.z = pk2(geluf_(v1[0]), geluf_(v1[1])); w.w = pk2(geluf_(v1[2]), geluf_(v1[3]));
                    *(u32x4*)(yapre + (size_t)row_of(b, c * 16 + i) * 256 + u.kind * 16 + hh) = w;
                }
            }
        EPI_ROWS_END
        return false;
    }
};
struct EpiL1 {
    bf16_t* L1o;
    __device__ __forceinline__ bool operator()(Acc& acc, const GU& u, int wr, int wc, int fr, int fq) const {
        EPI_ROWS_BEGIN
#pragma unroll
            for (int bj = 0; bj < 2; ++bj) {
                const int col = EPI_COL(bj); const int mode = u.pn * 2 + bj;
                f32x4 v0 = acc[ai][bj][m][0], v1 = acc[ai][bj][m][1]; float f[8] = {v0[0], v0[1], v0[2], v0[3], v1[0], v1[1], v1[2], v1[3]};
#pragma unroll
                for (int e = 0; e < 8; ++e) f[e] = mode == 0 ? tanhf_(f[e]) : (mode == 1 ? f[e] : (mode == 2 ? sigmoidf_(f[e]) : 0.f));
                *(u32x4*)(L1o + (size_t)row * 512 + u.pn * 256 + col) = pack8(f);
            }
        EPI_ROWS_END
        return false;
    }
};
struct EpiL2 {
    bf16_t* L2o; const float* w0; const float* a0;
    __device__ __forceinline__ bool operator()(Acc& acc, const GU& u, int wr, int wc, int fr, int fq) const {
        EPI_ROWS_BEGIN
#pragma unroll
            for (int bj = 0; bj < 2; ++bj) {
                const int col = EPI_COL(bj);
                f32x4 v0 = acc[ai][bj][m][0], v1 = acc[ai][bj][m][1]; float f[8] = {v0[0], v0[1], v0[2], v0[3], v1[0], v1[1], v1[2], v1[3]};
                if (u.pn < 2) {
                    const float* bp = w0 + u.pn * 256 + col;
#pragma unroll
                    for (int e = 0; e < 8; ++e) { const float v = bp[e] + f[e]; f[e] = -__expf(-softplusf_(-v) - 0.5f); }
                } else if (u.pn < 4) {
                    const float* bp = a0 + (u.pn - 2) * 256 + col;
#pragma unroll
                    for (int e = 0; e < 8; ++e) f[e] = sigmoidf_(bp[e] + f[e]);
                }
                *(u32x4*)(L2o + (size_t)row * 1280 + u.pn * 256 + col) = pack8(f);
            }
        EPI_ROWS_END
        return false;
    }
};
struct EpiGLU {
    bf16_t* ya; const float* bias;
    __device__ __forceinline__ bool operator()(Acc& acc, const GU& u, int wr, int wc, int fr, int fq) const {
        const int lc = wc * 32 + fq * 8, oc = u.pn * 128 + lc;
        float bv[8], bg[8];
#pragma unroll
        for (int e = 0; e < 8; ++e) { bv[e] = bias[oc + e]; bg[e] = bias[256 + oc + e]; }
        EPI_ROWS_BEGIN
            const f32x4 a0 = acc[ai][0][m][0], a1 = acc[ai][0][m][1], g0 = acc[ai][1][m][0], g1 = acc[ai][1][m][1];
            float v[8] = {a0[0], a0[1], a0[2], a0[3], a1[0], a1[1], a1[2], a1[3]}, g[8] = {g0[0], g0[1], g0[2], g0[3], g1[0], g1[1], g1[2], g1[3]};
#pragma unroll
            for (int e = 0; e < 8; ++e) v[e] = (v[e] + bv[e]) * sigmoidf_(g[e] + bg[e]);
            *(u32x4*)(ya + (size_t)row * 256 + oc) = pack8(v);
        EPI_ROWS_END
        return false;
    }
};
struct EpiProj {
    const float* ssq; const float* ssqb; unsigned char* park; bf16_t* merged; int tid;
    __device__ __forceinline__ bool operator()(Acc& acc, const GU& u, int wr, int wc, int fr, int fq) const {
        const int k = u.kind;
        EPI_ROWS_BEGIN
            float s = 1.f; if (k < 3) s = row_scale(ssq, row < M_ROWS ? row : 0);
            else if (k < 5) { s = __builtin_amdgcn_rsqf(ssqb[row < M_ROWS ? row : 0] * (1.0f / 512.f) + EPS); if (k == 3) s = __builtin_amdgcn_rcpf(s); }
#pragma unroll
            for (int bj = 0; bj < 2; ++bj) {
                const int q = (ai * 2 + bj) * 4 + m;
                f32x4& v0 = acc[ai][bj][m][0]; f32x4& v1 = acc[ai][bj][m][1];
                if (k < 3) {
                    float f[8] = {v0[0], v0[1], v0[2], v0[3], v1[0], v1[1], v1[2], v1[3]};
#pragma unroll
                    for (int e = 0; e < 8; ++e) f[e] = sigmoidf_(f[e] * s);
                    *(u32x4*)(park + ((size_t)(k * 16 + q) * NTHREADS + tid) * 16) = pack8(f);
                } else {
                    float num[8], den[8];
                    unpack8(*(const u32x4*)(park + ((size_t)((k - 3) * 16 + q) * NTHREADS + tid) * 16), num);
                    if (k < 5) { unpack8(*(const u32x4*)(park + ((size_t)((k - 2) * 16 + q) * NTHREADS + tid) * 16), den);
#pragma unroll
                        for (int e = 0; e < 8; ++e) num[e] = num[e] * __builtin_amdgcn_rcpf(den[e]) * s; }
                    v0[0] *= num[0]; v0[1] *= num[1]; v0[2] *= num[2]; v0[3] *= num[3]; v1[0] *= num[4]; v1[1] *= num[5]; v1[2] *= num[6]; v1[3] *= num[7];
                    if (k == 5) { u32x4 w; w.x = pk2(v0[0], v0[1]); w.y = pk2(v0[2], v0[3]); w.z = pk2(v1[0], v1[1]); w.w = pk2(v1[2], v1[3]);
                        *(u32x4*)(merged + (size_t)row * DM + u.pn * 256 + EPI_COL(bj)) = w; }
                }
            }
        EPI_ROWS_END
        return k == 3 || k == 4;
    }
};
struct EpiResid {
    bf16_t* H; float* ssq;
    __device__ __forceinline__ bool operator()(Acc& acc, const GU& u, int wr, int wc, int fr, int fq) const {
        EPI_ROWS_BEGIN
            float ss = 0.f;
            if (row < M_ROWS) {
#pragma unroll
                for (int bj = 0; bj < 2; ++bj) {
                    bf16_t* hp = H + (size_t)row * DM + u.pn * 256 + EPI_COL(bj);
                    float f[8]; unpack8(*(const u32x4*)hp, f);
                    const f32x4 v0 = acc[ai][bj][m][0], v1 = acc[ai][bj][m][1];
                    f[0] += v0[0]; f[1] += v0[1]; f[2] += v0[2]; f[3] += v0[3]; f[4] += v1[0]; f[5] += v1[1]; f[6] += v1[2]; f[7] += v1[3];
#pragma unroll
                    for (int e = 0; e < 8; ++e) ss += f[e] * f[e];
                    *(u32x4*)hp = pack8(f);
                }
            }
            ss += __shfl_xor(ss, 16); ss += __shfl_xor(ss, 32);
            if (fq == 0 && row < M_ROWS) ssq[(size_t)row * 16 + u.pn * 4 + wc] = ss;
        EPI_ROWS_END
        return false;
    }
};
struct EpiUp {
    const float* ssq; bf16_t* act;
    __device__ __forceinline__ bool operator()(Acc& acc, const GU& u, int wr, int wc, int fr, int fq) const {
        EPI_ROWS_BEGIN
            const float s = row_scale(ssq, row < M_ROWS ? row : 0);
#pragma unroll
            for (int bj = 0; bj < 2; ++bj) {
                const f32x4 v0 = acc[ai][bj][m][0] * s, v1 = acc[ai][bj][m][1] * s; float f[8] = {v0[0], v0[1], v0[2], v0[3], v1[0], v1[1], v1[2], v1[3]};
#pragma unroll
                for (int e = 0; e < 8; ++e) { const float r = fmaxf(f[e], 0.f); f[e] = r * r; }
                *(u32x4*)(act + (size_t)row * DFF + u.pn * 256 + EPI_COL(bj)) = pack8(f);
            }
        EPI_ROWS_END
        return false;
    }
};
typedef __attribute__((address_space(1))) unsigned gu32;
#define XB_TMO      128
#define XB_XCNT(j)  (256  + 64 * (j))
#define XB_XSUB(j)  (1280 + 64 * (j))
#define XB_XGEN(j)  (2304 + 64 * (j))
#define XB_TOP      3328
#define XB_TOPGEN   3392
#define XCD_BAR_WORDS 3456
#define XB_SPIN_CAP (1u << 18)

__device__ __forceinline__ unsigned xb_ld(unsigned* p)              { return __hip_atomic_load(p, __ATOMIC_RELAXED, __HIP_MEMORY_SCOPE_AGENT); }
__device__ __forceinline__ unsigned xb_add(unsigned* p, unsigned v) { return __hip_atomic_fetch_add(p, v, __ATOMIC_RELAXED, __HIP_MEMORY_SCOPE_AGENT); }
__device__ __forceinline__ unsigned xb_xcc_id() { return (unsigned)__builtin_amdgcn_s_getreg((3 << 11) | 20) & 0xFu; }
#define XB_SPIN(cond, bar) do { unsigned _sp = 0; while (cond) { __builtin_amdgcn_s_sleep(1); \
    if ((++_sp & 255u) == 0u) { if (xb_ld(&(bar)[XB_TMO])) break; if (_sp > XB_SPIN_CAP) { atomicAdd(&(bar)[XB_TMO], 1u); break; } } } } while (0)

struct XcdBarrier {
    unsigned* bar; unsigned x;
    volatile LAS unsigned* st;
};

__device__ __forceinline__ XcdBarrier xcd_barrier_post(unsigned* bar, volatile LAS unsigned* st) {
    XcdBarrier b; b.bar = bar; b.x = xb_xcc_id(); b.st = st;
    if (threadIdx.x == 0) (void)xb_add(&bar[XB_XCNT(b.x)], 1u);
    return b;
}
__device__ __forceinline__ void xcd_barrier_complete(unsigned* bar, unsigned x, unsigned& nloc, unsigned& nx) {
    const unsigned G = gridDim.x * gridDim.y * gridDim.z;
    unsigned sum, cnt, mine, sp = 0u;
    for (;;) {
        sum = 0u; cnt = 0u; mine = 0u;
#pragma unroll
        for (unsigned j = 0; j < 16; ++j) { const unsigned c = xb_ld(&bar[XB_XCNT(j)]); sum += c; cnt += (c > 0u) ? 1u : 0u; mine = (j == x) ? c : mine; }
        if (sum == G) break;
        __builtin_amdgcn_s_sleep(1);
        if ((++sp & 255u) == 0u) { if (xb_ld(&bar[XB_TMO])) break; if (sp > XB_SPIN_CAP) { atomicAdd(&bar[XB_TMO], 1u); break; } }
    }
    nloc = mine > 0u ? mine : 1u; nx = cnt > 0u ? cnt : 1u;
}

__device__ __forceinline__ void xcd_barrier(const XcdBarrier& b) {
    asm volatile("s_waitcnt vmcnt(0)" ::: "memory");
    __syncthreads();
    if (threadIdx.x == 0) {
        unsigned* bar = b.bar;
        __builtin_amdgcn_s_waitcnt(0);
        unsigned nloc = b.st[0], nx = b.st[1];
        if (nloc == 0u) { xcd_barrier_complete(bar, b.x, nloc, nx); b.st[0] = nloc; b.st[1] = nx; }
        const unsigned old = xb_add(&bar[XB_XSUB(b.x)], 1u);
        const unsigned gen = old / nloc;
        if (old + 1u == (gen + 1u) * nloc) {
            __builtin_amdgcn_fence(__ATOMIC_RELEASE, "agent");
            asm volatile("s_waitcnt vmcnt(0)" ::: "memory");
            const unsigned og = xb_add(&bar[XB_TOP], 1u);
            const unsigned tg = og / nx;
            if (og + 1u == (tg + 1u) * nx) xb_add(&bar[XB_TOPGEN], 1u);
            else XB_SPIN(xb_ld(&bar[XB_TOPGEN]) == tg, bar);
            __builtin_amdgcn_fence(__ATOMIC_ACQUIRE, "agent");
            xb_add(&bar[XB_XGEN(b.x)], 1u);
            asm volatile("s_waitcnt vmcnt(0)" ::: "memory");
        } else {
            XB_SPIN(xb_ld(&bar[XB_XGEN(b.x)]) == gen, bar);
            __builtin_amdgcn_fence(__ATOMIC_ACQUIRE, "agent");
            asm volatile("s_waitcnt vmcnt(0)" ::: "memory");
        }
    }
    __syncthreads();
}

struct TJob { const float* src; int ld, col0, K, N; bf16_t* dst; int dld, dk0, rmode, row0; const float* ksc; };
constexpr int N_TJOBS = 27;
__device__ __forceinline__ void get_tjob(const Ctx& c, int l, int j, TJob& t) {
    bf16_t* wb = c.wb(l);
    const float* win = c.in[I_WIN] + (size_t)l * DM * N_IN;
    t.rmode = 0; t.ksc = nullptr; t.dk0 = 0; t.col0 = 0; t.row0 = 0;
    if (j < 5) {
        t.src = win; t.ld = N_IN; t.K = DM; t.dld = DM; t.ksc = c.in[I_MIXNW] + l * DM; t.dst = wb + WB_IN;
        if (j == 0) { t.col0 = 0; t.N = 256; t.row0 = 0; }
        else if (j == 1) { t.col0 = 256; t.N = 512; t.row0 = 256; }
        else if (j == 2) { t.col0 = 768; t.N = 1024; t.row0 = 768; }
        else if (j == 3) { t.col0 = 1800; t.N = 1024; t.row0 = 1792; }
        else { t.col0 = 2824; t.N = 3072; t.row0 = 0; t.dst = wb + WB_G; }
    } else if (j == 5) { t.src = c.in[I_PA] + (size_t)l * 256 * DM; t.ld = DM; t.K = 256; t.N = DM; t.dst = wb + WB_P; t.dld = DM; t.dk0 = 0; }
    else if (j == 6) { t.src = c.in[I_PB] + (size_t)l * 512 * DM; t.ld = DM; t.K = 512; t.N = DM; t.dst = wb + WB_P; t.dld = DM; t.dk0 = 256; t.ksc = c.in[I_SSDNW] + (size_t)l * 512; }
    else if (j == 7) { t.src = c.in[I_PC] + (size_t)l * 256 * DM; t.ld = DM; t.K = 256; t.N = DM; t.dst = wb + WB_P; t.dld = DM; t.dk0 = 768; }
    else if (j == 8) { t.src = c.in[I_WOUT] + (size_t)l * DM * DM; t.ld = DM; t.K = DM; t.N = DM; t.dst = wb + WB_O; t.dld = DM; }
    else if (j == 9) { t.src = c.in[I_MLPW1] + (size_t)l * DM * DFF; t.ld = DFF; t.K = DM; t.N = DFF; t.dst = wb + WB_1; t.dld = DM; t.ksc = c.in[I_MLPNW] + l * DM; }
    else if (j == 10) { t.src = c.in[I_MLPW2] + (size_t)l * DFF * DM; t.ld = DM; t.K = DFF; t.N = DM; t.dst = wb + WB_2; t.dld = DFF; }
    else if (j == 11) { t.src = c.in[I_GLUW] + (size_t)l * 256 * 512; t.ld = 512; t.K = 256; t.N = 512; t.dst = wb + WB_GLU; t.dld = 256; t.rmode = 1; }
    else if (j < 22) {
        const int q = j - 12;
        t.K = 256; t.dst = wb + WB_L1; t.dld = 512;
        if (q < 4) { const int d = q >> 1, hf = q & 1; t.src = c.in[I_W1] + ((size_t)l * 2 + d) * 256 * 64; t.ld = 64; t.N = 64; t.row0 = d * 64; t.dk0 = hf * 256; if (hf) t.ksc = c.in[I_MUWAG] + ((size_t)l * 3 + 0) * 256; }
        else if (q < 8) { const int d = (q - 4) >> 1, hf = q & 1; t.src = c.in[I_A1] + ((size_t)l * 2 + d) * 256 * 64; t.ld = 64; t.N = 64; t.row0 = 128 + d * 64; t.dk0 = hf * 256; if (hf) t.ksc = c.in[I_MUWAG] + ((size_t)l * 3 + 1) * 256; }
        else { const int hf = q & 1; t.src = c.in[I_G1] + (size_t)l * 256 * 128; t.ld = 128; t.N = 128; t.row0 = 256; t.dk0 = hf * 256; if (hf) t.ksc = c.in[I_MUWAG] + ((size_t)l * 3 + 2) * 256; }
    } else {
        const int q = j - 22;
        t.dst = wb + WB_L2; t.dld = 256; t.ld = 256; t.N = 256;
        if (q < 2) { t.src = c.in[I_W2] + ((size_t)l * 2 + q) * 64 * 256; t.K = 64; t.row0 = q * 256; t.dk0 = q * 64; }
        else if (q < 4) { const int d = q - 2; t.src = c.in[I_A2] + ((size_t)l * 2 + d) * 64 * 256; t.K = 64; t.row0 = (2 + d) * 256; t.dk0 = d * 64; }
        else { t.src = c.in[I_G2] + (size_t)l * 128 * 256; t.K = 128; t.row0 = 4 * 256; t.dk0 = 0; }
    }
}
__device__ __forceinline__ int tjob_items(const TJob& t) { return (t.K / 64) * (t.N / 32); }
__device__ __forceinline__ void transpose_item(const TJob& t, LAS float* scr, int item, int lane) {
    const int nblk = t.N / 32, kb = item / nblk, nb = item % nblk, k0 = 64 * kb, n0 = 32 * nb;
#pragma unroll 8
    for (int i = 0; i < 32; ++i) { const int kk = 2 * i + (lane >> 5); float v = t.src[(size_t)(k0 + kk) * t.ld + t.col0 + n0 + (lane & 31)]; if (t.ksc) v *= t.ksc[k0 + kk]; scr[kk * 33 + (lane & 31)] = v; }
    asm volatile("s_waitcnt lgkmcnt(0)" ::: "memory");
    const int cc = lane & 7;
#pragma unroll
    for (int j = 0; j < 4; ++j) {
        const int n = (lane >> 3) + 8 * j; const LAS float* s = scr + (8 * cc) * 33 + n;
        u32x4 o; o.x = pk2(s[0 * 33], s[1 * 33]); o.y = pk2(s[2 * 33], s[3 * 33]); o.z = pk2(s[4 * 33], s[5 * 33]); o.w = pk2(s[6 * 33], s[7 * 33]);
        const int nn = n0 + n; int drow;
        if (t.rmode == 0) drow = t.row0 + nn; else drow = nn < 256 ? (nn >> 7) * 256 + (nn & 127) : ((nn - 256) >> 7) * 256 + 128 + ((nn - 256) & 127);
        *(u32x4*)(t.dst + (size_t)drow * t.dld + t.dk0 + k0 + 8 * cc) = o;
    }
    asm volatile("s_waitcnt lgkmcnt(0)" ::: "memory");
}

__device__ __forceinline__ void s5_build(const Ctx& cx_, int l, int g) {
    const Ctx c = relaunder(cx_);
    LAS float* F = (LAS float*)c.lds;
    LAS float* pwr = F;
    LAS float* pwi = pwr + 2176;
    LAS float* cor = pwi + 2176;
    LAS float* coi = cor + 128;
    LAS float* Cr = coi + 128;
    LAS float* Ci = Cr + 1024;
    LAS float* Br = Ci + 1024;
    LAS float* Bi = Br + 1024;
    LAS float* kr = Bi + 1024;
    LAS float* ki = kr + 1984;
    LAS float* Kd = ki + 1984;
    const int tid = c.tid;
    if (tid < 128) {
        const int d = tid >> 6, n = tid & 63; const size_t li_ = (((size_t)l * 2 + d) * 16 + g) * 64 + n;
        const float lr = c.in[I_S5LRE][li_], li = c.in[I_S5LIM][li_], step = expf(c.in[I_S5LS][((size_t)l * 2 + d) * 16 + g]);
        for (int k = 0; k <= 16; ++k) { const float mag = expf((float)k * lr * step), ang = (float)k * li * step; float sn, cs; sincosf(ang, &sn, &cs); pwr[(d * 17 + k) * 64 + n] = mag * cs; pwi[(d * 17 + k) * 64 + n] = mag * sn; }
        const float mag1 = expf(lr * step); float sn, cs; sincosf(li * step, &sn, &cs); const float abr = mag1 * cs, abi = mag1 * sn, den = lr * lr + li * li;
        cor[d * 64 + n] = ((abr - 1.f) * lr + abi * li) / den; coi[d * 64 + n] = (abi * lr - (abr - 1.f) * li) / den;
    }
    for (int i = tid; i < 1024; i += NTHREADS) {
        Cr[i] = c.in[I_S5CRE][((size_t)l * 16 + g) * 1024 + i]; Ci[i] = c.in[I_S5CIM][((size_t)l * 16 + g) * 1024 + i];
        Br[i] = c.in[I_S5BRE][((size_t)l * 16 + g) * 1024 + i]; Bi[i] = c.in[I_S5BIM][((size_t)l * 16 + g) * 1024 + i];
    }
    __syncthreads();
    for (int i = tid; i < 31 * 64; i += NTHREADS) {
        const int dd = i / 64 - 15, n = i & 63; float r, im;
        if (dd > 0) { const float pr = pwr[(0 * 17 + dd) * 64 + n], pi = pwi[(0 * 17 + dd) * 64 + n]; r = pr * cor[n] - pi * coi[n]; im = pr * coi[n] + pi * cor[n]; }
        else if (dd < 0) { const float pr = pwr[(1 * 17 - dd) * 64 + n], pi = pwi[(1 * 17 - dd) * 64 + n]; r = pr * cor[64 + n] - pi * coi[64 + n]; im = pr * coi[64 + n] + pi * cor[64 + n]; }
        else { r = cor[n] + cor[64 + n]; im = coi[n] + coi[64 + n]; }
        kr[i] = r; ki[i] = im;
    }
    __syncthreads();
    for (int i = tid; i < 31 * 256; i += NTHREADS) {
        const int ddi = i >> 8, h = (i >> 4) & 15, hp = i & 15; float a = 0.f;
        for (int n = 0; n < 64; ++n) { const float cr = Cr[h * 64 + n], ci = Ci[h * 64 + n], xr = kr[ddi * 64 + n], xi = ki[ddi * 64 + n]; const float pr = cr * xr - ci * xi, pi = cr * xi + ci * xr; a += pr * Br[n * 16 + hp] - pi * Bi[n * 16 + hp]; }
        Kd[i] = a;
    }
    __syncthreads();
    bf16_t* SX = c.wb(l) + WB_SX + (size_t)g * 256 * 256; bf16_t* SY = c.wb(l) + WB_SY + (size_t)g * 256 * 512;
    const float* dsk = c.in[I_S5D] + (size_t)l * 256 + g * 16;
    for (int u = tid; u < 256 * 64; u += NTHREADS) {
        const int o = u >> 6, kk0 = (u & 63) * 8, i = o >> 4, h = o & 15; float v[8];
        if (kk0 < 256) { const int j = kk0 >> 4, hp0 = kk0 & 15;
#pragma unroll
            for (int e = 0; e < 8; ++e) v[e] = Kd[(i - j + 15) * 256 + h * 16 + hp0 + e] + ((i == j && h == hp0 + e) ? dsk[h] : 0.f);
        } else { const int q = kk0 - 256, d = q >> 7, part = (q >> 6) & 1, n0 = q & 63, ex = d == 0 ? i + 1 : 16 - i;
#pragma unroll
            for (int e = 0; e < 8; ++e) { const int n = n0 + e; const float cr = Cr[h * 64 + n], ci = Ci[h * 64 + n], pr = pwr[(d * 17 + ex) * 64 + n], pi = pwi[(d * 17 + ex) * 64 + n]; v[e] = part == 0 ? (cr * pr - ci * pi) : -(cr * pi + ci * pr); }
        }
        *(u32x4*)(SY + (size_t)o * 512 + kk0) = pack8(v);
    }
    for (int u = tid; u < 256 * 32; u += NTHREADS) {
        const int o = u >> 5, kk0 = (u & 31) * 8, d = o >> 7, part = (o >> 6) & 1, n = o & 63, j = kk0 >> 4, hp0 = kk0 & 15, ex = d == 0 ? 15 - j : j;
        const float pr = pwr[(d * 17 + ex) * 64 + n], pi = pwi[(d * 17 + ex) * 64 + n], qr = pr * cor[d * 64 + n] - pi * coi[d * 64 + n], qi = pr * coi[d * 64 + n] + pi * cor[d * 64 + n];
        float v[8];
#pragma unroll
        for (int e = 0; e < 8; ++e) { const float br = Br[n * 16 + hp0 + e], bi = Bi[n * 16 + hp0 + e]; v[e] = part == 0 ? (qr * br - qi * bi) : (qr * bi + qi * br); }
        *(u32x4*)(SX + (size_t)o * 256 + kk0) = pack8(v);
    }
    __syncthreads();
}

__device__ __forceinline__ void phase0(const Ctx& cx_) {
    const Ctx c = relaunder(cx_);
    if (c.bid < 32) s5_build(c, c.bid >> 4, c.bid & 15);
    const int gw = c.bid * NWAVES + c.wave, NGW = c.G * NWAVES, lane = c.lane;
    bf16_t* H = c.H(); float* ssq = c.ssq();
    for (int m = gw; m < MP; m += NGW) {
        u32x2* hp = (u32x2*)(H + (size_t)m * DM);
        if (m >= M_ROWS) {
#pragma unroll
            for (int i = 0; i < 4; ++i) hp[lane + 64 * i] = (u32x2){0u, 0u};
            continue;
        }
        int b, t; bt_of(m, b, t);
        const f32x4* src = (const f32x4*)(t < NMETA ? c.in[I_META] + (size_t)t * DM : c.in[I_X] + ((size_t)b * SEQ + (t - NMETA)) * DM);
        float ss = 0.f;
#pragma unroll
        for (int i = 0; i < 4; ++i) { const f32x4 v = src[lane + 64 * i]; ss += (v.x * v.x + v.y * v.y) + (v.z * v.z + v.w * v.w); hp[lane + 64 * i] = (u32x2){pk2(v.x, v.y), pk2(v.z, v.w)}; }
        ss = wave_sum(ss);
        if (lane < 16) ssq[(size_t)m * 16 + lane] = lane == 0 ? ss : 0.f;
    }
    LAS float* scr = (LAS float*)(c.lds + c.wave * 8448);
    for (int l = 0; l < DEPTH; ++l) {
        int base = 0;
        for (int j = 0; j < N_TJOBS; ++j) {
            TJob t; get_tjob(c, l, j, t); const int ni = tjob_items(t);
            int first = (gw - base % NGW + NGW) % NGW;
            for (int it = first; it < ni; it += NGW) transpose_item(t, scr, it, lane);
            base += ni;
        }
        bf16_t* wb = c.wb(l);
        const int gt = c.bid * NTHREADS + c.tid, NGT = c.G * NTHREADS;
        for (int u = gt; u < 128 * 64; u += NGT) *(u32x4*)(wb + WB_L1 + (size_t)384 * 512 + (size_t)u * 8) = (u32x4){0u, 0u, 0u, 0u};
        for (int u = gt; u < 5 * 256 * 4 * 8; u += NGT) {
            const int sub = u & 7, blk = (u >> 3) & 3, row = (u >> 5) & 255, tile = u >> 13;
            const bool nz = (tile == 0 || tile == 2) ? (blk == 0) : ((tile == 1 || tile == 3) ? (blk == 1) : (blk < 2));
            if (!nz) *(u32x4*)(wb + WB_L2 + ((size_t)tile * 256 + row) * 256 + blk * 64 + sub * 8) = (u32x4){0u, 0u, 0u, 0u};
        }
    }
}

__device__ __forceinline__ void dt_job(const Ctx& cx_, int l) {
    const Ctx c = relaunder(cx_);
    LAS float* dtw = (LAS float*)c.lds;
    const float* win = c.in[I_WIN] + (size_t)l * DM * N_IN; const float* nw = c.in[I_MIXNW] + l * DM;
    for (int i = c.tid; i < 8 * DM; i += NTHREADS) { const int k = i >> 3, j = i & 7; dtw[j * DM + k] = nw[k] * win[(size_t)k * N_IN + 1792 + j]; }
    __syncthreads();
    const int gw = c.bid * NWAVES + c.wave, NGW = c.G * NWAVES, lane = c.lane;
    const bf16_t* H = c.H(); float* dt = (float*)(c.ws + WS_DT); float* dec = (float*)(c.ws + WS_DEC);
    const float* dtb = c.in[I_DTB] + l * 16; const float* alog = c.in[I_ALOG] + l * 16;
    for (int m = gw; m < M_ROWS; m += NGW) {
        const u32x2* hp = (const u32x2*)(H + (size_t)m * DM);
        float ss = 0.f, d8[8] = {0.f, 0.f, 0.f, 0.f, 0.f, 0.f, 0.f, 0.f};
#pragma unroll
        for (int i = 0; i < 4; ++i) {
            const u32x2 w = hp[lane + 64 * i]; const float h0 = bflo(w.x), h1 = bfhi(w.x), h2 = bflo(w.y), h3 = bfhi(w.y);
            ss += (h0 * h0 + h1 * h1) + (h2 * h2 + h3 * h3);
#pragma unroll
            for (int j = 0; j < 8; ++j) { const f32x4 wv = *(const LAS f32x4*)(dtw + j * DM + 4 * lane + 256 * i); d8[j] += (h0 * wv.x + h1 * wv.y) + (h2 * wv.z + h3 * wv.w); }
        }
        ss = wave_sum(ss);
#pragma unroll
        for (int j = 0; j < 8; ++j) d8[j] = wave_sum(d8[j]);
        const float s = __builtin_amdgcn_rsqf(ss * (1.0f / DM) + EPS);
        if (lane < 16) {
            const int j = lane & 7; float raw = d8[0];
#pragma unroll
            for (int e = 1; e < 8; ++e) raw = (j == e) ? d8[e] : raw;
            const float dtv = softplusf_(raw * s + dtb[lane]);
            dt[(size_t)m * 16 + lane] = dtv; dec[(size_t)m * 16 + lane] = -dtv * __expf(alog[lane]);
        }
    }
    __syncthreads();
}

__device__ __forceinline__ void rwkv_prep(const Ctx& cx_, int l) {
    const Ctx c = relaunder(cx_);
    const int gw = c.bid * NWAVES + c.wave, NGW = c.G * NWAVES, lane = c.lane, c0 = 4 * lane;
    const bf16_t* P = (const bf16_t*)(c.ws + WS_PRKVX); bf16_t* rk = (bf16_t*)(c.dout + DO_RKVP); bf16_t* l1 = (bf16_t*)(c.ws + WS_L1IN);
    float mu[3][4], kkw[4];
#pragma unroll
    for (int x = 0; x < 3; ++x)
#pragma unroll
        for (int e = 0; e < 4; ++e) mu[x][e] = c.in[I_MURKV][((size_t)l * 3 + x) * 256 + c0 + e];
#pragma unroll
    for (int e = 0; e < 4; ++e) kkw[e] = c.in[I_KK][(size_t)l * 256 + c0 + e];
    for (int m = gw; m < M_ROWS; m += NGW) {
        int b, t; bt_of(m, b, t); const bool hp = t > 0, hn = t < LEN - 1; const size_t mp_ = hp ? row_of(b, t - 1) : 0, mn_ = hn ? row_of(b, t + 1) : 0;
        float o[4][4];
        float xc[4], dxc[4];
#pragma unroll
        for (int x = 0; x < 4; ++x) {
            const u32x2 wc_ = *(const u32x2*)(P + (size_t)m * 1024 + x * 256 + c0);
            u32x2 wp = (u32x2){0u, 0u}, wn = (u32x2){0u, 0u};
            if (hp) wp = *(const u32x2*)(P + mp_ * 1024 + x * 256 + c0);
            if (hn) wn = *(const u32x2*)(P + mn_ * 1024 + x * 256 + c0);
            const float cur[4] = {bflo(wc_.x), bfhi(wc_.x), bflo(wc_.y), bfhi(wc_.y)}, pv[4] = {bflo(wp.x), bfhi(wp.x), bflo(wp.y), bfhi(wp.y)}, nv[4] = {bflo(wn.x), bfhi(wn.x), bflo(wn.y), bfhi(wn.y)};
#pragma unroll
            for (int e = 0; e < 4; ++e) { const float cs = 0.5f * (pv[e] + nv[e]) - cur[e]; if (x < 3) o[x][e] = cur[e] + cs * mu[x][e]; else { xc[e] = cur[e]; dxc[e] = cs; } }
        }
        float kr_[4], ss = 0.f;
#pragma unroll
        for (int e = 0; e < 4; ++e) { kr_[e] = o[1][e] * kkw[e]; ss += kr_[e] * kr_[e]; }
        ss = sum16(ss); const float rn = __builtin_amdgcn_rsqf(ss + 1e-12f);
        bf16_t* rp = rk + (size_t)m * 1024 + c0;
        *(u32x2*)(rp) = (u32x2){pk2(o[0][0], o[0][1]), pk2(o[0][2], o[0][3])};
        *(u32x2*)(rp + 256) = (u32x2){pk2(o[1][0], o[1][1]), pk2(o[1][2], o[1][3])};
        *(u32x2*)(rp + 512) = (u32x2){pk2(o[2][0], o[2][1]), pk2(o[2][2], o[2][3])};
        *(u32x2*)(rp + 768) = (u32x2){pk2(kr_[0] * rn, kr_[1] * rn), pk2(kr_[2] * rn, kr_[3] * rn)};
        bf16_t* lp = l1 + (size_t)m * 512 + c0;
        *(u32x2*)(lp) = (u32x2){pk2(xc[0], xc[1]), pk2(xc[2], xc[3])};
        *(u32x2*)(lp + 256) = (u32x2){pk2(dxc[0], dxc[1]), pk2(dxc[2], dxc[3])};
    }
}
__device__ __forceinline__ void ssd_prep(const Ctx& cx_, int l) {
    const Ctx c = relaunder(cx_);
    const int gw = c.bid * NWAVES + c.wave, NGW = c.G * NWAVES, lane = c.lane, c0 = 16 * lane;
    const bf16_t* P = (const bf16_t*)(c.ws + WS_PXBC); bf16_t* xs = (bf16_t*)(c.ws + WS_XS); bf16_t* bc = (bf16_t*)(c.ws + WS_BC);
    float w[5][16], bias[16];
#pragma unroll
    for (int j = 0; j < 5; ++j)
#pragma unroll
        for (int e = 0; e < 16; ++e) w[j][e] = c.in[I_CONVW][((size_t)l * 5 + j) * 1024 + c0 + e];
#pragma unroll
    for (int e = 0; e < 16; ++e) bias[e] = c.in[I_CONVB][(size_t)l * 1024 + c0 + e];
    for (int m = gw; m < M_ROWS; m += NGW) {
        int b, t; bt_of(m, b, t);
        float a[16];
#pragma unroll
        for (int e = 0; e < 16; ++e) a[e] = bias[e];
#pragma unroll
        for (int j = 0; j < 5; ++j) {
            const int tt = t + j - 2;
            if (tt >= 0 && tt < LEN) {
                const u32x4* p = (const u32x4*)(P + (size_t)row_of(b, tt) * 1024 + c0); float f0[8], f1[8]; unpack8(p[0], f0); unpack8(p[1], f1);
#pragma unroll
                for (int e = 0; e < 8; ++e) { a[e] += w[j][e] * f0[e]; a[8 + e] += w[j][8 + e] * f1[e]; }
            }
        }
        float o0[8], o1[8];
#pragma unroll
        for (int e = 0; e < 8; ++e) { o0[e] = siluf_(a[e]); o1[e] = siluf_(a[8 + e]); }
        bf16_t* dst = lane < 32 ? xs + (size_t)m * 512 + c0 : bc + (size_t)m * 512 + (c0 - 512);
        ((u32x4*)dst)[0] = pack8(o0); ((u32x4*)dst)[1] = pack8(o1);
    }
}

__device__ __forceinline__ void s5_scan(const Ctx& cx_, int l) {
    const Ctx c = relaunder(cx_);
    if (c.tid >= 64) return;
    const int gt = c.bid * 64 + c.tid; if (gt >= 16384) return;
    const int n = gt & 63, d = (gt >> 6) & 1, b = (gt >> 7) & 7, g = gt >> 10;
    const size_t li_ = (((size_t)l * 2 + d) * 16 + g) * 64 + n;
    const float lr = c.in[I_S5LRE][li_], li = c.in[I_S5LIM][li_], step = expf(c.in[I_S5LS][((size_t)l * 2 + d) * 16 + g]);
    const float mag = expf(16.f * lr * step); float sn, cs; sincosf(16.f * li * step, &sn, &cs); const float ar = mag * cs, ai = mag * sn;
    const float* X = (const float*)(c.ws + WS_X) + ((size_t)g * S5RP + (size_t)b * NCH16) * 256 + d * 128 + n;
    bf16_t* U = (bf16_t*)(c.ws + WS_UH) + ((size_t)g * S5RP + (size_t)b * NCH16) * 512 + 256 + d * 128 + n;
    float hr = 0.f, hi = 0.f;
    for (int i0 = 0; i0 < NCH16; i0 += 32) {
        float xr[32], xi[32];
#pragma unroll
        for (int k = 0; k < 32; ++k) { const int i = i0 + k; const int ch = d == 0 ? i : NCH16 - 1 - i; const bool ok = i < NCH16; xr[k] = ok ? X[(size_t)ch * 256] : 0.f; xi[k] = ok ? X[(size_t)ch * 256 + 64] : 0.f; }
#pragma unroll
        for (int k = 0; k < 32; ++k) { const int i = i0 + k; if (i < NCH16) { const int ch = d == 0 ? i : NCH16 - 1 - i;
            U[(size_t)ch * 512] = (bf16_t)f2bf(hr); U[(size_t)ch * 512 + 64] = (bf16_t)f2bf(hi);
            const float nr = ar * hr - ai * hi + xr[k], ni = ar * hi + ai * hr + xi[k]; hr = nr; hi = ni; } }
    }
}
typedef short s16x4 __attribute__((ext_vector_type(4)));
__device__ __forceinline__ s16x4 lds_tr(const LAS unsigned char* p) { return __builtin_bit_cast(s16x4, __builtin_amdgcn_ds_read_tr16_b64_v4i16((LAS s16x4*)p)); }
__device__ __forceinline__ bf16x8 frag_tr(const LAS unsigned char* img, int rs, int kbase, int colbase, int lane) {
    const LAS unsigned char* a = img + (kbase + 8 * (lane >> 4) + ((lane & 15) >> 2)) * rs + (colbase + 4 * (lane & 3)) * 2;
    const s16x4 lo = lds_tr(a), hi = lds_tr(a + 4 * rs);
    return (bf16x8){lo[0], lo[1], lo[2], lo[3], hi[0], hi[1], hi[2], hi[3]};
}
__device__ __forceinline__ bf16x8 frag_row(const LAS unsigned char* img, int rs, int rowbase, int kbase, int lane) {
    return *(const LAS bf16x8*)(img + (rowbase + (lane & 15)) * rs + (kbase + 8 * (lane >> 4)) * 2);
}
constexpr int SD_RS = 272;
constexpr int SD_XRS = 144;
constexpr int SD_OFF_C = 0, SD_OFF_B = 34816, SD_OFF_X = 69632, SD_OFF_M = 88064, SD_OFF_SC = 122880;
constexpr int SD_OFF_HF = SD_OFF_B, SD_OFF_HB = SD_OFF_B + 17408;
constexpr size_t WS_STB = WS_YSSD;
constexpr size_t WS_CDEC = WS_DEC + (size_t)MP * 64 + 256;
constexpr size_t WS_SSQB = WS_CDEC + (size_t)BATCH * 33 * 16 * 4;
constexpr size_t WS_BAR = (WS_SSQB + (size_t)MP * 4 + 255) / 256 * 256;
static_assert(WS_BAR + 3456 * 4 <= 7 * QB, "small region");
static_assert((size_t)BATCH * 2 * 8 * 32 * 8192 * 2 <= 4 * QB, "chunk states fit the yssd slot");

struct SsdUnit { int b, ck, t0, ns; };
__device__ __forceinline__ bool ssd_unit(int bid, int round, SsdUnit& u) {
    if (round == 0) { u.b = bid >> 5; u.ck = 1 + (bid & 31); u.t0 = NMETA + 128 * (u.ck - 1); u.ns = 8; return true; }
    if (round == 1 && bid < BATCH) { u.b = bid; u.ck = 0; u.t0 = 0; u.ns = 1; return true; }
    return false;
}
__device__ __forceinline__ void ssd_load_img(LAS unsigned char* img, int rs, const bf16_t* src, int ld, size_t m0, int col0, int ncol, int ns, int tid) {
    const int cpr = ncol / 8, nrow = ns == 1 ? 32 : 128;
    for (int i = tid; i < nrow * cpr; i += NTHREADS) {
        const int r = i / cpr, cc = i - r * cpr; u32x4 v = (u32x4){0u, 0u, 0u, 0u};
        if (r < 16 * ns) v = *(const u32x4*)(src + (m0 + r) * ld + col0 + cc * 8);
        *(LAS u32x4*)(img + r * rs + cc * 16) = v;
    }
}
__device__ __forceinline__ void ssd_scalars(LAS float* sc, const float* dt, const float* al, size_t m0, int head, int ns, int lane, float& totf, float& totb) {
    const int Q = 16 * ns;
    float a0f = 0.f, a1f = 0.f, a0b = 0.f, a1b = 0.f, d0f = 0.f, d1f = 0.f, d0b = 0.f, d1b = 0.f;
    const int s0 = 2 * lane, s1 = 2 * lane + 1;
    if (s0 < Q) { a0f = al[(m0 + s0) * 16 + head]; a0b = al[(m0 + s0) * 16 + 8 + head]; d0f = dt[(m0 + s0) * 16 + head]; d0b = dt[(m0 + s0) * 16 + 8 + head]; }
    if (s1 < Q) { a1f = al[(m0 + s1) * 16 + head]; a1b = al[(m0 + s1) * 16 + 8 + head]; d1f = dt[(m0 + s1) * 16 + head]; d1b = dt[(m0 + s1) * 16 + 8 + head]; }
    float pf = a0f + a1f, pb = a0b + a1b;
#pragma unroll
    for (int o = 1; o < 64; o <<= 1) { const float tf = __shfl_up(pf, o), tb = __shfl_up(pb, o); if (lane >= o) { pf += tf; pb += tb; } }
    totf = __shfl(pf, 63); totb = __shfl(pb, 63);
    const float af1 = pf, af0 = pf - a1f;
    const float eb0 = pb - a0b - a1b, eb1 = pb - a1b;
    sc[s0] = af0; sc[s1] = af1; sc[128 + s0] = eb0; sc[128 + s1] = eb1; sc[256 + s0] = d0f; sc[256 + s1] = d1f; sc[384 + s0] = d0b; sc[384 + s1] = d1b;
    sc[512 + s0] = __expf(totf - af0) * d0f; sc[512 + s1] = __expf(totf - af1) * d1f;
    sc[640 + s0] = __expf(eb0) * d0b; sc[640 + s1] = __expf(eb1) * d1b;
    sc[768 + s0] = __expf(af0); sc[768 + s1] = __expf(af1);
    sc[896 + s0] = __expf(totb - eb0); sc[896 + s1] = __expf(totb - eb1);
}

__device__ __forceinline__ void ssd_states(const Ctx& cx_, int l) {
    const Ctx c = relaunder(cx_);
    const int tid = c.tid, lane = c.lane, wave = c.wave;
    const bf16_t* bc = (const bf16_t*)(c.ws + WS_BC); const bf16_t* xs = (const bf16_t*)(c.ws + WS_XS);
    const float* dt = (const float*)(c.ws + WS_DT); const float* al = (const float*)(c.ws + WS_DEC);
    bf16_t* stb = (bf16_t*)(c.ws + WS_STB); float* cdec = (float*)(c.ws + WS_CDEC);
    LAS unsigned char* Bimg = c.lds + SD_OFF_B; LAS unsigned char* Ximg = c.lds + SD_OFF_X; LAS float* sc = (LAS float*)(c.lds + SD_OFF_SC);
    for (int round = 0; round < 2; ++round) {
        SsdUnit u; if (!ssd_unit(c.bid, round, u)) break;
        const size_t m0 = (size_t)row_of(u.b, u.t0); const int nks = u.ns == 1 ? 1 : 4;
        for (int g = 0; g < 2; ++g) {
            __syncthreads();
            ssd_load_img(Bimg, SD_RS, bc, 512, m0, g * 128, 128, u.ns, tid);
            for (int j = 0; j < 4; ++j) {
                const int head = g * 4 + j;
                if (j) __syncthreads();
                ssd_load_img(Ximg, SD_XRS, xs, 512, m0, head * 64, 64, u.ns, tid);
                if (wave == 0) { float totf, totb; ssd_scalars(sc, dt, al, m0, head, u.ns, lane, totf, totb);
                    if (lane == 0) { cdec[((size_t)u.b * 33 + u.ck) * 16 + head] = __expf(totf); cdec[((size_t)u.b * 33 + u.ck) * 16 + 8 + head] = __expf(totb); } }
                __syncthreads();
                f32x4 accf[4], accb[4];
#pragma unroll
                for (int pt = 0; pt < 4; ++pt) { accf[pt] = (f32x4){0.f, 0.f, 0.f, 0.f}; accb[pt] = accf[pt]; }
                for (int ks = 0; ks < nks; ++ks) {
                    const bf16x8 af = frag_tr(Bimg, SD_RS, 32 * ks, 16 * wave, lane);
                    const int k0 = 32 * ks + 8 * (lane >> 4);
                    const f32x4 wf0 = *(const LAS f32x4*)(sc + 512 + k0), wf1 = *(const LAS f32x4*)(sc + 512 + k0 + 4), wb0 = *(const LAS f32x4*)(sc + 640 + k0), wb1 = *(const LAS f32x4*)(sc + 640 + k0 + 4);
#pragma unroll
                    for (int pt = 0; pt < 4; ++pt) {
                        const bf16x8 xr = frag_tr(Ximg, SD_XRS, 32 * ks, 16 * pt, lane);
                        float xf[8];
#pragma unroll
                        for (int e = 0; e < 8; ++e) xf[e] = bf1((bf16_t)xr[e]);
                        bf16x8 bfv, bbv;
                        { const unsigned p0 = pk2(xf[0] * wf0.x, xf[1] * wf0.y), p1 = pk2(xf[2] * wf0.z, xf[3] * wf0.w), p2 = pk2(xf[4] * wf1.x, xf[5] * wf1.y), p3 = pk2(xf[6] * wf1.z, xf[7] * wf1.w);
                          bfv = __builtin_bit_cast(bf16x8, (u32x4){p0, p1, p2, p3}); }
                        { const unsigned p0 = pk2(xf[0] * wb0.x, xf[1] * wb0.y), p1 = pk2(xf[2] * wb0.z, xf[3] * wb0.w), p2 = pk2(xf[4] * wb1.x, xf[5] * wb1.y), p3 = pk2(xf[6] * wb1.z, xf[7] * wb1.w);
                          bbv = __builtin_bit_cast(bf16x8, (u32x4){p0, p1, p2, p3}); }
                        accf[pt] = __builtin_amdgcn_mfma_f32_16x16x32_bf16(af, bfv, accf[pt], 0, 0, 0);
                        accb[pt] = __builtin_amdgcn_mfma_f32_16x16x32_bf16(af, bbv, accb[pt], 0, 0, 0);
                    }
                }
#pragma unroll
                for (int pt = 0; pt < 4; ++pt) {
                    const int p = 16 * pt + (lane & 15), n0 = 16 * wave + 4 * (lane >> 4);
                    if (u.ck <= 31) { bf16_t* d = stb + ((((size_t)u.b * 2 + 0) * 8 + head) * 32 + u.ck) * 8192 + (size_t)p * 128 + n0; *(u32x2*)d = (u32x2){pk2(accf[pt][0], accf[pt][1]), pk2(accf[pt][2], accf[pt][3])}; }
                    if (u.ck >= 1) { bf16_t* d = stb + ((((size_t)u.b * 2 + 1) * 8 + head) * 32 + (u.ck - 1)) * 8192 + (size_t)p * 128 + n0; *(u32x2*)d = (u32x2){pk2(accb[pt][0], accb[pt][1]), pk2(accb[pt][2], accb[pt][3])}; }
                }
            }
        }
    }
    __syncthreads();
}

__device__ __forceinline__ void ssd_chunk_scan(const Ctx& cx_, int l) {
    const Ctx c = relaunder(cx_);
    bf16_t* stb = (bf16_t*)(c.ws + WS_STB); const float* cdec = (const float*)(c.ws + WS_CDEC);
    const int gt = c.bid * NTHREADS + c.tid;
    const int e8 = gt & 1023, bdh = gt >> 10;
    if (bdh >= BATCH * 16) return;
    const int head = bdh & 7, dir = (bdh >> 3) & 1, b = bdh >> 4;
    bf16_t* base = stb + (size_t)bdh * 32 * 8192 + (size_t)e8 * 8;
    float h[8] = {0.f, 0.f, 0.f, 0.f, 0.f, 0.f, 0.f, 0.f};
    for (int i0 = 0; i0 < 32; i0 += 8) {
        u32x4 v[8]; float dcy[8];
#pragma unroll
        for (int k = 0; k < 8; ++k) { const int slot = dir == 0 ? i0 + k : 31 - (i0 + k); v[k] = *(const u32x4*)(base + (size_t)slot * 8192);
            const int ck = dir == 0 ? slot : slot + 1; dcy[k] = cdec[((size_t)b * 33 + ck) * 16 + dir * 8 + head]; }
#pragma unroll
        for (int k = 0; k < 8; ++k) { const int slot = dir == 0 ? i0 + k : 31 - (i0 + k); float s[8]; unpack8(v[k], s);
#pragma unroll
            for (int e = 0; e < 8; ++e) h[e] = h[e] * dcy[k] + s[e];
            *(u32x4*)(base + (size_t)slot * 8192) = pack8(h); }
    }
}

__device__ __forceinline__ void ssd_outputs(const Ctx& cx_, int l) {
    const Ctx c = relaunder(cx_);
    const int tid = c.tid, lane = c.lane, wave = c.wave;
    const bf16_t* bc = (const bf16_t*)(c.ws + WS_BC); const bf16_t* xs = (const bf16_t*)(c.ws + WS_XS); const bf16_t* pz = (const bf16_t*)(c.ws + WS_PZ);
    const float* dt = (const float*)(c.ws + WS_DT); const float* al = (const float*)(c.ws + WS_DEC);
    const bf16_t* stb = (const bf16_t*)(c.ws + WS_STB); bf16_t* yb = (bf16_t*)(c.ws + WS_YB); float* ssqb = (float*)(c.ws + WS_SSQB);
    LAS unsigned char* Cimg = c.lds + SD_OFF_C; LAS unsigned char* Bimg = c.lds + SD_OFF_B; LAS unsigned char* Ximg = c.lds + SD_OFF_X;
    LAS unsigned char* HfT = c.lds + SD_OFF_HF; LAS unsigned char* HbT = c.lds + SD_OFF_HB;
    LAS unsigned char* Ms = c.lds + SD_OFF_M + wave * 4352; LAS float* sc = (LAS float*)(c.lds + SD_OFF_SC);
    for (int round = 0; round < 2; ++round) {
        SsdUnit u; if (!ssd_unit(c.bid, round, u)) break;
        const size_t m0 = (size_t)row_of(u.b, u.t0); const int nks = u.ns == 1 ? 1 : 4; const bool active = wave < u.ns;
        float ssrow = 0.f;
        for (int g = 0; g < 2; ++g) {
            __syncthreads();
            ssd_load_img(Cimg, SD_RS, bc, 512, m0, 256 + g * 128, 128, u.ns, tid);
            ssd_load_img(Bimg, SD_RS, bc, 512, m0, g * 128, 128, u.ns, tid);
            __syncthreads();
            f32x4 cb[8];
#pragma unroll
            for (int t = 0; t < 8; ++t) cb[t] = (f32x4){0.f, 0.f, 0.f, 0.f};
            if (active) {
#pragma unroll
                for (int ks = 0; ks < 4; ++ks) {
                    const bf16x8 cfr = frag_row(Cimg, SD_RS, 16 * wave, 32 * ks, lane);
#pragma unroll
                    for (int t = 0; t < 8; ++t) if (t < u.ns) cb[t] = __builtin_amdgcn_mfma_f32_16x16x32_bf16(frag_row(Bimg, SD_RS, 16 * t, 32 * ks, lane), cfr, cb[t], 0, 0, 0);
                }
            }
            for (int j = 0; j < 4; ++j) {
                const int head = g * 4 + j;
                __syncthreads();
                ssd_load_img(Ximg, SD_XRS, xs, 512, m0, head * 64, 64, u.ns, tid);
                {
                    const bf16_t* hf = u.ck >= 1 ? stb + ((((size_t)u.b * 2 + 0) * 8 + head) * 32 + (u.ck - 1)) * 8192 : nullptr;
                    const bf16_t* hb = u.ck <= 31 ? stb + ((((size_t)u.b * 2 + 1) * 8 + head) * 32 + u.ck) * 8192 : nullptr;
                    for (int i = tid; i < 64 * 16; i += NTHREADS) { const int p = i >> 4, cc = i & 15;
                        *(LAS u32x4*)(HfT + p * SD_RS + cc * 16) = hf ? *(const u32x4*)(hf + p * 128 + cc * 8) : (u32x4){0u, 0u, 0u, 0u};
                        *(LAS u32x4*)(HbT + p * SD_RS + cc * 16) = hb ? *(const u32x4*)(hb + p * 128 + cc * 8) : (u32x4){0u, 0u, 0u, 0u}; }
                }
                if (wave == 0) { float totf, totb; ssd_scalars(sc, dt, al, m0, head, u.ns, lane, totf, totb); }
                __syncthreads();
                if (active) {
                    const int ll = 16 * wave + (lane & 15); const float afl = sc[ll], ebl = sc[128 + ll];
#pragma unroll
                    for (int t = 0; t < 8; ++t) {
                        u32x2 w2 = (u32x2){0u, 0u};
                        if (t < u.ns) {
                            const int s0 = 16 * t + 4 * (lane >> 4);
                            const f32x4 afs = *(const LAS f32x4*)(sc + s0), ebs = *(const LAS f32x4*)(sc + 128 + s0), dfs = *(const LAS f32x4*)(sc + 256 + s0), dbs = *(const LAS f32x4*)(sc + 384 + s0);
                            float mv[4];
#pragma unroll
                            for (int r = 0; r < 4; ++r) { const int s = s0 + r; float wgt = 0.f; if (s <= ll) wgt += __expf(afl - afs[r]) * dfs[r]; if (s >= ll) wgt += __expf(ebs[r] - ebl) * dbs[r]; mv[r] = cb[t][r] * wgt; }
                            w2 = (u32x2){pk2(mv[0], mv[1]), pk2(mv[2], mv[3])};
                        }
                        if (t < 2 * nks) *(LAS u32x2*)(Ms + (lane & 15) * SD_RS + (16 * t + 4 * (lane >> 4)) * 2) = w2;
                    }
                    f32x4 ay[4], ahf[4], ahb[4];
#pragma unroll
                    for (int pt = 0; pt < 4; ++pt) { ay[pt] = (f32x4){0.f, 0.f, 0.f, 0.f}; ahf[pt] = ay[pt]; ahb[pt] = ay[pt]; }
                    for (int ks = 0; ks < nks; ++ks) {
                        const bf16x8 mf = frag_row(Ms, SD_RS, 0, 32 * ks, lane);
#pragma unroll
                        for (int pt = 0; pt < 4; ++pt) ay[pt] = __builtin_amdgcn_mfma_f32_16x16x32_bf16(mf, frag_tr(Ximg, SD_XRS, 32 * ks, 16 * pt, lane), ay[pt], 0, 0, 0);
                    }
#pragma unroll
                    for (int ks = 0; ks < 4; ++ks) {
                        const bf16x8 cfr = frag_row(Cimg, SD_RS, 16 * wave, 32 * ks, lane);
#pragma unroll
                        for (int pt = 0; pt < 4; ++pt) {
                            ahf[pt] = __builtin_amdgcn_mfma_f32_16x16x32_bf16(cfr, frag_row(HfT, SD_RS, 16 * pt, 32 * ks, lane), ahf[pt], 0, 0, 0);
                            ahb[pt] = __builtin_amdgcn_mfma_f32_16x16x32_bf16(cfr, frag_row(HbT, SD_RS, 16 * pt, 32 * ks, lane), ahb[pt], 0, 0, 0);
                        }
                    }
                    const int l0 = 16 * wave + 4 * (lane >> 4);
                    const f32x4 efv = *(const LAS f32x4*)(sc + 768 + l0), ebv = *(const LAS f32x4*)(sc + 896 + l0);
                    LAS float* ys = (LAS float*)Ms;
#pragma unroll
                    for (int pt = 0; pt < 4; ++pt)
#pragma unroll
                        for (int r = 0; r < 4; ++r) ys[(4 * (lane >> 4) + r) * 68 + 16 * pt + (lane & 15)] = ay[pt][r] + efv[r] * ahf[pt][r] + ebv[r] * ahb[pt][r];
                    const int rr = lane >> 2, p0 = 16 * (lane & 3); const size_t m = m0 + 16 * wave + rr;
                    const float dsk = c.in[I_SSDD][l * 8 + head];
                    float xv[16], zv[16];
                    { float t8[8]; unpack8(*(const LAS u32x4*)(Ximg + (16 * wave + rr) * SD_XRS + p0 * 2), t8);
#pragma unroll
                      for (int e = 0; e < 8; ++e) xv[e] = t8[e];
                      unpack8(*(const LAS u32x4*)(Ximg + (16 * wave + rr) * SD_XRS + p0 * 2 + 16), t8);
#pragma unroll
                      for (int e = 0; e < 8; ++e) xv[8 + e] = t8[e];
                      unpack8(*(const u32x4*)(pz + m * 512 + head * 64 + p0), t8);
#pragma unroll
                      for (int e = 0; e < 8; ++e) zv[e] = t8[e];
                      unpack8(*(const u32x4*)(pz + m * 512 + head * 64 + p0 + 8), t8);
#pragma unroll
                      for (int e = 0; e < 8; ++e) zv[8 + e] = t8[e]; }
                    float o[16];
#pragma unroll
                    for (int e4 = 0; e4 < 4; ++e4) { const f32x4 yv = *(const LAS f32x4*)(ys + rr * 68 + p0 + 4 * e4);
#pragma unroll
                        for (int e = 0; e < 4; ++e) { const float val = (yv[e] + dsk * xv[4 * e4 + e]) * siluf_(zv[4 * e4 + e]); o[4 * e4 + e] = val; ssrow += val * val; } }
                    u32x4 w0, w1; w0.x = pk2(o[0], o[1]); w0.y = pk2(o[2], o[3]); w0.z = pk2(o[4], o[5]); w0.w = pk2(o[6], o[7]); w1.x = pk2(o[8], o[9]); w1.y = pk2(o[10], o[11]); w1.z = pk2(o[12], o[13]); w1.w = pk2(o[14], o[15]);
                    *(u32x4*)(yb + m * 512 + head * 64 + p0) = w0; *(u32x4*)(yb + m * 512 + head * 64 + p0 + 8) = w1;
                }
            }
        }
        if (active) { ssrow += dpp_mov<0xB1>(ssrow); ssrow += dpp_mov<0x4E>(ssrow); if ((lane & 3) == 0) ssqb[m0 + 16 * wave + (lane >> 2)] = ssrow; }
    }
    __syncthreads();
}
constexpr int RW_T = 32, RW_NC = (LEN + RW_T - 1) / RW_T, RW_BUF = 45056;
__device__ __forceinline__ void rwkv_scan(const Ctx& cx_, int l) {
    const Ctx c = relaunder(cx_);
    const int bid = c.bid, q = bid & 3, dir = (bid >> 2) & 1, head = (bid >> 3) & 3, b = bid >> 5;
    const int tid = c.tid, lane = c.lane, wave = c.wave;
    const bf16_t* rk = (const bf16_t*)(c.dout + DO_RKVP); const bf16_t* l2 = (const bf16_t*)(c.ws + WS_L2O);
    bf16_t* yo = (bf16_t*)(c.ws + WS_YRW) + (size_t)dir * MP * 256;
    const bool producer = wave >= 4;
    const int pt = tid - 256, pstep = pt >> 3, pc0 = (pt & 7) * 8, pv0 = 2 * (pt & 7);
    float ka[8];
    u32x4 R, K, KK, DL, AS; unsigned V2 = 0; R = K = KK = DL = AS = (u32x4){0u, 0u, 0u, 0u};
    if (producer) {
#pragma unroll
        for (int e = 0; e < 8; ++e) ka[e] = c.in[I_KA][(size_t)l * 256 + head * 64 + pc0 + e];
    }
    auto tok = [&](int s) -> size_t { const int t = dir ? LEN - 1 - s : s; return (size_t)row_of(b, t); };
#define RW_LOAD(chunk) do { const int s_ = (chunk) * RW_T + pstep; if (s_ < LEN) { const size_t m_ = tok(s_); const bf16_t* rp_ = rk + m_ * 1024 + head * 64; const bf16_t* lp_ = l2 + m_ * 1280 + dir * 256 + head * 64; \
        R = *(const u32x4*)(rp_ + pc0); K = *(const u32x4*)(rp_ + 256 + pc0); KK = *(const u32x4*)(rp_ + 768 + pc0); V2 = *(const unsigned*)(rp_ + 512 + 16 * q + pv0); \
        DL = *(const u32x4*)(lp_ + pc0); AS = *(const u32x4*)(lp_ + 512 + pc0); } } while (0)
#define RW_WRITE(buf) do { LAS float* vec_ = (LAS float*)(c.lds + (buf) * RW_BUF); float r_[8], k_[8], kk_[8], dl_[8], as_[8]; unpack8(R, r_); unpack8(K, k_); unpack8(KK, kk_); unpack8(DL, dl_); unpack8(AS, as_); \
        float w_[8], a_[8], b_[8], kd_[8]; _Pragma("unroll") for (int e = 0; e < 8; ++e) { w_[e] = __expf(dl_[e]); a_[e] = -kk_[e]; b_[e] = kk_[e] * as_[e]; kd_[e] = k_[e] * (1.f + (as_[e] - 1.f) * ka[e]); } \
        LAS float* bp_ = vec_ + pstep * 320 + pc0; \
        *(LAS f32x4*)(bp_) = (f32x4){w_[0], w_[1], w_[2], w_[3]}; *(LAS f32x4*)(bp_ + 4) = (f32x4){w_[4], w_[5], w_[6], w_[7]}; \
        *(LAS f32x4*)(bp_ + 64) = (f32x4){a_[0], a_[1], a_[2], a_[3]}; *(LAS f32x4*)(bp_ + 68) = (f32x4){a_[4], a_[5], a_[6], a_[7]}; \
        *(LAS f32x4*)(bp_ + 128) = (f32x4){b_[0], b_[1], b_[2], b_[3]}; *(LAS f32x4*)(bp_ + 132) = (f32x4){b_[4], b_[5], b_[6], b_[7]}; \
        *(LAS f32x4*)(bp_ + 192) = (f32x4){kd_[0], kd_[1], kd_[2], kd_[3]}; *(LAS f32x4*)(bp_ + 196) = (f32x4){kd_[4], kd_[5], kd_[6], kd_[7]}; \
        *(LAS f32x4*)(bp_ + 256) = (f32x4){r_[0], r_[1], r_[2], r_[3]}; *(LAS f32x4*)(bp_ + 260) = (f32x4){r_[4], r_[5], r_[6], r_[7]}; \
        LAS float* vr_ = vec_ + 10240 + pstep * 16 + pv0; vr_[0] = bflo(V2); vr_[1] = bfhi(V2); } while (0)
#define RW_FLUSH(chunk) do { const int s_ = (chunk) * RW_T + pstep; if (s_ < LEN) { const LAS float* yy_ = (const LAS float*)(c.lds + ((chunk) & 1) * RW_BUF) + 10752 + pstep * 16 + pv0; \
        *(unsigned*)(yo + tok(s_) * 256 + head * 64 + 16 * q + pv0) = pk2(yy_[0], yy_[1]); } } while (0)
    if (producer) { RW_LOAD(0); RW_WRITE(0); RW_LOAD(1); }
    __syncthreads();
    const int rowl = (wave & 3) * 4 + (lane >> 4), j4 = (lane & 15) * 4;
    float S0 = 0.f, S1 = 0.f, S2 = 0.f, S3 = 0.f;
#define RW_SCAN(NS) do { float yv_[NS]; \
        _Pragma("unroll") for (int st = 0; st < NS; ++st) { \
            const LAS float* bp = vec + st * 320 + j4; \
            const f32x4 w = *(const LAS f32x4*)(bp), a = *(const LAS f32x4*)(bp + 64), bb = *(const LAS f32x4*)(bp + 128), kd = *(const LAS f32x4*)(bp + 192), r = *(const LAS f32x4*)(bp + 256); \
            const float v = vec[10240 + st * 16 + rowl]; \
            float sa = (S0 * a.x + S1 * a.y) + (S2 * a.z + S3 * a.w); \
            sa = allred16(sa); \
            S0 = S0 * w.x + v * kd.x; S1 = S1 * w.y + v * kd.y; S2 = S2 * w.z + v * kd.z; S3 = S3 * w.w + v * kd.w; \
            S0 += sa * bb.x; S1 += sa * bb.y; S2 += sa * bb.z; S3 += sa * bb.w; \
            float y = (S0 * r.x + S1 * r.y) + (S2 * r.z + S3 * r.w); \
            yv_[st] = allred16(y); } \
        if ((lane & 15) == 0) { _Pragma("unroll") for (int st = 0; st < NS; ++st) yy[st * 16 + rowl] = yv_[st]; } } while (0)
    for (int ch = 0; ch < RW_NC; ++ch) {
        if (!producer) {
            const LAS float* vec = (const LAS float*)(c.lds + (ch & 1) * RW_BUF);
            LAS float* yy = (LAS float*)(c.lds + (ch & 1) * RW_BUF) + 10752;
            if (ch < RW_NC - 1) RW_SCAN(32); else RW_SCAN(LEN - (RW_NC - 1) * RW_T);
        } else {
            if (ch + 1 < RW_NC) RW_WRITE((ch + 1) & 1);
            if (ch + 2 < RW_NC) RW_LOAD(ch + 2);
            if (ch >= 1) RW_FLUSH(ch - 1);
        }
        __syncthreads();
    }
#undef RW_SCAN
    if (producer) RW_FLUSH(RW_NC - 1);
    __syncthreads();
#undef RW_LOAD
#undef RW_WRITE
#undef RW_FLUSH
}

__device__ __forceinline__ void rwkv_post(const Ctx& cx_, int l) {
    const Ctx c = relaunder(cx_);
    const int gw = c.bid * NWAVES + c.wave, NGW = c.G * NWAVES, lane = c.lane, c0 = 4 * lane;
    const bf16_t* y0 = (const bf16_t*)(c.ws + WS_YRW); const bf16_t* y1 = y0 + (size_t)MP * 256;
    const bf16_t* rk = (const bf16_t*)(c.dout + DO_RKVP); const bf16_t* l2 = (const bf16_t*)(c.ws + WS_L2O); bf16_t* yc = (bf16_t*)(c.ws + WS_YC);
    float lw[4], lb[4], rkw[4];
#pragma unroll
    for (int e = 0; e < 4; ++e) { lw[e] = c.in[I_LNW][(size_t)l * 256 + c0 + e]; lb[e] = c.in[I_LNB][(size_t)l * 256 + c0 + e]; rkw[e] = c.in[I_RK][(size_t)l * 256 + c0 + e]; }
    for (int m = gw; m < M_ROWS; m += NGW) {
        const u32x2 a = *(const u32x2*)(y0 + (size_t)m * 256 + c0), bq = *(const u32x2*)(y1 + (size_t)m * 256 + c0);
        const u32x2 rr = *(const u32x2*)(rk + (size_t)m * 1024 + c0), kk = *(const u32x2*)(rk + (size_t)m * 1024 + 256 + c0), vv = *(const u32x2*)(rk + (size_t)m * 1024 + 512 + c0);
        const u32x2 gg = *(const u32x2*)(l2 + (size_t)m * 1280 + 1024 + c0);
        float y[4] = {bflo(a.x) + bflo(bq.x), bfhi(a.x) + bfhi(bq.x), bflo(a.y) + bflo(bq.y), bfhi(a.y) + bfhi(bq.y)};
        const float r[4] = {bflo(rr.x), bfhi(rr.x), bflo(rr.y), bfhi(rr.y)}, k[4] = {bflo(kk.x), bfhi(kk.x), bflo(kk.y), bfhi(kk.y)};
        const float v[4] = {bflo(vv.x), bfhi(vv.x), bflo(vv.y), bfhi(vv.y)}, g[4] = {bflo(gg.x), bfhi(gg.x), bflo(gg.y), bfhi(gg.y)};
        const float mean = sum16((y[0] + y[1]) + (y[2] + y[3])) * (1.f / 64.f);
        float q = 0.f, bo = 0.f;
#pragma unroll
        for (int e = 0; e < 4; ++e) { y[e] -= mean; q += y[e] * y[e]; bo += r[e] * k[e] * rkw[e]; }
        q = sum16(q) * (1.f / 64.f); bo = sum16(bo);
        const float rs = __builtin_amdgcn_rsqf(q + 64e-5f);
        float o[4];
#pragma unroll
        for (int e = 0; e < 4; ++e) o[e] = (y[e] * rs * lw[e] + lb[e] + bo * v[e]) * g[e];
        *(u32x2*)(yc + (size_t)m * 256 + c0) = (u32x2){pk2(o[0], o[1]), pk2(o[2], o[3])};
    }
}
__device__ __forceinline__ void final_phase(const Ctx& cx_, float* out) {
    const Ctx c = relaunder(cx_);
    const int gw = c.bid * NWAVES + c.wave, NGW = c.G * NWAVES, lane = c.lane;
    const bf16_t* H = c.H(); const f32x4* fw = (const f32x4*)c.in[I_FNW];
    for (int r = gw; r < BATCH * SEQ; r += NGW) {
        const size_t m = (size_t)r;
        const u32x2* hp = (const u32x2*)(H + m * DM);
        float v[4][4], ss = 0.f;
#pragma unroll
        for (int i = 0; i < 4; ++i) { const u32x2 w = hp[lane + 64 * i]; v[i][0] = bflo(w.x); v[i][1] = bfhi(w.x); v[i][2] = bflo(w.y); v[i][3] = bfhi(w.y); ss += (v[i][0] * v[i][0] + v[i][1] * v[i][1]) + (v[i][2] * v[i][2] + v[i][3] * v[i][3]); }
        ss = wave_sum(ss); const float s = __builtin_amdgcn_rsqf(ss * (1.0f / DM) + EPS);
        f32x4* op = (f32x4*)(out + (size_t)r * DM);
#pragma unroll
        for (int i = 0; i < 4; ++i) { const f32x4 w = fw[lane + 64 * i]; op[lane + 64 * i] = (f32x4){v[i][0] * s * w.x, v[i][1] * s * w.y, v[i][2] * s * w.z, v[i][3] * s * w.w}; }
    }
}

constexpr int LDS_BYTES = 147456;
#ifndef PHMASK
#define PHMASK 0xFFFFF
#endif
__global__ void __launch_bounds__(NTHREADS, 2) mega_fwd(Params p) {
    extern __shared__ __attribute__((aligned(16))) unsigned char lds_raw[];
    cg::grid_group grid = cg::this_grid();
    Ctx c; c.in = p.in; c.ws = p.ws; c.dout = (unsigned char*)p.out; c.lds = (LAS unsigned char*)lds_raw;
    c.tid = threadIdx.x; c.lane = c.tid & 63; c.wave = __builtin_amdgcn_readfirstlane(c.tid >> 6); c.G = gridDim.x; c.bid = blockIdx.x;
    const int G = c.G, bid = c.bid;
#ifdef PROF_A
#ifndef PROF_SHIFT
#define PROF_SHIFT 1.0f
#endif
#define PROF_PTR ((unsigned long long*)(c.ws + WS_DEC + (size_t)MP * 64))
    if (blockIdx.x == 0 && threadIdx.x == 0) { for (int k = 0; k < 15; ++k) PROF_PTR[k] = 0; PROF_PTR[15] = __builtin_amdgcn_s_memrealtime(); }
#define STAMP(k) do { if (blockIdx.x == 0 && threadIdx.x == 0) { const unsigned long long t_ = __builtin_amdgcn_s_memrealtime(); PROF_PTR[k] += t_ - PROF_PTR[15]; PROF_PTR[15] = t_; } } while (0)
#else
#define STAMP(k) do { } while (0)
#endif
    unsigned* barw = (unsigned*)(c.ws + WS_BAR);
    volatile LAS unsigned* bst = (volatile LAS unsigned*)(c.lds + LDS_BYTES - 64);
    if (bid == 0) for (int i = threadIdx.x; i < XCD_BAR_WORDS; i += NTHREADS) barw[i] = 0u;
    if (threadIdx.x < 2) bst[threadIdx.x] = 0u;
    __syncthreads();
    if (PHMASK & 1) phase0(c);
    grid.sync(); STAMP(0);
    const XcdBarrier xbar = xcd_barrier_post(barw, bst);
#define GRID_BAR() xcd_barrier(xbar)
#pragma unroll 1
    for (int l = 0; l < DEPTH; ++l) {
        bf16_t* wb = c.wb(l);
        const int nMt = (l == DEPTH - 1) ? BATCH * SEQ / 256 : MP / 256;
        if (PHMASK & 2) dt_job(c, l);
        if (PHMASK & 4) { SchedPlain S{c.H(), wb + WB_IN, DM, DM, DM, MP / 256, 11, G, bid};
          EpiInProj E{c.ssq(), (bf16_t*)(c.ws + WS_UH), (bf16_t*)(c.ws + WS_PZ), (bf16_t*)(c.ws + WS_PXBC), (bf16_t*)(c.ws + WS_PRKVX)};
          pg8::gemm_phase(c.lds, S, E); }
        GRID_BAR(); STAMP(1);
        if (PHMASK & 8) { SchedS5 S{(const bf16_t*)(c.ws + WS_UH), wb + WB_SX, 256, G, bid}; EpiS5X E{(float*)(c.ws + WS_X)}; pg8::gemm_phase(c.lds, S, E); }
        if (PHMASK & 16) rwkv_prep(c, l);
        if (PHMASK & 32) ssd_prep(c, l);
        GRID_BAR(); STAMP(2);
        if (PHMASK & 64) s5_scan(c, l);
        if (PHMASK & 4096) ssd_states(c, l);
        if (PHMASK & 128) { SchedPlain S{(const bf16_t*)(c.ws + WS_L1IN), wb + WB_L1, 512, 512, 512, MP / 256, 2, G, bid}; EpiL1 E{(bf16_t*)(c.ws + WS_L1O)}; pg8::gemm_phase(c.lds, S, E); }
        GRID_BAR(); STAMP(3);
        ssd_chunk_scan(c, l);
        if (PHMASK & 256) { SchedL2 S{(const bf16_t*)(c.ws + WS_L1O), wb + WB_L2, G, bid}; EpiL2 E{(bf16_t*)(c.ws + WS_L2O), c.in[I_W0] + (size_t)l * 512, c.in[I_A0] + (size_t)l * 512}; pg8::gemm_phase(c.lds, S, E); }
        if (PHMASK & 512) { SchedS5 S{(const bf16_t*)(c.ws + WS_UH), wb + WB_SY, 512, G, bid}; EpiS5Y E{(bf16_t*)(c.ws + WS_YAPRE)}; pg8::gemm_phase(c.lds, S, E); }
        GRID_BAR(); STAMP(4);
        if (PHMASK & 1024) rwkv_scan(c, l);
        STAMP(5);
        if (PHMASK & 2048) ssd_outputs(c, l);
        GRID_BAR(); STAMP(6);
        if (PHMASK & 8192) rwkv_post(c, l);
        if (PHMASK & 16384) { SchedPlain S{(const bf16_t*)(c.ws + WS_YAPRE), wb + WB_GLU, 256, 256, 256, MP / 256, 2, G, bid}; EpiGLU E{(bf16_t*)(c.ws + WS_YA), c.in[I_GLUB] + (size_t)l * 512}; pg8::gemm_phase(c.lds, S, E); }
        GRID_BAR(); STAMP(7);
        if (PHMASK & 32768) { SchedProj S{c.H(), wb + WB_G, wb + WB_P, (const bf16_t*)(c.ws + WS_YA), (const bf16_t*)(c.ws + WS_YB), (const bf16_t*)(c.ws + WS_YC), nMt, G, bid};
          EpiProj E{c.ssq(), (const float*)(c.ws + WS_SSQB), c.ws + WS_PARK + (size_t)bid * 393216, (bf16_t*)(c.dout + DO_MERGED), opaque_tid()}; pg8::gemm_phase(c.lds, S, E); }
        GRID_BAR(); STAMP(8);
        if (PHMASK & 65536) { SchedPlain S{(const bf16_t*)(c.dout + DO_MERGED), wb + WB_O, DM, DM, DM, nMt, 4, G, bid}; EpiResid E{c.H(), c.ssq()}; pg8::gemm_phase(c.lds, S, E); }
        GRID_BAR(); STAMP(9);
        if (PHMASK & 131072) { SchedPlain S{c.H(), wb + WB_1, DM, DM, DM, nMt, 16, G, bid}; EpiUp E{c.ssq(), (bf16_t*)(c.ws + WS_ACT)}; pg8::gemm_phase(c.lds, S, E); }
        GRID_BAR(); STAMP(10);
        if (PHMASK & 262144) { SchedPlain S{(const bf16_t*)(c.ws + WS_ACT), wb + WB_2, DFF, DFF, DFF, nMt, 4, G, bid}; EpiResid E{c.H(), c.ssq()}; pg8::gemm_phase(c.lds, S, E); }
        GRID_BAR(); STAMP(11);
    }
    if (PHMASK & 524288) final_phase(c, p.out);
#ifdef PROF_A
    GRID_BAR(); STAMP(12);
    if (blockIdx.x == 0) {
        __syncthreads();
        float va = (float)(__hip_atomic_load(&PROF_PTR[PROF_A], __ATOMIC_RELAXED, __HIP_MEMORY_SCOPE_AGENT)) * 0.01f, vb = (float)(__hip_atomic_load(&PROF_PTR[PROF_B], __ATOMIC_RELAXED, __HIP_MEMORY_SCOPE_AGENT)) * 0.01f;
        va = exp2f(rintf(log2f(va * PROF_SHIFT) * 2.f) * 0.5f); vb = exp2f(rintf(log2f(vb * PROF_SHIFT) * 2.f) * 0.5f);
        for (int i = threadIdx.x; i < (1 << 20); i += NTHREADS) p.out[1 + i] = vb;
        if (threadIdx.x == 0) p.out[0] = 100.f * va;
    }
#endif
}

extern "C" void kernel_launch(void* const* d_in, const int* in_sizes, int n_in, void* d_out, int out_size, void* d_ws, size_t ws_size, hipStream_t stream) {
    static int grid = 0;
    if (grid == 0) {
        int dev = 0, cus = 0, per_cu = 0;
        if (n_in != N_INPUTS || out_size != BATCH * SEQ * DM || ws_size < WS_END) { fprintf(stderr, "kernel_launch: unexpected shapes (n_in %d out %d ws %zu)\n", n_in, out_size, ws_size); grid = -1; return; }
        (void)hipGetDevice(&dev); (void)hipDeviceGetAttribute(&cus, hipDeviceAttributeMultiprocessorCount, dev);
        (void)hipFuncSetAttribute((const void*)mega_fwd, hipFuncAttributeMaxDynamicSharedMemorySize, LDS_BYTES);
        (void)hipOccupancyMaxActiveBlocksPerMultiprocessor(&per_cu, (const void*)mega_fwd, NTHREADS, LDS_BYTES);
        if (per_cu < 1) { fprintf(stderr, "kernel_launch: occupancy query says %d blocks per CU\n", per_cu); per_cu = 1; }
        grid = cus * 1;
        if (grid != 256) fprintf(stderr, "kernel_launch: %d CUs (the scan phases are laid out for 256 workgroups)\n", grid);
    }
    if (grid < 0) return;
    Params p{};
    for (int i = 0; i < N_INPUTS; ++i) p.in[i] = (const float*)d_in[i];
    p.out = (float*)d_out; p.ws = (unsigned char*)d_ws; p.ph_lo = 0; p.ph_hi = 0;
    void* args[] = {&p};
    hipError_t e = hipLaunchCooperativeKernel((const void*)mega_fwd, dim3(grid), dim3(NTHREADS), args, LDS_BYTES, stream);
    if (e != hipSuccess) fprintf(stderr, "cooperative launch failed: %s (grid %d)\n", hipGetErrorString(e), grid);
}
```

```cpp
#include <hip/hip_runtime.h>
#include <hip/hip_cooperative_groups.h>
#include <cstdio>
#include <cstdint>
namespace cg = cooperative_groups;

#define LAS __attribute__((address_space(3)))
typedef unsigned short bf16_t;
typedef short bf16x8 __attribute__((ext_vector_type(8)));
typedef float f32x4 __attribute__((ext_vector_type(4)));
typedef unsigned u32x4 __attribute__((ext_vector_type(4)));
typedef unsigned u32x2 __attribute__((ext_vector_type(2)));

constexpr int BATCH = 8, SEQ = 4096, NMETA = 16, LEN = SEQ + NMETA, DM = 1024, DFF = 4096, DEPTH = 2;
constexpr int M_ROWS = BATCH * LEN;
constexpr int MP = 33024;
constexpr int N_IN = 5896;
constexpr int NCH16 = LEN / 16;
constexpr int S5ROWS = BATCH * NCH16;
constexpr int S5RP = 2304;
constexpr float EPS = 1e-6f;
constexpr int NTHREADS = 512, NWAVES = 8;

constexpr size_t QB = (size_t)MP * 256 * 2;
constexpr size_t WB_IN = 0;
constexpr size_t WB_G = WB_IN + (size_t)2816 * 1024;
constexpr size_t WB_P = WB_G + (size_t)3072 * 1024;
constexpr size_t WB_O = WB_P + (size_t)1024 * 1024;
constexpr size_t WB_1 = WB_O + (size_t)1024 * 1024;
constexpr size_t WB_2 = WB_1 + (size_t)4096 * 1024;
constexpr size_t WB_GLU = WB_2 + (size_t)1024 * 4096;
constexpr size_t WB_L1 = WB_GLU + (size_t)512 * 256;
constexpr size_t WB_L2 = WB_L1 + (size_t)512 * 512;
constexpr size_t WB_SX = WB_L2 + (size_t)1280 * 256;
constexpr size_t WB_SY = WB_SX + (size_t)16 * 256 * 256;
constexpr size_t WB_ELEMS = WB_SY + (size_t)16 * 256 * 512;
constexpr size_t WB_BYTES = WB_ELEMS * 2;
static_assert(WB_BYTES <= 5 * QB / 2, "weight block fits 2.5 Q");

constexpr size_t WS_H = 0;
constexpr size_t WS_WB0 = 4 * QB;
constexpr size_t WS_SMALL = 13 * QB / 2;
constexpr size_t WS_SSQ = WS_SMALL;
constexpr size_t WS_DT = WS_SSQ + (size_t)MP * 16 * 4;
constexpr size_t WS_DEC = WS_DT + (size_t)MP * 16 * 4;
static_assert(WS_DEC + (size_t)MP * 16 * 4 <= 7 * QB, "small region");
constexpr size_t WS_MIX = 7 * QB;
constexpr size_t WS_PXBC = WS_MIX;
constexpr size_t WS_YSSD = WS_MIX;
constexpr size_t WS_PARK = WS_MIX;
constexpr size_t WS_ACT = WS_MIX;
constexpr size_t WS_PRKVX = WS_MIX + 4 * QB;
constexpr size_t WS_L2O = WS_MIX + 4 * QB;
constexpr size_t WS_PZ = WS_MIX + 9 * QB;
constexpr size_t WS_UH = WS_MIX + 11 * QB;
constexpr size_t WS_X = WS_MIX + 53 * QB / 4;
constexpr size_t WS_YRW = WS_X;
constexpr size_t WS_L1IN = WS_MIX + 31 * QB / 2;
constexpr size_t WS_YAPRE = WS_L1IN;
constexpr size_t WS_L1O = WS_MIX + 35 * QB / 2;
constexpr size_t WS_YB = WS_L1O;
constexpr size_t WS_BC = WS_MIX + 39 * QB / 2;
constexpr size_t WS_YA = WS_BC;
constexpr size_t WS_YC = WS_BC + QB;
constexpr size_t WS_XS = WS_MIX + 43 * QB / 2;
constexpr size_t WS_END = WS_XS + 2 * QB;
static_assert(WS_END <= (size_t)512 << 20, "workspace map fits 512 MiB");
static_assert((size_t)16 * S5RP * 512 * 2 <= 9 * QB / 4 && (size_t)16 * S5RP * 256 * 4 <= 9 * QB / 4, "S5 buffers fit their slots");
static_assert((size_t)256 * 393216 <= 6 * QB, "gate park");
constexpr size_t DO_RKVP = 0;
constexpr size_t DO_MERGED = 0;
constexpr size_t DO_WB1 = 4 * QB;
static_assert(DO_WB1 + WB_BYTES <= (size_t)BATCH * SEQ * DM * 4, "d_out scratch map");

__device__ __forceinline__ unsigned f2bf(float f) { unsigned u = __builtin_bit_cast(unsigned, f); return (u + 0x7fffu + ((u >> 16) & 1u)) >> 16; }
typedef float f32x2_t_ __attribute__((ext_vector_type(2))); typedef __bf16 bf16x2_t_ __attribute__((ext_vector_type(2)));
__device__ __forceinline__ unsigned pk2(float lo, float hi) { const f32x2_t_ v = {lo, hi}; const bf16x2_t_ b = __builtin_convertvector(v, bf16x2_t_); return __builtin_bit_cast(unsigned, b); }
__device__ __forceinline__ float bflo(unsigned w) { return __builtin_bit_cast(float, w << 16); }
__device__ __forceinline__ float bfhi(unsigned w) { return __builtin_bit_cast(float, w & 0xffff0000u); }
__device__ __forceinline__ float bf1(bf16_t v) { return __builtin_bit_cast(float, (unsigned)v << 16); }
__device__ __forceinline__ float sigmoidf_(float x) { return 1.0f / (1.0f + __expf(-x)); }
__device__ __forceinline__ float siluf_(float x) { return x / (1.0f + __expf(-x)); }
__device__ __forceinline__ float tanhf_(float x) { x = fminf(fmaxf(x, -15.f), 15.f); const float t = __expf(2.f * x); return (t - 1.f) / (t + 1.f); }
__device__ __forceinline__ float softplusf_(float x) { return fmaxf(x, 0.f) + __logf(1.0f + __expf(-fabsf(x))); }
__device__ __forceinline__ float geluf_(float x) { const float u = 0.7978845608028654f * (x + 0.044715f * x * x * x); return 0.5f * x * (1.f + tanhf_(u)); }
__device__ __forceinline__ float wave_sum(float v) {
#pragma unroll
    for (int o = 1; o < 64; o <<= 1) v += __shfl_xor(v, o);
    return v;
}
__device__ __forceinline__ float sum16(float v) {
#pragma unroll
    for (int o = 1; o < 16; o <<= 1) v += __shfl_xor(v, o);
    return v;
}
template <int CTRL> __device__ __forceinline__ float dpp_mov(float x) {
    return __builtin_bit_cast(float, __builtin_amdgcn_update_dpp(0, __builtin_bit_cast(int, x), CTRL, 0xf, 0xf, true));
}
__device__ __forceinline__ float allred16(float x) {
    x += dpp_mov<0xB1>(x); x += dpp_mov<0x4E>(x); x += dpp_mov<0x141>(x); x += dpp_mov<0x140>(x); return x;
}
__device__ __forceinline__ void unpack8(const u32x4 w, float (&f)[8]) {
    f[0] = bflo(w.x); f[1] = bfhi(w.x); f[2] = bflo(w.y); f[3] = bfhi(w.y); f[4] = bflo(w.z); f[5] = bfhi(w.z); f[6] = bflo(w.w); f[7] = bfhi(w.w);
}
__device__ __forceinline__ u32x4 pack8(const float (&f)[8]) { u32x4 w; w.x = pk2(f[0], f[1]); w.y = pk2(f[2], f[3]); w.z = pk2(f[4], f[5]); w.w = pk2(f[6], f[7]); return w; }
__device__ __forceinline__ int opaque_tid(int) { int t = threadIdx.x; asm volatile("" : "+v"(t)); return t; }
__device__ __forceinline__ int row_of(int b, int t) { return t < NMETA ? BATCH * SEQ + b * NMETA + t : b * SEQ + (t - NMETA); }
__device__ __forceinline__ void bt_of(int m, int& b, int& t) { if (m < BATCH * SEQ) { b = m >> 12; t = NMETA + (m & (SEQ - 1)); } else { const int q = m - BATCH * SEQ; b = q >> 4; t = q & (NMETA - 1); } }
namespace pg8 {
constexpr int BM = 256, BK = 64, HALF = 128, HTB = HALF * BK * 2  , STAGE_BYTES = 8 * HTB;
__host__ __device__ __forceinline__ int lds_byte(int r, int c) { const int st = (r >> 4) * 2 + (c >> 5), rr = r & 15, cc = c & 31, ob = rr * 64 + cc * 2; return st * 1024 + (ob ^ (((ob >> 9) & 1) << 5)); }
__host__ __device__ __forceinline__ void stage_rc(int b, int& R, int& C) { const int st = b / 1024, sb = b % 1024, swz = sb ^ (((sb >> 9) & 1) << 5); R = (st >> 1) * 16 + swz / 64; C = (st & 1) * 32 + (swz % 64) / 2; }
__host__ __device__ __forceinline__ int perm32(int rho) { const int n = rho >> 4, i = rho & 15; return 8 * (i >> 2) + 4 * n + (i & 3); }

struct GU {
    const bf16_t* A;
    const bf16_t* B;
    int lda, ldb, nt;
    int pm, pn, kind;
};

template <bool SKIP_HI = false, class Epi, class Sched>
__device__ __forceinline__ void gemm_phase(LAS unsigned char* lds, int wave_s, const Sched& S, const Epi& E) {
    const int tid = opaque_tid(wave_s), wid = wave_s, lane = tid & 63, wr = wid >> 2, wc = wid & 3, fr = lane & 15, fq = lane >> 4;
#define PG8_VOFF(lda_, ldb_, a0, b0) do { int R0_, C0_; stage_rc(tid * 16, R0_, C0_); \
        a0 = (unsigned)(R0_ * (lda_) + C0_) * 2u; b0 = (unsigned)(((R0_ & ~31) + perm32(R0_ & 31)) * (ldb_) + C0_) * 2u; } while (0)
    const size_t kstep = (size_t)(BK * 2);
    const unsigned ldsw = (unsigned)wid * 1024u;
    const int aoff = lds_byte(wr * 64 + fr, fq * 8), boff = lds_byte(wc * 32 + fr, fq * 8);
#define PG8_SA(b, h) (((b) * 2 + (h)) * HTB)
#define PG8_SB(b, h) ((4 + (b) * 2 + (h)) * HTB)
#define PG8_STAGE(bufoff, gbase, v0, hs) do { \
        __builtin_amdgcn_global_load_lds((const unsigned*)((const char*)(gbase) + (v0)), (LAS unsigned*)(lds + (bufoff) + ldsw), 16, 0, 0); \
        __builtin_amdgcn_global_load_lds((const unsigned*)((const char*)(gbase) + ((hs) >> 1) + (v0)), (LAS unsigned*)(lds + (bufoff) + ldsw + 8192), 16, 0, 0); } while (0)
#define PG8_LDA(dst, b, h) do { _Pragma("unroll") for (int m = 0; m < 4; ++m) _Pragma("unroll") for (int k = 0; k < 2; ++k) dst[m][k] = *(const LAS bf16x8*)(lds + PG8_SA(b, h) + aoff + m * 2048 + k * 1024); } while (0)
#define PG8_LDB(dst, b, h) do { _Pragma("unroll") for (int n = 0; n < 2; ++n) _Pragma("unroll") for (int k = 0; k < 2; ++k) dst[n][k] = *(const LAS bf16x8*)(lds + PG8_SB(b, h) + boff + n * 2048 + k * 1024); } while (0)
#define PG8_MMA(ai, bj, At, Bt) do { __builtin_amdgcn_s_setprio(1); _Pragma("unroll") for (int m = 0; m < 4; ++m) _Pragma("unroll") for (int n = 0; n < 2; ++n) _Pragma("unroll") for (int k = 0; k < 2; ++k) \
        acc[ai][bj][m][n] = __builtin_amdgcn_mfma_f32_16x16x32_bf16(Bt[n][k], At[m][k], acc[ai][bj][m][n], 0, 0, 0); __builtin_amdgcn_s_setprio(0); } while (0)
#define PG8_WAIT_V(n) asm volatile("s_waitcnt vmcnt(" #n ")" ::: "memory")
#define PG8_WAIT_L(n) asm volatile("s_waitcnt lgkmcnt(" #n ")" ::: "memory")
#define PG8_BAR __builtin_amdgcn_s_barrier()
#define PG8_SCHED __builtin_amdgcn_sched_barrier(0)
    GU cur, nxt; int ui = 0;
    if (!S.next(0, cur)) return;
    f32x4 acc[2][2][4][2];
#pragma unroll
    for (int a = 0; a < 2; ++a)
#pragma unroll
        for (int b = 0; b < 2; ++b)
#pragma unroll
            for (int m = 0; m < 4; ++m)
#pragma unroll
                for (int n = 0; n < 2; ++n) acc[a][b][m][n] = (f32x4){0.f, 0.f, 0.f, 0.f};
    bf16x8 At[4][2], B0[2][2], B1[2][2];
    const char* cA = (const char*)cur.A; const char* cB = (const char*)cur.B;
    unsigned vA0, vB0; PG8_VOFF(cur.lda, cur.ldb, vA0, vB0);
    size_t hsA = (size_t)HALF * cur.lda * 2, hsB = (size_t)HALF * cur.ldb * 2;
    int nt = cur.nt; asm volatile("" : "+s"(nt));
    PG8_STAGE(PG8_SB(0, 0), cB, vB0, hsB); PG8_STAGE(PG8_SB(0, 1), cB + hsB, vB0, hsB); PG8_STAGE(PG8_SA(0, 0), cA, vA0, hsA); PG8_STAGE(PG8_SA(0, 1), cA + hsA, vA0, hsA);
    if (wr == 1) PG8_BAR;
    PG8_WAIT_V(2); PG8_BAR;
    PG8_STAGE(PG8_SB(1, 0), cB + kstep, vB0, hsB); PG8_STAGE(PG8_SA(1, 0), cA + kstep, vA0, hsA); PG8_STAGE(PG8_SB(1, 1), cB + hsB + kstep, vB0, hsB);
    PG8_WAIT_V(6); PG8_BAR;
    for (;;) {
        const bool has_next = S.next(ui + 1, nxt);
        const char* nA = has_next ? (const char*)nxt.A : cA; const char* nB = has_next ? (const char*)nxt.B : cB;
        unsigned nvA0 = vA0, nvB0 = vB0;
        if (has_next) PG8_VOFF(nxt.lda, nxt.ldb, nvA0, nvB0);
        const size_t nhsA = has_next ? (size_t)HALF * nxt.lda * 2 : hsA, nhsB = has_next ? (size_t)HALF * nxt.ldb * 2 : hsB;
        for (int t = 0; t < nt; t += 2) {
            const bool last = (t == nt - 2);
            const char* a1 = cA + (size_t)(t + 1) * kstep;
            const char* a2 = last ? nA : cA + (size_t)(t + 2) * kstep; const char* b2 = last ? nB : cB + (size_t)(t + 2) * kstep;
            const char* a3 = a2 + kstep; const char* b3 = b2 + kstep;
            const unsigned xA0 = last ? nvA0 : vA0, xB0 = last ? nvB0 : vB0;
            const size_t xhA = last ? nhsA : hsA, xhB = last ? nhsB : hsB;
            PG8_LDB(B0, 0, 0); PG8_LDB(B1, 0, 1); PG8_SCHED; PG8_LDA(At, 0, 0); PG8_STAGE(PG8_SA(1, 1), a1 + hsA, vA0, hsA);
            PG8_WAIT_V(8); PG8_WAIT_L(0); PG8_BAR; PG8_MMA(0, 0, At, B0); PG8_MMA(0, 1, At, B1); PG8_BAR; PG8_SCHED;
            PG8_LDA(At, 0, 1); PG8_STAGE(PG8_SB(0, 0), b2, xB0, xhB); PG8_STAGE(PG8_SB(0, 1), b2 + xhB, xB0, xhB); PG8_STAGE(PG8_SA(0, 0), a2, xA0, xhA);
            PG8_WAIT_V(8); PG8_WAIT_L(0); PG8_BAR; if constexpr (!SKIP_HI) { PG8_MMA(1, 0, At, B0); PG8_MMA(1, 1, At, B1); } PG8_BAR; PG8_SCHED;
            PG8_LDB(B0, 1, 0); PG8_LDB(B1, 1, 1); PG8_SCHED; PG8_LDA(At, 1, 0); PG8_STAGE(PG8_SA(0, 1), a2 + xhA, xA0, xhA);
            PG8_WAIT_V(8); PG8_WAIT_L(0); PG8_BAR; PG8_MMA(0, 0, At, B0); PG8_MMA(0, 1, At, B1); PG8_BAR; PG8_SCHED;
            PG8_LDA(At, 1, 1); PG8_STAGE(PG8_SB(1, 0), b3, xB0, xhB); PG8_STAGE(PG8_SB(1, 1), b3 + xhB, xB0, xhB); PG8_STAGE(PG8_SA(1, 0), a3, xA0, xhA);
            PG8_WAIT_V(8); PG8_WAIT_L(0); PG8_BAR; if constexpr (!SKIP_HI) { PG8_MMA(1, 0, At, B0); PG8_MMA(1, 1, At, B1); } PG8_BAR; PG8_SCHED;
        }
        if (wr == 0) PG8_BAR;
        const bool keep = E(acc, cur, wr, wc, fr, fq);
        if (!has_next) break;
        if (!keep) {
#pragma unroll
            for (int a = 0; a < 2; ++a)
#pragma unroll
                for (int b = 0; b < 2; ++b)
#pragma unroll
                    for (int m = 0; m < 4; ++m)
#pragma unroll
                        for (int n = 0; n < 2; ++n) acc[a][b][m][n] = (f32x4){0.f, 0.f, 0.f, 0.f};
        }
        cur = nxt; cA = nA; cB = nB; vA0 = nvA0; vB0 = nvB0; hsA = nhsA; hsB = nhsB; nt = cur.nt; asm volatile("" : "+s"(nt)); ++ui;
        if (wr == 1) PG8_BAR;
    }
    PG8_WAIT_V(0);
    PG8_BAR;
#undef PG8_VOFF
#undef PG8_SA
#undef PG8_SB
#undef PG8_STAGE
#undef PG8_LDA
#undef PG8_LDB
#undef PG8_MMA
#undef PG8_WAIT_V
#undef PG8_WAIT_L
#undef PG8_BAR
#undef PG8_SCHED
}

__device__ __forceinline__ bool tile_order(int i, int G, int c, int nM, int nN, int& pm, int& pn) {
    const int nwg = nM * nN; const long L = (long)i * G + c; if (L >= nwg) return false;
    int wgid = (int)L; { const int q = nwg / 8, r = nwg % 8, xcd = wgid % 8, off = wgid / 8; wgid = (xcd < r ? xcd * (q + 1) : r * (q + 1) + (xcd - r) * q) + off; }
    const int nig = 8 * nN, gid = wgid / nig, fm = gid * 8, gsz = (nM - fm) < 8 ? (nM - fm) : 8;
    pm = fm + ((wgid % nig) % gsz); pn = (wgid % nig) / gsz; return true;
}
}
using pg8::GU;
enum InIdx { I_X = 0, I_META, I_FNW, I_MIXNW, I_WIN, I_S5LRE, I_S5LIM, I_S5LS, I_S5BRE, I_S5BIM, I_S5CRE, I_S5CIM, I_S5D, I_GLUW, I_GLUB,
             I_CONVW, I_CONVB, I_ALOG, I_DTB, I_SSDD, I_SSDNW, I_MURKV, I_MUWAG, I_W0, I_W1, I_W2, I_A0, I_A1, I_A2, I_G1, I_G2, I_KK, I_KA, I_RK, I_LNW, I_LNB,
             I_PA, I_PB, I_PC, I_WOUT, I_MLPNW, I_MLPW1, I_MLPW2, N_INPUTS };
struct Params { const float* in[N_INPUTS]; float* out; unsigned char* ws; int ph_lo, ph_hi; };

struct Ctx {
    const float* const* in; unsigned char* ws; unsigned char* dout;
    LAS unsigned char* lds;
    int tid, lane, wave, G, bid;
    __device__ __forceinline__ bf16_t* wb(int layer) const { return (bf16_t*)(layer == 0 ? ws + WS_WB0 : dout + DO_WB1); }
    __device__ __forceinline__ bf16_t* H() const { return (bf16_t*)(ws + WS_H); }
    __device__ __forceinline__ float* ssq() const { return (float*)(ws + WS_SSQ); }
};
__device__ __forceinline__ Ctx relaunder(const Ctx& c0) {
    Ctx c = c0; c.tid = opaque_tid(c0.wave); c.lane = c.tid & 63;
    return c;
}
__device__ __forceinline__ float row_scale(const float* ssq, int row) {
    const f32x4* p = (const f32x4*)(ssq + (size_t)row * 16);
    const f32x4 a = p[0], b = p[1], c = p[2], d = p[3];
    const float s = ((a.x + a.y) + (a.z + a.w)) + ((b.x + b.y) + (b.z + b.w)) + ((c.x + c.y) + (c.z + c.w)) + ((d.x + d.y) + (d.z + d.w));
    return __builtin_amdgcn_rsqf(s * (1.0f / DM) + EPS);
}

struct SchedPlain {
    const bf16_t* A; const bf16_t* B; int lda, ldb, K, nM, nN, G, c, pm0;
    __device__ __forceinline__ bool next(int i, GU& u) const {
        int pm, pn; if (!pg8::tile_order(i, G, c, nM, nN, pm, pn)) return false;
        pm += pm0;
        u.A = A + (size_t)pm * 256 * lda; u.B = B + (size_t)pn * 256 * ldb; u.lda = lda; u.ldb = ldb; u.nt = K / 64; u.pm = pm; u.pn = pn; u.kind = 0; return true;
    }
};
struct SchedS5 {
    const bf16_t* UH; const bf16_t* W; int K, G, c;
    __device__ __forceinline__ bool next(int i, GU& u) const {
        const int L = i * G + c; if (L >= 144) return false;
        const int g = L / 9, pm = L % 9;
        u.A = UH + ((size_t)g * S5RP + (size_t)pm * 256) * 512; u.B = W + (size_t)g * 256 * K; u.lda = 512; u.ldb = K; u.nt = K / 64; u.pm = pm; u.pn = 0; u.kind = g; return true;
    }
};
struct SchedL2 {
    const bf16_t* L1o; const bf16_t* W; int G, c, nM, pm0;
    __device__ __forceinline__ bool next(int i, GU& u) const {
        int pm, pn; if (!pg8::tile_order(i, G, c, nM, 5, pm, pn)) return false;
        pm += pm0;
        const int koff = pn < 2 ? 0 : (pn < 4 ? 128 : 256);
        u.A = L1o + (size_t)pm * 256 * 512 + koff; u.B = W + (size_t)pn * 256 * 256; u.lda = 512; u.ldb = 256; u.nt = 4; u.pm = pm; u.pn = pn; u.kind = 0; return true;
    }
};
struct SchedProj {
    const bf16_t* Hb; const bf16_t* Wg; const bf16_t* Wp; const bf16_t* ya; const bf16_t* yb; const bf16_t* yc; int nM, G, c, pm0;
    __device__ __forceinline__ bool next(int i, GU& u) const {
        const int ti = i / 6, sub = i - ti * 6; int pm, pn;
        if (!pg8::tile_order(ti, G, c, nM, 4, pm, pn)) return false;
        pm += pm0;
        u.pm = pm; u.pn = pn; u.kind = sub;
        if (sub < 3) { u.A = Hb + (size_t)pm * 256 * DM; u.lda = DM; u.B = Wg + ((size_t)sub * 1024 + (size_t)pn * 256) * DM; u.ldb = DM; u.nt = 16; }
        else if (sub == 3) { u.A = ya + (size_t)pm * 256 * 256; u.lda = 256; u.B = Wp + (size_t)pn * 256 * DM; u.ldb = DM; u.nt = 4; }
        else if (sub == 4) { u.A = yb + (size_t)pm * 256 * 512; u.lda = 512; u.B = Wp + (size_t)pn * 256 * DM + 256; u.ldb = DM; u.nt = 8; }
        else { u.A = yc + (size_t)pm * 256 * 256; u.lda = 256; u.B = Wp + (size_t)pn * 256 * DM + 768; u.ldb = DM; u.nt = 4; }
        return true;
    }
};

typedef f32x4 Acc[2][2][4][2];
#define EPI_ROWS_BEGIN  _Pragma("unroll") for (int ai = 0; ai < 2; ++ai) _Pragma("unroll") for (int m = 0; m < 4; ++m) { const int rl = ai * 128 + wr * 64 + m * 16 + fr; const int row = u.pm * 256 + rl; (void)rl;
#define EPI_ROWS_END    asm volatile("" ::: "memory"); }
#define EPI_COL(bj) ((bj) * 128 + wc * 32 + fq * 8)

struct EpiInProj {
    const float* ssq; bf16_t* UH; bf16_t* Pz; bf16_t* Pxbc; bf16_t* Prkvx;
    __device__ __forceinline__ bool operator()(Acc& acc, const GU& u, int wr, int wc, int fr, int fq) const {
        EPI_ROWS_BEGIN
            if (row < M_ROWS) {
                const float s = row_scale(ssq, row);
                int b, t; bt_of(row, b, t);
#pragma unroll
                for (int bj = 0; bj < 2; ++bj) {
                    const int col = EPI_COL(bj);
                    const f32x4 v0 = acc[ai][bj][m][0] * s, v1 = acc[ai][bj][m][1] * s;
                    u32x4 w; w.x = pk2(v0[0], v0[1]); w.y = pk2(v0[2], v0[3]); w.z = pk2(v1[0], v1[1]); w.w = pk2(v1[2], v1[3]);
                    bf16_t* dst;
                    if (u.pn == 0) { const int g = col >> 4, hh = col & 15; dst = UH + ((size_t)g * S5RP + (size_t)(b * NCH16 + (t >> 4))) * 512 + (t & 15) * 16 + hh; }
                    else if (u.pn < 3) dst = Pz + (size_t)row * 512 + (u.pn - 1) * 256 + col;
                    else if (u.pn < 7) dst = Pxbc + (size_t)row * 1024 + (u.pn - 3) * 256 + col;
                    else dst = Prkvx + (size_t)row * 1024 + (u.pn - 7) * 256 + col;
                    *(u32x4*)dst = w;
                }
            }
        EPI_ROWS_END
        return false;
    }
};
struct EpiS5X {
    float* X;
    __device__ __forceinline__ bool operator()(Acc& acc, const GU& u, int wr, int wc, int fr, int fq) const {
        EPI_ROWS_BEGIN
            float* rp = X + ((size_t)u.kind * S5RP + row) * 256;
#pragma unroll
            for (int bj = 0; bj < 2; ++bj) { const int col = EPI_COL(bj); *(f32x4*)(rp + col) = acc[ai][bj][m][0]; *(f32x4*)(rp + col + 4) = acc[ai][bj][m][1]; }
        EPI_ROWS_END
        return false;
    }
};
struct EpiS5Y {
    bf16_t* yapre;
    __device__ __forceinline__ bool operator()(Acc& acc, const GU& u, int wr, int wc, int fr, int fq) const {
        EPI_ROWS_BEGIN
            if (row < S5ROWS) {
                const int b = row / NCH16, c = row - b * NCH16;
#pragma unroll
                for (int bj = 0; bj < 2; ++bj) {
                    const int col = EPI_COL(bj), i = col >> 4, hh = col & 15;
                    const f32x4 v0 = acc[ai][bj][m][0], v1 = acc[ai][bj][m][1];
                    u32x4 w; w.x = pk2(geluf_(v0[0]), geluf_(v0[1])); w.y = pk2(geluf_(v0[2]), geluf_(v0[3])); w.z = pk2(geluf_(v1[0]), geluf_(v1[1])); w.w = pk2(geluf_(v1[2]), geluf_(v1[3]));
                    *(u32x4*)(yapre + (size_t)row_of(b, c * 16 + i) * 256 + u.kind * 16 + hh) = w;
                }
            }
        EPI_ROWS_END
        return false;
    }
};
struct EpiL1 {
    bf16_t* L1o;
    __device__ __forceinline__ bool operator()(Acc& acc, const GU& u, int wr, int wc, int fr, int fq) const {
        EPI_ROWS_BEGIN
#pragma unroll
            for (int bj = 0; bj < 2; ++bj) {
                const int col = EPI_COL(bj); const int mode = u.pn * 2 + bj;
                f32x4 v0 = acc[ai][bj][m][0], v1 = acc[ai][bj][m][1]; float f[8] = {v0[0], v0[1], v0[2], v0[3], v1[0], v1[1], v1[2], v1[3]};
#pragma unroll
                for (int e = 0; e < 8; ++e) f[e] = mode == 0 ? tanhf_(f[e]) : (mode == 1 ? f[e] : (mode == 2 ? sigmoidf_(f[e]) : 0.f));
                *(u32x4*)(L1o + (size_t)row * 512 + u.pn * 256 + col) = pack8(f);
            }
        EPI_ROWS_END
        return false;
    }
};
struct EpiL2 {
    bf16_t* L2o; const float* w0; const float* a0;
    __device__ __forceinline__ bool operator()(Acc& acc, const GU& u, int wr, int wc, int fr, int fq) const {
        EPI_ROWS_BEGIN
#pragma unroll
            for (int bj = 0; bj < 2; ++bj) {
                const int col = EPI_COL(bj);
                f32x4 v0 = acc[ai][bj][m][0], v1 = acc[ai][bj][m][1]; float f[8] = {v0[0], v0[1], v0[2], v0[3], v1[0], v1[1], v1[2], v1[3]};
                if (u.pn < 2) {
                    const float* bp = w0 + u.pn * 256 + col;
#pragma unroll
                    for (int e = 0; e < 8; ++e) { const float v = bp[e] + f[e]; f[e] = -__expf(-softplusf_(-v) - 0.5f); }
                } else if (u.pn < 4) {
                    const float* bp = a0 + (u.pn - 2) * 256 + col;
#pragma unroll
                    for (int e = 0; e < 8; ++e) f[e] = sigmoidf_(bp[e] + f[e]);
                }
                *(u32x4*)(L2o + (size_t)row * 1280 + u.pn * 256 + col) = pack8(f);
            }
        EPI_ROWS_END
        return false;
    }
};
struct EpiGLU {
    bf16_t* ya; const float* bias;
    __device__ __forceinline__ bool operator()(Acc& acc, const GU& u, int wr, int wc, int fr, int fq) const {
        const int lc = wc * 32 + fq * 8, oc = u.pn * 128 + lc;
        float bv[8], bg[8];
#pragma unroll
        for (int e = 0; e < 8; ++e) { bv[e] = bias[oc + e]; bg[e] = bias[256 + oc + e]; }
        EPI_ROWS_BEGIN
            const f32x4 a0 = acc[ai][0][m][0], a1 = acc[ai][0][m][1], g0 = acc[ai][1][m][0], g1 = acc[ai][1][m][1];
            float v[8] = {a0[0], a0[1], a0[2], a0[3], a1[0], a1[1], a1[2], a1[3]}, g[8] = {g0[0], g0[1], g0[2], g0[3], g1[0], g1[1], g1[2], g1[3]};
#pragma unroll
            for (int e = 0; e < 8; ++e) v[e] = (v[e] + bv[e]) * sigmoidf_(g[e] + bg[e]);
            *(u32x4*)(ya + (size_t)row * 256 + oc) = pack8(v);
        EPI_ROWS_END
        return false;
    }
};
struct EpiProj {
    const float* ssq; const float* ssqb; unsigned char* park; bf16_t* merged; int tid;
    __device__ __forceinline__ bool operator()(Acc& acc, const GU& u, int wr, int wc, int fr, int fq) const {
        const int k = u.kind;
        EPI_ROWS_BEGIN
            float s = 1.f; if (k < 3) s = row_scale(ssq, row < M_ROWS ? row : 0);
            else if (k < 5) { s = __builtin_amdgcn_rsqf(ssqb[row < M_ROWS ? row : 0] * (1.0f / 512.f) + EPS); if (k == 3) s = __builtin_amdgcn_rcpf(s); }
#pragma unroll
            for (int bj = 0; bj < 2; ++bj) {
                const int q = (ai * 2 + bj) * 4 + m;
                f32x4& v0 = acc[ai][bj][m][0]; f32x4& v1 = acc[ai][bj][m][1];
                if (k < 3) {
                    float f[8] = {v0[0], v0[1], v0[2], v0[3], v1[0], v1[1], v1[2], v1[3]};
#pragma unroll
                    for (int e = 0; e < 8; ++e) f[e] = sigmoidf_(f[e] * s);
                    *(u32x4*)(park + ((size_t)(k * 16 + q) * NTHREADS + tid) * 16) = pack8(f);
                } else {
                    float num[8], den[8];
                    unpack8(*(const u32x4*)(park + ((size_t)((k - 3) * 16 + q) * NTHREADS + tid) * 16), num);
                    if (k < 5) { unpack8(*(const u32x4*)(park + ((size_t)((k - 2) * 16 + q) * NTHREADS + tid) * 16), den);
#pragma unroll
                        for (int e = 0; e < 8; ++e) num[e] = num[e] * __builtin_amdgcn_rcpf(den[e]) * s; }
                    v0[0] *= num[0]; v0[1] *= num[1]; v0[2] *= num[2]; v0[3] *= num[3]; v1[0] *= num[4]; v1[1] *= num[5]; v1[2] *= num[6]; v1[3] *= num[7];
                    if (k == 5) { u32x4 w; w.x = pk2(v0[0], v0[1]); w.y = pk2(v0[2], v0[3]); w.z = pk2(v1[0], v1[1]); w.w = pk2(v1[2], v1[3]);
                        *(u32x4*)(merged + (size_t)row * DM + u.pn * 256 + EPI_COL(bj)) = w; }
                }
            }
        EPI_ROWS_END
        return k == 3 || k == 4;
    }
};
struct EpiResid {
    bf16_t* H; float* ssq;
    __device__ __forceinline__ bool operator()(Acc& acc, const GU& u, int wr, int wc, int fr, int fq) const {
        EPI_ROWS_BEGIN
            float ss = 0.f;
            if (row < M_ROWS) {
#pragma unroll
                for (int bj = 0; bj < 2; ++bj) {
                    bf16_t* hp = H + (size_t)row * DM + u.pn * 256 + EPI_COL(bj);
                    float f[8]; unpack8(*(const u32x4*)hp, f);
                    const f32x4 v0 = acc[ai][bj][m][0], v1 = acc[ai][bj][m][1];
                    f[0] += v0[0]; f[1] += v0[1]; f[2] += v0[2]; f[3] += v0[3]; f[4] += v1[0]; f[5] += v1[1]; f[6] += v1[2]; f[7] += v1[3];
#pragma unroll
                    for (int e = 0; e < 8; ++e) ss += f[e] * f[e];
                    *(u32x4*)hp = pack8(f);
                }
            }
            ss += __shfl_xor(ss, 16); ss += __shfl_xor(ss, 32);
            if (fq == 0 && row < M_ROWS) ssq[(size_t)row * 16 + u.pn * 4 + wc] = ss;
        EPI_ROWS_END
        return false;
    }
};
struct EpiUp {
    const float* ssq; bf16_t* act;
    __device__ __forceinline__ bool operator()(Acc& acc, const GU& u, int wr, int wc, int fr, int fq) const {
        EPI_ROWS_BEGIN
            const float s = row_scale(ssq, row < M_ROWS ? row : 0);
#pragma unroll
            for (int bj = 0; bj < 2; ++bj) {
                const f32x4 v0 = acc[ai][bj][m][0] * s, v1 = acc[ai][bj][m][1] * s; float f[8] = {v0[0], v0[1], v0[2], v0[3], v1[0], v1[1], v1[2], v1[3]};
#pragma unroll
                for (int e = 0; e < 8; ++e) { const float r = fmaxf(f[e], 0.f); f[e] = r * r; }
                *(u32x4*)(act + (size_t)row * DFF + u.pn * 256 + EPI_COL(bj)) = pack8(f);
            }
        EPI_ROWS_END
        return false;
    }
};
typedef __attribute__((address_space(1))) unsigned gu32;
#define XB_TMO      128
#define XB_XCNT(j)  (256  + 64 * (j))
#define XB_XSUB(j)  (1280 + 64 * (j))
#define XB_XGEN(j)  (2304 + 64 * (j))
#define XB_TOP      3328
#define XB_TOPGEN   3392
#define XCD_BAR_WORDS 3456
#define XB_SPIN_CAP (1u << 18)

__device__ __forceinline__ unsigned xb_ld(unsigned* p)              { return __hip_atomic_load(p, __ATOMIC_RELAXED, __HIP_MEMORY_SCOPE_AGENT); }
__device__ __forceinline__ unsigned xb_add(unsigned* p, unsigned v) { return __hip_atomic_fetch_add(p, v, __ATOMIC_RELAXED, __HIP_MEMORY_SCOPE_AGENT); }
__device__ __forceinline__ unsigned xb_xcc_id() { return (unsigned)__builtin_amdgcn_s_getreg((3 << 11) | 20) & 0xFu; }
#define XB_SPIN(cond, bar) do { unsigned _sp = 0; while (cond) { __builtin_amdgcn_s_sleep(1); \
    if ((++_sp & 255u) == 0u) { if (xb_ld(&(bar)[XB_TMO])) break; if (_sp > XB_SPIN_CAP) { atomicAdd(&(bar)[XB_TMO], 1u); break; } } } } while (0)

struct XcdBarrier {
    unsigned* bar; unsigned x;
    volatile LAS unsigned* st;
};

__device__ __forceinline__ XcdBarrier xcd_barrier_post(unsigned* bar, volatile LAS unsigned* st) {
    XcdBarrier b; b.bar = bar; b.x = xb_xcc_id(); b.st = st;
    if (threadIdx.x == 0) (void)xb_add(&bar[XB_XCNT(b.x)], 1u);
    return b;
}
__device__ __forceinline__ void xcd_barrier_complete(unsigned* bar, unsigned x, unsigned& nloc, unsigned& nx) {
    const unsigned G = gridDim.x * gridDim.y * gridDim.z;
    unsigned sum, cnt, mine, sp = 0u;
    for (;;) {
        sum = 0u; cnt = 0u; mine = 0u;
#pragma unroll
        for (unsigned j = 0; j < 16; ++j) { const unsigned c = xb_ld(&bar[XB_XCNT(j)]); sum += c; cnt += (c > 0u) ? 1u : 0u; mine = (j == x) ? c : mine; }
        if (sum == G) break;
        __builtin_amdgcn_s_sleep(1);
        if ((++sp & 255u) == 0u) { if (xb_ld(&bar[XB_TMO])) break; if (sp > XB_SPIN_CAP) { atomicAdd(&bar[XB_TMO], 1u); break; } }
    }
    nloc = mine > 0u ? mine : 1u; nx = cnt > 0u ? cnt : 1u;
}

__device__ __forceinline__ void xcd_barrier(const XcdBarrier& b, int wave_s) {
    const bool xb_t0 = threadIdx.x == 0; (void)wave_s;
    asm volatile("s_waitcnt vmcnt(0)" ::: "memory");
    __syncthreads();
    if (xb_t0) {
        unsigned* bar = b.bar;
        __builtin_amdgcn_s_waitcnt(0);
        unsigned nloc = b.st[0], nx = b.st[1];
        if (nloc == 0u) { xcd_barrier_complete(bar, b.x, nloc, nx); b.st[0] = nloc; b.st[1] = nx; }
        const unsigned old = xb_add(&bar[XB_XSUB(b.x)], 1u);
        const unsigned gen = old / nloc;
        if (old + 1u == (gen + 1u) * nloc) {
            __builtin_amdgcn_fence(__ATOMIC_RELEASE, "agent");
            asm volatile("s_waitcnt vmcnt(0)" ::: "memory");
            const unsigned og = xb_add(&bar[XB_TOP], 1u);
            const unsigned tg = og / nx;
            if (og + 1u == (tg + 1u) * nx) xb_add(&bar[XB_TOPGEN], 1u);
            else XB_SPIN(xb_ld(&bar[XB_TOPGEN]) == tg, bar);
            __builtin_amdgcn_fence(__ATOMIC_ACQUIRE, "agent");
            xb_add(&bar[XB_XGEN(b.x)], 1u);
            asm volatile("s_waitcnt vmcnt(0)" ::: "memory");
        } else {
            XB_SPIN(xb_ld(&bar[XB_XGEN(b.x)]) == gen, bar);
            __builtin_amdgcn_fence(__ATOMIC_ACQUIRE, "agent");
            asm volatile("s_waitcnt vmcnt(0)" ::: "memory");
        }
    }
    __syncthreads();
}

struct TJob { const float* src; int ld, col0, K, N; bf16_t* dst; int dld, dk0, rmode, row0; const float* ksc; };
constexpr int N_TJOBS = 27;
__device__ __forceinline__ void get_tjob(const Ctx& c, int l, int j, TJob& t) {
    bf16_t* wb = c.wb(l);
    const float* win = c.in[I_WIN] + (size_t)l * DM * N_IN;
    t.rmode = 0; t.ksc = nullptr; t.dk0 = 0; t.col0 = 0; t.row0 = 0;
    if (j < 5) {
        t.src = win; t.ld = N_IN; t.K = DM; t.dld = DM; t.ksc = c.in[I_MIXNW] + l * DM; t.dst = wb + WB_IN;
        if (j == 0) { t.col0 = 0; t.N = 256; t.row0 = 0; }
        else if (j == 1) { t.col0 = 256; t.N = 512; t.row0 = 256; }
        else if (j == 2) { t.col0 = 768; t.N = 1024; t.row0 = 768; }
        else if (j == 3) { t.col0 = 1800; t.N = 1024; t.row0 = 1792; }
        else { t.col0 = 2824; t.N = 3072; t.row0 = 0; t.dst = wb + WB_G; }
    } else if (j == 5) { t.src = c.in[I_PA] + (size_t)l * 256 * DM; t.ld = DM; t.K = 256; t.N = DM; t.dst = wb + WB_P; t.dld = DM; t.dk0 = 0; }
    else if (j == 6) { t.src = c.in[I_PB] + (size_t)l * 512 * DM; t.ld = DM; t.K = 512; t.N = DM; t.dst = wb + WB_P; t.dld = DM; t.dk0 = 256; t.ksc = c.in[I_SSDNW] + (size_t)l * 512; }
    else if (j == 7) { t.src = c.in[I_PC] + (size_t)l * 256 * DM; t.ld = DM; t.K = 256; t.N = DM; t.dst = wb + WB_P; t.dld = DM; t.dk0 = 768; }
    else if (j == 8) { t.src = c.in[I_WOUT] + (size_t)l * DM * DM; t.ld = DM; t.K = DM; t.N = DM; t.dst = wb + WB_O; t.dld = DM; }
    else if (j == 9) { t.src = c.in[I_MLPW1] + (size_t)l * DM * DFF; t.ld = DFF; t.K = DM; t.N = DFF; t.dst = wb + WB_1; t.dld = DM; t.ksc = c.in[I_MLPNW] + l * DM; }
    else if (j == 10) { t.src = c.in[I_MLPW2] + (size_t)l * DFF * DM; t.ld = DM; t.K = DFF; t.N = DM; t.dst = wb + WB_2; t.dld = DFF; }
    else if (j == 11) { t.src = c.in[I_GLUW] + (size_t)l * 256 * 512; t.ld = 512; t.K = 256; t.N = 512; t.dst = wb + WB_GLU; t.dld = 256; t.rmode = 1; }
    else if (j < 22) {
        const int q = j - 12;
        t.K = 256; t.dst = wb + WB_L1; t.dld = 512;
        if (q < 4) { const int d = q >> 1, hf = q & 1; t.src = c.in[I_W1] + ((size_t)l * 2 + d) * 256 * 64; t.ld = 64; t.N = 64; t.row0 = d * 64; t.dk0 = hf * 256; if (hf) t.ksc = c.in[I_MUWAG] + ((size_t)l * 3 + 0) * 256; }
        else if (q < 8) { const int d = (q - 4) >> 1, hf = q & 1; t.src = c.in[I_A1] + ((size_t)l * 2 + d) * 256 * 64; t.ld = 64; t.N = 64; t.row0 = 128 + d * 64; t.dk0 = hf * 256; if (hf) t.ksc = c.in[I_MUWAG] + ((size_t)l * 3 + 1) * 256; }
        else { const int hf = q & 1; t.src = c.in[I_G1] + (size_t)l * 256 * 128; t.ld = 128; t.N = 128; t.row0 = 256; t.dk0 = hf * 256; if (hf) t.ksc = c.in[I_MUWAG] + ((size_t)l * 3 + 2) * 256; }
    } else {
        const int q = j - 22;
        t.dst = wb + WB_L2; t.dld = 256; t.ld = 256; t.N = 256;
        if (q < 2) { t.src = c.in[I_W2] + ((size_t)l * 2 + q) * 64 * 256; t.K = 64; t.row0 = q * 256; t.dk0 = q * 64; }
        else if (q < 4) { const int d = q - 2; t.src = c.in[I_A2] + ((size_t)l * 2 + d) * 64 * 256; t.K = 64; t.row0 = (2 + d) * 256; t.dk0 = d * 64; }
        else { t.src = c.in[I_G2] + (size_t)l * 128 * 256; t.K = 128; t.row0 = 4 * 256; t.dk0 = 0; }
    }
}
__device__ __forceinline__ int tjob_items(const TJob& t) { return (t.K / 64) * (t.N / 32); }
__device__ __forceinline__ void transpose_item(const TJob& t, LAS float* scr, int item, int lane) {
    const int nblk = t.N / 32, kb = item / nblk, nb = item % nblk, k0 = 64 * kb, n0 = 32 * nb;
#pragma unroll 8
    for (int i = 0; i < 32; ++i) { const int kk = 2 * i + (lane >> 5); float v = t.src[(size_t)(k0 + kk) * t.ld + t.col0 + n0 + (lane & 31)]; if (t.ksc) v *= t.ksc[k0 + kk]; scr[kk * 33 + (lane & 31)] = v; }
    asm volatile("s_waitcnt lgkmcnt(0)" ::: "memory");
    const int cc = lane & 7;
#pragma unroll
    for (int j = 0; j < 4; ++j) {
        const int n = (lane >> 3) + 8 * j; const LAS float* s = scr + (8 * cc) * 33 + n;
        u32x4 o; o.x = pk2(s[0 * 33], s[1 * 33]); o.y = pk2(s[2 * 33], s[3 * 33]); o.z = pk2(s[4 * 33], s[5 * 33]); o.w = pk2(s[6 * 33], s[7 * 33]);
        const int nn = n0 + n; int drow;
        if (t.rmode == 0) drow = t.row0 + nn; else drow = nn < 256 ? (nn >> 7) * 256 + (nn & 127) : ((nn - 256) >> 7) * 256 + 128 + ((nn - 256) & 127);
        *(u32x4*)(t.dst + (size_t)drow * t.dld + t.dk0 + k0 + 8 * cc) = o;
    }
    asm volatile("s_waitcnt lgkmcnt(0)" ::: "memory");
}

__device__ __forceinline__ void s5_build(const Ctx& cx_, int l, int g) {
    const Ctx c = relaunder(cx_);
    LAS float* F = (LAS float*)c.lds;
    LAS float* pwr = F;
    LAS float* pwi = pwr + 2176;
    LAS float* cor = pwi + 2176;
    LAS float* coi = cor + 128;
    LAS float* Cr = coi + 128;
    LAS float* Ci = Cr + 1024;
    LAS float* Br = Ci + 1024;
    LAS float* Bi = Br + 1024;
    LAS float* kr = Bi + 1024;
    LAS float* ki = kr + 1984;
    LAS float* Kd = ki + 1984;
    const int tid = c.tid;
    if (tid < 128) {
        const int d = tid >> 6, n = tid & 63; const size_t li_ = (((size_t)l * 2 + d) * 16 + g) * 64 + n;
        const float lr = c.in[I_S5LRE][li_], li = c.in[I_S5LIM][li_], step = expf(c.in[I_S5LS][((size_t)l * 2 + d) * 16 + g]);
        for (int k = 0; k <= 16; ++k) { const float mag = expf((float)k * lr * step), ang = (float)k * li * step; float sn, cs; sincosf(ang, &sn, &cs); pwr[(d * 17 + k) * 64 + n] = mag * cs; pwi[(d * 17 + k) * 64 + n] = mag * sn; }
        const float mag1 = expf(lr * step); float sn, cs; sincosf(li * step, &sn, &cs); const float abr = mag1 * cs, abi = mag1 * sn, den = lr * lr + li * li;
        cor[d * 64 + n] = ((abr - 1.f) * lr + abi * li) / den; coi[d * 64 + n] = (abi * lr - (abr - 1.f) * li) / den;
    }
    for (int i = tid; i < 1024; i += NTHREADS) {
        Cr[i] = c.in[I_S5CRE][((size_t)l * 16 + g) * 1024 + i]; Ci[i] = c.in[I_S5CIM][((size_t)l * 16 + g) * 1024 + i];
        Br[i] = c.in[I_S5BRE][((size_t)l * 16 + g) * 1024 + i]; Bi[i] = c.in[I_S5BIM][((size_t)l * 16 + g) * 1024 + i];
    }
    __syncthreads();
    for (int i = tid; i < 31 * 64; i += NTHREADS) {
        const int dd = i / 64 - 15, n = i & 63; float r, im;
        if (dd > 0) { const float pr = pwr[(0 * 17 + dd) * 64 + n], pi = pwi[(0 * 17 + dd) * 64 + n]; r = pr * cor[n] - pi * coi[n]; im = pr * coi[n] + pi * cor[n]; }
        else if (dd < 0) { const float pr = pwr[(1 * 17 - dd) * 64 + n], pi = pwi[(1 * 17 - dd) * 64 + n]; r = pr * cor[64 + n] - pi * coi[64 + n]; im = pr * coi[64 + n] + pi * cor[64 + n]; }
        else { r = cor[n] + cor[64 + n]; im = coi[n] + coi[64 + n]; }
        kr[i] = r; ki[i] = im;
    }
    __syncthreads();
    for (int i = tid; i < 31 * 256; i += NTHREADS) {
        const int ddi = i >> 8, h = (i >> 4) & 15, hp = i & 15; float a = 0.f;
        for (int n = 0; n < 64; ++n) { const float cr = Cr[h * 64 + n], ci = Ci[h * 64 + n], xr = kr[ddi * 64 + n], xi = ki[ddi * 64 + n]; const float pr = cr * xr - ci * xi, pi = cr * xi + ci * xr; a += pr * Br[n * 16 + hp] - pi * Bi[n * 16 + hp]; }
        Kd[i] = a;
    }
    __syncthreads();
    bf16_t* SX = c.wb(l) + WB_SX + (size_t)g * 256 * 256; bf16_t* SY = c.wb(l) + WB_SY + (size_t)g * 256 * 512;
    const float* dsk = c.in[I_S5D] + (size_t)l * 256 + g * 16;
    for (int u = tid; u < 256 * 64; u += NTHREADS) {
        const int o = u >> 6, kk0 = (u & 63) * 8, i = o >> 4, h = o & 15; float v[8];
        if (kk0 < 256) { const int j = kk0 >> 4, hp0 = kk0 & 15;
#pragma unroll
            for (int e = 0; e < 8; ++e) v[e] = Kd[(i - j + 15) * 256 + h * 16 + hp0 + e] + ((i == j && h == hp0 + e) ? dsk[h] : 0.f);
        } else { const int q = kk0 - 256, d = q >> 7, part = (q >> 6) & 1, n0 = q & 63, ex = d == 0 ? i + 1 : 16 - i;
#pragma unroll
            for (int e = 0; e < 8; ++e) { const int n = n0 + e; const float cr = Cr[h * 64 + n], ci = Ci[h * 64 + n], pr = pwr[(d * 17 + ex) * 64 + n], pi = pwi[(d * 17 + ex) * 64 + n]; v[e] = part == 0 ? (cr * pr - ci * pi) : -(cr * pi + ci * pr); }
        }
        *(u32x4*)(SY + (size_t)o * 512 + kk0) = pack8(v);
    }
    for (int u = tid; u < 256 * 32; u += NTHREADS) {
        const int o = u >> 5, kk0 = (u & 31) * 8, d = o >> 7, part = (o >> 6) & 1, n = o & 63, j = kk0 >> 4, hp0 = kk0 & 15, ex = d == 0 ? 15 - j : j;
        const float pr = pwr[(d * 17 + ex) * 64 + n], pi = pwi[(d * 17 + ex) * 64 + n], qr = pr * cor[d * 64 + n] - pi * coi[d * 64 + n], qi = pr * coi[d * 64 + n] + pi * cor[d * 64 + n];
        float v[8];
#pragma unroll
        for (int e = 0; e < 8; ++e) { const float br = Br[n * 16 + hp0 + e], bi = Bi[n * 16 + hp0 + e]; v[e] = part == 0 ? (qr * br - qi * bi) : (qr * bi + qi * br); }
        *(u32x4*)(SX + (size_t)o * 256 + kk0) = pack8(v);
    }
    __syncthreads();
}

__device__ __forceinline__ void phase0(const Ctx& cx_) {
    const Ctx c = relaunder(cx_);
    if (c.bid < 32) s5_build(c, c.bid >> 4, c.bid & 15);
    const int gw = c.bid * NWAVES + c.wave, NGW = c.G * NWAVES, lane = c.lane;
    bf16_t* H = c.H(); float* ssq = c.ssq();
    for (int m = gw; m < MP; m += NGW) {
        u32x2* hp = (u32x2*)(H + (size_t)m * DM);
        if (m >= M_ROWS) {
#pragma unroll
            for (int i = 0; i < 4; ++i) hp[lane + 64 * i] = (u32x2){0u, 0u};
            continue;
        }
        int b, t; bt_of(m, b, t);
        const f32x4* src = (const f32x4*)(t < NMETA ? c.in[I_META] + (size_t)t * DM : c.in[I_X] + ((size_t)b * SEQ + (t - NMETA)) * DM);
        float ss = 0.f;
#pragma unroll
        for (int i = 0; i < 4; ++i) { const f32x4 v = src[lane + 64 * i]; ss += (v.x * v.x + v.y * v.y) + (v.z * v.z + v.w * v.w); hp[lane + 64 * i] = (u32x2){pk2(v.x, v.y), pk2(v.z, v.w)}; }
        ss = wave_sum(ss);
        if (lane < 16) ssq[(size_t)m * 16 + lane] = lane == 0 ? ss : 0.f;
    }
    LAS float* scr = (LAS float*)(c.lds + c.wave * 8448);
    for (int l = 0; l < DEPTH; ++l) {
        int base = 0;
        for (int j = 0; j < N_TJOBS; ++j) {
            TJob t; get_tjob(c, l, j, t); const int ni = tjob_items(t);
            int first = (gw - base % NGW + NGW) % NGW;
            for (int it = first; it < ni; it += NGW) transpose_item(t, scr, it, lane);
            base += ni;
        }
        bf16_t* wb = c.wb(l);
        const int gt = c.bid * NTHREADS + c.tid, NGT = c.G * NTHREADS;
        for (int u = gt; u < 128 * 64; u += NGT) *(u32x4*)(wb + WB_L1 + (size_t)384 * 512 + (size_t)u * 8) = (u32x4){0u, 0u, 0u, 0u};
        for (int u = gt; u < 5 * 256 * 4 * 8; u += NGT) {
            const int sub = u & 7, blk = (u >> 3) & 3, row = (u >> 5) & 255, tile = u >> 13;
            const bool nz = (tile == 0 || tile == 2) ? (blk == 0) : ((tile == 1 || tile == 3) ? (blk == 1) : (blk < 2));
            if (!nz) *(u32x4*)(wb + WB_L2 + ((size_t)tile * 256 + row) * 256 + blk * 64 + sub * 8) = (u32x4){0u, 0u, 0u, 0u};
        }
    }
}

__device__ __forceinline__ void dt_job(const Ctx& cx_, int l) {
    const Ctx c = relaunder(cx_);
    LAS float* dtw = (LAS float*)c.lds;
    const float* win = c.in[I_WIN] + (size_t)l * DM * N_IN; const float* nw = c.in[I_MIXNW] + l * DM;
    for (int i = c.tid; i < 8 * DM; i += NTHREADS) { const int k = i >> 3, j = i & 7; dtw[j * DM + k] = nw[k] * win[(size_t)k * N_IN + 1792 + j]; }
    __syncthreads();
    const int gw = c.bid * NWAVES + c.wave, NGW = c.G * NWAVES, lane = c.lane;
    const bf16_t* H = c.H(); float* dt = (float*)(c.ws + WS_DT); float* dec = (float*)(c.ws + WS_DEC);
    const float* dtb = c.in[I_DTB] + l * 16; const float* alog = c.in[I_ALOG] + l * 16;
    for (int m = gw; m < M_ROWS; m += NGW) {
        const u32x2* hp = (const u32x2*)(H + (size_t)m * DM);
        float ss = 0.f, d8[8] = {0.f, 0.f, 0.f, 0.f, 0.f, 0.f, 0.f, 0.f};
#pragma unroll
        for (int i = 0; i < 4; ++i) {
            const u32x2 w = hp[lane + 64 * i]; const float h0 = bflo(w.x), h1 = bfhi(w.x), h2 = bflo(w.y), h3 = bfhi(w.y);
            ss += (h0 * h0 + h1 * h1) + (h2 * h2 + h3 * h3);
#pragma unroll
            for (int j = 0; j < 8; ++j) { const f32x4 wv = *(const LAS f32x4*)(dtw + j * DM + 4 * lane + 256 * i); d8[j] += (h0 * wv.x + h1 * wv.y) + (h2 * wv.z + h3 * wv.w); }
        }
        ss = wave_sum(ss);
#pragma unroll
        for (int j = 0; j < 8; ++j) d8[j] = wave_sum(d8[j]);
        const float s = __builtin_amdgcn_rsqf(ss * (1.0f / DM) + EPS);
        if (lane < 16) {
            const int j = lane & 7; float raw = d8[0];
#pragma unroll
            for (int e = 1; e < 8; ++e) raw = (j == e) ? d8[e] : raw;
            const float dtv = softplusf_(raw * s + dtb[lane]);
            dt[(size_t)m * 16 + lane] = dtv; dec[(size_t)m * 16 + lane] = -dtv * __expf(alog[lane]);
        }
    }
    __syncthreads();
}

__device__ __forceinline__ void rwkv_prep(const Ctx& cx_, int l) {
    const Ctx c = relaunder(cx_);
    const int gw = c.bid * NWAVES + c.wave, NGW = c.G * NWAVES, lane = c.lane, c0 = 4 * lane;
    const bf16_t* P = (const bf16_t*)(c.ws + WS_PRKVX); bf16_t* rk = (bf16_t*)(c.dout + DO_RKVP); bf16_t* l1 = (bf16_t*)(c.ws + WS_L1IN);
    float mu[3][4], kkw[4];
#pragma unroll
    for (int x = 0; x < 3; ++x)
#pragma unroll
        for (int e = 0; e < 4; ++e) mu[x][e] = c.in[I_MURKV][((size_t)l * 3 + x) * 256 + c0 + e];
#pragma unroll
    for (int e = 0; e < 4; ++e) kkw[e] = c.in[I_KK][(size_t)l * 256 + c0 + e];
    for (int m = gw; m < M_ROWS; m += NGW) {
        int b, t; bt_of(m, b, t); const bool hp = t > 0, hn = t < LEN - 1; const size_t mp_ = hp ? row_of(b, t - 1) : 0, mn_ = hn ? row_of(b, t + 1) : 0;
        float o[4][4];
        float xc[4], dxc[4];
#pragma unroll
        for (int x = 0; x < 4; ++x) {
            const u32x2 wc_ = *(const u32x2*)(P + (size_t)m * 1024 + x * 256 + c0);
            u32x2 wp = (u32x2){0u, 0u}, wn = (u32x2){0u, 0u};
            if (hp) wp = *(const u32x2*)(P + mp_ * 1024 + x * 256 + c0);
            if (hn) wn = *(const u32x2*)(P + mn_ * 1024 + x * 256 + c0);
            const float cur[4] = {bflo(wc_.x), bfhi(wc_.x), bflo(wc_.y), bfhi(wc_.y)}, pv[4] = {bflo(wp.x), bfhi(wp.x), bflo(wp.y), bfhi(wp.y)}, nv[4] = {bflo(wn.x), bfhi(wn.x), bflo(wn.y), bfhi(wn.y)};
#pragma unroll
            for (int e = 0; e < 4; ++e) { const float cs = 0.5f * (pv[e] + nv[e]) - cur[e]; if (x < 3) o[x][e] = cur[e] + cs * mu[x][e]; else { xc[e] = cur[e]; dxc[e] = cs; } }
        }
        float kr_[4], ss = 0.f;
#pragma unroll
        for (int e = 0; e < 4; ++e) { kr_[e] = o[1][e] * kkw[e]; ss += kr_[e] * kr_[e]; }
        ss = sum16(ss); const float rn = __builtin_amdgcn_rsqf(ss + 1e-12f);
        bf16_t* rp = rk + (size_t)m * 1024 + c0;
        *(u32x2*)(rp) = (u32x2){pk2(o[0][0], o[0][1]), pk2(o[0][2], o[0][3])};
        *(u32x2*)(rp + 256) = (u32x2){pk2(o[1][0], o[1][1]), pk2(o[1][2], o[1][3])};
        *(u32x2*)(rp + 512) = (u32x2){pk2(o[2][0], o[2][1]), pk2(o[2][2], o[2][3])};
        *(u32x2*)(rp + 768) = (u32x2){pk2(kr_[0] * rn, kr_[1] * rn), pk2(kr_[2] * rn, kr_[3] * rn)};
        bf16_t* lp = l1 + (size_t)m * 512 + c0;
        *(u32x2*)(lp) = (u32x2){pk2(xc[0], xc[1]), pk2(xc[2], xc[3])};
        *(u32x2*)(lp + 256) = (u32x2){pk2(dxc[0], dxc[1]), pk2(dxc[2], dxc[3])};
    }
}
__device__ __forceinline__ void ssd_prep(const Ctx& cx_, int l) {
    const Ctx c = relaunder(cx_);
    const int gw = c.bid * NWAVES + c.wave, NGW = c.G * NWAVES, lane = c.lane, c0 = 16 * lane;
    const bf16_t* P = (const bf16_t*)(c.ws + WS_PXBC); bf16_t* xs = (bf16_t*)(c.ws + WS_XS); bf16_t* bc = (bf16_t*)(c.ws + WS_BC);
    float w[5][16], bias[16];
#pragma unroll
    for (int j = 0; j < 5; ++j)
#pragma unroll
        for (int e = 0; e < 16; ++e) w[j][e] = c.in[I_CONVW][((size_t)l * 5 + j) * 1024 + c0 + e];
#pragma unroll
    for (int e = 0; e < 16; ++e) bias[e] = c.in[I_CONVB][(size_t)l * 1024 + c0 + e];
    for (int m = gw; m < M_ROWS; m += NGW) {
        int b, t; bt_of(m, b, t);
        float a[16];
#pragma unroll
        for (int e = 0; e < 16; ++e) a[e] = bias[e];
#pragma unroll
        for (int j = 0; j < 5; ++j) {
            const int tt = t + j - 2;
            if (tt >= 0 && tt < LEN) {
                const u32x4* p = (const u32x4*)(P + (size_t)row_of(b, tt) * 1024 + c0); float f0[8], f1[8]; unpack8(p[0], f0); unpack8(p[1], f1);
#pragma unroll
                for (int e = 0; e < 8; ++e) { a[e] += w[j][e] * f0[e]; a[8 + e] += w[j][8 + e] * f1[e]; }
            }
        }
        float o0[8], o1[8];
#pragma unroll
        for (int e = 0; e < 8; ++e) { o0[e] = siluf_(a[e]); o1[e] = siluf_(a[8 + e]); }
        bf16_t* dst = lane < 32 ? xs + (size_t)m * 512 + c0 : bc + (size_t)m * 512 + (c0 - 512);
        ((u32x4*)dst)[0] = pack8(o0); ((u32x4*)dst)[1] = pack8(o1);
    }
}

__device__ __forceinline__ void s5_scan(const Ctx& cx_, int l) {
    const Ctx c = relaunder(cx_);
    if (c.tid >= 64) return;
    const int gt = c.bid * 64 + c.tid; if (gt >= 16384) return;
    const int n = gt & 63, d = (gt >> 6) & 1, b = (gt >> 7) & 7, g = gt >> 10;
    const size_t li_ = (((size_t)l * 2 + d) * 16 + g) * 64 + n;
    const float lr = c.in[I_S5LRE][li_], li = c.in[I_S5LIM][li_], step = expf(c.in[I_S5LS][((size_t)l * 2 + d) * 16 + g]);
    const float mag = expf(16.f * lr * step); float sn, cs; sincosf(16.f * li * step, &sn, &cs); const float ar = mag * cs, ai = mag * sn;
    const float* X = (const float*)(c.ws + WS_X) + ((size_t)g * S5RP + (size_t)b * NCH16) * 256 + d * 128 + n;
    bf16_t* U = (bf16_t*)(c.ws + WS_UH) + ((size_t)g * S5RP + (size_t)b * NCH16) * 512 + 256 + d * 128 + n;
    float hr = 0.f, hi = 0.f;
    for (int i0 = 0; i0 < NCH16; i0 += 32) {
        float xr[32], xi[32];
#pragma unroll
        for (int k = 0; k < 32; ++k) { const int i = i0 + k; const int ch = d == 0 ? i : NCH16 - 1 - i; const bool ok = i < NCH16; xr[k] = ok ? X[(size_t)ch * 256] : 0.f; xi[k] = ok ? X[(size_t)ch * 256 + 64] : 0.f; }
#pragma unroll
        for (int k = 0; k < 32; ++k) { const int i = i0 + k; if (i < NCH16) { const int ch = d == 0 ? i : NCH16 - 1 - i;
            U[(size_t)ch * 512] = (bf16_t)f2bf(hr); U[(size_t)ch * 512 + 64] = (bf16_t)f2bf(hi);
            const float nr = ar * hr - ai * hi + xr[k], ni = ar * hi + ai * hr + xi[k]; hr = nr; hi = ni; } }
    }
}
typedef short s16x4 __attribute__((ext_vector_type(4)));
__device__ __forceinline__ s16x4 lds_tr(const LAS unsigned char* p) { return __builtin_bit_cast(s16x4, __builtin_amdgcn_ds_read_tr16_b64_v4i16((LAS s16x4*)p)); }
__device__ __forceinline__ bf16x8 frag_tr(const LAS unsigned char* img, int rs, int kbase, int colbase, int lane) {
    const LAS unsigned char* a = img + (kbase + 8 * (lane >> 4) + ((lane & 15) >> 2)) * rs + (colbase + 4 * (lane & 3)) * 2;
    const s16x4 lo = lds_tr(a), hi = lds_tr(a + 4 * rs);
    return (bf16x8){lo[0], lo[1], lo[2], lo[3], hi[0], hi[1], hi[2], hi[3]};
}
__device__ __forceinline__ bf16x8 frag_row(const LAS unsigned char* img, int rs, int rowbase, int kbase, int lane) {
    return *(const LAS bf16x8*)(img + (rowbase + (lane & 15)) * rs + (kbase + 8 * (lane >> 4)) * 2);
}
constexpr int SD_RS = 272;
constexpr int SD_XRS = 144;
constexpr int SD_OFF_C = 0, SD_OFF_B = 34816, SD_OFF_X = 69632, SD_OFF_M = 88064, SD_OFF_SC = 122880;
constexpr int SD_OFF_HF = SD_OFF_B, SD_OFF_HB = SD_OFF_B + 17408;
constexpr size_t WS_STB = WS_YSSD;
constexpr size_t WS_CDEC = WS_DEC + (size_t)MP * 64 + 256;
constexpr size_t WS_SSQB = WS_CDEC + (size_t)BATCH * 33 * 16 * 4;
constexpr size_t WS_BAR = (WS_SSQB + (size_t)MP * 4 + 255) / 256 * 256;
static_assert(WS_BAR + 3456 * 4 <= 7 * QB, "small region");
static_assert((size_t)BATCH * 2 * 8 * 32 * 8192 * 2 <= 4 * QB, "chunk states fit the yssd slot");

struct SsdUnit { int b, ck, t0, ns; };
__device__ __forceinline__ bool ssd_unit(int bid, int round, SsdUnit& u) {
    if (round == 0) { u.b = bid >> 5; u.ck = 1 + (bid & 31); u.t0 = NMETA + 128 * (u.ck - 1); u.ns = 8; return true; }
    if (round == 1 && bid < BATCH) { u.b = bid; u.ck = 0; u.t0 = 0; u.ns = 1; return true; }
    return false;
}
__device__ __forceinline__ void ssd_load_img(LAS unsigned char* img, int rs, const bf16_t* src, int ld, size_t m0, int col0, int ncol, int ns, int tid) {
    const int cpr = ncol / 8, nrow = ns == 1 ? 32 : 128;
    for (int i = tid; i < nrow * cpr; i += NTHREADS) {
        const int r = i / cpr, cc = i - r * cpr; u32x4 v = (u32x4){0u, 0u, 0u, 0u};
        if (r < 16 * ns) v = *(const u32x4*)(src + (m0 + r) * ld + col0 + cc * 8);
        *(LAS u32x4*)(img + r * rs + cc * 16) = v;
    }
}
__device__ __forceinline__ void ssd_scalars(LAS float* sc, const float* dt, const float* al, size_t m0, int head, int ns, int lane, float& totf, float& totb) {
    const int Q = 16 * ns;
    float a0f = 0.f, a1f = 0.f, a0b = 0.f, a1b = 0.f, d0f = 0.f, d1f = 0.f, d0b = 0.f, d1b = 0.f;
    const int s0 = 2 * lane, s1 = 2 * lane + 1;
    if (s0 < Q) { a0f = al[(m0 + s0) * 16 + head]; a0b = al[(m0 + s0) * 16 + 8 + head]; d0f = dt[(m0 + s0) * 16 + head]; d0b = dt[(m0 + s0) * 16 + 8 + head]; }
    if (s1 < Q) { a1f = al[(m0 + s1) * 16 + head]; a1b = al[(m0 + s1) * 16 + 8 + head]; d1f = dt[(m0 + s1) * 16 + head]; d1b = dt[(m0 + s1) * 16 + 8 + head]; }
    float pf = a0f + a1f, pb = a0b + a1b;
#pragma unroll
    for (int o = 1; o < 64; o <<= 1) { const float tf = __shfl_up(pf, o), tb = __shfl_up(pb, o); if (lane >= o) { pf += tf; pb += tb; } }
    totf = __shfl(pf, 63); totb = __shfl(pb, 63);
    const float af1 = pf, af0 = pf - a1f;
    const float eb0 = pb - a0b - a1b, eb1 = pb - a1b;
    sc[s0] = af0; sc[s1] = af1; sc[128 + s0] = eb0; sc[128 + s1] = eb1; sc[256 + s0] = d0f; sc[256 + s1] = d1f; sc[384 + s0] = d0b; sc[384 + s1] = d1b;
    sc[512 + s0] = __expf(totf - af0) * d0f; sc[512 + s1] = __expf(totf - af1) * d1f;
    sc[640 + s0] = __expf(eb0) * d0b; sc[640 + s1] = __expf(eb1) * d1b;
    sc[768 + s0] = __expf(af0); sc[768 + s1] = __expf(af1);
    sc[896 + s0] = __expf(totb - eb0); sc[896 + s1] = __expf(totb - eb1);
}

__device__ __forceinline__ void ssd_states(const Ctx& cx_, int l) {
    const Ctx c = relaunder(cx_);
    const int tid = c.tid, lane = c.lane, wave = c.wave;
    const bf16_t* bc = (const bf16_t*)(c.ws + WS_BC); const bf16_t* xs = (const bf16_t*)(c.ws + WS_XS);
    const float* dt = (const float*)(c.ws + WS_DT); const float* al = (const float*)(c.ws + WS_DEC);
    bf16_t* stb = (bf16_t*)(c.ws + WS_STB); float* cdec = (float*)(c.ws + WS_CDEC);
    LAS unsigned char* Bimg = c.lds + SD_OFF_B; LAS unsigned char* Ximg = c.lds + SD_OFF_X; LAS float* sc = (LAS float*)(c.lds + SD_OFF_SC);
    for (int round = 0; round < 2; ++round) {
        SsdUnit u; if (!ssd_unit(c.bid, round, u)) break;
        const size_t m0 = (size_t)row_of(u.b, u.t0); const int nks = u.ns == 1 ? 1 : 4;
        for (int g = 0; g < 2; ++g) {
            __syncthreads();
            ssd_load_img(Bimg, SD_RS, bc, 512, m0, g * 128, 128, u.ns, tid);
            for (int j = 0; j < 4; ++j) {
                const int head = g * 4 + j;
                if (j) __syncthreads();
                ssd_load_img(Ximg, SD_XRS, xs, 512, m0, head * 64, 64, u.ns, tid);
                if (wave == 0) { float totf, totb; ssd_scalars(sc, dt, al, m0, head, u.ns, lane, totf, totb);
                    if (lane == 0) { cdec[((size_t)u.b * 33 + u.ck) * 16 + head] = __expf(totf); cdec[((size_t)u.b * 33 + u.ck) * 16 + 8 + head] = __expf(totb); } }
                __syncthreads();
                f32x4 accf[4], accb[4];
#pragma unroll
                for (int pt = 0; pt < 4; ++pt) { accf[pt] = (f32x4){0.f, 0.f, 0.f, 0.f}; accb[pt] = accf[pt]; }
                for (int ks = 0; ks < nks; ++ks) {
                    const bf16x8 af = frag_tr(Bimg, SD_RS, 32 * ks, 16 * wave, lane);
                    const int k0 = 32 * ks + 8 * (lane >> 4);
                    const f32x4 wf0 = *(const LAS f32x4*)(sc + 512 + k0), wf1 = *(const LAS f32x4*)(sc + 512 + k0 + 4), wb0 = *(const LAS f32x4*)(sc + 640 + k0), wb1 = *(const LAS f32x4*)(sc + 640 + k0 + 4);
#pragma unroll
                    for (int pt = 0; pt < 4; ++pt) {
                        const bf16x8 xr = frag_tr(Ximg, SD_XRS, 32 * ks, 16 * pt, lane);
                        float xf[8];
#pragma unroll
                        for (int e = 0; e < 8; ++e) xf[e] = bf1((bf16_t)xr[e]);
                        bf16x8 bfv, bbv;
                        { const unsigned p0 = pk2(xf[0] * wf0.x, xf[1] * wf0.y), p1 = pk2(xf[2] * wf0.z, xf[3] * wf0.w), p2 = pk2(xf[4] * wf1.x, xf[5] * wf1.y), p3 = pk2(xf[6] * wf1.z, xf[7] * wf1.w);
                          bfv = __builtin_bit_cast(bf16x8, (u32x4){p0, p1, p2, p3}); }
                        { const unsigned p0 = pk2(xf[0] * wb0.x, xf[1] * wb0.y), p1 = pk2(xf[2] * wb0.z, xf[3] * wb0.w), p2 = pk2(xf[4] * wb1.x, xf[5] * wb1.y), p3 = pk2(xf[6] * wb1.z, xf[7] * wb1.w);
                          bbv = __builtin_bit_cast(bf16x8, (u32x4){p0, p1, p2, p3}); }
                        accf[pt] = __builtin_amdgcn_mfma_f32_16x16x32_bf16(af, bfv, accf[pt], 0, 0, 0);
                        accb[pt] = __builtin_amdgcn_mfma_f32_16x16x32_bf16(af, bbv, accb[pt], 0, 0, 0);
                    }
                }
#pragma unroll
                for (int pt = 0; pt < 4; ++pt) {
                    const int p = 16 * pt + (lane & 15), n0 = 16 * wave + 4 * (lane >> 4);
                    if (u.ck <= 31) { bf16_t* d = stb + ((((size_t)u.b * 2 + 0) * 8 + head) * 32 + u.ck) * 8192 + (size_t)p * 128 + n0; *(u32x2*)d = (u32x2){pk2(accf[pt][0], accf[pt][1]), pk2(accf[pt][2], accf[pt][3])}; }
                    if (u.ck >= 1) { bf16_t* d = stb + ((((size_t)u.b * 2 + 1) * 8 + head) * 32 + (u.ck - 1)) * 8192 + (size_t)p * 128 + n0; *(u32x2*)d = (u32x2){pk2(accb[pt][0], accb[pt][1]), pk2(accb[pt][2], accb[pt][3])}; }
                }
            }
        }
    }
    __syncthreads();
}

__device__ __forceinline__ void ssd_chunk_scan(const Ctx& cx_, int l) {
    const Ctx c = relaunder(cx_);
    bf16_t* stb = (bf16_t*)(c.ws + WS_STB); const float* cdec = (const float*)(c.ws + WS_CDEC);
    const int gt = c.bid * NTHREADS + c.tid;
    const int e8 = gt & 1023, bdh = gt >> 10;
    if (bdh >= BATCH * 16) return;
    const int head = bdh & 7, dir = (bdh >> 3) & 1, b = bdh >> 4;
    bf16_t* base = stb + (size_t)bdh * 32 * 8192 + (size_t)e8 * 8;
    float h[8] = {0.f, 0.f, 0.f, 0.f, 0.f, 0.f, 0.f, 0.f};
    for (int i0 = 0; i0 < 32; i0 += 8) {
        u32x4 v[8]; float dcy[8];
#pragma unroll
        for (int k = 0; k < 8; ++k) { const int slot = dir == 0 ? i0 + k : 31 - (i0 + k); v[k] = *(const u32x4*)(base + (size_t)slot * 8192);
            const int ck = dir == 0 ? slot : slot + 1; dcy[k] = cdec[((size_t)b * 33 + ck) * 16 + dir * 8 + head]; }
#pragma unroll
        for (int k = 0; k < 8; ++k) { const int slot = dir == 0 ? i0 + k : 31 - (i0 + k); float s[8]; unpack8(v[k], s);
#pragma unroll
            for (int e = 0; e < 8; ++e) h[e] = h[e] * dcy[k] + s[e];
            *(u32x4*)(base + (size_t)slot * 8192) = pack8(h); }
    }
}

__device__ __forceinline__ void ssd_outputs(const Ctx& cx_, int l) {
    const Ctx c = relaunder(cx_);
    const int tid = c.tid, lane = c.lane, wave = c.wave;
    const bf16_t* bc = (const bf16_t*)(c.ws + WS_BC); const bf16_t* xs = (const bf16_t*)(c.ws + WS_XS); const bf16_t* pz = (const bf16_t*)(c.ws + WS_PZ);
    const float* dt = (const float*)(c.ws + WS_DT); const float* al = (const float*)(c.ws + WS_DEC);
    const bf16_t* stb = (const bf16_t*)(c.ws + WS_STB); bf16_t* yb = (bf16_t*)(c.ws + WS_YB); float* ssqb = (float*)(c.ws + WS_SSQB);
    LAS unsigned char* Cimg = c.lds + SD_OFF_C; LAS unsigned char* Bimg = c.lds + SD_OFF_B; LAS unsigned char* Ximg = c.lds + SD_OFF_X;
    LAS unsigned char* HfT = c.lds + SD_OFF_HF; LAS unsigned char* HbT = c.lds + SD_OFF_HB;
    LAS unsigned char* Ms = c.lds + SD_OFF_M + wave * 4352; LAS float* sc = (LAS float*)(c.lds + SD_OFF_SC);
    for (int round = 0; round < 2; ++round) {
        SsdUnit u; if (!ssd_unit(c.bid, round, u)) break;
        const size_t m0 = (size_t)row_of(u.b, u.t0); const int nks = u.ns == 1 ? 1 : 4; const bool active = wave < u.ns;
        float ssrow = 0.f;
        for (int g = 0; g < 2; ++g) {
            __syncthreads();
            ssd_load_img(Cimg, SD_RS, bc, 512, m0, 256 + g * 128, 128, u.ns, tid);
            ssd_load_img(Bimg, SD_RS, bc, 512, m0, g * 128, 128, u.ns, tid);
            __syncthreads();
            f32x4 cb[8];
#pragma unroll
            for (int t = 0; t < 8; ++t) cb[t] = (f32x4){0.f, 0.f, 0.f, 0.f};
            if (active) {
#pragma unroll
                for (int ks = 0; ks < 4; ++ks) {
                    const bf16x8 cfr = frag_row(Cimg, SD_RS, 16 * wave, 32 * ks, lane);
#pragma unroll
                    for (int t = 0; t < 8; ++t) if (t < u.ns) cb[t] = __builtin_amdgcn_mfma_f32_16x16x32_bf16(frag_row(Bimg, SD_RS, 16 * t, 32 * ks, lane), cfr, cb[t], 0, 0, 0);
                }
            }
            for (int j = 0; j < 4; ++j) {
                const int head = g * 4 + j;
                __syncthreads();
                ssd_load_img(Ximg, SD_XRS, xs, 512, m0, head * 64, 64, u.ns, tid);
                {
                    const bf16_t* hf = u.ck >= 1 ? stb + ((((size_t)u.b * 2 + 0) * 8 + head) * 32 + (u.ck - 1)) * 8192 : nullptr;
                    const bf16_t* hb = u.ck <= 31 ? stb + ((((size_t)u.b * 2 + 1) * 8 + head) * 32 + u.ck) * 8192 : nullptr;
                    for (int i = tid; i < 64 * 16; i += NTHREADS) { const int p = i >> 4, cc = i & 15;
                        *(LAS u32x4*)(HfT + p * SD_RS + cc * 16) = hf ? *(const u32x4*)(hf + p * 128 + cc * 8) : (u32x4){0u, 0u, 0u, 0u};
                        *(LAS u32x4*)(HbT + p * SD_RS + cc * 16) = hb ? *(const u32x4*)(hb + p * 128 + cc * 8) : (u32x4){0u, 0u, 0u, 0u}; }
                }
                if (wave == 0) { float totf, totb; ssd_scalars(sc, dt, al, m0, head, u.ns, lane, totf, totb); }
                __syncthreads();
                if (active) {
                    const int ll = 16 * wave + (lane & 15); const float afl = sc[ll], ebl = sc[128 + ll];
#pragma unroll
                    for (int t = 0; t < 8; ++t) {
                        u32x2 w2 = (u32x2){0u, 0u};
                        if (t < u.ns) {
                            const int s0 = 16 * t + 4 * (lane >> 4);
                            const f32x4 afs = *(const LAS f32x4*)(sc + s0), ebs = *(const LAS f32x4*)(sc + 128 + s0), dfs = *(const LAS f32x4*)(sc + 256 + s0), dbs = *(const LAS f32x4*)(sc + 384 + s0);
                            float mv[4];
#pragma unroll
                            for (int r = 0; r < 4; ++r) { const int s = s0 + r; float wgt = 0.f; if (s <= ll) wgt += __expf(afl - afs[r]) * dfs[r]; if (s >= ll) wgt += __expf(ebs[r] - ebl) * dbs[r]; mv[r] = cb[t][r] * wgt; }
                            w2 = (u32x2){pk2(mv[0], mv[1]), pk2(mv[2], mv[3])};
                        }
                        if (t < 2 * nks) *(LAS u32x2*)(Ms + (lane & 15) * SD_RS + (16 * t + 4 * (lane >> 4)) * 2) = w2;
                    }
                    asm volatile("s_waitcnt lgkmcnt(0)" ::: "memory");
                    f32x4 ay[4], ahf[4], ahb[4];
#pragma unroll
                    for (int pt = 0; pt < 4; ++pt) { ay[pt] = (f32x4){0.f, 0.f, 0.f, 0.f}; ahf[pt] = ay[pt]; ahb[pt] = ay[pt]; }
                    for (int ks = 0; ks < nks; ++ks) {
                        const bf16x8 mf = frag_row(Ms, SD_RS, 0, 32 * ks, lane);
#pragma unroll
                        for (int pt = 0; pt < 4; ++pt) ay[pt] = __builtin_amdgcn_mfma_f32_16x16x32_bf16(mf, frag_tr(Ximg, SD_XRS, 32 * ks, 16 * pt, lane), ay[pt], 0, 0, 0);
                    }
#pragma unroll
                    for (int ks = 0; ks < 4; ++ks) {
                        const bf16x8 cfr = frag_row(Cimg, SD_RS, 16 * wave, 32 * ks, lane);
#pragma unroll
                        for (int pt = 0; pt < 4; ++pt) {
                            ahf[pt] = __builtin_amdgcn_mfma_f32_16x16x32_bf16(cfr, frag_row(HfT, SD_RS, 16 * pt, 32 * ks, lane), ahf[pt], 0, 0, 0);
                            ahb[pt] = __builtin_amdgcn_mfma_f32_16x16x32_bf16(cfr, frag_row(HbT, SD_RS, 16 * pt, 32 * ks, lane), ahb[pt], 0, 0, 0);
                        }
                    }
                    const int l0 = 16 * wave + 4 * (lane >> 4);
                    const f32x4 efv = *(const LAS f32x4*)(sc + 768 + l0), ebv = *(const LAS f32x4*)(sc + 896 + l0);
                    asm volatile("s_waitcnt lgkmcnt(0)" ::: "memory");
                    LAS float* ys = (LAS float*)Ms;
#pragma unroll
                    for (int pt = 0; pt < 4; ++pt)
#pragma unroll
                        for (int r = 0; r < 4; ++r) ys[(4 * (lane >> 4) + r) * 68 + 16 * pt + (lane & 15)] = ay[pt][r] + efv[r] * ahf[pt][r] + ebv[r] * ahb[pt][r];
                    asm volatile("s_waitcnt lgkmcnt(0)" ::: "memory");
                    const int rr = lane >> 2, p0 = 16 * (lane & 3); const size_t m = m0 + 16 * wave + rr;
                    const float dsk = c.in[I_SSDD][l * 8 + head];
                    float xv[16], zv[16];
                    { float t8[8]; unpack8(*(const LAS u32x4*)(Ximg + (16 * wave + rr) * SD_XRS + p0 * 2), t8);
#pragma unroll
                      for (int e = 0; e < 8; ++e) xv[e] = t8[e];
                      unpack8(*(const LAS u32x4*)(Ximg + (16 * wave + rr) * SD_XRS + p0 * 2 + 16), t8);
#pragma unroll
                      for (int e = 0; e < 8; ++e) xv[8 + e] = t8[e];
                      unpack8(*(const u32x4*)(pz + m * 512 + head * 64 + p0), t8);
#pragma unroll
                      for (int e = 0; e < 8; ++e) zv[e] = t8[e];
                      unpack8(*(const u32x4*)(pz + m * 512 + head * 64 + p0 + 8), t8);
#pragma unroll
                      for (int e = 0; e < 8; ++e) zv[8 + e] = t8[e]; }
                    float o[16];
#pragma unroll
                    for (int e4 = 0; e4 < 4; ++e4) { const f32x4 yv = *(const LAS f32x4*)(ys + rr * 68 + p0 + 4 * e4);
#pragma unroll
                        for (int e = 0; e < 4; ++e) { const float val = (yv[e] + dsk * xv[4 * e4 + e]) * siluf_(zv[4 * e4 + e]); o[4 * e4 + e] = val; ssrow += val * val; } }
                    u32x4 w0, w1; w0.x = pk2(o[0], o[1]); w0.y = pk2(o[2], o[3]); w0.z = pk2(o[4], o[5]); w0.w = pk2(o[6], o[7]); w1.x = pk2(o[8], o[9]); w1.y = pk2(o[10], o[11]); w1.z = pk2(o[12], o[13]); w1.w = pk2(o[14], o[15]);
                    *(u32x4*)(yb + m * 512 + head * 64 + p0) = w0; *(u32x4*)(yb + m * 512 + head * 64 + p0 + 8) = w1;
                }
            }
        }
        if (active) { ssrow += dpp_mov<0xB1>(ssrow); ssrow += dpp_mov<0x4E>(ssrow); if ((lane & 3) == 0) ssqb[m0 + 16 * wave + (lane >> 2)] = ssrow; }
    }
    __syncthreads();
}
#define RC_NONE 1
typedef short s16x4v __attribute__((ext_vector_type(4)));
constexpr int RC_NCH = LEN / 16;
constexpr int RC_NP = 7;
constexpr int RC_ROUNDS = (RC_NCH + RC_NP - 1) / RC_NP;
constexpr int RC_S64 = 144;
constexpr int RC_S16 = 40;
constexpr int RC_AT = 0, RC_RT = 2304, RC_BBT = 4608, RC_KBT = 7168, RC_T = 9728, RC_AAK = 10368, RC_ARB = 11008, RC_ARK = 11648, RC_VT = 12288, RC_P16 = 12928, RC_SLOT = 13312;
constexpr int RC_SCR0 = RC_NP * RC_SLOT;
constexpr int RC_SCR = 2304 * 2 + 1280;
static_assert(RC_SCR0 + RC_NP * RC_SCR <= 147456 - 512, "rwkv chunk LDS");
__device__ __forceinline__ s16x4v mfma16_frag(const LAS unsigned char* mat, int row, int q) { return *(const LAS s16x4v*)(mat + row * RC_S16 + q * 8); }

__device__ __forceinline__ void rwkv_chunked(const Ctx& cx_, int l) {
    const Ctx c = relaunder(cx_);


    const int bid = c.bid, qs = bid & 3, dir = 1 - ((bid >> 2) & 1), head = (bid >> 3) & 3, b = bid >> 5;
    const int lane = c.lane, wave = c.wave;
    const bf16_t* rk = (const bf16_t*)(c.dout + DO_RKVP) + head * 64; const bf16_t* l2 = (const bf16_t*)(c.ws + WS_L2O) + dir * 256 + head * 64;
#ifdef RWKV_DBG
    bf16_t* yo = (bf16_t*)(c.ws + WS_MIX + (dir ? 47 * QB / 2 : 33 * QB / 2)) + head * 64 + 16 * qs;
#else
    bf16_t* yo = (bf16_t*)(c.ws + WS_YRW) + (size_t)dir * MP * 256 + head * 64 + 16 * qs;
#endif
    auto tok = [&](int s) -> size_t { const int t = s + dir * (LEN - 1 - 2 * s); return (size_t)row_of(b, t); };
    const int q = lane >> 4, li = lane & 15;
#ifdef RC_ZLDS
    for (int i = c.tid; i < 131072 / 16; i += NTHREADS) *(LAS u32x4*)(c.lds + i * 16) = (u32x4){0u, 0u, 0u, 0u};
    __syncthreads();
#endif
#ifdef RC_DELAY
    { const unsigned long long t0_ = __builtin_amdgcn_s_memrealtime(); while (__builtin_amdgcn_s_memrealtime() - t0_ < 40000ull) __builtin_amdgcn_s_sleep(16); }
#endif
#ifdef RC_PREFILL
    for (int i = c.tid; i < LEN * 2; i += NTHREADS) { const size_t m = (size_t)row_of(b, i >> 1); *(u32x4*)(yo + m * 256 + (i & 1) * 8) = (u32x4){0u, 0u, 0u, 0u}; }
    asm volatile("s_waitcnt vmcnt(0)" ::: "memory"); __syncthreads();
#endif
    bf16_t rr[16], kr[16], kkr[16], dlr[16], asr[16], vr[4];
    auto load_raw = [&](int ch) {
        const int k = lane;
#pragma unroll
        for (int i = 0; i < 16; ++i) { const size_t m = tok(16 * ch + i); rr[i] = rk[m * 1024 + k]; kr[i] = rk[m * 1024 + 256 + k]; kkr[i] = rk[m * 1024 + 768 + k]; dlr[i] = l2[m * 1280 + k]; asr[i] = l2[m * 1280 + 512 + k]; }
        const int vv = lane >> 2, sg = lane & 3;
#pragma unroll
        for (int j = 0; j < 4; ++j) vr[j] = rk[tok(16 * ch + 4 * sg + j) * 1024 + 512 + 16 * qs + vv];
    };
    auto produce = [&](int slot) {
        LAS unsigned char* sb = c.lds + slot * RC_SLOT; LAS unsigned char* scr = c.lds + RC_SCR0 + (wave - 1) * RC_SCR;
        LAS unsigned char* Bh = scr; LAS unsigned char* Kh = scr + 2304; LAS float* Aab = (LAS float*)(scr + 4608);
        const int k = lane; const float ka = c.in[I_KA][(size_t)l * 256 + head * 64 + k];
        {
            const int vv = lane >> 2, sg = lane & 3;
            *(LAS u32x2*)(sb + RC_VT + vv * RC_S16 + sg * 8) = (u32x2){(unsigned)vr[0] | ((unsigned)vr[1] << 16), (unsigned)vr[2] | ((unsigned)vr[3] << 16)};
        }
        float P = 1.f, bh[16], kh[16];
#pragma unroll
        for (int i = 0; i < 16; ++i) {
            const float w = __expf(bf1(dlr[i])), kkv = bf1(kkr[i]), asv = bf1(asr[i]), kv = bf1(kr[i]);
            const float a = -kkv, bb = kkv * asv, kd = kv * (1.f + (asv - 1.f) * ka);
            *(LAS bf16_t*)(sb + RC_AT + i * RC_S64 + k * 2) = (bf16_t)f2bf(a * P);
            P *= w;
            *(LAS bf16_t*)(sb + RC_RT + i * RC_S64 + k * 2) = (bf16_t)f2bf(bf1(rr[i]) * P);
            const float ip = __builtin_amdgcn_rcpf(P); bh[i] = bb * ip; kh[i] = kd * ip;
            *(LAS bf16_t*)(Bh + i * RC_S64 + k * 2) = (bf16_t)f2bf(bh[i]); *(LAS bf16_t*)(Kh + i * RC_S64 + k * 2) = (bf16_t)f2bf(kh[i]);
        }
        *(LAS float*)(sb + RC_P16 + k * 4) = P;
        {
            u32x4 w0, w1;
            w0.x = pk2(bh[0] * P, bh[1] * P); w0.y = pk2(bh[2] * P, bh[3] * P); w0.z = pk2(bh[4] * P, bh[5] * P); w0.w = pk2(bh[6] * P, bh[7] * P);
            w1.x = pk2(bh[8] * P, bh[9] * P); w1.y = pk2(bh[10] * P, bh[11] * P); w1.z = pk2(bh[12] * P, bh[13] * P); w1.w = pk2(bh[14] * P, bh[15] * P);
            *(LAS u32x2*)(sb + RC_BBT + k * RC_S16) = (u32x2){w0.x, w0.y}; *(LAS u32x2*)(sb + RC_BBT + k * RC_S16 + 8) = (u32x2){w0.z, w0.w};
            *(LAS u32x2*)(sb + RC_BBT + k * RC_S16 + 16) = (u32x2){w1.x, w1.y}; *(LAS u32x2*)(sb + RC_BBT + k * RC_S16 + 24) = (u32x2){w1.z, w1.w};
            w0.x = pk2(kh[0] * P, kh[1] * P); w0.y = pk2(kh[2] * P, kh[3] * P); w0.z = pk2(kh[4] * P, kh[5] * P); w0.w = pk2(kh[6] * P, kh[7] * P);
            w1.x = pk2(kh[8] * P, kh[9] * P); w1.y = pk2(kh[10] * P, kh[11] * P); w1.z = pk2(kh[12] * P, kh[13] * P); w1.w = pk2(kh[14] * P, kh[15] * P);
            *(LAS u32x2*)(sb + RC_KBT + k * RC_S16) = (u32x2){w0.x, w0.y}; *(LAS u32x2*)(sb + RC_KBT + k * RC_S16 + 8) = (u32x2){w0.z, w0.w};
            *(LAS u32x2*)(sb + RC_KBT + k * RC_S16 + 16) = (u32x2){w1.x, w1.y}; *(LAS u32x2*)(sb + RC_KBT + k * RC_S16 + 24) = (u32x2){w1.z, w1.w};
        }
        asm volatile("s_waitcnt lgkmcnt(0)" ::: "memory");
        f32x4 ab = (f32x4){0.f, 0.f, 0.f, 0.f}, ak = ab, rb = ab, rkm = ab;
#pragma unroll
        for (int ks = 0; ks < 2; ++ks) {
            const bf16x8 fa = *(const LAS bf16x8*)(sb + RC_AT + li * RC_S64 + (32 * ks + 8 * q) * 2), fr = *(const LAS bf16x8*)(sb + RC_RT + li * RC_S64 + (32 * ks + 8 * q) * 2);
            const bf16x8 fb = *(const LAS bf16x8*)(Bh + li * RC_S64 + (32 * ks + 8 * q) * 2), fk = *(const LAS bf16x8*)(Kh + li * RC_S64 + (32 * ks + 8 * q) * 2);
            ab = __builtin_amdgcn_mfma_f32_16x16x32_bf16(fa, fb, ab, 0, 0, 0); ak = __builtin_amdgcn_mfma_f32_16x16x32_bf16(fa, fk, ak, 0, 0, 0);
            rb = __builtin_amdgcn_mfma_f32_16x16x32_bf16(fr, fb, rb, 0, 0, 0); rkm = __builtin_amdgcn_mfma_f32_16x16x32_bf16(fr, fk, rkm, 0, 0, 0);
        }
#pragma unroll
        for (int r = 0; r < 4; ++r) {
            const int t = 4 * q + r, s = li;
            Aab[t * 20 + s] = s < t ? ab[r] : 0.f;
            *(LAS bf16_t*)(sb + RC_AAK + t * RC_S16 + s * 2) = (bf16_t)f2bf(s < t ? ak[r] : 0.f);
            *(LAS bf16_t*)(sb + RC_ARB + t * RC_S16 + s * 2) = (bf16_t)f2bf(s <= t ? rb[r] : 0.f);
            *(LAS bf16_t*)(sb + RC_ARK + t * RC_S16 + s * 2) = (bf16_t)f2bf(s <= t ? rkm[r] : 0.f);
        }
        asm volatile("s_waitcnt lgkmcnt(0)" ::: "memory");
        float tc[16];
#pragma unroll
        for (int t = 0; t < 16; ++t) {
            float acc = (t == li) ? 1.f : 0.f;
            f32x4 a0 = *(const LAS f32x4*)(Aab + t * 20), a1 = *(const LAS f32x4*)(Aab + t * 20 + 4), a2 = *(const LAS f32x4*)(Aab + t * 20 + 8), a3 = *(const LAS f32x4*)(Aab + t * 20 + 12);
            const float av[16] = {a0.x, a0.y, a0.z, a0.w, a1.x, a1.y, a1.z, a1.w, a2.x, a2.y, a2.z, a2.w, a3.x, a3.y, a3.z, a3.w};
#pragma unroll
            for (int s = 0; s < t; ++s) acc += av[s] * tc[s];
            tc[t] = acc;
        }
        if (q == 0) {
#pragma unroll
            for (int t = 0; t < 16; ++t) *(LAS bf16_t*)(sb + RC_T + t * RC_S16 + li * 2) = (bf16_t)f2bf(tc[t]);
        }
    };
    if (wave >= 1) { const int ch0 = wave - 1; if (ch0 < RC_NCH) load_raw(ch0); }
    f32x4 S[4]; bf16x8 sop[2];
#pragma unroll
    for (int kt = 0; kt < 4; ++kt) S[kt] = (f32x4){0.f, 0.f, 0.f, 0.f};
    sop[0] = (bf16x8){0, 0, 0, 0, 0, 0, 0, 0}; sop[1] = sop[0];
    for (int rd = 0; rd < RC_ROUNDS; ++rd) {
        if (wave >= 1) { const int chp = RC_NP * rd + (wave - 1); if (chp < RC_NCH) { produce(wave - 1); if (chp + RC_NP < RC_NCH) load_raw(chp + RC_NP); } }
        __syncthreads();
        if (wave == 0) {
            for (int i = 0; i < RC_NP; ++i) {
                const int ch = RC_NP * rd + i; if (ch >= RC_NCH) break;
                const LAS unsigned char* sb = c.lds + i * RC_SLOT;
                const s16x4v vt = mfma16_frag(sb + RC_VT, li, q);
                f32x4 aw = __builtin_amdgcn_mfma_f32_16x16x16bf16_1k(mfma16_frag(sb + RC_AAK, li, q), vt, (f32x4){0.f, 0.f, 0.f, 0.f}, 0, 0, 0);
                f32x4 ay = __builtin_amdgcn_mfma_f32_16x16x16bf16_1k(mfma16_frag(sb + RC_ARK, li, q), vt, (f32x4){0.f, 0.f, 0.f, 0.f}, 0, 0, 0);
#pragma unroll
                for (int ks = 0; ks < 2; ++ks) {
                    const s16x4v alo = *(const LAS s16x4v*)(sb + RC_AT + li * RC_S64 + (32 * ks + 4 * q) * 2), ahi = *(const LAS s16x4v*)(sb + RC_AT + li * RC_S64 + (32 * ks + 16 + 4 * q) * 2);
                    const s16x4v rlo = *(const LAS s16x4v*)(sb + RC_RT + li * RC_S64 + (32 * ks + 4 * q) * 2), rhi = *(const LAS s16x4v*)(sb + RC_RT + li * RC_S64 + (32 * ks + 16 + 4 * q) * 2);
                    aw = __builtin_amdgcn_mfma_f32_16x16x32_bf16((bf16x8){alo[0], alo[1], alo[2], alo[3], ahi[0], ahi[1], ahi[2], ahi[3]}, sop[ks], aw, 0, 0, 0);
                    ay = __builtin_amdgcn_mfma_f32_16x16x32_bf16((bf16x8){rlo[0], rlo[1], rlo[2], rlo[3], rhi[0], rhi[1], rhi[2], rhi[3]}, sop[ks], ay, 0, 0, 0);
                }
                const u32x2 wb2 = (u32x2){pk2(aw[0], aw[1]), pk2(aw[2], aw[3])};
                const f32x4 au = __builtin_amdgcn_mfma_f32_16x16x16bf16_1k(mfma16_frag(sb + RC_T, li, q), __builtin_bit_cast(s16x4v, wb2), (f32x4){0.f, 0.f, 0.f, 0.f}, 0, 0, 0);
                const u32x2 ub2 = (u32x2){pk2(au[0], au[1]), pk2(au[2], au[3])}; const s16x4v ub = __builtin_bit_cast(s16x4v, ub2);
                ay = __builtin_amdgcn_mfma_f32_16x16x16bf16_1k(mfma16_frag(sb + RC_ARB, li, q), ub, ay, 0, 0, 0);
#pragma unroll
                for (int kt = 0; kt < 4; ++kt) {
                    const f32x4 p16 = *(const LAS f32x4*)(sb + RC_P16 + (16 * kt + 4 * q) * 4);
                    f32x4 sv = S[kt] * p16;
                    sv = __builtin_amdgcn_mfma_f32_16x16x16bf16_1k(mfma16_frag(sb + RC_KBT, 16 * kt + li, q), vt, sv, 0, 0, 0);
                    sv = __builtin_amdgcn_mfma_f32_16x16x16bf16_1k(mfma16_frag(sb + RC_BBT, 16 * kt + li, q), ub, sv, 0, 0, 0);
                    S[kt] = sv;
                }
#pragma unroll
                for (int ks = 0; ks < 2; ++ks) {
                    const u32x4 w = (u32x4){pk2(S[2 * ks][0], S[2 * ks][1]), pk2(S[2 * ks][2], S[2 * ks][3]), pk2(S[2 * ks + 1][0], S[2 * ks + 1][1]), pk2(S[2 * ks + 1][2], S[2 * ks + 1][3])};
                    sop[ks] = __builtin_bit_cast(bf16x8, w);
                }
#pragma unroll
                for (int r = 0; r < 4; ++r) yo[tok(16 * ch + 4 * q + r) * 256 + li] = (bf16_t)f2bf(ay[r]);
            }
        }
        __syncthreads();
    }
}
constexpr int RW_T = 32, RW_NC = (LEN + RW_T - 1) / RW_T, RW_BUF = 45056;
__device__ __forceinline__ void rwkv_scan(const Ctx& cx_, int l) {
    const Ctx c = relaunder(cx_);
    const int bid = c.bid, q = bid & 3, dir = 1 - ((bid >> 2) & 1), head = (bid >> 3) & 3, b = bid >> 5;
    const int tid = c.tid, lane = c.lane, wave = c.wave;
    const bf16_t* rk = (const bf16_t*)(c.dout + DO_RKVP); const bf16_t* l2 = (const bf16_t*)(c.ws + WS_L2O);
    bf16_t* yo = (bf16_t*)(c.ws + WS_YRW) + (size_t)dir * MP * 256;
    const bool producer = wave >= 4;
    const int pt = tid - 256, pstep = pt >> 3, pc0 = (pt & 7) * 8, pv0 = 2 * (pt & 7);
    float ka[8];
    u32x4 R, K, KK, DL, AS; unsigned V2 = 0; R = K = KK = DL = AS = (u32x4){0u, 0u, 0u, 0u};
    if (producer) {
#pragma unroll
        for (int e = 0; e < 8; ++e) ka[e] = c.in[I_KA][(size_t)l * 256 + head * 64 + pc0 + e];
    }
    auto tok = [&](int s) -> size_t { const int t = dir ? LEN - 1 - s : s; return (size_t)row_of(b, t); };
#define RW_LOAD(chunk) do { const int s_ = (chunk) * RW_T + pstep; if (s_ < LEN) { const size_t m_ = tok(s_); const bf16_t* rp_ = rk + m_ * 1024 + head * 64; const bf16_t* lp_ = l2 + m_ * 1280 + dir * 256 + head * 64; \
        R = *(const u32x4*)(rp_ + pc0); K = *(const u32x4*)(rp_ + 256 + pc0); KK = *(const u32x4*)(rp_ + 768 + pc0); V2 = *(const unsigned*)(rp_ + 512 + 16 * q + pv0); \
        DL = *(const u32x4*)(lp_ + pc0); AS = *(const u32x4*)(lp_ + 512 + pc0); } } while (0)
#define RW_WRITE(buf) do { LAS float* vec_ = (LAS float*)(c.lds + (buf) * RW_BUF); float r_[8], k_[8], kk_[8], dl_[8], as_[8]; unpack8(R, r_); unpack8(K, k_); unpack8(KK, kk_); unpack8(DL, dl_); unpack8(AS, as_); \
        float w_[8], a_[8], b_[8], kd_[8]; _Pragma("unroll") for (int e = 0; e < 8; ++e) { w_[e] = __expf(dl_[e]); a_[e] = -kk_[e]; b_[e] = kk_[e] * as_[e]; kd_[e] = k_[e] * (1.f + (as_[e] - 1.f) * ka[e]); } \
        LAS float* bp_ = vec_ + pstep * 320 + pc0; \
        *(LAS f32x4*)(bp_) = (f32x4){w_[0], w_[1], w_[2], w_[3]}; *(LAS f32x4*)(bp_ + 4) = (f32x4){w_[4], w_[5], w_[6], w_[7]}; \
        *(LAS f32x4*)(bp_ + 64) = (f32x4){a_[0], a_[1], a_[2], a_[3]}; *(LAS f32x4*)(bp_ + 68) = (f32x4){a_[4], a_[5], a_[6], a_[7]}; \
        *(LAS f32x4*)(bp_ + 128) = (f32x4){b_[0], b_[1], b_[2], b_[3]}; *(LAS f32x4*)(bp_ + 132) = (f32x4){b_[4], b_[5], b_[6], b_[7]}; \
        *(LAS f32x4*)(bp_ + 192) = (f32x4){kd_[0], kd_[1], kd_[2], kd_[3]}; *(LAS f32x4*)(bp_ + 196) = (f32x4){kd_[4], kd_[5], kd_[6], kd_[7]}; \
        *(LAS f32x4*)(bp_ + 256) = (f32x4){r_[0], r_[1], r_[2], r_[3]}; *(LAS f32x4*)(bp_ + 260) = (f32x4){r_[4], r_[5], r_[6], r_[7]}; \
        LAS float* vr_ = vec_ + 10240 + pstep * 16 + pv0; vr_[0] = bflo(V2); vr_[1] = bfhi(V2); } while (0)
#define RW_FLUSH(chunk) do { const int s_ = (chunk) * RW_T + pstep; if (s_ < LEN) { const LAS float* yy_ = (const LAS float*)(c.lds + ((chunk) & 1) * RW_BUF) + 10752 + pstep * 16 + pv0; \
        *(unsigned*)(yo + tok(s_) * 256 + head * 64 + 16 * q + pv0) = pk2(yy_[0], yy_[1]); } } while (0)
    if (producer) { RW_LOAD(0); RW_WRITE(0); RW_LOAD(1); }
    __syncthreads();
    const int rowl = (wave & 3) * 4 + (lane >> 4), j4 = (lane & 15) * 4;
    float S0 = 0.f, S1 = 0.f, S2 = 0.f, S3 = 0.f;
#define RW_SCAN(NS) do { float yv_[NS]; \
        _Pragma("unroll") for (int st = 0; st < NS; ++st) { \
            const LAS float* bp = vec + st * 320 + j4; \
            const f32x4 w = *(const LAS f32x4*)(bp), a = *(const LAS f32x4*)(bp + 64), bb = *(const LAS f32x4*)(bp + 128), kd = *(const LAS f32x4*)(bp + 192), r = *(const LAS f32x4*)(bp + 256); \
            const float v = vec[10240 + st * 16 + rowl]; \
            float sa = (S0 * a.x + S1 * a.y) + (S2 * a.z + S3 * a.w); \
            sa = allred16(sa); \
            S0 = S0 * w.x + v * kd.x; S1 = S1 * w.y + v * kd.y; S2 = S2 * w.z + v * kd.z; S3 = S3 * w.w + v * kd.w; \
            S0 += sa * bb.x; S1 += sa * bb.y; S2 += sa * bb.z; S3 += sa * bb.w; \
            float y = (S0 * r.x + S1 * r.y) + (S2 * r.z + S3 * r.w); \
            yv_[st] = allred16(y); } \
        if ((lane & 15) == 0) { _Pragma("unroll") for (int st = 0; st < NS; ++st) yy[st * 16 + rowl] = yv_[st]; } } while (0)
    for (int ch = 0; ch < RW_NC; ++ch) {
        if (!producer) {
            const LAS float* vec = (const LAS float*)(c.lds + (ch & 1) * RW_BUF);
            LAS float* yy = (LAS float*)(c.lds + (ch & 1) * RW_BUF) + 10752;
            if (ch < RW_NC - 1) RW_SCAN(32); else RW_SCAN(LEN - (RW_NC - 1) * RW_T);
        } else {
            if (ch + 1 < RW_NC) RW_WRITE((ch + 1) & 1);
            if (ch + 2 < RW_NC) RW_LOAD(ch + 2);
            if (ch >= 1) RW_FLUSH(ch - 1);
        }
        __syncthreads();
    }
#undef RW_SCAN
    if (producer) RW_FLUSH(RW_NC - 1);
    __syncthreads();
#undef RW_LOAD
#undef RW_WRITE
#undef RW_FLUSH
}

__device__ __forceinline__ void rwkv_post(const Ctx& cx_, int l) {
    const Ctx c = relaunder(cx_);
    const int gw = c.bid * NWAVES + c.wave, NGW = c.G * NWAVES, lane = c.lane, c0 = 4 * lane;
    const bf16_t* y0 = (const bf16_t*)(c.ws + WS_YRW); const bf16_t* y1 = y0 + (size_t)MP * 256;
    const bf16_t* rk = (const bf16_t*)(c.dout + DO_RKVP); const bf16_t* l2 = (const bf16_t*)(c.ws + WS_L2O); bf16_t* yc = (bf16_t*)(c.ws + WS_YC);
    float lw[4], lb[4], rkw[4];
#pragma unroll
    for (int e = 0; e < 4; ++e) { lw[e] = c.in[I_LNW][(size_t)l * 256 + c0 + e]; lb[e] = c.in[I_LNB][(size_t)l * 256 + c0 + e]; rkw[e] = c.in[I_RK][(size_t)l * 256 + c0 + e]; }
    for (int m = gw; m < M_ROWS; m += NGW) {
        const u32x2 a = *(const u32x2*)(y0 + (size_t)m * 256 + c0), bq = *(const u32x2*)(y1 + (size_t)m * 256 + c0);
        const u32x2 rr = *(const u32x2*)(rk + (size_t)m * 1024 + c0), kk = *(const u32x2*)(rk + (size_t)m * 1024 + 256 + c0), vv = *(const u32x2*)(rk + (size_t)m * 1024 + 512 + c0);
        const u32x2 gg = *(const u32x2*)(l2 + (size_t)m * 1280 + 1024 + c0);
        float y[4] = {bflo(a.x) + bflo(bq.x), bfhi(a.x) + bfhi(bq.x), bflo(a.y) + bflo(bq.y), bfhi(a.y) + bfhi(bq.y)};
        const float r[4] = {bflo(rr.x), bfhi(rr.x), bflo(rr.y), bfhi(rr.y)}, k[4] = {bflo(kk.x), bfhi(kk.x), bflo(kk.y), bfhi(kk.y)};
        const float v[4] = {bflo(vv.x), bfhi(vv.x), bflo(vv.y), bfhi(vv.y)}, g[4] = {bflo(gg.x), bfhi(gg.x), bflo(gg.y), bfhi(gg.y)};
        const float mean = sum16((y[0] + y[1]) + (y[2] + y[3])) * (1.f / 64.f);
        float q = 0.f, bo = 0.f;
#pragma unroll
        for (int e = 0; e < 4; ++e) { y[e] -= mean; q += y[e] * y[e]; bo += r[e] * k[e] * rkw[e]; }
        q = sum16(q) * (1.f / 64.f); bo = sum16(bo);
        const float rs = __builtin_amdgcn_rsqf(q + 64e-5f);
        float o[4];
#pragma unroll
        for (int e = 0; e < 4; ++e) o[e] = (y[e] * rs * lw[e] + lb[e] + bo * v[e]) * g[e];
        *(u32x2*)(yc + (size_t)m * 256 + c0) = (u32x2){pk2(o[0], o[1]), pk2(o[2], o[3])};
    }
}
__device__ __forceinline__ void final_phase(const Ctx& cx_, float* out) {
    const Ctx c = relaunder(cx_);
    const int gw = c.bid * NWAVES + c.wave, NGW = c.G * NWAVES, lane = c.lane;
    const bf16_t* H = c.H(); const f32x4* fw = (const f32x4*)c.in[I_FNW];
    for (int r = gw; r < BATCH * SEQ; r += NGW) {
        const size_t m = (size_t)r;
        const u32x2* hp = (const u32x2*)(H + m * DM);
        float v[4][4], ss = 0.f;
#pragma unroll
        for (int i = 0; i < 4; ++i) { const u32x2 w = hp[lane + 64 * i]; v[i][0] = bflo(w.x); v[i][1] = bfhi(w.x); v[i][2] = bflo(w.y); v[i][3] = bfhi(w.y); ss += (v[i][0] * v[i][0] + v[i][1] * v[i][1]) + (v[i][2] * v[i][2] + v[i][3] * v[i][3]); }
        ss = wave_sum(ss); const float s = __builtin_amdgcn_rsqf(ss * (1.0f / DM) + EPS);
        f32x4* op = (f32x4*)(out + (size_t)r * DM);
#pragma unroll
        for (int i = 0; i < 4; ++i) { const f32x4 w = fw[lane + 64 * i]; op[lane + 64 * i] = (f32x4){v[i][0] * s * w.x, v[i][1] * s * w.y, v[i][2] * s * w.z, v[i][3] * s * w.w}; }
    }
}

constexpr int LDS_BYTES = 147456;
#ifndef MIXDIR
#define MIXDIR 0
#define MIXLAYER 0
#endif
#ifndef PHMASK
#define PHMASK 0xFFFFF
#endif
__global__ void __launch_bounds__(NTHREADS, 2) mega_fwd(Params p) {
    extern __shared__ __attribute__((aligned(16))) unsigned char lds_raw[];
    cg::grid_group grid = cg::this_grid();
    Ctx c0_; c0_.in = p.in; c0_.ws = p.ws; c0_.dout = (unsigned char*)p.out; c0_.lds = (LAS unsigned char*)lds_raw;
    c0_.wave = __builtin_amdgcn_readfirstlane((int)threadIdx.x >> 6); c0_.tid = opaque_tid(c0_.wave); c0_.lane = c0_.tid & 63; c0_.G = gridDim.x; c0_.bid = blockIdx.x;
    Ctx c = c0_;
    const int G = c.G, bid = c.bid;
#ifdef PROF_A
#ifndef PROF_SHIFT
#define PROF_SHIFT 1.0f
#endif
#define PROF_PTR ((unsigned long long*)(c.ws + WS_DEC + (size_t)MP * 64))
    if (blockIdx.x == 0 && threadIdx.x == 0) { for (int k = 0; k < 15; ++k) PROF_PTR[k] = 0; PROF_PTR[15] = __builtin_amdgcn_s_memrealtime(); }
#define STAMP(k) do { if (blockIdx.x == 0 && threadIdx.x == 0) { const unsigned long long t_ = __builtin_amdgcn_s_memrealtime(); PROF_PTR[k] += t_ - PROF_PTR[15]; PROF_PTR[15] = t_; } } while (0)
#else
#define STAMP(k) do { } while (0)
#endif
    unsigned* barw = (unsigned*)(c.ws + WS_BAR);
    volatile LAS unsigned* bst = (volatile LAS unsigned*)(c.lds + LDS_BYTES - 64);
    if (bid == 0) for (int i = threadIdx.x; i < XCD_BAR_WORDS + 1024; i += NTHREADS) barw[i < XCD_BAR_WORDS ? i : 4096 + (i - XCD_BAR_WORDS)] = 0u;
    if (threadIdx.x < 2) bst[threadIdx.x] = 0u;
    __syncthreads();
    if (PHMASK & 1) phase0(c);
    grid.sync(); STAMP(0);
    const XcdBarrier xbar = xcd_barrier_post(barw, bst);
#define GRID_BAR() do { xcd_barrier(xbar, c0_.wave); c = relaunder(c0_); } while (0)
#pragma unroll 1
    for (int l = 0; l < DEPTH; ++l) {
#define wb (c.wb(l))
        if (PHMASK & 2) dt_job(c, l);
        if (PHMASK & 4) { SchedPlain S{c.H(), wb + WB_IN, DM, DM, DM, MP / 256, 11, G, bid, 0};
          EpiInProj E{c.ssq(), (bf16_t*)(c.ws + WS_UH), (bf16_t*)(c.ws + WS_PZ), (bf16_t*)(c.ws + WS_PXBC), (bf16_t*)(c.ws + WS_PRKVX)};
          pg8::gemm_phase(c.lds, c.wave, S, E); }
        GRID_BAR(); STAMP(1);
        if (PHMASK & 8) { SchedS5 S{(const bf16_t*)(c.ws + WS_UH), wb + WB_SX, 256, G, bid}; EpiS5X E{(float*)(c.ws + WS_X)}; pg8::gemm_phase(c.lds, c.wave, S, E); }
        if (PHMASK & 16) rwkv_prep(c, l);
        if (PHMASK & 32) ssd_prep(c, l);
        GRID_BAR(); STAMP(2);
        if (PHMASK & 64) s5_scan(c, l);
        if (PHMASK & 4096) ssd_states(c, l);
        if (PHMASK & 128) { SchedPlain S{(const bf16_t*)(c.ws + WS_L1IN), wb + WB_L1, 512, 512, 512, MP / 256, 2, G, bid, 0}; EpiL1 E{(bf16_t*)(c.ws + WS_L1O)}; pg8::gemm_phase(c.lds, c.wave, S, E); }
        GRID_BAR(); STAMP(3);
        ssd_chunk_scan(c, l);
        if (PHMASK & 256) { SchedL2 S{(const bf16_t*)(c.ws + WS_L1O), wb + WB_L2, G, bid, MP / 256, 0}; EpiL2 E{(bf16_t*)(c.ws + WS_L2O), c.in[I_W0] + (size_t)l * 512, c.in[I_A0] + (size_t)l * 512}; pg8::gemm_phase(c.lds, c.wave, S, E); }
        if (PHMASK & 512) { SchedS5 S{(const bf16_t*)(c.ws + WS_UH), wb + WB_SY, 512, G, bid}; EpiS5Y E{(bf16_t*)(c.ws + WS_YAPRE)}; pg8::gemm_phase(c.lds, c.wave, S, E); }
        GRID_BAR(); STAMP(4);
#ifdef RWKV_DBG
        if (PHMASK & 1024) rwkv_scan(c, l);
        if (l == 0) rwkv_chunked(c, l);
#else
        if (PHMASK & 1024) rwkv_chunked(c, l);
#endif
        STAMP(5);
        if (PHMASK & 2048) ssd_outputs(c, l);
        GRID_BAR(); STAMP(6);
#ifdef RWKV_DBG
        if (l == 0) { unsigned* dbg = (unsigned*)(c.ws + WS_BAR + 16384); const bf16_t* y0_ = (const bf16_t*)(c.ws + WS_YRW); const bf16_t* y1_ = (const bf16_t*)(c.ws + WS_MIX + 33 * QB / 2);
          float s0 = 0.f, d0 = 0.f, s1 = 0.f, d1 = 0.f; const bf16_t* y0b_ = y0_ + (size_t)MP * 256; const bf16_t* y1b_ = (const bf16_t*)(c.ws + WS_MIX + 47 * QB / 2);
          for (size_t i = (size_t)bid * NTHREADS + threadIdx.x; i < (size_t)M_ROWS * 256; i += (size_t)G * NTHREADS) { const float a = bf1(y0_[i]), b2 = bf1(y1_[i]), a1 = bf1(y0b_[i]), b1 = bf1(y1b_[i]);
            s0 += a * a; d0 += (a - b2) * (a - b2); s1 += a1 * a1; d1 += (a1 - b1) * (a1 - b1); }
          s0 = wave_sum(s0); d0 = wave_sum(d0); s1 = wave_sum(s1); d1 = wave_sum(d1);
          if ((threadIdx.x & 63) == 0) { atomicAdd((float*)dbg + 0, s0); atomicAdd((float*)dbg + 1, d0); atomicAdd((float*)dbg + 2, s1); atomicAdd((float*)dbg + 3, d1); } }
#endif
        if (PHMASK & 8192) rwkv_post(c, l);
        if (PHMASK & 16384) { SchedPlain S{(const bf16_t*)(c.ws + WS_YAPRE), wb + WB_GLU, 256, 256, 256, MP / 256, 2, G, bid, 0}; EpiGLU E{(bf16_t*)(c.ws + WS_YA), c.in[I_GLUB] + (size_t)l * 512}; pg8::gemm_phase(c.lds, c.wave, S, E); }
        GRID_BAR(); STAMP(7);
        if (PHMASK & 32768) { SchedProj S{c.H(), wb + WB_G, wb + WB_P, (const bf16_t*)(c.ws + WS_YA), (const bf16_t*)(c.ws + WS_YB), (const bf16_t*)(c.ws + WS_YC), (l < DEPTH - 1 ? MP / 256 : BATCH * SEQ / 256), G, bid, 0};
          EpiProj E{c.ssq(), (const float*)(c.ws + WS_SSQB), c.ws + WS_PARK + (size_t)bid * 393216, (bf16_t*)(c.dout + DO_MERGED), opaque_tid(c.wave)}; pg8::gemm_phase(c.lds, c.wave, S, E); }
        GRID_BAR(); STAMP(8);
        if (PHMASK & 65536) { SchedPlain S{(const bf16_t*)(c.dout + DO_MERGED), wb + WB_O, DM, DM, DM, (l < DEPTH - 1 ? MP / 256 : BATCH * SEQ / 256), 4, G, bid, 0}; EpiResid E{c.H(), c.ssq()}; pg8::gemm_phase(c.lds, c.wave, S, E); }
        GRID_BAR(); STAMP(9);
        if (PHMASK & 131072) { SchedPlain S{c.H(), wb + WB_1, DM, DM, DM, (l < DEPTH - 1 ? MP / 256 : BATCH * SEQ / 256), 16, G, bid, 0}; EpiUp E{c.ssq(), (bf16_t*)(c.ws + WS_ACT)}; pg8::gemm_phase(c.lds, c.wave, S, E); }
        GRID_BAR(); STAMP(10);
        if (PHMASK & 262144) { SchedPlain S{(const bf16_t*)(c.ws + WS_ACT), wb + WB_2, DFF, DFF, DFF, (l < DEPTH - 1 ? MP / 256 : BATCH * SEQ / 256), 4, G, bid, 0}; EpiResid E{c.H(), c.ssq()}; pg8::gemm_phase(c.lds, c.wave, S, E); }
        GRID_BAR(); STAMP(11);
    }
    if (PHMASK & 524288) final_phase(c, p.out);
#ifdef RWKV_DBG
    GRID_BAR();
    if (blockIdx.x == 0) { const unsigned* dbg = (const unsigned*)(c.ws + WS_BAR + 16384); const float s0 = __uint_as_float(__hip_atomic_load(dbg + 0, __ATOMIC_RELAXED, __HIP_MEMORY_SCOPE_AGENT)), d0 = __uint_as_float(__hip_atomic_load(dbg + 1, __ATOMIC_RELAXED, __HIP_MEMORY_SCOPE_AGENT)), s1 = __uint_as_float(__hip_atomic_load(dbg + 2, __ATOMIC_RELAXED, __HIP_MEMORY_SCOPE_AGENT)), d1 = __uint_as_float(__hip_atomic_load(dbg + 3, __ATOMIC_RELAXED, __HIP_MEMORY_SCOPE_AGENT));
        float va = 100.f + 10000.f * sqrtf(d1 / s1), vb = 100.f + 10000.f * sqrtf(d0 / s0);
        va = rintf(va * 0.1f) * 10.f; vb = rintf(vb * 0.1f) * 10.f;
        for (int i = threadIdx.x; i < (1 << 20); i += NTHREADS) p.out[1 + i] = vb;
        if (threadIdx.x == 0) p.out[0] = 100.f * va; }
#endif
#ifdef PROF_A
    GRID_BAR(); STAMP(12);
    if (blockIdx.x == 0) {
        __syncthreads();
        float va = (float)(__hip_atomic_load(&PROF_PTR[PROF_A], __ATOMIC_RELAXED, __HIP_MEMORY_SCOPE_AGENT)) * 0.01f, vb = (float)(__hip_atomic_load(&PROF_PTR[PROF_B], __ATOMIC_RELAXED, __HIP_MEMORY_SCOPE_AGENT)) * 0.01f;
        va = exp2f(rintf(log2f(va * PROF_SHIFT) * 2.f) * 0.5f); vb = exp2f(rintf(log2f(vb * PROF_SHIFT) * 2.f) * 0.5f);
        for (int i = threadIdx.x; i < (1 << 20); i += NTHREADS) p.out[1 + i] = vb;
        if (threadIdx.x == 0) p.out[0] = 100.f * va;
    }
#endif
}

extern "C" void kernel_launch(void* const* d_in, const int* in_sizes, int n_in, void* d_out, int out_size, void* d_ws, size_t ws_size, hipStream_t stream) {
    static int grid = 0;
    if (grid == 0) {
        int dev = 0, cus = 0, per_cu = 0;
        if (n_in != N_INPUTS || out_size != BATCH * SEQ * DM || ws_size < WS_END) { fprintf(stderr, "kernel_launch: unexpected shapes (n_in %d out %d ws %zu)\n", n_in, out_size, ws_size); grid = -1; return; }
        (void)hipGetDevice(&dev); (void)hipDeviceGetAttribute(&cus, hipDeviceAttributeMultiprocessorCount, dev);
        (void)hipFuncSetAttribute((const void*)mega_fwd, hipFuncAttributeMaxDynamicSharedMemorySize, LDS_BYTES);
        (void)hipOccupancyMaxActiveBlocksPerMultiprocessor(&per_cu, (const void*)mega_fwd, NTHREADS, LDS_BYTES);
        if (per_cu < 1) { fprintf(stderr, "kernel_launch: occupancy query says %d blocks per CU\n", per_cu); per_cu = 1; }
        grid = cus * 1;
        if (grid != 256) fprintf(stderr, "kernel_launch: %d CUs (the scan phases are laid out for 256 workgroups)\n", grid);
    }
    if (grid < 0) return;
    Params p{};
    for (int i = 0; i < N_INPUTS; ++i) p.in[i] = (const float*)d_in[i];
    p.out = (float*)d_out; p.ws = (unsigned char*)d_ws; p.ph_lo = 0; p.ph_hi = 0;
    void* args[] = {&p};
    hipError_t e = hipLaunchCooperativeKernel((const void*)mega_fwd, dim3(grid), dim3(NTHREADS), args, LDS_BYTES, stream);
    if (e != hipSuccess) fprintf(stderr, "cooperative launch failed: %s (grid %d)\n", hipGetErrorString(e), grid);
}
```

```cpp
#include <hip/hip_runtime.h>
#include <hip/hip_cooperative_groups.h>
#include <cstdio>
#include <cstdint>
namespace cg = cooperative_groups;

#define LAS __attribute__((address_space(3)))
typedef unsigned short bf16_t;
typedef short bf16x8 __attribute__((ext_vector_type(8)));
typedef float f32x4 __attribute__((ext_vector_type(4)));
typedef unsigned u32x4 __attribute__((ext_vector_type(4)));
typedef unsigned u32x2 __attribute__((ext_vector_type(2)));

constexpr int BATCH = 8, SEQ = 4096, NMETA = 16, LEN = SEQ + NMETA, DM = 1024, DFF = 4096, DEPTH = 2;
constexpr int M_ROWS = BATCH * LEN;
constexpr int MP = 33024;
constexpr int N_IN = 5896;
constexpr int NCH16 = LEN / 16;
constexpr int S5ROWS = BATCH * NCH16;
constexpr int S5RP = 2304;
constexpr float EPS = 1e-6f;
constexpr int NTHREADS = 512, NWAVES = 8;

constexpr size_t QB = (size_t)MP * 256 * 2;
constexpr size_t WB_IN = 0;
constexpr size_t WB_G = WB_IN + (size_t)2816 * 1024;
constexpr size_t WB_P = WB_G + (size_t)3072 * 1024;
constexpr size_t WB_O = WB_P + (size_t)1024 * 1024;
constexpr size_t WB_1 = WB_O + (size_t)1024 * 1024;
constexpr size_t WB_2 = WB_1 + (size_t)4096 * 1024;
constexpr size_t WB_GLU = WB_2 + (size_t)1024 * 4096;
constexpr size_t WB_L1 = WB_GLU + (size_t)512 * 256;
constexpr size_t WB_L2 = WB_L1 + (size_t)512 * 512;
constexpr size_t WB_SX = WB_L2 + (size_t)1280 * 256;
constexpr size_t WB_SY = WB_SX + (size_t)16 * 256 * 256;
constexpr size_t WB_ELEMS = WB_SY + (size_t)16 * 256 * 512;
constexpr size_t WB_BYTES = WB_ELEMS * 2;
static_assert(WB_BYTES <= 5 * QB / 2, "weight block fits 2.5 Q");

constexpr size_t WS_H = 0;
constexpr size_t WS_WB0 = 4 * QB;
constexpr size_t WS_SMALL = 13 * QB / 2;
constexpr size_t WS_SSQ = WS_SMALL;
constexpr size_t WS_DT = WS_SSQ + (size_t)MP * 16 * 4;
constexpr size_t WS_DEC = WS_DT + (size_t)MP * 16 * 4;
static_assert(WS_DEC + (size_t)MP * 16 * 4 <= 7 * QB, "small region");
constexpr size_t WS_MIX = 7 * QB;
constexpr size_t WS_PXBC = WS_MIX;
constexpr size_t WS_YSSD = WS_MIX;
constexpr size_t WS_PARK = WS_MIX;
constexpr size_t WS_ACT = WS_MIX;
constexpr size_t WS_PRKVX = WS_MIX + 4 * QB;
constexpr size_t WS_L2O = WS_MIX + 4 * QB;
constexpr size_t WS_PZ = WS_MIX + 9 * QB;
constexpr size_t WS_UH = WS_MIX + 11 * QB;
constexpr size_t WS_X = WS_MIX + 53 * QB / 4;
constexpr size_t WS_YRW = WS_X;
constexpr size_t WS_L1IN = WS_MIX + 31 * QB / 2;
constexpr size_t WS_YAPRE = WS_L1IN;
constexpr size_t WS_L1O = WS_MIX + 35 * QB / 2;
constexpr size_t WS_YB = WS_L1O;
constexpr size_t WS_BC = WS_MIX + 39 * QB / 2;
constexpr size_t WS_YA = WS_BC;
constexpr size_t WS_YC = WS_BC + QB;
constexpr size_t WS_XS = WS_MIX + 43 * QB / 2;
constexpr size_t WS_END = WS_XS + 2 * QB;
static_assert(WS_END <= (size_t)512 << 20, "workspace map fits 512 MiB");
static_assert((size_t)16 * S5RP * 512 * 2 <= 9 * QB / 4 && (size_t)16 * S5RP * 256 * 4 <= 9 * QB / 4, "S5 buffers fit their slots");
static_assert((size_t)256 * 393216 <= 6 * QB, "gate park");
constexpr size_t DO_RKVP = 0;
constexpr size_t DO_MERGED = 0;
constexpr size_t DO_WB1 = 4 * QB;
static_assert(DO_WB1 + WB_BYTES <= (size_t)BATCH * SEQ * DM * 4, "d_out scratch map");

__device__ __forceinline__ unsigned f2bf(float f) { unsigned u = __builtin_bit_cast(unsigned, f); return (u + 0x7fffu + ((u >> 16) & 1u)) >> 16; }
typedef float f32x2_t_ __attribute__((ext_vector_type(2))); typedef __bf16 bf16x2_t_ __attribute__((ext_vector_type(2)));
__device__ __forceinline__ unsigned pk2(float lo, float hi) { const f32x2_t_ v = {lo, hi}; const bf16x2_t_ b = __builtin_convertvector(v, bf16x2_t_); return __builtin_bit_cast(unsigned, b); }
__device__ __forceinline__ float bflo(unsigned w) { return __builtin_bit_cast(float, w << 16); }
__device__ __forceinline__ float bfhi(unsigned w) { return __builtin_bit_cast(float, w & 0xffff0000u); }
__device__ __forceinline__ float bf1(bf16_t v) { return __builtin_bit_cast(float, (unsigned)v << 16); }
__device__ __forceinline__ float sigmoidf_(float x) { return 1.0f / (1.0f + __expf(-x)); }
__device__ __forceinline__ float siluf_(float x) { return x / (1.0f + __expf(-x)); }
__device__ __forceinline__ float tanhf_(float x) { x = fminf(fmaxf(x, -15.f), 15.f); const float t = __expf(2.f * x); return (t - 1.f) / (t + 1.f); }
__device__ __forceinline__ float softplusf_(float x) { return fmaxf(x, 0.f) + __logf(1.0f + __expf(-fabsf(x))); }
__device__ __forceinline__ float geluf_(float x) { const float u = 0.7978845608028654f * (x + 0.044715f * x * x * x); return 0.5f * x * (1.f + tanhf_(u)); }
__device__ __forceinline__ float wave_sum(float v) {
#pragma unroll
    for (int o = 1; o < 64; o <<= 1) v += __shfl_xor(v, o);
    return v;
}
__device__ __forceinline__ float sum16(float v) {
#pragma unroll
    for (int o = 1; o < 16; o <<= 1) v += __shfl_xor(v, o);
    return v;
}
template <int CTRL> __device__ __forceinline__ float dpp_mov(float x) {
    return __builtin_bit_cast(float, __builtin_amdgcn_update_dpp(0, __builtin_bit_cast(int, x), CTRL, 0xf, 0xf, true));
}
__device__ __forceinline__ float allred16(float x) {
    x += dpp_mov<0xB1>(x); x += dpp_mov<0x4E>(x); x += dpp_mov<0x141>(x); x += dpp_mov<0x140>(x); return x;
}
__device__ __forceinline__ void unpack8(const u32x4 w, float (&f)[8]) {
    f[0] = bflo(w.x); f[1] = bfhi(w.x); f[2] = bflo(w.y); f[3] = bfhi(w.y); f[4] = bflo(w.z); f[5] = bfhi(w.z); f[6] = bflo(w.w); f[7] = bfhi(w.w);
}
__device__ __forceinline__ u32x4 pack8(const float (&f)[8]) { u32x4 w; w.x = pk2(f[0], f[1]); w.y = pk2(f[2], f[3]); w.z = pk2(f[4], f[5]); w.w = pk2(f[6], f[7]); return w; }
__device__ __forceinline__ int opaque_tid(int) { int t = threadIdx.x; asm volatile("" : "+v"(t)); return t; }
__device__ __forceinline__ int row_of(int b, int t) { return t < NMETA ? BATCH * SEQ + b * NMETA + t : b * SEQ + (t - NMETA); }
__device__ __forceinline__ void bt_of(int m, int& b, int& t) { if (m < BATCH * SEQ) { b = m >> 12; t = NMETA + (m & (SEQ - 1)); } else { const int q = m - BATCH * SEQ; b = q >> 4; t = q & (NMETA - 1); } }
namespace pg8 {
constexpr int BM = 256, BK = 64, HALF = 128, HTB = HALF * BK * 2  , STAGE_BYTES = 8 * HTB;
__host__ __device__ __forceinline__ int lds_byte(int r, int c) { const int st = (r >> 4) * 2 + (c >> 5), rr = r & 15, cc = c & 31, ob = rr * 64 + cc * 2; return st * 1024 + (ob ^ (((ob >> 9) & 1) << 5)); }
__host__ __device__ __forceinline__ void stage_rc(int b, int& R, int& C) { const int st = b / 1024, sb = b % 1024, swz = sb ^ (((sb >> 9) & 1) << 5); R = (st >> 1) * 16 + swz / 64; C = (st & 1) * 32 + (swz % 64) / 2; }
__host__ __device__ __forceinline__ int perm32(int rho) { const int n = rho >> 4, i = rho & 15; return 8 * (i >> 2) + 4 * n + (i & 3); }

struct GU {
    const bf16_t* A;
    const bf16_t* B;
    int lda, ldb, nt;
    int pm, pn, kind;
};

template <bool SKIP_HI = false, class Epi, class Sched>
__device__ __forceinline__ void gemm_phase(LAS unsigned char* lds, int wave_s, const Sched& S, const Epi& E) {
    const int tid = opaque_tid(wave_s), wid = wave_s, lane = tid & 63, wr = wid >> 2, wc = wid & 3, fr = lane & 15, fq = lane >> 4;
#define PG8_VOFF(lda_, ldb_, a0, b0) do { int R0_, C0_; stage_rc(tid * 16, R0_, C0_); \
        a0 = (unsigned)(R0_ * (lda_) + C0_) * 2u; b0 = (unsigned)(((R0_ & ~31) + perm32(R0_ & 31)) * (ldb_) + C0_) * 2u; } while (0)
    const size_t kstep = (size_t)(BK * 2);
    const unsigned ldsw = (unsigned)wid * 1024u;
    const int aoff = lds_byte(wr * 64 + fr, fq * 8), boff = lds_byte(wc * 32 + fr, fq * 8);
#define PG8_SA(b, h) (((b) * 2 + (h)) * HTB)
#define PG8_SB(b, h) ((4 + (b) * 2 + (h)) * HTB)
#define PG8_STAGE(bufoff, gbase, v0, hs) do { \
        __builtin_amdgcn_global_load_lds((const unsigned*)((const char*)(gbase) + (v0)), (LAS unsigned*)(lds + (bufoff) + ldsw), 16, 0, 0); \
        __builtin_amdgcn_global_load_lds((const unsigned*)((const char*)(gbase) + ((hs) >> 1) + (v0)), (LAS unsigned*)(lds + (bufoff) + ldsw + 8192), 16, 0, 0); } while (0)
#define PG8_LDA(dst, b, h) do { _Pragma("unroll") for (int m = 0; m < 4; ++m) _Pragma("unroll") for (int k = 0; k < 2; ++k) dst[m][k] = *(const LAS bf16x8*)(lds + PG8_SA(b, h) + aoff + m * 2048 + k * 1024); } while (0)
#define PG8_LDB(dst, b, h) do { _Pragma("unroll") for (int n = 0; n < 2; ++n) _Pragma("unroll") for (int k = 0; k < 2; ++k) dst[n][k] = *(const LAS bf16x8*)(lds + PG8_SB(b, h) + boff + n * 2048 + k * 1024); } while (0)
#define PG8_MMA(ai, bj, At, Bt) do { __builtin_amdgcn_s_setprio(1); _Pragma("unroll") for (int m = 0; m < 4; ++m) _Pragma("unroll") for (int n = 0; n < 2; ++n) _Pragma("unroll") for (int k = 0; k < 2; ++k) \
        acc[ai][bj][m][n] = __builtin_amdgcn_mfma_f32_16x16x32_bf16(Bt[n][k], At[m][k], acc[ai][bj][m][n], 0, 0, 0); __builtin_amdgcn_s_setprio(0); } while (0)
#define PG8_WAIT_V(n) asm volatile("s_waitcnt vmcnt(" #n ")" ::: "memory")
#define PG8_WAIT_L(n) asm volatile("s_waitcnt lgkmcnt(" #n ")" ::: "memory")
#define PG8_BAR __builtin_amdgcn_s_barrier()
#define PG8_SCHED __builtin_amdgcn_sched_barrier(0)
    GU cur, nxt; int ui = 0;
    if (!S.next(0, cur)) return;
    f32x4 acc[2][2][4][2];
#pragma unroll
    for (int a = 0; a < 2; ++a)
#pragma unroll
        for (int b = 0; b < 2; ++b)
#pragma unroll
            for (int m = 0; m < 4; ++m)
#pragma unroll
                for (int n = 0; n < 2; ++n) acc[a][b][m][n] = (f32x4){0.f, 0.f, 0.f, 0.f};
    bf16x8 At[4][2], B0[2][2], B1[2][2];
    const char* cA = (const char*)cur.A; const char* cB = (const char*)cur.B;
    unsigned vA0, vB0; PG8_VOFF(cur.lda, cur.ldb, vA0, vB0);
    size_t hsA = (size_t)HALF * cur.lda * 2, hsB = (size_t)HALF * cur.ldb * 2;
    int nt = cur.nt; asm volatile("" : "+s"(nt));
    PG8_STAGE(PG8_SB(0, 0), cB, vB0, hsB); PG8_STAGE(PG8_SB(0, 1), cB + hsB, vB0, hsB); PG8_STAGE(PG8_SA(0, 0), cA, vA0, hsA); PG8_STAGE(PG8_SA(0, 1), cA + hsA, vA0, hsA);
    if (wr == 1) PG8_BAR;
    PG8_WAIT_V(2); PG8_BAR;
    PG8_STAGE(PG8_SB(1, 0), cB + kstep, vB0, hsB); PG8_STAGE(PG8_SA(1, 0), cA + kstep, vA0, hsA); PG8_STAGE(PG8_SB(1, 1), cB + hsB + kstep, vB0, hsB);
    PG8_WAIT_V(6); PG8_BAR;
    for (;;) {
        const bool has_next = S.next(ui + 1, nxt);
        const char* nA = has_next ? (const char*)nxt.A : cA; const char* nB = has_next ? (const char*)nxt.B : cB;
        unsigned nvA0 = vA0, nvB0 = vB0;
        if (has_next) PG8_VOFF(nxt.lda, nxt.ldb, nvA0, nvB0);
        const size_t nhsA = has_next ? (size_t)HALF * nxt.lda * 2 : hsA, nhsB = has_next ? (size_t)HALF * nxt.ldb * 2 : hsB;
        for (int t = 0; t < nt; t += 2) {
            const bool last = (t == nt - 2);
            const char* a1 = cA + (size_t)(t + 1) * kstep;
            const char* a2 = last ? nA : cA + (size_t)(t + 2) * kstep; const char* b2 = last ? nB : cB + (size_t)(t + 2) * kstep;
            const char* a3 = a2 + kstep; const char* b3 = b2 + kstep;
            const unsigned xA0 = last ? nvA0 : vA0, xB0 = last ? nvB0 : vB0;
            const size_t xhA = last ? nhsA : hsA, xhB = last ? nhsB : hsB;
            PG8_LDB(B0, 0, 0); PG8_LDB(B1, 0, 1); PG8_SCHED; PG8_LDA(At, 0, 0); PG8_STAGE(PG8_SA(1, 1), a1 + hsA, vA0, hsA);
            PG8_WAIT_V(8); PG8_WAIT_L(0); PG8_BAR; PG8_MMA(0, 0, At, B0); PG8_MMA(0, 1, At, B1); PG8_BAR; PG8_SCHED;
            PG8_LDA(At, 0, 1); PG8_STAGE(PG8_SB(0, 0), b2, xB0, xhB); PG8_STAGE(PG8_SB(0, 1), b2 + xhB, xB0, xhB); PG8_STAGE(PG8_SA(0, 0), a2, xA0, xhA);
            PG8_WAIT_V(8); PG8_WAIT_L(0); PG8_BAR; if constexpr (!SKIP_HI) { PG8_MMA(1, 0, At, B0); PG8_MMA(1, 1, At, B1); } PG8_BAR; PG8_SCHED;
            PG8_LDB(B0, 1, 0); PG8_LDB(B1, 1, 1); PG8_SCHED; PG8_LDA(At, 1, 0); PG8_STAGE(PG8_SA(0, 1), a2 + xhA, xA0, xhA);
            PG8_WAIT_V(8); PG8_WAIT_L(0); PG8_BAR; PG8_MMA(0, 0, At, B0); PG8_MMA(0, 1, At, B1); PG8_BAR; PG8_SCHED;
            PG8_LDA(At, 1, 1); PG8_STAGE(PG8_SB(1, 0), b3, xB0, xhB); PG8_STAGE(PG8_SB(1, 1), b3 + xhB, xB0, xhB); PG8_STAGE(PG8_SA(1, 0), a3, xA0, xhA);
            PG8_WAIT_V(8); PG8_WAIT_L(0); PG8_BAR; if constexpr (!SKIP_HI) { PG8_MMA(1, 0, At, B0); PG8_MMA(1, 1, At, B1); } PG8_BAR; PG8_SCHED;
        }
        if (wr == 0) PG8_BAR;
        const bool keep = E(acc, cur, wr, wc, fr, fq);
        if (!has_next) break;
        if (!keep) {
#pragma unroll
            for (int a = 0; a < 2; ++a)
#pragma unroll
                for (int b = 0; b < 2; ++b)
#pragma unroll
                    for (int m = 0; m < 4; ++m)
#pragma unroll
                        for (int n = 0; n < 2; ++n) acc[a][b][m][n] = (f32x4){0.f, 0.f, 0.f, 0.f};
        }
        cur = nxt; cA = nA; cB = nB; vA0 = nvA0; vB0 = nvB0; hsA = nhsA; hsB = nhsB; nt = cur.nt; asm volatile("" : "+s"(nt)); ++ui;
        if (wr == 1) PG8_BAR;
    }
    PG8_WAIT_V(0);
    PG8_BAR;
#undef PG8_VOFF
#undef PG8_SA
#undef PG8_SB
#undef PG8_STAGE
#undef PG8_LDA
#undef PG8_LDB
#undef PG8_MMA
#undef PG8_WAIT_V
#undef PG8_WAIT_L
#undef PG8_BAR
#undef PG8_SCHED
}

__device__ __forceinline__ bool tile_order(int i, int G, int c, int nM, int nN, int& pm, int& pn) {
    const int nwg = nM * nN; const long L = (long)i * G + c; if (L >= nwg) return false;
    int wgid = (int)L; { const int q = nwg / 8, r = nwg % 8, xcd = wgid % 8, off = wgid / 8; wgid = (xcd < r ? xcd * (q + 1) : r * (q + 1) + (xcd - r) * q) + off; }
    const int nig = 8 * nN, gid = wgid / nig, fm = gid * 8, gsz = (nM - fm) < 8 ? (nM - fm) : 8;
    pm = fm + ((wgid % nig) % gsz); pn = (wgid % nig) / gsz; return true;
}
}
using pg8::GU;
enum InIdx { I_X = 0, I_META, I_FNW, I_MIXNW, I_WIN, I_S5LRE, I_S5LIM, I_S5LS, I_S5BRE, I_S5BIM, I_S5CRE, I_S5CIM, I_S5D, I_GLUW, I_GLUB,
             I_CONVW, I_CONVB, I_ALOG, I_DTB, I_SSDD, I_SSDNW, I_MURKV, I_MUWAG, I_W0, I_W1, I_W2, I_A0, I_A1, I_A2, I_G1, I_G2, I_KK, I_KA, I_RK, I_LNW, I_LNB,
             I_PA, I_PB, I_PC, I_WOUT, I_MLPNW, I_MLPW1, I_MLPW2, N_INPUTS };
struct Params { const float* in[N_INPUTS]; float* out; unsigned char* ws; int ph_lo, ph_hi; };

struct Ctx {
    const float* const* in; unsigned char* ws; unsigned char* dout;
    LAS unsigned char* lds;
    int tid, lane, wave, G, bid;
    __device__ __forceinline__ bf16_t* wb(int layer) const { return (bf16_t*)(layer == 0 ? ws + WS_WB0 : dout + DO_WB1); }
    __device__ __forceinline__ bf16_t* H() const { return (bf16_t*)(ws + WS_H); }
    __device__ __forceinline__ float* ssq() const { return (float*)(ws + WS_SSQ); }
};
__device__ __forceinline__ Ctx relaunder(const Ctx& c0) {
    Ctx c = c0; c.tid = opaque_tid(c0.wave); c.lane = c.tid & 63;
    return c;
}
__device__ __forceinline__ float row_scale(const float* ssq, int row) {
    const f32x4* p = (const f32x4*)(ssq + (size_t)row * 16);
    const f32x4 a = p[0], b = p[1], c = p[2], d = p[3];
    const float s = ((a.x + a.y) + (a.z + a.w)) + ((b.x + b.y) + (b.z + b.w)) + ((c.x + c.y) + (c.z + c.w)) + ((d.x + d.y) + (d.z + d.w));
    return __builtin_amdgcn_rsqf(s * (1.0f / DM) + EPS);
}

struct SchedPlain {
    const bf16_t* A; const bf16_t* B; int lda, ldb, K, nM, nN, G, c, pm0;
    __device__ __forceinline__ bool next(int i, GU& u) const {
        int pm, pn; if (!pg8::tile_order(i, G, c, nM, nN, pm, pn)) return false;
        pm += pm0;
        u.A = A + (size_t)pm * 256 * lda; u.B = B + (size_t)pn * 256 * ldb; u.lda = lda; u.ldb = ldb; u.nt = K / 64; u.pm = pm; u.pn = pn; u.kind = 0; return true;
    }
};
struct SchedS5 {
    const bf16_t* UH; const bf16_t* W; int K, G, c;
    __device__ __forceinline__ bool next(int i, GU& u) const {
        const int L = i * G + c; if (L >= 144) return false;
        const int g = L / 9, pm = L % 9;
        u.A = UH + ((size_t)g * S5RP + (size_t)pm * 256) * 512; u.B = W + (size_t)g * 256 * K; u.lda = 512; u.ldb = K; u.nt = K / 64; u.pm = pm; u.pn = 0; u.kind = g; return true;
    }
};
struct SchedL2 {
    const bf16_t* L1o; const bf16_t* W; int G, c, nM, pm0;
    __device__ __forceinline__ bool next(int i, GU& u) const {
        int pm, pn; if (!pg8::tile_order(i, G, c, nM, 5, pm, pn)) return false;
        pm += pm0;
        const int koff = pn < 2 ? 0 : (pn < 4 ? 128 : 256);
        u.A = L1o + (size_t)pm * 256 * 512 + koff; u.B = W + (size_t)pn * 256 * 256; u.lda = 512; u.ldb = 256; u.nt = 4; u.pm = pm; u.pn = pn; u.kind = 0; return true;
    }
};
struct SchedProj {
    const bf16_t* Hb; const bf16_t* Wg; const bf16_t* Wp; const bf16_t* ya; const bf16_t* yb; const bf16_t* yc; int nM, G, c, pm0;
    __device__ __forceinline__ bool next(int i, GU& u) const {
        const int ti = i / 6, sub = i - ti * 6; int pm, pn;
        if (!pg8::tile_order(ti, G, c, nM, 4, pm, pn)) return false;
        pm += pm0;
        u.pm = pm; u.pn = pn; u.kind = sub;
        if (sub < 3) { u.A = Hb + (size_t)pm * 256 * DM; u.lda = DM; u.B = Wg + ((size_t)sub * 1024 + (size_t)pn * 256) * DM; u.ldb = DM; u.nt = 16; }
        else if (sub == 3) { u.A = ya + (size_t)pm * 256 * 256; u.lda = 256; u.B = Wp + (size_t)pn * 256 * DM; u.ldb = DM; u.nt = 4; }
        else if (sub == 4) { u.A = yb + (size_t)pm * 256 * 512; u.lda = 512; u.B = Wp + (size_t)pn * 256 * DM + 256; u.ldb = DM; u.nt = 8; }
        else { u.A = yc + (size_t)pm * 256 * 256; u.lda = 256; u.B = Wp + (size_t)pn * 256 * DM + 768; u.ldb = DM; u.nt = 4; }
        return true;
    }
};

typedef f32x4 Acc[2][2][4][2];
#define EPI_ROWS_BEGIN  _Pragma("unroll") for (int ai = 0; ai < 2; ++ai) _Pragma("unroll") for (int m = 0; m < 4; ++m) { const int rl = ai * 128 + wr * 64 + m * 16 + fr; const int row = u.pm * 256 + rl; (void)rl;
#define EPI_ROWS_END    asm volatile("" ::: "memory"); }
#define EPI_COL(bj) ((bj) * 128 + wc * 32 + fq * 8)

struct EpiInProj {
    const float* ssq; bf16_t* UH; bf16_t* Pz; bf16_t* Pxbc; bf16_t* Prkvx;
    __device__ __forceinline__ bool operator()(Acc& acc, const GU& u, int wr, int wc, int fr, int fq) const {
        EPI_ROWS_BEGIN
            if (row < M_ROWS) {
                const float s = row_scale(ssq, row);
                int b, t; bt_of(row, b, t);
#pragma unroll
                for (int bj = 0; bj < 2; ++bj) {
                    const int col = EPI_COL(bj);
                    const f32x4 v0 = acc[ai][bj][m][0] * s, v1 = acc[ai][bj][m][1] * s;
                    u32x4 w; w.x = pk2(v0[0], v0[1]); w.y = pk2(v0[2], v0[3]); w.z = pk2(v1[0], v1[1]); w.w = pk2(v1[2], v1[3]);
                    bf16_t* dst;
                    if (u.pn == 0) { const int g = col >> 4, hh = col & 15; dst = UH + ((size_t)g * S5RP + (size_t)(b * NCH16 + (t >> 4))) * 512 + (t & 15) * 16 + hh; }
                    else if (u.pn < 3) dst = Pz + (size_t)row * 512 + (u.pn - 1) * 256 + col;
                    else if (u.pn < 7) dst = Pxbc + (size_t)row * 1024 + (u.pn - 3) * 256 + col;
                    else dst = Prkvx + (size_t)row * 1024 + (u.pn - 7) * 256 + col;
                    *(u32x4*)dst = w;
                }
            }
        EPI_ROWS_END
        return false;
    }
};
struct EpiS5X {
    float* X;
    __device__ __forceinline__ bool operator()(Acc& acc, const GU& u, int wr, int wc, int fr, int fq) const {
        EPI_ROWS_BEGIN
            float* rp = X + ((size_t)u.kind * S5RP + row) * 256;
#pragma unroll
            for (int bj = 0; bj < 2; ++bj) { const int col = EPI_COL(bj); *(f32x4*)(rp + col) = acc[ai][bj][m][0]; *(f32x4*)(rp + col + 4) = acc[ai][bj][m][1]; }
        EPI_ROWS_END
        return false;
    }
};
struct EpiS5Y {
    bf16_t* yapre;
    __device__ __forceinline__ bool operator()(Acc& acc, const GU& u, int wr, int wc, int fr, int fq) const {
        EPI_ROWS_BEGIN
            if (row < S5ROWS) {
                const int b = row / NCH16, c = row - b * NCH16;
#pragma unroll
                for (int bj = 0; bj < 2; ++bj) {
                    const int col = EPI_COL(bj), i = col >> 4, hh = col & 15;
                    const f32x4 v0 = acc[ai][bj][m][0], v1 = acc[ai][bj][m][1];
                    u32x4 w; w.x = pk2(geluf_(v0[0]), geluf_(v0[1])); w.y = pk2(geluf_(v0[2]), geluf_(v0[3])); w.z = pk2(geluf_(v1[0]), geluf_(v1[1])); w.w = pk2(geluf_(v1[2]), geluf_(v1[3]));
                    *(u32x4*)(yapre + (size_t)row_of(b, c * 16 + i) * 256 + u.kind * 16 + hh) = w;
                }
            }
        EPI_ROWS_END
        return false;
    }
};
struct EpiL1 {
    bf16_t* L1o;
    __device__ __forceinline__ bool operator()(Acc& acc, const GU& u, int wr, int wc, int fr, int fq) const {
        EPI_ROWS_BEGIN
#pragma unroll
            for (int bj = 0; bj < 2; ++bj) {
                const int col = EPI_COL(bj); const int mode = u.pn * 2 + bj;
                f32x4 v0 = acc[ai][bj][m][0], v1 = acc[ai][bj][m][1]; float f[8] = {v0[0], v0[1], v0[2], v0[3], v1[0], v1[1], v1[2], v1[3]};
#pragma unroll
                for (int e = 0; e < 8; ++e) f[e] = mode == 0 ? tanhf_(f[e]) : (mode == 1 ? f[e] : (mode == 2 ? sigmoidf_(f[e]) : 0.f));
                *(u32x4*)(L1o + (size_t)row * 512 + u.pn * 256 + col) = pack8(f);
            }
        EPI_ROWS_END
        return false;
    }
};
struct EpiL2 {
    bf16_t* L2o; const float* w0; const float* a0;
    __device__ __forceinline__ bool operator()(Acc& acc, const GU& u, int wr, int wc, int fr, int fq) const {
        EPI_ROWS_BEGIN
#pragma unroll
            for (int bj = 0; bj < 2; ++bj) {
                const int col = EPI_COL(bj);
                f32x4 v0 = acc[ai][bj][m][0], v1 = acc[ai][bj][m][1]; float f[8] = {v0[0], v0[1], v0[2], v0[3], v1[0], v1[1], v1[2], v1[3]};
                if (u.pn < 2) {
                    const float* bp = w0 + u.pn * 256 + col;
#pragma unroll
                    for (int e = 0; e < 8; ++e) { const float v = bp[e] + f[e]; f[e] = -__expf(-softplusf_(-v) - 0.5f); }
                } else if (u.pn < 4) {
                    const float* bp = a0 + (u.pn - 2) * 256 + col;
#pragma unroll
                    for (int e = 0; e < 8; ++e) f[e] = sigmoidf_(bp[e] + f[e]);
                }
                *(u32x4*)(L2o + (size_t)row * 1280 + u.pn * 256 + col) = pack8(f);
            }
        EPI_ROWS_END
        return false;
    }
};
struct EpiGLU {
    bf16_t* ya; const float* bias;
    __device__ __forceinline__ bool operator()(Acc& acc, const GU& u, int wr, int wc, int fr, int fq) const {
        const int lc = wc * 32 + fq * 8, oc = u.pn * 128 + lc;
        float bv[8], bg[8];
#pragma unroll
        for (int e = 0; e < 8; ++e) { bv[e] = bias[oc + e]; bg[e] = bias[256 + oc + e]; }
        EPI_ROWS_BEGIN
            const f32x4 a0 = acc[ai][0][m][0], a1 = acc[ai][0][m][1], g0 = acc[ai][1][m][0], g1 = acc[ai][1][m][1];
            float v[8] = {a0[0], a0[1], a0[2], a0[3], a1[0], a1[1], a1[2], a1[3]}, g[8] = {g0[0], g0[1], g0[2], g0[3], g1[0], g1[1], g1[2], g1[3]};
#pragma unroll
            for (int e = 0; e < 8; ++e) v[e] = (v[e] + bv[e]) * sigmoidf_(g[e] + bg[e]);
            *(u32x4*)(ya + (size_t)row * 256 + oc) = pack8(v);
        EPI_ROWS_END
        return false;
    }
};
struct EpiProj {
    const float* ssq; const float* ssqb; unsigned char* park; bf16_t* merged; int tid;
    __device__ __forceinline__ bool operator()(Acc& acc, const GU& u, int wr, int wc, int fr, int fq) const {
        const int k = u.kind;
        EPI_ROWS_BEGIN
            float s = 1.f; if (k < 3) s = row_scale(ssq, row < M_ROWS ? row : 0);
            else if (k < 5) { s = __builtin_amdgcn_rsqf(ssqb[row < M_ROWS ? row : 0] * (1.0f / 512.f) + EPS); if (k == 3) s = __builtin_amdgcn_rcpf(s); }
#pragma unroll
            for (int bj = 0; bj < 2; ++bj) {
                const int q = (ai * 2 + bj) * 4 + m;
                f32x4& v0 = acc[ai][bj][m][0]; f32x4& v1 = acc[ai][bj][m][1];
                if (k < 3) {
                    float f[8] = {v0[0], v0[1], v0[2], v0[3], v1[0], v1[1], v1[2], v1[3]};
#pragma unroll
                    for (int e = 0; e < 8; ++e) f[e] = sigmoidf_(f[e] * s);
                    *(u32x4*)(park + ((size_t)(k * 16 + q) * NTHREADS + tid) * 16) = pack8(f);
                } else {
                    float num[8], den[8];
                    unpack8(*(const u32x4*)(park + ((size_t)((k - 3) * 16 + q) * NTHREADS + tid) * 16), num);
                    if (k < 5) { unpack8(*(const u32x4*)(park + ((size_t)((k - 2) * 16 + q) * NTHREADS + tid) * 16), den);
#pragma unroll
                        for (int e = 0; e < 8; ++e) num[e] = num[e] * __builtin_amdgcn_rcpf(den[e]) * s; }
                    v0[0] *= num[0]; v0[1] *= num[1]; v0[2] *= num[2]; v0[3] *= num[3]; v1[0] *= num[4]; v1[1] *= num[5]; v1[2] *= num[6]; v1[3] *= num[7];
                    if (k == 5) { u32x4 w; w.x = pk2(v0[0], v0[1]); w.y = pk2(v0[2], v0[3]); w.z = pk2(v1[0], v1[1]); w.w = pk2(v1[2], v1[3]);
                        *(u32x4*)(merged + (size_t)row * DM + u.pn * 256 + EPI_COL(bj)) = w; }
                }
            }
        EPI_ROWS_END
        return k == 3 || k == 4;
    }
};
struct EpiResid {
    bf16_t* H; float* ssq;
    __device__ __forceinline__ bool operator()(Acc& acc, const GU& u, int wr, int wc, int fr, int fq) const {
        EPI_ROWS_BEGIN
            float ss = 0.f;
            if (row < M_ROWS) {
#pragma unroll
                for (int bj = 0; bj < 2; ++bj) {
                    bf16_t* hp = H + (size_t)row * DM + u.pn * 256 + EPI_COL(bj);
                    float f[8]; unpack8(*(const u32x4*)hp, f);
                    const f32x4 v0 = acc[ai][bj][m][0], v1 = acc[ai][bj][m][1];
                    f[0] += v0[0]; f[1] += v0[1]; f[2] += v0[2]; f[3] += v0[3]; f[4] += v1[0]; f[5] += v1[1]; f[6] += v1[2]; f[7] += v1[3];
#pragma unroll
                    for (int e = 0; e < 8; ++e) ss += f[e] * f[e];
                    *(u32x4*)hp = pack8(f);
                }
            }
            ss += __shfl_xor(ss, 16); ss += __shfl_xor(ss, 32);
            if (fq == 0 && row < M_ROWS) ssq[(size_t)row * 16 + u.pn * 4 + wc] = ss;
        EPI_ROWS_END
        return false;
    }
};
struct EpiUp {
    const float* ssq; bf16_t* act;
    __device__ __forceinline__ bool operator()(Acc& acc, const GU& u, int wr, int wc, int fr, int fq) const {
        EPI_ROWS_BEGIN
            const float s = row_scale(ssq, row < M_ROWS ? row : 0);
#pragma unroll
            for (int bj = 0; bj < 2; ++bj) {
                const f32x4 v0 = acc[ai][bj][m][0] * s, v1 = acc[ai][bj][m][1] * s; float f[8] = {v0[0], v0[1], v0[2], v0[3], v1[0], v1[1], v1[2], v1[3]};
#pragma unroll
                for (int e = 0; e < 8; ++e) { const float r = fmaxf(f[e], 0.f); f[e] = r * r; }
                *(u32x4*)(act + (size_t)row * DFF + u.pn * 256 + EPI_COL(bj)) = pack8(f);
            }
        EPI_ROWS_END
        return false;
    }
};
typedef __attribute__((address_space(1))) unsigned gu32;
#define XB_TMO      128
#define XB_XCNT(j)  (256  + 64 * (j))
#define XB_XSUB(j)  (1280 + 64 * (j))
#define XB_XGEN(j)  (2304 + 64 * (j))
#define XB_TOP      3328
#define XB_TOPGEN   3392
#define XCD_BAR_WORDS 3456
#define XB_SPIN_CAP (1u << 18)

__device__ __forceinline__ unsigned xb_ld(unsigned* p)              { return __hip_atomic_load(p, __ATOMIC_RELAXED, __HIP_MEMORY_SCOPE_AGENT); }
__device__ __forceinline__ unsigned xb_add(unsigned* p, unsigned v) { return __hip_atomic_fetch_add(p, v, __ATOMIC_RELAXED, __HIP_MEMORY_SCOPE_AGENT); }
__device__ __forceinline__ unsigned xb_xcc_id() { return (unsigned)__builtin_amdgcn_s_getreg((3 << 11) | 20) & 0xFu; }
#define XB_SPIN(cond, bar) do { unsigned _sp = 0; while (cond) { __builtin_amdgcn_s_sleep(1); \
    if ((++_sp & 255u) == 0u) { if (xb_ld(&(bar)[XB_TMO])) break; if (_sp > XB_SPIN_CAP) { atomicAdd(&(bar)[XB_TMO], 1u); break; } } } } while (0)

struct XcdBarrier {
    unsigned* bar; unsigned x;
    volatile LAS unsigned* st;
};

__device__ __forceinline__ XcdBarrier xcd_barrier_post(unsigned* bar, volatile LAS unsigned* st) {
    XcdBarrier b; b.bar = bar; b.x = xb_xcc_id(); b.st = st;
    if (threadIdx.x == 0) (void)xb_add(&bar[XB_XCNT(b.x)], 1u);
    return b;
}
__device__ __forceinline__ void xcd_barrier_complete(unsigned* bar, unsigned x, unsigned& nloc, unsigned& nx) {
    const unsigned G = gridDim.x * gridDim.y * gridDim.z;
    unsigned sum, cnt, mine, sp = 0u;
    for (;;) {
        sum = 0u; cnt = 0u; mine = 0u;
#pragma unroll
        for (unsigned j = 0; j < 16; ++j) { const unsigned c = xb_ld(&bar[XB_XCNT(j)]); sum += c; cnt += (c > 0u) ? 1u : 0u; mine = (j == x) ? c : mine; }
        if (sum == G) break;
        __builtin_amdgcn_s_sleep(1);
        if ((++sp & 255u) == 0u) { if (xb_ld(&bar[XB_TMO])) break; if (sp > XB_SPIN_CAP) { atomicAdd(&bar[XB_TMO], 1u); break; } }
    }
    nloc = mine > 0u ? mine : 1u; nx = cnt > 0u ? cnt : 1u;
}

__device__ __forceinline__ void xcd_barrier(const XcdBarrier& b, int wave_s) {
    const bool xb_t0 = threadIdx.x == 0; (void)wave_s;
    asm volatile("s_waitcnt vmcnt(0)" ::: "memory");
    __syncthreads();
    if (xb_t0) {
        unsigned* bar = b.bar;
        __builtin_amdgcn_s_waitcnt(0);
        unsigned nloc = b.st[0], nx = b.st[1];
        if (nloc == 0u) { xcd_barrier_complete(bar, b.x, nloc, nx); b.st[0] = nloc; b.st[1] = nx; }
        const unsigned old = xb_add(&bar[XB_XSUB(b.x)], 1u);
        const unsigned gen = old / nloc;
        if (old + 1u == (gen + 1u) * nloc) {
            __builtin_amdgcn_fence(__ATOMIC_RELEASE, "agent");
            asm volatile("s_waitcnt vmcnt(0)" ::: "memory");
            const unsigned og = xb_add(&bar[XB_TOP], 1u);
            const unsigned tg = og / nx;
            if (og + 1u == (tg + 1u) * nx) xb_add(&bar[XB_TOPGEN], 1u);
            else XB_SPIN(xb_ld(&bar[XB_TOPGEN]) == tg, bar);
            __builtin_amdgcn_fence(__ATOMIC_ACQUIRE, "agent");
            xb_add(&bar[XB_XGEN(b.x)], 1u);
            asm volatile("s_waitcnt vmcnt(0)" ::: "memory");
        } else {
            XB_SPIN(xb_ld(&bar[XB_XGEN(b.x)]) == gen, bar);
            __builtin_amdgcn_fence(__ATOMIC_ACQUIRE, "agent");
            asm volatile("s_waitcnt vmcnt(0)" ::: "memory");
        }
    }
    __syncthreads();
}

struct TJob { const float* src; int ld, col0, K, N; bf16_t* dst; int dld, dk0, rmode, row0; const float* ksc; };
constexpr int N_TJOBS = 27;
__device__ __forceinline__ void get_tjob(const Ctx& c, int l, int j, TJob& t) {
    bf16_t* wb = c.wb(l);
    const float* win = c.in[I_WIN] + (size_t)l * DM * N_IN;
    t.rmode = 0; t.ksc = nullptr; t.dk0 = 0; t.col0 = 0; t.row0 = 0;
    if (j < 5) {
        t.src = win; t.ld = N_IN; t.K = DM; t.dld = DM; t.ksc = c.in[I_MIXNW] + l * DM; t.dst = wb + WB_IN;
        if (j == 0) { t.col0 = 0; t.N = 256; t.row0 = 0; }
        else if (j == 1) { t.col0 = 256; t.N = 512; t.row0 = 256; }
        else if (j == 2) { t.col0 = 768; t.N = 1024; t.row0 = 768; }
        else if (j == 3) { t.col0 = 1800; t.N = 1024; t.row0 = 1792; }
        else { t.col0 = 2824; t.N = 3072; t.row0 = 0; t.dst = wb + WB_G; }
    } else if (j == 5) { t.src = c.in[I_PA] + (size_t)l * 256 * DM; t.ld = DM; t.K = 256; t.N = DM; t.dst = wb + WB_P; t.dld = DM; t.dk0 = 0; }
    else if (j == 6) { t.src = c.in[I_PB] + (size_t)l * 512 * DM; t.ld = DM; t.K = 512; t.N = DM; t.dst = wb + WB_P; t.dld = DM; t.dk0 = 256; t.ksc = c.in[I_SSDNW] + (size_t)l * 512; }
    else if (j == 7) { t.src = c.in[I_PC] + (size_t)l * 256 * DM; t.ld = DM; t.K = 256; t.N = DM; t.dst = wb + WB_P; t.dld = DM; t.dk0 = 768; }
    else if (j == 8) { t.src = c.in[I_WOUT] + (size_t)l * DM * DM; t.ld = DM; t.K = DM; t.N = DM; t.dst = wb + WB_O; t.dld = DM; }
    else if (j == 9) { t.src = c.in[I_MLPW1] + (size_t)l * DM * DFF; t.ld = DFF; t.K = DM; t.N = DFF; t.dst = wb + WB_1; t.dld = DM; t.ksc = c.in[I_MLPNW] + l * DM; }
    else if (j == 10) { t.src = c.in[I_MLPW2] + (size_t)l * DFF * DM; t.ld = DM; t.K = DFF; t.N = DM; t.dst = wb + WB_2; t.dld = DFF; }
    else if (j == 11) { t.src = c.in[I_GLUW] + (size_t)l * 256 * 512; t.ld = 512; t.K = 256; t.N = 512; t.dst = wb + WB_GLU; t.dld = 256; t.rmode = 1; }
    else if (j < 22) {
        const int q = j - 12;
        t.K = 256; t.dst = wb + WB_L1; t.dld = 512;
        if (q < 4) { const int d = q >> 1, hf = q & 1; t.src = c.in[I_W1] + ((size_t)l * 2 + d) * 256 * 64; t.ld = 64; t.N = 64; t.row0 = d * 64; t.dk0 = hf * 256; if (hf) t.ksc = c.in[I_MUWAG] + ((size_t)l * 3 + 0) * 256; }
        else if (q < 8) { const int d = (q - 4) >> 1, hf = q & 1; t.src = c.in[I_A1] + ((size_t)l * 2 + d) * 256 * 64; t.ld = 64; t.N = 64; t.row0 = 128 + d * 64; t.dk0 = hf * 256; if (hf) t.ksc = c.in[I_MUWAG] + ((size_t)l * 3 + 1) * 256; }
        else { const int hf = q & 1; t.src = c.in[I_G1] + (size_t)l * 256 * 128; t.ld = 128; t.N = 128; t.row0 = 256; t.dk0 = hf * 256; if (hf) t.ksc = c.in[I_MUWAG] + ((size_t)l * 3 + 2) * 256; }
    } else {
        const int q = j - 22;
        t.dst = wb + WB_L2; t.dld = 256; t.ld = 256; t.N = 256;
        if (q < 2) { t.src = c.in[I_W2] + ((size_t)l * 2 + q) * 64 * 256; t.K = 64; t.row0 = q * 256; t.dk0 = q * 64; }
        else if (q < 4) { const int d = q - 2; t.src = c.in[I_A2] + ((size_t)l * 2 + d) * 64 * 256; t.K = 64; t.row0 = (2 + d) * 256; t.dk0 = d * 64; }
        else { t.src = c.in[I_G2] + (size_t)l * 128 * 256; t.K = 128; t.row0 = 4 * 256; t.dk0 = 0; }
    }
}
__device__ __forceinline__ int tjob_items(const TJob& t) { return (t.K / 64) * (t.N / 32); }
__device__ __forceinline__ void transpose_item(const TJob& t, LAS float* scr, int item, int lane) {
    const int nblk = t.N / 32, kb = item / nblk, nb = item % nblk, k0 = 64 * kb, n0 = 32 * nb;
#pragma unroll 8
    for (int i = 0; i < 32; ++i) { const int kk = 2 * i + (lane >> 5); float v = t.src[(size_t)(k0 + kk) * t.ld + t.col0 + n0 + (lane & 31)]; if (t.ksc) v *= t.ksc[k0 + kk]; scr[kk * 33 + (lane & 31)] = v; }
    asm volatile("s_waitcnt lgkmcnt(0)" ::: "memory");
    const int cc = lane & 7;
#pragma unroll
    for (int j = 0; j < 4; ++j) {
        const int n = (lane >> 3) + 8 * j; const LAS float* s = scr + (8 * cc) * 33 + n;
        u32x4 o; o.x = pk2(s[0 * 33], s[1 * 33]); o.y = pk2(s[2 * 33], s[3 * 33]); o.z = pk2(s[4 * 33], s[5 * 33]); o.w = pk2(s[6 * 33], s[7 * 33]);
        const int nn = n0 + n; int drow;
        if (t.rmode == 0) drow = t.row0 + nn; else drow = nn < 256 ? (nn >> 7) * 256 + (nn & 127) : ((nn - 256) >> 7) * 256 + 128 + ((nn - 256) & 127);
        *(u32x4*)(t.dst + (size_t)drow * t.dld + t.dk0 + k0 + 8 * cc) = o;
    }
    asm volatile("s_waitcnt lgkmcnt(0)" ::: "memory");
}

__device__ __forceinline__ void s5_build(const Ctx& cx_, int l, int g) {
    const Ctx c = relaunder(cx_);
    LAS float* F = (LAS float*)c.lds;
    LAS float* pwr = F;
    LAS float* pwi = pwr + 2176;
    LAS float* cor = pwi + 2176;
    LAS float* coi = cor + 128;
    LAS float* Cr = coi + 128;
    LAS float* Ci = Cr + 1024;
    LAS float* Br = Ci + 1024;
    LAS float* Bi = Br + 1024;
    LAS float* kr = Bi + 1024;
    LAS float* ki = kr + 1984;
    LAS float* Kd = ki + 1984;
    const int tid = c.tid;
    if (tid < 128) {
        const int d = tid >> 6, n = tid & 63; const size_t li_ = (((size_t)l * 2 + d) * 16 + g) * 64 + n;
        const float lr = c.in[I_S5LRE][li_], li = c.in[I_S5LIM][li_], step = expf(c.in[I_S5LS][((size_t)l * 2 + d) * 16 + g]);
        for (int k = 0; k <= 16; ++k) { const float mag = expf((float)k * lr * step), ang = (float)k * li * step; float sn, cs; sincosf(ang, &sn, &cs); pwr[(d * 17 + k) * 64 + n] = mag * cs; pwi[(d * 17 + k) * 64 + n] = mag * sn; }
        const float mag1 = expf(lr * step); float sn, cs; sincosf(li * step, &sn, &cs); const float abr = mag1 * cs, abi = mag1 * sn, den = lr * lr + li * li;
        cor[d * 64 + n] = ((abr - 1.f) * lr + abi * li) / den; coi[d * 64 + n] = (abi * lr - (abr - 1.f) * li) / den;
    }
    for (int i = tid; i < 1024; i += NTHREADS) {
        Cr[i] = c.in[I_S5CRE][((size_t)l * 16 + g) * 1024 + i]; Ci[i] = c.in[I_S5CIM][((size_t)l * 16 + g) * 1024 + i];
        Br[i] = c.in[I_S5BRE][((size_t)l * 16 + g) * 1024 + i]; Bi[i] = c.in[I_S5BIM][((size_t)l * 16 + g) * 1024 + i];
    }
    __syncthreads();
    for (int i = tid; i < 31 * 64; i += NTHREADS) {
        const int dd = i / 64 - 15, n = i & 63; float r, im;
        if (dd > 0) { const float pr = pwr[(0 * 17 + dd) * 64 + n], pi = pwi[(0 * 17 + dd) * 64 + n]; r = pr * cor[n] - pi * coi[n]; im = pr * coi[n] + pi * cor[n]; }
        else if (dd < 0) { const float pr = pwr[(1 * 17 - dd) * 64 + n], pi = pwi[(1 * 17 - dd) * 64 + n]; r = pr * cor[64 + n] - pi * coi[64 + n]; im = pr * coi[64 + n] + pi * cor[64 + n]; }
        else { r = cor[n] + cor[64 + n]; im = coi[n] + coi[64 + n]; }
        kr[i] = r; ki[i] = im;
    }
    __syncthreads();
    for (int i = tid; i < 31 * 256; i += NTHREADS) {
        const int ddi = i >> 8, h = (i >> 4) & 15, hp = i & 15; float a = 0.f;
        for (int n = 0; n < 64; ++n) { const float cr = Cr[h * 64 + n], ci = Ci[h * 64 + n], xr = kr[ddi * 64 + n], xi = ki[ddi * 64 + n]; const float pr = cr * xr - ci * xi, pi = cr * xi + ci * xr; a += pr * Br[n * 16 + hp] - pi * Bi[n * 16 + hp]; }
        Kd[i] = a;
    }
    __syncthreads();
    bf16_t* SX = c.wb(l) + WB_SX + (size_t)g * 256 * 256; bf16_t* SY = c.wb(l) + WB_SY + (size_t)g * 256 * 512;
    const float* dsk = c.in[I_S5D] + (size_t)l * 256 + g * 16;
    for (int u = tid; u < 256 * 64; u += NTHREADS) {
        const int o = u >> 6, kk0 = (u & 63) * 8, i = o >> 4, h = o & 15; float v[8];
        if (kk0 < 256) { const int j = kk0 >> 4, hp0 = kk0 & 15;
#pragma unroll
            for (int e = 0; e < 8; ++e) v[e] = Kd[(i - j + 15) * 256 + h * 16 + hp0 + e] + ((i == j && h == hp0 + e) ? dsk[h] : 0.f);
        } else { const int q = kk0 - 256, d = q >> 7, part = (q >> 6) & 1, n0 = q & 63, ex = d == 0 ? i + 1 : 16 - i;
#pragma unroll
            for (int e = 0; e < 8; ++e) { const int n = n0 + e; const float cr = Cr[h * 64 + n], ci = Ci[h * 64 + n], pr = pwr[(d * 17 + ex) * 64 + n], pi = pwi[(d * 17 + ex) * 64 + n]; v[e] = part == 0 ? (cr * pr - ci * pi) : -(cr * pi + ci * pr); }
        }
        *(u32x4*)(SY + (size_t)o * 512 + kk0) = pack8(v);
    }
    for (int u = tid; u < 256 * 32; u += NTHREADS) {
        const int o = u >> 5, kk0 = (u & 31) * 8, d = o >> 7, part = (o >> 6) & 1, n = o & 63, j = kk0 >> 4, hp0 = kk0 & 15, ex = d == 0 ? 15 - j : j;
        const float pr = pwr[(d * 17 + ex) * 64 + n], pi = pwi[(d * 17 + ex) * 64 + n], qr = pr * cor[d * 64 + n] - pi * coi[d * 64 + n], qi = pr * coi[d * 64 + n] + pi * cor[d * 64 + n];
        float v[8];
#pragma unroll
        for (int e = 0; e < 8; ++e) { const float br = Br[n * 16 + hp0 + e], bi = Bi[n * 16 + hp0 + e]; v[e] = part == 0 ? (qr * br - qi * bi) : (qr * bi + qi * br); }
        *(u32x4*)(SX + (size_t)o * 256 + kk0) = pack8(v);
    }
    __syncthreads();
}

__device__ __forceinline__ void phase0(const Ctx& cx_) {
    const Ctx c = relaunder(cx_);
    if (c.bid < 32) s5_build(c, c.bid >> 4, c.bid & 15);
    const int gw = c.bid * NWAVES + c.wave, NGW = c.G * NWAVES, lane = c.lane;
    bf16_t* H = c.H(); float* ssq = c.ssq();
    for (int m = gw; m < MP; m += NGW) {
        u32x2* hp = (u32x2*)(H + (size_t)m * DM);
        if (m >= M_ROWS) {
#pragma unroll
            for (int i = 0; i < 4; ++i) hp[lane + 64 * i] = (u32x2){0u, 0u};
            continue;
        }
        int b, t; bt_of(m, b, t);
        const f32x4* src = (const f32x4*)(t < NMETA ? c.in[I_META] + (size_t)t * DM : c.in[I_X] + ((size_t)b * SEQ + (t - NMETA)) * DM);
        float ss = 0.f;
#pragma unroll
        for (int i = 0; i < 4; ++i) { const f32x4 v = src[lane + 64 * i]; ss += (v.x * v.x + v.y * v.y) + (v.z * v.z + v.w * v.w); hp[lane + 64 * i] = (u32x2){pk2(v.x, v.y), pk2(v.z, v.w)}; }
        ss = wave_sum(ss);
        if (lane < 16) ssq[(size_t)m * 16 + lane] = lane == 0 ? ss : 0.f;
    }
    LAS float* scr = (LAS float*)(c.lds + c.wave * 8448);
    for (int l = 0; l < DEPTH; ++l) {
        int base = 0;
        for (int j = 0; j < N_TJOBS; ++j) {
            TJob t; get_tjob(c, l, j, t); const int ni = tjob_items(t);
            int first = (gw - base % NGW + NGW) % NGW;
            for (int it = first; it < ni; it += NGW) transpose_item(t, scr, it, lane);
            base += ni;
        }
        bf16_t* wb = c.wb(l);
        const int gt = c.bid * NTHREADS + c.tid, NGT = c.G * NTHREADS;
        for (int u = gt; u < 128 * 64; u += NGT) *(u32x4*)(wb + WB_L1 + (size_t)384 * 512 + (size_t)u * 8) = (u32x4){0u, 0u, 0u, 0u};
        for (int u = gt; u < 5 * 256 * 4 * 8; u += NGT) {
            const int sub = u & 7, blk = (u >> 3) & 3, row = (u >> 5) & 255, tile = u >> 13;
            const bool nz = (tile == 0 || tile == 2) ? (blk == 0) : ((tile == 1 || tile == 3) ? (blk == 1) : (blk < 2));
            if (!nz) *(u32x4*)(wb + WB_L2 + ((size_t)tile * 256 + row) * 256 + blk * 64 + sub * 8) = (u32x4){0u, 0u, 0u, 0u};
        }
    }
}

__device__ __forceinline__ void dt_job(const Ctx& cx_, int l) {
    const Ctx c = relaunder(cx_);
    LAS float* dtw = (LAS float*)c.lds;
    const float* win = c.in[I_WIN] + (size_t)l * DM * N_IN; const float* nw = c.in[I_MIXNW] + l * DM;
    for (int i = c.tid; i < 8 * DM; i += NTHREADS) { const int k = i >> 3, j = i & 7; dtw[j * DM + k] = nw[k] * win[(size_t)k * N_IN + 1792 + j]; }
    __syncthreads();
    const int gw = c.bid * NWAVES + c.wave, NGW = c.G * NWAVES, lane = c.lane;
    const bf16_t* H = c.H(); float* dt = (float*)(c.ws + WS_DT); float* dec = (float*)(c.ws + WS_DEC);
    const float* dtb = c.in[I_DTB] + l * 16; const float* alog = c.in[I_ALOG] + l * 16;
    for (int m = gw; m < M_ROWS; m += NGW) {
        const u32x2* hp = (const u32x2*)(H + (size_t)m * DM);
        float ss = 0.f, d8[8] = {0.f, 0.f, 0.f, 0.f, 0.f, 0.f, 0.f, 0.f};
#pragma unroll
        for (int i = 0; i < 4; ++i) {
            const u32x2 w = hp[lane + 64 * i]; const float h0 = bflo(w.x), h1 = bfhi(w.x), h2 = bflo(w.y), h3 = bfhi(w.y);
            ss += (h0 * h0 + h1 * h1) + (h2 * h2 + h3 * h3);
#pragma unroll
            for (int j = 0; j < 8; ++j) { const f32x4 wv = *(const LAS f32x4*)(dtw + j * DM + 4 * lane + 256 * i); d8[j] += (h0 * wv.x + h1 * wv.y) + (h2 * wv.z + h3 * wv.w); }
        }
        ss = wave_sum(ss);
#pragma unroll
        for (int j = 0; j < 8; ++j) d8[j] = wave_sum(d8[j]);
        const float s = __builtin_amdgcn_rsqf(ss * (1.0f / DM) + EPS);
        if (lane < 16) {
            const int j = lane & 7; float raw = d8[0];
#pragma unroll
            for (int e = 1; e < 8; ++e) raw = (j == e) ? d8[e] : raw;
            const float dtv = softplusf_(raw * s + dtb[lane]);
            dt[(size_t)m * 16 + lane] = dtv; dec[(size_t)m * 16 + lane] = -dtv * __expf(alog[lane]);
        }
    }
    __syncthreads();
}

__device__ __forceinline__ void rwkv_prep(const Ctx& cx_, int l) {
    const Ctx c = relaunder(cx_);
    const int gw = c.bid * NWAVES + c.wave, NGW = c.G * NWAVES, lane = c.lane, c0 = 4 * lane;
    const bf16_t* P = (const bf16_t*)(c.ws + WS_PRKVX); bf16_t* rk = (bf16_t*)(c.dout + DO_RKVP); bf16_t* l1 = (bf16_t*)(c.ws + WS_L1IN);
    float mu[3][4], kkw[4];
#pragma unroll
    for (int x = 0; x < 3; ++x)
#pragma unroll
        for (int e = 0; e < 4; ++e) mu[x][e] = c.in[I_MURKV][((size_t)l * 3 + x) * 256 + c0 + e];
#pragma unroll
    for (int e = 0; e < 4; ++e) kkw[e] = c.in[I_KK][(size_t)l * 256 + c0 + e];
    for (int m = gw; m < M_ROWS; m += NGW) {
        int b, t; bt_of(m, b, t); const bool hp = t > 0, hn = t < LEN - 1; const size_t mp_ = hp ? row_of(b, t - 1) : 0, mn_ = hn ? row_of(b, t + 1) : 0;
        float o[4][4];
        float xc[4], dxc[4];
#pragma unroll
        for (int x = 0; x < 4; ++x) {
            const u32x2 wc_ = *(const u32x2*)(P + (size_t)m * 1024 + x * 256 + c0);
            u32x2 wp = (u32x2){0u, 0u}, wn = (u32x2){0u, 0u};
            if (hp) wp = *(const u32x2*)(P + mp_ * 1024 + x * 256 + c0);
            if (hn) wn = *(const u32x2*)(P + mn_ * 1024 + x * 256 + c0);
            const float cur[4] = {bflo(wc_.x), bfhi(wc_.x), bflo(wc_.y), bfhi(wc_.y)}, pv[4] = {bflo(wp.x), bfhi(wp.x), bflo(wp.y), bfhi(wp.y)}, nv[4] = {bflo(wn.x), bfhi(wn.x), bflo(wn.y), bfhi(wn.y)};
#pragma unroll
            for (int e = 0; e < 4; ++e) { const float cs = 0.5f * (pv[e] + nv[e]) - cur[e]; if (x < 3) o[x][e] = cur[e] + cs * mu[x][e]; else { xc[e] = cur[e]; dxc[e] = cs; } }
        }
        float kr_[4], ss = 0.f;
#pragma unroll
        for (int e = 0; e < 4; ++e) { kr_[e] = o[1][e] * kkw[e]; ss += kr_[e] * kr_[e]; }
        ss = sum16(ss); const float rn = __builtin_amdgcn_rsqf(ss + 1e-12f);
        bf16_t* rp = rk + (size_t)m * 1024 + c0;
        *(u32x2*)(rp) = (u32x2){pk2(o[0][0], o[0][1]), pk2(o[0][2], o[0][3])};
        *(u32x2*)(rp + 256) = (u32x2){pk2(o[1][0], o[1][1]), pk2(o[1][2], o[1][3])};
        *(u32x2*)(rp + 512) = (u32x2){pk2(o[2][0], o[2][1]), pk2(o[2][2], o[2][3])};
        *(u32x2*)(rp + 768) = (u32x2){pk2(kr_[0] * rn, kr_[1] * rn), pk2(kr_[2] * rn, kr_[3] * rn)};
        bf16_t* lp = l1 + (size_t)m * 512 + c0;
        *(u32x2*)(lp) = (u32x2){pk2(xc[0], xc[1]), pk2(xc[2], xc[3])};
        *(u32x2*)(lp + 256) = (u32x2){pk2(dxc[0], dxc[1]), pk2(dxc[2], dxc[3])};
    }
}
__device__ __forceinline__ void ssd_prep(const Ctx& cx_, int l) {
    const Ctx c = relaunder(cx_);
    const int gw = c.bid * NWAVES + c.wave, NGW = c.G * NWAVES, lane = c.lane, c0 = 16 * lane;
    const bf16_t* P = (const bf16_t*)(c.ws + WS_PXBC); bf16_t* xs = (bf16_t*)(c.ws + WS_XS); bf16_t* bc = (bf16_t*)(c.ws + WS_BC);
    float w[5][16], bias[16];
#pragma unroll
    for (int j = 0; j < 5; ++j)
#pragma unroll
        for (int e = 0; e < 16; ++e) w[j][e] = c.in[I_CONVW][((size_t)l * 5 + j) * 1024 + c0 + e];
#pragma unroll
    for (int e = 0; e < 16; ++e) bias[e] = c.in[I_CONVB][(size_t)l * 1024 + c0 + e];
    for (int m = gw; m < M_ROWS; m += NGW) {
        int b, t; bt_of(m, b, t);
        float a[16];
#pragma unroll
        for (int e = 0; e < 16; ++e) a[e] = bias[e];
#pragma unroll
        for (int j = 0; j < 5; ++j) {
            const int tt = t + j - 2;
            if (tt >= 0 && tt < LEN) {
                const u32x4* p = (const u32x4*)(P + (size_t)row_of(b, tt) * 1024 + c0); float f0[8], f1[8]; unpack8(p[0], f0); unpack8(p[1], f1);
#pragma unroll
                for (int e = 0; e < 8; ++e) { a[e] += w[j][e] * f0[e]; a[8 + e] += w[j][8 + e] * f1[e]; }
            }
        }
        float o0[8], o1[8];
#pragma unroll
        for (int e = 0; e < 8; ++e) { o0[e] = siluf_(a[e]); o1[e] = siluf_(a[8 + e]); }
        bf16_t* dst = lane < 32 ? xs + (size_t)m * 512 + c0 : bc + (size_t)m * 512 + (c0 - 512);
        ((u32x4*)dst)[0] = pack8(o0); ((u32x4*)dst)[1] = pack8(o1);
    }
}

__device__ __forceinline__ void s5_scan(const Ctx& cx_, int l) {
    const Ctx c = relaunder(cx_);
    if (c.tid >= 64) return;
    const int gt = c.bid * 64 + c.tid; if (gt >= 16384) return;
    const int n = gt & 63, d = (gt >> 6) & 1, b = (gt >> 7) & 7, g = gt >> 10;
    const size_t li_ = (((size_t)l * 2 + d) * 16 + g) * 64 + n;
    const float lr = c.in[I_S5LRE][li_], li = c.in[I_S5LIM][li_], step = expf(c.in[I_S5LS][((size_t)l * 2 + d) * 16 + g]);
    const float mag = expf(16.f * lr * step); float sn, cs; sincosf(16.f * li * step, &sn, &cs); const float ar = mag * cs, ai = mag * sn;
    const float* X = (const float*)(c.ws + WS_X) + ((size_t)g * S5RP + (size_t)b * NCH16) * 256 + d * 128 + n;
    bf16_t* U = (bf16_t*)(c.ws + WS_UH) + ((size_t)g * S5RP + (size_t)b * NCH16) * 512 + 256 + d * 128 + n;
    float hr = 0.f, hi = 0.f;
    for (int i0 = 0; i0 < NCH16; i0 += 32) {
        float xr[32], xi[32];
#pragma unroll
        for (int k = 0; k < 32; ++k) { const int i = i0 + k; const int ch = d == 0 ? i : NCH16 - 1 - i; const bool ok = i < NCH16; xr[k] = ok ? X[(size_t)ch * 256] : 0.f; xi[k] = ok ? X[(size_t)ch * 256 + 64] : 0.f; }
#pragma unroll
        for (int k = 0; k < 32; ++k) { const int i = i0 + k; if (i < NCH16) { const int ch = d == 0 ? i : NCH16 - 1 - i;
            U[(size_t)ch * 512] = (bf16_t)f2bf(hr); U[(size_t)ch * 512 + 64] = (bf16_t)f2bf(hi);
            const float nr = ar * hr - ai * hi + xr[k], ni = ar * hi + ai * hr + xi[k]; hr = nr; hi = ni; } }
    }
}
typedef short s16x4 __attribute__((ext_vector_type(4)));
__device__ __forceinline__ s16x4 lds_tr(const LAS unsigned char* p) { return __builtin_bit_cast(s16x4, __builtin_amdgcn_ds_read_tr16_b64_v4i16((LAS s16x4*)p)); }
__device__ __forceinline__ bf16x8 frag_tr(const LAS unsigned char* img, int rs, int kbase, int colbase, int lane) {
    const LAS unsigned char* a = img + (kbase + 8 * (lane >> 4) + ((lane & 15) >> 2)) * rs + (colbase + 4 * (lane & 3)) * 2;
    const s16x4 lo = lds_tr(a), hi = lds_tr(a + 4 * rs);
    return (bf16x8){lo[0], lo[1], lo[2], lo[3], hi[0], hi[1], hi[2], hi[3]};
}
__device__ __forceinline__ bf16x8 frag_row(const LAS unsigned char* img, int rs, int rowbase, int kbase, int lane) {
    return *(const LAS bf16x8*)(img + (rowbase + (lane & 15)) * rs + (kbase + 8 * (lane >> 4)) * 2);
}
constexpr int SD_RS = 272;
constexpr int SD_XRS = 144;
constexpr int SD_OFF_C = 0, SD_OFF_B = 34816, SD_OFF_X = 69632, SD_OFF_M = 88064, SD_OFF_SC = 122880;
constexpr int SD_OFF_HF = SD_OFF_B, SD_OFF_HB = SD_OFF_B + 17408;
constexpr size_t WS_STB = WS_YSSD;
constexpr size_t WS_CDEC = WS_DEC + (size_t)MP * 64 + 256;
constexpr size_t WS_SSQB = WS_CDEC + (size_t)BATCH * 33 * 16 * 4;
constexpr size_t WS_BAR = (WS_SSQB + (size_t)MP * 4 + 255) / 256 * 256;
static_assert(WS_BAR + 3456 * 4 <= 7 * QB, "small region");
static_assert((size_t)BATCH * 2 * 8 * 32 * 8192 * 2 <= 4 * QB, "chunk states fit the yssd slot");

struct SsdUnit { int b, ck, t0, ns; };
__device__ __forceinline__ bool ssd_unit(int bid, int round, SsdUnit& u) {
    if (round == 0) { u.b = bid >> 5; u.ck = 1 + (bid & 31); u.t0 = NMETA + 128 * (u.ck - 1); u.ns = 8; return true; }
    if (round == 1 && bid < BATCH) { u.b = bid; u.ck = 0; u.t0 = 0; u.ns = 1; return true; }
    return false;
}
__device__ __forceinline__ void ssd_load_img(LAS unsigned char* img, int rs, const bf16_t* src, int ld, size_t m0, int col0, int ncol, int ns, int tid) {
    const int cpr = ncol / 8, nrow = ns == 1 ? 32 : 128;
    for (int i = tid; i < nrow * cpr; i += NTHREADS) {
        const int r = i / cpr, cc = i - r * cpr; u32x4 v = (u32x4){0u, 0u, 0u, 0u};
        if (r < 16 * ns) v = *(const u32x4*)(src + (m0 + r) * ld + col0 + cc * 8);
        *(LAS u32x4*)(img + r * rs + cc * 16) = v;
    }
}
__device__ __forceinline__ void ssd_scalars(LAS float* sc, const float* dt, const float* al, size_t m0, int head, int ns, int lane, float& totf, float& totb) {
    const int Q = 16 * ns;
    float a0f = 0.f, a1f = 0.f, a0b = 0.f, a1b = 0.f, d0f = 0.f, d1f = 0.f, d0b = 0.f, d1b = 0.f;
    const int s0 = 2 * lane, s1 = 2 * lane + 1;
    if (s0 < Q) { a0f = al[(m0 + s0) * 16 + head]; a0b = al[(m0 + s0) * 16 + 8 + head]; d0f = dt[(m0 + s0) * 16 + head]; d0b = dt[(m0 + s0) * 16 + 8 + head]; }
    if (s1 < Q) { a1f = al[(m0 + s1) * 16 + head]; a1b = al[(m0 + s1) * 16 + 8 + head]; d1f = dt[(m0 + s1) * 16 + head]; d1b = dt[(m0 + s1) * 16 + 8 + head]; }
    float pf = a0f + a1f, pb = a0b + a1b;
#pragma unroll
    for (int o = 1; o < 64; o <<= 1) { const float tf = __shfl_up(pf, o), tb = __shfl_up(pb, o); if (lane >= o) { pf += tf; pb += tb; } }
    totf = __shfl(pf, 63); totb = __shfl(pb, 63);
    const float af1 = pf, af0 = pf - a1f;
    const float eb0 = pb - a0b - a1b, eb1 = pb - a1b;
    sc[s0] = af0; sc[s1] = af1; sc[128 + s0] = eb0; sc[128 + s1] = eb1; sc[256 + s0] = d0f; sc[256 + s1] = d1f; sc[384 + s0] = d0b; sc[384 + s1] = d1b;
    sc[512 + s0] = __expf(totf - af0) * d0f; sc[512 + s1] = __expf(totf - af1) * d1f;
    sc[640 + s0] = __expf(eb0) * d0b; sc[640 + s1] = __expf(eb1) * d1b;
    sc[768 + s0] = __expf(af0); sc[768 + s1] = __expf(af1);
    sc[896 + s0] = __expf(totb - eb0); sc[896 + s1] = __expf(totb - eb1);
}

__device__ __forceinline__ void ssd_states(const Ctx& cx_, int l) {
    const Ctx c = relaunder(cx_);
    const int tid = c.tid, lane = c.lane, wave = c.wave;
    const bf16_t* bc = (const bf16_t*)(c.ws + WS_BC); const bf16_t* xs = (const bf16_t*)(c.ws + WS_XS);
    const float* dt = (const float*)(c.ws + WS_DT); const float* al = (const float*)(c.ws + WS_DEC);
    bf16_t* stb = (bf16_t*)(c.ws + WS_STB); float* cdec = (float*)(c.ws + WS_CDEC);
    LAS unsigned char* Bimg = c.lds + SD_OFF_B; LAS unsigned char* Ximg = c.lds + SD_OFF_X; LAS float* sc = (LAS float*)(c.lds + SD_OFF_SC);
    for (int round = 0; round < 2; ++round) {
        SsdUnit u; if (!ssd_unit(c.bid, round, u)) break;
        const size_t m0 = (size_t)row_of(u.b, u.t0); const int nks = u.ns == 1 ? 1 : 4;
        for (int g = 0; g < 2; ++g) {
            __syncthreads();
            ssd_load_img(Bimg, SD_RS, bc, 512, m0, g * 128, 128, u.ns, tid);
            for (int j = 0; j < 4; ++j) {
                const int head = g * 4 + j;
                if (j) __syncthreads();
                ssd_load_img(Ximg, SD_XRS, xs, 512, m0, head * 64, 64, u.ns, tid);
                if (wave == 0) { float totf, totb; ssd_scalars(sc, dt, al, m0, head, u.ns, lane, totf, totb);
                    if (lane == 0) { cdec[((size_t)u.b * 33 + u.ck) * 16 + head] = __expf(totf); cdec[((size_t)u.b * 33 + u.ck) * 16 + 8 + head] = __expf(totb); } }
                __syncthreads();
                f32x4 accf[4], accb[4];
#pragma unroll
                for (int pt = 0; pt < 4; ++pt) { accf[pt] = (f32x4){0.f, 0.f, 0.f, 0.f}; accb[pt] = accf[pt]; }
                for (int ks = 0; ks < nks; ++ks) {
                    const bf16x8 af = frag_tr(Bimg, SD_RS, 32 * ks, 16 * wave, lane);
                    const int k0 = 32 * ks + 8 * (lane >> 4);
                    const f32x4 wf0 = *(const LAS f32x4*)(sc + 512 + k0), wf1 = *(const LAS f32x4*)(sc + 512 + k0 + 4), wb0 = *(const LAS f32x4*)(sc + 640 + k0), wb1 = *(const LAS f32x4*)(sc + 640 + k0 + 4);
#pragma unroll
                    for (int pt = 0; pt < 4; ++pt) {
                        const bf16x8 xr = frag_tr(Ximg, SD_XRS, 32 * ks, 16 * pt, lane);
                        float xf[8];
#pragma unroll
                        for (int e = 0; e < 8; ++e) xf[e] = bf1((bf16_t)xr[e]);
                        bf16x8 bfv, bbv;
                        { const unsigned p0 = pk2(xf[0] * wf0.x, xf[1] * wf0.y), p1 = pk2(xf[2] * wf0.z, xf[3] * wf0.w), p2 = pk2(xf[4] * wf1.x, xf[5] * wf1.y), p3 = pk2(xf[6] * wf1.z, xf[7] * wf1.w);
                          bfv = __builtin_bit_cast(bf16x8, (u32x4){p0, p1, p2, p3}); }
                        { const unsigned p0 = pk2(xf[0] * wb0.x, xf[1] * wb0.y), p1 = pk2(xf[2] * wb0.z, xf[3] * wb0.w), p2 = pk2(xf[4] * wb1.x, xf[5] * wb1.y), p3 = pk2(xf[6] * wb1.z, xf[7] * wb1.w);
                          bbv = __builtin_bit_cast(bf16x8, (u32x4){p0, p1, p2, p3}); }
                        accf[pt] = __builtin_amdgcn_mfma_f32_16x16x32_bf16(af, bfv, accf[pt], 0, 0, 0);
                        accb[pt] = __builtin_amdgcn_mfma_f32_16x16x32_bf16(af, bbv, accb[pt], 0, 0, 0);
                    }
                }
#pragma unroll
                for (int pt = 0; pt < 4; ++pt) {
                    const int p = 16 * pt + (lane & 15), n0 = 16 * wave + 4 * (lane >> 4);
                    if (u.ck <= 31) { bf16_t* d = stb + ((((size_t)u.b * 2 + 0) * 8 + head) * 32 + u.ck) * 8192 + (size_t)p * 128 + n0; *(u32x2*)d = (u32x2){pk2(accf[pt][0], accf[pt][1]), pk2(accf[pt][2], accf[pt][3])}; }
                    if (u.ck >= 1) { bf16_t* d = stb + ((((size_t)u.b * 2 + 1) * 8 + head) * 32 + (u.ck - 1)) * 8192 + (size_t)p * 128 + n0; *(u32x2*)d = (u32x2){pk2(accb[pt][0], accb[pt][1]), pk2(accb[pt][2], accb[pt][3])}; }
                }
            }
        }
    }
    __syncthreads();
}

__device__ __forceinline__ void ssd_chunk_scan(const Ctx& cx_, int l) {
    const Ctx c = relaunder(cx_);
    bf16_t* stb = (bf16_t*)(c.ws + WS_STB); const float* cdec = (const float*)(c.ws + WS_CDEC);
    const int gt = c.bid * NTHREADS + c.tid;
    const int e8 = gt & 1023, bdh = gt >> 10;
    if (bdh >= BATCH * 16) return;
    const int head = bdh & 7, dir = (bdh >> 3) & 1, b = bdh >> 4;
    bf16_t* base = stb + (size_t)bdh * 32 * 8192 + (size_t)e8 * 8;
    float h[8] = {0.f, 0.f, 0.f, 0.f, 0.f, 0.f, 0.f, 0.f};
    for (int i0 = 0; i0 < 32; i0 += 8) {
        u32x4 v[8]; float dcy[8];
#pragma unroll
        for (int k = 0; k < 8; ++k) { const int slot = dir == 0 ? i0 + k : 31 - (i0 + k); v[k] = *(const u32x4*)(base + (size_t)slot * 8192);
            const int ck = dir == 0 ? slot : slot + 1; dcy[k] = cdec[((size_t)b * 33 + ck) * 16 + dir * 8 + head]; }
#pragma unroll
        for (int k = 0; k < 8; ++k) { const int slot = dir == 0 ? i0 + k : 31 - (i0 + k); float s[8]; unpack8(v[k], s);
#pragma unroll
            for (int e = 0; e < 8; ++e) h[e] = h[e] * dcy[k] + s[e];
            *(u32x4*)(base + (size_t)slot * 8192) = pack8(h); }
    }
}

__device__ __forceinline__ void ssd_outputs(const Ctx& cx_, int l) {
    const Ctx c = relaunder(cx_);
    const int tid = c.tid, lane = c.lane, wave = c.wave;
    const bf16_t* bc = (const bf16_t*)(c.ws + WS_BC); const bf16_t* xs = (const bf16_t*)(c.ws + WS_XS); const bf16_t* pz = (const bf16_t*)(c.ws + WS_PZ);
    const float* dt = (const float*)(c.ws + WS_DT); const float* al = (const float*)(c.ws + WS_DEC);
    const bf16_t* stb = (const bf16_t*)(c.ws + WS_STB); bf16_t* yb = (bf16_t*)(c.ws + WS_YB); float* ssqb = (float*)(c.ws + WS_SSQB);
    LAS unsigned char* Cimg = c.lds + SD_OFF_C; LAS unsigned char* Bimg = c.lds + SD_OFF_B; LAS unsigned char* Ximg = c.lds + SD_OFF_X;
    LAS unsigned char* HfT = c.lds + SD_OFF_HF; LAS unsigned char* HbT = c.lds + SD_OFF_HB;
    LAS unsigned char* Ms = c.lds + SD_OFF_M + wave * 4352; LAS float* sc = (LAS float*)(c.lds + SD_OFF_SC);
    for (int round = 0; round < 2; ++round) {
        SsdUnit u; if (!ssd_unit(c.bid, round, u)) break;
        const size_t m0 = (size_t)row_of(u.b, u.t0); const int nks = u.ns == 1 ? 1 : 4; const bool active = wave < u.ns;
        float ssrow = 0.f;
        for (int g = 0; g < 2; ++g) {
            __syncthreads();
            ssd_load_img(Cimg, SD_RS, bc, 512, m0, 256 + g * 128, 128, u.ns, tid);
            ssd_load_img(Bimg, SD_RS, bc, 512, m0, g * 128, 128, u.ns, tid);
            __syncthreads();
            f32x4 cb[8];
#pragma unroll
            for (int t = 0; t < 8; ++t) cb[t] = (f32x4){0.f, 0.f, 0.f, 0.f};
            if (active) {
#pragma unroll
                for (int ks = 0; ks < 4; ++ks) {
                    const bf16x8 cfr = frag_row(Cimg, SD_RS, 16 * wave, 32 * ks, lane);
#pragma unroll
                    for (int t = 0; t < 8; ++t) if (t < u.ns) cb[t] = __builtin_amdgcn_mfma_f32_16x16x32_bf16(frag_row(Bimg, SD_RS, 16 * t, 32 * ks, lane), cfr, cb[t], 0, 0, 0);
                }
            }
            for (int j = 0; j < 4; ++j) {
                const int head = g * 4 + j;
                __syncthreads();
                ssd_load_img(Ximg, SD_XRS, xs, 512, m0, head * 64, 64, u.ns, tid);
                {
                    const bf16_t* hf = u.ck >= 1 ? stb + ((((size_t)u.b * 2 + 0) * 8 + head) * 32 + (u.ck - 1)) * 8192 : nullptr;
                    const bf16_t* hb = u.ck <= 31 ? stb + ((((size_t)u.b * 2 + 1) * 8 + head) * 32 + u.ck) * 8192 : nullptr;
                    for (int i = tid; i < 64 * 16; i += NTHREADS) { const int p = i >> 4, cc = i & 15;
                        *(LAS u32x4*)(HfT + p * SD_RS + cc * 16) = hf ? *(const u32x4*)(hf + p * 128 + cc * 8) : (u32x4){0u, 0u, 0u, 0u};
                        *(LAS u32x4*)(HbT + p * SD_RS + cc * 16) = hb ? *(const u32x4*)(hb + p * 128 + cc * 8) : (u32x4){0u, 0u, 0u, 0u}; }
                }
                if (wave == 0) { float totf, totb; ssd_scalars(sc, dt, al, m0, head, u.ns, lane, totf, totb); }
                __syncthreads();
                if (active) {
                    const int ll = 16 * wave + (lane & 15); const float afl = sc[ll], ebl = sc[128 + ll];
#pragma unroll
                    for (int t = 0; t < 8; ++t) {
                        u32x2 w2 = (u32x2){0u, 0u};
                        if (t < u.ns) {
                            const int s0 = 16 * t + 4 * (lane >> 4);
                            const f32x4 afs = *(const LAS f32x4*)(sc + s0), ebs = *(const LAS f32x4*)(sc + 128 + s0), dfs = *(const LAS f32x4*)(sc + 256 + s0), dbs = *(const LAS f32x4*)(sc + 384 + s0);
                            float mv[4];
#pragma unroll
                            for (int r = 0; r < 4; ++r) { const int s = s0 + r; float wgt = 0.f; if (s <= ll) wgt += __expf(afl - afs[r]) * dfs[r]; if (s >= ll) wgt += __expf(ebs[r] - ebl) * dbs[r]; mv[r] = cb[t][r] * wgt; }
                            w2 = (u32x2){pk2(mv[0], mv[1]), pk2(mv[2], mv[3])};
                        }
                        if (t < 2 * nks) *(LAS u32x2*)(Ms + (lane & 15) * SD_RS + (16 * t + 4 * (lane >> 4)) * 2) = w2;
                    }
                    asm volatile("s_waitcnt lgkmcnt(0)" ::: "memory");
                    f32x4 ay[4], ahf[4], ahb[4];
#pragma unroll
                    for (int pt = 0; pt < 4; ++pt) { ay[pt] = (f32x4){0.f, 0.f, 0.f, 0.f}; ahf[pt] = ay[pt]; ahb[pt] = ay[pt]; }
                    for (int ks = 0; ks < nks; ++ks) {
                        const bf16x8 mf = frag_row(Ms, SD_RS, 0, 32 * ks, lane);
#pragma unroll
                        for (int pt = 0; pt < 4; ++pt) ay[pt] = __builtin_amdgcn_mfma_f32_16x16x32_bf16(mf, frag_tr(Ximg, SD_XRS, 32 * ks, 16 * pt, lane), ay[pt], 0, 0, 0);
                    }
#pragma unroll
                    for (int ks = 0; ks < 4; ++ks) {
                        const bf16x8 cfr = frag_row(Cimg, SD_RS, 16 * wave, 32 * ks, lane);
#pragma unroll
                        for (int pt = 0; pt < 4; ++pt) {
                            ahf[pt] = __builtin_amdgcn_mfma_f32_16x16x32_bf16(cfr, frag_row(HfT, SD_RS, 16 * pt, 32 * ks, lane), ahf[pt], 0, 0, 0);
                            ahb[pt] = __builtin_amdgcn_mfma_f32_16x16x32_bf16(cfr, frag_row(HbT, SD_RS, 16 * pt, 32 * ks, lane), ahb[pt], 0, 0, 0);
                        }
                    }
                    const int l0 = 16 * wave + 4 * (lane >> 4);
                    const f32x4 efv = *(const LAS f32x4*)(sc + 768 + l0), ebv = *(const LAS f32x4*)(sc + 896 + l0);
                    asm volatile("s_waitcnt lgkmcnt(0)" ::: "memory");
                    LAS float* ys = (LAS float*)Ms;
#pragma unroll
                    for (int pt = 0; pt < 4; ++pt)
#pragma unroll
                        for (int r = 0; r < 4; ++r) ys[(4 * (lane >> 4) + r) * 68 + 16 * pt + (lane & 15)] = ay[pt][r] + efv[r] * ahf[pt][r] + ebv[r] * ahb[pt][r];
                    asm volatile("s_waitcnt lgkmcnt(0)" ::: "memory");
                    const int rr = lane >> 2, p0 = 16 * (lane & 3); const size_t m = m0 + 16 * wave + rr;
                    const float dsk = c.in[I_SSDD][l * 8 + head];
                    float xv[16], zv[16];
                    { float t8[8]; unpack8(*(const LAS u32x4*)(Ximg + (16 * wave + rr) * SD_XRS + p0 * 2), t8);
#pragma unroll
                      for (int e = 0; e < 8; ++e) xv[e] = t8[e];
                      unpack8(*(const LAS u32x4*)(Ximg + (16 * wave + rr) * SD_XRS + p0 * 2 + 16), t8);
#pragma unroll
                      for (int e = 0; e < 8; ++e) xv[8 + e] = t8[e];
                      unpack8(*(const u32x4*)(pz + m * 512 + head * 64 + p0), t8);
#pragma unroll
                      for (int e = 0; e < 8; ++e) zv[e] = t8[e];
                      unpack8(*(const u32x4*)(pz + m * 512 + head * 64 + p0 + 8), t8);
#pragma unroll
                      for (int e = 0; e < 8; ++e) zv[8 + e] = t8[e]; }
                    float o[16];
#pragma unroll
                    for (int e4 = 0; e4 < 4; ++e4) { const f32x4 yv = *(const LAS f32x4*)(ys + rr * 68 + p0 + 4 * e4);
#pragma unroll
                        for (int e = 0; e < 4; ++e) { const float val = (yv[e] + dsk * xv[4 * e4 + e]) * siluf_(zv[4 * e4 + e]); o[4 * e4 + e] = val; ssrow += val * val; } }
                    u32x4 w0, w1; w0.x = pk2(o[0], o[1]); w0.y = pk2(o[2], o[3]); w0.z = pk2(o[4], o[5]); w0.w = pk2(o[6], o[7]); w1.x = pk2(o[8], o[9]); w1.y = pk2(o[10], o[11]); w1.z = pk2(o[12], o[13]); w1.w = pk2(o[14], o[15]);
                    *(u32x4*)(yb + m * 512 + head * 64 + p0) = w0; *(u32x4*)(yb + m * 512 + head * 64 + p0 + 8) = w1;
                }
            }
        }
        if (active) { ssrow += dpp_mov<0xB1>(ssrow); ssrow += dpp_mov<0x4E>(ssrow); if ((lane & 3) == 0) ssqb[m0 + 16 * wave + (lane >> 2)] = ssrow; }
    }
    __syncthreads();
}
#define RC_NONE 1
typedef short s16x4v __attribute__((ext_vector_type(4)));
constexpr int RC_NCH = LEN / 16;
constexpr int RC_NP = 5;
constexpr int RC_ROUNDS = (RC_NCH + RC_NP - 1) / RC_NP;
constexpr int RC_S64 = 144;
constexpr int RC_S16 = 40;
constexpr int RC_AT = 0, RC_RT = 2304, RC_BH = 4608, RC_KH = 6912, RC_T = 9216, RC_AAK = 9856, RC_ARB = 10496, RC_ARK = 11136, RC_VT = 11776, RC_P16 = 12416, RC_SLOT = 12800;
constexpr int RC_SCR0 = 2 * RC_NP * RC_SLOT;
constexpr int RC_SCR = 1280;
static_assert(RC_SCR0 + RC_NP * RC_SCR <= 147456 - 512, "rwkv chunk LDS");
__device__ __forceinline__ f32x4 mm16(s16x4v a, s16x4v b, f32x4 c, int, int, int) { return __builtin_amdgcn_mfma_f32_16x16x32_bf16((bf16x8){a[0], a[1], a[2], a[3], 0, 0, 0, 0}, (bf16x8){b[0], b[1], b[2], b[3], 0, 0, 0, 0}, c, 0, 0, 0); }
__device__ __forceinline__ s16x4v mfma16_frag(const LAS unsigned char* mat, int row, int q) { return *(const LAS s16x4v*)(mat + row * RC_S16 + q * 8); }

__device__ __forceinline__ void rwkv_chunked(const Ctx& cx_, int l) {
    const Ctx c = relaunder(cx_);


    const int bid = c.bid, qs = bid & 3, dir = 1 - ((bid >> 2) & 1), head = (bid >> 3) & 3, b = bid >> 5;
    const int lane = c.lane, wave = c.wave;
    const bf16_t* rk = (const bf16_t*)(c.dout + DO_RKVP) + head * 64; const bf16_t* l2 = (const bf16_t*)(c.ws + WS_L2O) + dir * 256 + head * 64;
#ifdef RWKV_DBG
    bf16_t* yo = (bf16_t*)(c.ws + WS_MIX + (dir ? 47 * QB / 2 : 33 * QB / 2)) + head * 64 + 16 * qs;
#else
    bf16_t* yo = (bf16_t*)(c.ws + WS_YRW) + (size_t)dir * MP * 256 + head * 64 + 16 * qs;
#endif
    auto tok = [&](int s) -> size_t { const int t = s + dir * (LEN - 1 - 2 * s); return (size_t)row_of(b, t); };
    const int q = lane >> 4, li = lane & 15;
#ifdef RC_ZLDS
    for (int i = c.tid; i < 131072 / 16; i += NTHREADS) *(LAS u32x4*)(c.lds + i * 16) = (u32x4){0u, 0u, 0u, 0u};
    __syncthreads();
#endif
#ifdef RC_DELAY
    { const unsigned long long t0_ = __builtin_amdgcn_s_memrealtime(); while (__builtin_amdgcn_s_memrealtime() - t0_ < 40000ull) __builtin_amdgcn_s_sleep(16); }
#endif
#ifdef RC_PREFILL
    for (int i = c.tid; i < LEN * 2; i += NTHREADS) { const size_t m = (size_t)row_of(b, i >> 1); *(u32x4*)(yo + m * 256 + (i & 1) * 8) = (u32x4){0u, 0u, 0u, 0u}; }
    asm volatile("s_waitcnt vmcnt(0)" ::: "memory"); __syncthreads();
#endif
    u32x4 Rr[2], Kr[2], KKr[2], DLr[2], ASr[2]; bf16_t vr[4];
    auto load_raw = [&](int ch) {
        const size_t m = tok(16 * ch + li); const int k0 = 16 * q;
#pragma unroll
        for (int h = 0; h < 2; ++h) { Rr[h] = *(const u32x4*)(rk + m * 1024 + k0 + 8 * h); Kr[h] = *(const u32x4*)(rk + m * 1024 + 256 + k0 + 8 * h); KKr[h] = *(const u32x4*)(rk + m * 1024 + 768 + k0 + 8 * h);
            DLr[h] = *(const u32x4*)(l2 + m * 1280 + k0 + 8 * h); ASr[h] = *(const u32x4*)(l2 + m * 1280 + 512 + k0 + 8 * h); }
        const int vv = lane >> 2, sg = lane & 3;
#pragma unroll
        for (int j = 0; j < 4; ++j) vr[j] = rk[tok(16 * ch + 4 * sg + j) * 1024 + 512 + 16 * qs + vv];
    };
    auto produce = [&](int slot) {
        LAS unsigned char* sb = c.lds + slot * RC_SLOT; LAS float* Aab = (LAS float*)(c.lds + RC_SCR0 + (wave - 1) * RC_SCR);
        LAS unsigned char* Bh = sb + RC_BH; LAS unsigned char* Kh = sb + RC_KH;
        {
            const int vv = lane >> 2, sg = lane & 3;
            *(LAS u32x2*)(sb + RC_VT + vv * RC_S16 + sg * 8) = (u32x2){(unsigned)vr[0] | ((unsigned)vr[1] << 16), (unsigned)vr[2] | ((unsigned)vr[3] << 16)};
        }
        const int k0 = 16 * q;
#pragma unroll
        for (int h = 0; h < 2; ++h) {
            float r_[8], k_[8], kk_[8], dl_[8], as_[8], cs_[8]; unpack8(Rr[h], r_); unpack8(Kr[h], k_); unpack8(KKr[h], kk_); unpack8(DLr[h], dl_); unpack8(ASr[h], as_);
            const f32x4 ka0 = *(const f32x4*)(c.in[I_KA] + (size_t)l * 256 + head * 64 + k0 + 8 * h), ka1 = *(const f32x4*)(c.in[I_KA] + (size_t)l * 256 + head * 64 + k0 + 8 * h + 4);
            const float ka[8] = {ka0.x, ka0.y, ka0.z, ka0.w, ka1.x, ka1.y, ka1.z, ka1.w};
            float at_[8], rt_[8], bh_[8], kh_[8], p_[8];
#pragma unroll
            for (int e = 0; e < 8; ++e) {
                float x = dl_[e];
                x += dpp_mov<0x111>(x); x += dpp_mov<0x112>(x); x += dpp_mov<0x114>(x); x += dpp_mov<0x118>(x);
                cs_[e] = x;
            }
#pragma unroll
            for (int e = 0; e < 8; ++e) {
                const float P = __expf(cs_[e]), Pm = __expf(cs_[e] - dl_[e]), iP = __expf(-cs_[e]);
                at_[e] = -kk_[e] * Pm; rt_[e] = r_[e] * P; bh_[e] = kk_[e] * as_[e] * iP; kh_[e] = k_[e] * (1.f + (as_[e] - 1.f) * ka[e]) * iP; p_[e] = P;
            }
            *(LAS u32x4*)(sb + RC_AT + li * RC_S64 + (k0 + 8 * h) * 2) = pack8(at_); *(LAS u32x4*)(sb + RC_RT + li * RC_S64 + (k0 + 8 * h) * 2) = pack8(rt_);
            *(LAS u32x4*)(Bh + li * RC_S64 + (k0 + 8 * h) * 2) = pack8(bh_); *(LAS u32x4*)(Kh + li * RC_S64 + (k0 + 8 * h) * 2) = pack8(kh_);
            if (li == 15) { *(LAS f32x4*)(sb + RC_P16 + (k0 + 8 * h) * 4) = (f32x4){p_[0], p_[1], p_[2], p_[3]}; *(LAS f32x4*)(sb + RC_P16 + (k0 + 8 * h + 4) * 4) = (f32x4){p_[4], p_[5], p_[6], p_[7]}; }
        }
        asm volatile("s_waitcnt lgkmcnt(0)" ::: "memory");
        f32x4 ab = (f32x4){0.f, 0.f, 0.f, 0.f}, ak = ab, rb = ab, rkm = ab;
#pragma unroll
        for (int ks = 0; ks < 2; ++ks) {
            const bf16x8 fa = *(const LAS bf16x8*)(sb + RC_AT + li * RC_S64 + (32 * ks + 8 * q) * 2), fr = *(const LAS bf16x8*)(sb + RC_RT + li * RC_S64 + (32 * ks + 8 * q) * 2);
            const bf16x8 fb = *(const LAS bf16x8*)(Bh + li * RC_S64 + (32 * ks + 8 * q) * 2), fk = *(const LAS bf16x8*)(Kh + li * RC_S64 + (32 * ks + 8 * q) * 2);
            ab = __builtin_amdgcn_mfma_f32_16x16x32_bf16(fa, fb, ab, 0, 0, 0); ak = __builtin_amdgcn_mfma_f32_16x16x32_bf16(fa, fk, ak, 0, 0, 0);
            rb = __builtin_amdgcn_mfma_f32_16x16x32_bf16(fr, fb, rb, 0, 0, 0); rkm = __builtin_amdgcn_mfma_f32_16x16x32_bf16(fr, fk, rkm, 0, 0, 0);
        }
#pragma unroll
        for (int r = 0; r < 4; ++r) {
            const int t = 4 * q + r, s = li;
            Aab[t * 20 + s] = s < t ? ab[r] : 0.f;
            *(LAS bf16_t*)(sb + RC_AAK + t * RC_S16 + s * 2) = (bf16_t)f2bf(s < t ? ak[r] : 0.f);
            *(LAS bf16_t*)(sb + RC_ARB + t * RC_S16 + s * 2) = (bf16_t)f2bf(s <= t ? rb[r] : 0.f);
            *(LAS bf16_t*)(sb + RC_ARK + t * RC_S16 + s * 2) = (bf16_t)f2bf(s <= t ? rkm[r] : 0.f);
        }
        asm volatile("s_waitcnt lgkmcnt(0)" ::: "memory");
        float tc[16];
#pragma unroll
        for (int t = 0; t < 16; ++t) {
            float acc = (t == li) ? 1.f : 0.f;
            f32x4 a0 = *(const LAS f32x4*)(Aab + t * 20), a1 = *(const LAS f32x4*)(Aab + t * 20 + 4), a2 = *(const LAS f32x4*)(Aab + t * 20 + 8), a3 = *(const LAS f32x4*)(Aab + t * 20 + 12);
            const float av[16] = {a0.x, a0.y, a0.z, a0.w, a1.x, a1.y, a1.z, a1.w, a2.x, a2.y, a2.z, a2.w, a3.x, a3.y, a3.z, a3.w};
#pragma unroll
            for (int s = 0; s < t; ++s) acc += av[s] * tc[s];
            tc[t] = acc;
        }
        if (q == 0) {
#pragma unroll
            for (int t = 0; t < 16; ++t) *(LAS bf16_t*)(sb + RC_T + t * RC_S16 + li * 2) = (bf16_t)f2bf(tc[t]);
        }
    };
    if (wave >= 1 && wave <= RC_NP) { const int ch0 = wave - 1; load_raw(ch0); produce(wave - 1); load_raw(ch0 + RC_NP); }
    __syncthreads();
    f32x4 S[4]; bf16x8 sop[2];
#pragma unroll
    for (int kt = 0; kt < 4; ++kt) S[kt] = (f32x4){0.f, 0.f, 0.f, 0.f};
    sop[0] = (bf16x8){0, 0, 0, 0, 0, 0, 0, 0}; sop[1] = sop[0];
    int sbase = 0;
    auto consume = [&](const int i, const int ch) {
                const LAS unsigned char* sb = c.lds + (sbase + i) * RC_SLOT;
        const s16x4v vt = mfma16_frag(sb + RC_VT, li, q);
        f32x4 aw = mm16(mfma16_frag(sb + RC_AAK, li, q), vt, (f32x4){0.f, 0.f, 0.f, 0.f}, 0, 0, 0);
        f32x4 ay = mm16(mfma16_frag(sb + RC_ARK, li, q), vt, (f32x4){0.f, 0.f, 0.f, 0.f}, 0, 0, 0);
#pragma unroll
        for (int ks = 0; ks < 2; ++ks) {
            const s16x4v alo = *(const LAS s16x4v*)(sb + RC_AT + li * RC_S64 + (32 * ks + 4 * q) * 2), ahi = *(const LAS s16x4v*)(sb + RC_AT + li * RC_S64 + (32 * ks + 16 + 4 * q) * 2);
            const s16x4v rlo = *(const LAS s16x4v*)(sb + RC_RT + li * RC_S64 + (32 * ks + 4 * q) * 2), rhi = *(const LAS s16x4v*)(sb + RC_RT + li * RC_S64 + (32 * ks + 16 + 4 * q) * 2);
            aw = __builtin_amdgcn_mfma_f32_16x16x32_bf16((bf16x8){alo[0], alo[1], alo[2], alo[3], ahi[0], ahi[1], ahi[2], ahi[3]}, sop[ks], aw, 0, 0, 0);
            ay = __builtin_amdgcn_mfma_f32_16x16x32_bf16((bf16x8){rlo[0], rlo[1], rlo[2], rlo[3], rhi[0], rhi[1], rhi[2], rhi[3]}, sop[ks], ay, 0, 0, 0);
        }
        const u32x2 wb2 = (u32x2){pk2(aw[0], aw[1]), pk2(aw[2], aw[3])};
        const f32x4 au = mm16(mfma16_frag(sb + RC_T, li, q), __builtin_bit_cast(s16x4v, wb2), (f32x4){0.f, 0.f, 0.f, 0.f}, 0, 0, 0);
        const u32x2 ub2 = (u32x2){pk2(au[0], au[1]), pk2(au[2], au[3])}; const s16x4v ub = __builtin_bit_cast(s16x4v, ub2);
        ay = mm16(mfma16_frag(sb + RC_ARB, li, q), ub, ay, 0, 0, 0);
#pragma unroll
        for (int kt = 0; kt < 4; ++kt) {
            const f32x4 p16 = *(const LAS f32x4*)(sb + RC_P16 + (16 * kt + 4 * q) * 4);
            const int troff = (4 * q + (li >> 2)) * RC_S64 + (16 * kt + 4 * (li & 3)) * 2;
            f32x4 sv = S[kt];
            sv = mm16(lds_tr(sb + RC_KH + troff), vt, sv, 0, 0, 0);
            sv = mm16(lds_tr(sb + RC_BH + troff), ub, sv, 0, 0, 0);
            sv = sv * p16;
            S[kt] = sv;
        }
#pragma unroll
        for (int ks = 0; ks < 2; ++ks) {
            const u32x4 w = (u32x4){pk2(S[2 * ks][0], S[2 * ks][1]), pk2(S[2 * ks][2], S[2 * ks][3]), pk2(S[2 * ks + 1][0], S[2 * ks + 1][1]), pk2(S[2 * ks + 1][2], S[2 * ks + 1][3])};
            sop[ks] = __builtin_bit_cast(bf16x8, w);
        }
#pragma unroll
        for (int r = 0; r < 4; ++r) yo[tok(16 * ch + 4 * q + r) * 256 + li] = (bf16_t)f2bf(ay[r]);
    };
    for (int rd = 0; rd < RC_ROUNDS; ++rd) {
        if (wave == 0) {
            sbase = (rd & 1) * RC_NP;
            if (rd < RC_ROUNDS - 1) {
#pragma unroll
                for (int i = 0; i < RC_NP; ++i) consume(i, RC_NP * rd + i);
            } else {
                for (int i = 0; i < RC_NP; ++i) { const int ch = RC_NP * rd + i; if (ch >= RC_NCH) break; consume(i, ch); }
            }
        } else if (wave <= RC_NP) {
            const int chn = RC_NP * (rd + 1) + (wave - 1);
            if (chn < RC_NCH) { produce(((rd + 1) & 1) * RC_NP + (wave - 1)); if (chn + RC_NP < RC_NCH) load_raw(chn + RC_NP); }
        }
        __syncthreads();
    }
}
constexpr int RW_T = 32, RW_NC = (LEN + RW_T - 1) / RW_T, RW_BUF = 45056;
__device__ __forceinline__ void rwkv_scan(const Ctx& cx_, int l) {
    const Ctx c = relaunder(cx_);
    const int bid = c.bid, q = bid & 3, dir = 1 - ((bid >> 2) & 1), head = (bid >> 3) & 3, b = bid >> 5;
    const int tid = c.tid, lane = c.lane, wave = c.wave;
    const bf16_t* rk = (const bf16_t*)(c.dout + DO_RKVP); const bf16_t* l2 = (const bf16_t*)(c.ws + WS_L2O);
    bf16_t* yo = (bf16_t*)(c.ws + WS_YRW) + (size_t)dir * MP * 256;
    const bool producer = wave >= 4;
    const int pt = tid - 256, pstep = pt >> 3, pc0 = (pt & 7) * 8, pv0 = 2 * (pt & 7);
    float ka[8];
    u32x4 R, K, KK, DL, AS; unsigned V2 = 0; R = K = KK = DL = AS = (u32x4){0u, 0u, 0u, 0u};
    if (producer) {
#pragma unroll
        for (int e = 0; e < 8; ++e) ka[e] = c.in[I_KA][(size_t)l * 256 + head * 64 + pc0 + e];
    }
    auto tok = [&](int s) -> size_t { const int t = dir ? LEN - 1 - s : s; return (size_t)row_of(b, t); };
#define RW_LOAD(chunk) do { const int s_ = (chunk) * RW_T + pstep; if (s_ < LEN) { const size_t m_ = tok(s_); const bf16_t* rp_ = rk + m_ * 1024 + head * 64; const bf16_t* lp_ = l2 + m_ * 1280 + dir * 256 + head * 64; \
        R = *(const u32x4*)(rp_ + pc0); K = *(const u32x4*)(rp_ + 256 + pc0); KK = *(const u32x4*)(rp_ + 768 + pc0); V2 = *(const unsigned*)(rp_ + 512 + 16 * q + pv0); \
        DL = *(const u32x4*)(lp_ + pc0); AS = *(const u32x4*)(lp_ + 512 + pc0); } } while (0)
#define RW_WRITE(buf) do { LAS float* vec_ = (LAS float*)(c.lds + (buf) * RW_BUF); float r_[8], k_[8], kk_[8], dl_[8], as_[8]; unpack8(R, r_); unpack8(K, k_); unpack8(KK, kk_); unpack8(DL, dl_); unpack8(AS, as_); \
        float w_[8], a_[8], b_[8], kd_[8]; _Pragma("unroll") for (int e = 0; e < 8; ++e) { w_[e] = __expf(dl_[e]); a_[e] = -kk_[e]; b_[e] = kk_[e] * as_[e]; kd_[e] = k_[e] * (1.f + (as_[e] - 1.f) * ka[e]); } \
        LAS float* bp_ = vec_ + pstep * 320 + pc0; \
        *(LAS f32x4*)(bp_) = (f32x4){w_[0], w_[1], w_[2], w_[3]}; *(LAS f32x4*)(bp_ + 4) = (f32x4){w_[4], w_[5], w_[6], w_[7]}; \
        *(LAS f32x4*)(bp_ + 64) = (f32x4){a_[0], a_[1], a_[2], a_[3]}; *(LAS f32x4*)(bp_ + 68) = (f32x4){a_[4], a_[5], a_[6], a_[7]}; \
        *(LAS f32x4*)(bp_ + 128) = (f32x4){b_[0], b_[1], b_[2], b_[3]}; *(LAS f32x4*)(bp_ + 132) = (f32x4){b_[4], b_[5], b_[6], b_[7]}; \
        *(LAS f32x4*)(bp_ + 192) = (f32x4){kd_[0], kd_[1], kd_[2], kd_[3]}; *(LAS f32x4*)(bp_ + 196) = (f32x4){kd_[4], kd_[5], kd_[6], kd_[7]}; \
        *(LAS f32x4*)(bp_ + 256) = (f32x4){r_[0], r_[1], r_[2], r_[3]}; *(LAS f32x4*)(bp_ + 260) = (f32x4){r_[4], r_[5], r_[6], r_[7]}; \
        LAS float* vr_ = vec_ + 10240 + pstep * 16 + pv0; vr_[0] = bflo(V2); vr_[1] = bfhi(V2); } while (0)
#define RW_FLUSH(chunk) do { const int s_ = (chunk) * RW_T + pstep; if (s_ < LEN) { const LAS float* yy_ = (const LAS float*)(c.lds + ((chunk) & 1) * RW_BUF) + 10752 + pstep * 16 + pv0; \
        *(unsigned*)(yo + tok(s_) * 256 + head * 64 + 16 * q + pv0) = pk2(yy_[0], yy_[1]); } } while (0)
    if (producer) { RW_LOAD(0); RW_WRITE(0); RW_LOAD(1); }
    __syncthreads();
    const int rowl = (wave & 3) * 4 + (lane >> 4), j4 = (lane & 15) * 4;
    float S0 = 0.f, S1 = 0.f, S2 = 0.f, S3 = 0.f;
#define RW_SCAN(NS) do { float yv_[NS]; \
        _Pragma("unroll") for (int st = 0; st < NS; ++st) { \
            const LAS float* bp = vec + st * 320 + j4; \
            const f32x4 w = *(const LAS f32x4*)(bp), a = *(const LAS f32x4*)(bp + 64), bb = *(const LAS f32x4*)(bp + 128), kd = *(const LAS f32x4*)(bp + 192), r = *(const LAS f32x4*)(bp + 256); \
            const float v = vec[10240 + st * 16 + rowl]; \
            float sa = (S0 * a.x + S1 * a.y) + (S2 * a.z + S3 * a.w); \
            sa = allred16(sa); \
            S0 = S0 * w.x + v * kd.x; S1 = S1 * w.y + v * kd.y; S2 = S2 * w.z + v * kd.z; S3 = S3 * w.w + v * kd.w; \
            S0 += sa * bb.x; S1 += sa * bb.y; S2 += sa * bb.z; S3 += sa * bb.w; \
            float y = (S0 * r.x + S1 * r.y) + (S2 * r.z + S3 * r.w); \
            yv_[st] = allred16(y); } \
        if ((lane & 15) == 0) { _Pragma("unroll") for (int st = 0; st < NS; ++st) yy[st * 16 + rowl] = yv_[st]; } } while (0)
    for (int ch = 0; ch < RW_NC; ++ch) {
        if (!producer) {
            const LAS float* vec = (const LAS float*)(c.lds + (ch & 1) * RW_BUF);
            LAS float* yy = (LAS float*)(c.lds + (ch & 1) * RW_BUF) + 10752;
            if (ch < RW_NC - 1) RW_SCAN(32); else RW_SCAN(LEN - (RW_NC - 1) * RW_T);
        } else {
            if (ch + 1 < RW_NC) RW_WRITE((ch + 1) & 1);
            if (ch + 2 < RW_NC) RW_LOAD(ch + 2);
            if (ch >= 1) RW_FLUSH(ch - 1);
        }
        __syncthreads();
    }
#undef RW_SCAN
    if (producer) RW_FLUSH(RW_NC - 1);
    __syncthreads();
#undef RW_LOAD
#undef RW_WRITE
#undef RW_FLUSH
}

__device__ __forceinline__ void rwkv_post(const Ctx& cx_, int l) {
    const Ctx c = relaunder(cx_);
    const int gw = c.bid * NWAVES + c.wave, NGW = c.G * NWAVES, lane = c.lane, c0 = 4 * lane;
    const bf16_t* y0 = (const bf16_t*)(c.ws + WS_YRW); const bf16_t* y1 = y0 + (size_t)MP * 256;
    const bf16_t* rk = (const bf16_t*)(c.dout + DO_RKVP); const bf16_t* l2 = (const bf16_t*)(c.ws + WS_L2O); bf16_t* yc = (bf16_t*)(c.ws + WS_YC);
    float lw[4], lb[4], rkw[4];
#pragma unroll
    for (int e = 0; e < 4; ++e) { lw[e] = c.in[I_LNW][(size_t)l * 256 + c0 + e]; lb[e] = c.in[I_LNB][(size_t)l * 256 + c0 + e]; rkw[e] = c.in[I_RK][(size_t)l * 256 + c0 + e]; }
    for (int m = gw; m < M_ROWS; m += NGW) {
        const u32x2 a = *(const u32x2*)(y0 + (size_t)m * 256 + c0), bq = *(const u32x2*)(y1 + (size_t)m * 256 + c0);
        const u32x2 rr = *(const u32x2*)(rk + (size_t)m * 1024 + c0), kk = *(const u32x2*)(rk + (size_t)m * 1024 + 256 + c0), vv = *(const u32x2*)(rk + (size_t)m * 1024 + 512 + c0);
        const u32x2 gg = *(const u32x2*)(l2 + (size_t)m * 1280 + 1024 + c0);
        float y[4] = {bflo(a.x) + bflo(bq.x), bfhi(a.x) + bfhi(bq.x), bflo(a.y) + bflo(bq.y), bfhi(a.y) + bfhi(bq.y)};
        const float r[4] = {bflo(rr.x), bfhi(rr.x), bflo(rr.y), bfhi(rr.y)}, k[4] = {bflo(kk.x), bfhi(kk.x), bflo(kk.y), bfhi(kk.y)};
        const float v[4] = {bflo(vv.x), bfhi(vv.x), bflo(vv.y), bfhi(vv.y)}, g[4] = {bflo(gg.x), bfhi(gg.x), bflo(gg.y), bfhi(gg.y)};
        const float mean = sum16((y[0] + y[1]) + (y[2] + y[3])) * (1.f / 64.f);
        float q = 0.f, bo = 0.f;
#pragma unroll
        for (int e = 0; e < 4; ++e) { y[e] -= mean; q += y[e] * y[e]; bo += r[e] * k[e] * rkw[e]; }
        q = sum16(q) * (1.f / 64.f); bo = sum16(bo);
        const float rs = __builtin_amdgcn_rsqf(q + 64e-5f);
        float o[4];
#pragma unroll
        for (int e = 0; e < 4; ++e) o[e] = (y[e] * rs * lw[e] + lb[e] + bo * v[e]) * g[e];
        *(u32x2*)(yc + (size_t)m * 256 + c0) = (u32x2){pk2(o[0], o[1]), pk2(o[2], o[3])};
    }
}
__device__ __forceinline__ void final_phase(const Ctx& cx_, float* out) {
    const Ctx c = relaunder(cx_);
    const int gw = c.bid * NWAVES + c.wave, NGW = c.G * NWAVES, lane = c.lane;
    const bf16_t* H = c.H(); const f32x4* fw = (const f32x4*)c.in[I_FNW];
    for (int r = gw; r < BATCH * SEQ; r += NGW) {
        const size_t m = (size_t)r;
        const u32x2* hp = (const u32x2*)(H + m * DM);
        float v[4][4], ss = 0.f;
#pragma unroll
        for (int i = 0; i < 4; ++i) { const u32x2 w = hp[lane + 64 * i]; v[i][0] = bflo(w.x); v[i][1] = bfhi(w.x); v[i][2] = bflo(w.y); v[i][3] = bfhi(w.y); ss += (v[i][0] * v[i][0] + v[i][1] * v[i][1]) + (v[i][2] * v[i][2] + v[i][3] * v[i][3]); }
        ss = wave_sum(ss); const float s = __builtin_amdgcn_rsqf(ss * (1.0f / DM) + EPS);
        f32x4* op = (f32x4*)(out + (size_t)r * DM);
#pragma unroll
        for (int i = 0; i < 4; ++i) { const f32x4 w = fw[lane + 64 * i]; op[lane + 64 * i] = (f32x4){v[i][0] * s * w.x, v[i][1] * s * w.y, v[i][2] * s * w.z, v[i][3] * s * w.w}; }
    }
}

constexpr int LDS_BYTES = 147456;
#ifndef MIXDIR
#define MIXDIR 0
#define MIXLAYER 0
#endif
#ifndef PHMASK
#define PHMASK 0xFFFFF
#endif
__global__ void __launch_bounds__(NTHREADS, 2) mega_fwd(Params p) {
    extern __shared__ __attribute__((aligned(16))) unsigned char lds_raw[];
    cg::grid_group grid = cg::this_grid();
    Ctx c0_; c0_.in = p.in; c0_.ws = p.ws; c0_.dout = (unsigned char*)p.out; c0_.lds = (LAS unsigned char*)lds_raw;
    c0_.wave = __builtin_amdgcn_readfirstlane((int)threadIdx.x >> 6); c0_.tid = opaque_tid(c0_.wave); c0_.lane = c0_.tid & 63; c0_.G = gridDim.x; c0_.bid = blockIdx.x;
    Ctx c = c0_;
    const int G = c.G, bid = c.bid;
#ifdef PROF_A
#ifndef PROF_SHIFT
#define PROF_SHIFT 1.0f
#endif
#define PROF_PTR ((unsigned long long*)(c.ws + WS_DEC + (size_t)MP * 64))
    if (blockIdx.x == 0 && threadIdx.x == 0) { for (int k = 0; k < 15; ++k) PROF_PTR[k] = 0; PROF_PTR[15] = __builtin_amdgcn_s_memrealtime(); }
#define STAMP(k) do { if (blockIdx.x == 0 && threadIdx.x == 0) { const unsigned long long t_ = __builtin_amdgcn_s_memrealtime(); PROF_PTR[k] += t_ - PROF_PTR[15]; PROF_PTR[15] = t_; } } while (0)
#else
#define STAMP(k) do { } while (0)
#endif
    unsigned* barw = (unsigned*)(c.ws + WS_BAR);
    volatile LAS unsigned* bst = (volatile LAS unsigned*)(c.lds + LDS_BYTES - 64);
    if (bid == 0) for (int i = threadIdx.x; i < XCD_BAR_WORDS + 1024; i += NTHREADS) barw[i < XCD_BAR_WORDS ? i : 4096 + (i - XCD_BAR_WORDS)] = 0u;
    if (threadIdx.x < 2) bst[threadIdx.x] = 0u;
    __syncthreads();
    if (PHMASK & 1) phase0(c);
    grid.sync(); STAMP(0);
    const XcdBarrier xbar = xcd_barrier_post(barw, bst);
#define GRID_BAR() do { xcd_barrier(xbar, c0_.wave); c = relaunder(c0_); } while (0)
#pragma unroll 1
    for (int l = 0; l < DEPTH; ++l) {
#define wb (c.wb(l))
        if (PHMASK & 2) dt_job(c, l);
        if (PHMASK & 4) { SchedPlain S{c.H(), wb + WB_IN, DM, DM, DM, MP / 256, 11, G, bid, 0};
          EpiInProj E{c.ssq(), (bf16_t*)(c.ws + WS_UH), (bf16_t*)(c.ws + WS_PZ), (bf16_t*)(c.ws + WS_PXBC), (bf16_t*)(c.ws + WS_PRKVX)};
          pg8::gemm_phase(c.lds, c.wave, S, E); }
        GRID_BAR(); STAMP(1);
        if (PHMASK & 8) { SchedS5 S{(const bf16_t*)(c.ws + WS_UH), wb + WB_SX, 256, G, bid}; EpiS5X E{(float*)(c.ws + WS_X)}; pg8::gemm_phase(c.lds, c.wave, S, E); }
        if (PHMASK & 16) rwkv_prep(c, l);
        if (PHMASK & 32) ssd_prep(c, l);
        GRID_BAR(); STAMP(2);
        if (PHMASK & 64) s5_scan(c, l);
        if (PHMASK & 4096) ssd_states(c, l);
        if (PHMASK & 128) { SchedPlain S{(const bf16_t*)(c.ws + WS_L1IN), wb + WB_L1, 512, 512, 512, MP / 256, 2, G, bid, 0}; EpiL1 E{(bf16_t*)(c.ws + WS_L1O)}; pg8::gemm_phase(c.lds, c.wave, S, E); }
        GRID_BAR(); STAMP(3);
        ssd_chunk_scan(c, l);
        if (PHMASK & 256) { SchedL2 S{(const bf16_t*)(c.ws + WS_L1O), wb + WB_L2, G, bid, MP / 256, 0}; EpiL2 E{(bf16_t*)(c.ws + WS_L2O), c.in[I_W0] + (size_t)l * 512, c.in[I_A0] + (size_t)l * 512}; pg8::gemm_phase(c.lds, c.wave, S, E); }
        if (PHMASK & 512) { SchedS5 S{(const bf16_t*)(c.ws + WS_UH), wb + WB_SY, 512, G, bid}; EpiS5Y E{(bf16_t*)(c.ws + WS_YAPRE)}; pg8::gemm_phase(c.lds, c.wave, S, E); }
        GRID_BAR(); STAMP(4);
#ifdef RWKV_DBG
        if (PHMASK & 1024) rwkv_scan(c, l);
        if (l == 0) rwkv_chunked(c, l);
#else
        if (PHMASK & 1024) rwkv_chunked(c, l);
#endif
        STAMP(5);
        if (PHMASK & 2048) ssd_outputs(c, l);
        GRID_BAR(); STAMP(6);
#ifdef RWKV_DBG
        if (l == 0) { unsigned* dbg = (unsigned*)(c.ws + WS_BAR + 16384); const bf16_t* y0_ = (const bf16_t*)(c.ws + WS_YRW); const bf16_t* y1_ = (const bf16_t*)(c.ws + WS_MIX + 33 * QB / 2);
          float s0 = 0.f, d0 = 0.f, s1 = 0.f, d1 = 0.f; const bf16_t* y0b_ = y0_ + (size_t)MP * 256; const bf16_t* y1b_ = (const bf16_t*)(c.ws + WS_MIX + 47 * QB / 2);
          for (size_t i = (size_t)bid * NTHREADS + threadIdx.x; i < (size_t)M_ROWS * 256; i += (size_t)G * NTHREADS) { const float a = bf1(y0_[i]), b2 = bf1(y1_[i]), a1 = bf1(y0b_[i]), b1 = bf1(y1b_[i]);
            s0 += a * a; d0 += (a - b2) * (a - b2); s1 += a1 * a1; d1 += (a1 - b1) * (a1 - b1); }
          s0 = wave_sum(s0); d0 = wave_sum(d0); s1 = wave_sum(s1); d1 = wave_sum(d1);
          if ((threadIdx.x & 63) == 0) { atomicAdd((float*)dbg + 0, s0); atomicAdd((float*)dbg + 1, d0); atomicAdd((float*)dbg + 2, s1); atomicAdd((float*)dbg + 3, d1); } }
#endif
        if (PHMASK & 8192) rwkv_post(c, l);
        if (PHMASK & 16384) { SchedPlain S{(const bf16_t*)(c.ws + WS_YAPRE), wb + WB_GLU, 256, 256, 256, MP / 256, 2, G, bid, 0}; EpiGLU E{(bf16_t*)(c.ws + WS_YA), c.in[I_GLUB] + (size_t)l * 512}; pg8::gemm_phase(c.lds, c.wave, S, E); }
        GRID_BAR(); STAMP(7);
        if (PHMASK & 32768) { SchedProj S{c.H(), wb + WB_G, wb + WB_P, (const bf16_t*)(c.ws + WS_YA), (const bf16_t*)(c.ws + WS_YB), (const bf16_t*)(c.ws + WS_YC), (l < DEPTH - 1 ? MP / 256 : BATCH * SEQ / 256), G, bid, 0};
          EpiProj E{c.ssq(), (const float*)(c.ws + WS_SSQB), c.ws + WS_PARK + (size_t)bid * 393216, (bf16_t*)(c.dout + DO_MERGED), opaque_tid(c.wave)}; pg8::gemm_phase(c.lds, c.wave, S, E); }
        GRID_BAR(); STAMP(8);
        if (PHMASK & 65536) { SchedPlain S{(const bf16_t*)(c.dout + DO_MERGED), wb + WB_O, DM, DM, DM, (l < DEPTH - 1 ? MP / 256 : BATCH * SEQ / 256), 4, G, bid, 0}; EpiResid E{c.H(), c.ssq()}; pg8::gemm_phase(c.lds, c.wave, S, E); }
        GRID_BAR(); STAMP(9);
        if (PHMASK & 131072) { SchedPlain S{c.H(), wb + WB_1, DM, DM, DM, (l < DEPTH - 1 ? MP / 256 : BATCH * SEQ / 256), 16, G, bid, 0}; EpiUp E{c.ssq(), (bf16_t*)(c.ws + WS_ACT)}; pg8::gemm_phase(c.lds, c.wave, S, E); }
        GRID_BAR(); STAMP(10);
        if (PHMASK & 262144) { SchedPlain S{(const bf16_t*)(c.ws + WS_ACT), wb + WB_2, DFF, DFF, DFF, (l < DEPTH - 1 ? MP / 256 : BATCH * SEQ / 256), 4, G, bid, 0}; EpiResid E{c.H(), c.ssq()}; pg8::gemm_phase(c.lds, c.wave, S, E); }
        GRID_BAR(); STAMP(11);
    }
    if (PHMASK & 524288) final_phase(c, p.out);
#ifdef RWKV_DBG
    GRID_BAR();
    if (blockIdx.x == 0) { const unsigned* dbg = (const unsigned*)(c.ws + WS_BAR + 16384); const float s0 = __uint_as_float(__hip_atomic_load(dbg + 0, __ATOMIC_RELAXED, __HIP_MEMORY_SCOPE_AGENT)), d0 = __uint_as_float(__hip_atomic_load(dbg + 1, __ATOMIC_RELAXED, __HIP_MEMORY_SCOPE_AGENT)), s1 = __uint_as_float(__hip_atomic_load(dbg + 2, __ATOMIC_RELAXED, __HIP_MEMORY_SCOPE_AGENT)), d1 = __uint_as_float(__hip_atomic_load(dbg + 3, __ATOMIC_RELAXED, __HIP_MEMORY_SCOPE_AGENT));
        float va = 100.f + 10000.f * sqrtf(d1 / s1), vb = 100.f + 10000.f * sqrtf(d0 / s0);
        va = rintf(va * 0.1f) * 10.f; vb = rintf(vb * 0.1f) * 10.f;
        for (int i = threadIdx.x; i < (1 << 20); i += NTHREADS) p.out[1 + i] = vb;
        if (threadIdx.x == 0) p.out[0] = 100.f * va; }
#endif
#ifdef PROF_A
    GRID_BAR(); STAMP(12);
    if (blockIdx.x == 0) {
        __syncthreads();
        float va = (float)(__hip_atomic_load(&PROF_PTR[PROF_A], __ATOMIC_RELAXED, __HIP_MEMORY_SCOPE_AGENT)) * 0.01f, vb = (float)(__hip_atomic_load(&PROF_PTR[PROF_B], __ATOMIC_RELAXED, __HIP_MEMORY_SCOPE_AGENT)) * 0.01f;
        va = exp2f(rintf(log2f(va * PROF_SHIFT) * 2.f) * 0.5f); vb = exp2f(rintf(log2f(vb * PROF_SHIFT) * 2.f) * 0.5f);
        for (int i = threadIdx.x; i < (1 << 20); i += NTHREADS) p.out[1 + i] = vb;
        if (threadIdx.x == 0) p.out[0] = 100.f * va;
    }
#endif
}

extern "C" void kernel_launch(void* const* d_in, const int* in_sizes, int n_in, void* d_out, int out_size, void* d_ws, size_t ws_size, hipStream_t stream) {
    static int grid = 0;
    if (grid == 0) {
        int dev = 0, cus = 0, per_cu = 0;
        if (n_in != N_INPUTS || out_size != BATCH * SEQ * DM || ws_size < WS_END) { fprintf(stderr, "kernel_launch: unexpected shapes (n_in %d out %d ws %zu)\n", n_in, out_size, ws_size); grid = -1; return; }
        (void)hipGetDevice(&dev); (void)hipDeviceGetAttribute(&cus, hipDeviceAttributeMultiprocessorCount, dev);
        (void)hipFuncSetAttribute((const void*)mega_fwd, hipFuncAttributeMaxDynamicSharedMemorySize, LDS_BYTES);
        (void)hipOccupancyMaxActiveBlocksPerMultiprocessor(&per_cu, (const void*)mega_fwd, NTHREADS, LDS_BYTES);
        if (per_cu < 1) { fprintf(stderr, "kernel_launch: occupancy query says %d blocks per CU\n", per_cu); per_cu = 1; }
        grid = cus * 1;
        if (grid != 256) fprintf(stderr, "kernel_launch: %d CUs (the scan phases are laid out for 256 workgroups)\n", grid);
    }
    if (grid < 0) return;
    Params p{};
    for (int i = 0; i < N_INPUTS; ++i) p.in[i] = (const float*)d_in[i];
    p.out = (float*)d_out; p.ws = (unsigned char*)d_ws; p.ph_lo = 0; p.ph_hi = 0;
    void* args[] = {&p};
    hipError_t e = hipLaunchCooperativeKernel((const void*)mega_fwd, dim3(grid), dim3(NTHREADS), args, LDS_BYTES, stream);
    if (e != hipSuccess) fprintf(stderr, "cooperative launch failed: %s (grid %d)\n", hipGetErrorString(e), grid);
}
```

```cpp
#include <hip/hip_runtime.h>
#include <hip/hip_cooperative_groups.h>
#include <cstdio>
#include <cstdint>
namespace cg = cooperative_groups;

#define LAS __attribute__((address_space(3)))
typedef unsigned short bf16_t;
typedef short bf16x8 __attribute__((ext_vector_type(8)));
typedef float f32x4 __attribute__((ext_vector_type(4)));
typedef unsigned u32x4 __attribute__((ext_vector_type(4)));
typedef unsigned u32x2 __attribute__((ext_vector_type(2)));

constexpr int BATCH = 8, SEQ = 4096, NMETA = 16, LEN = SEQ + NMETA, DM = 1024, DFF = 4096, DEPTH = 2;
constexpr int M_ROWS = BATCH * LEN;
constexpr int MP = 33024;
constexpr int N_IN = 5896;
constexpr int NCH16 = LEN / 16;
constexpr int S5ROWS = BATCH * NCH16;
constexpr int S5RP = 2304;
constexpr float EPS = 1e-6f;
constexpr int NTHREADS = 512, NWAVES = 8;

constexpr size_t QB = (size_t)MP * 256 * 2;
constexpr size_t WB_IN = 0;
constexpr size_t WB_G = WB_IN + (size_t)2816 * 1024;
constexpr size_t WB_P = WB_G + (size_t)3072 * 1024;
constexpr size_t WB_O = WB_P + (size_t)1024 * 1024;
constexpr size_t WB_1 = WB_O + (size_t)1024 * 1024;
constexpr size_t WB_2 = WB_1 + (size_t)4096 * 1024;
constexpr size_t WB_GLU = WB_2 + (size_t)1024 * 4096;
constexpr size_t WB_L1 = WB_GLU + (size_t)512 * 256;
constexpr size_t WB_L2 = WB_L1 + (size_t)512 * 512;
constexpr size_t WB_SX = WB_L2 + (size_t)1280 * 256;
constexpr size_t WB_SY = WB_SX + (size_t)16 * 256 * 256;
constexpr size_t WB_ELEMS = WB_SY + (size_t)16 * 256 * 512;
constexpr size_t WB_BYTES = WB_ELEMS * 2;
static_assert(WB_BYTES <= 5 * QB / 2, "weight block fits 2.5 Q");

constexpr size_t WS_H = 0;
constexpr size_t WS_WB0 = 4 * QB;
constexpr size_t WS_SMALL = 13 * QB / 2;
constexpr size_t WS_SSQ = WS_SMALL;
constexpr size_t WS_DT = WS_SSQ + (size_t)MP * 16 * 4;
constexpr size_t WS_DEC = WS_DT + (size_t)MP * 16 * 4;
static_assert(WS_DEC + (size_t)MP * 16 * 4 <= 7 * QB, "small region");
constexpr size_t WS_MIX = 7 * QB;
constexpr size_t WS_PXBC = WS_MIX;
constexpr size_t WS_YSSD = WS_MIX;
constexpr size_t WS_PARK = WS_MIX;
constexpr size_t WS_ACT = WS_MIX;
constexpr size_t WS_PRKVX = WS_MIX + 4 * QB;
constexpr size_t WS_L2O = WS_MIX + 4 * QB;
constexpr size_t WS_PZ = WS_MIX + 9 * QB;
constexpr size_t WS_UH = WS_MIX + 11 * QB;
constexpr size_t WS_X = WS_MIX + 53 * QB / 4;
constexpr size_t WS_YRW = WS_X;
constexpr size_t WS_L1IN = WS_MIX + 31 * QB / 2;
constexpr size_t WS_YAPRE = WS_L1IN;
constexpr size_t WS_L1O = WS_MIX + 35 * QB / 2;
constexpr size_t WS_YB = WS_L1O;
constexpr size_t WS_BC = WS_MIX + 39 * QB / 2;
constexpr size_t WS_YA = WS_BC;
constexpr size_t WS_YC = WS_BC + QB;
constexpr size_t WS_XS = WS_MIX + 43 * QB / 2;
constexpr size_t WS_END = WS_XS + 2 * QB;
static_assert(WS_END <= (size_t)512 << 20, "workspace map fits 512 MiB");
static_assert((size_t)16 * S5RP * 512 * 2 <= 9 * QB / 4 && (size_t)16 * S5RP * 256 * 4 <= 9 * QB / 4, "S5 buffers fit their slots");
static_assert((size_t)256 * 393216 <= 6 * QB, "gate park");
constexpr size_t DO_RKVP = 0;
constexpr size_t DO_MERGED = 0;
constexpr size_t DO_WB1 = 4 * QB;
static_assert(DO_WB1 + WB_BYTES <= (size_t)BATCH * SEQ * DM * 4, "d_out scratch map");

__device__ __forceinline__ unsigned f2bf(float f) { unsigned u = __builtin_bit_cast(unsigned, f); return (u + 0x7fffu + ((u >> 16) & 1u)) >> 16; }
typedef float f32x2_t_ __attribute__((ext_vector_type(2))); typedef __bf16 bf16x2_t_ __attribute__((ext_vector_type(2)));
__device__ __forceinline__ unsigned pk2(float lo, float hi) { const f32x2_t_ v = {lo, hi}; const bf16x2_t_ b = __builtin_convertvector(v, bf16x2_t_); return __builtin_bit_cast(unsigned, b); }
__device__ __forceinline__ float bflo(unsigned w) { return __builtin_bit_cast(float, w << 16); }
__device__ __forceinline__ float bfhi(unsigned w) { return __builtin_bit_cast(float, w & 0xffff0000u); }
__device__ __forceinline__ float bf1(bf16_t v) { return __builtin_bit_cast(float, (unsigned)v << 16); }
__device__ __forceinline__ float sigmoidf_(float x) { return 1.0f / (1.0f + __expf(-x)); }
__device__ __forceinline__ float siluf_(float x) { return x / (1.0f + __expf(-x)); }
__device__ __forceinline__ float tanhf_(float x) { x = fminf(fmaxf(x, -15.f), 15.f); const float t = __expf(2.f * x); return (t - 1.f) / (t + 1.f); }
__device__ __forceinline__ float softplusf_(float x) { return fmaxf(x, 0.f) + __logf(1.0f + __expf(-fabsf(x))); }
__device__ __forceinline__ float geluf_(float x) { const float u = 0.7978845608028654f * (x + 0.044715f * x * x * x); return 0.5f * x * (1.f + tanhf_(u)); }
__device__ __forceinline__ float wave_sum(float v) {
#pragma unroll
    for (int o = 1; o < 64; o <<= 1) v += __shfl_xor(v, o);
    return v;
}
__device__ __forceinline__ float sum16(float v) {
#pragma unroll
    for (int o = 1; o < 16; o <<= 1) v += __shfl_xor(v, o);
    return v;
}
template <int CTRL> __device__ __forceinline__ float dpp_mov(float x) {
    return __builtin_bit_cast(float, __builtin_amdgcn_update_dpp(0, __builtin_bit_cast(int, x), CTRL, 0xf, 0xf, true));
}
__device__ __forceinline__ float allred16(float x) {
    x += dpp_mov<0xB1>(x); x += dpp_mov<0x4E>(x); x += dpp_mov<0x141>(x); x += dpp_mov<0x140>(x); return x;
}
__device__ __forceinline__ void unpack8(const u32x4 w, float (&f)[8]) {
    f[0] = bflo(w.x); f[1] = bfhi(w.x); f[2] = bflo(w.y); f[3] = bfhi(w.y); f[4] = bflo(w.z); f[5] = bfhi(w.z); f[6] = bflo(w.w); f[7] = bfhi(w.w);
}
__device__ __forceinline__ u32x4 pack8(const float (&f)[8]) { u32x4 w; w.x = pk2(f[0], f[1]); w.y = pk2(f[2], f[3]); w.z = pk2(f[4], f[5]); w.w = pk2(f[6], f[7]); return w; }
__device__ __forceinline__ int opaque_tid(int) { int t = threadIdx.x; asm volatile("" : "+v"(t)); return t; }
__device__ __forceinline__ int row_of(int b, int t) { return t < NMETA ? BATCH * SEQ + b * NMETA + t : b * SEQ + (t - NMETA); }
__device__ __forceinline__ void bt_of(int m, int& b, int& t) { if (m < BATCH * SEQ) { b = m >> 12; t = NMETA + (m & (SEQ - 1)); } else { const int q = m - BATCH * SEQ; b = q >> 4; t = q & (NMETA - 1); } }
namespace pg8 {
constexpr int BM = 256, BK = 64, HALF = 128, HTB = HALF * BK * 2  , STAGE_BYTES = 8 * HTB;
__host__ __device__ __forceinline__ int lds_byte(int r, int c) { const int st = (r >> 4) * 2 + (c >> 5), rr = r & 15, cc = c & 31, ob = rr * 64 + cc * 2; return st * 1024 + (ob ^ (((ob >> 9) & 1) << 5)); }
__host__ __device__ __forceinline__ void stage_rc(int b, int& R, int& C) { const int st = b / 1024, sb = b % 1024, swz = sb ^ (((sb >> 9) & 1) << 5); R = (st >> 1) * 16 + swz / 64; C = (st & 1) * 32 + (swz % 64) / 2; }
__host__ __device__ __forceinline__ int perm32(int rho) { const int n = rho >> 4, i = rho & 15; return 8 * (i >> 2) + 4 * n + (i & 3); }

struct GU {
    const bf16_t* A;
    const bf16_t* B;
    int lda, ldb, nt;
    int pm, pn, kind;
};

template <bool SKIP_HI = false, class Epi, class Sched>
__device__ __forceinline__ void gemm_phase(LAS unsigned char* lds, int wave_s, const Sched& S, const Epi& E) {
    const int tid = opaque_tid(wave_s), wid = wave_s, lane = tid & 63, wr = wid >> 2, wc = wid & 3, fr = lane & 15, fq = lane >> 4;
#define PG8_VOFF(lda_, ldb_, a0, b0) do { int R0_, C0_; stage_rc(tid * 16, R0_, C0_); \
        a0 = (unsigned)(R0_ * (lda_) + C0_) * 2u; b0 = (unsigned)(((R0_ & ~31) + perm32(R0_ & 31)) * (ldb_) + C0_) * 2u; } while (0)
    const size_t kstep = (size_t)(BK * 2);
    const unsigned ldsw = (unsigned)wid * 1024u;
    const int aoff = lds_byte(wr * 64 + fr, fq * 8), boff = lds_byte(wc * 32 + fr, fq * 8);
#define PG8_SA(b, h) (((b) * 2 + (h)) * HTB)
#define PG8_SB(b, h) ((4 + (b) * 2 + (h)) * HTB)
#define PG8_STAGE(bufoff, gbase, v0, hs) do { \
        __builtin_amdgcn_global_load_lds((const unsigned*)((const char*)(gbase) + (v0)), (LAS unsigned*)(lds + (bufoff) + ldsw), 16, 0, 0); \
        __builtin_amdgcn_global_load_lds((const unsigned*)((const char*)(gbase) + ((hs) >> 1) + (v0)), (LAS unsigned*)(lds + (bufoff) + ldsw + 8192), 16, 0, 0); } while (0)
#define PG8_LDA(dst, b, h) do { _Pragma("unroll") for (int m = 0; m < 4; ++m) _Pragma("unroll") for (int k = 0; k < 2; ++k) dst[m][k] = *(const LAS bf16x8*)(lds + PG8_SA(b, h) + aoff + m * 2048 + k * 1024); } while (0)
#define PG8_LDB(dst, b, h) do { _Pragma("unroll") for (int n = 0; n < 2; ++n) _Pragma("unroll") for (int k = 0; k < 2; ++k) dst[n][k] = *(const LAS bf16x8*)(lds + PG8_SB(b, h) + boff + n * 2048 + k * 1024); } while (0)
#define PG8_MMA(ai, bj, At, Bt) do { __builtin_amdgcn_s_setprio(1); _Pragma("unroll") for (int m = 0; m < 4; ++m) _Pragma("unroll") for (int n = 0; n < 2; ++n) _Pragma("unroll") for (int k = 0; k < 2; ++k) \
        acc[ai][bj][m][n] = __builtin_amdgcn_mfma_f32_16x16x32_bf16(Bt[n][k], At[m][k], acc[ai][bj][m][n], 0, 0, 0); __builtin_amdgcn_s_setprio(0); } while (0)
#define PG8_WAIT_V(n) asm volatile("s_waitcnt vmcnt(" #n ")" ::: "memory")
#define PG8_WAIT_L(n) asm volatile("s_waitcnt lgkmcnt(" #n ")" ::: "memory")
#define PG8_BAR __builtin_amdgcn_s_barrier()
#define PG8_SCHED __builtin_amdgcn_sched_barrier(0)
    GU cur, nxt; int ui = 0;
    if (!S.next(0, cur)) return;
    f32x4 acc[2][2][4][2];
#pragma unroll
    for (int a = 0; a < 2; ++a)
#pragma unroll
        for (int b = 0; b < 2; ++b)
#pragma unroll
            for (int m = 0; m < 4; ++m)
#pragma unroll
                for (int n = 0; n < 2; ++n) acc[a][b][m][n] = (f32x4){0.f, 0.f, 0.f, 0.f};
    bf16x8 At[4][2], B0[2][2], B1[2][2];
    const char* cA = (const char*)cur.A; const char* cB = (const char*)cur.B;
    unsigned vA0, vB0; PG8_VOFF(cur.lda, cur.ldb, vA0, vB0);
    size_t hsA = (size_t)HALF * cur.lda * 2, hsB = (size_t)HALF * cur.ldb * 2;
    int nt = cur.nt; asm volatile("" : "+s"(nt));
    PG8_STAGE(PG8_SB(0, 0), cB, vB0, hsB); PG8_STAGE(PG8_SB(0, 1), cB + hsB, vB0, hsB); PG8_STAGE(PG8_SA(0, 0), cA, vA0, hsA); PG8_STAGE(PG8_SA(0, 1), cA + hsA, vA0, hsA);
    if (wr == 1) PG8_BAR;
    PG8_WAIT_V(2); PG8_BAR;
    PG8_STAGE(PG8_SB(1, 0), cB + kstep, vB0, hsB); PG8_STAGE(PG8_SA(1, 0), cA + kstep, vA0, hsA); PG8_STAGE(PG8_SB(1, 1), cB + hsB + kstep, vB0, hsB);
    PG8_WAIT_V(6); PG8_BAR;
    for (;;) {
        const bool has_next = S.next(ui + 1, nxt);
        const char* nA = has_next ? (const char*)nxt.A : cA; const char* nB = has_next ? (const char*)nxt.B : cB;
        unsigned nvA0 = vA0, nvB0 = vB0;
        if (has_next) PG8_VOFF(nxt.lda, nxt.ldb, nvA0, nvB0);
        const size_t nhsA = has_next ? (size_t)HALF * nxt.lda * 2 : hsA, nhsB = has_next ? (size_t)HALF * nxt.ldb * 2 : hsB;
        for (int t = 0; t < nt; t += 2) {
            const bool last = (t == nt - 2);
            const char* a1 = cA + (size_t)(t + 1) * kstep;
            const char* a2 = last ? nA : cA + (size_t)(t + 2) * kstep; const char* b2 = last ? nB : cB + (size_t)(t + 2) * kstep;
            const char* a3 = a2 + kstep; const char* b3 = b2 + kstep;
            const unsigned xA0 = last ? nvA0 : vA0, xB0 = last ? nvB0 : vB0;
            const size_t xhA = last ? nhsA : hsA, xhB = last ? nhsB : hsB;
            PG8_LDB(B0, 0, 0); PG8_LDB(B1, 0, 1); PG8_SCHED; PG8_LDA(At, 0, 0); PG8_STAGE(PG8_SA(1, 1), a1 + hsA, vA0, hsA);
            PG8_WAIT_V(8); PG8_WAIT_L(0); PG8_BAR; PG8_MMA(0, 0, At, B0); PG8_MMA(0, 1, At, B1); PG8_BAR; PG8_SCHED;
            PG8_LDA(At, 0, 1); PG8_STAGE(PG8_SB(0, 0), b2, xB0, xhB); PG8_STAGE(PG8_SB(0, 1), b2 + xhB, xB0, xhB); PG8_STAGE(PG8_SA(0, 0), a2, xA0, xhA);
            PG8_WAIT_V(8); PG8_WAIT_L(0); PG8_BAR; if constexpr (!SKIP_HI) { PG8_MMA(1, 0, At, B0); PG8_MMA(1, 1, At, B1); } PG8_BAR; PG8_SCHED;
            PG8_LDB(B0, 1, 0); PG8_LDB(B1, 1, 1); PG8_SCHED; PG8_LDA(At, 1, 0); PG8_STAGE(PG8_SA(0, 1), a2 + xhA, xA0, xhA);
            PG8_WAIT_V(8); PG8_WAIT_L(0); PG8_BAR; PG8_MMA(0, 0, At, B0); PG8_MMA(0, 1, At, B1); PG8_BAR; PG8_SCHED;
            PG8_LDA(At, 1, 1); PG8_STAGE(PG8_SB(1, 0), b3, xB0, xhB); PG8_STAGE(PG8_SB(1, 1), b3 + xhB, xB0, xhB); PG8_STAGE(PG8_SA(1, 0), a3, xA0, xhA);
            PG8_WAIT_V(8); PG8_WAIT_L(0); PG8_BAR; if constexpr (!SKIP_HI) { PG8_MMA(1, 0, At, B0); PG8_MMA(1, 1, At, B1); } PG8_BAR; PG8_SCHED;
        }
        if (wr == 0) PG8_BAR;
        const bool keep = E(acc, cur, wr, wc, fr, fq);
        if (!has_next) break;
        if (!keep) {
#pragma unroll
            for (int a = 0; a < 2; ++a)
#pragma unroll
                for (int b = 0; b < 2; ++b)
#pragma unroll
                    for (int m = 0; m < 4; ++m)
#pragma unroll
                        for (int n = 0; n < 2; ++n) acc[a][b][m][n] = (f32x4){0.f, 0.f, 0.f, 0.f};
        }
        cur = nxt; cA = nA; cB = nB; vA0 = nvA0; vB0 = nvB0; hsA = nhsA; hsB = nhsB; nt = cur.nt; asm volatile("" : "+s"(nt)); ++ui;
        if (wr == 1) PG8_BAR;
    }
    PG8_WAIT_V(0);
    PG8_BAR;
#undef PG8_VOFF
#undef PG8_SA
#undef PG8_SB
#undef PG8_STAGE
#undef PG8_LDA
#undef PG8_LDB
#undef PG8_MMA
#undef PG8_WAIT_V
#undef PG8_WAIT_L
#undef PG8_BAR
#undef PG8_SCHED
}

__device__ __forceinline__ bool tile_order(int i, int G, int c, int nM, int nN, int& pm, int& pn) {
    const int nwg = nM * nN; const long L = (long)i * G + c; if (L >= nwg) return false;
    int wgid = (int)L; { const int q = nwg / 8, r = nwg % 8, xcd = wgid % 8, off = wgid / 8; wgid = (xcd < r ? xcd * (q + 1) : r * (q + 1) + (xcd - r) * q) + off; }
    const int nig = 8 * nN, gid = wgid / nig, fm = gid * 8, gsz = (nM - fm) < 8 ? (nM - fm) : 8;
    pm = fm + ((wgid % nig) % gsz); pn = (wgid % nig) / gsz; return true;
}
}
using pg8::GU;
enum InIdx { I_X = 0, I_META, I_FNW, I_MIXNW, I_WIN, I_S5LRE, I_S5LIM, I_S5LS, I_S5BRE, I_S5BIM, I_S5CRE, I_S5CIM, I_S5D, I_GLUW, I_GLUB,
             I_CONVW, I_CONVB, I_ALOG, I_DTB, I_SSDD, I_SSDNW, I_MURKV, I_MUWAG, I_W0, I_W1, I_W2, I_A0, I_A1, I_A2, I_G1, I_G2, I_KK, I_KA, I_RK, I_LNW, I_LNB,
             I_PA, I_PB, I_PC, I_WOUT, I_MLPNW, I_MLPW1, I_MLPW2, N_INPUTS };
struct Params { const float* in[N_INPUTS]; float* out; unsigned char* ws; int ph_lo, ph_hi; };

struct Ctx {
    const float* const* in; unsigned char* ws; unsigned char* dout;
    LAS unsigned char* lds;
    int tid, lane, wave, G, bid;
    __device__ __forceinline__ bf16_t* wb(int layer) const { return (bf16_t*)(layer == 0 ? ws + WS_WB0 : dout + DO_WB1); }
    __device__ __forceinline__ bf16_t* H() const { return (bf16_t*)(ws + WS_H); }
    __device__ __forceinline__ float* ssq() const { return (float*)(ws + WS_SSQ); }
};
__device__ __forceinline__ Ctx relaunder(const Ctx& c0) {
    Ctx c = c0; c.tid = opaque_tid(c0.wave); c.lane = c.tid & 63;
    return c;
}
__device__ __forceinline__ float row_scale(const float* ssq, int row) {
    const f32x4* p = (const f32x4*)(ssq + (size_t)row * 16);
    const f32x4 a = p[0], b = p[1], c = p[2], d = p[3];
    const float s = ((a.x + a.y) + (a.z + a.w)) + ((b.x + b.y) + (b.z + b.w)) + ((c.x + c.y) + (c.z + c.w)) + ((d.x + d.y) + (d.z + d.w));
    return __builtin_amdgcn_rsqf(s * (1.0f / DM) + EPS);
}

struct SchedPlain {
    const bf16_t* A; const bf16_t* B; int lda, ldb, K, nM, nN, G, c, pm0;
    __device__ __forceinline__ bool next(int i, GU& u) const {
        int pm, pn; if (!pg8::tile_order(i, G, c, nM, nN, pm, pn)) return false;
        pm += pm0;
        u.A = A + (size_t)pm * 256 * lda; u.B = B + (size_t)pn * 256 * ldb; u.lda = lda; u.ldb = ldb; u.nt = K / 64; u.pm = pm; u.pn = pn; u.kind = 0; return true;
    }
};
struct SchedS5 {
    const bf16_t* UH; const bf16_t* W; int K, G, c;
    __device__ __forceinline__ bool next(int i, GU& u) const {
        const int L = i * G + c; if (L >= 144) return false;
        const int g = L / 9, pm = L % 9;
        u.A = UH + ((size_t)g * S5RP + (size_t)pm * 256) * 512; u.B = W + (size_t)g * 256 * K; u.lda = 512; u.ldb = K; u.nt = K / 64; u.pm = pm; u.pn = 0; u.kind = g; return true;
    }
};
struct SchedL2 {
    const bf16_t* L1o; const bf16_t* W; int G, c, nM, pm0;
    __device__ __forceinline__ bool next(int i, GU& u) const {
        int pm, pn; if (!pg8::tile_order(i, G, c, nM, 5, pm, pn)) return false;
        pm += pm0;
        const int koff = pn < 2 ? 0 : (pn < 4 ? 128 : 256);
        u.A = L1o + (size_t)pm * 256 * 512 + koff; u.B = W + (size_t)pn * 256 * 256; u.lda = 512; u.ldb = 256; u.nt = 4; u.pm = pm; u.pn = pn; u.kind = 0; return true;
    }
};
struct SchedProj {
    const bf16_t* Hb; const bf16_t* Wg; const bf16_t* Wp; const bf16_t* ya; const bf16_t* yb; const bf16_t* yc; int nM, G, c, pm0;
    __device__ __forceinline__ bool next(int i, GU& u) const {
        const int ti = i / 6, sub = i - ti * 6; int pm, pn;
        if (!pg8::tile_order(ti, G, c, nM, 4, pm, pn)) return false;
        pm += pm0;
        u.pm = pm; u.pn = pn; u.kind = sub;
        if (sub < 3) { u.A = Hb + (size_t)pm * 256 * DM; u.lda = DM; u.B = Wg + ((size_t)sub * 1024 + (size_t)pn * 256) * DM; u.ldb = DM; u.nt = 16; }
        else if (sub == 3) { u.A = ya + (size_t)pm * 256 * 256; u.lda = 256; u.B = Wp + (size_t)pn * 256 * DM; u.ldb = DM; u.nt = 4; }
        else if (sub == 4) { u.A = yb + (size_t)pm * 256 * 512; u.lda = 512; u.B = Wp + (size_t)pn * 256 * DM + 256; u.ldb = DM; u.nt = 8; }
        else { u.A = yc + (size_t)pm * 256 * 256; u.lda = 256; u.B = Wp + (size_t)pn * 256 * DM + 768; u.ldb = DM; u.nt = 4; }
        return true;
    }
};

typedef f32x4 Acc[2][2][4][2];
#define EPI_ROWS_BEGIN  _Pragma("unroll") for (int ai = 0; ai < 2; ++ai) _Pragma("unroll") for (int m = 0; m < 4; ++m) { const int rl = ai * 128 + wr * 64 + m * 16 + fr; const int row = u.pm * 256 + rl; (void)rl;
#define EPI_ROWS_END    asm volatile("" ::: "memory"); }
#define EPI_COL(bj) ((bj) * 128 + wc * 32 + fq * 8)

struct EpiInProj {
    const float* ssq; bf16_t* UH; bf16_t* Pz; bf16_t* Pxbc; bf16_t* Prkvx;
    __device__ __forceinline__ bool operator()(Acc& acc, const GU& u, int wr, int wc, int fr, int fq) const {
        EPI_ROWS_BEGIN
            if (row < M_ROWS) {
                const float s = row_scale(ssq, row);
                int b, t; bt_of(row, b, t);
#pragma unroll
                for (int bj = 0; bj < 2; ++bj) {
                    const int col = EPI_COL(bj);
                    const f32x4 v0 = acc[ai][bj][m][0] * s, v1 = acc[ai][bj][m][1] * s;
                    u32x4 w; w.x = pk2(v0[0], v0[1]); w.y = pk2(v0[2], v0[3]); w.z = pk2(v1[0], v1[1]); w.w = pk2(v1[2], v1[3]);
                    bf16_t* dst;
                    if (u.pn == 0) { const int g = col >> 4, hh = col & 15; dst = UH + ((size_t)g * S5RP + (size_t)(b * NCH16 + (t >> 4))) * 512 + (t & 15) * 16 + hh; }
                    else if (u.pn < 3) dst = Pz + (size_t)row * 512 + (u.pn - 1) * 256 + col;
                    else if (u.pn < 7) dst = Pxbc + (size_t)row * 1024 + (u.pn - 3) * 256 + col;
                    else dst = Prkvx + (size_t)row * 1024 + (u.pn - 7) * 256 + col;
                    *(u32x4*)dst = w;
                }
            }
        EPI_ROWS_END
        return false;
    }
};
struct EpiS5X {
    float* X;
    __device__ __forceinline__ bool operator()(Acc& acc, const GU& u, int wr, int wc, int fr, int fq) const {
        EPI_ROWS_BEGIN
            float* rp = X + ((size_t)u.kind * S5RP + row) * 256;
#pragma unroll
            for (int bj = 0; bj < 2; ++bj) { const int col = EPI_COL(bj); *(f32x4*)(rp + col) = acc[ai][bj][m][0]; *(f32x4*)(rp + col + 4) = acc[ai][bj][m][1]; }
        EPI_ROWS_END
        return false;
    }
};
struct EpiS5Y {
    bf16_t* yapre;
    __device__ __forceinline__ bool operator()(Acc& acc, const GU& u, int wr, int wc, int fr, int fq) const {
        EPI_ROWS_BEGIN
            if (row < S5ROWS) {
                const int b = row / NCH16, c = row - b * NCH16;
#pragma unroll
                for (int bj = 0; bj < 2; ++bj) {
                    const int col = EPI_COL(bj), i = col >> 4, hh = col & 15;
                    const f32x4 v0 = acc[ai][bj][m][0], v1 = acc[ai][bj][m][1];
                    u32x4 w; w.x = pk2(geluf_(v0[0]), geluf_(v0[1])); w.y = pk2(geluf_(v0[2]), geluf_(v0[3])); w.z = pk2(geluf_(v1[0]), geluf_(v1[1])); w.w = pk2(geluf_(v1[2]), geluf_(v1[3]));
                    *(u32x4*)(yapre + (size_t)row_of(b, c * 16 + i) * 256 + u.kind * 16 + hh) = w;
                }
            }
        EPI_ROWS_END
        return false;
    }
};
struct EpiL1 {
    bf16_t* L1o;
    __device__ __forceinline__ bool operator()(Acc& acc, const GU& u, int wr, int wc, int fr, int fq) const {
        EPI_ROWS_BEGIN
#pragma unroll
            for (int bj = 0; bj < 2; ++bj) {
                const int col = EPI_COL(bj); const int mode = u.pn * 2 + bj;
                f32x4 v0 = acc[ai][bj][m][0], v1 = acc[ai][bj][m][1]; float f[8] = {v0[0], v0[1], v0[2], v0[3], v1[0], v1[1], v1[2], v1[3]};
#pragma unroll
                for (int e = 0; e < 8; ++e) f[e] = mode == 0 ? tanhf_(f[e]) : (mode == 1 ? f[e] : (mode == 2 ? sigmoidf_(f[e]) : 0.f));
                *(u32x4*)(L1o + (size_t)row * 512 + u.pn * 256 + col) = pack8(f);
            }
        EPI_ROWS_END
        return false;
    }
};
struct EpiL2 {
    bf16_t* L2o; const float* w0; const float* a0;
    __device__ __forceinline__ bool operator()(Acc& acc, const GU& u, int wr, int wc, int fr, int fq) const {
        EPI_ROWS_BEGIN
#pragma unroll
            for (int bj = 0; bj < 2; ++bj) {
                const int col = EPI_COL(bj);
                f32x4 v0 = acc[ai][bj][m][0], v1 = acc[ai][bj][m][1]; float f[8] = {v0[0], v0[1], v0[2], v0[3], v1[0], v1[1], v1[2], v1[3]};
                if (u.pn < 2) {
                    const float* bp = w0 + u.pn * 256 + col;
#pragma unroll
                    for (int e = 0; e < 8; ++e) { const float v = bp[e] + f[e]; f[e] = -__expf(-softplusf_(-v) - 0.5f); }
                } else if (u.pn < 4) {
                    const float* bp = a0 + (u.pn - 2) * 256 + col;
#pragma unroll
                    for (int e = 0; e < 8; ++e) f[e] = sigmoidf_(bp[e] + f[e]);
                }
                *(u32x4*)(L2o + (size_t)row * 1280 + u.pn * 256 + col) = pack8(f);
            }
        EPI_ROWS_END
        return false;
    }
};
struct EpiGLU {
    bf16_t* ya; const float* bias;
    __device__ __forceinline__ bool operator()(Acc& acc, const GU& u, int wr, int wc, int fr, int fq) const {
        const int lc = wc * 32 + fq * 8, oc = u.pn * 128 + lc;
        float bv[8], bg[8];
#pragma unroll
        for (int e = 0; e < 8; ++e) { bv[e] = bias[oc + e]; bg[e] = bias[256 + oc + e]; }
        EPI_ROWS_BEGIN
            const f32x4 a0 = acc[ai][0][m][0], a1 = acc[ai][0][m][1], g0 = acc[ai][1][m][0], g1 = acc[ai][1][m][1];
            float v[8] = {a0[0], a0[1], a0[2], a0[3], a1[0], a1[1], a1[2], a1[3]}, g[8] = {g0[0], g0[1], g0[2], g0[3], g1[0], g1[1], g1[2], g1[3]};
#pragma unroll
            for (int e = 0; e < 8; ++e) v[e] = (v[e] + bv[e]) * sigmoidf_(g[e] + bg[e]);
            *(u32x4*)(ya + (size_t)row * 256 + oc) = pack8(v);
        EPI_ROWS_END
        return false;
    }
};
struct EpiProj {
    const float* ssq; const float* ssqb; unsigned char* park; bf16_t* merged; int tid;
    __device__ __forceinline__ bool operator()(Acc& acc, const GU& u, int wr, int wc, int fr, int fq) const {
        const int k = u.kind;
        EPI_ROWS_BEGIN
            float s = 1.f; if (k < 3) s = row_scale(ssq, row < M_ROWS ? row : 0);
            else if (k < 5) { s = __builtin_amdgcn_rsqf(ssqb[row < M_ROWS ? row : 0] * (1.0f / 512.f) + EPS); if (k == 3) s = __builtin_amdgcn_rcpf(s); }
#pragma unroll
            for (int bj = 0; bj < 2; ++bj) {
                const int q = (ai * 2 + bj) * 4 + m;
                f32x4& v0 = acc[ai][bj][m][0]; f32x4& v1 = acc[ai][bj][m][1];
                if (k < 3) {
                    float f[8] = {v0[0], v0[1], v0[2], v0[3], v1[0], v1[1], v1[2], v1[3]};
#pragma unroll
                    for (int e = 0; e < 8; ++e) f[e] = sigmoidf_(f[e] * s);
                    *(u32x4*)(park + ((size_t)(k * 16 + q) * NTHREADS + tid) * 16) = pack8(f);
                } else {
                    float num[8], den[8];
                    unpack8(*(const u32x4*)(park + ((size_t)((k - 3) * 16 + q) * NTHREADS + tid) * 16), num);
                    if (k < 5) { unpack8(*(const u32x4*)(park + ((size_t)((k - 2) * 16 + q) * NTHREADS + tid) * 16), den);
#pragma unroll
                        for (int e = 0; e < 8; ++e) num[e] = num[e] * __builtin_amdgcn_rcpf(den[e]) * s; }
                    v0[0] *= num[0]; v0[1] *= num[1]; v0[2] *= num[2]; v0[3] *= num[3]; v1[0] *= num[4]; v1[1] *= num[5]; v1[2] *= num[6]; v1[3] *= num[7];
                    if (k == 5) { u32x4 w; w.x = pk2(v0[0], v0[1]); w.y = pk2(v0[2], v0[3]); w.z = pk2(v1[0], v1[1]); w.w = pk2(v1[2], v1[3]);
                        *(u32x4*)(merged + (size_t)row * DM + u.pn * 256 + EPI_COL(bj)) = w; }
                }
            }
        EPI_ROWS_END
        return k == 3 || k == 4;
    }
};
struct EpiResid {
    bf16_t* H; float* ssq;
    __device__ __forceinline__ bool operator()(Acc& acc, const GU& u, int wr, int wc, int fr, int fq) const {
        EPI_ROWS_BEGIN
            float ss = 0.f;
            if (row < M_ROWS) {
#pragma unroll
                for (int bj = 0; bj < 2; ++bj) {
                    bf16_t* hp = H + (size_t)row * DM + u.pn * 256 + EPI_COL(bj);
                    float f[8]; unpack8(*(const u32x4*)hp, f);
                    const f32x4 v0 = acc[ai][bj][m][0], v1 = acc[ai][bj][m][1];
                    f[0] += v0[0]; f[1] += v0[1]; f[2] += v0[2]; f[3] += v0[3]; f[4] += v1[0]; f[5] += v1[1]; f[6] += v1[2]; f[7] += v1[3];
#pragma unroll
                    for (int e = 0; e < 8; ++e) ss += f[e] * f[e];
                    *(u32x4*)hp = pack8(f);
                }
            }
            ss += __shfl_xor(ss, 16); ss += __shfl_xor(ss, 32);
            if (fq == 0 && row < M_ROWS) ssq[(size_t)row * 16 + u.pn * 4 + wc] = ss;
        EPI_ROWS_END
        return false;
    }
};
struct EpiUp {
    const float* ssq; bf16_t* act;
    __device__ __forceinline__ bool operator()(Acc& acc, const GU& u, int wr, int wc, int fr, int fq) const {
        EPI_ROWS_BEGIN
            const float s = row_scale(ssq, row < M_ROWS ? row : 0);
#pragma unroll
            for (int bj = 0; bj < 2; ++bj) {
                const f32x4 v0 = acc[ai][bj][m][0] * s, v1 = acc[ai][bj][m][1] * s; float f[8] = {v0[0], v0[1], v0[2], v0[3], v1[0], v1[1], v1[2], v1[3]};
#pragma unroll
                for (int e = 0; e < 8; ++e) { const float r = fmaxf(f[e], 0.f); f[e] = r * r; }
                *(u32x4*)(act + (size_t)row * DFF + u.pn * 256 + EPI_COL(bj)) = pack8(f);
            }
        EPI_ROWS_END
        return false;
    }
};
typedef __attribute__((address_space(1))) unsigned gu32;
#define XB_TMO      128
#define XB_XCNT(j)  (256  + 64 * (j))
#define XB_XSUB(j)  (1280 + 64 * (j))
#define XB_XGEN(j)  (2304 + 64 * (j))
#define XB_TOP      3328
#define XB_TOPGEN   3392
#define XCD_BAR_WORDS 3456
#define XB_SPIN_CAP (1u << 18)

__device__ __forceinline__ unsigned xb_ld(unsigned* p)              { return __hip_atomic_load(p, __ATOMIC_RELAXED, __HIP_MEMORY_SCOPE_AGENT); }
__device__ __forceinline__ unsigned xb_add(unsigned* p, unsigned v) { return __hip_atomic_fetch_add(p, v, __ATOMIC_RELAXED, __HIP_MEMORY_SCOPE_AGENT); }
__device__ __forceinline__ unsigned xb_xcc_id() { return (unsigned)__builtin_amdgcn_s_getreg((3 << 11) | 20) & 0xFu; }
#define XB_SPIN(cond, bar) do { unsigned _sp = 0; while (cond) { __builtin_amdgcn_s_sleep(1); \
    if ((++_sp & 255u) == 0u) { if (xb_ld(&(bar)[XB_TMO])) break; if (_sp > XB_SPIN_CAP) { atomicAdd(&(bar)[XB_TMO], 1u); break; } } } } while (0)

struct XcdBarrier {
    unsigned* bar; unsigned x;
    volatile LAS unsigned* st;
};

__device__ __forceinline__ XcdBarrier xcd_barrier_post(unsigned* bar, volatile LAS unsigned* st) {
    XcdBarrier b; b.bar = bar; b.x = xb_xcc_id(); b.st = st;
    if (threadIdx.x == 0) (void)xb_add(&bar[XB_XCNT(b.x)], 1u);
    return b;
}
__device__ __forceinline__ void xcd_barrier_complete(unsigned* bar, unsigned x, unsigned& nloc, unsigned& nx) {
    const unsigned G = gridDim.x * gridDim.y * gridDim.z;
    unsigned sum, cnt, mine, sp = 0u;
    for (;;) {
        sum = 0u; cnt = 0u; mine = 0u;
#pragma unroll
        for (unsigned j = 0; j < 16; ++j) { const unsigned c = xb_ld(&bar[XB_XCNT(j)]); sum += c; cnt += (c > 0u) ? 1u : 0u; mine = (j == x) ? c : mine; }
        if (sum == G) break;
        __builtin_amdgcn_s_sleep(1);
        if ((++sp & 255u) == 0u) { if (xb_ld(&bar[XB_TMO])) break; if (sp > XB_SPIN_CAP) { atomicAdd(&bar[XB_TMO], 1u); break; } }
    }
    nloc = mine > 0u ? mine : 1u; nx = cnt > 0u ? cnt : 1u;
}

__device__ __forceinline__ void xcd_barrier(const XcdBarrier& b, int wave_s) {
    const bool xb_t0 = threadIdx.x == 0; (void)wave_s;
    asm volatile("s_waitcnt vmcnt(0)" ::: "memory");
    __syncthreads();
    if (xb_t0) {
        unsigned* bar = b.bar;
        __builtin_amdgcn_s_waitcnt(0);
        unsigned nloc = b.st[0], nx = b.st[1];
        if (nloc == 0u) { xcd_barrier_complete(bar, b.x, nloc, nx); b.st[0] = nloc; b.st[1] = nx; }
        const unsigned old = xb_add(&bar[XB_XSUB(b.x)], 1u);
        const unsigned gen = old / nloc;
        if (old + 1u == (gen + 1u) * nloc) {
            __builtin_amdgcn_fence(__ATOMIC_RELEASE, "agent");
            asm volatile("s_waitcnt vmcnt(0)" ::: "memory");
            const unsigned og = xb_add(&bar[XB_TOP], 1u);
            const unsigned tg = og / nx;
            if (og + 1u == (tg + 1u) * nx) xb_add(&bar[XB_TOPGEN], 1u);
            else XB_SPIN(xb_ld(&bar[XB_TOPGEN]) == tg, bar);
            __builtin_amdgcn_fence(__ATOMIC_ACQUIRE, "agent");
            xb_add(&bar[XB_XGEN(b.x)], 1u);
            asm volatile("s_waitcnt vmcnt(0)" ::: "memory");
        } else {
            XB_SPIN(xb_ld(&bar[XB_XGEN(b.x)]) == gen, bar);
            __builtin_amdgcn_fence(__ATOMIC_ACQUIRE, "agent");
            asm volatile("s_waitcnt vmcnt(0)" ::: "memory");
        }
    }
    __syncthreads();
}

struct TJob { const float* src; int ld, col0, K, N; bf16_t* dst; int dld, dk0, rmode, row0; const float* ksc; };
constexpr int N_TJOBS = 27;
__device__ __forceinline__ void get_tjob(const Ctx& c, int l, int j, TJob& t) {
    bf16_t* wb = c.wb(l);
    const float* win = c.in[I_WIN] + (size_t)l * DM * N_IN;
    t.rmode = 0; t.ksc = nullptr; t.dk0 = 0; t.col0 = 0; t.row0 = 0;
    if (j < 5) {
        t.src = win; t.ld = N_IN; t.K = DM; t.dld = DM; t.ksc = c.in[I_MIXNW] + l * DM; t.dst = wb + WB_IN;
        if (j == 0) { t.col0 = 0; t.N = 256; t.row0 = 0; }
        else if (j == 1) { t.col0 = 256; t.N = 512; t.row0 = 256; }
        else if (j == 2) { t.col0 = 768; t.N = 1024; t.row0 = 768; }
        else if (j == 3) { t.col0 = 1800; t.N = 1024; t.row0 = 1792; }
        else { t.col0 = 2824; t.N = 3072; t.row0 = 0; t.dst = wb + WB_G; }
    } else if (j == 5) { t.src = c.in[I_PA] + (size_t)l * 256 * DM; t.ld = DM; t.K = 256; t.N = DM; t.dst = wb + WB_P; t.dld = DM; t.dk0 = 0; }
    else if (j == 6) { t.src = c.in[I_PB] + (size_t)l * 512 * DM; t.ld = DM; t.K = 512; t.N = DM; t.dst = wb + WB_P; t.dld = DM; t.dk0 = 256; t.ksc = c.in[I_SSDNW] + (size_t)l * 512; }
    else if (j == 7) { t.src = c.in[I_PC] + (size_t)l * 256 * DM; t.ld = DM; t.K = 256; t.N = DM; t.dst = wb + WB_P; t.dld = DM; t.dk0 = 768; }
    else if (j == 8) { t.src = c.in[I_WOUT] + (size_t)l * DM * DM; t.ld = DM; t.K = DM; t.N = DM; t.dst = wb + WB_O; t.dld = DM; }
    else if (j == 9) { t.src = c.in[I_MLPW1] + (size_t)l * DM * DFF; t.ld = DFF; t.K = DM; t.N = DFF; t.dst = wb + WB_1; t.dld = DM; t.ksc = c.in[I_MLPNW] + l * DM; }
    else if (j == 10) { t.src = c.in[I_MLPW2] + (size_t)l * DFF * DM; t.ld = DM; t.K = DFF; t.N = DM; t.dst = wb + WB_2; t.dld = DFF; }
    else if (j == 11) { t.src = c.in[I_GLUW] + (size_t)l * 256 * 512; t.ld = 512; t.K = 256; t.N = 512; t.dst = wb + WB_GLU; t.dld = 256; t.rmode = 1; }
    else if (j < 22) {
        const int q = j - 12;
        t.K = 256; t.dst = wb + WB_L1; t.dld = 512;
        if (q < 4) { const int d = q >> 1, hf = q & 1; t.src = c.in[I_W1] + ((size_t)l * 2 + d) * 256 * 64; t.ld = 64; t.N = 64; t.row0 = d * 64; t.dk0 = hf * 256; if (hf) t.ksc = c.in[I_MUWAG] + ((size_t)l * 3 + 0) * 256; }
        else if (q < 8) { const int d = (q - 4) >> 1, hf = q & 1; t.src = c.in[I_A1] + ((size_t)l * 2 + d) * 256 * 64; t.ld = 64; t.N = 64; t.row0 = 128 + d * 64; t.dk0 = hf * 256; if (hf) t.ksc = c.in[I_MUWAG] + ((size_t)l * 3 + 1) * 256; }
        else { const int hf = q & 1; t.src = c.in[I_G1] + (size_t)l * 256 * 128; t.ld = 128; t.N = 128; t.row0 = 256; t.dk0 = hf * 256; if (hf) t.ksc = c.in[I_MUWAG] + ((size_t)l * 3 + 2) * 256; }
    } else {
        const int q = j - 22;
        t.dst = wb + WB_L2; t.dld = 256; t.ld = 256; t.N = 256;
        if (q < 2) { t.src = c.in[I_W2] + ((size_t)l * 2 + q) * 64 * 256; t.K = 64; t.row0 = q * 256; t.dk0 = q * 64; }
        else if (q < 4) { const int d = q - 2; t.src = c.in[I_A2] + ((size_t)l * 2 + d) * 64 * 256; t.K = 64; t.row0 = (2 + d) * 256; t.dk0 = d * 64; }
        else { t.src = c.in[I_G2] + (size_t)l * 128 * 256; t.K = 128; t.row0 = 4 * 256; t.dk0 = 0; }
    }
}
__device__ __forceinline__ int tjob_items(const TJob& t) { return (t.K / 64) * (t.N / 32); }
__device__ __forceinline__ void transpose_item(const TJob& t, LAS float* scr, int item, int lane) {
    const int nblk = t.N / 32, kb = item / nblk, nb = item % nblk, k0 = 64 * kb, n0 = 32 * nb;
#pragma unroll 8
    for (int i = 0; i < 32; ++i) { const int kk = 2 * i + (lane >> 5); float v = t.src[(size_t)(k0 + kk) * t.ld + t.col0 + n0 + (lane & 31)]; if (t.ksc) v *= t.ksc[k0 + kk]; scr[kk * 33 + (lane & 31)] = v; }
    asm volatile("s_waitcnt lgkmcnt(0)" ::: "memory");
    const int cc = lane & 7;
#pragma unroll
    for (int j = 0; j < 4; ++j) {
        const int n = (lane >> 3) + 8 * j; const LAS float* s = scr + (8 * cc) * 33 + n;
        u32x4 o; o.x = pk2(s[0 * 33], s[1 * 33]); o.y = pk2(s[2 * 33], s[3 * 33]); o.z = pk2(s[4 * 33], s[5 * 33]); o.w = pk2(s[6 * 33], s[7 * 33]);
        const int nn = n0 + n; int drow;
        if (t.rmode == 0) drow = t.row0 + nn; else drow = nn < 256 ? (nn >> 7) * 256 + (nn & 127) : ((nn - 256) >> 7) * 256 + 128 + ((nn - 256) & 127);
        *(u32x4*)(t.dst + (size_t)drow * t.dld + t.dk0 + k0 + 8 * cc) = o;
    }
    asm volatile("s_waitcnt lgkmcnt(0)" ::: "memory");
}

__device__ __forceinline__ void s5_build(const Ctx& cx_, int l, int g, int part) {
    const Ctx c = relaunder(cx_);
    LAS float* F = (LAS float*)c.lds;
    LAS float* pwr = F;
    LAS float* pwi = pwr + 2176;
    LAS float* cor = pwi + 2176;
    LAS float* coi = cor + 128;
    LAS float* Cr = coi + 128;
    LAS float* Ci = Cr + 1024;
    LAS float* Br = Ci + 1024;
    LAS float* Bi = Br + 1024;
    LAS float* kr = Bi + 1024;
    LAS float* ki = kr + 1984;
    LAS float* Kd = ki + 1984;
    const int tid = c.tid;
    if (tid < 128) {
        const int d = tid >> 6, n = tid & 63; const size_t li_ = (((size_t)l * 2 + d) * 16 + g) * 64 + n;
        const float lr = c.in[I_S5LRE][li_], li = c.in[I_S5LIM][li_], step = expf(c.in[I_S5LS][((size_t)l * 2 + d) * 16 + g]);
        for (int k = 0; k <= 16; ++k) { const float mag = expf((float)k * lr * step), ang = (float)k * li * step; float sn, cs; sincosf(ang, &sn, &cs); pwr[(d * 17 + k) * 64 + n] = mag * cs; pwi[(d * 17 + k) * 64 + n] = mag * sn; }
        const float mag1 = expf(lr * step); float sn, cs; sincosf(li * step, &sn, &cs); const float abr = mag1 * cs, abi = mag1 * sn, den = lr * lr + li * li;
        cor[d * 64 + n] = ((abr - 1.f) * lr + abi * li) / den; coi[d * 64 + n] = (abi * lr - (abr - 1.f) * li) / den;
    }
    for (int i = tid; i < 1024; i += NTHREADS) {
        Cr[i] = c.in[I_S5CRE][((size_t)l * 16 + g) * 1024 + i]; Ci[i] = c.in[I_S5CIM][((size_t)l * 16 + g) * 1024 + i];
        Br[i] = c.in[I_S5BRE][((size_t)l * 16 + g) * 1024 + i]; Bi[i] = c.in[I_S5BIM][((size_t)l * 16 + g) * 1024 + i];
    }
    __syncthreads();
    for (int i = tid; i < 31 * 64; i += NTHREADS) {
        const int dd = i / 64 - 15, n = i & 63; float r, im;
        if (dd > 0) { const float pr = pwr[(0 * 17 + dd) * 64 + n], pi = pwi[(0 * 17 + dd) * 64 + n]; r = pr * cor[n] - pi * coi[n]; im = pr * coi[n] + pi * cor[n]; }
        else if (dd < 0) { const float pr = pwr[(1 * 17 - dd) * 64 + n], pi = pwi[(1 * 17 - dd) * 64 + n]; r = pr * cor[64 + n] - pi * coi[64 + n]; im = pr * coi[64 + n] + pi * cor[64 + n]; }
        else { r = cor[n] + cor[64 + n]; im = coi[n] + coi[64 + n]; }
        kr[i] = r; ki[i] = im;
    }
    __syncthreads();
    for (int i0 = tid; i0 < 17 * 256; i0 += NTHREADS) {
        const int i = i0 + 2 * part * 256; const int ddi = i >> 8, h = (i >> 4) & 15, hp = i & 15; float a = 0.f;
        for (int n = 0; n < 64; ++n) { const float cr = Cr[h * 64 + n], ci = Ci[h * 64 + n], xr = kr[ddi * 64 + n], xi = ki[ddi * 64 + n]; const float pr = cr * xr - ci * xi, pi = cr * xi + ci * xr; a += pr * Br[n * 16 + hp] - pi * Bi[n * 16 + hp]; }
        Kd[i] = a;
    }
    __syncthreads();
    bf16_t* SX = c.wb(l) + WB_SX + (size_t)g * 256 * 256; bf16_t* SY = c.wb(l) + WB_SY + (size_t)g * 256 * 512;
    const float* dsk = c.in[I_S5D] + (size_t)l * 256 + g * 16;
    for (int u = tid; u < 32 * 64; u += NTHREADS) {
        const int o = 32 * part + (u >> 6), kk0 = (u & 63) * 8, i = o >> 4, h = o & 15; float v[8];
        if (kk0 < 256) { const int j = kk0 >> 4, hp0 = kk0 & 15;
#pragma unroll
            for (int e = 0; e < 8; ++e) v[e] = Kd[(i - j + 15) * 256 + h * 16 + hp0 + e] + ((i == j && h == hp0 + e) ? dsk[h] : 0.f);
        } else { const int q = kk0 - 256, d = q >> 7, part = (q >> 6) & 1, n0 = q & 63, ex = d == 0 ? i + 1 : 16 - i;
#pragma unroll
            for (int e = 0; e < 8; ++e) { const int n = n0 + e; const float cr = Cr[h * 64 + n], ci = Ci[h * 64 + n], pr = pwr[(d * 17 + ex) * 64 + n], pi = pwi[(d * 17 + ex) * 64 + n]; v[e] = part == 0 ? (cr * pr - ci * pi) : -(cr * pi + ci * pr); }
        }
        *(u32x4*)(SY + (size_t)o * 512 + kk0) = pack8(v);
    }
    for (int u = tid; u < 32 * 32; u += NTHREADS) {
        const int o = 32 * part + (u >> 5), kk0 = (u & 31) * 8, d = o >> 7, part = (o >> 6) & 1, n = o & 63, j = kk0 >> 4, hp0 = kk0 & 15, ex = d == 0 ? 15 - j : j;
        const float pr = pwr[(d * 17 + ex) * 64 + n], pi = pwi[(d * 17 + ex) * 64 + n], qr = pr * cor[d * 64 + n] - pi * coi[d * 64 + n], qi = pr * coi[d * 64 + n] + pi * cor[d * 64 + n];
        float v[8];
#pragma unroll
        for (int e = 0; e < 8; ++e) { const float br = Br[n * 16 + hp0 + e], bi = Bi[n * 16 + hp0 + e]; v[e] = part == 0 ? (qr * br - qi * bi) : (qr * bi + qi * br); }
        *(u32x4*)(SX + (size_t)o * 256 + kk0) = pack8(v);
    }
    __syncthreads();
}

__device__ __forceinline__ void phase0(const Ctx& cx_) {
    const Ctx c = relaunder(cx_);
    if (c.bid < 256) s5_build(c, c.bid >> 7, (c.bid >> 3) & 15, c.bid & 7);
    const int gw = c.bid * NWAVES + c.wave, NGW = c.G * NWAVES, lane = c.lane;
    bf16_t* H = c.H(); float* ssq = c.ssq();
#pragma unroll 2
    for (int m = gw; m < MP; m += NGW) {
        u32x2* hp = (u32x2*)(H + (size_t)m * DM);
        if (m >= M_ROWS) {
#pragma unroll
            for (int i = 0; i < 4; ++i) hp[lane + 64 * i] = (u32x2){0u, 0u};
            continue;
        }
        int b, t; bt_of(m, b, t);
        const f32x4* src = (const f32x4*)(t < NMETA ? c.in[I_META] + (size_t)t * DM : c.in[I_X] + ((size_t)b * SEQ + (t - NMETA)) * DM);
        float ss = 0.f;
#pragma unroll
        for (int i = 0; i < 4; ++i) { const f32x4 v = src[lane + 64 * i]; ss += (v.x * v.x + v.y * v.y) + (v.z * v.z + v.w * v.w); hp[lane + 64 * i] = (u32x2){pk2(v.x, v.y), pk2(v.z, v.w)}; }
        ss = wave_sum(ss);
        if (lane < 16) ssq[(size_t)m * 16 + lane] = lane == 0 ? ss : 0.f;
    }
    LAS float* scr = (LAS float*)(c.lds + c.wave * 8448);
    for (int l = 0; l < DEPTH; ++l) {
        int base = 0;
        for (int j = 0; j < N_TJOBS; ++j) {
            TJob t; get_tjob(c, l, j, t); const int ni = tjob_items(t);
            int first = (gw - base % NGW + NGW) % NGW;
            for (int it = first; it < ni; it += NGW) transpose_item(t, scr, it, lane);
            base += ni;
        }
        bf16_t* wb = c.wb(l);
        const int gt = c.bid * NTHREADS + c.tid, NGT = c.G * NTHREADS;
        for (int u = gt; u < 128 * 64; u += NGT) *(u32x4*)(wb + WB_L1 + (size_t)384 * 512 + (size_t)u * 8) = (u32x4){0u, 0u, 0u, 0u};
        for (int u = gt; u < 5 * 256 * 4 * 8; u += NGT) {
            const int sub = u & 7, blk = (u >> 3) & 3, row = (u >> 5) & 255, tile = u >> 13;
            const bool nz = (tile == 0 || tile == 2) ? (blk == 0) : ((tile == 1 || tile == 3) ? (blk == 1) : (blk < 2));
            if (!nz) *(u32x4*)(wb + WB_L2 + ((size_t)tile * 256 + row) * 256 + blk * 64 + sub * 8) = (u32x4){0u, 0u, 0u, 0u};
        }
    }
}

__device__ __forceinline__ void dt_job(const Ctx& cx_, int l) {
    const Ctx c = relaunder(cx_);
    LAS float* dtw = (LAS float*)c.lds;
    const float* win = c.in[I_WIN] + (size_t)l * DM * N_IN; const float* nw = c.in[I_MIXNW] + l * DM;
    for (int i = c.tid; i < 8 * DM; i += NTHREADS) { const int k = i >> 3, j = i & 7; dtw[j * DM + k] = nw[k] * win[(size_t)k * N_IN + 1792 + j]; }
    __syncthreads();
    const int gw = c.bid * NWAVES + c.wave, NGW = c.G * NWAVES, lane = c.lane;
    const bf16_t* H = c.H(); float* dt = (float*)(c.ws + WS_DT); float* dec = (float*)(c.ws + WS_DEC);
    const float* dtb = c.in[I_DTB] + l * 16; const float* alog = c.in[I_ALOG] + l * 16;
#pragma unroll 2
    for (int m = gw; m < M_ROWS; m += NGW) {
        const u32x2* hp = (const u32x2*)(H + (size_t)m * DM);
        float ss = 0.f, d8[8] = {0.f, 0.f, 0.f, 0.f, 0.f, 0.f, 0.f, 0.f};
#pragma unroll
        for (int i = 0; i < 4; ++i) {
            const u32x2 w = hp[lane + 64 * i]; const float h0 = bflo(w.x), h1 = bfhi(w.x), h2 = bflo(w.y), h3 = bfhi(w.y);
            ss += (h0 * h0 + h1 * h1) + (h2 * h2 + h3 * h3);
#pragma unroll
            for (int j = 0; j < 8; ++j) { const f32x4 wv = *(const LAS f32x4*)(dtw + j * DM + 4 * lane + 256 * i); d8[j] += (h0 * wv.x + h1 * wv.y) + (h2 * wv.z + h3 * wv.w); }
        }
        ss = wave_sum(ss);
#pragma unroll
        for (int j = 0; j < 8; ++j) d8[j] = wave_sum(d8[j]);
        const float s = __builtin_amdgcn_rsqf(ss * (1.0f / DM) + EPS);
        if (lane < 16) {
            const int j = lane & 7; float raw = d8[0];
#pragma unroll
            for (int e = 1; e < 8; ++e) raw = (j == e) ? d8[e] : raw;
            const float dtv = softplusf_(raw * s + dtb[lane]);
            dt[(size_t)m * 16 + lane] = dtv; dec[(size_t)m * 16 + lane] = -dtv * __expf(alog[lane]);
        }
    }
    __syncthreads();
}

__device__ __forceinline__ void rwkv_prep(const Ctx& cx_, int l) {
    const Ctx c = relaunder(cx_);
    const int gw = c.bid * NWAVES + c.wave, NGW = c.G * NWAVES, lane = c.lane, c0 = 4 * lane;
    const bf16_t* P = (const bf16_t*)(c.ws + WS_PRKVX); bf16_t* rk = (bf16_t*)(c.dout + DO_RKVP); bf16_t* l1 = (bf16_t*)(c.ws + WS_L1IN);
    float mu[3][4], kkw[4];
#pragma unroll
    for (int x = 0; x < 3; ++x)
#pragma unroll
        for (int e = 0; e < 4; ++e) mu[x][e] = c.in[I_MURKV][((size_t)l * 3 + x) * 256 + c0 + e];
#pragma unroll
    for (int e = 0; e < 4; ++e) kkw[e] = c.in[I_KK][(size_t)l * 256 + c0 + e];
#pragma unroll 2
    for (int m = gw; m < M_ROWS; m += NGW) {
        int b, t; bt_of(m, b, t); const bool hp = t > 0, hn = t < LEN - 1; const size_t mp_ = hp ? row_of(b, t - 1) : 0, mn_ = hn ? row_of(b, t + 1) : 0;
        float o[4][4];
        float xc[4], dxc[4];
#pragma unroll
        for (int x = 0; x < 4; ++x) {
            const u32x2 wc_ = *(const u32x2*)(P + (size_t)m * 1024 + x * 256 + c0);
            u32x2 wp = (u32x2){0u, 0u}, wn = (u32x2){0u, 0u};
            if (hp) wp = *(const u32x2*)(P + mp_ * 1024 + x * 256 + c0);
            if (hn) wn = *(const u32x2*)(P + mn_ * 1024 + x * 256 + c0);
            const float cur[4] = {bflo(wc_.x), bfhi(wc_.x), bflo(wc_.y), bfhi(wc_.y)}, pv[4] = {bflo(wp.x), bfhi(wp.x), bflo(wp.y), bfhi(wp.y)}, nv[4] = {bflo(wn.x), bfhi(wn.x), bflo(wn.y), bfhi(wn.y)};
#pragma unroll
            for (int e = 0; e < 4; ++e) { const float cs = 0.5f * (pv[e] + nv[e]) - cur[e]; if (x < 3) o[x][e] = cur[e] + cs * mu[x][e]; else { xc[e] = cur[e]; dxc[e] = cs; } }
        }
        float kr_[4], ss = 0.f;
#pragma unroll
        for (int e = 0; e < 4; ++e) { kr_[e] = o[1][e] * kkw[e]; ss += kr_[e] * kr_[e]; }
        ss = sum16(ss); const float rn = __builtin_amdgcn_rsqf(ss + 1e-12f);
        bf16_t* rp = rk + (size_t)m * 1024 + c0;
        *(u32x2*)(rp) = (u32x2){pk2(o[0][0], o[0][1]), pk2(o[0][2], o[0][3])};
        *(u32x2*)(rp + 256) = (u32x2){pk2(o[1][0], o[1][1]), pk2(o[1][2], o[1][3])};
        *(u32x2*)(rp + 512) = (u32x2){pk2(o[2][0], o[2][1]), pk2(o[2][2], o[2][3])};
        *(u32x2*)(rp + 768) = (u32x2){pk2(kr_[0] * rn, kr_[1] * rn), pk2(kr_[2] * rn, kr_[3] * rn)};
        bf16_t* lp = l1 + (size_t)m * 512 + c0;
        *(u32x2*)(lp) = (u32x2){pk2(xc[0], xc[1]), pk2(xc[2], xc[3])};
        *(u32x2*)(lp + 256) = (u32x2){pk2(dxc[0], dxc[1]), pk2(dxc[2], dxc[3])};
    }
}
__device__ __forceinline__ void ssd_prep(const Ctx& cx_, int l) {
    const Ctx c = relaunder(cx_);
    const int gw = c.bid * NWAVES + c.wave, NGW = c.G * NWAVES, lane = c.lane, c0 = 16 * lane;
    const bf16_t* P = (const bf16_t*)(c.ws + WS_PXBC); bf16_t* xs = (bf16_t*)(c.ws + WS_XS); bf16_t* bc = (bf16_t*)(c.ws + WS_BC);
    float w[5][16], bias[16];
#pragma unroll
    for (int j = 0; j < 5; ++j)
#pragma unroll
        for (int e = 0; e < 16; ++e) w[j][e] = c.in[I_CONVW][((size_t)l * 5 + j) * 1024 + c0 + e];
#pragma unroll
    for (int e = 0; e < 16; ++e) bias[e] = c.in[I_CONVB][(size_t)l * 1024 + c0 + e];
#pragma unroll 2
    for (int m = gw; m < M_ROWS; m += NGW) {
        int b, t; bt_of(m, b, t);
        float a[16];
#pragma unroll
        for (int e = 0; e < 16; ++e) a[e] = bias[e];
#pragma unroll
        for (int j = 0; j < 5; ++j) {
            const int tt = t + j - 2;
            if (tt >= 0 && tt < LEN) {
                const u32x4* p = (const u32x4*)(P + (size_t)row_of(b, tt) * 1024 + c0); float f0[8], f1[8]; unpack8(p[0], f0); unpack8(p[1], f1);
#pragma unroll
                for (int e = 0; e < 8; ++e) { a[e] += w[j][e] * f0[e]; a[8 + e] += w[j][8 + e] * f1[e]; }
            }
        }
        float o0[8], o1[8];
#pragma unroll
        for (int e = 0; e < 8; ++e) { o0[e] = siluf_(a[e]); o1[e] = siluf_(a[8 + e]); }
        bf16_t* dst = lane < 32 ? xs + (size_t)m * 512 + c0 : bc + (size_t)m * 512 + (c0 - 512);
        ((u32x4*)dst)[0] = pack8(o0); ((u32x4*)dst)[1] = pack8(o1);
    }
}

__device__ __forceinline__ void s5_scan(const Ctx& cx_, int l) {
    const Ctx c = relaunder(cx_);
    if (c.tid >= 64) return;
    const int gt = c.bid * 64 + c.tid; if (gt >= 16384) return;
    const int n = gt & 63, d = (gt >> 6) & 1, b = (gt >> 7) & 7, g = gt >> 10;
    const size_t li_ = (((size_t)l * 2 + d) * 16 + g) * 64 + n;
    const float lr = c.in[I_S5LRE][li_], li = c.in[I_S5LIM][li_], step = expf(c.in[I_S5LS][((size_t)l * 2 + d) * 16 + g]);
    const float mag = expf(16.f * lr * step); float sn, cs; sincosf(16.f * li * step, &sn, &cs); const float ar = mag * cs, ai = mag * sn;
    const float* X = (const float*)(c.ws + WS_X) + ((size_t)g * S5RP + (size_t)b * NCH16) * 256 + d * 128 + n;
    bf16_t* U = (bf16_t*)(c.ws + WS_UH) + ((size_t)g * S5RP + (size_t)b * NCH16) * 512 + 256 + d * 128 + n;
    float hr = 0.f, hi = 0.f;
    for (int i0 = 0; i0 < NCH16; i0 += 32) {
        float xr[32], xi[32];
#pragma unroll
        for (int k = 0; k < 32; ++k) { const int i = i0 + k; const int ch = d == 0 ? i : NCH16 - 1 - i; const bool ok = i < NCH16; xr[k] = ok ? X[(size_t)ch * 256] : 0.f; xi[k] = ok ? X[(size_t)ch * 256 + 64] : 0.f; }
#pragma unroll
        for (int k = 0; k < 32; ++k) { const int i = i0 + k; if (i < NCH16) { const int ch = d == 0 ? i : NCH16 - 1 - i;
            U[(size_t)ch * 512] = (bf16_t)f2bf(hr); U[(size_t)ch * 512 + 64] = (bf16_t)f2bf(hi);
            const float nr = ar * hr - ai * hi + xr[k], ni = ar * hi + ai * hr + xi[k]; hr = nr; hi = ni; } }
    }
}
typedef short s16x4 __attribute__((ext_vector_type(4)));
__device__ __forceinline__ s16x4 lds_tr(const LAS unsigned char* p) { return __builtin_bit_cast(s16x4, __builtin_amdgcn_ds_read_tr16_b64_v4i16((LAS s16x4*)p)); }
__device__ __forceinline__ bf16x8 frag_tr(const LAS unsigned char* img, int rs, int kbase, int colbase, int lane) {
    const LAS unsigned char* a = img + (kbase + 8 * (lane >> 4) + ((lane & 15) >> 2)) * rs + (colbase + 4 * (lane & 3)) * 2;
    const s16x4 lo = lds_tr(a), hi = lds_tr(a + 4 * rs);
    return (bf16x8){lo[0], lo[1], lo[2], lo[3], hi[0], hi[1], hi[2], hi[3]};
}
__device__ __forceinline__ bf16x8 frag_row(const LAS unsigned char* img, int rs, int rowbase, int kbase, int lane) {
    return *(const LAS bf16x8*)(img + (rowbase + (lane & 15)) * rs + (kbase + 8 * (lane >> 4)) * 2);
}
constexpr int SD_RS = 272;
constexpr int SD_XRS = 144;
constexpr int SD_OFF_C = 0, SD_OFF_B = 34816, SD_OFF_X = 69632, SD_OFF_M = 88064, SD_OFF_SC = 122880;
constexpr int SD_OFF_HF = SD_OFF_B, SD_OFF_HB = SD_OFF_B + 17408;
constexpr size_t WS_STB = WS_YSSD;
constexpr size_t WS_CDEC = WS_DEC + (size_t)MP * 64 + 256;
constexpr size_t WS_SSQB = WS_CDEC + (size_t)BATCH * 33 * 16 * 4;
constexpr size_t WS_BAR = (WS_SSQB + (size_t)MP * 4 + 255) / 256 * 256;
static_assert(WS_BAR + 3456 * 4 <= 7 * QB, "small region");
static_assert((size_t)BATCH * 2 * 8 * 32 * 8192 * 2 <= 4 * QB, "chunk states fit the yssd slot");

struct SsdUnit { int b, ck, t0, ns; };
__device__ __forceinline__ bool ssd_unit(int bid, int round, SsdUnit& u) {
    if (round == 0) { u.b = bid >> 5; u.ck = 1 + (bid & 31); u.t0 = NMETA + 128 * (u.ck - 1); u.ns = 8; return true; }
    if (round == 1 && bid < BATCH) { u.b = bid; u.ck = 0; u.t0 = 0; u.ns = 1; return true; }
    return false;
}
__device__ __forceinline__ void ssd_load_img(LAS unsigned char* img, int rs, const bf16_t* src, int ld, size_t m0, int col0, int ncol, int ns, int tid) {
    const int cpr = ncol / 8, nrow = ns == 1 ? 32 : 128;
    for (int i = tid; i < nrow * cpr; i += NTHREADS) {
        const int r = i / cpr, cc = i - r * cpr; u32x4 v = (u32x4){0u, 0u, 0u, 0u};
        if (r < 16 * ns) v = *(const u32x4*)(src + (m0 + r) * ld + col0 + cc * 8);
        *(LAS u32x4*)(img + r * rs + cc * 16) = v;
    }
}
__device__ __forceinline__ void ssd_scalars(LAS float* sc, const float* dt, const float* al, size_t m0, int head, int ns, int lane, float& totf, float& totb) {
    const int Q = 16 * ns;
    float a0f = 0.f, a1f = 0.f, a0b = 0.f, a1b = 0.f, d0f = 0.f, d1f = 0.f, d0b = 0.f, d1b = 0.f;
    const int s0 = 2 * lane, s1 = 2 * lane + 1;
    if (s0 < Q) { a0f = al[(m0 + s0) * 16 + head]; a0b = al[(m0 + s0) * 16 + 8 + head]; d0f = dt[(m0 + s0) * 16 + head]; d0b = dt[(m0 + s0) * 16 + 8 + head]; }
    if (s1 < Q) { a1f = al[(m0 + s1) * 16 + head]; a1b = al[(m0 + s1) * 16 + 8 + head]; d1f = dt[(m0 + s1) * 16 + head]; d1b = dt[(m0 + s1) * 16 + 8 + head]; }
    float pf = a0f + a1f, pb = a0b + a1b;
#pragma unroll
    for (int o = 1; o < 64; o <<= 1) { const float tf = __shfl_up(pf, o), tb = __shfl_up(pb, o); if (lane >= o) { pf += tf; pb += tb; } }
    totf = __shfl(pf, 63); totb = __shfl(pb, 63);
    const float af1 = pf, af0 = pf - a1f;
    const float eb0 = pb - a0b - a1b, eb1 = pb - a1b;
    sc[s0] = af0; sc[s1] = af1; sc[128 + s0] = eb0; sc[128 + s1] = eb1; sc[256 + s0] = d0f; sc[256 + s1] = d1f; sc[384 + s0] = d0b; sc[384 + s1] = d1b;
    sc[512 + s0] = __expf(totf - af0) * d0f; sc[512 + s1] = __expf(totf - af1) * d1f;
    sc[640 + s0] = __expf(eb0) * d0b; sc[640 + s1] = __expf(eb1) * d1b;
    sc[768 + s0] = __expf(af0); sc[768 + s1] = __expf(af1);
    sc[896 + s0] = __expf(totb - eb0); sc[896 + s1] = __expf(totb - eb1);
}

__device__ __forceinline__ void ssd_states(const Ctx& cx_, int l) {
    const Ctx c = relaunder(cx_);
    const int tid = c.tid, lane = c.lane, wave = c.wave;
    const bf16_t* bc = (const bf16_t*)(c.ws + WS_BC); const bf16_t* xs = (const bf16_t*)(c.ws + WS_XS);
    const float* dt = (const float*)(c.ws + WS_DT); const float* al = (const float*)(c.ws + WS_DEC);
    bf16_t* stb = (bf16_t*)(c.ws + WS_STB); float* cdec = (float*)(c.ws + WS_CDEC);
    LAS unsigned char* Bimg = c.lds + SD_OFF_B; LAS unsigned char* Ximg = c.lds + SD_OFF_X; LAS float* sc = (LAS float*)(c.lds + SD_OFF_SC);
    for (int round = 0; round < 2; ++round) {
        SsdUnit u; if (!ssd_unit(c.bid, round, u)) break;
        const size_t m0 = (size_t)row_of(u.b, u.t0); const int nks = u.ns == 1 ? 1 : 4;
        for (int g = 0; g < 2; ++g) {
            __syncthreads();
            ssd_load_img(Bimg, SD_RS, bc, 512, m0, g * 128, 128, u.ns, tid);
            for (int j = 0; j < 4; ++j) {
                const int head = g * 4 + j;
                if (j) __syncthreads();
                ssd_load_img(Ximg, SD_XRS, xs, 512, m0, head * 64, 64, u.ns, tid);
                if (wave == 0) { float totf, totb; ssd_scalars(sc, dt, al, m0, head, u.ns, lane, totf, totb);
                    if (lane == 0) { cdec[((size_t)u.b * 33 + u.ck) * 16 + head] = __expf(totf); cdec[((size_t)u.b * 33 + u.ck) * 16 + 8 + head] = __expf(totb); } }
                __syncthreads();
                f32x4 accf[4], accb[4];
#pragma unroll
                for (int pt = 0; pt < 4; ++pt) { accf[pt] = (f32x4){0.f, 0.f, 0.f, 0.f}; accb[pt] = accf[pt]; }
                for (int ks = 0; ks < nks; ++ks) {
                    const bf16x8 af = frag_tr(Bimg, SD_RS, 32 * ks, 16 * wave, lane);
                    const int k0 = 32 * ks + 8 * (lane >> 4);
                    const f32x4 wf0 = *(const LAS f32x4*)(sc + 512 + k0), wf1 = *(const LAS f32x4*)(sc + 512 + k0 + 4), wb0 = *(const LAS f32x4*)(sc + 640 + k0), wb1 = *(const LAS f32x4*)(sc + 640 + k0 + 4);
#pragma unroll
                    for (int pt = 0; pt < 4; ++pt) {
                        const bf16x8 xr = frag_tr(Ximg, SD_XRS, 32 * ks, 16 * pt, lane);
                        float xf[8];
#pragma unroll
                        for (int e = 0; e < 8; ++e) xf[e] = bf1((bf16_t)xr[e]);
                        bf16x8 bfv, bbv;
                        { const unsigned p0 = pk2(xf[0] * wf0.x, xf[1] * wf0.y), p1 = pk2(xf[2] * wf0.z, xf[3] * wf0.w), p2 = pk2(xf[4] * wf1.x, xf[5] * wf1.y), p3 = pk2(xf[6] * wf1.z, xf[7] * wf1.w);
                          bfv = __builtin_bit_cast(bf16x8, (u32x4){p0, p1, p2, p3}); }
                        { const unsigned p0 = pk2(xf[0] * wb0.x, xf[1] * wb0.y), p1 = pk2(xf[2] * wb0.z, xf[3] * wb0.w), p2 = pk2(xf[4] * wb1.x, xf[5] * wb1.y), p3 = pk2(xf[6] * wb1.z, xf[7] * wb1.w);
                          bbv = __builtin_bit_cast(bf16x8, (u32x4){p0, p1, p2, p3}); }
                        accf[pt] = __builtin_amdgcn_mfma_f32_16x16x32_bf16(af, bfv, accf[pt], 0, 0, 0);
                        accb[pt] = __builtin_amdgcn_mfma_f32_16x16x32_bf16(af, bbv, accb[pt], 0, 0, 0);
                    }
                }
#pragma unroll
                for (int pt = 0; pt < 4; ++pt) {
                    const int p = 16 * pt + (lane & 15), n0 = 16 * wave + 4 * (lane >> 4);
                    if (u.ck <= 31) { bf16_t* d = stb + ((((size_t)u.b * 2 + 0) * 8 + head) * 32 + u.ck) * 8192 + (size_t)p * 128 + n0; *(u32x2*)d = (u32x2){pk2(accf[pt][0], accf[pt][1]), pk2(accf[pt][2], accf[pt][3])}; }
                    if (u.ck >= 1) { bf16_t* d = stb + ((((size_t)u.b * 2 + 1) * 8 + head) * 32 + (u.ck - 1)) * 8192 + (size_t)p * 128 + n0; *(u32x2*)d = (u32x2){pk2(accb[pt][0], accb[pt][1]), pk2(accb[pt][2], accb[pt][3])}; }
                }
            }
        }
    }
    __syncthreads();
}

__device__ __forceinline__ void ssd_chunk_scan(const Ctx& cx_, int l) {
    const Ctx c = relaunder(cx_);
    bf16_t* stb = (bf16_t*)(c.ws + WS_STB); const float* cdec = (const float*)(c.ws + WS_CDEC);
    const int gt = c.bid * NTHREADS + c.tid;
    const int e8 = gt & 1023, bdh = gt >> 10;
    if (bdh >= BATCH * 16) return;
    const int head = bdh & 7, dir = (bdh >> 3) & 1, b = bdh >> 4;
    bf16_t* base = stb + (size_t)bdh * 32 * 8192 + (size_t)e8 * 8;
    float h[8] = {0.f, 0.f, 0.f, 0.f, 0.f, 0.f, 0.f, 0.f};
    for (int i0 = 0; i0 < 32; i0 += 8) {
        u32x4 v[8]; float dcy[8];
#pragma unroll
        for (int k = 0; k < 8; ++k) { const int slot = dir == 0 ? i0 + k : 31 - (i0 + k); v[k] = *(const u32x4*)(base + (size_t)slot * 8192);
            const int ck = dir == 0 ? slot : slot + 1; dcy[k] = cdec[((size_t)b * 33 + ck) * 16 + dir * 8 + head]; }
#pragma unroll
        for (int k = 0; k < 8; ++k) { const int slot = dir == 0 ? i0 + k : 31 - (i0 + k); float s[8]; unpack8(v[k], s);
#pragma unroll
            for (int e = 0; e < 8; ++e) h[e] = h[e] * dcy[k] + s[e];
            *(u32x4*)(base + (size_t)slot * 8192) = pack8(h); }
    }
}

__device__ __forceinline__ bool ssd_unit_n(int idx, int nblk, int round, SsdUnit& u) {
    const int n = idx + nblk * round; if (n >= 264) return false;
    if (n < 256) { u.b = n >> 5; u.ck = 1 + (n & 31); u.t0 = NMETA + 128 * (u.ck - 1); u.ns = 8; } else { u.b = n - 256; u.ck = 0; u.t0 = 0; u.ns = 1; }
    return true;
}
__device__ __forceinline__ void ssd_outputs(const Ctx& cx_, int l, int first, int nblk) {
    const Ctx c = relaunder(cx_);
    const int tid = c.tid, lane = c.lane, wave = c.wave;
    const bf16_t* bc = (const bf16_t*)(c.ws + WS_BC); const bf16_t* xs = (const bf16_t*)(c.ws + WS_XS); const bf16_t* pz = (const bf16_t*)(c.ws + WS_PZ);
    const float* dt = (const float*)(c.ws + WS_DT); const float* al = (const float*)(c.ws + WS_DEC);
    const bf16_t* stb = (const bf16_t*)(c.ws + WS_STB); bf16_t* yb = (bf16_t*)(c.ws + WS_YB); float* ssqb = (float*)(c.ws + WS_SSQB);
    LAS unsigned char* Cimg = c.lds + SD_OFF_C; LAS unsigned char* Bimg = c.lds + SD_OFF_B; LAS unsigned char* Ximg = c.lds + SD_OFF_X;
    LAS unsigned char* HfT = c.lds + SD_OFF_HF; LAS unsigned char* HbT = c.lds + SD_OFF_HB;
    LAS unsigned char* Ms = c.lds + SD_OFF_M + wave * 4352; LAS float* sc = (LAS float*)(c.lds + SD_OFF_SC);
    for (int round = 0; round < 4; ++round) {
        SsdUnit u; if (!ssd_unit_n(c.bid - first, nblk, round, u)) break;
        const size_t m0 = (size_t)row_of(u.b, u.t0); const int nks = u.ns == 1 ? 1 : 4; const bool active = wave < u.ns;
        float ssrow = 0.f;
        for (int g = 0; g < 2; ++g) {
            __syncthreads();
            ssd_load_img(Cimg, SD_RS, bc, 512, m0, 256 + g * 128, 128, u.ns, tid);
            ssd_load_img(Bimg, SD_RS, bc, 512, m0, g * 128, 128, u.ns, tid);
            __syncthreads();
            f32x4 cb[8];
#pragma unroll
            for (int t = 0; t < 8; ++t) cb[t] = (f32x4){0.f, 0.f, 0.f, 0.f};
            if (active) {
#pragma unroll
                for (int ks = 0; ks < 4; ++ks) {
                    const bf16x8 cfr = frag_row(Cimg, SD_RS, 16 * wave, 32 * ks, lane);
#pragma unroll
                    for (int t = 0; t < 8; ++t) if (t < u.ns) cb[t] = __builtin_amdgcn_mfma_f32_16x16x32_bf16(frag_row(Bimg, SD_RS, 16 * t, 32 * ks, lane), cfr, cb[t], 0, 0, 0);
                }
            }
            for (int j = 0; j < 4; ++j) {
                const int head = g * 4 + j;
                __syncthreads();
                ssd_load_img(Ximg, SD_XRS, xs, 512, m0, head * 64, 64, u.ns, tid);
                {
                    const bf16_t* hf = u.ck >= 1 ? stb + ((((size_t)u.b * 2 + 0) * 8 + head) * 32 + (u.ck - 1)) * 8192 : nullptr;
                    const bf16_t* hb = u.ck <= 31 ? stb + ((((size_t)u.b * 2 + 1) * 8 + head) * 32 + u.ck) * 8192 : nullptr;
                    for (int i = tid; i < 64 * 16; i += NTHREADS) { const int p = i >> 4, cc = i & 15;
                        *(LAS u32x4*)(HfT + p * SD_RS + cc * 16) = hf ? *(const u32x4*)(hf + p * 128 + cc * 8) : (u32x4){0u, 0u, 0u, 0u};
                        *(LAS u32x4*)(HbT + p * SD_RS + cc * 16) = hb ? *(const u32x4*)(hb + p * 128 + cc * 8) : (u32x4){0u, 0u, 0u, 0u}; }
                }
                if (wave == 0) { float totf, totb; ssd_scalars(sc, dt, al, m0, head, u.ns, lane, totf, totb); }
                __syncthreads();
                if (active) {
                    const int ll = 16 * wave + (lane & 15); const float afl = sc[ll], ebl = sc[128 + ll];
#pragma unroll
                    for (int t = 0; t < 8; ++t) {
                        u32x2 w2 = (u32x2){0u, 0u};
                        if (t < u.ns) {
                            const int s0 = 16 * t + 4 * (lane >> 4);
                            const f32x4 afs = *(const LAS f32x4*)(sc + s0), ebs = *(const LAS f32x4*)(sc + 128 + s0), dfs = *(const LAS f32x4*)(sc + 256 + s0), dbs = *(const LAS f32x4*)(sc + 384 + s0);
                            float mv[4];
#pragma unroll
                            for (int r = 0; r < 4; ++r) { const int s = s0 + r; float wgt = 0.f; if (s <= ll) wgt += __expf(afl - afs[r]) * dfs[r]; if (s >= ll) wgt += __expf(ebs[r] - ebl) * dbs[r]; mv[r] = cb[t][r] * wgt; }
                            w2 = (u32x2){pk2(mv[0], mv[1]), pk2(mv[2], mv[3])};
                        }
                        if (t < 2 * nks) *(LAS u32x2*)(Ms + (lane & 15) * SD_RS + (16 * t + 4 * (lane >> 4)) * 2) = w2;
                    }
                    asm volatile("s_waitcnt lgkmcnt(0)" ::: "memory");
                    f32x4 ay[4], ahf[4], ahb[4];
#pragma unroll
                    for (int pt = 0; pt < 4; ++pt) { ay[pt] = (f32x4){0.f, 0.f, 0.f, 0.f}; ahf[pt] = ay[pt]; ahb[pt] = ay[pt]; }
                    for (int ks = 0; ks < nks; ++ks) {
                        const bf16x8 mf = frag_row(Ms, SD_RS, 0, 32 * ks, lane);
#pragma unroll
                        for (int pt = 0; pt < 4; ++pt) ay[pt] = __builtin_amdgcn_mfma_f32_16x16x32_bf16(mf, frag_tr(Ximg, SD_XRS, 32 * ks, 16 * pt, lane), ay[pt], 0, 0, 0);
                    }
#pragma unroll
                    for (int ks = 0; ks < 4; ++ks) {
                        const bf16x8 cfr = frag_row(Cimg, SD_RS, 16 * wave, 32 * ks, lane);
#pragma unroll
                        for (int pt = 0; pt < 4; ++pt) {
                            ahf[pt] = __builtin_amdgcn_mfma_f32_16x16x32_bf16(cfr, frag_row(HfT, SD_RS, 16 * pt, 32 * ks, lane), ahf[pt], 0, 0, 0);
                            ahb[pt] = __builtin_amdgcn_mfma_f32_16x16x32_bf16(cfr, frag_row(HbT, SD_RS, 16 * pt, 32 * ks, lane), ahb[pt], 0, 0, 0);
                        }
                    }
                    const int l0 = 16 * wave + 4 * (lane >> 4);
                    const f32x4 efv = *(const LAS f32x4*)(sc + 768 + l0), ebv = *(const LAS f32x4*)(sc + 896 + l0);
                    asm volatile("s_waitcnt lgkmcnt(0)" ::: "memory");
                    LAS float* ys = (LAS float*)Ms;
#pragma unroll
                    for (int pt = 0; pt < 4; ++pt)
#pragma unroll
                        for (int r = 0; r < 4; ++r) ys[(4 * (lane >> 4) + r) * 68 + 16 * pt + (lane & 15)] = ay[pt][r] + efv[r] * ahf[pt][r] + ebv[r] * ahb[pt][r];
                    asm volatile("s_waitcnt lgkmcnt(0)" ::: "memory");
                    const int rr = lane >> 2, p0 = 16 * (lane & 3); const size_t m = m0 + 16 * wave + rr;
                    const float dsk = c.in[I_SSDD][l * 8 + head];
                    float xv[16], zv[16];
                    { float t8[8]; unpack8(*(const LAS u32x4*)(Ximg + (16 * wave + rr) * SD_XRS + p0 * 2), t8);
#pragma unroll
                      for (int e = 0; e < 8; ++e) xv[e] = t8[e];
                      unpack8(*(const LAS u32x4*)(Ximg + (16 * wave + rr) * SD_XRS + p0 * 2 + 16), t8);
#pragma unroll
                      for (int e = 0; e < 8; ++e) xv[8 + e] = t8[e];
                      unpack8(*(const u32x4*)(pz + m * 512 + head * 64 + p0), t8);
#pragma unroll
                      for (int e = 0; e < 8; ++e) zv[e] = t8[e];
                      unpack8(*(const u32x4*)(pz + m * 512 + head * 64 + p0 + 8), t8);
#pragma unroll
                      for (int e = 0; e < 8; ++e) zv[8 + e] = t8[e]; }
                    float o[16];
#pragma unroll
                    for (int e4 = 0; e4 < 4; ++e4) { const f32x4 yv = *(const LAS f32x4*)(ys + rr * 68 + p0 + 4 * e4);
#pragma unroll
                        for (int e = 0; e < 4; ++e) { const float val = (yv[e] + dsk * xv[4 * e4 + e]) * siluf_(zv[4 * e4 + e]); o[4 * e4 + e] = val; ssrow += val * val; } }
                    u32x4 w0, w1; w0.x = pk2(o[0], o[1]); w0.y = pk2(o[2], o[3]); w0.z = pk2(o[4], o[5]); w0.w = pk2(o[6], o[7]); w1.x = pk2(o[8], o[9]); w1.y = pk2(o[10], o[11]); w1.z = pk2(o[12], o[13]); w1.w = pk2(o[14], o[15]);
                    *(u32x4*)(yb + m * 512 + head * 64 + p0) = w0; *(u32x4*)(yb + m * 512 + head * 64 + p0 + 8) = w1;
                }
            }
        }
        if (active) { ssrow += dpp_mov<0xB1>(ssrow); ssrow += dpp_mov<0x4E>(ssrow); if ((lane & 3) == 0) ssqb[m0 + 16 * wave + (lane >> 2)] = ssrow; }
    }
    __syncthreads();
}
#define RC_NONE 1
typedef short s16x4v __attribute__((ext_vector_type(4)));
constexpr int RC_NCH = LEN / 16;
constexpr int RC_NP = 5;
constexpr int RC_ROUNDS = (RC_NCH + RC_NP - 1) / RC_NP;
constexpr int RC_S64 = 144;
constexpr int RC_S16 = 40;
constexpr int RC_AT = 0, RC_RT = 2304, RC_BH = 4608, RC_KH = 6912, RC_T = 9216, RC_AAK = 9856, RC_ARB = 10496, RC_ARK = 11136, RC_VT = 11776, RC_P16 = 12416, RC_SLOT = 12800;
constexpr int RC_SCR0 = 2 * RC_NP * RC_SLOT;
constexpr int RC_SCR = 1280;
static_assert(RC_SCR0 + RC_NP * RC_SCR <= 147456 - 512, "rwkv chunk LDS");
__device__ __forceinline__ f32x4 mm16(s16x4v a, s16x4v b, f32x4 c, int, int, int) { return __builtin_amdgcn_mfma_f32_16x16x32_bf16((bf16x8){a[0], a[1], a[2], a[3], 0, 0, 0, 0}, (bf16x8){b[0], b[1], b[2], b[3], 0, 0, 0, 0}, c, 0, 0, 0); }
__device__ __forceinline__ s16x4v mfma16_frag(const LAS unsigned char* mat, int row, int q) { return *(const LAS s16x4v*)(mat + row * RC_S16 + q * 8); }

__device__ __forceinline__ void rwkv_chunked(const Ctx& cx_, int l) {
    const Ctx c = relaunder(cx_);


    const int bid = c.bid, qs = bid & 3, dir = 1 - ((bid >> 2) & 1), head = (bid >> 3) & 3, b = bid >> 5;
    const int lane = c.lane, wave = c.wave;
    const bf16_t* rk = (const bf16_t*)(c.dout + DO_RKVP) + head * 64; const bf16_t* l2 = (const bf16_t*)(c.ws + WS_L2O) + dir * 256 + head * 64;
#ifdef RWKV_DBG
    bf16_t* yo = (bf16_t*)(c.ws + WS_MIX + (dir ? 47 * QB / 2 : 33 * QB / 2)) + head * 64 + 16 * qs;
#else
    bf16_t* yo = (bf16_t*)(c.ws + WS_YRW) + (size_t)dir * MP * 256 + head * 64 + 16 * qs;
#endif
    auto tok = [&](int s) -> size_t { const int t = s + dir * (LEN - 1 - 2 * s); return (size_t)row_of(b, t); };
    const int q = lane >> 4, li = lane & 15;
#ifdef RC_ZLDS
    for (int i = c.tid; i < 131072 / 16; i += NTHREADS) *(LAS u32x4*)(c.lds + i * 16) = (u32x4){0u, 0u, 0u, 0u};
    __syncthreads();
#endif
#ifdef RC_DELAY
    { const unsigned long long t0_ = __builtin_amdgcn_s_memrealtime(); while (__builtin_amdgcn_s_memrealtime() - t0_ < 40000ull) __builtin_amdgcn_s_sleep(16); }
#endif
#ifdef RC_PREFILL
    for (int i = c.tid; i < LEN * 2; i += NTHREADS) { const size_t m = (size_t)row_of(b, i >> 1); *(u32x4*)(yo + m * 256 + (i & 1) * 8) = (u32x4){0u, 0u, 0u, 0u}; }
    asm volatile("s_waitcnt vmcnt(0)" ::: "memory"); __syncthreads();
#endif
    u32x4 Rr[2], Kr[2], KKr[2], DLr[2], ASr[2]; bf16_t vr[4];
    auto load_raw = [&](int ch) {
        const size_t m = tok(16 * ch + li); const int k0 = 16 * q;
#pragma unroll
        for (int h = 0; h < 2; ++h) { Rr[h] = *(const u32x4*)(rk + m * 1024 + k0 + 8 * h); Kr[h] = *(const u32x4*)(rk + m * 1024 + 256 + k0 + 8 * h); KKr[h] = *(const u32x4*)(rk + m * 1024 + 768 + k0 + 8 * h);
            DLr[h] = *(const u32x4*)(l2 + m * 1280 + k0 + 8 * h); ASr[h] = *(const u32x4*)(l2 + m * 1280 + 512 + k0 + 8 * h); }
        const int vv = lane >> 2, sg = lane & 3;
#pragma unroll
        for (int j = 0; j < 4; ++j) vr[j] = rk[tok(16 * ch + 4 * sg + j) * 1024 + 512 + 16 * qs + vv];
    };
    auto produce = [&](int slot) {
        LAS unsigned char* sb = c.lds + slot * RC_SLOT; LAS float* Aab = (LAS float*)(c.lds + RC_SCR0 + (wave - 1) * RC_SCR);
        LAS unsigned char* Bh = sb + RC_BH; LAS unsigned char* Kh = sb + RC_KH;
        {
            const int vv = lane >> 2, sg = lane & 3;
            *(LAS u32x2*)(sb + RC_VT + vv * RC_S16 + sg * 8) = (u32x2){(unsigned)vr[0] | ((unsigned)vr[1] << 16), (unsigned)vr[2] | ((unsigned)vr[3] << 16)};
        }
        const int k0 = 16 * q;
#pragma unroll
        for (int h = 0; h < 2; ++h) {
            float r_[8], k_[8], kk_[8], dl_[8], as_[8], cs_[8]; unpack8(Rr[h], r_); unpack8(Kr[h], k_); unpack8(KKr[h], kk_); unpack8(DLr[h], dl_); unpack8(ASr[h], as_);
            const f32x4 ka0 = *(const f32x4*)(c.in[I_KA] + (size_t)l * 256 + head * 64 + k0 + 8 * h), ka1 = *(const f32x4*)(c.in[I_KA] + (size_t)l * 256 + head * 64 + k0 + 8 * h + 4);
            const float ka[8] = {ka0.x, ka0.y, ka0.z, ka0.w, ka1.x, ka1.y, ka1.z, ka1.w};
            float at_[8], rt_[8], bh_[8], kh_[8], p_[8];
#pragma unroll
            for (int e = 0; e < 8; ++e) {
                float x = dl_[e];
                x += dpp_mov<0x111>(x); x += dpp_mov<0x112>(x); x += dpp_mov<0x114>(x); x += dpp_mov<0x118>(x);
                cs_[e] = x;
            }
#pragma unroll
            for (int e = 0; e < 8; ++e) {
                const float P = __expf(cs_[e]), Pm = __expf(cs_[e] - dl_[e]), iP = __expf(-cs_[e]);
                at_[e] = -kk_[e] * Pm; rt_[e] = r_[e] * P; bh_[e] = kk_[e] * as_[e] * iP; kh_[e] = k_[e] * (1.f + (as_[e] - 1.f) * ka[e]) * iP; p_[e] = P;
            }
            *(LAS u32x4*)(sb + RC_AT + li * RC_S64 + (k0 + 8 * h) * 2) = pack8(at_); *(LAS u32x4*)(sb + RC_RT + li * RC_S64 + (k0 + 8 * h) * 2) = pack8(rt_);
            *(LAS u32x4*)(Bh + li * RC_S64 + (k0 + 8 * h) * 2) = pack8(bh_); *(LAS u32x4*)(Kh + li * RC_S64 + (k0 + 8 * h) * 2) = pack8(kh_);
            if (li == 15) { *(LAS f32x4*)(sb + RC_P16 + (k0 + 8 * h) * 4) = (f32x4){p_[0], p_[1], p_[2], p_[3]}; *(LAS f32x4*)(sb + RC_P16 + (k0 + 8 * h + 4) * 4) = (f32x4){p_[4], p_[5], p_[6], p_[7]}; }
        }
        asm volatile("s_waitcnt lgkmcnt(0)" ::: "memory");
        f32x4 ab = (f32x4){0.f, 0.f, 0.f, 0.f}, ak = ab, rb = ab, rkm = ab;
#pragma unroll
        for (int ks = 0; ks < 2; ++ks) {
            const bf16x8 fa = *(const LAS bf16x8*)(sb + RC_AT + li * RC_S64 + (32 * ks + 8 * q) * 2), fr = *(const LAS bf16x8*)(sb + RC_RT + li * RC_S64 + (32 * ks + 8 * q) * 2);
            const bf16x8 fb = *(const LAS bf16x8*)(Bh + li * RC_S64 + (32 * ks + 8 * q) * 2), fk = *(const LAS bf16x8*)(Kh + li * RC_S64 + (32 * ks + 8 * q) * 2);
            ab = __builtin_amdgcn_mfma_f32_16x16x32_bf16(fa, fb, ab, 0, 0, 0); ak = __builtin_amdgcn_mfma_f32_16x16x32_bf16(fa, fk, ak, 0, 0, 0);
            rb = __builtin_amdgcn_mfma_f32_16x16x32_bf16(fr, fb, rb, 0, 0, 0); rkm = __builtin_amdgcn_mfma_f32_16x16x32_bf16(fr, fk, rkm, 0, 0, 0);
        }
#pragma unroll
        for (int r = 0; r < 4; ++r) {
            const int t = 4 * q + r, s = li;
            Aab[t * 20 + s] = s < t ? ab[r] : 0.f;
            *(LAS bf16_t*)(sb + RC_AAK + t * RC_S16 + s * 2) = (bf16_t)f2bf(s < t ? ak[r] : 0.f);
            *(LAS bf16_t*)(sb + RC_ARB + t * RC_S16 + s * 2) = (bf16_t)f2bf(s <= t ? rb[r] : 0.f);
            *(LAS bf16_t*)(sb + RC_ARK + t * RC_S16 + s * 2) = (bf16_t)f2bf(s <= t ? rkm[r] : 0.f);
        }
        asm volatile("s_waitcnt lgkmcnt(0)" ::: "memory");
        float tc[16];
#pragma unroll
        for (int t = 0; t < 16; ++t) {
            float acc = (t == li) ? 1.f : 0.f;
            f32x4 a0 = *(const LAS f32x4*)(Aab + t * 20), a1 = *(const LAS f32x4*)(Aab + t * 20 + 4), a2 = *(const LAS f32x4*)(Aab + t * 20 + 8), a3 = *(const LAS f32x4*)(Aab + t * 20 + 12);
            const float av[16] = {a0.x, a0.y, a0.z, a0.w, a1.x, a1.y, a1.z, a1.w, a2.x, a2.y, a2.z, a2.w, a3.x, a3.y, a3.z, a3.w};
#pragma unroll
            for (int s = 0; s < t; ++s) acc += av[s] * tc[s];
            tc[t] = acc;
        }
        if (q == 0) {
#pragma unroll
            for (int t = 0; t < 16; ++t) *(LAS bf16_t*)(sb + RC_T + t * RC_S16 + li * 2) = (bf16_t)f2bf(tc[t]);
        }
    };
    if (wave >= 1 && wave <= RC_NP) { const int ch0 = wave - 1; load_raw(ch0); produce(wave - 1); load_raw(ch0 + RC_NP); }
    __syncthreads();
    f32x4 S[4]; bf16x8 sop[2];
#pragma unroll
    for (int kt = 0; kt < 4; ++kt) S[kt] = (f32x4){0.f, 0.f, 0.f, 0.f};
    sop[0] = (bf16x8){0, 0, 0, 0, 0, 0, 0, 0}; sop[1] = sop[0];
    int sbase = 0;
    auto consume = [&](const int i, const int ch) {
                const LAS unsigned char* sb = c.lds + (sbase + i) * RC_SLOT;
        const s16x4v vt = mfma16_frag(sb + RC_VT, li, q);
        f32x4 aw = mm16(mfma16_frag(sb + RC_AAK, li, q), vt, (f32x4){0.f, 0.f, 0.f, 0.f}, 0, 0, 0);
        f32x4 ay = mm16(mfma16_frag(sb + RC_ARK, li, q), vt, (f32x4){0.f, 0.f, 0.f, 0.f}, 0, 0, 0);
#pragma unroll
        for (int ks = 0; ks < 2; ++ks) {
            const s16x4v alo = *(const LAS s16x4v*)(sb + RC_AT + li * RC_S64 + (32 * ks + 4 * q) * 2), ahi = *(const LAS s16x4v*)(sb + RC_AT + li * RC_S64 + (32 * ks + 16 + 4 * q) * 2);
            const s16x4v rlo = *(const LAS s16x4v*)(sb + RC_RT + li * RC_S64 + (32 * ks + 4 * q) * 2), rhi = *(const LAS s16x4v*)(sb + RC_RT + li * RC_S64 + (32 * ks + 16 + 4 * q) * 2);
            aw = __builtin_amdgcn_mfma_f32_16x16x32_bf16((bf16x8){alo[0], alo[1], alo[2], alo[3], ahi[0], ahi[1], ahi[2], ahi[3]}, sop[ks], aw, 0, 0, 0);
            ay = __builtin_amdgcn_mfma_f32_16x16x32_bf16((bf16x8){rlo[0], rlo[1], rlo[2], rlo[3], rhi[0], rhi[1], rhi[2], rhi[3]}, sop[ks], ay, 0, 0, 0);
        }
        const u32x2 wb2 = (u32x2){pk2(aw[0], aw[1]), pk2(aw[2], aw[3])};
        const f32x4 au = mm16(mfma16_frag(sb + RC_T, li, q), __builtin_bit_cast(s16x4v, wb2), (f32x4){0.f, 0.f, 0.f, 0.f}, 0, 0, 0);
        const u32x2 ub2 = (u32x2){pk2(au[0], au[1]), pk2(au[2], au[3])}; const s16x4v ub = __builtin_bit_cast(s16x4v, ub2);
        ay = mm16(mfma16_frag(sb + RC_ARB, li, q), ub, ay, 0, 0, 0);
#pragma unroll
        for (int kt = 0; kt < 4; ++kt) {
            const f32x4 p16 = *(const LAS f32x4*)(sb + RC_P16 + (16 * kt + 4 * q) * 4);
            const int troff = (4 * q + (li >> 2)) * RC_S64 + (16 * kt + 4 * (li & 3)) * 2;
            f32x4 sv = S[kt];
            sv = mm16(lds_tr(sb + RC_KH + troff), vt, sv, 0, 0, 0);
            sv = mm16(lds_tr(sb + RC_BH + troff), ub, sv, 0, 0, 0);
            sv = sv * p16;
            S[kt] = sv;
        }
#pragma unroll
        for (int ks = 0; ks < 2; ++ks) {
            const u32x4 w = (u32x4){pk2(S[2 * ks][0], S[2 * ks][1]), pk2(S[2 * ks][2], S[2 * ks][3]), pk2(S[2 * ks + 1][0], S[2 * ks + 1][1]), pk2(S[2 * ks + 1][2], S[2 * ks + 1][3])};
            sop[ks] = __builtin_bit_cast(bf16x8, w);
        }
#pragma unroll
        for (int r = 0; r < 4; ++r) yo[tok(16 * ch + 4 * q + r) * 256 + li] = (bf16_t)f2bf(ay[r]);
    };
    for (int rd = 0; rd < RC_ROUNDS; ++rd) {
        if (wave == 0) {
            sbase = (rd & 1) * RC_NP;
            if (rd < RC_ROUNDS - 1) {
#pragma unroll
                for (int i = 0; i < RC_NP; ++i) consume(i, RC_NP * rd + i);
            } else {
                for (int i = 0; i < RC_NP; ++i) { const int ch = RC_NP * rd + i; if (ch >= RC_NCH) break; consume(i, ch); }
            }
        } else if (wave <= RC_NP) {
            const int chn = RC_NP * (rd + 1) + (wave - 1);
            if (chn < RC_NCH) { produce(((rd + 1) & 1) * RC_NP + (wave - 1)); if (chn + RC_NP < RC_NCH) load_raw(chn + RC_NP); }
        }
        __syncthreads();
    }
}constexpr int RC64_NP = 4, RC64_ROUNDS = (RC_NCH + RC64_NP - 1) / RC64_NP;
constexpr int RC64_V = 11776, RC64_P16 = 14080, RC64_SLOT = 14336;
constexpr int RC64_SCR0 = 2 * RC64_NP * RC64_SLOT;
static_assert(RC64_SCR0 + RC64_NP * RC_SCR <= 147456 - 512, "rwkv64 LDS");
__device__ __forceinline__ void rwkv_chunked64(const Ctx& cx_, int l) {
    const Ctx c = relaunder(cx_);


    const int bid = c.bid, dir = bid & 1, head = (bid >> 1) & 3, b = bid >> 3;
    const int lane = c.lane, wave = c.wave;
    const bf16_t* rk = (const bf16_t*)(c.dout + DO_RKVP) + head * 64; const bf16_t* l2 = (const bf16_t*)(c.ws + WS_L2O) + dir * 256 + head * 64;
    bf16_t* yo = (bf16_t*)(c.ws + WS_YRW) + (size_t)dir * MP * 256 + head * 64 + 16 * (wave & 3);
    auto tok = [&](int s) -> size_t { const int t = s + dir * (LEN - 1 - 2 * s); return (size_t)row_of(b, t); };
    const int q = lane >> 4, li = lane & 15;
    u32x4 Rr[2], Kr[2], KKr[2], DLr[2], ASr[2], Vr[2];
    auto load_raw = [&](int ch) {
        const size_t m = tok(16 * ch + li); const int k0 = 16 * q;
#pragma unroll
        for (int h = 0; h < 2; ++h) { Rr[h] = *(const u32x4*)(rk + m * 1024 + k0 + 8 * h); Kr[h] = *(const u32x4*)(rk + m * 1024 + 256 + k0 + 8 * h); KKr[h] = *(const u32x4*)(rk + m * 1024 + 768 + k0 + 8 * h);
            DLr[h] = *(const u32x4*)(l2 + m * 1280 + k0 + 8 * h); ASr[h] = *(const u32x4*)(l2 + m * 1280 + 512 + k0 + 8 * h); Vr[h] = *(const u32x4*)(rk + m * 1024 + 512 + k0 + 8 * h); }
    };
    auto produce = [&](int slot) {
        LAS unsigned char* sb = c.lds + slot * RC64_SLOT; LAS float* Aab = (LAS float*)(c.lds + RC64_SCR0 + (wave - 4) * RC_SCR);
        LAS unsigned char* Bh = sb + RC_BH; LAS unsigned char* Kh = sb + RC_KH;
        *(LAS u32x4*)(sb + RC64_V + li * RC_S64 + (16 * q) * 2) = Vr[0]; *(LAS u32x4*)(sb + RC64_V + li * RC_S64 + (16 * q + 8) * 2) = Vr[1];
        const int k0 = 16 * q;
#pragma unroll
        for (int h = 0; h < 2; ++h) {
            float r_[8], k_[8], kk_[8], dl_[8], as_[8], cs_[8]; unpack8(Rr[h], r_); unpack8(Kr[h], k_); unpack8(KKr[h], kk_); unpack8(DLr[h], dl_); unpack8(ASr[h], as_);
            const f32x4 ka0 = *(const f32x4*)(c.in[I_KA] + (size_t)l * 256 + head * 64 + k0 + 8 * h), ka1 = *(const f32x4*)(c.in[I_KA] + (size_t)l * 256 + head * 64 + k0 + 8 * h + 4);
            const float ka[8] = {ka0.x, ka0.y, ka0.z, ka0.w, ka1.x, ka1.y, ka1.z, ka1.w};
            float at_[8], rt_[8], bh_[8], kh_[8], p_[8];
#pragma unroll
            for (int e = 0; e < 8; ++e) {
                float x = dl_[e];
                x += dpp_mov<0x111>(x); x += dpp_mov<0x112>(x); x += dpp_mov<0x114>(x); x += dpp_mov<0x118>(x);
                cs_[e] = x;
            }
#pragma unroll
            for (int e = 0; e < 8; ++e) {
                const float P = __expf(cs_[e]), Pm = __expf(cs_[e] - dl_[e]), iP = __expf(-cs_[e]);
                at_[e] = -kk_[e] * Pm; rt_[e] = r_[e] * P; bh_[e] = kk_[e] * as_[e] * iP; kh_[e] = k_[e] * (1.f + (as_[e] - 1.f) * ka[e]) * iP; p_[e] = P;
            }
            *(LAS u32x4*)(sb + RC_AT + li * RC_S64 + (k0 + 8 * h) * 2) = pack8(at_); *(LAS u32x4*)(sb + RC_RT + li * RC_S64 + (k0 + 8 * h) * 2) = pack8(rt_);
            *(LAS u32x4*)(Bh + li * RC_S64 + (k0 + 8 * h) * 2) = pack8(bh_); *(LAS u32x4*)(Kh + li * RC_S64 + (k0 + 8 * h) * 2) = pack8(kh_);
            if (li == 15) { *(LAS f32x4*)(sb + RC64_P16 + (k0 + 8 * h) * 4) = (f32x4){p_[0], p_[1], p_[2], p_[3]}; *(LAS f32x4*)(sb + RC64_P16 + (k0 + 8 * h + 4) * 4) = (f32x4){p_[4], p_[5], p_[6], p_[7]}; }
        }
        asm volatile("s_waitcnt lgkmcnt(0)" ::: "memory");
        f32x4 ab = (f32x4){0.f, 0.f, 0.f, 0.f}, ak = ab, rb = ab, rkm = ab;
#pragma unroll
        for (int ks = 0; ks < 2; ++ks) {
            const bf16x8 fa = *(const LAS bf16x8*)(sb + RC_AT + li * RC_S64 + (32 * ks + 8 * q) * 2), fr = *(const LAS bf16x8*)(sb + RC_RT + li * RC_S64 + (32 * ks + 8 * q) * 2);
            const bf16x8 fb = *(const LAS bf16x8*)(Bh + li * RC_S64 + (32 * ks + 8 * q) * 2), fk = *(const LAS bf16x8*)(Kh + li * RC_S64 + (32 * ks + 8 * q) * 2);
            ab = __builtin_amdgcn_mfma_f32_16x16x32_bf16(fa, fb, ab, 0, 0, 0); ak = __builtin_amdgcn_mfma_f32_16x16x32_bf16(fa, fk, ak, 0, 0, 0);
            rb = __builtin_amdgcn_mfma_f32_16x16x32_bf16(fr, fb, rb, 0, 0, 0); rkm = __builtin_amdgcn_mfma_f32_16x16x32_bf16(fr, fk, rkm, 0, 0, 0);
        }
#pragma unroll
        for (int r = 0; r < 4; ++r) {
            const int t = 4 * q + r, s = li;
            Aab[t * 20 + s] = s < t ? ab[r] : 0.f;
            *(LAS bf16_t*)(sb + RC_AAK + t * RC_S16 + s * 2) = (bf16_t)f2bf(s < t ? ak[r] : 0.f);
            *(LAS bf16_t*)(sb + RC_ARB + t * RC_S16 + s * 2) = (bf16_t)f2bf(s <= t ? rb[r] : 0.f);
            *(LAS bf16_t*)(sb + RC_ARK + t * RC_S16 + s * 2) = (bf16_t)f2bf(s <= t ? rkm[r] : 0.f);
        }
        asm volatile("s_waitcnt lgkmcnt(0)" ::: "memory");
        float tc[16];
#pragma unroll
        for (int t = 0; t < 16; ++t) {
            float acc = (t == li) ? 1.f : 0.f;
            f32x4 a0 = *(const LAS f32x4*)(Aab + t * 20), a1 = *(const LAS f32x4*)(Aab + t * 20 + 4), a2 = *(const LAS f32x4*)(Aab + t * 20 + 8), a3 = *(const LAS f32x4*)(Aab + t * 20 + 12);
            const float av[16] = {a0.x, a0.y, a0.z, a0.w, a1.x, a1.y, a1.z, a1.w, a2.x, a2.y, a2.z, a2.w, a3.x, a3.y, a3.z, a3.w};
#pragma unroll
            for (int s = 0; s < t; ++s) acc += av[s] * tc[s];
            tc[t] = acc;
        }
        if (q == 0) {
#pragma unroll
            for (int t = 0; t < 16; ++t) *(LAS bf16_t*)(sb + RC_T + t * RC_S16 + li * 2) = (bf16_t)f2bf(tc[t]);
        }
    };
    if (wave >= 4) { const int ch0 = wave - 4; load_raw(ch0); produce(wave - 4); load_raw(ch0 + RC64_NP); }
    __syncthreads();
    f32x4 S[4]; bf16x8 sop[2];
#pragma unroll
    for (int kt = 0; kt < 4; ++kt) S[kt] = (f32x4){0.f, 0.f, 0.f, 0.f};
    sop[0] = (bf16x8){0, 0, 0, 0, 0, 0, 0, 0}; sop[1] = sop[0];
    int sbase = 0;
    auto consume = [&](const int i, const int ch) {
                const LAS unsigned char* sb = c.lds + (sbase + i) * RC64_SLOT;
        const s16x4v vt = lds_tr(sb + RC64_V + (4 * q + (li >> 2)) * RC_S64 + (16 * (wave & 3) + 4 * (li & 3)) * 2);
        f32x4 aw = mm16(mfma16_frag(sb + RC_AAK, li, q), vt, (f32x4){0.f, 0.f, 0.f, 0.f}, 0, 0, 0);
        f32x4 ay = mm16(mfma16_frag(sb + RC_ARK, li, q), vt, (f32x4){0.f, 0.f, 0.f, 0.f}, 0, 0, 0);
#pragma unroll
        for (int ks = 0; ks < 2; ++ks) {
            const s16x4v alo = *(const LAS s16x4v*)(sb + RC_AT + li * RC_S64 + (32 * ks + 4 * q) * 2), ahi = *(const LAS s16x4v*)(sb + RC_AT + li * RC_S64 + (32 * ks + 16 + 4 * q) * 2);
            const s16x4v rlo = *(const LAS s16x4v*)(sb + RC_RT + li * RC_S64 + (32 * ks + 4 * q) * 2), rhi = *(const LAS s16x4v*)(sb + RC_RT + li * RC_S64 + (32 * ks + 16 + 4 * q) * 2);
            aw = __builtin_amdgcn_mfma_f32_16x16x32_bf16((bf16x8){alo[0], alo[1], alo[2], alo[3], ahi[0], ahi[1], ahi[2], ahi[3]}, sop[ks], aw, 0, 0, 0);
            ay = __builtin_amdgcn_mfma_f32_16x16x32_bf16((bf16x8){rlo[0], rlo[1], rlo[2], rlo[3], rhi[0], rhi[1], rhi[2], rhi[3]}, sop[ks], ay, 0, 0, 0);
        }
        const u32x2 wb2 = (u32x2){pk2(aw[0], aw[1]), pk2(aw[2], aw[3])};
        const f32x4 au = mm16(mfma16_frag(sb + RC_T, li, q), __builtin_bit_cast(s16x4v, wb2), (f32x4){0.f, 0.f, 0.f, 0.f}, 0, 0, 0);
        const u32x2 ub2 = (u32x2){pk2(au[0], au[1]), pk2(au[2], au[3])}; const s16x4v ub = __builtin_bit_cast(s16x4v, ub2);
        ay = mm16(mfma16_frag(sb + RC_ARB, li, q), ub, ay, 0, 0, 0);
#pragma unroll
        for (int kt = 0; kt < 4; ++kt) {
            const f32x4 p16 = *(const LAS f32x4*)(sb + RC64_P16 + (16 * kt + 4 * q) * 4);
            const int troff = (4 * q + (li >> 2)) * RC_S64 + (16 * kt + 4 * (li & 3)) * 2;
            f32x4 sv = S[kt];
            sv = mm16(lds_tr(sb + RC_KH + troff), vt, sv, 0, 0, 0);
            sv = mm16(lds_tr(sb + RC_BH + troff), ub, sv, 0, 0, 0);
            sv = sv * p16;
            S[kt] = sv;
        }
#pragma unroll
        for (int ks = 0; ks < 2; ++ks) {
            const u32x4 w = (u32x4){pk2(S[2 * ks][0], S[2 * ks][1]), pk2(S[2 * ks][2], S[2 * ks][3]), pk2(S[2 * ks + 1][0], S[2 * ks + 1][1]), pk2(S[2 * ks + 1][2], S[2 * ks + 1][3])};
            sop[ks] = __builtin_bit_cast(bf16x8, w);
        }
#pragma unroll
        for (int r = 0; r < 4; ++r) yo[tok(16 * ch + 4 * q + r) * 256 + li] = (bf16_t)f2bf(ay[r]);
    };
    for (int rd = 0; rd < RC64_ROUNDS; ++rd) {
        if (wave < 4) {
            sbase = (rd & 1) * RC64_NP;
            if (rd < RC64_ROUNDS - 1) {
#pragma unroll
                for (int i = 0; i < RC64_NP; ++i) consume(i, RC64_NP * rd + i);
            } else {
                for (int i = 0; i < RC64_NP; ++i) { const int ch = RC64_NP * rd + i; if (ch >= RC_NCH) break; consume(i, ch); }
            }
        } else {
            const int chn = RC64_NP * (rd + 1) + (wave - 4);
            if (chn < RC_NCH) { produce(((rd + 1) & 1) * RC64_NP + (wave - 4)); if (chn + RC64_NP < RC_NCH) load_raw(chn + RC64_NP); }
        }
        __syncthreads();
    }
}
constexpr int RW_T = 32, RW_NC = (LEN + RW_T - 1) / RW_T, RW_BUF = 45056;
__device__ __forceinline__ void rwkv_scan(const Ctx& cx_, int l) {
    const Ctx c = relaunder(cx_);
    const int bid = c.bid, q = bid & 3, dir = 1 - ((bid >> 2) & 1), head = (bid >> 3) & 3, b = bid >> 5;
    const int tid = c.tid, lane = c.lane, wave = c.wave;
    const bf16_t* rk = (const bf16_t*)(c.dout + DO_RKVP); const bf16_t* l2 = (const bf16_t*)(c.ws + WS_L2O);
    bf16_t* yo = (bf16_t*)(c.ws + WS_YRW) + (size_t)dir * MP * 256;
    const bool producer = wave >= 4;
    const int pt = tid - 256, pstep = pt >> 3, pc0 = (pt & 7) * 8, pv0 = 2 * (pt & 7);
    float ka[8];
    u32x4 R, K, KK, DL, AS; unsigned V2 = 0; R = K = KK = DL = AS = (u32x4){0u, 0u, 0u, 0u};
    if (producer) {
#pragma unroll
        for (int e = 0; e < 8; ++e) ka[e] = c.in[I_KA][(size_t)l * 256 + head * 64 + pc0 + e];
    }
    auto tok = [&](int s) -> size_t { const int t = dir ? LEN - 1 - s : s; return (size_t)row_of(b, t); };
#define RW_LOAD(chunk) do { const int s_ = (chunk) * RW_T + pstep; if (s_ < LEN) { const size_t m_ = tok(s_); const bf16_t* rp_ = rk + m_ * 1024 + head * 64; const bf16_t* lp_ = l2 + m_ * 1280 + dir * 256 + head * 64; \
        R = *(const u32x4*)(rp_ + pc0); K = *(const u32x4*)(rp_ + 256 + pc0); KK = *(const u32x4*)(rp_ + 768 + pc0); V2 = *(const unsigned*)(rp_ + 512 + 16 * q + pv0); \
        DL = *(const u32x4*)(lp_ + pc0); AS = *(const u32x4*)(lp_ + 512 + pc0); } } while (0)
#define RW_WRITE(buf) do { LAS float* vec_ = (LAS float*)(c.lds + (buf) * RW_BUF); float r_[8], k_[8], kk_[8], dl_[8], as_[8]; unpack8(R, r_); unpack8(K, k_); unpack8(KK, kk_); unpack8(DL, dl_); unpack8(AS, as_); \
        float w_[8], a_[8], b_[8], kd_[8]; _Pragma("unroll") for (int e = 0; e < 8; ++e) { w_[e] = __expf(dl_[e]); a_[e] = -kk_[e]; b_[e] = kk_[e] * as_[e]; kd_[e] = k_[e] * (1.f + (as_[e] - 1.f) * ka[e]); } \
        LAS float* bp_ = vec_ + pstep * 320 + pc0; \
        *(LAS f32x4*)(bp_) = (f32x4){w_[0], w_[1], w_[2], w_[3]}; *(LAS f32x4*)(bp_ + 4) = (f32x4){w_[4], w_[5], w_[6], w_[7]}; \
        *(LAS f32x4*)(bp_ + 64) = (f32x4){a_[0], a_[1], a_[2], a_[3]}; *(LAS f32x4*)(bp_ + 68) = (f32x4){a_[4], a_[5], a_[6], a_[7]}; \
        *(LAS f32x4*)(bp_ + 128) = (f32x4){b_[0], b_[1], b_[2], b_[3]}; *(LAS f32x4*)(bp_ + 132) = (f32x4){b_[4], b_[5], b_[6], b_[7]}; \
        *(LAS f32x4*)(bp_ + 192) = (f32x4){kd_[0], kd_[1], kd_[2], kd_[3]}; *(LAS f32x4*)(bp_ + 196) = (f32x4){kd_[4], kd_[5], kd_[6], kd_[7]}; \
        *(LAS f32x4*)(bp_ + 256) = (f32x4){r_[0], r_[1], r_[2], r_[3]}; *(LAS f32x4*)(bp_ + 260) = (f32x4){r_[4], r_[5], r_[6], r_[7]}; \
        LAS float* vr_ = vec_ + 10240 + pstep * 16 + pv0; vr_[0] = bflo(V2); vr_[1] = bfhi(V2); } while (0)
#define RW_FLUSH(chunk) do { const int s_ = (chunk) * RW_T + pstep; if (s_ < LEN) { const LAS float* yy_ = (const LAS float*)(c.lds + ((chunk) & 1) * RW_BUF) + 10752 + pstep * 16 + pv0; \
        *(unsigned*)(yo + tok(s_) * 256 + head * 64 + 16 * q + pv0) = pk2(yy_[0], yy_[1]); } } while (0)
    if (producer) { RW_LOAD(0); RW_WRITE(0); RW_LOAD(1); }
    __syncthreads();
    const int rowl = (wave & 3) * 4 + (lane >> 4), j4 = (lane & 15) * 4;
    float S0 = 0.f, S1 = 0.f, S2 = 0.f, S3 = 0.f;
#define RW_SCAN(NS) do { float yv_[NS]; \
        _Pragma("unroll") for (int st = 0; st < NS; ++st) { \
            const LAS float* bp = vec + st * 320 + j4; \
            const f32x4 w = *(const LAS f32x4*)(bp), a = *(const LAS f32x4*)(bp + 64), bb = *(const LAS f32x4*)(bp + 128), kd = *(const LAS f32x4*)(bp + 192), r = *(const LAS f32x4*)(bp + 256); \
            const float v = vec[10240 + st * 16 + rowl]; \
            float sa = (S0 * a.x + S1 * a.y) + (S2 * a.z + S3 * a.w); \
            sa = allred16(sa); \
            S0 = S0 * w.x + v * kd.x; S1 = S1 * w.y + v * kd.y; S2 = S2 * w.z + v * kd.z; S3 = S3 * w.w + v * kd.w; \
            S0 += sa * bb.x; S1 += sa * bb.y; S2 += sa * bb.z; S3 += sa * bb.w; \
            float y = (S0 * r.x + S1 * r.y) + (S2 * r.z + S3 * r.w); \
            yv_[st] = allred16(y); } \
        if ((lane & 15) == 0) { _Pragma("unroll") for (int st = 0; st < NS; ++st) yy[st * 16 + rowl] = yv_[st]; } } while (0)
    for (int ch = 0; ch < RW_NC; ++ch) {
        if (!producer) {
            const LAS float* vec = (const LAS float*)(c.lds + (ch & 1) * RW_BUF);
            LAS float* yy = (LAS float*)(c.lds + (ch & 1) * RW_BUF) + 10752;
            if (ch < RW_NC - 1) RW_SCAN(32); else RW_SCAN(LEN - (RW_NC - 1) * RW_T);
        } else {
            if (ch + 1 < RW_NC) RW_WRITE((ch + 1) & 1);
            if (ch + 2 < RW_NC) RW_LOAD(ch + 2);
            if (ch >= 1) RW_FLUSH(ch - 1);
        }
        __syncthreads();
    }
#undef RW_SCAN
    if (producer) RW_FLUSH(RW_NC - 1);
    __syncthreads();
#undef RW_LOAD
#undef RW_WRITE
#undef RW_FLUSH
}

__device__ __forceinline__ void rwkv_post(const Ctx& cx_, int l) {
    const Ctx c = relaunder(cx_);
    const int gw = c.bid * NWAVES + c.wave, NGW = c.G * NWAVES, lane = c.lane, c0 = 4 * lane;
    const bf16_t* y0 = (const bf16_t*)(c.ws + WS_YRW); const bf16_t* y1 = y0 + (size_t)MP * 256;
    const bf16_t* rk = (const bf16_t*)(c.dout + DO_RKVP); const bf16_t* l2 = (const bf16_t*)(c.ws + WS_L2O); bf16_t* yc = (bf16_t*)(c.ws + WS_YC);
    float lw[4], lb[4], rkw[4];
#pragma unroll
    for (int e = 0; e < 4; ++e) { lw[e] = c.in[I_LNW][(size_t)l * 256 + c0 + e]; lb[e] = c.in[I_LNB][(size_t)l * 256 + c0 + e]; rkw[e] = c.in[I_RK][(size_t)l * 256 + c0 + e]; }
#pragma unroll 2
    for (int m = gw; m < M_ROWS; m += NGW) {
        const u32x2 a = *(const u32x2*)(y0 + (size_t)m * 256 + c0), bq = *(const u32x2*)(y1 + (size_t)m * 256 + c0);
        const u32x2 rr = *(const u32x2*)(rk + (size_t)m * 1024 + c0), kk = *(const u32x2*)(rk + (size_t)m * 1024 + 256 + c0), vv = *(const u32x2*)(rk + (size_t)m * 1024 + 512 + c0);
        const u32x2 gg = *(const u32x2*)(l2 + (size_t)m * 1280 + 1024 + c0);
        float y[4] = {bflo(a.x) + bflo(bq.x), bfhi(a.x) + bfhi(bq.x), bflo(a.y) + bflo(bq.y), bfhi(a.y) + bfhi(bq.y)};
        const float r[4] = {bflo(rr.x), bfhi(rr.x), bflo(rr.y), bfhi(rr.y)}, k[4] = {bflo(kk.x), bfhi(kk.x), bflo(kk.y), bfhi(kk.y)};
        const float v[4] = {bflo(vv.x), bfhi(vv.x), bflo(vv.y), bfhi(vv.y)}, g[4] = {bflo(gg.x), bfhi(gg.x), bflo(gg.y), bfhi(gg.y)};
        const float mean = sum16((y[0] + y[1]) + (y[2] + y[3])) * (1.f / 64.f);
        float q = 0.f, bo = 0.f;
#pragma unroll
        for (int e = 0; e < 4; ++e) { y[e] -= mean; q += y[e] * y[e]; bo += r[e] * k[e] * rkw[e]; }
        q = sum16(q) * (1.f / 64.f); bo = sum16(bo);
        const float rs = __builtin_amdgcn_rsqf(q + 64e-5f);
        float o[4];
#pragma unroll
        for (int e = 0; e < 4; ++e) o[e] = (y[e] * rs * lw[e] + lb[e] + bo * v[e]) * g[e];
        *(u32x2*)(yc + (size_t)m * 256 + c0) = (u32x2){pk2(o[0], o[1]), pk2(o[2], o[3])};
    }
}
__device__ __forceinline__ void final_phase(const Ctx& cx_, float* out) {
    const Ctx c = relaunder(cx_);
    const int gw = c.bid * NWAVES + c.wave, NGW = c.G * NWAVES, lane = c.lane;
    const bf16_t* H = c.H(); const f32x4* fw = (const f32x4*)c.in[I_FNW];
#pragma unroll 2
    for (int r = gw; r < BATCH * SEQ; r += NGW) {
        const size_t m = (size_t)r;
        const u32x2* hp = (const u32x2*)(H + m * DM);
        float v[4][4], ss = 0.f;
#pragma unroll
        for (int i = 0; i < 4; ++i) { const u32x2 w = hp[lane + 64 * i]; v[i][0] = bflo(w.x); v[i][1] = bfhi(w.x); v[i][2] = bflo(w.y); v[i][3] = bfhi(w.y); ss += (v[i][0] * v[i][0] + v[i][1] * v[i][1]) + (v[i][2] * v[i][2] + v[i][3] * v[i][3]); }
        ss = wave_sum(ss); const float s = __builtin_amdgcn_rsqf(ss * (1.0f / DM) + EPS);
        f32x4* op = (f32x4*)(out + (size_t)r * DM);
#pragma unroll
        for (int i = 0; i < 4; ++i) { const f32x4 w = fw[lane + 64 * i]; op[lane + 64 * i] = (f32x4){v[i][0] * s * w.x, v[i][1] * s * w.y, v[i][2] * s * w.z, v[i][3] * s * w.w}; }
    }
}

constexpr int LDS_BYTES = 147456;
#ifndef MIXDIR
#define MIXDIR 0
#define MIXLAYER 0
#endif
#ifndef PHMASK
#define PHMASK 0xFFFFF
#endif
__global__ void __launch_bounds__(NTHREADS, 2) mega_fwd(Params p) {
    extern __shared__ __attribute__((aligned(16))) unsigned char lds_raw[];
    cg::grid_group grid = cg::this_grid();
    Ctx c0_; c0_.in = p.in; c0_.ws = p.ws; c0_.dout = (unsigned char*)p.out; c0_.lds = (LAS unsigned char*)lds_raw;
    c0_.wave = __builtin_amdgcn_readfirstlane((int)threadIdx.x >> 6); c0_.tid = opaque_tid(c0_.wave); c0_.lane = c0_.tid & 63; c0_.G = gridDim.x; c0_.bid = blockIdx.x;
    Ctx c = c0_;
    const int G = c.G, bid = c.bid;
#ifdef PROF_A
#ifndef PROF_SHIFT
#define PROF_SHIFT 1.0f
#endif
#define PROF_PTR ((unsigned long long*)(c.ws + WS_DEC + (size_t)MP * 64))
    if (blockIdx.x == 0 && threadIdx.x == 0) { for (int k = 0; k < 15; ++k) PROF_PTR[k] = 0; PROF_PTR[15] = __builtin_amdgcn_s_memrealtime(); }
#define STAMP(k) do { if (blockIdx.x == 0 && threadIdx.x == 0) { const unsigned long long t_ = __builtin_amdgcn_s_memrealtime(); PROF_PTR[k] += t_ - PROF_PTR[15]; PROF_PTR[15] = t_; } } while (0)
#else
#define STAMP(k) do { } while (0)
#endif
    unsigned* barw = (unsigned*)(c.ws + WS_BAR);
    volatile LAS unsigned* bst = (volatile LAS unsigned*)(c.lds + LDS_BYTES - 64);
    if (bid == 0) for (int i = threadIdx.x; i < XCD_BAR_WORDS + 1024; i += NTHREADS) barw[i < XCD_BAR_WORDS ? i : 4096 + (i - XCD_BAR_WORDS)] = 0u;
    if (threadIdx.x < 2) bst[threadIdx.x] = 0u;
    __syncthreads();
    if (PHMASK & 1) phase0(c);
    grid.sync(); STAMP(0);
    const XcdBarrier xbar = xcd_barrier_post(barw, bst);
#define GRID_BAR() do { xcd_barrier(xbar, c0_.wave); c = relaunder(c0_); } while (0)
#pragma unroll 1
    for (int l = 0; l < DEPTH; ++l) {
#define wb (c.wb(l))
        if (PHMASK & 2) dt_job(c, l);
        if (PHMASK & 4) { SchedPlain S{c.H(), wb + WB_IN, DM, DM, DM, MP / 256, 11, G, bid, 0};
          EpiInProj E{c.ssq(), (bf16_t*)(c.ws + WS_UH), (bf16_t*)(c.ws + WS_PZ), (bf16_t*)(c.ws + WS_PXBC), (bf16_t*)(c.ws + WS_PRKVX)};
          pg8::gemm_phase(c.lds, c.wave, S, E); }
        GRID_BAR(); STAMP(1);
        if (PHMASK & 8) { SchedS5 S{(const bf16_t*)(c.ws + WS_UH), wb + WB_SX, 256, G, bid}; EpiS5X E{(float*)(c.ws + WS_X)}; pg8::gemm_phase(c.lds, c.wave, S, E); }
        if (PHMASK & 16) rwkv_prep(c, l);
        if (PHMASK & 32) ssd_prep(c, l);
        GRID_BAR(); STAMP(2);
        if (PHMASK & 64) s5_scan(c, l);
        if (PHMASK & 4096) ssd_states(c, l);
        if (PHMASK & 128) { SchedPlain S{(const bf16_t*)(c.ws + WS_L1IN), wb + WB_L1, 512, 512, 512, MP / 256, 2, G, bid, 0}; EpiL1 E{(bf16_t*)(c.ws + WS_L1O)}; pg8::gemm_phase(c.lds, c.wave, S, E); }
        GRID_BAR(); STAMP(3);
        ssd_chunk_scan(c, l);
        if (PHMASK & 256) { SchedL2 S{(const bf16_t*)(c.ws + WS_L1O), wb + WB_L2, G, bid, MP / 256, 0}; EpiL2 E{(bf16_t*)(c.ws + WS_L2O), c.in[I_W0] + (size_t)l * 512, c.in[I_A0] + (size_t)l * 512}; pg8::gemm_phase(c.lds, c.wave, S, E); }
        if (PHMASK & 512) { SchedS5 S{(const bf16_t*)(c.ws + WS_UH), wb + WB_SY, 512, G, bid}; EpiS5Y E{(bf16_t*)(c.ws + WS_YAPRE)}; pg8::gemm_phase(c.lds, c.wave, S, E); }
        GRID_BAR(); STAMP(4);
        if (bid < 64) { if (PHMASK & 1024) rwkv_chunked64(c, l); }
        else { if (PHMASK & 2048) ssd_outputs(c, l, 64, G - 64); }
        STAMP(5);
        GRID_BAR(); STAMP(6);
#ifdef RWKV_DBG
        if (l == 0) { unsigned* dbg = (unsigned*)(c.ws + WS_BAR + 16384); const bf16_t* y0_ = (const bf16_t*)(c.ws + WS_YRW); const bf16_t* y1_ = (const bf16_t*)(c.ws + WS_MIX + 33 * QB / 2);
          float s0 = 0.f, d0 = 0.f, s1 = 0.f, d1 = 0.f; const bf16_t* y0b_ = y0_ + (size_t)MP * 256; const bf16_t* y1b_ = (const bf16_t*)(c.ws + WS_MIX + 47 * QB / 2);
          for (size_t i = (size_t)bid * NTHREADS + threadIdx.x; i < (size_t)M_ROWS * 256; i += (size_t)G * NTHREADS) { const float a = bf1(y0_[i]), b2 = bf1(y1_[i]), a1 = bf1(y0b_[i]), b1 = bf1(y1b_[i]);
            s0 += a * a; d0 += (a - b2) * (a - b2); s1 += a1 * a1; d1 += (a1 - b1) * (a1 - b1); }
          s0 = wave_sum(s0); d0 = wave_sum(d0); s1 = wave_sum(s1); d1 = wave_sum(d1);
          if ((threadIdx.x & 63) == 0) { atomicAdd((float*)dbg + 0, s0); atomicAdd((float*)dbg + 1, d0); atomicAdd((float*)dbg + 2, s1); atomicAdd((float*)dbg + 3, d1); } }
#endif
        if (PHMASK & 8192) rwkv_post(c, l);
        if (PHMASK & 16384) { SchedPlain S{(const bf16_t*)(c.ws + WS_YAPRE), wb + WB_GLU, 256, 256, 256, MP / 256, 2, G, bid, 0}; EpiGLU E{(bf16_t*)(c.ws + WS_YA), c.in[I_GLUB] + (size_t)l * 512}; pg8::gemm_phase(c.lds, c.wave, S, E); }
        GRID_BAR(); STAMP(7);
        if (PHMASK & 32768) { SchedProj S{c.H(), wb + WB_G, wb + WB_P, (const bf16_t*)(c.ws + WS_YA), (const bf16_t*)(c.ws + WS_YB), (const bf16_t*)(c.ws + WS_YC), (l < DEPTH - 1 ? MP / 256 : BATCH * SEQ / 256), G, bid, 0};
          EpiProj E{c.ssq(), (const float*)(c.ws + WS_SSQB), c.ws + WS_PARK + (size_t)bid * 393216, (bf16_t*)(c.dout + DO_MERGED), opaque_tid(c.wave)}; pg8::gemm_phase(c.lds, c.wave, S, E); }
        GRID_BAR(); STAMP(8);
        if (PHMASK & 65536) { SchedPlain S{(const bf16_t*)(c.dout + DO_MERGED), wb + WB_O, DM, DM, DM, (l < DEPTH - 1 ? MP / 256 : BATCH * SEQ / 256), 4, G, bid, 0}; EpiResid E{c.H(), c.ssq()}; pg8::gemm_phase(c.lds, c.wave, S, E); }
        GRID_BAR(); STAMP(9);
        if (PHMASK & 131072) { SchedPlain S{c.H(), wb + WB_1, DM, DM, DM, (l < DEPTH - 1 ? MP / 256 : BATCH * SEQ / 256), 16, G, bid, 0}; EpiUp E{c.ssq(), (bf16_t*)(c.ws + WS_ACT)}; pg8::gemm_phase(c.lds, c.wave, S, E); }
        GRID_BAR(); STAMP(10);
        if (PHMASK & 262144) { SchedPlain S{(const bf16_t*)(c.ws + WS_ACT), wb + WB_2, DFF, DFF, DFF, (l < DEPTH - 1 ? MP / 256 : BATCH * SEQ / 256), 4, G, bid, 0}; EpiResid E{c.H(), c.ssq()}; pg8::gemm_phase(c.lds, c.wave, S, E); }
        GRID_BAR(); STAMP(11);
    }
    if (PHMASK & 524288) final_phase(c, p.out);
#ifdef RWKV_DBG
    GRID_BAR();
    if (blockIdx.x == 0) { const unsigned* dbg = (const unsigned*)(c.ws + WS_BAR + 16384); const float s0 = __uint_as_float(__hip_atomic_load(dbg + 0, __ATOMIC_RELAXED, __HIP_MEMORY_SCOPE_AGENT)), d0 = __uint_as_float(__hip_atomic_load(dbg + 1, __ATOMIC_RELAXED, __HIP_MEMORY_SCOPE_AGENT)), s1 = __uint_as_float(__hip_atomic_load(dbg + 2, __ATOMIC_RELAXED, __HIP_MEMORY_SCOPE_AGENT)), d1 = __uint_as_float(__hip_atomic_load(dbg + 3, __ATOMIC_RELAXED, __HIP_MEMORY_SCOPE_AGENT));
        float va = 100.f + 10000.f * sqrtf(d1 / s1), vb = 100.f + 10000.f * sqrtf(d0 / s0);
        va = rintf(va * 0.1f) * 10.f; vb = rintf(vb * 0.1f) * 10.f;
        for (int i = threadIdx.x; i < (1 << 20); i += NTHREADS) p.out[1 + i] = vb;
        if (threadIdx.x == 0) p.out[0] = 100.f * va; }
#endif
#ifdef PROF_A
    GRID_BAR(); STAMP(12);
    if (blockIdx.x == 0) {
        __syncthreads();
        float va = (float)(__hip_atomic_load(&PROF_PTR[PROF_A], __ATOMIC_RELAXED, __HIP_MEMORY_SCOPE_AGENT)) * 0.01f, vb = (float)(__hip_atomic_load(&PROF_PTR[PROF_B], __ATOMIC_RELAXED, __HIP_MEMORY_SCOPE_AGENT)) * 0.01f;
        va = exp2f(rintf(log2f(va * PROF_SHIFT) * 2.f) * 0.5f); vb = exp2f(rintf(log2f(vb * PROF_SHIFT) * 2.f) * 0.5f);
        for (int i = threadIdx.x; i < (1 << 20); i += NTHREADS) p.out[1 + i] = vb;
        if (threadIdx.x == 0) p.out[0] = 100.f * va;
    }
#endif
}

extern "C" void kernel_launch(void* const* d_in, const int* in_sizes, int n_in, void* d_out, int out_size, void* d_ws, size_t ws_size, hipStream_t stream) {
    static int grid = 0;
    if (grid == 0) {
        int dev = 0, cus = 0, per_cu = 0;
        if (n_in != N_INPUTS || out_size != BATCH * SEQ * DM || ws_size < WS_END) { fprintf(stderr, "kernel_launch: unexpected shapes (n_in %d out %d ws %zu)\n", n_in, out_size, ws_size); grid = -1; return; }
        (void)hipGetDevice(&dev); (void)hipDeviceGetAttribute(&cus, hipDeviceAttributeMultiprocessorCount, dev);
        (void)hipFuncSetAttribute((const void*)mega_fwd, hipFuncAttributeMaxDynamicSharedMemorySize, LDS_BYTES);
        (void)hipOccupancyMaxActiveBlocksPerMultiprocessor(&per_cu, (const void*)mega_fwd, NTHREADS, LDS_BYTES);
        if (per_cu < 1) { fprintf(stderr, "kernel_launch: occupancy query says %d blocks per CU\n", per_cu); per_cu = 1; }
        grid = cus * 1;
        if (grid != 256) fprintf(stderr, "kernel_launch: %d CUs (the scan phases are laid out for 256 workgroups)\n", grid);
    }
    if (grid < 0) return;
    Params p{};
    for (int i = 0; i < N_INPUTS; ++i) p.in[i] = (const float*)d_in[i];
    p.out = (float*)d_out; p.ws = (unsigned char*)d_ws; p.ph_lo = 0; p.ph_hi = 0;
    void* args[] = {&p};
    hipError_t e = hipLaunchCooperativeKernel((const void*)mega_fwd, dim3(grid), dim3(NTHREADS), args, LDS_BYTES, stream);
    if (e != hipSuccess) fprintf(stderr, "cooperative launch failed: %s (grid %d)\n", hipGetErrorString(e), grid);
}
```

```cpp
#include <hip/hip_runtime.h>
#include <hip/hip_cooperative_groups.h>
#include <cstdio>
#include <cstdint>
namespace cg = cooperative_groups;

#define LAS __attribute__((address_space(3)))
typedef unsigned short bf16_t;
typedef short bf16x8 __attribute__((ext_vector_type(8)));
typedef float f32x4 __attribute__((ext_vector_type(4)));
typedef unsigned u32x4 __attribute__((ext_vector_type(4)));
typedef unsigned u32x2 __attribute__((ext_vector_type(2)));

constexpr int BATCH = 8, SEQ = 4096, NMETA = 16, LEN = SEQ + NMETA, DM = 1024, DFF = 4096, DEPTH = 2;
constexpr int M_ROWS = BATCH * LEN;
constexpr int MP = 33024;
constexpr int N_IN = 5896;
constexpr int NCH16 = LEN / 16;
constexpr int S5ROWS = BATCH * NCH16;
constexpr int S5RP = 2304;
constexpr float EPS = 1e-6f;
constexpr int NTHREADS = 512, NWAVES = 8;

constexpr size_t QB = (size_t)MP * 256 * 2;
constexpr size_t WB_IN = 0;
constexpr size_t WB_G = WB_IN + (size_t)2816 * 1024;
constexpr size_t WB_P = WB_G + (size_t)3072 * 1024;
constexpr size_t WB_O = WB_P + (size_t)1024 * 1024;
constexpr size_t WB_1 = WB_O + (size_t)1024 * 1024;
constexpr size_t WB_2 = WB_1 + (size_t)4096 * 1024;
constexpr size_t WB_GLU = WB_2 + (size_t)1024 * 4096;
constexpr size_t WB_L1 = WB_GLU + (size_t)512 * 256;
constexpr size_t WB_L2 = WB_L1 + (size_t)512 * 512;
constexpr size_t WB_SX = WB_L2 + (size_t)1280 * 256;
constexpr size_t WB_SY = WB_SX + (size_t)16 * 256 * 256;
constexpr size_t WB_ELEMS = WB_SY + (size_t)16 * 256 * 512;
constexpr size_t WB_BYTES = WB_ELEMS * 2;
static_assert(WB_BYTES <= 5 * QB / 2, "weight block fits 2.5 Q");

constexpr size_t WS_H = 0;
constexpr size_t WS_WB0 = 4 * QB;
constexpr size_t WS_SMALL = 13 * QB / 2;
constexpr size_t WS_SSQ = WS_SMALL;
constexpr size_t WS_DT = WS_SSQ + (size_t)MP * 16 * 4;
constexpr size_t WS_DEC = WS_DT + (size_t)MP * 16 * 4;
static_assert(WS_DEC + (size_t)MP * 16 * 4 <= 7 * QB, "small region");
constexpr size_t WS_MIX = 7 * QB;
constexpr size_t WS_PXBC = WS_MIX;
constexpr size_t WS_YSSD = WS_MIX;
constexpr size_t WS_PARK = WS_MIX;
constexpr size_t WS_ACT = WS_MIX;
constexpr size_t WS_PRKVX = WS_MIX + 4 * QB;
constexpr size_t WS_L2O = WS_MIX + 4 * QB;
constexpr size_t WS_PZ = WS_MIX + 9 * QB;
constexpr size_t WS_UH = WS_MIX + 11 * QB;
constexpr size_t WS_X = WS_MIX + 53 * QB / 4;
constexpr size_t WS_YRW = WS_X;
constexpr size_t WS_L1IN = WS_MIX + 31 * QB / 2;
constexpr size_t WS_YAPRE = WS_L1IN;
constexpr size_t WS_L1O = WS_MIX + 35 * QB / 2;
constexpr size_t WS_YB = WS_L1O;
constexpr size_t WS_BC = WS_MIX + 39 * QB / 2;
constexpr size_t WS_YA = WS_MIX + 33 * QB / 2;
constexpr size_t WS_YC = WS_BC + QB;
constexpr size_t WS_XS = WS_MIX + 43 * QB / 2;
constexpr size_t WS_END = WS_XS + 2 * QB;
static_assert(WS_END <= (size_t)512 << 20, "workspace map fits 512 MiB");
static_assert((size_t)16 * S5RP * 512 * 2 <= 9 * QB / 4 && (size_t)16 * S5RP * 256 * 4 <= 9 * QB / 4, "S5 buffers fit their slots");

constexpr size_t DO_RKVP = 0;
constexpr size_t DO_MERGED = 0;
constexpr size_t DO_WB1 = 4 * QB;
static_assert(DO_WB1 + WB_BYTES <= (size_t)BATCH * SEQ * DM * 4, "d_out scratch map");

__device__ __forceinline__ unsigned f2bf(float f) { unsigned u = __builtin_bit_cast(unsigned, f); return (u + 0x7fffu + ((u >> 16) & 1u)) >> 16; }
typedef float f32x2_t_ __attribute__((ext_vector_type(2))); typedef __bf16 bf16x2_t_ __attribute__((ext_vector_type(2)));
__device__ __forceinline__ unsigned pk2(float lo, float hi) { const f32x2_t_ v = {lo, hi}; const bf16x2_t_ b = __builtin_convertvector(v, bf16x2_t_); return __builtin_bit_cast(unsigned, b); }
__device__ __forceinline__ float bflo(unsigned w) { return __builtin_bit_cast(float, w << 16); }
__device__ __forceinline__ float bfhi(unsigned w) { return __builtin_bit_cast(float, w & 0xffff0000u); }
__device__ __forceinline__ float bf1(bf16_t v) { return __builtin_bit_cast(float, (unsigned)v << 16); }
__device__ __forceinline__ float sigmoidf_(float x) { return 1.0f / (1.0f + __expf(-x)); }
__device__ __forceinline__ float siluf_(float x) { return x / (1.0f + __expf(-x)); }
__device__ __forceinline__ float tanhf_(float x) { x = fminf(fmaxf(x, -15.f), 15.f); const float t = __expf(2.f * x); return (t - 1.f) / (t + 1.f); }
__device__ __forceinline__ float softplusf_(float x) { return fmaxf(x, 0.f) + __logf(1.0f + __expf(-fabsf(x))); }
__device__ __forceinline__ float geluf_(float x) { const float u = 0.7978845608028654f * (x + 0.044715f * x * x * x); return 0.5f * x * (1.f + tanhf_(u)); }
__device__ __forceinline__ float wave_sum(float v) {
#pragma unroll
    for (int o = 1; o < 64; o <<= 1) v += __shfl_xor(v, o);
    return v;
}
__device__ __forceinline__ float sum16(float v) {
#pragma unroll
    for (int o = 1; o < 16; o <<= 1) v += __shfl_xor(v, o);
    return v;
}
template <int CTRL> __device__ __forceinline__ float dpp_mov(float x) {
    return __builtin_bit_cast(float, __builtin_amdgcn_update_dpp(0, __builtin_bit_cast(int, x), CTRL, 0xf, 0xf, true));
}
__device__ __forceinline__ float allred16(float x) {
    x += dpp_mov<0xB1>(x); x += dpp_mov<0x4E>(x); x += dpp_mov<0x141>(x); x += dpp_mov<0x140>(x); return x;
}
__device__ __forceinline__ void unpack8(const u32x4 w, float (&f)[8]) {
    f[0] = bflo(w.x); f[1] = bfhi(w.x); f[2] = bflo(w.y); f[3] = bfhi(w.y); f[4] = bflo(w.z); f[5] = bfhi(w.z); f[6] = bflo(w.w); f[7] = bfhi(w.w);
}
__device__ __forceinline__ u32x4 pack8(const float (&f)[8]) { u32x4 w; w.x = pk2(f[0], f[1]); w.y = pk2(f[2], f[3]); w.z = pk2(f[4], f[5]); w.w = pk2(f[6], f[7]); return w; }
__device__ __forceinline__ int opaque_tid(int) { int t = threadIdx.x; asm volatile("" : "+v"(t)); return t; }
__device__ __forceinline__ int row_of(int b, int t) { return t < NMETA ? BATCH * SEQ + b * NMETA + t : b * SEQ + (t - NMETA); }
__device__ __forceinline__ void bt_of(int m, int& b, int& t) { if (m < BATCH * SEQ) { b = m >> 12; t = NMETA + (m & (SEQ - 1)); } else { const int q = m - BATCH * SEQ; b = q >> 4; t = q & (NMETA - 1); } }
namespace pg8 {
constexpr int BM = 256, BK = 64, HALF = 128, HTB = HALF * BK * 2  , STAGE_BYTES = 8 * HTB;
__host__ __device__ __forceinline__ int lds_byte(int r, int c) { const int st = (r >> 4) * 2 + (c >> 5), rr = r & 15, cc = c & 31, ob = rr * 64 + cc * 2; return st * 1024 + (ob ^ (((ob >> 9) & 1) << 5)); }
__host__ __device__ __forceinline__ void stage_rc(int b, int& R, int& C) { const int st = b / 1024, sb = b % 1024, swz = sb ^ (((sb >> 9) & 1) << 5); R = (st >> 1) * 16 + swz / 64; C = (st & 1) * 32 + (swz % 64) / 2; }
__host__ __device__ __forceinline__ int perm32(int rho) { const int n = rho >> 4, i = rho & 15; return 8 * (i >> 2) + 4 * n + (i & 3); }

struct GU {
    const bf16_t* A;
    const bf16_t* B;
    int lda, ldb, nt;
    int pm, pn, kind;
};

template <bool SKIP_HI = false, class Epi, class Sched>
__device__ __forceinline__ void gemm_phase(LAS unsigned char* lds, int wave_s, const Sched& S, const Epi& E) {
    const int tid = opaque_tid(wave_s), wid = wave_s, lane = tid & 63, wr = wid >> 2, wc = wid & 3, fr = lane & 15, fq = lane >> 4;
#define PG8_VOFF(lda_, ldb_, a0, b0) do { int R0_, C0_; stage_rc(tid * 16, R0_, C0_); \
        a0 = (unsigned)(R0_ * (lda_) + C0_) * 2u; b0 = (unsigned)(((R0_ & ~31) + perm32(R0_ & 31)) * (ldb_) + C0_) * 2u; } while (0)
    const size_t kstep = (size_t)(BK * 2);
    const unsigned ldsw = (unsigned)wid * 1024u;
    const int aoff = lds_byte(wr * 64 + fr, fq * 8), boff = lds_byte(wc * 32 + fr, fq * 8);
#define PG8_SA(b, h) (((b) * 2 + (h)) * HTB)
#define PG8_SB(b, h) ((4 + (b) * 2 + (h)) * HTB)
#define PG8_STAGE(bufoff, gbase, v0, hs) do { \
        __builtin_amdgcn_global_load_lds((const unsigned*)((const char*)(gbase) + (v0)), (LAS unsigned*)(lds + (bufoff) + ldsw), 16, 0, 0); \
        __builtin_amdgcn_global_load_lds((const unsigned*)((const char*)(gbase) + ((hs) >> 1) + (v0)), (LAS unsigned*)(lds + (bufoff) + ldsw + 8192), 16, 0, 0); } while (0)
#define PG8_LDA(dst, b, h) do { _Pragma("unroll") for (int m = 0; m < 4; ++m) _Pragma("unroll") for (int k = 0; k < 2; ++k) dst[m][k] = *(const LAS bf16x8*)(lds + PG8_SA(b, h) + aoff + m * 2048 + k * 1024); } while (0)
#define PG8_LDB(dst, b, h) do { _Pragma("unroll") for (int n = 0; n < 2; ++n) _Pragma("unroll") for (int k = 0; k < 2; ++k) dst[n][k] = *(const LAS bf16x8*)(lds + PG8_SB(b, h) + boff + n * 2048 + k * 1024); } while (0)
#define PG8_MMA(ai, bj, At, Bt) do { __builtin_amdgcn_s_setprio(1); _Pragma("unroll") for (int m = 0; m < 4; ++m) _Pragma("unroll") for (int n = 0; n < 2; ++n) _Pragma("unroll") for (int k = 0; k < 2; ++k) \
        acc[ai][bj][m][n] = __builtin_amdgcn_mfma_f32_16x16x32_bf16(Bt[n][k], At[m][k], acc[ai][bj][m][n], 0, 0, 0); __builtin_amdgcn_s_setprio(0); } while (0)
#define PG8_WAIT_V(n) asm volatile("s_waitcnt vmcnt(" #n ")" ::: "memory")
#define PG8_WAIT_L(n) asm volatile("s_waitcnt lgkmcnt(" #n ")" ::: "memory")
#define PG8_BAR __builtin_amdgcn_s_barrier()
#define PG8_SCHED __builtin_amdgcn_sched_barrier(0)
    GU cur, nxt; int ui = 0;
    if (!S.next(0, cur)) return;
    f32x4 acc[2][2][4][2];
#pragma unroll
    for (int a = 0; a < 2; ++a)
#pragma unroll
        for (int b = 0; b < 2; ++b)
#pragma unroll
            for (int m = 0; m < 4; ++m)
#pragma unroll
                for (int n = 0; n < 2; ++n) acc[a][b][m][n] = (f32x4){0.f, 0.f, 0.f, 0.f};
    bf16x8 At[4][2], B0[2][2], B1[2][2];
    const char* cA = (const char*)cur.A; const char* cB = (const char*)cur.B;
    unsigned vA0, vB0; PG8_VOFF(cur.lda, cur.ldb, vA0, vB0);
    size_t hsA = (size_t)HALF * cur.lda * 2, hsB = (size_t)HALF * cur.ldb * 2;
    int nt = cur.nt; asm volatile("" : "+s"(nt));
    PG8_STAGE(PG8_SB(0, 0), cB, vB0, hsB); PG8_STAGE(PG8_SB(0, 1), cB + hsB, vB0, hsB); PG8_STAGE(PG8_SA(0, 0), cA, vA0, hsA); PG8_STAGE(PG8_SA(0, 1), cA + hsA, vA0, hsA);
    if (wr == 1) PG8_BAR;
    PG8_WAIT_V(2); PG8_BAR;
    PG8_STAGE(PG8_SB(1, 0), cB + kstep, vB0, hsB); PG8_STAGE(PG8_SA(1, 0), cA + kstep, vA0, hsA); PG8_STAGE(PG8_SB(1, 1), cB + hsB + kstep, vB0, hsB);
    PG8_WAIT_V(6); PG8_BAR;
    for (;;) {
        const bool has_next = S.next(ui + 1, nxt);
        const char* nA = has_next ? (const char*)nxt.A : cA; const char* nB = has_next ? (const char*)nxt.B : cB;
        unsigned nvA0 = vA0, nvB0 = vB0;
        if (has_next) PG8_VOFF(nxt.lda, nxt.ldb, nvA0, nvB0);
        const size_t nhsA = has_next ? (size_t)HALF * nxt.lda * 2 : hsA, nhsB = has_next ? (size_t)HALF * nxt.ldb * 2 : hsB;
        for (int t = 0; t < nt; t += 2) {
            const bool last = (t == nt - 2);
            const char* a1 = cA + (size_t)(t + 1) * kstep;
            const char* a2 = last ? nA : cA + (size_t)(t + 2) * kstep; const char* b2 = last ? nB : cB + (size_t)(t + 2) * kstep;
            const char* a3 = a2 + kstep; const char* b3 = b2 + kstep;
            const unsigned xA0 = last ? nvA0 : vA0, xB0 = last ? nvB0 : vB0;
            const size_t xhA = last ? nhsA : hsA, xhB = last ? nhsB : hsB;
            PG8_LDB(B0, 0, 0); PG8_LDB(B1, 0, 1); PG8_SCHED; PG8_LDA(At, 0, 0); PG8_STAGE(PG8_SA(1, 1), a1 + hsA, vA0, hsA);
            PG8_WAIT_V(8); PG8_WAIT_L(0); PG8_BAR; PG8_MMA(0, 0, At, B0); PG8_MMA(0, 1, At, B1); PG8_BAR; PG8_SCHED;
            PG8_LDA(At, 0, 1); PG8_STAGE(PG8_SB(0, 0), b2, xB0, xhB); PG8_STAGE(PG8_SB(0, 1), b2 + xhB, xB0, xhB); PG8_STAGE(PG8_SA(0, 0), a2, xA0, xhA);
            PG8_WAIT_V(8); PG8_WAIT_L(0); PG8_BAR; if constexpr (!SKIP_HI) { PG8_MMA(1, 0, At, B0); PG8_MMA(1, 1, At, B1); } PG8_BAR; PG8_SCHED;
            PG8_LDB(B0, 1, 0); PG8_LDB(B1, 1, 1); PG8_SCHED; PG8_LDA(At, 1, 0); PG8_STAGE(PG8_SA(0, 1), a2 + xhA, xA0, xhA);
            PG8_WAIT_V(8); PG8_WAIT_L(0); PG8_BAR; PG8_MMA(0, 0, At, B0); PG8_MMA(0, 1, At, B1); PG8_BAR; PG8_SCHED;
            PG8_LDA(At, 1, 1); PG8_STAGE(PG8_SB(1, 0), b3, xB0, xhB); PG8_STAGE(PG8_SB(1, 1), b3 + xhB, xB0, xhB); PG8_STAGE(PG8_SA(1, 0), a3, xA0, xhA);
            PG8_WAIT_V(8); PG8_WAIT_L(0); PG8_BAR; if constexpr (!SKIP_HI) { PG8_MMA(1, 0, At, B0); PG8_MMA(1, 1, At, B1); } PG8_BAR; PG8_SCHED;
        }
        if (wr == 0) PG8_BAR;
        const bool keep = E(acc, cur, wr, wc, fr, fq);
        if (!has_next) break;
        if (!keep) {
#pragma unroll
            for (int a = 0; a < 2; ++a)
#pragma unroll
                for (int b = 0; b < 2; ++b)
#pragma unroll
                    for (int m = 0; m < 4; ++m)
#pragma unroll
                        for (int n = 0; n < 2; ++n) acc[a][b][m][n] = (f32x4){0.f, 0.f, 0.f, 0.f};
        }
        cur = nxt; cA = nA; cB = nB; vA0 = nvA0; vB0 = nvB0; hsA = nhsA; hsB = nhsB; nt = cur.nt; asm volatile("" : "+s"(nt)); ++ui;
        if (wr == 1) PG8_BAR;
    }
    PG8_WAIT_V(0);
    PG8_BAR;
#undef PG8_VOFF
#undef PG8_SA
#undef PG8_SB
#undef PG8_STAGE
#undef PG8_LDA
#undef PG8_LDB
#undef PG8_MMA
#undef PG8_WAIT_V
#undef PG8_WAIT_L
#undef PG8_BAR
#undef PG8_SCHED
}

__device__ __forceinline__ bool tile_order(int i, int G, int c, int nM, int nN, int& pm, int& pn) {
    const int nwg = nM * nN; const long L = (long)i * G + c; if (L >= nwg) return false;
    int wgid = (int)L; { const int q = nwg / 8, r = nwg % 8, xcd = wgid % 8, off = wgid / 8; wgid = (xcd < r ? xcd * (q + 1) : r * (q + 1) + (xcd - r) * q) + off; }
    const int nig = 8 * nN, gid = wgid / nig, fm = gid * 8, gsz = (nM - fm) < 8 ? (nM - fm) : 8;
    pm = fm + ((wgid % nig) % gsz); pn = (wgid % nig) / gsz; return true;
}
}
using pg8::GU;
enum InIdx { I_X = 0, I_META, I_FNW, I_MIXNW, I_WIN, I_S5LRE, I_S5LIM, I_S5LS, I_S5BRE, I_S5BIM, I_S5CRE, I_S5CIM, I_S5D, I_GLUW, I_GLUB,
             I_CONVW, I_CONVB, I_ALOG, I_DTB, I_SSDD, I_SSDNW, I_MURKV, I_MUWAG, I_W0, I_W1, I_W2, I_A0, I_A1, I_A2, I_G1, I_G2, I_KK, I_KA, I_RK, I_LNW, I_LNB,
             I_PA, I_PB, I_PC, I_WOUT, I_MLPNW, I_MLPW1, I_MLPW2, N_INPUTS };
struct Params { const float* in[N_INPUTS]; float* out; unsigned char* ws; int ph_lo, ph_hi; };

struct Ctx {
    const float* const* in; unsigned char* ws; unsigned char* dout;
    LAS unsigned char* lds;
    int tid, lane, wave, G, bid;
    __device__ __forceinline__ bf16_t* wb(int layer) const { return (bf16_t*)(layer == 0 ? ws + WS_WB0 : dout + DO_WB1); }
    __device__ __forceinline__ bf16_t* H() const { return (bf16_t*)(ws + WS_H); }
    __device__ __forceinline__ float* ssq() const { return (float*)(ws + WS_SSQ); }
};
__device__ __forceinline__ Ctx relaunder(const Ctx& c0) {
    Ctx c = c0; c.tid = opaque_tid(c0.wave); c.lane = c.tid & 63;
    return c;
}
__device__ __forceinline__ float row_scale(const float* ssq, int row) {
    const f32x4* p = (const f32x4*)(ssq + (size_t)row * 16);
    const f32x4 a = p[0], b = p[1], c = p[2], d = p[3];
    const float s = ((a.x + a.y) + (a.z + a.w)) + ((b.x + b.y) + (b.z + b.w)) + ((c.x + c.y) + (c.z + c.w)) + ((d.x + d.y) + (d.z + d.w));
    return __builtin_amdgcn_rsqf(s * (1.0f / DM) + EPS);
}

struct SchedPlain {
    const bf16_t* A; const bf16_t* B; int lda, ldb, K, nM, nN, G, c, pm0;
    __device__ __forceinline__ bool next(int i, GU& u) const {
        int pm, pn; if (!pg8::tile_order(i, G, c, nM, nN, pm, pn)) return false;
        pm += pm0;
        u.A = A + (size_t)pm * 256 * lda; u.B = B + (size_t)pn * 256 * ldb; u.lda = lda; u.ldb = ldb; u.nt = K / 64; u.pm = pm; u.pn = pn; u.kind = 0; return true;
    }
};
struct SchedS5 {
    const bf16_t* UH; const bf16_t* W; int K, G, c;
    __device__ __forceinline__ bool next(int i, GU& u) const {
        const int L = i * G + c; if (L >= 144) return false;
        const int g = L / 9, pm = L % 9;
        u.A = UH + ((size_t)g * S5RP + (size_t)pm * 256) * 512; u.B = W + (size_t)g * 256 * K; u.lda = 512; u.ldb = K; u.nt = K / 64; u.pm = pm; u.pn = 0; u.kind = g; return true;
    }
};
struct SchedL2 {
    const bf16_t* L1o; const bf16_t* W; int G, c, nM, pm0;
    __device__ __forceinline__ bool next(int i, GU& u) const {
        int pm, pn; if (!pg8::tile_order(i, G, c, nM, 5, pm, pn)) return false;
        pm += pm0;
        const int koff = pn < 2 ? 0 : (pn < 4 ? 128 : 256);
        u.A = L1o + (size_t)pm * 256 * 512 + koff; u.B = W + (size_t)pn * 256 * 256; u.lda = 512; u.ldb = 256; u.nt = 4; u.pm = pm; u.pn = pn; u.kind = 0; return true;
    }
};
struct SchedProj {
    const bf16_t* Hb; const bf16_t* Wg; const bf16_t* Wp; const bf16_t* ya; const bf16_t* yb; const bf16_t* yc; int nM, G, c, pm0;
    __device__ __forceinline__ bool next(int i, GU& u) const {
        const int ti = i / 6, sub = i - ti * 6; int pm, pn;
        if (!pg8::tile_order(ti, G, c, nM, 4, pm, pn)) return false;
        pm += pm0;
        u.pm = pm; u.pn = pn; u.kind = sub;
        if (sub < 3) { u.A = Hb + (size_t)pm * 256 * DM; u.lda = DM; u.B = Wg + ((size_t)sub * 1024 + (size_t)pn * 256) * DM; u.ldb = DM; u.nt = 16; }
        else if (sub == 3) { u.A = ya + (size_t)pm * 256 * 256; u.lda = 256; u.B = Wp + (size_t)pn * 256 * DM; u.ldb = DM; u.nt = 4; }
        else if (sub == 4) { u.A = yb + (size_t)pm * 256 * 512; u.lda = 512; u.B = Wp + (size_t)pn * 256 * DM + 256; u.ldb = DM; u.nt = 8; }
        else { u.A = yc + (size_t)pm * 256 * 256; u.lda = 256; u.B = Wp + (size_t)pn * 256 * DM + 768; u.ldb = DM; u.nt = 4; }
        return true;
    }
};

typedef f32x4 Acc[2][2][4][2];
#define EPI_ROWS_BEGIN  _Pragma("unroll") for (int ai = 0; ai < 2; ++ai) _Pragma("unroll") for (int m = 0; m < 4; ++m) { const int rl = ai * 128 + wr * 64 + m * 16 + fr; const int row = u.pm * 256 + rl; (void)rl;
#define EPI_ROWS_END    asm volatile("" ::: "memory"); }
#define EPI_COL(bj) ((bj) * 128 + wc * 32 + fq * 8)

struct EpiInProj {
    const float* ssq; bf16_t* UH; bf16_t* Pz; bf16_t* Pxbc; bf16_t* Prkvx;
    __device__ __forceinline__ bool operator()(Acc& acc, const GU& u, int wr, int wc, int fr, int fq) const {
        EPI_ROWS_BEGIN
            if (row < M_ROWS) {
                const float s = row_scale(ssq, row);
                int b, t; bt_of(row, b, t);
#pragma unroll
                for (int bj = 0; bj < 2; ++bj) {
                    const int col = EPI_COL(bj);
                    const f32x4 v0 = acc[ai][bj][m][0] * s, v1 = acc[ai][bj][m][1] * s;
                    u32x4 w; w.x = pk2(v0[0], v0[1]); w.y = pk2(v0[2], v0[3]); w.z = pk2(v1[0], v1[1]); w.w = pk2(v1[2], v1[3]);
                    bf16_t* dst;
                    if (u.pn == 0) { const int g = col >> 4, hh = col & 15; dst = UH + ((size_t)g * S5RP + (size_t)(b * NCH16 + (t >> 4))) * 512 + (t & 15) * 16 + hh; }
                    else if (u.pn < 3) dst = Pz + (size_t)row * 512 + (u.pn - 1) * 256 + col;
                    else if (u.pn < 7) dst = Pxbc + (size_t)row * 1024 + (u.pn - 3) * 256 + col;
                    else dst = Prkvx + (size_t)row * 1024 + (u.pn - 7) * 256 + col;
                    *(u32x4*)dst = w;
                }
            }
        EPI_ROWS_END
        return false;
    }
};
struct EpiS5X {
    float* X;
    __device__ __forceinline__ bool operator()(Acc& acc, const GU& u, int wr, int wc, int fr, int fq) const {
        EPI_ROWS_BEGIN
            float* rp = X + ((size_t)u.kind * S5RP + row) * 256;
#pragma unroll
            for (int bj = 0; bj < 2; ++bj) { const int col = EPI_COL(bj); *(f32x4*)(rp + col) = acc[ai][bj][m][0]; *(f32x4*)(rp + col + 4) = acc[ai][bj][m][1]; }
        EPI_ROWS_END
        return false;
    }
};
struct EpiS5Y {
    bf16_t* yapre;
    __device__ __forceinline__ bool operator()(Acc& acc, const GU& u, int wr, int wc, int fr, int fq) const {
        EPI_ROWS_BEGIN
            if (row < S5ROWS) {
                const int b = row / NCH16, c = row - b * NCH16;
#pragma unroll
                for (int bj = 0; bj < 2; ++bj) {
                    const int col = EPI_COL(bj), i = col >> 4, hh = col & 15;
                    const f32x4 v0 = acc[ai][bj][m][0], v1 = acc[ai][bj][m][1];
                    u32x4 w; w.x = pk2(geluf_(v0[0]), geluf_(v0[1])); w.y = pk2(geluf_(v0[2]), geluf_(v0[3])); w.z = pk2(geluf_(v1[0]), geluf_(v1[1])); w.w = pk2(geluf_(v1[2]), geluf_(v1[3]));
                    *(u32x4*)(yapre + (size_t)row_of(b, c * 16 + i) * 256 + u.kind * 16 + hh) = w;
                }
            }
        EPI_ROWS_END
        return false;
    }
};
struct EpiL1 {
    bf16_t* L1o;
    __device__ __forceinline__ bool operator()(Acc& acc, const GU& u, int wr, int wc, int fr, int fq) const {
        EPI_ROWS_BEGIN
#pragma unroll
            for (int bj = 0; bj < 2; ++bj) {
                const int col = EPI_COL(bj); const int mode = u.pn * 2 + bj;
                f32x4 v0 = acc[ai][bj][m][0], v1 = acc[ai][bj][m][1]; float f[8] = {v0[0], v0[1], v0[2], v0[3], v1[0], v1[1], v1[2], v1[3]};
#pragma unroll
                for (int e = 0; e < 8; ++e) f[e] = mode == 0 ? tanhf_(f[e]) : (mode == 1 ? f[e] : (mode == 2 ? sigmoidf_(f[e]) : 0.f));
                *(u32x4*)(L1o + (size_t)row * 512 + u.pn * 256 + col) = pack8(f);
            }
        EPI_ROWS_END
        return false;
    }
};
struct EpiL2 {
    bf16_t* L2o; const float* w0; const float* a0;
    __device__ __forceinline__ bool operator()(Acc& acc, const GU& u, int wr, int wc, int fr, int fq) const {
        EPI_ROWS_BEGIN
#pragma unroll
            for (int bj = 0; bj < 2; ++bj) {
                const int col = EPI_COL(bj);
                f32x4 v0 = acc[ai][bj][m][0], v1 = acc[ai][bj][m][1]; float f[8] = {v0[0], v0[1], v0[2], v0[3], v1[0], v1[1], v1[2], v1[3]};
                if (u.pn < 2) {
                    const float* bp = w0 + u.pn * 256 + col;
#pragma unroll
                    for (int e = 0; e < 8; ++e) { const float v = bp[e] + f[e]; f[e] = -__expf(-softplusf_(-v) - 0.5f); }
                } else if (u.pn < 4) {
                    const float* bp = a0 + (u.pn - 2) * 256 + col;
#pragma unroll
                    for (int e = 0; e < 8; ++e) f[e] = sigmoidf_(bp[e] + f[e]);
                }
                *(u32x4*)(L2o + (size_t)row * 1280 + u.pn * 256 + col) = pack8(f);
            }
        EPI_ROWS_END
        return false;
    }
};
struct EpiGLU {
    bf16_t* ya; const float* bias;
    __device__ __forceinline__ bool operator()(Acc& acc, const GU& u, int wr, int wc, int fr, int fq) const {
        const int lc = wc * 32 + fq * 8, oc = u.pn * 128 + lc;
        float bv[8], bg[8];
#pragma unroll
        for (int e = 0; e < 8; ++e) { bv[e] = bias[oc + e]; bg[e] = bias[256 + oc + e]; }
        EPI_ROWS_BEGIN
            const f32x4 a0 = acc[ai][0][m][0], a1 = acc[ai][0][m][1], g0 = acc[ai][1][m][0], g1 = acc[ai][1][m][1];
            float v[8] = {a0[0], a0[1], a0[2], a0[3], a1[0], a1[1], a1[2], a1[3]}, g[8] = {g0[0], g0[1], g0[2], g0[3], g1[0], g1[1], g1[2], g1[3]};
#pragma unroll
            for (int e = 0; e < 8; ++e) v[e] = (v[e] + bv[e]) * sigmoidf_(g[e] + bg[e]);
            *(u32x4*)(ya + (size_t)row * 256 + oc) = pack8(v);
        EPI_ROWS_END
        return false;
    }
};
struct EpiProj {
    const float* ssq; const float* ssqb; unsigned char* park; bf16_t* merged; int tid;
    __device__ __forceinline__ bool operator()(Acc& acc, const GU& u, int wr, int wc, int fr, int fq) const {
        const int k = u.kind;
        EPI_ROWS_BEGIN
            float s = 1.f; if (k < 3) s = row_scale(ssq, row < M_ROWS ? row : 0);
            else if (k < 5) { { const int rr_ = row < M_ROWS ? row : 0; s = __builtin_amdgcn_rsqf((ssqb[2 * rr_] + ssqb[2 * rr_ + 1]) * (1.0f / 512.f) + EPS); } if (k == 3) s = __builtin_amdgcn_rcpf(s); }
#pragma unroll
            for (int bj = 0; bj < 2; ++bj) {
                const int q = (ai * 2 + bj) * 4 + m;
                f32x4& v0 = acc[ai][bj][m][0]; f32x4& v1 = acc[ai][bj][m][1];
                if (k < 3) {
                    float f[8] = {v0[0], v0[1], v0[2], v0[3], v1[0], v1[1], v1[2], v1[3]};
#pragma unroll
                    for (int e = 0; e < 8; ++e) f[e] = sigmoidf_(f[e] * s);
                    *(u32x4*)(park + ((size_t)(k * 16 + q) * NTHREADS + tid) * 16) = pack8(f);
                } else {
                    float num[8], den[8];
                    unpack8(*(const u32x4*)(park + ((size_t)((k - 3) * 16 + q) * NTHREADS + tid) * 16), num);
                    if (k < 5) { unpack8(*(const u32x4*)(park + ((size_t)((k - 2) * 16 + q) * NTHREADS + tid) * 16), den);
#pragma unroll
                        for (int e = 0; e < 8; ++e) num[e] = num[e] * __builtin_amdgcn_rcpf(den[e]) * s; }
                    v0[0] *= num[0]; v0[1] *= num[1]; v0[2] *= num[2]; v0[3] *= num[3]; v1[0] *= num[4]; v1[1] *= num[5]; v1[2] *= num[6]; v1[3] *= num[7];
                    if (k == 5) { u32x4 w; w.x = pk2(v0[0], v0[1]); w.y = pk2(v0[2], v0[3]); w.z = pk2(v1[0], v1[1]); w.w = pk2(v1[2], v1[3]);
                        *(u32x4*)(merged + (size_t)row * DM + u.pn * 256 + EPI_COL(bj)) = w; }
                }
            }
        EPI_ROWS_END
        return k == 3 || k == 4;
    }
};
struct EpiResid {
    bf16_t* H; float* ssq;
    __device__ __forceinline__ bool operator()(Acc& acc, const GU& u, int wr, int wc, int fr, int fq) const {
        EPI_ROWS_BEGIN
            float ss = 0.f;
            if (row < M_ROWS) {
#pragma unroll
                for (int bj = 0; bj < 2; ++bj) {
                    bf16_t* hp = H + (size_t)row * DM + u.pn * 256 + EPI_COL(bj);
                    float f[8]; unpack8(*(const u32x4*)hp, f);
                    const f32x4 v0 = acc[ai][bj][m][0], v1 = acc[ai][bj][m][1];
                    f[0] += v0[0]; f[1] += v0[1]; f[2] += v0[2]; f[3] += v0[3]; f[4] += v1[0]; f[5] += v1[1]; f[6] += v1[2]; f[7] += v1[3];
#pragma unroll
                    for (int e = 0; e < 8; ++e) ss += f[e] * f[e];
                    *(u32x4*)hp = pack8(f);
                }
            }
            ss += __shfl_xor(ss, 16); ss += __shfl_xor(ss, 32);
            if (fq == 0 && row < M_ROWS) ssq[(size_t)row * 16 + u.pn * 4 + wc] = ss;
        EPI_ROWS_END
        return false;
    }
};
struct EpiUp {
    const float* ssq; bf16_t* act;
    __device__ __forceinline__ bool operator()(Acc& acc, const GU& u, int wr, int wc, int fr, int fq) const {
        EPI_ROWS_BEGIN
            const float s = row_scale(ssq, row < M_ROWS ? row : 0);
#pragma unroll
            for (int bj = 0; bj < 2; ++bj) {
                const f32x4 v0 = acc[ai][bj][m][0] * s, v1 = acc[ai][bj][m][1] * s; float f[8] = {v0[0], v0[1], v0[2], v0[3], v1[0], v1[1], v1[2], v1[3]};
#pragma unroll
                for (int e = 0; e < 8; ++e) { const float r = fmaxf(f[e], 0.f); f[e] = r * r; }
                *(u32x4*)(act + (size_t)row * DFF + u.pn * 256 + EPI_COL(bj)) = pack8(f);
            }
        EPI_ROWS_END
        return false;
    }
};
typedef __attribute__((address_space(1))) unsigned gu32;
#define XB_TMO      128
#define XB_XCNT(j)  (256  + 64 * (j))
#define XB_XSUB(j)  (1280 + 64 * (j))
#define XB_XGEN(j)  (2304 + 64 * (j))
#define XB_TOP      3328
#define XB_TOPGEN   3392
#define XCD_BAR_WORDS 3456
#define XB_SPIN_CAP (1u << 18)

__device__ __forceinline__ unsigned xb_ld(unsigned* p)              { return __hip_atomic_load(p, __ATOMIC_RELAXED, __HIP_MEMORY_SCOPE_AGENT); }
__device__ __forceinline__ unsigned xb_add(unsigned* p, unsigned v) { return __hip_atomic_fetch_add(p, v, __ATOMIC_RELAXED, __HIP_MEMORY_SCOPE_AGENT); }
__device__ __forceinline__ unsigned xb_xcc_id() { return (unsigned)__builtin_amdgcn_s_getreg((3 << 11) | 20) & 0xFu; }
#define XB_SPIN(cond, bar) do { unsigned _sp = 0; while (cond) { __builtin_amdgcn_s_sleep(1); \
    if ((++_sp & 255u) == 0u) { if (xb_ld(&(bar)[XB_TMO])) break; if (_sp > XB_SPIN_CAP) { atomicAdd(&(bar)[XB_TMO], 1u); break; } } } } while (0)

struct XcdBarrier {
    unsigned* bar; unsigned x;
    volatile LAS unsigned* st;
};

__device__ __forceinline__ XcdBarrier xcd_barrier_post(unsigned* bar, volatile LAS unsigned* st) {
    XcdBarrier b; b.bar = bar; b.x = xb_xcc_id(); b.st = st;
    if (threadIdx.x == 0) (void)xb_add(&bar[XB_XCNT(b.x)], 1u);
    return b;
}
__device__ __forceinline__ void xcd_barrier_complete(unsigned* bar, unsigned x, unsigned& nloc, unsigned& nx) {
    const unsigned G = gridDim.x * gridDim.y * gridDim.z;
    unsigned sum, cnt, mine, sp = 0u;
    for (;;) {
        sum = 0u; cnt = 0u; mine = 0u;
#pragma unroll
        for (unsigned j = 0; j < 16; ++j) { const unsigned c = xb_ld(&bar[XB_XCNT(j)]); sum += c; cnt += (c > 0u) ? 1u : 0u; mine = (j == x) ? c : mine; }
        if (sum == G) break;
        __builtin_amdgcn_s_sleep(1);
        if ((++sp & 255u) == 0u) { if (xb_ld(&bar[XB_TMO])) break; if (sp > XB_SPIN_CAP) { atomicAdd(&bar[XB_TMO], 1u); break; } }
    }
    nloc = mine > 0u ? mine : 1u; nx = cnt > 0u ? cnt : 1u;
}

__device__ __forceinline__ void xcd_barrier(const XcdBarrier& b, int wave_s) {
    const bool xb_t0 = threadIdx.x == 0; (void)wave_s;
    asm volatile("s_waitcnt vmcnt(0)" ::: "memory");
    __syncthreads();
    if (xb_t0) {
        unsigned* bar = b.bar;
        __builtin_amdgcn_s_waitcnt(0);
        unsigned nloc = b.st[0], nx = b.st[1];
        if (nloc == 0u) { xcd_barrier_complete(bar, b.x, nloc, nx); b.st[0] = nloc; b.st[1] = nx; }
        const unsigned old = xb_add(&bar[XB_XSUB(b.x)], 1u);
        const unsigned gen = old / nloc;
        if (old + 1u == (gen + 1u) * nloc) {
            __builtin_amdgcn_fence(__ATOMIC_RELEASE, "agent");
            asm volatile("s_waitcnt vmcnt(0)" ::: "memory");
            const unsigned og = xb_add(&bar[XB_TOP], 1u);
            const unsigned tg = og / nx;
            if (og + 1u == (tg + 1u) * nx) xb_add(&bar[XB_TOPGEN], 1u);
            else XB_SPIN(xb_ld(&bar[XB_TOPGEN]) == tg, bar);
            __builtin_amdgcn_fence(__ATOMIC_ACQUIRE, "agent");
            xb_add(&bar[XB_XGEN(b.x)], 1u);
            asm volatile("s_waitcnt vmcnt(0)" ::: "memory");
        } else {
            XB_SPIN(xb_ld(&bar[XB_XGEN(b.x)]) == gen, bar);
            __builtin_amdgcn_fence(__ATOMIC_ACQUIRE, "agent");
            asm volatile("s_waitcnt vmcnt(0)" ::: "memory");
        }
    }
    __syncthreads();
}

struct TJob { const float* src; int ld, col0, K, N; bf16_t* dst; int dld, dk0, rmode, row0; const float* ksc; };
constexpr int N_TJOBS = 27;
__device__ __forceinline__ void get_tjob(const Ctx& c, int l, int j, TJob& t) {
    bf16_t* wb = c.wb(l);
    const float* win = c.in[I_WIN] + (size_t)l * DM * N_IN;
    t.rmode = 0; t.ksc = nullptr; t.dk0 = 0; t.col0 = 0; t.row0 = 0;
    if (j < 5) {
        t.src = win; t.ld = N_IN; t.K = DM; t.dld = DM; t.ksc = c.in[I_MIXNW] + l * DM; t.dst = wb + WB_IN;
        if (j == 0) { t.col0 = 0; t.N = 256; t.row0 = 0; }
        else if (j == 1) { t.col0 = 256; t.N = 512; t.row0 = 256; }
        else if (j == 2) { t.col0 = 768; t.N = 1024; t.row0 = 768; }
        else if (j == 3) { t.col0 = 1800; t.N = 1024; t.row0 = 1792; }
        else { t.col0 = 2824; t.N = 3072; t.row0 = 0; t.dst = wb + WB_G; }
    } else if (j == 5) { t.src = c.in[I_PA] + (size_t)l * 256 * DM; t.ld = DM; t.K = 256; t.N = DM; t.dst = wb + WB_P; t.dld = DM; t.dk0 = 0; }
    else if (j == 6) { t.src = c.in[I_PB] + (size_t)l * 512 * DM; t.ld = DM; t.K = 512; t.N = DM; t.dst = wb + WB_P; t.dld = DM; t.dk0 = 256; t.ksc = c.in[I_SSDNW] + (size_t)l * 512; }
    else if (j == 7) { t.src = c.in[I_PC] + (size_t)l * 256 * DM; t.ld = DM; t.K = 256; t.N = DM; t.dst = wb + WB_P; t.dld = DM; t.dk0 = 768; }
    else if (j == 8) { t.src = c.in[I_WOUT] + (size_t)l * DM * DM; t.ld = DM; t.K = DM; t.N = DM; t.dst = wb + WB_O; t.dld = DM; }
    else if (j == 9) { t.src = c.in[I_MLPW1] + (size_t)l * DM * DFF; t.ld = DFF; t.K = DM; t.N = DFF; t.dst = wb + WB_1; t.dld = DM; t.ksc = c.in[I_MLPNW] + l * DM; }
    else if (j == 10) { t.src = c.in[I_MLPW2] + (size_t)l * DFF * DM; t.ld = DM; t.K = DFF; t.N = DM; t.dst = wb + WB_2; t.dld = DFF; }
    else if (j == 11) { t.src = c.in[I_GLUW] + (size_t)l * 256 * 512; t.ld = 512; t.K = 256; t.N = 512; t.dst = wb + WB_GLU; t.dld = 256; t.rmode = 1; }
    else if (j < 22) {
        const int q = j - 12;
        t.K = 256; t.dst = wb + WB_L1; t.dld = 512;
        if (q < 4) { const int d = q >> 1, hf = q & 1; t.src = c.in[I_W1] + ((size_t)l * 2 + d) * 256 * 64; t.ld = 64; t.N = 64; t.row0 = d * 64; t.dk0 = hf * 256; if (hf) t.ksc = c.in[I_MUWAG] + ((size_t)l * 3 + 0) * 256; }
        else if (q < 8) { const int d = (q - 4) >> 1, hf = q & 1; t.src = c.in[I_A1] + ((size_t)l * 2 + d) * 256 * 64; t.ld = 64; t.N = 64; t.row0 = 128 + d * 64; t.dk0 = hf * 256; if (hf) t.ksc = c.in[I_MUWAG] + ((size_t)l * 3 + 1) * 256; }
        else { const int hf = q & 1; t.src = c.in[I_G1] + (size_t)l * 256 * 128; t.ld = 128; t.N = 128; t.row0 = 256; t.dk0 = hf * 256; if (hf) t.ksc = c.in[I_MUWAG] + ((size_t)l * 3 + 2) * 256; }
    } else {
        const int q = j - 22;
        t.dst = wb + WB_L2; t.dld = 256; t.ld = 256; t.N = 256;
        if (q < 2) { t.src = c.in[I_W2] + ((size_t)l * 2 + q) * 64 * 256; t.K = 64; t.row0 = q * 256; t.dk0 = q * 64; }
        else if (q < 4) { const int d = q - 2; t.src = c.in[I_A2] + ((size_t)l * 2 + d) * 64 * 256; t.K = 64; t.row0 = (2 + d) * 256; t.dk0 = d * 64; }
        else { t.src = c.in[I_G2] + (size_t)l * 128 * 256; t.K = 128; t.row0 = 4 * 256; t.dk0 = 0; }
    }
}
__device__ __forceinline__ int tjob_items(const TJob& t) { return (t.K / 64) * (t.N / 32); }
__device__ __forceinline__ void transpose_item(const TJob& t, LAS float* scr, int item, int lane) {
    const int nblk = t.N / 32, kb = item / nblk, nb = item % nblk, k0 = 64 * kb, n0 = 32 * nb;
#pragma unroll 8
    for (int i = 0; i < 32; ++i) { const int kk = 2 * i + (lane >> 5); float v = t.src[(size_t)(k0 + kk) * t.ld + t.col0 + n0 + (lane & 31)]; if (t.ksc) v *= t.ksc[k0 + kk]; scr[kk * 33 + (lane & 31)] = v; }
    asm volatile("s_waitcnt lgkmcnt(0)" ::: "memory");
    const int cc = lane & 7;
#pragma unroll
    for (int j = 0; j < 4; ++j) {
        const int n = (lane >> 3) + 8 * j; const LAS float* s = scr + (8 * cc) * 33 + n;
        u32x4 o; o.x = pk2(s[0 * 33], s[1 * 33]); o.y = pk2(s[2 * 33], s[3 * 33]); o.z = pk2(s[4 * 33], s[5 * 33]); o.w = pk2(s[6 * 33], s[7 * 33]);
        const int nn = n0 + n; int drow;
        if (t.rmode == 0) drow = t.row0 + nn; else drow = nn < 256 ? (nn >> 7) * 256 + (nn & 127) : ((nn - 256) >> 7) * 256 + 128 + ((nn - 256) & 127);
        *(u32x4*)(t.dst + (size_t)drow * t.dld + t.dk0 + k0 + 8 * cc) = o;
    }
    asm volatile("s_waitcnt lgkmcnt(0)" ::: "memory");
}

__device__ __forceinline__ void s5_build(const Ctx& cx_, int l, int g, int part) {
    const Ctx c = relaunder(cx_);
    LAS float* F = (LAS float*)c.lds;
    LAS float* pwr = F;
    LAS float* pwi = pwr + 2176;
    LAS float* cor = pwi + 2176;
    LAS float* coi = cor + 128;
    LAS float* Cr = coi + 128;
    LAS float* Ci = Cr + 1024;
    LAS float* Br = Ci + 1024;
    LAS float* Bi = Br + 1024;
    LAS float* kr = Bi + 1024;
    LAS float* ki = kr + 1984;
    LAS float* Kd = ki + 1984;
    const int tid = c.tid;
    if (tid < 128) {
        const int d = tid >> 6, n = tid & 63; const size_t li_ = (((size_t)l * 2 + d) * 16 + g) * 64 + n;
        const float lr = c.in[I_S5LRE][li_], li = c.in[I_S5LIM][li_], step = expf(c.in[I_S5LS][((size_t)l * 2 + d) * 16 + g]);
        for (int k = 0; k <= 16; ++k) { const float mag = expf((float)k * lr * step), ang = (float)k * li * step; float sn, cs; sincosf(ang, &sn, &cs); pwr[(d * 17 + k) * 64 + n] = mag * cs; pwi[(d * 17 + k) * 64 + n] = mag * sn; }
        const float mag1 = expf(lr * step); float sn, cs; sincosf(li * step, &sn, &cs); const float abr = mag1 * cs, abi = mag1 * sn, den = lr * lr + li * li;
        cor[d * 64 + n] = ((abr - 1.f) * lr + abi * li) / den; coi[d * 64 + n] = (abi * lr - (abr - 1.f) * li) / den;
    }
    for (int i = tid; i < 1024; i += NTHREADS) {
        Cr[i] = c.in[I_S5CRE][((size_t)l * 16 + g) * 1024 + i]; Ci[i] = c.in[I_S5CIM][((size_t)l * 16 + g) * 1024 + i];
        Br[i] = c.in[I_S5BRE][((size_t)l * 16 + g) * 1024 + i]; Bi[i] = c.in[I_S5BIM][((size_t)l * 16 + g) * 1024 + i];
    }
    __syncthreads();
    for (int i = tid; i < 31 * 64; i += NTHREADS) {
        const int dd = i / 64 - 15, n = i & 63; float r, im;
        if (dd > 0) { const float pr = pwr[(0 * 17 + dd) * 64 + n], pi = pwi[(0 * 17 + dd) * 64 + n]; r = pr * cor[n] - pi * coi[n]; im = pr * coi[n] + pi * cor[n]; }
        else if (dd < 0) { const float pr = pwr[(1 * 17 - dd) * 64 + n], pi = pwi[(1 * 17 - dd) * 64 + n]; r = pr * cor[64 + n] - pi * coi[64 + n]; im = pr * coi[64 + n] + pi * cor[64 + n]; }
        else { r = cor[n] + cor[64 + n]; im = coi[n] + coi[64 + n]; }
        kr[i] = r; ki[i] = im;
    }
    __syncthreads();
    for (int i0 = tid; i0 < 17 * 256; i0 += NTHREADS) {
        const int i = i0 + 2 * part * 256; const int ddi = i >> 8, h = (i >> 4) & 15, hp = i & 15; float a = 0.f;
        for (int n = 0; n < 64; ++n) { const float cr = Cr[h * 64 + n], ci = Ci[h * 64 + n], xr = kr[ddi * 64 + n], xi = ki[ddi * 64 + n]; const float pr = cr * xr - ci * xi, pi = cr * xi + ci * xr; a += pr * Br[n * 16 + hp] - pi * Bi[n * 16 + hp]; }
        Kd[i] = a;
    }
    __syncthreads();
    bf16_t* SX = c.wb(l) + WB_SX + (size_t)g * 256 * 256; bf16_t* SY = c.wb(l) + WB_SY + (size_t)g * 256 * 512;
    const float* dsk = c.in[I_S5D] + (size_t)l * 256 + g * 16;
    for (int u = tid; u < 32 * 64; u += NTHREADS) {
        const int o = 32 * part + (u >> 6), kk0 = (u & 63) * 8, i = o >> 4, h = o & 15; float v[8];
        if (kk0 < 256) { const int j = kk0 >> 4, hp0 = kk0 & 15;
#pragma unroll
            for (int e = 0; e < 8; ++e) v[e] = Kd[(i - j + 15) * 256 + h * 16 + hp0 + e] + ((i == j && h == hp0 + e) ? dsk[h] : 0.f);
        } else { const int q = kk0 - 256, d = q >> 7, part = (q >> 6) & 1, n0 = q & 63, ex = d == 0 ? i + 1 : 16 - i;
#pragma unroll
            for (int e = 0; e < 8; ++e) { const int n = n0 + e; const float cr = Cr[h * 64 + n], ci = Ci[h * 64 + n], pr = pwr[(d * 17 + ex) * 64 + n], pi = pwi[(d * 17 + ex) * 64 + n]; v[e] = part == 0 ? (cr * pr - ci * pi) : -(cr * pi + ci * pr); }
        }
        *(u32x4*)(SY + (size_t)o * 512 + kk0) = pack8(v);
    }
    for (int u = tid; u < 32 * 32; u += NTHREADS) {
        const int o = 32 * part + (u >> 5), kk0 = (u & 31) * 8, d = o >> 7, part = (o >> 6) & 1, n = o & 63, j = kk0 >> 4, hp0 = kk0 & 15, ex = d == 0 ? 15 - j : j;
        const float pr = pwr[(d * 17 + ex) * 64 + n], pi = pwi[(d * 17 + ex) * 64 + n], qr = pr * cor[d * 64 + n] - pi * coi[d * 64 + n], qi = pr * coi[d * 64 + n] + pi * cor[d * 64 + n];
        float v[8];
#pragma unroll
        for (int e = 0; e < 8; ++e) { const float br = Br[n * 16 + hp0 + e], bi = Bi[n * 16 + hp0 + e]; v[e] = part == 0 ? (qr * br - qi * bi) : (qr * bi + qi * br); }
        *(u32x4*)(SX + (size_t)o * 256 + kk0) = pack8(v);
    }
    __syncthreads();
}

__device__ __forceinline__ void phase0(const Ctx& cx_) {
    const Ctx c = relaunder(cx_);
    if (c.bid < 256) s5_build(c, c.bid >> 7, (c.bid >> 3) & 15, c.bid & 7);
    const int gw = c.bid * NWAVES + c.wave, NGW = c.G * NWAVES, lane = c.lane;
    bf16_t* H = c.H(); float* ssq = c.ssq();
#pragma unroll 2
    for (int m = gw; m < MP; m += NGW) {
        u32x2* hp = (u32x2*)(H + (size_t)m * DM);
        if (m >= M_ROWS) {
#pragma unroll
            for (int i = 0; i < 4; ++i) hp[lane + 64 * i] = (u32x2){0u, 0u};
            continue;
        }
        int b, t; bt_of(m, b, t);
        const f32x4* src = (const f32x4*)(t < NMETA ? c.in[I_META] + (size_t)t * DM : c.in[I_X] + ((size_t)b * SEQ + (t - NMETA)) * DM);
        float ss = 0.f;
#pragma unroll
        for (int i = 0; i < 4; ++i) { const f32x4 v = src[lane + 64 * i]; ss += (v.x * v.x + v.y * v.y) + (v.z * v.z + v.w * v.w); hp[lane + 64 * i] = (u32x2){pk2(v.x, v.y), pk2(v.z, v.w)}; }
        ss = wave_sum(ss);
        if (lane < 16) ssq[(size_t)m * 16 + lane] = lane == 0 ? ss : 0.f;
    }
    LAS float* scr = (LAS float*)(c.lds + c.wave * 8448);
    for (int l = 0; l < DEPTH; ++l) {
        int base = 0;
        for (int j = 0; j < N_TJOBS; ++j) {
            TJob t; get_tjob(c, l, j, t); const int ni = tjob_items(t);
            int first = (gw - base % NGW + NGW) % NGW;
            for (int it = first; it < ni; it += NGW) transpose_item(t, scr, it, lane);
            base += ni;
        }
        bf16_t* wb = c.wb(l);
        const int gt = c.bid * NTHREADS + c.tid, NGT = c.G * NTHREADS;
        for (int u = gt; u < 128 * 64; u += NGT) *(u32x4*)(wb + WB_L1 + (size_t)384 * 512 + (size_t)u * 8) = (u32x4){0u, 0u, 0u, 0u};
        for (int u = gt; u < 5 * 256 * 4 * 8; u += NGT) {
            const int sub = u & 7, blk = (u >> 3) & 3, row = (u >> 5) & 255, tile = u >> 13;
            const bool nz = (tile == 0 || tile == 2) ? (blk == 0) : ((tile == 1 || tile == 3) ? (blk == 1) : (blk < 2));
            if (!nz) *(u32x4*)(wb + WB_L2 + ((size_t)tile * 256 + row) * 256 + blk * 64 + sub * 8) = (u32x4){0u, 0u, 0u, 0u};
        }
    }
}

__device__ __forceinline__ void dt_job(const Ctx& cx_, int l) {
    const Ctx c = relaunder(cx_);
    LAS float* dtw = (LAS float*)c.lds;
    const float* win = c.in[I_WIN] + (size_t)l * DM * N_IN; const float* nw = c.in[I_MIXNW] + l * DM;
    for (int i = c.tid; i < 8 * DM; i += NTHREADS) { const int k = i >> 3, j = i & 7; dtw[j * DM + k] = nw[k] * win[(size_t)k * N_IN + 1792 + j]; }
    __syncthreads();
    const int gw = c.bid * NWAVES + c.wave, NGW = c.G * NWAVES, lane = c.lane;
    const bf16_t* H = c.H(); float* dt = (float*)(c.ws + WS_DT); float* dec = (float*)(c.ws + WS_DEC);
    const float* dtb = c.in[I_DTB] + l * 16; const float* alog = c.in[I_ALOG] + l * 16;
#pragma unroll 2
    for (int m = gw; m < M_ROWS; m += NGW) {
        const u32x2* hp = (const u32x2*)(H + (size_t)m * DM);
        float ss = 0.f, d8[8] = {0.f, 0.f, 0.f, 0.f, 0.f, 0.f, 0.f, 0.f};
#pragma unroll
        for (int i = 0; i < 4; ++i) {
            const u32x2 w = hp[lane + 64 * i]; const float h0 = bflo(w.x), h1 = bfhi(w.x), h2 = bflo(w.y), h3 = bfhi(w.y);
            ss += (h0 * h0 + h1 * h1) + (h2 * h2 + h3 * h3);
#pragma unroll
            for (int j = 0; j < 8; ++j) { const f32x4 wv = *(const LAS f32x4*)(dtw + j * DM + 4 * lane + 256 * i); d8[j] += (h0 * wv.x + h1 * wv.y) + (h2 * wv.z + h3 * wv.w); }
        }
        ss = wave_sum(ss);
#pragma unroll
        for (int j = 0; j < 8; ++j) d8[j] = wave_sum(d8[j]);
        const float s = __builtin_amdgcn_rsqf(ss * (1.0f / DM) + EPS);
        if (lane < 16) {
            const int j = lane & 7; float raw = d8[0];
#pragma unroll
            for (int e = 1; e < 8; ++e) raw = (j == e) ? d8[e] : raw;
            const float dtv = softplusf_(raw * s + dtb[lane]);
            dt[(size_t)m * 16 + lane] = dtv; dec[(size_t)m * 16 + lane] = -dtv * __expf(alog[lane]);
        }
    }
    __syncthreads();
}

__device__ __forceinline__ void rwkv_prep(const Ctx& cx_, int l) {
    const Ctx c = relaunder(cx_);
    const int gw = c.bid * NWAVES + c.wave, NGW = c.G * NWAVES, lane = c.lane, c0 = 4 * lane;
    const bf16_t* __restrict__ P = (const bf16_t*)(c.ws + WS_PRKVX); bf16_t* __restrict__ rk = (bf16_t*)(c.dout + DO_RKVP); bf16_t* __restrict__ l1 = (bf16_t*)(c.ws + WS_L1IN);
    float mu[3][4], kkw[4];
#pragma unroll
    for (int x = 0; x < 3; ++x)
#pragma unroll
        for (int e = 0; e < 4; ++e) mu[x][e] = c.in[I_MURKV][((size_t)l * 3 + x) * 256 + c0 + e];
#pragma unroll
    for (int e = 0; e < 4; ++e) kkw[e] = c.in[I_KK][(size_t)l * 256 + c0 + e];
#pragma unroll 4
    for (int m = gw; m < M_ROWS; m += NGW) {
        int b, t; bt_of(m, b, t); const bool hp = t > 0, hn = t < LEN - 1; const size_t mp_ = hp ? row_of(b, t - 1) : 0, mn_ = hn ? row_of(b, t + 1) : 0;
        float o[4][4];
        float xc[4], dxc[4];
#pragma unroll
        for (int x = 0; x < 4; ++x) {
            const u32x2 wc_ = *(const u32x2*)(P + (size_t)m * 1024 + x * 256 + c0);
            u32x2 wp = (u32x2){0u, 0u}, wn = (u32x2){0u, 0u};
            if (hp) wp = *(const u32x2*)(P + mp_ * 1024 + x * 256 + c0);
            if (hn) wn = *(const u32x2*)(P + mn_ * 1024 + x * 256 + c0);
            const float cur[4] = {bflo(wc_.x), bfhi(wc_.x), bflo(wc_.y), bfhi(wc_.y)}, pv[4] = {bflo(wp.x), bfhi(wp.x), bflo(wp.y), bfhi(wp.y)}, nv[4] = {bflo(wn.x), bfhi(wn.x), bflo(wn.y), bfhi(wn.y)};
#pragma unroll
            for (int e = 0; e < 4; ++e) { const float cs = 0.5f * (pv[e] + nv[e]) - cur[e]; if (x < 3) o[x][e] = cur[e] + cs * mu[x][e]; else { xc[e] = cur[e]; dxc[e] = cs; } }
        }
        float kr_[4], ss = 0.f;
#pragma unroll
        for (int e = 0; e < 4; ++e) { kr_[e] = o[1][e] * kkw[e]; ss += kr_[e] * kr_[e]; }
        ss = sum16(ss); const float rn = __builtin_amdgcn_rsqf(ss + 1e-12f);
        bf16_t* rp = rk + (size_t)m * 1024 + c0;
        *(u32x2*)(rp) = (u32x2){pk2(o[0][0], o[0][1]), pk2(o[0][2], o[0][3])};
        *(u32x2*)(rp + 256) = (u32x2){pk2(o[1][0], o[1][1]), pk2(o[1][2], o[1][3])};
        *(u32x2*)(rp + 512) = (u32x2){pk2(o[2][0], o[2][1]), pk2(o[2][2], o[2][3])};
        *(u32x2*)(rp + 768) = (u32x2){pk2(kr_[0] * rn, kr_[1] * rn), pk2(kr_[2] * rn, kr_[3] * rn)};
        bf16_t* lp = l1 + (size_t)m * 512 + c0;
        *(u32x2*)(lp) = (u32x2){pk2(xc[0], xc[1]), pk2(xc[2], xc[3])};
        *(u32x2*)(lp + 256) = (u32x2){pk2(dxc[0], dxc[1]), pk2(dxc[2], dxc[3])};
    }
}
__device__ __forceinline__ void ssd_prep(const Ctx& cx_, int l) {
    const Ctx c = relaunder(cx_);
    const int gw = c.bid * NWAVES + c.wave, NGW = c.G * NWAVES, lane = c.lane, c0 = 16 * lane;
    const bf16_t* __restrict__ P = (const bf16_t*)(c.ws + WS_PXBC); bf16_t* __restrict__ xs = (bf16_t*)(c.ws + WS_XS); bf16_t* __restrict__ bc = (bf16_t*)(c.ws + WS_BC);
    float w[5][16], bias[16];
#pragma unroll
    for (int j = 0; j < 5; ++j)
#pragma unroll
        for (int e = 0; e < 16; ++e) w[j][e] = c.in[I_CONVW][((size_t)l * 5 + j) * 1024 + c0 + e];
#pragma unroll
    for (int e = 0; e < 16; ++e) bias[e] = c.in[I_CONVB][(size_t)l * 1024 + c0 + e];
#pragma unroll 2
    for (int m = gw; m < M_ROWS; m += NGW) {
        int b, t; bt_of(m, b, t);
        float a[16];
#pragma unroll
        for (int e = 0; e < 16; ++e) a[e] = bias[e];
#pragma unroll
        for (int j = 0; j < 5; ++j) {
            const int tt = t + j - 2;
            if (tt >= 0 && tt < LEN) {
                const u32x4* p = (const u32x4*)(P + (size_t)row_of(b, tt) * 1024 + c0); float f0[8], f1[8]; unpack8(p[0], f0); unpack8(p[1], f1);
#pragma unroll
                for (int e = 0; e < 8; ++e) { a[e] += w[j][e] * f0[e]; a[8 + e] += w[j][8 + e] * f1[e]; }
            }
        }
        float o0[8], o1[8];
#pragma unroll
        for (int e = 0; e < 8; ++e) { o0[e] = siluf_(a[e]); o1[e] = siluf_(a[8 + e]); }
        bf16_t* dst = lane < 32 ? xs + (size_t)m * 512 + c0 : bc + (size_t)m * 512 + (c0 - 512);
        ((u32x4*)dst)[0] = pack8(o0); ((u32x4*)dst)[1] = pack8(o1);
    }
}

__device__ __forceinline__ void s5_scan(const Ctx& cx_, int l) {
    const Ctx c = relaunder(cx_);
    if (c.tid >= 64) return;
    const int gt = c.bid * 64 + c.tid; if (gt >= 16384) return;
    const int n = gt & 63, d = (gt >> 6) & 1, b = (gt >> 7) & 7, g = gt >> 10;
    const size_t li_ = (((size_t)l * 2 + d) * 16 + g) * 64 + n;
    const float lr = c.in[I_S5LRE][li_], li = c.in[I_S5LIM][li_], step = expf(c.in[I_S5LS][((size_t)l * 2 + d) * 16 + g]);
    const float mag = expf(16.f * lr * step); float sn, cs; sincosf(16.f * li * step, &sn, &cs); const float ar = mag * cs, ai = mag * sn;
    const float* X = (const float*)(c.ws + WS_X) + ((size_t)g * S5RP + (size_t)b * NCH16) * 256 + d * 128 + n;
    bf16_t* U = (bf16_t*)(c.ws + WS_UH) + ((size_t)g * S5RP + (size_t)b * NCH16) * 512 + 256 + d * 128 + n;
    float hr = 0.f, hi = 0.f;
    for (int i0 = 0; i0 < NCH16; i0 += 32) {
        float xr[32], xi[32];
#pragma unroll
        for (int k = 0; k < 32; ++k) { const int i = i0 + k; const int ch = d == 0 ? i : NCH16 - 1 - i; const bool ok = i < NCH16; xr[k] = ok ? X[(size_t)ch * 256] : 0.f; xi[k] = ok ? X[(size_t)ch * 256 + 64] : 0.f; }
#pragma unroll
        for (int k = 0; k < 32; ++k) { const int i = i0 + k; if (i < NCH16) { const int ch = d == 0 ? i : NCH16 - 1 - i;
            U[(size_t)ch * 512] = (bf16_t)f2bf(hr); U[(size_t)ch * 512 + 64] = (bf16_t)f2bf(hi);
            const float nr = ar * hr - ai * hi + xr[k], ni = ar * hi + ai * hr + xi[k]; hr = nr; hi = ni; } }
    }
}
typedef short s16x4 __attribute__((ext_vector_type(4)));
__device__ __forceinline__ s16x4 lds_tr(const LAS unsigned char* p) { return __builtin_bit_cast(s16x4, __builtin_amdgcn_ds_read_tr16_b64_v4i16((LAS s16x4*)p)); }
__device__ __forceinline__ bf16x8 frag_tr(const LAS unsigned char* img, int rs, int kbase, int colbase, int lane) {
    const LAS unsigned char* a = img + (kbase + 8 * (lane >> 4) + ((lane & 15) >> 2)) * rs + (colbase + 4 * (lane & 3)) * 2;
    const s16x4 lo = lds_tr(a), hi = lds_tr(a + 4 * rs);
    return (bf16x8){lo[0], lo[1], lo[2], lo[3], hi[0], hi[1], hi[2], hi[3]};
}
__device__ __forceinline__ bf16x8 frag_row(const LAS unsigned char* img, int rs, int rowbase, int kbase, int lane) {
    return *(const LAS bf16x8*)(img + (rowbase + (lane & 15)) * rs + (kbase + 8 * (lane >> 4)) * 2);
}
constexpr int SD_RS = 272;
constexpr int SD_XRS = 144;
constexpr int SD_OFF_C = 0, SD_OFF_B = 34816, SD_OFF_X = 69632, SD_OFF_M = 88064, SD_OFF_SC = 122880;
constexpr int SD_OFF_HF = SD_OFF_B, SD_OFF_HB = SD_OFF_B + 17408;
constexpr size_t WS_STB = WS_YSSD;
constexpr size_t WS_CDEC = WS_DEC + (size_t)MP * 64 + 256;
constexpr size_t WS_SSQB = WS_CDEC + (size_t)BATCH * 33 * 16 * 4;
constexpr size_t WS_BAR = (WS_SSQB + (size_t)MP * 8 + 255) / 256 * 256;
static_assert(WS_BAR + 3456 * 4 <= 7 * QB, "small region");
static_assert((size_t)BATCH * 2 * 8 * 32 * 8192 * 2 <= 4 * QB, "chunk states fit the yssd slot");

struct SsdUnit { int b, ck, t0, ns; };
__device__ __forceinline__ bool ssd_unit(int bid, int round, SsdUnit& u) {
    if (round == 0) { u.b = bid >> 5; u.ck = 1 + (bid & 31); u.t0 = NMETA + 128 * (u.ck - 1); u.ns = 8; return true; }
    if (round == 1 && bid < BATCH) { u.b = bid; u.ck = 0; u.t0 = 0; u.ns = 1; return true; }
    return false;
}
__device__ __forceinline__ void ssd_load_img(LAS unsigned char* img, int rs, const bf16_t* src, int ld, size_t m0, int col0, int ncol, int ns, int tid) {
    const int cpr = ncol / 8, nrow = ns == 1 ? 32 : 128;
    for (int i = tid; i < nrow * cpr; i += NTHREADS) {
        const int r = i / cpr, cc = i - r * cpr; u32x4 v = (u32x4){0u, 0u, 0u, 0u};
        if (r < 16 * ns) v = *(const u32x4*)(src + (m0 + r) * ld + col0 + cc * 8);
        *(LAS u32x4*)(img + r * rs + cc * 16) = v;
    }
}
__device__ __forceinline__ void ssd_scalars(LAS float* sc, const float* dt, const float* al, size_t m0, int head, int ns, int lane, float& totf, float& totb) {
    const int Q = 16 * ns;
    float a0f = 0.f, a1f = 0.f, a0b = 0.f, a1b = 0.f, d0f = 0.f, d1f = 0.f, d0b = 0.f, d1b = 0.f;
    const int s0 = 2 * lane, s1 = 2 * lane + 1;
    if (s0 < Q) { a0f = al[(m0 + s0) * 16 + head]; a0b = al[(m0 + s0) * 16 + 8 + head]; d0f = dt[(m0 + s0) * 16 + head]; d0b = dt[(m0 + s0) * 16 + 8 + head]; }
    if (s1 < Q) { a1f = al[(m0 + s1) * 16 + head]; a1b = al[(m0 + s1) * 16 + 8 + head]; d1f = dt[(m0 + s1) * 16 + head]; d1b = dt[(m0 + s1) * 16 + 8 + head]; }
    float pf = a0f + a1f, pb = a0b + a1b;
#pragma unroll
    for (int o = 1; o < 64; o <<= 1) { const float tf = __shfl_up(pf, o), tb = __shfl_up(pb, o); if (lane >= o) { pf += tf; pb += tb; } }
    totf = __shfl(pf, 63); totb = __shfl(pb, 63);
    const float af1 = pf, af0 = pf - a1f;
    const float eb0 = pb - a0b - a1b, eb1 = pb - a1b;
    sc[s0] = af0; sc[s1] = af1; sc[128 + s0] = eb0; sc[128 + s1] = eb1; sc[256 + s0] = d0f; sc[256 + s1] = d1f; sc[384 + s0] = d0b; sc[384 + s1] = d1b;
    sc[512 + s0] = __expf(totf - af0) * d0f; sc[512 + s1] = __expf(totf - af1) * d1f;
    sc[640 + s0] = __expf(eb0) * d0b; sc[640 + s1] = __expf(eb1) * d1b;
    sc[768 + s0] = __expf(af0); sc[768 + s1] = __expf(af1);
    sc[896 + s0] = __expf(totb - eb0); sc[896 + s1] = __expf(totb - eb1);
}

__device__ __forceinline__ void ssd_states(const Ctx& cx_, int l) {
    const Ctx c = relaunder(cx_);
    const int tid = c.tid, lane = c.lane, wave = c.wave;
    const bf16_t* bc = (const bf16_t*)(c.ws + WS_BC); const bf16_t* xs = (const bf16_t*)(c.ws + WS_XS);
    const float* dt = (const float*)(c.ws + WS_DT); const float* al = (const float*)(c.ws + WS_DEC);
    bf16_t* stb = (bf16_t*)(c.ws + WS_STB); float* cdec = (float*)(c.ws + WS_CDEC);
    LAS unsigned char* Bimg = c.lds + SD_OFF_B; LAS unsigned char* Ximg = c.lds + SD_OFF_X; LAS float* sc = (LAS float*)(c.lds + SD_OFF_SC);
    for (int round = 0; round < 2; ++round) {
        SsdUnit u; if (!ssd_unit(c.bid, round, u)) break;
        const size_t m0 = (size_t)row_of(u.b, u.t0); const int nks = u.ns == 1 ? 1 : 4;
        for (int g = 0; g < 2; ++g) {
            __syncthreads();
            ssd_load_img(Bimg, SD_RS, bc, 512, m0, g * 128, 128, u.ns, tid);
            for (int j = 0; j < 4; ++j) {
                const int head = g * 4 + j;
                if (j) __syncthreads();
                ssd_load_img(Ximg, SD_XRS, xs, 512, m0, head * 64, 64, u.ns, tid);
                if (wave == 0) { float totf, totb; ssd_scalars(sc, dt, al, m0, head, u.ns, lane, totf, totb);
                    if (lane == 0) { cdec[((size_t)u.b * 33 + u.ck) * 16 + head] = __expf(totf); cdec[((size_t)u.b * 33 + u.ck) * 16 + 8 + head] = __expf(totb); } }
                __syncthreads();
                f32x4 accf[4], accb[4];
#pragma unroll
                for (int pt = 0; pt < 4; ++pt) { accf[pt] = (f32x4){0.f, 0.f, 0.f, 0.f}; accb[pt] = accf[pt]; }
                for (int ks = 0; ks < nks; ++ks) {
                    const bf16x8 af = frag_tr(Bimg, SD_RS, 32 * ks, 16 * wave, lane);
                    const int k0 = 32 * ks + 8 * (lane >> 4);
                    const f32x4 wf0 = *(const LAS f32x4*)(sc + 512 + k0), wf1 = *(const LAS f32x4*)(sc + 512 + k0 + 4), wb0 = *(const LAS f32x4*)(sc + 640 + k0), wb1 = *(const LAS f32x4*)(sc + 640 + k0 + 4);
#pragma unroll
                    for (int pt = 0; pt < 4; ++pt) {
                        const bf16x8 xr = frag_tr(Ximg, SD_XRS, 32 * ks, 16 * pt, lane);
                        float xf[8];
#pragma unroll
                        for (int e = 0; e < 8; ++e) xf[e] = bf1((bf16_t)xr[e]);
                        bf16x8 bfv, bbv;
                        { const unsigned p0 = pk2(xf[0] * wf0.x, xf[1] * wf0.y), p1 = pk2(xf[2] * wf0.z, xf[3] * wf0.w), p2 = pk2(xf[4] * wf1.x, xf[5] * wf1.y), p3 = pk2(xf[6] * wf1.z, xf[7] * wf1.w);
                          bfv = __builtin_bit_cast(bf16x8, (u32x4){p0, p1, p2, p3}); }
                        { const unsigned p0 = pk2(xf[0] * wb0.x, xf[1] * wb0.y), p1 = pk2(xf[2] * wb0.z, xf[3] * wb0.w), p2 = pk2(xf[4] * wb1.x, xf[5] * wb1.y), p3 = pk2(xf[6] * wb1.z, xf[7] * wb1.w);
                          bbv = __builtin_bit_cast(bf16x8, (u32x4){p0, p1, p2, p3}); }
                        accf[pt] = __builtin_amdgcn_mfma_f32_16x16x32_bf16(af, bfv, accf[pt], 0, 0, 0);
                        accb[pt] = __builtin_amdgcn_mfma_f32_16x16x32_bf16(af, bbv, accb[pt], 0, 0, 0);
                    }
                }
#pragma unroll
                for (int pt = 0; pt < 4; ++pt) {
                    const int p = 16 * pt + (lane & 15), n0 = 16 * wave + 4 * (lane >> 4);
                    if (u.ck <= 31) { bf16_t* d = stb + ((((size_t)u.b * 2 + 0) * 8 + head) * 32 + u.ck) * 8192 + (size_t)p * 128 + n0; *(u32x2*)d = (u32x2){pk2(accf[pt][0], accf[pt][1]), pk2(accf[pt][2], accf[pt][3])}; }
                    if (u.ck >= 1) { bf16_t* d = stb + ((((size_t)u.b * 2 + 1) * 8 + head) * 32 + (u.ck - 1)) * 8192 + (size_t)p * 128 + n0; *(u32x2*)d = (u32x2){pk2(accb[pt][0], accb[pt][1]), pk2(accb[pt][2], accb[pt][3])}; }
                }
            }
        }
    }
    __syncthreads();
}

__device__ __forceinline__ void ssd_chunk_scan(const Ctx& cx_, int l) {
    const Ctx c = relaunder(cx_);
    bf16_t* stb = (bf16_t*)(c.ws + WS_STB); const float* cdec = (const float*)(c.ws + WS_CDEC);
    const int gt = c.bid * NTHREADS + c.tid;
    const int e8 = gt & 1023, bdh = gt >> 10;
    if (bdh >= BATCH * 16) return;
    const int head = bdh & 7, dir = (bdh >> 3) & 1, b = bdh >> 4;
    bf16_t* base = stb + (size_t)bdh * 32 * 8192 + (size_t)e8 * 8;
    float h[8] = {0.f, 0.f, 0.f, 0.f, 0.f, 0.f, 0.f, 0.f};
    for (int i0 = 0; i0 < 32; i0 += 8) {
        u32x4 v[8]; float dcy[8];
#pragma unroll
        for (int k = 0; k < 8; ++k) { const int slot = dir == 0 ? i0 + k : 31 - (i0 + k); v[k] = *(const u32x4*)(base + (size_t)slot * 8192);
            const int ck = dir == 0 ? slot : slot + 1; dcy[k] = cdec[((size_t)b * 33 + ck) * 16 + dir * 8 + head]; }
#pragma unroll
        for (int k = 0; k < 8; ++k) { const int slot = dir == 0 ? i0 + k : 31 - (i0 + k); float s[8]; unpack8(v[k], s);
#pragma unroll
            for (int e = 0; e < 8; ++e) h[e] = h[e] * dcy[k] + s[e];
            *(u32x4*)(base + (size_t)slot * 8192) = pack8(h); }
    }
}

__device__ __forceinline__ bool ssd_unit_n(int idx, int nblk, int round, SsdUnit& u, int& grp) {
    const int n2 = idx + nblk * round; if (n2 >= 528) return false; const int n = n2 >> 1; grp = n2 & 1;
    if (n < 256) { u.b = n >> 5; u.ck = 1 + (n & 31); u.t0 = NMETA + 128 * (u.ck - 1); u.ns = 8; } else { u.b = n - 256; u.ck = 0; u.t0 = 0; u.ns = 1; }
    return true;
}
__device__ __forceinline__ void ssd_outputs(const Ctx& cx_, int l, int first, int nblk) {
    const Ctx c = relaunder(cx_);
    const int tid = c.tid, lane = c.lane, wave = c.wave;
    const bf16_t* bc = (const bf16_t*)(c.ws + WS_BC); const bf16_t* xs = (const bf16_t*)(c.ws + WS_XS); const bf16_t* pz = (const bf16_t*)(c.ws + WS_PZ);
    const float* dt = (const float*)(c.ws + WS_DT); const float* al = (const float*)(c.ws + WS_DEC);
    const bf16_t* stb = (const bf16_t*)(c.ws + WS_STB); bf16_t* yb = (bf16_t*)(c.ws + WS_YB); float* ssqb = (float*)(c.ws + WS_SSQB);
    LAS unsigned char* Cimg = c.lds + SD_OFF_C; LAS unsigned char* Bimg = c.lds + SD_OFF_B; LAS unsigned char* Ximg = c.lds + SD_OFF_X;
    LAS unsigned char* HfT = c.lds + SD_OFF_HF; LAS unsigned char* HbT = c.lds + SD_OFF_HB;
    LAS unsigned char* Ms = c.lds + SD_OFF_M + wave * 4352; LAS float* sc = (LAS float*)(c.lds + SD_OFF_SC);
    for (int round = 0; round < 8; ++round) {
        SsdUnit u; int g0; if (!ssd_unit_n(c.bid - first, nblk, round, u, g0)) break;
        const size_t m0 = (size_t)row_of(u.b, u.t0); const int nks = u.ns == 1 ? 1 : 4; const bool active = wave < u.ns;
        float ssrow = 0.f;
        for (int g = g0; g <= g0; ++g) {
            __syncthreads();
            ssd_load_img(Cimg, SD_RS, bc, 512, m0, 256 + g * 128, 128, u.ns, tid);
            ssd_load_img(Bimg, SD_RS, bc, 512, m0, g * 128, 128, u.ns, tid);
            __syncthreads();
            f32x4 cb[8];
#pragma unroll
            for (int t = 0; t < 8; ++t) cb[t] = (f32x4){0.f, 0.f, 0.f, 0.f};
            if (active) {
#pragma unroll
                for (int ks = 0; ks < 4; ++ks) {
                    const bf16x8 cfr = frag_row(Cimg, SD_RS, 16 * wave, 32 * ks, lane);
#pragma unroll
                    for (int t = 0; t < 8; ++t) if (t < u.ns) cb[t] = __builtin_amdgcn_mfma_f32_16x16x32_bf16(frag_row(Bimg, SD_RS, 16 * t, 32 * ks, lane), cfr, cb[t], 0, 0, 0);
                }
            }
            for (int j = 0; j < 4; ++j) {
                const int head = g * 4 + j;
                __syncthreads();
                ssd_load_img(Ximg, SD_XRS, xs, 512, m0, head * 64, 64, u.ns, tid);
                {
                    const bf16_t* hf = u.ck >= 1 ? stb + ((((size_t)u.b * 2 + 0) * 8 + head) * 32 + (u.ck - 1)) * 8192 : nullptr;
                    const bf16_t* hb = u.ck <= 31 ? stb + ((((size_t)u.b * 2 + 1) * 8 + head) * 32 + u.ck) * 8192 : nullptr;
                    for (int i = tid; i < 64 * 16; i += NTHREADS) { const int p = i >> 4, cc = i & 15;
                        *(LAS u32x4*)(HfT + p * SD_RS + cc * 16) = hf ? *(const u32x4*)(hf + p * 128 + cc * 8) : (u32x4){0u, 0u, 0u, 0u};
                        *(LAS u32x4*)(HbT + p * SD_RS + cc * 16) = hb ? *(const u32x4*)(hb + p * 128 + cc * 8) : (u32x4){0u, 0u, 0u, 0u}; }
                }
                if (wave == 0) { float totf, totb; ssd_scalars(sc, dt, al, m0, head, u.ns, lane, totf, totb); }
                __syncthreads();
                if (active) {
                    const int ll = 16 * wave + (lane & 15); const float afl = sc[ll], ebl = sc[128 + ll];
#pragma unroll
                    for (int t = 0; t < 8; ++t) {
                        u32x2 w2 = (u32x2){0u, 0u};
                        if (t < u.ns) {
                            const int s0 = 16 * t + 4 * (lane >> 4);
                            const f32x4 afs = *(const LAS f32x4*)(sc + s0), ebs = *(const LAS f32x4*)(sc + 128 + s0), dfs = *(const LAS f32x4*)(sc + 256 + s0), dbs = *(const LAS f32x4*)(sc + 384 + s0);
                            float mv[4];
#pragma unroll
                            for (int r = 0; r < 4; ++r) { const int s = s0 + r; float wgt = 0.f; if (s <= ll) wgt += __expf(afl - afs[r]) * dfs[r]; if (s >= ll) wgt += __expf(ebs[r] - ebl) * dbs[r]; mv[r] = cb[t][r] * wgt; }
                            w2 = (u32x2){pk2(mv[0], mv[1]), pk2(mv[2], mv[3])};
                        }
                        if (t < 2 * nks) *(LAS u32x2*)(Ms + (lane & 15) * SD_RS + (16 * t + 4 * (lane >> 4)) * 2) = w2;
                    }
                    asm volatile("s_waitcnt lgkmcnt(0)" ::: "memory");
                    f32x4 ay[4], ahf[4], ahb[4];
#pragma unroll
                    for (int pt = 0; pt < 4; ++pt) { ay[pt] = (f32x4){0.f, 0.f, 0.f, 0.f}; ahf[pt] = ay[pt]; ahb[pt] = ay[pt]; }
                    for (int ks = 0; ks < nks; ++ks) {
                        const bf16x8 mf = frag_row(Ms, SD_RS, 0, 32 * ks, lane);
#pragma unroll
                        for (int pt = 0; pt < 4; ++pt) ay[pt] = __builtin_amdgcn_mfma_f32_16x16x32_bf16(mf, frag_tr(Ximg, SD_XRS, 32 * ks, 16 * pt, lane), ay[pt], 0, 0, 0);
                    }
#pragma unroll
                    for (int ks = 0; ks < 4; ++ks) {
                        const bf16x8 cfr = frag_row(Cimg, SD_RS, 16 * wave, 32 * ks, lane);
#pragma unroll
                        for (int pt = 0; pt < 4; ++pt) {
                            ahf[pt] = __builtin_amdgcn_mfma_f32_16x16x32_bf16(cfr, frag_row(HfT, SD_RS, 16 * pt, 32 * ks, lane), ahf[pt], 0, 0, 0);
                            ahb[pt] = __builtin_amdgcn_mfma_f32_16x16x32_bf16(cfr, frag_row(HbT, SD_RS, 16 * pt, 32 * ks, lane), ahb[pt], 0, 0, 0);
                        }
                    }
                    const int l0 = 16 * wave + 4 * (lane >> 4);
                    const f32x4 efv = *(const LAS f32x4*)(sc + 768 + l0), ebv = *(const LAS f32x4*)(sc + 896 + l0);
                    asm volatile("s_waitcnt lgkmcnt(0)" ::: "memory");
                    LAS float* ys = (LAS float*)Ms;
#pragma unroll
                    for (int pt = 0; pt < 4; ++pt)
#pragma unroll
                        for (int r = 0; r < 4; ++r) ys[(4 * (lane >> 4) + r) * 68 + 16 * pt + (lane & 15)] = ay[pt][r] + efv[r] * ahf[pt][r] + ebv[r] * ahb[pt][r];
                    asm volatile("s_waitcnt lgkmcnt(0)" ::: "memory");
                    const int rr = lane >> 2, p0 = 16 * (lane & 3); const size_t m = m0 + 16 * wave + rr;
                    const float dsk = c.in[I_SSDD][l * 8 + head];
                    float xv[16], zv[16];
                    { float t8[8]; unpack8(*(const LAS u32x4*)(Ximg + (16 * wave + rr) * SD_XRS + p0 * 2), t8);
#pragma unroll
                      for (int e = 0; e < 8; ++e) xv[e] = t8[e];
                      unpack8(*(const LAS u32x4*)(Ximg + (16 * wave + rr) * SD_XRS + p0 * 2 + 16), t8);
#pragma unroll
                      for (int e = 0; e < 8; ++e) xv[8 + e] = t8[e];
                      unpack8(*(const u32x4*)(pz + m * 512 + head * 64 + p0), t8);
#pragma unroll
                      for (int e = 0; e < 8; ++e) zv[e] = t8[e];
                      unpack8(*(const u32x4*)(pz + m * 512 + head * 64 + p0 + 8), t8);
#pragma unroll
                      for (int e = 0; e < 8; ++e) zv[8 + e] = t8[e]; }
                    float o[16];
#pragma unroll
                    for (int e4 = 0; e4 < 4; ++e4) { const f32x4 yv = *(const LAS f32x4*)(ys + rr * 68 + p0 + 4 * e4);
#pragma unroll
                        for (int e = 0; e < 4; ++e) { const float val = (yv[e] + dsk * xv[4 * e4 + e]) * siluf_(zv[4 * e4 + e]); o[4 * e4 + e] = val; ssrow += val * val; } }
                    u32x4 w0, w1; w0.x = pk2(o[0], o[1]); w0.y = pk2(o[2], o[3]); w0.z = pk2(o[4], o[5]); w0.w = pk2(o[6], o[7]); w1.x = pk2(o[8], o[9]); w1.y = pk2(o[10], o[11]); w1.z = pk2(o[12], o[13]); w1.w = pk2(o[14], o[15]);
                    *(u32x4*)(yb + m * 512 + head * 64 + p0) = w0; *(u32x4*)(yb + m * 512 + head * 64 + p0 + 8) = w1;
                }
            }
        }
        if (active) { ssrow += dpp_mov<0xB1>(ssrow); ssrow += dpp_mov<0x4E>(ssrow); if ((lane & 3) == 0) ssqb[(m0 + 16 * wave + (lane >> 2)) * 2 + g0] = ssrow; }
    }
    __syncthreads();
}
#define RC_NONE 1
typedef short s16x4v __attribute__((ext_vector_type(4)));
constexpr int RC_NCH = LEN / 16;
constexpr int RC_NP = 5;
constexpr int RC_ROUNDS = (RC_NCH + RC_NP - 1) / RC_NP;
constexpr int RC_S64 = 144;
constexpr int RC_S16 = 40;
constexpr int RC_AT = 0, RC_RT = 2304, RC_BH = 4608, RC_KH = 6912, RC_T = 9216, RC_AAK = 9856, RC_ARB = 10496, RC_ARK = 11136, RC_VT = 11776, RC_P16 = 12416, RC_SLOT = 12800;
constexpr int RC_SCR0 = 2 * RC_NP * RC_SLOT;
constexpr int RC_SCR = 1280;
static_assert(RC_SCR0 + RC_NP * RC_SCR <= 147456 - 512, "rwkv chunk LDS");
__device__ __forceinline__ f32x4 mm16(s16x4v a, s16x4v b, f32x4 c, int, int, int) { return __builtin_amdgcn_mfma_f32_16x16x32_bf16((bf16x8){a[0], a[1], a[2], a[3], 0, 0, 0, 0}, (bf16x8){b[0], b[1], b[2], b[3], 0, 0, 0, 0}, c, 0, 0, 0); }
__device__ __forceinline__ s16x4v mfma16_frag(const LAS unsigned char* mat, int row, int q) { return *(const LAS s16x4v*)(mat + row * RC_S16 + q * 8); }

__device__ __forceinline__ void rwkv_chunked(const Ctx& cx_, int l) {
    const Ctx c = relaunder(cx_);


    const int bid = c.bid, qs = bid & 3, dir = 1 - ((bid >> 2) & 1), head = (bid >> 3) & 3, b = bid >> 5;
    const int lane = c.lane, wave = c.wave;
    const bf16_t* rk = (const bf16_t*)(c.dout + DO_RKVP) + head * 64; const bf16_t* l2 = (const bf16_t*)(c.ws + WS_L2O) + dir * 256 + head * 64;
#ifdef RWKV_DBG
    bf16_t* yo = (bf16_t*)(c.ws + WS_MIX + (dir ? 47 * QB / 2 : 33 * QB / 2)) + head * 64 + 16 * qs;
#else
    bf16_t* yo = (bf16_t*)(c.ws + WS_YRW) + (size_t)dir * MP * 256 + head * 64 + 16 * qs;
#endif
    auto tok = [&](int s) -> size_t { const int t = s + dir * (LEN - 1 - 2 * s); return (size_t)row_of(b, t); };
    const int q = lane >> 4, li = lane & 15;
#ifdef RC_ZLDS
    for (int i = c.tid; i < 131072 / 16; i += NTHREADS) *(LAS u32x4*)(c.lds + i * 16) = (u32x4){0u, 0u, 0u, 0u};
    __syncthreads();
#endif
#ifdef RC_DELAY
    { const unsigned long long t0_ = __builtin_amdgcn_s_memrealtime(); while (__builtin_amdgcn_s_memrealtime() - t0_ < 40000ull) __builtin_amdgcn_s_sleep(16); }
#endif
#ifdef RC_PREFILL
    for (int i = c.tid; i < LEN * 2; i += NTHREADS) { const size_t m = (size_t)row_of(b, i >> 1); *(u32x4*)(yo + m * 256 + (i & 1) * 8) = (u32x4){0u, 0u, 0u, 0u}; }
    asm volatile("s_waitcnt vmcnt(0)" ::: "memory"); __syncthreads();
#endif
    u32x4 Rr[2], Kr[2], KKr[2], DLr[2], ASr[2]; bf16_t vr[4];
    auto load_raw = [&](int ch) {
        const size_t m = tok(16 * ch + li); const int k0 = 16 * q;
#pragma unroll
        for (int h = 0; h < 2; ++h) { Rr[h] = *(const u32x4*)(rk + m * 1024 + k0 + 8 * h); Kr[h] = *(const u32x4*)(rk + m * 1024 + 256 + k0 + 8 * h); KKr[h] = *(const u32x4*)(rk + m * 1024 + 768 + k0 + 8 * h);
            DLr[h] = *(const u32x4*)(l2 + m * 1280 + k0 + 8 * h); ASr[h] = *(const u32x4*)(l2 + m * 1280 + 512 + k0 + 8 * h); }
        const int vv = lane >> 2, sg = lane & 3;
#pragma unroll
        for (int j = 0; j < 4; ++j) vr[j] = rk[tok(16 * ch + 4 * sg + j) * 1024 + 512 + 16 * qs + vv];
    };
    auto produce = [&](int slot) {
        LAS unsigned char* sb = c.lds + slot * RC_SLOT; LAS float* Aab = (LAS float*)(c.lds + RC_SCR0 + (wave - 1) * RC_SCR);
        LAS unsigned char* Bh = sb + RC_BH; LAS unsigned char* Kh = sb + RC_KH;
        {
            const int vv = lane >> 2, sg = lane & 3;
            *(LAS u32x2*)(sb + RC_VT + vv * RC_S16 + sg * 8) = (u32x2){(unsigned)vr[0] | ((unsigned)vr[1] << 16), (unsigned)vr[2] | ((unsigned)vr[3] << 16)};
        }
        const int k0 = 16 * q;
#pragma unroll
        for (int h = 0; h < 2; ++h) {
            float r_[8], k_[8], kk_[8], dl_[8], as_[8], cs_[8]; unpack8(Rr[h], r_); unpack8(Kr[h], k_); unpack8(KKr[h], kk_); unpack8(DLr[h], dl_); unpack8(ASr[h], as_);
            const f32x4 ka0 = *(const f32x4*)(c.in[I_KA] + (size_t)l * 256 + head * 64 + k0 + 8 * h), ka1 = *(const f32x4*)(c.in[I_KA] + (size_t)l * 256 + head * 64 + k0 + 8 * h + 4);
            const float ka[8] = {ka0.x, ka0.y, ka0.z, ka0.w, ka1.x, ka1.y, ka1.z, ka1.w};
            float at_[8], rt_[8], bh_[8], kh_[8], p_[8];
#pragma unroll
            for (int e = 0; e < 8; ++e) {
                float x = dl_[e];
                x += dpp_mov<0x111>(x); x += dpp_mov<0x112>(x); x += dpp_mov<0x114>(x); x += dpp_mov<0x118>(x);
                cs_[e] = x;
            }
#pragma unroll
            for (int e = 0; e < 8; ++e) {
                const float P = __expf(cs_[e]), Pm = __expf(cs_[e] - dl_[e]), iP = __expf(-cs_[e]);
                at_[e] = -kk_[e] * Pm; rt_[e] = r_[e] * P; bh_[e] = kk_[e] * as_[e] * iP; kh_[e] = k_[e] * (1.f + (as_[e] - 1.f) * ka[e]) * iP; p_[e] = P;
            }
            *(LAS u32x4*)(sb + RC_AT + li * RC_S64 + (k0 + 8 * h) * 2) = pack8(at_); *(LAS u32x4*)(sb + RC_RT + li * RC_S64 + (k0 + 8 * h) * 2) = pack8(rt_);
            *(LAS u32x4*)(Bh + li * RC_S64 + (k0 + 8 * h) * 2) = pack8(bh_); *(LAS u32x4*)(Kh + li * RC_S64 + (k0 + 8 * h) * 2) = pack8(kh_);
            if (li == 15) { *(LAS f32x4*)(sb + RC_P16 + (k0 + 8 * h) * 4) = (f32x4){p_[0], p_[1], p_[2], p_[3]}; *(LAS f32x4*)(sb + RC_P16 + (k0 + 8 * h + 4) * 4) = (f32x4){p_[4], p_[5], p_[6], p_[7]}; }
        }
        asm volatile("s_waitcnt lgkmcnt(0)" ::: "memory");
        f32x4 ab = (f32x4){0.f, 0.f, 0.f, 0.f}, ak = ab, rb = ab, rkm = ab;
#pragma unroll
        for (int ks = 0; ks < 2; ++ks) {
            const bf16x8 fa = *(const LAS bf16x8*)(sb + RC_AT + li * RC_S64 + (32 * ks + 8 * q) * 2), fr = *(const LAS bf16x8*)(sb + RC_RT + li * RC_S64 + (32 * ks + 8 * q) * 2);
            const bf16x8 fb = *(const LAS bf16x8*)(Bh + li * RC_S64 + (32 * ks + 8 * q) * 2), fk = *(const LAS bf16x8*)(Kh + li * RC_S64 + (32 * ks + 8 * q) * 2);
            ab = __builtin_amdgcn_mfma_f32_16x16x32_bf16(fa, fb, ab, 0, 0, 0); ak = __builtin_amdgcn_mfma_f32_16x16x32_bf16(fa, fk, ak, 0, 0, 0);
            rb = __builtin_amdgcn_mfma_f32_16x16x32_bf16(fr, fb, rb, 0, 0, 0); rkm = __builtin_amdgcn_mfma_f32_16x16x32_bf16(fr, fk, rkm, 0, 0, 0);
        }
#pragma unroll
        for (int r = 0; r < 4; ++r) {
            const int t = 4 * q + r, s = li;
            Aab[t * 20 + s] = s < t ? ab[r] : 0.f;
            *(LAS bf16_t*)(sb + RC_AAK + t * RC_S16 + s * 2) = (bf16_t)f2bf(s < t ? ak[r] : 0.f);
            *(LAS bf16_t*)(sb + RC_ARB + t * RC_S16 + s * 2) = (bf16_t)f2bf(s <= t ? rb[r] : 0.f);
            *(LAS bf16_t*)(sb + RC_ARK + t * RC_S16 + s * 2) = (bf16_t)f2bf(s <= t ? rkm[r] : 0.f);
        }
        asm volatile("s_waitcnt lgkmcnt(0)" ::: "memory");
        float tc[16];
#pragma unroll
        for (int t = 0; t < 16; ++t) {
            float acc = (t == li) ? 1.f : 0.f;
            f32x4 a0 = *(const LAS f32x4*)(Aab + t * 20), a1 = *(const LAS f32x4*)(Aab + t * 20 + 4), a2 = *(const LAS f32x4*)(Aab + t * 20 + 8), a3 = *(const LAS f32x4*)(Aab + t * 20 + 12);
            const float av[16] = {a0.x, a0.y, a0.z, a0.w, a1.x, a1.y, a1.z, a1.w, a2.x, a2.y, a2.z, a2.w, a3.x, a3.y, a3.z, a3.w};
#pragma unroll
            for (int s = 0; s < t; ++s) acc += av[s] * tc[s];
            tc[t] = acc;
        }
        if (q == 0) {
#pragma unroll
            for (int t = 0; t < 16; ++t) *(LAS bf16_t*)(sb + RC_T + t * RC_S16 + li * 2) = (bf16_t)f2bf(tc[t]);
        }
    };
    if (wave >= 1 && wave <= RC_NP) { const int ch0 = wave - 1; load_raw(ch0); produce(wave - 1); load_raw(ch0 + RC_NP); }
    __syncthreads();
    f32x4 S[4]; bf16x8 sop[2];
#pragma unroll
    for (int kt = 0; kt < 4; ++kt) S[kt] = (f32x4){0.f, 0.f, 0.f, 0.f};
    sop[0] = (bf16x8){0, 0, 0, 0, 0, 0, 0, 0}; sop[1] = sop[0];
    int sbase = 0;
    auto consume = [&](const int i, const int ch) {
                const LAS unsigned char* sb = c.lds + (sbase + i) * RC_SLOT;
        const s16x4v vt = mfma16_frag(sb + RC_VT, li, q);
        f32x4 aw = mm16(mfma16_frag(sb + RC_AAK, li, q), vt, (f32x4){0.f, 0.f, 0.f, 0.f}, 0, 0, 0);
        f32x4 ay = mm16(mfma16_frag(sb + RC_ARK, li, q), vt, (f32x4){0.f, 0.f, 0.f, 0.f}, 0, 0, 0);
#pragma unroll
        for (int ks = 0; ks < 2; ++ks) {
            const s16x4v alo = *(const LAS s16x4v*)(sb + RC_AT + li * RC_S64 + (32 * ks + 4 * q) * 2), ahi = *(const LAS s16x4v*)(sb + RC_AT + li * RC_S64 + (32 * ks + 16 + 4 * q) * 2);
            const s16x4v rlo = *(const LAS s16x4v*)(sb + RC_RT + li * RC_S64 + (32 * ks + 4 * q) * 2), rhi = *(const LAS s16x4v*)(sb + RC_RT + li * RC_S64 + (32 * ks + 16 + 4 * q) * 2);
            aw = __builtin_amdgcn_mfma_f32_16x16x32_bf16((bf16x8){alo[0], alo[1], alo[2], alo[3], ahi[0], ahi[1], ahi[2], ahi[3]}, sop[ks], aw, 0, 0, 0);
            ay = __builtin_amdgcn_mfma_f32_16x16x32_bf16((bf16x8){rlo[0], rlo[1], rlo[2], rlo[3], rhi[0], rhi[1], rhi[2], rhi[3]}, sop[ks], ay, 0, 0, 0);
        }
        const u32x2 wb2 = (u32x2){pk2(aw[0], aw[1]), pk2(aw[2], aw[3])};
        const f32x4 au = mm16(mfma16_frag(sb + RC_T, li, q), __builtin_bit_cast(s16x4v, wb2), (f32x4){0.f, 0.f, 0.f, 0.f}, 0, 0, 0);
        const u32x2 ub2 = (u32x2){pk2(au[0], au[1]), pk2(au[2], au[3])}; const s16x4v ub = __builtin_bit_cast(s16x4v, ub2);
        ay = mm16(mfma16_frag(sb + RC_ARB, li, q), ub, ay, 0, 0, 0);
#pragma unroll
        for (int kt = 0; kt < 4; ++kt) {
            const f32x4 p16 = *(const LAS f32x4*)(sb + RC_P16 + (16 * kt + 4 * q) * 4);
            const int troff = (4 * q + (li >> 2)) * RC_S64 + (16 * kt + 4 * (li & 3)) * 2;
            f32x4 sv = S[kt];
            sv = mm16(lds_tr(sb + RC_KH + troff), vt, sv, 0, 0, 0);
            sv = mm16(lds_tr(sb + RC_BH + troff), ub, sv, 0, 0, 0);
            sv = sv * p16;
            S[kt] = sv;
        }
#pragma unroll
        for (int ks = 0; ks < 2; ++ks) {
            const u32x4 w = (u32x4){pk2(S[2 * ks][0], S[2 * ks][1]), pk2(S[2 * ks][2], S[2 * ks][3]), pk2(S[2 * ks + 1][0], S[2 * ks + 1][1]), pk2(S[2 * ks + 1][2], S[2 * ks + 1][3])};
            sop[ks] = __builtin_bit_cast(bf16x8, w);
        }
#pragma unroll
        for (int r = 0; r < 4; ++r) yo[tok(16 * ch + 4 * q + r) * 256 + li] = (bf16_t)f2bf(ay[r]);
    };
    for (int rd = 0; rd < RC_ROUNDS; ++rd) {
        if (wave == 0) {
            sbase = (rd & 1) * RC_NP;
            if (rd < RC_ROUNDS - 1) {
#pragma unroll
                for (int i = 0; i < RC_NP; ++i) consume(i, RC_NP * rd + i);
            } else {
                for (int i = 0; i < RC_NP; ++i) { const int ch = RC_NP * rd + i; if (ch >= RC_NCH) break; consume(i, ch); }
            }
        } else if (wave <= RC_NP) {
            const int chn = RC_NP * (rd + 1) + (wave - 1);
            if (chn < RC_NCH) { produce(((rd + 1) & 1) * RC_NP + (wave - 1)); if (chn + RC_NP < RC_NCH) load_raw(chn + RC_NP); }
        }
        __syncthreads();
    }
}constexpr int RC64_NP = 4, RC64_ROUNDS = (RC_NCH + RC64_NP - 1) / RC64_NP;
constexpr int RC64_V = 11776, RC64_P16 = 14080, RC64_SLOT = 14336;
constexpr int RC64_SCR0 = 2 * RC64_NP * RC64_SLOT;
static_assert(RC64_SCR0 + RC64_NP * RC_SCR <= 147456 - 512, "rwkv64 LDS");
__device__ __forceinline__ void rwkv_chunked64(const Ctx& cx_, int l) {
    const Ctx c = relaunder(cx_);


    const int bid = c.bid, dir = bid & 1, head = (bid >> 1) & 3, b = bid >> 3;
    const int lane = c.lane, wave = c.wave;
    const bf16_t* rk = (const bf16_t*)(c.dout + DO_RKVP) + head * 64; const bf16_t* l2 = (const bf16_t*)(c.ws + WS_L2O) + dir * 256 + head * 64;
    bf16_t* yo = (bf16_t*)(c.ws + WS_YRW) + (size_t)dir * MP * 256 + head * 64 + 16 * (wave & 3);
    auto tok = [&](int s) -> size_t { const int t = s + dir * (LEN - 1 - 2 * s); return (size_t)row_of(b, t); };
    const int q = lane >> 4, li = lane & 15;
    u32x4 Rr[2], Kr[2], KKr[2], DLr[2], ASr[2], Vr[2];
    auto load_raw = [&](int ch) {
        const size_t m = tok(16 * ch + li); const int k0 = 16 * q;
#pragma unroll
        for (int h = 0; h < 2; ++h) { Rr[h] = *(const u32x4*)(rk + m * 1024 + k0 + 8 * h); Kr[h] = *(const u32x4*)(rk + m * 1024 + 256 + k0 + 8 * h); KKr[h] = *(const u32x4*)(rk + m * 1024 + 768 + k0 + 8 * h);
            DLr[h] = *(const u32x4*)(l2 + m * 1280 + k0 + 8 * h); ASr[h] = *(const u32x4*)(l2 + m * 1280 + 512 + k0 + 8 * h); Vr[h] = *(const u32x4*)(rk + m * 1024 + 512 + k0 + 8 * h); }
    };
    float kaall[16];
#pragma unroll
    for (int e = 0; e < 16; ++e) kaall[e] = c.in[I_KA][(size_t)l * 256 + head * 64 + 16 * q + e];
    auto produce = [&](int slot) {
        LAS unsigned char* sb = c.lds + slot * RC64_SLOT; LAS float* Aab = (LAS float*)(c.lds + RC64_SCR0 + (wave - 4) * RC_SCR);
        LAS unsigned char* Bh = sb + RC_BH; LAS unsigned char* Kh = sb + RC_KH;
        *(LAS u32x4*)(sb + RC64_V + li * RC_S64 + (16 * q) * 2) = Vr[0]; *(LAS u32x4*)(sb + RC64_V + li * RC_S64 + (16 * q + 8) * 2) = Vr[1];
        const int k0 = 16 * q;
#pragma unroll
        for (int h = 0; h < 2; ++h) {
            float r_[8], k_[8], kk_[8], dl_[8], as_[8], cs_[8]; unpack8(Rr[h], r_); unpack8(Kr[h], k_); unpack8(KKr[h], kk_); unpack8(DLr[h], dl_); unpack8(ASr[h], as_);
            const float* ka = kaall + 8 * h;
            float at_[8], rt_[8], bh_[8], kh_[8], p_[8];
#pragma unroll
            for (int e = 0; e < 8; ++e) {
                float x = dl_[e];
                x += dpp_mov<0x111>(x); x += dpp_mov<0x112>(x); x += dpp_mov<0x114>(x); x += dpp_mov<0x118>(x);
                cs_[e] = x;
            }
#pragma unroll
            for (int e = 0; e < 8; ++e) {
                const float P = __expf(cs_[e]), Pm = __expf(cs_[e] - dl_[e]), iP = __expf(-cs_[e]);
                at_[e] = -kk_[e] * Pm; rt_[e] = r_[e] * P; bh_[e] = kk_[e] * as_[e] * iP; kh_[e] = k_[e] * (1.f + (as_[e] - 1.f) * ka[e]) * iP; p_[e] = P;
            }
            *(LAS u32x4*)(sb + RC_AT + li * RC_S64 + (k0 + 8 * h) * 2) = pack8(at_); *(LAS u32x4*)(sb + RC_RT + li * RC_S64 + (k0 + 8 * h) * 2) = pack8(rt_);
            *(LAS u32x4*)(Bh + li * RC_S64 + (k0 + 8 * h) * 2) = pack8(bh_); *(LAS u32x4*)(Kh + li * RC_S64 + (k0 + 8 * h) * 2) = pack8(kh_);
            if (li == 15) { *(LAS f32x4*)(sb + RC64_P16 + (k0 + 8 * h) * 4) = (f32x4){p_[0], p_[1], p_[2], p_[3]}; *(LAS f32x4*)(sb + RC64_P16 + (k0 + 8 * h + 4) * 4) = (f32x4){p_[4], p_[5], p_[6], p_[7]}; }
        }
        asm volatile("s_waitcnt lgkmcnt(0)" ::: "memory");
        f32x4 ab = (f32x4){0.f, 0.f, 0.f, 0.f}, ak = ab, rb = ab, rkm = ab;
#pragma unroll
        for (int ks = 0; ks < 2; ++ks) {
            const bf16x8 fa = *(const LAS bf16x8*)(sb + RC_AT + li * RC_S64 + (32 * ks + 8 * q) * 2), fr = *(const LAS bf16x8*)(sb + RC_RT + li * RC_S64 + (32 * ks + 8 * q) * 2);
            const bf16x8 fb = *(const LAS bf16x8*)(Bh + li * RC_S64 + (32 * ks + 8 * q) * 2), fk = *(const LAS bf16x8*)(Kh + li * RC_S64 + (32 * ks + 8 * q) * 2);
            ab = __builtin_amdgcn_mfma_f32_16x16x32_bf16(fa, fb, ab, 0, 0, 0); ak = __builtin_amdgcn_mfma_f32_16x16x32_bf16(fa, fk, ak, 0, 0, 0);
            rb = __builtin_amdgcn_mfma_f32_16x16x32_bf16(fr, fb, rb, 0, 0, 0); rkm = __builtin_amdgcn_mfma_f32_16x16x32_bf16(fr, fk, rkm, 0, 0, 0);
        }
#pragma unroll
        for (int r = 0; r < 4; ++r) {
            const int t = 4 * q + r, s = li;
            Aab[t * 20 + s] = s < t ? ab[r] : 0.f;
            *(LAS bf16_t*)(sb + RC_AAK + t * RC_S16 + s * 2) = (bf16_t)f2bf(s < t ? ak[r] : 0.f);
            *(LAS bf16_t*)(sb + RC_ARB + t * RC_S16 + s * 2) = (bf16_t)f2bf(s <= t ? rb[r] : 0.f);
            *(LAS bf16_t*)(sb + RC_ARK + t * RC_S16 + s * 2) = (bf16_t)f2bf(s <= t ? rkm[r] : 0.f);
        }
        asm volatile("s_waitcnt lgkmcnt(0)" ::: "memory");
        float tc[16];
#pragma unroll
        for (int t = 0; t < 16; ++t) {
            float acc = (t == li) ? 1.f : 0.f;
            f32x4 a0 = *(const LAS f32x4*)(Aab + t * 20), a1 = *(const LAS f32x4*)(Aab + t * 20 + 4), a2 = *(const LAS f32x4*)(Aab + t * 20 + 8), a3 = *(const LAS f32x4*)(Aab + t * 20 + 12);
            const float av[16] = {a0.x, a0.y, a0.z, a0.w, a1.x, a1.y, a1.z, a1.w, a2.x, a2.y, a2.z, a2.w, a3.x, a3.y, a3.z, a3.w};
            float a1_ = 0.f, a2_ = 0.f, a3_ = 0.f;
#pragma unroll
            for (int s = 0; s < t; ++s) { const float pr_ = av[s] * tc[s]; if ((s & 3) == 0) acc += pr_; else if ((s & 3) == 1) a1_ += pr_; else if ((s & 3) == 2) a2_ += pr_; else a3_ += pr_; }
            tc[t] = (acc + a1_) + (a2_ + a3_);
        }
        if (q == 0) {
#pragma unroll
            for (int t = 0; t < 16; ++t) *(LAS bf16_t*)(sb + RC_T + t * RC_S16 + li * 2) = (bf16_t)f2bf(tc[t]);
        }
    };
    if (wave >= 4 && wave - 4 < RC64_NP) { const int ch0 = wave - 4; load_raw(ch0); produce(wave - 4); load_raw(ch0 + RC64_NP); }
    __syncthreads();
    f32x4 S[4]; bf16x8 sop[2];
#pragma unroll
    for (int kt = 0; kt < 4; ++kt) S[kt] = (f32x4){0.f, 0.f, 0.f, 0.f};
    sop[0] = (bf16x8){0, 0, 0, 0, 0, 0, 0, 0}; sop[1] = sop[0];
    int sbase = 0;
    auto consume = [&](const int i, const int ch) {
                const LAS unsigned char* sb = c.lds + (sbase + i) * RC64_SLOT;
        const s16x4v vt = lds_tr(sb + RC64_V + (4 * q + (li >> 2)) * RC_S64 + (16 * (wave & 3) + 4 * (li & 3)) * 2);
        f32x4 aw = mm16(mfma16_frag(sb + RC_AAK, li, q), vt, (f32x4){0.f, 0.f, 0.f, 0.f}, 0, 0, 0);
        f32x4 ay = mm16(mfma16_frag(sb + RC_ARK, li, q), vt, (f32x4){0.f, 0.f, 0.f, 0.f}, 0, 0, 0);
#pragma unroll
        for (int ks = 0; ks < 2; ++ks) {
            const s16x4v alo = *(const LAS s16x4v*)(sb + RC_AT + li * RC_S64 + (32 * ks + 4 * q) * 2), ahi = *(const LAS s16x4v*)(sb + RC_AT + li * RC_S64 + (32 * ks + 16 + 4 * q) * 2);
            const s16x4v rlo = *(const LAS s16x4v*)(sb + RC_RT + li * RC_S64 + (32 * ks + 4 * q) * 2), rhi = *(const LAS s16x4v*)(sb + RC_RT + li * RC_S64 + (32 * ks + 16 + 4 * q) * 2);
            aw = __builtin_amdgcn_mfma_f32_16x16x32_bf16((bf16x8){alo[0], alo[1], alo[2], alo[3], ahi[0], ahi[1], ahi[2], ahi[3]}, sop[ks], aw, 0, 0, 0);
            ay = __builtin_amdgcn_mfma_f32_16x16x32_bf16((bf16x8){rlo[0], rlo[1], rlo[2], rlo[3], rhi[0], rhi[1], rhi[2], rhi[3]}, sop[ks], ay, 0, 0, 0);
        }
        const u32x2 wb2 = (u32x2){pk2(aw[0], aw[1]), pk2(aw[2], aw[3])};
        const f32x4 au = mm16(mfma16_frag(sb + RC_T, li, q), __builtin_bit_cast(s16x4v, wb2), (f32x4){0.f, 0.f, 0.f, 0.f}, 0, 0, 0);
        const u32x2 ub2 = (u32x2){pk2(au[0], au[1]), pk2(au[2], au[3])}; const s16x4v ub = __builtin_bit_cast(s16x4v, ub2);
        ay = mm16(mfma16_frag(sb + RC_ARB, li, q), ub, ay, 0, 0, 0);
#pragma unroll
        for (int kt = 0; kt < 4; ++kt) {
            const f32x4 p16 = *(const LAS f32x4*)(sb + RC64_P16 + (16 * kt + 4 * q) * 4);
            const int troff = (4 * q + (li >> 2)) * RC_S64 + (16 * kt + 4 * (li & 3)) * 2;
            f32x4 sv = S[kt];
            sv = mm16(lds_tr(sb + RC_KH + troff), vt, sv, 0, 0, 0);
            sv = mm16(lds_tr(sb + RC_BH + troff), ub, sv, 0, 0, 0);
            sv = sv * p16;
            S[kt] = sv;
        }
#pragma unroll
        for (int ks = 0; ks < 2; ++ks) {
            const u32x4 w = (u32x4){pk2(S[2 * ks][0], S[2 * ks][1]), pk2(S[2 * ks][2], S[2 * ks][3]), pk2(S[2 * ks + 1][0], S[2 * ks + 1][1]), pk2(S[2 * ks + 1][2], S[2 * ks + 1][3])};
            sop[ks] = __builtin_bit_cast(bf16x8, w);
        }
#pragma unroll
        for (int r = 0; r < 4; ++r) yo[tok(16 * ch + 4 * q + r) * 256 + li] = (bf16_t)f2bf(ay[r]);
    };
    for (int rd = 0; rd < RC64_ROUNDS; ++rd) {
        if (wave < 4) {
            sbase = (rd & 1) * RC64_NP;
            if (rd < RC64_ROUNDS - 1) {
#pragma unroll
                for (int i = 0; i < RC64_NP; ++i) consume(i, RC64_NP * rd + i);
            } else {
                for (int i = 0; i < RC64_NP; ++i) { const int ch = RC64_NP * rd + i; if (ch >= RC_NCH) break; consume(i, ch); }
            }
        } else if (wave - 4 < RC64_NP) {
            const int chn = RC64_NP * (rd + 1) + (wave - 4);
            if (chn < RC_NCH) { produce(((rd + 1) & 1) * RC64_NP + (wave - 4)); if (chn + RC64_NP < RC_NCH) load_raw(chn + RC64_NP); }
        }
        __syncthreads();
    }
}
constexpr int RW_T = 32, RW_NC = (LEN + RW_T - 1) / RW_T, RW_BUF = 45056;
__device__ __forceinline__ void rwkv_scan(const Ctx& cx_, int l) {
    const Ctx c = relaunder(cx_);
    const int bid = c.bid, q = bid & 3, dir = 1 - ((bid >> 2) & 1), head = (bid >> 3) & 3, b = bid >> 5;
    const int tid = c.tid, lane = c.lane, wave = c.wave;
    const bf16_t* rk = (const bf16_t*)(c.dout + DO_RKVP); const bf16_t* l2 = (const bf16_t*)(c.ws + WS_L2O);
    bf16_t* yo = (bf16_t*)(c.ws + WS_YRW) + (size_t)dir * MP * 256;
    const bool producer = wave >= 4;
    const int pt = tid - 256, pstep = pt >> 3, pc0 = (pt & 7) * 8, pv0 = 2 * (pt & 7);
    float ka[8];
    u32x4 R, K, KK, DL, AS; unsigned V2 = 0; R = K = KK = DL = AS = (u32x4){0u, 0u, 0u, 0u};
    if (producer) {
#pragma unroll
        for (int e = 0; e < 8; ++e) ka[e] = c.in[I_KA][(size_t)l * 256 + head * 64 + pc0 + e];
    }
    auto tok = [&](int s) -> size_t { const int t = dir ? LEN - 1 - s : s; return (size_t)row_of(b, t); };
#define RW_LOAD(chunk) do { const int s_ = (chunk) * RW_T + pstep; if (s_ < LEN) { const size_t m_ = tok(s_); const bf16_t* rp_ = rk + m_ * 1024 + head * 64; const bf16_t* lp_ = l2 + m_ * 1280 + dir * 256 + head * 64; \
        R = *(const u32x4*)(rp_ + pc0); K = *(const u32x4*)(rp_ + 256 + pc0); KK = *(const u32x4*)(rp_ + 768 + pc0); V2 = *(const unsigned*)(rp_ + 512 + 16 * q + pv0); \
        DL = *(const u32x4*)(lp_ + pc0); AS = *(const u32x4*)(lp_ + 512 + pc0); } } while (0)
#define RW_WRITE(buf) do { LAS float* vec_ = (LAS float*)(c.lds + (buf) * RW_BUF); float r_[8], k_[8], kk_[8], dl_[8], as_[8]; unpack8(R, r_); unpack8(K, k_); unpack8(KK, kk_); unpack8(DL, dl_); unpack8(AS, as_); \
        float w_[8], a_[8], b_[8], kd_[8]; _Pragma("unroll") for (int e = 0; e < 8; ++e) { w_[e] = __expf(dl_[e]); a_[e] = -kk_[e]; b_[e] = kk_[e] * as_[e]; kd_[e] = k_[e] * (1.f + (as_[e] - 1.f) * ka[e]); } \
        LAS float* bp_ = vec_ + pstep * 320 + pc0; \
        *(LAS f32x4*)(bp_) = (f32x4){w_[0], w_[1], w_[2], w_[3]}; *(LAS f32x4*)(bp_ + 4) = (f32x4){w_[4], w_[5], w_[6], w_[7]}; \
        *(LAS f32x4*)(bp_ + 64) = (f32x4){a_[0], a_[1], a_[2], a_[3]}; *(LAS f32x4*)(bp_ + 68) = (f32x4){a_[4], a_[5], a_[6], a_[7]}; \
        *(LAS f32x4*)(bp_ + 128) = (f32x4){b_[0], b_[1], b_[2], b_[3]}; *(LAS f32x4*)(bp_ + 132) = (f32x4){b_[4], b_[5], b_[6], b_[7]}; \
        *(LAS f32x4*)(bp_ + 192) = (f32x4){kd_[0], kd_[1], kd_[2], kd_[3]}; *(LAS f32x4*)(bp_ + 196) = (f32x4){kd_[4], kd_[5], kd_[6], kd_[7]}; \
        *(LAS f32x4*)(bp_ + 256) = (f32x4){r_[0], r_[1], r_[2], r_[3]}; *(LAS f32x4*)(bp_ + 260) = (f32x4){r_[4], r_[5], r_[6], r_[7]}; \
        LAS float* vr_ = vec_ + 10240 + pstep * 16 + pv0; vr_[0] = bflo(V2); vr_[1] = bfhi(V2); } while (0)
#define RW_FLUSH(chunk) do { const int s_ = (chunk) * RW_T + pstep; if (s_ < LEN) { const LAS float* yy_ = (const LAS float*)(c.lds + ((chunk) & 1) * RW_BUF) + 10752 + pstep * 16 + pv0; \
        *(unsigned*)(yo + tok(s_) * 256 + head * 64 + 16 * q + pv0) = pk2(yy_[0], yy_[1]); } } while (0)
    if (producer) { RW_LOAD(0); RW_WRITE(0); RW_LOAD(1); }
    __syncthreads();
    const int rowl = (wave & 3) * 4 + (lane >> 4), j4 = (lane & 15) * 4;
    float S0 = 0.f, S1 = 0.f, S2 = 0.f, S3 = 0.f;
#define RW_SCAN(NS) do { float yv_[NS]; \
        _Pragma("unroll") for (int st = 0; st < NS; ++st) { \
            const LAS float* bp = vec + st * 320 + j4; \
            const f32x4 w = *(const LAS f32x4*)(bp), a = *(const LAS f32x4*)(bp + 64), bb = *(const LAS f32x4*)(bp + 128), kd = *(const LAS f32x4*)(bp + 192), r = *(const LAS f32x4*)(bp + 256); \
            const float v = vec[10240 + st * 16 + rowl]; \
            float sa = (S0 * a.x + S1 * a.y) + (S2 * a.z + S3 * a.w); \
            sa = allred16(sa); \
            S0 = S0 * w.x + v * kd.x; S1 = S1 * w.y + v * kd.y; S2 = S2 * w.z + v * kd.z; S3 = S3 * w.w + v * kd.w; \
            S0 += sa * bb.x; S1 += sa * bb.y; S2 += sa * bb.z; S3 += sa * bb.w; \
            float y = (S0 * r.x + S1 * r.y) + (S2 * r.z + S3 * r.w); \
            yv_[st] = allred16(y); } \
        if ((lane & 15) == 0) { _Pragma("unroll") for (int st = 0; st < NS; ++st) yy[st * 16 + rowl] = yv_[st]; } } while (0)
    for (int ch = 0; ch < RW_NC; ++ch) {
        if (!producer) {
            const LAS float* vec = (const LAS float*)(c.lds + (ch & 1) * RW_BUF);
            LAS float* yy = (LAS float*)(c.lds + (ch & 1) * RW_BUF) + 10752;
            if (ch < RW_NC - 1) RW_SCAN(32); else RW_SCAN(LEN - (RW_NC - 1) * RW_T);
        } else {
            if (ch + 1 < RW_NC) RW_WRITE((ch + 1) & 1);
            if (ch + 2 < RW_NC) RW_LOAD(ch + 2);
            if (ch >= 1) RW_FLUSH(ch - 1);
        }
        __syncthreads();
    }
#undef RW_SCAN
    if (producer) RW_FLUSH(RW_NC - 1);
    __syncthreads();
#undef RW_LOAD
#undef RW_WRITE
#undef RW_FLUSH
}

__device__ __forceinline__ void rwkv_post(const Ctx& cx_, int l) {
    const Ctx c = relaunder(cx_);
    const int gw = c.bid * NWAVES + c.wave, NGW = c.G * NWAVES, lane = c.lane, c0 = 4 * lane;
    const bf16_t* __restrict__ y0 = (const bf16_t*)(c.ws + WS_YRW); const bf16_t* __restrict__ y1 = y0 + (size_t)MP * 256;
    const bf16_t* __restrict__ rk = (const bf16_t*)(c.dout + DO_RKVP); const bf16_t* __restrict__ l2 = (const bf16_t*)(c.ws + WS_L2O); bf16_t* __restrict__ yc = (bf16_t*)(c.ws + WS_YC);
    float lw[4], lb[4], rkw[4];
#pragma unroll
    for (int e = 0; e < 4; ++e) { lw[e] = c.in[I_LNW][(size_t)l * 256 + c0 + e]; lb[e] = c.in[I_LNB][(size_t)l * 256 + c0 + e]; rkw[e] = c.in[I_RK][(size_t)l * 256 + c0 + e]; }
#pragma unroll 2
    for (int m = gw; m < M_ROWS; m += NGW) {
        const u32x2 a = *(const u32x2*)(y0 + (size_t)m * 256 + c0), bq = *(const u32x2*)(y1 + (size_t)m * 256 + c0);
        const u32x2 rr = *(const u32x2*)(rk + (size_t)m * 1024 + c0), kk = *(const u32x2*)(rk + (size_t)m * 1024 + 256 + c0), vv = *(const u32x2*)(rk + (size_t)m * 1024 + 512 + c0);
        const u32x2 gg = *(const u32x2*)(l2 + (size_t)m * 1280 + 1024 + c0);
        float y[4] = {bflo(a.x) + bflo(bq.x), bfhi(a.x) + bfhi(bq.x), bflo(a.y) + bflo(bq.y), bfhi(a.y) + bfhi(bq.y)};
        const float r[4] = {bflo(rr.x), bfhi(rr.x), bflo(rr.y), bfhi(rr.y)}, k[4] = {bflo(kk.x), bfhi(kk.x), bflo(kk.y), bfhi(kk.y)};
        const float v[4] = {bflo(vv.x), bfhi(vv.x), bflo(vv.y), bfhi(vv.y)}, g[4] = {bflo(gg.x), bfhi(gg.x), bflo(gg.y), bfhi(gg.y)};
        const float mean = sum16((y[0] + y[1]) + (y[2] + y[3])) * (1.f / 64.f);
        float q = 0.f, bo = 0.f;
#pragma unroll
        for (int e = 0; e < 4; ++e) { y[e] -= mean; q += y[e] * y[e]; bo += r[e] * k[e] * rkw[e]; }
        q = sum16(q) * (1.f / 64.f); bo = sum16(bo);
        const float rs = __builtin_amdgcn_rsqf(q + 64e-5f);
        float o[4];
#pragma unroll
        for (int e = 0; e < 4; ++e) o[e] = (y[e] * rs * lw[e] + lb[e] + bo * v[e]) * g[e];
        *(u32x2*)(yc + (size_t)m * 256 + c0) = (u32x2){pk2(o[0], o[1]), pk2(o[2], o[3])};
    }
}
__device__ __forceinline__ void final_phase(const Ctx& cx_, float* out) {
    const Ctx c = relaunder(cx_);
    const int gw = c.bid * NWAVES + c.wave, NGW = c.G * NWAVES, lane = c.lane;
    const bf16_t* H = c.H(); const f32x4* fw = (const f32x4*)c.in[I_FNW];
#pragma unroll 2
    for (int r = gw; r < BATCH * SEQ; r += NGW) {
        const size_t m = (size_t)r;
        const u32x2* hp = (const u32x2*)(H + m * DM);
        float v[4][4], ss = 0.f;
#pragma unroll
        for (int i = 0; i < 4; ++i) { const u32x2 w = hp[lane + 64 * i]; v[i][0] = bflo(w.x); v[i][1] = bfhi(w.x); v[i][2] = bflo(w.y); v[i][3] = bfhi(w.y); ss += (v[i][0] * v[i][0] + v[i][1] * v[i][1]) + (v[i][2] * v[i][2] + v[i][3] * v[i][3]); }
        ss = wave_sum(ss); const float s = __builtin_amdgcn_rsqf(ss * (1.0f / DM) + EPS);
        f32x4* op = (f32x4*)(out + (size_t)r * DM);
#pragma unroll
        for (int i = 0; i < 4; ++i) { const f32x4 w = fw[lane + 64 * i]; op[lane + 64 * i] = (f32x4){v[i][0] * s * w.x, v[i][1] * s * w.y, v[i][2] * s * w.z, v[i][3] * s * w.w}; }
    }
}

constexpr int LDS_BYTES = 147456;
#ifndef MIXDIR
#define MIXDIR 0
#define MIXLAYER 0
#endif
#ifndef PHMASK
#define PHMASK 0xFFFFF
#endif
__global__ void __launch_bounds__(NTHREADS, 2) mega_fwd(Params p) {
    extern __shared__ __attribute__((aligned(16))) unsigned char lds_raw[];
    cg::grid_group grid = cg::this_grid();
    Ctx c0_; c0_.in = p.in; c0_.ws = p.ws; c0_.dout = (unsigned char*)p.out; c0_.lds = (LAS unsigned char*)lds_raw;
    c0_.wave = __builtin_amdgcn_readfirstlane((int)threadIdx.x >> 6); c0_.tid = opaque_tid(c0_.wave); c0_.lane = c0_.tid & 63; c0_.G = gridDim.x; c0_.bid = blockIdx.x;
    Ctx c = c0_;
    const int G = c.G, bid = c.bid;
#ifdef PROF_A
#ifndef PROF_SHIFT
#define PROF_SHIFT 1.0f
#endif
#define PROF_PTR ((unsigned long long*)(c.ws + WS_DEC + (size_t)MP * 64))
    if (blockIdx.x == 0 && threadIdx.x == 0) { for (int k = 0; k < 15; ++k) PROF_PTR[k] = 0; PROF_PTR[15] = __builtin_amdgcn_s_memrealtime(); }
#define STAMP(k) do { if (blockIdx.x == 0 && threadIdx.x == 0) { const unsigned long long t_ = __builtin_amdgcn_s_memrealtime(); PROF_PTR[k] += t_ - PROF_PTR[15]; PROF_PTR[15] = t_; } } while (0)
#else
#define STAMP(k) do { } while (0)
#endif
    unsigned* barw = (unsigned*)(c.ws + WS_BAR);
    volatile LAS unsigned* bst = (volatile LAS unsigned*)(c.lds + LDS_BYTES - 64);
    if (bid == 0) for (int i = threadIdx.x; i < XCD_BAR_WORDS + 1024; i += NTHREADS) barw[i < XCD_BAR_WORDS ? i : 4096 + (i - XCD_BAR_WORDS)] = 0u;
    if (threadIdx.x < 2) bst[threadIdx.x] = 0u;
    __syncthreads();
    if (PHMASK & 1) phase0(c);
    grid.sync(); STAMP(0);
    const XcdBarrier xbar = xcd_barrier_post(barw, bst);
#define GRID_BAR() do { xcd_barrier(xbar, c0_.wave); c = relaunder(c0_); } while (0)
#pragma unroll 1
    for (int l = 0; l < DEPTH; ++l) {
#define wb (c.wb(l))
        if (PHMASK & 2) dt_job(c, l);
        if (PHMASK & 4) { SchedPlain S{c.H(), wb + WB_IN, DM, DM, DM, MP / 256, 11, G, bid, 0};
          EpiInProj E{c.ssq(), (bf16_t*)(c.ws + WS_UH), (bf16_t*)(c.ws + WS_PZ), (bf16_t*)(c.ws + WS_PXBC), (bf16_t*)(c.ws + WS_PRKVX)};
          pg8::gemm_phase(c.lds, c.wave, S, E); }
        GRID_BAR(); STAMP(1);
        if (PHMASK & 8) { SchedS5 S{(const bf16_t*)(c.ws + WS_UH), wb + WB_SX, 256, G, bid}; EpiS5X E{(float*)(c.ws + WS_X)}; pg8::gemm_phase(c.lds, c.wave, S, E); }
        if (PHMASK & 16) rwkv_prep(c, l);
        if (PHMASK & 32) ssd_prep(c, l);
        GRID_BAR(); STAMP(2);
        if (PHMASK & 64) s5_scan(c, l);
        if (PHMASK & 4096) ssd_states(c, l);
        if (PHMASK & 128) { SchedPlain S{(const bf16_t*)(c.ws + WS_L1IN), wb + WB_L1, 512, 512, 512, MP / 256, 2, G, bid, 0}; EpiL1 E{(bf16_t*)(c.ws + WS_L1O)}; pg8::gemm_phase(c.lds, c.wave, S, E); }
        GRID_BAR(); STAMP(3);
        ssd_chunk_scan(c, l);
        if (PHMASK & 256) { SchedL2 S{(const bf16_t*)(c.ws + WS_L1O), wb + WB_L2, G, bid, MP / 256, 0}; EpiL2 E{(bf16_t*)(c.ws + WS_L2O), c.in[I_W0] + (size_t)l * 512, c.in[I_A0] + (size_t)l * 512}; pg8::gemm_phase(c.lds, c.wave, S, E); }
        if (PHMASK & 512) { SchedS5 S{(const bf16_t*)(c.ws + WS_UH), wb + WB_SY, 512, G, bid}; EpiS5Y E{(bf16_t*)(c.ws + WS_YAPRE)}; pg8::gemm_phase(c.lds, c.wave, S, E); }
        GRID_BAR(); STAMP(4);
        if (bid < 64) { if (PHMASK & 1024) rwkv_chunked64(c, l); }
        else { if (PHMASK & 2048) ssd_outputs(c, l, 64, G - 64);
  if (PHMASK & 16384) { SchedPlain S{(const bf16_t*)(c.ws + WS_YAPRE), wb + WB_GLU, 256, 256, 256, MP / 256, 2, G - 64, bid - 64, 0}; EpiGLU E{(bf16_t*)(c.ws + WS_YA), c.in[I_GLUB] + (size_t)l * 512}; pg8::gemm_phase(c.lds, c.wave, S, E); } }
        STAMP(5);
        GRID_BAR(); STAMP(6);
#ifdef RWKV_DBG
        if (l == 0) { unsigned* dbg = (unsigned*)(c.ws + WS_BAR + 16384); const bf16_t* y0_ = (const bf16_t*)(c.ws + WS_YRW); const bf16_t* y1_ = (const bf16_t*)(c.ws + WS_MIX + 33 * QB / 2);
          float s0 = 0.f, d0 = 0.f, s1 = 0.f, d1 = 0.f; const bf16_t* y0b_ = y0_ + (size_t)MP * 256; const bf16_t* y1b_ = (const bf16_t*)(c.ws + WS_MIX + 47 * QB / 2);
          for (size_t i = (size_t)bid * NTHREADS + threadIdx.x; i < (size_t)M_ROWS * 256; i += (size_t)G * NTHREADS) { const float a = bf1(y0_[i]), b2 = bf1(y1_[i]), a1 = bf1(y0b_[i]), b1 = bf1(y1b_[i]);
            s0 += a * a; d0 += (a - b2) * (a - b2); s1 += a1 * a1; d1 += (a1 - b1) * (a1 - b1); }
          s0 = wave_sum(s0); d0 = wave_sum(d0); s1 = wave_sum(s1); d1 = wave_sum(d1);
          if ((threadIdx.x & 63) == 0) { atomicAdd((float*)dbg + 0, s0); atomicAdd((float*)dbg + 1, d0); atomicAdd((float*)dbg + 2, s1); atomicAdd((float*)dbg + 3, d1); } }
#endif
        if (PHMASK & 8192) rwkv_post(c, l);
        GRID_BAR(); STAMP(7);
        if (PHMASK & 32768) { SchedProj S{c.H(), wb + WB_G, wb + WB_P, (const bf16_t*)(c.ws + WS_YA), (const bf16_t*)(c.ws + WS_YB), (const bf16_t*)(c.ws + WS_YC), (l < DEPTH - 1 ? MP / 256 : BATCH * SEQ / 256), G, bid, 0};
          EpiProj E{c.ssq(), (const float*)(c.ws + WS_SSQB), c.ws + WS_PARK + (size_t)bid * 393216, (bf16_t*)(c.dout + DO_MERGED), opaque_tid(c.wave)}; pg8::gemm_phase(c.lds, c.wave, S, E); }
        GRID_BAR(); STAMP(8);
        if (PHMASK & 65536) { SchedPlain S{(const bf16_t*)(c.dout + DO_MERGED), wb + WB_O, DM, DM, DM, (l < DEPTH - 1 ? MP / 256 : BATCH * SEQ / 256), 4, G, bid, 0}; EpiResid E{c.H(), c.ssq()}; pg8::gemm_phase(c.lds, c.wave, S, E); }
        GRID_BAR(); STAMP(9);
        if (PHMASK & 131072) { SchedPlain S{c.H(), wb + WB_1, DM, DM, DM, (l < DEPTH - 1 ? MP / 256 : BATCH * SEQ / 256), 16, G, bid, 0}; EpiUp E{c.ssq(), (bf16_t*)(c.ws + WS_ACT)}; pg8::gemm_phase(c.lds, c.wave, S, E); }
        GRID_BAR(); STAMP(10);
        if (PHMASK & 262144) { SchedPlain S{(const bf16_t*)(c.ws + WS_ACT), wb + WB_2, DFF, DFF, DFF, (l < DEPTH - 1 ? MP / 256 : BATCH * SEQ / 256), 4, G, bid, 0}; EpiResid E{c.H(), c.ssq()}; pg8::gemm_phase(c.lds, c.wave, S, E); }
        GRID_BAR(); STAMP(11);
    }
    if (PHMASK & 524288) final_phase(c, p.out);
#ifdef RWKV_DBG
    GRID_BAR();
    if (blockIdx.x == 0) { const unsigned* dbg = (const unsigned*)(c.ws + WS_BAR + 16384); const float s0 = __uint_as_float(__hip_atomic_load(dbg + 0, __ATOMIC_RELAXED, __HIP_MEMORY_SCOPE_AGENT)), d0 = __uint_as_float(__hip_atomic_load(dbg + 1, __ATOMIC_RELAXED, __HIP_MEMORY_SCOPE_AGENT)), s1 = __uint_as_float(__hip_atomic_load(dbg + 2, __ATOMIC_RELAXED, __HIP_MEMORY_SCOPE_AGENT)), d1 = __uint_as_float(__hip_atomic_load(dbg + 3, __ATOMIC_RELAXED, __HIP_MEMORY_SCOPE_AGENT));
        float va = 100.f + 10000.f * sqrtf(d1 / s1), vb = 100.f + 10000.f * sqrtf(d0 / s0);
        va = rintf(va * 0.1f) * 10.f; vb = rintf(vb * 0.1f) * 10.f;
        for (int i = threadIdx.x; i < (1 << 20); i += NTHREADS) p.out[1 + i] = vb;
        if (threadIdx.x == 0) p.out[0] = 100.f * va; }
#endif
#ifdef PROF_A
    GRID_BAR(); STAMP(12);
    if (blockIdx.x == 0) {
        __syncthreads();
        float va = (float)(__hip_atomic_load(&PROF_PTR[PROF_A], __ATOMIC_RELAXED, __HIP_MEMORY_SCOPE_AGENT)) * 0.01f, vb = (float)(__hip_atomic_load(&PROF_PTR[PROF_B], __ATOMIC_RELAXED, __HIP_MEMORY_SCOPE_AGENT)) * 0.01f;
        va = exp2f(rintf(log2f(va * PROF_SHIFT) * 2.f) * 0.5f); vb = exp2f(rintf(log2f(vb * PROF_SHIFT) * 2.f) * 0.5f);
        for (int i = threadIdx.x; i < (1 << 20); i += NTHREADS) p.out[1 + i] = vb;
        if (threadIdx.x == 0) p.out[0] = 100.f * va;
    }
#endif
}

extern "C" void kernel_launch(void* const* d_in, const int* in_sizes, int n_in, void* d_out, int out_size, void* d_ws, size_t ws_size, hipStream_t stream) {
    static int grid = 0;
    if (grid == 0) {
        int dev = 0, cus = 0, per_cu = 0;
        if (n_in != N_INPUTS || out_size != BATCH * SEQ * DM || ws_size < WS_END) { fprintf(stderr, "kernel_launch: unexpected shapes (n_in %d out %d ws %zu)\n", n_in, out_size, ws_size); grid = -1; return; }
        (void)hipGetDevice(&dev); (void)hipDeviceGetAttribute(&cus, hipDeviceAttributeMultiprocessorCount, dev);
        (void)hipFuncSetAttribute((const void*)mega_fwd, hipFuncAttributeMaxDynamicSharedMemorySize, LDS_BYTES);
        (void)hipOccupancyMaxActiveBlocksPerMultiprocessor(&per_cu, (const void*)mega_fwd, NTHREADS, LDS_BYTES);
        if (per_cu < 1) { fprintf(stderr, "kernel_launch: occupancy query says %d blocks per CU\n", per_cu); per_cu = 1; }
        grid = cus * 1;
        if (grid != 256) fprintf(stderr, "kernel_launch: %d CUs (the scan phases are laid out for 256 workgroups)\n", grid);
    }
    if (grid < 0) return;
    Params p{};
    for (int i = 0; i < N_INPUTS; ++i) p.in[i] = (const float*)d_in[i];
    p.out = (float*)d_out; p.ws = (unsigned char*)d_ws; p.ph_lo = 0; p.ph_hi = 0;
    void* args[] = {&p};
    hipError_t e = hipLaunchCooperativeKernel((const void*)mega_fwd, dim3(grid), dim3(NTHREADS), args, LDS_BYTES, stream);
    if (e != hipSuccess) fprintf(stderr, "cooperative launch failed: %s (grid %d)\n", hipGetErrorString(e), grid);
}
```

```cpp
#include <hip/hip_runtime.h>
#include <hip/hip_cooperative_groups.h>
#include <cstdio>
#include <cstdint>
namespace cg = cooperative_groups;

#define LAS __attribute__((address_space(3)))
typedef unsigned short bf16_t;
typedef short bf16x8 __attribute__((ext_vector_type(8)));
typedef float f32x4 __attribute__((ext_vector_type(4)));
typedef unsigned u32x4 __attribute__((ext_vector_type(4)));
typedef unsigned u32x2 __attribute__((ext_vector_type(2)));

constexpr int BATCH = 8, SEQ = 4096, NMETA = 16, LEN = SEQ + NMETA, DM = 1024, DFF = 4096, DEPTH = 2;
constexpr int M_ROWS = BATCH * LEN;
constexpr int MP = 33024;
constexpr int N_IN = 5896;
constexpr int NCH16 = LEN / 16;
constexpr int S5ROWS = BATCH * NCH16;
constexpr int S5RP = 2304;
constexpr float EPS = 1e-6f;
constexpr int NTHREADS = 512, NWAVES = 8;

constexpr size_t QB = (size_t)MP * 256 * 2;
constexpr size_t WB_IN = 0;
constexpr size_t WB_G = WB_IN + (size_t)2816 * 1024;
constexpr size_t WB_P = WB_G + (size_t)3072 * 1024;
constexpr size_t WB_O = WB_P + (size_t)1024 * 1024;
constexpr size_t WB_1 = WB_O + (size_t)1024 * 1024;
constexpr size_t WB_2 = WB_1 + (size_t)4096 * 1024;
constexpr size_t WB_GLU = WB_2 + (size_t)1024 * 4096;
constexpr size_t WB_L1 = WB_GLU + (size_t)512 * 256;
constexpr size_t WB_L2 = WB_L1 + (size_t)512 * 512;
constexpr size_t WB_SX = WB_L2 + (size_t)1280 * 256;
constexpr size_t WB_SY = WB_SX + (size_t)16 * 256 * 256;
constexpr size_t WB_ELEMS = WB_SY + (size_t)16 * 256 * 512;
constexpr size_t WB_BYTES = WB_ELEMS * 2;
static_assert(WB_BYTES <= 5 * QB / 2, "weight block fits 2.5 Q");

constexpr size_t WS_H = 0;
constexpr size_t WS_WB0 = 4 * QB;
constexpr size_t WS_SMALL = 13 * QB / 2;
constexpr size_t WS_SSQ = WS_SMALL;
constexpr size_t WS_DT = WS_SSQ + (size_t)MP * 16 * 4;
constexpr size_t WS_DEC = WS_DT + (size_t)MP * 16 * 4;
static_assert(WS_DEC + (size_t)MP * 16 * 4 <= 7 * QB, "small region");
constexpr size_t WS_MIX = 7 * QB;
constexpr size_t WS_PXBC = WS_MIX;
constexpr size_t WS_YSSD = WS_MIX;
constexpr size_t WS_PARK = WS_MIX;
constexpr size_t WS_ACT = WS_MIX;
constexpr size_t WS_PRKVX = WS_MIX + 4 * QB;
constexpr size_t WS_L2O = WS_MIX + 4 * QB;
constexpr size_t WS_PZ = WS_MIX + 9 * QB;
constexpr size_t WS_UH = WS_MIX + 11 * QB;
constexpr size_t WS_X = WS_MIX + 53 * QB / 4;
constexpr size_t WS_YRW = WS_X;
constexpr size_t WS_L1IN = WS_MIX + 31 * QB / 2;
constexpr size_t WS_YAPRE = WS_L1IN;
constexpr size_t WS_L1O = WS_MIX + 35 * QB / 2;
constexpr size_t WS_YB = WS_L1O;
constexpr size_t WS_BC = WS_MIX + 39 * QB / 2;
constexpr size_t WS_YA = WS_MIX + 33 * QB / 2;
constexpr size_t WS_YC = WS_BC + QB;
constexpr size_t WS_XS = WS_MIX + 43 * QB / 2;
constexpr size_t WS_END = WS_XS + 2 * QB;
static_assert(WS_END <= (size_t)512 << 20, "workspace map fits 512 MiB");
static_assert((size_t)16 * S5RP * 512 * 2 <= 9 * QB / 4 && (size_t)16 * S5RP * 256 * 4 <= 9 * QB / 4, "S5 buffers fit their slots");

constexpr size_t DO_RKVP = 0;
constexpr size_t DO_MERGED = 0;
constexpr size_t DO_WB1 = 4 * QB;
static_assert(DO_WB1 + WB_BYTES <= (size_t)BATCH * SEQ * DM * 4, "d_out scratch map");

__device__ __forceinline__ unsigned f2bf(float f) { unsigned u = __builtin_bit_cast(unsigned, f); return (u + 0x7fffu + ((u >> 16) & 1u)) >> 16; }
typedef float f32x2_t_ __attribute__((ext_vector_type(2))); typedef __bf16 bf16x2_t_ __attribute__((ext_vector_type(2)));
__device__ __forceinline__ unsigned pk2(float lo, float hi) { const f32x2_t_ v = {lo, hi}; const bf16x2_t_ b = __builtin_convertvector(v, bf16x2_t_); return __builtin_bit_cast(unsigned, b); }
__device__ __forceinline__ float bflo(unsigned w) { return __builtin_bit_cast(float, w << 16); }
__device__ __forceinline__ float bfhi(unsigned w) { return __builtin_bit_cast(float, w & 0xffff0000u); }
__device__ __forceinline__ float bf1(bf16_t v) { return __builtin_bit_cast(float, (unsigned)v << 16); }
__device__ __forceinline__ float sigmoidf_(float x) { return 1.0f / (1.0f + __expf(-x)); }
__device__ __forceinline__ float siluf_(float x) { return x / (1.0f + __expf(-x)); }
__device__ __forceinline__ float tanhf_(float x) { x = fminf(fmaxf(x, -15.f), 15.f); const float t = __expf(2.f * x); return (t - 1.f) / (t + 1.f); }
__device__ __forceinline__ float softplusf_(float x) { return fmaxf(x, 0.f) + __logf(1.0f + __expf(-fabsf(x))); }
__device__ __forceinline__ float geluf_(float x) { const float u = 0.7978845608028654f * (x + 0.044715f * x * x * x); return 0.5f * x * (1.f + tanhf_(u)); }
__device__ __forceinline__ float wave_sum(float v) {
#pragma unroll
    for (int o = 1; o < 64; o <<= 1) v += __shfl_xor(v, o);
    return v;
}
__device__ __forceinline__ float sum16(float v) {
#pragma unroll
    for (int o = 1; o < 16; o <<= 1) v += __shfl_xor(v, o);
    return v;
}
template <int CTRL> __device__ __forceinline__ float dpp_mov(float x) {
    return __builtin_bit_cast(float, __builtin_amdgcn_update_dpp(0, __builtin_bit_cast(int, x), CTRL, 0xf, 0xf, true));
}
__device__ __forceinline__ float allred16(float x) {
    x += dpp_mov<0xB1>(x); x += dpp_mov<0x4E>(x); x += dpp_mov<0x141>(x); x += dpp_mov<0x140>(x); return x;
}
__device__ __forceinline__ void unpack8(const u32x4 w, float (&f)[8]) {
    f[0] = bflo(w.x); f[1] = bfhi(w.x); f[2] = bflo(w.y); f[3] = bfhi(w.y); f[4] = bflo(w.z); f[5] = bfhi(w.z); f[6] = bflo(w.w); f[7] = bfhi(w.w);
}
__device__ __forceinline__ u32x4 pack8(const float (&f)[8]) { u32x4 w; w.x = pk2(f[0], f[1]); w.y = pk2(f[2], f[3]); w.z = pk2(f[4], f[5]); w.w = pk2(f[6], f[7]); return w; }
__device__ __forceinline__ int opaque_tid(int) { int t = threadIdx.x; asm volatile("" : "+v"(t)); return t; }
__device__ __forceinline__ int row_of(int b, int t) { return t < NMETA ? BATCH * SEQ + b * NMETA + t : b * SEQ + (t - NMETA); }
__device__ __forceinline__ void bt_of(int m, int& b, int& t) { if (m < BATCH * SEQ) { b = m >> 12; t = NMETA + (m & (SEQ - 1)); } else { const int q = m - BATCH * SEQ; b = q >> 4; t = q & (NMETA - 1); } }
namespace pg8 {
constexpr int BM = 256, BK = 64, HALF = 128, HTB = HALF * BK * 2  , STAGE_BYTES = 8 * HTB;
__host__ __device__ __forceinline__ int lds_byte(int r, int c) { const int st = (r >> 4) * 2 + (c >> 5), rr = r & 15, cc = c & 31, ob = rr * 64 + cc * 2; return st * 1024 + (ob ^ (((ob >> 9) & 1) << 5)); }
__host__ __device__ __forceinline__ void stage_rc(int b, int& R, int& C) { const int st = b / 1024, sb = b % 1024, swz = sb ^ (((sb >> 9) & 1) << 5); R = (st >> 1) * 16 + swz / 64; C = (st & 1) * 32 + (swz % 64) / 2; }
__host__ __device__ __forceinline__ int perm32(int rho) { const int n = rho >> 4, i = rho & 15; return 8 * (i >> 2) + 4 * n + (i & 3); }

struct GU {
    const bf16_t* A;
    const bf16_t* B;
    int lda, ldb, nt;
    int pm, pn, kind;
};

template <bool SKIP_HI = false, class Epi, class Sched>
__device__ __forceinline__ void gemm_phase(LAS unsigned char* lds, int wave_s, const Sched& S, const Epi& E) {
    const int tid = opaque_tid(wave_s), wid = wave_s, lane = tid & 63, wr = wid >> 2, wc = wid & 3, fr = lane & 15, fq = lane >> 4;
#define PG8_VOFF(lda_, ldb_, a0, b0) do { int R0_, C0_; stage_rc(tid * 16, R0_, C0_); \
        a0 = (unsigned)(R0_ * (lda_) + C0_) * 2u; b0 = (unsigned)(((R0_ & ~31) + perm32(R0_ & 31)) * (ldb_) + C0_) * 2u; } while (0)
    const size_t kstep = (size_t)(BK * 2);
    const unsigned ldsw = (unsigned)wid * 1024u;
    const int aoff = lds_byte(wr * 64 + fr, fq * 8), boff = lds_byte(wc * 32 + fr, fq * 8);
#define PG8_SA(b, h) (((b) * 2 + (h)) * HTB)
#define PG8_SB(b, h) ((4 + (b) * 2 + (h)) * HTB)
#define PG8_STAGE(bufoff, gbase, v0, hs) do { \
        __builtin_amdgcn_global_load_lds((const unsigned*)((const char*)(gbase) + (v0)), (LAS unsigned*)(lds + (bufoff) + ldsw), 16, 0, 0); \
        __builtin_amdgcn_global_load_lds((const unsigned*)((const char*)(gbase) + ((hs) >> 1) + (v0)), (LAS unsigned*)(lds + (bufoff) + ldsw + 8192), 16, 0, 0); } while (0)
#define PG8_LDA(dst, b, h) do { _Pragma("unroll") for (int m = 0; m < 4; ++m) _Pragma("unroll") for (int k = 0; k < 2; ++k) dst[m][k] = *(const LAS bf16x8*)(lds + PG8_SA(b, h) + aoff + m * 2048 + k * 1024); } while (0)
#define PG8_LDB(dst, b, h) do { _Pragma("unroll") for (int n = 0; n < 2; ++n) _Pragma("unroll") for (int k = 0; k < 2; ++k) dst[n][k] = *(const LAS bf16x8*)(lds + PG8_SB(b, h) + boff + n * 2048 + k * 1024); } while (0)
#define PG8_MMA(ai, bj, At, Bt) do { __builtin_amdgcn_s_setprio(1); _Pragma("unroll") for (int m = 0; m < 4; ++m) _Pragma("unroll") for (int n = 0; n < 2; ++n) _Pragma("unroll") for (int k = 0; k < 2; ++k) \
        acc[ai][bj][m][n] = __builtin_amdgcn_mfma_f32_16x16x32_bf16(Bt[n][k], At[m][k], acc[ai][bj][m][n], 0, 0, 0); __builtin_amdgcn_s_setprio(0); } while (0)
#define PG8_WAIT_V(n) asm volatile("s_waitcnt vmcnt(" #n ")" ::: "memory")
#define PG8_WAIT_L(n) asm volatile("s_waitcnt lgkmcnt(" #n ")" ::: "memory")
#define PG8_BAR __builtin_amdgcn_s_barrier()
#define PG8_SCHED __builtin_amdgcn_sched_barrier(0)
    GU cur, nxt; int ui = 0;
    if (!S.next(0, cur)) return;
    f32x4 acc[2][2][4][2];
#pragma unroll
    for (int a = 0; a < 2; ++a)
#pragma unroll
        for (int b = 0; b < 2; ++b)
#pragma unroll
            for (int m = 0; m < 4; ++m)
#pragma unroll
                for (int n = 0; n < 2; ++n) acc[a][b][m][n] = (f32x4){0.f, 0.f, 0.f, 0.f};
    bf16x8 At[4][2], B0[2][2], B1[2][2];
    const char* cA = (const char*)cur.A; const char* cB = (const char*)cur.B;
    unsigned vA0, vB0; PG8_VOFF(cur.lda, cur.ldb, vA0, vB0);
    size_t hsA = (size_t)HALF * cur.lda * 2, hsB = (size_t)HALF * cur.ldb * 2;
    int nt = cur.nt; asm volatile("" : "+s"(nt));
    PG8_STAGE(PG8_SB(0, 0), cB, vB0, hsB); PG8_STAGE(PG8_SB(0, 1), cB + hsB, vB0, hsB); PG8_STAGE(PG8_SA(0, 0), cA, vA0, hsA); PG8_STAGE(PG8_SA(0, 1), cA + hsA, vA0, hsA);
    if (wr == 1) PG8_BAR;
    PG8_WAIT_V(2); PG8_BAR;
    PG8_STAGE(PG8_SB(1, 0), cB + kstep, vB0, hsB); PG8_STAGE(PG8_SA(1, 0), cA + kstep, vA0, hsA); PG8_STAGE(PG8_SB(1, 1), cB + hsB + kstep, vB0, hsB);
    PG8_WAIT_V(6); PG8_BAR;
    for (;;) {
        const bool has_next = S.next(ui + 1, nxt);
        const char* nA = has_next ? (const char*)nxt.A : cA; const char* nB = has_next ? (const char*)nxt.B : cB;
        unsigned nvA0 = vA0, nvB0 = vB0;
        if (has_next) PG8_VOFF(nxt.lda, nxt.ldb, nvA0, nvB0);
        const size_t nhsA = has_next ? (size_t)HALF * nxt.lda * 2 : hsA, nhsB = has_next ? (size_t)HALF * nxt.ldb * 2 : hsB;
        for (int t = 0; t < nt; t += 2) {
            const bool last = (t == nt - 2);
            const char* a1 = cA + (size_t)(t + 1) * kstep;
            const char* a2 = last ? nA : cA + (size_t)(t + 2) * kstep; const char* b2 = last ? nB : cB + (size_t)(t + 2) * kstep;
            const char* a3 = a2 + kstep; const char* b3 = b2 + kstep;
            const unsigned xA0 = last ? nvA0 : vA0, xB0 = last ? nvB0 : vB0;
            const size_t xhA = last ? nhsA : hsA, xhB = last ? nhsB : hsB;
            PG8_LDB(B0, 0, 0); PG8_LDB(B1, 0, 1); PG8_SCHED; PG8_LDA(At, 0, 0); PG8_STAGE(PG8_SA(1, 1), a1 + hsA, vA0, hsA);
            PG8_WAIT_V(8); PG8_WAIT_L(0); PG8_BAR; PG8_MMA(0, 0, At, B0); PG8_MMA(0, 1, At, B1); PG8_BAR; PG8_SCHED;
            PG8_LDA(At, 0, 1); PG8_STAGE(PG8_SB(0, 0), b2, xB0, xhB); PG8_STAGE(PG8_SB(0, 1), b2 + xhB, xB0, xhB); PG8_STAGE(PG8_SA(0, 0), a2, xA0, xhA);
            PG8_WAIT_V(8); PG8_WAIT_L(0); PG8_BAR; if constexpr (!SKIP_HI) { PG8_MMA(1, 0, At, B0); PG8_MMA(1, 1, At, B1); } PG8_BAR; PG8_SCHED;
            PG8_LDB(B0, 1, 0); PG8_LDB(B1, 1, 1); PG8_SCHED; PG8_LDA(At, 1, 0); PG8_STAGE(PG8_SA(0, 1), a2 + xhA, xA0, xhA);
            PG8_WAIT_V(8); PG8_WAIT_L(0); PG8_BAR; PG8_MMA(0, 0, At, B0); PG8_MMA(0, 1, At, B1); PG8_BAR; PG8_SCHED;
            PG8_LDA(At, 1, 1); PG8_STAGE(PG8_SB(1, 0), b3, xB0, xhB); PG8_STAGE(PG8_SB(1, 1), b3 + xhB, xB0, xhB); PG8_STAGE(PG8_SA(1, 0), a3, xA0, xhA);
            PG8_WAIT_V(8); PG8_WAIT_L(0); PG8_BAR; if constexpr (!SKIP_HI) { PG8_MMA(1, 0, At, B0); PG8_MMA(1, 1, At, B1); } PG8_BAR; PG8_SCHED;
        }
        if (wr == 0) PG8_BAR;
        const bool keep = E(acc, cur, wr, wc, fr, fq);
        if (!has_next) break;
        if (!keep) {
#pragma unroll
            for (int a = 0; a < 2; ++a)
#pragma unroll
                for (int b = 0; b < 2; ++b)
#pragma unroll
                    for (int m = 0; m < 4; ++m)
#pragma unroll
                        for (int n = 0; n < 2; ++n) acc[a][b][m][n] = (f32x4){0.f, 0.f, 0.f, 0.f};
        }
        cur = nxt; cA = nA; cB = nB; vA0 = nvA0; vB0 = nvB0; hsA = nhsA; hsB = nhsB; nt = cur.nt; asm volatile("" : "+s"(nt)); ++ui;
        if (wr == 1) PG8_BAR;
    }
    PG8_WAIT_V(0);
    PG8_BAR;
#undef PG8_VOFF
#undef PG8_SA
#undef PG8_SB
#undef PG8_STAGE
#undef PG8_LDA
#undef PG8_LDB
#undef PG8_MMA
#undef PG8_WAIT_V
#undef PG8_WAIT_L
#undef PG8_BAR
#undef PG8_SCHED
}

__device__ __forceinline__ bool tile_order(int i, int G, int c, int nM, int nN, int& pm, int& pn) {
    const int nwg = nM * nN; const long L = (long)i * G + c; if (L >= nwg) return false;
    int wgid = (int)L; { const int q = nwg / 8, r = nwg % 8, xcd = wgid % 8, off = wgid / 8; wgid = (xcd < r ? xcd * (q + 1) : r * (q + 1) + (xcd - r) * q) + off; }
    const int nig = 8 * nN, gid = wgid / nig, fm = gid * 8, gsz = (nM - fm) < 8 ? (nM - fm) : 8;
    pm = fm + ((wgid % nig) % gsz); pn = (wgid % nig) / gsz; return true;
}
}
using pg8::GU;
enum InIdx { I_X = 0, I_META, I_FNW, I_MIXNW, I_WIN, I_S5LRE, I_S5LIM, I_S5LS, I_S5BRE, I_S5BIM, I_S5CRE, I_S5CIM, I_S5D, I_GLUW, I_GLUB,
             I_CONVW, I_CONVB, I_ALOG, I_DTB, I_SSDD, I_SSDNW, I_MURKV, I_MUWAG, I_W0, I_W1, I_W2, I_A0, I_A1, I_A2, I_G1, I_G2, I_KK, I_KA, I_RK, I_LNW, I_LNB,
             I_PA, I_PB, I_PC, I_WOUT, I_MLPNW, I_MLPW1, I_MLPW2, N_INPUTS };
struct Params { const float* in[N_INPUTS]; float* out; unsigned char* ws; int ph_lo, ph_hi; };

struct Ctx {
    const float* const* in; unsigned char* ws; unsigned char* dout;
    LAS unsigned char* lds;
    int tid, lane, wave, G, bid;
    __device__ __forceinline__ bf16_t* wb(int layer) const { return (bf16_t*)(layer == 0 ? ws + WS_WB0 : dout + DO_WB1); }
    __device__ __forceinline__ bf16_t* H() const { return (bf16_t*)(ws + WS_H); }
    __device__ __forceinline__ float* ssq() const { return (float*)(ws + WS_SSQ); }
};
__device__ __forceinline__ Ctx relaunder(const Ctx& c0) {
    Ctx c = c0; c.tid = opaque_tid(c0.wave); c.lane = c.tid & 63;
    return c;
}
__device__ __forceinline__ float row_scale(const float* ssq, int row) {
    const f32x4* p = (const f32x4*)(ssq + (size_t)row * 16);
    const f32x4 a = p[0], b = p[1], c = p[2], d = p[3];
    const float s = ((a.x + a.y) + (a.z + a.w)) + ((b.x + b.y) + (b.z + b.w)) + ((c.x + c.y) + (c.z + c.w)) + ((d.x + d.y) + (d.z + d.w));
    return __builtin_amdgcn_rsqf(s * (1.0f / DM) + EPS);
}

struct SchedPlain {
    const bf16_t* A; const bf16_t* B; int lda, ldb, K, nM, nN, G, c, pm0;
    __device__ __forceinline__ bool next(int i, GU& u) const {
        int pm, pn; if (!pg8::tile_order(i, G, c, nM, nN, pm, pn)) return false;
        pm += pm0;
        u.A = A + (size_t)pm * 256 * lda; u.B = B + (size_t)pn * 256 * ldb; u.lda = lda; u.ldb = ldb; u.nt = K / 64; u.pm = pm; u.pn = pn; u.kind = 0; return true;
    }
};
struct SchedS5 {
    const bf16_t* UH; const bf16_t* W; int K, G, c;
    __device__ __forceinline__ bool next(int i, GU& u) const {
        const int L = i * G + c; if (L >= 144) return false;
        const int g = L / 9, pm = L % 9;
        u.A = UH + ((size_t)g * S5RP + (size_t)pm * 256) * 512; u.B = W + (size_t)g * 256 * K; u.lda = 512; u.ldb = K; u.nt = K / 64; u.pm = pm; u.pn = 0; u.kind = g; return true;
    }
};
struct SchedL2 {
    const bf16_t* L1o; const bf16_t* W; int G, c, nM, pm0;
    __device__ __forceinline__ bool next(int i, GU& u) const {
        int pm, pn; if (!pg8::tile_order(i, G, c, nM, 5, pm, pn)) return false;
        pm += pm0;
        const int koff = pn < 2 ? 0 : (pn < 4 ? 128 : 256);
        u.A = L1o + (size_t)pm * 256 * 512 + koff; u.B = W + (size_t)pn * 256 * 256; u.lda = 512; u.ldb = 256; u.nt = 4; u.pm = pm; u.pn = pn; u.kind = 0; return true;
    }
};
struct SchedProj {
    const bf16_t* Hb; const bf16_t* Wg; const bf16_t* Wp; const bf16_t* ya; const bf16_t* yb; const bf16_t* yc; int nM, G, c, pm0;
    __device__ __forceinline__ bool next(int i, GU& u) const {
        const int ti = i / 6, sub = i - ti * 6; int pm, pn;
        if (!pg8::tile_order(ti, G, c, nM, 4, pm, pn)) return false;
        pm += pm0;
        u.pm = pm; u.pn = pn; u.kind = sub;
        if (sub < 3) { u.A = Hb + (size_t)pm * 256 * DM; u.lda = DM; u.B = Wg + ((size_t)sub * 1024 + (size_t)pn * 256) * DM; u.ldb = DM; u.nt = 16; }
        else if (sub == 3) { u.A = ya + (size_t)pm * 256 * 256; u.lda = 256; u.B = Wp + (size_t)pn * 256 * DM; u.ldb = DM; u.nt = 4; }
        else if (sub == 4) { u.A = yb + (size_t)pm * 256 * 512; u.lda = 512; u.B = Wp + (size_t)pn * 256 * DM + 256; u.ldb = DM; u.nt = 8; }
        else { u.A = yc + (size_t)pm * 256 * 256; u.lda = 256; u.B = Wp + (size_t)pn * 256 * DM + 768; u.ldb = DM; u.nt = 4; }
        return true;
    }
};

typedef f32x4 Acc[2][2][4][2];
#define EPI_ROWS_BEGIN  _Pragma("unroll") for (int ai = 0; ai < 2; ++ai) _Pragma("unroll") for (int m = 0; m < 4; ++m) { const int rl = ai * 128 + wr * 64 + m * 16 + fr; const int row = u.pm * 256 + rl; (void)rl;
#define EPI_ROWS_END    asm volatile("" ::: "memory"); }
#define EPI_COL(bj) ((bj) * 128 + wc * 32 + fq * 8)

struct EpiInProj {
    const float* ssq; bf16_t* UH; bf16_t* Pz; bf16_t* Pxbc; bf16_t* Prkvx;
    __device__ __forceinline__ bool operator()(Acc& acc, const GU& u, int wr, int wc, int fr, int fq) const {
        EPI_ROWS_BEGIN
            if (row < M_ROWS) {
                const float s = row_scale(ssq, row);
                int b, t; bt_of(row, b, t);
#pragma unroll
                for (int bj = 0; bj < 2; ++bj) {
                    const int col = EPI_COL(bj);
                    const f32x4 v0 = acc[ai][bj][m][0] * s, v1 = acc[ai][bj][m][1] * s;
                    u32x4 w; w.x = pk2(v0[0], v0[1]); w.y = pk2(v0[2], v0[3]); w.z = pk2(v1[0], v1[1]); w.w = pk2(v1[2], v1[3]);
                    bf16_t* dst;
                    if (u.pn == 0) { const int g = col >> 4, hh = col & 15; dst = UH + ((size_t)g * S5RP + (size_t)(b * NCH16 + (t >> 4))) * 512 + (t & 15) * 16 + hh; }
                    else if (u.pn < 3) dst = Pz + (size_t)row * 512 + (u.pn - 1) * 256 + col;
                    else if (u.pn < 7) dst = Pxbc + (size_t)row * 1024 + (u.pn - 3) * 256 + col;
                    else dst = Prkvx + (size_t)row * 1024 + (u.pn - 7) * 256 + col;
                    *(u32x4*)dst = w;
                }
            }
        EPI_ROWS_END
        return false;
    }
};
struct EpiS5X {
    float* X;
    __device__ __forceinline__ bool operator()(Acc& acc, const GU& u, int wr, int wc, int fr, int fq) const {
        EPI_ROWS_BEGIN
            float* rp = X + ((size_t)u.kind * S5RP + row) * 256;
#pragma unroll
            for (int bj = 0; bj < 2; ++bj) { const int col = EPI_COL(bj); *(f32x4*)(rp + col) = acc[ai][bj][m][0]; *(f32x4*)(rp + col + 4) = acc[ai][bj][m][1]; }
        EPI_ROWS_END
        return false;
    }
};
struct EpiS5Y {
    bf16_t* yapre;
    __device__ __forceinline__ bool operator()(Acc& acc, const GU& u, int wr, int wc, int fr, int fq) const {
        EPI_ROWS_BEGIN
            if (row < S5ROWS) {
                const int b = row / NCH16, c = row - b * NCH16;
#pragma unroll
                for (int bj = 0; bj < 2; ++bj) {
                    const int col = EPI_COL(bj), i = col >> 4, hh = col & 15;
                    const f32x4 v0 = acc[ai][bj][m][0], v1 = acc[ai][bj][m][1];
                    u32x4 w; w.x = pk2(geluf_(v0[0]), geluf_(v0[1])); w.y = pk2(geluf_(v0[2]), geluf_(v0[3])); w.z = pk2(geluf_(v1[0]), geluf_(v1[1])); w.w = pk2(geluf_(v1[2]), geluf_(v1[3]));
                    *(u32x4*)(yapre + (size_t)row_of(b, c * 16 + i) * 256 + u.kind * 16 + hh) = w;
                }
            }
        EPI_ROWS_END
        return false;
    }
};
struct EpiL1 {
    bf16_t* L1o;
    __device__ __forceinline__ bool operator()(Acc& acc, const GU& u, int wr, int wc, int fr, int fq) const {
        EPI_ROWS_BEGIN
#pragma unroll
            for (int bj = 0; bj < 2; ++bj) {
                const int col = EPI_COL(bj); const int mode = u.pn * 2 + bj;
                f32x4 v0 = acc[ai][bj][m][0], v1 = acc[ai][bj][m][1]; float f[8] = {v0[0], v0[1], v0[2], v0[3], v1[0], v1[1], v1[2], v1[3]};
#pragma unroll
                for (int e = 0; e < 8; ++e) f[e] = mode == 0 ? tanhf_(f[e]) : (mode == 1 ? f[e] : (mode == 2 ? sigmoidf_(f[e]) : 0.f));
                *(u32x4*)(L1o + (size_t)row * 512 + u.pn * 256 + col) = pack8(f);
            }
        EPI_ROWS_END
        return false;
    }
};
struct EpiL2 {
    bf16_t* L2o; const float* w0; const float* a0;
    __device__ __forceinline__ bool operator()(Acc& acc, const GU& u, int wr, int wc, int fr, int fq) const {
        EPI_ROWS_BEGIN
#pragma unroll
            for (int bj = 0; bj < 2; ++bj) {
                const int col = EPI_COL(bj);
                f32x4 v0 = acc[ai][bj][m][0], v1 = acc[ai][bj][m][1]; float f[8] = {v0[0], v0[1], v0[2], v0[3], v1[0], v1[1], v1[2], v1[3]};
                if (u.pn < 2) {
                    const float* bp = w0 + u.pn * 256 + col;
#pragma unroll
                    for (int e = 0; e < 8; ++e) { const float v = bp[e] + f[e]; f[e] = -__expf(-softplusf_(-v) - 0.5f); }
                } else if (u.pn < 4) {
                    const float* bp = a0 + (u.pn - 2) * 256 + col;
#pragma unroll
                    for (int e = 0; e < 8; ++e) f[e] = sigmoidf_(bp[e] + f[e]);
                }
                *(u32x4*)(L2o + (size_t)row * 1280 + u.pn * 256 + col) = pack8(f);
            }
        EPI_ROWS_END
        return false;
    }
};
struct EpiGLU {
    bf16_t* ya; const float* bias;
    __device__ __forceinline__ bool operator()(Acc& acc, const GU& u, int wr, int wc, int fr, int fq) const {
        const int lc = wc * 32 + fq * 8, oc = u.pn * 128 + lc;
        float bv[8], bg[8];
#pragma unroll
        for (int e = 0; e < 8; ++e) { bv[e] = bias[oc + e]; bg[e] = bias[256 + oc + e]; }
        EPI_ROWS_BEGIN
            const f32x4 a0 = acc[ai][0][m][0], a1 = acc[ai][0][m][1], g0 = acc[ai][1][m][0], g1 = acc[ai][1][m][1];
            float v[8] = {a0[0], a0[1], a0[2], a0[3], a1[0], a1[1], a1[2], a1[3]}, g[8] = {g0[0], g0[1], g0[2], g0[3], g1[0], g1[1], g1[2], g1[3]};
#pragma unroll
            for (int e = 0; e < 8; ++e) v[e] = (v[e] + bv[e]) * sigmoidf_(g[e] + bg[e]);
            *(u32x4*)(ya + (size_t)row * 256 + oc) = pack8(v);
        EPI_ROWS_END
        return false;
    }
};
struct EpiProj {
    const float* ssq; const float* ssqb; unsigned char* park; bf16_t* merged; int tid;
    __device__ __forceinline__ bool operator()(Acc& acc, const GU& u, int wr, int wc, int fr, int fq) const {
        const int k = u.kind;
        EPI_ROWS_BEGIN
            float s = 1.f; if (k < 3) s = row_scale(ssq, row < M_ROWS ? row : 0);
            else if (k < 5) { { const int rr_ = row < M_ROWS ? row : 0; s = __builtin_amdgcn_rsqf((ssqb[2 * rr_] + ssqb[2 * rr_ + 1]) * (1.0f / 512.f) + EPS); } if (k == 3) s = __builtin_amdgcn_rcpf(s); }
#pragma unroll
            for (int bj = 0; bj < 2; ++bj) {
                const int q = (ai * 2 + bj) * 4 + m;
                f32x4& v0 = acc[ai][bj][m][0]; f32x4& v1 = acc[ai][bj][m][1];
                if (k < 3) {
                    float f[8] = {v0[0], v0[1], v0[2], v0[3], v1[0], v1[1], v1[2], v1[3]};
#pragma unroll
                    for (int e = 0; e < 8; ++e) f[e] = sigmoidf_(f[e] * s);
                    *(u32x4*)(park + ((size_t)(k * 16 + q) * NTHREADS + tid) * 16) = pack8(f);
                } else {
                    float num[8], den[8];
                    unpack8(*(const u32x4*)(park + ((size_t)((k - 3) * 16 + q) * NTHREADS + tid) * 16), num);
                    if (k < 5) { unpack8(*(const u32x4*)(park + ((size_t)((k - 2) * 16 + q) * NTHREADS + tid) * 16), den);
#pragma unroll
                        for (int e = 0; e < 8; ++e) num[e] = num[e] * __builtin_amdgcn_rcpf(den[e]) * s; }
                    v0[0] *= num[0]; v0[1] *= num[1]; v0[2] *= num[2]; v0[3] *= num[3]; v1[0] *= num[4]; v1[1] *= num[5]; v1[2] *= num[6]; v1[3] *= num[7];
                    if (k == 5) { u32x4 w; w.x = pk2(v0[0], v0[1]); w.y = pk2(v0[2], v0[3]); w.z = pk2(v1[0], v1[1]); w.w = pk2(v1[2], v1[3]);
                        *(u32x4*)(merged + (size_t)row * DM + u.pn * 256 + EPI_COL(bj)) = w; }
                }
            }
        EPI_ROWS_END
        return k == 3 || k == 4;
    }
};
struct EpiResid {
    bf16_t* H; float* ssq;
    __device__ __forceinline__ bool operator()(Acc& acc, const GU& u, int wr, int wc, int fr, int fq) const {
        EPI_ROWS_BEGIN
            float ss = 0.f;
            if (row < M_ROWS) {
#pragma unroll
                for (int bj = 0; bj < 2; ++bj) {
                    bf16_t* hp = H + (size_t)row * DM + u.pn * 256 + EPI_COL(bj);
                    float f[8]; unpack8(*(const u32x4*)hp, f);
                    const f32x4 v0 = acc[ai][bj][m][0], v1 = acc[ai][bj][m][1];
                    f[0] += v0[0]; f[1] += v0[1]; f[2] += v0[2]; f[3] += v0[3]; f[4] += v1[0]; f[5] += v1[1]; f[6] += v1[2]; f[7] += v1[3];
#pragma unroll
                    for (int e = 0; e < 8; ++e) ss += f[e] * f[e];
                    *(u32x4*)hp = pack8(f);
                }
            }
            ss += __shfl_xor(ss, 16); ss += __shfl_xor(ss, 32);
            if (fq == 0 && row < M_ROWS) ssq[(size_t)row * 16 + u.pn * 4 + wc] = ss;
        EPI_ROWS_END
        return false;
    }
};
struct EpiUp {
    const float* ssq; bf16_t* act;
    __device__ __forceinline__ bool operator()(Acc& acc, const GU& u, int wr, int wc, int fr, int fq) const {
        EPI_ROWS_BEGIN
            const float s = row_scale(ssq, row < M_ROWS ? row : 0);
#pragma unroll
            for (int bj = 0; bj < 2; ++bj) {
                const f32x4 v0 = acc[ai][bj][m][0] * s, v1 = acc[ai][bj][m][1] * s; float f[8] = {v0[0], v0[1], v0[2], v0[3], v1[0], v1[1], v1[2], v1[3]};
#pragma unroll
                for (int e = 0; e < 8; ++e) { const float r = fmaxf(f[e], 0.f); f[e] = r * r; }
                *(u32x4*)(act + (size_t)row * DFF + u.pn * 256 + EPI_COL(bj)) = pack8(f);
            }
        EPI_ROWS_END
        return false;
    }
};
typedef __attribute__((address_space(1))) unsigned gu32;
#define XB_TMO      128
#define XB_XCNT(j)  (256  + 64 * (j))
#define XB_XSUB(j)  (1280 + 64 * (j))
#define XB_XGEN(j)  (2304 + 64 * (j))
#define XB_TOP      3328
#define XB_TOPGEN   3392
#define XCD_BAR_WORDS 3456
#define XB_SPIN_CAP (1u << 18)

__device__ __forceinline__ unsigned xb_ld(unsigned* p)              { return __hip_atomic_load(p, __ATOMIC_RELAXED, __HIP_MEMORY_SCOPE_AGENT); }
__device__ __forceinline__ unsigned xb_add(unsigned* p, unsigned v) { return __hip_atomic_fetch_add(p, v, __ATOMIC_RELAXED, __HIP_MEMORY_SCOPE_AGENT); }
__device__ __forceinline__ unsigned xb_xcc_id() { return (unsigned)__builtin_amdgcn_s_getreg((3 << 11) | 20) & 0xFu; }
#define XB_SPIN(cond, bar) do { unsigned _sp = 0; while (cond) { __builtin_amdgcn_s_sleep(1); \
    if ((++_sp & 255u) == 0u) { if (xb_ld(&(bar)[XB_TMO])) break; if (_sp > XB_SPIN_CAP) { atomicAdd(&(bar)[XB_TMO], 1u); break; } } } } while (0)

struct XcdBarrier {
    unsigned* bar; unsigned x;
    volatile LAS unsigned* st;
};

__device__ __forceinline__ XcdBarrier xcd_barrier_post(unsigned* bar, volatile LAS unsigned* st) {
    XcdBarrier b; b.bar = bar; b.x = xb_xcc_id(); b.st = st;
    if (threadIdx.x == 0) (void)xb_add(&bar[XB_XCNT(b.x)], 1u);
    return b;
}
__device__ __forceinline__ void xcd_barrier_complete(unsigned* bar, unsigned x, unsigned& nloc, unsigned& nx) {
    const unsigned G = gridDim.x * gridDim.y * gridDim.z;
    unsigned sum, cnt, mine, sp = 0u;
    for (;;) {
        sum = 0u; cnt = 0u; mine = 0u;
#pragma unroll
        for (unsigned j = 0; j < 16; ++j) { const unsigned c = xb_ld(&bar[XB_XCNT(j)]); sum += c; cnt += (c > 0u) ? 1u : 0u; mine = (j == x) ? c : mine; }
        if (sum == G) break;
        __builtin_amdgcn_s_sleep(1);
        if ((++sp & 255u) == 0u) { if (xb_ld(&bar[XB_TMO])) break; if (sp > XB_SPIN_CAP) { atomicAdd(&bar[XB_TMO], 1u); break; } }
    }
    nloc = mine > 0u ? mine : 1u; nx = cnt > 0u ? cnt : 1u;
}

__device__ __forceinline__ void xcd_barrier(const XcdBarrier& b, int wave_s) {
    const bool xb_t0 = threadIdx.x == 0; (void)wave_s;
    asm volatile("s_waitcnt vmcnt(0)" ::: "memory");
    __syncthreads();
    if (xb_t0) {
        unsigned* bar = b.bar;
        __builtin_amdgcn_s_waitcnt(0);
        unsigned nloc = b.st[0], nx = b.st[1];
        if (nloc == 0u) { xcd_barrier_complete(bar, b.x, nloc, nx); b.st[0] = nloc; b.st[1] = nx; }
        const unsigned old = xb_add(&bar[XB_XSUB(b.x)], 1u);
        const unsigned gen = old / nloc;
        if (old + 1u == (gen + 1u) * nloc) {
            __builtin_amdgcn_fence(__ATOMIC_RELEASE, "agent");
            asm volatile("s_waitcnt vmcnt(0)" ::: "memory");
            const unsigned og = xb_add(&bar[XB_TOP], 1u);
            const unsigned tg = og / nx;
            if (og + 1u == (tg + 1u) * nx) xb_add(&bar[XB_TOPGEN], 1u);
            else XB_SPIN(xb_ld(&bar[XB_TOPGEN]) == tg, bar);
            __builtin_amdgcn_fence(__ATOMIC_ACQUIRE, "agent");
            xb_add(&bar[XB_XGEN(b.x)], 1u);
            asm volatile("s_waitcnt vmcnt(0)" ::: "memory");
        } else {
            XB_SPIN(xb_ld(&bar[XB_XGEN(b.x)]) == gen, bar);
            __builtin_amdgcn_fence(__ATOMIC_ACQUIRE, "agent");
            asm volatile("s_waitcnt vmcnt(0)" ::: "memory");
        }
    }
    __syncthreads();
}

struct TJob { const float* src; int ld, col0, K, N; bf16_t* dst; int dld, dk0, rmode, row0; const float* ksc; };
constexpr int N_TJOBS = 27;
__device__ __forceinline__ void get_tjob(const Ctx& c, int l, int j, TJob& t) {
    bf16_t* wb = c.wb(l);
    const float* win = c.in[I_WIN] + (size_t)l * DM * N_IN;
    t.rmode = 0; t.ksc = nullptr; t.dk0 = 0; t.col0 = 0; t.row0 = 0;
    if (j < 5) {
        t.src = win; t.ld = N_IN; t.K = DM; t.dld = DM; t.ksc = c.in[I_MIXNW] + l * DM; t.dst = wb + WB_IN;
        if (j == 0) { t.col0 = 0; t.N = 256; t.row0 = 0; }
        else if (j == 1) { t.col0 = 256; t.N = 512; t.row0 = 256; }
        else if (j == 2) { t.col0 = 768; t.N = 1024; t.row0 = 768; }
        else if (j == 3) { t.col0 = 1800; t.N = 1024; t.row0 = 1792; }
        else { t.col0 = 2824; t.N = 3072; t.row0 = 0; t.dst = wb + WB_G; }
    } else if (j == 5) { t.src = c.in[I_PA] + (size_t)l * 256 * DM; t.ld = DM; t.K = 256; t.N = DM; t.dst = wb + WB_P; t.dld = DM; t.dk0 = 0; }
    else if (j == 6) { t.src = c.in[I_PB] + (size_t)l * 512 * DM; t.ld = DM; t.K = 512; t.N = DM; t.dst = wb + WB_P; t.dld = DM; t.dk0 = 256; t.ksc = c.in[I_SSDNW] + (size_t)l * 512; }
    else if (j == 7) { t.src = c.in[I_PC] + (size_t)l * 256 * DM; t.ld = DM; t.K = 256; t.N = DM; t.dst = wb + WB_P; t.dld = DM; t.dk0 = 768; }
    else if (j == 8) { t.src = c.in[I_WOUT] + (size_t)l * DM * DM; t.ld = DM; t.K = DM; t.N = DM; t.dst = wb + WB_O; t.dld = DM; }
    else if (j == 9) { t.src = c.in[I_MLPW1] + (size_t)l * DM * DFF; t.ld = DFF; t.K = DM; t.N = DFF; t.dst = wb + WB_1; t.dld = DM; t.ksc = c.in[I_MLPNW] + l * DM; }
    else if (j == 10) { t.src = c.in[I_MLPW2] + (size_t)l * DFF * DM; t.ld = DM; t.K = DFF; t.N = DM; t.dst = wb + WB_2; t.dld = DFF; }
    else if (j == 11) { t.src = c.in[I_GLUW] + (size_t)l * 256 * 512; t.ld = 512; t.K = 256; t.N = 512; t.dst = wb + WB_GLU; t.dld = 256; t.rmode = 1; }
    else if (j < 22) {
        const int q = j - 12;
        t.K = 256; t.dst = wb + WB_L1; t.dld = 512;
        if (q < 4) { const int d = q >> 1, hf = q & 1; t.src = c.in[I_W1] + ((size_t)l * 2 + d) * 256 * 64; t.ld = 64; t.N = 64; t.row0 = d * 64; t.dk0 = hf * 256; if (hf) t.ksc = c.in[I_MUWAG] + ((size_t)l * 3 + 0) * 256; }
        else if (q < 8) { const int d = (q - 4) >> 1, hf = q & 1; t.src = c.in[I_A1] + ((size_t)l * 2 + d) * 256 * 64; t.ld = 64; t.N = 64; t.row0 = 128 + d * 64; t.dk0 = hf * 256; if (hf) t.ksc = c.in[I_MUWAG] + ((size_t)l * 3 + 1) * 256; }
        else { const int hf = q & 1; t.src = c.in[I_G1] + (size_t)l * 256 * 128; t.ld = 128; t.N = 128; t.row0 = 256; t.dk0 = hf * 256; if (hf) t.ksc = c.in[I_MUWAG] + ((size_t)l * 3 + 2) * 256; }
    } else {
        const int q = j - 22;
        t.dst = wb + WB_L2; t.dld = 256; t.ld = 256; t.N = 256;
        if (q < 2) { t.src = c.in[I_W2] + ((size_t)l * 2 + q) * 64 * 256; t.K = 64; t.row0 = q * 256; t.dk0 = q * 64; }
        else if (q < 4) { const int d = q - 2; t.src = c.in[I_A2] + ((size_t)l * 2 + d) * 64 * 256; t.K = 64; t.row0 = (2 + d) * 256; t.dk0 = d * 64; }
        else { t.src = c.in[I_G2] + (size_t)l * 128 * 256; t.K = 128; t.row0 = 4 * 256; t.dk0 = 0; }
    }
}
__device__ __forceinline__ int tjob_items(const TJob& t) { return (t.K / 64) * (t.N / 32); }
__device__ __forceinline__ void transpose_item(const TJob& t, LAS float* scr, int item, int lane) {
    const int nblk = t.N / 32, kb = item / nblk, nb = item % nblk, k0 = 64 * kb, n0 = 32 * nb;
#pragma unroll 8
    for (int i = 0; i < 32; ++i) { const int kk = 2 * i + (lane >> 5); float v = t.src[(size_t)(k0 + kk) * t.ld + t.col0 + n0 + (lane & 31)]; if (t.ksc) v *= t.ksc[k0 + kk]; scr[kk * 33 + (lane & 31)] = v; }
    asm volatile("s_waitcnt lgkmcnt(0)" ::: "memory");
    const int cc = lane & 7;
#pragma unroll
    for (int j = 0; j < 4; ++j) {
        const int n = (lane >> 3) + 8 * j; const LAS float* s = scr + (8 * cc) * 33 + n;
        u32x4 o; o.x = pk2(s[0 * 33], s[1 * 33]); o.y = pk2(s[2 * 33], s[3 * 33]); o.z = pk2(s[4 * 33], s[5 * 33]); o.w = pk2(s[6 * 33], s[7 * 33]);
        const int nn = n0 + n; int drow;
        if (t.rmode == 0) drow = t.row0 + nn; else drow = nn < 256 ? (nn >> 7) * 256 + (nn & 127) : ((nn - 256) >> 7) * 256 + 128 + ((nn - 256) & 127);
        *(u32x4*)(t.dst + (size_t)drow * t.dld + t.dk0 + k0 + 8 * cc) = o;
    }
    asm volatile("s_waitcnt lgkmcnt(0)" ::: "memory");
}

__device__ __forceinline__ void s5_build(const Ctx& cx_, int l, int g, int part) {
    const Ctx c = relaunder(cx_);
    LAS float* F = (LAS float*)c.lds;
    LAS float* pwr = F;
    LAS float* pwi = pwr + 2176;
    LAS float* cor = pwi + 2176;
    LAS float* coi = cor + 128;
    LAS float* Cr = coi + 128;
    LAS float* Ci = Cr + 1024;
    LAS float* Br = Ci + 1024;
    LAS float* Bi = Br + 1024;
    LAS float* kr = Bi + 1024;
    LAS float* ki = kr + 1984;
    LAS float* Kd = ki + 1984;
    const int tid = c.tid;
    if (tid < 128) {
        const int d = tid >> 6, n = tid & 63; const size_t li_ = (((size_t)l * 2 + d) * 16 + g) * 64 + n;
        const float lr = c.in[I_S5LRE][li_], li = c.in[I_S5LIM][li_], step = expf(c.in[I_S5LS][((size_t)l * 2 + d) * 16 + g]);
        for (int k = 0; k <= 16; ++k) { const float mag = expf((float)k * lr * step), ang = (float)k * li * step; float sn, cs; sincosf(ang, &sn, &cs); pwr[(d * 17 + k) * 64 + n] = mag * cs; pwi[(d * 17 + k) * 64 + n] = mag * sn; }
        const float mag1 = expf(lr * step); float sn, cs; sincosf(li * step, &sn, &cs); const float abr = mag1 * cs, abi = mag1 * sn, den = lr * lr + li * li;
        cor[d * 64 + n] = ((abr - 1.f) * lr + abi * li) / den; coi[d * 64 + n] = (abi * lr - (abr - 1.f) * li) / den;
    }
    for (int i = tid; i < 1024; i += NTHREADS) {
        Cr[i] = c.in[I_S5CRE][((size_t)l * 16 + g) * 1024 + i]; Ci[i] = c.in[I_S5CIM][((size_t)l * 16 + g) * 1024 + i];
        Br[i] = c.in[I_S5BRE][((size_t)l * 16 + g) * 1024 + i]; Bi[i] = c.in[I_S5BIM][((size_t)l * 16 + g) * 1024 + i];
    }
    __syncthreads();
    for (int i = tid; i < 31 * 64; i += NTHREADS) {
        const int dd = i / 64 - 15, n = i & 63; float r, im;
        if (dd > 0) { const float pr = pwr[(0 * 17 + dd) * 64 + n], pi = pwi[(0 * 17 + dd) * 64 + n]; r = pr * cor[n] - pi * coi[n]; im = pr * coi[n] + pi * cor[n]; }
        else if (dd < 0) { const float pr = pwr[(1 * 17 - dd) * 64 + n], pi = pwi[(1 * 17 - dd) * 64 + n]; r = pr * cor[64 + n] - pi * coi[64 + n]; im = pr * coi[64 + n] + pi * cor[64 + n]; }
        else { r = cor[n] + cor[64 + n]; im = coi[n] + coi[64 + n]; }
        kr[i] = r; ki[i] = im;
    }
    __syncthreads();
    for (int i0 = tid; i0 < 17 * 256; i0 += NTHREADS) {
        const int i = i0 + 2 * part * 256; const int ddi = i >> 8, h = (i >> 4) & 15, hp = i & 15; float a = 0.f;
        for (int n = 0; n < 64; ++n) { const float cr = Cr[h * 64 + n], ci = Ci[h * 64 + n], xr = kr[ddi * 64 + n], xi = ki[ddi * 64 + n]; const float pr = cr * xr - ci * xi, pi = cr * xi + ci * xr; a += pr * Br[n * 16 + hp] - pi * Bi[n * 16 + hp]; }
        Kd[i] = a;
    }
    __syncthreads();
    bf16_t* SX = c.wb(l) + WB_SX + (size_t)g * 256 * 256; bf16_t* SY = c.wb(l) + WB_SY + (size_t)g * 256 * 512;
    const float* dsk = c.in[I_S5D] + (size_t)l * 256 + g * 16;
    for (int u = tid; u < 32 * 64; u += NTHREADS) {
        const int o = 32 * part + (u >> 6), kk0 = (u & 63) * 8, i = o >> 4, h = o & 15; float v[8];
        if (kk0 < 256) { const int j = kk0 >> 4, hp0 = kk0 & 15;
#pragma unroll
            for (int e = 0; e < 8; ++e) v[e] = Kd[(i - j + 15) * 256 + h * 16 + hp0 + e] + ((i == j && h == hp0 + e) ? dsk[h] : 0.f);
        } else { const int q = kk0 - 256, d = q >> 7, part = (q >> 6) & 1, n0 = q & 63, ex = d == 0 ? i + 1 : 16 - i;
#pragma unroll
            for (int e = 0; e < 8; ++e) { const int n = n0 + e; const float cr = Cr[h * 64 + n], ci = Ci[h * 64 + n], pr = pwr[(d * 17 + ex) * 64 + n], pi = pwi[(d * 17 + ex) * 64 + n]; v[e] = part == 0 ? (cr * pr - ci * pi) : -(cr * pi + ci * pr); }
        }
        *(u32x4*)(SY + (size_t)o * 512 + kk0) = pack8(v);
    }
    for (int u = tid; u < 32 * 32; u += NTHREADS) {
        const int o = 32 * part + (u >> 5), kk0 = (u & 31) * 8, d = o >> 7, part = (o >> 6) & 1, n = o & 63, j = kk0 >> 4, hp0 = kk0 & 15, ex = d == 0 ? 15 - j : j;
        const float pr = pwr[(d * 17 + ex) * 64 + n], pi = pwi[(d * 17 + ex) * 64 + n], qr = pr * cor[d * 64 + n] - pi * coi[d * 64 + n], qi = pr * coi[d * 64 + n] + pi * cor[d * 64 + n];
        float v[8];
#pragma unroll
        for (int e = 0; e < 8; ++e) { const float br = Br[n * 16 + hp0 + e], bi = Bi[n * 16 + hp0 + e]; v[e] = part == 0 ? (qr * br - qi * bi) : (qr * bi + qi * br); }
        *(u32x4*)(SX + (size_t)o * 256 + kk0) = pack8(v);
    }
    __syncthreads();
}

__device__ __forceinline__ void phase0(const Ctx& cx_) {
    const Ctx c = relaunder(cx_);
    if (c.bid < 256) s5_build(c, c.bid >> 7, (c.bid >> 3) & 15, c.bid & 7);
    const int gw = c.bid * NWAVES + c.wave, NGW = c.G * NWAVES, lane = c.lane;
    bf16_t* H = c.H(); float* ssq = c.ssq();
#pragma unroll 2
    for (int m = gw; m < MP; m += NGW) {
        u32x2* hp = (u32x2*)(H + (size_t)m * DM);
        if (m >= M_ROWS) {
#pragma unroll
            for (int i = 0; i < 4; ++i) hp[lane + 64 * i] = (u32x2){0u, 0u};
            continue;
        }
        int b, t; bt_of(m, b, t);
        const f32x4* src = (const f32x4*)(t < NMETA ? c.in[I_META] + (size_t)t * DM : c.in[I_X] + ((size_t)b * SEQ + (t - NMETA)) * DM);
        float ss = 0.f;
#pragma unroll
        for (int i = 0; i < 4; ++i) { const f32x4 v = src[lane + 64 * i]; ss += (v.x * v.x + v.y * v.y) + (v.z * v.z + v.w * v.w); hp[lane + 64 * i] = (u32x2){pk2(v.x, v.y), pk2(v.z, v.w)}; }
        ss = wave_sum(ss);
        if (lane < 16) ssq[(size_t)m * 16 + lane] = lane == 0 ? ss : 0.f;
    }
    LAS float* scr = (LAS float*)(c.lds + c.wave * 8448);
    for (int l = 0; l < DEPTH; ++l) {
        int base = 0;
        for (int j = 0; j < N_TJOBS; ++j) {
            TJob t; get_tjob(c, l, j, t); const int ni = tjob_items(t);
            int first = (gw - base % NGW + NGW) % NGW;
            for (int it = first; it < ni; it += NGW) transpose_item(t, scr, it, lane);
            base += ni;
        }
        bf16_t* wb = c.wb(l);
        const int gt = c.bid * NTHREADS + c.tid, NGT = c.G * NTHREADS;
        for (int u = gt; u < 128 * 64; u += NGT) *(u32x4*)(wb + WB_L1 + (size_t)384 * 512 + (size_t)u * 8) = (u32x4){0u, 0u, 0u, 0u};
        for (int u = gt; u < 5 * 256 * 4 * 8; u += NGT) {
            const int sub = u & 7, blk = (u >> 3) & 3, row = (u >> 5) & 255, tile = u >> 13;
            const bool nz = (tile == 0 || tile == 2) ? (blk == 0) : ((tile == 1 || tile == 3) ? (blk == 1) : (blk < 2));
            if (!nz) *(u32x4*)(wb + WB_L2 + ((size_t)tile * 256 + row) * 256 + blk * 64 + sub * 8) = (u32x4){0u, 0u, 0u, 0u};
        }
    }
}

__device__ __forceinline__ void dt_job(const Ctx& cx_, int l) {
    const Ctx c = relaunder(cx_);
    LAS float* dtw = (LAS float*)c.lds;
    const float* win = c.in[I_WIN] + (size_t)l * DM * N_IN; const float* nw = c.in[I_MIXNW] + l * DM;
    for (int i = c.tid; i < 8 * DM; i += NTHREADS) { const int k = i >> 3, j = i & 7; dtw[j * DM + k] = nw[k] * win[(size_t)k * N_IN + 1792 + j]; }
    __syncthreads();
    const int gw = c.bid * NWAVES + c.wave, NGW = c.G * NWAVES, lane = c.lane;
    const bf16_t* H = c.H(); float* dt = (float*)(c.ws + WS_DT); float* dec = (float*)(c.ws + WS_DEC);
    const float* dtb = c.in[I_DTB] + l * 16; const float* alog = c.in[I_ALOG] + l * 16;
#pragma unroll 2
    for (int m = gw; m < M_ROWS; m += NGW) {
        const u32x2* hp = (const u32x2*)(H + (size_t)m * DM);
        float ss = 0.f, d8[8] = {0.f, 0.f, 0.f, 0.f, 0.f, 0.f, 0.f, 0.f};
#pragma unroll
        for (int i = 0; i < 4; ++i) {
            const u32x2 w = hp[lane + 64 * i]; const float h0 = bflo(w.x), h1 = bfhi(w.x), h2 = bflo(w.y), h3 = bfhi(w.y);
            ss += (h0 * h0 + h1 * h1) + (h2 * h2 + h3 * h3);
#pragma unroll
            for (int j = 0; j < 8; ++j) { const f32x4 wv = *(const LAS f32x4*)(dtw + j * DM + 4 * lane + 256 * i); d8[j] += (h0 * wv.x + h1 * wv.y) + (h2 * wv.z + h3 * wv.w); }
        }
        ss = wave_sum(ss);
#pragma unroll
        for (int j = 0; j < 8; ++j) d8[j] = wave_sum(d8[j]);
        const float s = __builtin_amdgcn_rsqf(ss * (1.0f / DM) + EPS);
        if (lane < 16) {
            const int j = lane & 7; float raw = d8[0];
#pragma unroll
            for (int e = 1; e < 8; ++e) raw = (j == e) ? d8[e] : raw;
            const float dtv = softplusf_(raw * s + dtb[lane]);
            dt[(size_t)m * 16 + lane] = dtv; dec[(size_t)m * 16 + lane] = -dtv * __expf(alog[lane]);
        }
    }
    __syncthreads();
}

__device__ __forceinline__ void rwkv_prep(const Ctx& cx_, int l) {
    const Ctx c = relaunder(cx_);
    const int gw = c.bid * NWAVES + c.wave, NGW = c.G * NWAVES, lane = c.lane, c0 = 4 * lane;
    const bf16_t* __restrict__ P = (const bf16_t*)(c.ws + WS_PRKVX); bf16_t* __restrict__ rk = (bf16_t*)(c.dout + DO_RKVP); bf16_t* __restrict__ l1 = (bf16_t*)(c.ws + WS_L1IN);
    float mu[3][4], kkw[4];
#pragma unroll
    for (int x = 0; x < 3; ++x)
#pragma unroll
        for (int e = 0; e < 4; ++e) mu[x][e] = c.in[I_MURKV][((size_t)l * 3 + x) * 256 + c0 + e];
#pragma unroll
    for (int e = 0; e < 4; ++e) kkw[e] = c.in[I_KK][(size_t)l * 256 + c0 + e];
#pragma unroll 4
    for (int m = gw; m < M_ROWS; m += NGW) {
        int b, t; bt_of(m, b, t); const bool hp = t > 0, hn = t < LEN - 1; const size_t mp_ = hp ? row_of(b, t - 1) : 0, mn_ = hn ? row_of(b, t + 1) : 0;
        float o[4][4];
        float xc[4], dxc[4];
#pragma unroll
        for (int x = 0; x < 4; ++x) {
            const u32x2 wc_ = *(const u32x2*)(P + (size_t)m * 1024 + x * 256 + c0);
            u32x2 wp = (u32x2){0u, 0u}, wn = (u32x2){0u, 0u};
            if (hp) wp = *(const u32x2*)(P + mp_ * 1024 + x * 256 + c0);
            if (hn) wn = *(const u32x2*)(P + mn_ * 1024 + x * 256 + c0);
            const float cur[4] = {bflo(wc_.x), bfhi(wc_.x), bflo(wc_.y), bfhi(wc_.y)}, pv[4] = {bflo(wp.x), bfhi(wp.x), bflo(wp.y), bfhi(wp.y)}, nv[4] = {bflo(wn.x), bfhi(wn.x), bflo(wn.y), bfhi(wn.y)};
#pragma unroll
            for (int e = 0; e < 4; ++e) { const float cs = 0.5f * (pv[e] + nv[e]) - cur[e]; if (x < 3) o[x][e] = cur[e] + cs * mu[x][e]; else { xc[e] = cur[e]; dxc[e] = cs; } }
        }
        float kr_[4], ss = 0.f;
#pragma unroll
        for (int e = 0; e < 4; ++e) { kr_[e] = o[1][e] * kkw[e]; ss += kr_[e] * kr_[e]; }
        ss = sum16(ss); const float rn = __builtin_amdgcn_rsqf(ss + 1e-12f);
        bf16_t* rp = rk + (size_t)m * 1024 + c0;
        *(u32x2*)(rp) = (u32x2){pk2(o[0][0], o[0][1]), pk2(o[0][2], o[0][3])};
        *(u32x2*)(rp + 256) = (u32x2){pk2(o[1][0], o[1][1]), pk2(o[1][2], o[1][3])};
        *(u32x2*)(rp + 512) = (u32x2){pk2(o[2][0], o[2][1]), pk2(o[2][2], o[2][3])};
        *(u32x2*)(rp + 768) = (u32x2){pk2(kr_[0] * rn, kr_[1] * rn), pk2(kr_[2] * rn, kr_[3] * rn)};
        bf16_t* lp = l1 + (size_t)m * 512 + c0;
        *(u32x2*)(lp) = (u32x2){pk2(xc[0], xc[1]), pk2(xc[2], xc[3])};
        *(u32x2*)(lp + 256) = (u32x2){pk2(dxc[0], dxc[1]), pk2(dxc[2], dxc[3])};
    }
}
__device__ __forceinline__ void ssd_prep(const Ctx& cx_, int l) {
    const Ctx c = relaunder(cx_);
    const int gw = c.bid * NWAVES + c.wave, NGW = c.G * NWAVES, lane = c.lane, c0 = 16 * lane;
    const bf16_t* __restrict__ P = (const bf16_t*)(c.ws + WS_PXBC); bf16_t* __restrict__ xs = (bf16_t*)(c.ws + WS_XS); bf16_t* __restrict__ bc = (bf16_t*)(c.ws + WS_BC);
    float w[5][16], bias[16];
#pragma unroll
    for (int j = 0; j < 5; ++j)
#pragma unroll
        for (int e = 0; e < 16; ++e) w[j][e] = c.in[I_CONVW][((size_t)l * 5 + j) * 1024 + c0 + e];
#pragma unroll
    for (int e = 0; e < 16; ++e) bias[e] = c.in[I_CONVB][(size_t)l * 1024 + c0 + e];
#pragma unroll 2
    for (int m = gw; m < M_ROWS; m += NGW) {
        int b, t; bt_of(m, b, t);
        float a[16];
#pragma unroll
        for (int e = 0; e < 16; ++e) a[e] = bias[e];
#pragma unroll
        for (int j = 0; j < 5; ++j) {
            const int tt = t + j - 2;
            if (tt >= 0 && tt < LEN) {
                const u32x4* p = (const u32x4*)(P + (size_t)row_of(b, tt) * 1024 + c0); float f0[8], f1[8]; unpack8(p[0], f0); unpack8(p[1], f1);
#pragma unroll
                for (int e = 0; e < 8; ++e) { a[e] += w[j][e] * f0[e]; a[8 + e] += w[j][8 + e] * f1[e]; }
            }
        }
        float o0[8], o1[8];
#pragma unroll
        for (int e = 0; e < 8; ++e) { o0[e] = siluf_(a[e]); o1[e] = siluf_(a[8 + e]); }
        bf16_t* dst = lane < 32 ? xs + (size_t)m * 512 + c0 : bc + (size_t)m * 512 + (c0 - 512);
        ((u32x4*)dst)[0] = pack8(o0); ((u32x4*)dst)[1] = pack8(o1);
    }
}

__device__ __forceinline__ void s5_scan(const Ctx& cx_, int l) {
    const Ctx c = relaunder(cx_);
    if (c.tid >= 64) return;
    const int gt = c.bid * 64 + c.tid; if (gt >= 16384) return;
    const int n = gt & 63, d = (gt >> 6) & 1, b = (gt >> 7) & 7, g = gt >> 10;
    const size_t li_ = (((size_t)l * 2 + d) * 16 + g) * 64 + n;
    const float lr = c.in[I_S5LRE][li_], li = c.in[I_S5LIM][li_], step = expf(c.in[I_S5LS][((size_t)l * 2 + d) * 16 + g]);
    const float mag = expf(16.f * lr * step); float sn, cs; sincosf(16.f * li * step, &sn, &cs); const float ar = mag * cs, ai = mag * sn;
    const float* X = (const float*)(c.ws + WS_X) + ((size_t)g * S5RP + (size_t)b * NCH16) * 256 + d * 128 + n;
    bf16_t* U = (bf16_t*)(c.ws + WS_UH) + ((size_t)g * S5RP + (size_t)b * NCH16) * 512 + 256 + d * 128 + n;
    float hr = 0.f, hi = 0.f;
    for (int i0 = 0; i0 < NCH16; i0 += 32) {
        float xr[32], xi[32];
#pragma unroll
        for (int k = 0; k < 32; ++k) { const int i = i0 + k; const int ch = d == 0 ? i : NCH16 - 1 - i; const bool ok = i < NCH16; xr[k] = ok ? X[(size_t)ch * 256] : 0.f; xi[k] = ok ? X[(size_t)ch * 256 + 64] : 0.f; }
#pragma unroll
        for (int k = 0; k < 32; ++k) { const int i = i0 + k; if (i < NCH16) { const int ch = d == 0 ? i : NCH16 - 1 - i;
            U[(size_t)ch * 512] = (bf16_t)f2bf(hr); U[(size_t)ch * 512 + 64] = (bf16_t)f2bf(hi);
            const float nr = ar * hr - ai * hi + xr[k], ni = ar * hi + ai * hr + xi[k]; hr = nr; hi = ni; } }
    }
}
typedef short s16x4 __attribute__((ext_vector_type(4)));
__device__ __forceinline__ s16x4 lds_tr(const LAS unsigned char* p) { return __builtin_bit_cast(s16x4, __builtin_amdgcn_ds_read_tr16_b64_v4i16((LAS s16x4*)p)); }
__device__ __forceinline__ bf16x8 frag_tr(const LAS unsigned char* img, int rs, int kbase, int colbase, int lane) {
    const LAS unsigned char* a = img + (kbase + 8 * (lane >> 4) + ((lane & 15) >> 2)) * rs + (colbase + 4 * (lane & 3)) * 2;
    const s16x4 lo = lds_tr(a), hi = lds_tr(a + 4 * rs);
    return (bf16x8){lo[0], lo[1], lo[2], lo[3], hi[0], hi[1], hi[2], hi[3]};
}
__device__ __forceinline__ bf16x8 frag_row(const LAS unsigned char* img, int rs, int rowbase, int kbase, int lane) {
    return *(const LAS bf16x8*)(img + (rowbase + (lane & 15)) * rs + (kbase + 8 * (lane >> 4)) * 2);
}
constexpr int SD_RS = 272;
constexpr int SD_XRS = 144;
constexpr int SD_OFF_C = 0, SD_OFF_B = 34816, SD_OFF_X = 69632, SD_OFF_M = 88064, SD_OFF_SC = 122880;
constexpr int SD_OFF_HF = SD_OFF_B, SD_OFF_HB = SD_OFF_B + 17408;
constexpr size_t WS_STB = WS_YSSD;
constexpr size_t WS_CDEC = WS_DEC + (size_t)MP * 64 + 256;
constexpr size_t WS_SSQB = WS_CDEC + (size_t)BATCH * 33 * 16 * 4;
constexpr size_t WS_BAR = (WS_SSQB + (size_t)MP * 8 + 255) / 256 * 256;
static_assert(WS_BAR + 3456 * 4 <= 7 * QB, "small region");
static_assert((size_t)BATCH * 2 * 8 * 32 * 8192 * 2 <= 4 * QB, "chunk states fit the yssd slot");

struct SsdUnit { int b, ck, t0, ns; };
__device__ __forceinline__ bool ssd_unit(int bid, int round, SsdUnit& u) {
    if (round == 0) { u.b = bid >> 5; u.ck = 1 + (bid & 31); u.t0 = NMETA + 128 * (u.ck - 1); u.ns = 8; return true; }
    if (round == 1 && bid < BATCH) { u.b = bid; u.ck = 0; u.t0 = 0; u.ns = 1; return true; }
    return false;
}
__device__ __forceinline__ void ssd_load_img(LAS unsigned char* img, int rs, const bf16_t* src, int ld, size_t m0, int col0, int ncol, int ns, int tid) {
    const int cpr = ncol / 8, nrow = ns == 1 ? 32 : 128;
    for (int i = tid; i < nrow * cpr; i += NTHREADS) {
        const int r = i / cpr, cc = i - r * cpr; u32x4 v = (u32x4){0u, 0u, 0u, 0u};
        if (r < 16 * ns) v = *(const u32x4*)(src + (m0 + r) * ld + col0 + cc * 8);
        *(LAS u32x4*)(img + r * rs + cc * 16) = v;
    }
}
__device__ __forceinline__ void ssd_scalars(LAS float* sc, const float* dt, const float* al, size_t m0, int head, int ns, int lane, float& totf, float& totb) {
    const int Q = 16 * ns;
    float a0f = 0.f, a1f = 0.f, a0b = 0.f, a1b = 0.f, d0f = 0.f, d1f = 0.f, d0b = 0.f, d1b = 0.f;
    const int s0 = 2 * lane, s1 = 2 * lane + 1;
    if (s0 < Q) { a0f = al[(m0 + s0) * 16 + head]; a0b = al[(m0 + s0) * 16 + 8 + head]; d0f = dt[(m0 + s0) * 16 + head]; d0b = dt[(m0 + s0) * 16 + 8 + head]; }
    if (s1 < Q) { a1f = al[(m0 + s1) * 16 + head]; a1b = al[(m0 + s1) * 16 + 8 + head]; d1f = dt[(m0 + s1) * 16 + head]; d1b = dt[(m0 + s1) * 16 + 8 + head]; }
    float pf = a0f + a1f, pb = a0b + a1b;
#pragma unroll
    for (int o = 1; o < 64; o <<= 1) { const float tf = __shfl_up(pf, o), tb = __shfl_up(pb, o); if (lane >= o) { pf += tf; pb += tb; } }
    totf = __shfl(pf, 63); totb = __shfl(pb, 63);
    const float af1 = pf, af0 = pf - a1f;
    const float eb0 = pb - a0b - a1b, eb1 = pb - a1b;
    sc[s0] = af0; sc[s1] = af1; sc[128 + s0] = eb0; sc[128 + s1] = eb1; sc[256 + s0] = d0f; sc[256 + s1] = d1f; sc[384 + s0] = d0b; sc[384 + s1] = d1b;
    sc[512 + s0] = __expf(totf - af0) * d0f; sc[512 + s1] = __expf(totf - af1) * d1f;
    sc[640 + s0] = __expf(eb0) * d0b; sc[640 + s1] = __expf(eb1) * d1b;
    sc[768 + s0] = __expf(af0); sc[768 + s1] = __expf(af1);
    sc[896 + s0] = __expf(totb - eb0); sc[896 + s1] = __expf(totb - eb1);
}

__device__ __forceinline__ void ssd_states(const Ctx& cx_, int l) {
    const Ctx c = relaunder(cx_);
    const int tid = c.tid, lane = c.lane, wave = c.wave;
    const bf16_t* bc = (const bf16_t*)(c.ws + WS_BC); const bf16_t* xs = (const bf16_t*)(c.ws + WS_XS);
    const float* dt = (const float*)(c.ws + WS_DT); const float* al = (const float*)(c.ws + WS_DEC);
    bf16_t* stb = (bf16_t*)(c.ws + WS_STB); float* cdec = (float*)(c.ws + WS_CDEC);
    LAS unsigned char* Bimg = c.lds + SD_OFF_B; LAS unsigned char* Ximg = c.lds + SD_OFF_X; LAS float* sc = (LAS float*)(c.lds + SD_OFF_SC);
    for (int round = 0; round < 2; ++round) {
        SsdUnit u; if (!ssd_unit(c.bid, round, u)) break;
        const size_t m0 = (size_t)row_of(u.b, u.t0); const int nks = u.ns == 1 ? 1 : 4;
        for (int g = 0; g < 2; ++g) {
            __syncthreads();
            ssd_load_img(Bimg, SD_RS, bc, 512, m0, g * 128, 128, u.ns, tid);
            for (int j = 0; j < 4; ++j) {
                const int head = g * 4 + j;
                if (j) __syncthreads();
                ssd_load_img(Ximg, SD_XRS, xs, 512, m0, head * 64, 64, u.ns, tid);
                if (wave == 0) { float totf, totb; ssd_scalars(sc, dt, al, m0, head, u.ns, lane, totf, totb);
                    if (lane == 0) { cdec[((size_t)u.b * 33 + u.ck) * 16 + head] = __expf(totf); cdec[((size_t)u.b * 33 + u.ck) * 16 + 8 + head] = __expf(totb); } }
                __syncthreads();
                f32x4 accf[4], accb[4];
#pragma unroll
                for (int pt = 0; pt < 4; ++pt) { accf[pt] = (f32x4){0.f, 0.f, 0.f, 0.f}; accb[pt] = accf[pt]; }
                for (int ks = 0; ks < nks; ++ks) {
                    const bf16x8 af = frag_tr(Bimg, SD_RS, 32 * ks, 16 * wave, lane);
                    const int k0 = 32 * ks + 8 * (lane >> 4);
                    const f32x4 wf0 = *(const LAS f32x4*)(sc + 512 + k0), wf1 = *(const LAS f32x4*)(sc + 512 + k0 + 4), wb0 = *(const LAS f32x4*)(sc + 640 + k0), wb1 = *(const LAS f32x4*)(sc + 640 + k0 + 4);
#pragma unroll
                    for (int pt = 0; pt < 4; ++pt) {
                        const bf16x8 xr = frag_tr(Ximg, SD_XRS, 32 * ks, 16 * pt, lane);
                        float xf[8];
#pragma unroll
                        for (int e = 0; e < 8; ++e) xf[e] = bf1((bf16_t)xr[e]);
                        bf16x8 bfv, bbv;
                        { const unsigned p0 = pk2(xf[0] * wf0.x, xf[1] * wf0.y), p1 = pk2(xf[2] * wf0.z, xf[3] * wf0.w), p2 = pk2(xf[4] * wf1.x, xf[5] * wf1.y), p3 = pk2(xf[6] * wf1.z, xf[7] * wf1.w);
                          bfv = __builtin_bit_cast(bf16x8, (u32x4){p0, p1, p2, p3}); }
                        { const unsigned p0 = pk2(xf[0] * wb0.x, xf[1] * wb0.y), p1 = pk2(xf[2] * wb0.z, xf[3] * wb0.w), p2 = pk2(xf[4] * wb1.x, xf[5] * wb1.y), p3 = pk2(xf[6] * wb1.z, xf[7] * wb1.w);
                          bbv = __builtin_bit_cast(bf16x8, (u32x4){p0, p1, p2, p3}); }
                        accf[pt] = __builtin_amdgcn_mfma_f32_16x16x32_bf16(af, bfv, accf[pt], 0, 0, 0);
                        accb[pt] = __builtin_amdgcn_mfma_f32_16x16x32_bf16(af, bbv, accb[pt], 0, 0, 0);
                    }
                }
#pragma unroll
                for (int pt = 0; pt < 4; ++pt) {
                    const int p = 16 * pt + (lane & 15), n0 = 16 * wave + 4 * (lane >> 4);
                    if (u.ck <= 31) { bf16_t* d = stb + ((((size_t)u.b * 2 + 0) * 8 + head) * 32 + u.ck) * 8192 + (size_t)p * 128 + n0; *(u32x2*)d = (u32x2){pk2(accf[pt][0], accf[pt][1]), pk2(accf[pt][2], accf[pt][3])}; }
                    if (u.ck >= 1) { bf16_t* d = stb + ((((size_t)u.b * 2 + 1) * 8 + head) * 32 + (u.ck - 1)) * 8192 + (size_t)p * 128 + n0; *(u32x2*)d = (u32x2){pk2(accb[pt][0], accb[pt][1]), pk2(accb[pt][2], accb[pt][3])}; }
                }
            }
        }
    }
    __syncthreads();
}

__device__ __forceinline__ void ssd_chunk_scan(const Ctx& cx_, int l) {
    const Ctx c = relaunder(cx_);
    bf16_t* stb = (bf16_t*)(c.ws + WS_STB); const float* cdec = (const float*)(c.ws + WS_CDEC);
    const int gt = c.bid * NTHREADS + c.tid;
    const int e8 = gt & 1023, bdh = gt >> 10;
    if (bdh >= BATCH * 16) return;
    const int head = bdh & 7, dir = (bdh >> 3) & 1, b = bdh >> 4;
    bf16_t* base = stb + (size_t)bdh * 32 * 8192 + (size_t)e8 * 8;
    float h[8] = {0.f, 0.f, 0.f, 0.f, 0.f, 0.f, 0.f, 0.f};
    for (int i0 = 0; i0 < 32; i0 += 8) {
        u32x4 v[8]; float dcy[8];
#pragma unroll
        for (int k = 0; k < 8; ++k) { const int slot = dir == 0 ? i0 + k : 31 - (i0 + k); v[k] = *(const u32x4*)(base + (size_t)slot * 8192);
            const int ck = dir == 0 ? slot : slot + 1; dcy[k] = cdec[((size_t)b * 33 + ck) * 16 + dir * 8 + head]; }
#pragma unroll
        for (int k = 0; k < 8; ++k) { const int slot = dir == 0 ? i0 + k : 31 - (i0 + k); float s[8]; unpack8(v[k], s);
#pragma unroll
            for (int e = 0; e < 8; ++e) h[e] = h[e] * dcy[k] + s[e];
            *(u32x4*)(base + (size_t)slot * 8192) = pack8(h); }
    }
}

__device__ __forceinline__ bool ssd_unit_n(int idx, int nblk, int round, SsdUnit& u, int& grp) {
    const int n2 = idx + nblk * round; if (n2 >= 528) return false; const int n = n2 >> 1; grp = n2 & 1;
    if (n < 256) { u.b = n >> 5; u.ck = 1 + (n & 31); u.t0 = NMETA + 128 * (u.ck - 1); u.ns = 8; } else { u.b = n - 256; u.ck = 0; u.t0 = 0; u.ns = 1; }
    return true;
}
__device__ __forceinline__ void ssd_outputs(const Ctx& cx_, int l, int first, int nblk) {
    const Ctx c = relaunder(cx_);
    const int tid = c.tid, lane = c.lane, wave = c.wave;
    const bf16_t* bc = (const bf16_t*)(c.ws + WS_BC); const bf16_t* xs = (const bf16_t*)(c.ws + WS_XS); const bf16_t* pz = (const bf16_t*)(c.ws + WS_PZ);
    const float* dt = (const float*)(c.ws + WS_DT); const float* al = (const float*)(c.ws + WS_DEC);
    const bf16_t* stb = (const bf16_t*)(c.ws + WS_STB); bf16_t* yb = (bf16_t*)(c.ws + WS_YB); float* ssqb = (float*)(c.ws + WS_SSQB);
    LAS unsigned char* Cimg = c.lds + SD_OFF_C; LAS unsigned char* Bimg = c.lds + SD_OFF_B; LAS unsigned char* Ximg = c.lds + SD_OFF_X;
    LAS unsigned char* HfT = c.lds + SD_OFF_HF; LAS unsigned char* HbT = c.lds + SD_OFF_HB;
    LAS unsigned char* Ms = c.lds + SD_OFF_M + wave * 4352; LAS float* sc = (LAS float*)(c.lds + SD_OFF_SC);
    for (int round = 0; round < 8; ++round) {
        SsdUnit u; int g0; if (!ssd_unit_n(c.bid - first, nblk, round, u, g0)) break;
        const size_t m0 = (size_t)row_of(u.b, u.t0); const int nks = u.ns == 1 ? 1 : 4; const bool active = wave < u.ns;
        float ssrow = 0.f;
        for (int g = g0; g <= g0; ++g) {
            __syncthreads();
            ssd_load_img(Cimg, SD_RS, bc, 512, m0, 256 + g * 128, 128, u.ns, tid);
            ssd_load_img(Bimg, SD_RS, bc, 512, m0, g * 128, 128, u.ns, tid);
            __syncthreads();
            f32x4 cb[8];
#pragma unroll
            for (int t = 0; t < 8; ++t) cb[t] = (f32x4){0.f, 0.f, 0.f, 0.f};
            if (active) {
#pragma unroll
                for (int ks = 0; ks < 4; ++ks) {
                    const bf16x8 cfr = frag_row(Cimg, SD_RS, 16 * wave, 32 * ks, lane);
#pragma unroll
                    for (int t = 0; t < 8; ++t) if (t < u.ns) cb[t] = __builtin_amdgcn_mfma_f32_16x16x32_bf16(frag_row(Bimg, SD_RS, 16 * t, 32 * ks, lane), cfr, cb[t], 0, 0, 0);
                }
            }
            for (int j = 0; j < 4; ++j) {
                const int head = g * 4 + j;
                __syncthreads();
                ssd_load_img(Ximg, SD_XRS, xs, 512, m0, head * 64, 64, u.ns, tid);
                {
                    const bf16_t* hf = u.ck >= 1 ? stb + ((((size_t)u.b * 2 + 0) * 8 + head) * 32 + (u.ck - 1)) * 8192 : nullptr;
                    const bf16_t* hb = u.ck <= 31 ? stb + ((((size_t)u.b * 2 + 1) * 8 + head) * 32 + u.ck) * 8192 : nullptr;
                    for (int i = tid; i < 64 * 16; i += NTHREADS) { const int p = i >> 4, cc = i & 15;
                        *(LAS u32x4*)(HfT + p * SD_RS + cc * 16) = hf ? *(const u32x4*)(hf + p * 128 + cc * 8) : (u32x4){0u, 0u, 0u, 0u};
                        *(LAS u32x4*)(HbT + p * SD_RS + cc * 16) = hb ? *(const u32x4*)(hb + p * 128 + cc * 8) : (u32x4){0u, 0u, 0u, 0u}; }
                }
                if (wave == 0) { float totf, totb; ssd_scalars(sc, dt, al, m0, head, u.ns, lane, totf, totb); }
                __syncthreads();
                if (active) {
                    const int ll = 16 * wave + (lane & 15); const float afl = sc[ll], ebl = sc[128 + ll];
#pragma unroll
                    for (int t = 0; t < 8; ++t) {
                        u32x2 w2 = (u32x2){0u, 0u};
                        if (t < u.ns) {
                            const int s0 = 16 * t + 4 * (lane >> 4);
                            const f32x4 afs = *(const LAS f32x4*)(sc + s0), ebs = *(const LAS f32x4*)(sc + 128 + s0), dfs = *(const LAS f32x4*)(sc + 256 + s0), dbs = *(const LAS f32x4*)(sc + 384 + s0);
                            float mv[4];
#pragma unroll
                            for (int r = 0; r < 4; ++r) { const int s = s0 + r; float wgt = 0.f; if (s <= ll) wgt += __expf(afl - afs[r]) * dfs[r]; if (s >= ll) wgt += __expf(ebs[r] - ebl) * dbs[r]; mv[r] = cb[t][r] * wgt; }
                            w2 = (u32x2){pk2(mv[0], mv[1]), pk2(mv[2], mv[3])};
                        }
                        if (t < 2 * nks) *(LAS u32x2*)(Ms + (lane & 15) * SD_RS + (16 * t + 4 * (lane >> 4)) * 2) = w2;
                    }
                    asm volatile("s_waitcnt lgkmcnt(0)" ::: "memory");
                    f32x4 ay[4], ahf[4], ahb[4];
#pragma unroll
                    for (int pt = 0; pt < 4; ++pt) { ay[pt] = (f32x4){0.f, 0.f, 0.f, 0.f}; ahf[pt] = ay[pt]; ahb[pt] = ay[pt]; }
                    for (int ks = 0; ks < nks; ++ks) {
                        const bf16x8 mf = frag_row(Ms, SD_RS, 0, 32 * ks, lane);
#pragma unroll
                        for (int pt = 0; pt < 4; ++pt) ay[pt] = __builtin_amdgcn_mfma_f32_16x16x32_bf16(mf, frag_tr(Ximg, SD_XRS, 32 * ks, 16 * pt, lane), ay[pt], 0, 0, 0);
                    }
#pragma unroll
                    for (int ks = 0; ks < 4; ++ks) {
                        const bf16x8 cfr = frag_row(Cimg, SD_RS, 16 * wave, 32 * ks, lane);
#pragma unroll
                        for (int pt = 0; pt < 4; ++pt) {
                            ahf[pt] = __builtin_amdgcn_mfma_f32_16x16x32_bf16(cfr, frag_row(HfT, SD_RS, 16 * pt, 32 * ks, lane), ahf[pt], 0, 0, 0);
                            ahb[pt] = __builtin_amdgcn_mfma_f32_16x16x32_bf16(cfr, frag_row(HbT, SD_RS, 16 * pt, 32 * ks, lane), ahb[pt], 0, 0, 0);
                        }
                    }
                    const int l0 = 16 * wave + 4 * (lane >> 4);
                    const f32x4 efv = *(const LAS f32x4*)(sc + 768 + l0), ebv = *(const LAS f32x4*)(sc + 896 + l0);
                    asm volatile("s_waitcnt lgkmcnt(0)" ::: "memory");
                    LAS float* ys = (LAS float*)Ms;
#pragma unroll
                    for (int pt = 0; pt < 4; ++pt)
#pragma unroll
                        for (int r = 0; r < 4; ++r) ys[(4 * (lane >> 4) + r) * 68 + 16 * pt + (lane & 15)] = ay[pt][r] + efv[r] * ahf[pt][r] + ebv[r] * ahb[pt][r];
                    asm volatile("s_waitcnt lgkmcnt(0)" ::: "memory");
                    const int rr = lane >> 2, p0 = 16 * (lane & 3); const size_t m = m0 + 16 * wave + rr;
                    const float dsk = c.in[I_SSDD][l * 8 + head];
                    float xv[16], zv[16];
                    { float t8[8]; unpack8(*(const LAS u32x4*)(Ximg + (16 * wave + rr) * SD_XRS + p0 * 2), t8);
#pragma unroll
                      for (int e = 0; e < 8; ++e) xv[e] = t8[e];
                      unpack8(*(const LAS u32x4*)(Ximg + (16 * wave + rr) * SD_XRS + p0 * 2 + 16), t8);
#pragma unroll
                      for (int e = 0; e < 8; ++e) xv[8 + e] = t8[e];
                      unpack8(*(const u32x4*)(pz + m * 512 + head * 64 + p0), t8);
#pragma unroll
                      for (int e = 0; e < 8; ++e) zv[e] = t8[e];
                      unpack8(*(const u32x4*)(pz + m * 512 + head * 64 + p0 + 8), t8);
#pragma unroll
                      for (int e = 0; e < 8; ++e) zv[8 + e] = t8[e]; }
                    float o[16];
#pragma unroll
                    for (int e4 = 0; e4 < 4; ++e4) { const f32x4 yv = *(const LAS f32x4*)(ys + rr * 68 + p0 + 4 * e4);
#pragma unroll
                        for (int e = 0; e < 4; ++e) { const float val = (yv[e] + dsk * xv[4 * e4 + e]) * siluf_(zv[4 * e4 + e]); o[4 * e4 + e] = val; ssrow += val * val; } }
                    u32x4 w0, w1; w0.x = pk2(o[0], o[1]); w0.y = pk2(o[2], o[3]); w0.z = pk2(o[4], o[5]); w0.w = pk2(o[6], o[7]); w1.x = pk2(o[8], o[9]); w1.y = pk2(o[10], o[11]); w1.z = pk2(o[12], o[13]); w1.w = pk2(o[14], o[15]);
                    *(u32x4*)(yb + m * 512 + head * 64 + p0) = w0; *(u32x4*)(yb + m * 512 + head * 64 + p0 + 8) = w1;
                }
            }
        }
        if (active) { ssrow += dpp_mov<0xB1>(ssrow); ssrow += dpp_mov<0x4E>(ssrow); if ((lane & 3) == 0) ssqb[(m0 + 16 * wave + (lane >> 2)) * 2 + g0] = ssrow; }
    }
    __syncthreads();
}
typedef short s16x4v __attribute__((ext_vector_type(4)));
constexpr int RC_NCH = LEN / 16;
constexpr int RC_NP = 5;
constexpr int RC_ROUNDS = (RC_NCH + RC_NP - 1) / RC_NP;
constexpr int RC_S64 = 144;
constexpr int RC_S16 = 40;
constexpr int RC_AT = 0, RC_RT = 2304, RC_BH = 4608, RC_KH = 6912, RC_T = 9216, RC_AAK = 9856, RC_ARB = 10496, RC_ARK = 11136, RC_VT = 11776, RC_P16 = 12416, RC_SLOT = 12800;
constexpr int RC_SCR0 = 2 * RC_NP * RC_SLOT;
constexpr int RC_SCR = 1280;
static_assert(RC_SCR0 + RC_NP * RC_SCR <= 147456 - 512, "rwkv chunk LDS");
__device__ __forceinline__ f32x4 mm16(s16x4v a, s16x4v b, f32x4 c, int, int, int) { return __builtin_amdgcn_mfma_f32_16x16x32_bf16((bf16x8){a[0], a[1], a[2], a[3], 0, 0, 0, 0}, (bf16x8){b[0], b[1], b[2], b[3], 0, 0, 0, 0}, c, 0, 0, 0); }
__device__ __forceinline__ s16x4v mfma16_frag(const LAS unsigned char* mat, int row, int q) { return *(const LAS s16x4v*)(mat + row * RC_S16 + q * 8); }

constexpr int RC64_NP = 4, RC64_ROUNDS = (RC_NCH + RC64_NP - 1) / RC64_NP;
constexpr int RC64_V = 11776, RC64_P16 = 14080, RC64_SLOT = 14336;
constexpr int RC64_SCR0 = 2 * RC64_NP * RC64_SLOT;
static_assert(RC64_SCR0 + RC64_NP * RC_SCR <= 147456 - 512, "rwkv64 LDS");
__device__ __forceinline__ void rwkv_chunked64(const Ctx& cx_, int l) {
    const Ctx c = relaunder(cx_);


    const int bid = c.bid, dir = bid & 1, head = (bid >> 1) & 3, b = bid >> 3;
    const int lane = c.lane, wave = c.wave;
    const bf16_t* rk = (const bf16_t*)(c.dout + DO_RKVP) + head * 64; const bf16_t* l2 = (const bf16_t*)(c.ws + WS_L2O) + dir * 256 + head * 64;
    bf16_t* yo = (bf16_t*)(c.ws + WS_YRW) + (size_t)dir * MP * 256 + head * 64 + 16 * (wave & 3);
    auto tok = [&](int s) -> size_t { const int t = s + dir * (LEN - 1 - 2 * s); return (size_t)row_of(b, t); };
    const int q = lane >> 4, li = lane & 15;
    u32x4 Rr[2], Kr[2], KKr[2], DLr[2], ASr[2], Vr[2];
    auto load_raw = [&](int ch) {
        const size_t m = tok(16 * ch + li); const int k0 = 16 * q;
#pragma unroll
        for (int h = 0; h < 2; ++h) { Rr[h] = *(const u32x4*)(rk + m * 1024 + k0 + 8 * h); Kr[h] = *(const u32x4*)(rk + m * 1024 + 256 + k0 + 8 * h); KKr[h] = *(const u32x4*)(rk + m * 1024 + 768 + k0 + 8 * h);
            DLr[h] = *(const u32x4*)(l2 + m * 1280 + k0 + 8 * h); ASr[h] = *(const u32x4*)(l2 + m * 1280 + 512 + k0 + 8 * h); Vr[h] = *(const u32x4*)(rk + m * 1024 + 512 + k0 + 8 * h); }
    };
    float kaall[16];
#pragma unroll
    for (int e = 0; e < 16; ++e) kaall[e] = c.in[I_KA][(size_t)l * 256 + head * 64 + 16 * q + e];
    auto produce = [&](int slot) {
        LAS unsigned char* sb = c.lds + slot * RC64_SLOT; LAS float* Aab = (LAS float*)(c.lds + RC64_SCR0 + (wave - 4) * RC_SCR);
        LAS unsigned char* Bh = sb + RC_BH; LAS unsigned char* Kh = sb + RC_KH;
        *(LAS u32x4*)(sb + RC64_V + li * RC_S64 + (16 * q) * 2) = Vr[0]; *(LAS u32x4*)(sb + RC64_V + li * RC_S64 + (16 * q + 8) * 2) = Vr[1];
        const int k0 = 16 * q;
#pragma unroll
        for (int h = 0; h < 2; ++h) {
            float r_[8], k_[8], kk_[8], dl_[8], as_[8], cs_[8]; unpack8(Rr[h], r_); unpack8(Kr[h], k_); unpack8(KKr[h], kk_); unpack8(DLr[h], dl_); unpack8(ASr[h], as_);
            const float* ka = kaall + 8 * h;
            float at_[8], rt_[8], bh_[8], kh_[8], p_[8];
#pragma unroll
            for (int e = 0; e < 8; ++e) {
                float x = dl_[e];
                x += dpp_mov<0x111>(x); x += dpp_mov<0x112>(x); x += dpp_mov<0x114>(x); x += dpp_mov<0x118>(x);
                cs_[e] = x;
            }
#pragma unroll
            for (int e = 0; e < 8; ++e) {
                const float P = __expf(cs_[e]), Pm = __expf(cs_[e] - dl_[e]), iP = __expf(-cs_[e]);
                at_[e] = -kk_[e] * Pm; rt_[e] = r_[e] * P; bh_[e] = kk_[e] * as_[e] * iP; kh_[e] = k_[e] * (1.f + (as_[e] - 1.f) * ka[e]) * iP; p_[e] = P;
            }
            *(LAS u32x4*)(sb + RC_AT + li * RC_S64 + (k0 + 8 * h) * 2) = pack8(at_); *(LAS u32x4*)(sb + RC_RT + li * RC_S64 + (k0 + 8 * h) * 2) = pack8(rt_);
            *(LAS u32x4*)(Bh + li * RC_S64 + (k0 + 8 * h) * 2) = pack8(bh_); *(LAS u32x4*)(Kh + li * RC_S64 + (k0 + 8 * h) * 2) = pack8(kh_);
            if (li == 15) { *(LAS f32x4*)(sb + RC64_P16 + (k0 + 8 * h) * 4) = (f32x4){p_[0], p_[1], p_[2], p_[3]}; *(LAS f32x4*)(sb + RC64_P16 + (k0 + 8 * h + 4) * 4) = (f32x4){p_[4], p_[5], p_[6], p_[7]}; }
        }
        asm volatile("s_waitcnt lgkmcnt(0)" ::: "memory");
        f32x4 ab = (f32x4){0.f, 0.f, 0.f, 0.f}, ak = ab, rb = ab, rkm = ab;
#pragma unroll
        for (int ks = 0; ks < 2; ++ks) {
            const bf16x8 fa = *(const LAS bf16x8*)(sb + RC_AT + li * RC_S64 + (32 * ks + 8 * q) * 2), fr = *(const LAS bf16x8*)(sb + RC_RT + li * RC_S64 + (32 * ks + 8 * q) * 2);
            const bf16x8 fb = *(const LAS bf16x8*)(Bh + li * RC_S64 + (32 * ks + 8 * q) * 2), fk = *(const LAS bf16x8*)(Kh + li * RC_S64 + (32 * ks + 8 * q) * 2);
            ab = __builtin_amdgcn_mfma_f32_16x16x32_bf16(fa, fb, ab, 0, 0, 0); ak = __builtin_amdgcn_mfma_f32_16x16x32_bf16(fa, fk, ak, 0, 0, 0);
            rb = __builtin_amdgcn_mfma_f32_16x16x32_bf16(fr, fb, rb, 0, 0, 0); rkm = __builtin_amdgcn_mfma_f32_16x16x32_bf16(fr, fk, rkm, 0, 0, 0);
        }
#pragma unroll
        for (int r = 0; r < 4; ++r) {
            const int t = 4 * q + r, s = li;
            Aab[t * 20 + s] = s < t ? ab[r] : 0.f;
            *(LAS bf16_t*)(sb + RC_AAK + t * RC_S16 + s * 2) = (bf16_t)f2bf(s < t ? ak[r] : 0.f);
            *(LAS bf16_t*)(sb + RC_ARB + t * RC_S16 + s * 2) = (bf16_t)f2bf(s <= t ? rb[r] : 0.f);
            *(LAS bf16_t*)(sb + RC_ARK + t * RC_S16 + s * 2) = (bf16_t)f2bf(s <= t ? rkm[r] : 0.f);
        }
        asm volatile("s_waitcnt lgkmcnt(0)" ::: "memory");
        float tc[16];
#pragma unroll
        for (int t = 0; t < 16; ++t) {
            float acc = (t == li) ? 1.f : 0.f;
            f32x4 a0 = *(const LAS f32x4*)(Aab + t * 20), a1 = *(const LAS f32x4*)(Aab + t * 20 + 4), a2 = *(const LAS f32x4*)(Aab + t * 20 + 8), a3 = *(const LAS f32x4*)(Aab + t * 20 + 12);
            const float av[16] = {a0.x, a0.y, a0.z, a0.w, a1.x, a1.y, a1.z, a1.w, a2.x, a2.y, a2.z, a2.w, a3.x, a3.y, a3.z, a3.w};
            float a1_ = 0.f, a2_ = 0.f, a3_ = 0.f;
#pragma unroll
            for (int s = 0; s < t; ++s) { const float pr_ = av[s] * tc[s]; if ((s & 3) == 0) acc += pr_; else if ((s & 3) == 1) a1_ += pr_; else if ((s & 3) == 2) a2_ += pr_; else a3_ += pr_; }
            tc[t] = (acc + a1_) + (a2_ + a3_);
        }
        if (q == 0) {
#pragma unroll
            for (int t = 0; t < 16; ++t) *(LAS bf16_t*)(sb + RC_T + t * RC_S16 + li * 2) = (bf16_t)f2bf(tc[t]);
        }
    };
    if (wave >= 4 && wave - 4 < RC64_NP) { const int ch0 = wave - 4; load_raw(ch0); produce(wave - 4); load_raw(ch0 + RC64_NP); }
    __syncthreads();
    f32x4 S[4]; bf16x8 sop[2];
#pragma unroll
    for (int kt = 0; kt < 4; ++kt) S[kt] = (f32x4){0.f, 0.f, 0.f, 0.f};
    sop[0] = (bf16x8){0, 0, 0, 0, 0, 0, 0, 0}; sop[1] = sop[0];
    int sbase = 0;
    auto consume = [&](const int i, const int ch) {
                const LAS unsigned char* sb = c.lds + (sbase + i) * RC64_SLOT;
        const s16x4v vt = lds_tr(sb + RC64_V + (4 * q + (li >> 2)) * RC_S64 + (16 * (wave & 3) + 4 * (li & 3)) * 2);
        f32x4 aw = mm16(mfma16_frag(sb + RC_AAK, li, q), vt, (f32x4){0.f, 0.f, 0.f, 0.f}, 0, 0, 0);
        f32x4 ay = mm16(mfma16_frag(sb + RC_ARK, li, q), vt, (f32x4){0.f, 0.f, 0.f, 0.f}, 0, 0, 0);
#pragma unroll
        for (int ks = 0; ks < 2; ++ks) {
            const s16x4v alo = *(const LAS s16x4v*)(sb + RC_AT + li * RC_S64 + (32 * ks + 4 * q) * 2), ahi = *(const LAS s16x4v*)(sb + RC_AT + li * RC_S64 + (32 * ks + 16 + 4 * q) * 2);
            const s16x4v rlo = *(const LAS s16x4v*)(sb + RC_RT + li * RC_S64 + (32 * ks + 4 * q) * 2), rhi = *(const LAS s16x4v*)(sb + RC_RT + li * RC_S64 + (32 * ks + 16 + 4 * q) * 2);
            aw = __builtin_amdgcn_mfma_f32_16x16x32_bf16((bf16x8){alo[0], alo[1], alo[2], alo[3], ahi[0], ahi[1], ahi[2], ahi[3]}, sop[ks], aw, 0, 0, 0);
            ay = __builtin_amdgcn_mfma_f32_16x16x32_bf16((bf16x8){rlo[0], rlo[1], rlo[2], rlo[3], rhi[0], rhi[1], rhi[2], rhi[3]}, sop[ks], ay, 0, 0, 0);
        }
        const u32x2 wb2 = (u32x2){pk2(aw[0], aw[1]), pk2(aw[2], aw[3])};
        const f32x4 au = mm16(mfma16_frag(sb + RC_T, li, q), __builtin_bit_cast(s16x4v, wb2), (f32x4){0.f, 0.f, 0.f, 0.f}, 0, 0, 0);
        const u32x2 ub2 = (u32x2){pk2(au[0], au[1]), pk2(au[2], au[3])}; const s16x4v ub = __builtin_bit_cast(s16x4v, ub2);
        ay = mm16(mfma16_frag(sb + RC_ARB, li, q), ub, ay, 0, 0, 0);
#pragma unroll
        for (int kt = 0; kt < 4; ++kt) {
            const f32x4 p16 = *(const LAS f32x4*)(sb + RC64_P16 + (16 * kt + 4 * q) * 4);
            const int troff = (4 * q + (li >> 2)) * RC_S64 + (16 * kt + 4 * (li & 3)) * 2;
            f32x4 sv = S[kt];
            sv = mm16(lds_tr(sb + RC_KH + troff), vt, sv, 0, 0, 0);
            sv = mm16(lds_tr(sb + RC_BH + troff), ub, sv, 0, 0, 0);
            sv = sv * p16;
            S[kt] = sv;
        }
#pragma unroll
        for (int ks = 0; ks < 2; ++ks) {
            const u32x4 w = (u32x4){pk2(S[2 * ks][0], S[2 * ks][1]), pk2(S[2 * ks][2], S[2 * ks][3]), pk2(S[2 * ks + 1][0], S[2 * ks + 1][1]), pk2(S[2 * ks + 1][2], S[2 * ks + 1][3])};
            sop[ks] = __builtin_bit_cast(bf16x8, w);
        }
#pragma unroll
        for (int r = 0; r < 4; ++r) yo[tok(16 * ch + 4 * q + r) * 256 + li] = (bf16_t)f2bf(ay[r]);
    };
    for (int rd = 0; rd < RC64_ROUNDS; ++rd) {
        if (wave < 4) {
            sbase = (rd & 1) * RC64_NP;
            if (rd < RC64_ROUNDS - 1) {
#pragma unroll
                for (int i = 0; i < RC64_NP; ++i) consume(i, RC64_NP * rd + i);
            } else {
                for (int i = 0; i < RC64_NP; ++i) { const int ch = RC64_NP * rd + i; if (ch >= RC_NCH) break; consume(i, ch); }
            }
        } else if (wave - 4 < RC64_NP) {
            const int chn = RC64_NP * (rd + 1) + (wave - 4);
            if (chn < RC_NCH) { produce(((rd + 1) & 1) * RC64_NP + (wave - 4)); if (chn + RC64_NP < RC_NCH) load_raw(chn + RC64_NP); }
        }
        __syncthreads();
    }
}
__device__ __forceinline__ void rwkv_post(const Ctx& cx_, int l) {
    const Ctx c = relaunder(cx_);
    const int gw = c.bid * NWAVES + c.wave, NGW = c.G * NWAVES, lane = c.lane, c0 = 4 * lane;
    const bf16_t* __restrict__ y0 = (const bf16_t*)(c.ws + WS_YRW); const bf16_t* __restrict__ y1 = y0 + (size_t)MP * 256;
    const bf16_t* __restrict__ rk = (const bf16_t*)(c.dout + DO_RKVP); const bf16_t* __restrict__ l2 = (const bf16_t*)(c.ws + WS_L2O); bf16_t* __restrict__ yc = (bf16_t*)(c.ws + WS_YC);
    float lw[4], lb[4], rkw[4];
#pragma unroll
    for (int e = 0; e < 4; ++e) { lw[e] = c.in[I_LNW][(size_t)l * 256 + c0 + e]; lb[e] = c.in[I_LNB][(size_t)l * 256 + c0 + e]; rkw[e] = c.in[I_RK][(size_t)l * 256 + c0 + e]; }
#pragma unroll 2
    for (int m = gw; m < M_ROWS; m += NGW) {
        const u32x2 a = *(const u32x2*)(y0 + (size_t)m * 256 + c0), bq = *(const u32x2*)(y1 + (size_t)m * 256 + c0);
        const u32x2 rr = *(const u32x2*)(rk + (size_t)m * 1024 + c0), kk = *(const u32x2*)(rk + (size_t)m * 1024 + 256 + c0), vv = *(const u32x2*)(rk + (size_t)m * 1024 + 512 + c0);
        const u32x2 gg = *(const u32x2*)(l2 + (size_t)m * 1280 + 1024 + c0);
        float y[4] = {bflo(a.x) + bflo(bq.x), bfhi(a.x) + bfhi(bq.x), bflo(a.y) + bflo(bq.y), bfhi(a.y) + bfhi(bq.y)};
        const float r[4] = {bflo(rr.x), bfhi(rr.x), bflo(rr.y), bfhi(rr.y)}, k[4] = {bflo(kk.x), bfhi(kk.x), bflo(kk.y), bfhi(kk.y)};
        const float v[4] = {bflo(vv.x), bfhi(vv.x), bflo(vv.y), bfhi(vv.y)}, g[4] = {bflo(gg.x), bfhi(gg.x), bflo(gg.y), bfhi(gg.y)};
        const float mean = sum16((y[0] + y[1]) + (y[2] + y[3])) * (1.f / 64.f);
        float q = 0.f, bo = 0.f;
#pragma unroll
        for (int e = 0; e < 4; ++e) { y[e] -= mean; q += y[e] * y[e]; bo += r[e] * k[e] * rkw[e]; }
        q = sum16(q) * (1.f / 64.f); bo = sum16(bo);
        const float rs = __builtin_amdgcn_rsqf(q + 64e-5f);
        float o[4];
#pragma unroll
        for (int e = 0; e < 4; ++e) o[e] = (y[e] * rs * lw[e] + lb[e] + bo * v[e]) * g[e];
        *(u32x2*)(yc + (size_t)m * 256 + c0) = (u32x2){pk2(o[0], o[1]), pk2(o[2], o[3])};
    }
}
__device__ __forceinline__ void final_phase(const Ctx& cx_, float* out) {
    const Ctx c = relaunder(cx_);
    const int gw = c.bid * NWAVES + c.wave, NGW = c.G * NWAVES, lane = c.lane;
    const bf16_t* H = c.H(); const f32x4* fw = (const f32x4*)c.in[I_FNW];
#pragma unroll 2
    for (int r = gw; r < BATCH * SEQ; r += NGW) {
        const size_t m = (size_t)r;
        const u32x2* hp = (const u32x2*)(H + m * DM);
        float v[4][4], ss = 0.f;
#pragma unroll
        for (int i = 0; i < 4; ++i) { const u32x2 w = hp[lane + 64 * i]; v[i][0] = bflo(w.x); v[i][1] = bfhi(w.x); v[i][2] = bflo(w.y); v[i][3] = bfhi(w.y); ss += (v[i][0] * v[i][0] + v[i][1] * v[i][1]) + (v[i][2] * v[i][2] + v[i][3] * v[i][3]); }
        ss = wave_sum(ss); const float s = __builtin_amdgcn_rsqf(ss * (1.0f / DM) + EPS);
        f32x4* op = (f32x4*)(out + (size_t)r * DM);
#pragma unroll
        for (int i = 0; i < 4; ++i) { const f32x4 w = fw[lane + 64 * i]; op[lane + 64 * i] = (f32x4){v[i][0] * s * w.x, v[i][1] * s * w.y, v[i][2] * s * w.z, v[i][3] * s * w.w}; }
    }
}

constexpr int LDS_BYTES = 147456;
#ifndef MIXDIR
#define MIXDIR 0
#define MIXLAYER 0
#endif
#ifndef PHMASK
#define PHMASK 0xFFFFF
#endif
__global__ void __launch_bounds__(NTHREADS, 2) mega_fwd(Params p) {
    extern __shared__ __attribute__((aligned(16))) unsigned char lds_raw[];
    cg::grid_group grid = cg::this_grid();
    Ctx c0_; c0_.in = p.in; c0_.ws = p.ws; c0_.dout = (unsigned char*)p.out; c0_.lds = (LAS unsigned char*)lds_raw;
    c0_.wave = __builtin_amdgcn_readfirstlane((int)threadIdx.x >> 6); c0_.tid = opaque_tid(c0_.wave); c0_.lane = c0_.tid & 63; c0_.G = gridDim.x; c0_.bid = blockIdx.x;
    Ctx c = c0_;
    const int G = c.G, bid = c.bid;
#ifdef PROF_A
#ifndef PROF_SHIFT
#define PROF_SHIFT 1.0f
#endif
#define PROF_PTR ((unsigned long long*)(c.ws + WS_DEC + (size_t)MP * 64))
    if (blockIdx.x == 0 && threadIdx.x == 0) { for (int k = 0; k < 15; ++k) PROF_PTR[k] = 0; PROF_PTR[15] = __builtin_amdgcn_s_memrealtime(); }
#define STAMP(k) do { if (blockIdx.x == 0 && threadIdx.x == 0) { const unsigned long long t_ = __builtin_amdgcn_s_memrealtime(); PROF_PTR[k] += t_ - PROF_PTR[15]; PROF_PTR[15] = t_; } } while (0)
#else
#define STAMP(k) do { } while (0)
#endif
    unsigned* barw = (unsigned*)(c.ws + WS_BAR);
    volatile LAS unsigned* bst = (volatile LAS unsigned*)(c.lds + LDS_BYTES - 64);
    if (bid == 0) for (int i = threadIdx.x; i < XCD_BAR_WORDS + 1024; i += NTHREADS) barw[i < XCD_BAR_WORDS ? i : 4096 + (i - XCD_BAR_WORDS)] = 0u;
    if (threadIdx.x < 2) bst[threadIdx.x] = 0u;
    __syncthreads();
    if (PHMASK & 1) phase0(c);
    grid.sync(); STAMP(0);
    const XcdBarrier xbar = xcd_barrier_post(barw, bst);
#define GRID_BAR() do { xcd_barrier(xbar, c0_.wave); c = relaunder(c0_); } while (0)
#pragma unroll 1
    for (int l = 0; l < DEPTH; ++l) {
#define wb (c.wb(l))
        if (PHMASK & 2) dt_job(c, l);
        if (PHMASK & 4) { SchedPlain S{c.H(), wb + WB_IN, DM, DM, DM, MP / 256, 11, G, bid, 0};
          EpiInProj E{c.ssq(), (bf16_t*)(c.ws + WS_UH), (bf16_t*)(c.ws + WS_PZ), (bf16_t*)(c.ws + WS_PXBC), (bf16_t*)(c.ws + WS_PRKVX)};
          pg8::gemm_phase(c.lds, c.wave, S, E); }
        GRID_BAR(); STAMP(1);
        if (PHMASK & 8) { SchedS5 S{(const bf16_t*)(c.ws + WS_UH), wb + WB_SX, 256, G, bid}; EpiS5X E{(float*)(c.ws + WS_X)}; pg8::gemm_phase(c.lds, c.wave, S, E); }
        if (PHMASK & 16) rwkv_prep(c, l);
        if (PHMASK & 32) ssd_prep(c, l);
        GRID_BAR(); STAMP(2);
        if (PHMASK & 64) s5_scan(c, l);
        if (PHMASK & 4096) ssd_states(c, l);
        if (PHMASK & 128) { SchedPlain S{(const bf16_t*)(c.ws + WS_L1IN), wb + WB_L1, 512, 512, 512, MP / 256, 2, G, bid, 0}; EpiL1 E{(bf16_t*)(c.ws + WS_L1O)}; pg8::gemm_phase(c.lds, c.wave, S, E); }
        GRID_BAR(); STAMP(3);
        ssd_chunk_scan(c, l);
        if (PHMASK & 256) { SchedL2 S{(const bf16_t*)(c.ws + WS_L1O), wb + WB_L2, G, bid, MP / 256, 0}; EpiL2 E{(bf16_t*)(c.ws + WS_L2O), c.in[I_W0] + (size_t)l * 512, c.in[I_A0] + (size_t)l * 512}; pg8::gemm_phase(c.lds, c.wave, S, E); }
        if (PHMASK & 512) { SchedS5 S{(const bf16_t*)(c.ws + WS_UH), wb + WB_SY, 512, G, bid}; EpiS5Y E{(bf16_t*)(c.ws + WS_YAPRE)}; pg8::gemm_phase(c.lds, c.wave, S, E); }
        GRID_BAR(); STAMP(4);
        if (bid < 64) { if (PHMASK & 1024) rwkv_chunked64(c, l); }
        else { if (PHMASK & 2048) ssd_outputs(c, l, 64, G - 64);
  if (PHMASK & 16384) { SchedPlain S{(const bf16_t*)(c.ws + WS_YAPRE), wb + WB_GLU, 256, 256, 256, MP / 256, 2, G - 64, bid - 64, 0}; EpiGLU E{(bf16_t*)(c.ws + WS_YA), c.in[I_GLUB] + (size_t)l * 512}; pg8::gemm_phase(c.lds, c.wave, S, E); } }
        STAMP(5);
        GRID_BAR(); STAMP(6);
        if (PHMASK & 8192) rwkv_post(c, l);
        GRID_BAR(); STAMP(7);
        if (PHMASK & 32768) { SchedProj S{c.H(), wb + WB_G, wb + WB_P, (const bf16_t*)(c.ws + WS_YA), (const bf16_t*)(c.ws + WS_YB), (const bf16_t*)(c.ws + WS_YC), (l < DEPTH - 1 ? MP / 256 : BATCH * SEQ / 256), G, bid, 0};
          EpiProj E{c.ssq(), (const float*)(c.ws + WS_SSQB), c.ws + WS_PARK + (size_t)bid * 393216, (bf16_t*)(c.dout + DO_MERGED), opaque_tid(c.wave)}; pg8::gemm_phase(c.lds, c.wave, S, E); }
        GRID_BAR(); STAMP(8);
        if (PHMASK & 65536) { SchedPlain S{(const bf16_t*)(c.dout + DO_MERGED), wb + WB_O, DM, DM, DM, (l < DEPTH - 1 ? MP / 256 : BATCH * SEQ / 256), 4, G, bid, 0}; EpiResid E{c.H(), c.ssq()}; pg8::gemm_phase(c.lds, c.wave, S, E); }
        GRID_BAR(); STAMP(9);
        if (PHMASK & 131072) { SchedPlain S{c.H(), wb + WB_1, DM, DM, DM, (l < DEPTH - 1 ? MP / 256 : BATCH * SEQ / 256), 16, G, bid, 0}; EpiUp E{c.ssq(), (bf16_t*)(c.ws + WS_ACT)}; pg8::gemm_phase(c.lds, c.wave, S, E); }
        GRID_BAR(); STAMP(10);
        if (PHMASK & 262144) { SchedPlain S{(const bf16_t*)(c.ws + WS_ACT), wb + WB_2, DFF, DFF, DFF, (l < DEPTH - 1 ? MP / 256 : BATCH * SEQ / 256), 4, G, bid, 0}; EpiResid E{c.H(), c.ssq()}; pg8::gemm_phase(c.lds, c.wave, S, E); }
        GRID_BAR(); STAMP(11);
    }
    if (PHMASK & 524288) final_phase(c, p.out);
#ifdef PROF_A
    GRID_BAR(); STAMP(12);
    if (blockIdx.x == 0) {
        __syncthreads();
        float va = (float)(__hip_atomic_load(&PROF_PTR[PROF_A], __ATOMIC_RELAXED, __HIP_MEMORY_SCOPE_AGENT)) * 0.01f, vb = (float)(__hip_atomic_load(&PROF_PTR[PROF_B], __ATOMIC_RELAXED, __HIP_MEMORY_SCOPE_AGENT)) * 0.01f;
        va = exp2f(rintf(log2f(va * PROF_SHIFT) * 2.f) * 0.5f); vb = exp2f(rintf(log2f(vb * PROF_SHIFT) * 2.f) * 0.5f);
        for (int i = threadIdx.x; i < (1 << 20); i += NTHREADS) p.out[1 + i] = vb;
        if (threadIdx.x == 0) p.out[0] = 100.f * va;
    }
#endif
}

extern "C" void kernel_launch(void* const* d_in, const int* in_sizes, int n_in, void* d_out, int out_size, void* d_ws, size_t ws_size, hipStream_t stream) {
    static int grid = 0;
    if (grid == 0) {
        int dev = 0, cus = 0, per_cu = 0;
        if (n_in != N_INPUTS || out_size != BATCH * SEQ * DM || ws_size < WS_END) { fprintf(stderr, "kernel_launch: unexpected shapes (n_in %d out %d ws %zu)\n", n_in, out_size, ws_size); grid = -1; return; }
        (void)hipGetDevice(&dev); (void)hipDeviceGetAttribute(&cus, hipDeviceAttributeMultiprocessorCount, dev);
        (void)hipFuncSetAttribute((const void*)mega_fwd, hipFuncAttributeMaxDynamicSharedMemorySize, LDS_BYTES);
        (void)hipOccupancyMaxActiveBlocksPerMultiprocessor(&per_cu, (const void*)mega_fwd, NTHREADS, LDS_BYTES);
        if (per_cu < 1) { fprintf(stderr, "kernel_launch: occupancy query says %d blocks per CU\n", per_cu); per_cu = 1; }
        grid = cus * 1;
        if (grid != 256) fprintf(stderr, "kernel_launch: %d CUs (the scan phases are laid out for 256 workgroups)\n", grid);
    }
    if (grid < 0) return;
    Params p{};
    for (int i = 0; i < N_INPUTS; ++i) p.in[i] = (const float*)d_in[i];
    p.out = (float*)d_out; p.ws = (unsigned char*)d_ws; p.ph_lo = 0; p.ph_hi = 0;
    void* args[] = {&p};
    hipError_t e = hipLaunchCooperativeKernel((const void*)mega_fwd, dim3(grid), dim3(NTHREADS), args, LDS_BYTES, stream);
    if (e != hipSuccess) fprintf(stderr, "cooperative launch failed: %s (grid %d)\n", hipGetErrorString(e), grid);
}
```

```cpp
#include <hip/hip_runtime.h>
#include <hip/hip_cooperative_groups.h>
#include <cstdio>
#include <cstdint>
namespace cg = cooperative_groups;

#define LAS __attribute__((address_space(3)))
typedef unsigned short bf16_t;
typedef short bf16x8 __attribute__((ext_vector_type(8)));
typedef float f32x4 __attribute__((ext_vector_type(4)));
typedef unsigned u32x4 __attribute__((ext_vector_type(4)));
typedef unsigned u32x2 __attribute__((ext_vector_type(2)));

constexpr int BATCH = 8, SEQ = 4096, NMETA = 16, LEN = SEQ + NMETA, DM = 1024, DFF = 4096, DEPTH = 2;
constexpr int M_ROWS = BATCH * LEN;
constexpr int MP = 33024;
constexpr int N_IN = 5896;
constexpr int NCH16 = LEN / 16;
constexpr int S5ROWS = BATCH * NCH16;
constexpr int S5RP = 2304;
constexpr float EPS = 1e-6f;
constexpr int NTHREADS = 512, NWAVES = 8;

constexpr size_t QB = (size_t)MP * 256 * 2;
constexpr size_t WB_IN = 0;
constexpr size_t WB_G = WB_IN + (size_t)2816 * 1024;
constexpr size_t WB_P = WB_G + (size_t)3072 * 1024;
constexpr size_t WB_O = WB_P + (size_t)1024 * 1024;
constexpr size_t WB_1 = WB_O + (size_t)1024 * 1024;
constexpr size_t WB_2 = WB_1 + (size_t)4096 * 1024;
constexpr size_t WB_GLU = WB_2 + (size_t)1024 * 4096;
constexpr size_t WB_L1 = WB_GLU + (size_t)512 * 256;
constexpr size_t WB_L2 = WB_L1 + (size_t)512 * 512;
constexpr size_t WB_SX = WB_L2 + (size_t)1280 * 256;
constexpr size_t WB_SY = WB_SX + (size_t)16 * 256 * 256;
constexpr size_t WB_ELEMS = WB_SY + (size_t)16 * 256 * 512;
constexpr size_t WB_BYTES = WB_ELEMS * 2;
static_assert(WB_BYTES <= 5 * QB / 2, "weight block fits 2.5 Q");

constexpr size_t WS_H = 0;
constexpr size_t WS_WB0 = 4 * QB;
constexpr size_t WS_SMALL = 13 * QB / 2;
constexpr size_t WS_SSQ = WS_SMALL;
constexpr size_t WS_DT = WS_SSQ + (size_t)MP * 16 * 4;
constexpr size_t WS_DEC = WS_DT + (size_t)MP * 16 * 4;
static_assert(WS_DEC + (size_t)MP * 16 * 4 <= 7 * QB, "small region");
constexpr size_t WS_MIX = 7 * QB;
constexpr size_t WS_PXBC = WS_MIX;
constexpr size_t WS_YSSD = WS_MIX;
constexpr size_t WS_PARK = WS_MIX;
constexpr size_t WS_ACT = WS_MIX;
constexpr size_t WS_PRKVX = WS_MIX + 4 * QB;
constexpr size_t WS_L2O = WS_MIX + 4 * QB;
constexpr size_t WS_PZ = WS_MIX + 9 * QB;
constexpr size_t WS_UH = WS_MIX + 11 * QB;
constexpr size_t WS_X = WS_MIX + 53 * QB / 4;
constexpr size_t WS_YRW = WS_X;
constexpr size_t WS_L1IN = WS_MIX + 31 * QB / 2;
constexpr size_t WS_YAPRE = WS_L1IN;
constexpr size_t WS_L1O = WS_MIX + 35 * QB / 2;
constexpr size_t WS_YB = WS_L1O;
constexpr size_t WS_BC = WS_MIX + 39 * QB / 2;
constexpr size_t WS_YA = WS_MIX + 33 * QB / 2;
constexpr size_t WS_YC = WS_BC + QB;
constexpr size_t WS_XS = WS_MIX + 43 * QB / 2;
constexpr size_t WS_END = WS_XS + 2 * QB;
static_assert(WS_END <= (size_t)512 << 20, "workspace map fits 512 MiB");
static_assert((size_t)16 * S5RP * 512 * 2 <= 9 * QB / 4 && (size_t)16 * S5RP * 256 * 4 <= 9 * QB / 4, "S5 buffers fit their slots");

constexpr size_t DO_RKVP = 0;
constexpr size_t DO_MERGED = 0;
constexpr size_t DO_WB1 = 4 * QB;
static_assert(DO_WB1 + WB_BYTES <= (size_t)BATCH * SEQ * DM * 4, "d_out scratch map");

__device__ __forceinline__ unsigned f2bf(float f) { unsigned u = __builtin_bit_cast(unsigned, f); return (u + 0x7fffu + ((u >> 16) & 1u)) >> 16; }
typedef float f32x2_t_ __attribute__((ext_vector_type(2))); typedef __bf16 bf16x2_t_ __attribute__((ext_vector_type(2)));
__device__ __forceinline__ unsigned pk2(float lo, float hi) { const f32x2_t_ v = {lo, hi}; const bf16x2_t_ b = __builtin_convertvector(v, bf16x2_t_); return __builtin_bit_cast(unsigned, b); }
__device__ __forceinline__ float bflo(unsigned w) { return __builtin_bit_cast(float, w << 16); }
__device__ __forceinline__ float bfhi(unsigned w) { return __builtin_bit_cast(float, w & 0xffff0000u); }
__device__ __forceinline__ float bf1(bf16_t v) { return __builtin_bit_cast(float, (unsigned)v << 16); }
__device__ __forceinline__ float sigmoidf_(float x) { return 1.0f / (1.0f + __expf(-x)); }
__device__ __forceinline__ float siluf_(float x) { return x / (1.0f + __expf(-x)); }
__device__ __forceinline__ float tanhf_(float x) { x = fminf(fmaxf(x, -15.f), 15.f); const float t = __expf(2.f * x); return (t - 1.f) / (t + 1.f); }
__device__ __forceinline__ float softplusf_(float x) { return fmaxf(x, 0.f) + __logf(1.0f + __expf(-fabsf(x))); }
__device__ __forceinline__ float geluf_(float x) { const float u = 0.7978845608028654f * (x + 0.044715f * x * x * x); return 0.5f * x * (1.f + tanhf_(u)); }
__device__ __forceinline__ float wave_sum(float v) {
#pragma unroll
    for (int o = 1; o < 64; o <<= 1) v += __shfl_xor(v, o);
    return v;
}
__device__ __forceinline__ float sum16(float v) {
#pragma unroll
    for (int o = 1; o < 16; o <<= 1) v += __shfl_xor(v, o);
    return v;
}
template <int CTRL> __device__ __forceinline__ float dpp_mov(float x) {
    return __builtin_bit_cast(float, __builtin_amdgcn_update_dpp(0, __builtin_bit_cast(int, x), CTRL, 0xf, 0xf, true));
}
__device__ __forceinline__ float allred16(float x) {
    x += dpp_mov<0xB1>(x); x += dpp_mov<0x4E>(x); x += dpp_mov<0x141>(x); x += dpp_mov<0x140>(x); return x;
}
__device__ __forceinline__ void unpack8(const u32x4 w, float (&f)[8]) {
    f[0] = bflo(w.x); f[1] = bfhi(w.x); f[2] = bflo(w.y); f[3] = bfhi(w.y); f[4] = bflo(w.z); f[5] = bfhi(w.z); f[6] = bflo(w.w); f[7] = bfhi(w.w);
}
__device__ __forceinline__ u32x4 pack8(const float (&f)[8]) { u32x4 w; w.x = pk2(f[0], f[1]); w.y = pk2(f[2], f[3]); w.z = pk2(f[4], f[5]); w.w = pk2(f[6], f[7]); return w; }
__device__ __forceinline__ int opaque_tid(int) { int t = threadIdx.x; asm volatile("" : "+v"(t)); return t; }
__device__ __forceinline__ int row_of(int b, int t) { return t < NMETA ? BATCH * SEQ + b * NMETA + t : b * SEQ + (t - NMETA); }
__device__ __forceinline__ void bt_of(int m, int& b, int& t) { if (m < BATCH * SEQ) { b = m >> 12; t = NMETA + (m & (SEQ - 1)); } else { const int q = m - BATCH * SEQ; b = q >> 4; t = q & (NMETA - 1); } }
namespace pg8 {
constexpr int BM = 256, BK = 64, HALF = 128, HTB = HALF * BK * 2  , STAGE_BYTES = 8 * HTB;
__host__ __device__ __forceinline__ int lds_byte(int r, int c) { const int st = (r >> 4) * 2 + (c >> 5), rr = r & 15, cc = c & 31, ob = rr * 64 + cc * 2; return st * 1024 + (ob ^ (((ob >> 9) & 1) << 5)); }
__host__ __device__ __forceinline__ void stage_rc(int b, int& R, int& C) { const int st = b / 1024, sb = b % 1024, swz = sb ^ (((sb >> 9) & 1) << 5); R = (st >> 1) * 16 + swz / 64; C = (st & 1) * 32 + (swz % 64) / 2; }
__host__ __device__ __forceinline__ int perm32(int rho) { const int n = rho >> 4, i = rho & 15; return 8 * (i >> 2) + 4 * n + (i & 3); }

struct GU {
    const bf16_t* A;
    const bf16_t* B;
    int lda, ldb, nt;
    int pm, pn, kind;
};

template <bool SKIP_HI = false, class Epi, class Sched>
__device__ __forceinline__ void gemm_phase(LAS unsigned char* lds, int wave_s, const Sched& S, const Epi& E) {
    const int tid = opaque_tid(wave_s), wid = wave_s, lane = tid & 63, wr = wid >> 2, wc = wid & 3, fr = lane & 15, fq = lane >> 4;
#define PG8_VOFF(lda_, ldb_, a0, b0) do { int R0_, C0_; stage_rc(tid * 16, R0_, C0_); \
        a0 = (unsigned)(R0_ * (lda_) + C0_) * 2u; b0 = (unsigned)(((R0_ & ~31) + perm32(R0_ & 31)) * (ldb_) + C0_) * 2u; } while (0)
    const size_t kstep = (size_t)(BK * 2);
    const unsigned ldsw = (unsigned)wid * 1024u;
    const int aoff = lds_byte(wr * 64 + fr, fq * 8), boff = lds_byte(wc * 32 + fr, fq * 8);
#define PG8_SA(b, h) (((b) * 2 + (h)) * HTB)
#define PG8_SB(b, h) ((4 + (b) * 2 + (h)) * HTB)
#define PG8_STAGE(bufoff, gbase, v0, hs) do { \
        __builtin_amdgcn_global_load_lds((const unsigned*)((const char*)(gbase) + (v0)), (LAS unsigned*)(lds + (bufoff) + ldsw), 16, 0, 0); \
        __builtin_amdgcn_global_load_lds((const unsigned*)((const char*)(gbase) + ((hs) >> 1) + (v0)), (LAS unsigned*)(lds + (bufoff) + ldsw + 8192), 16, 0, 0); } while (0)
#define PG8_LDA(dst, b, h) do { _Pragma("unroll") for (int m = 0; m < 4; ++m) _Pragma("unroll") for (int k = 0; k < 2; ++k) dst[m][k] = *(const LAS bf16x8*)(lds + PG8_SA(b, h) + aoff + m * 2048 + k * 1024); } while (0)
#define PG8_LDB(dst, b, h) do { _Pragma("unroll") for (int n = 0; n < 2; ++n) _Pragma("unroll") for (int k = 0; k < 2; ++k) dst[n][k] = *(const LAS bf16x8*)(lds + PG8_SB(b, h) + boff + n * 2048 + k * 1024); } while (0)
#define PG8_MMA(ai, bj, At, Bt) do { __builtin_amdgcn_s_setprio(1); _Pragma("unroll") for (int m = 0; m < 4; ++m) _Pragma("unroll") for (int n = 0; n < 2; ++n) _Pragma("unroll") for (int k = 0; k < 2; ++k) \
        acc[ai][bj][m][n] = __builtin_amdgcn_mfma_f32_16x16x32_bf16(Bt[n][k], At[m][k], acc[ai][bj][m][n], 0, 0, 0); __builtin_amdgcn_s_setprio(0); } while (0)
#define PG8_WAIT_V(n) asm volatile("s_waitcnt vmcnt(" #n ")" ::: "memory")
#define PG8_WAIT_L(n) asm volatile("s_waitcnt lgkmcnt(" #n ")" ::: "memory")
#define PG8_BAR __builtin_amdgcn_s_barrier()
#define PG8_SCHED __builtin_amdgcn_sched_barrier(0)
    GU cur, nxt; int ui = 0;
    if (!S.next(0, cur)) return;
    f32x4 acc[2][2][4][2];
#pragma unroll
    for (int a = 0; a < 2; ++a)
#pragma unroll
        for (int b = 0; b < 2; ++b)
#pragma unroll
            for (int m = 0; m < 4; ++m)
#pragma unroll
                for (int n = 0; n < 2; ++n) acc[a][b][m][n] = (f32x4){0.f, 0.f, 0.f, 0.f};
    bf16x8 At[4][2], B0[2][2], B1[2][2];
    const char* cA = (const char*)cur.A; const char* cB = (const char*)cur.B;
    unsigned vA0, vB0; PG8_VOFF(cur.lda, cur.ldb, vA0, vB0);
    size_t hsA = (size_t)HALF * cur.lda * 2, hsB = (size_t)HALF * cur.ldb * 2;
    int nt = cur.nt; asm volatile("" : "+s"(nt));
    PG8_STAGE(PG8_SB(0, 0), cB, vB0, hsB); PG8_STAGE(PG8_SB(0, 1), cB + hsB, vB0, hsB); PG8_STAGE(PG8_SA(0, 0), cA, vA0, hsA); PG8_STAGE(PG8_SA(0, 1), cA + hsA, vA0, hsA);
    if (wr == 1) PG8_BAR;
    PG8_WAIT_V(2); PG8_BAR;
    PG8_STAGE(PG8_SB(1, 0), cB + kstep, vB0, hsB); PG8_STAGE(PG8_SA(1, 0), cA + kstep, vA0, hsA); PG8_STAGE(PG8_SB(1, 1), cB + hsB + kstep, vB0, hsB);
    PG8_WAIT_V(6); PG8_BAR;
    for (;;) {
        const bool has_next = S.next(ui + 1, nxt);
        const char* nA = has_next ? (const char*)nxt.A : cA; const char* nB = has_next ? (const char*)nxt.B : cB;
        unsigned nvA0 = vA0, nvB0 = vB0;
        if (has_next) PG8_VOFF(nxt.lda, nxt.ldb, nvA0, nvB0);
        const size_t nhsA = has_next ? (size_t)HALF * nxt.lda * 2 : hsA, nhsB = has_next ? (size_t)HALF * nxt.ldb * 2 : hsB;
        for (int t = 0; t < nt; t += 2) {
            const bool last = (t == nt - 2);
            const char* a1 = cA + (size_t)(t + 1) * kstep;
            const char* a2 = last ? nA : cA + (size_t)(t + 2) * kstep; const char* b2 = last ? nB : cB + (size_t)(t + 2) * kstep;
            const char* a3 = a2 + kstep; const char* b3 = b2 + kstep;
            const unsigned xA0 = last ? nvA0 : vA0, xB0 = last ? nvB0 : vB0;
            const size_t xhA = last ? nhsA : hsA, xhB = last ? nhsB : hsB;
            PG8_LDB(B0, 0, 0); PG8_LDB(B1, 0, 1); PG8_SCHED; PG8_LDA(At, 0, 0); PG8_STAGE(PG8_SA(1, 1), a1 + hsA, vA0, hsA);
            PG8_WAIT_V(8); PG8_WAIT_L(0); PG8_BAR; PG8_MMA(0, 0, At, B0); PG8_MMA(0, 1, At, B1); PG8_BAR; PG8_SCHED;
            PG8_LDA(At, 0, 1); PG8_STAGE(PG8_SB(0, 0), b2, xB0, xhB); PG8_STAGE(PG8_SB(0, 1), b2 + xhB, xB0, xhB); PG8_STAGE(PG8_SA(0, 0), a2, xA0, xhA);
            PG8_WAIT_V(8); PG8_WAIT_L(0); PG8_BAR; if constexpr (!SKIP_HI) { PG8_MMA(1, 0, At, B0); PG8_MMA(1, 1, At, B1); } PG8_BAR; PG8_SCHED;
            PG8_LDB(B0, 1, 0); PG8_LDB(B1, 1, 1); PG8_SCHED; PG8_LDA(At, 1, 0); PG8_STAGE(PG8_SA(0, 1), a2 + xhA, xA0, xhA);
            PG8_WAIT_V(8); PG8_WAIT_L(0); PG8_BAR; PG8_MMA(0, 0, At, B0); PG8_MMA(0, 1, At, B1); PG8_BAR; PG8_SCHED;
            PG8_LDA(At, 1, 1); PG8_STAGE(PG8_SB(1, 0), b3, xB0, xhB); PG8_STAGE(PG8_SB(1, 1), b3 + xhB, xB0, xhB); PG8_STAGE(PG8_SA(1, 0), a3, xA0, xhA);
            PG8_WAIT_V(8); PG8_WAIT_L(0); PG8_BAR; if constexpr (!SKIP_HI) { PG8_MMA(1, 0, At, B0); PG8_MMA(1, 1, At, B1); } PG8_BAR; PG8_SCHED;
        }
        if (wr == 0) PG8_BAR;
        const bool keep = E(acc, cur, wr, wc, fr, fq);
        if (!has_next) break;
        if (!keep) {
#pragma unroll
            for (int a = 0; a < 2; ++a)
#pragma unroll
                for (int b = 0; b < 2; ++b)
#pragma unroll
                    for (int m = 0; m < 4; ++m)
#pragma unroll
                        for (int n = 0; n < 2; ++n) acc[a][b][m][n] = (f32x4){0.f, 0.f, 0.f, 0.f};
        }
        cur = nxt; cA = nA; cB = nB; vA0 = nvA0; vB0 = nvB0; hsA = nhsA; hsB = nhsB; nt = cur.nt; asm volatile("" : "+s"(nt)); ++ui;
        if (wr == 1) PG8_BAR;
    }
    PG8_WAIT_V(0);
    PG8_BAR;
#undef PG8_VOFF
#undef PG8_SA
#undef PG8_SB
#undef PG8_STAGE
#undef PG8_LDA
#undef PG8_LDB
#undef PG8_MMA
#undef PG8_WAIT_V
#undef PG8_WAIT_L
#undef PG8_BAR
#undef PG8_SCHED
}

__device__ __forceinline__ bool tile_order(int i, int G, int c, int nM, int nN, int& pm, int& pn) {
    const int nwg = nM * nN; const long L = (long)i * G + c; if (L >= nwg) return false;
    int wgid = (int)L; { const int q = nwg / 8, r = nwg % 8, xcd = wgid % 8, off = wgid / 8; wgid = (xcd < r ? xcd * (q + 1) : r * (q + 1) + (xcd - r) * q) + off; }
    const int nig = 8 * nN, gid = wgid / nig, fm = gid * 8, gsz = (nM - fm) < 8 ? (nM - fm) : 8;
    pm = fm + ((wgid % nig) % gsz); pn = (wgid % nig) / gsz; return true;
}
}
using pg8::GU;
enum InIdx { I_X = 0, I_META, I_FNW, I_MIXNW, I_WIN, I_S5LRE, I_S5LIM, I_S5LS, I_S5BRE, I_S5BIM, I_S5CRE, I_S5CIM, I_S5D, I_GLUW, I_GLUB,
             I_CONVW, I_CONVB, I_ALOG, I_DTB, I_SSDD, I_SSDNW, I_MURKV, I_MUWAG, I_W0, I_W1, I_W2, I_A0, I_A1, I_A2, I_G1, I_G2, I_KK, I_KA, I_RK, I_LNW, I_LNB,
             I_PA, I_PB, I_PC, I_WOUT, I_MLPNW, I_MLPW1, I_MLPW2, N_INPUTS };
struct Params { const float* in[N_INPUTS]; float* out; unsigned char* ws; int ph_lo, ph_hi; };

struct Ctx {
    const float* const* in; unsigned char* ws; unsigned char* dout;
    LAS unsigned char* lds;
    int tid, lane, wave, G, bid;
    __device__ __forceinline__ bf16_t* wb(int layer) const { return (bf16_t*)(layer == 0 ? ws + WS_WB0 : dout + DO_WB1); }
    __device__ __forceinline__ bf16_t* H() const { return (bf16_t*)(ws + WS_H); }
    __device__ __forceinline__ float* ssq() const { return (float*)(ws + WS_SSQ); }
};
__device__ __forceinline__ Ctx relaunder(const Ctx& c0) {
    Ctx c = c0; c.tid = opaque_tid(c0.wave); c.lane = c.tid & 63;
    return c;
}
__device__ __forceinline__ float row_scale(const float* ssq, int row) {
    const f32x4* p = (const f32x4*)(ssq + (size_t)row * 16);
    const f32x4 a = p[0], b = p[1], c = p[2], d = p[3];
    const float s = ((a.x + a.y) + (a.z + a.w)) + ((b.x + b.y) + (b.z + b.w)) + ((c.x + c.y) + (c.z + c.w)) + ((d.x + d.y) + (d.z + d.w));
    return __builtin_amdgcn_rsqf(s * (1.0f / DM) + EPS);
}

struct SchedPlain {
    const bf16_t* A; const bf16_t* B; int lda, ldb, K, nM, nN, G, c, pm0;
    __device__ __forceinline__ bool next(int i, GU& u) const {
        int pm, pn; if (!pg8::tile_order(i, G, c, nM, nN, pm, pn)) return false;
        pm += pm0;
        u.A = A + (size_t)pm * 256 * lda; u.B = B + (size_t)pn * 256 * ldb; u.lda = lda; u.ldb = ldb; u.nt = K / 64; u.pm = pm; u.pn = pn; u.kind = 0; return true;
    }
};
struct SchedS5 {
    const bf16_t* UH; const bf16_t* W; int K, G, c;
    __device__ __forceinline__ bool next(int i, GU& u) const {
        const int L = i * G + c; if (L >= 144) return false;
        const int g = L / 9, pm = L % 9;
        u.A = UH + ((size_t)g * S5RP + (size_t)pm * 256) * 512; u.B = W + (size_t)g * 256 * K; u.lda = 512; u.ldb = K; u.nt = K / 64; u.pm = pm; u.pn = 0; u.kind = g; return true;
    }
};
struct SchedL2 {
    const bf16_t* L1o; const bf16_t* W; int G, c, nM, pm0;
    __device__ __forceinline__ bool next(int i, GU& u) const {
        int pm, pn; if (!pg8::tile_order(i, G, c, nM, 5, pm, pn)) return false;
        pm += pm0;
        const int koff = pn < 2 ? 0 : (pn < 4 ? 128 : 256);
        u.A = L1o + (size_t)pm * 256 * 512 + koff; u.B = W + (size_t)pn * 256 * 256; u.lda = 512; u.ldb = 256; u.nt = 4; u.pm = pm; u.pn = pn; u.kind = 0; return true;
    }
};
struct SchedProj {
    const bf16_t* Hb; const bf16_t* Wg; const bf16_t* Wp; const bf16_t* ya; const bf16_t* yb; const bf16_t* yc; int nM, G, c, pm0;
    __device__ __forceinline__ bool next(int i, GU& u) const {
        const int ti = i / 6, sub = i - ti * 6; int pm, pn;
        if (!pg8::tile_order(ti, G, c, nM, 4, pm, pn)) return false;
        pm += pm0;
        u.pm = pm; u.pn = pn; u.kind = sub;
        if (sub < 3) { u.A = Hb + (size_t)pm * 256 * DM; u.lda = DM; u.B = Wg + ((size_t)sub * 1024 + (size_t)pn * 256) * DM; u.ldb = DM; u.nt = 16; }
        else if (sub == 3) { u.A = ya + (size_t)pm * 256 * 256; u.lda = 256; u.B = Wp + (size_t)pn * 256 * DM; u.ldb = DM; u.nt = 4; }
        else if (sub == 4) { u.A = yb + (size_t)pm * 256 * 512; u.lda = 512; u.B = Wp + (size_t)pn * 256 * DM + 256; u.ldb = DM; u.nt = 8; }
        else { u.A = yc + (size_t)pm * 256 * 256; u.lda = 256; u.B = Wp + (size_t)pn * 256 * DM + 768; u.ldb = DM; u.nt = 4; }
        return true;
    }
};

typedef f32x4 Acc[2][2][4][2];
#define EPI_ROWS_BEGIN  _Pragma("unroll") for (int ai = 0; ai < 2; ++ai) _Pragma("unroll") for (int m = 0; m < 4; ++m) { const int rl = ai * 128 + wr * 64 + m * 16 + fr; const int row = u.pm * 256 + rl; (void)rl;
#define EPI_ROWS_END    asm volatile("" ::: "memory"); }
#define EPI_COL(bj) ((bj) * 128 + wc * 32 + fq * 8)

struct EpiInProj {
    const float* ssq; bf16_t* UH; bf16_t* Pz; bf16_t* Pxbc; bf16_t* Prkvx;
    __device__ __forceinline__ bool operator()(Acc& acc, const GU& u, int wr, int wc, int fr, int fq) const {
        EPI_ROWS_BEGIN
            if (row < M_ROWS) {
                const float s = row_scale(ssq, row);
                int b, t; bt_of(row, b, t);
#pragma unroll
                for (int bj = 0; bj < 2; ++bj) {
                    const int col = EPI_COL(bj);
                    const f32x4 v0 = acc[ai][bj][m][0] * s, v1 = acc[ai][bj][m][1] * s;
                    u32x4 w; w.x = pk2(v0[0], v0[1]); w.y = pk2(v0[2], v0[3]); w.z = pk2(v1[0], v1[1]); w.w = pk2(v1[2], v1[3]);
                    bf16_t* dst;
                    if (u.pn == 0) { const int g = col >> 4, hh = col & 15; dst = UH + ((size_t)g * S5RP + (size_t)(b * NCH16 + (t >> 4))) * 512 + (t & 15) * 16 + hh; }
                    else if (u.pn < 3) dst = Pz + (size_t)row * 512 + (u.pn - 1) * 256 + col;
                    else if (u.pn < 7) dst = Pxbc + (size_t)row * 1024 + (u.pn - 3) * 256 + col;
                    else dst = Prkvx + (size_t)row * 1024 + (u.pn - 7) * 256 + col;
                    *(u32x4*)dst = w;
                }
            }
        EPI_ROWS_END
        return false;
    }
};
struct EpiS5X {
    float* X;
    __device__ __forceinline__ bool operator()(Acc& acc, const GU& u, int wr, int wc, int fr, int fq) const {
        EPI_ROWS_BEGIN
            float* rp = X + ((size_t)u.kind * S5RP + row) * 256;
#pragma unroll
            for (int bj = 0; bj < 2; ++bj) { const int col = EPI_COL(bj); *(f32x4*)(rp + col) = acc[ai][bj][m][0]; *(f32x4*)(rp + col + 4) = acc[ai][bj][m][1]; }
        EPI_ROWS_END
        return false;
    }
};
struct EpiS5Y {
    bf16_t* yapre;
    __device__ __forceinline__ bool operator()(Acc& acc, const GU& u, int wr, int wc, int fr, int fq) const {
        EPI_ROWS_BEGIN
            if (row < S5ROWS) {
                const int b = row / NCH16, c = row - b * NCH16;
#pragma unroll
                for (int bj = 0; bj < 2; ++bj) {
                    const int col = EPI_COL(bj), i = col >> 4, hh = col & 15;
                    const f32x4 v0 = acc[ai][bj][m][0], v1 = acc[ai][bj][m][1];
                    u32x4 w; w.x = pk2(geluf_(v0[0]), geluf_(v0[1])); w.y = pk2(geluf_(v0[2]), geluf_(v0[3])); w.z = pk2(geluf_(v1[0]), geluf_(v1[1])); w.w = pk2(geluf_(v1[2]), geluf_(v1[3]));
                    *(u32x4*)(yapre + (size_t)row_of(b, c * 16 + i) * 256 + u.kind * 16 + hh) = w;
                }
            }
        EPI_ROWS_END
        return false;
    }
};
struct EpiL1 {
    bf16_t* L1o;
    __device__ __forceinline__ bool operator()(Acc& acc, const GU& u, int wr, int wc, int fr, int fq) const {
        EPI_ROWS_BEGIN
#pragma unroll
            for (int bj = 0; bj < 2; ++bj) {
                const int col = EPI_COL(bj); const int mode = u.pn * 2 + bj;
                f32x4 v0 = acc[ai][bj][m][0], v1 = acc[ai][bj][m][1]; float f[8] = {v0[0], v0[1], v0[2], v0[3], v1[0], v1[1], v1[2], v1[3]};
#pragma unroll
                for (int e = 0; e < 8; ++e) f[e] = mode == 0 ? tanhf_(f[e]) : (mode == 1 ? f[e] : (mode == 2 ? sigmoidf_(f[e]) : 0.f));
                *(u32x4*)(L1o + (size_t)row * 512 + u.pn * 256 + col) = pack8(f);
            }
        EPI_ROWS_END
        return false;
    }
};
struct EpiL2 {
    bf16_t* L2o; const float* w0; const float* a0;
    __device__ __forceinline__ bool operator()(Acc& acc, const GU& u, int wr, int wc, int fr, int fq) const {
        EPI_ROWS_BEGIN
#pragma unroll
            for (int bj = 0; bj < 2; ++bj) {
                const int col = EPI_COL(bj);
                f32x4 v0 = acc[ai][bj][m][0], v1 = acc[ai][bj][m][1]; float f[8] = {v0[0], v0[1], v0[2], v0[3], v1[0], v1[1], v1[2], v1[3]};
                if (u.pn < 2) {
                    const float* bp = w0 + u.pn * 256 + col;
#pragma unroll
                    for (int e = 0; e < 8; ++e) { const float v = bp[e] + f[e]; f[e] = -__expf(-softplusf_(-v) - 0.5f); }
                } else if (u.pn < 4) {
                    const float* bp = a0 + (u.pn - 2) * 256 + col;
#pragma unroll
                    for (int e = 0; e < 8; ++e) f[e] = sigmoidf_(bp[e] + f[e]);
                }
                *(u32x4*)(L2o + (size_t)row * 1280 + u.pn * 256 + col) = pack8(f);
            }
        EPI_ROWS_END
        return false;
    }
};
struct EpiGLU {
    bf16_t* ya; const float* bias;
    __device__ __forceinline__ bool operator()(Acc& acc, const GU& u, int wr, int wc, int fr, int fq) const {
        const int lc = wc * 32 + fq * 8, oc = u.pn * 128 + lc;
        float bv[8], bg[8];
#pragma unroll
        for (int e = 0; e < 8; ++e) { bv[e] = bias[oc + e]; bg[e] = bias[256 + oc + e]; }
        EPI_ROWS_BEGIN
            const f32x4 a0 = acc[ai][0][m][0], a1 = acc[ai][0][m][1], g0 = acc[ai][1][m][0], g1 = acc[ai][1][m][1];
            float v[8] = {a0[0], a0[1], a0[2], a0[3], a1[0], a1[1], a1[2], a1[3]}, g[8] = {g0[0], g0[1], g0[2], g0[3], g1[0], g1[1], g1[2], g1[3]};
#pragma unroll
            for (int e = 0; e < 8; ++e) v[e] = (v[e] + bv[e]) * sigmoidf_(g[e] + bg[e]);
            *(u32x4*)(ya + (size_t)row * 256 + oc) = pack8(v);
        EPI_ROWS_END
        return false;
    }
};
struct EpiProj {
    const float* ssq; const float* ssqb; unsigned char* park; bf16_t* merged; int tid;
    __device__ __forceinline__ bool operator()(Acc& acc, const GU& u, int wr, int wc, int fr, int fq) const {
        const int k = u.kind;
        EPI_ROWS_BEGIN
            float s = 1.f; if (k < 3) s = row_scale(ssq, row < M_ROWS ? row : 0);
            else if (k < 5) { { const int rr_ = row < M_ROWS ? row : 0; s = __builtin_amdgcn_rsqf((ssqb[2 * rr_] + ssqb[2 * rr_ + 1]) * (1.0f / 512.f) + EPS); } if (k == 3) s = __builtin_amdgcn_rcpf(s); }
#pragma unroll
            for (int bj = 0; bj < 2; ++bj) {
                const int q = (ai * 2 + bj) * 4 + m;
                f32x4& v0 = acc[ai][bj][m][0]; f32x4& v1 = acc[ai][bj][m][1];
                if (k < 3) {
                    float f[8] = {v0[0], v0[1], v0[2], v0[3], v1[0], v1[1], v1[2], v1[3]};
#pragma unroll
                    for (int e = 0; e < 8; ++e) f[e] = sigmoidf_(f[e] * s);
                    *(u32x4*)(park + ((size_t)(k * 16 + q) * NTHREADS + tid) * 16) = pack8(f);
                } else {
                    float num[8], den[8];
                    unpack8(*(const u32x4*)(park + ((size_t)((k - 3) * 16 + q) * NTHREADS + tid) * 16), num);
                    if (k < 5) { unpack8(*(const u32x4*)(park + ((size_t)((k - 2) * 16 + q) * NTHREADS + tid) * 16), den);
#pragma unroll
                        for (int e = 0; e < 8; ++e) num[e] = num[e] * __builtin_amdgcn_rcpf(den[e]) * s; }
                    v0[0] *= num[0]; v0[1] *= num[1]; v0[2] *= num[2]; v0[3] *= num[3]; v1[0] *= num[4]; v1[1] *= num[5]; v1[2] *= num[6]; v1[3] *= num[7];
                    if (k == 5) { u32x4 w; w.x = pk2(v0[0], v0[1]); w.y = pk2(v0[2], v0[3]); w.z = pk2(v1[0], v1[1]); w.w = pk2(v1[2], v1[3]);
                        *(u32x4*)(merged + (size_t)row * DM + u.pn * 256 + EPI_COL(bj)) = w; }
                }
            }
        EPI_ROWS_END
        return k == 3 || k == 4;
    }
};
struct EpiResid {
    bf16_t* H; float* ssq;
    __device__ __forceinline__ bool operator()(Acc& acc, const GU& u, int wr, int wc, int fr, int fq) const {
        EPI_ROWS_BEGIN
            float ss = 0.f;
            if (row < M_ROWS) {
#pragma unroll
                for (int bj = 0; bj < 2; ++bj) {
                    bf16_t* hp = H + (size_t)row * DM + u.pn * 256 + EPI_COL(bj);
                    float f[8]; unpack8(*(const u32x4*)hp, f);
                    const f32x4 v0 = acc[ai][bj][m][0], v1 = acc[ai][bj][m][1];
                    f[0] += v0[0]; f[1] += v0[1]; f[2] += v0[2]; f[3] += v0[3]; f[4] += v1[0]; f[5] += v1[1]; f[6] += v1[2]; f[7] += v1[3];
#pragma unroll
                    for (int e = 0; e < 8; ++e) ss += f[e] * f[e];
                    *(u32x4*)hp = pack8(f);
                }
            }
            ss += __shfl_xor(ss, 16); ss += __shfl_xor(ss, 32);
            if (fq == 0 && row < M_ROWS) ssq[(size_t)row * 16 + u.pn * 4 + wc] = ss;
        EPI_ROWS_END
        return false;
    }
};
struct EpiUp {
    const float* ssq; bf16_t* act;
    __device__ __forceinline__ bool operator()(Acc& acc, const GU& u, int wr, int wc, int fr, int fq) const {
        EPI_ROWS_BEGIN
            const float s = row_scale(ssq, row < M_ROWS ? row : 0);
#pragma unroll
            for (int bj = 0; bj < 2; ++bj) {
                const f32x4 v0 = acc[ai][bj][m][0] * s, v1 = acc[ai][bj][m][1] * s; float f[8] = {v0[0], v0[1], v0[2], v0[3], v1[0], v1[1], v1[2], v1[3]};
#pragma unroll
                for (int e = 0; e < 8; ++e) { const float r = fmaxf(f[e], 0.f); f[e] = r * r; }
                *(u32x4*)(act + (size_t)row * DFF + u.pn * 256 + EPI_COL(bj)) = pack8(f);
            }
        EPI_ROWS_END
        return false;
    }
};
typedef __attribute__((address_space(1))) unsigned gu32;
#define XB_TMO      128
#define XB_XCNT(j)  (256  + 64 * (j))
#define XB_XSUB(j)  (1280 + 64 * (j))
#define XB_XGEN(j)  (2304 + 64 * (j))
#define XB_TOP      3328
#define XB_TOPGEN   3392
#define XCD_BAR_WORDS 3456
#define XB_SPIN_CAP (1u << 18)

__device__ __forceinline__ unsigned xb_ld(unsigned* p)              { return __hip_atomic_load(p, __ATOMIC_RELAXED, __HIP_MEMORY_SCOPE_AGENT); }
__device__ __forceinline__ unsigned xb_add(unsigned* p, unsigned v) { return __hip_atomic_fetch_add(p, v, __ATOMIC_RELAXED, __HIP_MEMORY_SCOPE_AGENT); }
__device__ __forceinline__ unsigned xb_xcc_id() { return (unsigned)__builtin_amdgcn_s_getreg((3 << 11) | 20) & 0xFu; }
#define XB_SPIN(cond, bar) do { unsigned _sp = 0; while (cond) { __builtin_amdgcn_s_sleep(1); \
    if ((++_sp & 255u) == 0u) { if (xb_ld(&(bar)[XB_TMO])) break; if (_sp > XB_SPIN_CAP) { atomicAdd(&(bar)[XB_TMO], 1u); break; } } } } while (0)

struct XcdBarrier {
    unsigned* bar; unsigned x;
    volatile LAS unsigned* st;
};

__device__ __forceinline__ XcdBarrier xcd_barrier_post(unsigned* bar, volatile LAS unsigned* st) {
    XcdBarrier b; b.bar = bar; b.x = xb_xcc_id(); b.st = st;
    if (threadIdx.x == 0) (void)xb_add(&bar[XB_XCNT(b.x)], 1u);
    return b;
}
__device__ __forceinline__ void xcd_barrier_complete(unsigned* bar, unsigned x, unsigned& nloc, unsigned& nx) {
    const unsigned G = gridDim.x * gridDim.y * gridDim.z;
    unsigned sum, cnt, mine, sp = 0u;
    for (;;) {
        sum = 0u; cnt = 0u; mine = 0u;
#pragma unroll
        for (unsigned j = 0; j < 16; ++j) { const unsigned c = xb_ld(&bar[XB_XCNT(j)]); sum += c; cnt += (c > 0u) ? 1u : 0u; mine = (j == x) ? c : mine; }
        if (sum == G) break;
        __builtin_amdgcn_s_sleep(1);
        if ((++sp & 255u) == 0u) { if (xb_ld(&bar[XB_TMO])) break; if (sp > XB_SPIN_CAP) { atomicAdd(&bar[XB_TMO], 1u); break; } }
    }
    nloc = mine > 0u ? mine : 1u; nx = cnt > 0u ? cnt : 1u;
}

__device__ __forceinline__ void xcd_barrier(const XcdBarrier& b, int wave_s) {
    const bool xb_t0 = threadIdx.x == 0; (void)wave_s;
    asm volatile("s_waitcnt vmcnt(0)" ::: "memory");
    __syncthreads();
    if (xb_t0) {
        unsigned* bar = b.bar;
        __builtin_amdgcn_s_waitcnt(0);
        unsigned nloc = b.st[0], nx = b.st[1];
        if (nloc == 0u) { xcd_barrier_complete(bar, b.x, nloc, nx); b.st[0] = nloc; b.st[1] = nx; }
        const unsigned old = xb_add(&bar[XB_XSUB(b.x)], 1u);
        const unsigned gen = old / nloc;
        if (old + 1u == (gen + 1u) * nloc) {
            __builtin_amdgcn_fence(__ATOMIC_RELEASE, "agent");
            asm volatile("s_waitcnt vmcnt(0)" ::: "memory");
            const unsigned og = xb_add(&bar[XB_TOP], 1u);
            const unsigned tg = og / nx;
            if (og + 1u == (tg + 1u) * nx) xb_add(&bar[XB_TOPGEN], 1u);
            else XB_SPIN(xb_ld(&bar[XB_TOPGEN]) == tg, bar);
            __builtin_amdgcn_fence(__ATOMIC_ACQUIRE, "agent");
            xb_add(&bar[XB_XGEN(b.x)], 1u);
            asm volatile("s_waitcnt vmcnt(0)" ::: "memory");
        } else {
            XB_SPIN(xb_ld(&bar[XB_XGEN(b.x)]) == gen, bar);
            __builtin_amdgcn_fence(__ATOMIC_ACQUIRE, "agent");
            asm volatile("s_waitcnt vmcnt(0)" ::: "memory");
        }
    }
    __syncthreads();
}

struct TJob { const float* src; int ld, col0, K, N; bf16_t* dst; int dld, dk0, rmode, row0; const float* ksc; };
constexpr int N_TJOBS = 27;
__device__ __forceinline__ void get_tjob(const Ctx& c, int l, int j, TJob& t) {
    bf16_t* wb = c.wb(l);
    const float* win = c.in[I_WIN] + (size_t)l * DM * N_IN;
    t.rmode = 0; t.ksc = nullptr; t.dk0 = 0; t.col0 = 0; t.row0 = 0;
    if (j < 5) {
        t.src = win; t.ld = N_IN; t.K = DM; t.dld = DM; t.ksc = c.in[I_MIXNW] + l * DM; t.dst = wb + WB_IN;
        if (j == 0) { t.col0 = 0; t.N = 256; t.row0 = 0; }
        else if (j == 1) { t.col0 = 256; t.N = 512; t.row0 = 256; }
        else if (j == 2) { t.col0 = 768; t.N = 1024; t.row0 = 768; }
        else if (j == 3) { t.col0 = 1800; t.N = 1024; t.row0 = 1792; }
        else { t.col0 = 2824; t.N = 3072; t.row0 = 0; t.dst = wb + WB_G; }
    } else if (j == 5) { t.src = c.in[I_PA] + (size_t)l * 256 * DM; t.ld = DM; t.K = 256; t.N = DM; t.dst = wb + WB_P; t.dld = DM; t.dk0 = 0; }
    else if (j == 6) { t.src = c.in[I_PB] + (size_t)l * 512 * DM; t.ld = DM; t.K = 512; t.N = DM; t.dst = wb + WB_P; t.dld = DM; t.dk0 = 256; t.ksc = c.in[I_SSDNW] + (size_t)l * 512; }
    else if (j == 7) { t.src = c.in[I_PC] + (size_t)l * 256 * DM; t.ld = DM; t.K = 256; t.N = DM; t.dst = wb + WB_P; t.dld = DM; t.dk0 = 768; }
    else if (j == 8) { t.src = c.in[I_WOUT] + (size_t)l * DM * DM; t.ld = DM; t.K = DM; t.N = DM; t.dst = wb + WB_O; t.dld = DM; }
    else if (j == 9) { t.src = c.in[I_MLPW1] + (size_t)l * DM * DFF; t.ld = DFF; t.K = DM; t.N = DFF; t.dst = wb + WB_1; t.dld = DM; t.ksc = c.in[I_MLPNW] + l * DM; }
    else if (j == 10) { t.src = c.in[I_MLPW2] + (size_t)l * DFF * DM; t.ld = DM; t.K = DFF; t.N = DM; t.dst = wb + WB_2; t.dld = DFF; }
    else if (j == 11) { t.src = c.in[I_GLUW] + (size_t)l * 256 * 512; t.ld = 512; t.K = 256; t.N = 512; t.dst = wb + WB_GLU; t.dld = 256; t.rmode = 1; }
    else if (j < 22) {
        const int q = j - 12;
        t.K = 256; t.dst = wb + WB_L1; t.dld = 512;
        if (q < 4) { const int d = q >> 1, hf = q & 1; t.src = c.in[I_W1] + ((size_t)l * 2 + d) * 256 * 64; t.ld = 64; t.N = 64; t.row0 = d * 64; t.dk0 = hf * 256; if (hf) t.ksc = c.in[I_MUWAG] + ((size_t)l * 3 + 0) * 256; }
        else if (q < 8) { const int d = (q - 4) >> 1, hf = q & 1; t.src = c.in[I_A1] + ((size_t)l * 2 + d) * 256 * 64; t.ld = 64; t.N = 64; t.row0 = 128 + d * 64; t.dk0 = hf * 256; if (hf) t.ksc = c.in[I_MUWAG] + ((size_t)l * 3 + 1) * 256; }
        else { const int hf = q & 1; t.src = c.in[I_G1] + (size_t)l * 256 * 128; t.ld = 128; t.N = 128; t.row0 = 256; t.dk0 = hf * 256; if (hf) t.ksc = c.in[I_MUWAG] + ((size_t)l * 3 + 2) * 256; }
    } else {
        const int q = j - 22;
        t.dst = wb + WB_L2; t.dld = 256; t.ld = 256; t.N = 256;
        if (q < 2) { t.src = c.in[I_W2] + ((size_t)l * 2 + q) * 64 * 256; t.K = 64; t.row0 = q * 256; t.dk0 = q * 64; }
        else if (q < 4) { const int d = q - 2; t.src = c.in[I_A2] + ((size_t)l * 2 + d) * 64 * 256; t.K = 64; t.row0 = (2 + d) * 256; t.dk0 = d * 64; }
        else { t.src = c.in[I_G2] + (size_t)l * 128 * 256; t.K = 128; t.row0 = 4 * 256; t.dk0 = 0; }
    }
}
__device__ __forceinline__ int tjob_items(const TJob& t) { return (t.K / 64) * (t.N / 32); }
__device__ __forceinline__ void transpose_item(const TJob& t, LAS float* scr, int item, int lane) {
    const int nblk = t.N / 32, kb = item / nblk, nb = item % nblk, k0 = 64 * kb, n0 = 32 * nb;
#pragma unroll 8
    for (int i = 0; i < 32; ++i) { const int kk = 2 * i + (lane >> 5); float v = t.src[(size_t)(k0 + kk) * t.ld + t.col0 + n0 + (lane & 31)]; if (t.ksc) v *= t.ksc[k0 + kk]; scr[kk * 33 + (lane & 31)] = v; }
    asm volatile("s_waitcnt lgkmcnt(0)" ::: "memory");
    const int cc = lane & 7;
#pragma unroll
    for (int j = 0; j < 4; ++j) {
        const int n = (lane >> 3) + 8 * j; const LAS float* s = scr + (8 * cc) * 33 + n;
        u32x4 o; o.x = pk2(s[0 * 33], s[1 * 33]); o.y = pk2(s[2 * 33], s[3 * 33]); o.z = pk2(s[4 * 33], s[5 * 33]); o.w = pk2(s[6 * 33], s[7 * 33]);
        const int nn = n0 + n; int drow;
        if (t.rmode == 0) drow = t.row0 + nn; else drow = nn < 256 ? (nn >> 7) * 256 + (nn & 127) : ((nn - 256) >> 7) * 256 + 128 + ((nn - 256) & 127);
        *(u32x4*)(t.dst + (size_t)drow * t.dld + t.dk0 + k0 + 8 * cc) = o;
    }
    asm volatile("s_waitcnt lgkmcnt(0)" ::: "memory");
}

__device__ __forceinline__ void s5_build(const Ctx& cx_, int l, int g, int part) {
    const Ctx c = relaunder(cx_);
    LAS float* F = (LAS float*)c.lds;
    LAS float* pwr = F;
    LAS float* pwi = pwr + 2176;
    LAS float* cor = pwi + 2176;
    LAS float* coi = cor + 128;
    LAS float* Cr = coi + 128;
    LAS float* Ci = Cr + 1024;
    LAS float* Br = Ci + 1024;
    LAS float* Bi = Br + 1024;
    LAS float* kr = Bi + 1024;
    LAS float* ki = kr + 1984;
    LAS float* Kd = ki + 1984;
    const int tid = c.tid;
    if (tid < 128) {
        const int d = tid >> 6, n = tid & 63; const size_t li_ = (((size_t)l * 2 + d) * 16 + g) * 64 + n;
        const float lr = c.in[I_S5LRE][li_], li = c.in[I_S5LIM][li_], step = expf(c.in[I_S5LS][((size_t)l * 2 + d) * 16 + g]);
        for (int k = 0; k <= 16; ++k) { const float mag = expf((float)k * lr * step), ang = (float)k * li * step; float sn, cs; sincosf(ang, &sn, &cs); pwr[(d * 17 + k) * 64 + n] = mag * cs; pwi[(d * 17 + k) * 64 + n] = mag * sn; }
        const float mag1 = expf(lr * step); float sn, cs; sincosf(li * step, &sn, &cs); const float abr = mag1 * cs, abi = mag1 * sn, den = lr * lr + li * li;
        cor[d * 64 + n] = ((abr - 1.f) * lr + abi * li) / den; coi[d * 64 + n] = (abi * lr - (abr - 1.f) * li) / den;
    }
    for (int i = tid; i < 1024; i += NTHREADS) {
        Cr[i] = c.in[I_S5CRE][((size_t)l * 16 + g) * 1024 + i]; Ci[i] = c.in[I_S5CIM][((size_t)l * 16 + g) * 1024 + i];
        Br[i] = c.in[I_S5BRE][((size_t)l * 16 + g) * 1024 + i]; Bi[i] = c.in[I_S5BIM][((size_t)l * 16 + g) * 1024 + i];
    }
    __syncthreads();
    for (int i = tid; i < 31 * 64; i += NTHREADS) {
        const int dd = i / 64 - 15, n = i & 63; float r, im;
        if (dd > 0) { const float pr = pwr[(0 * 17 + dd) * 64 + n], pi = pwi[(0 * 17 + dd) * 64 + n]; r = pr * cor[n] - pi * coi[n]; im = pr * coi[n] + pi * cor[n]; }
        else if (dd < 0) { const float pr = pwr[(1 * 17 - dd) * 64 + n], pi = pwi[(1 * 17 - dd) * 64 + n]; r = pr * cor[64 + n] - pi * coi[64 + n]; im = pr * coi[64 + n] + pi * cor[64 + n]; }
        else { r = cor[n] + cor[64 + n]; im = coi[n] + coi[64 + n]; }
        kr[i] = r; ki[i] = im;
    }
    __syncthreads();
    for (int i0 = tid; i0 < 17 * 256; i0 += NTHREADS) {
        const int i = i0 + 2 * part * 256; const int ddi = i >> 8, h = (i >> 4) & 15, hp = i & 15; float a = 0.f;
        for (int n = 0; n < 64; ++n) { const float cr = Cr[h * 64 + n], ci = Ci[h * 64 + n], xr = kr[ddi * 64 + n], xi = ki[ddi * 64 + n]; const float pr = cr * xr - ci * xi, pi = cr * xi + ci * xr; a += pr * Br[n * 16 + hp] - pi * Bi[n * 16 + hp]; }
        Kd[i] = a;
    }
    __syncthreads();
    bf16_t* SX = c.wb(l) + WB_SX + (size_t)g * 256 * 256; bf16_t* SY = c.wb(l) + WB_SY + (size_t)g * 256 * 512;
    const float* dsk = c.in[I_S5D] + (size_t)l * 256 + g * 16;
    for (int u = tid; u < 32 * 64; u += NTHREADS) {
        const int o = 32 * part + (u >> 6), kk0 = (u & 63) * 8, i = o >> 4, h = o & 15; float v[8];
        if (kk0 < 256) { const int j = kk0 >> 4, hp0 = kk0 & 15;
#pragma unroll
            for (int e = 0; e < 8; ++e) v[e] = Kd[(i - j + 15) * 256 + h * 16 + hp0 + e] + ((i == j && h == hp0 + e) ? dsk[h] : 0.f);
        } else { const int q = kk0 - 256, d = q >> 7, part = (q >> 6) & 1, n0 = q & 63, ex = d == 0 ? i + 1 : 16 - i;
#pragma unroll
            for (int e = 0; e < 8; ++e) { const int n = n0 + e; const float cr = Cr[h * 64 + n], ci = Ci[h * 64 + n], pr = pwr[(d * 17 + ex) * 64 + n], pi = pwi[(d * 17 + ex) * 64 + n]; v[e] = part == 0 ? (cr * pr - ci * pi) : -(cr * pi + ci * pr); }
        }
        *(u32x4*)(SY + (size_t)o * 512 + kk0) = pack8(v);
    }
    for (int u = tid; u < 32 * 32; u += NTHREADS) {
        const int o = 32 * part + (u >> 5), kk0 = (u & 31) * 8, d = o >> 7, part = (o >> 6) & 1, n = o & 63, j = kk0 >> 4, hp0 = kk0 & 15, ex = d == 0 ? 15 - j : j;
        const float pr = pwr[(d * 17 + ex) * 64 + n], pi = pwi[(d * 17 + ex) * 64 + n], qr = pr * cor[d * 64 + n] - pi * coi[d * 64 + n], qi = pr * coi[d * 64 + n] + pi * cor[d * 64 + n];
        float v[8];
#pragma unroll
        for (int e = 0; e < 8; ++e) { const float br = Br[n * 16 + hp0 + e], bi = Bi[n * 16 + hp0 + e]; v[e] = part == 0 ? (qr * br - qi * bi) : (qr * bi + qi * br); }
        *(u32x4*)(SX + (size_t)o * 256 + kk0) = pack8(v);
    }
    __syncthreads();
}

__device__ __forceinline__ void phase0(const Ctx& cx_) {
    const Ctx c = relaunder(cx_);
    if (c.bid < 256) s5_build(c, c.bid >> 7, (c.bid >> 3) & 15, c.bid & 7);
    const int gw = c.bid * NWAVES + c.wave, NGW = c.G * NWAVES, lane = c.lane;
    bf16_t* H = c.H(); float* ssq = c.ssq();
#pragma unroll 2
    for (int m = gw; m < MP; m += NGW) {
        u32x2* hp = (u32x2*)(H + (size_t)m * DM);
        if (m >= M_ROWS) {
#pragma unroll
            for (int i = 0; i < 4; ++i) hp[lane + 64 * i] = (u32x2){0u, 0u};
            continue;
        }
        int b, t; bt_of(m, b, t);
        const f32x4* src = (const f32x4*)(t < NMETA ? c.in[I_META] + (size_t)t * DM : c.in[I_X] + ((size_t)b * SEQ + (t - NMETA)) * DM);
        float ss = 0.f;
#pragma unroll
        for (int i = 0; i < 4; ++i) { const f32x4 v = src[lane + 64 * i]; ss += (v.x * v.x + v.y * v.y) + (v.z * v.z + v.w * v.w); hp[lane + 64 * i] = (u32x2){pk2(v.x, v.y), pk2(v.z, v.w)}; }
        ss = wave_sum(ss);
        if (lane < 16) ssq[(size_t)m * 16 + lane] = lane == 0 ? ss : 0.f;
    }
    LAS float* scr = (LAS float*)(c.lds + c.wave * 8448);
    for (int l = 0; l < DEPTH; ++l) {
        int base = 0;
        for (int j = 0; j < N_TJOBS; ++j) {
            TJob t; get_tjob(c, l, j, t); const int ni = tjob_items(t);
            int first = (gw - base % NGW + NGW) % NGW;
            for (int it = first; it < ni; it += NGW) transpose_item(t, scr, it, lane);
            base += ni;
        }
        bf16_t* wb = c.wb(l);
        const int gt = c.bid * NTHREADS + c.tid, NGT = c.G * NTHREADS;
        for (int u = gt; u < 128 * 64; u += NGT) *(u32x4*)(wb + WB_L1 + (size_t)384 * 512 + (size_t)u * 8) = (u32x4){0u, 0u, 0u, 0u};
        for (int u = gt; u < 5 * 256 * 4 * 8; u += NGT) {
            const int sub = u & 7, blk = (u >> 3) & 3, row = (u >> 5) & 255, tile = u >> 13;
            const bool nz = (tile == 0 || tile == 2) ? (blk == 0) : ((tile == 1 || tile == 3) ? (blk == 1) : (blk < 2));
            if (!nz) *(u32x4*)(wb + WB_L2 + ((size_t)tile * 256 + row) * 256 + blk * 64 + sub * 8) = (u32x4){0u, 0u, 0u, 0u};
        }
    }
}

__device__ __forceinline__ void dt_job(const Ctx& cx_, int l) {
    const Ctx c = relaunder(cx_);
    LAS float* dtw = (LAS float*)c.lds;
    const float* win = c.in[I_WIN] + (size_t)l * DM * N_IN; const float* nw = c.in[I_MIXNW] + l * DM;
    for (int i = c.tid; i < 8 * DM; i += NTHREADS) { const int k = i >> 3, j = i & 7; dtw[j * DM + k] = nw[k] * win[(size_t)k * N_IN + 1792 + j]; }
    __syncthreads();
    const int gw = c.bid * NWAVES + c.wave, NGW = c.G * NWAVES, lane = c.lane;
    const bf16_t* H = c.H(); float* dt = (float*)(c.ws + WS_DT); float* dec = (float*)(c.ws + WS_DEC);
    const float* dtb = c.in[I_DTB] + l * 16; const float* alog = c.in[I_ALOG] + l * 16;
#pragma unroll 2
    for (int m = gw; m < M_ROWS; m += NGW) {
        const u32x2* hp = (const u32x2*)(H + (size_t)m * DM);
        float ss = 0.f, d8[8] = {0.f, 0.f, 0.f, 0.f, 0.f, 0.f, 0.f, 0.f};
#pragma unroll
        for (int i = 0; i < 4; ++i) {
            const u32x2 w = hp[lane + 64 * i]; const float h0 = bflo(w.x), h1 = bfhi(w.x), h2 = bflo(w.y), h3 = bfhi(w.y);
            ss += (h0 * h0 + h1 * h1) + (h2 * h2 + h3 * h3);
#pragma unroll
            for (int j = 0; j < 8; ++j) { const f32x4 wv = *(const LAS f32x4*)(dtw + j * DM + 4 * lane + 256 * i); d8[j] += (h0 * wv.x + h1 * wv.y) + (h2 * wv.z + h3 * wv.w); }
        }
        ss = wave_sum(ss);
#pragma unroll
        for (int j = 0; j < 8; ++j) d8[j] = wave_sum(d8[j]);
        const float s = __builtin_amdgcn_rsqf(ss * (1.0f / DM) + EPS);
        if (lane < 16) {
            const int j = lane & 7; float raw = d8[0];
#pragma unroll
            for (int e = 1; e < 8; ++e) raw = (j == e) ? d8[e] : raw;
            const float dtv = softplusf_(raw * s + dtb[lane]);
            dt[(size_t)m * 16 + lane] = dtv; dec[(size_t)m * 16 + lane] = -dtv * __expf(alog[lane]);
        }
    }
    __syncthreads();
}

__device__ __forceinline__ void rwkv_prep(const Ctx& cx_, int l) {
    const Ctx c = relaunder(cx_);
    const int gw = c.bid * NWAVES + c.wave, NGW = c.G * NWAVES, lane = c.lane, c0 = 4 * lane;
    const bf16_t* __restrict__ P = (const bf16_t*)(c.ws + WS_PRKVX); bf16_t* __restrict__ rk = (bf16_t*)(c.dout + DO_RKVP); bf16_t* __restrict__ l1 = (bf16_t*)(c.ws + WS_L1IN);
    float mu[3][4], kkw[4];
#pragma unroll
    for (int x = 0; x < 3; ++x)
#pragma unroll
        for (int e = 0; e < 4; ++e) mu[x][e] = c.in[I_MURKV][((size_t)l * 3 + x) * 256 + c0 + e];
#pragma unroll
    for (int e = 0; e < 4; ++e) kkw[e] = c.in[I_KK][(size_t)l * 256 + c0 + e];
#pragma unroll 4
    for (int m = gw; m < M_ROWS; m += NGW) {
        int b, t; bt_of(m, b, t); const bool hp = t > 0, hn = t < LEN - 1; const size_t mp_ = hp ? row_of(b, t - 1) : 0, mn_ = hn ? row_of(b, t + 1) : 0;
        float o[4][4];
        float xc[4], dxc[4];
#pragma unroll
        for (int x = 0; x < 4; ++x) {
            const u32x2 wc_ = *(const u32x2*)(P + (size_t)m * 1024 + x * 256 + c0);
            u32x2 wp = (u32x2){0u, 0u}, wn = (u32x2){0u, 0u};
            if (hp) wp = *(const u32x2*)(P + mp_ * 1024 + x * 256 + c0);
            if (hn) wn = *(const u32x2*)(P + mn_ * 1024 + x * 256 + c0);
            const float cur[4] = {bflo(wc_.x), bfhi(wc_.x), bflo(wc_.y), bfhi(wc_.y)}, pv[4] = {bflo(wp.x), bfhi(wp.x), bflo(wp.y), bfhi(wp.y)}, nv[4] = {bflo(wn.x), bfhi(wn.x), bflo(wn.y), bfhi(wn.y)};
#pragma unroll
            for (int e = 0; e < 4; ++e) { const float cs = 0.5f * (pv[e] + nv[e]) - cur[e]; if (x < 3) o[x][e] = cur[e] + cs * mu[x][e]; else { xc[e] = cur[e]; dxc[e] = cs; } }
        }
        float kr_[4], ss = 0.f;
#pragma unroll
        for (int e = 0; e < 4; ++e) { kr_[e] = o[1][e] * kkw[e]; ss += kr_[e] * kr_[e]; }
        ss = sum16(ss); const float rn = __builtin_amdgcn_rsqf(ss + 1e-12f);
        bf16_t* rp = rk + (size_t)m * 1024 + c0;
        *(u32x2*)(rp) = (u32x2){pk2(o[0][0], o[0][1]), pk2(o[0][2], o[0][3])};
        *(u32x2*)(rp + 256) = (u32x2){pk2(o[1][0], o[1][1]), pk2(o[1][2], o[1][3])};
        *(u32x2*)(rp + 512) = (u32x2){pk2(o[2][0], o[2][1]), pk2(o[2][2], o[2][3])};
        *(u32x2*)(rp + 768) = (u32x2){pk2(kr_[0] * rn, kr_[1] * rn), pk2(kr_[2] * rn, kr_[3] * rn)};
        bf16_t* lp = l1 + (size_t)m * 512 + c0;
        *(u32x2*)(lp) = (u32x2){pk2(xc[0], xc[1]), pk2(xc[2], xc[3])};
        *(u32x2*)(lp + 256) = (u32x2){pk2(dxc[0], dxc[1]), pk2(dxc[2], dxc[3])};
    }
}
__device__ __forceinline__ void ssd_prep(const Ctx& cx_, int l) {
    const Ctx c = relaunder(cx_);
    const int gw = c.bid * NWAVES + c.wave, NGW = c.G * NWAVES, lane = c.lane, c0 = 16 * lane;
    const bf16_t* __restrict__ P = (const bf16_t*)(c.ws + WS_PXBC); bf16_t* __restrict__ xs = (bf16_t*)(c.ws + WS_XS); bf16_t* __restrict__ bc = (bf16_t*)(c.ws + WS_BC);
    float w[5][16], bias[16];
#pragma unroll
    for (int j = 0; j < 5; ++j)
#pragma unroll
        for (int e = 0; e < 16; ++e) w[j][e] = c.in[I_CONVW][((size_t)l * 5 + j) * 1024 + c0 + e];
#pragma unroll
    for (int e = 0; e < 16; ++e) bias[e] = c.in[I_CONVB][(size_t)l * 1024 + c0 + e];
#pragma unroll 2
    for (int m = gw; m < M_ROWS; m += NGW) {
        int b, t; bt_of(m, b, t);
        float a[16];
#pragma unroll
        for (int e = 0; e < 16; ++e) a[e] = bias[e];
#pragma unroll
        for (int j = 0; j < 5; ++j) {
            const int tt = t + j - 2;
            if (tt >= 0 && tt < LEN) {
                const u32x4* p = (const u32x4*)(P + (size_t)row_of(b, tt) * 1024 + c0); float f0[8], f1[8]; unpack8(p[0], f0); unpack8(p[1], f1);
#pragma unroll
                for (int e = 0; e < 8; ++e) { a[e] += w[j][e] * f0[e]; a[8 + e] += w[j][8 + e] * f1[e]; }
            }
        }
        float o0[8], o1[8];
#pragma unroll
        for (int e = 0; e < 8; ++e) { o0[e] = siluf_(a[e]); o1[e] = siluf_(a[8 + e]); }
        bf16_t* dst = lane < 32 ? xs + (size_t)m * 512 + c0 : bc + (size_t)m * 512 + (c0 - 512);
        ((u32x4*)dst)[0] = pack8(o0); ((u32x4*)dst)[1] = pack8(o1);
    }
}

__device__ __forceinline__ void s5_scan(const Ctx& cx_, int l) {
    const Ctx c = relaunder(cx_);
    if (c.tid >= 64) return;
    const int gt = c.bid * 64 + c.tid; if (gt >= 16384) return;
    const int n = gt & 63, d = (gt >> 6) & 1, b = (gt >> 7) & 7, g = gt >> 10;
    const size_t li_ = (((size_t)l * 2 + d) * 16 + g) * 64 + n;
    const float lr = c.in[I_S5LRE][li_], li = c.in[I_S5LIM][li_], step = expf(c.in[I_S5LS][((size_t)l * 2 + d) * 16 + g]);
    const float mag = expf(16.f * lr * step); float sn, cs; sincosf(16.f * li * step, &sn, &cs); const float ar = mag * cs, ai = mag * sn;
    const float* X = (const float*)(c.ws + WS_X) + ((size_t)g * S5RP + (size_t)b * NCH16) * 256 + d * 128 + n;
    bf16_t* U = (bf16_t*)(c.ws + WS_UH) + ((size_t)g * S5RP + (size_t)b * NCH16) * 512 + 256 + d * 128 + n;
    float hr = 0.f, hi = 0.f;
    for (int i0 = 0; i0 < NCH16; i0 += 32) {
        float xr[32], xi[32];
#pragma unroll
        for (int k = 0; k < 32; ++k) { const int i = i0 + k; const int ch = d == 0 ? i : NCH16 - 1 - i; const bool ok = i < NCH16; xr[k] = ok ? X[(size_t)ch * 256] : 0.f; xi[k] = ok ? X[(size_t)ch * 256 + 64] : 0.f; }
#pragma unroll
        for (int k = 0; k < 32; ++k) { const int i = i0 + k; if (i < NCH16) { const int ch = d == 0 ? i : NCH16 - 1 - i;
            U[(size_t)ch * 512] = (bf16_t)f2bf(hr); U[(size_t)ch * 512 + 64] = (bf16_t)f2bf(hi);
            const float nr = ar * hr - ai * hi + xr[k], ni = ar * hi + ai * hr + xi[k]; hr = nr; hi = ni; } }
    }
}
typedef short s16x4 __attribute__((ext_vector_type(4)));
__device__ __forceinline__ s16x4 lds_tr(const LAS unsigned char* p) { return __builtin_bit_cast(s16x4, __builtin_amdgcn_ds_read_tr16_b64_v4i16((LAS s16x4*)p)); }
__device__ __forceinline__ bf16x8 frag_tr(const LAS unsigned char* img, int rs, int kbase, int colbase, int lane) {
    const LAS unsigned char* a = img + (kbase + 8 * (lane >> 4) + ((lane & 15) >> 2)) * rs + (colbase + 4 * (lane & 3)) * 2;
    const s16x4 lo = lds_tr(a), hi = lds_tr(a + 4 * rs);
    return (bf16x8){lo[0], lo[1], lo[2], lo[3], hi[0], hi[1], hi[2], hi[3]};
}
__device__ __forceinline__ bf16x8 frag_row(const LAS unsigned char* img, int rs, int rowbase, int kbase, int lane) {
    return *(const LAS bf16x8*)(img + (rowbase + (lane & 15)) * rs + (kbase + 8 * (lane >> 4)) * 2);
}
constexpr int SD_RS = 272;
constexpr int SD_XRS = 144;
constexpr int SD_OFF_C = 0, SD_OFF_B = 34816, SD_OFF_X = 69632, SD_OFF_M = 88064, SD_OFF_SC = 122880;
constexpr int SD_OFF_HF = SD_OFF_B, SD_OFF_HB = SD_OFF_B + 17408;
constexpr size_t WS_STB = WS_YSSD;
constexpr size_t WS_CDEC = WS_DEC + (size_t)MP * 64 + 256;
constexpr size_t WS_SSQB = WS_CDEC + (size_t)BATCH * 33 * 16 * 4;
constexpr size_t WS_BAR = (WS_SSQB + (size_t)MP * 8 + 255) / 256 * 256;
static_assert(WS_BAR + 3456 * 4 <= 7 * QB, "small region");
static_assert((size_t)BATCH * 2 * 8 * 32 * 8192 * 2 <= 4 * QB, "chunk states fit the yssd slot");

struct SsdUnit { int b, ck, t0, ns; };
__device__ __forceinline__ bool ssd_unit(int bid, int round, SsdUnit& u) {
    if (round == 0) { u.b = bid >> 5; u.ck = 1 + (bid & 31); u.t0 = NMETA + 128 * (u.ck - 1); u.ns = 8; return true; }
    if (round == 1 && bid < BATCH) { u.b = bid; u.ck = 0; u.t0 = 0; u.ns = 1; return true; }
    return false;
}
__device__ __forceinline__ void ssd_load_img(LAS unsigned char* img, int rs, const bf16_t* src, int ld, size_t m0, int col0, int ncol, int ns, int tid) {
    const int cpr = ncol / 8, nrow = ns == 1 ? 32 : 128;
    for (int i = tid; i < nrow * cpr; i += NTHREADS) {
        const int r = i / cpr, cc = i - r * cpr; u32x4 v = (u32x4){0u, 0u, 0u, 0u};
        if (r < 16 * ns) v = *(const u32x4*)(src + (m0 + r) * ld + col0 + cc * 8);
        *(LAS u32x4*)(img + r * rs + cc * 16) = v;
    }
}
__device__ __forceinline__ void ssd_scalars(LAS float* sc, const float* dt, const float* al, size_t m0, int head, int ns, int lane, float& totf, float& totb) {
    const int Q = 16 * ns;
    float a0f = 0.f, a1f = 0.f, a0b = 0.f, a1b = 0.f, d0f = 0.f, d1f = 0.f, d0b = 0.f, d1b = 0.f;
    const int s0 = 2 * lane, s1 = 2 * lane + 1;
    if (s0 < Q) { a0f = al[(m0 + s0) * 16 + head]; a0b = al[(m0 + s0) * 16 + 8 + head]; d0f = dt[(m0 + s0) * 16 + head]; d0b = dt[(m0 + s0) * 16 + 8 + head]; }
    if (s1 < Q) { a1f = al[(m0 + s1) * 16 + head]; a1b = al[(m0 + s1) * 16 + 8 + head]; d1f = dt[(m0 + s1) * 16 + head]; d1b = dt[(m0 + s1) * 16 + 8 + head]; }
    float pf = a0f + a1f, pb = a0b + a1b;
#pragma unroll
    for (int o = 1; o < 64; o <<= 1) { const float tf = __shfl_up(pf, o), tb = __shfl_up(pb, o); if (lane >= o) { pf += tf; pb += tb; } }
    totf = __shfl(pf, 63); totb = __shfl(pb, 63);
    const float af1 = pf, af0 = pf - a1f;
    const float eb0 = pb - a0b - a1b, eb1 = pb - a1b;
    sc[s0] = af0; sc[s1] = af1; sc[128 + s0] = eb0; sc[128 + s1] = eb1; sc[256 + s0] = d0f; sc[256 + s1] = d1f; sc[384 + s0] = d0b; sc[384 + s1] = d1b;
    sc[512 + s0] = __expf(totf - af0) * d0f; sc[512 + s1] = __expf(totf - af1) * d1f;
    sc[640 + s0] = __expf(eb0) * d0b; sc[640 + s1] = __expf(eb1) * d1b;
    sc[768 + s0] = __expf(af0); sc[768 + s1] = __expf(af1);
    sc[896 + s0] = __expf(totb - eb0); sc[896 + s1] = __expf(totb - eb1);
}

__device__ __forceinline__ void ssd_states(const Ctx& cx_, int l) {
    const Ctx c = relaunder(cx_);
    const int tid = c.tid, lane = c.lane, wave = c.wave;
    const bf16_t* bc = (const bf16_t*)(c.ws + WS_BC); const bf16_t* xs = (const bf16_t*)(c.ws + WS_XS);
    const float* dt = (const float*)(c.ws + WS_DT); const float* al = (const float*)(c.ws + WS_DEC);
    bf16_t* stb = (bf16_t*)(c.ws + WS_STB); float* cdec = (float*)(c.ws + WS_CDEC);
    LAS unsigned char* Bimg = c.lds + SD_OFF_B; LAS unsigned char* Ximg = c.lds + SD_OFF_X; LAS float* sc = (LAS float*)(c.lds + SD_OFF_SC);
    for (int round = 0; round < 2; ++round) {
        SsdUnit u; if (!ssd_unit(c.bid, round, u)) break;
        const size_t m0 = (size_t)row_of(u.b, u.t0); const int nks = u.ns == 1 ? 1 : 4;
        for (int g = 0; g < 2; ++g) {
            __syncthreads();
            ssd_load_img(Bimg, SD_RS, bc, 512, m0, g * 128, 128, u.ns, tid);
            for (int j = 0; j < 4; ++j) {
                const int head = g * 4 + j;
                if (j) __syncthreads();
                ssd_load_img(Ximg, SD_XRS, xs, 512, m0, head * 64, 64, u.ns, tid);
                if (wave == 0) { float totf, totb; ssd_scalars(sc, dt, al, m0, head, u.ns, lane, totf, totb);
                    if (lane == 0) { cdec[((size_t)u.b * 33 + u.ck) * 16 + head] = __expf(totf); cdec[((size_t)u.b * 33 + u.ck) * 16 + 8 + head] = __expf(totb); } }
                __syncthreads();
                f32x4 accf[4], accb[4];
#pragma unroll
                for (int pt = 0; pt < 4; ++pt) { accf[pt] = (f32x4){0.f, 0.f, 0.f, 0.f}; accb[pt] = accf[pt]; }
                for (int ks = 0; ks < nks; ++ks) {
                    const bf16x8 af = frag_tr(Bimg, SD_RS, 32 * ks, 16 * wave, lane);
                    const int k0 = 32 * ks + 8 * (lane >> 4);
                    const f32x4 wf0 = *(const LAS f32x4*)(sc + 512 + k0), wf1 = *(const LAS f32x4*)(sc + 512 + k0 + 4), wb0 = *(const LAS f32x4*)(sc + 640 + k0), wb1 = *(const LAS f32x4*)(sc + 640 + k0 + 4);
#pragma unroll
                    for (int pt = 0; pt < 4; ++pt) {
                        const bf16x8 xr = frag_tr(Ximg, SD_XRS, 32 * ks, 16 * pt, lane);
                        float xf[8];
#pragma unroll
                        for (int e = 0; e < 8; ++e) xf[e] = bf1((bf16_t)xr[e]);
                        bf16x8 bfv, bbv;
                        { const unsigned p0 = pk2(xf[0] * wf0.x, xf[1] * wf0.y), p1 = pk2(xf[2] * wf0.z, xf[3] * wf0.w), p2 = pk2(xf[4] * wf1.x, xf[5] * wf1.y), p3 = pk2(xf[6] * wf1.z, xf[7] * wf1.w);
                          bfv = __builtin_bit_cast(bf16x8, (u32x4){p0, p1, p2, p3}); }
                        { const unsigned p0 = pk2(xf[0] * wb0.x, xf[1] * wb0.y), p1 = pk2(xf[2] * wb0.z, xf[3] * wb0.w), p2 = pk2(xf[4] * wb1.x, xf[5] * wb1.y), p3 = pk2(xf[6] * wb1.z, xf[7] * wb1.w);
                          bbv = __builtin_bit_cast(bf16x8, (u32x4){p0, p1, p2, p3}); }
                        accf[pt] = __builtin_amdgcn_mfma_f32_16x16x32_bf16(af, bfv, accf[pt], 0, 0, 0);
                        accb[pt] = __builtin_amdgcn_mfma_f32_16x16x32_bf16(af, bbv, accb[pt], 0, 0, 0);
                    }
                }
#pragma unroll
                for (int pt = 0; pt < 4; ++pt) {
                    const int p = 16 * pt + (lane & 15), n0 = 16 * wave + 4 * (lane >> 4);
                    if (u.ck <= 31) { bf16_t* d = stb + ((((size_t)u.b * 2 + 0) * 8 + head) * 32 + u.ck) * 8192 + (size_t)p * 128 + n0; *(u32x2*)d = (u32x2){pk2(accf[pt][0], accf[pt][1]), pk2(accf[pt][2], accf[pt][3])}; }
                    if (u.ck >= 1) { bf16_t* d = stb + ((((size_t)u.b * 2 + 1) * 8 + head) * 32 + (u.ck - 1)) * 8192 + (size_t)p * 128 + n0; *(u32x2*)d = (u32x2){pk2(accb[pt][0], accb[pt][1]), pk2(accb[pt][2], accb[pt][3])}; }
                }
            }
        }
    }
    __syncthreads();
}

__device__ __forceinline__ void ssd_chunk_scan(const Ctx& cx_, int l) {
    const Ctx c = relaunder(cx_);
    bf16_t* stb = (bf16_t*)(c.ws + WS_STB); const float* cdec = (const float*)(c.ws + WS_CDEC);
    const int gt = c.bid * NTHREADS + c.tid;
    const int e8 = gt & 1023, bdh = gt >> 10;
    if (bdh >= BATCH * 16) return;
    const int head = bdh & 7, dir = (bdh >> 3) & 1, b = bdh >> 4;
    bf16_t* base = stb + (size_t)bdh * 32 * 8192 + (size_t)e8 * 8;
    float h[8] = {0.f, 0.f, 0.f, 0.f, 0.f, 0.f, 0.f, 0.f};
    for (int i0 = 0; i0 < 32; i0 += 8) {
        u32x4 v[8]; float dcy[8];
#pragma unroll
        for (int k = 0; k < 8; ++k) { const int slot = dir == 0 ? i0 + k : 31 - (i0 + k); v[k] = *(const u32x4*)(base + (size_t)slot * 8192);
            const int ck = dir == 0 ? slot : slot + 1; dcy[k] = cdec[((size_t)b * 33 + ck) * 16 + dir * 8 + head]; }
#pragma unroll
        for (int k = 0; k < 8; ++k) { const int slot = dir == 0 ? i0 + k : 31 - (i0 + k); float s[8]; unpack8(v[k], s);
#pragma unroll
            for (int e = 0; e < 8; ++e) h[e] = h[e] * dcy[k] + s[e];
            *(u32x4*)(base + (size_t)slot * 8192) = pack8(h); }
    }
}

__device__ __forceinline__ bool ssd_unit_n(int idx, int nblk, int round, SsdUnit& u, int& grp) {
    const int n2 = idx + nblk * round; if (n2 >= 528) return false; const int n = n2 >> 1; grp = n2 & 1;
    if (n < 256) { u.b = n >> 5; u.ck = 1 + (n & 31); u.t0 = NMETA + 128 * (u.ck - 1); u.ns = 8; } else { u.b = n - 256; u.ck = 0; u.t0 = 0; u.ns = 1; }
    return true;
}
__device__ __forceinline__ void ssd_outputs(const Ctx& cx_, int l, int first, int nblk) {
    const Ctx c = relaunder(cx_);
    const int tid = c.tid, lane = c.lane, wave = c.wave;
    const bf16_t* bc = (const bf16_t*)(c.ws + WS_BC); const bf16_t* xs = (const bf16_t*)(c.ws + WS_XS); const bf16_t* pz = (const bf16_t*)(c.ws + WS_PZ);
    const float* dt = (const float*)(c.ws + WS_DT); const float* al = (const float*)(c.ws + WS_DEC);
    const bf16_t* stb = (const bf16_t*)(c.ws + WS_STB); bf16_t* yb = (bf16_t*)(c.ws + WS_YB); float* ssqb = (float*)(c.ws + WS_SSQB);
    LAS unsigned char* Cimg = c.lds + SD_OFF_C; LAS unsigned char* Bimg = c.lds + SD_OFF_B; LAS unsigned char* Ximg = c.lds + SD_OFF_X;
    LAS unsigned char* HfT = c.lds + SD_OFF_HF; LAS unsigned char* HbT = c.lds + SD_OFF_HB;
    LAS unsigned char* Ms = c.lds + SD_OFF_M + wave * 4352; LAS float* sc = (LAS float*)(c.lds + SD_OFF_SC);
    for (int round = 0; round < 8; ++round) {
        SsdUnit u; int g0; if (!ssd_unit_n(c.bid - first, nblk, round, u, g0)) break;
        const size_t m0 = (size_t)row_of(u.b, u.t0); const int nks = u.ns == 1 ? 1 : 4; const bool active = wave < u.ns;
        float ssrow = 0.f;
        for (int g = g0; g <= g0; ++g) {
            __syncthreads();
            ssd_load_img(Cimg, SD_RS, bc, 512, m0, 256 + g * 128, 128, u.ns, tid);
            ssd_load_img(Bimg, SD_RS, bc, 512, m0, g * 128, 128, u.ns, tid);
            __syncthreads();
            f32x4 cb[8];
#pragma unroll
            for (int t = 0; t < 8; ++t) cb[t] = (f32x4){0.f, 0.f, 0.f, 0.f};
            if (active) {
#pragma unroll
                for (int ks = 0; ks < 4; ++ks) {
                    const bf16x8 cfr = frag_row(Cimg, SD_RS, 16 * wave, 32 * ks, lane);
#pragma unroll
                    for (int t = 0; t < 8; ++t) if (t < u.ns) cb[t] = __builtin_amdgcn_mfma_f32_16x16x32_bf16(frag_row(Bimg, SD_RS, 16 * t, 32 * ks, lane), cfr, cb[t], 0, 0, 0);
                }
            }
            for (int j = 0; j < 4; ++j) {
                const int head = g * 4 + j;
                __syncthreads();
                ssd_load_img(Ximg, SD_XRS, xs, 512, m0, head * 64, 64, u.ns, tid);
                {
                    const bf16_t* hf = u.ck >= 1 ? stb + ((((size_t)u.b * 2 + 0) * 8 + head) * 32 + (u.ck - 1)) * 8192 : nullptr;
                    const bf16_t* hb = u.ck <= 31 ? stb + ((((size_t)u.b * 2 + 1) * 8 + head) * 32 + u.ck) * 8192 : nullptr;
                    for (int i = tid; i < 64 * 16; i += NTHREADS) { const int p = i >> 4, cc = i & 15;
                        *(LAS u32x4*)(HfT + p * SD_RS + cc * 16) = hf ? *(const u32x4*)(hf + p * 128 + cc * 8) : (u32x4){0u, 0u, 0u, 0u};
                        *(LAS u32x4*)(HbT + p * SD_RS + cc * 16) = hb ? *(const u32x4*)(hb + p * 128 + cc * 8) : (u32x4){0u, 0u, 0u, 0u}; }
                }
                if (wave == 0) { float totf, totb; ssd_scalars(sc, dt, al, m0, head, u.ns, lane, totf, totb); }
                __syncthreads();
                if (active) {
                    const int ll = 16 * wave + (lane & 15); const float afl = sc[ll], ebl = sc[128 + ll];
#pragma unroll
                    for (int t = 0; t < 8; ++t) {
                        u32x2 w2 = (u32x2){0u, 0u};
                        if (t < u.ns) {
                            const int s0 = 16 * t + 4 * (lane >> 4);
                            const f32x4 afs = *(const LAS f32x4*)(sc + s0), ebs = *(const LAS f32x4*)(sc + 128 + s0), dfs = *(const LAS f32x4*)(sc + 256 + s0), dbs = *(const LAS f32x4*)(sc + 384 + s0);
                            float mv[4];
#pragma unroll
                            for (int r = 0; r < 4; ++r) { const int s = s0 + r; float wgt = 0.f; if (s <= ll) wgt += __expf(afl - afs[r]) * dfs[r]; if (s >= ll) wgt += __expf(ebs[r] - ebl) * dbs[r]; mv[r] = cb[t][r] * wgt; }
                            w2 = (u32x2){pk2(mv[0], mv[1]), pk2(mv[2], mv[3])};
                        }
                        if (t < 2 * nks) *(LAS u32x2*)(Ms + (lane & 15) * SD_RS + (16 * t + 4 * (lane >> 4)) * 2) = w2;
                    }
                    asm volatile("s_waitcnt lgkmcnt(0)" ::: "memory");
                    f32x4 ay[4], ahf[4], ahb[4];
#pragma unroll
                    for (int pt = 0; pt < 4; ++pt) { ay[pt] = (f32x4){0.f, 0.f, 0.f, 0.f}; ahf[pt] = ay[pt]; ahb[pt] = ay[pt]; }
                    for (int ks = 0; ks < nks; ++ks) {
                        const bf16x8 mf = frag_row(Ms, SD_RS, 0, 32 * ks, lane);
#pragma unroll
                        for (int pt = 0; pt < 4; ++pt) ay[pt] = __builtin_amdgcn_mfma_f32_16x16x32_bf16(mf, frag_tr(Ximg, SD_XRS, 32 * ks, 16 * pt, lane), ay[pt], 0, 0, 0);
                    }
#pragma unroll
                    for (int ks = 0; ks < 4; ++ks) {
                        const bf16x8 cfr = frag_row(Cimg, SD_RS, 16 * wave, 32 * ks, lane);
#pragma unroll
                        for (int pt = 0; pt < 4; ++pt) {
                            ahf[pt] = __builtin_amdgcn_mfma_f32_16x16x32_bf16(cfr, frag_row(HfT, SD_RS, 16 * pt, 32 * ks, lane), ahf[pt], 0, 0, 0);
                            ahb[pt] = __builtin_amdgcn_mfma_f32_16x16x32_bf16(cfr, frag_row(HbT, SD_RS, 16 * pt, 32 * ks, lane), ahb[pt], 0, 0, 0);
                        }
                    }
                    const int l0 = 16 * wave + 4 * (lane >> 4);
                    const f32x4 efv = *(const LAS f32x4*)(sc + 768 + l0), ebv = *(const LAS f32x4*)(sc + 896 + l0);
                    asm volatile("s_waitcnt lgkmcnt(0)" ::: "memory");
                    LAS float* ys = (LAS float*)Ms;
#pragma unroll
                    for (int pt = 0; pt < 4; ++pt)
#pragma unroll
                        for (int r = 0; r < 4; ++r) ys[(4 * (lane >> 4) + r) * 68 + 16 * pt + (lane & 15)] = ay[pt][r] + efv[r] * ahf[pt][r] + ebv[r] * ahb[pt][r];
                    asm volatile("s_waitcnt lgkmcnt(0)" ::: "memory");
                    const int rr = lane >> 2, p0 = 16 * (lane & 3); const size_t m = m0 + 16 * wave + rr;
                    const float dsk = c.in[I_SSDD][l * 8 + head];
                    float xv[16], zv[16];
                    { float t8[8]; unpack8(*(const LAS u32x4*)(Ximg + (16 * wave + rr) * SD_XRS + p0 * 2), t8);
#pragma unroll
                      for (int e = 0; e < 8; ++e) xv[e] = t8[e];
                      unpack8(*(const LAS u32x4*)(Ximg + (16 * wave + rr) * SD_XRS + p0 * 2 + 16), t8);
#pragma unroll
                      for (int e = 0; e < 8; ++e) xv[8 + e] = t8[e];
                      unpack8(*(const u32x4*)(pz + m * 512 + head * 64 + p0), t8);
#pragma unroll
                      for (int e = 0; e < 8; ++e) zv[e] = t8[e];
                      unpack8(*(const u32x4*)(pz + m * 512 + head * 64 + p0 + 8), t8);
#pragma unroll
                      for (int e = 0; e < 8; ++e) zv[8 + e] = t8[e]; }
                    float o[16];
#pragma unroll
                    for (int e4 = 0; e4 < 4; ++e4) { const f32x4 yv = *(const LAS f32x4*)(ys + rr * 68 + p0 + 4 * e4);
#pragma unroll
                        for (int e = 0; e < 4; ++e) { const float val = (yv[e] + dsk * xv[4 * e4 + e]) * siluf_(zv[4 * e4 + e]); o[4 * e4 + e] = val; ssrow += val * val; } }
                    u32x4 w0, w1; w0.x = pk2(o[0], o[1]); w0.y = pk2(o[2], o[3]); w0.z = pk2(o[4], o[5]); w0.w = pk2(o[6], o[7]); w1.x = pk2(o[8], o[9]); w1.y = pk2(o[10], o[11]); w1.z = pk2(o[12], o[13]); w1.w = pk2(o[14], o[15]);
                    *(u32x4*)(yb + m * 512 + head * 64 + p0) = w0; *(u32x4*)(yb + m * 512 + head * 64 + p0 + 8) = w1;
                }
            }
        }
        if (active) { ssrow += dpp_mov<0xB1>(ssrow); ssrow += dpp_mov<0x4E>(ssrow); if ((lane & 3) == 0) ssqb[(m0 + 16 * wave + (lane >> 2)) * 2 + g0] = ssrow; }
    }
    __syncthreads();
}
typedef short s16x4v __attribute__((ext_vector_type(4)));
constexpr int RC_NCH = LEN / 16;
constexpr int RC_NP = 5;
constexpr int RC_ROUNDS = (RC_NCH + RC_NP - 1) / RC_NP;
constexpr int RC_S64 = 144;
constexpr int RC_S16 = 40;
constexpr int RC_AT = 0, RC_RT = 2304, RC_BH = 4608, RC_KH = 6912, RC_T = 9216, RC_AAK = 9856, RC_ARB = 10496, RC_ARK = 11136, RC_VT = 11776, RC_P16 = 12416, RC_SLOT = 12800;
constexpr int RC_SCR0 = 2 * RC_NP * RC_SLOT;
constexpr int RC_SCR = 1280;
static_assert(RC_SCR0 + RC_NP * RC_SCR <= 147456 - 512, "rwkv chunk LDS");
__device__ __forceinline__ f32x4 mm16(s16x4v a, s16x4v b, f32x4 c, int, int, int) { return __builtin_amdgcn_mfma_f32_16x16x32_bf16((bf16x8){a[0], a[1], a[2], a[3], 0, 0, 0, 0}, (bf16x8){b[0], b[1], b[2], b[3], 0, 0, 0, 0}, c, 0, 0, 0); }
__device__ __forceinline__ s16x4v mfma16_frag(const LAS unsigned char* mat, int row, int q) { return *(const LAS s16x4v*)(mat + row * RC_S16 + q * 8); }

constexpr int RC64_NP = 4, RC64_ROUNDS = (RC_NCH + RC64_NP - 1) / RC64_NP;
constexpr int RC64_V = 11776, RC64_P16 = 14080, RC64_SLOT = 14336;
constexpr int RC64_SCR0 = 2 * RC64_NP * RC64_SLOT;
static_assert(RC64_SCR0 + RC64_NP * RC_SCR <= 147456 - 512, "rwkv64 LDS");
__device__ __forceinline__ void rwkv_chunked64(const Ctx& cx_, int l) {
    const Ctx c = relaunder(cx_);


    const int bid = c.bid, dir = bid & 1, head = (bid >> 1) & 3, b = bid >> 3;
    const int lane = c.lane, wave = c.wave;
    const bf16_t* rk = (const bf16_t*)(c.dout + DO_RKVP) + head * 64; const bf16_t* l2 = (const bf16_t*)(c.ws + WS_L2O) + dir * 256 + head * 64;
    bf16_t* yo = (bf16_t*)(c.ws + WS_YRW) + (size_t)dir * MP * 256 + head * 64 + 16 * (wave & 3);
    auto tok = [&](int s) -> size_t { const int t = s + dir * (LEN - 1 - 2 * s); return (size_t)row_of(b, t); };
    const int q = lane >> 4, li = lane & 15;
    u32x4 Rr[2], Kr[2], KKr[2], DLr[2], ASr[2], Vr[2];
    auto load_raw = [&](int ch) {
        const size_t m = tok(16 * ch + li); const int k0 = 16 * q;
#pragma unroll
        for (int h = 0; h < 2; ++h) { Rr[h] = *(const u32x4*)(rk + m * 1024 + k0 + 8 * h); Kr[h] = *(const u32x4*)(rk + m * 1024 + 256 + k0 + 8 * h); KKr[h] = *(const u32x4*)(rk + m * 1024 + 768 + k0 + 8 * h);
            DLr[h] = *(const u32x4*)(l2 + m * 1280 + k0 + 8 * h); ASr[h] = *(const u32x4*)(l2 + m * 1280 + 512 + k0 + 8 * h); Vr[h] = *(const u32x4*)(rk + m * 1024 + 512 + k0 + 8 * h); }
    };
    float kaall[16];
#pragma unroll
    for (int e = 0; e < 16; ++e) kaall[e] = c.in[I_KA][(size_t)l * 256 + head * 64 + 16 * q + e];
    auto produce = [&](int slot) {
        LAS unsigned char* sb = c.lds + slot * RC64_SLOT; LAS float* Aab = (LAS float*)(c.lds + RC64_SCR0 + (wave - 4) * RC_SCR);
        LAS unsigned char* Bh = sb + RC_BH; LAS unsigned char* Kh = sb + RC_KH;
        *(LAS u32x4*)(sb + RC64_V + li * RC_S64 + (16 * q) * 2) = Vr[0]; *(LAS u32x4*)(sb + RC64_V + li * RC_S64 + (16 * q + 8) * 2) = Vr[1];
        const int k0 = 16 * q;
#pragma unroll
        for (int h = 0; h < 2; ++h) {
            float r_[8], k_[8], kk_[8], dl_[8], as_[8], cs_[8]; unpack8(Rr[h], r_); unpack8(Kr[h], k_); unpack8(KKr[h], kk_); unpack8(DLr[h], dl_); unpack8(ASr[h], as_);
            const float* ka = kaall + 8 * h;
            float at_[8], rt_[8], bh_[8], kh_[8], p_[8];
#pragma unroll
            for (int e = 0; e < 8; ++e) {
                float x = dl_[e];
                x += dpp_mov<0x111>(x); x += dpp_mov<0x112>(x); x += dpp_mov<0x114>(x); x += dpp_mov<0x118>(x);
                cs_[e] = x;
            }
#pragma unroll
            for (int e = 0; e < 8; ++e) {
                const float P = __expf(cs_[e]), Pm = __expf(cs_[e] - dl_[e]), iP = __expf(-cs_[e]);
                at_[e] = -kk_[e] * Pm; rt_[e] = r_[e] * P; bh_[e] = kk_[e] * as_[e] * iP; kh_[e] = k_[e] * (1.f + (as_[e] - 1.f) * ka[e]) * iP; p_[e] = P;
            }
            *(LAS u32x4*)(sb + RC_AT + li * RC_S64 + (k0 + 8 * h) * 2) = pack8(at_); *(LAS u32x4*)(sb + RC_RT + li * RC_S64 + (k0 + 8 * h) * 2) = pack8(rt_);
            *(LAS u32x4*)(Bh + li * RC_S64 + (k0 + 8 * h) * 2) = pack8(bh_); *(LAS u32x4*)(Kh + li * RC_S64 + (k0 + 8 * h) * 2) = pack8(kh_);
            if (li == 15) { *(LAS f32x4*)(sb + RC64_P16 + (k0 + 8 * h) * 4) = (f32x4){p_[0], p_[1], p_[2], p_[3]}; *(LAS f32x4*)(sb + RC64_P16 + (k0 + 8 * h + 4) * 4) = (f32x4){p_[4], p_[5], p_[6], p_[7]}; }
        }
        asm volatile("s_waitcnt lgkmcnt(0)" ::: "memory");
        f32x4 ab = (f32x4){0.f, 0.f, 0.f, 0.f}, ak = ab, rb = ab, rkm = ab;
#pragma unroll
        for (int ks = 0; ks < 2; ++ks) {
            const bf16x8 fa = *(const LAS bf16x8*)(sb + RC_AT + li * RC_S64 + (32 * ks + 8 * q) * 2), fr = *(const LAS bf16x8*)(sb + RC_RT + li * RC_S64 + (32 * ks + 8 * q) * 2);
            const bf16x8 fb = *(const LAS bf16x8*)(Bh + li * RC_S64 + (32 * ks + 8 * q) * 2), fk = *(const LAS bf16x8*)(Kh + li * RC_S64 + (32 * ks + 8 * q) * 2);
            ab = __builtin_amdgcn_mfma_f32_16x16x32_bf16(fa, fb, ab, 0, 0, 0); ak = __builtin_amdgcn_mfma_f32_16x16x32_bf16(fa, fk, ak, 0, 0, 0);
            rb = __builtin_amdgcn_mfma_f32_16x16x32_bf16(fr, fb, rb, 0, 0, 0); rkm = __builtin_amdgcn_mfma_f32_16x16x32_bf16(fr, fk, rkm, 0, 0, 0);
        }
#pragma unroll
        for (int r = 0; r < 4; ++r) {
            const int t = 4 * q + r, s = li;
            Aab[t * 20 + s] = s < t ? ab[r] : 0.f;
            *(LAS bf16_t*)(sb + RC_AAK + t * RC_S16 + s * 2) = (bf16_t)f2bf(s < t ? ak[r] : 0.f);
            *(LAS bf16_t*)(sb + RC_ARB + t * RC_S16 + s * 2) = (bf16_t)f2bf(s <= t ? rb[r] : 0.f);
            *(LAS bf16_t*)(sb + RC_ARK + t * RC_S16 + s * 2) = (bf16_t)f2bf(s <= t ? rkm[r] : 0.f);
        }
        asm volatile("s_waitcnt lgkmcnt(0)" ::: "memory");
        float tc[16];
#pragma unroll
        for (int t = 0; t < 16; ++t) {
            float acc = (t == li) ? 1.f : 0.f;
            f32x4 a0 = *(const LAS f32x4*)(Aab + t * 20), a1 = *(const LAS f32x4*)(Aab + t * 20 + 4), a2 = *(const LAS f32x4*)(Aab + t * 20 + 8), a3 = *(const LAS f32x4*)(Aab + t * 20 + 12);
            const float av[16] = {a0.x, a0.y, a0.z, a0.w, a1.x, a1.y, a1.z, a1.w, a2.x, a2.y, a2.z, a2.w, a3.x, a3.y, a3.z, a3.w};
            float a1_ = 0.f, a2_ = 0.f, a3_ = 0.f;
#pragma unroll
            for (int s = 0; s < t; ++s) { const float pr_ = av[s] * tc[s]; if ((s & 3) == 0) acc += pr_; else if ((s & 3) == 1) a1_ += pr_; else if ((s & 3) == 2) a2_ += pr_; else a3_ += pr_; }
            tc[t] = (acc + a1_) + (a2_ + a3_);
        }
        if (q == 0) {
#pragma unroll
            for (int t = 0; t < 16; ++t) *(LAS bf16_t*)(sb + RC_T + t * RC_S16 + li * 2) = (bf16_t)f2bf(tc[t]);
        }
    };
    if (wave >= 4 && wave - 4 < RC64_NP) { const int ch0 = wave - 4; load_raw(ch0); produce(wave - 4); load_raw(ch0 + RC64_NP); }
    __syncthreads();
    f32x4 S[4]; bf16x8 sop[2];
#pragma unroll
    for (int kt = 0; kt < 4; ++kt) S[kt] = (f32x4){0.f, 0.f, 0.f, 0.f};
    sop[0] = (bf16x8){0, 0, 0, 0, 0, 0, 0, 0}; sop[1] = sop[0];
    int sbase = 0;
    auto consume = [&](const int i, const int ch) {
                const LAS unsigned char* sb = c.lds + (sbase + i) * RC64_SLOT;
        const s16x4v vt = lds_tr(sb + RC64_V + (4 * q + (li >> 2)) * RC_S64 + (16 * (wave & 3) + 4 * (li & 3)) * 2);
        f32x4 aw = mm16(mfma16_frag(sb + RC_AAK, li, q), vt, (f32x4){0.f, 0.f, 0.f, 0.f}, 0, 0, 0);
        f32x4 ay = mm16(mfma16_frag(sb + RC_ARK, li, q), vt, (f32x4){0.f, 0.f, 0.f, 0.f}, 0, 0, 0);
#pragma unroll
        for (int ks = 0; ks < 2; ++ks) {
            const s16x4v alo = *(const LAS s16x4v*)(sb + RC_AT + li * RC_S64 + (32 * ks + 4 * q) * 2), ahi = *(const LAS s16x4v*)(sb + RC_AT + li * RC_S64 + (32 * ks + 16 + 4 * q) * 2);
            const s16x4v rlo = *(const LAS s16x4v*)(sb + RC_RT + li * RC_S64 + (32 * ks + 4 * q) * 2), rhi = *(const LAS s16x4v*)(sb + RC_RT + li * RC_S64 + (32 * ks + 16 + 4 * q) * 2);
            aw = __builtin_amdgcn_mfma_f32_16x16x32_bf16((bf16x8){alo[0], alo[1], alo[2], alo[3], ahi[0], ahi[1], ahi[2], ahi[3]}, sop[ks], aw, 0, 0, 0);
            ay = __builtin_amdgcn_mfma_f32_16x16x32_bf16((bf16x8){rlo[0], rlo[1], rlo[2], rlo[3], rhi[0], rhi[1], rhi[2], rhi[3]}, sop[ks], ay, 0, 0, 0);
        }
        const u32x2 wb2 = (u32x2){pk2(aw[0], aw[1]), pk2(aw[2], aw[3])};
        const f32x4 au = mm16(mfma16_frag(sb + RC_T, li, q), __builtin_bit_cast(s16x4v, wb2), (f32x4){0.f, 0.f, 0.f, 0.f}, 0, 0, 0);
        const u32x2 ub2 = (u32x2){pk2(au[0], au[1]), pk2(au[2], au[3])}; const s16x4v ub = __builtin_bit_cast(s16x4v, ub2);
        ay = mm16(mfma16_frag(sb + RC_ARB, li, q), ub, ay, 0, 0, 0);
#pragma unroll
        for (int kt = 0; kt < 4; ++kt) {
            const f32x4 p16 = *(const LAS f32x4*)(sb + RC64_P16 + (16 * kt + 4 * q) * 4);
            const int troff = (4 * q + (li >> 2)) * RC_S64 + (16 * kt + 4 * (li & 3)) * 2;
            f32x4 sv = S[kt];
            sv = mm16(lds_tr(sb + RC_KH + troff), vt, sv, 0, 0, 0);
            sv = mm16(lds_tr(sb + RC_BH + troff), ub, sv, 0, 0, 0);
            sv = sv * p16;
            S[kt] = sv;
        }
#pragma unroll
        for (int ks = 0; ks < 2; ++ks) {
            const u32x4 w = (u32x4){pk2(S[2 * ks][0], S[2 * ks][1]), pk2(S[2 * ks][2], S[2 * ks][3]), pk2(S[2 * ks + 1][0], S[2 * ks + 1][1]), pk2(S[2 * ks + 1][2], S[2 * ks + 1][3])};
            sop[ks] = __builtin_bit_cast(bf16x8, w);
        }
#pragma unroll
        for (int r = 0; r < 4; ++r) yo[tok(16 * ch + 4 * q + r) * 256 + li] = (bf16_t)f2bf(ay[r]);
    };
    for (int rd = 0; rd < RC64_ROUNDS; ++rd) {
        if (wave < 4) {
            sbase = (rd & 1) * RC64_NP;
            if (rd < RC64_ROUNDS - 1) {
#pragma unroll
                for (int i = 0; i < RC64_NP; ++i) consume(i, RC64_NP * rd + i);
            } else {
                for (int i = 0; i < RC64_NP; ++i) { const int ch = RC64_NP * rd + i; if (ch >= RC_NCH) break; consume(i, ch); }
            }
        } else if (wave - 4 < RC64_NP) {
            const int chn = RC64_NP * (rd + 1) + (wave - 4);
            if (chn < RC_NCH) { produce(((rd + 1) & 1) * RC64_NP + (wave - 4)); if (chn + RC64_NP < RC_NCH) load_raw(chn + RC64_NP); }
        }
        __syncthreads();
    }
}
__device__ __forceinline__ f32x4 mg_dot(const bf16_t* __restrict__ w, const bf16_t* __restrict__ x, int nk, f32x4 acc) {
#pragma unroll 8
    for (int k = 0; k < nk; ++k) acc = __builtin_amdgcn_mfma_f32_16x16x32_bf16(*(const bf16x8*)(w + k * 32), *(const bf16x8*)(x + k * 32), acc, 0, 0, 0);
    return acc;
}
__device__ __forceinline__ void mg_store4(bf16_t* dst, float a, float b, float c, float d) { uint2 w; w.x = pk2(a, b); w.y = pk2(c, d); *(uint2*)dst = w; }

__device__ __forceinline__ void meta_gates(const Ctx& c, int l) {
    const int lane = c.lane, wave = c.wave, li = lane & 15, lq = lane >> 4, role = wave & 3, rh = wave >> 2;
    const int c0 = (c.bid >> 2) * 16, row = BATCH * SEQ + ((c.bid & 3) * 2 + rh) * 16 + li;
    const bf16_t* wbase = c.wb(l);
    LAS float* sg = (LAS float*)c.lds;
    const f32x4 zero = {0.f, 0.f, 0.f, 0.f};
    f32x4 p0 = zero, p1 = zero, p2 = zero;
    __syncthreads();
    if (role < 3) {
        const f32x4 acc = mg_dot(wbase + WB_G + ((size_t)role * 1024 + c0 + li) * DM + lq * 8, c.H() + (size_t)row * DM + lq * 8, 32, zero);
        const float s = row_scale(c.ssq(), row);
#pragma unroll
        for (int j = 0; j < 4; ++j) sg[((rh * 3 + role) * 4 + j) * 64 + lane] = sigmoidf_(acc[j] * s);
    } else {
        const bf16_t* wp = wbase + WB_P + (size_t)(c0 + li) * DM + lq * 8;
        p0 = mg_dot(wp, (const bf16_t*)(c.ws + WS_YA) + (size_t)row * 256 + lq * 8, 8, zero);
        p1 = mg_dot(wp + 256, (const bf16_t*)(c.ws + WS_YB) + (size_t)row * 512 + lq * 8, 16, zero);
        p2 = mg_dot(wp + 768, (const bf16_t*)(c.ws + WS_YC) + (size_t)row * 256 + lq * 8, 8, zero);
    }
    __syncthreads();
    if (role == 3) {
        const float* ssqb = (const float*)(c.ws + WS_SSQB);
        const float rsb = __builtin_amdgcn_rsqf((ssqb[2 * row] + ssqb[2 * row + 1]) * (1.0f / 512.f) + EPS);
        float m[4];
#pragma unroll
        for (int j = 0; j < 4; ++j) m[j] = sg[((rh * 3 + 0) * 4 + j) * 64 + lane] * p0[j] + sg[((rh * 3 + 1) * 4 + j) * 64 + lane] * rsb * p1[j] + sg[((rh * 3 + 2) * 4 + j) * 64 + lane] * p2[j];
        mg_store4((bf16_t*)(c.dout + DO_MERGED) + (size_t)row * DM + c0 + lq * 4, m[0], m[1], m[2], m[3]);
    }
    __syncthreads();
}

__device__ __forceinline__ void meta_resid(const Ctx& c, const bf16_t* A, const bf16_t* W, int K) {
    if (c.bid >= 128) return;
    const int lane = c.lane, wave = c.wave, li = lane & 15, lq = lane >> 4, blk = wave & 3, kh = wave >> 2;
    const int cg16 = c.bid & 15, c0 = cg16 * 64 + blk * 16, row = BATCH * SEQ + (c.bid >> 4) * 16 + li;
    LAS float* red = (LAS float*)c.lds;
    const f32x4 zero = {0.f, 0.f, 0.f, 0.f};
    __syncthreads();
    f32x4 acc = mg_dot(W + (size_t)(c0 + li) * K + kh * (K >> 1) + lq * 8, A + (size_t)row * K + kh * (K >> 1) + lq * 8, K >> 6, zero);
    if (kh == 1) {
#pragma unroll
        for (int j = 0; j < 4; ++j) red[(blk * 4 + j) * 64 + lane] = acc[j];
    }
    __syncthreads();
    float ss = 0.f;
    if (kh == 0) {
        bf16_t* hp = c.H() + (size_t)row * DM + c0 + lq * 4;
        const uint2 hv = *(const uint2*)hp;
        float f[4] = {bflo(hv.x), bfhi(hv.x), bflo(hv.y), bfhi(hv.y)};
#pragma unroll
        for (int j = 0; j < 4; ++j) { f[j] += acc[j] + red[(blk * 4 + j) * 64 + lane]; ss += f[j] * f[j]; }
        mg_store4(hp, f[0], f[1], f[2], f[3]);
        ss += __shfl_xor(ss, 16); ss += __shfl_xor(ss, 32);
    }
    __syncthreads();
    if (kh == 0 && lq == 0) red[blk * 16 + li] = ss;
    __syncthreads();
    if (wave == 0 && lq == 0) c.ssq()[(size_t)row * 16 + cg16] = (red[li] + red[16 + li]) + (red[32 + li] + red[48 + li]);
    __syncthreads();
}

__device__ __forceinline__ void meta_up(const Ctx& c, const bf16_t* W) {
    const int lane = c.lane, li = lane & 15, lq = lane >> 4;
    const int c0 = c.bid * 16, row = BATCH * SEQ + c.wave * 16 + li;
    const f32x4 zero = {0.f, 0.f, 0.f, 0.f};
    const f32x4 acc = mg_dot(W + (size_t)(c0 + li) * DM + lq * 8, c.H() + (size_t)row * DM + lq * 8, 32, zero);
    const float s = row_scale(c.ssq(), row);
    float f[4];
#pragma unroll
    for (int j = 0; j < 4; ++j) { const float r = fmaxf(acc[j] * s, 0.f); f[j] = r * r; }
    mg_store4((bf16_t*)(c.ws + WS_ACT) + (size_t)row * DFF + c0 + lq * 4, f[0], f[1], f[2], f[3]);
}

__device__ __forceinline__ void rwkv_post(const Ctx& cx_, int l) {
    const Ctx c = relaunder(cx_);
    const int gw = c.bid * NWAVES + c.wave, NGW = c.G * NWAVES, lane = c.lane, c0 = 4 * lane;
    const bf16_t* __restrict__ y0 = (const bf16_t*)(c.ws + WS_YRW); const bf16_t* __restrict__ y1 = y0 + (size_t)MP * 256;
    const bf16_t* __restrict__ rk = (const bf16_t*)(c.dout + DO_RKVP); const bf16_t* __restrict__ l2 = (const bf16_t*)(c.ws + WS_L2O); bf16_t* __restrict__ yc = (bf16_t*)(c.ws + WS_YC);
    float lw[4], lb[4], rkw[4];
#pragma unroll
    for (int e = 0; e < 4; ++e) { lw[e] = c.in[I_LNW][(size_t)l * 256 + c0 + e]; lb[e] = c.in[I_LNB][(size_t)l * 256 + c0 + e]; rkw[e] = c.in[I_RK][(size_t)l * 256 + c0 + e]; }
#pragma unroll 2
    for (int m = gw; m < M_ROWS; m += NGW) {
        const u32x2 a = *(const u32x2*)(y0 + (size_t)m * 256 + c0), bq = *(const u32x2*)(y1 + (size_t)m * 256 + c0);
        const u32x2 rr = *(const u32x2*)(rk + (size_t)m * 1024 + c0), kk = *(const u32x2*)(rk + (size_t)m * 1024 + 256 + c0), vv = *(const u32x2*)(rk + (size_t)m * 1024 + 512 + c0);
        const u32x2 gg = *(const u32x2*)(l2 + (size_t)m * 1280 + 1024 + c0);
        float y[4] = {bflo(a.x) + bflo(bq.x), bfhi(a.x) + bfhi(bq.x), bflo(a.y) + bflo(bq.y), bfhi(a.y) + bfhi(bq.y)};
        const float r[4] = {bflo(rr.x), bfhi(rr.x), bflo(rr.y), bfhi(rr.y)}, k[4] = {bflo(kk.x), bfhi(kk.x), bflo(kk.y), bfhi(kk.y)};
        const float v[4] = {bflo(vv.x), bfhi(vv.x), bflo(vv.y), bfhi(vv.y)}, g[4] = {bflo(gg.x), bfhi(gg.x), bflo(gg.y), bfhi(gg.y)};
        const float mean = sum16((y[0] + y[1]) + (y[2] + y[3])) * (1.f / 64.f);
        float q = 0.f, bo = 0.f;
#pragma unroll
        for (int e = 0; e < 4; ++e) { y[e] -= mean; q += y[e] * y[e]; bo += r[e] * k[e] * rkw[e]; }
        q = sum16(q) * (1.f / 64.f); bo = sum16(bo);
        const float rs = __builtin_amdgcn_rsqf(q + 64e-5f);
        float o[4];
#pragma unroll
        for (int e = 0; e < 4; ++e) o[e] = (y[e] * rs * lw[e] + lb[e] + bo * v[e]) * g[e];
        *(u32x2*)(yc + (size_t)m * 256 + c0) = (u32x2){pk2(o[0], o[1]), pk2(o[2], o[3])};
    }
}
__device__ __forceinline__ void final_phase(const Ctx& cx_, float* out) {
    const Ctx c = relaunder(cx_);
    const int gw = c.bid * NWAVES + c.wave, NGW = c.G * NWAVES, lane = c.lane;
    const bf16_t* H = c.H(); const f32x4* fw = (const f32x4*)c.in[I_FNW];
#pragma unroll 2
    for (int r = gw; r < BATCH * SEQ; r += NGW) {
        const size_t m = (size_t)r;
        const u32x2* hp = (const u32x2*)(H + m * DM);
        float v[4][4], ss = 0.f;
#pragma unroll
        for (int i = 0; i < 4; ++i) { const u32x2 w = hp[lane + 64 * i]; v[i][0] = bflo(w.x); v[i][1] = bfhi(w.x); v[i][2] = bflo(w.y); v[i][3] = bfhi(w.y); ss += (v[i][0] * v[i][0] + v[i][1] * v[i][1]) + (v[i][2] * v[i][2] + v[i][3] * v[i][3]); }
        ss = wave_sum(ss); const float s = __builtin_amdgcn_rsqf(ss * (1.0f / DM) + EPS);
        f32x4* op = (f32x4*)(out + (size_t)r * DM);
#pragma unroll
        for (int i = 0; i < 4; ++i) { const f32x4 w = fw[lane + 64 * i]; op[lane + 64 * i] = (f32x4){v[i][0] * s * w.x, v[i][1] * s * w.y, v[i][2] * s * w.z, v[i][3] * s * w.w}; }
    }
}

constexpr int LDS_BYTES = 147456;
#ifndef MIXDIR
#define MIXDIR 0
#define MIXLAYER 0
#endif
#ifndef PHMASK
#define PHMASK 0xFFFFF
#endif
__global__ void __launch_bounds__(NTHREADS, 2) mega_fwd(Params p) {
    extern __shared__ __attribute__((aligned(16))) unsigned char lds_raw[];
    cg::grid_group grid = cg::this_grid();
    Ctx c0_; c0_.in = p.in; c0_.ws = p.ws; c0_.dout = (unsigned char*)p.out; c0_.lds = (LAS unsigned char*)lds_raw;
    c0_.wave = __builtin_amdgcn_readfirstlane((int)threadIdx.x >> 6); c0_.tid = opaque_tid(c0_.wave); c0_.lane = c0_.tid & 63; c0_.G = gridDim.x; c0_.bid = blockIdx.x;
    Ctx c = c0_;
    const int G = c.G, bid = c.bid;
#ifdef PROF_A
#ifndef PROF_SHIFT
#define PROF_SHIFT 1.0f
#endif
#define PROF_PTR ((unsigned long long*)(c.ws + WS_DEC + (size_t)MP * 64))
    if (blockIdx.x == 0 && threadIdx.x == 0) { for (int k = 0; k < 15; ++k) PROF_PTR[k] = 0; PROF_PTR[15] = __builtin_amdgcn_s_memrealtime(); }
#define STAMP(k) do { if (blockIdx.x == 0 && threadIdx.x == 0) { const unsigned long long t_ = __builtin_amdgcn_s_memrealtime(); PROF_PTR[k] += t_ - PROF_PTR[15]; PROF_PTR[15] = t_; } } while (0)
#else
#define STAMP(k) do { } while (0)
#endif
    unsigned* barw = (unsigned*)(c.ws + WS_BAR);
    volatile LAS unsigned* bst = (volatile LAS unsigned*)(c.lds + LDS_BYTES - 64);
    if (bid == 0) for (int i = threadIdx.x; i < XCD_BAR_WORDS + 1024; i += NTHREADS) barw[i < XCD_BAR_WORDS ? i : 4096 + (i - XCD_BAR_WORDS)] = 0u;
    if (threadIdx.x < 2) bst[threadIdx.x] = 0u;
    __syncthreads();
    if (PHMASK & 1) phase0(c);
    grid.sync(); STAMP(0);
    const XcdBarrier xbar = xcd_barrier_post(barw, bst);
#define GRID_BAR() do { xcd_barrier(xbar, c0_.wave); c = relaunder(c0_); } while (0)
#pragma unroll 1
    for (int l = 0; l < DEPTH; ++l) {
#define wb (c.wb(l))
        if (PHMASK & 2) dt_job(c, l);
        if (PHMASK & 4) { SchedPlain S{c.H(), wb + WB_IN, DM, DM, DM, MP / 256, 11, G, bid, 0};
          EpiInProj E{c.ssq(), (bf16_t*)(c.ws + WS_UH), (bf16_t*)(c.ws + WS_PZ), (bf16_t*)(c.ws + WS_PXBC), (bf16_t*)(c.ws + WS_PRKVX)};
          pg8::gemm_phase(c.lds, c.wave, S, E); }
        GRID_BAR(); STAMP(1);
        if (PHMASK & 8) { SchedS5 S{(const bf16_t*)(c.ws + WS_UH), wb + WB_SX, 256, G, bid}; EpiS5X E{(float*)(c.ws + WS_X)}; pg8::gemm_phase(c.lds, c.wave, S, E); }
        if (PHMASK & 16) rwkv_prep(c, l);
        if (PHMASK & 32) ssd_prep(c, l);
        GRID_BAR(); STAMP(2);
        if (PHMASK & 64) s5_scan(c, l);
        if (PHMASK & 4096) ssd_states(c, l);
        if (PHMASK & 128) { SchedPlain S{(const bf16_t*)(c.ws + WS_L1IN), wb + WB_L1, 512, 512, 512, MP / 256, 2, G, bid, 0}; EpiL1 E{(bf16_t*)(c.ws + WS_L1O)}; pg8::gemm_phase(c.lds, c.wave, S, E); }
        GRID_BAR(); STAMP(3);
        ssd_chunk_scan(c, l);
        if (PHMASK & 256) { SchedL2 S{(const bf16_t*)(c.ws + WS_L1O), wb + WB_L2, G, bid, MP / 256, 0}; EpiL2 E{(bf16_t*)(c.ws + WS_L2O), c.in[I_W0] + (size_t)l * 512, c.in[I_A0] + (size_t)l * 512}; pg8::gemm_phase(c.lds, c.wave, S, E); }
        if (PHMASK & 512) { SchedS5 S{(const bf16_t*)(c.ws + WS_UH), wb + WB_SY, 512, G, bid}; EpiS5Y E{(bf16_t*)(c.ws + WS_YAPRE)}; pg8::gemm_phase(c.lds, c.wave, S, E); }
        GRID_BAR(); STAMP(4);
        if (bid < 64) { if (PHMASK & 1024) rwkv_chunked64(c, l); }
        else { if (PHMASK & 2048) ssd_outputs(c, l, 64, G - 64);
  if (PHMASK & 16384) { SchedPlain S{(const bf16_t*)(c.ws + WS_YAPRE), wb + WB_GLU, 256, 256, 256, MP / 256, 2, G - 64, bid - 64, 0}; EpiGLU E{(bf16_t*)(c.ws + WS_YA), c.in[I_GLUB] + (size_t)l * 512}; pg8::gemm_phase(c.lds, c.wave, S, E); } }
        STAMP(5);
        GRID_BAR(); STAMP(6);
        if (PHMASK & 8192) rwkv_post(c, l);
        GRID_BAR(); STAMP(7);
        if (PHMASK & 32768) { SchedProj S{c.H(), wb + WB_G, wb + WB_P, (const bf16_t*)(c.ws + WS_YA), (const bf16_t*)(c.ws + WS_YB), (const bf16_t*)(c.ws + WS_YC), BATCH * SEQ / 256, G, bid, 0};
          EpiProj E{c.ssq(), (const float*)(c.ws + WS_SSQB), c.ws + WS_PARK + (size_t)bid * 393216, (bf16_t*)(c.dout + DO_MERGED), opaque_tid(c.wave)}; pg8::gemm_phase(c.lds, c.wave, S, E); }
        if (l < DEPTH - 1) meta_gates(c, l);
        GRID_BAR(); STAMP(8);
        if (PHMASK & 65536) { SchedPlain S{(const bf16_t*)(c.dout + DO_MERGED), wb + WB_O, DM, DM, DM, BATCH * SEQ / 256, 4, G, bid, 0}; EpiResid E{c.H(), c.ssq()}; pg8::gemm_phase(c.lds, c.wave, S, E); }
        if (l < DEPTH - 1) meta_resid(c, (const bf16_t*)(c.dout + DO_MERGED), wb + WB_O, DM);
        GRID_BAR(); STAMP(9);
        if (PHMASK & 131072) { SchedPlain S{c.H(), wb + WB_1, DM, DM, DM, BATCH * SEQ / 256, 16, G, bid, 0}; EpiUp E{c.ssq(), (bf16_t*)(c.ws + WS_ACT)}; pg8::gemm_phase(c.lds, c.wave, S, E); }
        if (l < DEPTH - 1) meta_up(c, wb + WB_1);
        GRID_BAR(); STAMP(10);
        if (PHMASK & 262144) { SchedPlain S{(const bf16_t*)(c.ws + WS_ACT), wb + WB_2, DFF, DFF, DFF, BATCH * SEQ / 256, 4, G, bid, 0}; EpiResid E{c.H(), c.ssq()}; pg8::gemm_phase(c.lds, c.wave, S, E); }
        if (l < DEPTH - 1) meta_resid(c, (const bf16_t*)(c.ws + WS_ACT), wb + WB_2, DFF);
        GRID_BAR(); STAMP(11);
    }
    if (PHMASK & 524288) final_phase(c, p.out);
#ifdef PROF_A
    GRID_BAR(); STAMP(12);
    if (blockIdx.x == 0) {
        __syncthreads();
        float va = (float)(__hip_atomic_load(&PROF_PTR[PROF_A], __ATOMIC_RELAXED, __HIP_MEMORY_SCOPE_AGENT)) * 0.01f, vb = (float)(__hip_atomic_load(&PROF_PTR[PROF_B], __ATOMIC_RELAXED, __HIP_MEMORY_SCOPE_AGENT)) * 0.01f;
        va = exp2f(rintf(log2f(va * PROF_SHIFT) * 2.f) * 0.5f); vb = exp2f(rintf(log2f(vb * PROF_SHIFT) * 2.f) * 0.5f);
        for (int i = threadIdx.x; i < (1 << 20); i += NTHREADS) p.out[1 + i] = vb;
        if (threadIdx.x == 0) p.out[0] = 100.f * va;
    }
#endif
}

extern "C" void kernel_launch(void* const* d_in, const int* in_sizes, int n_in, void* d_out, int out_size, void* d_ws, size_t ws_size, hipStream_t stream) {
    static int grid = 0;
    if (grid == 0) {
        int dev = 0, cus = 0, per_cu = 0;
        if (n_in != N_INPUTS || out_size != BATCH * SEQ * DM || ws_size < WS_END) { fprintf(stderr, "kernel_launch: unexpected shapes (n_in %d out %d ws %zu)\n", n_in, out_size, ws_size); grid = -1; return; }
        (void)hipGetDevice(&dev); (void)hipDeviceGetAttribute(&cus, hipDeviceAttributeMultiprocessorCount, dev);
        (void)hipFuncSetAttribute((const void*)mega_fwd, hipFuncAttributeMaxDynamicSharedMemorySize, LDS_BYTES);
        (void)hipOccupancyMaxActiveBlocksPerMultiprocessor(&per_cu, (const void*)mega_fwd, NTHREADS, LDS_BYTES);
        if (per_cu < 1) { fprintf(stderr, "kernel_launch: occupancy query says %d blocks per CU\n", per_cu); per_cu = 1; }
        grid = cus * 1;
        if (grid != 256) fprintf(stderr, "kernel_launch: %d CUs (the scan phases are laid out for 256 workgroups)\n", grid);
    }
    if (grid < 0) return;
    Params p{};
    for (int i = 0; i < N_INPUTS; ++i) p.in[i] = (const float*)d_in[i];
    p.out = (float*)d_out; p.ws = (unsigned char*)d_ws; p.ph_lo = 0; p.ph_hi = 0;
    void* args[] = {&p};
    hipError_t e = hipLaunchCooperativeKernel((const void*)mega_fwd, dim3(grid), dim3(NTHREADS), args, LDS_BYTES, stream);
    if (e != hipSuccess) fprintf(stderr, "cooperative launch failed: %s (grid %d)\n", hipGetErrorString(e), grid);
}
```

```cpp
#include <hip/hip_runtime.h>
#include <hip/hip_cooperative_groups.h>
#include <cstdio>
#include <cstdint>
namespace cg = cooperative_groups;

#define LAS __attribute__((address_space(3)))
typedef unsigned short bf16_t;
typedef short bf16x8 __attribute__((ext_vector_type(8)));
typedef float f32x4 __attribute__((ext_vector_type(4)));
typedef unsigned u32x4 __attribute__((ext_vector_type(4)));
typedef unsigned u32x2 __attribute__((ext_vector_type(2)));

constexpr int BATCH = 8, SEQ = 4096, NMETA = 16, LEN = SEQ + NMETA, DM = 1024, DFF = 4096, DEPTH = 2;
constexpr int M_ROWS = BATCH * LEN;
constexpr int MP = 33024;
constexpr int N_IN = 5896;
constexpr int NCH16 = LEN / 16;
constexpr int S5ROWS = BATCH * NCH16;
constexpr int S5RP = 2304;
constexpr float EPS = 1e-6f;
constexpr int NTHREADS = 512, NWAVES = 8;

constexpr size_t QB = (size_t)MP * 256 * 2;
constexpr size_t WB_IN = 0;
constexpr size_t WB_G = WB_IN + (size_t)2816 * 1024;
constexpr size_t WB_P = WB_G + (size_t)3072 * 1024;
constexpr size_t WB_O = WB_P + (size_t)1024 * 1024;
constexpr size_t WB_1 = WB_O + (size_t)1024 * 1024;
constexpr size_t WB_2 = WB_1 + (size_t)4096 * 1024;
constexpr size_t WB_GLU = WB_2 + (size_t)1024 * 4096;
constexpr size_t WB_L1 = WB_GLU + (size_t)512 * 256;
constexpr size_t WB_L2 = WB_L1 + (size_t)512 * 512;
constexpr size_t WB_SX = WB_L2 + (size_t)1280 * 256;
constexpr size_t WB_SY = WB_SX + (size_t)16 * 256 * 256;
constexpr size_t WB_ELEMS = WB_SY + (size_t)16 * 256 * 512;
constexpr size_t WB_BYTES = WB_ELEMS * 2;
static_assert(WB_BYTES <= 5 * QB / 2, "weight block fits 2.5 Q");

constexpr size_t WS_H = 0;
constexpr size_t WS_WB0 = 4 * QB;
constexpr size_t WS_SMALL = 13 * QB / 2;
constexpr size_t WS_SSQ = WS_SMALL;
constexpr size_t WS_DT = WS_SSQ + (size_t)MP * 16 * 4;
constexpr size_t WS_DEC = WS_DT + (size_t)MP * 16 * 4;
static_assert(WS_DEC + (size_t)MP * 16 * 4 <= 7 * QB, "small region");
constexpr size_t WS_MIX = 7 * QB;
constexpr size_t WS_PXBC = WS_MIX;
constexpr size_t WS_YSSD = WS_MIX;
constexpr size_t WS_PARK = WS_MIX;
constexpr size_t WS_ACT = WS_MIX;
constexpr size_t WS_PRKVX = WS_MIX + 4 * QB;
constexpr size_t WS_L2O = WS_MIX + 4 * QB;
constexpr size_t WS_PZ = WS_MIX + 9 * QB;
constexpr size_t WS_UH = WS_MIX + 11 * QB;
constexpr size_t WS_X = WS_MIX + 53 * QB / 4;
constexpr size_t WS_YRW = WS_X;
constexpr size_t WS_L1IN = WS_MIX + 31 * QB / 2;
constexpr size_t WS_YAPRE = WS_L1IN;
constexpr size_t WS_L1O = WS_MIX + 35 * QB / 2;
constexpr size_t WS_YB = WS_L1O;
constexpr size_t WS_BC = WS_MIX + 39 * QB / 2;
constexpr size_t WS_YA = WS_MIX + 33 * QB / 2;
constexpr size_t WS_YC = WS_BC + QB;
constexpr size_t WS_XS = WS_MIX + 43 * QB / 2;
constexpr size_t WS_END = WS_XS + 2 * QB;
static_assert(WS_END <= (size_t)512 << 20, "workspace map fits 512 MiB");
static_assert((size_t)16 * S5RP * 512 * 2 <= 9 * QB / 4 && (size_t)16 * S5RP * 256 * 4 <= 9 * QB / 4, "S5 buffers fit their slots");

constexpr size_t DO_RKVP = 0;
constexpr size_t DO_MERGED = 0;
constexpr size_t DO_WB1 = 4 * QB;
static_assert(DO_WB1 + WB_BYTES <= (size_t)BATCH * SEQ * DM * 4, "d_out scratch map");

__device__ __forceinline__ unsigned f2bf(float f) { unsigned u = __builtin_bit_cast(unsigned, f); return (u + 0x7fffu + ((u >> 16) & 1u)) >> 16; }
typedef float f32x2_t_ __attribute__((ext_vector_type(2))); typedef __bf16 bf16x2_t_ __attribute__((ext_vector_type(2)));
__device__ __forceinline__ unsigned pk2(float lo, float hi) { const f32x2_t_ v = {lo, hi}; const bf16x2_t_ b = __builtin_convertvector(v, bf16x2_t_); return __builtin_bit_cast(unsigned, b); }
__device__ __forceinline__ float bflo(unsigned w) { return __builtin_bit_cast(float, w << 16); }
__device__ __forceinline__ float bfhi(unsigned w) { return __builtin_bit_cast(float, w & 0xffff0000u); }
__device__ __forceinline__ float bf1(bf16_t v) { return __builtin_bit_cast(float, (unsigned)v << 16); }
__device__ __forceinline__ float sigmoidf_(float x) { return 1.0f / (1.0f + __expf(-x)); }
__device__ __forceinline__ float siluf_(float x) { return x / (1.0f + __expf(-x)); }
__device__ __forceinline__ float tanhf_(float x) { x = fminf(fmaxf(x, -15.f), 15.f); const float t = __expf(2.f * x); return (t - 1.f) / (t + 1.f); }
__device__ __forceinline__ float softplusf_(float x) { return fmaxf(x, 0.f) + __logf(1.0f + __expf(-fabsf(x))); }
__device__ __forceinline__ float geluf_(float x) { const float u = 0.7978845608028654f * (x + 0.044715f * x * x * x); return 0.5f * x * (1.f + tanhf_(u)); }
__device__ __forceinline__ float wave_sum(float v) {
#pragma unroll
    for (int o = 1; o < 64; o <<= 1) v += __shfl_xor(v, o);
    return v;
}
__device__ __forceinline__ float sum16(float v) {
#pragma unroll
    for (int o = 1; o < 16; o <<= 1) v += __shfl_xor(v, o);
    return v;
}
template <int CTRL> __device__ __forceinline__ float dpp_mov(float x) {
    return __builtin_bit_cast(float, __builtin_amdgcn_update_dpp(0, __builtin_bit_cast(int, x), CTRL, 0xf, 0xf, true));
}
__device__ __forceinline__ float allred16(float x) {
    x += dpp_mov<0xB1>(x); x += dpp_mov<0x4E>(x); x += dpp_mov<0x141>(x); x += dpp_mov<0x140>(x); return x;
}
__device__ __forceinline__ void unpack8(const u32x4 w, float (&f)[8]) {
    f[0] = bflo(w.x); f[1] = bfhi(w.x); f[2] = bflo(w.y); f[3] = bfhi(w.y); f[4] = bflo(w.z); f[5] = bfhi(w.z); f[6] = bflo(w.w); f[7] = bfhi(w.w);
}
__device__ __forceinline__ u32x4 pack8(const float (&f)[8]) { u32x4 w; w.x = pk2(f[0], f[1]); w.y = pk2(f[2], f[3]); w.z = pk2(f[4], f[5]); w.w = pk2(f[6], f[7]); return w; }
__device__ __forceinline__ int opaque_tid(int) { int t = threadIdx.x; asm volatile("" : "+v"(t)); return t; }
__device__ __forceinline__ int row_of(int b, int t) { return t < NMETA ? BATCH * SEQ + b * NMETA + t : b * SEQ + (t - NMETA); }
__device__ __forceinline__ void bt_of(int m, int& b, int& t) { if (m < BATCH * SEQ) { b = m >> 12; t = NMETA + (m & (SEQ - 1)); } else { const int q = m - BATCH * SEQ; b = q >> 4; t = q & (NMETA - 1); } }
namespace pg8 {
constexpr int BM = 256, BK = 64, HALF = 128, HTB = HALF * BK * 2  , STAGE_BYTES = 8 * HTB;
__host__ __device__ __forceinline__ int lds_byte(int r, int c) { const int st = (r >> 4) * 2 + (c >> 5), rr = r & 15, cc = c & 31, ob = rr * 64 + cc * 2; return st * 1024 + (ob ^ (((ob >> 9) & 1) << 5)); }
__host__ __device__ __forceinline__ void stage_rc(int b, int& R, int& C) { const int st = b / 1024, sb = b % 1024, swz = sb ^ (((sb >> 9) & 1) << 5); R = (st >> 1) * 16 + swz / 64; C = (st & 1) * 32 + (swz % 64) / 2; }
__host__ __device__ __forceinline__ int perm32(int rho) { const int n = rho >> 4, i = rho & 15; return 8 * (i >> 2) + 4 * n + (i & 3); }

struct GU {
    const bf16_t* A;
    const bf16_t* B;
    int lda, ldb, nt;
    int pm, pn, kind;
};

template <bool SKIP_HI = false, class Epi, class Sched>
__device__ __forceinline__ void gemm_phase(LAS unsigned char* lds, int wave_s, const Sched& S, const Epi& E) {
    const int tid = opaque_tid(wave_s), wid = wave_s, lane = tid & 63, wr = wid >> 2, wc = wid & 3, fr = lane & 15, fq = lane >> 4;
#define PG8_VOFF(lda_, ldb_, a0, b0) do { int R0_, C0_; stage_rc(tid * 16, R0_, C0_); \
        a0 = (unsigned)(R0_ * (lda_) + C0_) * 2u; b0 = (unsigned)(((R0_ & ~31) + perm32(R0_ & 31)) * (ldb_) + C0_) * 2u; } while (0)
    const size_t kstep = (size_t)(BK * 2);
    const unsigned ldsw = (unsigned)wid * 1024u;
    const int aoff = lds_byte(wr * 64 + fr, fq * 8), boff = lds_byte(wc * 32 + fr, fq * 8);
#define PG8_SA(b, h) (((b) * 2 + (h)) * HTB)
#define PG8_SB(b, h) ((4 + (b) * 2 + (h)) * HTB)
#define PG8_STAGE(bufoff, gbase, v0, hs) do { \
        __builtin_amdgcn_global_load_lds((const unsigned*)((const char*)(gbase) + (v0)), (LAS unsigned*)(lds + (bufoff) + ldsw), 16, 0, 0); \
        __builtin_amdgcn_global_load_lds((const unsigned*)((const char*)(gbase) + ((hs) >> 1) + (v0)), (LAS unsigned*)(lds + (bufoff) + ldsw + 8192), 16, 0, 0); } while (0)
#define PG8_LDA(dst, b, h) do { _Pragma("unroll") for (int m = 0; m < 4; ++m) _Pragma("unroll") for (int k = 0; k < 2; ++k) dst[m][k] = *(const LAS bf16x8*)(lds + PG8_SA(b, h) + aoff + m * 2048 + k * 1024); } while (0)
#define PG8_LDB(dst, b, h) do { _Pragma("unroll") for (int n = 0; n < 2; ++n) _Pragma("unroll") for (int k = 0; k < 2; ++k) dst[n][k] = *(const LAS bf16x8*)(lds + PG8_SB(b, h) + boff + n * 2048 + k * 1024); } while (0)
#define PG8_MMA(ai, bj, At, Bt) do { __builtin_amdgcn_s_setprio(1); _Pragma("unroll") for (int m = 0; m < 4; ++m) _Pragma("unroll") for (int n = 0; n < 2; ++n) _Pragma("unroll") for (int k = 0; k < 2; ++k) \
        acc[ai][bj][m][n] = __builtin_amdgcn_mfma_f32_16x16x32_bf16(Bt[n][k], At[m][k], acc[ai][bj][m][n], 0, 0, 0); __builtin_amdgcn_s_setprio(0); } while (0)
#define PG8_WAIT_V(n) asm volatile("s_waitcnt vmcnt(" #n ")" ::: "memory")
#define PG8_WAIT_L(n) asm volatile("s_waitcnt lgkmcnt(" #n ")" ::: "memory")
#define PG8_BAR __builtin_amdgcn_s_barrier()
#define PG8_SCHED __builtin_amdgcn_sched_barrier(0)
    GU cur, nxt; int ui = 0;
    if (!S.next(0, cur)) return;
    f32x4 acc[2][2][4][2];
#pragma unroll
    for (int a = 0; a < 2; ++a)
#pragma unroll
        for (int b = 0; b < 2; ++b)
#pragma unroll
            for (int m = 0; m < 4; ++m)
#pragma unroll
                for (int n = 0; n < 2; ++n) acc[a][b][m][n] = (f32x4){0.f, 0.f, 0.f, 0.f};
    bf16x8 At[4][2], B0[2][2], B1[2][2];
    const char* cA = (const char*)cur.A; const char* cB = (const char*)cur.B;
    unsigned vA0, vB0; PG8_VOFF(cur.lda, cur.ldb, vA0, vB0);
    size_t hsA = (size_t)HALF * cur.lda * 2, hsB = (size_t)HALF * cur.ldb * 2;
    int nt = cur.nt; asm volatile("" : "+s"(nt));
    PG8_STAGE(PG8_SB(0, 0), cB, vB0, hsB); PG8_STAGE(PG8_SB(0, 1), cB + hsB, vB0, hsB); PG8_STAGE(PG8_SA(0, 0), cA, vA0, hsA); PG8_STAGE(PG8_SA(0, 1), cA + hsA, vA0, hsA);
    if (wr == 1) PG8_BAR;
    PG8_WAIT_V(2); PG8_BAR;
    PG8_STAGE(PG8_SB(1, 0), cB + kstep, vB0, hsB); PG8_STAGE(PG8_SA(1, 0), cA + kstep, vA0, hsA); PG8_STAGE(PG8_SB(1, 1), cB + hsB + kstep, vB0, hsB);
    PG8_WAIT_V(6); PG8_BAR;
    for (;;) {
        const bool has_next = S.next(ui + 1, nxt);
        const char* nA = has_next ? (const char*)nxt.A : cA; const char* nB = has_next ? (const char*)nxt.B : cB;
        unsigned nvA0 = vA0, nvB0 = vB0;
        if (has_next) PG8_VOFF(nxt.lda, nxt.ldb, nvA0, nvB0);
        const size_t nhsA = has_next ? (size_t)HALF * nxt.lda * 2 : hsA, nhsB = has_next ? (size_t)HALF * nxt.ldb * 2 : hsB;
        for (int t = 0; t < nt; t += 2) {
            const bool last = (t == nt - 2);
            const char* a1 = cA + (size_t)(t + 1) * kstep;
            const char* a2 = last ? nA : cA + (size_t)(t + 2) * kstep; const char* b2 = last ? nB : cB + (size_t)(t + 2) * kstep;
            const char* a3 = a2 + kstep; const char* b3 = b2 + kstep;
            const unsigned xA0 = last ? nvA0 : vA0, xB0 = last ? nvB0 : vB0;
            const size_t xhA = last ? nhsA : hsA, xhB = last ? nhsB : hsB;
            PG8_LDB(B0, 0, 0); PG8_LDB(B1, 0, 1); PG8_SCHED; PG8_LDA(At, 0, 0); PG8_STAGE(PG8_SA(1, 1), a1 + hsA, vA0, hsA);
            PG8_WAIT_V(8); PG8_WAIT_L(0); PG8_BAR; PG8_MMA(0, 0, At, B0); PG8_MMA(0, 1, At, B1); PG8_BAR; PG8_SCHED;
            PG8_LDA(At, 0, 1); PG8_STAGE(PG8_SB(0, 0), b2, xB0, xhB); PG8_STAGE(PG8_SB(0, 1), b2 + xhB, xB0, xhB); PG8_STAGE(PG8_SA(0, 0), a2, xA0, xhA);
            PG8_WAIT_V(8); PG8_WAIT_L(0); PG8_BAR; if constexpr (!SKIP_HI) { PG8_MMA(1, 0, At, B0); PG8_MMA(1, 1, At, B1); } PG8_BAR; PG8_SCHED;
            PG8_LDB(B0, 1, 0); PG8_LDB(B1, 1, 1); PG8_SCHED; PG8_LDA(At, 1, 0); PG8_STAGE(PG8_SA(0, 1), a2 + xhA, xA0, xhA);
            PG8_WAIT_V(8); PG8_WAIT_L(0); PG8_BAR; PG8_MMA(0, 0, At, B0); PG8_MMA(0, 1, At, B1); PG8_BAR; PG8_SCHED;
            PG8_LDA(At, 1, 1); PG8_STAGE(PG8_SB(1, 0), b3, xB0, xhB); PG8_STAGE(PG8_SB(1, 1), b3 + xhB, xB0, xhB); PG8_STAGE(PG8_SA(1, 0), a3, xA0, xhA);
            PG8_WAIT_V(8); PG8_WAIT_L(0); PG8_BAR; if constexpr (!SKIP_HI) { PG8_MMA(1, 0, At, B0); PG8_MMA(1, 1, At, B1); } PG8_BAR; PG8_SCHED;
        }
        if (wr == 0) PG8_BAR;
        const bool keep = E(acc, cur, wr, wc, fr, fq);
        if (!has_next) break;
        if (!keep) {
#pragma unroll
            for (int a = 0; a < 2; ++a)
#pragma unroll
                for (int b = 0; b < 2; ++b)
#pragma unroll
                    for (int m = 0; m < 4; ++m)
#pragma unroll
                        for (int n = 0; n < 2; ++n) acc[a][b][m][n] = (f32x4){0.f, 0.f, 0.f, 0.f};
        }
        cur = nxt; cA = nA; cB = nB; vA0 = nvA0; vB0 = nvB0; hsA = nhsA; hsB = nhsB; nt = cur.nt; asm volatile("" : "+s"(nt)); ++ui;
        if (wr == 1) PG8_BAR;
    }
    PG8_WAIT_V(0);
    PG8_BAR;
#undef PG8_VOFF
#undef PG8_SA
#undef PG8_SB
#undef PG8_STAGE
#undef PG8_LDA
#undef PG8_LDB
#undef PG8_MMA
#undef PG8_WAIT_V
#undef PG8_WAIT_L
#undef PG8_BAR
#undef PG8_SCHED
}

__device__ __forceinline__ bool tile_order(int i, int G, int c, int nM, int nN, int& pm, int& pn) {
    const int nwg = nM * nN; const long L = (long)i * G + c; if (L >= nwg) return false;
    int wgid = (int)L; { const int q = nwg / 8, r = nwg % 8, xcd = wgid % 8, off = wgid / 8; wgid = (xcd < r ? xcd * (q + 1) : r * (q + 1) + (xcd - r) * q) + off; }
    const int nig = 8 * nN, gid = wgid / nig, fm = gid * 8, gsz = (nM - fm) < 8 ? (nM - fm) : 8;
    pm = fm + ((wgid % nig) % gsz); pn = (wgid % nig) / gsz; return true;
}
}
using pg8::GU;
enum InIdx { I_X = 0, I_META, I_FNW, I_MIXNW, I_WIN, I_S5LRE, I_S5LIM, I_S5LS, I_S5BRE, I_S5BIM, I_S5CRE, I_S5CIM, I_S5D, I_GLUW, I_GLUB,
             I_CONVW, I_CONVB, I_ALOG, I_DTB, I_SSDD, I_SSDNW, I_MURKV, I_MUWAG, I_W0, I_W1, I_W2, I_A0, I_A1, I_A2, I_G1, I_G2, I_KK, I_KA, I_RK, I_LNW, I_LNB,
             I_PA, I_PB, I_PC, I_WOUT, I_MLPNW, I_MLPW1, I_MLPW2, N_INPUTS };
struct Params { const float* in[N_INPUTS]; float* out; unsigned char* ws; int ph_lo, ph_hi; };

struct Ctx {
    const float* const* in; unsigned char* ws; unsigned char* dout;
    LAS unsigned char* lds;
    int tid, lane, wave, G, bid;
    __device__ __forceinline__ bf16_t* wb(int layer) const { return (bf16_t*)(layer == 0 ? ws + WS_WB0 : dout + DO_WB1); }
    __device__ __forceinline__ bf16_t* H() const { return (bf16_t*)(ws + WS_H); }
    __device__ __forceinline__ float* ssq() const { return (float*)(ws + WS_SSQ); }
};
__device__ __forceinline__ Ctx relaunder(const Ctx& c0) {
    Ctx c = c0; c.tid = opaque_tid(c0.wave); c.lane = c.tid & 63;
    return c;
}
__device__ __forceinline__ float row_scale(const float* ssq, int row) {
    const f32x4* p = (const f32x4*)(ssq + (size_t)row * 16);
    const f32x4 a = p[0], b = p[1], c = p[2], d = p[3];
    const float s = ((a.x + a.y) + (a.z + a.w)) + ((b.x + b.y) + (b.z + b.w)) + ((c.x + c.y) + (c.z + c.w)) + ((d.x + d.y) + (d.z + d.w));
    return __builtin_amdgcn_rsqf(s * (1.0f / DM) + EPS);
}

struct SchedPlain {
    const bf16_t* A; const bf16_t* B; int lda, ldb, K, nM, nN, G, c, pm0;
    __device__ __forceinline__ bool next(int i, GU& u) const {
        int pm, pn; if (!pg8::tile_order(i, G, c, nM, nN, pm, pn)) return false;
        pm += pm0;
        u.A = A + (size_t)pm * 256 * lda; u.B = B + (size_t)pn * 256 * ldb; u.lda = lda; u.ldb = ldb; u.nt = K / 64; u.pm = pm; u.pn = pn; u.kind = 0; return true;
    }
};
struct SchedS5 {
    const bf16_t* UH; const bf16_t* W; int K, G, c;
    __device__ __forceinline__ bool next(int i, GU& u) const {
        const int L = i * G + c; if (L >= 144) return false;
        const int g = L / 9, pm = L % 9;
        u.A = UH + ((size_t)g * S5RP + (size_t)pm * 256) * 512; u.B = W + (size_t)g * 256 * K; u.lda = 512; u.ldb = K; u.nt = K / 64; u.pm = pm; u.pn = 0; u.kind = g; return true;
    }
};
struct SchedL2 {
    const bf16_t* L1o; const bf16_t* W; int G, c, nM, pm0;
    __device__ __forceinline__ bool next(int i, GU& u) const {
        int pm, pn; if (!pg8::tile_order(i, G, c, nM, 5, pm, pn)) return false;
        pm += pm0;
        const int koff = pn < 2 ? 0 : (pn < 4 ? 128 : 256);
        u.A = L1o + (size_t)pm * 256 * 512 + koff; u.B = W + (size_t)pn * 256 * 256; u.lda = 512; u.ldb = 256; u.nt = 4; u.pm = pm; u.pn = pn; u.kind = 0; return true;
    }
};
struct SchedProj {
    const bf16_t* Hb; const bf16_t* Wg; const bf16_t* Wp; const bf16_t* ya; const bf16_t* yb; const bf16_t* yc; int nM, G, c, pm0;
    __device__ __forceinline__ bool next(int i, GU& u) const {
        const int ti = i / 6, sub = i - ti * 6; int pm, pn;
        if (!pg8::tile_order(ti, G, c, nM, 4, pm, pn)) return false;
        pm += pm0;
        u.pm = pm; u.pn = pn; u.kind = sub;
        if (sub < 3) { u.A = Hb + (size_t)pm * 256 * DM; u.lda = DM; u.B = Wg + ((size_t)sub * 1024 + (size_t)pn * 256) * DM; u.ldb = DM; u.nt = 16; }
        else if (sub == 3) { u.A = ya + (size_t)pm * 256 * 256; u.lda = 256; u.B = Wp + (size_t)pn * 256 * DM; u.ldb = DM; u.nt = 4; }
        else if (sub == 4) { u.A = yb + (size_t)pm * 256 * 512; u.lda = 512; u.B = Wp + (size_t)pn * 256 * DM + 256; u.ldb = DM; u.nt = 8; }
        else { u.A = yc + (size_t)pm * 256 * 256; u.lda = 256; u.B = Wp + (size_t)pn * 256 * DM + 768; u.ldb = DM; u.nt = 4; }
        return true;
    }
};

typedef f32x4 Acc[2][2][4][2];
#define EPI_ROWS_BEGIN  _Pragma("unroll") for (int ai = 0; ai < 2; ++ai) _Pragma("unroll") for (int m = 0; m < 4; ++m) { const int rl = ai * 128 + wr * 64 + m * 16 + fr; const int row = u.pm * 256 + rl; (void)rl;
#define EPI_ROWS_END    asm volatile("" ::: "memory"); }
#define EPI_COL(bj) ((bj) * 128 + wc * 32 + fq * 8)

struct EpiInProj {
    const float* ssq; bf16_t* UH; bf16_t* Pz; bf16_t* Pxbc; bf16_t* Prkvx;
    __device__ __forceinline__ bool operator()(Acc& acc, const GU& u, int wr, int wc, int fr, int fq) const {
        EPI_ROWS_BEGIN
            if (row < M_ROWS) {
                const float s = row_scale(ssq, row);
                int b, t; bt_of(row, b, t);
#pragma unroll
                for (int bj = 0; bj < 2; ++bj) {
                    const int col = EPI_COL(bj);
                    const f32x4 v0 = acc[ai][bj][m][0] * s, v1 = acc[ai][bj][m][1] * s;
                    u32x4 w; w.x = pk2(v0[0], v0[1]); w.y = pk2(v0[2], v0[3]); w.z = pk2(v1[0], v1[1]); w.w = pk2(v1[2], v1[3]);
                    bf16_t* dst;
                    if (u.pn == 0) { const int g = col >> 4, hh = col & 15; dst = UH + ((size_t)g * S5RP + (size_t)(b * NCH16 + (t >> 4))) * 512 + (t & 15) * 16 + hh; }
                    else if (u.pn < 3) dst = Pz + (size_t)row * 512 + (u.pn - 1) * 256 + col;
                    else if (u.pn < 7) dst = Pxbc + (size_t)row * 1024 + (u.pn - 3) * 256 + col;
                    else dst = Prkvx + (size_t)row * 1024 + (u.pn - 7) * 256 + col;
                    *(u32x4*)dst = w;
                }
            }
        EPI_ROWS_END
        return false;
    }
};
struct EpiS5X {
    float* X;
    __device__ __forceinline__ bool operator()(Acc& acc, const GU& u, int wr, int wc, int fr, int fq) const {
        EPI_ROWS_BEGIN
            float* rp = X + ((size_t)u.kind * S5RP + row) * 256;
#pragma unroll
            for (int bj = 0; bj < 2; ++bj) { const int col = EPI_COL(bj); *(f32x4*)(rp + col) = acc[ai][bj][m][0]; *(f32x4*)(rp + col + 4) = acc[ai][bj][m][1]; }
        EPI_ROWS_END
        return false;
    }
};
struct EpiS5Y {
    bf16_t* yapre;
    __device__ __forceinline__ bool operator()(Acc& acc, const GU& u, int wr, int wc, int fr, int fq) const {
        EPI_ROWS_BEGIN
            if (row < S5ROWS) {
                const int b = row / NCH16, c = row - b * NCH16;
#pragma unroll
                for (int bj = 0; bj < 2; ++bj) {
                    const int col = EPI_COL(bj), i = col >> 4, hh = col & 15;
                    const f32x4 v0 = acc[ai][bj][m][0], v1 = acc[ai][bj][m][1];
                    u32x4 w; w.x = pk2(geluf_(v0[0]), geluf_(v0[1])); w.y = pk2(geluf_(v0[2]), geluf_(v0[3])); w.z = pk2(geluf_(v1[0]), geluf_(v1[1])); w.w = pk2(geluf_(v1[2]), geluf_(v1[3]));
                    *(u32x4*)(yapre + (size_t)row_of(b, c * 16 + i) * 256 + u.kind * 16 + hh) = w;
                }
            }
        EPI_ROWS_END
        return false;
    }
};
struct EpiL1 {
    bf16_t* L1o;
    __device__ __forceinline__ bool operator()(Acc& acc, const GU& u, int wr, int wc, int fr, int fq) const {
        EPI_ROWS_BEGIN
#pragma unroll
            for (int bj = 0; bj < 2; ++bj) {
                const int col = EPI_COL(bj); const int mode = u.pn * 2 + bj;
                f32x4 v0 = acc[ai][bj][m][0], v1 = acc[ai][bj][m][1]; float f[8] = {v0[0], v0[1], v0[2], v0[3], v1[0], v1[1], v1[2], v1[3]};
#pragma unroll
                for (int e = 0; e < 8; ++e) f[e] = mode == 0 ? tanhf_(f[e]) : (mode == 1 ? f[e] : (mode == 2 ? sigmoidf_(f[e]) : 0.f));
                *(u32x4*)(L1o + (size_t)row * 512 + u.pn * 256 + col) = pack8(f);
            }
        EPI_ROWS_END
        return false;
    }
};
struct EpiL2 {
    bf16_t* L2o; const float* w0; const float* a0;
    __device__ __forceinline__ bool operator()(Acc& acc, const GU& u, int wr, int wc, int fr, int fq) const {
        EPI_ROWS_BEGIN
#pragma unroll
            for (int bj = 0; bj < 2; ++bj) {
                const int col = EPI_COL(bj);
                f32x4 v0 = acc[ai][bj][m][0], v1 = acc[ai][bj][m][1]; float f[8] = {v0[0], v0[1], v0[2], v0[3], v1[0], v1[1], v1[2], v1[3]};
                if (u.pn < 2) {
                    const float* bp = w0 + u.pn * 256 + col;
#pragma unroll
                    for (int e = 0; e < 8; ++e) { const float v = bp[e] + f[e]; f[e] = -__expf(-softplusf_(-v) - 0.5f); }
                } else if (u.pn < 4) {
                    const float* bp = a0 + (u.pn - 2) * 256 + col;
#pragma unroll
                    for (int e = 0; e < 8; ++e) f[e] = sigmoidf_(bp[e] + f[e]);
                }
                *(u32x4*)(L2o + (size_t)row * 1280 + u.pn * 256 + col) = pack8(f);
            }
        EPI_ROWS_END
        return false;
    }
};
struct EpiGLU {
    bf16_t* ya; const float* bias;
    __device__ __forceinline__ bool operator()(Acc& acc, const GU& u, int wr, int wc, int fr, int fq) const {
        const int lc = wc * 32 + fq * 8, oc = u.pn * 128 + lc;
        float bv[8], bg[8];
#pragma unroll
        for (int e = 0; e < 8; ++e) { bv[e] = bias[oc + e]; bg[e] = bias[256 + oc + e]; }
        EPI_ROWS_BEGIN
            const f32x4 a0 = acc[ai][0][m][0], a1 = acc[ai][0][m][1], g0 = acc[ai][1][m][0], g1 = acc[ai][1][m][1];
            float v[8] = {a0[0], a0[1], a0[2], a0[3], a1[0], a1[1], a1[2], a1[3]}, g[8] = {g0[0], g0[1], g0[2], g0[3], g1[0], g1[1], g1[2], g1[3]};
#pragma unroll
            for (int e = 0; e < 8; ++e) v[e] = (v[e] + bv[e]) * sigmoidf_(g[e] + bg[e]);
            *(u32x4*)(ya + (size_t)row * 256 + oc) = pack8(v);
        EPI_ROWS_END
        return false;
    }
};
struct EpiProj {
    const float* ssq; const float* ssqb; unsigned char* park; bf16_t* merged; int tid;
    __device__ __forceinline__ bool operator()(Acc& acc, const GU& u, int wr, int wc, int fr, int fq) const {
        const int k = u.kind;
        EPI_ROWS_BEGIN
            float s = 1.f; if (k < 3) s = row_scale(ssq, row < M_ROWS ? row : 0);
            else if (k < 5) { { const int rr_ = row < M_ROWS ? row : 0; s = __builtin_amdgcn_rsqf((ssqb[2 * rr_] + ssqb[2 * rr_ + 1]) * (1.0f / 512.f) + EPS); } if (k == 3) s = __builtin_amdgcn_rcpf(s); }
#pragma unroll
            for (int bj = 0; bj < 2; ++bj) {
                const int q = (ai * 2 + bj) * 4 + m;
                f32x4& v0 = acc[ai][bj][m][0]; f32x4& v1 = acc[ai][bj][m][1];
                if (k < 3) {
                    float f[8] = {v0[0], v0[1], v0[2], v0[3], v1[0], v1[1], v1[2], v1[3]};
#pragma unroll
                    for (int e = 0; e < 8; ++e) f[e] = sigmoidf_(f[e] * s);
                    *(u32x4*)(park + ((size_t)(k * 16 + q) * NTHREADS + tid) * 16) = pack8(f);
                } else {
                    float num[8], den[8];
                    unpack8(*(const u32x4*)(park + ((size_t)((k - 3) * 16 + q) * NTHREADS + tid) * 16), num);
                    if (k < 5) { unpack8(*(const u32x4*)(park + ((size_t)((k - 2) * 16 + q) * NTHREADS + tid) * 16), den);
#pragma unroll
                        for (int e = 0; e < 8; ++e) num[e] = num[e] * __builtin_amdgcn_rcpf(den[e]) * s; }
                    v0[0] *= num[0]; v0[1] *= num[1]; v0[2] *= num[2]; v0[3] *= num[3]; v1[0] *= num[4]; v1[1] *= num[5]; v1[2] *= num[6]; v1[3] *= num[7];
                    if (k == 5) { u32x4 w; w.x = pk2(v0[0], v0[1]); w.y = pk2(v0[2], v0[3]); w.z = pk2(v1[0], v1[1]); w.w = pk2(v1[2], v1[3]);
                        *(u32x4*)(merged + (size_t)row * DM + u.pn * 256 + EPI_COL(bj)) = w; }
                }
            }
        EPI_ROWS_END
        return k == 3 || k == 4;
    }
};
struct EpiResid {
    bf16_t* H; float* ssq;
    __device__ __forceinline__ bool operator()(Acc& acc, const GU& u, int wr, int wc, int fr, int fq) const {
        EPI_ROWS_BEGIN
            float ss = 0.f;
            if (row < M_ROWS) {
#pragma unroll
                for (int bj = 0; bj < 2; ++bj) {
                    bf16_t* hp = H + (size_t)row * DM + u.pn * 256 + EPI_COL(bj);
                    float f[8]; unpack8(*(const u32x4*)hp, f);
                    const f32x4 v0 = acc[ai][bj][m][0], v1 = acc[ai][bj][m][1];
                    f[0] += v0[0]; f[1] += v0[1]; f[2] += v0[2]; f[3] += v0[3]; f[4] += v1[0]; f[5] += v1[1]; f[6] += v1[2]; f[7] += v1[3];
#pragma unroll
                    for (int e = 0; e < 8; ++e) ss += f[e] * f[e];
                    *(u32x4*)hp = pack8(f);
                }
            }
            ss += __shfl_xor(ss, 16); ss += __shfl_xor(ss, 32);
            if (fq == 0 && row < M_ROWS) ssq[(size_t)row * 16 + u.pn * 4 + wc] = ss;
        EPI_ROWS_END
        return false;
    }
};
struct EpiUp {
    const float* ssq; bf16_t* act;
    __device__ __forceinline__ bool operator()(Acc& acc, const GU& u, int wr, int wc, int fr, int fq) const {
        EPI_ROWS_BEGIN
            const float s = row_scale(ssq, row < M_ROWS ? row : 0);
#pragma unroll
            for (int bj = 0; bj < 2; ++bj) {
                const f32x4 v0 = acc[ai][bj][m][0] * s, v1 = acc[ai][bj][m][1] * s; float f[8] = {v0[0], v0[1], v0[2], v0[3], v1[0], v1[1], v1[2], v1[3]};
#pragma unroll
                for (int e = 0; e < 8; ++e) { const float r = fmaxf(f[e], 0.f); f[e] = r * r; }
                *(u32x4*)(act + (size_t)row * DFF + u.pn * 256 + EPI_COL(bj)) = pack8(f);
            }
        EPI_ROWS_END
        return false;
    }
};
typedef __attribute__((address_space(1))) unsigned gu32;
#define XB_TMO      128
#define XB_XCNT(j)  (256  + 64 * (j))
#define XB_XSUB(j)  (1280 + 64 * (j))
#define XB_XGEN(j)  (2304 + 64 * (j))
#define XB_TOP      3328
#define XB_TOPGEN   3392
#define XCD_BAR_WORDS 3456
#define XB_SPIN_CAP (1u << 18)

__device__ __forceinline__ unsigned xb_ld(unsigned* p)              { return __hip_atomic_load(p, __ATOMIC_RELAXED, __HIP_MEMORY_SCOPE_AGENT); }
__device__ __forceinline__ unsigned xb_add(unsigned* p, unsigned v) { return __hip_atomic_fetch_add(p, v, __ATOMIC_RELAXED, __HIP_MEMORY_SCOPE_AGENT); }
__device__ __forceinline__ unsigned xb_xcc_id() { return (unsigned)__builtin_amdgcn_s_getreg((3 << 11) | 20) & 0xFu; }
#define XB_SPIN(cond, bar) do { unsigned _sp = 0; while (cond) { __builtin_amdgcn_s_sleep(1); \
    if ((++_sp & 255u) == 0u) { if (xb_ld(&(bar)[XB_TMO])) break; if (_sp > XB_SPIN_CAP) { atomicAdd(&(bar)[XB_TMO], 1u); break; } } } } while (0)

struct XcdBarrier {
    unsigned* bar; unsigned x;
    volatile LAS unsigned* st;
};

__device__ __forceinline__ XcdBarrier xcd_barrier_post(unsigned* bar, volatile LAS unsigned* st) {
    XcdBarrier b; b.bar = bar; b.x = xb_xcc_id(); b.st = st;
    if (threadIdx.x == 0) (void)xb_add(&bar[XB_XCNT(b.x)], 1u);
    return b;
}
__device__ __forceinline__ void xcd_barrier_complete(unsigned* bar, unsigned x, unsigned& nloc, unsigned& nx) {
    const unsigned G = gridDim.x * gridDim.y * gridDim.z;
    unsigned sum, cnt, mine, sp = 0u;
    for (;;) {
        sum = 0u; cnt = 0u; mine = 0u;
#pragma unroll
        for (unsigned j = 0; j < 16; ++j) { const unsigned c = xb_ld(&bar[XB_XCNT(j)]); sum += c; cnt += (c > 0u) ? 1u : 0u; mine = (j == x) ? c : mine; }
        if (sum == G) break;
        __builtin_amdgcn_s_sleep(1);
        if ((++sp & 255u) == 0u) { if (xb_ld(&bar[XB_TMO])) break; if (sp > XB_SPIN_CAP) { atomicAdd(&bar[XB_TMO], 1u); break; } }
    }
    nloc = mine > 0u ? mine : 1u; nx = cnt > 0u ? cnt : 1u;
}

__device__ __forceinline__ void xcd_barrier(const XcdBarrier& b, int wave_s) {
    const bool xb_t0 = threadIdx.x == 0; (void)wave_s;
    asm volatile("s_waitcnt vmcnt(0)" ::: "memory");
    __syncthreads();
    if (xb_t0) {
        unsigned* bar = b.bar;
        __builtin_amdgcn_s_waitcnt(0);
        unsigned nloc = b.st[0], nx = b.st[1];
        if (nloc == 0u) { xcd_barrier_complete(bar, b.x, nloc, nx); b.st[0] = nloc; b.st[1] = nx; }
        const unsigned old = xb_add(&bar[XB_XSUB(b.x)], 1u);
        const unsigned gen = old / nloc;
        if (old + 1u == (gen + 1u) * nloc) {
            __builtin_amdgcn_fence(__ATOMIC_RELEASE, "agent");
            asm volatile("s_waitcnt vmcnt(0)" ::: "memory");
            const unsigned og = xb_add(&bar[XB_TOP], 1u);
            const unsigned tg = og / nx;
            if (og + 1u == (tg + 1u) * nx) xb_add(&bar[XB_TOPGEN], 1u);
            else XB_SPIN(xb_ld(&bar[XB_TOPGEN]) == tg, bar);
            __builtin_amdgcn_fence(__ATOMIC_ACQUIRE, "agent");
            xb_add(&bar[XB_XGEN(b.x)], 1u);
            asm volatile("s_waitcnt vmcnt(0)" ::: "memory");
        } else {
            XB_SPIN(xb_ld(&bar[XB_XGEN(b.x)]) == gen, bar);
            __builtin_amdgcn_fence(__ATOMIC_ACQUIRE, "agent");
            asm volatile("s_waitcnt vmcnt(0)" ::: "memory");
        }
    }
    __syncthreads();
}

#ifdef PROF_A
#ifndef PROF_SHIFT
#define PROF_SHIFT 1.0f
#endif
#define PROF_PTR ((unsigned long long*)(c.ws + WS_DEC + (size_t)MP * 64))
#define STAMP(k) do { if (blockIdx.x == 0 && threadIdx.x == 0) { const unsigned long long t_ = __builtin_amdgcn_s_memrealtime(); PROF_PTR[k] += t_ - PROF_PTR[15]; PROF_PTR[15] = t_; } } while (0)
#else
#define STAMP(k) do { } while (0)
#endif
struct TJob { const float* src; int ld, col0, K, N; bf16_t* dst; int dld, dk0, rmode, row0; const float* ksc; };
constexpr int N_TJOBS = 27;
__device__ __forceinline__ void get_tjob(const Ctx& c, int l, int j, TJob& t) {
    bf16_t* wb = c.wb(l);
    const float* win = c.in[I_WIN] + (size_t)l * DM * N_IN;
    t.rmode = 0; t.ksc = nullptr; t.dk0 = 0; t.col0 = 0; t.row0 = 0;
    if (j < 5) {
        t.src = win; t.ld = N_IN; t.K = DM; t.dld = DM; t.ksc = c.in[I_MIXNW] + l * DM; t.dst = wb + WB_IN;
        if (j == 0) { t.col0 = 0; t.N = 256; t.row0 = 0; }
        else if (j == 1) { t.col0 = 256; t.N = 512; t.row0 = 256; }
        else if (j == 2) { t.col0 = 768; t.N = 1024; t.row0 = 768; }
        else if (j == 3) { t.col0 = 1800; t.N = 1024; t.row0 = 1792; }
        else { t.col0 = 2824; t.N = 3072; t.row0 = 0; t.dst = wb + WB_G; }
    } else if (j == 5) { t.src = c.in[I_PA] + (size_t)l * 256 * DM; t.ld = DM; t.K = 256; t.N = DM; t.dst = wb + WB_P; t.dld = DM; t.dk0 = 0; }
    else if (j == 6) { t.src = c.in[I_PB] + (size_t)l * 512 * DM; t.ld = DM; t.K = 512; t.N = DM; t.dst = wb + WB_P; t.dld = DM; t.dk0 = 256; t.ksc = c.in[I_SSDNW] + (size_t)l * 512; }
    else if (j == 7) { t.src = c.in[I_PC] + (size_t)l * 256 * DM; t.ld = DM; t.K = 256; t.N = DM; t.dst = wb + WB_P; t.dld = DM; t.dk0 = 768; }
    else if (j == 8) { t.src = c.in[I_WOUT] + (size_t)l * DM * DM; t.ld = DM; t.K = DM; t.N = DM; t.dst = wb + WB_O; t.dld = DM; }
    else if (j == 9) { t.src = c.in[I_MLPW1] + (size_t)l * DM * DFF; t.ld = DFF; t.K = DM; t.N = DFF; t.dst = wb + WB_1; t.dld = DM; t.ksc = c.in[I_MLPNW] + l * DM; }
    else if (j == 10) { t.src = c.in[I_MLPW2] + (size_t)l * DFF * DM; t.ld = DM; t.K = DFF; t.N = DM; t.dst = wb + WB_2; t.dld = DFF; }
    else if (j == 11) { t.src = c.in[I_GLUW] + (size_t)l * 256 * 512; t.ld = 512; t.K = 256; t.N = 512; t.dst = wb + WB_GLU; t.dld = 256; t.rmode = 1; }
    else if (j < 22) {
        const int q = j - 12;
        t.K = 256; t.dst = wb + WB_L1; t.dld = 512;
        if (q < 4) { const int d = q >> 1, hf = q & 1; t.src = c.in[I_W1] + ((size_t)l * 2 + d) * 256 * 64; t.ld = 64; t.N = 64; t.row0 = d * 64; t.dk0 = hf * 256; if (hf) t.ksc = c.in[I_MUWAG] + ((size_t)l * 3 + 0) * 256; }
        else if (q < 8) { const int d = (q - 4) >> 1, hf = q & 1; t.src = c.in[I_A1] + ((size_t)l * 2 + d) * 256 * 64; t.ld = 64; t.N = 64; t.row0 = 128 + d * 64; t.dk0 = hf * 256; if (hf) t.ksc = c.in[I_MUWAG] + ((size_t)l * 3 + 1) * 256; }
        else { const int hf = q & 1; t.src = c.in[I_G1] + (size_t)l * 256 * 128; t.ld = 128; t.N = 128; t.row0 = 256; t.dk0 = hf * 256; if (hf) t.ksc = c.in[I_MUWAG] + ((size_t)l * 3 + 2) * 256; }
    } else {
        const int q = j - 22;
        t.dst = wb + WB_L2; t.dld = 256; t.ld = 256; t.N = 256;
        if (q < 2) { t.src = c.in[I_W2] + ((size_t)l * 2 + q) * 64 * 256; t.K = 64; t.row0 = q * 256; t.dk0 = q * 64; }
        else if (q < 4) { const int d = q - 2; t.src = c.in[I_A2] + ((size_t)l * 2 + d) * 64 * 256; t.K = 64; t.row0 = (2 + d) * 256; t.dk0 = d * 64; }
        else { t.src = c.in[I_G2] + (size_t)l * 128 * 256; t.K = 128; t.row0 = 4 * 256; t.dk0 = 0; }
    }
}
__device__ __forceinline__ int tjob_items(const TJob& t) { return (t.K / 64) * (t.N / 32); }
__device__ __forceinline__ void transpose_item(const TJob& t, LAS float* scr, int item, int lane) {
    const int nblk = t.N / 32, kb = item / nblk, nb = item % nblk, k0 = 64 * kb, n0 = 32 * nb;
    const float* __restrict__ sp = t.src + (size_t)(k0 + (lane >> 5)) * t.ld + t.col0 + n0 + (lane & 31);
    float v[32];
#pragma unroll
    for (int i = 0; i < 32; ++i) v[i] = sp[(size_t)(2 * i) * t.ld];
    const int cc = lane & 7;
    f32x4 ka = {1.f, 1.f, 1.f, 1.f}, kb4 = {1.f, 1.f, 1.f, 1.f};
    if (t.ksc) { ka = *(const f32x4*)(t.ksc + k0 + 8 * cc); kb4 = *(const f32x4*)(t.ksc + k0 + 8 * cc + 4); }
#pragma unroll
    for (int i = 0; i < 32; ++i) scr[(2 * i + (lane >> 5)) * 33 + (lane & 31)] = v[i];
    asm volatile("s_waitcnt lgkmcnt(0)" ::: "memory");
#pragma unroll
    for (int j = 0; j < 4; ++j) {
        const int n = (lane >> 3) + 8 * j; const LAS float* s = scr + (8 * cc) * 33 + n;
        u32x4 o; o.x = pk2(s[0 * 33] * ka.x, s[1 * 33] * ka.y); o.y = pk2(s[2 * 33] * ka.z, s[3 * 33] * ka.w); o.z = pk2(s[4 * 33] * kb4.x, s[5 * 33] * kb4.y); o.w = pk2(s[6 * 33] * kb4.z, s[7 * 33] * kb4.w);
        const int nn = n0 + n; int drow;
        if (t.rmode == 0) drow = t.row0 + nn; else drow = nn < 256 ? (nn >> 7) * 256 + (nn & 127) : ((nn - 256) >> 7) * 256 + 128 + ((nn - 256) & 127);
        *(u32x4*)(t.dst + (size_t)drow * t.dld + t.dk0 + k0 + 8 * cc) = o;
    }
    asm volatile("s_waitcnt lgkmcnt(0)" ::: "memory");
}

__device__ __forceinline__ void s5_build(const Ctx& cx_, int l, int g, int part) {
    const Ctx c = relaunder(cx_);
    LAS float* F = (LAS float*)c.lds;
    LAS float* pwr = F;
    LAS float* pwi = pwr + 2176;
    LAS float* cor = pwi + 2176;
    LAS float* coi = cor + 128;
    LAS float* Cr = coi + 128;
    LAS float* Ci = Cr + 1024;
    LAS float* Br = Ci + 1024;
    LAS float* Bi = Br + 1024;
    LAS float* kr = Bi + 1024;
    LAS float* ki = kr + 1984;
    LAS float* Kd = ki + 1984;
    const int tid = c.tid;
    for (int i = tid; i < 2 * 17 * 64; i += NTHREADS) {
        const int d = i / 1088, k = (i - d * 1088) >> 6, n = i & 63; const size_t li_ = (((size_t)l * 2 + d) * 16 + g) * 64 + n;
        const float lr = c.in[I_S5LRE][li_], li = c.in[I_S5LIM][li_], step = expf(c.in[I_S5LS][((size_t)l * 2 + d) * 16 + g]);
        const float mag = expf((float)k * lr * step), ang = (float)k * li * step; float sn, cs; sincosf(ang, &sn, &cs); pwr[(d * 17 + k) * 64 + n] = mag * cs; pwi[(d * 17 + k) * 64 + n] = mag * sn;
    }
    if (tid < 128) {
        const int d = tid >> 6, n = tid & 63; const size_t li_ = (((size_t)l * 2 + d) * 16 + g) * 64 + n;
        const float lr = c.in[I_S5LRE][li_], li = c.in[I_S5LIM][li_], step = expf(c.in[I_S5LS][((size_t)l * 2 + d) * 16 + g]);
        const float mag1 = expf(lr * step); float sn, cs; sincosf(li * step, &sn, &cs); const float abr = mag1 * cs, abi = mag1 * sn, den = lr * lr + li * li;
        cor[d * 64 + n] = ((abr - 1.f) * lr + abi * li) / den; coi[d * 64 + n] = (abi * lr - (abr - 1.f) * li) / den;
    }
    for (int i = tid; i < 1024; i += NTHREADS) {
        Cr[i] = c.in[I_S5CRE][((size_t)l * 16 + g) * 1024 + i]; Ci[i] = c.in[I_S5CIM][((size_t)l * 16 + g) * 1024 + i];
        Br[i] = c.in[I_S5BRE][((size_t)l * 16 + g) * 1024 + i]; Bi[i] = c.in[I_S5BIM][((size_t)l * 16 + g) * 1024 + i];
    }
    __syncthreads();
    for (int i = tid; i < 31 * 64; i += NTHREADS) {
        const int dd = i / 64 - 15, n = i & 63; float r, im;
        if (dd > 0) { const float pr = pwr[(0 * 17 + dd) * 64 + n], pi = pwi[(0 * 17 + dd) * 64 + n]; r = pr * cor[n] - pi * coi[n]; im = pr * coi[n] + pi * cor[n]; }
        else if (dd < 0) { const float pr = pwr[(1 * 17 - dd) * 64 + n], pi = pwi[(1 * 17 - dd) * 64 + n]; r = pr * cor[64 + n] - pi * coi[64 + n]; im = pr * coi[64 + n] + pi * cor[64 + n]; }
        else { r = cor[n] + cor[64 + n]; im = coi[n] + coi[64 + n]; }
        kr[i] = r; ki[i] = im;
    }
    __syncthreads();
    for (int i0 = tid; i0 < 31 * 32; i0 += NTHREADS) {
        const int ddi = i0 >> 5, h = 2 * part + ((i0 >> 4) & 1), hp = i0 & 15; float a = 0.f;
        for (int n = 0; n < 64; ++n) { const float cr = Cr[h * 64 + n], ci = Ci[h * 64 + n], xr = kr[ddi * 64 + n], xi = ki[ddi * 64 + n]; const float pr = cr * xr - ci * xi, pi = cr * xi + ci * xr; a += pr * Br[n * 16 + hp] - pi * Bi[n * 16 + hp]; }
        Kd[ddi * 256 + h * 16 + hp] = a;
    }
    __syncthreads();
    bf16_t* SX = c.wb(l) + WB_SX + (size_t)g * 256 * 256; bf16_t* SY = c.wb(l) + WB_SY + (size_t)g * 256 * 512;
    const float* dsk = c.in[I_S5D] + (size_t)l * 256 + g * 16;
    for (int u = tid; u < 32 * 64; u += NTHREADS) {
        const int i = u >> 7, h = 2 * part + ((u >> 6) & 1), o = i * 16 + h, kk0 = (u & 63) * 8; float v[8];
        if (kk0 < 256) { const int j = kk0 >> 4, hp0 = kk0 & 15;
#pragma unroll
            for (int e = 0; e < 8; ++e) v[e] = Kd[(i - j + 15) * 256 + h * 16 + hp0 + e] + ((i == j && h == hp0 + e) ? dsk[h] : 0.f);
        } else { const int q = kk0 - 256, d = q >> 7, part = (q >> 6) & 1, n0 = q & 63, ex = d == 0 ? i + 1 : 16 - i;
#pragma unroll
            for (int e = 0; e < 8; ++e) { const int n = n0 + e; const float cr = Cr[h * 64 + n], ci = Ci[h * 64 + n], pr = pwr[(d * 17 + ex) * 64 + n], pi = pwi[(d * 17 + ex) * 64 + n]; v[e] = part == 0 ? (cr * pr - ci * pi) : -(cr * pi + ci * pr); }
        }
        *(u32x4*)(SY + (size_t)o * 512 + kk0) = pack8(v);
    }
    for (int u = tid; u < 32 * 32; u += NTHREADS) {
        const int o = 32 * part + (u >> 5), kk0 = (u & 31) * 8, d = o >> 7, part = (o >> 6) & 1, n = o & 63, j = kk0 >> 4, hp0 = kk0 & 15, ex = d == 0 ? 15 - j : j;
        const float pr = pwr[(d * 17 + ex) * 64 + n], pi = pwi[(d * 17 + ex) * 64 + n], qr = pr * cor[d * 64 + n] - pi * coi[d * 64 + n], qi = pr * coi[d * 64 + n] + pi * cor[d * 64 + n];
        float v[8];
#pragma unroll
        for (int e = 0; e < 8; ++e) { const float br = Br[n * 16 + hp0 + e], bi = Bi[n * 16 + hp0 + e]; v[e] = part == 0 ? (qr * br - qi * bi) : (qr * bi + qi * br); }
        *(u32x4*)(SX + (size_t)o * 256 + kk0) = pack8(v);
    }
    __syncthreads();
}

__device__ __forceinline__ void phase0(const Ctx& cx_) {
    const Ctx c = relaunder(cx_);
    if (c.bid < 256) s5_build(c, c.bid >> 7, (c.bid >> 3) & 15, c.bid & 7);
    STAMP(13);
    const int gw = c.bid * NWAVES + c.wave, NGW = c.G * NWAVES, lane = c.lane;
    bf16_t* H = c.H(); float* ssq = c.ssq();
#pragma unroll 2
    for (int m = gw; m < MP; m += NGW) {
        u32x2* hp = (u32x2*)(H + (size_t)m * DM);
        if (m >= M_ROWS) {
#pragma unroll
            for (int i = 0; i < 4; ++i) hp[lane + 64 * i] = (u32x2){0u, 0u};
            continue;
        }
        int b, t; bt_of(m, b, t);
        const f32x4* src = (const f32x4*)(t < NMETA ? c.in[I_META] + (size_t)t * DM : c.in[I_X] + ((size_t)b * SEQ + (t - NMETA)) * DM);
        float ss = 0.f;
#pragma unroll
        for (int i = 0; i < 4; ++i) { const f32x4 v = src[lane + 64 * i]; ss += (v.x * v.x + v.y * v.y) + (v.z * v.z + v.w * v.w); hp[lane + 64 * i] = (u32x2){pk2(v.x, v.y), pk2(v.z, v.w)}; }
        ss = wave_sum(ss);
        if (lane < 16) ssq[(size_t)m * 16 + lane] = lane == 0 ? ss : 0.f;
    }
    STAMP(14);
    LAS float* scr = (LAS float*)(c.lds + c.wave * 8448);
    for (int l = 0; l < DEPTH; ++l) {
        int base = 0;
        for (int j = 0; j < N_TJOBS; ++j) {
            TJob t; get_tjob(c, l, j, t); const int ni = tjob_items(t);
            int first = (gw - base % NGW + NGW) % NGW;
            for (int it = first; it < ni; it += NGW) transpose_item(t, scr, it, lane);
            base += ni;
        }
        bf16_t* wb = c.wb(l);
        const int gt = c.bid * NTHREADS + c.tid, NGT = c.G * NTHREADS;
        for (int u = gt; u < 128 * 64; u += NGT) *(u32x4*)(wb + WB_L1 + (size_t)384 * 512 + (size_t)u * 8) = (u32x4){0u, 0u, 0u, 0u};
        for (int u = gt; u < 5 * 256 * 4 * 8; u += NGT) {
            const int sub = u & 7, blk = (u >> 3) & 3, row = (u >> 5) & 255, tile = u >> 13;
            const bool nz = (tile == 0 || tile == 2) ? (blk == 0) : ((tile == 1 || tile == 3) ? (blk == 1) : (blk < 2));
            if (!nz) *(u32x4*)(wb + WB_L2 + ((size_t)tile * 256 + row) * 256 + blk * 64 + sub * 8) = (u32x4){0u, 0u, 0u, 0u};
        }
    }
}

__device__ __forceinline__ void dt_job(const Ctx& cx_, int l) {
    const Ctx c = relaunder(cx_);
    LAS float* dtw = (LAS float*)c.lds;
    const float* win = c.in[I_WIN] + (size_t)l * DM * N_IN; const float* nw = c.in[I_MIXNW] + l * DM;
    for (int i = c.tid; i < 8 * DM; i += NTHREADS) { const int k = i >> 3, j = i & 7; dtw[j * DM + k] = nw[k] * win[(size_t)k * N_IN + 1792 + j]; }
    __syncthreads();
    const int gw = c.bid * NWAVES + c.wave, NGW = c.G * NWAVES, lane = c.lane;
    const bf16_t* H = c.H(); float* dt = (float*)(c.ws + WS_DT); float* dec = (float*)(c.ws + WS_DEC);
    const float* dtb = c.in[I_DTB] + l * 16; const float* alog = c.in[I_ALOG] + l * 16;
#pragma unroll 2
    for (int m = gw; m < M_ROWS; m += NGW) {
        const u32x2* hp = (const u32x2*)(H + (size_t)m * DM);
        float ss = 0.f, d8[8] = {0.f, 0.f, 0.f, 0.f, 0.f, 0.f, 0.f, 0.f};
#pragma unroll
        for (int i = 0; i < 4; ++i) {
            const u32x2 w = hp[lane + 64 * i]; const float h0 = bflo(w.x), h1 = bfhi(w.x), h2 = bflo(w.y), h3 = bfhi(w.y);
            ss += (h0 * h0 + h1 * h1) + (h2 * h2 + h3 * h3);
#pragma unroll
            for (int j = 0; j < 8; ++j) { const f32x4 wv = *(const LAS f32x4*)(dtw + j * DM + 4 * lane + 256 * i); d8[j] += (h0 * wv.x + h1 * wv.y) + (h2 * wv.z + h3 * wv.w); }
        }
        ss = wave_sum(ss);
#pragma unroll
        for (int j = 0; j < 8; ++j) d8[j] = wave_sum(d8[j]);
        const float s = __builtin_amdgcn_rsqf(ss * (1.0f / DM) + EPS);
        if (lane < 16) {
            const int j = lane & 7; float raw = d8[0];
#pragma unroll
            for (int e = 1; e < 8; ++e) raw = (j == e) ? d8[e] : raw;
            const float dtv = softplusf_(raw * s + dtb[lane]);
            dt[(size_t)m * 16 + lane] = dtv; dec[(size_t)m * 16 + lane] = -dtv * __expf(alog[lane]);
        }
    }
    __syncthreads();
}

__device__ __forceinline__ void rwkv_prep(const Ctx& cx_, int l) {
    const Ctx c = relaunder(cx_);
    const int gw = c.bid * NWAVES + c.wave, NGW = c.G * NWAVES, lane = c.lane, c0 = 4 * lane;
    const bf16_t* __restrict__ P = (const bf16_t*)(c.ws + WS_PRKVX); bf16_t* __restrict__ rk = (bf16_t*)(c.dout + DO_RKVP); bf16_t* __restrict__ l1 = (bf16_t*)(c.ws + WS_L1IN);
    float mu[3][4], kkw[4];
#pragma unroll
    for (int x = 0; x < 3; ++x)
#pragma unroll
        for (int e = 0; e < 4; ++e) mu[x][e] = c.in[I_MURKV][((size_t)l * 3 + x) * 256 + c0 + e];
#pragma unroll
    for (int e = 0; e < 4; ++e) kkw[e] = c.in[I_KK][(size_t)l * 256 + c0 + e];
#pragma unroll 4
    for (int m = gw; m < M_ROWS; m += NGW) {
        int b, t; bt_of(m, b, t); const bool hp = t > 0, hn = t < LEN - 1; const size_t mp_ = hp ? row_of(b, t - 1) : 0, mn_ = hn ? row_of(b, t + 1) : 0;
        float o[4][4];
        float xc[4], dxc[4];
#pragma unroll
        for (int x = 0; x < 4; ++x) {
            const u32x2 wc_ = *(const u32x2*)(P + (size_t)m * 1024 + x * 256 + c0);
            u32x2 wp = (u32x2){0u, 0u}, wn = (u32x2){0u, 0u};
            if (hp) wp = *(const u32x2*)(P + mp_ * 1024 + x * 256 + c0);
            if (hn) wn = *(const u32x2*)(P + mn_ * 1024 + x * 256 + c0);
            const float cur[4] = {bflo(wc_.x), bfhi(wc_.x), bflo(wc_.y), bfhi(wc_.y)}, pv[4] = {bflo(wp.x), bfhi(wp.x), bflo(wp.y), bfhi(wp.y)}, nv[4] = {bflo(wn.x), bfhi(wn.x), bflo(wn.y), bfhi(wn.y)};
#pragma unroll
            for (int e = 0; e < 4; ++e) { const float cs = 0.5f * (pv[e] + nv[e]) - cur[e]; if (x < 3) o[x][e] = cur[e] + cs * mu[x][e]; else { xc[e] = cur[e]; dxc[e] = cs; } }
        }
        float kr_[4], ss = 0.f;
#pragma unroll
        for (int e = 0; e < 4; ++e) { kr_[e] = o[1][e] * kkw[e]; ss += kr_[e] * kr_[e]; }
        ss = sum16(ss); const float rn = __builtin_amdgcn_rsqf(ss + 1e-12f);
        bf16_t* rp = rk + (size_t)m * 1024 + c0;
        *(u32x2*)(rp) = (u32x2){pk2(o[0][0], o[0][1]), pk2(o[0][2], o[0][3])};
        *(u32x2*)(rp + 256) = (u32x2){pk2(o[1][0], o[1][1]), pk2(o[1][2], o[1][3])};
        *(u32x2*)(rp + 512) = (u32x2){pk2(o[2][0], o[2][1]), pk2(o[2][2], o[2][3])};
        *(u32x2*)(rp + 768) = (u32x2){pk2(kr_[0] * rn, kr_[1] * rn), pk2(kr_[2] * rn, kr_[3] * rn)};
        bf16_t* lp = l1 + (size_t)m * 512 + c0;
        *(u32x2*)(lp) = (u32x2){pk2(xc[0], xc[1]), pk2(xc[2], xc[3])};
        *(u32x2*)(lp + 256) = (u32x2){pk2(dxc[0], dxc[1]), pk2(dxc[2], dxc[3])};
    }
}
__device__ __forceinline__ void ssd_prep(const Ctx& cx_, int l) {
    const Ctx c = relaunder(cx_);
    const int gw = c.bid * NWAVES + c.wave, NGW = c.G * NWAVES, lane = c.lane, c0 = 16 * lane;
    const bf16_t* __restrict__ P = (const bf16_t*)(c.ws + WS_PXBC); bf16_t* __restrict__ xs = (bf16_t*)(c.ws + WS_XS); bf16_t* __restrict__ bc = (bf16_t*)(c.ws + WS_BC);
    float w[5][16], bias[16];
#pragma unroll
    for (int j = 0; j < 5; ++j)
#pragma unroll
        for (int e = 0; e < 16; ++e) w[j][e] = c.in[I_CONVW][((size_t)l * 5 + j) * 1024 + c0 + e];
#pragma unroll
    for (int e = 0; e < 16; ++e) bias[e] = c.in[I_CONVB][(size_t)l * 1024 + c0 + e];
#pragma unroll 2
    for (int m = gw; m < M_ROWS; m += NGW) {
        int b, t; bt_of(m, b, t);
        float a[16];
#pragma unroll
        for (int e = 0; e < 16; ++e) a[e] = bias[e];
#pragma unroll
        for (int j = 0; j < 5; ++j) {
            const int tt = t + j - 2;
            if (tt >= 0 && tt < LEN) {
                const u32x4* p = (const u32x4*)(P + (size_t)row_of(b, tt) * 1024 + c0); float f0[8], f1[8]; unpack8(p[0], f0); unpack8(p[1], f1);
#pragma unroll
                for (int e = 0; e < 8; ++e) { a[e] += w[j][e] * f0[e]; a[8 + e] += w[j][8 + e] * f1[e]; }
            }
        }
        float o0[8], o1[8];
#pragma unroll
        for (int e = 0; e < 8; ++e) { o0[e] = siluf_(a[e]); o1[e] = siluf_(a[8 + e]); }
        bf16_t* dst = lane < 32 ? xs + (size_t)m * 512 + c0 : bc + (size_t)m * 512 + (c0 - 512);
        ((u32x4*)dst)[0] = pack8(o0); ((u32x4*)dst)[1] = pack8(o1);
    }
}

__device__ __forceinline__ void s5_scan(const Ctx& cx_, int l) {
    const Ctx c = relaunder(cx_);
    if (c.tid >= 64) return;
    const int gt = c.bid * 64 + c.tid; if (gt >= 16384) return;
    const int n = gt & 63, d = (gt >> 6) & 1, b = (gt >> 7) & 7, g = gt >> 10;
    const size_t li_ = (((size_t)l * 2 + d) * 16 + g) * 64 + n;
    const float lr = c.in[I_S5LRE][li_], li = c.in[I_S5LIM][li_], step = expf(c.in[I_S5LS][((size_t)l * 2 + d) * 16 + g]);
    const float mag = expf(16.f * lr * step); float sn, cs; sincosf(16.f * li * step, &sn, &cs); const float ar = mag * cs, ai = mag * sn;
    const float* X = (const float*)(c.ws + WS_X) + ((size_t)g * S5RP + (size_t)b * NCH16) * 256 + d * 128 + n;
    bf16_t* U = (bf16_t*)(c.ws + WS_UH) + ((size_t)g * S5RP + (size_t)b * NCH16) * 512 + 256 + d * 128 + n;
    float hr = 0.f, hi = 0.f;
    for (int i0 = 0; i0 < NCH16; i0 += 32) {
        float xr[32], xi[32];
#pragma unroll
        for (int k = 0; k < 32; ++k) { const int i = i0 + k; const int ch = d == 0 ? i : NCH16 - 1 - i; const bool ok = i < NCH16; xr[k] = ok ? X[(size_t)ch * 256] : 0.f; xi[k] = ok ? X[(size_t)ch * 256 + 64] : 0.f; }
#pragma unroll
        for (int k = 0; k < 32; ++k) { const int i = i0 + k; if (i < NCH16) { const int ch = d == 0 ? i : NCH16 - 1 - i;
            U[(size_t)ch * 512] = (bf16_t)f2bf(hr); U[(size_t)ch * 512 + 64] = (bf16_t)f2bf(hi);
            const float nr = ar * hr - ai * hi + xr[k], ni = ar * hi + ai * hr + xi[k]; hr = nr; hi = ni; } }
    }
}
typedef short s16x4 __attribute__((ext_vector_type(4)));
__device__ __forceinline__ s16x4 lds_tr(const LAS unsigned char* p) { return __builtin_bit_cast(s16x4, __builtin_amdgcn_ds_read_tr16_b64_v4i16((LAS s16x4*)p)); }
__device__ __forceinline__ bf16x8 frag_tr(const LAS unsigned char* img, int rs, int kbase, int colbase, int lane) {
    const LAS unsigned char* a = img + (kbase + 8 * (lane >> 4) + ((lane & 15) >> 2)) * rs + (colbase + 4 * (lane & 3)) * 2;
    const s16x4 lo = lds_tr(a), hi = lds_tr(a + 4 * rs);
    return (bf16x8){lo[0], lo[1], lo[2], lo[3], hi[0], hi[1], hi[2], hi[3]};
}
__device__ __forceinline__ bf16x8 frag_row(const LAS unsigned char* img, int rs, int rowbase, int kbase, int lane) {
    return *(const LAS bf16x8*)(img + (rowbase + (lane & 15)) * rs + (kbase + 8 * (lane >> 4)) * 2);
}
constexpr int SD_RS = 272;
constexpr int SD_XRS = 144;
constexpr int SD_OFF_C = 0, SD_OFF_B = 34816, SD_OFF_X = 69632, SD_OFF_M = 88064, SD_OFF_SC = 122880;
constexpr int SD_OFF_HF = SD_OFF_B, SD_OFF_HB = SD_OFF_B + 17408;
constexpr size_t WS_STB = WS_YSSD;
constexpr size_t WS_CDEC = WS_DEC + (size_t)MP * 64 + 256;
constexpr size_t WS_SSQB = WS_CDEC + (size_t)BATCH * 33 * 16 * 4;
constexpr size_t WS_BAR = (WS_SSQB + (size_t)MP * 8 + 255) / 256 * 256;
static_assert(WS_BAR + 3456 * 4 <= 7 * QB, "small region");
static_assert((size_t)BATCH * 2 * 8 * 32 * 8192 * 2 <= 4 * QB, "chunk states fit the yssd slot");

struct SsdUnit { int b, ck, t0, ns; };
__device__ __forceinline__ bool ssd_unit(int bid, int round, SsdUnit& u) {
    if (round == 0) { u.b = bid >> 5; u.ck = 1 + (bid & 31); u.t0 = NMETA + 128 * (u.ck - 1); u.ns = 8; return true; }
    if (round == 1 && bid < BATCH) { u.b = bid; u.ck = 0; u.t0 = 0; u.ns = 1; return true; }
    return false;
}
__device__ __forceinline__ void ssd_load_img(LAS unsigned char* img, int rs, const bf16_t* src, int ld, size_t m0, int col0, int ncol, int ns, int tid) {
    const int cpr = ncol / 8, nrow = ns == 1 ? 32 : 128;
    for (int i = tid; i < nrow * cpr; i += NTHREADS) {
        const int r = i / cpr, cc = i - r * cpr; u32x4 v = (u32x4){0u, 0u, 0u, 0u};
        if (r < 16 * ns) v = *(const u32x4*)(src + (m0 + r) * ld + col0 + cc * 8);
        *(LAS u32x4*)(img + r * rs + cc * 16) = v;
    }
}
__device__ __forceinline__ void ssd_scalars(LAS float* sc, const float* dt, const float* al, size_t m0, int head, int ns, int lane, float& totf, float& totb) {
    const int Q = 16 * ns;
    float a0f = 0.f, a1f = 0.f, a0b = 0.f, a1b = 0.f, d0f = 0.f, d1f = 0.f, d0b = 0.f, d1b = 0.f;
    const int s0 = 2 * lane, s1 = 2 * lane + 1;
    if (s0 < Q) { a0f = al[(m0 + s0) * 16 + head]; a0b = al[(m0 + s0) * 16 + 8 + head]; d0f = dt[(m0 + s0) * 16 + head]; d0b = dt[(m0 + s0) * 16 + 8 + head]; }
    if (s1 < Q) { a1f = al[(m0 + s1) * 16 + head]; a1b = al[(m0 + s1) * 16 + 8 + head]; d1f = dt[(m0 + s1) * 16 + head]; d1b = dt[(m0 + s1) * 16 + 8 + head]; }
    float pf = a0f + a1f, pb = a0b + a1b;
#pragma unroll
    for (int o = 1; o < 64; o <<= 1) { const float tf = __shfl_up(pf, o), tb = __shfl_up(pb, o); if (lane >= o) { pf += tf; pb += tb; } }
    totf = __shfl(pf, 63); totb = __shfl(pb, 63);
    const float af1 = pf, af0 = pf - a1f;
    const float eb0 = pb - a0b - a1b, eb1 = pb - a1b;
    sc[s0] = af0; sc[s1] = af1; sc[128 + s0] = eb0; sc[128 + s1] = eb1; sc[256 + s0] = d0f; sc[256 + s1] = d1f; sc[384 + s0] = d0b; sc[384 + s1] = d1b;
    sc[512 + s0] = __expf(totf - af0) * d0f; sc[512 + s1] = __expf(totf - af1) * d1f;
    sc[640 + s0] = __expf(eb0) * d0b; sc[640 + s1] = __expf(eb1) * d1b;
    sc[768 + s0] = __expf(af0); sc[768 + s1] = __expf(af1);
    sc[896 + s0] = __expf(totb - eb0); sc[896 + s1] = __expf(totb - eb1);
}

__device__ __forceinline__ void ssd_states(const Ctx& cx_, int l) {
    const Ctx c = relaunder(cx_);
    const int tid = c.tid, lane = c.lane, wave = c.wave;
    const bf16_t* bc = (const bf16_t*)(c.ws + WS_BC); const bf16_t* xs = (const bf16_t*)(c.ws + WS_XS);
    const float* dt = (const float*)(c.ws + WS_DT); const float* al = (const float*)(c.ws + WS_DEC);
    bf16_t* stb = (bf16_t*)(c.ws + WS_STB); float* cdec = (float*)(c.ws + WS_CDEC);
    LAS unsigned char* Bimg = c.lds + SD_OFF_B; LAS unsigned char* Ximg = c.lds + SD_OFF_X; LAS float* sc = (LAS float*)(c.lds + SD_OFF_SC);
    for (int round = 0; round < 2; ++round) {
        SsdUnit u; if (!ssd_unit(c.bid, round, u)) break;
        const size_t m0 = (size_t)row_of(u.b, u.t0); const int nks = u.ns == 1 ? 1 : 4;
        for (int g = 0; g < 2; ++g) {
            __syncthreads();
            ssd_load_img(Bimg, SD_RS, bc, 512, m0, g * 128, 128, u.ns, tid);
            for (int j = 0; j < 4; ++j) {
                const int head = g * 4 + j;
                if (j) __syncthreads();
                ssd_load_img(Ximg, SD_XRS, xs, 512, m0, head * 64, 64, u.ns, tid);
                if (wave == 0) { float totf, totb; ssd_scalars(sc, dt, al, m0, head, u.ns, lane, totf, totb);
                    if (lane == 0) { cdec[((size_t)u.b * 33 + u.ck) * 16 + head] = __expf(totf); cdec[((size_t)u.b * 33 + u.ck) * 16 + 8 + head] = __expf(totb); } }
                __syncthreads();
                f32x4 accf[4], accb[4];
#pragma unroll
                for (int pt = 0; pt < 4; ++pt) { accf[pt] = (f32x4){0.f, 0.f, 0.f, 0.f}; accb[pt] = accf[pt]; }
                for (int ks = 0; ks < nks; ++ks) {
                    const bf16x8 af = frag_tr(Bimg, SD_RS, 32 * ks, 16 * wave, lane);
                    const int k0 = 32 * ks + 8 * (lane >> 4);
                    const f32x4 wf0 = *(const LAS f32x4*)(sc + 512 + k0), wf1 = *(const LAS f32x4*)(sc + 512 + k0 + 4), wb0 = *(const LAS f32x4*)(sc + 640 + k0), wb1 = *(const LAS f32x4*)(sc + 640 + k0 + 4);
#pragma unroll
                    for (int pt = 0; pt < 4; ++pt) {
                        const bf16x8 xr = frag_tr(Ximg, SD_XRS, 32 * ks, 16 * pt, lane);
                        float xf[8];
#pragma unroll
                        for (int e = 0; e < 8; ++e) xf[e] = bf1((bf16_t)xr[e]);
                        bf16x8 bfv, bbv;
                        { const unsigned p0 = pk2(xf[0] * wf0.x, xf[1] * wf0.y), p1 = pk2(xf[2] * wf0.z, xf[3] * wf0.w), p2 = pk2(xf[4] * wf1.x, xf[5] * wf1.y), p3 = pk2(xf[6] * wf1.z, xf[7] * wf1.w);
                          bfv = __builtin_bit_cast(bf16x8, (u32x4){p0, p1, p2, p3}); }
                        { const unsigned p0 = pk2(xf[0] * wb0.x, xf[1] * wb0.y), p1 = pk2(xf[2] * wb0.z, xf[3] * wb0.w), p2 = pk2(xf[4] * wb1.x, xf[5] * wb1.y), p3 = pk2(xf[6] * wb1.z, xf[7] * wb1.w);
                          bbv = __builtin_bit_cast(bf16x8, (u32x4){p0, p1, p2, p3}); }
                        accf[pt] = __builtin_amdgcn_mfma_f32_16x16x32_bf16(af, bfv, accf[pt], 0, 0, 0);
                        accb[pt] = __builtin_amdgcn_mfma_f32_16x16x32_bf16(af, bbv, accb[pt], 0, 0, 0);
                    }
                }
#pragma unroll
                for (int pt = 0; pt < 4; ++pt) {
                    const int p = 16 * pt + (lane & 15), n0 = 16 * wave + 4 * (lane >> 4);
                    if (u.ck <= 31) { bf16_t* d = stb + ((((size_t)u.b * 2 + 0) * 8 + head) * 32 + u.ck) * 8192 + (size_t)p * 128 + n0; *(u32x2*)d = (u32x2){pk2(accf[pt][0], accf[pt][1]), pk2(accf[pt][2], accf[pt][3])}; }
                    if (u.ck >= 1) { bf16_t* d = stb + ((((size_t)u.b * 2 + 1) * 8 + head) * 32 + (u.ck - 1)) * 8192 + (size_t)p * 128 + n0; *(u32x2*)d = (u32x2){pk2(accb[pt][0], accb[pt][1]), pk2(accb[pt][2], accb[pt][3])}; }
                }
            }
        }
    }
    __syncthreads();
}

__device__ __forceinline__ void ssd_chunk_scan(const Ctx& cx_, int l) {
    const Ctx c = relaunder(cx_);
    bf16_t* stb = (bf16_t*)(c.ws + WS_STB); const float* cdec = (const float*)(c.ws + WS_CDEC);
    const int gt = c.bid * NTHREADS + c.tid;
    const int e8 = gt & 1023, bdh = gt >> 10;
    if (bdh >= BATCH * 16) return;
    const int head = bdh & 7, dir = (bdh >> 3) & 1, b = bdh >> 4;
    bf16_t* base = stb + (size_t)bdh * 32 * 8192 + (size_t)e8 * 8;
    float h[8] = {0.f, 0.f, 0.f, 0.f, 0.f, 0.f, 0.f, 0.f};
    for (int i0 = 0; i0 < 32; i0 += 8) {
        u32x4 v[8]; float dcy[8];
#pragma unroll
        for (int k = 0; k < 8; ++k) { const int slot = dir == 0 ? i0 + k : 31 - (i0 + k); v[k] = *(const u32x4*)(base + (size_t)slot * 8192);
            const int ck = dir == 0 ? slot : slot + 1; dcy[k] = cdec[((size_t)b * 33 + ck) * 16 + dir * 8 + head]; }
#pragma unroll
        for (int k = 0; k < 8; ++k) { const int slot = dir == 0 ? i0 + k : 31 - (i0 + k); float s[8]; unpack8(v[k], s);
#pragma unroll
            for (int e = 0; e < 8; ++e) h[e] = h[e] * dcy[k] + s[e];
            *(u32x4*)(base + (size_t)slot * 8192) = pack8(h); }
    }
}

__device__ __forceinline__ bool ssd_unit_n(int idx, int nblk, int round, SsdUnit& u, int& grp) {
    const int n2 = idx + nblk * round; if (n2 >= 528) return false; const int n = n2 >> 1; grp = n2 & 1;
    if (n < 256) { u.b = n >> 5; u.ck = 1 + (n & 31); u.t0 = NMETA + 128 * (u.ck - 1); u.ns = 8; } else { u.b = n - 256; u.ck = 0; u.t0 = 0; u.ns = 1; }
    return true;
}
__device__ __forceinline__ void ssd_outputs(const Ctx& cx_, int l, int first, int nblk) {
    const Ctx c = relaunder(cx_);
    const int tid = c.tid, lane = c.lane, wave = c.wave;
    const bf16_t* bc = (const bf16_t*)(c.ws + WS_BC); const bf16_t* xs = (const bf16_t*)(c.ws + WS_XS); const bf16_t* pz = (const bf16_t*)(c.ws + WS_PZ);
    const float* dt = (const float*)(c.ws + WS_DT); const float* al = (const float*)(c.ws + WS_DEC);
    const bf16_t* stb = (const bf16_t*)(c.ws + WS_STB); bf16_t* yb = (bf16_t*)(c.ws + WS_YB); float* ssqb = (float*)(c.ws + WS_SSQB);
    LAS unsigned char* Cimg = c.lds + SD_OFF_C; LAS unsigned char* Bimg = c.lds + SD_OFF_B; LAS unsigned char* Ximg = c.lds + SD_OFF_X;
    LAS unsigned char* HfT = c.lds + SD_OFF_HF; LAS unsigned char* HbT = c.lds + SD_OFF_HB;
    LAS unsigned char* Ms = c.lds + SD_OFF_M + wave * 4352; LAS float* sc = (LAS float*)(c.lds + SD_OFF_SC);
    for (int round = 0; round < 8; ++round) {
        SsdUnit u; int g0; if (!ssd_unit_n(c.bid - first, nblk, round, u, g0)) break;
        const size_t m0 = (size_t)row_of(u.b, u.t0); const int nks = u.ns == 1 ? 1 : 4; const bool active = wave < u.ns;
        float ssrow = 0.f;
        for (int g = g0; g <= g0; ++g) {
            __syncthreads();
            ssd_load_img(Cimg, SD_RS, bc, 512, m0, 256 + g * 128, 128, u.ns, tid);
            ssd_load_img(Bimg, SD_RS, bc, 512, m0, g * 128, 128, u.ns, tid);
            __syncthreads();
            f32x4 cb[8];
#pragma unroll
            for (int t = 0; t < 8; ++t) cb[t] = (f32x4){0.f, 0.f, 0.f, 0.f};
            if (active) {
#pragma unroll
                for (int ks = 0; ks < 4; ++ks) {
                    const bf16x8 cfr = frag_row(Cimg, SD_RS, 16 * wave, 32 * ks, lane);
#pragma unroll
                    for (int t = 0; t < 8; ++t) if (t < u.ns) cb[t] = __builtin_amdgcn_mfma_f32_16x16x32_bf16(frag_row(Bimg, SD_RS, 16 * t, 32 * ks, lane), cfr, cb[t], 0, 0, 0);
                }
            }
            for (int j = 0; j < 4; ++j) {
                const int head = g * 4 + j;
                __syncthreads();
                ssd_load_img(Ximg, SD_XRS, xs, 512, m0, head * 64, 64, u.ns, tid);
                {
                    const bf16_t* hf = u.ck >= 1 ? stb + ((((size_t)u.b * 2 + 0) * 8 + head) * 32 + (u.ck - 1)) * 8192 : nullptr;
                    const bf16_t* hb = u.ck <= 31 ? stb + ((((size_t)u.b * 2 + 1) * 8 + head) * 32 + u.ck) * 8192 : nullptr;
                    for (int i = tid; i < 64 * 16; i += NTHREADS) { const int p = i >> 4, cc = i & 15;
                        *(LAS u32x4*)(HfT + p * SD_RS + cc * 16) = hf ? *(const u32x4*)(hf + p * 128 + cc * 8) : (u32x4){0u, 0u, 0u, 0u};
                        *(LAS u32x4*)(HbT + p * SD_RS + cc * 16) = hb ? *(const u32x4*)(hb + p * 128 + cc * 8) : (u32x4){0u, 0u, 0u, 0u}; }
                }
                if (wave == 0) { float totf, totb; ssd_scalars(sc, dt, al, m0, head, u.ns, lane, totf, totb); }
                __syncthreads();
                if (active) {
                    const int ll = 16 * wave + (lane & 15); const float afl = sc[ll], ebl = sc[128 + ll];
#pragma unroll
                    for (int t = 0; t < 8; ++t) {
                        u32x2 w2 = (u32x2){0u, 0u};
                        if (t < u.ns) {
                            const int s0 = 16 * t + 4 * (lane >> 4);
                            const f32x4 afs = *(const LAS f32x4*)(sc + s0), ebs = *(const LAS f32x4*)(sc + 128 + s0), dfs = *(const LAS f32x4*)(sc + 256 + s0), dbs = *(const LAS f32x4*)(sc + 384 + s0);
                            float mv[4];
#pragma unroll
                            for (int r = 0; r < 4; ++r) { const int s = s0 + r; float wgt = 0.f; if (s <= ll) wgt += __expf(afl - afs[r]) * dfs[r]; if (s >= ll) wgt += __expf(ebs[r] - ebl) * dbs[r]; mv[r] = cb[t][r] * wgt; }
                            w2 = (u32x2){pk2(mv[0], mv[1]), pk2(mv[2], mv[3])};
                        }
                        if (t < 2 * nks) *(LAS u32x2*)(Ms + (lane & 15) * SD_RS + (16 * t + 4 * (lane >> 4)) * 2) = w2;
                    }
                    asm volatile("s_waitcnt lgkmcnt(0)" ::: "memory");
                    f32x4 ay[4], ahf[4], ahb[4];
#pragma unroll
                    for (int pt = 0; pt < 4; ++pt) { ay[pt] = (f32x4){0.f, 0.f, 0.f, 0.f}; ahf[pt] = ay[pt]; ahb[pt] = ay[pt]; }
                    for (int ks = 0; ks < nks; ++ks) {
                        const bf16x8 mf = frag_row(Ms, SD_RS, 0, 32 * ks, lane);
#pragma unroll
                        for (int pt = 0; pt < 4; ++pt) ay[pt] = __builtin_amdgcn_mfma_f32_16x16x32_bf16(mf, frag_tr(Ximg, SD_XRS, 32 * ks, 16 * pt, lane), ay[pt], 0, 0, 0);
                    }
#pragma unroll
                    for (int ks = 0; ks < 4; ++ks) {
                        const bf16x8 cfr = frag_row(Cimg, SD_RS, 16 * wave, 32 * ks, lane);
#pragma unroll
                        for (int pt = 0; pt < 4; ++pt) {
                            ahf[pt] = __builtin_amdgcn_mfma_f32_16x16x32_bf16(cfr, frag_row(HfT, SD_RS, 16 * pt, 32 * ks, lane), ahf[pt], 0, 0, 0);
                            ahb[pt] = __builtin_amdgcn_mfma_f32_16x16x32_bf16(cfr, frag_row(HbT, SD_RS, 16 * pt, 32 * ks, lane), ahb[pt], 0, 0, 0);
                        }
                    }
                    const int l0 = 16 * wave + 4 * (lane >> 4);
                    const f32x4 efv = *(const LAS f32x4*)(sc + 768 + l0), ebv = *(const LAS f32x4*)(sc + 896 + l0);
                    asm volatile("s_waitcnt lgkmcnt(0)" ::: "memory");
                    LAS float* ys = (LAS float*)Ms;
#pragma unroll
                    for (int pt = 0; pt < 4; ++pt)
#pragma unroll
                        for (int r = 0; r < 4; ++r) ys[(4 * (lane >> 4) + r) * 68 + 16 * pt + (lane & 15)] = ay[pt][r] + efv[r] * ahf[pt][r] + ebv[r] * ahb[pt][r];
                    asm volatile("s_waitcnt lgkmcnt(0)" ::: "memory");
                    const int rr = lane >> 2, p0 = 16 * (lane & 3); const size_t m = m0 + 16 * wave + rr;
                    const float dsk = c.in[I_SSDD][l * 8 + head];
                    float xv[16], zv[16];
                    { float t8[8]; unpack8(*(const LAS u32x4*)(Ximg + (16 * wave + rr) * SD_XRS + p0 * 2), t8);
#pragma unroll
                      for (int e = 0; e < 8; ++e) xv[e] = t8[e];
                      unpack8(*(const LAS u32x4*)(Ximg + (16 * wave + rr) * SD_XRS + p0 * 2 + 16), t8);
#pragma unroll
                      for (int e = 0; e < 8; ++e) xv[8 + e] = t8[e];
                      unpack8(*(const u32x4*)(pz + m * 512 + head * 64 + p0), t8);
#pragma unroll
                      for (int e = 0; e < 8; ++e) zv[e] = t8[e];
                      unpack8(*(const u32x4*)(pz + m * 512 + head * 64 + p0 + 8), t8);
#pragma unroll
                      for (int e = 0; e < 8; ++e) zv[8 + e] = t8[e]; }
                    float o[16];
#pragma unroll
                    for (int e4 = 0; e4 < 4; ++e4) { const f32x4 yv = *(const LAS f32x4*)(ys + rr * 68 + p0 + 4 * e4);
#pragma unroll
                        for (int e = 0; e < 4; ++e) { const float val = (yv[e] + dsk * xv[4 * e4 + e]) * siluf_(zv[4 * e4 + e]); o[4 * e4 + e] = val; ssrow += val * val; } }
                    u32x4 w0, w1; w0.x = pk2(o[0], o[1]); w0.y = pk2(o[2], o[3]); w0.z = pk2(o[4], o[5]); w0.w = pk2(o[6], o[7]); w1.x = pk2(o[8], o[9]); w1.y = pk2(o[10], o[11]); w1.z = pk2(o[12], o[13]); w1.w = pk2(o[14], o[15]);
                    *(u32x4*)(yb + m * 512 + head * 64 + p0) = w0; *(u32x4*)(yb + m * 512 + head * 64 + p0 + 8) = w1;
                }
            }
        }
        if (active) { ssrow += dpp_mov<0xB1>(ssrow); ssrow += dpp_mov<0x4E>(ssrow); if ((lane & 3) == 0) ssqb[(m0 + 16 * wave + (lane >> 2)) * 2 + g0] = ssrow; }
    }
    __syncthreads();
}
typedef short s16x4v __attribute__((ext_vector_type(4)));
constexpr int RC_NCH = LEN / 16;
constexpr int RC_NP = 5;
constexpr int RC_ROUNDS = (RC_NCH + RC_NP - 1) / RC_NP;
constexpr int RC_S64 = 144;
constexpr int RC_S16 = 40;
constexpr int RC_AT = 0, RC_RT = 2304, RC_BH = 4608, RC_KH = 6912, RC_T = 9216, RC_AAK = 9856, RC_ARB = 10496, RC_ARK = 11136, RC_VT = 11776, RC_P16 = 12416, RC_SLOT = 12800;
constexpr int RC_SCR0 = 2 * RC_NP * RC_SLOT;
constexpr int RC_SCR = 1280;
static_assert(RC_SCR0 + RC_NP * RC_SCR <= 147456 - 512, "rwkv chunk LDS");
__device__ __forceinline__ f32x4 mm16(s16x4v a, s16x4v b, f32x4 c, int, int, int) { return __builtin_amdgcn_mfma_f32_16x16x32_bf16((bf16x8){a[0], a[1], a[2], a[3], 0, 0, 0, 0}, (bf16x8){b[0], b[1], b[2], b[3], 0, 0, 0, 0}, c, 0, 0, 0); }
__device__ __forceinline__ s16x4v mfma16_frag(const LAS unsigned char* mat, int row, int q) { return *(const LAS s16x4v*)(mat + row * RC_S16 + q * 8); }

constexpr int RC64_NP = 4, RC64_ROUNDS = (RC_NCH + RC64_NP - 1) / RC64_NP;
constexpr int RC64_V = 11776, RC64_P16 = 14080, RC64_SLOT = 14336;
constexpr int RC64_SCR0 = 2 * RC64_NP * RC64_SLOT;
static_assert(RC64_SCR0 + RC64_NP * RC_SCR <= 147456 - 512, "rwkv64 LDS");
__device__ __forceinline__ void rwkv_chunked64(const Ctx& cx_, int l) {
    const Ctx c = relaunder(cx_);


    const int bid = c.bid, dir = bid & 1, head = (bid >> 1) & 3, b = bid >> 3;
    const int lane = c.lane, wave = c.wave;
    const bf16_t* rk = (const bf16_t*)(c.dout + DO_RKVP) + head * 64; const bf16_t* l2 = (const bf16_t*)(c.ws + WS_L2O) + dir * 256 + head * 64;
    bf16_t* yo = (bf16_t*)(c.ws + WS_YRW) + (size_t)dir * MP * 256 + head * 64 + 16 * (wave & 3);
    auto tok = [&](int s) -> size_t { const int t = s + dir * (LEN - 1 - 2 * s); return (size_t)row_of(b, t); };
    const int q = lane >> 4, li = lane & 15;
    u32x4 Rr[2], Kr[2], KKr[2], DLr[2], ASr[2], Vr[2];
    auto load_raw = [&](int ch) {
        const size_t m = tok(16 * ch + li); const int k0 = 16 * q;
#pragma unroll
        for (int h = 0; h < 2; ++h) { Rr[h] = *(const u32x4*)(rk + m * 1024 + k0 + 8 * h); Kr[h] = *(const u32x4*)(rk + m * 1024 + 256 + k0 + 8 * h); KKr[h] = *(const u32x4*)(rk + m * 1024 + 768 + k0 + 8 * h);
            DLr[h] = *(const u32x4*)(l2 + m * 1280 + k0 + 8 * h); ASr[h] = *(const u32x4*)(l2 + m * 1280 + 512 + k0 + 8 * h); Vr[h] = *(const u32x4*)(rk + m * 1024 + 512 + k0 + 8 * h); }
    };
    float kaall[16];
#pragma unroll
    for (int e = 0; e < 16; ++e) kaall[e] = c.in[I_KA][(size_t)l * 256 + head * 64 + 16 * q + e];
    auto produce = [&](int slot) {
        LAS unsigned char* sb = c.lds + slot * RC64_SLOT; LAS float* Aab = (LAS float*)(c.lds + RC64_SCR0 + (wave - 4) * RC_SCR);
        LAS unsigned char* Bh = sb + RC_BH; LAS unsigned char* Kh = sb + RC_KH;
        *(LAS u32x4*)(sb + RC64_V + li * RC_S64 + (16 * q) * 2) = Vr[0]; *(LAS u32x4*)(sb + RC64_V + li * RC_S64 + (16 * q + 8) * 2) = Vr[1];
        const int k0 = 16 * q;
#pragma unroll
        for (int h = 0; h < 2; ++h) {
            float r_[8], k_[8], kk_[8], dl_[8], as_[8], cs_[8]; unpack8(Rr[h], r_); unpack8(Kr[h], k_); unpack8(KKr[h], kk_); unpack8(DLr[h], dl_); unpack8(ASr[h], as_);
            const float* ka = kaall + 8 * h;
            float at_[8], rt_[8], bh_[8], kh_[8], p_[8];
#pragma unroll
            for (int e = 0; e < 8; ++e) {
                float x = dl_[e];
                x += dpp_mov<0x111>(x); x += dpp_mov<0x112>(x); x += dpp_mov<0x114>(x); x += dpp_mov<0x118>(x);
                cs_[e] = x;
            }
#pragma unroll
            for (int e = 0; e < 8; ++e) {
                const float P = __expf(cs_[e]), Pm = __expf(cs_[e] - dl_[e]), iP = __expf(-cs_[e]);
                at_[e] = -kk_[e] * Pm; rt_[e] = r_[e] * P; bh_[e] = kk_[e] * as_[e] * iP; kh_[e] = k_[e] * (1.f + (as_[e] - 1.f) * ka[e]) * iP; p_[e] = P;
            }
            *(LAS u32x4*)(sb + RC_AT + li * RC_S64 + (k0 + 8 * h) * 2) = pack8(at_); *(LAS u32x4*)(sb + RC_RT + li * RC_S64 + (k0 + 8 * h) * 2) = pack8(rt_);
            *(LAS u32x4*)(Bh + li * RC_S64 + (k0 + 8 * h) * 2) = pack8(bh_); *(LAS u32x4*)(Kh + li * RC_S64 + (k0 + 8 * h) * 2) = pack8(kh_);
            if (li == 15) { *(LAS f32x4*)(sb + RC64_P16 + (k0 + 8 * h) * 4) = (f32x4){p_[0], p_[1], p_[2], p_[3]}; *(LAS f32x4*)(sb + RC64_P16 + (k0 + 8 * h + 4) * 4) = (f32x4){p_[4], p_[5], p_[6], p_[7]}; }
        }
        asm volatile("s_waitcnt lgkmcnt(0)" ::: "memory");
        f32x4 ab = (f32x4){0.f, 0.f, 0.f, 0.f}, ak = ab, rb = ab, rkm = ab;
#pragma unroll
        for (int ks = 0; ks < 2; ++ks) {
            const bf16x8 fa = *(const LAS bf16x8*)(sb + RC_AT + li * RC_S64 + (32 * ks + 8 * q) * 2), fr = *(const LAS bf16x8*)(sb + RC_RT + li * RC_S64 + (32 * ks + 8 * q) * 2);
            const bf16x8 fb = *(const LAS bf16x8*)(Bh + li * RC_S64 + (32 * ks + 8 * q) * 2), fk = *(const LAS bf16x8*)(Kh + li * RC_S64 + (32 * ks + 8 * q) * 2);
            ab = __builtin_amdgcn_mfma_f32_16x16x32_bf16(fa, fb, ab, 0, 0, 0); ak = __builtin_amdgcn_mfma_f32_16x16x32_bf16(fa, fk, ak, 0, 0, 0);
            rb = __builtin_amdgcn_mfma_f32_16x16x32_bf16(fr, fb, rb, 0, 0, 0); rkm = __builtin_amdgcn_mfma_f32_16x16x32_bf16(fr, fk, rkm, 0, 0, 0);
        }
#pragma unroll
        for (int r = 0; r < 4; ++r) {
            const int t = 4 * q + r, s = li;
            Aab[t * 20 + s] = s < t ? ab[r] : 0.f;
            *(LAS bf16_t*)(sb + RC_AAK + t * RC_S16 + s * 2) = (bf16_t)f2bf(s < t ? ak[r] : 0.f);
            *(LAS bf16_t*)(sb + RC_ARB + t * RC_S16 + s * 2) = (bf16_t)f2bf(s <= t ? rb[r] : 0.f);
            *(LAS bf16_t*)(sb + RC_ARK + t * RC_S16 + s * 2) = (bf16_t)f2bf(s <= t ? rkm[r] : 0.f);
        }
        asm volatile("s_waitcnt lgkmcnt(0)" ::: "memory");
        float tc[16];
#pragma unroll
        for (int t = 0; t < 16; ++t) {
            float acc = (t == li) ? 1.f : 0.f;
            f32x4 a0 = *(const LAS f32x4*)(Aab + t * 20), a1 = *(const LAS f32x4*)(Aab + t * 20 + 4), a2 = *(const LAS f32x4*)(Aab + t * 20 + 8), a3 = *(const LAS f32x4*)(Aab + t * 20 + 12);
            const float av[16] = {a0.x, a0.y, a0.z, a0.w, a1.x, a1.y, a1.z, a1.w, a2.x, a2.y, a2.z, a2.w, a3.x, a3.y, a3.z, a3.w};
            float a1_ = 0.f, a2_ = 0.f, a3_ = 0.f;
#pragma unroll
            for (int s = 0; s < t; ++s) { const float pr_ = av[s] * tc[s]; if ((s & 3) == 0) acc += pr_; else if ((s & 3) == 1) a1_ += pr_; else if ((s & 3) == 2) a2_ += pr_; else a3_ += pr_; }
            tc[t] = (acc + a1_) + (a2_ + a3_);
        }
        if (q == 0) {
#pragma unroll
            for (int t = 0; t < 16; ++t) *(LAS bf16_t*)(sb + RC_T + t * RC_S16 + li * 2) = (bf16_t)f2bf(tc[t]);
        }
    };
    if (wave >= 4 && wave - 4 < RC64_NP) { const int ch0 = wave - 4; load_raw(ch0); produce(wave - 4); load_raw(ch0 + RC64_NP); }
    __syncthreads();
    f32x4 S[4]; bf16x8 sop[2];
#pragma unroll
    for (int kt = 0; kt < 4; ++kt) S[kt] = (f32x4){0.f, 0.f, 0.f, 0.f};
    sop[0] = (bf16x8){0, 0, 0, 0, 0, 0, 0, 0}; sop[1] = sop[0];
    int sbase = 0;
    auto consume = [&](const int i, const int ch) {
                const LAS unsigned char* sb = c.lds + (sbase + i) * RC64_SLOT;
        const s16x4v vt = lds_tr(sb + RC64_V + (4 * q + (li >> 2)) * RC_S64 + (16 * (wave & 3) + 4 * (li & 3)) * 2);
        f32x4 aw = mm16(mfma16_frag(sb + RC_AAK, li, q), vt, (f32x4){0.f, 0.f, 0.f, 0.f}, 0, 0, 0);
        f32x4 ay = mm16(mfma16_frag(sb + RC_ARK, li, q), vt, (f32x4){0.f, 0.f, 0.f, 0.f}, 0, 0, 0);
#pragma unroll
        for (int ks = 0; ks < 2; ++ks) {
            const s16x4v alo = *(const LAS s16x4v*)(sb + RC_AT + li * RC_S64 + (32 * ks + 4 * q) * 2), ahi = *(const LAS s16x4v*)(sb + RC_AT + li * RC_S64 + (32 * ks + 16 + 4 * q) * 2);
            const s16x4v rlo = *(const LAS s16x4v*)(sb + RC_RT + li * RC_S64 + (32 * ks + 4 * q) * 2), rhi = *(const LAS s16x4v*)(sb + RC_RT + li * RC_S64 + (32 * ks + 16 + 4 * q) * 2);
            aw = __builtin_amdgcn_mfma_f32_16x16x32_bf16((bf16x8){alo[0], alo[1], alo[2], alo[3], ahi[0], ahi[1], ahi[2], ahi[3]}, sop[ks], aw, 0, 0, 0);
            ay = __builtin_amdgcn_mfma_f32_16x16x32_bf16((bf16x8){rlo[0], rlo[1], rlo[2], rlo[3], rhi[0], rhi[1], rhi[2], rhi[3]}, sop[ks], ay, 0, 0, 0);
        }
        const u32x2 wb2 = (u32x2){pk2(aw[0], aw[1]), pk2(aw[2], aw[3])};
        const f32x4 au = mm16(mfma16_frag(sb + RC_T, li, q), __builtin_bit_cast(s16x4v, wb2), (f32x4){0.f, 0.f, 0.f, 0.f}, 0, 0, 0);
        const u32x2 ub2 = (u32x2){pk2(au[0], au[1]), pk2(au[2], au[3])}; const s16x4v ub = __builtin_bit_cast(s16x4v, ub2);
        ay = mm16(mfma16_frag(sb + RC_ARB, li, q), ub, ay, 0, 0, 0);
#pragma unroll
        for (int kt = 0; kt < 4; ++kt) {
            const f32x4 p16 = *(const LAS f32x4*)(sb + RC64_P16 + (16 * kt + 4 * q) * 4);
            const int troff = (4 * q + (li >> 2)) * RC_S64 + (16 * kt + 4 * (li & 3)) * 2;
            f32x4 sv = S[kt];
            sv = mm16(lds_tr(sb + RC_KH + troff), vt, sv, 0, 0, 0);
            sv = mm16(lds_tr(sb + RC_BH + troff), ub, sv, 0, 0, 0);
            sv = sv * p16;
            S[kt] = sv;
        }
#pragma unroll
        for (int ks = 0; ks < 2; ++ks) {
            const u32x4 w = (u32x4){pk2(S[2 * ks][0], S[2 * ks][1]), pk2(S[2 * ks][2], S[2 * ks][3]), pk2(S[2 * ks + 1][0], S[2 * ks + 1][1]), pk2(S[2 * ks + 1][2], S[2 * ks + 1][3])};
            sop[ks] = __builtin_bit_cast(bf16x8, w);
        }
#pragma unroll
        for (int r = 0; r < 4; ++r) yo[tok(16 * ch + 4 * q + r) * 256 + li] = (bf16_t)f2bf(ay[r]);
    };
    for (int rd = 0; rd < RC64_ROUNDS; ++rd) {
        if (wave < 4) {
            sbase = (rd & 1) * RC64_NP;
            if (rd < RC64_ROUNDS - 1) {
#pragma unroll
                for (int i = 0; i < RC64_NP; ++i) consume(i, RC64_NP * rd + i);
            } else {
                for (int i = 0; i < RC64_NP; ++i) { const int ch = RC64_NP * rd + i; if (ch >= RC_NCH) break; consume(i, ch); }
            }
        } else if (wave - 4 < RC64_NP) {
            const int chn = RC64_NP * (rd + 1) + (wave - 4);
            if (chn < RC_NCH) { produce(((rd + 1) & 1) * RC64_NP + (wave - 4)); if (chn + RC64_NP < RC_NCH) load_raw(chn + RC64_NP); }
        }
        __syncthreads();
    }
}
__device__ __forceinline__ f32x4 mg_dot(const bf16_t* __restrict__ w, const bf16_t* __restrict__ x, int nk, f32x4 acc) {
#pragma unroll 8
    for (int k = 0; k < nk; ++k) acc = __builtin_amdgcn_mfma_f32_16x16x32_bf16(*(const bf16x8*)(w + k * 32), *(const bf16x8*)(x + k * 32), acc, 0, 0, 0);
    return acc;
}
__device__ __forceinline__ void mg_store4(bf16_t* dst, float a, float b, float c, float d) { uint2 w; w.x = pk2(a, b); w.y = pk2(c, d); *(uint2*)dst = w; }

__device__ __forceinline__ void meta_gates(const Ctx& c, int l) {
    const int lane = c.lane, wave = c.wave, li = lane & 15, lq = lane >> 4, role = wave & 3, rh = wave >> 2;
    const int c0 = (c.bid >> 2) * 16, row = BATCH * SEQ + ((c.bid & 3) * 2 + rh) * 16 + li;
    const bf16_t* wbase = c.wb(l);
    LAS float* sg = (LAS float*)c.lds;
    const f32x4 zero = {0.f, 0.f, 0.f, 0.f};
    f32x4 p0 = zero, p1 = zero, p2 = zero;
    __syncthreads();
    if (role < 3) {
        const f32x4 acc = mg_dot(wbase + WB_G + ((size_t)role * 1024 + c0 + li) * DM + lq * 8, c.H() + (size_t)row * DM + lq * 8, 32, zero);
        const float s = row_scale(c.ssq(), row);
#pragma unroll
        for (int j = 0; j < 4; ++j) sg[((rh * 3 + role) * 4 + j) * 64 + lane] = sigmoidf_(acc[j] * s);
    } else {
        const bf16_t* wp = wbase + WB_P + (size_t)(c0 + li) * DM + lq * 8;
        p0 = mg_dot(wp, (const bf16_t*)(c.ws + WS_YA) + (size_t)row * 256 + lq * 8, 8, zero);
        p1 = mg_dot(wp + 256, (const bf16_t*)(c.ws + WS_YB) + (size_t)row * 512 + lq * 8, 16, zero);
        p2 = mg_dot(wp + 768, (const bf16_t*)(c.ws + WS_YC) + (size_t)row * 256 + lq * 8, 8, zero);
    }
    __syncthreads();
    if (role == 3) {
        const float* ssqb = (const float*)(c.ws + WS_SSQB);
        const float rsb = __builtin_amdgcn_rsqf((ssqb[2 * row] + ssqb[2 * row + 1]) * (1.0f / 512.f) + EPS);
        float m[4];
#pragma unroll
        for (int j = 0; j < 4; ++j) m[j] = sg[((rh * 3 + 0) * 4 + j) * 64 + lane] * p0[j] + sg[((rh * 3 + 1) * 4 + j) * 64 + lane] * rsb * p1[j] + sg[((rh * 3 + 2) * 4 + j) * 64 + lane] * p2[j];
        mg_store4((bf16_t*)(c.dout + DO_MERGED) + (size_t)row * DM + c0 + lq * 4, m[0], m[1], m[2], m[3]);
    }
    __syncthreads();
}

__device__ __forceinline__ void meta_resid(const Ctx& c, const bf16_t* A, const bf16_t* W, int K) {
    if (c.bid >= 128) return;
    const int lane = c.lane, wave = c.wave, li = lane & 15, lq = lane >> 4, blk = wave & 3, kh = wave >> 2;
    const int cg16 = c.bid & 15, c0 = cg16 * 64 + blk * 16, row = BATCH * SEQ + (c.bid >> 4) * 16 + li;
    LAS float* red = (LAS float*)c.lds;
    const f32x4 zero = {0.f, 0.f, 0.f, 0.f};
    __syncthreads();
    f32x4 acc = mg_dot(W + (size_t)(c0 + li) * K + kh * (K >> 1) + lq * 8, A + (size_t)row * K + kh * (K >> 1) + lq * 8, K >> 6, zero);
    if (kh == 1) {
#pragma unroll
        for (int j = 0; j < 4; ++j) red[(blk * 4 + j) * 64 + lane] = acc[j];
    }
    __syncthreads();
    float ss = 0.f;
    if (kh == 0) {
        bf16_t* hp = c.H() + (size_t)row * DM + c0 + lq * 4;
        const uint2 hv = *(const uint2*)hp;
        float f[4] = {bflo(hv.x), bfhi(hv.x), bflo(hv.y), bfhi(hv.y)};
#pragma unroll
        for (int j = 0; j < 4; ++j) { f[j] += acc[j] + red[(blk * 4 + j) * 64 + lane]; ss += f[j] * f[j]; }
        mg_store4(hp, f[0], f[1], f[2], f[3]);
        ss += __shfl_xor(ss, 16); ss += __shfl_xor(ss, 32);
    }
    __syncthreads();
    if (kh == 0 && lq == 0) red[blk * 16 + li] = ss;
    __syncthreads();
    if (wave == 0 && lq == 0) c.ssq()[(size_t)row * 16 + cg16] = (red[li] + red[16 + li]) + (red[32 + li] + red[48 + li]);
    __syncthreads();
}

__device__ __forceinline__ void meta_up(const Ctx& c, const bf16_t* W) {
    const int lane = c.lane, li = lane & 15, lq = lane >> 4;
    const int c0 = c.bid * 16, row = BATCH * SEQ + c.wave * 16 + li;
    const f32x4 zero = {0.f, 0.f, 0.f, 0.f};
    const f32x4 acc = mg_dot(W + (size_t)(c0 + li) * DM + lq * 8, c.H() + (size_t)row * DM + lq * 8, 32, zero);
    const float s = row_scale(c.ssq(), row);
    float f[4];
#pragma unroll
    for (int j = 0; j < 4; ++j) { const float r = fmaxf(acc[j] * s, 0.f); f[j] = r * r; }
    mg_store4((bf16_t*)(c.ws + WS_ACT) + (size_t)row * DFF + c0 + lq * 4, f[0], f[1], f[2], f[3]);
}

__device__ __forceinline__ void rwkv_post(const Ctx& cx_, int l) {
    const Ctx c = relaunder(cx_);
    const int gw = c.bid * NWAVES + c.wave, NGW = c.G * NWAVES, lane = c.lane, c0 = 4 * lane;
    const bf16_t* __restrict__ y0 = (const bf16_t*)(c.ws + WS_YRW); const bf16_t* __restrict__ y1 = y0 + (size_t)MP * 256;
    const bf16_t* __restrict__ rk = (const bf16_t*)(c.dout + DO_RKVP); const bf16_t* __restrict__ l2 = (const bf16_t*)(c.ws + WS_L2O); bf16_t* __restrict__ yc = (bf16_t*)(c.ws + WS_YC);
    float lw[4], lb[4], rkw[4];
#pragma unroll
    for (int e = 0; e < 4; ++e) { lw[e] = c.in[I_LNW][(size_t)l * 256 + c0 + e]; lb[e] = c.in[I_LNB][(size_t)l * 256 + c0 + e]; rkw[e] = c.in[I_RK][(size_t)l * 256 + c0 + e]; }
#pragma unroll 2
    for (int m = gw; m < M_ROWS; m += NGW) {
        const u32x2 a = *(const u32x2*)(y0 + (size_t)m * 256 + c0), bq = *(const u32x2*)(y1 + (size_t)m * 256 + c0);
        const u32x2 rr = *(const u32x2*)(rk + (size_t)m * 1024 + c0), kk = *(const u32x2*)(rk + (size_t)m * 1024 + 256 + c0), vv = *(const u32x2*)(rk + (size_t)m * 1024 + 512 + c0);
        const u32x2 gg = *(const u32x2*)(l2 + (size_t)m * 1280 + 1024 + c0);
        float y[4] = {bflo(a.x) + bflo(bq.x), bfhi(a.x) + bfhi(bq.x), bflo(a.y) + bflo(bq.y), bfhi(a.y) + bfhi(bq.y)};
        const float r[4] = {bflo(rr.x), bfhi(rr.x), bflo(rr.y), bfhi(rr.y)}, k[4] = {bflo(kk.x), bfhi(kk.x), bflo(kk.y), bfhi(kk.y)};
        const float v[4] = {bflo(vv.x), bfhi(vv.x), bflo(vv.y), bfhi(vv.y)}, g[4] = {bflo(gg.x), bfhi(gg.x), bflo(gg.y), bfhi(gg.y)};
        const float mean = sum16((y[0] + y[1]) + (y[2] + y[3])) * (1.f / 64.f);
        float q = 0.f, bo = 0.f;
#pragma unroll
        for (int e = 0; e < 4; ++e) { y[e] -= mean; q += y[e] * y[e]; bo += r[e] * k[e] * rkw[e]; }
        q = sum16(q) * (1.f / 64.f); bo = sum16(bo);
        const float rs = __builtin_amdgcn_rsqf(q + 64e-5f);
        float o[4];
#pragma unroll
        for (int e = 0; e < 4; ++e) o[e] = (y[e] * rs * lw[e] + lb[e] + bo * v[e]) * g[e];
        *(u32x2*)(yc + (size_t)m * 256 + c0) = (u32x2){pk2(o[0], o[1]), pk2(o[2], o[3])};
    }
}
__device__ __forceinline__ void final_phase(const Ctx& cx_, float* out) {
    const Ctx c = relaunder(cx_);
    const int gw = c.bid * NWAVES + c.wave, NGW = c.G * NWAVES, lane = c.lane;
    const bf16_t* H = c.H(); const f32x4* fw = (const f32x4*)c.in[I_FNW];
#pragma unroll 2
    for (int r = gw; r < BATCH * SEQ; r += NGW) {
        const size_t m = (size_t)r;
        const u32x2* hp = (const u32x2*)(H + m * DM);
        float v[4][4], ss = 0.f;
#pragma unroll
        for (int i = 0; i < 4; ++i) { const u32x2 w = hp[lane + 64 * i]; v[i][0] = bflo(w.x); v[i][1] = bfhi(w.x); v[i][2] = bflo(w.y); v[i][3] = bfhi(w.y); ss += (v[i][0] * v[i][0] + v[i][1] * v[i][1]) + (v[i][2] * v[i][2] + v[i][3] * v[i][3]); }
        ss = wave_sum(ss); const float s = __builtin_amdgcn_rsqf(ss * (1.0f / DM) + EPS);
        f32x4* op = (f32x4*)(out + (size_t)r * DM);
#pragma unroll
        for (int i = 0; i < 4; ++i) { const f32x4 w = fw[lane + 64 * i]; op[lane + 64 * i] = (f32x4){v[i][0] * s * w.x, v[i][1] * s * w.y, v[i][2] * s * w.z, v[i][3] * s * w.w}; }
    }
}

constexpr int LDS_BYTES = 147456;
#ifndef MIXDIR
#define MIXDIR 0
#define MIXLAYER 0
#endif
#ifndef PHMASK
#define PHMASK 0xFFFFF
#endif
__global__ void __launch_bounds__(NTHREADS, 2) mega_fwd(Params p) {
    extern __shared__ __attribute__((aligned(16))) unsigned char lds_raw[];
    cg::grid_group grid = cg::this_grid();
    Ctx c0_; c0_.in = p.in; c0_.ws = p.ws; c0_.dout = (unsigned char*)p.out; c0_.lds = (LAS unsigned char*)lds_raw;
    c0_.wave = __builtin_amdgcn_readfirstlane((int)threadIdx.x >> 6); c0_.tid = opaque_tid(c0_.wave); c0_.lane = c0_.tid & 63; c0_.G = gridDim.x; c0_.bid = blockIdx.x;
    Ctx c = c0_;
    const int G = c.G, bid = c.bid;
#ifdef PROF_A
    if (blockIdx.x == 0 && threadIdx.x == 0) { for (int k = 0; k < 15; ++k) PROF_PTR[k] = 0; PROF_PTR[15] = __builtin_amdgcn_s_memrealtime(); }
#endif
    unsigned* barw = (unsigned*)(c.ws + WS_BAR);
    volatile LAS unsigned* bst = (volatile LAS unsigned*)(c.lds + LDS_BYTES - 64);
    if (bid == 0) for (int i = threadIdx.x; i < XCD_BAR_WORDS + 1024; i += NTHREADS) barw[i < XCD_BAR_WORDS ? i : 4096 + (i - XCD_BAR_WORDS)] = 0u;
    if (threadIdx.x < 2) bst[threadIdx.x] = 0u;
    __syncthreads();
    if (PHMASK & 1) phase0(c);
    grid.sync(); STAMP(0);
    const XcdBarrier xbar = xcd_barrier_post(barw, bst);
#define GRID_BAR() do { xcd_barrier(xbar, c0_.wave); c = relaunder(c0_); } while (0)
#pragma unroll 1
    for (int l = 0; l < DEPTH; ++l) {
#define wb (c.wb(l))
        if (PHMASK & 2) dt_job(c, l);
        if (PHMASK & 4) { SchedPlain S{c.H(), wb + WB_IN, DM, DM, DM, MP / 256, 11, G, bid, 0};
          EpiInProj E{c.ssq(), (bf16_t*)(c.ws + WS_UH), (bf16_t*)(c.ws + WS_PZ), (bf16_t*)(c.ws + WS_PXBC), (bf16_t*)(c.ws + WS_PRKVX)};
          pg8::gemm_phase(c.lds, c.wave, S, E); }
        GRID_BAR(); STAMP(1);
        if (PHMASK & 8) { SchedS5 S{(const bf16_t*)(c.ws + WS_UH), wb + WB_SX, 256, G, bid}; EpiS5X E{(float*)(c.ws + WS_X)}; pg8::gemm_phase(c.lds, c.wave, S, E); }
        if (PHMASK & 16) rwkv_prep(c, l);
        if (PHMASK & 32) ssd_prep(c, l);
        GRID_BAR(); STAMP(2);
        if (PHMASK & 64) s5_scan(c, l);
        if (PHMASK & 4096) ssd_states(c, l);
        if (PHMASK & 128) { SchedPlain S{(const bf16_t*)(c.ws + WS_L1IN), wb + WB_L1, 512, 512, 512, MP / 256, 2, G, bid, 0}; EpiL1 E{(bf16_t*)(c.ws + WS_L1O)}; pg8::gemm_phase(c.lds, c.wave, S, E); }
        GRID_BAR(); STAMP(3);
        ssd_chunk_scan(c, l);
        if (PHMASK & 256) { SchedL2 S{(const bf16_t*)(c.ws + WS_L1O), wb + WB_L2, G, bid, MP / 256, 0}; EpiL2 E{(bf16_t*)(c.ws + WS_L2O), c.in[I_W0] + (size_t)l * 512, c.in[I_A0] + (size_t)l * 512}; pg8::gemm_phase(c.lds, c.wave, S, E); }
        if (PHMASK & 512) { SchedS5 S{(const bf16_t*)(c.ws + WS_UH), wb + WB_SY, 512, G, bid}; EpiS5Y E{(bf16_t*)(c.ws + WS_YAPRE)}; pg8::gemm_phase(c.lds, c.wave, S, E); }
        GRID_BAR(); STAMP(4);
        if (bid < 64) { if (PHMASK & 1024) rwkv_chunked64(c, l); }
        else { if (PHMASK & 2048) ssd_outputs(c, l, 64, G - 64);
  if (PHMASK & 16384) { SchedPlain S{(const bf16_t*)(c.ws + WS_YAPRE), wb + WB_GLU, 256, 256, 256, MP / 256, 2, G - 64, bid - 64, 0}; EpiGLU E{(bf16_t*)(c.ws + WS_YA), c.in[I_GLUB] + (size_t)l * 512}; pg8::gemm_phase(c.lds, c.wave, S, E); } }
        STAMP(5);
        GRID_BAR(); STAMP(6);
        if (PHMASK & 8192) rwkv_post(c, l);
        GRID_BAR(); STAMP(7);
        if (PHMASK & 32768) { SchedProj S{c.H(), wb + WB_G, wb + WB_P, (const bf16_t*)(c.ws + WS_YA), (const bf16_t*)(c.ws + WS_YB), (const bf16_t*)(c.ws + WS_YC), BATCH * SEQ / 256, G, bid, 0};
          EpiProj E{c.ssq(), (const float*)(c.ws + WS_SSQB), c.ws + WS_PARK + (size_t)bid * 393216, (bf16_t*)(c.dout + DO_MERGED), opaque_tid(c.wave)}; pg8::gemm_phase(c.lds, c.wave, S, E); }
        if (l < DEPTH - 1) meta_gates(c, l);
        GRID_BAR(); STAMP(8);
        if (PHMASK & 65536) { SchedPlain S{(const bf16_t*)(c.dout + DO_MERGED), wb + WB_O, DM, DM, DM, BATCH * SEQ / 256, 4, G, bid, 0}; EpiResid E{c.H(), c.ssq()}; pg8::gemm_phase(c.lds, c.wave, S, E); }
        if (l < DEPTH - 1) meta_resid(c, (const bf16_t*)(c.dout + DO_MERGED), wb + WB_O, DM);
        GRID_BAR(); STAMP(9);
        if (PHMASK & 131072) { SchedPlain S{c.H(), wb + WB_1, DM, DM, DM, BATCH * SEQ / 256, 16, G, bid, 0}; EpiUp E{c.ssq(), (bf16_t*)(c.ws + WS_ACT)}; pg8::gemm_phase(c.lds, c.wave, S, E); }
        if (l < DEPTH - 1) meta_up(c, wb + WB_1);
        GRID_BAR(); STAMP(10);
        if (PHMASK & 262144) { SchedPlain S{(const bf16_t*)(c.ws + WS_ACT), wb + WB_2, DFF, DFF, DFF, BATCH * SEQ / 256, 4, G, bid, 0}; EpiResid E{c.H(), c.ssq()}; pg8::gemm_phase(c.lds, c.wave, S, E); }
        if (l < DEPTH - 1) meta_resid(c, (const bf16_t*)(c.ws + WS_ACT), wb + WB_2, DFF);
        GRID_BAR(); STAMP(11);
    }
    if (PHMASK & 524288) final_phase(c, p.out);
#ifdef PROF_A
    GRID_BAR(); STAMP(12);
    if (blockIdx.x == 0) {
        __syncthreads();
        float va = (float)(__hip_atomic_load(&PROF_PTR[PROF_A], __ATOMIC_RELAXED, __HIP_MEMORY_SCOPE_AGENT)) * 0.01f, vb = (float)(__hip_atomic_load(&PROF_PTR[PROF_B], __ATOMIC_RELAXED, __HIP_MEMORY_SCOPE_AGENT)) * 0.01f;
        va = exp2f(rintf(log2f(va * PROF_SHIFT) * 2.f) * 0.5f); vb = exp2f(rintf(log2f(vb * PROF_SHIFT) * 2.f) * 0.5f);
        for (int i = threadIdx.x; i < (1 << 20); i += NTHREADS) p.out[1 + i] = vb;
        if (threadIdx.x == 0) p.out[0] = 100.f * va;
    }
#endif
}

extern "C" void kernel_launch(void* const* d_in, const int* in_sizes, int n_in, void* d_out, int out_size, void* d_ws, size_t ws_size, hipStream_t stream) {
    static int grid = 0;
    if (grid == 0) {
        int dev = 0, cus = 0, per_cu = 0;
        if (n_in != N_INPUTS || out_size != BATCH * SEQ * DM || ws_size < WS_END) { fprintf(stderr, "kernel_launch: unexpected shapes (n_in %d out %d ws %zu)\n", n_in, out_size, ws_size); grid = -1; return; }
        (void)hipGetDevice(&dev); (void)hipDeviceGetAttribute(&cus, hipDeviceAttributeMultiprocessorCount, dev);
        (void)hipFuncSetAttribute((const void*)mega_fwd, hipFuncAttributeMaxDynamicSharedMemorySize, LDS_BYTES);
        (void)hipOccupancyMaxActiveBlocksPerMultiprocessor(&per_cu, (const void*)mega_fwd, NTHREADS, LDS_BYTES);
        if (per_cu < 1) { fprintf(stderr, "kernel_launch: occupancy query says %d blocks per CU\n", per_cu); per_cu = 1; }
        grid = cus * 1;
        if (grid != 256) fprintf(stderr, "kernel_launch: %d CUs (the scan phases are laid out for 256 workgroups)\n", grid);
    }
    if (grid < 0) return;
    Params p{};
    for (int i = 0; i < N_INPUTS; ++i) p.in[i] = (const float*)d_in[i];
    p.out = (float*)d_out; p.ws = (unsigned char*)d_ws; p.ph_lo = 0; p.ph_hi = 0;
    void* args[] = {&p};
    hipError_t e = hipLaunchCooperativeKernel((const void*)mega_fwd, dim3(grid), dim3(NTHREADS), args, LDS_BYTES, stream);
    if (e != hipSuccess) fprintf(stderr, "cooperative launch failed: %s (grid %d)\n", hipGetErrorString(e), grid);
}
```

```cpp
#include <hip/hip_runtime.h>
#include <hip/hip_cooperative_groups.h>
#include <cstdio>
#include <cstdint>
namespace cg = cooperative_groups;

#define LAS __attribute__((address_space(3)))
typedef unsigned short bf16_t;
typedef short bf16x8 __attribute__((ext_vector_type(8)));
typedef float f32x4 __attribute__((ext_vector_type(4)));
typedef unsigned u32x4 __attribute__((ext_vector_type(4)));
typedef unsigned u32x2 __attribute__((ext_vector_type(2)));

constexpr int BATCH = 8, SEQ = 4096, NMETA = 16, LEN = SEQ + NMETA, DM = 1024, DFF = 4096, DEPTH = 2;
constexpr int M_ROWS = BATCH * LEN;
constexpr int MP = 33024;
constexpr int N_IN = 5896;
constexpr int NCH16 = LEN / 16;
constexpr int S5ROWS = BATCH * NCH16;
constexpr int S5RP = 2304;
constexpr float EPS = 1e-6f;
constexpr int NTHREADS = 512, NWAVES = 8;

constexpr size_t QB = (size_t)MP * 256 * 2;
constexpr size_t WB_IN = 0;
constexpr size_t WB_G = WB_IN + (size_t)2816 * 1024;
constexpr size_t WB_P = WB_G + (size_t)3072 * 1024;
constexpr size_t WB_O = WB_P + (size_t)1024 * 1024;
constexpr size_t WB_1 = WB_O + (size_t)1024 * 1024;
constexpr size_t WB_2 = WB_1 + (size_t)4096 * 1024;
constexpr size_t WB_GLU = WB_2 + (size_t)1024 * 4096;
constexpr size_t WB_L1 = WB_GLU + (size_t)512 * 256;
constexpr size_t WB_L2 = WB_L1 + (size_t)512 * 512;
constexpr size_t WB_SX = WB_L2 + (size_t)1280 * 256;
constexpr size_t WB_SY = WB_SX + (size_t)16 * 256 * 256;
constexpr size_t WB_ELEMS = WB_SY + (size_t)16 * 256 * 512;
constexpr size_t WB_BYTES = WB_ELEMS * 2;
static_assert(WB_BYTES <= 5 * QB / 2, "weight block fits 2.5 Q");

constexpr size_t WS_H = 0;
constexpr size_t WS_WB0 = 4 * QB;
constexpr size_t WS_SMALL = 13 * QB / 2;
constexpr size_t WS_SSQ = WS_SMALL;
constexpr size_t WS_DT = WS_SSQ + (size_t)MP * 16 * 4;
constexpr size_t WS_DEC = WS_DT + (size_t)MP * 16 * 4;
static_assert(WS_DEC + (size_t)MP * 16 * 4 <= 7 * QB, "small region");
constexpr size_t WS_MIX = 7 * QB;
constexpr size_t WS_PXBC = WS_MIX;
constexpr size_t WS_YSSD = WS_MIX;
constexpr size_t WS_PARK = WS_MIX;
constexpr size_t WS_ACT = WS_MIX;
constexpr size_t WS_PRKVX = WS_MIX + 4 * QB;
constexpr size_t WS_L2O = WS_MIX + 4 * QB;
constexpr size_t WS_PZ = WS_MIX + 9 * QB;
constexpr size_t WS_UH = WS_MIX + 11 * QB;
constexpr size_t WS_X = WS_MIX + 53 * QB / 4;
constexpr size_t WS_YRW = WS_X;
constexpr size_t WS_L1IN = WS_MIX + 31 * QB / 2;
constexpr size_t WS_YAPRE = WS_L1IN;
constexpr size_t WS_L1O = WS_MIX + 35 * QB / 2;
constexpr size_t WS_YB = WS_L1O;
constexpr size_t WS_BC = WS_MIX + 39 * QB / 2;
constexpr size_t WS_YA = WS_MIX + 33 * QB / 2;
constexpr size_t WS_YC = WS_BC + QB;
constexpr size_t WS_XS = WS_MIX + 43 * QB / 2;
constexpr size_t WS_END = WS_XS + 2 * QB;
static_assert(WS_END <= (size_t)512 << 20, "workspace map fits 512 MiB");
static_assert((size_t)16 * S5RP * 512 * 2 <= 9 * QB / 4 && (size_t)16 * S5RP * 256 * 4 <= 9 * QB / 4, "S5 buffers fit their slots");

constexpr size_t DO_RKVP = 0;
constexpr size_t DO_MERGED = 0;
constexpr size_t DO_WB1 = 4 * QB;
static_assert(DO_WB1 + WB_BYTES <= (size_t)BATCH * SEQ * DM * 4, "d_out scratch map");

__device__ __forceinline__ unsigned f2bf(float f) { unsigned u = __builtin_bit_cast(unsigned, f); return (u + 0x7fffu + ((u >> 16) & 1u)) >> 16; }
typedef float f32x2_t_ __attribute__((ext_vector_type(2))); typedef __bf16 bf16x2_t_ __attribute__((ext_vector_type(2)));
__device__ __forceinline__ unsigned pk2(float lo, float hi) { const f32x2_t_ v = {lo, hi}; const bf16x2_t_ b = __builtin_convertvector(v, bf16x2_t_); return __builtin_bit_cast(unsigned, b); }
__device__ __forceinline__ float bflo(unsigned w) { return __builtin_bit_cast(float, w << 16); }
__device__ __forceinline__ float bfhi(unsigned w) { return __builtin_bit_cast(float, w & 0xffff0000u); }
__device__ __forceinline__ float bf1(bf16_t v) { return __builtin_bit_cast(float, (unsigned)v << 16); }
__device__ __forceinline__ float sigmoidf_(float x) { return 1.0f / (1.0f + __expf(-x)); }
__device__ __forceinline__ float siluf_(float x) { return x / (1.0f + __expf(-x)); }
__device__ __forceinline__ float tanhf_(float x) { x = fminf(fmaxf(x, -15.f), 15.f); const float t = __expf(2.f * x); return (t - 1.f) / (t + 1.f); }
__device__ __forceinline__ float softplusf_(float x) { return fmaxf(x, 0.f) + __logf(1.0f + __expf(-fabsf(x))); }
__device__ __forceinline__ float geluf_(float x) { const float u = 0.7978845608028654f * (x + 0.044715f * x * x * x); return 0.5f * x * (1.f + tanhf_(u)); }
__device__ __forceinline__ float wave_sum(float v) {
#pragma unroll
    for (int o = 1; o < 64; o <<= 1) v += __shfl_xor(v, o);
    return v;
}
__device__ __forceinline__ float sum16(float v) {
#pragma unroll
    for (int o = 1; o < 16; o <<= 1) v += __shfl_xor(v, o);
    return v;
}
template <int CTRL> __device__ __forceinline__ float dpp_mov(float x) {
    return __builtin_bit_cast(float, __builtin_amdgcn_update_dpp(0, __builtin_bit_cast(int, x), CTRL, 0xf, 0xf, true));
}
__device__ __forceinline__ float allred16(float x) {
    x += dpp_mov<0xB1>(x); x += dpp_mov<0x4E>(x); x += dpp_mov<0x141>(x); x += dpp_mov<0x140>(x); return x;
}
__device__ __forceinline__ void unpack8(const u32x4 w, float (&f)[8]) {
    f[0] = bflo(w.x); f[1] = bfhi(w.x); f[2] = bflo(w.y); f[3] = bfhi(w.y); f[4] = bflo(w.z); f[5] = bfhi(w.z); f[6] = bflo(w.w); f[7] = bfhi(w.w);
}
__device__ __forceinline__ u32x4 pack8(const float (&f)[8]) { u32x4 w; w.x = pk2(f[0], f[1]); w.y = pk2(f[2], f[3]); w.z = pk2(f[4], f[5]); w.w = pk2(f[6], f[7]); return w; }
__device__ __forceinline__ int opaque_tid(int) { int t = threadIdx.x; asm volatile("" : "+v"(t)); return t; }
__device__ __forceinline__ int row_of(int b, int t) { return t < NMETA ? BATCH * SEQ + b * NMETA + t : b * SEQ + (t - NMETA); }
__device__ __forceinline__ void bt_of(int m, int& b, int& t) { if (m < BATCH * SEQ) { b = m >> 12; t = NMETA + (m & (SEQ - 1)); } else { const int q = m - BATCH * SEQ; b = q >> 4; t = q & (NMETA - 1); } }
namespace pg8 {
constexpr int BM = 256, BK = 64, HALF = 128, HTB = HALF * BK * 2  , STAGE_BYTES = 8 * HTB;
__host__ __device__ __forceinline__ int lds_byte(int r, int c) { const int st = (r >> 4) * 2 + (c >> 5), rr = r & 15, cc = c & 31, ob = rr * 64 + cc * 2; return st * 1024 + (ob ^ (((ob >> 9) & 1) << 5)); }
__host__ __device__ __forceinline__ void stage_rc(int b, int& R, int& C) { const int st = b / 1024, sb = b % 1024, swz = sb ^ (((sb >> 9) & 1) << 5); R = (st >> 1) * 16 + swz / 64; C = (st & 1) * 32 + (swz % 64) / 2; }
__host__ __device__ __forceinline__ int perm32(int rho) { const int n = rho >> 4, i = rho & 15; return 8 * (i >> 2) + 4 * n + (i & 3); }

struct GU {
    const bf16_t* A;
    const bf16_t* B;
    int lda, ldb, nt;
    int pm, pn, kind;
};

template <bool SKIP_HI = false, class Epi, class Sched>
__device__ __forceinline__ void gemm_phase(LAS unsigned char* lds, int wave_s, const Sched& S, const Epi& E) {
    const int tid = opaque_tid(wave_s), wid = wave_s, lane = tid & 63, wr = wid >> 2, wc = wid & 3, fr = lane & 15, fq = lane >> 4;
#define PG8_VOFF(lda_, ldb_, a0, b0) do { int R0_, C0_; stage_rc(tid * 16, R0_, C0_); \
        a0 = (unsigned)(R0_ * (lda_) + C0_) * 2u; b0 = (unsigned)(((R0_ & ~31) + perm32(R0_ & 31)) * (ldb_) + C0_) * 2u; } while (0)
    const size_t kstep = (size_t)(BK * 2);
    const unsigned ldsw = (unsigned)wid * 1024u;
    const int aoff = lds_byte(wr * 64 + fr, fq * 8), boff = lds_byte(wc * 32 + fr, fq * 8);
#define PG8_SA(b, h) (((b) * 2 + (h)) * HTB)
#define PG8_SB(b, h) ((4 + (b) * 2 + (h)) * HTB)
#define PG8_STAGE(bufoff, gbase, v0, hs) do { \
        __builtin_amdgcn_global_load_lds((const unsigned*)((const char*)(gbase) + (v0)), (LAS unsigned*)(lds + (bufoff) + ldsw), 16, 0, 0); \
        __builtin_amdgcn_global_load_lds((const unsigned*)((const char*)(gbase) + ((hs) >> 1) + (v0)), (LAS unsigned*)(lds + (bufoff) + ldsw + 8192), 16, 0, 0); } while (0)
#define PG8_LDA(dst, b, h) do { _Pragma("unroll") for (int m = 0; m < 4; ++m) _Pragma("unroll") for (int k = 0; k < 2; ++k) dst[m][k] = *(const LAS bf16x8*)(lds + PG8_SA(b, h) + aoff + m * 2048 + k * 1024); } while (0)
#define PG8_LDB(dst, b, h) do { _Pragma("unroll") for (int n = 0; n < 2; ++n) _Pragma("unroll") for (int k = 0; k < 2; ++k) dst[n][k] = *(const LAS bf16x8*)(lds + PG8_SB(b, h) + boff + n * 2048 + k * 1024); } while (0)
#define PG8_MMA(ai, bj, At, Bt) do { __builtin_amdgcn_s_setprio(1); _Pragma("unroll") for (int m = 0; m < 4; ++m) _Pragma("unroll") for (int n = 0; n < 2; ++n) _Pragma("unroll") for (int k = 0; k < 2; ++k) \
        acc[ai][bj][m][n] = __builtin_amdgcn_mfma_f32_16x16x32_bf16(Bt[n][k], At[m][k], acc[ai][bj][m][n], 0, 0, 0); __builtin_amdgcn_s_setprio(0); } while (0)
#define PG8_WAIT_V(n) asm volatile("s_waitcnt vmcnt(" #n ")" ::: "memory")
#define PG8_WAIT_L(n) asm volatile("s_waitcnt lgkmcnt(" #n ")" ::: "memory")
#define PG8_BAR __builtin_amdgcn_s_barrier()
#define PG8_SCHED __builtin_amdgcn_sched_barrier(0)
    GU cur, nxt; int ui = 0;
    if (!S.next(0, cur)) return;
    f32x4 acc[2][2][4][2];
#pragma unroll
    for (int a = 0; a < 2; ++a)
#pragma unroll
        for (int b = 0; b < 2; ++b)
#pragma unroll
            for (int m = 0; m < 4; ++m)
#pragma unroll
                for (int n = 0; n < 2; ++n) acc[a][b][m][n] = (f32x4){0.f, 0.f, 0.f, 0.f};
    bf16x8 At[4][2], B0[2][2], B1[2][2];
    const char* cA = (const char*)cur.A; const char* cB = (const char*)cur.B;
    unsigned vA0, vB0; PG8_VOFF(cur.lda, cur.ldb, vA0, vB0);
    size_t hsA = (size_t)HALF * cur.lda * 2, hsB = (size_t)HALF * cur.ldb * 2;
    int nt = cur.nt; asm volatile("" : "+s"(nt));
    PG8_STAGE(PG8_SB(0, 0), cB, vB0, hsB); PG8_STAGE(PG8_SB(0, 1), cB + hsB, vB0, hsB); PG8_STAGE(PG8_SA(0, 0), cA, vA0, hsA); PG8_STAGE(PG8_SA(0, 1), cA + hsA, vA0, hsA);
    if (wr == 1) PG8_BAR;
    PG8_WAIT_V(2); PG8_BAR;
    PG8_STAGE(PG8_SB(1, 0), cB + kstep, vB0, hsB); PG8_STAGE(PG8_SA(1, 0), cA + kstep, vA0, hsA); PG8_STAGE(PG8_SB(1, 1), cB + hsB + kstep, vB0, hsB);
    PG8_WAIT_V(6); PG8_BAR;
    for (;;) {
        const bool has_next = S.next(ui + 1, nxt);
        const char* nA = has_next ? (const char*)nxt.A : cA; const char* nB = has_next ? (const char*)nxt.B : cB;
        unsigned nvA0 = vA0, nvB0 = vB0;
        if (has_next) PG8_VOFF(nxt.lda, nxt.ldb, nvA0, nvB0);
        const size_t nhsA = has_next ? (size_t)HALF * nxt.lda * 2 : hsA, nhsB = has_next ? (size_t)HALF * nxt.ldb * 2 : hsB;
        for (int t = 0; t < nt; t += 2) {
            const bool last = (t == nt - 2);
            const char* a1 = cA + (size_t)(t + 1) * kstep;
            const char* a2 = last ? nA : cA + (size_t)(t + 2) * kstep; const char* b2 = last ? nB : cB + (size_t)(t + 2) * kstep;
            const char* a3 = a2 + kstep; const char* b3 = b2 + kstep;
            const unsigned xA0 = last ? nvA0 : vA0, xB0 = last ? nvB0 : vB0;
            const size_t xhA = last ? nhsA : hsA, xhB = last ? nhsB : hsB;
            PG8_LDB(B0, 0, 0); PG8_LDB(B1, 0, 1); PG8_SCHED; PG8_LDA(At, 0, 0); PG8_STAGE(PG8_SA(1, 1), a1 + hsA, vA0, hsA);
            PG8_WAIT_V(8); PG8_WAIT_L(0); PG8_BAR; PG8_MMA(0, 0, At, B0); PG8_MMA(0, 1, At, B1); PG8_BAR; PG8_SCHED;
            PG8_LDA(At, 0, 1); PG8_STAGE(PG8_SB(0, 0), b2, xB0, xhB); PG8_STAGE(PG8_SB(0, 1), b2 + xhB, xB0, xhB); PG8_STAGE(PG8_SA(0, 0), a2, xA0, xhA);
            PG8_WAIT_V(8); PG8_WAIT_L(0); PG8_BAR; if constexpr (!SKIP_HI) { PG8_MMA(1, 0, At, B0); PG8_MMA(1, 1, At, B1); } PG8_BAR; PG8_SCHED;
            PG8_LDB(B0, 1, 0); PG8_LDB(B1, 1, 1); PG8_SCHED; PG8_LDA(At, 1, 0); PG8_STAGE(PG8_SA(0, 1), a2 + xhA, xA0, xhA);
            PG8_WAIT_V(8); PG8_WAIT_L(0); PG8_BAR; PG8_MMA(0, 0, At, B0); PG8_MMA(0, 1, At, B1); PG8_BAR; PG8_SCHED;
            PG8_LDA(At, 1, 1); PG8_STAGE(PG8_SB(1, 0), b3, xB0, xhB); PG8_STAGE(PG8_SB(1, 1), b3 + xhB, xB0, xhB); PG8_STAGE(PG8_SA(1, 0), a3, xA0, xhA);
            PG8_WAIT_V(8); PG8_WAIT_L(0); PG8_BAR; if constexpr (!SKIP_HI) { PG8_MMA(1, 0, At, B0); PG8_MMA(1, 1, At, B1); } PG8_BAR; PG8_SCHED;
        }
        if (wr == 0) PG8_BAR;
        const bool keep = E(acc, cur, wr, wc, fr, fq);
        if (!has_next) break;
        if (!keep) {
#pragma unroll
            for (int a = 0; a < 2; ++a)
#pragma unroll
                for (int b = 0; b < 2; ++b)
#pragma unroll
                    for (int m = 0; m < 4; ++m)
#pragma unroll
                        for (int n = 0; n < 2; ++n) acc[a][b][m][n] = (f32x4){0.f, 0.f, 0.f, 0.f};
        }
        cur = nxt; cA = nA; cB = nB; vA0 = nvA0; vB0 = nvB0; hsA = nhsA; hsB = nhsB; nt = cur.nt; asm volatile("" : "+s"(nt)); ++ui;
        if (wr == 1) PG8_BAR;
    }
    PG8_WAIT_V(0);
    PG8_BAR;
#undef PG8_VOFF
#undef PG8_SA
#undef PG8_SB
#undef PG8_STAGE
#undef PG8_LDA
#undef PG8_LDB
#undef PG8_MMA
#undef PG8_WAIT_V
#undef PG8_WAIT_L
#undef PG8_BAR
#undef PG8_SCHED
}

__device__ __forceinline__ bool tile_order(int i, int G, int c, int nM, int nN, int& pm, int& pn) {
    const int nwg = nM * nN; const long L = (long)i * G + c; if (L >= nwg) return false;
    int wgid = (int)L; { const int q = nwg / 8, r = nwg % 8, xcd = wgid % 8, off = wgid / 8; wgid = (xcd < r ? xcd * (q + 1) : r * (q + 1) + (xcd - r) * q) + off; }
    const int nig = 8 * nN, gid = wgid / nig, fm = gid * 8, gsz = (nM - fm) < 8 ? (nM - fm) : 8;
    pm = fm + ((wgid % nig) % gsz); pn = (wgid % nig) / gsz; return true;
}
}
using pg8::GU;
enum InIdx { I_X = 0, I_META, I_FNW, I_MIXNW, I_WIN, I_S5LRE, I_S5LIM, I_S5LS, I_S5BRE, I_S5BIM, I_S5CRE, I_S5CIM, I_S5D, I_GLUW, I_GLUB,
             I_CONVW, I_CONVB, I_ALOG, I_DTB, I_SSDD, I_SSDNW, I_MURKV, I_MUWAG, I_W0, I_W1, I_W2, I_A0, I_A1, I_A2, I_G1, I_G2, I_KK, I_KA, I_RK, I_LNW, I_LNB,
             I_PA, I_PB, I_PC, I_WOUT, I_MLPNW, I_MLPW1, I_MLPW2, N_INPUTS };
struct Params { const float* in[N_INPUTS]; float* out; unsigned char* ws; int ph_lo, ph_hi; };

struct Ctx {
    const float* const* in; unsigned char* ws; unsigned char* dout;
    LAS unsigned char* lds;
    int tid, lane, wave, G, bid;
    __device__ __forceinline__ bf16_t* wb(int layer) const { return (bf16_t*)(layer == 0 ? ws + WS_WB0 : dout + DO_WB1); }
    __device__ __forceinline__ bf16_t* H() const { return (bf16_t*)(ws + WS_H); }
    __device__ __forceinline__ float* ssq() const { return (float*)(ws + WS_SSQ); }
};
__device__ __forceinline__ Ctx relaunder(const Ctx& c0) {
    Ctx c = c0; c.tid = opaque_tid(c0.wave); c.lane = c.tid & 63;
    return c;
}
__device__ __forceinline__ float row_scale(const float* ssq, int row) {
    const f32x4* p = (const f32x4*)(ssq + (size_t)row * 16);
    const f32x4 a = p[0], b = p[1], c = p[2], d = p[3];
    const float s = ((a.x + a.y) + (a.z + a.w)) + ((b.x + b.y) + (b.z + b.w)) + ((c.x + c.y) + (c.z + c.w)) + ((d.x + d.y) + (d.z + d.w));
    return __builtin_amdgcn_rsqf(s * (1.0f / DM) + EPS);
}

struct SchedPlain {
    const bf16_t* A; const bf16_t* B; int lda, ldb, K, nM, nN, G, c, pm0;
    __device__ __forceinline__ bool next(int i, GU& u) const {
        int pm, pn; if (!pg8::tile_order(i, G, c, nM, nN, pm, pn)) return false;
        pm += pm0;
        u.A = A + (size_t)pm * 256 * lda; u.B = B + (size_t)pn * 256 * ldb; u.lda = lda; u.ldb = ldb; u.nt = K / 64; u.pm = pm; u.pn = pn; u.kind = 0; return true;
    }
};
struct SchedS5 {
    const bf16_t* UH; const bf16_t* W; int K, G, c;
    __device__ __forceinline__ bool next(int i, GU& u) const {
        const int L = i * G + c; if (L >= 144) return false;
        const int g = L / 9, pm = L % 9;
        u.A = UH + ((size_t)g * S5RP + (size_t)pm * 256) * 512; u.B = W + (size_t)g * 256 * K; u.lda = 512; u.ldb = K; u.nt = K / 64; u.pm = pm; u.pn = 0; u.kind = g; return true;
    }
};
struct SchedL2 {
    const bf16_t* L1o; const bf16_t* W; int G, c, nM, pm0;
    __device__ __forceinline__ bool next(int i, GU& u) const {
        int pm, pn; if (!pg8::tile_order(i, G, c, nM, 5, pm, pn)) return false;
        pm += pm0;
        const int koff = pn < 2 ? 0 : (pn < 4 ? 128 : 256);
        u.A = L1o + (size_t)pm * 256 * 512 + koff; u.B = W + (size_t)pn * 256 * 256; u.lda = 512; u.ldb = 256; u.nt = 4; u.pm = pm; u.pn = pn; u.kind = 0; return true;
    }
};
struct SchedProj {
    const bf16_t* Hb; const bf16_t* Wg; const bf16_t* Wp; const bf16_t* ya; const bf16_t* yb; const bf16_t* yc; int nM, G, c, pm0;
    __device__ __forceinline__ bool next(int i, GU& u) const {
        const int ti = i / 6, sub = i - ti * 6; int pm, pn;
        if (!pg8::tile_order(ti, G, c, nM, 4, pm, pn)) return false;
        pm += pm0;
        u.pm = pm; u.pn = pn; u.kind = sub;
        if (sub < 3) { u.A = Hb + (size_t)pm * 256 * DM; u.lda = DM; u.B = Wg + ((size_t)sub * 1024 + (size_t)pn * 256) * DM; u.ldb = DM; u.nt = 16; }
        else if (sub == 3) { u.A = ya + (size_t)pm * 256 * 256; u.lda = 256; u.B = Wp + (size_t)pn * 256 * DM; u.ldb = DM; u.nt = 4; }
        else if (sub == 4) { u.A = yb + (size_t)pm * 256 * 512; u.lda = 512; u.B = Wp + (size_t)pn * 256 * DM + 256; u.ldb = DM; u.nt = 8; }
        else { u.A = yc + (size_t)pm * 256 * 256; u.lda = 256; u.B = Wp + (size_t)pn * 256 * DM + 768; u.ldb = DM; u.nt = 4; }
        return true;
    }
};

typedef f32x4 Acc[2][2][4][2];
#define EPI_ROWS_BEGIN  _Pragma("unroll") for (int ai = 0; ai < 2; ++ai) _Pragma("unroll") for (int m = 0; m < 4; ++m) { const int rl = ai * 128 + wr * 64 + m * 16 + fr; const int row = u.pm * 256 + rl; (void)rl;
#define EPI_ROWS_END    asm volatile("" ::: "memory"); }
#define EPI_COL(bj) ((bj) * 128 + wc * 32 + fq * 8)

struct EpiInProj {
    const float* ssq; bf16_t* UH; bf16_t* Pz; bf16_t* Pxbc; bf16_t* Prkvx;
    __device__ __forceinline__ bool operator()(Acc& acc, const GU& u, int wr, int wc, int fr, int fq) const {
        EPI_ROWS_BEGIN
            if (row < M_ROWS) {
                const float s = row_scale(ssq, row);
                int b, t; bt_of(row, b, t);
#pragma unroll
                for (int bj = 0; bj < 2; ++bj) {
                    const int col = EPI_COL(bj);
                    const f32x4 v0 = acc[ai][bj][m][0] * s, v1 = acc[ai][bj][m][1] * s;
                    u32x4 w; w.x = pk2(v0[0], v0[1]); w.y = pk2(v0[2], v0[3]); w.z = pk2(v1[0], v1[1]); w.w = pk2(v1[2], v1[3]);
                    bf16_t* dst;
                    if (u.pn == 0) { const int g = col >> 4, hh = col & 15; dst = UH + ((size_t)g * S5RP + (size_t)(b * NCH16 + (t >> 4))) * 512 + (t & 15) * 16 + hh; }
                    else if (u.pn < 3) dst = Pz + (size_t)row * 512 + (u.pn - 1) * 256 + col;
                    else if (u.pn < 7) dst = Pxbc + (size_t)row * 1024 + (u.pn - 3) * 256 + col;
                    else dst = Prkvx + (size_t)row * 1024 + (u.pn - 7) * 256 + col;
                    *(u32x4*)dst = w;
                }
            }
        EPI_ROWS_END
        return false;
    }
};
struct EpiS5X {
    float* X;
    __device__ __forceinline__ bool operator()(Acc& acc, const GU& u, int wr, int wc, int fr, int fq) const {
        EPI_ROWS_BEGIN
            float* rp = X + ((size_t)u.kind * S5RP + row) * 256;
#pragma unroll
            for (int bj = 0; bj < 2; ++bj) { const int col = EPI_COL(bj); *(f32x4*)(rp + col) = acc[ai][bj][m][0]; *(f32x4*)(rp + col + 4) = acc[ai][bj][m][1]; }
        EPI_ROWS_END
        return false;
    }
};
struct EpiS5Y {
    bf16_t* yapre;
    __device__ __forceinline__ bool operator()(Acc& acc, const GU& u, int wr, int wc, int fr, int fq) const {
        EPI_ROWS_BEGIN
            if (row < S5ROWS) {
                const int b = row / NCH16, c = row - b * NCH16;
#pragma unroll
                for (int bj = 0; bj < 2; ++bj) {
                    const int col = EPI_COL(bj), i = col >> 4, hh = col & 15;
                    const f32x4 v0 = acc[ai][bj][m][0], v1 = acc[ai][bj][m][1];
                    u32x4 w; w.x = pk2(geluf_(v0[0]), geluf_(v0[1])); w.y = pk2(geluf_(v0[2]), geluf_(v0[3])); w.z = pk2(geluf_(v1[0]), geluf_(v1[1])); w.w = pk2(geluf_(v1[2]), geluf_(v1[3]));
                    *(u32x4*)(yapre + (size_t)row_of(b, c * 16 + i) * 256 + u.kind * 16 + hh) = w;
                }
            }
        EPI_ROWS_END
        return false;
    }
};
struct EpiL1 {
    bf16_t* L1o;
    __device__ __forceinline__ bool operator()(Acc& acc, const GU& u, int wr, int wc, int fr, int fq) const {
        EPI_ROWS_BEGIN
#pragma unroll
            for (int bj = 0; bj < 2; ++bj) {
                const int col = EPI_COL(bj); const int mode = u.pn * 2 + bj;
                f32x4 v0 = acc[ai][bj][m][0], v1 = acc[ai][bj][m][1]; float f[8] = {v0[0], v0[1], v0[2], v0[3], v1[0], v1[1], v1[2], v1[3]};
#pragma unroll
                for (int e = 0; e < 8; ++e) f[e] = mode == 0 ? tanhf_(f[e]) : (mode == 1 ? f[e] : (mode == 2 ? sigmoidf_(f[e]) : 0.f));
                *(u32x4*)(L1o + (size_t)row * 512 + u.pn * 256 + col) = pack8(f);
            }
        EPI_ROWS_END
        return false;
    }
};
struct EpiL2 {
    bf16_t* L2o; const float* w0; const float* a0;
    __device__ __forceinline__ bool operator()(Acc& acc, const GU& u, int wr, int wc, int fr, int fq) const {
        EPI_ROWS_BEGIN
#pragma unroll
            for (int bj = 0; bj < 2; ++bj) {
                const int col = EPI_COL(bj);
                f32x4 v0 = acc[ai][bj][m][0], v1 = acc[ai][bj][m][1]; float f[8] = {v0[0], v0[1], v0[2], v0[3], v1[0], v1[1], v1[2], v1[3]};
                if (u.pn < 2) {
                    const float* bp = w0 + u.pn * 256 + col;
#pragma unroll
                    for (int e = 0; e < 8; ++e) { const float v = bp[e] + f[e]; f[e] = -__expf(-softplusf_(-v) - 0.5f); }
                } else if (u.pn < 4) {
                    const float* bp = a0 + (u.pn - 2) * 256 + col;
#pragma unroll
                    for (int e = 0; e < 8; ++e) f[e] = sigmoidf_(bp[e] + f[e]);
                }
                *(u32x4*)(L2o + (size_t)row * 1280 + u.pn * 256 + col) = pack8(f);
            }
        EPI_ROWS_END
        return false;
    }
};
struct EpiGLU {
    bf16_t* ya; const float* bias;
    __device__ __forceinline__ bool operator()(Acc& acc, const GU& u, int wr, int wc, int fr, int fq) const {
        const int lc = wc * 32 + fq * 8, oc = u.pn * 128 + lc;
        float bv[8], bg[8];
#pragma unroll
        for (int e = 0; e < 8; ++e) { bv[e] = bias[oc + e]; bg[e] = bias[256 + oc + e]; }
        EPI_ROWS_BEGIN
            const f32x4 a0 = acc[ai][0][m][0], a1 = acc[ai][0][m][1], g0 = acc[ai][1][m][0], g1 = acc[ai][1][m][1];
            float v[8] = {a0[0], a0[1], a0[2], a0[3], a1[0], a1[1], a1[2], a1[3]}, g[8] = {g0[0], g0[1], g0[2], g0[3], g1[0], g1[1], g1[2], g1[3]};
#pragma unroll
            for (int e = 0; e < 8; ++e) v[e] = (v[e] + bv[e]) * sigmoidf_(g[e] + bg[e]);
            *(u32x4*)(ya + (size_t)row * 256 + oc) = pack8(v);
        EPI_ROWS_END
        return false;
    }
};
struct EpiProj {
    const float* ssq; const float* ssqb; unsigned char* park; bf16_t* merged; int tid;
    __device__ __forceinline__ bool operator()(Acc& acc, const GU& u, int wr, int wc, int fr, int fq) const {
        const int k = u.kind;
        EPI_ROWS_BEGIN
            float s = 1.f; if (k < 3) s = row_scale(ssq, row < M_ROWS ? row : 0);
            else if (k < 5) { { const int rr_ = row < M_ROWS ? row : 0; s = __builtin_amdgcn_rsqf((ssqb[2 * rr_] + ssqb[2 * rr_ + 1]) * (1.0f / 512.f) + EPS); } if (k == 3) s = __builtin_amdgcn_rcpf(s); }
#pragma unroll
            for (int bj = 0; bj < 2; ++bj) {
                const int q = (ai * 2 + bj) * 4 + m;
                f32x4& v0 = acc[ai][bj][m][0]; f32x4& v1 = acc[ai][bj][m][1];
                if (k < 3) {
                    float f[8] = {v0[0], v0[1], v0[2], v0[3], v1[0], v1[1], v1[2], v1[3]};
#pragma unroll
                    for (int e = 0; e < 8; ++e) f[e] = sigmoidf_(f[e] * s);
                    *(u32x4*)(park + ((size_t)(k * 16 + q) * NTHREADS + tid) * 16) = pack8(f);
                } else {
                    float num[8], den[8];
                    unpack8(*(const u32x4*)(park + ((size_t)((k - 3) * 16 + q) * NTHREADS + tid) * 16), num);
                    if (k < 5) { unpack8(*(const u32x4*)(park + ((size_t)((k - 2) * 16 + q) * NTHREADS + tid) * 16), den);
#pragma unroll
                        for (int e = 0; e < 8; ++e) num[e] = num[e] * __builtin_amdgcn_rcpf(den[e]) * s; }
                    v0[0] *= num[0]; v0[1] *= num[1]; v0[2] *= num[2]; v0[3] *= num[3]; v1[0] *= num[4]; v1[1] *= num[5]; v1[2] *= num[6]; v1[3] *= num[7];
                    if (k == 5) { u32x4 w; w.x = pk2(v0[0], v0[1]); w.y = pk2(v0[2], v0[3]); w.z = pk2(v1[0], v1[1]); w.w = pk2(v1[2], v1[3]);
                        *(u32x4*)(merged + (size_t)row * DM + u.pn * 256 + EPI_COL(bj)) = w; }
                }
            }
        EPI_ROWS_END
        return k == 3 || k == 4;
    }
};
struct EpiResid {
    bf16_t* H; float* ssq;
    __device__ __forceinline__ bool operator()(Acc& acc, const GU& u, int wr, int wc, int fr, int fq) const {
        EPI_ROWS_BEGIN
            float ss = 0.f;
            if (row < M_ROWS) {
#pragma unroll
                for (int bj = 0; bj < 2; ++bj) {
                    bf16_t* hp = H + (size_t)row * DM + u.pn * 256 + EPI_COL(bj);
                    float f[8]; unpack8(*(const u32x4*)hp, f);
                    const f32x4 v0 = acc[ai][bj][m][0], v1 = acc[ai][bj][m][1];
                    f[0] += v0[0]; f[1] += v0[1]; f[2] += v0[2]; f[3] += v0[3]; f[4] += v1[0]; f[5] += v1[1]; f[6] += v1[2]; f[7] += v1[3];
#pragma unroll
                    for (int e = 0; e < 8; ++e) ss += f[e] * f[e];
                    *(u32x4*)hp = pack8(f);
                }
            }
            ss += __shfl_xor(ss, 16); ss += __shfl_xor(ss, 32);
            if (fq == 0 && row < M_ROWS) ssq[(size_t)row * 16 + u.pn * 4 + wc] = ss;
        EPI_ROWS_END
        return false;
    }
};
struct EpiUp {
    const float* ssq; bf16_t* act;
    __device__ __forceinline__ bool operator()(Acc& acc, const GU& u, int wr, int wc, int fr, int fq) const {
        EPI_ROWS_BEGIN
            const float s = row_scale(ssq, row < M_ROWS ? row : 0);
#pragma unroll
            for (int bj = 0; bj < 2; ++bj) {
                const f32x4 v0 = acc[ai][bj][m][0] * s, v1 = acc[ai][bj][m][1] * s; float f[8] = {v0[0], v0[1], v0[2], v0[3], v1[0], v1[1], v1[2], v1[3]};
#pragma unroll
                for (int e = 0; e < 8; ++e) { const float r = fmaxf(f[e], 0.f); f[e] = r * r; }
                *(u32x4*)(act + (size_t)row * DFF + u.pn * 256 + EPI_COL(bj)) = pack8(f);
            }
        EPI_ROWS_END
        return false;
    }
};
typedef __attribute__((address_space(1))) unsigned gu32;
#define XB_TMO      128
#define XB_XCNT(j)  (256  + 64 * (j))
#define XB_XSUB(j)  (1280 + 64 * (j))
#define XB_XGEN(j)  (2304 + 64 * (j))
#define XB_TOP      3328
#define XB_TOPGEN   3392
#define XCD_BAR_WORDS 3456
#define XB_SPIN_CAP (1u << 18)

__device__ __forceinline__ unsigned xb_ld(unsigned* p)              { return __hip_atomic_load(p, __ATOMIC_RELAXED, __HIP_MEMORY_SCOPE_AGENT); }
__device__ __forceinline__ unsigned xb_add(unsigned* p, unsigned v) { return __hip_atomic_fetch_add(p, v, __ATOMIC_RELAXED, __HIP_MEMORY_SCOPE_AGENT); }
__device__ __forceinline__ unsigned xb_xcc_id() { return (unsigned)__builtin_amdgcn_s_getreg((3 << 11) | 20) & 0xFu; }
#define XB_SPIN(cond, bar) do { unsigned _sp = 0; while (cond) { __builtin_amdgcn_s_sleep(1); \
    if ((++_sp & 255u) == 0u) { if (xb_ld(&(bar)[XB_TMO])) break; if (_sp > XB_SPIN_CAP) { atomicAdd(&(bar)[XB_TMO], 1u); break; } } } } while (0)

struct XcdBarrier {
    unsigned* bar; unsigned x;
    volatile LAS unsigned* st;
};

__device__ __forceinline__ XcdBarrier xcd_barrier_post(unsigned* bar, volatile LAS unsigned* st) {
    XcdBarrier b; b.bar = bar; b.x = xb_xcc_id(); b.st = st;
    if (threadIdx.x == 0) (void)xb_add(&bar[XB_XCNT(b.x)], 1u);
    return b;
}
__device__ __forceinline__ void xcd_barrier_complete(unsigned* bar, unsigned x, unsigned& nloc, unsigned& nx) {
    const unsigned G = gridDim.x * gridDim.y * gridDim.z;
    unsigned sum, cnt, mine, sp = 0u;
    for (;;) {
        sum = 0u; cnt = 0u; mine = 0u;
#pragma unroll
        for (unsigned j = 0; j < 16; ++j) { const unsigned c = xb_ld(&bar[XB_XCNT(j)]); sum += c; cnt += (c > 0u) ? 1u : 0u; mine = (j == x) ? c : mine; }
        if (sum == G) break;
        __builtin_amdgcn_s_sleep(1);
        if ((++sp & 255u) == 0u) { if (xb_ld(&bar[XB_TMO])) break; if (sp > XB_SPIN_CAP) { atomicAdd(&bar[XB_TMO], 1u); break; } }
    }
    nloc = mine > 0u ? mine : 1u; nx = cnt > 0u ? cnt : 1u;
}

__device__ __forceinline__ void xcd_barrier(const XcdBarrier& b, int wave_s) {
    const bool xb_t0 = threadIdx.x == 0; (void)wave_s;
    asm volatile("s_waitcnt vmcnt(0)" ::: "memory");
    __syncthreads();
    if (xb_t0) {
        unsigned* bar = b.bar;
        __builtin_amdgcn_s_waitcnt(0);
        unsigned nloc = b.st[0], nx = b.st[1];
        if (nloc == 0u) { xcd_barrier_complete(bar, b.x, nloc, nx); b.st[0] = nloc; b.st[1] = nx; }
        const unsigned old = xb_add(&bar[XB_XSUB(b.x)], 1u);
        const unsigned gen = old / nloc;
        if (old + 1u == (gen + 1u) * nloc) {
            __builtin_amdgcn_fence(__ATOMIC_RELEASE, "agent");
            asm volatile("s_waitcnt vmcnt(0)" ::: "memory");
            const unsigned og = xb_add(&bar[XB_TOP], 1u);
            const unsigned tg = og / nx;
            if (og + 1u == (tg + 1u) * nx) xb_add(&bar[XB_TOPGEN], 1u);
            else XB_SPIN(xb_ld(&bar[XB_TOPGEN]) == tg, bar);
            __builtin_amdgcn_fence(__ATOMIC_ACQUIRE, "agent");
            xb_add(&bar[XB_XGEN(b.x)], 1u);
            asm volatile("s_waitcnt vmcnt(0)" ::: "memory");
        } else {
            XB_SPIN(xb_ld(&bar[XB_XGEN(b.x)]) == gen, bar);
            __builtin_amdgcn_fence(__ATOMIC_ACQUIRE, "agent");
            asm volatile("s_waitcnt vmcnt(0)" ::: "memory");
        }
    }
    __syncthreads();
}

#ifdef PROF_A
#ifndef PROF_SHIFT
#define PROF_SHIFT 1.0f
#endif
#define PROF_PTR ((unsigned long long*)(c.ws + WS_DEC + (size_t)MP * 64))
#define STAMP(k) do { if (blockIdx.x == 0 && threadIdx.x == 0) { const unsigned long long t_ = __builtin_amdgcn_s_memrealtime(); PROF_PTR[k] += t_ - PROF_PTR[15]; PROF_PTR[15] = t_; } } while (0)
#else
#define STAMP(k) do { } while (0)
#endif
struct TJob { const float* src; int ld, col0, K, N; bf16_t* dst; int dld, dk0, rmode, row0; const float* ksc; };
constexpr int N_TJOBS = 27;
__device__ __forceinline__ void get_tjob(const Ctx& c, int l, int j, TJob& t) {
    bf16_t* wb = c.wb(l);
    const float* win = c.in[I_WIN] + (size_t)l * DM * N_IN;
    t.rmode = 0; t.ksc = nullptr; t.dk0 = 0; t.col0 = 0; t.row0 = 0;
    if (j < 5) {
        t.src = win; t.ld = N_IN; t.K = DM; t.dld = DM; t.ksc = c.in[I_MIXNW] + l * DM; t.dst = wb + WB_IN;
        if (j == 0) { t.col0 = 0; t.N = 256; t.row0 = 0; }
        else if (j == 1) { t.col0 = 256; t.N = 512; t.row0 = 256; }
        else if (j == 2) { t.col0 = 768; t.N = 1024; t.row0 = 768; }
        else if (j == 3) { t.col0 = 1800; t.N = 1024; t.row0 = 1792; }
        else { t.col0 = 2824; t.N = 3072; t.row0 = 0; t.dst = wb + WB_G; }
    } else if (j == 5) { t.src = c.in[I_PA] + (size_t)l * 256 * DM; t.ld = DM; t.K = 256; t.N = DM; t.dst = wb + WB_P; t.dld = DM; t.dk0 = 0; }
    else if (j == 6) { t.src = c.in[I_PB] + (size_t)l * 512 * DM; t.ld = DM; t.K = 512; t.N = DM; t.dst = wb + WB_P; t.dld = DM; t.dk0 = 256; t.ksc = c.in[I_SSDNW] + (size_t)l * 512; }
    else if (j == 7) { t.src = c.in[I_PC] + (size_t)l * 256 * DM; t.ld = DM; t.K = 256; t.N = DM; t.dst = wb + WB_P; t.dld = DM; t.dk0 = 768; }
    else if (j == 8) { t.src = c.in[I_WOUT] + (size_t)l * DM * DM; t.ld = DM; t.K = DM; t.N = DM; t.dst = wb + WB_O; t.dld = DM; }
    else if (j == 9) { t.src = c.in[I_MLPW1] + (size_t)l * DM * DFF; t.ld = DFF; t.K = DM; t.N = DFF; t.dst = wb + WB_1; t.dld = DM; t.ksc = c.in[I_MLPNW] + l * DM; }
    else if (j == 10) { t.src = c.in[I_MLPW2] + (size_t)l * DFF * DM; t.ld = DM; t.K = DFF; t.N = DM; t.dst = wb + WB_2; t.dld = DFF; }
    else if (j == 11) { t.src = c.in[I_GLUW] + (size_t)l * 256 * 512; t.ld = 512; t.K = 256; t.N = 512; t.dst = wb + WB_GLU; t.dld = 256; t.rmode = 1; }
    else if (j < 22) {
        const int q = j - 12;
        t.K = 256; t.dst = wb + WB_L1; t.dld = 512;
        if (q < 4) { const int d = q >> 1, hf = q & 1; t.src = c.in[I_W1] + ((size_t)l * 2 + d) * 256 * 64; t.ld = 64; t.N = 64; t.row0 = d * 64; t.dk0 = hf * 256; if (hf) t.ksc = c.in[I_MUWAG] + ((size_t)l * 3 + 0) * 256; }
        else if (q < 8) { const int d = (q - 4) >> 1, hf = q & 1; t.src = c.in[I_A1] + ((size_t)l * 2 + d) * 256 * 64; t.ld = 64; t.N = 64; t.row0 = 128 + d * 64; t.dk0 = hf * 256; if (hf) t.ksc = c.in[I_MUWAG] + ((size_t)l * 3 + 1) * 256; }
        else { const int hf = q & 1; t.src = c.in[I_G1] + (size_t)l * 256 * 128; t.ld = 128; t.N = 128; t.row0 = 256; t.dk0 = hf * 256; if (hf) t.ksc = c.in[I_MUWAG] + ((size_t)l * 3 + 2) * 256; }
    } else {
        const int q = j - 22;
        t.dst = wb + WB_L2; t.dld = 256; t.ld = 256; t.N = 256;
        if (q < 2) { t.src = c.in[I_W2] + ((size_t)l * 2 + q) * 64 * 256; t.K = 64; t.row0 = q * 256; t.dk0 = q * 64; }
        else if (q < 4) { const int d = q - 2; t.src = c.in[I_A2] + ((size_t)l * 2 + d) * 64 * 256; t.K = 64; t.row0 = (2 + d) * 256; t.dk0 = d * 64; }
        else { t.src = c.in[I_G2] + (size_t)l * 128 * 256; t.K = 128; t.row0 = 4 * 256; t.dk0 = 0; }
    }
}
__device__ __forceinline__ int tjob_items(const TJob& t) { return (t.K / 64) * (t.N / 32); }
struct TIt { int l, j, base, gid; bool ok; TJob t; };
__device__ __forceinline__ void tit_seek(const Ctx& c, TIt& s) {
    s.ok = false;
    while (s.l < DEPTH) {
        const int ni = tjob_items(s.t);
        if (s.gid < s.base + ni) { s.ok = true; break; }
        s.base += ni;
        if (++s.j == N_TJOBS) { s.j = 0; ++s.l; if (s.l >= DEPTH) break; }
        get_tjob(c, s.l, s.j, s.t);
    }
}
__device__ __forceinline__ void tr_load(const TJob& t, int item, int lane, float (&v)[32]) {
    const int nblk = t.N / 32, kb = item / nblk, nb = item % nblk, k0 = 64 * kb, n0 = 32 * nb;
    const float* __restrict__ sp = t.src + (size_t)(k0 + (lane >> 5)) * t.ld + t.col0 + n0 + (lane & 31);
#pragma unroll
    for (int i = 0; i < 32; ++i) v[i] = sp[(size_t)(2 * i) * t.ld];
}
__device__ __forceinline__ void tr_store(const TJob& t, LAS float* scr, int item, int lane, const float (&v)[32]) {
    const int nblk = t.N / 32, kb = item / nblk, nb = item % nblk, k0 = 64 * kb, n0 = 32 * nb;
    const int cc = lane & 7;
    f32x4 ka = {1.f, 1.f, 1.f, 1.f}, kb4 = {1.f, 1.f, 1.f, 1.f};
    if (t.ksc) { ka = *(const f32x4*)(t.ksc + k0 + 8 * cc); kb4 = *(const f32x4*)(t.ksc + k0 + 8 * cc + 4); }
#pragma unroll
    for (int i = 0; i < 32; ++i) scr[(2 * i + (lane >> 5)) * 33 + (lane & 31)] = v[i];
    asm volatile("s_waitcnt lgkmcnt(0)" ::: "memory");
#pragma unroll
    for (int j = 0; j < 4; ++j) {
        const int n = (lane >> 3) + 8 * j; const LAS float* s = scr + (8 * cc) * 33 + n;
        u32x4 o; o.x = pk2(s[0 * 33] * ka.x, s[1 * 33] * ka.y); o.y = pk2(s[2 * 33] * ka.z, s[3 * 33] * ka.w); o.z = pk2(s[4 * 33] * kb4.x, s[5 * 33] * kb4.y); o.w = pk2(s[6 * 33] * kb4.z, s[7 * 33] * kb4.w);
        const int nn = n0 + n; int drow;
        if (t.rmode == 0) drow = t.row0 + nn; else drow = nn < 256 ? (nn >> 7) * 256 + (nn & 127) : ((nn - 256) >> 7) * 256 + 128 + ((nn - 256) & 127);
        *(u32x4*)(t.dst + (size_t)drow * t.dld + t.dk0 + k0 + 8 * cc) = o;
    }
    asm volatile("s_waitcnt lgkmcnt(0)" ::: "memory");
}

__device__ __forceinline__ void s5_build(const Ctx& cx_, int l, int g, int part) {
    const Ctx c = relaunder(cx_);
    LAS float* F = (LAS float*)c.lds;
    LAS float* pwr = F;
    LAS float* pwi = pwr + 2176;
    LAS float* cor = pwi + 2176;
    LAS float* coi = cor + 128;
    LAS float* Cr = coi + 128;
    LAS float* Ci = Cr + 1024;
    LAS float* Br = Ci + 1024;
    LAS float* Bi = Br + 1024;
    LAS float* kr = Bi + 1024;
    LAS float* ki = kr + 1984;
    LAS float* Kd = ki + 1984;
    const int tid = c.tid;
    for (int i = tid; i < 2 * 17 * 64; i += NTHREADS) {
        const int d = i / 1088, k = (i - d * 1088) >> 6, n = i & 63; const size_t li_ = (((size_t)l * 2 + d) * 16 + g) * 64 + n;
        const float lr = c.in[I_S5LRE][li_], li = c.in[I_S5LIM][li_], step = expf(c.in[I_S5LS][((size_t)l * 2 + d) * 16 + g]);
        const float mag = expf((float)k * lr * step), ang = (float)k * li * step; float sn, cs; sincosf(ang, &sn, &cs); pwr[(d * 17 + k) * 64 + n] = mag * cs; pwi[(d * 17 + k) * 64 + n] = mag * sn;
    }
    if (tid < 128) {
        const int d = tid >> 6, n = tid & 63; const size_t li_ = (((size_t)l * 2 + d) * 16 + g) * 64 + n;
        const float lr = c.in[I_S5LRE][li_], li = c.in[I_S5LIM][li_], step = expf(c.in[I_S5LS][((size_t)l * 2 + d) * 16 + g]);
        const float mag1 = expf(lr * step); float sn, cs; sincosf(li * step, &sn, &cs); const float abr = mag1 * cs, abi = mag1 * sn, den = lr * lr + li * li;
        cor[d * 64 + n] = ((abr - 1.f) * lr + abi * li) / den; coi[d * 64 + n] = (abi * lr - (abr - 1.f) * li) / den;
    }
    for (int i = tid; i < 1024; i += NTHREADS) {
        Cr[i] = c.in[I_S5CRE][((size_t)l * 16 + g) * 1024 + i]; Ci[i] = c.in[I_S5CIM][((size_t)l * 16 + g) * 1024 + i];
        Br[i] = c.in[I_S5BRE][((size_t)l * 16 + g) * 1024 + i]; Bi[i] = c.in[I_S5BIM][((size_t)l * 16 + g) * 1024 + i];
    }
    __syncthreads();
    for (int i = tid; i < 31 * 64; i += NTHREADS) {
        const int dd = i / 64 - 15, n = i & 63; float r, im;
        if (dd > 0) { const float pr = pwr[(0 * 17 + dd) * 64 + n], pi = pwi[(0 * 17 + dd) * 64 + n]; r = pr * cor[n] - pi * coi[n]; im = pr * coi[n] + pi * cor[n]; }
        else if (dd < 0) { const float pr = pwr[(1 * 17 - dd) * 64 + n], pi = pwi[(1 * 17 - dd) * 64 + n]; r = pr * cor[64 + n] - pi * coi[64 + n]; im = pr * coi[64 + n] + pi * cor[64 + n]; }
        else { r = cor[n] + cor[64 + n]; im = coi[n] + coi[64 + n]; }
        kr[i] = r; ki[i] = im;
    }
    __syncthreads();
    for (int i0 = tid; i0 < 31 * 32; i0 += NTHREADS) {
        const int ddi = i0 >> 5, h = 2 * part + ((i0 >> 4) & 1), hp = i0 & 15; float a = 0.f;
        for (int n = 0; n < 64; ++n) { const float cr = Cr[h * 64 + n], ci = Ci[h * 64 + n], xr = kr[ddi * 64 + n], xi = ki[ddi * 64 + n]; const float pr = cr * xr - ci * xi, pi = cr * xi + ci * xr; a += pr * Br[n * 16 + hp] - pi * Bi[n * 16 + hp]; }
        Kd[ddi * 256 + h * 16 + hp] = a;
    }
    __syncthreads();
    bf16_t* SX = c.wb(l) + WB_SX + (size_t)g * 256 * 256; bf16_t* SY = c.wb(l) + WB_SY + (size_t)g * 256 * 512;
    const float* dsk = c.in[I_S5D] + (size_t)l * 256 + g * 16;
    for (int u = tid; u < 32 * 64; u += NTHREADS) {
        const int i = u >> 7, h = 2 * part + ((u >> 6) & 1), o = i * 16 + h, kk0 = (u & 63) * 8; float v[8];
        if (kk0 < 256) { const int j = kk0 >> 4, hp0 = kk0 & 15;
#pragma unroll
            for (int e = 0; e < 8; ++e) v[e] = Kd[(i - j + 15) * 256 + h * 16 + hp0 + e] + ((i == j && h == hp0 + e) ? dsk[h] : 0.f);
        } else { const int q = kk0 - 256, d = q >> 7, part = (q >> 6) & 1, n0 = q & 63, ex = d == 0 ? i + 1 : 16 - i;
#pragma unroll
            for (int e = 0; e < 8; ++e) { const int n = n0 + e; const float cr = Cr[h * 64 + n], ci = Ci[h * 64 + n], pr = pwr[(d * 17 + ex) * 64 + n], pi = pwi[(d * 17 + ex) * 64 + n]; v[e] = part == 0 ? (cr * pr - ci * pi) : -(cr * pi + ci * pr); }
        }
        *(u32x4*)(SY + (size_t)o * 512 + kk0) = pack8(v);
    }
    for (int u = tid; u < 32 * 32; u += NTHREADS) {
        const int o = 32 * part + (u >> 5), kk0 = (u & 31) * 8, d = o >> 7, part = (o >> 6) & 1, n = o & 63, j = kk0 >> 4, hp0 = kk0 & 15, ex = d == 0 ? 15 - j : j;
        const float pr = pwr[(d * 17 + ex) * 64 + n], pi = pwi[(d * 17 + ex) * 64 + n], qr = pr * cor[d * 64 + n] - pi * coi[d * 64 + n], qi = pr * coi[d * 64 + n] + pi * cor[d * 64 + n];
        float v[8];
#pragma unroll
        for (int e = 0; e < 8; ++e) { const float br = Br[n * 16 + hp0 + e], bi = Bi[n * 16 + hp0 + e]; v[e] = part == 0 ? (qr * br - qi * bi) : (qr * bi + qi * br); }
        *(u32x4*)(SX + (size_t)o * 256 + kk0) = pack8(v);
    }
    __syncthreads();
}

__device__ __forceinline__ void phase0(const Ctx& cx_) {
    const Ctx c = relaunder(cx_);
    if (c.bid < 256) s5_build(c, c.bid >> 7, (c.bid >> 3) & 15, c.bid & 7);
    STAMP(13);
    const int gw = c.bid * NWAVES + c.wave, NGW = c.G * NWAVES, lane = c.lane;
    bf16_t* H = c.H(); float* ssq = c.ssq();
#pragma unroll 2
    for (int m = gw; m < MP; m += NGW) {
        u32x2* hp = (u32x2*)(H + (size_t)m * DM);
        if (m >= M_ROWS) {
#pragma unroll
            for (int i = 0; i < 4; ++i) hp[lane + 64 * i] = (u32x2){0u, 0u};
            continue;
        }
        int b, t; bt_of(m, b, t);
        const f32x4* src = (const f32x4*)(t < NMETA ? c.in[I_META] + (size_t)t * DM : c.in[I_X] + ((size_t)b * SEQ + (t - NMETA)) * DM);
        float ss = 0.f;
#pragma unroll
        for (int i = 0; i < 4; ++i) { const f32x4 v = src[lane + 64 * i]; ss += (v.x * v.x + v.y * v.y) + (v.z * v.z + v.w * v.w); hp[lane + 64 * i] = (u32x2){pk2(v.x, v.y), pk2(v.z, v.w)}; }
        ss = wave_sum(ss);
        if (lane < 16) ssq[(size_t)m * 16 + lane] = lane == 0 ? ss : 0.f;
    }
    STAMP(14);
    LAS float* scr = (LAS float*)(c.lds + c.wave * 8448);
    {
        TIt a; a.l = 0; a.j = 0; a.base = 0; a.gid = gw; get_tjob(c, 0, 0, a.t); tit_seek(c, a);
        float v[32], w[32];
        if (a.ok) tr_load(a.t, a.gid - a.base, lane, v);
        while (a.ok) {
            TIt b = a; b.gid += NGW; tit_seek(c, b);
            if (b.ok) tr_load(b.t, b.gid - b.base, lane, w);
            tr_store(a.t, scr, a.gid - a.base, lane, v);
            a = b;
#pragma unroll
            for (int i = 0; i < 32; ++i) v[i] = w[i];
        }
    }
    for (int l = 0; l < DEPTH; ++l) {
        bf16_t* wb = c.wb(l);
        const int gt = c.bid * NTHREADS + c.tid, NGT = c.G * NTHREADS;
        for (int u = gt; u < 128 * 64; u += NGT) *(u32x4*)(wb + WB_L1 + (size_t)384 * 512 + (size_t)u * 8) = (u32x4){0u, 0u, 0u, 0u};
        for (int u = gt; u < 5 * 256 * 4 * 8; u += NGT) {
            const int sub = u & 7, blk = (u >> 3) & 3, row = (u >> 5) & 255, tile = u >> 13;
            const bool nz = (tile == 0 || tile == 2) ? (blk == 0) : ((tile == 1 || tile == 3) ? (blk == 1) : (blk < 2));
            if (!nz) *(u32x4*)(wb + WB_L2 + ((size_t)tile * 256 + row) * 256 + blk * 64 + sub * 8) = (u32x4){0u, 0u, 0u, 0u};
        }
    }
}

__device__ __forceinline__ void dt_job(const Ctx& cx_, int l) {
    const Ctx c = relaunder(cx_);
    LAS float* dtw = (LAS float*)c.lds;
    const float* win = c.in[I_WIN] + (size_t)l * DM * N_IN; const float* nw = c.in[I_MIXNW] + l * DM;
    for (int i = c.tid; i < 8 * DM; i += NTHREADS) { const int k = i >> 3, j = i & 7; dtw[j * DM + k] = nw[k] * win[(size_t)k * N_IN + 1792 + j]; }
    __syncthreads();
    const int gw = c.bid * NWAVES + c.wave, NGW = c.G * NWAVES, lane = c.lane;
    const bf16_t* H = c.H(); float* dt = (float*)(c.ws + WS_DT); float* dec = (float*)(c.ws + WS_DEC);
    const float* dtb = c.in[I_DTB] + l * 16; const float* alog = c.in[I_ALOG] + l * 16;
#pragma unroll 2
    for (int m = gw; m < M_ROWS; m += NGW) {
        const u32x2* hp = (const u32x2*)(H + (size_t)m * DM);
        float ss = 0.f, d8[8] = {0.f, 0.f, 0.f, 0.f, 0.f, 0.f, 0.f, 0.f};
#pragma unroll
        for (int i = 0; i < 4; ++i) {
            const u32x2 w = hp[lane + 64 * i]; const float h0 = bflo(w.x), h1 = bfhi(w.x), h2 = bflo(w.y), h3 = bfhi(w.y);
            ss += (h0 * h0 + h1 * h1) + (h2 * h2 + h3 * h3);
#pragma unroll
            for (int j = 0; j < 8; ++j) { const f32x4 wv = *(const LAS f32x4*)(dtw + j * DM + 4 * lane + 256 * i); d8[j] += (h0 * wv.x + h1 * wv.y) + (h2 * wv.z + h3 * wv.w); }
        }
        ss = wave_sum(ss);
#pragma unroll
        for (int j = 0; j < 8; ++j) d8[j] = wave_sum(d8[j]);
        const float s = __builtin_amdgcn_rsqf(ss * (1.0f / DM) + EPS);
        if (lane < 16) {
            const int j = lane & 7; float raw = d8[0];
#pragma unroll
            for (int e = 1; e < 8; ++e) raw = (j == e) ? d8[e] : raw;
            const float dtv = softplusf_(raw * s + dtb[lane]);
            dt[(size_t)m * 16 + lane] = dtv; dec[(size_t)m * 16 + lane] = -dtv * __expf(alog[lane]);
        }
    }
    __syncthreads();
}

__device__ __forceinline__ void rwkv_prep(const Ctx& cx_, int l) {
    const Ctx c = relaunder(cx_);
    const int gw = c.bid * NWAVES + c.wave, NGW = c.G * NWAVES, lane = c.lane, c0 = 4 * lane;
    const bf16_t* __restrict__ P = (const bf16_t*)(c.ws + WS_PRKVX); bf16_t* __restrict__ rk = (bf16_t*)(c.dout + DO_RKVP); bf16_t* __restrict__ l1 = (bf16_t*)(c.ws + WS_L1IN);
    float mu[3][4], kkw[4];
#pragma unroll
    for (int x = 0; x < 3; ++x)
#pragma unroll
        for (int e = 0; e < 4; ++e) mu[x][e] = c.in[I_MURKV][((size_t)l * 3 + x) * 256 + c0 + e];
#pragma unroll
    for (int e = 0; e < 4; ++e) kkw[e] = c.in[I_KK][(size_t)l * 256 + c0 + e];
#pragma unroll 4
    for (int m = gw; m < M_ROWS; m += NGW) {
        int b, t; bt_of(m, b, t); const bool hp = t > 0, hn = t < LEN - 1; const size_t mp_ = hp ? row_of(b, t - 1) : 0, mn_ = hn ? row_of(b, t + 1) : 0;
        float o[4][4];
        float xc[4], dxc[4];
#pragma unroll
        for (int x = 0; x < 4; ++x) {
            const u32x2 wc_ = *(const u32x2*)(P + (size_t)m * 1024 + x * 256 + c0);
            u32x2 wp = (u32x2){0u, 0u}, wn = (u32x2){0u, 0u};
            if (hp) wp = *(const u32x2*)(P + mp_ * 1024 + x * 256 + c0);
            if (hn) wn = *(const u32x2*)(P + mn_ * 1024 + x * 256 + c0);
            const float cur[4] = {bflo(wc_.x), bfhi(wc_.x), bflo(wc_.y), bfhi(wc_.y)}, pv[4] = {bflo(wp.x), bfhi(wp.x), bflo(wp.y), bfhi(wp.y)}, nv[4] = {bflo(wn.x), bfhi(wn.x), bflo(wn.y), bfhi(wn.y)};
#pragma unroll
            for (int e = 0; e < 4; ++e) { const float cs = 0.5f * (pv[e] + nv[e]) - cur[e]; if (x < 3) o[x][e] = cur[e] + cs * mu[x][e]; else { xc[e] = cur[e]; dxc[e] = cs; } }
        }
        float kr_[4], ss = 0.f;
#pragma unroll
        for (int e = 0; e < 4; ++e) { kr_[e] = o[1][e] * kkw[e]; ss += kr_[e] * kr_[e]; }
        ss = sum16(ss); const float rn = __builtin_amdgcn_rsqf(ss + 1e-12f);
        bf16_t* rp = rk + (size_t)m * 1024 + c0;
        *(u32x2*)(rp) = (u32x2){pk2(o[0][0], o[0][1]), pk2(o[0][2], o[0][3])};
        *(u32x2*)(rp + 256) = (u32x2){pk2(o[1][0], o[1][1]), pk2(o[1][2], o[1][3])};
        *(u32x2*)(rp + 512) = (u32x2){pk2(o[2][0], o[2][1]), pk2(o[2][2], o[2][3])};
        *(u32x2*)(rp + 768) = (u32x2){pk2(kr_[0] * rn, kr_[1] * rn), pk2(kr_[2] * rn, kr_[3] * rn)};
        bf16_t* lp = l1 + (size_t)m * 512 + c0;
        *(u32x2*)(lp) = (u32x2){pk2(xc[0], xc[1]), pk2(xc[2], xc[3])};
        *(u32x2*)(lp + 256) = (u32x2){pk2(dxc[0], dxc[1]), pk2(dxc[2], dxc[3])};
    }
}
__device__ __forceinline__ void ssd_prep(const Ctx& cx_, int l) {
    const Ctx c = relaunder(cx_);
    const int gw = c.bid * NWAVES + c.wave, NGW = c.G * NWAVES, lane = c.lane, c0 = 16 * lane;
    const bf16_t* __restrict__ P = (const bf16_t*)(c.ws + WS_PXBC); bf16_t* __restrict__ xs = (bf16_t*)(c.ws + WS_XS); bf16_t* __restrict__ bc = (bf16_t*)(c.ws + WS_BC);
    float w[5][16], bias[16];
#pragma unroll
    for (int j = 0; j < 5; ++j)
#pragma unroll
        for (int e = 0; e < 16; ++e) w[j][e] = c.in[I_CONVW][((size_t)l * 5 + j) * 1024 + c0 + e];
#pragma unroll
    for (int e = 0; e < 16; ++e) bias[e] = c.in[I_CONVB][(size_t)l * 1024 + c0 + e];
#pragma unroll 2
    for (int m = gw; m < M_ROWS; m += NGW) {
        int b, t; bt_of(m, b, t);
        float a[16];
#pragma unroll
        for (int e = 0; e < 16; ++e) a[e] = bias[e];
#pragma unroll
        for (int j = 0; j < 5; ++j) {
            const int tt = t + j - 2;
            if (tt >= 0 && tt < LEN) {
                const u32x4* p = (const u32x4*)(P + (size_t)row_of(b, tt) * 1024 + c0); float f0[8], f1[8]; unpack8(p[0], f0); unpack8(p[1], f1);
#pragma unroll
                for (int e = 0; e < 8; ++e) { a[e] += w[j][e] * f0[e]; a[8 + e] += w[j][8 + e] * f1[e]; }
            }
        }
        float o0[8], o1[8];
#pragma unroll
        for (int e = 0; e < 8; ++e) { o0[e] = siluf_(a[e]); o1[e] = siluf_(a[8 + e]); }
        bf16_t* dst = lane < 32 ? xs + (size_t)m * 512 + c0 : bc + (size_t)m * 512 + (c0 - 512);
        ((u32x4*)dst)[0] = pack8(o0); ((u32x4*)dst)[1] = pack8(o1);
    }
}

__device__ __forceinline__ void s5_scan(const Ctx& cx_, int l) {
    const Ctx c = relaunder(cx_);
    if (c.tid >= 64) return;
    const int gt = c.bid * 64 + c.tid; if (gt >= 16384) return;
    const int n = gt & 63, d = (gt >> 6) & 1, b = (gt >> 7) & 7, g = gt >> 10;
    const size_t li_ = (((size_t)l * 2 + d) * 16 + g) * 64 + n;
    const float lr = c.in[I_S5LRE][li_], li = c.in[I_S5LIM][li_], step = expf(c.in[I_S5LS][((size_t)l * 2 + d) * 16 + g]);
    const float mag = expf(16.f * lr * step); float sn, cs; sincosf(16.f * li * step, &sn, &cs); const float ar = mag * cs, ai = mag * sn;
    const float* X = (const float*)(c.ws + WS_X) + ((size_t)g * S5RP + (size_t)b * NCH16) * 256 + d * 128 + n;
    bf16_t* U = (bf16_t*)(c.ws + WS_UH) + ((size_t)g * S5RP + (size_t)b * NCH16) * 512 + 256 + d * 128 + n;
    float hr = 0.f, hi = 0.f;
    for (int i0 = 0; i0 < NCH16; i0 += 32) {
        float xr[32], xi[32];
#pragma unroll
        for (int k = 0; k < 32; ++k) { const int i = i0 + k; const int ch = d == 0 ? i : NCH16 - 1 - i; const bool ok = i < NCH16; xr[k] = ok ? X[(size_t)ch * 256] : 0.f; xi[k] = ok ? X[(size_t)ch * 256 + 64] : 0.f; }
#pragma unroll
        for (int k = 0; k < 32; ++k) { const int i = i0 + k; if (i < NCH16) { const int ch = d == 0 ? i : NCH16 - 1 - i;
            U[(size_t)ch * 512] = (bf16_t)f2bf(hr); U[(size_t)ch * 512 + 64] = (bf16_t)f2bf(hi);
            const float nr = ar * hr - ai * hi + xr[k], ni = ar * hi + ai * hr + xi[k]; hr = nr; hi = ni; } }
    }
}
typedef short s16x4 __attribute__((ext_vector_type(4)));
__device__ __forceinline__ s16x4 lds_tr(const LAS unsigned char* p) { return __builtin_bit_cast(s16x4, __builtin_amdgcn_ds_read_tr16_b64_v4i16((LAS s16x4*)p)); }
__device__ __forceinline__ bf16x8 frag_tr(const LAS unsigned char* img, int rs, int kbase, int colbase, int lane) {
    const LAS unsigned char* a = img + (kbase + 8 * (lane >> 4) + ((lane & 15) >> 2)) * rs + (colbase + 4 * (lane & 3)) * 2;
    const s16x4 lo = lds_tr(a), hi = lds_tr(a + 4 * rs);
    return (bf16x8){lo[0], lo[1], lo[2], lo[3], hi[0], hi[1], hi[2], hi[3]};
}
__device__ __forceinline__ bf16x8 frag_row(const LAS unsigned char* img, int rs, int rowbase, int kbase, int lane) {
    return *(const LAS bf16x8*)(img + (rowbase + (lane & 15)) * rs + (kbase + 8 * (lane >> 4)) * 2);
}
constexpr int SD_RS = 272;
constexpr int SD_XRS = 144;
constexpr int SD_OFF_C = 0, SD_OFF_B = 34816, SD_OFF_X = 69632, SD_OFF_M = 88064, SD_OFF_SC = 122880;
constexpr int SD_OFF_HF = SD_OFF_B, SD_OFF_HB = SD_OFF_B + 17408;
constexpr size_t WS_STB = WS_YSSD;
constexpr size_t WS_CDEC = WS_DEC + (size_t)MP * 64 + 256;
constexpr size_t WS_SSQB = WS_CDEC + (size_t)BATCH * 33 * 16 * 4;
constexpr size_t WS_BAR = (WS_SSQB + (size_t)MP * 8 + 255) / 256 * 256;
static_assert(WS_BAR + 3456 * 4 <= 7 * QB, "small region");
static_assert((size_t)BATCH * 2 * 8 * 32 * 8192 * 2 <= 4 * QB, "chunk states fit the yssd slot");

struct SsdUnit { int b, ck, t0, ns; };
__device__ __forceinline__ bool ssd_unit(int bid, int round, SsdUnit& u) {
    if (round == 0) { u.b = bid >> 5; u.ck = 1 + (bid & 31); u.t0 = NMETA + 128 * (u.ck - 1); u.ns = 8; return true; }
    if (round == 1 && bid < BATCH) { u.b = bid; u.ck = 0; u.t0 = 0; u.ns = 1; return true; }
    return false;
}
__device__ __forceinline__ void ssd_load_img(LAS unsigned char* img, int rs, const bf16_t* src, int ld, size_t m0, int col0, int ncol, int ns, int tid) {
    const int cpr = ncol / 8, nrow = ns == 1 ? 32 : 128;
    for (int i = tid; i < nrow * cpr; i += NTHREADS) {
        const int r = i / cpr, cc = i - r * cpr; u32x4 v = (u32x4){0u, 0u, 0u, 0u};
        if (r < 16 * ns) v = *(const u32x4*)(src + (m0 + r) * ld + col0 + cc * 8);
        *(LAS u32x4*)(img + r * rs + cc * 16) = v;
    }
}
__device__ __forceinline__ void ssd_scalars(LAS float* sc, const float* dt, const float* al, size_t m0, int head, int ns, int lane, float& totf, float& totb) {
    const int Q = 16 * ns;
    float a0f = 0.f, a1f = 0.f, a0b = 0.f, a1b = 0.f, d0f = 0.f, d1f = 0.f, d0b = 0.f, d1b = 0.f;
    const int s0 = 2 * lane, s1 = 2 * lane + 1;
    if (s0 < Q) { a0f = al[(m0 + s0) * 16 + head]; a0b = al[(m0 + s0) * 16 + 8 + head]; d0f = dt[(m0 + s0) * 16 + head]; d0b = dt[(m0 + s0) * 16 + 8 + head]; }
    if (s1 < Q) { a1f = al[(m0 + s1) * 16 + head]; a1b = al[(m0 + s1) * 16 + 8 + head]; d1f = dt[(m0 + s1) * 16 + head]; d1b = dt[(m0 + s1) * 16 + 8 + head]; }
    float pf = a0f + a1f, pb = a0b + a1b;
#pragma unroll
    for (int o = 1; o < 64; o <<= 1) { const float tf = __shfl_up(pf, o), tb = __shfl_up(pb, o); if (lane >= o) { pf += tf; pb += tb; } }
    totf = __shfl(pf, 63); totb = __shfl(pb, 63);
    const float af1 = pf, af0 = pf - a1f;
    const float eb0 = pb - a0b - a1b, eb1 = pb - a1b;
    sc[s0] = af0; sc[s1] = af1; sc[128 + s0] = eb0; sc[128 + s1] = eb1; sc[256 + s0] = d0f; sc[256 + s1] = d1f; sc[384 + s0] = d0b; sc[384 + s1] = d1b;
    sc[512 + s0] = __expf(totf - af0) * d0f; sc[512 + s1] = __expf(totf - af1) * d1f;
    sc[640 + s0] = __expf(eb0) * d0b; sc[640 + s1] = __expf(eb1) * d1b;
    sc[768 + s0] = __expf(af0); sc[768 + s1] = __expf(af1);
    sc[896 + s0] = __expf(totb - eb0); sc[896 + s1] = __expf(totb - eb1);
}

__device__ __forceinline__ void ssd_states(const Ctx& cx_, int l) {
    const Ctx c = relaunder(cx_);
    const int tid = c.tid, lane = c.lane, wave = c.wave;
    const bf16_t* bc = (const bf16_t*)(c.ws + WS_BC); const bf16_t* xs = (const bf16_t*)(c.ws + WS_XS);
    const float* dt = (const float*)(c.ws + WS_DT); const float* al = (const float*)(c.ws + WS_DEC);
    bf16_t* stb = (bf16_t*)(c.ws + WS_STB); float* cdec = (float*)(c.ws + WS_CDEC);
    LAS unsigned char* Bimg = c.lds + SD_OFF_B; LAS unsigned char* Ximg = c.lds + SD_OFF_X; LAS float* sc = (LAS float*)(c.lds + SD_OFF_SC);
    for (int round = 0; round < 2; ++round) {
        SsdUnit u; if (!ssd_unit(c.bid, round, u)) break;
        const size_t m0 = (size_t)row_of(u.b, u.t0); const int nks = u.ns == 1 ? 1 : 4;
        for (int g = 0; g < 2; ++g) {
            __syncthreads();
            ssd_load_img(Bimg, SD_RS, bc, 512, m0, g * 128, 128, u.ns, tid);
            for (int j = 0; j < 4; ++j) {
                const int head = g * 4 + j;
                if (j) __syncthreads();
                ssd_load_img(Ximg, SD_XRS, xs, 512, m0, head * 64, 64, u.ns, tid);
                if (wave == 0) { float totf, totb; ssd_scalars(sc, dt, al, m0, head, u.ns, lane, totf, totb);
                    if (lane == 0) { cdec[((size_t)u.b * 33 + u.ck) * 16 + head] = __expf(totf); cdec[((size_t)u.b * 33 + u.ck) * 16 + 8 + head] = __expf(totb); } }
                __syncthreads();
                f32x4 accf[4], accb[4];
#pragma unroll
                for (int pt = 0; pt < 4; ++pt) { accf[pt] = (f32x4){0.f, 0.f, 0.f, 0.f}; accb[pt] = accf[pt]; }
                for (int ks = 0; ks < nks; ++ks) {
                    const bf16x8 af = frag_tr(Bimg, SD_RS, 32 * ks, 16 * wave, lane);
                    const int k0 = 32 * ks + 8 * (lane >> 4);
                    const f32x4 wf0 = *(const LAS f32x4*)(sc + 512 + k0), wf1 = *(const LAS f32x4*)(sc + 512 + k0 + 4), wb0 = *(const LAS f32x4*)(sc + 640 + k0), wb1 = *(const LAS f32x4*)(sc + 640 + k0 + 4);
#pragma unroll
                    for (int pt = 0; pt < 4; ++pt) {
                        const bf16x8 xr = frag_tr(Ximg, SD_XRS, 32 * ks, 16 * pt, lane);
                        float xf[8];
#pragma unroll
                        for (int e = 0; e < 8; ++e) xf[e] = bf1((bf16_t)xr[e]);
                        bf16x8 bfv, bbv;
                        { const unsigned p0 = pk2(xf[0] * wf0.x, xf[1] * wf0.y), p1 = pk2(xf[2] * wf0.z, xf[3] * wf0.w), p2 = pk2(xf[4] * wf1.x, xf[5] * wf1.y), p3 = pk2(xf[6] * wf1.z, xf[7] * wf1.w);
                          bfv = __builtin_bit_cast(bf16x8, (u32x4){p0, p1, p2, p3}); }
                        { const unsigned p0 = pk2(xf[0] * wb0.x, xf[1] * wb0.y), p1 = pk2(xf[2] * wb0.z, xf[3] * wb0.w), p2 = pk2(xf[4] * wb1.x, xf[5] * wb1.y), p3 = pk2(xf[6] * wb1.z, xf[7] * wb1.w);
                          bbv = __builtin_bit_cast(bf16x8, (u32x4){p0, p1, p2, p3}); }
                        accf[pt] = __builtin_amdgcn_mfma_f32_16x16x32_bf16(af, bfv, accf[pt], 0, 0, 0);
                        accb[pt] = __builtin_amdgcn_mfma_f32_16x16x32_bf16(af, bbv, accb[pt], 0, 0, 0);
                    }
                }
#pragma unroll
                for (int pt = 0; pt < 4; ++pt) {
                    const int p = 16 * pt + (lane & 15), n0 = 16 * wave + 4 * (lane >> 4);
                    if (u.ck <= 31) { bf16_t* d = stb + ((((size_t)u.b * 2 + 0) * 8 + head) * 32 + u.ck) * 8192 + (size_t)p * 128 + n0; *(u32x2*)d = (u32x2){pk2(accf[pt][0], accf[pt][1]), pk2(accf[pt][2], accf[pt][3])}; }
                    if (u.ck >= 1) { bf16_t* d = stb + ((((size_t)u.b * 2 + 1) * 8 + head) * 32 + (u.ck - 1)) * 8192 + (size_t)p * 128 + n0; *(u32x2*)d = (u32x2){pk2(accb[pt][0], accb[pt][1]), pk2(accb[pt][2], accb[pt][3])}; }
                }
            }
        }
    }
    __syncthreads();
}

__device__ __forceinline__ void ssd_chunk_scan(const Ctx& cx_, int l) {
    const Ctx c = relaunder(cx_);
    bf16_t* stb = (bf16_t*)(c.ws + WS_STB); const float* cdec = (const float*)(c.ws + WS_CDEC);
    const int gt = c.bid * NTHREADS + c.tid;
    const int e8 = gt & 1023, bdh = gt >> 10;
    if (bdh >= BATCH * 16) return;
    const int head = bdh & 7, dir = (bdh >> 3) & 1, b = bdh >> 4;
    bf16_t* base = stb + (size_t)bdh * 32 * 8192 + (size_t)e8 * 8;
    float h[8] = {0.f, 0.f, 0.f, 0.f, 0.f, 0.f, 0.f, 0.f};
    for (int i0 = 0; i0 < 32; i0 += 8) {
        u32x4 v[8]; float dcy[8];
#pragma unroll
        for (int k = 0; k < 8; ++k) { const int slot = dir == 0 ? i0 + k : 31 - (i0 + k); v[k] = *(const u32x4*)(base + (size_t)slot * 8192);
            const int ck = dir == 0 ? slot : slot + 1; dcy[k] = cdec[((size_t)b * 33 + ck) * 16 + dir * 8 + head]; }
#pragma unroll
        for (int k = 0; k < 8; ++k) { const int slot = dir == 0 ? i0 + k : 31 - (i0 + k); float s[8]; unpack8(v[k], s);
#pragma unroll
            for (int e = 0; e < 8; ++e) h[e] = h[e] * dcy[k] + s[e];
            *(u32x4*)(base + (size_t)slot * 8192) = pack8(h); }
    }
}

__device__ __forceinline__ bool ssd_unit_n(int idx, int nblk, int round, SsdUnit& u, int& grp) {
    const int n2 = idx + nblk * round; if (n2 >= 528) return false; const int n = n2 >> 1; grp = n2 & 1;
    if (n < 256) { u.b = n >> 5; u.ck = 1 + (n & 31); u.t0 = NMETA + 128 * (u.ck - 1); u.ns = 8; } else { u.b = n - 256; u.ck = 0; u.t0 = 0; u.ns = 1; }
    return true;
}
__device__ __forceinline__ void ssd_outputs(const Ctx& cx_, int l, int first, int nblk) {
    const Ctx c = relaunder(cx_);
    const int tid = c.tid, lane = c.lane, wave = c.wave;
    const bf16_t* bc = (const bf16_t*)(c.ws + WS_BC); const bf16_t* xs = (const bf16_t*)(c.ws + WS_XS); const bf16_t* pz = (const bf16_t*)(c.ws + WS_PZ);
    const float* dt = (const float*)(c.ws + WS_DT); const float* al = (const float*)(c.ws + WS_DEC);
    const bf16_t* stb = (const bf16_t*)(c.ws + WS_STB); bf16_t* yb = (bf16_t*)(c.ws + WS_YB); float* ssqb = (float*)(c.ws + WS_SSQB);
    LAS unsigned char* Cimg = c.lds + SD_OFF_C; LAS unsigned char* Bimg = c.lds + SD_OFF_B; LAS unsigned char* Ximg = c.lds + SD_OFF_X;
    LAS unsigned char* HfT = c.lds + SD_OFF_HF; LAS unsigned char* HbT = c.lds + SD_OFF_HB;
    LAS unsigned char* Ms = c.lds + SD_OFF_M + wave * 4352; LAS float* sc = (LAS float*)(c.lds + SD_OFF_SC);
    for (int round = 0; round < 8; ++round) {
        SsdUnit u; int g0; if (!ssd_unit_n(c.bid - first, nblk, round, u, g0)) break;
        const size_t m0 = (size_t)row_of(u.b, u.t0); const int nks = u.ns == 1 ? 1 : 4; const bool active = wave < u.ns;
        float ssrow = 0.f;
        for (int g = g0; g <= g0; ++g) {
            __syncthreads();
            ssd_load_img(Cimg, SD_RS, bc, 512, m0, 256 + g * 128, 128, u.ns, tid);
            ssd_load_img(Bimg, SD_RS, bc, 512, m0, g * 128, 128, u.ns, tid);
            __syncthreads();
            f32x4 cb[8];
#pragma unroll
            for (int t = 0; t < 8; ++t) cb[t] = (f32x4){0.f, 0.f, 0.f, 0.f};
            if (active) {
#pragma unroll
                for (int ks = 0; ks < 4; ++ks) {
                    const bf16x8 cfr = frag_row(Cimg, SD_RS, 16 * wave, 32 * ks, lane);
#pragma unroll
                    for (int t = 0; t < 8; ++t) if (t < u.ns) cb[t] = __builtin_amdgcn_mfma_f32_16x16x32_bf16(frag_row(Bimg, SD_RS, 16 * t, 32 * ks, lane), cfr, cb[t], 0, 0, 0);
                }
            }
            for (int j = 0; j < 4; ++j) {
                const int head = g * 4 + j;
                __syncthreads();
                ssd_load_img(Ximg, SD_XRS, xs, 512, m0, head * 64, 64, u.ns, tid);
                {
                    const bf16_t* hf = u.ck >= 1 ? stb + ((((size_t)u.b * 2 + 0) * 8 + head) * 32 + (u.ck - 1)) * 8192 : nullptr;
                    const bf16_t* hb = u.ck <= 31 ? stb + ((((size_t)u.b * 2 + 1) * 8 + head) * 32 + u.ck) * 8192 : nullptr;
                    for (int i = tid; i < 64 * 16; i += NTHREADS) { const int p = i >> 4, cc = i & 15;
                        *(LAS u32x4*)(HfT + p * SD_RS + cc * 16) = hf ? *(const u32x4*)(hf + p * 128 + cc * 8) : (u32x4){0u, 0u, 0u, 0u};
                        *(LAS u32x4*)(HbT + p * SD_RS + cc * 16) = hb ? *(const u32x4*)(hb + p * 128 + cc * 8) : (u32x4){0u, 0u, 0u, 0u}; }
                }
                if (wave == 0) { float totf, totb; ssd_scalars(sc, dt, al, m0, head, u.ns, lane, totf, totb); }
                __syncthreads();
                if (active) {
                    const int ll = 16 * wave + (lane & 15); const float afl = sc[ll], ebl = sc[128 + ll];
#pragma unroll
                    for (int t = 0; t < 8; ++t) {
                        u32x2 w2 = (u32x2){0u, 0u};
                        if (t < u.ns) {
                            const int s0 = 16 * t + 4 * (lane >> 4);
                            const f32x4 afs = *(const LAS f32x4*)(sc + s0), ebs = *(const LAS f32x4*)(sc + 128 + s0), dfs = *(const LAS f32x4*)(sc + 256 + s0), dbs = *(const LAS f32x4*)(sc + 384 + s0);
                            float mv[4];
#pragma unroll
                            for (int r = 0; r < 4; ++r) { const int s = s0 + r; float wgt = 0.f; if (s <= ll) wgt += __expf(afl - afs[r]) * dfs[r]; if (s >= ll) wgt += __expf(ebs[r] - ebl) * dbs[r]; mv[r] = cb[t][r] * wgt; }
                            w2 = (u32x2){pk2(mv[0], mv[1]), pk2(mv[2], mv[3])};
                        }
                        if (t < 2 * nks) *(LAS u32x2*)(Ms + (lane & 15) * SD_RS + (16 * t + 4 * (lane >> 4)) * 2) = w2;
                    }
                    asm volatile("s_waitcnt lgkmcnt(0)" ::: "memory");
                    f32x4 ay[4], ahf[4], ahb[4];
#pragma unroll
                    for (int pt = 0; pt < 4; ++pt) { ay[pt] = (f32x4){0.f, 0.f, 0.f, 0.f}; ahf[pt] = ay[pt]; ahb[pt] = ay[pt]; }
                    for (int ks = 0; ks < nks; ++ks) {
                        const bf16x8 mf = frag_row(Ms, SD_RS, 0, 32 * ks, lane);
#pragma unroll
                        for (int pt = 0; pt < 4; ++pt) ay[pt] = __builtin_amdgcn_mfma_f32_16x16x32_bf16(mf, frag_tr(Ximg, SD_XRS, 32 * ks, 16 * pt, lane), ay[pt], 0, 0, 0);
                    }
#pragma unroll
                    for (int ks = 0; ks < 4; ++ks) {
                        const bf16x8 cfr = frag_row(Cimg, SD_RS, 16 * wave, 32 * ks, lane);
#pragma unroll
                        for (int pt = 0; pt < 4; ++pt) {
                            ahf[pt] = __builtin_amdgcn_mfma_f32_16x16x32_bf16(cfr, frag_row(HfT, SD_RS, 16 * pt, 32 * ks, lane), ahf[pt], 0, 0, 0);
                            ahb[pt] = __builtin_amdgcn_mfma_f32_16x16x32_bf16(cfr, frag_row(HbT, SD_RS, 16 * pt, 32 * ks, lane), ahb[pt], 0, 0, 0);
                        }
                    }
                    const int l0 = 16 * wave + 4 * (lane >> 4);
                    const f32x4 efv = *(const LAS f32x4*)(sc + 768 + l0), ebv = *(const LAS f32x4*)(sc + 896 + l0);
                    asm volatile("s_waitcnt lgkmcnt(0)" ::: "memory");
                    LAS float* ys = (LAS float*)Ms;
#pragma unroll
                    for (int pt = 0; pt < 4; ++pt)
#pragma unroll
                        for (int r = 0; r < 4; ++r) ys[(4 * (lane >> 4) + r) * 68 + 16 * pt + (lane & 15)] = ay[pt][r] + efv[r] * ahf[pt][r] + ebv[r] * ahb[pt][r];
                    asm volatile("s_waitcnt lgkmcnt(0)" ::: "memory");
                    const int rr = lane >> 2, p0 = 16 * (lane & 3); const size_t m = m0 + 16 * wave + rr;
                    const float dsk = c.in[I_SSDD][l * 8 + head];
                    float xv[16], zv[16];
                    { float t8[8]; unpack8(*(const LAS u32x4*)(Ximg + (16 * wave + rr) * SD_XRS + p0 * 2), t8);
#pragma unroll
                      for (int e = 0; e < 8; ++e) xv[e] = t8[e];
                      unpack8(*(const LAS u32x4*)(Ximg + (16 * wave + rr) * SD_XRS + p0 * 2 + 16), t8);
#pragma unroll
                      for (int e = 0; e < 8; ++e) xv[8 + e] = t8[e];
                      unpack8(*(const u32x4*)(pz + m * 512 + head * 64 + p0), t8);
#pragma unroll
                      for (int e = 0; e < 8; ++e) zv[e] = t8[e];
                      unpack8(*(const u32x4*)(pz + m * 512 + head * 64 + p0 + 8), t8);
#pragma unroll
                      for (int e = 0; e < 8; ++e) zv[8 + e] = t8[e]; }
                    float o[16];
#pragma unroll
                    for (int e4 = 0; e4 < 4; ++e4) { const f32x4 yv = *(const LAS f32x4*)(ys + rr * 68 + p0 + 4 * e4);
#pragma unroll
                        for (int e = 0; e < 4; ++e) { const float val = (yv[e] + dsk * xv[4 * e4 + e]) * siluf_(zv[4 * e4 + e]); o[4 * e4 + e] = val; ssrow += val * val; } }
                    u32x4 w0, w1; w0.x = pk2(o[0], o[1]); w0.y = pk2(o[2], o[3]); w0.z = pk2(o[4], o[5]); w0.w = pk2(o[6], o[7]); w1.x = pk2(o[8], o[9]); w1.y = pk2(o[10], o[11]); w1.z = pk2(o[12], o[13]); w1.w = pk2(o[14], o[15]);
                    *(u32x4*)(yb + m * 512 + head * 64 + p0) = w0; *(u32x4*)(yb + m * 512 + head * 64 + p0 + 8) = w1;
                }
            }
        }
        if (active) { ssrow += dpp_mov<0xB1>(ssrow); ssrow += dpp_mov<0x4E>(ssrow); if ((lane & 3) == 0) ssqb[(m0 + 16 * wave + (lane >> 2)) * 2 + g0] = ssrow; }
    }
    __syncthreads();
}
typedef short s16x4v __attribute__((ext_vector_type(4)));
constexpr int RC_NCH = LEN / 16;
constexpr int RC_NP = 5;
constexpr int RC_ROUNDS = (RC_NCH + RC_NP - 1) / RC_NP;
constexpr int RC_S64 = 144;
constexpr int RC_S16 = 40;
constexpr int RC_AT = 0, RC_RT = 2304, RC_BH = 4608, RC_KH = 6912, RC_T = 9216, RC_AAK = 9856, RC_ARB = 10496, RC_ARK = 11136, RC_VT = 11776, RC_P16 = 12416, RC_SLOT = 12800;
constexpr int RC_SCR0 = 2 * RC_NP * RC_SLOT;
constexpr int RC_SCR = 1280;
static_assert(RC_SCR0 + RC_NP * RC_SCR <= 147456 - 512, "rwkv chunk LDS");
__device__ __forceinline__ f32x4 mm16(s16x4v a, s16x4v b, f32x4 c, int, int, int) { return __builtin_amdgcn_mfma_f32_16x16x32_bf16((bf16x8){a[0], a[1], a[2], a[3], 0, 0, 0, 0}, (bf16x8){b[0], b[1], b[2], b[3], 0, 0, 0, 0}, c, 0, 0, 0); }
__device__ __forceinline__ s16x4v mfma16_frag(const LAS unsigned char* mat, int row, int q) { return *(const LAS s16x4v*)(mat + row * RC_S16 + q * 8); }

constexpr int RC64_NP = 4, RC64_ROUNDS = (RC_NCH + RC64_NP - 1) / RC64_NP;
constexpr int RC64_V = 11776, RC64_P16 = 14080, RC64_SLOT = 14336;
constexpr int RC64_SCR0 = 2 * RC64_NP * RC64_SLOT;
static_assert(RC64_SCR0 + RC64_NP * RC_SCR <= 147456 - 512, "rwkv64 LDS");
__device__ __forceinline__ void rwkv_chunked64(const Ctx& cx_, int l) {
    const Ctx c = relaunder(cx_);


    const int bid = c.bid, dir = bid & 1, head = (bid >> 1) & 3, b = bid >> 3;
    const int lane = c.lane, wave = c.wave;
    const bf16_t* rk = (const bf16_t*)(c.dout + DO_RKVP) + head * 64; const bf16_t* l2 = (const bf16_t*)(c.ws + WS_L2O) + dir * 256 + head * 64;
    bf16_t* yo = (bf16_t*)(c.ws + WS_YRW) + (size_t)dir * MP * 256 + head * 64 + 16 * (wave & 3);
    auto tok = [&](int s) -> size_t { const int t = s + dir * (LEN - 1 - 2 * s); return (size_t)row_of(b, t); };
    const int q = lane >> 4, li = lane & 15;
    u32x4 Rr[2], Kr[2], KKr[2], DLr[2], ASr[2], Vr[2];
    auto load_raw = [&](int ch) {
        const size_t m = tok(16 * ch + li); const int k0 = 16 * q;
#pragma unroll
        for (int h = 0; h < 2; ++h) { Rr[h] = *(const u32x4*)(rk + m * 1024 + k0 + 8 * h); Kr[h] = *(const u32x4*)(rk + m * 1024 + 256 + k0 + 8 * h); KKr[h] = *(const u32x4*)(rk + m * 1024 + 768 + k0 + 8 * h);
            DLr[h] = *(const u32x4*)(l2 + m * 1280 + k0 + 8 * h); ASr[h] = *(const u32x4*)(l2 + m * 1280 + 512 + k0 + 8 * h); Vr[h] = *(const u32x4*)(rk + m * 1024 + 512 + k0 + 8 * h); }
    };
    float kaall[16];
#pragma unroll
    for (int e = 0; e < 16; ++e) kaall[e] = c.in[I_KA][(size_t)l * 256 + head * 64 + 16 * q + e];
    auto produce = [&](int slot) {
        LAS unsigned char* sb = c.lds + slot * RC64_SLOT; LAS float* Aab = (LAS float*)(c.lds + RC64_SCR0 + (wave - 4) * RC_SCR);
        LAS unsigned char* Bh = sb + RC_BH; LAS unsigned char* Kh = sb + RC_KH;
        *(LAS u32x4*)(sb + RC64_V + li * RC_S64 + (16 * q) * 2) = Vr[0]; *(LAS u32x4*)(sb + RC64_V + li * RC_S64 + (16 * q + 8) * 2) = Vr[1];
        const int k0 = 16 * q;
#pragma unroll
        for (int h = 0; h < 2; ++h) {
            float r_[8], k_[8], kk_[8], dl_[8], as_[8], cs_[8]; unpack8(Rr[h], r_); unpack8(Kr[h], k_); unpack8(KKr[h], kk_); unpack8(DLr[h], dl_); unpack8(ASr[h], as_);
            const float* ka = kaall + 8 * h;
            float at_[8], rt_[8], bh_[8], kh_[8], p_[8];
#pragma unroll
            for (int e = 0; e < 8; ++e) {
                float x = dl_[e];
                x += dpp_mov<0x111>(x); x += dpp_mov<0x112>(x); x += dpp_mov<0x114>(x); x += dpp_mov<0x118>(x);
                cs_[e] = x;
            }
#pragma unroll
            for (int e = 0; e < 8; ++e) {
                const float P = __expf(cs_[e]), Pm = __expf(cs_[e] - dl_[e]), iP = __expf(-cs_[e]);
                at_[e] = -kk_[e] * Pm; rt_[e] = r_[e] * P; bh_[e] = kk_[e] * as_[e] * iP; kh_[e] = k_[e] * (1.f + (as_[e] - 1.f) * ka[e]) * iP; p_[e] = P;
            }
            *(LAS u32x4*)(sb + RC_AT + li * RC_S64 + (k0 + 8 * h) * 2) = pack8(at_); *(LAS u32x4*)(sb + RC_RT + li * RC_S64 + (k0 + 8 * h) * 2) = pack8(rt_);
            *(LAS u32x4*)(Bh + li * RC_S64 + (k0 + 8 * h) * 2) = pack8(bh_); *(LAS u32x4*)(Kh + li * RC_S64 + (k0 + 8 * h) * 2) = pack8(kh_);
            if (li == 15) { *(LAS f32x4*)(sb + RC64_P16 + (k0 + 8 * h) * 4) = (f32x4){p_[0], p_[1], p_[2], p_[3]}; *(LAS f32x4*)(sb + RC64_P16 + (k0 + 8 * h + 4) * 4) = (f32x4){p_[4], p_[5], p_[6], p_[7]}; }
        }
        asm volatile("s_waitcnt lgkmcnt(0)" ::: "memory");
        f32x4 ab = (f32x4){0.f, 0.f, 0.f, 0.f}, ak = ab, rb = ab, rkm = ab;
#pragma unroll
        for (int ks = 0; ks < 2; ++ks) {
            const bf16x8 fa = *(const LAS bf16x8*)(sb + RC_AT + li * RC_S64 + (32 * ks + 8 * q) * 2), fr = *(const LAS bf16x8*)(sb + RC_RT + li * RC_S64 + (32 * ks + 8 * q) * 2);
            const bf16x8 fb = *(const LAS bf16x8*)(Bh + li * RC_S64 + (32 * ks + 8 * q) * 2), fk = *(const LAS bf16x8*)(Kh + li * RC_S64 + (32 * ks + 8 * q) * 2);
            ab = __builtin_amdgcn_mfma_f32_16x16x32_bf16(fa, fb, ab, 0, 0, 0); ak = __builtin_amdgcn_mfma_f32_16x16x32_bf16(fa, fk, ak, 0, 0, 0);
            rb = __builtin_amdgcn_mfma_f32_16x16x32_bf16(fr, fb, rb, 0, 0, 0); rkm = __builtin_amdgcn_mfma_f32_16x16x32_bf16(fr, fk, rkm, 0, 0, 0);
        }
#pragma unroll
        for (int r = 0; r < 4; ++r) {
            const int t = 4 * q + r, s = li;
            Aab[t * 20 + s] = s < t ? ab[r] : 0.f;
            *(LAS bf16_t*)(sb + RC_AAK + t * RC_S16 + s * 2) = (bf16_t)f2bf(s < t ? ak[r] : 0.f);
            *(LAS bf16_t*)(sb + RC_ARB + t * RC_S16 + s * 2) = (bf16_t)f2bf(s <= t ? rb[r] : 0.f);
            *(LAS bf16_t*)(sb + RC_ARK + t * RC_S16 + s * 2) = (bf16_t)f2bf(s <= t ? rkm[r] : 0.f);
        }
        asm volatile("s_waitcnt lgkmcnt(0)" ::: "memory");
        float tc[16];
#pragma unroll
        for (int t = 0; t < 16; ++t) {
            float acc = (t == li) ? 1.f : 0.f;
            f32x4 a0 = *(const LAS f32x4*)(Aab + t * 20), a1 = *(const LAS f32x4*)(Aab + t * 20 + 4), a2 = *(const LAS f32x4*)(Aab + t * 20 + 8), a3 = *(const LAS f32x4*)(Aab + t * 20 + 12);
            const float av[16] = {a0.x, a0.y, a0.z, a0.w, a1.x, a1.y, a1.z, a1.w, a2.x, a2.y, a2.z, a2.w, a3.x, a3.y, a3.z, a3.w};
            float a1_ = 0.f, a2_ = 0.f, a3_ = 0.f;
#pragma unroll
            for (int s = 0; s < t; ++s) { const float pr_ = av[s] * tc[s]; if ((s & 3) == 0) acc += pr_; else if ((s & 3) == 1) a1_ += pr_; else if ((s & 3) == 2) a2_ += pr_; else a3_ += pr_; }
            tc[t] = (acc + a1_) + (a2_ + a3_);
        }
        if (q == 0) {
#pragma unroll
            for (int t = 0; t < 16; ++t) *(LAS bf16_t*)(sb + RC_T + t * RC_S16 + li * 2) = (bf16_t)f2bf(tc[t]);
        }
    };
    if (wave >= 4 && wave - 4 < RC64_NP) { const int ch0 = wave - 4; load_raw(ch0); produce(wave - 4); load_raw(ch0 + RC64_NP); }
    __syncthreads();
    f32x4 S[4]; bf16x8 sop[2];
#pragma unroll
    for (int kt = 0; kt < 4; ++kt) S[kt] = (f32x4){0.f, 0.f, 0.f, 0.f};
    sop[0] = (bf16x8){0, 0, 0, 0, 0, 0, 0, 0}; sop[1] = sop[0];
    int sbase = 0;
    auto consume = [&](const int i, const int ch) {
                const LAS unsigned char* sb = c.lds + (sbase + i) * RC64_SLOT;
        const s16x4v vt = lds_tr(sb + RC64_V + (4 * q + (li >> 2)) * RC_S64 + (16 * (wave & 3) + 4 * (li & 3)) * 2);
        f32x4 aw = mm16(mfma16_frag(sb + RC_AAK, li, q), vt, (f32x4){0.f, 0.f, 0.f, 0.f}, 0, 0, 0);
        f32x4 ay = mm16(mfma16_frag(sb + RC_ARK, li, q), vt, (f32x4){0.f, 0.f, 0.f, 0.f}, 0, 0, 0);
#pragma unroll
        for (int ks = 0; ks < 2; ++ks) {
            const s16x4v alo = *(const LAS s16x4v*)(sb + RC_AT + li * RC_S64 + (32 * ks + 4 * q) * 2), ahi = *(const LAS s16x4v*)(sb + RC_AT + li * RC_S64 + (32 * ks + 16 + 4 * q) * 2);
            const s16x4v rlo = *(const LAS s16x4v*)(sb + RC_RT + li * RC_S64 + (32 * ks + 4 * q) * 2), rhi = *(const LAS s16x4v*)(sb + RC_RT + li * RC_S64 + (32 * ks + 16 + 4 * q) * 2);
            aw = __builtin_amdgcn_mfma_f32_16x16x32_bf16((bf16x8){alo[0], alo[1], alo[2], alo[3], ahi[0], ahi[1], ahi[2], ahi[3]}, sop[ks], aw, 0, 0, 0);
            ay = __builtin_amdgcn_mfma_f32_16x16x32_bf16((bf16x8){rlo[0], rlo[1], rlo[2], rlo[3], rhi[0], rhi[1], rhi[2], rhi[3]}, sop[ks], ay, 0, 0, 0);
        }
        const u32x2 wb2 = (u32x2){pk2(aw[0], aw[1]), pk2(aw[2], aw[3])};
        const f32x4 au = mm16(mfma16_frag(sb + RC_T, li, q), __builtin_bit_cast(s16x4v, wb2), (f32x4){0.f, 0.f, 0.f, 0.f}, 0, 0, 0);
        const u32x2 ub2 = (u32x2){pk2(au[0], au[1]), pk2(au[2], au[3])}; const s16x4v ub = __builtin_bit_cast(s16x4v, ub2);
        ay = mm16(mfma16_frag(sb + RC_ARB, li, q), ub, ay, 0, 0, 0);
#pragma unroll
        for (int kt = 0; kt < 4; ++kt) {
            const f32x4 p16 = *(const LAS f32x4*)(sb + RC64_P16 + (16 * kt + 4 * q) * 4);
            const int troff = (4 * q + (li >> 2)) * RC_S64 + (16 * kt + 4 * (li & 3)) * 2;
            f32x4 sv = S[kt];
            sv = mm16(lds_tr(sb + RC_KH + troff), vt, sv, 0, 0, 0);
            sv = mm16(lds_tr(sb + RC_BH + troff), ub, sv, 0, 0, 0);
            sv = sv * p16;
            S[kt] = sv;
        }
#pragma unroll
        for (int ks = 0; ks < 2; ++ks) {
            const u32x4 w = (u32x4){pk2(S[2 * ks][0], S[2 * ks][1]), pk2(S[2 * ks][2], S[2 * ks][3]), pk2(S[2 * ks + 1][0], S[2 * ks + 1][1]), pk2(S[2 * ks + 1][2], S[2 * ks + 1][3])};
            sop[ks] = __builtin_bit_cast(bf16x8, w);
        }
#pragma unroll
        for (int r = 0; r < 4; ++r) yo[tok(16 * ch + 4 * q + r) * 256 + li] = (bf16_t)f2bf(ay[r]);
    };
    for (int rd = 0; rd < RC64_ROUNDS; ++rd) {
        if (wave < 4) {
            sbase = (rd & 1) * RC64_NP;
            if (rd < RC64_ROUNDS - 1) {
#pragma unroll
                for (int i = 0; i < RC64_NP; ++i) consume(i, RC64_NP * rd + i);
            } else {
                for (int i = 0; i < RC64_NP; ++i) { const int ch = RC64_NP * rd + i; if (ch >= RC_NCH) break; consume(i, ch); }
            }
        } else if (wave - 4 < RC64_NP) {
            const int chn = RC64_NP * (rd + 1) + (wave - 4);
            if (chn < RC_NCH) { produce(((rd + 1) & 1) * RC64_NP + (wave - 4)); if (chn + RC64_NP < RC_NCH) load_raw(chn + RC64_NP); }
        }
        __syncthreads();
    }
}
__device__ __forceinline__ f32x4 mg_dot(const bf16_t* __restrict__ w, const bf16_t* __restrict__ x, int nk, f32x4 acc) {
#pragma unroll 8
    for (int k = 0; k < nk; ++k) acc = __builtin_amdgcn_mfma_f32_16x16x32_bf16(*(const bf16x8*)(w + k * 32), *(const bf16x8*)(x + k * 32), acc, 0, 0, 0);
    return acc;
}
__device__ __forceinline__ void mg_store4(bf16_t* dst, float a, float b, float c, float d) { uint2 w; w.x = pk2(a, b); w.y = pk2(c, d); *(uint2*)dst = w; }

__device__ __forceinline__ void meta_gates(const Ctx& c, int l) {
    const int lane = c.lane, wave = c.wave, li = lane & 15, lq = lane >> 4, role = wave & 3, rh = wave >> 2;
    const int c0 = (c.bid >> 2) * 16, row = BATCH * SEQ + ((c.bid & 3) * 2 + rh) * 16 + li;
    const bf16_t* wbase = c.wb(l);
    LAS float* sg = (LAS float*)c.lds;
    const f32x4 zero = {0.f, 0.f, 0.f, 0.f};
    f32x4 p0 = zero, p1 = zero, p2 = zero;
    __syncthreads();
    if (role < 3) {
        const f32x4 acc = mg_dot(wbase + WB_G + ((size_t)role * 1024 + c0 + li) * DM + lq * 8, c.H() + (size_t)row * DM + lq * 8, 32, zero);
        const float s = row_scale(c.ssq(), row);
#pragma unroll
        for (int j = 0; j < 4; ++j) sg[((rh * 3 + role) * 4 + j) * 64 + lane] = sigmoidf_(acc[j] * s);
    } else {
        const bf16_t* wp = wbase + WB_P + (size_t)(c0 + li) * DM + lq * 8;
        p0 = mg_dot(wp, (const bf16_t*)(c.ws + WS_YA) + (size_t)row * 256 + lq * 8, 8, zero);
        p1 = mg_dot(wp + 256, (const bf16_t*)(c.ws + WS_YB) + (size_t)row * 512 + lq * 8, 16, zero);
        p2 = mg_dot(wp + 768, (const bf16_t*)(c.ws + WS_YC) + (size_t)row * 256 + lq * 8, 8, zero);
    }
    __syncthreads();
    if (role == 3) {
        const float* ssqb = (const float*)(c.ws + WS_SSQB);
        const float rsb = __builtin_amdgcn_rsqf((ssqb[2 * row] + ssqb[2 * row + 1]) * (1.0f / 512.f) + EPS);
        float m[4];
#pragma unroll
        for (int j = 0; j < 4; ++j) m[j] = sg[((rh * 3 + 0) * 4 + j) * 64 + lane] * p0[j] + sg[((rh * 3 + 1) * 4 + j) * 64 + lane] * rsb * p1[j] + sg[((rh * 3 + 2) * 4 + j) * 64 + lane] * p2[j];
        mg_store4((bf16_t*)(c.dout + DO_MERGED) + (size_t)row * DM + c0 + lq * 4, m[0], m[1], m[2], m[3]);
    }
    __syncthreads();
}

__device__ __forceinline__ void meta_resid(const Ctx& c, const bf16_t* A, const bf16_t* W, int K) {
    if (c.bid >= 128) return;
    const int lane = c.lane, wave = c.wave, li = lane & 15, lq = lane >> 4, blk = wave & 3, kh = wave >> 2;
    const int cg16 = c.bid & 15, c0 = cg16 * 64 + blk * 16, row = BATCH * SEQ + (c.bid >> 4) * 16 + li;
    LAS float* red = (LAS float*)c.lds;
    const f32x4 zero = {0.f, 0.f, 0.f, 0.f};
    __syncthreads();
    f32x4 acc = mg_dot(W + (size_t)(c0 + li) * K + kh * (K >> 1) + lq * 8, A + (size_t)row * K + kh * (K >> 1) + lq * 8, K >> 6, zero);
    if (kh == 1) {
#pragma unroll
        for (int j = 0; j < 4; ++j) red[(blk * 4 + j) * 64 + lane] = acc[j];
    }
    __syncthreads();
    float ss = 0.f;
    if (kh == 0) {
        bf16_t* hp = c.H() + (size_t)row * DM + c0 + lq * 4;
        const uint2 hv = *(const uint2*)hp;
        float f[4] = {bflo(hv.x), bfhi(hv.x), bflo(hv.y), bfhi(hv.y)};
#pragma unroll
        for (int j = 0; j < 4; ++j) { f[j] += acc[j] + red[(blk * 4 + j) * 64 + lane]; ss += f[j] * f[j]; }
        mg_store4(hp, f[0], f[1], f[2], f[3]);
        ss += __shfl_xor(ss, 16); ss += __shfl_xor(ss, 32);
    }
    __syncthreads();
    if (kh == 0 && lq == 0) red[blk * 16 + li] = ss;
    __syncthreads();
    if (wave == 0 && lq == 0) c.ssq()[(size_t)row * 16 + cg16] = (red[li] + red[16 + li]) + (red[32 + li] + red[48 + li]);
    __syncthreads();
}

__device__ __forceinline__ void meta_up(const Ctx& c, const bf16_t* W) {
    const int lane = c.lane, li = lane & 15, lq = lane >> 4;
    const int c0 = c.bid * 16, row = BATCH * SEQ + c.wave * 16 + li;
    const f32x4 zero = {0.f, 0.f, 0.f, 0.f};
    const f32x4 acc = mg_dot(W + (size_t)(c0 + li) * DM + lq * 8, c.H() + (size_t)row * DM + lq * 8, 32, zero);
    const float s = row_scale(c.ssq(), row);
    float f[4];
#pragma unroll
    for (int j = 0; j < 4; ++j) { const float r = fmaxf(acc[j] * s, 0.f); f[j] = r * r; }
    mg_store4((bf16_t*)(c.ws + WS_ACT) + (size_t)row * DFF + c0 + lq * 4, f[0], f[1], f[2], f[3]);
}

__device__ __forceinline__ void rwkv_post(const Ctx& cx_, int l) {
    const Ctx c = relaunder(cx_);
    const int gw = c.bid * NWAVES + c.wave, NGW = c.G * NWAVES, lane = c.lane, c0 = 4 * lane;
    const bf16_t* __restrict__ y0 = (const bf16_t*)(c.ws + WS_YRW); const bf16_t* __restrict__ y1 = y0 + (size_t)MP * 256;
    const bf16_t* __restrict__ rk = (const bf16_t*)(c.dout + DO_RKVP); const bf16_t* __restrict__ l2 = (const bf16_t*)(c.ws + WS_L2O); bf16_t* __restrict__ yc = (bf16_t*)(c.ws + WS_YC);
    float lw[4], lb[4], rkw[4];
#pragma unroll
    for (int e = 0; e < 4; ++e) { lw[e] = c.in[I_LNW][(size_t)l * 256 + c0 + e]; lb[e] = c.in[I_LNB][(size_t)l * 256 + c0 + e]; rkw[e] = c.in[I_RK][(size_t)l * 256 + c0 + e]; }
#pragma unroll 2
    for (int m = gw; m < M_ROWS; m += NGW) {
        const u32x2 a = *(const u32x2*)(y0 + (size_t)m * 256 + c0), bq = *(const u32x2*)(y1 + (size_t)m * 256 + c0);
        const u32x2 rr = *(const u32x2*)(rk + (size_t)m * 1024 + c0), kk = *(const u32x2*)(rk + (size_t)m * 1024 + 256 + c0), vv = *(const u32x2*)(rk + (size_t)m * 1024 + 512 + c0);
        const u32x2 gg = *(const u32x2*)(l2 + (size_t)m * 1280 + 1024 + c0);
        float y[4] = {bflo(a.x) + bflo(bq.x), bfhi(a.x) + bfhi(bq.x), bflo(a.y) + bflo(bq.y), bfhi(a.y) + bfhi(bq.y)};
        const float r[4] = {bflo(rr.x), bfhi(rr.x), bflo(rr.y), bfhi(rr.y)}, k[4] = {bflo(kk.x), bfhi(kk.x), bflo(kk.y), bfhi(kk.y)};
        const float v[4] = {bflo(vv.x), bfhi(vv.x), bflo(vv.y), bfhi(vv.y)}, g[4] = {bflo(gg.x), bfhi(gg.x), bflo(gg.y), bfhi(gg.y)};
        const float mean = sum16((y[0] + y[1]) + (y[2] + y[3])) * (1.f / 64.f);
        float q = 0.f, bo = 0.f;
#pragma unroll
        for (int e = 0; e < 4; ++e) { y[e] -= mean; q += y[e] * y[e]; bo += r[e] * k[e] * rkw[e]; }
        q = sum16(q) * (1.f / 64.f); bo = sum16(bo);
        const float rs = __builtin_amdgcn_rsqf(q + 64e-5f);
        float o[4];
#pragma unroll
        for (int e = 0; e < 4; ++e) o[e] = (y[e] * rs * lw[e] + lb[e] + bo * v[e]) * g[e];
        *(u32x2*)(yc + (size_t)m * 256 + c0) = (u32x2){pk2(o[0], o[1]), pk2(o[2], o[3])};
    }
}
__device__ __forceinline__ void final_phase(const Ctx& cx_, float* out) {
    const Ctx c = relaunder(cx_);
    const int gw = c.bid * NWAVES + c.wave, NGW = c.G * NWAVES, lane = c.lane;
    const bf16_t* H = c.H(); const f32x4* fw = (const f32x4*)c.in[I_FNW];
#pragma unroll 2
    for (int r = gw; r < BATCH * SEQ; r += NGW) {
        const size_t m = (size_t)r;
        const u32x2* hp = (const u32x2*)(H + m * DM);
        float v[4][4], ss = 0.f;
#pragma unroll
        for (int i = 0; i < 4; ++i) { const u32x2 w = hp[lane + 64 * i]; v[i][0] = bflo(w.x); v[i][1] = bfhi(w.x); v[i][2] = bflo(w.y); v[i][3] = bfhi(w.y); ss += (v[i][0] * v[i][0] + v[i][1] * v[i][1]) + (v[i][2] * v[i][2] + v[i][3] * v[i][3]); }
        ss = wave_sum(ss); const float s = __builtin_amdgcn_rsqf(ss * (1.0f / DM) + EPS);
        f32x4* op = (f32x4*)(out + (size_t)r * DM);
#pragma unroll
        for (int i = 0; i < 4; ++i) { const f32x4 w = fw[lane + 64 * i]; op[lane + 64 * i] = (f32x4){v[i][0] * s * w.x, v[i][1] * s * w.y, v[i][2] * s * w.z, v[i][3] * s * w.w}; }
    }
}

constexpr int LDS_BYTES = 147456;
#ifndef MIXDIR
#define MIXDIR 0
#define MIXLAYER 0
#endif
#ifndef PHMASK
#define PHMASK 0xFFFFF
#endif
__global__ void __launch_bounds__(NTHREADS, 2) mega_fwd(Params p) {
    extern __shared__ __attribute__((aligned(16))) unsigned char lds_raw[];
    cg::grid_group grid = cg::this_grid();
    Ctx c0_; c0_.in = p.in; c0_.ws = p.ws; c0_.dout = (unsigned char*)p.out; c0_.lds = (LAS unsigned char*)lds_raw;
    c0_.wave = __builtin_amdgcn_readfirstlane((int)threadIdx.x >> 6); c0_.tid = opaque_tid(c0_.wave); c0_.lane = c0_.tid & 63; c0_.G = gridDim.x; c0_.bid = blockIdx.x;
    Ctx c = c0_;
    const int G = c.G, bid = c.bid;
#ifdef PROF_A
    if (blockIdx.x == 0 && threadIdx.x == 0) { for (int k = 0; k < 15; ++k) PROF_PTR[k] = 0; PROF_PTR[15] = __builtin_amdgcn_s_memrealtime(); }
#endif
    unsigned* barw = (unsigned*)(c.ws + WS_BAR);
    volatile LAS unsigned* bst = (volatile LAS unsigned*)(c.lds + LDS_BYTES - 64);
    if (bid == 0) for (int i = threadIdx.x; i < XCD_BAR_WORDS + 1024; i += NTHREADS) barw[i < XCD_BAR_WORDS ? i : 4096 + (i - XCD_BAR_WORDS)] = 0u;
    if (threadIdx.x < 2) bst[threadIdx.x] = 0u;
    __syncthreads();
    if (PHMASK & 1) phase0(c);
    grid.sync(); STAMP(0);
    const XcdBarrier xbar = xcd_barrier_post(barw, bst);
#define GRID_BAR() do { xcd_barrier(xbar, c0_.wave); c = relaunder(c0_); } while (0)
#pragma unroll 1
    for (int l = 0; l < DEPTH; ++l) {
#define wb (c.wb(l))
        if (PHMASK & 2) dt_job(c, l);
        if (PHMASK & 4) { SchedPlain S{c.H(), wb + WB_IN, DM, DM, DM, MP / 256, 11, G, bid, 0};
          EpiInProj E{c.ssq(), (bf16_t*)(c.ws + WS_UH), (bf16_t*)(c.ws + WS_PZ), (bf16_t*)(c.ws + WS_PXBC), (bf16_t*)(c.ws + WS_PRKVX)};
          pg8::gemm_phase(c.lds, c.wave, S, E); }
        GRID_BAR(); STAMP(1);
        if (PHMASK & 8) { SchedS5 S{(const bf16_t*)(c.ws + WS_UH), wb + WB_SX, 256, G, bid}; EpiS5X E{(float*)(c.ws + WS_X)}; pg8::gemm_phase(c.lds, c.wave, S, E); }
        if (PHMASK & 16) rwkv_prep(c, l);
        if (PHMASK & 32) ssd_prep(c, l);
        GRID_BAR(); STAMP(2);
        if (PHMASK & 64) s5_scan(c, l);
        if (PHMASK & 4096) ssd_states(c, l);
        if (PHMASK & 128) { SchedPlain S{(const bf16_t*)(c.ws + WS_L1IN), wb + WB_L1, 512, 512, 512, MP / 256, 2, G, bid, 0}; EpiL1 E{(bf16_t*)(c.ws + WS_L1O)}; pg8::gemm_phase(c.lds, c.wave, S, E); }
        GRID_BAR(); STAMP(3);
        ssd_chunk_scan(c, l);
        if (PHMASK & 256) { SchedL2 S{(const bf16_t*)(c.ws + WS_L1O), wb + WB_L2, G, bid, MP / 256, 0}; EpiL2 E{(bf16_t*)(c.ws + WS_L2O), c.in[I_W0] + (size_t)l * 512, c.in[I_A0] + (size_t)l * 512}; pg8::gemm_phase(c.lds, c.wave, S, E); }
        if (PHMASK & 512) { SchedS5 S{(const bf16_t*)(c.ws + WS_UH), wb + WB_SY, 512, G, bid}; EpiS5Y E{(bf16_t*)(c.ws + WS_YAPRE)}; pg8::gemm_phase(c.lds, c.wave, S, E); }
        GRID_BAR(); STAMP(4);
        if (bid < 64) { if (PHMASK & 1024) rwkv_chunked64(c, l); }
        else { if (PHMASK & 2048) ssd_outputs(c, l, 64, G - 64);
  if (PHMASK & 16384) { SchedPlain S{(const bf16_t*)(c.ws + WS_YAPRE), wb + WB_GLU, 256, 256, 256, MP / 256, 2, G - 64, bid - 64, 0}; EpiGLU E{(bf16_t*)(c.ws + WS_YA), c.in[I_GLUB] + (size_t)l * 512}; pg8::gemm_phase(c.lds, c.wave, S, E); } }
        STAMP(5);
        GRID_BAR(); STAMP(6);
        if (PHMASK & 8192) rwkv_post(c, l);
        GRID_BAR(); STAMP(7);
        if (PHMASK & 32768) { SchedProj S{c.H(), wb + WB_G, wb + WB_P, (const bf16_t*)(c.ws + WS_YA), (const bf16_t*)(c.ws + WS_YB), (const bf16_t*)(c.ws + WS_YC), BATCH * SEQ / 256, G, bid, 0};
          EpiProj E{c.ssq(), (const float*)(c.ws + WS_SSQB), c.ws + WS_PARK + (size_t)bid * 393216, (bf16_t*)(c.dout + DO_MERGED), opaque_tid(c.wave)}; pg8::gemm_phase(c.lds, c.wave, S, E); }
        if (l < DEPTH - 1) meta_gates(c, l);
        GRID_BAR(); STAMP(8);
        if (PHMASK & 65536) { SchedPlain S{(const bf16_t*)(c.dout + DO_MERGED), wb + WB_O, DM, DM, DM, BATCH * SEQ / 256, 4, G, bid, 0}; EpiResid E{c.H(), c.ssq()}; pg8::gemm_phase(c.lds, c.wave, S, E); }
        if (l < DEPTH - 1) meta_resid(c, (const bf16_t*)(c.dout + DO_MERGED), wb + WB_O, DM);
        GRID_BAR(); STAMP(9);
        if (PHMASK & 131072) { SchedPlain S{c.H(), wb + WB_1, DM, DM, DM, BATCH * SEQ / 256, 16, G, bid, 0}; EpiUp E{c.ssq(), (bf16_t*)(c.ws + WS_ACT)}; pg8::gemm_phase(c.lds, c.wave, S, E); }
        if (l < DEPTH - 1) meta_up(c, wb + WB_1);
        GRID_BAR(); STAMP(10);
        if (PHMASK & 262144) { SchedPlain S{(const bf16_t*)(c.ws + WS_ACT), wb + WB_2, DFF, DFF, DFF, BATCH * SEQ / 256, 4, G, bid, 0}; EpiResid E{c.H(), c.ssq()}; pg8::gemm_phase(c.lds, c.wave, S, E); }
        if (l < DEPTH - 1) meta_resid(c, (const bf16_t*)(c.ws + WS_ACT), wb + WB_2, DFF);
        GRID_BAR(); STAMP(11);
    }
    if (PHMASK & 524288) final_phase(c, p.out);
#ifdef PROF_A
    GRID_BAR(); STAMP(12);
    if (blockIdx.x == 0) {
        __syncthreads();
        float va = (float)(__hip_atomic_load(&PROF_PTR[PROF_A], __ATOMIC_RELAXED, __HIP_MEMORY_SCOPE_AGENT)) * 0.01f, vb = (float)(__hip_atomic_load(&PROF_PTR[PROF_B], __ATOMIC_RELAXED, __HIP_MEMORY_SCOPE_AGENT)) * 0.01f;
        va = exp2f(rintf(log2f(va * PROF_SHIFT) * 2.f) * 0.5f); vb = exp2f(rintf(log2f(vb * PROF_SHIFT) * 2.f) * 0.5f);
        for (int i = threadIdx.x; i < (1 << 20); i += NTHREADS) p.out[1 + i] = vb;
        if (threadIdx.x == 0) p.out[0] = 100.f * va;
    }
#endif
}

extern "C" void kernel_launch(void* const* d_in, const int* in_sizes, int n_in, void* d_out, int out_size, void* d_ws, size_t ws_size, hipStream_t stream) {
    static int grid = 0;
    if (grid == 0) {
        int dev = 0, cus = 0, per_cu = 0;
        if (n_in != N_INPUTS || out_size != BATCH * SEQ * DM || ws_size < WS_END) { fprintf(stderr, "kernel_launch: unexpected shapes (n_in %d out %d ws %zu)\n", n_in, out_size, ws_size); grid = -1; return; }
        (void)hipGetDevice(&dev); (void)hipDeviceGetAttribute(&cus, hipDeviceAttributeMultiprocessorCount, dev);
        (void)hipFuncSetAttribute((const void*)mega_fwd, hipFuncAttributeMaxDynamicSharedMemorySize, LDS_BYTES);
        (void)hipOccupancyMaxActiveBlocksPerMultiprocessor(&per_cu, (const void*)mega_fwd, NTHREADS, LDS_BYTES);
        if (per_cu < 1) { fprintf(stderr, "kernel_launch: occupancy query says %d blocks per CU\n", per_cu); per_cu = 1; }
        grid = cus * 1;
        if (grid != 256) fprintf(stderr, "kernel_launch: %d CUs (the scan phases are laid out for 256 workgroups)\n", grid);
    }
    if (grid < 0) return;
    Params p{};
    for (int i = 0; i < N_INPUTS; ++i) p.in[i] = (const float*)d_in[i];
    p.out = (float*)d_out; p.ws = (unsigned char*)d_ws; p.ph_lo = 0; p.ph_hi = 0;
    void* args[] = {&p};
    hipError_t e = hipLaunchCooperativeKernel((const void*)mega_fwd, dim3(grid), dim3(NTHREADS), args, LDS_BYTES, stream);
    if (e != hipSuccess) fprintf(stderr, "cooperative launch failed: %s (grid %d)\n", hipGetErrorString(e), grid);
}
```

```cpp
#include <hip/hip_runtime.h>
#include <hip/hip_cooperative_groups.h>
#include <cstdio>
#include <cstdint>
namespace cg = cooperative_groups;

#define LAS __attribute__((address_space(3)))
typedef unsigned short bf16_t;
typedef short bf16x8 __attribute__((ext_vector_type(8)));
typedef float f32x4 __attribute__((ext_vector_type(4)));
typedef unsigned u32x4 __attribute__((ext_vector_type(4)));
typedef unsigned u32x2 __attribute__((ext_vector_type(2)));

constexpr int BATCH = 8, SEQ = 4096, NMETA = 16, LEN = SEQ + NMETA, DM = 1024, DFF = 4096, DEPTH = 2;
constexpr int M_ROWS = BATCH * LEN;
constexpr int MP = 33024;
constexpr int N_IN = 5896;
constexpr int NCH16 = LEN / 16;
constexpr int S5ROWS = BATCH * NCH16;
constexpr int S5RP = 2304;
constexpr float EPS = 1e-6f;
constexpr int NTHREADS = 512, NWAVES = 8;

constexpr size_t QB = (size_t)MP * 256 * 2;
constexpr size_t WB_IN = 0;
constexpr size_t WB_G = WB_IN + (size_t)2816 * 1024;
constexpr size_t WB_P = WB_G + (size_t)3072 * 1024;
constexpr size_t WB_O = WB_P + (size_t)1024 * 1024;
constexpr size_t WB_1 = WB_O + (size_t)1024 * 1024;
constexpr size_t WB_2 = WB_1 + (size_t)4096 * 1024;
constexpr size_t WB_GLU = WB_2 + (size_t)1024 * 4096;
constexpr size_t WB_L1 = WB_GLU + (size_t)512 * 256;
constexpr size_t WB_L2 = WB_L1 + (size_t)512 * 512;
constexpr size_t WB_SX = WB_L2 + (size_t)1280 * 256;
constexpr size_t WB_SY = WB_SX + (size_t)16 * 256 * 256;
constexpr size_t WB_ELEMS = WB_SY + (size_t)16 * 256 * 512;
constexpr size_t WB_BYTES = WB_ELEMS * 2;
static_assert(WB_BYTES <= 5 * QB / 2, "weight block fits 2.5 Q");

constexpr size_t WS_H = 0;
constexpr size_t WS_WB0 = 4 * QB;
constexpr size_t WS_SMALL = 13 * QB / 2;
constexpr size_t WS_SSQ = WS_SMALL;
constexpr size_t WS_DT = WS_SSQ + (size_t)MP * 16 * 4;
constexpr size_t WS_DEC = WS_DT + (size_t)MP * 16 * 4;
static_assert(WS_DEC + (size_t)MP * 16 * 4 <= 7 * QB, "small region");
constexpr size_t WS_MIX = 7 * QB;
constexpr size_t WS_PXBC = WS_MIX;
constexpr size_t WS_YSSD = WS_MIX;
constexpr size_t WS_PARK = WS_MIX;
constexpr size_t WS_ACT = WS_MIX;
constexpr size_t WS_PRKVX = WS_MIX + 4 * QB;
constexpr size_t WS_L2O = WS_MIX + 4 * QB;
constexpr size_t WS_PZ = WS_MIX + 9 * QB;
constexpr size_t WS_UH = WS_MIX + 11 * QB;
constexpr size_t WS_X = WS_MIX + 53 * QB / 4;
constexpr size_t WS_YRW = WS_X;
constexpr size_t WS_L1IN = WS_MIX + 31 * QB / 2;
constexpr size_t WS_YAPRE = WS_L1IN;
constexpr size_t WS_L1O = WS_MIX + 35 * QB / 2;
constexpr size_t WS_YB = WS_L1O;
constexpr size_t WS_BC = WS_MIX + 39 * QB / 2;
constexpr size_t WS_YA = WS_MIX + 33 * QB / 2;
constexpr size_t WS_YC = WS_BC + QB;
constexpr size_t WS_XS = WS_MIX + 43 * QB / 2;
constexpr size_t WS_END = WS_XS + 2 * QB;
static_assert(WS_END <= (size_t)512 << 20, "workspace map fits 512 MiB");
static_assert((size_t)16 * S5RP * 512 * 2 <= 9 * QB / 4 && (size_t)16 * S5RP * 256 * 4 <= 9 * QB / 4, "S5 buffers fit their slots");

constexpr size_t DO_RKVP = 0;
constexpr size_t DO_MERGED = 0;
constexpr size_t DO_WB1 = 4 * QB;
static_assert(DO_WB1 + WB_BYTES <= (size_t)BATCH * SEQ * DM * 4, "d_out scratch map");

__device__ __forceinline__ unsigned f2bf(float f) { unsigned u = __builtin_bit_cast(unsigned, f); return (u + 0x7fffu + ((u >> 16) & 1u)) >> 16; }
typedef float f32x2_t_ __attribute__((ext_vector_type(2))); typedef __bf16 bf16x2_t_ __attribute__((ext_vector_type(2)));
__device__ __forceinline__ unsigned pk2(float lo, float hi) { const f32x2_t_ v = {lo, hi}; const bf16x2_t_ b = __builtin_convertvector(v, bf16x2_t_); return __builtin_bit_cast(unsigned, b); }
__device__ __forceinline__ float bflo(unsigned w) { return __builtin_bit_cast(float, w << 16); }
__device__ __forceinline__ float bfhi(unsigned w) { return __builtin_bit_cast(float, w & 0xffff0000u); }
__device__ __forceinline__ float bf1(bf16_t v) { return __builtin_bit_cast(float, (unsigned)v << 16); }
__device__ __forceinline__ float sigmoidf_(float x) { return 1.0f / (1.0f + __expf(-x)); }
__device__ __forceinline__ float siluf_(float x) { return x / (1.0f + __expf(-x)); }
__device__ __forceinline__ float tanhf_(float x) { x = fminf(fmaxf(x, -15.f), 15.f); const float t = __expf(2.f * x); return (t - 1.f) / (t + 1.f); }
__device__ __forceinline__ float softplusf_(float x) { return fmaxf(x, 0.f) + __logf(1.0f + __expf(-fabsf(x))); }
__device__ __forceinline__ float geluf_(float x) { const float u = 0.7978845608028654f * (x + 0.044715f * x * x * x); return 0.5f * x * (1.f + tanhf_(u)); }
__device__ __forceinline__ float wave_sum(float v) {
#pragma unroll
    for (int o = 1; o < 64; o <<= 1) v += __shfl_xor(v, o);
    return v;
}
__device__ __forceinline__ float sum16(float v) {
#pragma unroll
    for (int o = 1; o < 16; o <<= 1) v += __shfl_xor(v, o);
    return v;
}
template <int CTRL> __device__ __forceinline__ float dpp_mov(float x) {
    return __builtin_bit_cast(float, __builtin_amdgcn_update_dpp(0, __builtin_bit_cast(int, x), CTRL, 0xf, 0xf, true));
}
__device__ __forceinline__ float allred16(float x) {
    x += dpp_mov<0xB1>(x); x += dpp_mov<0x4E>(x); x += dpp_mov<0x141>(x); x += dpp_mov<0x140>(x); return x;
}
__device__ __forceinline__ void unpack8(const u32x4 w, float (&f)[8]) {
    f[0] = bflo(w.x); f[1] = bfhi(w.x); f[2] = bflo(w.y); f[3] = bfhi(w.y); f[4] = bflo(w.z); f[5] = bfhi(w.z); f[6] = bflo(w.w); f[7] = bfhi(w.w);
}
__device__ __forceinline__ u32x4 pack8(const float (&f)[8]) { u32x4 w; w.x = pk2(f[0], f[1]); w.y = pk2(f[2], f[3]); w.z = pk2(f[4], f[5]); w.w = pk2(f[6], f[7]); return w; }
__device__ __forceinline__ int opaque_tid(int) { int t = threadIdx.x; asm volatile("" : "+v"(t)); return t; }
__device__ __forceinline__ int row_of(int b, int t) { return t < NMETA ? BATCH * SEQ + b * NMETA + t : b * SEQ + (t - NMETA); }
__device__ __forceinline__ void bt_of(int m, int& b, int& t) { if (m < BATCH * SEQ) { b = m >> 12; t = NMETA + (m & (SEQ - 1)); } else { const int q = m - BATCH * SEQ; b = q >> 4; t = q & (NMETA - 1); } }
namespace pg8 {
constexpr int BM = 256, BK = 64, HALF = 128, HTB = HALF * BK * 2  , STAGE_BYTES = 8 * HTB;
__host__ __device__ __forceinline__ int lds_byte(int r, int c) { const int st = (r >> 4) * 2 + (c >> 5), rr = r & 15, cc = c & 31, ob = rr * 64 + cc * 2; return st * 1024 + (ob ^ (((ob >> 9) & 1) << 5)); }
__host__ __device__ __forceinline__ void stage_rc(int b, int& R, int& C) { const int st = b / 1024, sb = b % 1024, swz = sb ^ (((sb >> 9) & 1) << 5); R = (st >> 1) * 16 + swz / 64; C = (st & 1) * 32 + (swz % 64) / 2; }
__host__ __device__ __forceinline__ int perm32(int rho) { const int n = rho >> 4, i = rho & 15; return 8 * (i >> 2) + 4 * n + (i & 3); }

struct GU {
    const bf16_t* A;
    const bf16_t* B;
    int lda, ldb, nt;
    int pm, pn, kind;
};

template <bool SKIP_HI = false, class Epi, class Sched>
__device__ __forceinline__ void gemm_phase(LAS unsigned char* lds, int wave_s, const Sched& S, const Epi& E) {
    const int tid = opaque_tid(wave_s), wid = wave_s, lane = tid & 63, wr = wid >> 2, wc = wid & 3, fr = lane & 15, fq = lane >> 4;
#define PG8_VOFF(lda_, ldb_, a0, b0) do { int R0_, C0_; stage_rc(tid * 16, R0_, C0_); \
        a0 = (unsigned)(R0_ * (lda_) + C0_) * 2u; b0 = (unsigned)(((R0_ & ~31) + perm32(R0_ & 31)) * (ldb_) + C0_) * 2u; } while (0)
    const size_t kstep = (size_t)(BK * 2);
    const unsigned ldsw = (unsigned)wid * 1024u;
    const int aoff = lds_byte(wr * 64 + fr, fq * 8), boff = lds_byte(wc * 32 + fr, fq * 8);
#define PG8_SA(b, h) (((b) * 2 + (h)) * HTB)
#define PG8_SB(b, h) ((4 + (b) * 2 + (h)) * HTB)
#define PG8_STAGE(bufoff, gbase, v0, hs) do { \
        __builtin_amdgcn_global_load_lds((const unsigned*)((const char*)(gbase) + (v0)), (LAS unsigned*)(lds + (bufoff) + ldsw), 16, 0, 0); \
        __builtin_amdgcn_global_load_lds((const unsigned*)((const char*)(gbase) + ((hs) >> 1) + (v0)), (LAS unsigned*)(lds + (bufoff) + ldsw + 8192), 16, 0, 0); } while (0)
#define PG8_LDA(dst, b, h) do { _Pragma("unroll") for (int m = 0; m < 4; ++m) _Pragma("unroll") for (int k = 0; k < 2; ++k) dst[m][k] = *(const LAS bf16x8*)(lds + PG8_SA(b, h) + aoff + m * 2048 + k * 1024); } while (0)
#define PG8_LDB(dst, b, h) do { _Pragma("unroll") for (int n = 0; n < 2; ++n) _Pragma("unroll") for (int k = 0; k < 2; ++k) dst[n][k] = *(const LAS bf16x8*)(lds + PG8_SB(b, h) + boff + n * 2048 + k * 1024); } while (0)
#define PG8_MMA(ai, bj, At, Bt) do { __builtin_amdgcn_s_setprio(1); _Pragma("unroll") for (int m = 0; m < 4; ++m) _Pragma("unroll") for (int n = 0; n < 2; ++n) _Pragma("unroll") for (int k = 0; k < 2; ++k) \
        acc[ai][bj][m][n] = __builtin_amdgcn_mfma_f32_16x16x32_bf16(Bt[n][k], At[m][k], acc[ai][bj][m][n], 0, 0, 0); __builtin_amdgcn_s_setprio(0); } while (0)
#define PG8_WAIT_V(n) asm volatile("s_waitcnt vmcnt(" #n ")" ::: "memory")
#define PG8_WAIT_L(n) asm volatile("s_waitcnt lgkmcnt(" #n ")" ::: "memory")
#define PG8_BAR __builtin_amdgcn_s_barrier()
#define PG8_SCHED __builtin_amdgcn_sched_barrier(0)
    GU cur, nxt; int ui = 0;
    if (!S.next(0, cur)) return;
    f32x4 acc[2][2][4][2];
#pragma unroll
    for (int a = 0; a < 2; ++a)
#pragma unroll
        for (int b = 0; b < 2; ++b)
#pragma unroll
            for (int m = 0; m < 4; ++m)
#pragma unroll
                for (int n = 0; n < 2; ++n) acc[a][b][m][n] = (f32x4){0.f, 0.f, 0.f, 0.f};
    bf16x8 At[4][2], B0[2][2], B1[2][2];
    const char* cA = (const char*)cur.A; const char* cB = (const char*)cur.B;
    unsigned vA0, vB0; PG8_VOFF(cur.lda, cur.ldb, vA0, vB0);
    size_t hsA = (size_t)HALF * cur.lda * 2, hsB = (size_t)HALF * cur.ldb * 2;
    int nt = cur.nt; asm volatile("" : "+s"(nt));
    PG8_STAGE(PG8_SB(0, 0), cB, vB0, hsB); PG8_STAGE(PG8_SB(0, 1), cB + hsB, vB0, hsB); PG8_STAGE(PG8_SA(0, 0), cA, vA0, hsA); PG8_STAGE(PG8_SA(0, 1), cA + hsA, vA0, hsA);
    if (wr == 1) PG8_BAR;
    PG8_WAIT_V(2); PG8_BAR;
    PG8_STAGE(PG8_SB(1, 0), cB + kstep, vB0, hsB); PG8_STAGE(PG8_SA(1, 0), cA + kstep, vA0, hsA); PG8_STAGE(PG8_SB(1, 1), cB + hsB + kstep, vB0, hsB);
    PG8_WAIT_V(6); PG8_BAR;
    for (;;) {
        const bool has_next = S.next(ui + 1, nxt);
        const char* nA = has_next ? (const char*)nxt.A : cA; const char* nB = has_next ? (const char*)nxt.B : cB;
        unsigned nvA0 = vA0, nvB0 = vB0;
        if (has_next) PG8_VOFF(nxt.lda, nxt.ldb, nvA0, nvB0);
        const size_t nhsA = has_next ? (size_t)HALF * nxt.lda * 2 : hsA, nhsB = has_next ? (size_t)HALF * nxt.ldb * 2 : hsB;
        for (int t = 0; t < nt; t += 2) {
            const bool last = (t == nt - 2);
            const char* a1 = cA + (size_t)(t + 1) * kstep;
            const char* a2 = last ? nA : cA + (size_t)(t + 2) * kstep; const char* b2 = last ? nB : cB + (size_t)(t + 2) * kstep;
            const char* a3 = a2 + kstep; const char* b3 = b2 + kstep;
            const unsigned xA0 = last ? nvA0 : vA0, xB0 = last ? nvB0 : vB0;
            const size_t xhA = last ? nhsA : hsA, xhB = last ? nhsB : hsB;
            PG8_LDB(B0, 0, 0); PG8_LDB(B1, 0, 1); PG8_SCHED; PG8_LDA(At, 0, 0); PG8_STAGE(PG8_SA(1, 1), a1 + hsA, vA0, hsA);
            PG8_WAIT_V(8); PG8_WAIT_L(0); PG8_BAR; PG8_MMA(0, 0, At, B0); PG8_MMA(0, 1, At, B1); PG8_BAR; PG8_SCHED;
            PG8_LDA(At, 0, 1); PG8_STAGE(PG8_SB(0, 0), b2, xB0, xhB); PG8_STAGE(PG8_SB(0, 1), b2 + xhB, xB0, xhB); PG8_STAGE(PG8_SA(0, 0), a2, xA0, xhA);
            PG8_WAIT_V(8); PG8_WAIT_L(0); PG8_BAR; if constexpr (!SKIP_HI) { PG8_MMA(1, 0, At, B0); PG8_MMA(1, 1, At, B1); } PG8_BAR; PG8_SCHED;
            PG8_LDB(B0, 1, 0); PG8_LDB(B1, 1, 1); PG8_SCHED; PG8_LDA(At, 1, 0); PG8_STAGE(PG8_SA(0, 1), a2 + xhA, xA0, xhA);
            PG8_WAIT_V(8); PG8_WAIT_L(0); PG8_BAR; PG8_MMA(0, 0, At, B0); PG8_MMA(0, 1, At, B1); PG8_BAR; PG8_SCHED;
            PG8_LDA(At, 1, 1); PG8_STAGE(PG8_SB(1, 0), b3, xB0, xhB); PG8_STAGE(PG8_SB(1, 1), b3 + xhB, xB0, xhB); PG8_STAGE(PG8_SA(1, 0), a3, xA0, xhA);
            PG8_WAIT_V(8); PG8_WAIT_L(0); PG8_BAR; if constexpr (!SKIP_HI) { PG8_MMA(1, 0, At, B0); PG8_MMA(1, 1, At, B1); } PG8_BAR; PG8_SCHED;
        }
        if (wr == 0) PG8_BAR;
        const bool keep = E(acc, cur, wr, wc, fr, fq);
        if (!has_next) break;
        if (!keep) {
#pragma unroll
            for (int a = 0; a < 2; ++a)
#pragma unroll
                for (int b = 0; b < 2; ++b)
#pragma unroll
                    for (int m = 0; m < 4; ++m)
#pragma unroll
                        for (int n = 0; n < 2; ++n) acc[a][b][m][n] = (f32x4){0.f, 0.f, 0.f, 0.f};
        }
        cur = nxt; cA = nA; cB = nB; vA0 = nvA0; vB0 = nvB0; hsA = nhsA; hsB = nhsB; nt = cur.nt; asm volatile("" : "+s"(nt)); ++ui;
        if (wr == 1) PG8_BAR;
    }
    PG8_WAIT_V(0);
    PG8_BAR;
#undef PG8_VOFF
#undef PG8_SA
#undef PG8_SB
#undef PG8_STAGE
#undef PG8_LDA
#undef PG8_LDB
#undef PG8_MMA
#undef PG8_WAIT_V
#undef PG8_WAIT_L
#undef PG8_BAR
#undef PG8_SCHED
}

__device__ __forceinline__ bool tile_order(int i, int G, int c, int nM, int nN, int& pm, int& pn) {
    const int nwg = nM * nN; const long L = (long)i * G + c; if (L >= nwg) return false;
    int wgid = (int)L; { const int q = nwg / 8, r = nwg % 8, xcd = wgid % 8, off = wgid / 8; wgid = (xcd < r ? xcd * (q + 1) : r * (q + 1) + (xcd - r) * q) + off; }
    const int nig = 8 * nN, gid = wgid / nig, fm = gid * 8, gsz = (nM - fm) < 8 ? (nM - fm) : 8;
    pm = fm + ((wgid % nig) % gsz); pn = (wgid % nig) / gsz; return true;
}
}
using pg8::GU;
enum InIdx { I_X = 0, I_META, I_FNW, I_MIXNW, I_WIN, I_S5LRE, I_S5LIM, I_S5LS, I_S5BRE, I_S5BIM, I_S5CRE, I_S5CIM, I_S5D, I_GLUW, I_GLUB,
             I_CONVW, I_CONVB, I_ALOG, I_DTB, I_SSDD, I_SSDNW, I_MURKV, I_MUWAG, I_W0, I_W1, I_W2, I_A0, I_A1, I_A2, I_G1, I_G2, I_KK, I_KA, I_RK, I_LNW, I_LNB,
             I_PA, I_PB, I_PC, I_WOUT, I_MLPNW, I_MLPW1, I_MLPW2, N_INPUTS };
struct Params { const float* in[N_INPUTS]; float* out; unsigned char* ws; int ph_lo, ph_hi; };

struct Ctx {
    const float* const* in; unsigned char* ws; unsigned char* dout;
    LAS unsigned char* lds;
    int tid, lane, wave, G, bid;
    __device__ __forceinline__ bf16_t* wb(int layer) const { return (bf16_t*)(layer == 0 ? ws + WS_WB0 : dout + DO_WB1); }
    __device__ __forceinline__ bf16_t* H() const { return (bf16_t*)(ws + WS_H); }
    __device__ __forceinline__ float* ssq() const { return (float*)(ws + WS_SSQ); }
};
__device__ __forceinline__ Ctx relaunder(const Ctx& c0) {
    Ctx c = c0; c.tid = opaque_tid(c0.wave); c.lane = c.tid & 63;
    int z = 0; asm volatile("" : "+s"(z)); z = __builtin_amdgcn_readfirstlane(z);
    c.ws = c0.ws + z; c.dout = c0.dout + z; c.in = c0.in + z;
    return c;
}
__device__ __forceinline__ float row_scale(const float* ssq, int row) {
    const f32x4* p = (const f32x4*)(ssq + (size_t)row * 16);
    const f32x4 a = p[0], b = p[1], c = p[2], d = p[3];
    const float s = ((a.x + a.y) + (a.z + a.w)) + ((b.x + b.y) + (b.z + b.w)) + ((c.x + c.y) + (c.z + c.w)) + ((d.x + d.y) + (d.z + d.w));
    return __builtin_amdgcn_rsqf(s * (1.0f / DM) + EPS);
}

__device__ __forceinline__ void row_scales8(const float* ssq, int pm, int wr, int fr, int fq, float (&rs)[8]) {
    f32x4 p[8];
#pragma unroll
    for (int q = 0; q < 8; ++q) { int row = pm * 256 + (q >> 2) * 128 + wr * 64 + (q & 3) * 16 + fr; if (row >= M_ROWS) row = 0; p[q] = *(const f32x4*)(ssq + (size_t)row * 16 + fq * 4); }
#pragma unroll
    for (int q = 0; q < 8; ++q) { float s = (p[q].x + p[q].y) + (p[q].z + p[q].w); s += __shfl_xor(s, 16); s += __shfl_xor(s, 32); rs[q] = __builtin_amdgcn_rsqf(s * (1.0f / DM) + EPS); }
}

struct SchedPlain {
    const bf16_t* A; const bf16_t* B; int lda, ldb, K, nM, nN, G, c, pm0;
    __device__ __forceinline__ bool next(int i, GU& u) const {
        int pm, pn; if (!pg8::tile_order(i, G, c, nM, nN, pm, pn)) return false;
        pm += pm0;
        u.A = A + (size_t)pm * 256 * lda; u.B = B + (size_t)pn * 256 * ldb; u.lda = lda; u.ldb = ldb; u.nt = K / 64; u.pm = pm; u.pn = pn; u.kind = 0; return true;
    }
};
struct SchedS5 {
    const bf16_t* UH; const bf16_t* W; int K, G, c;
    __device__ __forceinline__ bool next(int i, GU& u) const {
        const int L = i * G + c; if (L >= 144) return false;
        const int g = L / 9, pm = L % 9;
        u.A = UH + ((size_t)g * S5RP + (size_t)pm * 256) * 512; u.B = W + (size_t)g * 256 * K; u.lda = 512; u.ldb = K; u.nt = K / 64; u.pm = pm; u.pn = 0; u.kind = g; return true;
    }
};
struct SchedL2 {
    const bf16_t* L1o; const bf16_t* W; int G, c, nM, pm0;
    __device__ __forceinline__ bool next(int i, GU& u) const {
        int pm, pn; if (!pg8::tile_order(i, G, c, nM, 5, pm, pn)) return false;
        pm += pm0;
        const int koff = pn < 2 ? 0 : (pn < 4 ? 128 : 256);
        u.A = L1o + (size_t)pm * 256 * 512 + koff; u.B = W + (size_t)pn * 256 * 256; u.lda = 512; u.ldb = 256; u.nt = 4; u.pm = pm; u.pn = pn; u.kind = 0; return true;
    }
};
struct SchedProj {
    const bf16_t* Hb; const bf16_t* Wg; const bf16_t* Wp; const bf16_t* ya; const bf16_t* yb; const bf16_t* yc; int nM, G, c, pm0;
    __device__ __forceinline__ bool next(int i, GU& u) const {
        const int ti = i / 6, sub = i - ti * 6; int pm, pn;
        if (!pg8::tile_order(ti, G, c, nM, 4, pm, pn)) return false;
        pm += pm0;
        u.pm = pm; u.pn = pn; u.kind = sub;
        if (sub < 3) { u.A = Hb + (size_t)pm * 256 * DM; u.lda = DM; u.B = Wg + ((size_t)sub * 1024 + (size_t)pn * 256) * DM; u.ldb = DM; u.nt = 16; }
        else if (sub == 3) { u.A = ya + (size_t)pm * 256 * 256; u.lda = 256; u.B = Wp + (size_t)pn * 256 * DM; u.ldb = DM; u.nt = 4; }
        else if (sub == 4) { u.A = yb + (size_t)pm * 256 * 512; u.lda = 512; u.B = Wp + (size_t)pn * 256 * DM + 256; u.ldb = DM; u.nt = 8; }
        else { u.A = yc + (size_t)pm * 256 * 256; u.lda = 256; u.B = Wp + (size_t)pn * 256 * DM + 768; u.ldb = DM; u.nt = 4; }
        return true;
    }
};

typedef f32x4 Acc[2][2][4][2];
#define EPI_ROWS_BEGIN  _Pragma("unroll") for (int ai = 0; ai < 2; ++ai) _Pragma("unroll") for (int m = 0; m < 4; ++m) { const int rl = ai * 128 + wr * 64 + m * 16 + fr; const int row = u.pm * 256 + rl; (void)rl;
#define EPI_ROWS_END    asm volatile("" ::: "memory"); }
#define EPI_COL(bj) ((bj) * 128 + wc * 32 + fq * 8)

struct EpiInProj {
    const float* ssq; bf16_t* UH; bf16_t* Pz; bf16_t* Pxbc; bf16_t* Prkvx;
    __device__ __forceinline__ bool operator()(Acc& acc, const GU& u, int wr, int wc, int fr, int fq) const {
        float rs8[8]; row_scales8(ssq, u.pm, wr, fr, fq, rs8);
        EPI_ROWS_BEGIN
            if (row < M_ROWS) {
                const float s = rs8[ai * 4 + m];
                int b, t; bt_of(row, b, t);
#pragma unroll
                for (int bj = 0; bj < 2; ++bj) {
                    const int col = EPI_COL(bj);
                    const f32x4 v0 = acc[ai][bj][m][0] * s, v1 = acc[ai][bj][m][1] * s;
                    u32x4 w; w.x = pk2(v0[0], v0[1]); w.y = pk2(v0[2], v0[3]); w.z = pk2(v1[0], v1[1]); w.w = pk2(v1[2], v1[3]);
                    bf16_t* dst;
                    if (u.pn == 0) { const int g = col >> 4, hh = col & 15; dst = UH + ((size_t)g * S5RP + (size_t)(b * NCH16 + (t >> 4))) * 512 + (t & 15) * 16 + hh; }
                    else if (u.pn < 3) dst = Pz + (size_t)row * 512 + (u.pn - 1) * 256 + col;
                    else if (u.pn < 7) dst = Pxbc + (size_t)row * 1024 + (u.pn - 3) * 256 + col;
                    else dst = Prkvx + (size_t)row * 1024 + (u.pn - 7) * 256 + col;
                    *(u32x4*)dst = w;
                }
            }
        EPI_ROWS_END
        return false;
    }
};
struct EpiS5X {
    float* X;
    __device__ __forceinline__ bool operator()(Acc& acc, const GU& u, int wr, int wc, int fr, int fq) const {
        EPI_ROWS_BEGIN
            float* rp = X + ((size_t)u.kind * S5RP + row) * 256;
#pragma unroll
            for (int bj = 0; bj < 2; ++bj) { const int col = EPI_COL(bj); *(f32x4*)(rp + col) = acc[ai][bj][m][0]; *(f32x4*)(rp + col + 4) = acc[ai][bj][m][1]; }
        EPI_ROWS_END
        return false;
    }
};
struct EpiS5Y {
    bf16_t* yapre;
    __device__ __forceinline__ bool operator()(Acc& acc, const GU& u, int wr, int wc, int fr, int fq) const {
        EPI_ROWS_BEGIN
            if (row < S5ROWS) {
                const int b = row / NCH16, c = row - b * NCH16;
#pragma unroll
                for (int bj = 0; bj < 2; ++bj) {
                    const int col = EPI_COL(bj), i = col >> 4, hh = col & 15;
                    const f32x4 v0 = acc[ai][bj][m][0], v1 = acc[ai][bj][m][1];
                    u32x4 w; w.x = pk2(geluf_(v0[0]), geluf_(v0[1])); w.y = pk2(geluf_(v0[2]), geluf_(v0[3])); w.z = pk2(geluf_(v1[0]), geluf_(v1[1])); w.w = pk2(geluf_(v1[2]), geluf_(v1[3]));
                    *(u32x4*)(yapre + (size_t)row_of(b, c * 16 + i) * 256 + u.kind * 16 + hh) = w;
                }
            }
        EPI_ROWS_END
        return false;
    }
};
struct EpiL1 {
    bf16_t* L1o;
    __device__ __forceinline__ bool operator()(Acc& acc, const GU& u, int wr, int wc, int fr, int fq) const {
        EPI_ROWS_BEGIN
#pragma unroll
            for (int bj = 0; bj < 2; ++bj) {
                const int col = EPI_COL(bj); const int mode = u.pn * 2 + bj;
                f32x4 v0 = acc[ai][bj][m][0], v1 = acc[ai][bj][m][1]; float f[8] = {v0[0], v0[1], v0[2], v0[3], v1[0], v1[1], v1[2], v1[3]};
#pragma unroll
                for (int e = 0; e < 8; ++e) f[e] = mode == 0 ? tanhf_(f[e]) : (mode == 1 ? f[e] : (mode == 2 ? sigmoidf_(f[e]) : 0.f));
                *(u32x4*)(L1o + (size_t)row * 512 + u.pn * 256 + col) = pack8(f);
            }
        EPI_ROWS_END
        return false;
    }
};
struct EpiL2 {
    bf16_t* L2o; const float* w0; const float* a0;
    __device__ __forceinline__ bool operator()(Acc& acc, const GU& u, int wr, int wc, int fr, int fq) const {
        EPI_ROWS_BEGIN
#pragma unroll
            for (int bj = 0; bj < 2; ++bj) {
                const int col = EPI_COL(bj);
                f32x4 v0 = acc[ai][bj][m][0], v1 = acc[ai][bj][m][1]; float f[8] = {v0[0], v0[1], v0[2], v0[3], v1[0], v1[1], v1[2], v1[3]};
                if (u.pn < 2) {
                    const float* bp = w0 + u.pn * 256 + col;
#pragma unroll
                    for (int e = 0; e < 8; ++e) { const float v = bp[e] + f[e]; f[e] = -__expf(-softplusf_(-v) - 0.5f); }
                } else if (u.pn < 4) {
                    const float* bp = a0 + (u.pn - 2) * 256 + col;
#pragma unroll
                    for (int e = 0; e < 8; ++e) f[e] = sigmoidf_(bp[e] + f[e]);
                }
                *(u32x4*)(L2o + (size_t)row * 1280 + u.pn * 256 + col) = pack8(f);
            }
        EPI_ROWS_END
        return false;
    }
};
struct EpiGLU {
    bf16_t* ya; const float* bias;
    __device__ __forceinline__ bool operator()(Acc& acc, const GU& u, int wr, int wc, int fr, int fq) const {
        const int lc = wc * 32 + fq * 8, oc = u.pn * 128 + lc;
        float bv[8], bg[8];
#pragma unroll
        for (int e = 0; e < 8; ++e) { bv[e] = bias[oc + e]; bg[e] = bias[256 + oc + e]; }
        EPI_ROWS_BEGIN
            const f32x4 a0 = acc[ai][0][m][0], a1 = acc[ai][0][m][1], g0 = acc[ai][1][m][0], g1 = acc[ai][1][m][1];
            float v[8] = {a0[0], a0[1], a0[2], a0[3], a1[0], a1[1], a1[2], a1[3]}, g[8] = {g0[0], g0[1], g0[2], g0[3], g1[0], g1[1], g1[2], g1[3]};
#pragma unroll
            for (int e = 0; e < 8; ++e) v[e] = (v[e] + bv[e]) * sigmoidf_(g[e] + bg[e]);
            *(u32x4*)(ya + (size_t)row * 256 + oc) = pack8(v);
        EPI_ROWS_END
        return false;
    }
};
struct EpiProj {
    const float* ssq; const float* ssqb; unsigned char* park; bf16_t* merged; int tid;
    __device__ __forceinline__ bool operator()(Acc& acc, const GU& u, int wr, int wc, int fr, int fq) const {
        const int k = u.kind;
        float s8[8];
        if (k < 3) row_scales8(ssq, u.pm, wr, fr, fq, s8);
        else if (k < 5) {
            f32x2_t_ sb[8];
#pragma unroll
            for (int g = 0; g < 8; ++g) { int row = u.pm * 256 + (g >> 2) * 128 + wr * 64 + (g & 3) * 16 + fr; if (row >= M_ROWS) row = 0; sb[g] = *(const f32x2_t_*)(ssqb + 2 * (size_t)row); }
#pragma unroll
            for (int g = 0; g < 8; ++g) { const float s = __builtin_amdgcn_rsqf((sb[g].x + sb[g].y) * (1.0f / 512.f) + EPS); s8[g] = k == 3 ? __builtin_amdgcn_rcpf(s) : s; }
        } else {
#pragma unroll
            for (int g = 0; g < 8; ++g) s8[g] = 1.f;
        }
        EPI_ROWS_BEGIN
            const float s = s8[ai * 4 + m];
#pragma unroll
            for (int bj = 0; bj < 2; ++bj) {
                const int q = (ai * 2 + bj) * 4 + m;
                f32x4& v0 = acc[ai][bj][m][0]; f32x4& v1 = acc[ai][bj][m][1];
                if (k < 3) {
                    float f[8] = {v0[0], v0[1], v0[2], v0[3], v1[0], v1[1], v1[2], v1[3]};
#pragma unroll
                    for (int e = 0; e < 8; ++e) f[e] = sigmoidf_(f[e] * s);
                    *(u32x4*)(park + ((size_t)(k * 16 + q) * NTHREADS + tid) * 16) = pack8(f);
                } else {
                    float num[8], den[8];
                    unpack8(*(const u32x4*)(park + ((size_t)((k - 3) * 16 + q) * NTHREADS + tid) * 16), num);
                    if (k < 5) { unpack8(*(const u32x4*)(park + ((size_t)((k - 2) * 16 + q) * NTHREADS + tid) * 16), den);
#pragma unroll
                        for (int e = 0; e < 8; ++e) num[e] = num[e] * __builtin_amdgcn_rcpf(den[e]) * s; }
                    v0[0] *= num[0]; v0[1] *= num[1]; v0[2] *= num[2]; v0[3] *= num[3]; v1[0] *= num[4]; v1[1] *= num[5]; v1[2] *= num[6]; v1[3] *= num[7];
                    if (k == 5) { u32x4 w; w.x = pk2(v0[0], v0[1]); w.y = pk2(v0[2], v0[3]); w.z = pk2(v1[0], v1[1]); w.w = pk2(v1[2], v1[3]);
                        *(u32x4*)(merged + (size_t)row * DM + u.pn * 256 + EPI_COL(bj)) = w; }
                }
            }
        EPI_ROWS_END
        return k == 3 || k == 4;
    }
};
struct EpiResid {
    bf16_t* H; float* ssq;
    __device__ __forceinline__ bool operator()(Acc& acc, const GU& u, int wr, int wc, int fr, int fq) const {
        bf16_t* hb = H + (size_t)(u.pm * 256 + wr * 64 + fr) * DM + u.pn * 256 + wc * 32 + fq * 8;
        u32x4 nx[2];
#pragma unroll
        for (int bj = 0; bj < 2; ++bj) nx[bj] = *(const u32x4*)(hb + bj * 128);
#pragma unroll
        for (int g = 0; g < 8; ++g) {
            const int ai = g >> 2, m = g & 3; const int row = u.pm * 256 + ai * 128 + wr * 64 + m * 16 + fr;
            const u32x4 cur[2] = {nx[0], nx[1]};
            if (g < 7) {
                const int ai2 = (g + 1) >> 2, m2 = (g + 1) & 3;
#pragma unroll
                for (int bj = 0; bj < 2; ++bj) nx[bj] = *(const u32x4*)(hb + (size_t)(ai2 * 128 + m2 * 16) * DM + bj * 128);
            }
            float ss = 0.f;
#pragma unroll
            for (int bj = 0; bj < 2; ++bj) {
                float f[8]; unpack8(cur[bj], f);
                const f32x4 v0 = acc[ai][bj][m][0], v1 = acc[ai][bj][m][1];
                f[0] += v0[0]; f[1] += v0[1]; f[2] += v0[2]; f[3] += v0[3]; f[4] += v1[0]; f[5] += v1[1]; f[6] += v1[2]; f[7] += v1[3];
#pragma unroll
                for (int e = 0; e < 8; ++e) ss += f[e] * f[e];
                *(u32x4*)(hb + (size_t)(ai * 128 + m * 16) * DM + bj * 128) = pack8(f);
            }
            ss += __shfl_xor(ss, 16); ss += __shfl_xor(ss, 32);
            if (fq == 0) ssq[(size_t)row * 16 + u.pn * 4 + wc] = ss;
            asm volatile("" ::: "memory");
        }
        return false;
    }
};
struct EpiUp {
    const float* ssq; bf16_t* act;
    __device__ __forceinline__ bool operator()(Acc& acc, const GU& u, int wr, int wc, int fr, int fq) const {
        float rs8[8]; row_scales8(ssq, u.pm, wr, fr, fq, rs8);
        EPI_ROWS_BEGIN
            const float s = rs8[ai * 4 + m];
#pragma unroll
            for (int bj = 0; bj < 2; ++bj) {
                const f32x4 v0 = acc[ai][bj][m][0] * s, v1 = acc[ai][bj][m][1] * s; float f[8] = {v0[0], v0[1], v0[2], v0[3], v1[0], v1[1], v1[2], v1[3]};
#pragma unroll
                for (int e = 0; e < 8; ++e) { const float r = fmaxf(f[e], 0.f); f[e] = r * r; }
                *(u32x4*)(act + (size_t)row * DFF + u.pn * 256 + EPI_COL(bj)) = pack8(f);
            }
        EPI_ROWS_END
        return false;
    }
};
typedef __attribute__((address_space(1))) unsigned gu32;
#define XB_TMO      128
#define XB_XCNT(j)  (256  + 64 * (j))
#define XB_XSUB(j)  (1280 + 64 * (j))
#define XB_XGEN(j)  (2304 + 64 * (j))
#define XB_TOP      3328
#define XB_TOPGEN   3392
#define XCD_BAR_WORDS 3456
#define XB_SPIN_CAP (1u << 18)

__device__ __forceinline__ unsigned xb_ld(unsigned* p)              { return __hip_atomic_load(p, __ATOMIC_RELAXED, __HIP_MEMORY_SCOPE_AGENT); }
__device__ __forceinline__ unsigned xb_add(unsigned* p, unsigned v) { return __hip_atomic_fetch_add(p, v, __ATOMIC_RELAXED, __HIP_MEMORY_SCOPE_AGENT); }
__device__ __forceinline__ unsigned xb_xcc_id() { return (unsigned)__builtin_amdgcn_s_getreg((3 << 11) | 20) & 0xFu; }
#define XB_SPIN(cond, bar) do { unsigned _sp = 0; while (cond) { __builtin_amdgcn_s_sleep(1); \
    if ((++_sp & 255u) == 0u) { if (xb_ld(&(bar)[XB_TMO])) break; if (_sp > XB_SPIN_CAP) { atomicAdd(&(bar)[XB_TMO], 1u); break; } } } } while (0)

struct XcdBarrier {
    unsigned* bar; unsigned x;
    volatile LAS unsigned* st;
};

__device__ __forceinline__ XcdBarrier xcd_barrier_post(unsigned* bar, volatile LAS unsigned* st) {
    XcdBarrier b; b.bar = bar; b.x = xb_xcc_id(); b.st = st;
    if (threadIdx.x == 0) (void)xb_add(&bar[XB_XCNT(b.x)], 1u);
    return b;
}
__device__ __forceinline__ void xcd_barrier_complete(unsigned* bar, unsigned x, unsigned& nloc, unsigned& nx) {
    const unsigned G = gridDim.x * gridDim.y * gridDim.z;
    unsigned sum, cnt, mine, sp = 0u;
    for (;;) {
        sum = 0u; cnt = 0u; mine = 0u;
#pragma unroll
        for (unsigned j = 0; j < 16; ++j) { const unsigned c = xb_ld(&bar[XB_XCNT(j)]); sum += c; cnt += (c > 0u) ? 1u : 0u; mine = (j == x) ? c : mine; }
        if (sum == G) break;
        __builtin_amdgcn_s_sleep(1);
        if ((++sp & 255u) == 0u) { if (xb_ld(&bar[XB_TMO])) break; if (sp > XB_SPIN_CAP) { atomicAdd(&bar[XB_TMO], 1u); break; } }
    }
    nloc = mine > 0u ? mine : 1u; nx = cnt > 0u ? cnt : 1u;
}

__device__ __forceinline__ void xcd_barrier(const XcdBarrier& b, int wave_s) {
    const bool xb_t0 = threadIdx.x == 0; (void)wave_s;
    asm volatile("s_waitcnt vmcnt(0)" ::: "memory");
    __syncthreads();
    if (xb_t0) {
        unsigned* bar = b.bar;
        __builtin_amdgcn_s_waitcnt(0);
        unsigned nloc = b.st[0], nx = b.st[1];
        if (nloc == 0u) { xcd_barrier_complete(bar, b.x, nloc, nx); b.st[0] = nloc; b.st[1] = nx; }
        const unsigned old = xb_add(&bar[XB_XSUB(b.x)], 1u);
        const unsigned gen = old / nloc;
        if (old + 1u == (gen + 1u) * nloc) {
            __builtin_amdgcn_fence(__ATOMIC_RELEASE, "agent");
            asm volatile("s_waitcnt vmcnt(0)" ::: "memory");
            const unsigned og = xb_add(&bar[XB_TOP], 1u);
            const unsigned tg = og / nx;
            if (og + 1u == (tg + 1u) * nx) xb_add(&bar[XB_TOPGEN], 1u);
            else XB_SPIN(xb_ld(&bar[XB_TOPGEN]) == tg, bar);
            __builtin_amdgcn_fence(__ATOMIC_ACQUIRE, "agent");
            xb_add(&bar[XB_XGEN(b.x)], 1u);
            asm volatile("s_waitcnt vmcnt(0)" ::: "memory");
        } else {
            XB_SPIN(xb_ld(&bar[XB_XGEN(b.x)]) == gen, bar);
            __builtin_amdgcn_fence(__ATOMIC_ACQUIRE, "agent");
            asm volatile("s_waitcnt vmcnt(0)" ::: "memory");
        }
    }
    __syncthreads();
}

#ifdef PROF_A
#ifndef PROF_SHIFT
#define PROF_SHIFT 1.0f
#endif
#define PROF_PTR ((unsigned long long*)(c.ws + WS_DEC + (size_t)MP * 64))
#define STAMP(k) do { if (blockIdx.x == 0 && threadIdx.x == 0) { const unsigned long long t_ = __builtin_amdgcn_s_memrealtime(); PROF_PTR[k] += t_ - PROF_PTR[15]; PROF_PTR[15] = t_; } } while (0)
#else
#define STAMP(k) do { } while (0)
#endif
struct TJob { const float* src; int ld, col0, K, N; bf16_t* dst; int dld, dk0, rmode, row0; const float* ksc; };
constexpr int N_TJOBS = 27;
__device__ __forceinline__ void get_tjob(const Ctx& c, int l, int j, TJob& t) {
    bf16_t* wb = c.wb(l);
    const float* win = c.in[I_WIN] + (size_t)l * DM * N_IN;
    t.rmode = 0; t.ksc = nullptr; t.dk0 = 0; t.col0 = 0; t.row0 = 0;
    if (j < 5) {
        t.src = win; t.ld = N_IN; t.K = DM; t.dld = DM; t.ksc = c.in[I_MIXNW] + l * DM; t.dst = wb + WB_IN;
        if (j == 0) { t.col0 = 0; t.N = 256; t.row0 = 0; }
        else if (j == 1) { t.col0 = 256; t.N = 512; t.row0 = 256; }
        else if (j == 2) { t.col0 = 768; t.N = 1024; t.row0 = 768; }
        else if (j == 3) { t.col0 = 1800; t.N = 1024; t.row0 = 1792; }
        else { t.col0 = 2824; t.N = 3072; t.row0 = 0; t.dst = wb + WB_G; }
    } else if (j == 5) { t.src = c.in[I_PA] + (size_t)l * 256 * DM; t.ld = DM; t.K = 256; t.N = DM; t.dst = wb + WB_P; t.dld = DM; t.dk0 = 0; }
    else if (j == 6) { t.src = c.in[I_PB] + (size_t)l * 512 * DM; t.ld = DM; t.K = 512; t.N = DM; t.dst = wb + WB_P; t.dld = DM; t.dk0 = 256; t.ksc = c.in[I_SSDNW] + (size_t)l * 512; }
    else if (j == 7) { t.src = c.in[I_PC] + (size_t)l * 256 * DM; t.ld = DM; t.K = 256; t.N = DM; t.dst = wb + WB_P; t.dld = DM; t.dk0 = 768; }
    else if (j == 8) { t.src = c.in[I_WOUT] + (size_t)l * DM * DM; t.ld = DM; t.K = DM; t.N = DM; t.dst = wb + WB_O; t.dld = DM; }
    else if (j == 9) { t.src = c.in[I_MLPW1] + (size_t)l * DM * DFF; t.ld = DFF; t.K = DM; t.N = DFF; t.dst = wb + WB_1; t.dld = DM; t.ksc = c.in[I_MLPNW] + l * DM; }
    else if (j == 10) { t.src = c.in[I_MLPW2] + (size_t)l * DFF * DM; t.ld = DM; t.K = DFF; t.N = DM; t.dst = wb + WB_2; t.dld = DFF; }
    else if (j == 11) { t.src = c.in[I_GLUW] + (size_t)l * 256 * 512; t.ld = 512; t.K = 256; t.N = 512; t.dst = wb + WB_GLU; t.dld = 256; t.rmode = 1; }
    else if (j < 22) {
        const int q = j - 12;
        t.K = 256; t.dst = wb + WB_L1; t.dld = 512;
        if (q < 4) { const int d = q >> 1, hf = q & 1; t.src = c.in[I_W1] + ((size_t)l * 2 + d) * 256 * 64; t.ld = 64; t.N = 64; t.row0 = d * 64; t.dk0 = hf * 256; if (hf) t.ksc = c.in[I_MUWAG] + ((size_t)l * 3 + 0) * 256; }
        else if (q < 8) { const int d = (q - 4) >> 1, hf = q & 1; t.src = c.in[I_A1] + ((size_t)l * 2 + d) * 256 * 64; t.ld = 64; t.N = 64; t.row0 = 128 + d * 64; t.dk0 = hf * 256; if (hf) t.ksc = c.in[I_MUWAG] + ((size_t)l * 3 + 1) * 256; }
        else { const int hf = q & 1; t.src = c.in[I_G1] + (size_t)l * 256 * 128; t.ld = 128; t.N = 128; t.row0 = 256; t.dk0 = hf * 256; if (hf) t.ksc = c.in[I_MUWAG] + ((size_t)l * 3 + 2) * 256; }
    } else {
        const int q = j - 22;
        t.dst = wb + WB_L2; t.dld = 256; t.ld = 256; t.N = 256;
        if (q < 2) { t.src = c.in[I_W2] + ((size_t)l * 2 + q) * 64 * 256; t.K = 64; t.row0 = q * 256; t.dk0 = q * 64; }
        else if (q < 4) { const int d = q - 2; t.src = c.in[I_A2] + ((size_t)l * 2 + d) * 64 * 256; t.K = 64; t.row0 = (2 + d) * 256; t.dk0 = d * 64; }
        else { t.src = c.in[I_G2] + (size_t)l * 128 * 256; t.K = 128; t.row0 = 4 * 256; t.dk0 = 0; }
    }
}
__device__ __forceinline__ int tjob_items(const TJob& t) { return (t.K / 64) * (t.N / 32); }
struct TIt { int l, j, base, gid; bool ok; TJob t; };
__device__ __forceinline__ void tit_seek(const Ctx& c, TIt& s) {
    s.ok = false;
    while (s.l < DEPTH) {
        const int ni = tjob_items(s.t);
        if (s.gid < s.base + ni) { s.ok = true; break; }
        s.base += ni;
        if (++s.j == N_TJOBS) { s.j = 0; ++s.l; if (s.l >= DEPTH) break; }
        get_tjob(c, s.l, s.j, s.t);
    }
}
__device__ __forceinline__ void tr_load(const TJob& t, int item, int lane, float (&v)[32]) {
    const int nblk = t.N / 32, kb = item / nblk, nb = item % nblk, k0 = 64 * kb, n0 = 32 * nb;
    const float* __restrict__ sp = t.src + (size_t)(k0 + (lane >> 5)) * t.ld + t.col0 + n0 + (lane & 31);
#pragma unroll
    for (int i = 0; i < 32; ++i) v[i] = sp[(size_t)(2 * i) * t.ld];
}
__device__ __forceinline__ void tr_store(const TJob& t, LAS float* scr, int item, int lane, const float (&v)[32]) {
    const int nblk = t.N / 32, kb = item / nblk, nb = item % nblk, k0 = 64 * kb, n0 = 32 * nb;
    const int cc = lane & 7;
    f32x4 ka = {1.f, 1.f, 1.f, 1.f}, kb4 = {1.f, 1.f, 1.f, 1.f};
    if (t.ksc) { ka = *(const f32x4*)(t.ksc + k0 + 8 * cc); kb4 = *(const f32x4*)(t.ksc + k0 + 8 * cc + 4); }
#pragma unroll
    for (int i = 0; i < 32; ++i) scr[(2 * i + (lane >> 5)) * 33 + (lane & 31)] = v[i];
    asm volatile("s_waitcnt lgkmcnt(0)" ::: "memory");
#pragma unroll
    for (int j = 0; j < 4; ++j) {
        const int n = (lane >> 3) + 8 * j; const LAS float* s = scr + (8 * cc) * 33 + n;
        u32x4 o; o.x = pk2(s[0 * 33] * ka.x, s[1 * 33] * ka.y); o.y = pk2(s[2 * 33] * ka.z, s[3 * 33] * ka.w); o.z = pk2(s[4 * 33] * kb4.x, s[5 * 33] * kb4.y); o.w = pk2(s[6 * 33] * kb4.z, s[7 * 33] * kb4.w);
        const int nn = n0 + n; int drow;
        if (t.rmode == 0) drow = t.row0 + nn; else drow = nn < 256 ? (nn >> 7) * 256 + (nn & 127) : ((nn - 256) >> 7) * 256 + 128 + ((nn - 256) & 127);
        *(u32x4*)(t.dst + (size_t)drow * t.dld + t.dk0 + k0 + 8 * cc) = o;
    }
    asm volatile("s_waitcnt lgkmcnt(0)" ::: "memory");
}

__device__ __forceinline__ void s5_build(const Ctx& cx_, int l, int g, int part) {
    const Ctx c = relaunder(cx_);
    LAS float* F = (LAS float*)c.lds;
    LAS float* pwr = F;
    LAS float* pwi = pwr + 2176;
    LAS float* cor = pwi + 2176;
    LAS float* coi = cor + 128;
    LAS float* Cr = coi + 128;
    LAS float* Ci = Cr + 1024;
    LAS float* Br = Ci + 1024;
    LAS float* Bi = Br + 1024;
    LAS float* kr = Bi + 1024;
    LAS float* ki = kr + 1984;
    LAS float* Kd = ki + 1984;
    const int tid = c.tid;
    for (int i = tid; i < 2 * 17 * 64; i += NTHREADS) {
        const int d = i / 1088, k = (i - d * 1088) >> 6, n = i & 63; const size_t li_ = (((size_t)l * 2 + d) * 16 + g) * 64 + n;
        const float lr = c.in[I_S5LRE][li_], li = c.in[I_S5LIM][li_], step = expf(c.in[I_S5LS][((size_t)l * 2 + d) * 16 + g]);
        const float mag = expf((float)k * lr * step), ang = (float)k * li * step; float sn, cs; sincosf(ang, &sn, &cs); pwr[(d * 17 + k) * 64 + n] = mag * cs; pwi[(d * 17 + k) * 64 + n] = mag * sn;
    }
    if (tid < 128) {
        const int d = tid >> 6, n = tid & 63; const size_t li_ = (((size_t)l * 2 + d) * 16 + g) * 64 + n;
        const float lr = c.in[I_S5LRE][li_], li = c.in[I_S5LIM][li_], step = expf(c.in[I_S5LS][((size_t)l * 2 + d) * 16 + g]);
        const float mag1 = expf(lr * step); float sn, cs; sincosf(li * step, &sn, &cs); const float abr = mag1 * cs, abi = mag1 * sn, den = lr * lr + li * li;
        cor[d * 64 + n] = ((abr - 1.f) * lr + abi * li) / den; coi[d * 64 + n] = (abi * lr - (abr - 1.f) * li) / den;
    }
    for (int i = tid; i < 1024; i += NTHREADS) {
        Cr[i] = c.in[I_S5CRE][((size_t)l * 16 + g) * 1024 + i]; Ci[i] = c.in[I_S5CIM][((size_t)l * 16 + g) * 1024 + i];
        Br[i] = c.in[I_S5BRE][((size_t)l * 16 + g) * 1024 + i]; Bi[i] = c.in[I_S5BIM][((size_t)l * 16 + g) * 1024 + i];
    }
    __syncthreads();
    for (int i = tid; i < 31 * 64; i += NTHREADS) {
        const int dd = i / 64 - 15, n = i & 63; float r, im;
        if (dd > 0) { const float pr = pwr[(0 * 17 + dd) * 64 + n], pi = pwi[(0 * 17 + dd) * 64 + n]; r = pr * cor[n] - pi * coi[n]; im = pr * coi[n] + pi * cor[n]; }
        else if (dd < 0) { const float pr = pwr[(1 * 17 - dd) * 64 + n], pi = pwi[(1 * 17 - dd) * 64 + n]; r = pr * cor[64 + n] - pi * coi[64 + n]; im = pr * coi[64 + n] + pi * cor[64 + n]; }
        else { r = cor[n] + cor[64 + n]; im = coi[n] + coi[64 + n]; }
        kr[i] = r; ki[i] = im;
    }
    __syncthreads();
    for (int i0 = tid; i0 < 31 * 32; i0 += NTHREADS) {
        const int ddi = i0 >> 5, h = 2 * part + ((i0 >> 4) & 1), hp = i0 & 15; float a = 0.f;
        for (int n = 0; n < 64; ++n) { const float cr = Cr[h * 64 + n], ci = Ci[h * 64 + n], xr = kr[ddi * 64 + n], xi = ki[ddi * 64 + n]; const float pr = cr * xr - ci * xi, pi = cr * xi + ci * xr; a += pr * Br[n * 16 + hp] - pi * Bi[n * 16 + hp]; }
        Kd[ddi * 256 + h * 16 + hp] = a;
    }
    __syncthreads();
    bf16_t* SX = c.wb(l) + WB_SX + (size_t)g * 256 * 256; bf16_t* SY = c.wb(l) + WB_SY + (size_t)g * 256 * 512;
    const float* dsk = c.in[I_S5D] + (size_t)l * 256 + g * 16;
    for (int u = tid; u < 32 * 64; u += NTHREADS) {
        const int i = u >> 7, h = 2 * part + ((u >> 6) & 1), o = i * 16 + h, kk0 = (u & 63) * 8; float v[8];
        if (kk0 < 256) { const int j = kk0 >> 4, hp0 = kk0 & 15;
#pragma unroll
            for (int e = 0; e < 8; ++e) v[e] = Kd[(i - j + 15) * 256 + h * 16 + hp0 + e] + ((i == j && h == hp0 + e) ? dsk[h] : 0.f);
        } else { const int q = kk0 - 256, d = q >> 7, part = (q >> 6) & 1, n0 = q & 63, ex = d == 0 ? i + 1 : 16 - i;
#pragma unroll
            for (int e = 0; e < 8; ++e) { const int n = n0 + e; const float cr = Cr[h * 64 + n], ci = Ci[h * 64 + n], pr = pwr[(d * 17 + ex) * 64 + n], pi = pwi[(d * 17 + ex) * 64 + n]; v[e] = part == 0 ? (cr * pr - ci * pi) : -(cr * pi + ci * pr); }
        }
        *(u32x4*)(SY + (size_t)o * 512 + kk0) = pack8(v);
    }
    for (int u = tid; u < 32 * 32; u += NTHREADS) {
        const int o = 32 * part + (u >> 5), kk0 = (u & 31) * 8, d = o >> 7, part = (o >> 6) & 1, n = o & 63, j = kk0 >> 4, hp0 = kk0 & 15, ex = d == 0 ? 15 - j : j;
        const float pr = pwr[(d * 17 + ex) * 64 + n], pi = pwi[(d * 17 + ex) * 64 + n], qr = pr * cor[d * 64 + n] - pi * coi[d * 64 + n], qi = pr * coi[d * 64 + n] + pi * cor[d * 64 + n];
        float v[8];
#pragma unroll
        for (int e = 0; e < 8; ++e) { const float br = Br[n * 16 + hp0 + e], bi = Bi[n * 16 + hp0 + e]; v[e] = part == 0 ? (qr * br - qi * bi) : (qr * bi + qi * br); }
        *(u32x4*)(SX + (size_t)o * 256 + kk0) = pack8(v);
    }
    __syncthreads();
}

__device__ __forceinline__ void phase0(const Ctx& cx_) {
    const Ctx c = relaunder(cx_);
    if (c.bid < 256) s5_build(c, c.bid >> 7, (c.bid >> 3) & 15, c.bid & 7);
    STAMP(13);
    const int gw = c.bid * NWAVES + c.wave, NGW = c.G * NWAVES, lane = c.lane;
    bf16_t* H = c.H(); float* ssq = c.ssq();
#pragma unroll 2
    for (int m = gw; m < MP; m += NGW) {
        u32x2* hp = (u32x2*)(H + (size_t)m * DM);
        if (m >= M_ROWS) {
#pragma unroll
            for (int i = 0; i < 4; ++i) hp[lane + 64 * i] = (u32x2){0u, 0u};
            continue;
        }
        int b, t; bt_of(m, b, t);
        const f32x4* src = (const f32x4*)(t < NMETA ? c.in[I_META] + (size_t)t * DM : c.in[I_X] + ((size_t)b * SEQ + (t - NMETA)) * DM);
        float ss = 0.f;
#pragma unroll
        for (int i = 0; i < 4; ++i) { const f32x4 v = src[lane + 64 * i]; ss += (v.x * v.x + v.y * v.y) + (v.z * v.z + v.w * v.w); hp[lane + 64 * i] = (u32x2){pk2(v.x, v.y), pk2(v.z, v.w)}; }
        ss = wave_sum(ss);
        if (lane < 16) ssq[(size_t)m * 16 + lane] = lane == 0 ? ss : 0.f;
    }
    STAMP(14);
    LAS float* scr = (LAS float*)(c.lds + c.wave * 8448);
    {
        TIt a; a.l = 0; a.j = 0; a.base = 0; a.gid = gw; get_tjob(c, 0, 0, a.t); tit_seek(c, a);
        float v[32], w[32];
        if (a.ok) tr_load(a.t, a.gid - a.base, lane, v);
        while (a.ok) {
            TIt b = a; b.gid += NGW; tit_seek(c, b);
            if (b.ok) tr_load(b.t, b.gid - b.base, lane, w);
            tr_store(a.t, scr, a.gid - a.base, lane, v);
            a = b;
#pragma unroll
            for (int i = 0; i < 32; ++i) v[i] = w[i];
        }
    }
    for (int l = 0; l < DEPTH; ++l) {
        bf16_t* wb = c.wb(l);
        const int gt = c.bid * NTHREADS + c.tid, NGT = c.G * NTHREADS;
        for (int u = gt; u < 128 * 64; u += NGT) *(u32x4*)(wb + WB_L1 + (size_t)384 * 512 + (size_t)u * 8) = (u32x4){0u, 0u, 0u, 0u};
        for (int u = gt; u < 5 * 256 * 4 * 8; u += NGT) {
            const int sub = u & 7, blk = (u >> 3) & 3, row = (u >> 5) & 255, tile = u >> 13;
            const bool nz = (tile == 0 || tile == 2) ? (blk == 0) : ((tile == 1 || tile == 3) ? (blk == 1) : (blk < 2));
            if (!nz) *(u32x4*)(wb + WB_L2 + ((size_t)tile * 256 + row) * 256 + blk * 64 + sub * 8) = (u32x4){0u, 0u, 0u, 0u};
        }
    }
}

__device__ __forceinline__ void dt_job(const Ctx& cx_, int l) {
    const Ctx c = relaunder(cx_);
    LAS float* dtw = (LAS float*)c.lds;
    const float* win = c.in[I_WIN] + (size_t)l * DM * N_IN; const float* nw = c.in[I_MIXNW] + l * DM;
    for (int i = c.tid; i < 8 * DM; i += NTHREADS) { const int k = i >> 3, j = i & 7; dtw[j * DM + k] = nw[k] * win[(size_t)k * N_IN + 1792 + j]; }
    __syncthreads();
    const int gw = c.bid * NWAVES + c.wave, NGW = c.G * NWAVES, lane = c.lane;
    const bf16_t* H = c.H(); float* dt = (float*)(c.ws + WS_DT); float* dec = (float*)(c.ws + WS_DEC);
    const float* dtb = c.in[I_DTB] + l * 16; const float* alog = c.in[I_ALOG] + l * 16;
#pragma unroll 2
    for (int m = gw; m < M_ROWS; m += NGW) {
        const u32x2* hp = (const u32x2*)(H + (size_t)m * DM);
        float ss = 0.f, d8[8] = {0.f, 0.f, 0.f, 0.f, 0.f, 0.f, 0.f, 0.f};
#pragma unroll
        for (int i = 0; i < 4; ++i) {
            const u32x2 w = hp[lane + 64 * i]; const float h0 = bflo(w.x), h1 = bfhi(w.x), h2 = bflo(w.y), h3 = bfhi(w.y);
            ss += (h0 * h0 + h1 * h1) + (h2 * h2 + h3 * h3);
#pragma unroll
            for (int j = 0; j < 8; ++j) { const f32x4 wv = *(const LAS f32x4*)(dtw + j * DM + 4 * lane + 256 * i); d8[j] += (h0 * wv.x + h1 * wv.y) + (h2 * wv.z + h3 * wv.w); }
        }
        ss = wave_sum(ss);
#pragma unroll
        for (int j = 0; j < 8; ++j) d8[j] = wave_sum(d8[j]);
        const float s = __builtin_amdgcn_rsqf(ss * (1.0f / DM) + EPS);
        if (lane < 16) {
            const int j = lane & 7; float raw = d8[0];
#pragma unroll
            for (int e = 1; e < 8; ++e) raw = (j == e) ? d8[e] : raw;
            const float dtv = softplusf_(raw * s + dtb[lane]);
            dt[(size_t)m * 16 + lane] = dtv; dec[(size_t)m * 16 + lane] = -dtv * __expf(alog[lane]);
        }
    }
    __syncthreads();
}

__device__ __forceinline__ void rwkv_prep(const Ctx& cx_, int l) {
    const Ctx c = relaunder(cx_);
    const int gw = c.bid * NWAVES + c.wave, NGW = c.G * NWAVES, lane = c.lane, c0 = 4 * lane;
    const bf16_t* __restrict__ P = (const bf16_t*)(c.ws + WS_PRKVX); bf16_t* __restrict__ rk = (bf16_t*)(c.dout + DO_RKVP); bf16_t* __restrict__ l1 = (bf16_t*)(c.ws + WS_L1IN);
    float mu[3][4], kkw[4];
#pragma unroll
    for (int x = 0; x < 3; ++x)
#pragma unroll
        for (int e = 0; e < 4; ++e) mu[x][e] = c.in[I_MURKV][((size_t)l * 3 + x) * 256 + c0 + e];
#pragma unroll
    for (int e = 0; e < 4; ++e) kkw[e] = c.in[I_KK][(size_t)l * 256 + c0 + e];
#pragma unroll 4
    for (int m = gw; m < M_ROWS; m += NGW) {
        int b, t; bt_of(m, b, t); const bool hp = t > 0, hn = t < LEN - 1; const size_t mp_ = hp ? row_of(b, t - 1) : 0, mn_ = hn ? row_of(b, t + 1) : 0;
        float o[4][4];
        float xc[4], dxc[4];
#pragma unroll
        for (int x = 0; x < 4; ++x) {
            const u32x2 wc_ = *(const u32x2*)(P + (size_t)m * 1024 + x * 256 + c0);
            u32x2 wp = (u32x2){0u, 0u}, wn = (u32x2){0u, 0u};
            if (hp) wp = *(const u32x2*)(P + mp_ * 1024 + x * 256 + c0);
            if (hn) wn = *(const u32x2*)(P + mn_ * 1024 + x * 256 + c0);
            const float cur[4] = {bflo(wc_.x), bfhi(wc_.x), bflo(wc_.y), bfhi(wc_.y)}, pv[4] = {bflo(wp.x), bfhi(wp.x), bflo(wp.y), bfhi(wp.y)}, nv[4] = {bflo(wn.x), bfhi(wn.x), bflo(wn.y), bfhi(wn.y)};
#pragma unroll
            for (int e = 0; e < 4; ++e) { const float cs = 0.5f * (pv[e] + nv[e]) - cur[e]; if (x < 3) o[x][e] = cur[e] + cs * mu[x][e]; else { xc[e] = cur[e]; dxc[e] = cs; } }
        }
        float kr_[4], ss = 0.f;
#pragma unroll
        for (int e = 0; e < 4; ++e) { kr_[e] = o[1][e] * kkw[e]; ss += kr_[e] * kr_[e]; }
        ss = sum16(ss); const float rn = __builtin_amdgcn_rsqf(ss + 1e-12f);
        bf16_t* rp = rk + (size_t)m * 1024 + c0;
        *(u32x2*)(rp) = (u32x2){pk2(o[0][0], o[0][1]), pk2(o[0][2], o[0][3])};
        *(u32x2*)(rp + 256) = (u32x2){pk2(o[1][0], o[1][1]), pk2(o[1][2], o[1][3])};
        *(u32x2*)(rp + 512) = (u32x2){pk2(o[2][0], o[2][1]), pk2(o[2][2], o[2][3])};
        *(u32x2*)(rp + 768) = (u32x2){pk2(kr_[0] * rn, kr_[1] * rn), pk2(kr_[2] * rn, kr_[3] * rn)};
        bf16_t* lp = l1 + (size_t)m * 512 + c0;
        *(u32x2*)(lp) = (u32x2){pk2(xc[0], xc[1]), pk2(xc[2], xc[3])};
        *(u32x2*)(lp + 256) = (u32x2){pk2(dxc[0], dxc[1]), pk2(dxc[2], dxc[3])};
    }
}
__device__ __forceinline__ void ssd_prep(const Ctx& cx_, int l) {
    const Ctx c = relaunder(cx_);
    const int gw = c.bid * NWAVES + c.wave, NGW = c.G * NWAVES, lane = c.lane, c0 = 16 * lane;
    const bf16_t* __restrict__ P = (const bf16_t*)(c.ws + WS_PXBC); bf16_t* __restrict__ xs = (bf16_t*)(c.ws + WS_XS); bf16_t* __restrict__ bc = (bf16_t*)(c.ws + WS_BC);
    float w[5][16], bias[16];
#pragma unroll
    for (int j = 0; j < 5; ++j)
#pragma unroll
        for (int e = 0; e < 16; ++e) w[j][e] = c.in[I_CONVW][((size_t)l * 5 + j) * 1024 + c0 + e];
#pragma unroll
    for (int e = 0; e < 16; ++e) bias[e] = c.in[I_CONVB][(size_t)l * 1024 + c0 + e];
#pragma unroll 2
    for (int m = gw; m < M_ROWS; m += NGW) {
        int b, t; bt_of(m, b, t);
        float a[16];
#pragma unroll
        for (int e = 0; e < 16; ++e) a[e] = bias[e];
#pragma unroll
        for (int j = 0; j < 5; ++j) {
            const int tt = t + j - 2;
            if (tt >= 0 && tt < LEN) {
                const u32x4* p = (const u32x4*)(P + (size_t)row_of(b, tt) * 1024 + c0); float f0[8], f1[8]; unpack8(p[0], f0); unpack8(p[1], f1);
#pragma unroll
                for (int e = 0; e < 8; ++e) { a[e] += w[j][e] * f0[e]; a[8 + e] += w[j][8 + e] * f1[e]; }
            }
        }
        float o0[8], o1[8];
#pragma unroll
        for (int e = 0; e < 8; ++e) { o0[e] = siluf_(a[e]); o1[e] = siluf_(a[8 + e]); }
        bf16_t* dst = lane < 32 ? xs + (size_t)m * 512 + c0 : bc + (size_t)m * 512 + (c0 - 512);
        ((u32x4*)dst)[0] = pack8(o0); ((u32x4*)dst)[1] = pack8(o1);
    }
}

__device__ __forceinline__ void s5_scan(const Ctx& cx_, int l) {
    const Ctx c = relaunder(cx_);
    const int gt = c.bid * 64 + c.lane; if (c.bid >= 256) return;
    const int n = gt & 63, d = (gt >> 6) & 1, b = (gt >> 7) & 7, g = gt >> 10, seg = c.wave, i0 = 33 * seg;
    const size_t li_ = (((size_t)l * 2 + d) * 16 + g) * 64 + n;
    const float lr = c.in[I_S5LRE][li_], li = c.in[I_S5LIM][li_], step = expf(c.in[I_S5LS][((size_t)l * 2 + d) * 16 + g]);
    const float mag = expf(16.f * lr * step); float sn, cs; sincosf(16.f * li * step, &sn, &cs); const float ar = mag * cs, ai = mag * sn;
    const float* __restrict__ X = (const float*)(c.ws + WS_X) + ((size_t)g * S5RP + (size_t)b * NCH16) * 256 + d * 128 + n;
    bf16_t* __restrict__ U = (bf16_t*)(c.ws + WS_UH) + ((size_t)g * S5RP + (size_t)b * NCH16) * 512 + 256 + d * 128 + n;
    LAS float* tot = (LAS float*)c.lds;
    float xr[33], xi[33];
#pragma unroll
    for (int k = 0; k < 33; ++k) { const int i = i0 + k; const int ch = d == 0 ? i : NCH16 - 1 - i; const bool ok = i < NCH16; xr[k] = ok ? X[(size_t)ch * 256] : 0.f; xi[k] = ok ? X[(size_t)ch * 256 + 64] : 0.f; }
    float hr = 0.f, hi = 0.f, pr = 1.f, pi = 0.f;
#pragma unroll
    for (int k = 0; k < 33; ++k) {
        const float nr = ar * hr - ai * hi + xr[k], ni = ar * hi + ai * hr + xi[k]; hr = nr; hi = ni;
        const float qr = pr * ar - pi * ai, qi = pr * ai + pi * ar; pr = qr; pi = qi;
    }
    __syncthreads();
    tot[(seg * 2 + 0) * 64 + c.lane] = hr; tot[(seg * 2 + 1) * 64 + c.lane] = hi;
    __syncthreads();
    hr = 0.f; hi = 0.f;
    for (int s = 0; s < seg; ++s) { const float tr = tot[(s * 2 + 0) * 64 + c.lane], ti = tot[(s * 2 + 1) * 64 + c.lane]; const float nr = pr * hr - pi * hi + tr, ni = pr * hi + pi * hr + ti; hr = nr; hi = ni; }
#pragma unroll
    for (int k = 0; k < 33; ++k) { const int i = i0 + k;
        if (i < NCH16) { const int ch = d == 0 ? i : NCH16 - 1 - i; U[(size_t)ch * 512] = (bf16_t)f2bf(hr); U[(size_t)ch * 512 + 64] = (bf16_t)f2bf(hi); }
        const float nr = ar * hr - ai * hi + xr[k], ni = ar * hi + ai * hr + xi[k]; hr = nr; hi = ni; }
    __syncthreads();
}
typedef short s16x4 __attribute__((ext_vector_type(4)));
__device__ __forceinline__ s16x4 lds_tr(const LAS unsigned char* p) { return __builtin_bit_cast(s16x4, __builtin_amdgcn_ds_read_tr16_b64_v4i16((LAS s16x4*)p)); }
__device__ __forceinline__ bf16x8 frag_tr(const LAS unsigned char* img, int rs, int kbase, int colbase, int lane) {
    const LAS unsigned char* a = img + (kbase + 8 * (lane >> 4) + ((lane & 15) >> 2)) * rs + (colbase + 4 * (lane & 3)) * 2;
    const s16x4 lo = lds_tr(a), hi = lds_tr(a + 4 * rs);
    return (bf16x8){lo[0], lo[1], lo[2], lo[3], hi[0], hi[1], hi[2], hi[3]};
}
__device__ __forceinline__ bf16x8 frag_row(const LAS unsigned char* img, int rs, int rowbase, int kbase, int lane) {
    return *(const LAS bf16x8*)(img + (rowbase + (lane & 15)) * rs + (kbase + 8 * (lane >> 4)) * 2);
}
constexpr int SD_RS = 272;
constexpr int SD_XRS = 144;
constexpr int SD_OFF_C = 0, SD_OFF_B = 34816, SD_OFF_X = 69632, SD_OFF_M = 88064, SD_OFF_SC = 122880;
constexpr int SD_OFF_HF = SD_OFF_B, SD_OFF_HB = SD_OFF_B + 17408;
constexpr size_t WS_STB = WS_YSSD;
constexpr size_t WS_CDEC = WS_DEC + (size_t)MP * 64 + 256;
constexpr size_t WS_SSQB = WS_CDEC + (size_t)BATCH * 33 * 16 * 4;
constexpr size_t WS_BAR = (WS_SSQB + (size_t)MP * 8 + 255) / 256 * 256;
static_assert(WS_BAR + 3456 * 4 <= 7 * QB, "small region");
static_assert((size_t)BATCH * 2 * 8 * 32 * 8192 * 2 <= 4 * QB, "chunk states fit the yssd slot");

struct SsdUnit { int b, ck, t0, ns; };
__device__ __forceinline__ bool ssd_unit(int bid, int round, SsdUnit& u) {
    if (round == 0) { u.b = bid >> 5; u.ck = 1 + (bid & 31); u.t0 = NMETA + 128 * (u.ck - 1); u.ns = 8; return true; }
    if (round == 1 && bid < BATCH) { u.b = bid; u.ck = 0; u.t0 = 0; u.ns = 1; return true; }
    return false;
}
__device__ __forceinline__ void ssd_load_img(LAS unsigned char* img, int rs, const bf16_t* src, int ld, size_t m0, int col0, int ncol, int ns, int tid) {
    const int cpr = ncol / 8, nrow = ns == 1 ? 32 : 128;
    for (int i = tid; i < nrow * cpr; i += NTHREADS) {
        const int r = i / cpr, cc = i - r * cpr; u32x4 v = (u32x4){0u, 0u, 0u, 0u};
        if (r < 16 * ns) v = *(const u32x4*)(src + (m0 + r) * ld + col0 + cc * 8);
        *(LAS u32x4*)(img + r * rs + cc * 16) = v;
    }
}
__device__ __forceinline__ void ssd_scalars(LAS float* sc, const float* dt, const float* al, size_t m0, int head, int ns, int lane, float& totf, float& totb) {
    const int Q = 16 * ns;
    float a0f = 0.f, a1f = 0.f, a0b = 0.f, a1b = 0.f, d0f = 0.f, d1f = 0.f, d0b = 0.f, d1b = 0.f;
    const int s0 = 2 * lane, s1 = 2 * lane + 1;
    if (s0 < Q) { a0f = al[(m0 + s0) * 16 + head]; a0b = al[(m0 + s0) * 16 + 8 + head]; d0f = dt[(m0 + s0) * 16 + head]; d0b = dt[(m0 + s0) * 16 + 8 + head]; }
    if (s1 < Q) { a1f = al[(m0 + s1) * 16 + head]; a1b = al[(m0 + s1) * 16 + 8 + head]; d1f = dt[(m0 + s1) * 16 + head]; d1b = dt[(m0 + s1) * 16 + 8 + head]; }
    float pf = a0f + a1f, pb = a0b + a1b;
#pragma unroll
    for (int o = 1; o < 64; o <<= 1) { const float tf = __shfl_up(pf, o), tb = __shfl_up(pb, o); if (lane >= o) { pf += tf; pb += tb; } }
    totf = __shfl(pf, 63); totb = __shfl(pb, 63);
    const float af1 = pf, af0 = pf - a1f;
    const float eb0 = pb - a0b - a1b, eb1 = pb - a1b;
    sc[s0] = af0; sc[s1] = af1; sc[128 + s0] = eb0; sc[128 + s1] = eb1; sc[256 + s0] = d0f; sc[256 + s1] = d1f; sc[384 + s0] = d0b; sc[384 + s1] = d1b;
    sc[512 + s0] = __expf(totf - af0) * d0f; sc[512 + s1] = __expf(totf - af1) * d1f;
    sc[640 + s0] = __expf(eb0) * d0b; sc[640 + s1] = __expf(eb1) * d1b;
    sc[768 + s0] = __expf(af0); sc[768 + s1] = __expf(af1);
    sc[896 + s0] = __expf(totb - eb0); sc[896 + s1] = __expf(totb - eb1);
}

__device__ __forceinline__ void ssd_states(const Ctx& cx_, int l) {
    const Ctx c = relaunder(cx_);
    const int tid = c.tid, lane = c.lane, wave = c.wave;
    const bf16_t* bc = (const bf16_t*)(c.ws + WS_BC); const bf16_t* xs = (const bf16_t*)(c.ws + WS_XS);
    const float* dt = (const float*)(c.ws + WS_DT); const float* al = (const float*)(c.ws + WS_DEC);
    bf16_t* stb = (bf16_t*)(c.ws + WS_STB); float* cdec = (float*)(c.ws + WS_CDEC);
    LAS unsigned char* Bimg = c.lds + SD_OFF_B; LAS unsigned char* Ximg = c.lds + SD_OFF_X; LAS float* sc = (LAS float*)(c.lds + SD_OFF_SC);
    for (int round = 0; round < 2; ++round) {
        SsdUnit u; if (!ssd_unit(c.bid, round, u)) break;
        const size_t m0 = (size_t)row_of(u.b, u.t0); const int nks = u.ns == 1 ? 1 : 4;
        for (int g = 0; g < 2; ++g) {
            __syncthreads();
            ssd_load_img(Bimg, SD_RS, bc, 512, m0, g * 128, 128, u.ns, tid);
            for (int j = 0; j < 4; ++j) {
                const int head = g * 4 + j;
                if (j) __syncthreads();
                ssd_load_img(Ximg, SD_XRS, xs, 512, m0, head * 64, 64, u.ns, tid);
                if (wave == 0) { float totf, totb; ssd_scalars(sc, dt, al, m0, head, u.ns, lane, totf, totb);
                    if (lane == 0) { cdec[((size_t)u.b * 33 + u.ck) * 16 + head] = __expf(totf); cdec[((size_t)u.b * 33 + u.ck) * 16 + 8 + head] = __expf(totb); } }
                __syncthreads();
                f32x4 accf[4], accb[4];
#pragma unroll
                for (int pt = 0; pt < 4; ++pt) { accf[pt] = (f32x4){0.f, 0.f, 0.f, 0.f}; accb[pt] = accf[pt]; }
                for (int ks = 0; ks < nks; ++ks) {
                    const bf16x8 af = frag_tr(Bimg, SD_RS, 32 * ks, 16 * wave, lane);
                    const int k0 = 32 * ks + 8 * (lane >> 4);
                    const f32x4 wf0 = *(const LAS f32x4*)(sc + 512 + k0), wf1 = *(const LAS f32x4*)(sc + 512 + k0 + 4), wb0 = *(const LAS f32x4*)(sc + 640 + k0), wb1 = *(const LAS f32x4*)(sc + 640 + k0 + 4);
#pragma unroll
                    for (int pt = 0; pt < 4; ++pt) {
                        const bf16x8 xr = frag_tr(Ximg, SD_XRS, 32 * ks, 16 * pt, lane);
                        float xf[8];
#pragma unroll
                        for (int e = 0; e < 8; ++e) xf[e] = bf1((bf16_t)xr[e]);
                        bf16x8 bfv, bbv;
                        { const unsigned p0 = pk2(xf[0] * wf0.x, xf[1] * wf0.y), p1 = pk2(xf[2] * wf0.z, xf[3] * wf0.w), p2 = pk2(xf[4] * wf1.x, xf[5] * wf1.y), p3 = pk2(xf[6] * wf1.z, xf[7] * wf1.w);
                          bfv = __builtin_bit_cast(bf16x8, (u32x4){p0, p1, p2, p3}); }
                        { const unsigned p0 = pk2(xf[0] * wb0.x, xf[1] * wb0.y), p1 = pk2(xf[2] * wb0.z, xf[3] * wb0.w), p2 = pk2(xf[4] * wb1.x, xf[5] * wb1.y), p3 = pk2(xf[6] * wb1.z, xf[7] * wb1.w);
                          bbv = __builtin_bit_cast(bf16x8, (u32x4){p0, p1, p2, p3}); }
                        accf[pt] = __builtin_amdgcn_mfma_f32_16x16x32_bf16(af, bfv, accf[pt], 0, 0, 0);
                        accb[pt] = __builtin_amdgcn_mfma_f32_16x16x32_bf16(af, bbv, accb[pt], 0, 0, 0);
                    }
                }
#pragma unroll
                for (int pt = 0; pt < 4; ++pt) {
                    const int p = 16 * pt + (lane & 15), n0 = 16 * wave + 4 * (lane >> 4);
                    if (u.ck <= 31) { bf16_t* d = stb + ((((size_t)u.b * 2 + 0) * 8 + head) * 32 + u.ck) * 8192 + (size_t)p * 128 + n0; *(u32x2*)d = (u32x2){pk2(accf[pt][0], accf[pt][1]), pk2(accf[pt][2], accf[pt][3])}; }
                    if (u.ck >= 1) { bf16_t* d = stb + ((((size_t)u.b * 2 + 1) * 8 + head) * 32 + (u.ck - 1)) * 8192 + (size_t)p * 128 + n0; *(u32x2*)d = (u32x2){pk2(accb[pt][0], accb[pt][1]), pk2(accb[pt][2], accb[pt][3])}; }
                }
            }
        }
    }
    __syncthreads();
}

__device__ __forceinline__ void ssd_chunk_scan(const Ctx& cx_, int l) {
    const Ctx c = relaunder(cx_);
    bf16_t* stb = (bf16_t*)(c.ws + WS_STB); const float* cdec = (const float*)(c.ws + WS_CDEC);
    const int gt = c.bid * NTHREADS + c.tid;
    const int e8 = gt & 1023, bdh = gt >> 10;
    if (bdh >= BATCH * 16) return;
    const int head = bdh & 7, dir = (bdh >> 3) & 1, b = bdh >> 4;
    bf16_t* base = stb + (size_t)bdh * 32 * 8192 + (size_t)e8 * 8;
    float h[8] = {0.f, 0.f, 0.f, 0.f, 0.f, 0.f, 0.f, 0.f};
    for (int i0 = 0; i0 < 32; i0 += 8) {
        u32x4 v[8]; float dcy[8];
#pragma unroll
        for (int k = 0; k < 8; ++k) { const int slot = dir == 0 ? i0 + k : 31 - (i0 + k); v[k] = *(const u32x4*)(base + (size_t)slot * 8192);
            const int ck = dir == 0 ? slot : slot + 1; dcy[k] = cdec[((size_t)b * 33 + ck) * 16 + dir * 8 + head]; }
#pragma unroll
        for (int k = 0; k < 8; ++k) { const int slot = dir == 0 ? i0 + k : 31 - (i0 + k); float s[8]; unpack8(v[k], s);
#pragma unroll
            for (int e = 0; e < 8; ++e) h[e] = h[e] * dcy[k] + s[e];
            *(u32x4*)(base + (size_t)slot * 8192) = pack8(h); }
    }
}

__device__ __forceinline__ bool ssd_unit_n(int idx, int nblk, int round, SsdUnit& u, int& grp) {
    const int n2 = idx + nblk * round; if (n2 >= 528) return false; const int n = n2 >> 1; grp = n2 & 1;
    if (n < 256) { u.b = n >> 5; u.ck = 1 + (n & 31); u.t0 = NMETA + 128 * (u.ck - 1); u.ns = 8; } else { u.b = n - 256; u.ck = 0; u.t0 = 0; u.ns = 1; }
    return true;
}
__device__ __forceinline__ void ssd_outputs(const Ctx& cx_, int l, int first, int nblk) {
    const Ctx c = relaunder(cx_);
    const int tid = c.tid, lane = c.lane, wave = c.wave;
    const bf16_t* bc = (const bf16_t*)(c.ws + WS_BC); const bf16_t* xs = (const bf16_t*)(c.ws + WS_XS); const bf16_t* pz = (const bf16_t*)(c.ws + WS_PZ);
    const float* dt = (const float*)(c.ws + WS_DT); const float* al = (const float*)(c.ws + WS_DEC);
    const bf16_t* stb = (const bf16_t*)(c.ws + WS_STB); bf16_t* yb = (bf16_t*)(c.ws + WS_YB); float* ssqb = (float*)(c.ws + WS_SSQB);
    LAS unsigned char* Cimg = c.lds + SD_OFF_C; LAS unsigned char* Bimg = c.lds + SD_OFF_B; LAS unsigned char* Ximg = c.lds + SD_OFF_X;
    LAS unsigned char* HfT = c.lds + SD_OFF_HF; LAS unsigned char* HbT = c.lds + SD_OFF_HB;
    LAS unsigned char* Ms = c.lds + SD_OFF_M + wave * 4352; LAS float* sc = (LAS float*)(c.lds + SD_OFF_SC);
    for (int round = 0; round < 8; ++round) {
        SsdUnit u; int g0; if (!ssd_unit_n(c.bid - first, nblk, round, u, g0)) break;
        const size_t m0 = (size_t)row_of(u.b, u.t0); const int nks = u.ns == 1 ? 1 : 4; const bool active = wave < u.ns;
        float ssrow = 0.f;
        for (int g = g0; g <= g0; ++g) {
            __syncthreads();
            ssd_load_img(Cimg, SD_RS, bc, 512, m0, 256 + g * 128, 128, u.ns, tid);
            ssd_load_img(Bimg, SD_RS, bc, 512, m0, g * 128, 128, u.ns, tid);
            __syncthreads();
            f32x4 cb[8];
#pragma unroll
            for (int t = 0; t < 8; ++t) cb[t] = (f32x4){0.f, 0.f, 0.f, 0.f};
            if (active) {
#pragma unroll
                for (int ks = 0; ks < 4; ++ks) {
                    const bf16x8 cfr = frag_row(Cimg, SD_RS, 16 * wave, 32 * ks, lane);
#pragma unroll
                    for (int t = 0; t < 8; ++t) if (t < u.ns) cb[t] = __builtin_amdgcn_mfma_f32_16x16x32_bf16(frag_row(Bimg, SD_RS, 16 * t, 32 * ks, lane), cfr, cb[t], 0, 0, 0);
                }
            }
            for (int j = 0; j < 4; ++j) {
                const int head = g * 4 + j;
                __syncthreads();
                ssd_load_img(Ximg, SD_XRS, xs, 512, m0, head * 64, 64, u.ns, tid);
                {
                    const bf16_t* hf = u.ck >= 1 ? stb + ((((size_t)u.b * 2 + 0) * 8 + head) * 32 + (u.ck - 1)) * 8192 : nullptr;
                    const bf16_t* hb = u.ck <= 31 ? stb + ((((size_t)u.b * 2 + 1) * 8 + head) * 32 + u.ck) * 8192 : nullptr;
                    for (int i = tid; i < 64 * 16; i += NTHREADS) { const int p = i >> 4, cc = i & 15;
                        *(LAS u32x4*)(HfT + p * SD_RS + cc * 16) = hf ? *(const u32x4*)(hf + p * 128 + cc * 8) : (u32x4){0u, 0u, 0u, 0u};
                        *(LAS u32x4*)(HbT + p * SD_RS + cc * 16) = hb ? *(const u32x4*)(hb + p * 128 + cc * 8) : (u32x4){0u, 0u, 0u, 0u}; }
                }
                if (wave == 0) { float totf, totb; ssd_scalars(sc, dt, al, m0, head, u.ns, lane, totf, totb); }
                __syncthreads();
                if (active) {
                    const int ll = 16 * wave + (lane & 15); const float afl = sc[ll], ebl = sc[128 + ll];
#pragma unroll
                    for (int t = 0; t < 8; ++t) {
                        u32x2 w2 = (u32x2){0u, 0u};
                        if (t < u.ns) {
                            const int s0 = 16 * t + 4 * (lane >> 4);
                            const f32x4 afs = *(const LAS f32x4*)(sc + s0), ebs = *(const LAS f32x4*)(sc + 128 + s0), dfs = *(const LAS f32x4*)(sc + 256 + s0), dbs = *(const LAS f32x4*)(sc + 384 + s0);
                            float mv[4];
#pragma unroll
                            for (int r = 0; r < 4; ++r) { const int s = s0 + r; float wgt = 0.f; if (s <= ll) wgt += __expf(afl - afs[r]) * dfs[r]; if (s >= ll) wgt += __expf(ebs[r] - ebl) * dbs[r]; mv[r] = cb[t][r] * wgt; }
                            w2 = (u32x2){pk2(mv[0], mv[1]), pk2(mv[2], mv[3])};
                        }
                        if (t < 2 * nks) *(LAS u32x2*)(Ms + (lane & 15) * SD_RS + (16 * t + 4 * (lane >> 4)) * 2) = w2;
                    }
                    asm volatile("s_waitcnt lgkmcnt(0)" ::: "memory");
                    f32x4 ay[4], ahf[4], ahb[4];
#pragma unroll
                    for (int pt = 0; pt < 4; ++pt) { ay[pt] = (f32x4){0.f, 0.f, 0.f, 0.f}; ahf[pt] = ay[pt]; ahb[pt] = ay[pt]; }
                    for (int ks = 0; ks < nks; ++ks) {
                        const bf16x8 mf = frag_row(Ms, SD_RS, 0, 32 * ks, lane);
#pragma unroll
                        for (int pt = 0; pt < 4; ++pt) ay[pt] = __builtin_amdgcn_mfma_f32_16x16x32_bf16(mf, frag_tr(Ximg, SD_XRS, 32 * ks, 16 * pt, lane), ay[pt], 0, 0, 0);
                    }
#pragma unroll
                    for (int ks = 0; ks < 4; ++ks) {
                        const bf16x8 cfr = frag_row(Cimg, SD_RS, 16 * wave, 32 * ks, lane);
#pragma unroll
                        for (int pt = 0; pt < 4; ++pt) {
                            ahf[pt] = __builtin_amdgcn_mfma_f32_16x16x32_bf16(cfr, frag_row(HfT, SD_RS, 16 * pt, 32 * ks, lane), ahf[pt], 0, 0, 0);
                            ahb[pt] = __builtin_amdgcn_mfma_f32_16x16x32_bf16(cfr, frag_row(HbT, SD_RS, 16 * pt, 32 * ks, lane), ahb[pt], 0, 0, 0);
                        }
                    }
                    const int l0 = 16 * wave + 4 * (lane >> 4);
                    const f32x4 efv = *(const LAS f32x4*)(sc + 768 + l0), ebv = *(const LAS f32x4*)(sc + 896 + l0);
                    asm volatile("s_waitcnt lgkmcnt(0)" ::: "memory");
                    LAS float* ys = (LAS float*)Ms;
#pragma unroll
                    for (int pt = 0; pt < 4; ++pt)
#pragma unroll
                        for (int r = 0; r < 4; ++r) ys[(4 * (lane >> 4) + r) * 68 + 16 * pt + (lane & 15)] = ay[pt][r] + efv[r] * ahf[pt][r] + ebv[r] * ahb[pt][r];
                    asm volatile("s_waitcnt lgkmcnt(0)" ::: "memory");
                    const int rr = lane >> 2, p0 = 16 * (lane & 3); const size_t m = m0 + 16 * wave + rr;
                    const float dsk = c.in[I_SSDD][l * 8 + head];
                    float xv[16], zv[16];
                    { float t8[8]; unpack8(*(const LAS u32x4*)(Ximg + (16 * wave + rr) * SD_XRS + p0 * 2), t8);
#pragma unroll
                      for (int e = 0; e < 8; ++e) xv[e] = t8[e];
                      unpack8(*(const LAS u32x4*)(Ximg + (16 * wave + rr) * SD_XRS + p0 * 2 + 16), t8);
#pragma unroll
                      for (int e = 0; e < 8; ++e) xv[8 + e] = t8[e];
                      unpack8(*(const u32x4*)(pz + m * 512 + head * 64 + p0), t8);
#pragma unroll
                      for (int e = 0; e < 8; ++e) zv[e] = t8[e];
                      unpack8(*(const u32x4*)(pz + m * 512 + head * 64 + p0 + 8), t8);
#pragma unroll
                      for (int e = 0; e < 8; ++e) zv[8 + e] = t8[e]; }
                    float o[16];
#pragma unroll
                    for (int e4 = 0; e4 < 4; ++e4) { const f32x4 yv = *(const LAS f32x4*)(ys + rr * 68 + p0 + 4 * e4);
#pragma unroll
                        for (int e = 0; e < 4; ++e) { const float val = (yv[e] + dsk * xv[4 * e4 + e]) * siluf_(zv[4 * e4 + e]); o[4 * e4 + e] = val; ssrow += val * val; } }
                    u32x4 w0, w1; w0.x = pk2(o[0], o[1]); w0.y = pk2(o[2], o[3]); w0.z = pk2(o[4], o[5]); w0.w = pk2(o[6], o[7]); w1.x = pk2(o[8], o[9]); w1.y = pk2(o[10], o[11]); w1.z = pk2(o[12], o[13]); w1.w = pk2(o[14], o[15]);
                    *(u32x4*)(yb + m * 512 + head * 64 + p0) = w0; *(u32x4*)(yb + m * 512 + head * 64 + p0 + 8) = w1;
                }
            }
        }
        if (active) { ssrow += dpp_mov<0xB1>(ssrow); ssrow += dpp_mov<0x4E>(ssrow); if ((lane & 3) == 0) ssqb[(m0 + 16 * wave + (lane >> 2)) * 2 + g0] = ssrow; }
    }
    __syncthreads();
}
typedef short s16x4v __attribute__((ext_vector_type(4)));
constexpr int RC_NCH = LEN / 16;
constexpr int RC_NP = 5;
constexpr int RC_ROUNDS = (RC_NCH + RC_NP - 1) / RC_NP;
constexpr int RC_S64 = 144;
constexpr int RC_S16 = 40;
constexpr int RC_AT = 0, RC_RT = 2304, RC_BH = 4608, RC_KH = 6912, RC_T = 9216, RC_AAK = 9856, RC_ARB = 10496, RC_ARK = 11136, RC_VT = 11776, RC_P16 = 12416, RC_SLOT = 12800;
constexpr int RC_SCR0 = 2 * RC_NP * RC_SLOT;
constexpr int RC_SCR = 1280;
static_assert(RC_SCR0 + RC_NP * RC_SCR <= 147456 - 512, "rwkv chunk LDS");
__device__ __forceinline__ f32x4 mm16(s16x4v a, s16x4v b, f32x4 c, int, int, int) { return __builtin_amdgcn_mfma_f32_16x16x32_bf16((bf16x8){a[0], a[1], a[2], a[3], 0, 0, 0, 0}, (bf16x8){b[0], b[1], b[2], b[3], 0, 0, 0, 0}, c, 0, 0, 0); }
__device__ __forceinline__ s16x4v mfma16_frag(const LAS unsigned char* mat, int row, int q) { return *(const LAS s16x4v*)(mat + row * RC_S16 + q * 8); }

constexpr int RC64_NP = 4, RC64_ROUNDS = (RC_NCH + RC64_NP - 1) / RC64_NP;
constexpr int RC64_V = 11776, RC64_P16 = 14080, RC64_SLOT = 14336;
constexpr int RC64_SCR0 = 2 * RC64_NP * RC64_SLOT;
static_assert(RC64_SCR0 + RC64_NP * RC_SCR <= 147456 - 512, "rwkv64 LDS");
__device__ __forceinline__ void rwkv_chunked64(const Ctx& cx_, int l) {
    const Ctx c = relaunder(cx_);


    const int bid = c.bid, dir = bid & 1, head = (bid >> 1) & 3, b = bid >> 3;
    const int lane = c.lane, wave = c.wave;
    const bf16_t* rk = (const bf16_t*)(c.dout + DO_RKVP) + head * 64; const bf16_t* l2 = (const bf16_t*)(c.ws + WS_L2O) + dir * 256 + head * 64;
    bf16_t* yo = (bf16_t*)(c.ws + WS_YRW) + (size_t)dir * MP * 256 + head * 64 + 16 * (wave & 3);
    auto tok = [&](int s) -> size_t { const int t = s + dir * (LEN - 1 - 2 * s); return (size_t)row_of(b, t); };
    const int q = lane >> 4, li = lane & 15;
    u32x4 Rr[2], Kr[2], KKr[2], DLr[2], ASr[2], Vr[2];
    auto load_raw = [&](int ch) {
        const size_t m = tok(16 * ch + li); const int k0 = 16 * q;
#pragma unroll
        for (int h = 0; h < 2; ++h) { Rr[h] = *(const u32x4*)(rk + m * 1024 + k0 + 8 * h); Kr[h] = *(const u32x4*)(rk + m * 1024 + 256 + k0 + 8 * h); KKr[h] = *(const u32x4*)(rk + m * 1024 + 768 + k0 + 8 * h);
            DLr[h] = *(const u32x4*)(l2 + m * 1280 + k0 + 8 * h); ASr[h] = *(const u32x4*)(l2 + m * 1280 + 512 + k0 + 8 * h); Vr[h] = *(const u32x4*)(rk + m * 1024 + 512 + k0 + 8 * h); }
    };
    float kaall[16];
#pragma unroll
    for (int e = 0; e < 16; ++e) kaall[e] = c.in[I_KA][(size_t)l * 256 + head * 64 + 16 * q + e];
    auto produce = [&](int slot) {
        LAS unsigned char* sb = c.lds + slot * RC64_SLOT; LAS float* Aab = (LAS float*)(c.lds + RC64_SCR0 + (wave - 4) * RC_SCR);
        LAS unsigned char* Bh = sb + RC_BH; LAS unsigned char* Kh = sb + RC_KH;
        *(LAS u32x4*)(sb + RC64_V + li * RC_S64 + (16 * q) * 2) = Vr[0]; *(LAS u32x4*)(sb + RC64_V + li * RC_S64 + (16 * q + 8) * 2) = Vr[1];
        const int k0 = 16 * q;
#pragma unroll
        for (int h = 0; h < 2; ++h) {
            float r_[8], k_[8], kk_[8], dl_[8], as_[8], cs_[8]; unpack8(Rr[h], r_); unpack8(Kr[h], k_); unpack8(KKr[h], kk_); unpack8(DLr[h], dl_); unpack8(ASr[h], as_);
            const float* ka = kaall + 8 * h;
            float at_[8], rt_[8], bh_[8], kh_[8], p_[8];
#pragma unroll
            for (int e = 0; e < 8; ++e) {
                float x = dl_[e];
                x += dpp_mov<0x111>(x); x += dpp_mov<0x112>(x); x += dpp_mov<0x114>(x); x += dpp_mov<0x118>(x);
                cs_[e] = x;
            }
#pragma unroll
            for (int e = 0; e < 8; ++e) {
                const float P = __expf(cs_[e]), Pm = __expf(cs_[e] - dl_[e]), iP = __expf(-cs_[e]);
                at_[e] = -kk_[e] * Pm; rt_[e] = r_[e] * P; bh_[e] = kk_[e] * as_[e] * iP; kh_[e] = k_[e] * (1.f + (as_[e] - 1.f) * ka[e]) * iP; p_[e] = P;
            }
            *(LAS u32x4*)(sb + RC_AT + li * RC_S64 + (k0 + 8 * h) * 2) = pack8(at_); *(LAS u32x4*)(sb + RC_RT + li * RC_S64 + (k0 + 8 * h) * 2) = pack8(rt_);
            *(LAS u32x4*)(Bh + li * RC_S64 + (k0 + 8 * h) * 2) = pack8(bh_); *(LAS u32x4*)(Kh + li * RC_S64 + (k0 + 8 * h) * 2) = pack8(kh_);
            if (li == 15) { *(LAS f32x4*)(sb + RC64_P16 + (k0 + 8 * h) * 4) = (f32x4){p_[0], p_[1], p_[2], p_[3]}; *(LAS f32x4*)(sb + RC64_P16 + (k0 + 8 * h + 4) * 4) = (f32x4){p_[4], p_[5], p_[6], p_[7]}; }
        }
        asm volatile("s_waitcnt lgkmcnt(0)" ::: "memory");
        f32x4 ab = (f32x4){0.f, 0.f, 0.f, 0.f}, ak = ab, rb = ab, rkm = ab;
#pragma unroll
        for (int ks = 0; ks < 2; ++ks) {
            const bf16x8 fa = *(const LAS bf16x8*)(sb + RC_AT + li * RC_S64 + (32 * ks + 8 * q) * 2), fr = *(const LAS bf16x8*)(sb + RC_RT + li * RC_S64 + (32 * ks + 8 * q) * 2);
            const bf16x8 fb = *(const LAS bf16x8*)(Bh + li * RC_S64 + (32 * ks + 8 * q) * 2), fk = *(const LAS bf16x8*)(Kh + li * RC_S64 + (32 * ks + 8 * q) * 2);
            ab = __builtin_amdgcn_mfma_f32_16x16x32_bf16(fa, fb, ab, 0, 0, 0); ak = __builtin_amdgcn_mfma_f32_16x16x32_bf16(fa, fk, ak, 0, 0, 0);
            rb = __builtin_amdgcn_mfma_f32_16x16x32_bf16(fr, fb, rb, 0, 0, 0); rkm = __builtin_amdgcn_mfma_f32_16x16x32_bf16(fr, fk, rkm, 0, 0, 0);
        }
#pragma unroll
        for (int r = 0; r < 4; ++r) {
            const int t = 4 * q + r, s = li;
            Aab[t * 20 + s] = s < t ? ab[r] : 0.f;
            *(LAS bf16_t*)(sb + RC_AAK + t * RC_S16 + s * 2) = (bf16_t)f2bf(s < t ? ak[r] : 0.f);
            *(LAS bf16_t*)(sb + RC_ARB + t * RC_S16 + s * 2) = (bf16_t)f2bf(s <= t ? rb[r] : 0.f);
            *(LAS bf16_t*)(sb + RC_ARK + t * RC_S16 + s * 2) = (bf16_t)f2bf(s <= t ? rkm[r] : 0.f);
        }
        asm volatile("s_waitcnt lgkmcnt(0)" ::: "memory");
        float tc[16];
#pragma unroll
        for (int t = 0; t < 16; ++t) {
            float acc = (t == li) ? 1.f : 0.f;
            f32x4 a0 = *(const LAS f32x4*)(Aab + t * 20), a1 = *(const LAS f32x4*)(Aab + t * 20 + 4), a2 = *(const LAS f32x4*)(Aab + t * 20 + 8), a3 = *(const LAS f32x4*)(Aab + t * 20 + 12);
            const float av[16] = {a0.x, a0.y, a0.z, a0.w, a1.x, a1.y, a1.z, a1.w, a2.x, a2.y, a2.z, a2.w, a3.x, a3.y, a3.z, a3.w};
            float a1_ = 0.f, a2_ = 0.f, a3_ = 0.f;
#pragma unroll
            for (int s = 0; s < t; ++s) { const float pr_ = av[s] * tc[s]; if ((s & 3) == 0) acc += pr_; else if ((s & 3) == 1) a1_ += pr_; else if ((s & 3) == 2) a2_ += pr_; else a3_ += pr_; }
            tc[t] = (acc + a1_) + (a2_ + a3_);
        }
        if (q == 0) {
#pragma unroll
            for (int t = 0; t < 16; ++t) *(LAS bf16_t*)(sb + RC_T + t * RC_S16 + li * 2) = (bf16_t)f2bf(tc[t]);
        }
    };
    if (wave >= 4 && wave - 4 < RC64_NP) { const int ch0 = wave - 4; load_raw(ch0); produce(wave - 4); load_raw(ch0 + RC64_NP); }
    __syncthreads();
    f32x4 S[4]; bf16x8 sop[2];
#pragma unroll
    for (int kt = 0; kt < 4; ++kt) S[kt] = (f32x4){0.f, 0.f, 0.f, 0.f};
    sop[0] = (bf16x8){0, 0, 0, 0, 0, 0, 0, 0}; sop[1] = sop[0];
    int sbase = 0;
    auto consume = [&](const int i, const int ch) {
                const LAS unsigned char* sb = c.lds + (sbase + i) * RC64_SLOT;
        const s16x4v vt = lds_tr(sb + RC64_V + (4 * q + (li >> 2)) * RC_S64 + (16 * (wave & 3) + 4 * (li & 3)) * 2);
        f32x4 aw = mm16(mfma16_frag(sb + RC_AAK, li, q), vt, (f32x4){0.f, 0.f, 0.f, 0.f}, 0, 0, 0);
        f32x4 ay = mm16(mfma16_frag(sb + RC_ARK, li, q), vt, (f32x4){0.f, 0.f, 0.f, 0.f}, 0, 0, 0);
#pragma unroll
        for (int ks = 0; ks < 2; ++ks) {
            const s16x4v alo = *(const LAS s16x4v*)(sb + RC_AT + li * RC_S64 + (32 * ks + 4 * q) * 2), ahi = *(const LAS s16x4v*)(sb + RC_AT + li * RC_S64 + (32 * ks + 16 + 4 * q) * 2);
            const s16x4v rlo = *(const LAS s16x4v*)(sb + RC_RT + li * RC_S64 + (32 * ks + 4 * q) * 2), rhi = *(const LAS s16x4v*)(sb + RC_RT + li * RC_S64 + (32 * ks + 16 + 4 * q) * 2);
            aw = __builtin_amdgcn_mfma_f32_16x16x32_bf16((bf16x8){alo[0], alo[1], alo[2], alo[3], ahi[0], ahi[1], ahi[2], ahi[3]}, sop[ks], aw, 0, 0, 0);
            ay = __builtin_amdgcn_mfma_f32_16x16x32_bf16((bf16x8){rlo[0], rlo[1], rlo[2], rlo[3], rhi[0], rhi[1], rhi[2], rhi[3]}, sop[ks], ay, 0, 0, 0);
        }
        const u32x2 wb2 = (u32x2){pk2(aw[0], aw[1]), pk2(aw[2], aw[3])};
        const f32x4 au = mm16(mfma16_frag(sb + RC_T, li, q), __builtin_bit_cast(s16x4v, wb2), (f32x4){0.f, 0.f, 0.f, 0.f}, 0, 0, 0);
        const u32x2 ub2 = (u32x2){pk2(au[0], au[1]), pk2(au[2], au[3])}; const s16x4v ub = __builtin_bit_cast(s16x4v, ub2);
        ay = mm16(mfma16_frag(sb + RC_ARB, li, q), ub, ay, 0, 0, 0);
#pragma unroll
        for (int kt = 0; kt < 4; ++kt) {
            const f32x4 p16 = *(const LAS f32x4*)(sb + RC64_P16 + (16 * kt + 4 * q) * 4);
            const int troff = (4 * q + (li >> 2)) * RC_S64 + (16 * kt + 4 * (li & 3)) * 2;
            f32x4 sv = S[kt];
            sv = mm16(lds_tr(sb + RC_KH + troff), vt, sv, 0, 0, 0);
            sv = mm16(lds_tr(sb + RC_BH + troff), ub, sv, 0, 0, 0);
            sv = sv * p16;
            S[kt] = sv;
        }
#pragma unroll
        for (int ks = 0; ks < 2; ++ks) {
            const u32x4 w = (u32x4){pk2(S[2 * ks][0], S[2 * ks][1]), pk2(S[2 * ks][2], S[2 * ks][3]), pk2(S[2 * ks + 1][0], S[2 * ks + 1][1]), pk2(S[2 * ks + 1][2], S[2 * ks + 1][3])};
            sop[ks] = __builtin_bit_cast(bf16x8, w);
        }
#pragma unroll
        for (int r = 0; r < 4; ++r) yo[tok(16 * ch + 4 * q + r) * 256 + li] = (bf16_t)f2bf(ay[r]);
    };
    for (int rd = 0; rd < RC64_ROUNDS; ++rd) {
        if (wave < 4) {
            sbase = (rd & 1) * RC64_NP;
            if (rd < RC64_ROUNDS - 1) {
#pragma unroll
                for (int i = 0; i < RC64_NP; ++i) consume(i, RC64_NP * rd + i);
            } else {
                for (int i = 0; i < RC64_NP; ++i) { const int ch = RC64_NP * rd + i; if (ch >= RC_NCH) break; consume(i, ch); }
            }
        } else if (wave - 4 < RC64_NP) {
            const int chn = RC64_NP * (rd + 1) + (wave - 4);
            if (chn < RC_NCH) { produce(((rd + 1) & 1) * RC64_NP + (wave - 4)); if (chn + RC64_NP < RC_NCH) load_raw(chn + RC64_NP); }
        }
        __syncthreads();
    }
}
__device__ __forceinline__ f32x4 mg_dot(const bf16_t* __restrict__ w, const bf16_t* __restrict__ x, int nk, f32x4 acc) {
#pragma unroll 8
    for (int k = 0; k < nk; ++k) acc = __builtin_amdgcn_mfma_f32_16x16x32_bf16(*(const bf16x8*)(w + k * 32), *(const bf16x8*)(x + k * 32), acc, 0, 0, 0);
    return acc;
}
__device__ __forceinline__ void mg_store4(bf16_t* dst, float a, float b, float c, float d) { uint2 w; w.x = pk2(a, b); w.y = pk2(c, d); *(uint2*)dst = w; }

__device__ __forceinline__ void meta_gates(const Ctx& cx_, int l) {
    const Ctx c = relaunder(cx_);
    const int lane = c.lane, wave = c.wave, li = lane & 15, lq = lane >> 4, role = wave & 3, rh = wave >> 2;
    const int c0 = (c.bid >> 2) * 16, row = BATCH * SEQ + ((c.bid & 3) * 2 + rh) * 16 + li;
    const bf16_t* wbase = c.wb(l);
    LAS float* sg = (LAS float*)c.lds;
    const f32x4 zero = {0.f, 0.f, 0.f, 0.f};
    f32x4 p0 = zero, p1 = zero, p2 = zero;
    __syncthreads();
    if (role < 3) {
        const f32x4 acc = mg_dot(wbase + WB_G + ((size_t)role * 1024 + c0 + li) * DM + lq * 8, c.H() + (size_t)row * DM + lq * 8, 32, zero);
        const float s = row_scale(c.ssq(), row);
#pragma unroll
        for (int j = 0; j < 4; ++j) sg[((rh * 3 + role) * 4 + j) * 64 + lane] = sigmoidf_(acc[j] * s);
    } else {
        const bf16_t* wp = wbase + WB_P + (size_t)(c0 + li) * DM + lq * 8;
        p0 = mg_dot(wp, (const bf16_t*)(c.ws + WS_YA) + (size_t)row * 256 + lq * 8, 8, zero);
        p1 = mg_dot(wp + 256, (const bf16_t*)(c.ws + WS_YB) + (size_t)row * 512 + lq * 8, 16, zero);
        p2 = mg_dot(wp + 768, (const bf16_t*)(c.ws + WS_YC) + (size_t)row * 256 + lq * 8, 8, zero);
    }
    __syncthreads();
    if (role == 3) {
        const float* ssqb = (const float*)(c.ws + WS_SSQB);
        const float rsb = __builtin_amdgcn_rsqf((ssqb[2 * row] + ssqb[2 * row + 1]) * (1.0f / 512.f) + EPS);
        float m[4];
#pragma unroll
        for (int j = 0; j < 4; ++j) m[j] = sg[((rh * 3 + 0) * 4 + j) * 64 + lane] * p0[j] + sg[((rh * 3 + 1) * 4 + j) * 64 + lane] * rsb * p1[j] + sg[((rh * 3 + 2) * 4 + j) * 64 + lane] * p2[j];
        mg_store4((bf16_t*)(c.dout + DO_MERGED) + (size_t)row * DM + c0 + lq * 4, m[0], m[1], m[2], m[3]);
    }
    __syncthreads();
}

__device__ __forceinline__ void meta_resid(const Ctx& cx_, const bf16_t* A, const bf16_t* W, int K) {
    if (cx_.bid >= 128) return;
    const Ctx c = relaunder(cx_);
    const int lane = c.lane, wave = c.wave, li = lane & 15, lq = lane >> 4, blk = wave & 3, kh = wave >> 2;
    const int cg16 = c.bid & 15, c0 = cg16 * 64 + blk * 16, row = BATCH * SEQ + (c.bid >> 4) * 16 + li;
    LAS float* red = (LAS float*)c.lds;
    const f32x4 zero = {0.f, 0.f, 0.f, 0.f};
    __syncthreads();
    f32x4 acc = mg_dot(W + (size_t)(c0 + li) * K + kh * (K >> 1) + lq * 8, A + (size_t)row * K + kh * (K >> 1) + lq * 8, K >> 6, zero);
    if (kh == 1) {
#pragma unroll
        for (int j = 0; j < 4; ++j) red[(blk * 4 + j) * 64 + lane] = acc[j];
    }
    __syncthreads();
    float ss = 0.f;
    if (kh == 0) {
        bf16_t* hp = c.H() + (size_t)row * DM + c0 + lq * 4;
        const uint2 hv = *(const uint2*)hp;
        float f[4] = {bflo(hv.x), bfhi(hv.x), bflo(hv.y), bfhi(hv.y)};
#pragma unroll
        for (int j = 0; j < 4; ++j) { f[j] += acc[j] + red[(blk * 4 + j) * 64 + lane]; ss += f[j] * f[j]; }
        mg_store4(hp, f[0], f[1], f[2], f[3]);
        ss += __shfl_xor(ss, 16); ss += __shfl_xor(ss, 32);
    }
    __syncthreads();
    if (kh == 0 && lq == 0) red[blk * 16 + li] = ss;
    __syncthreads();
    if (wave == 0 && lq == 0) c.ssq()[(size_t)row * 16 + cg16] = (red[li] + red[16 + li]) + (red[32 + li] + red[48 + li]);
    __syncthreads();
}

__device__ __forceinline__ void meta_up(const Ctx& cx_, const bf16_t* W) {
    const Ctx c = relaunder(cx_);
    const int lane = c.lane, li = lane & 15, lq = lane >> 4;
    const int c0 = c.bid * 16, row = BATCH * SEQ + c.wave * 16 + li;
    const f32x4 zero = {0.f, 0.f, 0.f, 0.f};
    const f32x4 acc = mg_dot(W + (size_t)(c0 + li) * DM + lq * 8, c.H() + (size_t)row * DM + lq * 8, 32, zero);
    const float s = row_scale(c.ssq(), row);
    float f[4];
#pragma unroll
    for (int j = 0; j < 4; ++j) { const float r = fmaxf(acc[j] * s, 0.f); f[j] = r * r; }
    mg_store4((bf16_t*)(c.ws + WS_ACT) + (size_t)row * DFF + c0 + lq * 4, f[0], f[1], f[2], f[3]);
}

__device__ __forceinline__ void rwkv_post(const Ctx& cx_, int l) {
    const Ctx c = relaunder(cx_);
    const int gw = c.bid * NWAVES + c.wave, NGW = c.G * NWAVES, lane = c.lane, c0 = 4 * lane;
    const bf16_t* __restrict__ y0 = (const bf16_t*)(c.ws + WS_YRW); const bf16_t* __restrict__ y1 = y0 + (size_t)MP * 256;
    const bf16_t* __restrict__ rk = (const bf16_t*)(c.dout + DO_RKVP); const bf16_t* __restrict__ l2 = (const bf16_t*)(c.ws + WS_L2O); bf16_t* __restrict__ yc = (bf16_t*)(c.ws + WS_YC);
    float lw[4], lb[4], rkw[4];
#pragma unroll
    for (int e = 0; e < 4; ++e) { lw[e] = c.in[I_LNW][(size_t)l * 256 + c0 + e]; lb[e] = c.in[I_LNB][(size_t)l * 256 + c0 + e]; rkw[e] = c.in[I_RK][(size_t)l * 256 + c0 + e]; }
#pragma unroll 2
    for (int m = gw; m < M_ROWS; m += NGW) {
        const u32x2 a = *(const u32x2*)(y0 + (size_t)m * 256 + c0), bq = *(const u32x2*)(y1 + (size_t)m * 256 + c0);
        const u32x2 rr = *(const u32x2*)(rk + (size_t)m * 1024 + c0), kk = *(const u32x2*)(rk + (size_t)m * 1024 + 256 + c0), vv = *(const u32x2*)(rk + (size_t)m * 1024 + 512 + c0);
        const u32x2 gg = *(const u32x2*)(l2 + (size_t)m * 1280 + 1024 + c0);
        float y[4] = {bflo(a.x) + bflo(bq.x), bfhi(a.x) + bfhi(bq.x), bflo(a.y) + bflo(bq.y), bfhi(a.y) + bfhi(bq.y)};
        const float r[4] = {bflo(rr.x), bfhi(rr.x), bflo(rr.y), bfhi(rr.y)}, k[4] = {bflo(kk.x), bfhi(kk.x), bflo(kk.y), bfhi(kk.y)};
        const float v[4] = {bflo(vv.x), bfhi(vv.x), bflo(vv.y), bfhi(vv.y)}, g[4] = {bflo(gg.x), bfhi(gg.x), bflo(gg.y), bfhi(gg.y)};
        const float mean = sum16((y[0] + y[1]) + (y[2] + y[3])) * (1.f / 64.f);
        float q = 0.f, bo = 0.f;
#pragma unroll
        for (int e = 0; e < 4; ++e) { y[e] -= mean; q += y[e] * y[e]; bo += r[e] * k[e] * rkw[e]; }
        q = sum16(q) * (1.f / 64.f); bo = sum16(bo);
        const float rs = __builtin_amdgcn_rsqf(q + 64e-5f);
        float o[4];
#pragma unroll
        for (int e = 0; e < 4; ++e) o[e] = (y[e] * rs * lw[e] + lb[e] + bo * v[e]) * g[e];
        *(u32x2*)(yc + (size_t)m * 256 + c0) = (u32x2){pk2(o[0], o[1]), pk2(o[2], o[3])};
    }
}
__device__ __forceinline__ void final_phase(const Ctx& cx_, float* out) {
    const Ctx c = relaunder(cx_);
    const int gw = c.bid * NWAVES + c.wave, NGW = c.G * NWAVES, lane = c.lane;
    const bf16_t* H = c.H(); const f32x4* fw = (const f32x4*)c.in[I_FNW];
    f32x4 fwv[4];
#pragma unroll
    for (int i = 0; i < 4; ++i) fwv[i] = fw[lane + 64 * i];
#pragma unroll 2
    for (int r = gw; r < BATCH * SEQ; r += NGW) {
        const size_t m = (size_t)r;
        const u32x2* __restrict__ hp = (const u32x2*)(H + m * DM);
        float v[4][4], ss = 0.f;
#pragma unroll
        for (int i = 0; i < 4; ++i) { const u32x2 w = hp[lane + 64 * i]; v[i][0] = bflo(w.x); v[i][1] = bfhi(w.x); v[i][2] = bflo(w.y); v[i][3] = bfhi(w.y); ss += (v[i][0] * v[i][0] + v[i][1] * v[i][1]) + (v[i][2] * v[i][2] + v[i][3] * v[i][3]); }
        ss = wave_sum(ss); const float s = __builtin_amdgcn_rsqf(ss * (1.0f / DM) + EPS);
        f32x4* __restrict__ op = (f32x4*)(out + (size_t)r * DM);
#pragma unroll
        for (int i = 0; i < 4; ++i) { const f32x4 w = fwv[i]; op[lane + 64 * i] = (f32x4){v[i][0] * s * w.x, v[i][1] * s * w.y, v[i][2] * s * w.z, v[i][3] * s * w.w}; }
    }
}

constexpr int LDS_BYTES = 147456;
#ifndef MIXDIR
#define MIXDIR 0
#define MIXLAYER 0
#endif
#ifndef PHMASK
#define PHMASK 0xFFFFF
#endif
__global__ void __launch_bounds__(NTHREADS, 2) mega_fwd(Params p) {
    extern __shared__ __attribute__((aligned(16))) unsigned char lds_raw[];
    cg::grid_group grid = cg::this_grid();
    Ctx c0_; c0_.in = p.in; c0_.ws = p.ws; c0_.dout = (unsigned char*)p.out; c0_.lds = (LAS unsigned char*)lds_raw;
    c0_.wave = __builtin_amdgcn_readfirstlane((int)threadIdx.x >> 6); c0_.tid = opaque_tid(c0_.wave); c0_.lane = c0_.tid & 63; c0_.G = gridDim.x; c0_.bid = blockIdx.x;
    Ctx c = c0_;
    const int G = c.G, bid = c.bid;
#ifdef PROF_A
    if (blockIdx.x == 0 && threadIdx.x == 0) { for (int k = 0; k < 15; ++k) PROF_PTR[k] = 0; PROF_PTR[15] = __builtin_amdgcn_s_memrealtime(); }
#endif
    unsigned* barw = (unsigned*)(c.ws + WS_BAR);
    volatile LAS unsigned* bst = (volatile LAS unsigned*)(c.lds + LDS_BYTES - 64);
    if (bid == 0) for (int i = threadIdx.x; i < XCD_BAR_WORDS + 1024; i += NTHREADS) barw[i < XCD_BAR_WORDS ? i : 4096 + (i - XCD_BAR_WORDS)] = 0u;
    if (threadIdx.x < 2) bst[threadIdx.x] = 0u;
    __syncthreads();
    if (PHMASK & 1) phase0(c);
    grid.sync(); STAMP(0);
    const XcdBarrier xbar = xcd_barrier_post(barw, bst);
#define GRID_BAR() do { xcd_barrier(xbar, c0_.wave); c = relaunder(c0_); } while (0)
#pragma unroll 1
    for (int l = 0; l < DEPTH; ++l) {
#define wb (c.wb(l))
        if (PHMASK & 2) dt_job(c, l);
        if (PHMASK & 4) { SchedPlain S{c.H(), wb + WB_IN, DM, DM, DM, MP / 256, 11, G, bid, 0};
          EpiInProj E{c.ssq(), (bf16_t*)(c.ws + WS_UH), (bf16_t*)(c.ws + WS_PZ), (bf16_t*)(c.ws + WS_PXBC), (bf16_t*)(c.ws + WS_PRKVX)};
          pg8::gemm_phase(c.lds, c.wave, S, E); }
        GRID_BAR(); STAMP(1);
        if (PHMASK & 8) { SchedS5 S{(const bf16_t*)(c.ws + WS_UH), wb + WB_SX, 256, G, bid}; EpiS5X E{(float*)(c.ws + WS_X)}; pg8::gemm_phase(c.lds, c.wave, S, E); }
        if (PHMASK & 16) rwkv_prep(c, l);
        if (PHMASK & 32) ssd_prep(c, l);
        GRID_BAR(); STAMP(2);
        if (PHMASK & 64) s5_scan(c, l);
        if (PHMASK & 4096) ssd_states(c, l);
        if (PHMASK & 128) { SchedPlain S{(const bf16_t*)(c.ws + WS_L1IN), wb + WB_L1, 512, 512, 512, MP / 256, 2, G, bid, 0}; EpiL1 E{(bf16_t*)(c.ws + WS_L1O)}; pg8::gemm_phase(c.lds, c.wave, S, E); }
        GRID_BAR(); STAMP(3);
        ssd_chunk_scan(c, l);
        if (PHMASK & 256) { SchedL2 S{(const bf16_t*)(c.ws + WS_L1O), wb + WB_L2, G, bid, MP / 256, 0}; EpiL2 E{(bf16_t*)(c.ws + WS_L2O), c.in[I_W0] + (size_t)l * 512, c.in[I_A0] + (size_t)l * 512}; pg8::gemm_phase(c.lds, c.wave, S, E); }
        if (PHMASK & 512) { SchedS5 S{(const bf16_t*)(c.ws + WS_UH), wb + WB_SY, 512, G, bid}; EpiS5Y E{(bf16_t*)(c.ws + WS_YAPRE)}; pg8::gemm_phase(c.lds, c.wave, S, E); }
        GRID_BAR(); STAMP(4);
        if (bid < 64) { if (PHMASK & 1024) rwkv_chunked64(c, l); }
        else { if (PHMASK & 2048) ssd_outputs(c, l, 64, G - 64);
  if (PHMASK & 16384) { SchedPlain S{(const bf16_t*)(c.ws + WS_YAPRE), wb + WB_GLU, 256, 256, 256, MP / 256, 2, G - 64, bid - 64, 0}; EpiGLU E{(bf16_t*)(c.ws + WS_YA), c.in[I_GLUB] + (size_t)l * 512}; pg8::gemm_phase(c.lds, c.wave, S, E); } }
        STAMP(5);
        GRID_BAR(); STAMP(6);
        if (PHMASK & 8192) rwkv_post(c, l);
        GRID_BAR(); STAMP(7);
        if (PHMASK & 32768) { SchedProj S{c.H(), wb + WB_G, wb + WB_P, (const bf16_t*)(c.ws + WS_YA), (const bf16_t*)(c.ws + WS_YB), (const bf16_t*)(c.ws + WS_YC), BATCH * SEQ / 256, G, bid, 0};
          EpiProj E{c.ssq(), (const float*)(c.ws + WS_SSQB), c.ws + WS_PARK + (size_t)bid * 393216, (bf16_t*)(c.dout + DO_MERGED), opaque_tid(c.wave)}; pg8::gemm_phase(c.lds, c.wave, S, E); }
        if (l < DEPTH - 1) meta_gates(c, l);
        GRID_BAR(); STAMP(8);
        if (PHMASK & 65536) { SchedPlain S{(const bf16_t*)(c.dout + DO_MERGED), wb + WB_O, DM, DM, DM, BATCH * SEQ / 256, 4, G, bid, 0}; EpiResid E{c.H(), c.ssq()}; pg8::gemm_phase(c.lds, c.wave, S, E); }
        if (l < DEPTH - 1) meta_resid(c, (const bf16_t*)(c.dout + DO_MERGED), wb + WB_O, DM);
        GRID_BAR(); STAMP(9);
        if (PHMASK & 131072) { SchedPlain S{c.H(), wb + WB_1, DM, DM, DM, BATCH * SEQ / 256, 16, G, bid, 0}; EpiUp E{c.ssq(), (bf16_t*)(c.ws + WS_ACT)}; pg8::gemm_phase(c.lds, c.wave, S, E); }
        if (l < DEPTH - 1) meta_up(c, wb + WB_1);
        GRID_BAR(); STAMP(10);
        if (PHMASK & 262144) { SchedPlain S{(const bf16_t*)(c.ws + WS_ACT), wb + WB_2, DFF, DFF, DFF, BATCH * SEQ / 256, 4, G, bid, 0}; EpiResid E{c.H(), c.ssq()}; pg8::gemm_phase(c.lds, c.wave, S, E); }
        if (l < DEPTH - 1) meta_resid(c, (const bf16_t*)(c.ws + WS_ACT), wb + WB_2, DFF);
        GRID_BAR(); STAMP(11);
    }
    if (PHMASK & 524288) final_phase(c, p.out);
#ifdef PROF_A
    GRID_BAR(); STAMP(12);
    if (blockIdx.x == 0) {
        __syncthreads();
        float va = (float)(__hip_atomic_load(&PROF_PTR[PROF_A], __ATOMIC_RELAXED, __HIP_MEMORY_SCOPE_AGENT)) * 0.01f, vb = (float)(__hip_atomic_load(&PROF_PTR[PROF_B], __ATOMIC_RELAXED, __HIP_MEMORY_SCOPE_AGENT)) * 0.01f;
        va = exp2f(rintf(log2f(va * PROF_SHIFT) * 2.f) * 0.5f); vb = exp2f(rintf(log2f(vb * PROF_SHIFT) * 2.f) * 0.5f);
        for (int i = threadIdx.x; i < (1 << 20); i += NTHREADS) p.out[1 + i] = vb;
        if (threadIdx.x == 0) p.out[0] = 100.f * va;
    }
#endif
}

extern "C" void kernel_launch(void* const* d_in, const int* in_sizes, int n_in, void* d_out, int out_size, void* d_ws, size_t ws_size, hipStream_t stream) {
    static int grid = 0;
    if (grid == 0) {
        int dev = 0, cus = 0, per_cu = 0;
        if (n_in != N_INPUTS || out_size != BATCH * SEQ * DM || ws_size < WS_END) { fprintf(stderr, "kernel_launch: unexpected shapes (n_in %d out %d ws %zu)\n", n_in, out_size, ws_size); grid = -1; return; }
        (void)hipGetDevice(&dev); (void)hipDeviceGetAttribute(&cus, hipDeviceAttributeMultiprocessorCount, dev);
        (void)hipFuncSetAttribute((const void*)mega_fwd, hipFuncAttributeMaxDynamicSharedMemorySize, LDS_BYTES);
        (void)hipOccupancyMaxActiveBlocksPerMultiprocessor(&per_cu, (const void*)mega_fwd, NTHREADS, LDS_BYTES);
        if (per_cu < 1) { fprintf(stderr, "kernel_launch: occupancy query says %d blocks per CU\n", per_cu); per_cu = 1; }
        grid = cus * 1;
        if (grid != 256) fprintf(stderr, "kernel_launch: %d CUs (the scan phases are laid out for 256 workgroups)\n", grid);
    }
    if (grid < 0) return;
    Params p{};
    for (int i = 0; i < N_INPUTS; ++i) p.in[i] = (const float*)d_in[i];
    p.out = (float*)d_out; p.ws = (unsigned char*)d_ws; p.ph_lo = 0; p.ph_hi = 0;
    void* args[] = {&p};
    hipError_t e = hipLaunchCooperativeKernel((const void*)mega_fwd, dim3(grid), dim3(NTHREADS), args, LDS_BYTES, stream);
    if (e != hipSuccess) fprintf(stderr, "cooperative launch failed: %s (grid %d)\n", hipGetErrorString(e), grid);
}
```

```cpp
#define CODE_SHIFT 3
#include <hip/hip_runtime.h>
#include <hip/hip_cooperative_groups.h>
#include <cstdio>
#include <cstdint>
namespace cg = cooperative_groups;

#define LAS __attribute__((address_space(3)))
typedef unsigned short bf16_t;
typedef short bf16x8 __attribute__((ext_vector_type(8)));
typedef float f32x4 __attribute__((ext_vector_type(4)));
typedef unsigned u32x4 __attribute__((ext_vector_type(4)));
typedef unsigned u32x2 __attribute__((ext_vector_type(2)));

constexpr int BATCH = 8, SEQ = 4096, NMETA = 16, LEN = SEQ + NMETA, DM = 1024, DFF = 4096, DEPTH = 2;
constexpr int M_ROWS = BATCH * LEN;
constexpr int MP = 33024;
constexpr int N_IN = 5896;
constexpr int NCH16 = LEN / 16;
constexpr int S5ROWS = BATCH * NCH16;
constexpr int S5RP = 2304;
constexpr float EPS = 1e-6f;
constexpr int NTHREADS = 512, NWAVES = 8;

constexpr size_t QB = (size_t)MP * 256 * 2;
constexpr size_t WB_IN = 0;
constexpr size_t WB_G = WB_IN + (size_t)2816 * 1024;
constexpr size_t WB_P = WB_G + (size_t)3072 * 1024;
constexpr size_t WB_O = WB_P + (size_t)1024 * 1024;
constexpr size_t WB_1 = WB_O + (size_t)1024 * 1024;
constexpr size_t WB_2 = WB_1 + (size_t)4096 * 1024;
constexpr size_t WB_GLU = WB_2 + (size_t)1024 * 4096;
constexpr size_t WB_L1 = WB_GLU + (size_t)512 * 256;
constexpr size_t WB_L2 = WB_L1 + (size_t)512 * 512;
constexpr size_t WB_SX = WB_L2 + (size_t)1280 * 256;
constexpr size_t WB_SY = WB_SX + (size_t)16 * 256 * 256;
constexpr size_t WB_ELEMS = WB_SY + (size_t)16 * 256 * 512;
constexpr size_t WB_BYTES = WB_ELEMS * 2;
static_assert(WB_BYTES <= 5 * QB / 2, "weight block fits 2.5 Q");

constexpr size_t WS_H = 0;
constexpr size_t WS_WB0 = 4 * QB;
constexpr size_t WS_SMALL = 13 * QB / 2;
constexpr size_t WS_SSQ = WS_SMALL;
constexpr size_t WS_DT = WS_SSQ + (size_t)MP * 16 * 4;
constexpr size_t WS_DEC = WS_DT + (size_t)MP * 16 * 4;
static_assert(WS_DEC + (size_t)MP * 16 * 4 <= 7 * QB, "small region");
constexpr size_t WS_MIX = 7 * QB;
constexpr size_t WS_PXBC = WS_MIX;
constexpr size_t WS_YSSD = WS_MIX;
constexpr size_t WS_PARK = WS_MIX;
constexpr size_t WS_ACT = WS_MIX;
constexpr size_t WS_PRKVX = WS_MIX + 4 * QB;
constexpr size_t WS_L2O = WS_MIX + 4 * QB;
constexpr size_t WS_PZ = WS_MIX + 9 * QB;
constexpr size_t WS_UH = WS_MIX + 11 * QB;
constexpr size_t WS_X = WS_MIX + 53 * QB / 4;
constexpr size_t WS_L1IN = WS_MIX + 31 * QB / 2;
constexpr size_t WS_YAPRE = WS_L1IN;
constexpr size_t WS_L1O = WS_MIX + 35 * QB / 2;
constexpr size_t WS_YB = WS_L1O;
constexpr size_t WS_BC = WS_MIX + 39 * QB / 2;
constexpr size_t WS_YA = WS_MIX + 33 * QB / 2;
constexpr size_t WS_YC = WS_BC + QB;
constexpr size_t WS_XS = WS_MIX + 43 * QB / 2;
constexpr size_t WS_YRW0 = WS_XS + 2 * QB;
constexpr size_t WS_END = WS_YRW0 + QB;
static_assert(WS_END <= (size_t)512 << 20, "workspace map fits 512 MiB");
static_assert((size_t)16 * S5RP * 512 * 2 <= 9 * QB / 4 && (size_t)16 * S5RP * 256 * 4 <= 9 * QB / 4, "S5 buffers fit their slots");

constexpr size_t DO_RKVP = 0;
constexpr size_t DO_MERGED = 0;
constexpr size_t DO_WB1 = 4 * QB;
constexpr size_t DO_YRW1 = 13 * QB / 2;
static_assert(DO_WB1 + WB_BYTES <= DO_YRW1 && DO_YRW1 + QB <= (size_t)BATCH * SEQ * DM * 4, "d_out scratch map");

__device__ __forceinline__ unsigned f2bf(float f) { unsigned u = __builtin_bit_cast(unsigned, f); return (u + 0x7fffu + ((u >> 16) & 1u)) >> 16; }
typedef float f32x2_t_ __attribute__((ext_vector_type(2))); typedef __bf16 bf16x2_t_ __attribute__((ext_vector_type(2)));
__device__ __forceinline__ unsigned pk2(float lo, float hi) { const f32x2_t_ v = {lo, hi}; const bf16x2_t_ b = __builtin_convertvector(v, bf16x2_t_); return __builtin_bit_cast(unsigned, b); }
__device__ __forceinline__ float bflo(unsigned w) { return __builtin_bit_cast(float, w << 16); }
__device__ __forceinline__ float bfhi(unsigned w) { return __builtin_bit_cast(float, w & 0xffff0000u); }
__device__ __forceinline__ float bf1(bf16_t v) { return __builtin_bit_cast(float, (unsigned)v << 16); }
__device__ __forceinline__ float sigmoidf_(float x) { return __builtin_amdgcn_rcpf(1.0f + __expf(-x)); }
__device__ __forceinline__ float siluf_(float x) { return x * __builtin_amdgcn_rcpf(1.0f + __expf(-x)); }
__device__ __forceinline__ float tanhf_(float x) { x = fminf(fmaxf(x, -15.f), 15.f); const float t = __expf(2.f * x); return (t - 1.f) * __builtin_amdgcn_rcpf(t + 1.f); }
__device__ __forceinline__ float softplusf_(float x) { return fmaxf(x, 0.f) + __logf(1.0f + __expf(-fabsf(x))); }
__device__ __forceinline__ float geluf_(float x) { const float u = 0.7978845608028654f * (x + 0.044715f * x * x * x); return 0.5f * x * (1.f + tanhf_(u)); }
__device__ __forceinline__ float wave_sum(float v) {
#pragma unroll
    for (int o = 1; o < 64; o <<= 1) v += __shfl_xor(v, o);
    return v;
}
__device__ __forceinline__ float sum16(float v) {
#pragma unroll
    for (int o = 1; o < 16; o <<= 1) v += __shfl_xor(v, o);
    return v;
}
template <int CTRL> __device__ __forceinline__ float dpp_mov(float x) {
    return __builtin_bit_cast(float, __builtin_amdgcn_update_dpp(0, __builtin_bit_cast(int, x), CTRL, 0xf, 0xf, true));
}
__device__ __forceinline__ float allred16(float x) {
    x += dpp_mov<0xB1>(x); x += dpp_mov<0x4E>(x); x += dpp_mov<0x141>(x); x += dpp_mov<0x140>(x); return x;
}
__device__ __forceinline__ void unpack8(const u32x4 w, float (&f)[8]) {
    f[0] = bflo(w.x); f[1] = bfhi(w.x); f[2] = bflo(w.y); f[3] = bfhi(w.y); f[4] = bflo(w.z); f[5] = bfhi(w.z); f[6] = bflo(w.w); f[7] = bfhi(w.w);
}
__device__ __forceinline__ u32x4 pack8(const float (&f)[8]) { u32x4 w; w.x = pk2(f[0], f[1]); w.y = pk2(f[2], f[3]); w.z = pk2(f[4], f[5]); w.w = pk2(f[6], f[7]); return w; }
__device__ __forceinline__ int opaque_tid(int) { int t = threadIdx.x; asm volatile("" : "+v"(t)); return t; }
__device__ __forceinline__ int row_of(int b, int t) { return t < NMETA ? BATCH * SEQ + b * NMETA + t : b * SEQ + (t - NMETA); }
__device__ __forceinline__ void bt_of(int m, int& b, int& t) { if (m < BATCH * SEQ) { b = m >> 12; t = NMETA + (m & (SEQ - 1)); } else { const int q = m - BATCH * SEQ; b = q >> 4; t = q & (NMETA - 1); } }
namespace pg8 {
constexpr int BM = 256, BK = 64, HALF = 128, HTB = HALF * BK * 2  , STAGE_BYTES = 8 * HTB;
__host__ __device__ __forceinline__ int lds_byte(int r, int c) { const int st = (r >> 4) * 2 + (c >> 5), rr = r & 15, cc = c & 31, ob = rr * 64 + cc * 2; return st * 1024 + (ob ^ (((ob >> 9) & 1) << 5)); }
__host__ __device__ __forceinline__ void stage_rc(int b, int& R, int& C) { const int st = b / 1024, sb = b % 1024, swz = sb ^ (((sb >> 9) & 1) << 5); R = (st >> 1) * 16 + swz / 64; C = (st & 1) * 32 + (swz % 64) / 2; }
__host__ __device__ __forceinline__ int perm32(int rho) { const int n = rho >> 4, i = rho & 15; return 8 * (i >> 2) + 4 * n + (i & 3); }

struct GU {
    const bf16_t* A;
    const bf16_t* B;
    int lda, ldb, nt;
    int pm, pn, kind;
};

template <bool SKIP_HI = false, class Epi, class Sched>
__device__ __forceinline__ void gemm_phase(LAS unsigned char* lds, int wave_s, const Sched& S, const Epi& E) {
    const int tid = opaque_tid(wave_s), wid = wave_s, lane = tid & 63, wr = wid >> 2, wc = wid & 3, fr = lane & 15, fq = lane >> 4;
#define PG8_VOFF(lda_, ldb_, a0, b0) do { int R0_, C0_; stage_rc(tid * 16, R0_, C0_); \
        a0 = (unsigned)(R0_ * (lda_) + C0_) * 2u; b0 = (unsigned)(((R0_ & ~31) + perm32(R0_ & 31)) * (ldb_) + C0_) * 2u; } while (0)
    const size_t kstep = (size_t)(BK * 2);
    const unsigned ldsw = (unsigned)wid * 1024u;
    const int aoff = lds_byte(wr * 64 + fr, fq * 8), boff = lds_byte(wc * 32 + fr, fq * 8);
#define PG8_SA(b, h) (((b) * 2 + (h)) * HTB)
#define PG8_SB(b, h) ((4 + (b) * 2 + (h)) * HTB)
#define PG8_STAGE(bufoff, gbase, v0, hs) do { \
        __builtin_amdgcn_global_load_lds((const unsigned*)((const char*)(gbase) + (v0)), (LAS unsigned*)(lds + (bufoff) + ldsw), 16, 0, 0); \
        __builtin_amdgcn_global_load_lds((const unsigned*)((const char*)(gbase) + ((hs) >> 1) + (v0)), (LAS unsigned*)(lds + (bufoff) + ldsw + 8192), 16, 0, 0); } while (0)
#define PG8_LDA(dst, b, h) do { _Pragma("unroll") for (int m = 0; m < 4; ++m) _Pragma("unroll") for (int k = 0; k < 2; ++k) dst[m][k] = *(const LAS bf16x8*)(lds + PG8_SA(b, h) + aoff + m * 2048 + k * 1024); } while (0)
#define PG8_LDB(dst, b, h) do { _Pragma("unroll") for (int n = 0; n < 2; ++n) _Pragma("unroll") for (int k = 0; k < 2; ++k) dst[n][k] = *(const LAS bf16x8*)(lds + PG8_SB(b, h) + boff + n * 2048 + k * 1024); } while (0)
#define PG8_MMA(ai, bj, At, Bt) do { __builtin_amdgcn_s_setprio(1); _Pragma("unroll") for (int m = 0; m < 4; ++m) _Pragma("unroll") for (int n = 0; n < 2; ++n) _Pragma("unroll") for (int k = 0; k < 2; ++k) \
        acc[ai][bj][m][n] = __builtin_amdgcn_mfma_f32_16x16x32_bf16(Bt[n][k], At[m][k], acc[ai][bj][m][n], 0, 0, 0); __builtin_amdgcn_s_setprio(0); } while (0)
#define PG8_WAIT_V(n) asm volatile("s_waitcnt vmcnt(" #n ")" ::: "memory")
#define PG8_WAIT_L(n) asm volatile("s_waitcnt lgkmcnt(" #n ")" ::: "memory")
#define PG8_BAR __builtin_amdgcn_s_barrier()
#define PG8_SCHED __builtin_amdgcn_sched_barrier(0)
    GU cur, nxt; int ui = 0;
    if (!S.next(0, cur)) return;
    f32x4 acc[2][2][4][2];
#pragma unroll
    for (int a = 0; a < 2; ++a)
#pragma unroll
        for (int b = 0; b < 2; ++b)
#pragma unroll
            for (int m = 0; m < 4; ++m)
#pragma unroll
                for (int n = 0; n < 2; ++n) acc[a][b][m][n] = (f32x4){0.f, 0.f, 0.f, 0.f};
    bf16x8 At[4][2], B0[2][2], B1[2][2];
    const char* cA = (const char*)cur.A; const char* cB = (const char*)cur.B;
    unsigned vA0, vB0; PG8_VOFF(cur.lda, cur.ldb, vA0, vB0);
    size_t hsA = (size_t)HALF * cur.lda * 2, hsB = (size_t)HALF * cur.ldb * 2;
    int nt = cur.nt; asm volatile("" : "+s"(nt));
    PG8_STAGE(PG8_SB(0, 0), cB, vB0, hsB); PG8_STAGE(PG8_SB(0, 1), cB + hsB, vB0, hsB); PG8_STAGE(PG8_SA(0, 0), cA, vA0, hsA); PG8_STAGE(PG8_SA(0, 1), cA + hsA, vA0, hsA);
    if (wr == 1) PG8_BAR;
    PG8_WAIT_V(2); PG8_BAR;
    PG8_STAGE(PG8_SB(1, 0), cB + kstep, vB0, hsB); PG8_STAGE(PG8_SA(1, 0), cA + kstep, vA0, hsA); PG8_STAGE(PG8_SB(1, 1), cB + hsB + kstep, vB0, hsB);
    PG8_WAIT_V(6); PG8_BAR;
    for (;;) {
        const bool has_next = S.next(ui + 1, nxt);
        const char* nA = has_next ? (const char*)nxt.A : cA; const char* nB = has_next ? (const char*)nxt.B : cB;
        unsigned nvA0 = vA0, nvB0 = vB0;
        if (has_next) PG8_VOFF(nxt.lda, nxt.ldb, nvA0, nvB0);
        const size_t nhsA = has_next ? (size_t)HALF * nxt.lda * 2 : hsA, nhsB = has_next ? (size_t)HALF * nxt.ldb * 2 : hsB;
        for (int t = 0; t < nt; t += 2) {
            const bool last = (t == nt - 2);
            const char* a1 = cA + (size_t)(t + 1) * kstep;
            const char* a2 = last ? nA : cA + (size_t)(t + 2) * kstep; const char* b2 = last ? nB : cB + (size_t)(t + 2) * kstep;
            const char* a3 = a2 + kstep; const char* b3 = b2 + kstep;
            const unsigned xA0 = last ? nvA0 : vA0, xB0 = last ? nvB0 : vB0;
            const size_t xhA = last ? nhsA : hsA, xhB = last ? nhsB : hsB;
            PG8_LDB(B0, 0, 0); PG8_LDB(B1, 0, 1); PG8_SCHED; PG8_LDA(At, 0, 0); PG8_STAGE(PG8_SA(1, 1), a1 + hsA, vA0, hsA);
            PG8_WAIT_V(8); PG8_WAIT_L(0); PG8_BAR; PG8_MMA(0, 0, At, B0); PG8_MMA(0, 1, At, B1); PG8_BAR; PG8_SCHED;
            PG8_LDA(At, 0, 1); PG8_STAGE(PG8_SB(0, 0), b2, xB0, xhB); PG8_STAGE(PG8_SB(0, 1), b2 + xhB, xB0, xhB); PG8_STAGE(PG8_SA(0, 0), a2, xA0, xhA);
            PG8_WAIT_V(8); PG8_WAIT_L(0); PG8_BAR; if constexpr (!SKIP_HI) { PG8_MMA(1, 0, At, B0); PG8_MMA(1, 1, At, B1); } PG8_BAR; PG8_SCHED;
            PG8_LDB(B0, 1, 0); PG8_LDB(B1, 1, 1); PG8_SCHED; PG8_LDA(At, 1, 0); PG8_STAGE(PG8_SA(0, 1), a2 + xhA, xA0, xhA);
            PG8_WAIT_V(8); PG8_WAIT_L(0); PG8_BAR; PG8_MMA(0, 0, At, B0); PG8_MMA(0, 1, At, B1); PG8_BAR; PG8_SCHED;
            PG8_LDA(At, 1, 1); PG8_STAGE(PG8_SB(1, 0), b3, xB0, xhB); PG8_STAGE(PG8_SB(1, 1), b3 + xhB, xB0, xhB); PG8_STAGE(PG8_SA(1, 0), a3, xA0, xhA);
            PG8_WAIT_V(8); PG8_WAIT_L(0); PG8_BAR; if constexpr (!SKIP_HI) { PG8_MMA(1, 0, At, B0); PG8_MMA(1, 1, At, B1); } PG8_BAR; PG8_SCHED;
        }
        if (wr == 0) PG8_BAR;
        const bool keep = E(acc, cur, wr, wc, fr, fq);
        if (!has_next) break;
        if (!keep) {
#pragma unroll
            for (int a = 0; a < 2; ++a)
#pragma unroll
                for (int b = 0; b < 2; ++b)
#pragma unroll
                    for (int m = 0; m < 4; ++m)
#pragma unroll
                        for (int n = 0; n < 2; ++n) acc[a][b][m][n] = (f32x4){0.f, 0.f, 0.f, 0.f};
        }
        cur = nxt; cA = nA; cB = nB; vA0 = nvA0; vB0 = nvB0; hsA = nhsA; hsB = nhsB; nt = cur.nt; asm volatile("" : "+s"(nt)); ++ui;
        if (wr == 1) PG8_BAR;
    }
    PG8_WAIT_V(0);
    PG8_BAR;
#undef PG8_VOFF
#undef PG8_SA
#undef PG8_SB
#undef PG8_STAGE
#undef PG8_LDA
#undef PG8_LDB
#undef PG8_MMA
#undef PG8_WAIT_V
#undef PG8_WAIT_L
#undef PG8_BAR
#undef PG8_SCHED
}

__device__ __forceinline__ bool tile_order(int i, int G, int c, int nM, int nN, int& pm, int& pn) {
    const int nwg = nM * nN; const long L = (long)i * G + c; if (L >= nwg) return false;
    int wgid = (int)L; { const int q = nwg / 8, r = nwg % 8, xcd = wgid % 8, off = wgid / 8; wgid = (xcd < r ? xcd * (q + 1) : r * (q + 1) + (xcd - r) * q) + off; }
    const int nig = 8 * nN, gid = wgid / nig, fm = gid * 8, gsz = (nM - fm) < 8 ? (nM - fm) : 8;
    pm = fm + ((wgid % nig) % gsz); pn = (wgid % nig) / gsz; return true;
}
}
using pg8::GU;
enum InIdx { I_X = 0, I_META, I_FNW, I_MIXNW, I_WIN, I_S5LRE, I_S5LIM, I_S5LS, I_S5BRE, I_S5BIM, I_S5CRE, I_S5CIM, I_S5D, I_GLUW, I_GLUB,
             I_CONVW, I_CONVB, I_ALOG, I_DTB, I_SSDD, I_SSDNW, I_MURKV, I_MUWAG, I_W0, I_W1, I_W2, I_A0, I_A1, I_A2, I_G1, I_G2, I_KK, I_KA, I_RK, I_LNW, I_LNB,
             I_PA, I_PB, I_PC, I_WOUT, I_MLPNW, I_MLPW1, I_MLPW2, N_INPUTS };
struct Params { const float* in[N_INPUTS]; float* out; unsigned char* ws; int ph_lo, ph_hi; };

struct Ctx {
    const float* const* in; unsigned char* ws; unsigned char* dout;
    LAS unsigned char* lds;
    int tid, lane, wave, G, bid;
    __device__ __forceinline__ bf16_t* wb(int layer) const { return (bf16_t*)(layer == 0 ? ws + WS_WB0 : dout + DO_WB1); }
    __device__ __forceinline__ bf16_t* H() const { return (bf16_t*)(ws + WS_H); }
    __device__ __forceinline__ float* ssq() const { return (float*)(ws + WS_SSQ); }
};
__device__ __forceinline__ Ctx relaunder(const Ctx& c0) {
    Ctx c = c0; c.tid = opaque_tid(c0.wave); c.lane = c.tid & 63;
    int z = 0; asm volatile("" : "+s"(z)); z = __builtin_amdgcn_readfirstlane(z);
    c.ws = c0.ws + z; c.dout = c0.dout + z; c.in = c0.in + z;
    c.wave = c0.wave + z; c.bid = c0.bid + z; c.G = c0.G + z;
    return c;
}
__device__ __forceinline__ float row_scale(const float* ssq, int row) {
    const f32x4* p = (const f32x4*)(ssq + (size_t)row * 16);
    const f32x4 a = p[0], b = p[1], c = p[2], d = p[3];
    const float s = ((a.x + a.y) + (a.z + a.w)) + ((b.x + b.y) + (b.z + b.w)) + ((c.x + c.y) + (c.z + c.w)) + ((d.x + d.y) + (d.z + d.w));
    return __builtin_amdgcn_rsqf(s * (1.0f / DM) + EPS);
}

__device__ __forceinline__ void row_scales8(const float* ssq, int pm, int wr, int fr, int fq, float (&rs)[8]) {
    f32x4 p[8];
#pragma unroll
    for (int q = 0; q < 8; ++q) { int row = pm * 256 + (q >> 2) * 128 + wr * 64 + (q & 3) * 16 + fr; if (row >= M_ROWS) row = 0; p[q] = *(const f32x4*)(ssq + (size_t)row * 16 + fq * 4); }
#pragma unroll
    for (int q = 0; q < 8; ++q) { float s = (p[q].x + p[q].y) + (p[q].z + p[q].w); s += __shfl_xor(s, 16); s += __shfl_xor(s, 32); rs[q] = __builtin_amdgcn_rsqf(s * (1.0f / DM) + EPS); }
}

struct SchedPlain {
    const bf16_t* A; const bf16_t* B; int lda, ldb, K, nM, nN, G, c, pm0;
    __device__ __forceinline__ bool next(int i, GU& u) const {
        int pm, pn; if (!pg8::tile_order(i, G, c, nM, nN, pm, pn)) return false;
        pm += pm0;
        u.A = A + (size_t)pm * 256 * lda; u.B = B + (size_t)pn * 256 * ldb; u.lda = lda; u.ldb = ldb; u.nt = K / 64; u.pm = pm; u.pn = pn; u.kind = 0; return true;
    }
};
struct SchedS5 {
    const bf16_t* UH; const bf16_t* W; int K, G, c;
    __device__ __forceinline__ bool next(int i, GU& u) const {
        const int L = i * G + c; if (L >= 144) return false;
        const int g = L / 9, pm = L % 9;
        u.A = UH + ((size_t)g * S5RP + (size_t)pm * 256) * 512; u.B = W + (size_t)g * 256 * K; u.lda = 512; u.ldb = K; u.nt = K / 64; u.pm = pm; u.pn = 0; u.kind = g; return true;
    }
};
struct SchedL2 {
    const bf16_t* L1o; const bf16_t* W; int G, c, nM, pm0;
    __device__ __forceinline__ bool next(int i, GU& u) const {
        int pm, pn; if (!pg8::tile_order(i, G, c, nM, 5, pm, pn)) return false;
        pm += pm0;
        const int koff = pn < 2 ? 0 : (pn < 4 ? 128 : 256);
        u.A = L1o + (size_t)pm * 256 * 512 + koff; u.B = W + (size_t)pn * 256 * 256; u.lda = 512; u.ldb = 256; u.nt = 2; u.pm = pm; u.pn = pn; u.kind = 0; return true;
    }
};
struct SchedProj {
    const bf16_t* Hb; const bf16_t* Wg; const bf16_t* Wp; const bf16_t* ya; const bf16_t* yb; const bf16_t* yc; int nM, G, c, pm0;
    __device__ __forceinline__ bool next(int i, GU& u) const {
#ifdef PROJ_TWICE
        const int ti = i / 9, s9 = i - ti * 9, sub = s9 < 6 ? s9 : s9 - 3; int pm, pn;
#elif defined(GATES_TWICE)
        const int ti = i / 9, s9 = i - ti * 9, sub = s9 < 6 ? (s9 >> 1) : s9 - 3; int pm, pn;
#else
        const int ti = i / 6, sub = i - ti * 6; int pm, pn;
#endif
        if (!pg8::tile_order(ti, G, c, nM, 4, pm, pn)) return false;
        pm += pm0;
        u.pm = pm; u.pn = pn; u.kind = sub;
        if (sub < 3) { u.A = Hb + (size_t)pm * 256 * DM; u.lda = DM; u.B = Wg + ((size_t)sub * 1024 + (size_t)pn * 256) * DM; u.ldb = DM; u.nt = 16; }
        else if (sub == 3) { u.A = ya + (size_t)pm * 256 * 256; u.lda = 256; u.B = Wp + (size_t)pn * 256 * DM; u.ldb = DM; u.nt = 4; }
        else if (sub == 4) { u.A = yb + (size_t)pm * 256 * 512; u.lda = 512; u.B = Wp + (size_t)pn * 256 * DM + 256; u.ldb = DM; u.nt = 8; }
        else { u.A = yc + (size_t)pm * 256 * 256; u.lda = 256; u.B = Wp + (size_t)pn * 256 * DM + 768; u.ldb = DM; u.nt = 4; }
        return true;
    }
};

typedef f32x4 Acc[2][2][4][2];
#define EPI_ROWS_BEGIN  _Pragma("unroll") for (int ai = 0; ai < 2; ++ai) _Pragma("unroll") for (int m = 0; m < 4; ++m) { const int rl = ai * 128 + wr * 64 + m * 16 + fr; const int row = u.pm * 256 + rl; (void)rl;
#define EPI_ROWS_END    asm volatile("" ::: "memory"); }
#define EPI_ROWS_END2   asm volatile("" ::: "memory"); }
#define EPI_COL(bj) ((bj) * 128 + wc * 32 + fq * 8)

struct EpiInProj {
    const float* ssq; bf16_t* UH; bf16_t* Pz; bf16_t* Pxbc; bf16_t* Prkvx;
    __device__ __forceinline__ bool operator()(Acc& acc, const GU& u, int wr, int wc, int fr, int fq) const {
        float rs8[8]; row_scales8(ssq, u.pm, wr, fr, fq, rs8);
        EPI_ROWS_BEGIN
            if (row < M_ROWS) {
                const float s = rs8[ai * 4 + m];
                int b, t; bt_of(row, b, t);
#pragma unroll
                for (int bj = 0; bj < 2; ++bj) {
                    const int col = EPI_COL(bj);
                    const f32x4 v0 = acc[ai][bj][m][0] * s, v1 = acc[ai][bj][m][1] * s;
                    u32x4 w; w.x = pk2(v0[0], v0[1]); w.y = pk2(v0[2], v0[3]); w.z = pk2(v1[0], v1[1]); w.w = pk2(v1[2], v1[3]);
                    bf16_t* dst;
                    if (u.pn == 0) { const int g = col >> 4, hh = col & 15; dst = UH + ((size_t)g * S5RP + (size_t)(b * NCH16 + (t >> 4))) * 512 + (t & 15) * 16 + hh; }
                    else if (u.pn < 3) dst = Pz + (size_t)row * 512 + (u.pn - 1) * 256 + col;
                    else if (u.pn < 7) dst = Pxbc + (size_t)row * 1024 + (u.pn - 3) * 256 + col;
                    else dst = Prkvx + (size_t)row * 1024 + (u.pn - 7) * 256 + col;
                    *(u32x4*)dst = w;
                }
            }
        EPI_ROWS_END
        return false;
    }
};
struct EpiS5X {
    float* X;
    __device__ __forceinline__ bool operator()(Acc& acc, const GU& u, int wr, int wc, int fr, int fq) const {
        EPI_ROWS_BEGIN
            float* rp = X + ((size_t)u.kind * S5RP + row) * 256;
#pragma unroll
            for (int bj = 0; bj < 2; ++bj) { const int col = EPI_COL(bj); *(f32x4*)(rp + col) = acc[ai][bj][m][0]; *(f32x4*)(rp + col + 4) = acc[ai][bj][m][1]; }
        EPI_ROWS_END
        return false;
    }
};
struct EpiS5Y {
    bf16_t* yapre;
    __device__ __forceinline__ bool operator()(Acc& acc, const GU& u, int wr, int wc, int fr, int fq) const {
        EPI_ROWS_BEGIN
            if (row < S5ROWS) {
                const int b = row / NCH16, c = row - b * NCH16;
#pragma unroll
                for (int bj = 0; bj < 2; ++bj) {
                    const int col = EPI_COL(bj), i = col >> 4, hh = col & 15;
                    const f32x4 v0 = acc[ai][bj][m][0], v1 = acc[ai][bj][m][1];
                    u32x4 w; w.x = pk2(geluf_(v0[0]), geluf_(v0[1])); w.y = pk2(geluf_(v0[2]), geluf_(v0[3])); w.z = pk2(geluf_(v1[0]), geluf_(v1[1])); w.w = pk2(geluf_(v1[2]), geluf_(v1[3]));
                    *(u32x4*)(yapre + (size_t)row_of(b, c * 16 + i) * 256 + u.kind * 16 + hh) = w;
                }
            }
        EPI_ROWS_END
        return false;
    }
};
struct EpiL1 {
    bf16_t* L1o;
    __device__ __forceinline__ bool operator()(Acc& acc, const GU& u, int wr, int wc, int fr, int fq) const {
        EPI_ROWS_BEGIN
#pragma unroll
            for (int bj = 0; bj < 2; ++bj) {
                const int col = EPI_COL(bj); const int mode = u.pn * 2 + bj;
                f32x4 v0 = acc[ai][bj][m][0], v1 = acc[ai][bj][m][1]; float f[8] = {v0[0], v0[1], v0[2], v0[3], v1[0], v1[1], v1[2], v1[3]};
#pragma unroll
                for (int e = 0; e < 8; ++e) f[e] = mode == 0 ? tanhf_(f[e]) : (mode == 1 ? f[e] : (mode == 2 ? sigmoidf_(f[e]) : 0.f));
                *(u32x4*)(L1o + (size_t)row * 512 + u.pn * 256 + col) = pack8(f);
            }
        EPI_ROWS_END
        return false;
    }
};
struct EpiL2 {
    bf16_t* L2o; const float* w0; const float* a0;
    __device__ __forceinline__ bool operator()(Acc& acc, const GU& u, int wr, int wc, int fr, int fq) const {
        float bias[2][8];
        { const float* bp = u.pn < 2 ? w0 + u.pn * 256 : a0 + (u.pn < 4 ? u.pn - 2 : 0) * 256;
#pragma unroll
          for (int bj = 0; bj < 2; ++bj) { const f32x4 b0 = *(const f32x4*)(bp + EPI_COL(bj)), b1 = *(const f32x4*)(bp + EPI_COL(bj) + 4);
              bias[bj][0] = b0.x; bias[bj][1] = b0.y; bias[bj][2] = b0.z; bias[bj][3] = b0.w; bias[bj][4] = b1.x; bias[bj][5] = b1.y; bias[bj][6] = b1.z; bias[bj][7] = b1.w; } }
        EPI_ROWS_BEGIN
#pragma unroll
            for (int bj = 0; bj < 2; ++bj) {
                const int col = EPI_COL(bj);
                f32x4 v0 = acc[ai][bj][m][0], v1 = acc[ai][bj][m][1]; float f[8] = {v0[0], v0[1], v0[2], v0[3], v1[0], v1[1], v1[2], v1[3]};
                if (u.pn < 2) {
#pragma unroll
                    for (int e = 0; e < 8; ++e) { const float v = bias[bj][e] + f[e]; f[e] = -__expf(-softplusf_(-v) - 0.5f); }
                } else if (u.pn < 4) {
#pragma unroll
                    for (int e = 0; e < 8; ++e) f[e] = sigmoidf_(bias[bj][e] + f[e]);
                }
                *(u32x4*)(L2o + (size_t)row * 1280 + u.pn * 256 + col) = pack8(f);
            }
        EPI_ROWS_END
        return false;
    }
};
struct EpiGLU {
    bf16_t* ya; const float* bias;
    __device__ __forceinline__ bool operator()(Acc& acc, const GU& u, int wr, int wc, int fr, int fq) const {
        const int lc = wc * 32 + fq * 8, oc = u.pn * 128 + lc;
        float bv[8], bg[8];
#pragma unroll
        for (int e = 0; e < 8; ++e) { bv[e] = bias[oc + e]; bg[e] = bias[256 + oc + e]; }
        EPI_ROWS_BEGIN
            const f32x4 a0 = acc[ai][0][m][0], a1 = acc[ai][0][m][1], g0 = acc[ai][1][m][0], g1 = acc[ai][1][m][1];
            float v[8] = {a0[0], a0[1], a0[2], a0[3], a1[0], a1[1], a1[2], a1[3]}, g[8] = {g0[0], g0[1], g0[2], g0[3], g1[0], g1[1], g1[2], g1[3]};
#pragma unroll
            for (int e = 0; e < 8; ++e) v[e] = (v[e] + bv[e]) * sigmoidf_(g[e] + bg[e]);
            *(u32x4*)(ya + (size_t)row * 256 + oc) = pack8(v);
        EPI_ROWS_END
        return false;
    }
};
struct EpiProj {
    const float* ssq; const float* ssqb; unsigned char* park; bf16_t* merged; int tid;
    __device__ __forceinline__ bool operator()(Acc& acc, const GU& u, int wr, int wc, int fr, int fq) const {
        const int k = u.kind;
        float s8[8];
        if (k < 3) row_scales8(ssq, u.pm, wr, fr, fq, s8);
        else if (k < 5) {
            f32x2_t_ sb[8];
#pragma unroll
            for (int g = 0; g < 8; ++g) { int row = u.pm * 256 + (g >> 2) * 128 + wr * 64 + (g & 3) * 16 + fr; if (row >= M_ROWS) row = 0; sb[g] = *(const f32x2_t_*)(ssqb + 2 * (size_t)row); }
#pragma unroll
            for (int g = 0; g < 8; ++g) { const float s = __builtin_amdgcn_rsqf((sb[g].x + sb[g].y) * (1.0f / 512.f) + EPS); s8[g] = k == 3 ? __builtin_amdgcn_rcpf(s) : s; }
        } else {
#pragma unroll
            for (int g = 0; g < 8; ++g) s8[g] = 1.f;
        }
        const int kn = k < 3 ? 0 : k - 3, kd = k < 3 ? 0 : (k < 5 ? k - 2 : 2);
        const unsigned char* pn_ = park + ((size_t)(kn * 16) * NTHREADS + tid) * 16;
        const unsigned char* pd_ = park + ((size_t)(kd * 16) * NTHREADS + tid) * 16;
        unsigned char* pk_ = park + ((size_t)((k < 3 ? k : 0) * 16) * NTHREADS + tid) * 16;
        u32x4 nn[2] = {(u32x4){0u, 0u, 0u, 0u}, (u32x4){0u, 0u, 0u, 0u}}, dd[2] = {nn[0], nn[0]};
        if (k >= 3) {
            nn[0] = *(const u32x4*)(pn_); nn[1] = *(const u32x4*)(pn_ + (size_t)4 * NTHREADS * 16);
            dd[0] = *(const u32x4*)(pd_); dd[1] = *(const u32x4*)(pd_ + (size_t)4 * NTHREADS * 16);
        }
#pragma unroll
        for (int g = 0; g < 8; ++g) {
            const int ai = g >> 2, m = g & 3; const int row = u.pm * 256 + ai * 128 + wr * 64 + m * 16 + fr;
            const float s = s8[g];
            const u32x4 cn[2] = {nn[0], nn[1]}, cd[2] = {dd[0], dd[1]};
            if (k >= 3 && g < 7) {
                const int q0 = (((g + 1) >> 2) * 2 + 0) * 4 + ((g + 1) & 3), q1 = q0 + 4;
                nn[0] = *(const u32x4*)(pn_ + (size_t)q0 * NTHREADS * 16); nn[1] = *(const u32x4*)(pn_ + (size_t)q1 * NTHREADS * 16);
                dd[0] = *(const u32x4*)(pd_ + (size_t)q0 * NTHREADS * 16); dd[1] = *(const u32x4*)(pd_ + (size_t)q1 * NTHREADS * 16);
            }
#pragma unroll
            for (int bj = 0; bj < 2; ++bj) {
                const int q = (ai * 2 + bj) * 4 + m;
                f32x4& v0 = acc[ai][bj][m][0]; f32x4& v1 = acc[ai][bj][m][1];
                if (k < 3) {
                    float f[8] = {v0[0], v0[1], v0[2], v0[3], v1[0], v1[1], v1[2], v1[3]};
#pragma unroll
                    for (int e = 0; e < 8; ++e) f[e] = sigmoidf_(f[e] * s);
                    *(u32x4*)(pk_ + (size_t)q * NTHREADS * 16) = pack8(f);
                } else {
                    float num[8], den[8];
                    unpack8(cn[bj], num);
                    if (k < 5) { unpack8(cd[bj], den);
#pragma unroll
                        for (int e = 0; e < 8; ++e) num[e] = num[e] * __builtin_amdgcn_rcpf(den[e]) * s; }
                    v0[0] *= num[0]; v0[1] *= num[1]; v0[2] *= num[2]; v0[3] *= num[3]; v1[0] *= num[4]; v1[1] *= num[5]; v1[2] *= num[6]; v1[3] *= num[7];
                    if (k == 5) { u32x4 w; w.x = pk2(v0[0], v0[1]); w.y = pk2(v0[2], v0[3]); w.z = pk2(v1[0], v1[1]); w.w = pk2(v1[2], v1[3]);
                        *(u32x4*)(merged + (size_t)row * DM + u.pn * 256 + EPI_COL(bj)) = w; }
                }
            }
            asm volatile("" ::: "memory");
        }
        return k == 3 || k == 4;
    }
};
struct EpiResid {
    bf16_t* H; float* ssq;
    __device__ __forceinline__ bool operator()(Acc& acc, const GU& u, int wr, int wc, int fr, int fq) const {
        bf16_t* hb = H + (size_t)(u.pm * 256 + wr * 64 + fr) * DM + u.pn * 256 + wc * 32 + fq * 8;
        u32x4 nx[2];
#pragma unroll
        for (int bj = 0; bj < 2; ++bj) nx[bj] = *(const u32x4*)(hb + bj * 128);
#pragma unroll
        for (int g = 0; g < 8; ++g) {
            const int ai = g >> 2, m = g & 3; const int row = u.pm * 256 + ai * 128 + wr * 64 + m * 16 + fr;
            const u32x4 cur[2] = {nx[0], nx[1]};
            if (g < 7) {
                const int ai2 = (g + 1) >> 2, m2 = (g + 1) & 3;
#pragma unroll
                for (int bj = 0; bj < 2; ++bj) nx[bj] = *(const u32x4*)(hb + (size_t)(ai2 * 128 + m2 * 16) * DM + bj * 128);
            }
            float ss = 0.f;
#pragma unroll
            for (int bj = 0; bj < 2; ++bj) {
                float f[8]; unpack8(cur[bj], f);
                const f32x4 v0 = acc[ai][bj][m][0], v1 = acc[ai][bj][m][1];
                f[0] += v0[0]; f[1] += v0[1]; f[2] += v0[2]; f[3] += v0[3]; f[4] += v1[0]; f[5] += v1[1]; f[6] += v1[2]; f[7] += v1[3];
#pragma unroll
                for (int e = 0; e < 8; ++e) ss += f[e] * f[e];
                *(u32x4*)(hb + (size_t)(ai * 128 + m * 16) * DM + bj * 128) = pack8(f);
            }
            ss += __shfl_xor(ss, 16); ss += __shfl_xor(ss, 32);
            if (fq == 0) ssq[(size_t)row * 16 + u.pn * 4 + wc] = ss;
            asm volatile("" ::: "memory");
        }
        return false;
    }
};
struct EpiUp {
    const float* ssq; bf16_t* act;
    __device__ __forceinline__ bool operator()(Acc& acc, const GU& u, int wr, int wc, int fr, int fq) const {
        float rs8[8]; row_scales8(ssq, u.pm, wr, fr, fq, rs8);
        EPI_ROWS_BEGIN
            const float s = rs8[ai * 4 + m];
#pragma unroll
            for (int bj = 0; bj < 2; ++bj) {
                const f32x4 v0 = acc[ai][bj][m][0] * s, v1 = acc[ai][bj][m][1] * s; float f[8] = {v0[0], v0[1], v0[2], v0[3], v1[0], v1[1], v1[2], v1[3]};
#pragma unroll
                for (int e = 0; e < 8; ++e) { const float r = fmaxf(f[e], 0.f); f[e] = r * r; }
                *(u32x4*)(act + (size_t)row * DFF + u.pn * 256 + EPI_COL(bj)) = pack8(f);
            }
        EPI_ROWS_END
        return false;
    }
};
typedef __attribute__((address_space(1))) unsigned gu32;
#define XB_TMO      128
#define XB_XCNT(j)  (256  + 64 * (j))
#define XB_XSUB(j)  (1280 + 64 * (j))
#define XB_XGEN(j)  (2304 + 64 * (j))
#define XB_TOP      3328
#define XB_TOPGEN   3392
#define XCD_BAR_WORDS 3456
#define XB_SPIN_CAP (1u << 18)

__device__ __forceinline__ unsigned xb_ld(unsigned* p)              { return __hip_atomic_load(p, __ATOMIC_RELAXED, __HIP_MEMORY_SCOPE_AGENT); }
__device__ __forceinline__ unsigned xb_add(unsigned* p, unsigned v) { return __hip_atomic_fetch_add(p, v, __ATOMIC_RELAXED, __HIP_MEMORY_SCOPE_AGENT); }
__device__ __forceinline__ unsigned xb_xcc_id() { return (unsigned)__builtin_amdgcn_s_getreg((3 << 11) | 20) & 0xFu; }
#define XB_SPIN(cond, bar) do { unsigned _sp = 0; while (cond) { __builtin_amdgcn_s_sleep(1); \
    if ((++_sp & 255u) == 0u) { if (xb_ld(&(bar)[XB_TMO])) break; if (_sp > XB_SPIN_CAP) { atomicAdd(&(bar)[XB_TMO], 1u); break; } } } } while (0)

struct XcdBarrier {
    unsigned* bar; unsigned x;
    volatile LAS unsigned* st;
};

__device__ __forceinline__ XcdBarrier xcd_barrier_post(unsigned* bar, volatile LAS unsigned* st) {
    XcdBarrier b; b.bar = bar; b.x = xb_xcc_id(); b.st = st;
    if (threadIdx.x == 0) (void)xb_add(&bar[XB_XCNT(b.x)], 1u);
    return b;
}
__device__ __forceinline__ void xcd_barrier_complete(unsigned* bar, unsigned x, unsigned& nloc, unsigned& nx) {
    const unsigned G = gridDim.x * gridDim.y * gridDim.z;
    unsigned sum, cnt, mine, sp = 0u;
    for (;;) {
        sum = 0u; cnt = 0u; mine = 0u;
#pragma unroll
        for (unsigned j = 0; j < 16; ++j) { const unsigned c = xb_ld(&bar[XB_XCNT(j)]); sum += c; cnt += (c > 0u) ? 1u : 0u; mine = (j == x) ? c : mine; }
        if (sum == G) break;
        __builtin_amdgcn_s_sleep(1);
        if ((++sp & 255u) == 0u) { if (xb_ld(&bar[XB_TMO])) break; if (sp > XB_SPIN_CAP) { atomicAdd(&bar[XB_TMO], 1u); break; } }
    }
    nloc = mine > 0u ? mine : 1u; nx = cnt > 0u ? cnt : 1u;
}

__device__ __forceinline__ void xcd_barrier(const XcdBarrier& b, int wave_s) {
    const bool xb_t0 = threadIdx.x == 0; (void)wave_s;
    asm volatile("s_waitcnt vmcnt(0)" ::: "memory");
    __syncthreads();
    if (xb_t0) {
        unsigned* bar = b.bar;
        __builtin_amdgcn_s_waitcnt(0);
        unsigned nloc = b.st[0], nx = b.st[1];
        if (nloc == 0u) { xcd_barrier_complete(bar, b.x, nloc, nx); b.st[0] = nloc; b.st[1] = nx; }
        const unsigned old = xb_add(&bar[XB_XSUB(b.x)], 1u);
        const unsigned gen = old / nloc;
        if (old + 1u == (gen + 1u) * nloc) {
            __builtin_amdgcn_fence(__ATOMIC_RELEASE, "agent");
            asm volatile("s_waitcnt vmcnt(0)" ::: "memory");
            const unsigned og = xb_add(&bar[XB_TOP], 1u);
            const unsigned tg = og / nx;
            if (og + 1u == (tg + 1u) * nx) xb_add(&bar[XB_TOPGEN], 1u);
            else XB_SPIN(xb_ld(&bar[XB_TOPGEN]) == tg, bar);
            __builtin_amdgcn_fence(__ATOMIC_ACQUIRE, "agent");
            xb_add(&bar[XB_XGEN(b.x)], 1u);
            asm volatile("s_waitcnt vmcnt(0)" ::: "memory");
        } else {
            XB_SPIN(xb_ld(&bar[XB_XGEN(b.x)]) == gen, bar);
            __builtin_amdgcn_fence(__ATOMIC_ACQUIRE, "agent");
            asm volatile("s_waitcnt vmcnt(0)" ::: "memory");
        }
    }
    __syncthreads();
}


__device__ __forceinline__ void sub_barrier(unsigned* cnt, unsigned n) {
    asm volatile("s_waitcnt vmcnt(0)" ::: "memory");
    __syncthreads();
    if (threadIdx.x == 0) {
        __builtin_amdgcn_s_waitcnt(0);
        __builtin_amdgcn_fence(__ATOMIC_RELEASE, "agent");
        asm volatile("s_waitcnt vmcnt(0)" ::: "memory");
        (void)xb_add(cnt, 1u);
        unsigned sp = 0u; while (xb_ld(cnt) < n) { __builtin_amdgcn_s_sleep(1); if (++sp > XB_SPIN_CAP) break; }
        __builtin_amdgcn_fence(__ATOMIC_ACQUIRE, "agent");
        asm volatile("s_waitcnt vmcnt(0)" ::: "memory");
    }
    __syncthreads();
}
#ifdef PROF_A
#ifndef PROF_SHIFT
#define PROF_SHIFT 1.0f
#endif
#define PROF_PTR ((unsigned long long*)(c.ws + WS_DEC + (size_t)MP * 64))
#define STAMP(k) do { if (blockIdx.x == 0 && threadIdx.x == 0) { const unsigned long long t_ = __builtin_amdgcn_s_memrealtime(); PROF_PTR[k] += t_ - PROF_PTR[15]; PROF_PTR[15] = t_; } } while (0)
#else
#define STAMP(k) do { } while (0)
#endif
struct TJob { const float* src; int ld, col0, K, N; bf16_t* dst; int dld, dk0, rmode, row0; const float* ksc; };
constexpr int N_TJOBS = 27;
__device__ __forceinline__ void get_tjob(const Ctx& c, int l, int j, TJob& t) {
    bf16_t* wb = c.wb(l);
    const float* win = c.in[I_WIN] + (size_t)l * DM * N_IN;
    t.rmode = 0; t.ksc = nullptr; t.dk0 = 0; t.col0 = 0; t.row0 = 0;
    if (j < 5) {
        t.src = win; t.ld = N_IN; t.K = DM; t.dld = DM; t.ksc = c.in[I_MIXNW] + l * DM; t.dst = wb + WB_IN;
        if (j == 0) { t.col0 = 0; t.N = 256; t.row0 = 0; }
        else if (j == 1) { t.col0 = 256; t.N = 512; t.row0 = 256; }
        else if (j == 2) { t.col0 = 768; t.N = 1024; t.row0 = 768; }
        else if (j == 3) { t.col0 = 1800; t.N = 1024; t.row0 = 1792; }
        else { t.col0 = 2824; t.N = 3072; t.row0 = 0; t.dst = wb + WB_G; }
    } else if (j == 5) { t.src = c.in[I_PA] + (size_t)l * 256 * DM; t.ld = DM; t.K = 256; t.N = DM; t.dst = wb + WB_P; t.dld = DM; t.dk0 = 0; }
    else if (j == 6) { t.src = c.in[I_PB] + (size_t)l * 512 * DM; t.ld = DM; t.K = 512; t.N = DM; t.dst = wb + WB_P; t.dld = DM; t.dk0 = 256; t.ksc = c.in[I_SSDNW] + (size_t)l * 512; }
    else if (j == 7) { t.src = c.in[I_PC] + (size_t)l * 256 * DM; t.ld = DM; t.K = 256; t.N = DM; t.dst = wb + WB_P; t.dld = DM; t.dk0 = 768; }
    else if (j == 8) { t.src = c.in[I_WOUT] + (size_t)l * DM * DM; t.ld = DM; t.K = DM; t.N = DM; t.dst = wb + WB_O; t.dld = DM; }
    else if (j == 9) { t.src = c.in[I_MLPW1] + (size_t)l * DM * DFF; t.ld = DFF; t.K = DM; t.N = DFF; t.dst = wb + WB_1; t.dld = DM; t.ksc = c.in[I_MLPNW] + l * DM; }
    else if (j == 10) { t.src = c.in[I_MLPW2] + (size_t)l * DFF * DM; t.ld = DM; t.K = DFF; t.N = DM; t.dst = wb + WB_2; t.dld = DFF; }
    else if (j == 11) { t.src = c.in[I_GLUW] + (size_t)l * 256 * 512; t.ld = 512; t.K = 256; t.N = 512; t.dst = wb + WB_GLU; t.dld = 256; t.rmode = 1; }
    else if (j < 22) {
        const int q = j - 12;
        t.K = 256; t.dst = wb + WB_L1; t.dld = 512;
        if (q < 4) { const int d = q >> 1, hf = q & 1; t.src = c.in[I_W1] + ((size_t)l * 2 + d) * 256 * 64; t.ld = 64; t.N = 64; t.row0 = d * 64; t.dk0 = hf * 256; if (hf) t.ksc = c.in[I_MUWAG] + ((size_t)l * 3 + 0) * 256; }
        else if (q < 8) { const int d = (q - 4) >> 1, hf = q & 1; t.src = c.in[I_A1] + ((size_t)l * 2 + d) * 256 * 64; t.ld = 64; t.N = 64; t.row0 = 128 + d * 64; t.dk0 = hf * 256; if (hf) t.ksc = c.in[I_MUWAG] + ((size_t)l * 3 + 1) * 256; }
        else { const int hf = q & 1; t.src = c.in[I_G1] + (size_t)l * 256 * 128; t.ld = 128; t.N = 128; t.row0 = 256; t.dk0 = hf * 256; if (hf) t.ksc = c.in[I_MUWAG] + ((size_t)l * 3 + 2) * 256; }
    } else {
        const int q = j - 22;
        t.dst = wb + WB_L2; t.dld = 256; t.ld = 256; t.N = 256;
        if (q < 2) { t.src = c.in[I_W2] + ((size_t)l * 2 + q) * 64 * 256; t.K = 64; t.row0 = q * 256; t.dk0 = q * 64; }
        else if (q < 4) { const int d = q - 2; t.src = c.in[I_A2] + ((size_t)l * 2 + d) * 64 * 256; t.K = 64; t.row0 = (2 + d) * 256; t.dk0 = d * 64; }
        else { t.src = c.in[I_G2] + (size_t)l * 128 * 256; t.K = 128; t.row0 = 4 * 256; t.dk0 = 0; }
    }
}
__device__ __forceinline__ int tjob_items(const TJob& t) { return (t.K / 64) * (t.N / 32); }
struct TIt { int l, j, base, gid; bool ok; TJob t; };
__device__ __forceinline__ void tit_seek(const Ctx& c, TIt& s) {
    s.ok = false;
    while (s.l < DEPTH) {
        const int ni = tjob_items(s.t);
        if (s.gid < s.base + ni) { s.ok = true; break; }
        s.base += ni;
        if (++s.j == N_TJOBS) { s.j = 0; ++s.l; if (s.l >= DEPTH) break; }
        get_tjob(c, s.l, s.j, s.t);
    }
}
__device__ __forceinline__ void tr_load(const TJob& t, int item, int lane, float (&v)[32]) {
    const int nblk = t.N / 32, kb = item / nblk, nb = item % nblk, k0 = 64 * kb, n0 = 32 * nb;
    const float* __restrict__ sp = t.src + (size_t)(k0 + (lane >> 5)) * t.ld + t.col0 + n0 + (lane & 31);
#pragma unroll
    for (int i = 0; i < 32; ++i) v[i] = sp[(size_t)(2 * i) * t.ld];
}
__device__ __forceinline__ void tr_store(const TJob& t, LAS float* scr, int item, int lane, const float (&v)[32]) {
    const int nblk = t.N / 32, kb = item / nblk, nb = item % nblk, k0 = 64 * kb, n0 = 32 * nb;
    const int cc = lane & 7;
    f32x4 ka = {1.f, 1.f, 1.f, 1.f}, kb4 = {1.f, 1.f, 1.f, 1.f};
    if (t.ksc) { ka = *(const f32x4*)(t.ksc + k0 + 8 * cc); kb4 = *(const f32x4*)(t.ksc + k0 + 8 * cc + 4); }
#pragma unroll
    for (int i = 0; i < 32; ++i) scr[(2 * i + (lane >> 5)) * 33 + (lane & 31)] = v[i];
    asm volatile("s_waitcnt lgkmcnt(0)" ::: "memory");
#pragma unroll
    for (int j = 0; j < 4; ++j) {
        const int n = (lane >> 3) + 8 * j; const LAS float* s = scr + (8 * cc) * 33 + n;
        u32x4 o; o.x = pk2(s[0 * 33] * ka.x, s[1 * 33] * ka.y); o.y = pk2(s[2 * 33] * ka.z, s[3 * 33] * ka.w); o.z = pk2(s[4 * 33] * kb4.x, s[5 * 33] * kb4.y); o.w = pk2(s[6 * 33] * kb4.z, s[7 * 33] * kb4.w);
        const int nn = n0 + n; int drow;
        if (t.rmode == 0) drow = t.row0 + nn; else drow = nn < 256 ? (nn >> 7) * 256 + (nn & 127) : ((nn - 256) >> 7) * 256 + 128 + ((nn - 256) & 127);
        *(u32x4*)(t.dst + (size_t)drow * t.dld + t.dk0 + k0 + 8 * cc) = o;
    }
    asm volatile("s_waitcnt lgkmcnt(0)" ::: "memory");
}

__device__ __forceinline__ void s5_build(const Ctx& cx_, int l, int g, int part) {
    const Ctx c = relaunder(cx_);
    LAS float* F = (LAS float*)c.lds;
    LAS float* pwr = F;
    LAS float* pwi = pwr + 2176;
    LAS float* cor = pwi + 2176;
    LAS float* coi = cor + 128;
    LAS float* Cr = coi + 128;
    LAS float* Ci = Cr + 1024;
    LAS float* Br = Ci + 1024;
    LAS float* Bi = Br + 1024;
    LAS float* kr = Bi + 1024;
    LAS float* ki = kr + 1984;
    LAS float* Kd = ki + 1984;
    const int tid = c.tid;
    for (int i = tid; i < 2 * 17 * 64; i += NTHREADS) {
        const int d = i / 1088, k = (i - d * 1088) >> 6, n = i & 63; const size_t li_ = (((size_t)l * 2 + d) * 16 + g) * 64 + n;
        const float lr = c.in[I_S5LRE][li_], li = c.in[I_S5LIM][li_], step = expf(c.in[I_S5LS][((size_t)l * 2 + d) * 16 + g]);
        const float mag = expf((float)k * lr * step), ang = (float)k * li * step; float sn, cs; sincosf(ang, &sn, &cs); pwr[(d * 17 + k) * 64 + n] = mag * cs; pwi[(d * 17 + k) * 64 + n] = mag * sn;
    }
    if (tid < 128) {
        const int d = tid >> 6, n = tid & 63; const size_t li_ = (((size_t)l * 2 + d) * 16 + g) * 64 + n;
        const float lr = c.in[I_S5LRE][li_], li = c.in[I_S5LIM][li_], step = expf(c.in[I_S5LS][((size_t)l * 2 + d) * 16 + g]);
        const float mag1 = expf(lr * step); float sn, cs; sincosf(li * step, &sn, &cs); const float abr = mag1 * cs, abi = mag1 * sn, den = lr * lr + li * li;
        cor[d * 64 + n] = ((abr - 1.f) * lr + abi * li) / den; coi[d * 64 + n] = (abi * lr - (abr - 1.f) * li) / den;
    }
    for (int i = tid; i < 1024; i += NTHREADS) {
        Cr[i] = c.in[I_S5CRE][((size_t)l * 16 + g) * 1024 + i]; Ci[i] = c.in[I_S5CIM][((size_t)l * 16 + g) * 1024 + i];
        Br[i] = c.in[I_S5BRE][((size_t)l * 16 + g) * 1024 + i]; Bi[i] = c.in[I_S5BIM][((size_t)l * 16 + g) * 1024 + i];
    }
    __syncthreads();
    for (int i = tid; i < 31 * 64; i += NTHREADS) {
        const int dd = i / 64 - 15, n = i & 63; float r, im;
        if (dd > 0) { const float pr = pwr[(0 * 17 + dd) * 64 + n], pi = pwi[(0 * 17 + dd) * 64 + n]; r = pr * cor[n] - pi * coi[n]; im = pr * coi[n] + pi * cor[n]; }
        else if (dd < 0) { const float pr = pwr[(1 * 17 - dd) * 64 + n], pi = pwi[(1 * 17 - dd) * 64 + n]; r = pr * cor[64 + n] - pi * coi[64 + n]; im = pr * coi[64 + n] + pi * cor[64 + n]; }
        else { r = cor[n] + cor[64 + n]; im = coi[n] + coi[64 + n]; }
        kr[i] = r; ki[i] = im;
    }
    __syncthreads();
    for (int i0 = tid; i0 < 31 * 32; i0 += NTHREADS) {
        const int ddi = i0 >> 5, h = 2 * part + ((i0 >> 4) & 1), hp = i0 & 15; float a = 0.f;
        for (int n = 0; n < 64; ++n) { const float cr = Cr[h * 64 + n], ci = Ci[h * 64 + n], xr = kr[ddi * 64 + n], xi = ki[ddi * 64 + n]; const float pr = cr * xr - ci * xi, pi = cr * xi + ci * xr; a += pr * Br[n * 16 + hp] - pi * Bi[n * 16 + hp]; }
        Kd[ddi * 256 + h * 16 + hp] = a;
    }
    __syncthreads();
    bf16_t* SX = c.wb(l) + WB_SX + (size_t)g * 256 * 256; bf16_t* SY = c.wb(l) + WB_SY + (size_t)g * 256 * 512;
    const float* dsk = c.in[I_S5D] + (size_t)l * 256 + g * 16;
    for (int u = tid; u < 32 * 64; u += NTHREADS) {
        const int i = u >> 7, h = 2 * part + ((u >> 6) & 1), o = i * 16 + h, kk0 = (u & 63) * 8; float v[8];
        if (kk0 < 256) { const int j = kk0 >> 4, hp0 = kk0 & 15;
#pragma unroll
            for (int e = 0; e < 8; ++e) v[e] = Kd[(i - j + 15) * 256 + h * 16 + hp0 + e] + ((i == j && h == hp0 + e) ? dsk[h] : 0.f);
        } else { const int q = kk0 - 256, d = q >> 7, part = (q >> 6) & 1, n0 = q & 63, ex = d == 0 ? i + 1 : 16 - i;
#pragma unroll
            for (int e = 0; e < 8; ++e) { const int n = n0 + e; const float cr = Cr[h * 64 + n], ci = Ci[h * 64 + n], pr = pwr[(d * 17 + ex) * 64 + n], pi = pwi[(d * 17 + ex) * 64 + n]; v[e] = part == 0 ? (cr * pr - ci * pi) : -(cr * pi + ci * pr); }
        }
        *(u32x4*)(SY + (size_t)o * 512 + kk0) = pack8(v);
    }
    for (int u = tid; u < 32 * 32; u += NTHREADS) {
        const int o = 32 * part + (u >> 5), kk0 = (u & 31) * 8, d = o >> 7, part = (o >> 6) & 1, n = o & 63, j = kk0 >> 4, hp0 = kk0 & 15, ex = d == 0 ? 15 - j : j;
        const float pr = pwr[(d * 17 + ex) * 64 + n], pi = pwi[(d * 17 + ex) * 64 + n], qr = pr * cor[d * 64 + n] - pi * coi[d * 64 + n], qi = pr * coi[d * 64 + n] + pi * cor[d * 64 + n];
        float v[8];
#pragma unroll
        for (int e = 0; e < 8; ++e) { const float br = Br[n * 16 + hp0 + e], bi = Bi[n * 16 + hp0 + e]; v[e] = part == 0 ? (qr * br - qi * bi) : (qr * bi + qi * br); }
        *(u32x4*)(SX + (size_t)o * 256 + kk0) = pack8(v);
    }
    __syncthreads();
}

__device__ __forceinline__ void phase0(const Ctx& cx_) {
    const Ctx c = relaunder(cx_);
    if (c.bid < 256) s5_build(c, c.bid >> 7, (c.bid >> 3) & 15, c.bid & 7);
    STAMP(13);
    const int gw = c.bid * NWAVES + c.wave, NGW = c.G * NWAVES, lane = c.lane;
    bf16_t* H = c.H(); float* ssq = c.ssq();
#pragma unroll 4
    for (int m = gw; m < MP; m += NGW) {
        u32x2* hp = (u32x2*)(H + (size_t)m * DM);
        if (m >= M_ROWS) {
#pragma unroll
            for (int i = 0; i < 4; ++i) hp[lane + 64 * i] = (u32x2){0u, 0u};
            continue;
        }
        int b, t; bt_of(m, b, t);
        const f32x4* src = (const f32x4*)(t < NMETA ? c.in[I_META] + (size_t)t * DM : c.in[I_X] + ((size_t)b * SEQ + (t - NMETA)) * DM);
        float ss = 0.f;
#pragma unroll
        for (int i = 0; i < 4; ++i) { const f32x4 v = src[lane + 64 * i]; ss += (v.x * v.x + v.y * v.y) + (v.z * v.z + v.w * v.w); hp[lane + 64 * i] = (u32x2){pk2(v.x, v.y), pk2(v.z, v.w)}; }
        ss = wave_sum(ss);
        if (lane < 16) ssq[(size_t)m * 16 + lane] = lane == 0 ? ss : 0.f;
    }
    STAMP(14);
    LAS float* scr = (LAS float*)(c.lds + c.wave * 8448);
    {
        TIt a; a.l = 0; a.j = 0; a.base = 0; a.gid = gw; get_tjob(c, 0, 0, a.t); tit_seek(c, a);
        float v[32], w[32];
        if (a.ok) tr_load(a.t, a.gid - a.base, lane, v);
        while (a.ok) {
            TIt b = a; b.gid += NGW; tit_seek(c, b);
            if (b.ok) tr_load(b.t, b.gid - b.base, lane, w);
            tr_store(a.t, scr, a.gid - a.base, lane, v);
            a = b;
#pragma unroll
            for (int i = 0; i < 32; ++i) v[i] = w[i];
        }
    }
    for (int l = 0; l < DEPTH; ++l) {
        bf16_t* wb = c.wb(l);
        const int gt = c.bid * NTHREADS + c.tid, NGT = c.G * NTHREADS;
        for (int u = gt; u < 128 * 64; u += NGT) *(u32x4*)(wb + WB_L1 + (size_t)384 * 512 + (size_t)u * 8) = (u32x4){0u, 0u, 0u, 0u};
        for (int u = gt; u < 5 * 256 * 4 * 8; u += NGT) {
            const int sub = u & 7, blk = (u >> 3) & 3, row = (u >> 5) & 255, tile = u >> 13;
            const bool nz = (tile == 0 || tile == 2) ? (blk == 0) : ((tile == 1 || tile == 3) ? (blk == 1) : (blk < 2));
            if (!nz) *(u32x4*)(wb + WB_L2 + ((size_t)tile * 256 + row) * 256 + blk * 64 + sub * 8) = (u32x4){0u, 0u, 0u, 0u};
        }
    }
}

__device__ __forceinline__ void dt_job(const Ctx& cx_, int l) {
    const Ctx c = relaunder(cx_);
    constexpr int DTS = 1032;
    LAS bf16_t* dtw = (LAS bf16_t*)c.lds;
    const float* win = c.in[I_WIN] + (size_t)l * DM * N_IN; const float* nw = c.in[I_MIXNW] + l * DM;
    {
        f32x4 wv[2][2]; float sc[2];
#pragma unroll
        for (int r = 0; r < 2; ++r) { const int k = c.tid + r * NTHREADS; const f32x4* wp = (const f32x4*)(win + (size_t)k * N_IN + 1792); wv[r][0] = wp[0]; wv[r][1] = wp[1]; sc[r] = nw[k]; }
#pragma unroll
        for (int r = 0; r < 2; ++r) { const int k = c.tid + r * NTHREADS;
#pragma unroll
            for (int j = 0; j < 8; ++j) { const float w = sc[r] * wv[r][j >> 2][j & 3]; const unsigned hi = f2bf(w); const float lo = w - __builtin_bit_cast(float, hi << 16);
                dtw[j * DTS + k] = (bf16_t)hi; dtw[(8 + j) * DTS + k] = (bf16_t)f2bf(lo); } }
    }
    __syncthreads();
    const int gw = c.bid * NWAVES + c.wave, NGW = c.G * NWAVES, lane = c.lane, li = lane & 15, lq = lane >> 4;
    const bf16_t* H = c.H(); float* dt = (float*)(c.ws + WS_DT); float* dec = (float*)(c.ws + WS_DEC); const float* ssq = c.ssq();
    const float* dtb = c.in[I_DTB] + l * 16; const float* alog = c.in[I_ALOG] + l * 16;
    float bias[2][4], ea[2][4];
#pragma unroll
    for (int d = 0; d < 2; ++d)
#pragma unroll
        for (int jj = 0; jj < 4; ++jj) { const int o = d * 8 + 4 * (lq & 1) + jj; bias[d][jj] = dtb[o]; ea[d][jj] = __expf(alog[o]); }
    for (int blk = gw; blk < M_ROWS / 16; blk += NGW) {
        const int row = blk * 16 + li;
        const bf16_t* __restrict__ hp = H + (size_t)row * DM + lq * 8; const LAS bf16_t* wp = dtw + li * DTS + lq * 8;
        f32x4 acc = {0.f, 0.f, 0.f, 0.f};
#pragma unroll 8
        for (int k = 0; k < 32; ++k) acc = __builtin_amdgcn_mfma_f32_16x16x32_bf16(*(const LAS bf16x8*)(wp + k * 32), *(const bf16x8*)(hp + k * 32), acc, 0, 0, 0);
        const f32x4 pq = *(const f32x4*)(ssq + (size_t)row * 16 + lq * 4);
        float sq = (pq.x + pq.y) + (pq.z + pq.w); sq += __shfl_xor(sq, 16); sq += __shfl_xor(sq, 32);
        const float s = __builtin_amdgcn_rsqf(sq * (1.0f / DM) + EPS);
        float d4[4];
#pragma unroll
        for (int jj = 0; jj < 4; ++jj) d4[jj] = acc[jj] + __shfl_xor(acc[jj], 32);
        if (lq < 2) {
#pragma unroll
            for (int d = 0; d < 2; ++d) {
                f32x4 dv, cv;
#pragma unroll
                for (int jj = 0; jj < 4; ++jj) { const float v = softplusf_(d4[jj] * s + bias[d][jj]); dv[jj] = v; cv[jj] = -v * ea[d][jj]; }
                *(f32x4*)(dt + (size_t)row * 16 + d * 8 + 4 * lq) = dv; *(f32x4*)(dec + (size_t)row * 16 + d * 8 + 4 * lq) = cv;
            }
        }
    }
    __syncthreads();
}

__device__ __forceinline__ void rwkv_prep(const Ctx& cx_, int l) {
    const Ctx c = relaunder(cx_);
    const int gw = c.bid * NWAVES + c.wave, NGW = c.G * NWAVES, lane = c.lane, c0 = 4 * lane;
    const bf16_t* __restrict__ P = (const bf16_t*)(c.ws + WS_PRKVX); bf16_t* __restrict__ rk = (bf16_t*)(c.dout + DO_RKVP); bf16_t* __restrict__ l1 = (bf16_t*)(c.ws + WS_L1IN);
    float mu[3][4], kkw[4];
#pragma unroll
    for (int x = 0; x < 3; ++x)
#pragma unroll
        for (int e = 0; e < 4; ++e) mu[x][e] = c.in[I_MURKV][((size_t)l * 3 + x) * 256 + c0 + e];
#pragma unroll
    for (int e = 0; e < 4; ++e) kkw[e] = c.in[I_KK][(size_t)l * 256 + c0 + e];
#pragma unroll 4
    for (int m = gw; m < M_ROWS; m += NGW) {
        int b, t; bt_of(m, b, t); const bool hp = t > 0, hn = t < LEN - 1; const size_t mp_ = hp ? row_of(b, t - 1) : 0, mn_ = hn ? row_of(b, t + 1) : 0;
        float o[4][4];
        float xc[4], dxc[4];
#pragma unroll
        for (int x = 0; x < 4; ++x) {
            const u32x2 wc_ = *(const u32x2*)(P + (size_t)m * 1024 + x * 256 + c0);
            u32x2 wp = (u32x2){0u, 0u}, wn = (u32x2){0u, 0u};
            if (hp) wp = *(const u32x2*)(P + mp_ * 1024 + x * 256 + c0);
            if (hn) wn = *(const u32x2*)(P + mn_ * 1024 + x * 256 + c0);
            const float cur[4] = {bflo(wc_.x), bfhi(wc_.x), bflo(wc_.y), bfhi(wc_.y)}, pv[4] = {bflo(wp.x), bfhi(wp.x), bflo(wp.y), bfhi(wp.y)}, nv[4] = {bflo(wn.x), bfhi(wn.x), bflo(wn.y), bfhi(wn.y)};
#pragma unroll
            for (int e = 0; e < 4; ++e) { const float cs = 0.5f * (pv[e] + nv[e]) - cur[e]; if (x < 3) o[x][e] = cur[e] + cs * mu[x][e]; else { xc[e] = cur[e]; dxc[e] = cs; } }
        }
        float kr_[4], ss = 0.f;
#pragma unroll
        for (int e = 0; e < 4; ++e) { kr_[e] = o[1][e] * kkw[e]; ss += kr_[e] * kr_[e]; }
        ss = sum16(ss); const float rn = __builtin_amdgcn_rsqf(ss + 1e-12f);
        bf16_t* rp = rk + (size_t)m * 1024 + c0;
        *(u32x2*)(rp) = (u32x2){pk2(o[0][0], o[0][1]), pk2(o[0][2], o[0][3])};
        *(u32x2*)(rp + 256) = (u32x2){pk2(o[1][0], o[1][1]), pk2(o[1][2], o[1][3])};
        *(u32x2*)(rp + 512) = (u32x2){pk2(o[2][0], o[2][1]), pk2(o[2][2], o[2][3])};
        *(u32x2*)(rp + 768) = (u32x2){pk2(kr_[0] * rn, kr_[1] * rn), pk2(kr_[2] * rn, kr_[3] * rn)};
        bf16_t* lp = l1 + (size_t)m * 512 + c0;
        *(u32x2*)(lp) = (u32x2){pk2(xc[0], xc[1]), pk2(xc[2], xc[3])};
        *(u32x2*)(lp + 256) = (u32x2){pk2(dxc[0], dxc[1]), pk2(dxc[2], dxc[3])};
    }
}
__device__ __forceinline__ void ssd_prep(const Ctx& cx_, int l) {
    const Ctx c = relaunder(cx_);
    const int gw = c.bid * NWAVES + c.wave, NGW = c.G * NWAVES, lane = c.lane, c0 = 16 * lane;
    const bf16_t* __restrict__ P = (const bf16_t*)(c.ws + WS_PXBC); bf16_t* __restrict__ xs = (bf16_t*)(c.ws + WS_XS); bf16_t* __restrict__ bc = (bf16_t*)(c.ws + WS_BC);
    float w[5][16], bias[16];
#pragma unroll
    for (int j = 0; j < 5; ++j)
#pragma unroll
        for (int e = 0; e < 16; ++e) w[j][e] = c.in[I_CONVW][((size_t)l * 5 + j) * 1024 + c0 + e];
#pragma unroll
    for (int e = 0; e < 16; ++e) bias[e] = c.in[I_CONVB][(size_t)l * 1024 + c0 + e];
#pragma unroll 2
    for (int m = gw; m < M_ROWS; m += NGW) {
        int b, t; bt_of(m, b, t);
        float a[16];
#pragma unroll
        for (int e = 0; e < 16; ++e) a[e] = bias[e];
#pragma unroll
        for (int j = 0; j < 5; ++j) {
            const int tt = t + j - 2;
            if (tt >= 0 && tt < LEN) {
                const u32x4* p = (const u32x4*)(P + (size_t)row_of(b, tt) * 1024 + c0); float f0[8], f1[8]; unpack8(p[0], f0); unpack8(p[1], f1);
#pragma unroll
                for (int e = 0; e < 8; ++e) { a[e] += w[j][e] * f0[e]; a[8 + e] += w[j][8 + e] * f1[e]; }
            }
        }
        float o0[8], o1[8];
#pragma unroll
        for (int e = 0; e < 8; ++e) { o0[e] = siluf_(a[e]); o1[e] = siluf_(a[8 + e]); }
        bf16_t* dst = lane < 32 ? xs + (size_t)m * 512 + c0 : bc + (size_t)m * 512 + (c0 - 512);
        ((u32x4*)dst)[0] = pack8(o0); ((u32x4*)dst)[1] = pack8(o1);
    }
}

__device__ __forceinline__ void s5_scan(const Ctx& cx_, int l, int idx, int nblk) {
    const Ctx c = relaunder(cx_);
    for (int task = idx; task < 256; task += nblk) {
    const int gt = task * 64 + c.lane;
    const int n = gt & 63, d = (gt >> 6) & 1, b = (gt >> 7) & 7, g = gt >> 10, seg = c.wave, i0 = 33 * seg;
    const size_t li_ = (((size_t)l * 2 + d) * 16 + g) * 64 + n;
    const float lr = c.in[I_S5LRE][li_], li = c.in[I_S5LIM][li_], step = expf(c.in[I_S5LS][((size_t)l * 2 + d) * 16 + g]);
    const float mag = expf(16.f * lr * step); float sn, cs; sincosf(16.f * li * step, &sn, &cs); const float ar = mag * cs, ai = mag * sn;
    const float* __restrict__ X = (const float*)(c.ws + WS_X) + ((size_t)g * S5RP + (size_t)b * NCH16) * 256 + d * 128 + n;
    bf16_t* __restrict__ U = (bf16_t*)(c.ws + WS_UH) + ((size_t)g * S5RP + (size_t)b * NCH16) * 512 + 256 + d * 128 + n;
    LAS float* tot = (LAS float*)c.lds;
    float xr[33], xi[33];
#pragma unroll
    for (int k = 0; k < 33; ++k) { const int i = i0 + k; const int ch = d == 0 ? i : NCH16 - 1 - i; const bool ok = i < NCH16; xr[k] = ok ? X[(size_t)ch * 256] : 0.f; xi[k] = ok ? X[(size_t)ch * 256 + 64] : 0.f; }
    float hr = 0.f, hi = 0.f, pr = 1.f, pi = 0.f;
#pragma unroll
    for (int k = 0; k < 33; ++k) {
        const float nr = ar * hr - ai * hi + xr[k], ni = ar * hi + ai * hr + xi[k]; hr = nr; hi = ni;
        const float qr = pr * ar - pi * ai, qi = pr * ai + pi * ar; pr = qr; pi = qi;
    }
    __syncthreads();
    tot[(seg * 2 + 0) * 64 + c.lane] = hr; tot[(seg * 2 + 1) * 64 + c.lane] = hi;
    __syncthreads();
    hr = 0.f; hi = 0.f;
    for (int s = 0; s < seg; ++s) { const float tr = tot[(s * 2 + 0) * 64 + c.lane], ti = tot[(s * 2 + 1) * 64 + c.lane]; const float nr = pr * hr - pi * hi + tr, ni = pr * hi + pi * hr + ti; hr = nr; hi = ni; }
#pragma unroll
    for (int k = 0; k < 33; ++k) { const int i = i0 + k;
        if (i < NCH16) { const int ch = d == 0 ? i : NCH16 - 1 - i; U[(size_t)ch * 512] = (bf16_t)f2bf(hr); U[(size_t)ch * 512 + 64] = (bf16_t)f2bf(hi); }
        const float nr = ar * hr - ai * hi + xr[k], ni = ar * hi + ai * hr + xi[k]; hr = nr; hi = ni; }
    __syncthreads();
    }
}
typedef short s16x4 __attribute__((ext_vector_type(4)));
__device__ __forceinline__ s16x4 lds_tr(const LAS unsigned char* p) { return __builtin_bit_cast(s16x4, __builtin_amdgcn_ds_read_tr16_b64_v4i16((LAS s16x4*)p)); }
__device__ __forceinline__ bf16x8 frag_tr(const LAS unsigned char* img, int rs, int kbase, int colbase, int lane) {
    const LAS unsigned char* a = img + (kbase + 8 * (lane >> 4) + ((lane & 15) >> 2)) * rs + (colbase + 4 * (lane & 3)) * 2;
    const s16x4 lo = lds_tr(a), hi = lds_tr(a + 4 * rs);
    return (bf16x8){lo[0], lo[1], lo[2], lo[3], hi[0], hi[1], hi[2], hi[3]};
}
__device__ __forceinline__ bf16x8 frag_row(const LAS unsigned char* img, int rs, int rowbase, int kbase, int lane) {
    return *(const LAS bf16x8*)(img + (rowbase + (lane & 15)) * rs + (kbase + 8 * (lane >> 4)) * 2);
}
constexpr int SD_RS = 272;
constexpr int SD_XRS = 144;
constexpr int SD_OFF_C = 0, SD_OFF_B = 34816, SD_OFF_X = 69632, SD_OFF_M = 88064, SD_OFF_SC = 122880;
constexpr int SD_OFF_HF = SD_OFF_B, SD_OFF_HB = SD_OFF_B + 17408;
constexpr size_t WS_STB = WS_YSSD;
constexpr size_t WS_CDEC = WS_DEC + (size_t)MP * 64 + 256;
constexpr size_t WS_SSQB = WS_CDEC + (size_t)BATCH * 33 * 16 * 4;
constexpr size_t WS_BAR = (WS_SSQB + (size_t)MP * 8 + 255) / 256 * 256;
static_assert(WS_BAR + 3456 * 4 <= 7 * QB, "small region");
static_assert((size_t)BATCH * 2 * 8 * 32 * 8192 * 2 <= 4 * QB, "chunk states fit the yssd slot");

struct SsdUnit { int b, ck, t0, ns; };
__device__ __forceinline__ bool ssd_unit(int bid, int round, SsdUnit& u) {
    if (round == 0) { u.b = bid >> 5; u.ck = 1 + (bid & 31); u.t0 = NMETA + 128 * (u.ck - 1); u.ns = 8; return true; }
    if (round == 1 && bid < BATCH) { u.b = bid; u.ck = 0; u.t0 = 0; u.ns = 1; return true; }
    return false;
}
__device__ __forceinline__ bool ssd_unit_n(int idx, int nblk, int round, SsdUnit& u, int& grp) {
    const int n2 = idx + nblk * round; if (n2 >= 528) return false; const int n = n2 >> 1; grp = n2 & 1;
    if (n < 256) { u.b = n >> 5; u.ck = 1 + (n & 31); u.t0 = NMETA + 128 * (u.ck - 1); u.ns = 8; } else { u.b = n - 256; u.ck = 0; u.t0 = 0; u.ns = 1; }
    return true;
}
__device__ __forceinline__ void ssd_load_img(LAS unsigned char* img, int rs, const bf16_t* src, int ld, size_t m0, int col0, int ncol, int ns, int tid) {
    const int cpr = ncol / 8, nrow = ns == 1 ? 32 : 128;
    for (int i = tid; i < nrow * cpr; i += NTHREADS) {
        const int r = i / cpr, cc = i - r * cpr; u32x4 v = (u32x4){0u, 0u, 0u, 0u};
        if (r < 16 * ns) v = *(const u32x4*)(src + (m0 + r) * ld + col0 + cc * 8);
        *(LAS u32x4*)(img + r * rs + cc * 16) = v;
    }
}
__device__ __forceinline__ void ssd_scalars(LAS float* sc, const float* dt, const float* al, size_t m0, int head, int ns, int lane, float& totf, float& totb) {
    const int Q = 16 * ns;
    float a0f = 0.f, a1f = 0.f, a0b = 0.f, a1b = 0.f, d0f = 0.f, d1f = 0.f, d0b = 0.f, d1b = 0.f;
    const int s0 = 2 * lane, s1 = 2 * lane + 1;
    if (s0 < Q) { a0f = al[(m0 + s0) * 16 + head]; a0b = al[(m0 + s0) * 16 + 8 + head]; d0f = dt[(m0 + s0) * 16 + head]; d0b = dt[(m0 + s0) * 16 + 8 + head]; }
    if (s1 < Q) { a1f = al[(m0 + s1) * 16 + head]; a1b = al[(m0 + s1) * 16 + 8 + head]; d1f = dt[(m0 + s1) * 16 + head]; d1b = dt[(m0 + s1) * 16 + 8 + head]; }
    float pf = a0f + a1f, pb = a0b + a1b;
#pragma unroll
    for (int o = 1; o < 64; o <<= 1) { const float tf = __shfl_up(pf, o), tb = __shfl_up(pb, o); if (lane >= o) { pf += tf; pb += tb; } }
    totf = __shfl(pf, 63); totb = __shfl(pb, 63);
    const float af1 = pf, af0 = pf - a1f;
    const float eb0 = pb - a0b - a1b, eb1 = pb - a1b;
    sc[s0] = af0; sc[s1] = af1; sc[128 + s0] = eb0; sc[128 + s1] = eb1; sc[256 + s0] = d0f; sc[256 + s1] = d1f; sc[384 + s0] = d0b; sc[384 + s1] = d1b;
    sc[512 + s0] = __expf(totf - af0) * d0f; sc[512 + s1] = __expf(totf - af1) * d1f;
    sc[640 + s0] = __expf(eb0) * d0b; sc[640 + s1] = __expf(eb1) * d1b;
    sc[768 + s0] = __expf(af0); sc[768 + s1] = __expf(af1);
    sc[896 + s0] = __expf(totb - eb0); sc[896 + s1] = __expf(totb - eb1);
}

__device__ __forceinline__ void ssd_states(const Ctx& cx_, int l, int idx, int nblk) {
    const Ctx c = relaunder(cx_);
    const int tid = c.tid, lane = c.lane, wave = c.wave;
    const bf16_t* bc = (const bf16_t*)(c.ws + WS_BC); const bf16_t* xs = (const bf16_t*)(c.ws + WS_XS);
    const float* dt = (const float*)(c.ws + WS_DT); const float* al = (const float*)(c.ws + WS_DEC);
    bf16_t* stb = (bf16_t*)(c.ws + WS_STB); float* cdec = (float*)(c.ws + WS_CDEC);
    LAS unsigned char* Bimg = c.lds + SD_OFF_B; LAS unsigned char* Ximg = c.lds + SD_OFF_X; LAS float* sc = (LAS float*)(c.lds + SD_OFF_SC);
    for (int round = 0; ; ++round) {
        SsdUnit u; int g; if (!ssd_unit_n(idx, nblk, round, u, g)) break;
        const size_t m0 = (size_t)row_of(u.b, u.t0); const int nks = u.ns == 1 ? 1 : 4;
        {
            __syncthreads();
            ssd_load_img(Bimg, SD_RS, bc, 512, m0, g * 128, 128, u.ns, tid);
            for (int j = 0; j < 4; ++j) {
                const int head = g * 4 + j;
                if (j) __syncthreads();
                ssd_load_img(Ximg, SD_XRS, xs, 512, m0, head * 64, 64, u.ns, tid);
                if (wave == 0) { float totf, totb; ssd_scalars(sc, dt, al, m0, head, u.ns, lane, totf, totb);
                    if (lane == 0) { cdec[((size_t)u.b * 33 + u.ck) * 16 + head] = __expf(totf); cdec[((size_t)u.b * 33 + u.ck) * 16 + 8 + head] = __expf(totb); } }
                __syncthreads();
                f32x4 accf[4], accb[4];
#pragma unroll
                for (int pt = 0; pt < 4; ++pt) { accf[pt] = (f32x4){0.f, 0.f, 0.f, 0.f}; accb[pt] = accf[pt]; }
                for (int ks = 0; ks < nks; ++ks) {
                    const bf16x8 af = frag_tr(Bimg, SD_RS, 32 * ks, 16 * wave, lane);
                    const int k0 = 32 * ks + 8 * (lane >> 4);
                    const f32x4 wf0 = *(const LAS f32x4*)(sc + 512 + k0), wf1 = *(const LAS f32x4*)(sc + 512 + k0 + 4), wb0 = *(const LAS f32x4*)(sc + 640 + k0), wb1 = *(const LAS f32x4*)(sc + 640 + k0 + 4);
#pragma unroll
                    for (int pt = 0; pt < 4; ++pt) {
                        const bf16x8 xr = frag_tr(Ximg, SD_XRS, 32 * ks, 16 * pt, lane);
                        float xf[8];
#pragma unroll
                        for (int e = 0; e < 8; ++e) xf[e] = bf1((bf16_t)xr[e]);
                        bf16x8 bfv, bbv;
                        { const unsigned p0 = pk2(xf[0] * wf0.x, xf[1] * wf0.y), p1 = pk2(xf[2] * wf0.z, xf[3] * wf0.w), p2 = pk2(xf[4] * wf1.x, xf[5] * wf1.y), p3 = pk2(xf[6] * wf1.z, xf[7] * wf1.w);
                          bfv = __builtin_bit_cast(bf16x8, (u32x4){p0, p1, p2, p3}); }
                        { const unsigned p0 = pk2(xf[0] * wb0.x, xf[1] * wb0.y), p1 = pk2(xf[2] * wb0.z, xf[3] * wb0.w), p2 = pk2(xf[4] * wb1.x, xf[5] * wb1.y), p3 = pk2(xf[6] * wb1.z, xf[7] * wb1.w);
                          bbv = __builtin_bit_cast(bf16x8, (u32x4){p0, p1, p2, p3}); }
                        accf[pt] = __builtin_amdgcn_mfma_f32_16x16x32_bf16(af, bfv, accf[pt], 0, 0, 0);
                        accb[pt] = __builtin_amdgcn_mfma_f32_16x16x32_bf16(af, bbv, accb[pt], 0, 0, 0);
                    }
                }
#pragma unroll
                for (int pt = 0; pt < 4; ++pt) {
                    const int p = 16 * pt + (lane & 15), n0 = 16 * wave + 4 * (lane >> 4);
                    if (u.ck <= 31) { bf16_t* d = stb + ((((size_t)u.b * 2 + 0) * 8 + head) * 32 + u.ck) * 8192 + (size_t)p * 128 + n0; *(u32x2*)d = (u32x2){pk2(accf[pt][0], accf[pt][1]), pk2(accf[pt][2], accf[pt][3])}; }
                    if (u.ck >= 1) { bf16_t* d = stb + ((((size_t)u.b * 2 + 1) * 8 + head) * 32 + (u.ck - 1)) * 8192 + (size_t)p * 128 + n0; *(u32x2*)d = (u32x2){pk2(accb[pt][0], accb[pt][1]), pk2(accb[pt][2], accb[pt][3])}; }
                }
            }
        }
    }
    __syncthreads();
}

__device__ __forceinline__ void ssd_chunk_scan(const Ctx& cx_, int l, int idx, int nblk) {
    const Ctx c = relaunder(cx_);
    bf16_t* stb = (bf16_t*)(c.ws + WS_STB); const float* cdec = (const float*)(c.ws + WS_CDEC);
    for (int gt = idx * NTHREADS + c.tid; gt < BATCH * 16 * 1024; gt += nblk * NTHREADS) {
    const int e8 = gt & 1023, bdh = gt >> 10;
    const int head = bdh & 7, dir = (bdh >> 3) & 1, b = bdh >> 4;
    bf16_t* base = stb + (size_t)bdh * 32 * 8192 + (size_t)e8 * 8;
    float h[8] = {0.f, 0.f, 0.f, 0.f, 0.f, 0.f, 0.f, 0.f};
    for (int i0 = 0; i0 < 32; i0 += 8) {
        u32x4 v[8]; float dcy[8];
#pragma unroll
        for (int k = 0; k < 8; ++k) { const int slot = dir == 0 ? i0 + k : 31 - (i0 + k); v[k] = *(const u32x4*)(base + (size_t)slot * 8192);
            const int ck = dir == 0 ? slot : slot + 1; dcy[k] = cdec[((size_t)b * 33 + ck) * 16 + dir * 8 + head]; }
#pragma unroll
        for (int k = 0; k < 8; ++k) { const int slot = dir == 0 ? i0 + k : 31 - (i0 + k); float s[8]; unpack8(v[k], s);
#pragma unroll
            for (int e = 0; e < 8; ++e) h[e] = h[e] * dcy[k] + s[e];
            *(u32x4*)(base + (size_t)slot * 8192) = pack8(h); }
    }
    }
}

__device__ __forceinline__ void ssd_outputs(const Ctx& cx_, int l, int first, int nblk) {
    const Ctx c = relaunder(cx_);
    const int tid = c.tid, lane = c.lane, wave = c.wave;
    const bf16_t* bc = (const bf16_t*)(c.ws + WS_BC); const bf16_t* xs = (const bf16_t*)(c.ws + WS_XS); const bf16_t* pz = (const bf16_t*)(c.ws + WS_PZ);
    const float* dt = (const float*)(c.ws + WS_DT); const float* al = (const float*)(c.ws + WS_DEC);
    const bf16_t* stb = (const bf16_t*)(c.ws + WS_STB); bf16_t* yb = (bf16_t*)(c.ws + WS_YB); float* ssqb = (float*)(c.ws + WS_SSQB);
    LAS unsigned char* Cimg = c.lds + SD_OFF_C; LAS unsigned char* Bimg = c.lds + SD_OFF_B; LAS unsigned char* Ximg = c.lds + SD_OFF_X;
    LAS unsigned char* HfT = c.lds + SD_OFF_HF; LAS unsigned char* HbT = c.lds + SD_OFF_HB;
    LAS unsigned char* Ms = c.lds + SD_OFF_M + wave * 4352; LAS float* sc = (LAS float*)(c.lds + SD_OFF_SC);
    for (int round = 0; round < 8; ++round) {
        SsdUnit u; int g0; if (!ssd_unit_n(c.bid - first, nblk, round, u, g0)) break;
        const size_t m0 = (size_t)row_of(u.b, u.t0); const int nks = u.ns == 1 ? 1 : 4; const bool active = wave < u.ns;
        float ssrow = 0.f;
        for (int g = g0; g <= g0; ++g) {
            __syncthreads();
            ssd_load_img(Cimg, SD_RS, bc, 512, m0, 256 + g * 128, 128, u.ns, tid);
            ssd_load_img(Bimg, SD_RS, bc, 512, m0, g * 128, 128, u.ns, tid);
            __syncthreads();
            f32x4 cb[8];
#pragma unroll
            for (int t = 0; t < 8; ++t) cb[t] = (f32x4){0.f, 0.f, 0.f, 0.f};
            if (active) {
#pragma unroll
                for (int ks = 0; ks < 4; ++ks) {
                    const bf16x8 cfr = frag_row(Cimg, SD_RS, 16 * wave, 32 * ks, lane);
#pragma unroll
                    for (int t = 0; t < 8; ++t) if (t < u.ns) cb[t] = __builtin_amdgcn_mfma_f32_16x16x32_bf16(frag_row(Bimg, SD_RS, 16 * t, 32 * ks, lane), cfr, cb[t], 0, 0, 0);
                }
            }
            for (int j = 0; j < 4; ++j) {
                const int head = g * 4 + j;
                __syncthreads();
                ssd_load_img(Ximg, SD_XRS, xs, 512, m0, head * 64, 64, u.ns, tid);
                {
                    const bf16_t* hf = u.ck >= 1 ? stb + ((((size_t)u.b * 2 + 0) * 8 + head) * 32 + (u.ck - 1)) * 8192 : nullptr;
                    const bf16_t* hb = u.ck <= 31 ? stb + ((((size_t)u.b * 2 + 1) * 8 + head) * 32 + u.ck) * 8192 : nullptr;
                    for (int i = tid; i < 64 * 16; i += NTHREADS) { const int p = i >> 4, cc = i & 15;
                        *(LAS u32x4*)(HfT + p * SD_RS + cc * 16) = hf ? *(const u32x4*)(hf + p * 128 + cc * 8) : (u32x4){0u, 0u, 0u, 0u};
                        *(LAS u32x4*)(HbT + p * SD_RS + cc * 16) = hb ? *(const u32x4*)(hb + p * 128 + cc * 8) : (u32x4){0u, 0u, 0u, 0u}; }
                }
                if (wave == 0) { float totf, totb; ssd_scalars(sc, dt, al, m0, head, u.ns, lane, totf, totb); }
                __syncthreads();
                if (active) {
                    const int ll = 16 * wave + (lane & 15); const float afl = sc[ll], ebl = sc[128 + ll];
#pragma unroll
                    for (int t = 0; t < 8; ++t) {
                        u32x2 w2 = (u32x2){0u, 0u};
                        if (t < u.ns) {
                            const int s0 = 16 * t + 4 * (lane >> 4);
                            const f32x4 afs = *(const LAS f32x4*)(sc + s0), ebs = *(const LAS f32x4*)(sc + 128 + s0), dfs = *(const LAS f32x4*)(sc + 256 + s0), dbs = *(const LAS f32x4*)(sc + 384 + s0);
                            float mv[4];
#pragma unroll
                            for (int r = 0; r < 4; ++r) { const int s = s0 + r; float wgt = 0.f; if (s <= ll) wgt += __expf(afl - afs[r]) * dfs[r]; if (s >= ll) wgt += __expf(ebs[r] - ebl) * dbs[r]; mv[r] = cb[t][r] * wgt; }
                            w2 = (u32x2){pk2(mv[0], mv[1]), pk2(mv[2], mv[3])};
                        }
                        if (t < 2 * nks) *(LAS u32x2*)(Ms + (lane & 15) * SD_RS + (16 * t + 4 * (lane >> 4)) * 2) = w2;
                    }
                    asm volatile("s_waitcnt lgkmcnt(0)" ::: "memory");
                    f32x4 ay[4], ahf[4], ahb[4];
#pragma unroll
                    for (int pt = 0; pt < 4; ++pt) { ay[pt] = (f32x4){0.f, 0.f, 0.f, 0.f}; ahf[pt] = ay[pt]; ahb[pt] = ay[pt]; }
                    for (int ks = 0; ks < nks; ++ks) {
                        const bf16x8 mf = frag_row(Ms, SD_RS, 0, 32 * ks, lane);
#pragma unroll
                        for (int pt = 0; pt < 4; ++pt) ay[pt] = __builtin_amdgcn_mfma_f32_16x16x32_bf16(mf, frag_tr(Ximg, SD_XRS, 32 * ks, 16 * pt, lane), ay[pt], 0, 0, 0);
                    }
#pragma unroll
                    for (int ks = 0; ks < 4; ++ks) {
                        const bf16x8 cfr = frag_row(Cimg, SD_RS, 16 * wave, 32 * ks, lane);
#pragma unroll
                        for (int pt = 0; pt < 4; ++pt) {
                            ahf[pt] = __builtin_amdgcn_mfma_f32_16x16x32_bf16(cfr, frag_row(HfT, SD_RS, 16 * pt, 32 * ks, lane), ahf[pt], 0, 0, 0);
                            ahb[pt] = __builtin_amdgcn_mfma_f32_16x16x32_bf16(cfr, frag_row(HbT, SD_RS, 16 * pt, 32 * ks, lane), ahb[pt], 0, 0, 0);
                        }
                    }
                    const int l0 = 16 * wave + 4 * (lane >> 4);
                    const f32x4 efv = *(const LAS f32x4*)(sc + 768 + l0), ebv = *(const LAS f32x4*)(sc + 896 + l0);
                    asm volatile("s_waitcnt lgkmcnt(0)" ::: "memory");
                    LAS float* ys = (LAS float*)Ms;
#pragma unroll
                    for (int pt = 0; pt < 4; ++pt)
#pragma unroll
                        for (int r = 0; r < 4; ++r) ys[(4 * (lane >> 4) + r) * 68 + 16 * pt + (lane & 15)] = ay[pt][r] + efv[r] * ahf[pt][r] + ebv[r] * ahb[pt][r];
                    asm volatile("s_waitcnt lgkmcnt(0)" ::: "memory");
                    const int rr = lane >> 2, p0 = 16 * (lane & 3); const size_t m = m0 + 16 * wave + rr;
                    const float dsk = c.in[I_SSDD][l * 8 + head];
                    float xv[16], zv[16];
                    { float t8[8]; unpack8(*(const LAS u32x4*)(Ximg + (16 * wave + rr) * SD_XRS + p0 * 2), t8);
#pragma unroll
                      for (int e = 0; e < 8; ++e) xv[e] = t8[e];
                      unpack8(*(const LAS u32x4*)(Ximg + (16 * wave + rr) * SD_XRS + p0 * 2 + 16), t8);
#pragma unroll
                      for (int e = 0; e < 8; ++e) xv[8 + e] = t8[e];
                      unpack8(*(const u32x4*)(pz + m * 512 + head * 64 + p0), t8);
#pragma unroll
                      for (int e = 0; e < 8; ++e) zv[e] = t8[e];
                      unpack8(*(const u32x4*)(pz + m * 512 + head * 64 + p0 + 8), t8);
#pragma unroll
                      for (int e = 0; e < 8; ++e) zv[8 + e] = t8[e]; }
                    float o[16];
#pragma unroll
                    for (int e4 = 0; e4 < 4; ++e4) { const f32x4 yv = *(const LAS f32x4*)(ys + rr * 68 + p0 + 4 * e4);
#pragma unroll
                        for (int e = 0; e < 4; ++e) { const float val = (yv[e] + dsk * xv[4 * e4 + e]) * siluf_(zv[4 * e4 + e]); o[4 * e4 + e] = val; ssrow += val * val; } }
                    u32x4 w0, w1; w0.x = pk2(o[0], o[1]); w0.y = pk2(o[2], o[3]); w0.z = pk2(o[4], o[5]); w0.w = pk2(o[6], o[7]); w1.x = pk2(o[8], o[9]); w1.y = pk2(o[10], o[11]); w1.z = pk2(o[12], o[13]); w1.w = pk2(o[14], o[15]);
                    *(u32x4*)(yb + m * 512 + head * 64 + p0) = w0; *(u32x4*)(yb + m * 512 + head * 64 + p0 + 8) = w1;
                }
            }
        }
        if (active) { ssrow += dpp_mov<0xB1>(ssrow); ssrow += dpp_mov<0x4E>(ssrow); if ((lane & 3) == 0) ssqb[(m0 + 16 * wave + (lane >> 2)) * 2 + g0] = ssrow; }
    }
    __syncthreads();
}
typedef short s16x4v __attribute__((ext_vector_type(4)));
constexpr int RC_NCH = LEN / 16;
constexpr int RC_NP = 5;
constexpr int RC_ROUNDS = (RC_NCH + RC_NP - 1) / RC_NP;
constexpr int RC_S64 = 144;
constexpr int RC_S16 = 40;
constexpr int RC_AT = 0, RC_RT = 2304, RC_BH = 4608, RC_KH = 6912, RC_T = 9216, RC_AAK = 9856, RC_ARB = 10496, RC_ARK = 11136, RC_VT = 11776, RC_P16 = 12416, RC_SLOT = 12800;
constexpr int RC_SCR0 = 2 * RC_NP * RC_SLOT;
constexpr int RC_SCR = 1280;
static_assert(RC_SCR0 + RC_NP * RC_SCR <= 147456 - 512, "rwkv chunk LDS");
__device__ __forceinline__ f32x4 mm16(s16x4v a, s16x4v b, f32x4 c, int, int, int) { return __builtin_amdgcn_mfma_f32_16x16x32_bf16((bf16x8){a[0], a[1], a[2], a[3], 0, 0, 0, 0}, (bf16x8){b[0], b[1], b[2], b[3], 0, 0, 0, 0}, c, 0, 0, 0); }
__device__ __forceinline__ s16x4v mfma16_frag(const LAS unsigned char* mat, int row, int q) { return *(const LAS s16x4v*)(mat + row * RC_S16 + q * 8); }

constexpr int RC64_NP = 4, RC64_ROUNDS = (RC_NCH + RC64_NP - 1) / RC64_NP;
constexpr int RC64_V = 11776, RC64_P16 = 14080, RC64_SLOT = 14336;
constexpr int RC64_SCR0 = 2 * RC64_NP * RC64_SLOT;
static_assert(RC64_SCR0 + RC64_NP * RC_SCR <= 147456 - 512, "rwkv64 LDS");
__device__ __forceinline__ void rwkv_chunked64(const Ctx& cx_, int l) {
    const Ctx c = relaunder(cx_);


    const int bid = c.bid, dir = bid & 1, head = (bid >> 1) & 3, b = bid >> 3;
    const int lane = c.lane, wave = c.wave;
    const bf16_t* rk = (const bf16_t*)(c.dout + DO_RKVP) + head * 64; const bf16_t* l2 = (const bf16_t*)(c.ws + WS_L2O) + dir * 256 + head * 64;
    bf16_t* yo = (bf16_t*)(dir == 0 ? c.ws + WS_YRW0 : c.dout + DO_YRW1) + head * 64 + 16 * (wave & 3);
    auto tok = [&](int s) -> size_t { const int t = s + dir * (LEN - 1 - 2 * s); return (size_t)row_of(b, t); };
    const int q = lane >> 4, li = lane & 15;
    u32x4 Rr[2], Kr[2], KKr[2], DLr[2], ASr[2], Vr[2];
    auto load_raw = [&](int ch) {
        const size_t m = tok(16 * ch + li); const int k0 = 16 * q;
#pragma unroll
        for (int h = 0; h < 2; ++h) { Rr[h] = *(const u32x4*)(rk + m * 1024 + k0 + 8 * h); Kr[h] = *(const u32x4*)(rk + m * 1024 + 256 + k0 + 8 * h); KKr[h] = *(const u32x4*)(rk + m * 1024 + 768 + k0 + 8 * h);
            DLr[h] = *(const u32x4*)(l2 + m * 1280 + k0 + 8 * h); ASr[h] = *(const u32x4*)(l2 + m * 1280 + 512 + k0 + 8 * h); Vr[h] = *(const u32x4*)(rk + m * 1024 + 512 + k0 + 8 * h); }
    };
    float kaall[16];
#pragma unroll
    for (int e = 0; e < 16; ++e) kaall[e] = c.in[I_KA][(size_t)l * 256 + head * 64 + 16 * q + e];
    auto produce = [&](int slot) {
        LAS unsigned char* sb = c.lds + slot * RC64_SLOT; LAS float* Aab = (LAS float*)(c.lds + RC64_SCR0 + (wave - 4) * RC_SCR);
        LAS unsigned char* Bh = sb + RC_BH; LAS unsigned char* Kh = sb + RC_KH;
        *(LAS u32x4*)(sb + RC64_V + li * RC_S64 + (16 * q) * 2) = Vr[0]; *(LAS u32x4*)(sb + RC64_V + li * RC_S64 + (16 * q + 8) * 2) = Vr[1];
        const int k0 = 16 * q;
#pragma unroll
        for (int h = 0; h < 2; ++h) {
            float r_[8], k_[8], kk_[8], dl_[8], as_[8], cs_[8]; unpack8(Rr[h], r_); unpack8(Kr[h], k_); unpack8(KKr[h], kk_); unpack8(DLr[h], dl_); unpack8(ASr[h], as_);
            const float* ka = kaall + 8 * h;
            float at_[8], rt_[8], bh_[8], kh_[8], p_[8];
#pragma unroll
            for (int e = 0; e < 8; ++e) {
                float x = dl_[e];
                x += dpp_mov<0x111>(x); x += dpp_mov<0x112>(x); x += dpp_mov<0x114>(x); x += dpp_mov<0x118>(x);
                cs_[e] = x;
            }
#pragma unroll
            for (int e = 0; e < 8; ++e) {
                const float P = __expf(cs_[e]), iP = __builtin_amdgcn_rcpf(P); const float Psh = dpp_mov<0x111>(P), Pm = li == 0 ? 1.f : Psh;
                at_[e] = -kk_[e] * Pm; rt_[e] = r_[e] * P; bh_[e] = kk_[e] * as_[e] * iP; kh_[e] = k_[e] * (1.f + (as_[e] - 1.f) * ka[e]) * iP; p_[e] = P;
            }
            *(LAS u32x4*)(sb + RC_AT + li * RC_S64 + (k0 + 8 * h) * 2) = pack8(at_); *(LAS u32x4*)(sb + RC_RT + li * RC_S64 + (k0 + 8 * h) * 2) = pack8(rt_);
            *(LAS u32x4*)(Bh + li * RC_S64 + (k0 + 8 * h) * 2) = pack8(bh_); *(LAS u32x4*)(Kh + li * RC_S64 + (k0 + 8 * h) * 2) = pack8(kh_);
            if (li == 15) { *(LAS f32x4*)(sb + RC64_P16 + (k0 + 8 * h) * 4) = (f32x4){p_[0], p_[1], p_[2], p_[3]}; *(LAS f32x4*)(sb + RC64_P16 + (k0 + 8 * h + 4) * 4) = (f32x4){p_[4], p_[5], p_[6], p_[7]}; }
        }
        asm volatile("s_waitcnt lgkmcnt(0)" ::: "memory");
        f32x4 ab = (f32x4){0.f, 0.f, 0.f, 0.f}, ak = ab, rb = ab, rkm = ab;
#pragma unroll
        for (int ks = 0; ks < 2; ++ks) {
            const bf16x8 fa = *(const LAS bf16x8*)(sb + RC_AT + li * RC_S64 + (32 * ks + 8 * q) * 2), fr = *(const LAS bf16x8*)(sb + RC_RT + li * RC_S64 + (32 * ks + 8 * q) * 2);
            const bf16x8 fb = *(const LAS bf16x8*)(Bh + li * RC_S64 + (32 * ks + 8 * q) * 2), fk = *(const LAS bf16x8*)(Kh + li * RC_S64 + (32 * ks + 8 * q) * 2);
            ab = __builtin_amdgcn_mfma_f32_16x16x32_bf16(fa, fb, ab, 0, 0, 0); ak = __builtin_amdgcn_mfma_f32_16x16x32_bf16(fa, fk, ak, 0, 0, 0);
            rb = __builtin_amdgcn_mfma_f32_16x16x32_bf16(fr, fb, rb, 0, 0, 0); rkm = __builtin_amdgcn_mfma_f32_16x16x32_bf16(fr, fk, rkm, 0, 0, 0);
        }
#pragma unroll
        for (int r = 0; r < 4; ++r) {
            const int t = 4 * q + r, s = li;
            Aab[t * 20 + s] = s < t ? ab[r] : 0.f;
            *(LAS bf16_t*)(sb + RC_AAK + t * RC_S16 + s * 2) = (bf16_t)f2bf(s < t ? ak[r] : 0.f);
            *(LAS bf16_t*)(sb + RC_ARB + t * RC_S16 + s * 2) = (bf16_t)f2bf(s <= t ? rb[r] : 0.f);
            *(LAS bf16_t*)(sb + RC_ARK + t * RC_S16 + s * 2) = (bf16_t)f2bf(s <= t ? rkm[r] : 0.f);
        }
        asm volatile("s_waitcnt lgkmcnt(0)" ::: "memory");
        float tc[16];
#pragma unroll
        for (int t = 0; t < 16; ++t) {
            float acc = (t == li) ? 1.f : 0.f;
            f32x4 a0 = *(const LAS f32x4*)(Aab + t * 20), a1 = *(const LAS f32x4*)(Aab + t * 20 + 4), a2 = *(const LAS f32x4*)(Aab + t * 20 + 8), a3 = *(const LAS f32x4*)(Aab + t * 20 + 12);
            const float av[16] = {a0.x, a0.y, a0.z, a0.w, a1.x, a1.y, a1.z, a1.w, a2.x, a2.y, a2.z, a2.w, a3.x, a3.y, a3.z, a3.w};
            float a1_ = 0.f, a2_ = 0.f, a3_ = 0.f;
#pragma unroll
            for (int s = 0; s < t; ++s) { const float pr_ = av[s] * tc[s]; if ((s & 3) == 0) acc += pr_; else if ((s & 3) == 1) a1_ += pr_; else if ((s & 3) == 2) a2_ += pr_; else a3_ += pr_; }
            tc[t] = (acc + a1_) + (a2_ + a3_);
        }
        if (q == 0) {
#pragma unroll
            for (int t = 0; t < 16; ++t) *(LAS bf16_t*)(sb + RC_T + t * RC_S16 + li * 2) = (bf16_t)f2bf(tc[t]);
        }
    };
    if (wave >= 4 && wave - 4 < RC64_NP) { const int ch0 = wave - 4; load_raw(ch0); produce(wave - 4); load_raw(ch0 + RC64_NP); }
    __syncthreads();
    f32x4 S[4]; bf16x8 sop[2];
#pragma unroll
    for (int kt = 0; kt < 4; ++kt) S[kt] = (f32x4){0.f, 0.f, 0.f, 0.f};
    sop[0] = (bf16x8){0, 0, 0, 0, 0, 0, 0, 0}; sop[1] = sop[0];
    int sbase = 0;
    auto consume = [&](const int i, const int ch) {
                const LAS unsigned char* sb = c.lds + (sbase + i) * RC64_SLOT;
        const s16x4v vt = lds_tr(sb + RC64_V + (4 * q + (li >> 2)) * RC_S64 + (16 * (wave & 3) + 4 * (li & 3)) * 2);
        f32x4 aw = mm16(mfma16_frag(sb + RC_AAK, li, q), vt, (f32x4){0.f, 0.f, 0.f, 0.f}, 0, 0, 0);
        f32x4 ay = mm16(mfma16_frag(sb + RC_ARK, li, q), vt, (f32x4){0.f, 0.f, 0.f, 0.f}, 0, 0, 0);
#pragma unroll
        for (int ks = 0; ks < 2; ++ks) {
            const s16x4v alo = *(const LAS s16x4v*)(sb + RC_AT + li * RC_S64 + (32 * ks + 4 * q) * 2), ahi = *(const LAS s16x4v*)(sb + RC_AT + li * RC_S64 + (32 * ks + 16 + 4 * q) * 2);
            const s16x4v rlo = *(const LAS s16x4v*)(sb + RC_RT + li * RC_S64 + (32 * ks + 4 * q) * 2), rhi = *(const LAS s16x4v*)(sb + RC_RT + li * RC_S64 + (32 * ks + 16 + 4 * q) * 2);
            aw = __builtin_amdgcn_mfma_f32_16x16x32_bf16((bf16x8){alo[0], alo[1], alo[2], alo[3], ahi[0], ahi[1], ahi[2], ahi[3]}, sop[ks], aw, 0, 0, 0);
            ay = __builtin_amdgcn_mfma_f32_16x16x32_bf16((bf16x8){rlo[0], rlo[1], rlo[2], rlo[3], rhi[0], rhi[1], rhi[2], rhi[3]}, sop[ks], ay, 0, 0, 0);
        }
        const u32x2 wb2 = (u32x2){pk2(aw[0], aw[1]), pk2(aw[2], aw[3])};
        const f32x4 au = mm16(mfma16_frag(sb + RC_T, li, q), __builtin_bit_cast(s16x4v, wb2), (f32x4){0.f, 0.f, 0.f, 0.f}, 0, 0, 0);
        const u32x2 ub2 = (u32x2){pk2(au[0], au[1]), pk2(au[2], au[3])}; const s16x4v ub = __builtin_bit_cast(s16x4v, ub2);
        ay = mm16(mfma16_frag(sb + RC_ARB, li, q), ub, ay, 0, 0, 0);
#pragma unroll
        for (int kt = 0; kt < 4; ++kt) {
            const f32x4 p16 = *(const LAS f32x4*)(sb + RC64_P16 + (16 * kt + 4 * q) * 4);
            const int troff = (4 * q + (li >> 2)) * RC_S64 + (16 * kt + 4 * (li & 3)) * 2;
            f32x4 sv = S[kt];
            sv = mm16(lds_tr(sb + RC_KH + troff), vt, sv, 0, 0, 0);
            sv = mm16(lds_tr(sb + RC_BH + troff), ub, sv, 0, 0, 0);
            sv = sv * p16;
            S[kt] = sv;
        }
#pragma unroll
        for (int ks = 0; ks < 2; ++ks) {
            const u32x4 w = (u32x4){pk2(S[2 * ks][0], S[2 * ks][1]), pk2(S[2 * ks][2], S[2 * ks][3]), pk2(S[2 * ks + 1][0], S[2 * ks + 1][1]), pk2(S[2 * ks + 1][2], S[2 * ks + 1][3])};
            sop[ks] = __builtin_bit_cast(bf16x8, w);
        }
#pragma unroll
        for (int r = 0; r < 4; ++r) yo[tok(16 * ch + 4 * q + r) * 256 + li] = (bf16_t)f2bf(ay[r]);
    };
    for (int rd = 0; rd < RC64_ROUNDS; ++rd) {
        if (wave < 4) {
            sbase = (rd & 1) * RC64_NP;
            if (rd < RC64_ROUNDS - 1) {
#pragma unroll
                for (int i = 0; i < RC64_NP; ++i) consume(i, RC64_NP * rd + i);
            } else {
                for (int i = 0; i < RC64_NP; ++i) { const int ch = RC64_NP * rd + i; if (ch >= RC_NCH) break; consume(i, ch); }
            }
        } else if (wave - 4 < RC64_NP) {
            const int chn = RC64_NP * (rd + 1) + (wave - 4);
            if (chn < RC_NCH) { produce(((rd + 1) & 1) * RC64_NP + (wave - 4)); if (chn + RC64_NP < RC_NCH) load_raw(chn + RC64_NP); }
        }
        __syncthreads();
    }
}
__device__ __forceinline__ f32x4 mg_dot(const bf16_t* __restrict__ w, const bf16_t* __restrict__ x, int nk, f32x4 acc) {
#pragma unroll 8
    for (int k = 0; k < nk; ++k) acc = __builtin_amdgcn_mfma_f32_16x16x32_bf16(*(const bf16x8*)(w + k * 32), *(const bf16x8*)(x + k * 32), acc, 0, 0, 0);
    return acc;
}
__device__ __forceinline__ void mg_store4(bf16_t* dst, float a, float b, float c, float d) { uint2 w; w.x = pk2(a, b); w.y = pk2(c, d); *(uint2*)dst = w; }

__device__ __forceinline__ void meta_gates(const Ctx& cx_, int l) {
    const Ctx c = relaunder(cx_);
    const int lane = c.lane, wave = c.wave, li = lane & 15, lq = lane >> 4, role = wave & 3, rh = wave >> 2;
    const int c0 = (c.bid >> 2) * 16, row = BATCH * SEQ + ((c.bid & 3) * 2 + rh) * 16 + li;
    const bf16_t* wbase = c.wb(l);
    LAS float* sg = (LAS float*)c.lds;
    const f32x4 zero = {0.f, 0.f, 0.f, 0.f};
    f32x4 p0 = zero, p1 = zero, p2 = zero;
    __syncthreads();
    if (role < 3) {
        const f32x4 acc = mg_dot(wbase + WB_G + ((size_t)role * 1024 + c0 + li) * DM + lq * 8, c.H() + (size_t)row * DM + lq * 8, 32, zero);
        const float s = row_scale(c.ssq(), row);
#pragma unroll
        for (int j = 0; j < 4; ++j) sg[((rh * 3 + role) * 4 + j) * 64 + lane] = sigmoidf_(acc[j] * s);
    } else {
        const bf16_t* wp = wbase + WB_P + (size_t)(c0 + li) * DM + lq * 8;
        p0 = mg_dot(wp, (const bf16_t*)(c.ws + WS_YA) + (size_t)row * 256 + lq * 8, 8, zero);
        p1 = mg_dot(wp + 256, (const bf16_t*)(c.ws + WS_YB) + (size_t)row * 512 + lq * 8, 16, zero);
        p2 = mg_dot(wp + 768, (const bf16_t*)(c.ws + WS_YC) + (size_t)row * 256 + lq * 8, 8, zero);
    }
    __syncthreads();
    if (role == 3) {
        const float* ssqb = (const float*)(c.ws + WS_SSQB);
        const float rsb = __builtin_amdgcn_rsqf((ssqb[2 * row] + ssqb[2 * row + 1]) * (1.0f / 512.f) + EPS);
        float m[4];
#pragma unroll
        for (int j = 0; j < 4; ++j) m[j] = sg[((rh * 3 + 0) * 4 + j) * 64 + lane] * p0[j] + sg[((rh * 3 + 1) * 4 + j) * 64 + lane] * rsb * p1[j] + sg[((rh * 3 + 2) * 4 + j) * 64 + lane] * p2[j];
        mg_store4((bf16_t*)(c.dout + DO_MERGED) + (size_t)row * DM + c0 + lq * 4, m[0], m[1], m[2], m[3]);
    }
    __syncthreads();
}

__device__ __forceinline__ void meta_resid(const Ctx& cx_, const bf16_t* A, const bf16_t* W, int K) {
    if (cx_.bid >= 128) return;
    const Ctx c = relaunder(cx_);
    const int lane = c.lane, wave = c.wave, li = lane & 15, lq = lane >> 4, blk = wave & 3, kh = wave >> 2;
    const int cg16 = c.bid & 15, c0 = cg16 * 64 + blk * 16, row = BATCH * SEQ + (c.bid >> 4) * 16 + li;
    LAS float* red = (LAS float*)c.lds;
    const f32x4 zero = {0.f, 0.f, 0.f, 0.f};
    __syncthreads();
    f32x4 acc = mg_dot(W + (size_t)(c0 + li) * K + kh * (K >> 1) + lq * 8, A + (size_t)row * K + kh * (K >> 1) + lq * 8, K >> 6, zero);
    if (kh == 1) {
#pragma unroll
        for (int j = 0; j < 4; ++j) red[(blk * 4 + j) * 64 + lane] = acc[j];
    }
    __syncthreads();
    float ss = 0.f;
    if (kh == 0) {
        bf16_t* hp = c.H() + (size_t)row * DM + c0 + lq * 4;
        const uint2 hv = *(const uint2*)hp;
        float f[4] = {bflo(hv.x), bfhi(hv.x), bflo(hv.y), bfhi(hv.y)};
#pragma unroll
        for (int j = 0; j < 4; ++j) { f[j] += acc[j] + red[(blk * 4 + j) * 64 + lane]; ss += f[j] * f[j]; }
        mg_store4(hp, f[0], f[1], f[2], f[3]);
        ss += __shfl_xor(ss, 16); ss += __shfl_xor(ss, 32);
    }
    __syncthreads();
    if (kh == 0 && lq == 0) red[blk * 16 + li] = ss;
    __syncthreads();
    if (wave == 0 && lq == 0) c.ssq()[(size_t)row * 16 + cg16] = (red[li] + red[16 + li]) + (red[32 + li] + red[48 + li]);
    __syncthreads();
}

__device__ __forceinline__ void meta_up(const Ctx& cx_, const bf16_t* W) {
    const Ctx c = relaunder(cx_);
    const int lane = c.lane, li = lane & 15, lq = lane >> 4;
    const int c0 = c.bid * 16, row = BATCH * SEQ + c.wave * 16 + li;
    const f32x4 zero = {0.f, 0.f, 0.f, 0.f};
    const f32x4 acc = mg_dot(W + (size_t)(c0 + li) * DM + lq * 8, c.H() + (size_t)row * DM + lq * 8, 32, zero);
    const float s = row_scale(c.ssq(), row);
    float f[4];
#pragma unroll
    for (int j = 0; j < 4; ++j) { const float r = fmaxf(acc[j] * s, 0.f); f[j] = r * r; }
    mg_store4((bf16_t*)(c.ws + WS_ACT) + (size_t)row * DFF + c0 + lq * 4, f[0], f[1], f[2], f[3]);
}

__device__ __forceinline__ void meta_l1(const Ctx& cx_, const bf16_t* W) {
    if (cx_.bid >= 32) return;
    const Ctx c = relaunder(cx_);
    const int lane = c.lane, li = lane & 15, lq = lane >> 4;
    const int c0 = c.bid * 16, mode = c.bid >> 3, row = BATCH * SEQ + c.wave * 16 + li;
    f32x4 acc = {0.f, 0.f, 0.f, 0.f};
    if (mode < 3) acc = mg_dot(W + (size_t)(c0 + li) * 512 + lq * 8, (const bf16_t*)(c.ws + WS_L1IN) + (size_t)row * 512 + lq * 8, 16, acc);
    float f[4];
#pragma unroll
    for (int j = 0; j < 4; ++j) f[j] = mode == 0 ? tanhf_(acc[j]) : (mode == 1 ? acc[j] : (mode == 2 ? sigmoidf_(acc[j]) : 0.f));
    mg_store4((bf16_t*)(c.ws + WS_L1O) + (size_t)row * 512 + c0 + lq * 4, f[0], f[1], f[2], f[3]);
}

__device__ __forceinline__ void rwkv_post(const Ctx& cx_, int l) {
    const Ctx c = relaunder(cx_);
    const int gw = c.bid * NWAVES + c.wave, NGW = c.G * NWAVES, lane = c.lane, c0 = 4 * lane;
    const bf16_t* __restrict__ y0 = (const bf16_t*)(c.ws + WS_YRW0); const bf16_t* __restrict__ y1 = (const bf16_t*)(c.dout + DO_YRW1);
    const bf16_t* __restrict__ rk = (const bf16_t*)(c.dout + DO_RKVP); const bf16_t* __restrict__ l2 = (const bf16_t*)(c.ws + WS_L2O); bf16_t* __restrict__ yc = (bf16_t*)(c.ws + WS_YC);
    float lw[4], lb[4], rkw[4];
#pragma unroll
    for (int e = 0; e < 4; ++e) { lw[e] = c.in[I_LNW][(size_t)l * 256 + c0 + e]; lb[e] = c.in[I_LNB][(size_t)l * 256 + c0 + e]; rkw[e] = c.in[I_RK][(size_t)l * 256 + c0 + e]; }
#pragma unroll 2
    for (int m = gw; m < M_ROWS; m += NGW) {
        const u32x2 a = *(const u32x2*)(y0 + (size_t)m * 256 + c0), bq = *(const u32x2*)(y1 + (size_t)m * 256 + c0);
        const u32x2 rr = *(const u32x2*)(rk + (size_t)m * 1024 + c0), kk = *(const u32x2*)(rk + (size_t)m * 1024 + 256 + c0), vv = *(const u32x2*)(rk + (size_t)m * 1024 + 512 + c0);
        const u32x2 gg = *(const u32x2*)(l2 + (size_t)m * 1280 + 1024 + c0);
        float y[4] = {bflo(a.x) + bflo(bq.x), bfhi(a.x) + bfhi(bq.x), bflo(a.y) + bflo(bq.y), bfhi(a.y) + bfhi(bq.y)};
        const float r[4] = {bflo(rr.x), bfhi(rr.x), bflo(rr.y), bfhi(rr.y)}, k[4] = {bflo(kk.x), bfhi(kk.x), bflo(kk.y), bfhi(kk.y)};
        const float v[4] = {bflo(vv.x), bfhi(vv.x), bflo(vv.y), bfhi(vv.y)}, g[4] = {bflo(gg.x), bfhi(gg.x), bflo(gg.y), bfhi(gg.y)};
        const float mean = sum16((y[0] + y[1]) + (y[2] + y[3])) * (1.f / 64.f);
        float q = 0.f, bo = 0.f;
#pragma unroll
        for (int e = 0; e < 4; ++e) { y[e] -= mean; q += y[e] * y[e]; bo += r[e] * k[e] * rkw[e]; }
        q = sum16(q) * (1.f / 64.f); bo = sum16(bo);
        const float rs = __builtin_amdgcn_rsqf(q + 64e-5f);
        float o[4];
#pragma unroll
        for (int e = 0; e < 4; ++e) o[e] = (y[e] * rs * lw[e] + lb[e] + bo * v[e]) * g[e];
        *(u32x2*)(yc + (size_t)m * 256 + c0) = (u32x2){pk2(o[0], o[1]), pk2(o[2], o[3])};
    }
}
__device__ __forceinline__ void final_phase(const Ctx& cx_, float* out) {
    const Ctx c = relaunder(cx_);
    const int gw = c.bid * NWAVES + c.wave, NGW = c.G * NWAVES, lane = c.lane;
    const bf16_t* H = c.H(); const f32x4* fw = (const f32x4*)c.in[I_FNW];
    f32x4 fwv[4];
#pragma unroll
    for (int i = 0; i < 4; ++i) fwv[i] = fw[lane + 64 * i];
#pragma unroll 4
    for (int r = gw; r < BATCH * SEQ; r += NGW) {
        const size_t m = (size_t)r;
        const u32x2* __restrict__ hp = (const u32x2*)(H + m * DM);
        float v[4][4], ss = 0.f;
#pragma unroll
        for (int i = 0; i < 4; ++i) { const u32x2 w = hp[lane + 64 * i]; v[i][0] = bflo(w.x); v[i][1] = bfhi(w.x); v[i][2] = bflo(w.y); v[i][3] = bfhi(w.y); ss += (v[i][0] * v[i][0] + v[i][1] * v[i][1]) + (v[i][2] * v[i][2] + v[i][3] * v[i][3]); }
        ss = wave_sum(ss); const float s = __builtin_amdgcn_rsqf(ss * (1.0f / DM) + EPS);
        f32x4* __restrict__ op = (f32x4*)(out + (size_t)r * DM);
#pragma unroll
        for (int i = 0; i < 4; ++i) { const f32x4 w = fwv[i]; op[lane + 64 * i] = (f32x4){v[i][0] * s * w.x, v[i][1] * s * w.y, v[i][2] * s * w.z, v[i][3] * s * w.w}; }
    }
}

constexpr int LDS_BYTES = 147456;
#ifndef MIXDIR
#define MIXDIR 0
#define MIXLAYER 0
#endif
#ifndef PHMASK
#define PHMASK 0xFFFFF
#endif
#ifndef REPMASK
#define REPMASK 0
#endif
#define REP(k) for (int r_ = 0; r_ <= ((REPMASK >> (k)) & 1); ++r_)
__global__ void __launch_bounds__(NTHREADS, 2) mega_fwd(Params p) {
    extern __shared__ __attribute__((aligned(16))) unsigned char lds_raw[];
    cg::grid_group grid = cg::this_grid();
#ifdef CODE_SHIFT
    asm volatile(".fill %0, 4, 0xBF800000" :: "n"(CODE_SHIFT));
#endif
    Ctx c0_; c0_.in = p.in; c0_.ws = p.ws; c0_.dout = (unsigned char*)p.out; c0_.lds = (LAS unsigned char*)lds_raw;
    c0_.wave = __builtin_amdgcn_readfirstlane((int)threadIdx.x >> 6); c0_.tid = opaque_tid(c0_.wave); c0_.lane = c0_.tid & 63; c0_.G = gridDim.x; c0_.bid = blockIdx.x;
    Ctx c = c0_;
    const int G = c.G, bid = c.bid;
#ifdef PROF_A
    if (blockIdx.x == 0 && threadIdx.x == 0) { for (int k = 0; k < 15; ++k) PROF_PTR[k] = 0; PROF_PTR[15] = __builtin_amdgcn_s_memrealtime(); }
#endif
    unsigned* barw = (unsigned*)(c.ws + WS_BAR);
    volatile LAS unsigned* bst = (volatile LAS unsigned*)(c.lds + LDS_BYTES - 64);
    if (bid == 0) for (int i = threadIdx.x; i < XCD_BAR_WORDS + 1024; i += NTHREADS) barw[i < XCD_BAR_WORDS ? i : 4096 + (i - XCD_BAR_WORDS)] = 0u;
    if (threadIdx.x < 2) bst[threadIdx.x] = 0u;
    __syncthreads();
    REP(14) if (PHMASK & 1) phase0(c);
    grid.sync(); STAMP(0);
    const XcdBarrier xbar = xcd_barrier_post(barw, bst);
#ifdef BAR_TWICE
#define GRID_BAR() do { xcd_barrier(xbar, c0_.wave); xcd_barrier(xbar, c0_.wave); c = relaunder(c0_); } while (0)
#else
#define GRID_BAR() do { xcd_barrier(xbar, c0_.wave); c = relaunder(c0_); } while (0)
#endif
#pragma unroll 1
    for (int l = 0; l < DEPTH; ++l) {
#define wb (c.wb(l))
        REP(0) if (PHMASK & 2) dt_job(c, l);
        REP(1) if (PHMASK & 4) { SchedPlain S{c.H(), wb + WB_IN, DM, DM, DM, MP / 256, 11, c.G, c.bid, 0};
          EpiInProj E{c.ssq(), (bf16_t*)(c.ws + WS_UH), (bf16_t*)(c.ws + WS_PZ), (bf16_t*)(c.ws + WS_PXBC), (bf16_t*)(c.ws + WS_PRKVX)};
          pg8::gemm_phase(c.lds, c.wave, S, E); }
        GRID_BAR(); STAMP(1);
        REP(2) if (PHMASK & 8) { SchedS5 S{(const bf16_t*)(c.ws + WS_UH), wb + WB_SX, 256, c.G, c.bid}; EpiS5X E{(float*)(c.ws + WS_X)}; pg8::gemm_phase(c.lds, c.wave, S, E); }
        REP(3) if (PHMASK & 16) rwkv_prep(c, l);
        REP(4) if (PHMASK & 32) ssd_prep(c, l);
        GRID_BAR(); STAMP(2);
        REP(7) if (PHMASK & 128) { SchedPlain S{(const bf16_t*)(c.ws + WS_L1IN), wb + WB_L1, 512, 512, 512, BATCH * SEQ / 256, 2, c.G, c.bid, 0}; EpiL1 E{(bf16_t*)(c.ws + WS_L1O)}; pg8::gemm_phase(c.lds, c.wave, S, E); }
        meta_l1(c, wb + WB_L1);
        GRID_BAR(); STAMP(3);
        REP(8) if (PHMASK & 256) { SchedL2 S{(const bf16_t*)(c.ws + WS_L1O), wb + WB_L2, c.G, c.bid, MP / 256, 0}; EpiL2 E{(bf16_t*)(c.ws + WS_L2O), c.in[I_W0] + (size_t)l * 512, c.in[I_A0] + (size_t)l * 512}; pg8::gemm_phase(c.lds, c.wave, S, E); }
        GRID_BAR(); STAMP(4);
        if (c.bid < 64) { REP(16) if (PHMASK & 1024) rwkv_chunked64(c, l); }
        else {
            const int nside = c.G - 64, iside = c.bid - 64;
            REP(5) if (PHMASK & 64) s5_scan(c, l, iside, nside);
            REP(6) if (PHMASK & 4096) ssd_states(c, l, iside, nside);
            sub_barrier(barw + 4096 + 64 * (2 * l), (unsigned)nside); c = relaunder(c0_);
            ssd_chunk_scan(c, l, iside, nside);
            REP(9) if (PHMASK & 512) { SchedS5 S{(const bf16_t*)(c.ws + WS_UH), wb + WB_SY, 512, c.G - 64, c.bid - 64}; EpiS5Y E{(bf16_t*)(c.ws + WS_YAPRE)}; pg8::gemm_phase(c.lds, c.wave, S, E); }
            sub_barrier(barw + 4096 + 64 * (2 * l + 1), (unsigned)nside); c = relaunder(c0_);
            REP(17) if (PHMASK & 2048) ssd_outputs(c, l, 64, c.G - 64);
            REP(18) if (PHMASK & 16384) { SchedPlain S{(const bf16_t*)(c.ws + WS_YAPRE), wb + WB_GLU, 256, 256, 256, MP / 256, 2, c.G - 64, c.bid - 64, 0}; EpiGLU E{(bf16_t*)(c.ws + WS_YA), c.in[I_GLUB] + (size_t)l * 512}; pg8::gemm_phase(c.lds, c.wave, S, E); }
        }
        STAMP(5);
        GRID_BAR(); STAMP(6);
#ifdef CODE_SHIFT2
        asm volatile(".fill %0, 4, 0xBF800000" :: "n"(CODE_SHIFT2));
#endif
        REP(11) if (PHMASK & 8192) rwkv_post(c, l);
        GRID_BAR(); STAMP(7);
        REP(12) if (PHMASK & 32768) { SchedProj S{c.H(), wb + WB_G, wb + WB_P, (const bf16_t*)(c.ws + WS_YA), (const bf16_t*)(c.ws + WS_YB), (const bf16_t*)(c.ws + WS_YC), BATCH * SEQ / 256, c.G, c.bid, 0};
          EpiProj E{c.ssq(), (const float*)(c.ws + WS_SSQB), c.ws + WS_PARK + (size_t)c.bid * 393216, (bf16_t*)(c.dout + DO_MERGED), opaque_tid(c.wave)}; pg8::gemm_phase(c.lds, c.wave, S, E); }
        if (l < DEPTH - 1) meta_gates(c, l);
        GRID_BAR(); STAMP(8);
        if (PHMASK & 65536) { SchedPlain S{(const bf16_t*)(c.dout + DO_MERGED), wb + WB_O, DM, DM, DM, BATCH * SEQ / 256, 4, c.G, c.bid, 0}; EpiResid E{c.H(), c.ssq()}; pg8::gemm_phase(c.lds, c.wave, S, E); }
        if (l < DEPTH - 1) meta_resid(c, (const bf16_t*)(c.dout + DO_MERGED), wb + WB_O, DM);
        GRID_BAR(); STAMP(9);
        REP(13) if (PHMASK & 131072) { SchedPlain S{c.H(), wb + WB_1, DM, DM, DM, BATCH * SEQ / 256, 16, c.G, c.bid, 0}; EpiUp E{c.ssq(), (bf16_t*)(c.ws + WS_ACT)}; pg8::gemm_phase(c.lds, c.wave, S, E); }
        if (l < DEPTH - 1) meta_up(c, wb + WB_1);
        GRID_BAR(); STAMP(10);
        if (PHMASK & 262144) { SchedPlain S{(const bf16_t*)(c.ws + WS_ACT), wb + WB_2, DFF, DFF, DFF, BATCH * SEQ / 256, 4, c.G, c.bid, 0}; EpiResid E{c.H(), c.ssq()}; pg8::gemm_phase(c.lds, c.wave, S, E); }
        if (l < DEPTH - 1) meta_resid(c, (const bf16_t*)(c.ws + WS_ACT), wb + WB_2, DFF);
        GRID_BAR(); STAMP(11);
    }
    REP(15) if (PHMASK & 524288) final_phase(c, p.out);
#ifdef PROF_A
    GRID_BAR(); STAMP(12);
    if (blockIdx.x == 0) {
        __syncthreads();
        float va = (float)(__hip_atomic_load(&PROF_PTR[PROF_A], __ATOMIC_RELAXED, __HIP_MEMORY_SCOPE_AGENT)) * 0.01f, vb = (float)(__hip_atomic_load(&PROF_PTR[PROF_B], __ATOMIC_RELAXED, __HIP_MEMORY_SCOPE_AGENT)) * 0.01f;
        va = exp2f(rintf(log2f(va * PROF_SHIFT) * 2.f) * 0.5f); vb = exp2f(rintf(log2f(vb * PROF_SHIFT) * 2.f) * 0.5f);
        for (int i = threadIdx.x; i < (1 << 20); i += NTHREADS) p.out[1 + i] = vb;
        if (threadIdx.x == 0) p.out[0] = 100.f * va;
    }
#endif
}

extern "C" void kernel_launch(void* const* d_in, const int* in_sizes, int n_in, void* d_out, int out_size, void* d_ws, size_t ws_size, hipStream_t stream) {
    static int grid = 0;
    if (grid == 0) {
        int dev = 0, cus = 0, per_cu = 0;
        if (n_in != N_INPUTS || out_size != BATCH * SEQ * DM || ws_size < WS_END) { fprintf(stderr, "kernel_launch: unexpected shapes (n_in %d out %d ws %zu)\n", n_in, out_size, ws_size); grid = -1; return; }
        (void)hipGetDevice(&dev); (void)hipDeviceGetAttribute(&cus, hipDeviceAttributeMultiprocessorCount, dev);
        (void)hipFuncSetAttribute((const void*)mega_fwd, hipFuncAttributeMaxDynamicSharedMemorySize, LDS_BYTES);
        (void)hipOccupancyMaxActiveBlocksPerMultiprocessor(&per_cu, (const void*)mega_fwd, NTHREADS, LDS_BYTES);
        if (per_cu < 1) { fprintf(stderr, "kernel_launch: occupancy query says %d blocks per CU\n", per_cu); per_cu = 1; }
        grid = cus * 1;
        if (grid != 256) fprintf(stderr, "kernel_launch: %d CUs (the scan phases are laid out for 256 workgroups)\n", grid);
    }
    if (grid < 0) return;
    Params p{};
    for (int i = 0; i < N_INPUTS; ++i) p.in[i] = (const float*)d_in[i];
    p.out = (float*)d_out; p.ws = (unsigned char*)d_ws; p.ph_lo = 0; p.ph_hi = 0;
    void* args[] = {&p};
    hipError_t e = hipLaunchCooperativeKernel((const void*)mega_fwd, dim3(grid), dim3(NTHREADS), args, LDS_BYTES, stream);
    if (e != hipSuccess) fprintf(stderr, "cooperative launch failed: %s (grid %d)\n", hipGetErrorString(e), grid);
}
```

```cpp
#define CODE_SHIFT 4
#include <hip/hip_runtime.h>
#include <hip/hip_cooperative_groups.h>
#include <cstdio>
#include <cstdint>
namespace cg = cooperative_groups;

#define LAS __attribute__((address_space(3)))
typedef unsigned short bf16_t;
typedef short bf16x8 __attribute__((ext_vector_type(8)));
typedef float f32x4 __attribute__((ext_vector_type(4)));
typedef unsigned u32x4 __attribute__((ext_vector_type(4)));
typedef unsigned u32x2 __attribute__((ext_vector_type(2)));

constexpr int BATCH = 8, SEQ = 4096, NMETA = 16, LEN = SEQ + NMETA, DM = 1024, DFF = 4096, DEPTH = 2;
constexpr int M_ROWS = BATCH * LEN;
constexpr int MP = 33024;
constexpr int N_IN = 5896;
constexpr int NCH16 = LEN / 16;
constexpr int S5ROWS = BATCH * NCH16;
constexpr int S5RP = 2304;
constexpr float EPS = 1e-6f;
constexpr int NTHREADS = 512, NWAVES = 8;

constexpr size_t QB = (size_t)MP * 256 * 2;
constexpr size_t WB_IN = 0;
constexpr size_t WB_G = WB_IN + (size_t)2816 * 1024;
constexpr size_t WB_P = WB_G + (size_t)3072 * 1024;
constexpr size_t WB_O = WB_P + (size_t)1024 * 1024;
constexpr size_t WB_1 = WB_O + (size_t)1024 * 1024;
constexpr size_t WB_2 = WB_1 + (size_t)4096 * 1024;
constexpr size_t WB_GLU = WB_2 + (size_t)1024 * 4096;
constexpr size_t WB_L1 = WB_GLU + (size_t)512 * 256;
constexpr size_t WB_L2 = WB_L1 + (size_t)512 * 512;
constexpr size_t WB_SX = WB_L2 + (size_t)1280 * 256;
constexpr size_t WB_SY = WB_SX + (size_t)16 * 256 * 256;
constexpr size_t WB_ELEMS = WB_SY + (size_t)16 * 256 * 512;
constexpr size_t WB_BYTES = WB_ELEMS * 2;
static_assert(WB_BYTES <= 5 * QB / 2, "weight block fits 2.5 Q");

constexpr size_t WS_H = 0;
constexpr size_t WS_WB0 = 4 * QB;
constexpr size_t WS_SMALL = 13 * QB / 2;
constexpr size_t WS_SSQ = WS_SMALL;
constexpr size_t WS_DT = WS_SSQ + (size_t)MP * 16 * 4;
constexpr size_t WS_DEC = WS_DT + (size_t)MP * 16 * 4;
static_assert(WS_DEC + (size_t)MP * 16 * 4 <= 7 * QB, "small region");
constexpr size_t WS_MIX = 7 * QB;
constexpr size_t WS_PXBC = WS_MIX;
constexpr size_t WS_YSSD = WS_MIX;
constexpr size_t WS_PARK = WS_MIX;
constexpr size_t WS_ACT = WS_MIX;
constexpr size_t WS_PRKVX = WS_MIX + 4 * QB;
constexpr size_t WS_L2O = WS_MIX + 4 * QB;
constexpr size_t WS_PZ = WS_MIX + 9 * QB;
constexpr size_t WS_UH = WS_MIX + 11 * QB;
constexpr size_t WS_X = WS_MIX + 53 * QB / 4;
constexpr size_t WS_L1IN = WS_MIX + 31 * QB / 2;
constexpr size_t WS_YAPRE = WS_L1IN;
constexpr size_t WS_L1O = WS_MIX + 35 * QB / 2;
constexpr size_t WS_YB = WS_L1O;
constexpr size_t WS_BC = WS_MIX + 39 * QB / 2;
constexpr size_t WS_YA = WS_MIX + 33 * QB / 2;
constexpr size_t WS_YC = WS_BC + QB;
constexpr size_t WS_XS = WS_MIX + 43 * QB / 2;
constexpr size_t WS_YRW0 = WS_XS + 2 * QB;
constexpr size_t WS_END = WS_YRW0 + QB;
static_assert(WS_END <= (size_t)512 << 20, "workspace map fits 512 MiB");
static_assert((size_t)16 * S5RP * 512 * 2 <= 9 * QB / 4 && (size_t)16 * S5RP * 256 * 4 <= 9 * QB / 4, "S5 buffers fit their slots");

constexpr size_t DO_RKVP = 0;
constexpr size_t DO_MERGED = 0;
constexpr size_t DO_WB1 = 4 * QB;
constexpr size_t DO_YRW1 = 13 * QB / 2;
static_assert(DO_WB1 + WB_BYTES <= DO_YRW1 && DO_YRW1 + QB <= (size_t)BATCH * SEQ * DM * 4, "d_out scratch map");

__device__ __forceinline__ unsigned f2bf(float f) { unsigned u = __builtin_bit_cast(unsigned, f); return (u + 0x7fffu + ((u >> 16) & 1u)) >> 16; }
typedef float f32x2_t_ __attribute__((ext_vector_type(2))); typedef __bf16 bf16x2_t_ __attribute__((ext_vector_type(2)));
__device__ __forceinline__ unsigned pk2(float lo, float hi) { const f32x2_t_ v = {lo, hi}; const bf16x2_t_ b = __builtin_convertvector(v, bf16x2_t_); return __builtin_bit_cast(unsigned, b); }
__device__ __forceinline__ float bflo(unsigned w) { return __builtin_bit_cast(float, w << 16); }
__device__ __forceinline__ float bfhi(unsigned w) { return __builtin_bit_cast(float, w & 0xffff0000u); }
__device__ __forceinline__ float bf1(bf16_t v) { return __builtin_bit_cast(float, (unsigned)v << 16); }
__device__ __forceinline__ float sigmoidf_(float x) { return __builtin_amdgcn_rcpf(1.0f + __expf(-x)); }
__device__ __forceinline__ float siluf_(float x) { return x * __builtin_amdgcn_rcpf(1.0f + __expf(-x)); }
__device__ __forceinline__ float tanhf_(float x) { x = fminf(fmaxf(x, -15.f), 15.f); const float t = __expf(2.f * x); return (t - 1.f) * __builtin_amdgcn_rcpf(t + 1.f); }
__device__ __forceinline__ float softplusf_(float x) { return fmaxf(x, 0.f) + __logf(1.0f + __expf(-fabsf(x))); }
__device__ __forceinline__ float geluf_(float x) { const float u = 0.7978845608028654f * (x + 0.044715f * x * x * x); return 0.5f * x * (1.f + tanhf_(u)); }
__device__ __forceinline__ float wave_sum(float v) {
#pragma unroll
    for (int o = 1; o < 64; o <<= 1) v += __shfl_xor(v, o);
    return v;
}
__device__ __forceinline__ float sum16(float v) {
#pragma unroll
    for (int o = 1; o < 16; o <<= 1) v += __shfl_xor(v, o);
    return v;
}
template <int CTRL> __device__ __forceinline__ float dpp_mov(float x) {
    return __builtin_bit_cast(float, __builtin_amdgcn_update_dpp(0, __builtin_bit_cast(int, x), CTRL, 0xf, 0xf, true));
}
__device__ __forceinline__ float allred16(float x) {
    x += dpp_mov<0xB1>(x); x += dpp_mov<0x4E>(x); x += dpp_mov<0x141>(x); x += dpp_mov<0x140>(x); return x;
}
__device__ __forceinline__ void unpack8(const u32x4 w, float (&f)[8]) {
    f[0] = bflo(w.x); f[1] = bfhi(w.x); f[2] = bflo(w.y); f[3] = bfhi(w.y); f[4] = bflo(w.z); f[5] = bfhi(w.z); f[6] = bflo(w.w); f[7] = bfhi(w.w);
}
__device__ __forceinline__ u32x4 pack8(const float (&f)[8]) { u32x4 w; w.x = pk2(f[0], f[1]); w.y = pk2(f[2], f[3]); w.z = pk2(f[4], f[5]); w.w = pk2(f[6], f[7]); return w; }
__device__ __forceinline__ int opaque_tid(int) { int t = threadIdx.x; asm volatile("" : "+v"(t)); return t; }
__device__ __forceinline__ int row_of(int b, int t) { return t < NMETA ? BATCH * SEQ + b * NMETA + t : b * SEQ + (t - NMETA); }
__device__ __forceinline__ void bt_of(int m, int& b, int& t) { if (m < BATCH * SEQ) { b = m >> 12; t = NMETA + (m & (SEQ - 1)); } else { const int q = m - BATCH * SEQ; b = q >> 4; t = q & (NMETA - 1); } }
namespace pg8 {
constexpr int BM = 256, BK = 64, HALF = 128, HTB = HALF * BK * 2  , STAGE_BYTES = 8 * HTB;
__host__ __device__ __forceinline__ int lds_byte(int r, int c) { const int st = (r >> 4) * 2 + (c >> 5), rr = r & 15, cc = c & 31, ob = rr * 64 + cc * 2; return st * 1024 + (ob ^ (((ob >> 9) & 1) << 5)); }
__host__ __device__ __forceinline__ void stage_rc(int b, int& R, int& C) { const int st = b / 1024, sb = b % 1024, swz = sb ^ (((sb >> 9) & 1) << 5); R = (st >> 1) * 16 + swz / 64; C = (st & 1) * 32 + (swz % 64) / 2; }
__host__ __device__ __forceinline__ int perm32(int rho) { const int n = rho >> 4, i = rho & 15; return 8 * (i >> 2) + 4 * n + (i & 3); }

struct GU {
    const bf16_t* A;
    const bf16_t* B;
    int lda, ldb, nt;
    int pm, pn, kind;
};

template <bool SKIP_HI = false, class Epi, class Sched>
__device__ __forceinline__ void gemm_phase(LAS unsigned char* lds, int wave_s, const Sched& S, const Epi& E) {
    const int tid = opaque_tid(wave_s), wid = wave_s, lane = tid & 63, wr = wid >> 2, wc = wid & 3, fr = lane & 15, fq = lane >> 4;
#define PG8_VOFF(lda_, ldb_, a0, b0) do { int R0_, C0_; stage_rc(tid * 16, R0_, C0_); \
        a0 = (unsigned)(R0_ * (lda_) + C0_) * 2u; b0 = (unsigned)(((R0_ & ~31) + perm32(R0_ & 31)) * (ldb_) + C0_) * 2u; } while (0)
    const size_t kstep = (size_t)(BK * 2);
    const unsigned ldsw = (unsigned)wid * 1024u;
    const int aoff = lds_byte(wr * 64 + fr, fq * 8), boff = lds_byte(wc * 32 + fr, fq * 8);
#define PG8_SA(b, h) (((b) * 2 + (h)) * HTB)
#define PG8_SB(b, h) ((4 + (b) * 2 + (h)) * HTB)
#define PG8_STAGE(bufoff, gbase, v0, hs) do { \
        __builtin_amdgcn_global_load_lds((const unsigned*)((const char*)(gbase) + (v0)), (LAS unsigned*)(lds + (bufoff) + ldsw), 16, 0, 0); \
        __builtin_amdgcn_global_load_lds((const unsigned*)((const char*)(gbase) + ((hs) >> 1) + (v0)), (LAS unsigned*)(lds + (bufoff) + ldsw + 8192), 16, 0, 0); } while (0)
#define PG8_LDA(dst, b, h) do { _Pragma("unroll") for (int m = 0; m < 4; ++m) _Pragma("unroll") for (int k = 0; k < 2; ++k) dst[m][k] = *(const LAS bf16x8*)(lds + PG8_SA(b, h) + aoff + m * 2048 + k * 1024); } while (0)
#define PG8_LDB(dst, b, h) do { _Pragma("unroll") for (int n = 0; n < 2; ++n) _Pragma("unroll") for (int k = 0; k < 2; ++k) dst[n][k] = *(const LAS bf16x8*)(lds + PG8_SB(b, h) + boff + n * 2048 + k * 1024); } while (0)
#define PG8_MMA(ai, bj, At, Bt) do { __builtin_amdgcn_s_setprio(1); _Pragma("unroll") for (int m = 0; m < 4; ++m) _Pragma("unroll") for (int n = 0; n < 2; ++n) _Pragma("unroll") for (int k = 0; k < 2; ++k) \
        acc[ai][bj][m][n] = __builtin_amdgcn_mfma_f32_16x16x32_bf16(Bt[n][k], At[m][k], acc[ai][bj][m][n], 0, 0, 0); __builtin_amdgcn_s_setprio(0); } while (0)
#define PG8_WAIT_V(n) asm volatile("s_waitcnt vmcnt(" #n ")" ::: "memory")
#define PG8_WAIT_L(n) asm volatile("s_waitcnt lgkmcnt(" #n ")" ::: "memory")
#define PG8_BAR __builtin_amdgcn_s_barrier()
#define PG8_SCHED __builtin_amdgcn_sched_barrier(0)
    GU cur, nxt; int ui = 0;
    if (!S.next(0, cur)) return;
    f32x4 acc[2][2][4][2];
#pragma unroll
    for (int a = 0; a < 2; ++a)
#pragma unroll
        for (int b = 0; b < 2; ++b)
#pragma unroll
            for (int m = 0; m < 4; ++m)
#pragma unroll
                for (int n = 0; n < 2; ++n) acc[a][b][m][n] = (f32x4){0.f, 0.f, 0.f, 0.f};
    bf16x8 At[4][2], B0[2][2], B1[2][2];
    const char* cA = (const char*)cur.A; const char* cB = (const char*)cur.B;
    unsigned vA0, vB0; PG8_VOFF(cur.lda, cur.ldb, vA0, vB0);
    size_t hsA = (size_t)HALF * cur.lda * 2, hsB = (size_t)HALF * cur.ldb * 2;
    int nt = cur.nt; asm volatile("" : "+s"(nt));
    PG8_STAGE(PG8_SB(0, 0), cB, vB0, hsB); PG8_STAGE(PG8_SB(0, 1), cB + hsB, vB0, hsB); PG8_STAGE(PG8_SA(0, 0), cA, vA0, hsA); PG8_STAGE(PG8_SA(0, 1), cA + hsA, vA0, hsA);
    if (wr == 1) PG8_BAR;
    PG8_WAIT_V(2); PG8_BAR;
    PG8_STAGE(PG8_SB(1, 0), cB + kstep, vB0, hsB); PG8_STAGE(PG8_SA(1, 0), cA + kstep, vA0, hsA); PG8_STAGE(PG8_SB(1, 1), cB + hsB + kstep, vB0, hsB);
    PG8_WAIT_V(6); PG8_BAR;
    for (;;) {
        const bool has_next = S.next(ui + 1, nxt);
        const char* nA = has_next ? (const char*)nxt.A : cA; const char* nB = has_next ? (const char*)nxt.B : cB;
        unsigned nvA0 = vA0, nvB0 = vB0;
        if (has_next) PG8_VOFF(nxt.lda, nxt.ldb, nvA0, nvB0);
        const size_t nhsA = has_next ? (size_t)HALF * nxt.lda * 2 : hsA, nhsB = has_next ? (size_t)HALF * nxt.ldb * 2 : hsB;
        for (int t = 0; t < nt; t += 2) {
            const bool last = (t == nt - 2);
            const char* a1 = cA + (size_t)(t + 1) * kstep;
            const char* a2 = last ? nA : cA + (size_t)(t + 2) * kstep; const char* b2 = last ? nB : cB + (size_t)(t + 2) * kstep;
            const char* a3 = a2 + kstep; const char* b3 = b2 + kstep;
            const unsigned xA0 = last ? nvA0 : vA0, xB0 = last ? nvB0 : vB0;
            const size_t xhA = last ? nhsA : hsA, xhB = last ? nhsB : hsB;
            PG8_LDB(B0, 0, 0); PG8_LDB(B1, 0, 1); PG8_SCHED; PG8_LDA(At, 0, 0); PG8_STAGE(PG8_SA(1, 1), a1 + hsA, vA0, hsA);
            PG8_WAIT_V(8); PG8_WAIT_L(0); PG8_BAR; PG8_MMA(0, 0, At, B0); PG8_MMA(0, 1, At, B1); PG8_BAR; PG8_SCHED;
            PG8_LDA(At, 0, 1); PG8_STAGE(PG8_SB(0, 0), b2, xB0, xhB); PG8_STAGE(PG8_SB(0, 1), b2 + xhB, xB0, xhB); PG8_STAGE(PG8_SA(0, 0), a2, xA0, xhA);
            PG8_WAIT_V(8); PG8_WAIT_L(0); PG8_BAR; if constexpr (!SKIP_HI) { PG8_MMA(1, 0, At, B0); PG8_MMA(1, 1, At, B1); } PG8_BAR; PG8_SCHED;
            PG8_LDB(B0, 1, 0); PG8_LDB(B1, 1, 1); PG8_SCHED; PG8_LDA(At, 1, 0); PG8_STAGE(PG8_SA(0, 1), a2 + xhA, xA0, xhA);
            PG8_WAIT_V(8); PG8_WAIT_L(0); PG8_BAR; PG8_MMA(0, 0, At, B0); PG8_MMA(0, 1, At, B1); PG8_BAR; PG8_SCHED;
            PG8_LDA(At, 1, 1); PG8_STAGE(PG8_SB(1, 0), b3, xB0, xhB); PG8_STAGE(PG8_SB(1, 1), b3 + xhB, xB0, xhB); PG8_STAGE(PG8_SA(1, 0), a3, xA0, xhA);
            PG8_WAIT_V(8); PG8_WAIT_L(0); PG8_BAR; if constexpr (!SKIP_HI) { PG8_MMA(1, 0, At, B0); PG8_MMA(1, 1, At, B1); } PG8_BAR; PG8_SCHED;
        }
        if (wr == 0) PG8_BAR;
        const bool keep = E(acc, cur, wr, wc, fr, fq);
        if (!has_next) break;
        if (!keep) {
#pragma unroll
            for (int a = 0; a < 2; ++a)
#pragma unroll
                for (int b = 0; b < 2; ++b)
#pragma unroll
                    for (int m = 0; m < 4; ++m)
#pragma unroll
                        for (int n = 0; n < 2; ++n) acc[a][b][m][n] = (f32x4){0.f, 0.f, 0.f, 0.f};
        }
        cur = nxt; cA = nA; cB = nB; vA0 = nvA0; vB0 = nvB0; hsA = nhsA; hsB = nhsB; nt = cur.nt; asm volatile("" : "+s"(nt)); ++ui;
        if (wr == 1) PG8_BAR;
    }
    PG8_WAIT_V(0);
    PG8_BAR;
#undef PG8_VOFF
#undef PG8_SA
#undef PG8_SB
#undef PG8_STAGE
#undef PG8_LDA
#undef PG8_LDB
#undef PG8_MMA
#undef PG8_WAIT_V
#undef PG8_WAIT_L
#undef PG8_BAR
#undef PG8_SCHED
}

__device__ __forceinline__ bool tile_order(int i, int G, int c, int nM, int nN, int& pm, int& pn) {
    const int nwg = nM * nN; const long L = (long)i * G + c; if (L >= nwg) return false;
    int wgid = (int)L; { const int q = nwg / 8, r = nwg % 8, xcd = wgid % 8, off = wgid / 8; wgid = (xcd < r ? xcd * (q + 1) : r * (q + 1) + (xcd - r) * q) + off; }
    const int nig = 8 * nN, gid = wgid / nig, fm = gid * 8, gsz = (nM - fm) < 8 ? (nM - fm) : 8;
    pm = fm + ((wgid % nig) % gsz); pn = (wgid % nig) / gsz; return true;
}
}
using pg8::GU;
enum InIdx { I_X = 0, I_META, I_FNW, I_MIXNW, I_WIN, I_S5LRE, I_S5LIM, I_S5LS, I_S5BRE, I_S5BIM, I_S5CRE, I_S5CIM, I_S5D, I_GLUW, I_GLUB,
             I_CONVW, I_CONVB, I_ALOG, I_DTB, I_SSDD, I_SSDNW, I_MURKV, I_MUWAG, I_W0, I_W1, I_W2, I_A0, I_A1, I_A2, I_G1, I_G2, I_KK, I_KA, I_RK, I_LNW, I_LNB,
             I_PA, I_PB, I_PC, I_WOUT, I_MLPNW, I_MLPW1, I_MLPW2, N_INPUTS };
struct Params { const float* in[N_INPUTS]; float* out; unsigned char* ws; int ph_lo, ph_hi; };

struct Ctx {
    const float* const* in; unsigned char* ws; unsigned char* dout;
    LAS unsigned char* lds;
    int tid, lane, wave, G, bid;
    __device__ __forceinline__ bf16_t* wb(int layer) const { return (bf16_t*)(layer == 0 ? ws + WS_WB0 : dout + DO_WB1); }
    __device__ __forceinline__ bf16_t* H() const { return (bf16_t*)(ws + WS_H); }
    __device__ __forceinline__ float* ssq() const { return (float*)(ws + WS_SSQ); }
};
__device__ __forceinline__ Ctx relaunder(const Ctx& c0) {
    Ctx c = c0; c.tid = opaque_tid(c0.wave); c.lane = c.tid & 63;
    int z = 0; asm volatile("" : "+s"(z)); z = __builtin_amdgcn_readfirstlane(z);
    c.ws = c0.ws + z; c.dout = c0.dout + z; c.in = c0.in + z;
    c.wave = c0.wave + z; c.bid = c0.bid + z; c.G = c0.G + z;
    return c;
}
__device__ __forceinline__ float row_scale(const float* ssq, int row) {
    const f32x4* p = (const f32x4*)(ssq + (size_t)row * 16);
    const f32x4 a = p[0], b = p[1], c = p[2], d = p[3];
    const float s = ((a.x + a.y) + (a.z + a.w)) + ((b.x + b.y) + (b.z + b.w)) + ((c.x + c.y) + (c.z + c.w)) + ((d.x + d.y) + (d.z + d.w));
    return __builtin_amdgcn_rsqf(s * (1.0f / DM) + EPS);
}

__device__ __forceinline__ void row_scales8(const float* ssq, int pm, int wr, int fr, int fq, float (&rs)[8]) {
    f32x4 p[8];
#pragma unroll
    for (int q = 0; q < 8; ++q) { int row = pm * 256 + (q >> 2) * 128 + wr * 64 + (q & 3) * 16 + fr; if (row >= M_ROWS) row = 0; p[q] = *(const f32x4*)(ssq + (size_t)row * 16 + fq * 4); }
#pragma unroll
    for (int q = 0; q < 8; ++q) { float s = (p[q].x + p[q].y) + (p[q].z + p[q].w); s += __shfl_xor(s, 16); s += __shfl_xor(s, 32); rs[q] = __builtin_amdgcn_rsqf(s * (1.0f / DM) + EPS); }
}

struct SchedPlain {
    const bf16_t* A; const bf16_t* B; int lda, ldb, K, nM, nN, G, c, pm0;
    __device__ __forceinline__ bool next(int i, GU& u) const {
        int pm, pn; if (!pg8::tile_order(i, G, c, nM, nN, pm, pn)) return false;
        pm += pm0;
        u.A = A + (size_t)pm * 256 * lda; u.B = B + (size_t)pn * 256 * ldb; u.lda = lda; u.ldb = ldb; u.nt = K / 64; u.pm = pm; u.pn = pn; u.kind = 0; return true;
    }
};
struct SchedS5 {
    const bf16_t* UH; const bf16_t* W; int K, G, c;
    __device__ __forceinline__ bool next(int i, GU& u) const {
        const int L = i * G + c; if (L >= 144) return false;
        const int g = L / 9, pm = L % 9;
        u.A = UH + ((size_t)g * S5RP + (size_t)pm * 256) * 512; u.B = W + (size_t)g * 256 * K; u.lda = 512; u.ldb = K; u.nt = K / 64; u.pm = pm; u.pn = 0; u.kind = g; return true;
    }
};
struct SchedL2 {
    const bf16_t* L1o; const bf16_t* W; int G, c, nM, pm0;
    __device__ __forceinline__ bool next(int i, GU& u) const {
        int pm, pn; if (!pg8::tile_order(i, G, c, nM, 5, pm, pn)) return false;
        pm += pm0;
        const int koff = pn < 2 ? 0 : (pn < 4 ? 128 : 256);
        u.A = L1o + (size_t)pm * 256 * 512 + koff; u.B = W + (size_t)pn * 256 * 256; u.lda = 512; u.ldb = 256; u.nt = 2; u.pm = pm; u.pn = pn; u.kind = 0; return true;
    }
};
struct SchedProj {
    const bf16_t* Hb; const bf16_t* Wg; const bf16_t* Wp; const bf16_t* ya; const bf16_t* yb; const bf16_t* yc; int nM, G, c, pm0;
    __device__ __forceinline__ bool next(int i, GU& u) const {
#ifdef PROJ_TWICE
        const int ti = i / 9, s9 = i - ti * 9, sub = s9 < 6 ? s9 : s9 - 3; int pm, pn;
#elif defined(GATES_TWICE)
        const int ti = i / 9, s9 = i - ti * 9, sub = s9 < 6 ? (s9 >> 1) : s9 - 3; int pm, pn;
#else
        const int ti = i / 6, sub = i - ti * 6; int pm, pn;
#endif
        if (!pg8::tile_order(ti, G, c, nM, 4, pm, pn)) return false;
        pm += pm0;
        u.pm = pm; u.pn = pn; u.kind = sub;
        if (sub < 3) { u.A = Hb + (size_t)pm * 256 * DM; u.lda = DM; u.B = Wg + ((size_t)sub * 1024 + (size_t)pn * 256) * DM; u.ldb = DM; u.nt = 16; }
        else if (sub == 3) { u.A = ya + (size_t)pm * 256 * 256; u.lda = 256; u.B = Wp + (size_t)pn * 256 * DM; u.ldb = DM; u.nt = 4; }
        else if (sub == 4) { u.A = yb + (size_t)pm * 256 * 512; u.lda = 512; u.B = Wp + (size_t)pn * 256 * DM + 256; u.ldb = DM; u.nt = 8; }
        else { u.A = yc + (size_t)pm * 256 * 256; u.lda = 256; u.B = Wp + (size_t)pn * 256 * DM + 768; u.ldb = DM; u.nt = 4; }
        return true;
    }
};

typedef f32x4 Acc[2][2][4][2];
#define EPI_ROWS_BEGIN  _Pragma("unroll") for (int ai = 0; ai < 2; ++ai) _Pragma("unroll") for (int m = 0; m < 4; ++m) { const int rl = ai * 128 + wr * 64 + m * 16 + fr; const int row = u.pm * 256 + rl; (void)rl;
#define EPI_ROWS_END    asm volatile("" ::: "memory"); }
#define EPI_ROWS_END2   asm volatile("" ::: "memory"); }
#define EPI_COL(bj) ((bj) * 128 + wc * 32 + fq * 8)

struct EpiInProj {
    const float* ssq; bf16_t* UH; bf16_t* Pz; bf16_t* Pxbc; bf16_t* Prkvx;
    __device__ __forceinline__ bool operator()(Acc& acc, const GU& u, int wr, int wc, int fr, int fq) const {
        float rs8[8]; row_scales8(ssq, u.pm, wr, fr, fq, rs8);
        EPI_ROWS_BEGIN
            if (row < M_ROWS) {
                const float s = rs8[ai * 4 + m];
                int b, t; bt_of(row, b, t);
#pragma unroll
                for (int bj = 0; bj < 2; ++bj) {
                    const int col = EPI_COL(bj);
                    const f32x4 v0 = acc[ai][bj][m][0] * s, v1 = acc[ai][bj][m][1] * s;
                    u32x4 w; w.x = pk2(v0[0], v0[1]); w.y = pk2(v0[2], v0[3]); w.z = pk2(v1[0], v1[1]); w.w = pk2(v1[2], v1[3]);
                    bf16_t* dst;
                    if (u.pn == 0) { const int g = col >> 4, hh = col & 15; dst = UH + ((size_t)g * S5RP + (size_t)(b * NCH16 + (t >> 4))) * 512 + (t & 15) * 16 + hh; }
                    else if (u.pn < 3) dst = Pz + (size_t)row * 512 + (u.pn - 1) * 256 + col;
                    else if (u.pn < 7) dst = Pxbc + (size_t)row * 1024 + (u.pn - 3) * 256 + col;
                    else dst = Prkvx + (size_t)row * 1024 + (u.pn - 7) * 256 + col;
                    *(u32x4*)dst = w;
                }
            }
        EPI_ROWS_END
        return false;
    }
};
struct EpiS5X {
    float* X;
    __device__ __forceinline__ bool operator()(Acc& acc, const GU& u, int wr, int wc, int fr, int fq) const {
        EPI_ROWS_BEGIN
            float* rp = X + ((size_t)u.kind * S5RP + row) * 256;
#pragma unroll
            for (int bj = 0; bj < 2; ++bj) { const int col = EPI_COL(bj); *(f32x4*)(rp + col) = acc[ai][bj][m][0]; *(f32x4*)(rp + col + 4) = acc[ai][bj][m][1]; }
        EPI_ROWS_END
        return false;
    }
};
struct EpiS5Y {
    bf16_t* yapre;
    __device__ __forceinline__ bool operator()(Acc& acc, const GU& u, int wr, int wc, int fr, int fq) const {
        EPI_ROWS_BEGIN
            if (row < S5ROWS) {
                const int b = row / NCH16, c = row - b * NCH16;
#pragma unroll
                for (int bj = 0; bj < 2; ++bj) {
                    const int col = EPI_COL(bj), i = col >> 4, hh = col & 15;
                    const f32x4 v0 = acc[ai][bj][m][0], v1 = acc[ai][bj][m][1];
                    u32x4 w; w.x = pk2(geluf_(v0[0]), geluf_(v0[1])); w.y = pk2(geluf_(v0[2]), geluf_(v0[3])); w.z = pk2(geluf_(v1[0]), geluf_(v1[1])); w.w = pk2(geluf_(v1[2]), geluf_(v1[3]));
                    *(u32x4*)(yapre + (size_t)row_of(b, c * 16 + i) * 256 + u.kind * 16 + hh) = w;
                }
            }
        EPI_ROWS_END
        return false;
    }
};
struct EpiL1 {
    bf16_t* L1o;
    __device__ __forceinline__ bool operator()(Acc& acc, const GU& u, int wr, int wc, int fr, int fq) const {
        EPI_ROWS_BEGIN
#pragma unroll
            for (int bj = 0; bj < 2; ++bj) {
                const int col = EPI_COL(bj); const int mode = u.pn * 2 + bj;
                f32x4 v0 = acc[ai][bj][m][0], v1 = acc[ai][bj][m][1]; float f[8] = {v0[0], v0[1], v0[2], v0[3], v1[0], v1[1], v1[2], v1[3]};
#pragma unroll
                for (int e = 0; e < 8; ++e) f[e] = mode == 0 ? tanhf_(f[e]) : (mode == 1 ? f[e] : (mode == 2 ? sigmoidf_(f[e]) : 0.f));
                if (mode != 3) *(u32x4*)(L1o + (size_t)row * 512 + u.pn * 256 + col) = pack8(f);
            }
        EPI_ROWS_END
        return false;
    }
};
struct EpiL2 {
    bf16_t* L2o; const float* w0; const float* a0;
    __device__ __forceinline__ bool operator()(Acc& acc, const GU& u, int wr, int wc, int fr, int fq) const {
        float bias[2][8];
        { const float* bp = u.pn < 2 ? w0 + u.pn * 256 : a0 + (u.pn < 4 ? u.pn - 2 : 0) * 256;
#pragma unroll
          for (int bj = 0; bj < 2; ++bj) { const f32x4 b0 = *(const f32x4*)(bp + EPI_COL(bj)), b1 = *(const f32x4*)(bp + EPI_COL(bj) + 4);
              bias[bj][0] = b0.x; bias[bj][1] = b0.y; bias[bj][2] = b0.z; bias[bj][3] = b0.w; bias[bj][4] = b1.x; bias[bj][5] = b1.y; bias[bj][6] = b1.z; bias[bj][7] = b1.w; } }
        EPI_ROWS_BEGIN
#pragma unroll
            for (int bj = 0; bj < 2; ++bj) {
                const int col = EPI_COL(bj);
                f32x4 v0 = acc[ai][bj][m][0], v1 = acc[ai][bj][m][1]; float f[8] = {v0[0], v0[1], v0[2], v0[3], v1[0], v1[1], v1[2], v1[3]};
                if (u.pn < 2) {
#pragma unroll
                    for (int e = 0; e < 8; ++e) f[e] = -0.60653065971263342f * sigmoidf_(bias[bj][e] + f[e]);
                } else if (u.pn < 4) {
#pragma unroll
                    for (int e = 0; e < 8; ++e) f[e] = sigmoidf_(bias[bj][e] + f[e]);
                }
                *(u32x4*)(L2o + (size_t)row * 1280 + u.pn * 256 + col) = pack8(f);
            }
        EPI_ROWS_END
        return false;
    }
};
struct EpiGLU {
    bf16_t* ya; const float* bias;
    __device__ __forceinline__ bool operator()(Acc& acc, const GU& u, int wr, int wc, int fr, int fq) const {
        const int lc = wc * 32 + fq * 8, oc = u.pn * 128 + lc;
        float bv[8], bg[8];
#pragma unroll
        for (int e = 0; e < 8; ++e) { bv[e] = bias[oc + e]; bg[e] = bias[256 + oc + e]; }
        EPI_ROWS_BEGIN
            const f32x4 a0 = acc[ai][0][m][0], a1 = acc[ai][0][m][1], g0 = acc[ai][1][m][0], g1 = acc[ai][1][m][1];
            float v[8] = {a0[0], a0[1], a0[2], a0[3], a1[0], a1[1], a1[2], a1[3]}, g[8] = {g0[0], g0[1], g0[2], g0[3], g1[0], g1[1], g1[2], g1[3]};
#pragma unroll
            for (int e = 0; e < 8; ++e) v[e] = (v[e] + bv[e]) * sigmoidf_(g[e] + bg[e]);
            *(u32x4*)(ya + (size_t)row * 256 + oc) = pack8(v);
        EPI_ROWS_END
        return false;
    }
};
struct EpiProj {
    const float* ssq; const float* ssqb; unsigned char* park; bf16_t* merged; int tid;
    __device__ __forceinline__ bool operator()(Acc& acc, const GU& u, int wr, int wc, int fr, int fq) const {
        const int k = u.kind;
        float s8[8];
        if (k < 3) row_scales8(ssq, u.pm, wr, fr, fq, s8);
        else if (k < 5) {
            f32x2_t_ sb[8];
#pragma unroll
            for (int g = 0; g < 8; ++g) { int row = u.pm * 256 + (g >> 2) * 128 + wr * 64 + (g & 3) * 16 + fr; if (row >= M_ROWS) row = 0; sb[g] = *(const f32x2_t_*)(ssqb + 2 * (size_t)row); }
#pragma unroll
            for (int g = 0; g < 8; ++g) { const float s = __builtin_amdgcn_rsqf((sb[g].x + sb[g].y) * (1.0f / 512.f) + EPS); s8[g] = k == 3 ? __builtin_amdgcn_rcpf(s) : s; }
        } else {
#pragma unroll
            for (int g = 0; g < 8; ++g) s8[g] = 1.f;
        }
        const int kn = k < 3 ? 0 : k - 3, kd = k < 3 ? 0 : (k < 5 ? k - 2 : 2);
        const unsigned char* pn_ = park + ((size_t)(kn * 16) * NTHREADS + tid) * 16;
        const unsigned char* pd_ = park + ((size_t)(kd * 16) * NTHREADS + tid) * 16;
        unsigned char* pk_ = park + ((size_t)((k < 3 ? k : 0) * 16) * NTHREADS + tid) * 16;
        u32x4 nn[2] = {(u32x4){0u, 0u, 0u, 0u}, (u32x4){0u, 0u, 0u, 0u}}, dd[2] = {nn[0], nn[0]};
        if (k >= 3) {
            nn[0] = *(const u32x4*)(pn_); nn[1] = *(const u32x4*)(pn_ + (size_t)4 * NTHREADS * 16);
            dd[0] = *(const u32x4*)(pd_); dd[1] = *(const u32x4*)(pd_ + (size_t)4 * NTHREADS * 16);
        }
#pragma unroll
        for (int g = 0; g < 8; ++g) {
            const int ai = g >> 2, m = g & 3; const int row = u.pm * 256 + ai * 128 + wr * 64 + m * 16 + fr;
            const float s = s8[g];
            const u32x4 cn[2] = {nn[0], nn[1]}, cd[2] = {dd[0], dd[1]};
            if (k >= 3 && g < 7) {
                const int q0 = (((g + 1) >> 2) * 2 + 0) * 4 + ((g + 1) & 3), q1 = q0 + 4;
                nn[0] = *(const u32x4*)(pn_ + (size_t)q0 * NTHREADS * 16); nn[1] = *(const u32x4*)(pn_ + (size_t)q1 * NTHREADS * 16);
                dd[0] = *(const u32x4*)(pd_ + (size_t)q0 * NTHREADS * 16); dd[1] = *(const u32x4*)(pd_ + (size_t)q1 * NTHREADS * 16);
            }
#pragma unroll
            for (int bj = 0; bj < 2; ++bj) {
                const int q = (ai * 2 + bj) * 4 + m;
                f32x4& v0 = acc[ai][bj][m][0]; f32x4& v1 = acc[ai][bj][m][1];
                if (k < 3) {
                    float f[8] = {v0[0], v0[1], v0[2], v0[3], v1[0], v1[1], v1[2], v1[3]};
#pragma unroll
                    for (int e = 0; e < 8; ++e) f[e] = sigmoidf_(f[e] * s);
                    *(u32x4*)(pk_ + (size_t)q * NTHREADS * 16) = pack8(f);
                } else {
                    float num[8], den[8];
                    unpack8(cn[bj], num);
                    if (k < 5) { unpack8(cd[bj], den);
#pragma unroll
                        for (int e = 0; e < 8; ++e) num[e] = num[e] * __builtin_amdgcn_rcpf(den[e]) * s; }
                    v0[0] *= num[0]; v0[1] *= num[1]; v0[2] *= num[2]; v0[3] *= num[3]; v1[0] *= num[4]; v1[1] *= num[5]; v1[2] *= num[6]; v1[3] *= num[7];
                    if (k == 5) { u32x4 w; w.x = pk2(v0[0], v0[1]); w.y = pk2(v0[2], v0[3]); w.z = pk2(v1[0], v1[1]); w.w = pk2(v1[2], v1[3]);
                        *(u32x4*)(merged + (size_t)row * DM + u.pn * 256 + EPI_COL(bj)) = w; }
                }
            }
            asm volatile("" ::: "memory");
        }
        return k == 3 || k == 4;
    }
};
struct EpiResid {
    bf16_t* H; float* ssq;
    __device__ __forceinline__ bool operator()(Acc& acc, const GU& u, int wr, int wc, int fr, int fq) const {
        bf16_t* hb = H + (size_t)(u.pm * 256 + wr * 64 + fr) * DM + u.pn * 256 + wc * 32 + fq * 8;
        u32x4 nx[2];
#pragma unroll
        for (int bj = 0; bj < 2; ++bj) nx[bj] = *(const u32x4*)(hb + bj * 128);
#pragma unroll
        for (int g = 0; g < 8; ++g) {
            const int ai = g >> 2, m = g & 3; const int row = u.pm * 256 + ai * 128 + wr * 64 + m * 16 + fr;
            const u32x4 cur[2] = {nx[0], nx[1]};
            if (g < 7) {
                const int ai2 = (g + 1) >> 2, m2 = (g + 1) & 3;
#pragma unroll
                for (int bj = 0; bj < 2; ++bj) nx[bj] = *(const u32x4*)(hb + (size_t)(ai2 * 128 + m2 * 16) * DM + bj * 128);
            }
            float ss = 0.f;
#pragma unroll
            for (int bj = 0; bj < 2; ++bj) {
                float f[8]; unpack8(cur[bj], f);
                const f32x4 v0 = acc[ai][bj][m][0], v1 = acc[ai][bj][m][1];
                f[0] += v0[0]; f[1] += v0[1]; f[2] += v0[2]; f[3] += v0[3]; f[4] += v1[0]; f[5] += v1[1]; f[6] += v1[2]; f[7] += v1[3];
#pragma unroll
                for (int e = 0; e < 8; ++e) ss += f[e] * f[e];
                *(u32x4*)(hb + (size_t)(ai * 128 + m * 16) * DM + bj * 128) = pack8(f);
            }
            ss += __shfl_xor(ss, 16); ss += __shfl_xor(ss, 32);
            if (fq == 0) ssq[(size_t)row * 16 + u.pn * 4 + wc] = ss;
            asm volatile("" ::: "memory");
        }
        return false;
    }
};
struct EpiUp {
    const float* ssq; bf16_t* act;
    __device__ __forceinline__ bool operator()(Acc& acc, const GU& u, int wr, int wc, int fr, int fq) const {
        float rs8[8]; row_scales8(ssq, u.pm, wr, fr, fq, rs8);
        EPI_ROWS_BEGIN
            const float s = rs8[ai * 4 + m];
#pragma unroll
            for (int bj = 0; bj < 2; ++bj) {
                const f32x4 v0 = acc[ai][bj][m][0] * s, v1 = acc[ai][bj][m][1] * s; float f[8] = {v0[0], v0[1], v0[2], v0[3], v1[0], v1[1], v1[2], v1[3]};
#pragma unroll
                for (int e = 0; e < 8; ++e) { const float r = fmaxf(f[e], 0.f); f[e] = r * r; }
                *(u32x4*)(act + (size_t)row * DFF + u.pn * 256 + EPI_COL(bj)) = pack8(f);
            }
        EPI_ROWS_END
        return false;
    }
};
typedef __attribute__((address_space(1))) unsigned gu32;
#define XB_TMO      128
#define XB_XCNT(j)  (256  + 64 * (j))
#define XB_XSUB(j)  (1280 + 64 * (j))
#define XB_XGEN(j)  (2304 + 64 * (j))
#define XB_TOP      3328
#define XB_TOPGEN   3392
#define XCD_BAR_WORDS 3456
#define XB_SPIN_CAP (1u << 18)

__device__ __forceinline__ unsigned xb_ld(unsigned* p)              { return __hip_atomic_load(p, __ATOMIC_RELAXED, __HIP_MEMORY_SCOPE_AGENT); }
__device__ __forceinline__ unsigned xb_add(unsigned* p, unsigned v) { return __hip_atomic_fetch_add(p, v, __ATOMIC_RELAXED, __HIP_MEMORY_SCOPE_AGENT); }
__device__ __forceinline__ unsigned xb_xcc_id() { return (unsigned)__builtin_amdgcn_s_getreg((3 << 11) | 20) & 0xFu; }
#define XB_SPIN(cond, bar) do { unsigned _sp = 0; while (cond) { __builtin_amdgcn_s_sleep(1); \
    if ((++_sp & 255u) == 0u) { if (xb_ld(&(bar)[XB_TMO])) break; if (_sp > XB_SPIN_CAP) { atomicAdd(&(bar)[XB_TMO], 1u); break; } } } } while (0)

struct XcdBarrier {
    unsigned* bar; unsigned x;
    volatile LAS unsigned* st;
};

__device__ __forceinline__ XcdBarrier xcd_barrier_post(unsigned* bar, volatile LAS unsigned* st) {
    XcdBarrier b; b.bar = bar; b.x = xb_xcc_id(); b.st = st;
    if (threadIdx.x == 0) (void)xb_add(&bar[XB_XCNT(b.x)], 1u);
    return b;
}
__device__ __forceinline__ void xcd_barrier_complete(unsigned* bar, unsigned x, unsigned& nloc, unsigned& nx) {
    const unsigned G = gridDim.x * gridDim.y * gridDim.z;
    unsigned sum, cnt, mine, sp = 0u;
    for (;;) {
        sum = 0u; cnt = 0u; mine = 0u;
#pragma unroll
        for (unsigned j = 0; j < 16; ++j) { const unsigned c = xb_ld(&bar[XB_XCNT(j)]); sum += c; cnt += (c > 0u) ? 1u : 0u; mine = (j == x) ? c : mine; }
        if (sum == G) break;
        __builtin_amdgcn_s_sleep(1);
        if ((++sp & 255u) == 0u) { if (xb_ld(&bar[XB_TMO])) break; if (sp > XB_SPIN_CAP) { atomicAdd(&bar[XB_TMO], 1u); break; } }
    }
    nloc = mine > 0u ? mine : 1u; nx = cnt > 0u ? cnt : 1u;
}

__device__ __forceinline__ void xcd_barrier(const XcdBarrier& b, int wave_s) {
    const bool xb_t0 = threadIdx.x == 0; (void)wave_s;
    asm volatile("s_waitcnt vmcnt(0)" ::: "memory");
    __syncthreads();
    if (xb_t0) {
        unsigned* bar = b.bar;
        __builtin_amdgcn_s_waitcnt(0);
        unsigned nloc = b.st[0], nx = b.st[1];
        if (nloc == 0u) { xcd_barrier_complete(bar, b.x, nloc, nx); b.st[0] = nloc; b.st[1] = nx; }
        const unsigned old = xb_add(&bar[XB_XSUB(b.x)], 1u);
        const unsigned gen = old / nloc;
        if (old + 1u == (gen + 1u) * nloc) {
            __builtin_amdgcn_fence(__ATOMIC_RELEASE, "agent");
            asm volatile("s_waitcnt vmcnt(0)" ::: "memory");
            const unsigned og = xb_add(&bar[XB_TOP], 1u);
            const unsigned tg = og / nx;
            if (og + 1u == (tg + 1u) * nx) xb_add(&bar[XB_TOPGEN], 1u);
            else XB_SPIN(xb_ld(&bar[XB_TOPGEN]) == tg, bar);
            __builtin_amdgcn_fence(__ATOMIC_ACQUIRE, "agent");
            xb_add(&bar[XB_XGEN(b.x)], 1u);
            asm volatile("s_waitcnt vmcnt(0)" ::: "memory");
        } else {
            XB_SPIN(xb_ld(&bar[XB_XGEN(b.x)]) == gen, bar);
            __builtin_amdgcn_fence(__ATOMIC_ACQUIRE, "agent");
            asm volatile("s_waitcnt vmcnt(0)" ::: "memory");
        }
    }
    __syncthreads();
}


__device__ __forceinline__ void sub_barrier(unsigned* cnt, unsigned n) {
    asm volatile("s_waitcnt vmcnt(0)" ::: "memory");
    __syncthreads();
    if (threadIdx.x == 0) {
        __builtin_amdgcn_s_waitcnt(0);
        __builtin_amdgcn_fence(__ATOMIC_RELEASE, "agent");
        asm volatile("s_waitcnt vmcnt(0)" ::: "memory");
        (void)xb_add(cnt, 1u);
        unsigned sp = 0u; while (xb_ld(cnt) < n) { __builtin_amdgcn_s_sleep(1); if (++sp > XB_SPIN_CAP) break; }
        __builtin_amdgcn_fence(__ATOMIC_ACQUIRE, "agent");
        asm volatile("s_waitcnt vmcnt(0)" ::: "memory");
    }
    __syncthreads();
}
#ifdef PROF_A
#ifndef PROF_SHIFT
#define PROF_SHIFT 1.0f
#endif
#define PROF_PTR ((unsigned long long*)(c.ws + WS_DEC + (size_t)MP * 64))
#define STAMP(k) do { if (blockIdx.x == 0 && threadIdx.x == 0) { const unsigned long long t_ = __builtin_amdgcn_s_memrealtime(); PROF_PTR[k] += t_ - PROF_PTR[15]; PROF_PTR[15] = t_; } } while (0)
#else
#define STAMP(k) do { } while (0)
#endif
struct TJob { const float* src; int ld, col0, K, N; bf16_t* dst; int dld, dk0, rmode, row0; const float* ksc; };
constexpr int N_TJOBS = 27;
__device__ __forceinline__ void get_tjob(const Ctx& c, int l, int j, TJob& t) {
    bf16_t* wb = c.wb(l);
    const float* win = c.in[I_WIN] + (size_t)l * DM * N_IN;
    t.rmode = 0; t.ksc = nullptr; t.dk0 = 0; t.col0 = 0; t.row0 = 0;
    if (j < 5) {
        t.src = win; t.ld = N_IN; t.K = DM; t.dld = DM; t.ksc = c.in[I_MIXNW] + l * DM; t.dst = wb + WB_IN;
        if (j == 0) { t.col0 = 0; t.N = 256; t.row0 = 0; }
        else if (j == 1) { t.col0 = 256; t.N = 512; t.row0 = 256; }
        else if (j == 2) { t.col0 = 768; t.N = 1024; t.row0 = 768; }
        else if (j == 3) { t.col0 = 1800; t.N = 1024; t.row0 = 1792; }
        else { t.col0 = 2824; t.N = 3072; t.row0 = 0; t.dst = wb + WB_G; }
    } else if (j == 5) { t.src = c.in[I_PA] + (size_t)l * 256 * DM; t.ld = DM; t.K = 256; t.N = DM; t.dst = wb + WB_P; t.dld = DM; t.dk0 = 0; }
    else if (j == 6) { t.src = c.in[I_PB] + (size_t)l * 512 * DM; t.ld = DM; t.K = 512; t.N = DM; t.dst = wb + WB_P; t.dld = DM; t.dk0 = 256; t.ksc = c.in[I_SSDNW] + (size_t)l * 512; }
    else if (j == 7) { t.src = c.in[I_PC] + (size_t)l * 256 * DM; t.ld = DM; t.K = 256; t.N = DM; t.dst = wb + WB_P; t.dld = DM; t.dk0 = 768; }
    else if (j == 8) { t.src = c.in[I_WOUT] + (size_t)l * DM * DM; t.ld = DM; t.K = DM; t.N = DM; t.dst = wb + WB_O; t.dld = DM; }
    else if (j == 9) { t.src = c.in[I_MLPW1] + (size_t)l * DM * DFF; t.ld = DFF; t.K = DM; t.N = DFF; t.dst = wb + WB_1; t.dld = DM; t.ksc = c.in[I_MLPNW] + l * DM; }
    else if (j == 10) { t.src = c.in[I_MLPW2] + (size_t)l * DFF * DM; t.ld = DM; t.K = DFF; t.N = DM; t.dst = wb + WB_2; t.dld = DFF; }
    else if (j == 11) { t.src = c.in[I_GLUW] + (size_t)l * 256 * 512; t.ld = 512; t.K = 256; t.N = 512; t.dst = wb + WB_GLU; t.dld = 256; t.rmode = 1; }
    else if (j < 22) {
        const int q = j - 12;
        t.K = 256; t.dst = wb + WB_L1; t.dld = 512;
        if (q < 4) { const int d = q >> 1, hf = q & 1; t.src = c.in[I_W1] + ((size_t)l * 2 + d) * 256 * 64; t.ld = 64; t.N = 64; t.row0 = d * 64; t.dk0 = hf * 256; if (hf) t.ksc = c.in[I_MUWAG] + ((size_t)l * 3 + 0) * 256; }
        else if (q < 8) { const int d = (q - 4) >> 1, hf = q & 1; t.src = c.in[I_A1] + ((size_t)l * 2 + d) * 256 * 64; t.ld = 64; t.N = 64; t.row0 = 128 + d * 64; t.dk0 = hf * 256; if (hf) t.ksc = c.in[I_MUWAG] + ((size_t)l * 3 + 1) * 256; }
        else { const int hf = q & 1; t.src = c.in[I_G1] + (size_t)l * 256 * 128; t.ld = 128; t.N = 128; t.row0 = 256; t.dk0 = hf * 256; if (hf) t.ksc = c.in[I_MUWAG] + ((size_t)l * 3 + 2) * 256; }
    } else {
        const int q = j - 22;
        t.dst = wb + WB_L2; t.dld = 256; t.ld = 256; t.N = 256;
        if (q < 2) { t.src = c.in[I_W2] + ((size_t)l * 2 + q) * 64 * 256; t.K = 64; t.row0 = q * 256; t.dk0 = q * 64; }
        else if (q < 4) { const int d = q - 2; t.src = c.in[I_A2] + ((size_t)l * 2 + d) * 64 * 256; t.K = 64; t.row0 = (2 + d) * 256; t.dk0 = d * 64; }
        else { t.src = c.in[I_G2] + (size_t)l * 128 * 256; t.K = 128; t.row0 = 4 * 256; t.dk0 = 0; }
    }
}
__device__ __forceinline__ int tjob_items(const TJob& t) { return (t.K / 64) * (t.N / 32); }
struct TIt { int l, j, base, gid; bool ok; TJob t; };
__device__ __forceinline__ void tit_seek(const Ctx& c, TIt& s) {
    s.ok = false;
    while (s.l < DEPTH) {
        const int ni = tjob_items(s.t);
        if (s.gid < s.base + ni) { s.ok = true; break; }
        s.base += ni;
        if (++s.j == N_TJOBS) { s.j = 0; ++s.l; if (s.l >= DEPTH) break; }
        get_tjob(c, s.l, s.j, s.t);
    }
}
__device__ __forceinline__ void tr_load(const TJob& t, int item, int lane, float (&v)[32]) {
    const int nblk = t.N / 32, kb = item / nblk, nb = item % nblk, k0 = 64 * kb, n0 = 32 * nb;
    const float* __restrict__ sp = t.src + (size_t)(k0 + (lane >> 5)) * t.ld + t.col0 + n0 + (lane & 31);
#pragma unroll
    for (int i = 0; i < 32; ++i) v[i] = sp[(size_t)(2 * i) * t.ld];
}
__device__ __forceinline__ void tr_store(const TJob& t, LAS float* scr, int item, int lane, const float (&v)[32]) {
    const int nblk = t.N / 32, kb = item / nblk, nb = item % nblk, k0 = 64 * kb, n0 = 32 * nb;
    const int cc = lane & 7;
    f32x4 ka = {1.f, 1.f, 1.f, 1.f}, kb4 = {1.f, 1.f, 1.f, 1.f};
    if (t.ksc) { ka = *(const f32x4*)(t.ksc + k0 + 8 * cc); kb4 = *(const f32x4*)(t.ksc + k0 + 8 * cc + 4); }
#pragma unroll
    for (int i = 0; i < 32; ++i) scr[(2 * i + (lane >> 5)) * 33 + (lane & 31)] = v[i];
    asm volatile("s_waitcnt lgkmcnt(0)" ::: "memory");
#pragma unroll
    for (int j = 0; j < 4; ++j) {
        const int n = (lane >> 3) + 8 * j; const LAS float* s = scr + (8 * cc) * 33 + n;
        u32x4 o; o.x = pk2(s[0 * 33] * ka.x, s[1 * 33] * ka.y); o.y = pk2(s[2 * 33] * ka.z, s[3 * 33] * ka.w); o.z = pk2(s[4 * 33] * kb4.x, s[5 * 33] * kb4.y); o.w = pk2(s[6 * 33] * kb4.z, s[7 * 33] * kb4.w);
        const int nn = n0 + n; int drow;
        if (t.rmode == 0) drow = t.row0 + nn; else drow = nn < 256 ? (nn >> 7) * 256 + (nn & 127) : ((nn - 256) >> 7) * 256 + 128 + ((nn - 256) & 127);
        *(u32x4*)(t.dst + (size_t)drow * t.dld + t.dk0 + k0 + 8 * cc) = o;
    }
    asm volatile("s_waitcnt lgkmcnt(0)" ::: "memory");
}

__device__ __forceinline__ void s5_build(const Ctx& cx_, int l, int g, int part) {
    const Ctx c = relaunder(cx_);
    LAS float* F = (LAS float*)c.lds;
    LAS float* pwr = F;
    LAS float* pwi = pwr + 2176;
    LAS float* cor = pwi + 2176;
    LAS float* coi = cor + 128;
    LAS float* Cr = coi + 128;
    LAS float* Ci = Cr + 1024;
    LAS float* Br = Ci + 1024;
    LAS float* Bi = Br + 1024;
    LAS float* kr = Bi + 1024;
    LAS float* ki = kr + 1984;
    LAS float* Kd = ki + 1984;
    const int tid = c.tid;
    for (int i = tid; i < 2 * 17 * 64; i += NTHREADS) {
        const int d = i / 1088, k = (i - d * 1088) >> 6, n = i & 63; const size_t li_ = (((size_t)l * 2 + d) * 16 + g) * 64 + n;
        const float lr = c.in[I_S5LRE][li_], li = c.in[I_S5LIM][li_], step = expf(c.in[I_S5LS][((size_t)l * 2 + d) * 16 + g]);
        const float mag = expf((float)k * lr * step), ang = (float)k * li * step; float sn, cs; sincosf(ang, &sn, &cs); pwr[(d * 17 + k) * 64 + n] = mag * cs; pwi[(d * 17 + k) * 64 + n] = mag * sn;
    }
    if (tid < 128) {
        const int d = tid >> 6, n = tid & 63; const size_t li_ = (((size_t)l * 2 + d) * 16 + g) * 64 + n;
        const float lr = c.in[I_S5LRE][li_], li = c.in[I_S5LIM][li_], step = expf(c.in[I_S5LS][((size_t)l * 2 + d) * 16 + g]);
        const float mag1 = expf(lr * step); float sn, cs; sincosf(li * step, &sn, &cs); const float abr = mag1 * cs, abi = mag1 * sn, den = lr * lr + li * li;
        cor[d * 64 + n] = ((abr - 1.f) * lr + abi * li) / den; coi[d * 64 + n] = (abi * lr - (abr - 1.f) * li) / den;
    }
    for (int i = tid; i < 1024; i += NTHREADS) {
        Cr[i] = c.in[I_S5CRE][((size_t)l * 16 + g) * 1024 + i]; Ci[i] = c.in[I_S5CIM][((size_t)l * 16 + g) * 1024 + i];
        Br[i] = c.in[I_S5BRE][((size_t)l * 16 + g) * 1024 + i]; Bi[i] = c.in[I_S5BIM][((size_t)l * 16 + g) * 1024 + i];
    }
    __syncthreads();
    for (int i = tid; i < 31 * 64; i += NTHREADS) {
        const int dd = i / 64 - 15, n = i & 63; float r, im;
        if (dd > 0) { const float pr = pwr[(0 * 17 + dd) * 64 + n], pi = pwi[(0 * 17 + dd) * 64 + n]; r = pr * cor[n] - pi * coi[n]; im = pr * coi[n] + pi * cor[n]; }
        else if (dd < 0) { const float pr = pwr[(1 * 17 - dd) * 64 + n], pi = pwi[(1 * 17 - dd) * 64 + n]; r = pr * cor[64 + n] - pi * coi[64 + n]; im = pr * coi[64 + n] + pi * cor[64 + n]; }
        else { r = cor[n] + cor[64 + n]; im = coi[n] + coi[64 + n]; }
        kr[i] = r; ki[i] = im;
    }
    __syncthreads();
    for (int i0 = tid; i0 < 31 * 32; i0 += NTHREADS) {
        const int ddi = i0 >> 5, h = 2 * part + ((i0 >> 4) & 1), hp = i0 & 15; float a = 0.f;
        for (int n = 0; n < 64; ++n) { const float cr = Cr[h * 64 + n], ci = Ci[h * 64 + n], xr = kr[ddi * 64 + n], xi = ki[ddi * 64 + n]; const float pr = cr * xr - ci * xi, pi = cr * xi + ci * xr; a += pr * Br[n * 16 + hp] - pi * Bi[n * 16 + hp]; }
        Kd[ddi * 256 + h * 16 + hp] = a;
    }
    __syncthreads();
    bf16_t* SX = c.wb(l) + WB_SX + (size_t)g * 256 * 256; bf16_t* SY = c.wb(l) + WB_SY + (size_t)g * 256 * 512;
    const float* dsk = c.in[I_S5D] + (size_t)l * 256 + g * 16;
    for (int u = tid; u < 32 * 64; u += NTHREADS) {
        const int i = u >> 7, h = 2 * part + ((u >> 6) & 1), o = i * 16 + h, kk0 = (u & 63) * 8; float v[8];
        if (kk0 < 256) { const int j = kk0 >> 4, hp0 = kk0 & 15;
#pragma unroll
            for (int e = 0; e < 8; ++e) v[e] = Kd[(i - j + 15) * 256 + h * 16 + hp0 + e] + ((i == j && h == hp0 + e) ? dsk[h] : 0.f);
        } else { const int q = kk0 - 256, d = q >> 7, part = (q >> 6) & 1, n0 = q & 63, ex = d == 0 ? i + 1 : 16 - i;
#pragma unroll
            for (int e = 0; e < 8; ++e) { const int n = n0 + e; const float cr = Cr[h * 64 + n], ci = Ci[h * 64 + n], pr = pwr[(d * 17 + ex) * 64 + n], pi = pwi[(d * 17 + ex) * 64 + n]; v[e] = part == 0 ? (cr * pr - ci * pi) : -(cr * pi + ci * pr); }
        }
        *(u32x4*)(SY + (size_t)o * 512 + kk0) = pack8(v);
    }
    for (int u = tid; u < 32 * 32; u += NTHREADS) {
        const int o = 32 * part + (u >> 5), kk0 = (u & 31) * 8, d = o >> 7, part = (o >> 6) & 1, n = o & 63, j = kk0 >> 4, hp0 = kk0 & 15, ex = d == 0 ? 15 - j : j;
        const float pr = pwr[(d * 17 + ex) * 64 + n], pi = pwi[(d * 17 + ex) * 64 + n], qr = pr * cor[d * 64 + n] - pi * coi[d * 64 + n], qi = pr * coi[d * 64 + n] + pi * cor[d * 64 + n];
        float v[8];
#pragma unroll
        for (int e = 0; e < 8; ++e) { const float br = Br[n * 16 + hp0 + e], bi = Bi[n * 16 + hp0 + e]; v[e] = part == 0 ? (qr * br - qi * bi) : (qr * bi + qi * br); }
        *(u32x4*)(SX + (size_t)o * 256 + kk0) = pack8(v);
    }
    __syncthreads();
}

__device__ __forceinline__ void phase0(const Ctx& cx_) {
    const Ctx c = relaunder(cx_);
    if (c.bid < 256) s5_build(c, c.bid >> 7, (c.bid >> 3) & 15, c.bid & 7);
    STAMP(13);
    const int gw = c.bid * NWAVES + c.wave, NGW = c.G * NWAVES, lane = c.lane;
    bf16_t* H = c.H(); float* ssq = c.ssq();
#pragma unroll 4
    for (int m = gw; m < MP; m += NGW) {
        u32x2* hp = (u32x2*)(H + (size_t)m * DM);
        if (m >= M_ROWS) {
#pragma unroll
            for (int i = 0; i < 4; ++i) hp[lane + 64 * i] = (u32x2){0u, 0u};
            continue;
        }
        int b, t; bt_of(m, b, t);
        const f32x4* src = (const f32x4*)(t < NMETA ? c.in[I_META] + (size_t)t * DM : c.in[I_X] + ((size_t)b * SEQ + (t - NMETA)) * DM);
        float ss = 0.f;
#pragma unroll
        for (int i = 0; i < 4; ++i) { const f32x4 v = src[lane + 64 * i]; ss += (v.x * v.x + v.y * v.y) + (v.z * v.z + v.w * v.w); hp[lane + 64 * i] = (u32x2){pk2(v.x, v.y), pk2(v.z, v.w)}; }
        ss = wave_sum(ss);
        if (lane < 16) ssq[(size_t)m * 16 + lane] = lane == 0 ? ss : 0.f;
    }
    STAMP(14);
    LAS float* scr = (LAS float*)(c.lds + c.wave * 8448);
    {
        TIt a; a.l = 0; a.j = 0; a.base = 0; a.gid = gw; get_tjob(c, 0, 0, a.t); tit_seek(c, a);
        float v[32], w[32];
        if (a.ok) tr_load(a.t, a.gid - a.base, lane, v);
        while (a.ok) {
            TIt b = a; b.gid += NGW; tit_seek(c, b);
            if (b.ok) tr_load(b.t, b.gid - b.base, lane, w);
            tr_store(a.t, scr, a.gid - a.base, lane, v);
            a = b;
#pragma unroll
            for (int i = 0; i < 32; ++i) v[i] = w[i];
        }
    }
    for (int l = 0; l < DEPTH; ++l) {
        bf16_t* wb = c.wb(l);
        const int gt = c.bid * NTHREADS + c.tid, NGT = c.G * NTHREADS;
        for (int u = gt; u < 128 * 64; u += NGT) *(u32x4*)(wb + WB_L1 + (size_t)384 * 512 + (size_t)u * 8) = (u32x4){0u, 0u, 0u, 0u};
        for (int u = gt; u < 5 * 256 * 4 * 8; u += NGT) {
            const int sub = u & 7, blk = (u >> 3) & 3, row = (u >> 5) & 255, tile = u >> 13;
            const bool nz = (tile == 0 || tile == 2) ? (blk == 0) : ((tile == 1 || tile == 3) ? (blk == 1) : (blk < 2));
            if (!nz) *(u32x4*)(wb + WB_L2 + ((size_t)tile * 256 + row) * 256 + blk * 64 + sub * 8) = (u32x4){0u, 0u, 0u, 0u};
        }
    }
}

__device__ __forceinline__ void dt_job(const Ctx& cx_, int l) {
    const Ctx c = relaunder(cx_);
    constexpr int DTS = 1032;
    LAS bf16_t* dtw = (LAS bf16_t*)c.lds;
    const float* win = c.in[I_WIN] + (size_t)l * DM * N_IN; const float* nw = c.in[I_MIXNW] + l * DM;
    {
        f32x4 wv[2][2]; float sc[2];
#pragma unroll
        for (int r = 0; r < 2; ++r) { const int k = c.tid + r * NTHREADS; const f32x4* wp = (const f32x4*)(win + (size_t)k * N_IN + 1792); wv[r][0] = wp[0]; wv[r][1] = wp[1]; sc[r] = nw[k]; }
#pragma unroll
        for (int r = 0; r < 2; ++r) { const int k = c.tid + r * NTHREADS;
#pragma unroll
            for (int j = 0; j < 8; ++j) { const float w = sc[r] * wv[r][j >> 2][j & 3]; const unsigned hi = f2bf(w); const float lo = w - __builtin_bit_cast(float, hi << 16);
                dtw[j * DTS + k] = (bf16_t)hi; dtw[(8 + j) * DTS + k] = (bf16_t)f2bf(lo); } }
    }
    __syncthreads();
    const int gw = c.bid * NWAVES + c.wave, NGW = c.G * NWAVES, lane = c.lane, li = lane & 15, lq = lane >> 4;
    const bf16_t* H = c.H(); float* dt = (float*)(c.ws + WS_DT); float* dec = (float*)(c.ws + WS_DEC); const float* ssq = c.ssq();
    const float* dtb = c.in[I_DTB] + l * 16; const float* alog = c.in[I_ALOG] + l * 16;
    float bias[2][4], ea[2][4];
#pragma unroll
    for (int d = 0; d < 2; ++d)
#pragma unroll
        for (int jj = 0; jj < 4; ++jj) { const int o = d * 8 + 4 * (lq & 1) + jj; bias[d][jj] = dtb[o]; ea[d][jj] = __expf(alog[o]); }
    for (int blk = gw; blk < M_ROWS / 16; blk += NGW) {
        const int row = blk * 16 + li;
        const bf16_t* __restrict__ hp = H + (size_t)row * DM + lq * 8; const LAS bf16_t* wp = dtw + li * DTS + lq * 8;
        f32x4 acc = {0.f, 0.f, 0.f, 0.f};
#pragma unroll 8
        for (int k = 0; k < 32; ++k) acc = __builtin_amdgcn_mfma_f32_16x16x32_bf16(*(const LAS bf16x8*)(wp + k * 32), *(const bf16x8*)(hp + k * 32), acc, 0, 0, 0);
        const f32x4 pq = *(const f32x4*)(ssq + (size_t)row * 16 + lq * 4);
        float sq = (pq.x + pq.y) + (pq.z + pq.w); sq += __shfl_xor(sq, 16); sq += __shfl_xor(sq, 32);
        const float s = __builtin_amdgcn_rsqf(sq * (1.0f / DM) + EPS);
        float d4[4];
#pragma unroll
        for (int jj = 0; jj < 4; ++jj) d4[jj] = acc[jj] + __shfl_xor(acc[jj], 32);
        if (lq < 2) {
#pragma unroll
            for (int d = 0; d < 2; ++d) {
                f32x4 dv, cv;
#pragma unroll
                for (int jj = 0; jj < 4; ++jj) { const float v = softplusf_(d4[jj] * s + bias[d][jj]); dv[jj] = v; cv[jj] = -v * ea[d][jj]; }
                *(f32x4*)(dt + (size_t)row * 16 + d * 8 + 4 * lq) = dv; *(f32x4*)(dec + (size_t)row * 16 + d * 8 + 4 * lq) = cv;
            }
        }
    }
    __syncthreads();
}

__device__ __forceinline__ void rwkv_prep(const Ctx& cx_, int l) {
    const Ctx c = relaunder(cx_);
    const int gw = c.bid * NWAVES + c.wave, NGW = c.G * NWAVES, lane = c.lane, c0 = 4 * lane;
    const bf16_t* __restrict__ P = (const bf16_t*)(c.ws + WS_PRKVX); bf16_t* __restrict__ rk = (bf16_t*)(c.dout + DO_RKVP); bf16_t* __restrict__ l1 = (bf16_t*)(c.ws + WS_L1IN);
    float mu[3][4], kkw[4];
#pragma unroll
    for (int x = 0; x < 3; ++x)
#pragma unroll
        for (int e = 0; e < 4; ++e) mu[x][e] = c.in[I_MURKV][((size_t)l * 3 + x) * 256 + c0 + e];
#pragma unroll
    for (int e = 0; e < 4; ++e) kkw[e] = c.in[I_KK][(size_t)l * 256 + c0 + e];
#pragma unroll 4
    for (int m = gw; m < M_ROWS; m += NGW) {
        int b, t; bt_of(m, b, t); const bool hp = t > 0, hn = t < LEN - 1; const size_t mp_ = hp ? row_of(b, t - 1) : 0, mn_ = hn ? row_of(b, t + 1) : 0;
        float o[4][4];
        float xc[4], dxc[4];
#pragma unroll
        for (int x = 0; x < 4; ++x) {
            const u32x2 wc_ = *(const u32x2*)(P + (size_t)m * 1024 + x * 256 + c0);
            u32x2 wp = (u32x2){0u, 0u}, wn = (u32x2){0u, 0u};
            if (hp) wp = *(const u32x2*)(P + mp_ * 1024 + x * 256 + c0);
            if (hn) wn = *(const u32x2*)(P + mn_ * 1024 + x * 256 + c0);
            const float cur[4] = {bflo(wc_.x), bfhi(wc_.x), bflo(wc_.y), bfhi(wc_.y)}, pv[4] = {bflo(wp.x), bfhi(wp.x), bflo(wp.y), bfhi(wp.y)}, nv[4] = {bflo(wn.x), bfhi(wn.x), bflo(wn.y), bfhi(wn.y)};
#pragma unroll
            for (int e = 0; e < 4; ++e) { const float cs = 0.5f * (pv[e] + nv[e]) - cur[e]; if (x < 3) o[x][e] = cur[e] + cs * mu[x][e]; else { xc[e] = cur[e]; dxc[e] = cs; } }
        }
        float kr_[4], ss = 0.f;
#pragma unroll
        for (int e = 0; e < 4; ++e) { kr_[e] = o[1][e] * kkw[e]; ss += kr_[e] * kr_[e]; }
        ss = sum16(ss); const float rn = __builtin_amdgcn_rsqf(ss + 1e-12f);
        bf16_t* rp = rk + (size_t)m * 1024 + c0;
        *(u32x2*)(rp) = (u32x2){pk2(o[0][0], o[0][1]), pk2(o[0][2], o[0][3])};
        *(u32x2*)(rp + 256) = (u32x2){pk2(o[1][0], o[1][1]), pk2(o[1][2], o[1][3])};
        *(u32x2*)(rp + 512) = (u32x2){pk2(o[2][0], o[2][1]), pk2(o[2][2], o[2][3])};
        *(u32x2*)(rp + 768) = (u32x2){pk2(kr_[0] * rn, kr_[1] * rn), pk2(kr_[2] * rn, kr_[3] * rn)};
        bf16_t* lp = l1 + (size_t)m * 512 + c0;
        *(u32x2*)(lp) = (u32x2){pk2(xc[0], xc[1]), pk2(xc[2], xc[3])};
        *(u32x2*)(lp + 256) = (u32x2){pk2(dxc[0], dxc[1]), pk2(dxc[2], dxc[3])};
    }
}
__device__ __forceinline__ void ssd_prep(const Ctx& cx_, int l) {
    const Ctx c = relaunder(cx_);
    const int gw = c.bid * NWAVES + c.wave, NGW = c.G * NWAVES, lane = c.lane, c0 = 16 * lane;
    const bf16_t* __restrict__ P = (const bf16_t*)(c.ws + WS_PXBC); bf16_t* __restrict__ xs = (bf16_t*)(c.ws + WS_XS); bf16_t* __restrict__ bc = (bf16_t*)(c.ws + WS_BC);
    float w[5][16], bias[16];
#pragma unroll
    for (int j = 0; j < 5; ++j)
#pragma unroll
        for (int e = 0; e < 16; ++e) w[j][e] = c.in[I_CONVW][((size_t)l * 5 + j) * 1024 + c0 + e];
#pragma unroll
    for (int e = 0; e < 16; ++e) bias[e] = c.in[I_CONVB][(size_t)l * 1024 + c0 + e];
#pragma unroll 2
    for (int m = gw; m < M_ROWS; m += NGW) {
        int b, t; bt_of(m, b, t);
        float a[16];
#pragma unroll
        for (int e = 0; e < 16; ++e) a[e] = bias[e];
#pragma unroll
        for (int j = 0; j < 5; ++j) {
            const int tt = t + j - 2;
            if (tt >= 0 && tt < LEN) {
                const u32x4* p = (const u32x4*)(P + (size_t)row_of(b, tt) * 1024 + c0); float f0[8], f1[8]; unpack8(p[0], f0); unpack8(p[1], f1);
#pragma unroll
                for (int e = 0; e < 8; ++e) { a[e] += w[j][e] * f0[e]; a[8 + e] += w[j][8 + e] * f1[e]; }
            }
        }
        float o0[8], o1[8];
#pragma unroll
        for (int e = 0; e < 8; ++e) { o0[e] = siluf_(a[e]); o1[e] = siluf_(a[8 + e]); }
        bf16_t* dst = lane < 32 ? xs + (size_t)m * 512 + c0 : bc + (size_t)m * 512 + (c0 - 512);
        ((u32x4*)dst)[0] = pack8(o0); ((u32x4*)dst)[1] = pack8(o1);
    }
}

__device__ __forceinline__ void s5_scan(const Ctx& cx_, int l, int idx, int nblk) {
    const Ctx c = relaunder(cx_);
    for (int task = idx; task < 256; task += nblk) {
    const int gt = task * 64 + c.lane;
    const int n = gt & 63, d = (gt >> 6) & 1, b = (gt >> 7) & 7, g = gt >> 10, seg = c.wave, i0 = 33 * seg;
    const size_t li_ = (((size_t)l * 2 + d) * 16 + g) * 64 + n;
    const float lr = c.in[I_S5LRE][li_], li = c.in[I_S5LIM][li_], step = expf(c.in[I_S5LS][((size_t)l * 2 + d) * 16 + g]);
    const float mag = expf(16.f * lr * step); float sn, cs; sincosf(16.f * li * step, &sn, &cs); const float ar = mag * cs, ai = mag * sn;
    const float* __restrict__ X = (const float*)(c.ws + WS_X) + ((size_t)g * S5RP + (size_t)b * NCH16) * 256 + d * 128 + n;
    bf16_t* __restrict__ U = (bf16_t*)(c.ws + WS_UH) + ((size_t)g * S5RP + (size_t)b * NCH16) * 512 + 256 + d * 128 + n;
    LAS float* tot = (LAS float*)c.lds;
    float xr[33], xi[33];
#pragma unroll
    for (int k = 0; k < 33; ++k) { const int i = i0 + k; const int ch = d == 0 ? i : NCH16 - 1 - i; const bool ok = i < NCH16; xr[k] = ok ? X[(size_t)ch * 256] : 0.f; xi[k] = ok ? X[(size_t)ch * 256 + 64] : 0.f; }
    float hr = 0.f, hi = 0.f, pr = 1.f, pi = 0.f;
#pragma unroll
    for (int k = 0; k < 33; ++k) {
        const float nr = ar * hr - ai * hi + xr[k], ni = ar * hi + ai * hr + xi[k]; hr = nr; hi = ni;
        const float qr = pr * ar - pi * ai, qi = pr * ai + pi * ar; pr = qr; pi = qi;
    }
    __syncthreads();
    tot[(seg * 2 + 0) * 64 + c.lane] = hr; tot[(seg * 2 + 1) * 64 + c.lane] = hi;
    __syncthreads();
    hr = 0.f; hi = 0.f;
    for (int s = 0; s < seg; ++s) { const float tr = tot[(s * 2 + 0) * 64 + c.lane], ti = tot[(s * 2 + 1) * 64 + c.lane]; const float nr = pr * hr - pi * hi + tr, ni = pr * hi + pi * hr + ti; hr = nr; hi = ni; }
#pragma unroll
    for (int k = 0; k < 33; ++k) { const int i = i0 + k;
        if (i < NCH16) { const int ch = d == 0 ? i : NCH16 - 1 - i; U[(size_t)ch * 512] = (bf16_t)f2bf(hr); U[(size_t)ch * 512 + 64] = (bf16_t)f2bf(hi); }
        const float nr = ar * hr - ai * hi + xr[k], ni = ar * hi + ai * hr + xi[k]; hr = nr; hi = ni; }
    __syncthreads();
    }
}
typedef short s16x4 __attribute__((ext_vector_type(4)));
__device__ __forceinline__ s16x4 lds_tr(const LAS unsigned char* p) { return __builtin_bit_cast(s16x4, __builtin_amdgcn_ds_read_tr16_b64_v4i16((LAS s16x4*)p)); }
__device__ __forceinline__ bf16x8 frag_tr(const LAS unsigned char* img, int rs, int kbase, int colbase, int lane) {
    const LAS unsigned char* a = img + (kbase + 8 * (lane >> 4) + ((lane & 15) >> 2)) * rs + (colbase + 4 * (lane & 3)) * 2;
    const s16x4 lo = lds_tr(a), hi = lds_tr(a + 4 * rs);
    return (bf16x8){lo[0], lo[1], lo[2], lo[3], hi[0], hi[1], hi[2], hi[3]};
}
__device__ __forceinline__ bf16x8 frag_row(const LAS unsigned char* img, int rs, int rowbase, int kbase, int lane) {
    return *(const LAS bf16x8*)(img + (rowbase + (lane & 15)) * rs + (kbase + 8 * (lane >> 4)) * 2);
}
constexpr int SD_RS = 272;
constexpr int SD_XRS = 144;
constexpr int SD_OFF_C = 0, SD_OFF_B = 34816, SD_OFF_X = 69632, SD_OFF_M = 88064, SD_OFF_SC = 122880;
constexpr int SD_OFF_HF = SD_OFF_B, SD_OFF_HB = SD_OFF_B + 17408;
constexpr size_t WS_STB = WS_YSSD;
constexpr size_t WS_CDEC = WS_DEC + (size_t)MP * 64 + 256;
constexpr size_t WS_SSQB = WS_CDEC + (size_t)BATCH * 33 * 16 * 4;
constexpr size_t WS_BAR = (WS_SSQB + (size_t)MP * 8 + 255) / 256 * 256;
static_assert(WS_BAR + 3456 * 4 <= 7 * QB, "small region");
static_assert((size_t)BATCH * 2 * 8 * 32 * 8192 * 2 <= 4 * QB, "chunk states fit the yssd slot");

struct SsdUnit { int b, ck, t0, ns; };
__device__ __forceinline__ bool ssd_unit(int bid, int round, SsdUnit& u) {
    if (round == 0) { u.b = bid >> 5; u.ck = 1 + (bid & 31); u.t0 = NMETA + 128 * (u.ck - 1); u.ns = 8; return true; }
    if (round == 1 && bid < BATCH) { u.b = bid; u.ck = 0; u.t0 = 0; u.ns = 1; return true; }
    return false;
}
__device__ __forceinline__ bool ssd_unit_n(int idx, int nblk, int round, SsdUnit& u, int& grp) {
    const int n2 = idx + nblk * round; if (n2 >= 528) return false; const int n = n2 >> 1; grp = n2 & 1;
    if (n < 256) { u.b = n >> 5; u.ck = 1 + (n & 31); u.t0 = NMETA + 128 * (u.ck - 1); u.ns = 8; } else { u.b = n - 256; u.ck = 0; u.t0 = 0; u.ns = 1; }
    return true;
}
__device__ __forceinline__ void ssd_load_img(LAS unsigned char* img, int rs, const bf16_t* src, int ld, size_t m0, int col0, int ncol, int ns, int tid) {
    const int cpr = ncol / 8, nrow = ns == 1 ? 32 : 128;
    for (int i = tid; i < nrow * cpr; i += NTHREADS) {
        const int r = i / cpr, cc = i - r * cpr; u32x4 v = (u32x4){0u, 0u, 0u, 0u};
        if (r < 16 * ns) v = *(const u32x4*)(src + (m0 + r) * ld + col0 + cc * 8);
        *(LAS u32x4*)(img + r * rs + cc * 16) = v;
    }
}
__device__ __forceinline__ void ssd_scalars(LAS float* sc, const float* dt, const float* al, size_t m0, int head, int ns, int lane, float& totf, float& totb) {
    const int Q = 16 * ns;
    float a0f = 0.f, a1f = 0.f, a0b = 0.f, a1b = 0.f, d0f = 0.f, d1f = 0.f, d0b = 0.f, d1b = 0.f;
    const int s0 = 2 * lane, s1 = 2 * lane + 1;
    if (s0 < Q) { a0f = al[(m0 + s0) * 16 + head]; a0b = al[(m0 + s0) * 16 + 8 + head]; d0f = dt[(m0 + s0) * 16 + head]; d0b = dt[(m0 + s0) * 16 + 8 + head]; }
    if (s1 < Q) { a1f = al[(m0 + s1) * 16 + head]; a1b = al[(m0 + s1) * 16 + 8 + head]; d1f = dt[(m0 + s1) * 16 + head]; d1b = dt[(m0 + s1) * 16 + 8 + head]; }
    float pf = a0f + a1f, pb = a0b + a1b;
#pragma unroll
    for (int o = 1; o < 64; o <<= 1) { const float tf = __shfl_up(pf, o), tb = __shfl_up(pb, o); if (lane >= o) { pf += tf; pb += tb; } }
    totf = __shfl(pf, 63); totb = __shfl(pb, 63);
    const float af1 = pf, af0 = pf - a1f;
    const float eb0 = pb - a0b - a1b, eb1 = pb - a1b;
    sc[s0] = af0; sc[s1] = af1; sc[128 + s0] = eb0; sc[128 + s1] = eb1; sc[256 + s0] = d0f; sc[256 + s1] = d1f; sc[384 + s0] = d0b; sc[384 + s1] = d1b;
    sc[512 + s0] = __expf(totf - af0) * d0f; sc[512 + s1] = __expf(totf - af1) * d1f;
    sc[640 + s0] = __expf(eb0) * d0b; sc[640 + s1] = __expf(eb1) * d1b;
    sc[768 + s0] = __expf(af0); sc[768 + s1] = __expf(af1);
    sc[896 + s0] = __expf(totb - eb0); sc[896 + s1] = __expf(totb - eb1);
}

__device__ __forceinline__ void ssd_states(const Ctx& cx_, int l, int idx, int nblk) {
    const Ctx c = relaunder(cx_);
    const int tid = c.tid, lane = c.lane, wave = c.wave;
    const bf16_t* bc = (const bf16_t*)(c.ws + WS_BC); const bf16_t* xs = (const bf16_t*)(c.ws + WS_XS);
    const float* dt = (const float*)(c.ws + WS_DT); const float* al = (const float*)(c.ws + WS_DEC);
    bf16_t* stb = (bf16_t*)(c.ws + WS_STB); float* cdec = (float*)(c.ws + WS_CDEC);
    LAS unsigned char* Bimg = c.lds + SD_OFF_B; LAS unsigned char* Ximg = c.lds + SD_OFF_X; LAS float* sc = (LAS float*)(c.lds + SD_OFF_SC);
    for (int round = 0; ; ++round) {
        SsdUnit u; int g; if (!ssd_unit_n(idx, nblk, round, u, g)) break;
        const size_t m0 = (size_t)row_of(u.b, u.t0); const int nks = u.ns == 1 ? 1 : 4;
        {
            __syncthreads();
            ssd_load_img(Bimg, SD_RS, bc, 512, m0, g * 128, 128, u.ns, tid);
            for (int j = 0; j < 4; ++j) {
                const int head = g * 4 + j;
                if (j) __syncthreads();
                ssd_load_img(Ximg, SD_XRS, xs, 512, m0, head * 64, 64, u.ns, tid);
                if (wave == 0) { float totf, totb; ssd_scalars(sc, dt, al, m0, head, u.ns, lane, totf, totb);
                    if (lane == 0) { cdec[((size_t)u.b * 33 + u.ck) * 16 + head] = __expf(totf); cdec[((size_t)u.b * 33 + u.ck) * 16 + 8 + head] = __expf(totb); } }
                __syncthreads();
                f32x4 accf[4], accb[4];
#pragma unroll
                for (int pt = 0; pt < 4; ++pt) { accf[pt] = (f32x4){0.f, 0.f, 0.f, 0.f}; accb[pt] = accf[pt]; }
                for (int ks = 0; ks < nks; ++ks) {
                    const bf16x8 af = frag_tr(Bimg, SD_RS, 32 * ks, 16 * wave, lane);
                    const int k0 = 32 * ks + 8 * (lane >> 4);
                    const f32x4 wf0 = *(const LAS f32x4*)(sc + 512 + k0), wf1 = *(const LAS f32x4*)(sc + 512 + k0 + 4), wb0 = *(const LAS f32x4*)(sc + 640 + k0), wb1 = *(const LAS f32x4*)(sc + 640 + k0 + 4);
#pragma unroll
                    for (int pt = 0; pt < 4; ++pt) {
                        const bf16x8 xr = frag_tr(Ximg, SD_XRS, 32 * ks, 16 * pt, lane);
                        float xf[8];
#pragma unroll
                        for (int e = 0; e < 8; ++e) xf[e] = bf1((bf16_t)xr[e]);
                        bf16x8 bfv, bbv;
                        { const unsigned p0 = pk2(xf[0] * wf0.x, xf[1] * wf0.y), p1 = pk2(xf[2] * wf0.z, xf[3] * wf0.w), p2 = pk2(xf[4] * wf1.x, xf[5] * wf1.y), p3 = pk2(xf[6] * wf1.z, xf[7] * wf1.w);
                          bfv = __builtin_bit_cast(bf16x8, (u32x4){p0, p1, p2, p3}); }
                        { const unsigned p0 = pk2(xf[0] * wb0.x, xf[1] * wb0.y), p1 = pk2(xf[2] * wb0.z, xf[3] * wb0.w), p2 = pk2(xf[4] * wb1.x, xf[5] * wb1.y), p3 = pk2(xf[6] * wb1.z, xf[7] * wb1.w);
                          bbv = __builtin_bit_cast(bf16x8, (u32x4){p0, p1, p2, p3}); }
                        accf[pt] = __builtin_amdgcn_mfma_f32_16x16x32_bf16(af, bfv, accf[pt], 0, 0, 0);
                        accb[pt] = __builtin_amdgcn_mfma_f32_16x16x32_bf16(af, bbv, accb[pt], 0, 0, 0);
                    }
                }
#pragma unroll
                for (int pt = 0; pt < 4; ++pt) {
                    const int p = 16 * pt + (lane & 15), n0 = 16 * wave + 4 * (lane >> 4);
                    if (u.ck <= 31) { bf16_t* d = stb + ((((size_t)u.b * 2 + 0) * 8 + head) * 32 + u.ck) * 8192 + (size_t)p * 128 + n0; *(u32x2*)d = (u32x2){pk2(accf[pt][0], accf[pt][1]), pk2(accf[pt][2], accf[pt][3])}; }
                    if (u.ck >= 1) { bf16_t* d = stb + ((((size_t)u.b * 2 + 1) * 8 + head) * 32 + (u.ck - 1)) * 8192 + (size_t)p * 128 + n0; *(u32x2*)d = (u32x2){pk2(accb[pt][0], accb[pt][1]), pk2(accb[pt][2], accb[pt][3])}; }
                }
            }
        }
    }
    __syncthreads();
}

__device__ __forceinline__ void ssd_chunk_scan(const Ctx& cx_, int l, int idx, int nblk) {
    const Ctx c = relaunder(cx_);
    bf16_t* stb = (bf16_t*)(c.ws + WS_STB); const float* cdec = (const float*)(c.ws + WS_CDEC);
    for (int gt = idx * NTHREADS + c.tid; gt < BATCH * 16 * 1024; gt += nblk * NTHREADS) {
    const int e8 = gt & 1023, bdh = gt >> 10;
    const int head = bdh & 7, dir = (bdh >> 3) & 1, b = bdh >> 4;
    bf16_t* base = stb + (size_t)bdh * 32 * 8192 + (size_t)e8 * 8;
    float h[8] = {0.f, 0.f, 0.f, 0.f, 0.f, 0.f, 0.f, 0.f};
    for (int i0 = 0; i0 < 32; i0 += 8) {
        u32x4 v[8]; float dcy[8];
#pragma unroll
        for (int k = 0; k < 8; ++k) { const int slot = dir == 0 ? i0 + k : 31 - (i0 + k); v[k] = *(const u32x4*)(base + (size_t)slot * 8192);
            const int ck = dir == 0 ? slot : slot + 1; dcy[k] = cdec[((size_t)b * 33 + ck) * 16 + dir * 8 + head]; }
#pragma unroll
        for (int k = 0; k < 8; ++k) { const int slot = dir == 0 ? i0 + k : 31 - (i0 + k); float s[8]; unpack8(v[k], s);
#pragma unroll
            for (int e = 0; e < 8; ++e) h[e] = h[e] * dcy[k] + s[e];
            *(u32x4*)(base + (size_t)slot * 8192) = pack8(h); }
    }
    }
}

__device__ __forceinline__ void ssd_outputs(const Ctx& cx_, int l, int first, int nblk) {
    const Ctx c = relaunder(cx_);
    const int tid = c.tid, lane = c.lane, wave = c.wave;
    const bf16_t* bc = (const bf16_t*)(c.ws + WS_BC); const bf16_t* xs = (const bf16_t*)(c.ws + WS_XS); const bf16_t* pz = (const bf16_t*)(c.ws + WS_PZ);
    const float* dt = (const float*)(c.ws + WS_DT); const float* al = (const float*)(c.ws + WS_DEC);
    const bf16_t* stb = (const bf16_t*)(c.ws + WS_STB); bf16_t* yb = (bf16_t*)(c.ws + WS_YB); float* ssqb = (float*)(c.ws + WS_SSQB);
    LAS unsigned char* Cimg = c.lds + SD_OFF_C; LAS unsigned char* Bimg = c.lds + SD_OFF_B; LAS unsigned char* Ximg = c.lds + SD_OFF_X;
    LAS unsigned char* HfT = c.lds + SD_OFF_HF; LAS unsigned char* HbT = c.lds + SD_OFF_HB;
    LAS unsigned char* Ms = c.lds + SD_OFF_M + wave * 4352; LAS float* sc = (LAS float*)(c.lds + SD_OFF_SC);
    for (int round = 0; round < 8; ++round) {
        SsdUnit u; int g0; if (!ssd_unit_n(c.bid - first, nblk, round, u, g0)) break;
        const size_t m0 = (size_t)row_of(u.b, u.t0); const int nks = u.ns == 1 ? 1 : 4; const bool active = wave < u.ns;
        float ssrow = 0.f;
        for (int g = g0; g <= g0; ++g) {
            __syncthreads();
            ssd_load_img(Cimg, SD_RS, bc, 512, m0, 256 + g * 128, 128, u.ns, tid);
            ssd_load_img(Bimg, SD_RS, bc, 512, m0, g * 128, 128, u.ns, tid);
            __syncthreads();
            f32x4 cb[8];
#pragma unroll
            for (int t = 0; t < 8; ++t) cb[t] = (f32x4){0.f, 0.f, 0.f, 0.f};
            if (active) {
#pragma unroll
                for (int ks = 0; ks < 4; ++ks) {
                    const bf16x8 cfr = frag_row(Cimg, SD_RS, 16 * wave, 32 * ks, lane);
#pragma unroll
                    for (int t = 0; t < 8; ++t) if (t < u.ns) cb[t] = __builtin_amdgcn_mfma_f32_16x16x32_bf16(frag_row(Bimg, SD_RS, 16 * t, 32 * ks, lane), cfr, cb[t], 0, 0, 0);
                }
            }
            for (int j = 0; j < 4; ++j) {
                const int head = g * 4 + j;
                __syncthreads();
                ssd_load_img(Ximg, SD_XRS, xs, 512, m0, head * 64, 64, u.ns, tid);
                {
                    const bf16_t* hf = u.ck >= 1 ? stb + ((((size_t)u.b * 2 + 0) * 8 + head) * 32 + (u.ck - 1)) * 8192 : nullptr;
                    const bf16_t* hb = u.ck <= 31 ? stb + ((((size_t)u.b * 2 + 1) * 8 + head) * 32 + u.ck) * 8192 : nullptr;
                    for (int i = tid; i < 64 * 16; i += NTHREADS) { const int p = i >> 4, cc = i & 15;
                        *(LAS u32x4*)(HfT + p * SD_RS + cc * 16) = hf ? *(const u32x4*)(hf + p * 128 + cc * 8) : (u32x4){0u, 0u, 0u, 0u};
                        *(LAS u32x4*)(HbT + p * SD_RS + cc * 16) = hb ? *(const u32x4*)(hb + p * 128 + cc * 8) : (u32x4){0u, 0u, 0u, 0u}; }
                }
                if (wave == 0) { float totf, totb; ssd_scalars(sc, dt, al, m0, head, u.ns, lane, totf, totb); }
                __syncthreads();
                if (active) {
                    const int ll = 16 * wave + (lane & 15); const float afl = sc[ll], ebl = sc[128 + ll];
#pragma unroll
                    for (int t = 0; t < 8; ++t) {
                        u32x2 w2 = (u32x2){0u, 0u};
                        if (t < u.ns) {
                            const int s0 = 16 * t + 4 * (lane >> 4);
                            const f32x4 afs = *(const LAS f32x4*)(sc + s0), ebs = *(const LAS f32x4*)(sc + 128 + s0), dfs = *(const LAS f32x4*)(sc + 256 + s0), dbs = *(const LAS f32x4*)(sc + 384 + s0);
                            float mv[4];
#pragma unroll
                            for (int r = 0; r < 4; ++r) { const int s = s0 + r; float wgt = 0.f; if (s <= ll) wgt += __expf(afl - afs[r]) * dfs[r]; if (s >= ll) wgt += __expf(ebs[r] - ebl) * dbs[r]; mv[r] = cb[t][r] * wgt; }
                            w2 = (u32x2){pk2(mv[0], mv[1]), pk2(mv[2], mv[3])};
                        }
                        if (t < 2 * nks) *(LAS u32x2*)(Ms + (lane & 15) * SD_RS + (16 * t + 4 * (lane >> 4)) * 2) = w2;
                    }
                    asm volatile("s_waitcnt lgkmcnt(0)" ::: "memory");
                    f32x4 ay[4], ahf[4], ahb[4];
#pragma unroll
                    for (int pt = 0; pt < 4; ++pt) { ay[pt] = (f32x4){0.f, 0.f, 0.f, 0.f}; ahf[pt] = ay[pt]; ahb[pt] = ay[pt]; }
                    for (int ks = 0; ks < nks; ++ks) {
                        const bf16x8 mf = frag_row(Ms, SD_RS, 0, 32 * ks, lane);
#pragma unroll
                        for (int pt = 0; pt < 4; ++pt) ay[pt] = __builtin_amdgcn_mfma_f32_16x16x32_bf16(mf, frag_tr(Ximg, SD_XRS, 32 * ks, 16 * pt, lane), ay[pt], 0, 0, 0);
                    }
#pragma unroll
                    for (int ks = 0; ks < 4; ++ks) {
                        const bf16x8 cfr = frag_row(Cimg, SD_RS, 16 * wave, 32 * ks, lane);
#pragma unroll
                        for (int pt = 0; pt < 4; ++pt) {
                            ahf[pt] = __builtin_amdgcn_mfma_f32_16x16x32_bf16(cfr, frag_row(HfT, SD_RS, 16 * pt, 32 * ks, lane), ahf[pt], 0, 0, 0);
                            ahb[pt] = __builtin_amdgcn_mfma_f32_16x16x32_bf16(cfr, frag_row(HbT, SD_RS, 16 * pt, 32 * ks, lane), ahb[pt], 0, 0, 0);
                        }
                    }
                    const int l0 = 16 * wave + 4 * (lane >> 4);
                    const f32x4 efv = *(const LAS f32x4*)(sc + 768 + l0), ebv = *(const LAS f32x4*)(sc + 896 + l0);
                    asm volatile("s_waitcnt lgkmcnt(0)" ::: "memory");
                    LAS float* ys = (LAS float*)Ms;
#pragma unroll
                    for (int pt = 0; pt < 4; ++pt)
#pragma unroll
                        for (int r = 0; r < 4; ++r) ys[(4 * (lane >> 4) + r) * 68 + 16 * pt + (lane & 15)] = ay[pt][r] + efv[r] * ahf[pt][r] + ebv[r] * ahb[pt][r];
                    asm volatile("s_waitcnt lgkmcnt(0)" ::: "memory");
                    const int rr = lane >> 2, p0 = 16 * (lane & 3); const size_t m = m0 + 16 * wave + rr;
                    const float dsk = c.in[I_SSDD][l * 8 + head];
                    float xv[16], zv[16];
                    { float t8[8]; unpack8(*(const LAS u32x4*)(Ximg + (16 * wave + rr) * SD_XRS + p0 * 2), t8);
#pragma unroll
                      for (int e = 0; e < 8; ++e) xv[e] = t8[e];
                      unpack8(*(const LAS u32x4*)(Ximg + (16 * wave + rr) * SD_XRS + p0 * 2 + 16), t8);
#pragma unroll
                      for (int e = 0; e < 8; ++e) xv[8 + e] = t8[e];
                      unpack8(*(const u32x4*)(pz + m * 512 + head * 64 + p0), t8);
#pragma unroll
                      for (int e = 0; e < 8; ++e) zv[e] = t8[e];
                      unpack8(*(const u32x4*)(pz + m * 512 + head * 64 + p0 + 8), t8);
#pragma unroll
                      for (int e = 0; e < 8; ++e) zv[8 + e] = t8[e]; }
                    float o[16];
#pragma unroll
                    for (int e4 = 0; e4 < 4; ++e4) { const f32x4 yv = *(const LAS f32x4*)(ys + rr * 68 + p0 + 4 * e4);
#pragma unroll
                        for (int e = 0; e < 4; ++e) { const float val = (yv[e] + dsk * xv[4 * e4 + e]) * siluf_(zv[4 * e4 + e]); o[4 * e4 + e] = val; ssrow += val * val; } }
                    u32x4 w0, w1; w0.x = pk2(o[0], o[1]); w0.y = pk2(o[2], o[3]); w0.z = pk2(o[4], o[5]); w0.w = pk2(o[6], o[7]); w1.x = pk2(o[8], o[9]); w1.y = pk2(o[10], o[11]); w1.z = pk2(o[12], o[13]); w1.w = pk2(o[14], o[15]);
                    *(u32x4*)(yb + m * 512 + head * 64 + p0) = w0; *(u32x4*)(yb + m * 512 + head * 64 + p0 + 8) = w1;
                }
            }
        }
        if (active) { ssrow += dpp_mov<0xB1>(ssrow); ssrow += dpp_mov<0x4E>(ssrow); if ((lane & 3) == 0) ssqb[(m0 + 16 * wave + (lane >> 2)) * 2 + g0] = ssrow; }
    }
    __syncthreads();
}
typedef short s16x4v __attribute__((ext_vector_type(4)));
constexpr int RC_NCH = LEN / 16;
constexpr int RC_NP = 5;
constexpr int RC_ROUNDS = (RC_NCH + RC_NP - 1) / RC_NP;
constexpr int RC_S64 = 144;
constexpr int RC_S16 = 40;
constexpr int RC_AT = 0, RC_RT = 2304, RC_BH = 4608, RC_KH = 6912, RC_T = 9216, RC_AAK = 9856, RC_ARB = 10496, RC_ARK = 11136, RC_VT = 11776, RC_P16 = 12416, RC_SLOT = 12800;
constexpr int RC_SCR0 = 2 * RC_NP * RC_SLOT;
constexpr int RC_SCR = 1280;
static_assert(RC_SCR0 + RC_NP * RC_SCR <= 147456 - 512, "rwkv chunk LDS");
__device__ __forceinline__ f32x4 mm16(s16x4v a, s16x4v b, f32x4 c, int, int, int) { return __builtin_amdgcn_mfma_f32_16x16x32_bf16((bf16x8){a[0], a[1], a[2], a[3], 0, 0, 0, 0}, (bf16x8){b[0], b[1], b[2], b[3], 0, 0, 0, 0}, c, 0, 0, 0); }
__device__ __forceinline__ s16x4v mfma16_frag(const LAS unsigned char* mat, int row, int q) { return *(const LAS s16x4v*)(mat + row * RC_S16 + q * 8); }

constexpr int RC64_NP = 4, RC64_ROUNDS = (RC_NCH + RC64_NP - 1) / RC64_NP;
constexpr int RC64_V = 11776, RC64_P16 = 14080, RC64_SLOT = 14336;
constexpr int RC64_SCR0 = 2 * RC64_NP * RC64_SLOT;
static_assert(RC64_SCR0 + RC64_NP * RC_SCR <= 147456 - 512, "rwkv64 LDS");
__device__ __forceinline__ void rwkv_chunked64(const Ctx& cx_, int l) {
    const Ctx c = relaunder(cx_);


    const int bid = c.bid, dir = bid & 1, head = (bid >> 1) & 3, b = bid >> 3;
    const int lane = c.lane, wave = c.wave;
    const bf16_t* rk = (const bf16_t*)(c.dout + DO_RKVP) + head * 64; const bf16_t* l2 = (const bf16_t*)(c.ws + WS_L2O) + dir * 256 + head * 64;
    bf16_t* yo = (bf16_t*)(dir == 0 ? c.ws + WS_YRW0 : c.dout + DO_YRW1) + head * 64 + 16 * (wave & 3);
    auto chunk_row0 = [&](int ch) -> int { const int tc = dir ? RC_NCH - 1 - ch : ch; return tc == 0 ? BATCH * SEQ + b * NMETA : b * SEQ + 16 * (tc - 1); };
    auto tokc = [&](int ch, int i) -> size_t { return (size_t)(chunk_row0(ch) + (dir ? 15 - i : i)); };
    const int q = lane >> 4, li = lane & 15;
    u32x4 Rr[2], Kr[2], KKr[2], DLr[2], ASr[2], Vr[2];
    auto load_raw = [&](int ch) {
        const size_t m = tokc(ch, li); const int k0 = 16 * q;
#pragma unroll
        for (int h = 0; h < 2; ++h) { Rr[h] = *(const u32x4*)(rk + m * 1024 + k0 + 8 * h); Kr[h] = *(const u32x4*)(rk + m * 1024 + 256 + k0 + 8 * h); KKr[h] = *(const u32x4*)(rk + m * 1024 + 768 + k0 + 8 * h);
            DLr[h] = *(const u32x4*)(l2 + m * 1280 + k0 + 8 * h); ASr[h] = *(const u32x4*)(l2 + m * 1280 + 512 + k0 + 8 * h); Vr[h] = *(const u32x4*)(rk + m * 1024 + 512 + k0 + 8 * h); }
    };
    float kaall[16];
#pragma unroll
    for (int e = 0; e < 16; ++e) kaall[e] = c.in[I_KA][(size_t)l * 256 + head * 64 + 16 * q + e];
    auto produce = [&](int slot) {
        LAS unsigned char* sb = c.lds + slot * RC64_SLOT; LAS float* Aab = (LAS float*)(c.lds + RC64_SCR0 + (wave - 4) * RC_SCR);
        LAS unsigned char* Bh = sb + RC_BH; LAS unsigned char* Kh = sb + RC_KH;
        *(LAS u32x4*)(sb + RC64_V + li * RC_S64 + (16 * q) * 2) = Vr[0]; *(LAS u32x4*)(sb + RC64_V + li * RC_S64 + (16 * q + 8) * 2) = Vr[1];
        const int k0 = 16 * q;
#pragma unroll
        for (int h = 0; h < 2; ++h) {
            float r_[8], k_[8], kk_[8], dl_[8], as_[8], cs_[8]; unpack8(Rr[h], r_); unpack8(Kr[h], k_); unpack8(KKr[h], kk_); unpack8(DLr[h], dl_); unpack8(ASr[h], as_);
            const float* ka = kaall + 8 * h;
            float at_[8], rt_[8], bh_[8], kh_[8], p_[8];
#pragma unroll
            for (int e = 0; e < 8; ++e) {
                float x = dl_[e];
                x += dpp_mov<0x111>(x); x += dpp_mov<0x112>(x); x += dpp_mov<0x114>(x); x += dpp_mov<0x118>(x);
                cs_[e] = x;
            }
#pragma unroll
            for (int e = 0; e < 8; ++e) {
                const float P = __expf(cs_[e]), iP = __builtin_amdgcn_rcpf(P); const float Psh = dpp_mov<0x111>(P), Pm = li == 0 ? 1.f : Psh;
                at_[e] = -kk_[e] * Pm; rt_[e] = r_[e] * P; bh_[e] = kk_[e] * as_[e] * iP; kh_[e] = k_[e] * (1.f + (as_[e] - 1.f) * ka[e]) * iP; p_[e] = P;
            }
            *(LAS u32x4*)(sb + RC_AT + li * RC_S64 + (k0 + 8 * h) * 2) = pack8(at_); *(LAS u32x4*)(sb + RC_RT + li * RC_S64 + (k0 + 8 * h) * 2) = pack8(rt_);
            *(LAS u32x4*)(Bh + li * RC_S64 + (k0 + 8 * h) * 2) = pack8(bh_); *(LAS u32x4*)(Kh + li * RC_S64 + (k0 + 8 * h) * 2) = pack8(kh_);
            if (li == 15) { *(LAS f32x4*)(sb + RC64_P16 + (k0 + 8 * h) * 4) = (f32x4){p_[0], p_[1], p_[2], p_[3]}; *(LAS f32x4*)(sb + RC64_P16 + (k0 + 8 * h + 4) * 4) = (f32x4){p_[4], p_[5], p_[6], p_[7]}; }
        }
        asm volatile("s_waitcnt lgkmcnt(0)" ::: "memory");
        f32x4 ab = (f32x4){0.f, 0.f, 0.f, 0.f}, ak = ab, rb = ab, rkm = ab;
#pragma unroll
        for (int ks = 0; ks < 2; ++ks) {
            const bf16x8 fa = *(const LAS bf16x8*)(sb + RC_AT + li * RC_S64 + (32 * ks + 8 * q) * 2), fr = *(const LAS bf16x8*)(sb + RC_RT + li * RC_S64 + (32 * ks + 8 * q) * 2);
            const bf16x8 fb = *(const LAS bf16x8*)(Bh + li * RC_S64 + (32 * ks + 8 * q) * 2), fk = *(const LAS bf16x8*)(Kh + li * RC_S64 + (32 * ks + 8 * q) * 2);
            ab = __builtin_amdgcn_mfma_f32_16x16x32_bf16(fa, fb, ab, 0, 0, 0); ak = __builtin_amdgcn_mfma_f32_16x16x32_bf16(fa, fk, ak, 0, 0, 0);
            rb = __builtin_amdgcn_mfma_f32_16x16x32_bf16(fr, fb, rb, 0, 0, 0); rkm = __builtin_amdgcn_mfma_f32_16x16x32_bf16(fr, fk, rkm, 0, 0, 0);
        }
#pragma unroll
        for (int r = 0; r < 4; ++r) {
            const int t = 4 * q + r, s = li;
            Aab[t * 20 + s] = s < t ? ab[r] : 0.f;
            *(LAS bf16_t*)(sb + RC_AAK + t * RC_S16 + s * 2) = (bf16_t)f2bf(s < t ? ak[r] : 0.f);
            *(LAS bf16_t*)(sb + RC_ARB + t * RC_S16 + s * 2) = (bf16_t)f2bf(s <= t ? rb[r] : 0.f);
            *(LAS bf16_t*)(sb + RC_ARK + t * RC_S16 + s * 2) = (bf16_t)f2bf(s <= t ? rkm[r] : 0.f);
        }
        asm volatile("s_waitcnt lgkmcnt(0)" ::: "memory");
        float tc[16];
#pragma unroll
        for (int t = 0; t < 16; ++t) {
            float acc = (t == li) ? 1.f : 0.f;
            f32x4 a0 = *(const LAS f32x4*)(Aab + t * 20), a1 = *(const LAS f32x4*)(Aab + t * 20 + 4), a2 = *(const LAS f32x4*)(Aab + t * 20 + 8), a3 = *(const LAS f32x4*)(Aab + t * 20 + 12);
            const float av[16] = {a0.x, a0.y, a0.z, a0.w, a1.x, a1.y, a1.z, a1.w, a2.x, a2.y, a2.z, a2.w, a3.x, a3.y, a3.z, a3.w};
            float a1_ = 0.f, a2_ = 0.f, a3_ = 0.f;
#pragma unroll
            for (int s = 0; s < t; ++s) { const float pr_ = av[s] * tc[s]; if ((s & 3) == 0) acc += pr_; else if ((s & 3) == 1) a1_ += pr_; else if ((s & 3) == 2) a2_ += pr_; else a3_ += pr_; }
            tc[t] = (acc + a1_) + (a2_ + a3_);
        }
        if (q == 0) {
#pragma unroll
            for (int t = 0; t < 16; ++t) *(LAS bf16_t*)(sb + RC_T + t * RC_S16 + li * 2) = (bf16_t)f2bf(tc[t]);
        }
    };
    if (wave >= 4 && wave - 4 < RC64_NP) { const int ch0 = wave - 4; load_raw(ch0); produce(wave - 4); load_raw(ch0 + RC64_NP); }
    __syncthreads();
    f32x4 S[4]; bf16x8 sop[2];
#pragma unroll
    for (int kt = 0; kt < 4; ++kt) S[kt] = (f32x4){0.f, 0.f, 0.f, 0.f};
    sop[0] = (bf16x8){0, 0, 0, 0, 0, 0, 0, 0}; sop[1] = sop[0];
    int sbase = 0;
    auto consume = [&](const int i, const int ch) {
                const LAS unsigned char* sb = c.lds + (sbase + i) * RC64_SLOT;
        const s16x4v vt = lds_tr(sb + RC64_V + (4 * q + (li >> 2)) * RC_S64 + (16 * (wave & 3) + 4 * (li & 3)) * 2);
        f32x4 aw = mm16(mfma16_frag(sb + RC_AAK, li, q), vt, (f32x4){0.f, 0.f, 0.f, 0.f}, 0, 0, 0);
        f32x4 ay = mm16(mfma16_frag(sb + RC_ARK, li, q), vt, (f32x4){0.f, 0.f, 0.f, 0.f}, 0, 0, 0);
#pragma unroll
        for (int ks = 0; ks < 2; ++ks) {
            const s16x4v alo = *(const LAS s16x4v*)(sb + RC_AT + li * RC_S64 + (32 * ks + 4 * q) * 2), ahi = *(const LAS s16x4v*)(sb + RC_AT + li * RC_S64 + (32 * ks + 16 + 4 * q) * 2);
            const s16x4v rlo = *(const LAS s16x4v*)(sb + RC_RT + li * RC_S64 + (32 * ks + 4 * q) * 2), rhi = *(const LAS s16x4v*)(sb + RC_RT + li * RC_S64 + (32 * ks + 16 + 4 * q) * 2);
            aw = __builtin_amdgcn_mfma_f32_16x16x32_bf16((bf16x8){alo[0], alo[1], alo[2], alo[3], ahi[0], ahi[1], ahi[2], ahi[3]}, sop[ks], aw, 0, 0, 0);
            ay = __builtin_amdgcn_mfma_f32_16x16x32_bf16((bf16x8){rlo[0], rlo[1], rlo[2], rlo[3], rhi[0], rhi[1], rhi[2], rhi[3]}, sop[ks], ay, 0, 0, 0);
        }
        const u32x2 wb2 = (u32x2){pk2(aw[0], aw[1]), pk2(aw[2], aw[3])};
        const f32x4 au = mm16(mfma16_frag(sb + RC_T, li, q), __builtin_bit_cast(s16x4v, wb2), (f32x4){0.f, 0.f, 0.f, 0.f}, 0, 0, 0);
        const u32x2 ub2 = (u32x2){pk2(au[0], au[1]), pk2(au[2], au[3])}; const s16x4v ub = __builtin_bit_cast(s16x4v, ub2);
        ay = mm16(mfma16_frag(sb + RC_ARB, li, q), ub, ay, 0, 0, 0);
#pragma unroll
        for (int kt = 0; kt < 4; ++kt) {
            const f32x4 p16 = *(const LAS f32x4*)(sb + RC64_P16 + (16 * kt + 4 * q) * 4);
            const int troff = (4 * q + (li >> 2)) * RC_S64 + (16 * kt + 4 * (li & 3)) * 2;
            f32x4 sv = S[kt];
            sv = mm16(lds_tr(sb + RC_KH + troff), vt, sv, 0, 0, 0);
            sv = mm16(lds_tr(sb + RC_BH + troff), ub, sv, 0, 0, 0);
            sv = sv * p16;
            S[kt] = sv;
        }
#pragma unroll
        for (int ks = 0; ks < 2; ++ks) {
            const u32x4 w = (u32x4){pk2(S[2 * ks][0], S[2 * ks][1]), pk2(S[2 * ks][2], S[2 * ks][3]), pk2(S[2 * ks + 1][0], S[2 * ks + 1][1]), pk2(S[2 * ks + 1][2], S[2 * ks + 1][3])};
            sop[ks] = __builtin_bit_cast(bf16x8, w);
        }
        bf16_t* yp = yo + tokc(ch, 4 * q) * 256 + li; const int ystep = dir ? -256 : 256;
#pragma unroll
        for (int r = 0; r < 4; ++r) yp[r * ystep] = (bf16_t)f2bf(ay[r]);
    };
    for (int rd = 0; rd < RC64_ROUNDS; ++rd) {
        if (wave < 4) {
            sbase = (rd & 1) * RC64_NP;
            if (rd < RC64_ROUNDS - 1) {
#pragma unroll
                for (int i = 0; i < RC64_NP; ++i) consume(i, RC64_NP * rd + i);
            } else {
                for (int i = 0; i < RC64_NP; ++i) { const int ch = RC64_NP * rd + i; if (ch >= RC_NCH) break; consume(i, ch); }
            }
        } else if (wave - 4 < RC64_NP) {
            const int chn = RC64_NP * (rd + 1) + (wave - 4);
            if (chn < RC_NCH) { produce(((rd + 1) & 1) * RC64_NP + (wave - 4)); if (chn + RC64_NP < RC_NCH) load_raw(chn + RC64_NP); }
        }
        __syncthreads();
    }
}
__device__ __forceinline__ f32x4 mg_dot(const bf16_t* __restrict__ w, const bf16_t* __restrict__ x, int nk, f32x4 acc) {
#pragma unroll 8
    for (int k = 0; k < nk; ++k) acc = __builtin_amdgcn_mfma_f32_16x16x32_bf16(*(const bf16x8*)(w + k * 32), *(const bf16x8*)(x + k * 32), acc, 0, 0, 0);
    return acc;
}
__device__ __forceinline__ void mg_store4(bf16_t* dst, float a, float b, float c, float d) { uint2 w; w.x = pk2(a, b); w.y = pk2(c, d); *(uint2*)dst = w; }

__device__ __forceinline__ void meta_gates(const Ctx& cx_, int l) {
    const Ctx c = relaunder(cx_);
    const int lane = c.lane, wave = c.wave, li = lane & 15, lq = lane >> 4, role = wave & 3, rh = wave >> 2;
    const int c0 = (c.bid >> 2) * 16, row = BATCH * SEQ + ((c.bid & 3) * 2 + rh) * 16 + li;
    const bf16_t* wbase = c.wb(l);
    LAS float* sg = (LAS float*)c.lds;
    const f32x4 zero = {0.f, 0.f, 0.f, 0.f};
    f32x4 p0 = zero, p1 = zero, p2 = zero;
    __syncthreads();
    if (role < 3) {
        const f32x4 acc = mg_dot(wbase + WB_G + ((size_t)role * 1024 + c0 + li) * DM + lq * 8, c.H() + (size_t)row * DM + lq * 8, 32, zero);
        const float s = row_scale(c.ssq(), row);
#pragma unroll
        for (int j = 0; j < 4; ++j) sg[((rh * 3 + role) * 4 + j) * 64 + lane] = sigmoidf_(acc[j] * s);
    } else {
        const bf16_t* wp = wbase + WB_P + (size_t)(c0 + li) * DM + lq * 8;
        p0 = mg_dot(wp, (const bf16_t*)(c.ws + WS_YA) + (size_t)row * 256 + lq * 8, 8, zero);
        p1 = mg_dot(wp + 256, (const bf16_t*)(c.ws + WS_YB) + (size_t)row * 512 + lq * 8, 16, zero);
        p2 = mg_dot(wp + 768, (const bf16_t*)(c.ws + WS_YC) + (size_t)row * 256 + lq * 8, 8, zero);
    }
    __syncthreads();
    if (role == 3) {
        const float* ssqb = (const float*)(c.ws + WS_SSQB);
        const float rsb = __builtin_amdgcn_rsqf((ssqb[2 * row] + ssqb[2 * row + 1]) * (1.0f / 512.f) + EPS);
        float m[4];
#pragma unroll
        for (int j = 0; j < 4; ++j) m[j] = sg[((rh * 3 + 0) * 4 + j) * 64 + lane] * p0[j] + sg[((rh * 3 + 1) * 4 + j) * 64 + lane] * rsb * p1[j] + sg[((rh * 3 + 2) * 4 + j) * 64 + lane] * p2[j];
        mg_store4((bf16_t*)(c.dout + DO_MERGED) + (size_t)row * DM + c0 + lq * 4, m[0], m[1], m[2], m[3]);
    }
    __syncthreads();
}

__device__ __forceinline__ void meta_resid(const Ctx& cx_, const bf16_t* A, const bf16_t* W, int K) {
    if (cx_.bid >= 128) return;
    const Ctx c = relaunder(cx_);
    const int lane = c.lane, wave = c.wave, li = lane & 15, lq = lane >> 4, blk = wave & 3, kh = wave >> 2;
    const int cg16 = c.bid & 15, c0 = cg16 * 64 + blk * 16, row = BATCH * SEQ + (c.bid >> 4) * 16 + li;
    LAS float* red = (LAS float*)c.lds;
    const f32x4 zero = {0.f, 0.f, 0.f, 0.f};
    __syncthreads();
    f32x4 acc = mg_dot(W + (size_t)(c0 + li) * K + kh * (K >> 1) + lq * 8, A + (size_t)row * K + kh * (K >> 1) + lq * 8, K >> 6, zero);
    if (kh == 1) {
#pragma unroll
        for (int j = 0; j < 4; ++j) red[(blk * 4 + j) * 64 + lane] = acc[j];
    }
    __syncthreads();
    float ss = 0.f;
    if (kh == 0) {
        bf16_t* hp = c.H() + (size_t)row * DM + c0 + lq * 4;
        const uint2 hv = *(const uint2*)hp;
        float f[4] = {bflo(hv.x), bfhi(hv.x), bflo(hv.y), bfhi(hv.y)};
#pragma unroll
        for (int j = 0; j < 4; ++j) { f[j] += acc[j] + red[(blk * 4 + j) * 64 + lane]; ss += f[j] * f[j]; }
        mg_store4(hp, f[0], f[1], f[2], f[3]);
        ss += __shfl_xor(ss, 16); ss += __shfl_xor(ss, 32);
    }
    __syncthreads();
    if (kh == 0 && lq == 0) red[blk * 16 + li] = ss;
    __syncthreads();
    if (wave == 0 && lq == 0) c.ssq()[(size_t)row * 16 + cg16] = (red[li] + red[16 + li]) + (red[32 + li] + red[48 + li]);
    __syncthreads();
}

__device__ __forceinline__ void meta_up(const Ctx& cx_, const bf16_t* W) {
    const Ctx c = relaunder(cx_);
    const int lane = c.lane, li = lane & 15, lq = lane >> 4;
    const int c0 = c.bid * 16, row = BATCH * SEQ + c.wave * 16 + li;
    const f32x4 zero = {0.f, 0.f, 0.f, 0.f};
    const f32x4 acc = mg_dot(W + (size_t)(c0 + li) * DM + lq * 8, c.H() + (size_t)row * DM + lq * 8, 32, zero);
    const float s = row_scale(c.ssq(), row);
    float f[4];
#pragma unroll
    for (int j = 0; j < 4; ++j) { const float r = fmaxf(acc[j] * s, 0.f); f[j] = r * r; }
    mg_store4((bf16_t*)(c.ws + WS_ACT) + (size_t)row * DFF + c0 + lq * 4, f[0], f[1], f[2], f[3]);
}

__device__ __forceinline__ void meta_l1(const Ctx& cx_, const bf16_t* W) {
    if (cx_.bid >= 24) return;
    const Ctx c = relaunder(cx_);
    const int lane = c.lane, li = lane & 15, lq = lane >> 4;
    const int c0 = c.bid * 16, mode = c.bid >> 3, row = BATCH * SEQ + c.wave * 16 + li;
    f32x4 acc = {0.f, 0.f, 0.f, 0.f};
    if (mode < 3) acc = mg_dot(W + (size_t)(c0 + li) * 512 + lq * 8, (const bf16_t*)(c.ws + WS_L1IN) + (size_t)row * 512 + lq * 8, 16, acc);
    float f[4];
#pragma unroll
    for (int j = 0; j < 4; ++j) f[j] = mode == 0 ? tanhf_(acc[j]) : (mode == 1 ? acc[j] : (mode == 2 ? sigmoidf_(acc[j]) : 0.f));
    mg_store4((bf16_t*)(c.ws + WS_L1O) + (size_t)row * 512 + c0 + lq * 4, f[0], f[1], f[2], f[3]);
}

__device__ __forceinline__ void rwkv_post(const Ctx& cx_, int l) {
    const Ctx c = relaunder(cx_);
    const int gw = c.bid * NWAVES + c.wave, NGW = c.G * NWAVES, lane = c.lane, c0 = 4 * lane;
    const bf16_t* __restrict__ y0 = (const bf16_t*)(c.ws + WS_YRW0); const bf16_t* __restrict__ y1 = (const bf16_t*)(c.dout + DO_YRW1);
    const bf16_t* __restrict__ rk = (const bf16_t*)(c.dout + DO_RKVP); const bf16_t* __restrict__ l2 = (const bf16_t*)(c.ws + WS_L2O); bf16_t* __restrict__ yc = (bf16_t*)(c.ws + WS_YC);
    float lw[4], lb[4], rkw[4];
#pragma unroll
    for (int e = 0; e < 4; ++e) { lw[e] = c.in[I_LNW][(size_t)l * 256 + c0 + e]; lb[e] = c.in[I_LNB][(size_t)l * 256 + c0 + e]; rkw[e] = c.in[I_RK][(size_t)l * 256 + c0 + e]; }
#pragma unroll 2
    for (int m = gw; m < M_ROWS; m += NGW) {
        const u32x2 a = *(const u32x2*)(y0 + (size_t)m * 256 + c0), bq = *(const u32x2*)(y1 + (size_t)m * 256 + c0);
        const u32x2 rr = *(const u32x2*)(rk + (size_t)m * 1024 + c0), kk = *(const u32x2*)(rk + (size_t)m * 1024 + 256 + c0), vv = *(const u32x2*)(rk + (size_t)m * 1024 + 512 + c0);
        const u32x2 gg = *(const u32x2*)(l2 + (size_t)m * 1280 + 1024 + c0);
        float y[4] = {bflo(a.x) + bflo(bq.x), bfhi(a.x) + bfhi(bq.x), bflo(a.y) + bflo(bq.y), bfhi(a.y) + bfhi(bq.y)};
        const float r[4] = {bflo(rr.x), bfhi(rr.x), bflo(rr.y), bfhi(rr.y)}, k[4] = {bflo(kk.x), bfhi(kk.x), bflo(kk.y), bfhi(kk.y)};
        const float v[4] = {bflo(vv.x), bfhi(vv.x), bflo(vv.y), bfhi(vv.y)}, g[4] = {bflo(gg.x), bfhi(gg.x), bflo(gg.y), bfhi(gg.y)};
        const float mean = sum16((y[0] + y[1]) + (y[2] + y[3])) * (1.f / 64.f);
        float q = 0.f, bo = 0.f;
#pragma unroll
        for (int e = 0; e < 4; ++e) { y[e] -= mean; q += y[e] * y[e]; bo += r[e] * k[e] * rkw[e]; }
        q = sum16(q) * (1.f / 64.f); bo = sum16(bo);
        const float rs = __builtin_amdgcn_rsqf(q + 64e-5f);
        float o[4];
#pragma unroll
        for (int e = 0; e < 4; ++e) o[e] = (y[e] * rs * lw[e] + lb[e] + bo * v[e]) * g[e];
        *(u32x2*)(yc + (size_t)m * 256 + c0) = (u32x2){pk2(o[0], o[1]), pk2(o[2], o[3])};
    }
}
__device__ __forceinline__ void final_phase(const Ctx& cx_, float* out) {
    const Ctx c = relaunder(cx_);
    const int gw = c.bid * NWAVES + c.wave, NGW = c.G * NWAVES, lane = c.lane;
    const bf16_t* H = c.H(); const f32x4* fw = (const f32x4*)c.in[I_FNW];
    f32x4 fwv[4];
#pragma unroll
    for (int i = 0; i < 4; ++i) fwv[i] = fw[lane + 64 * i];
#pragma unroll 4
    for (int r = gw; r < BATCH * SEQ; r += NGW) {
        const size_t m = (size_t)r;
        const u32x2* __restrict__ hp = (const u32x2*)(H + m * DM);
        float v[4][4], ss = 0.f;
#pragma unroll
        for (int i = 0; i < 4; ++i) { const u32x2 w = hp[lane + 64 * i]; v[i][0] = bflo(w.x); v[i][1] = bfhi(w.x); v[i][2] = bflo(w.y); v[i][3] = bfhi(w.y); ss += (v[i][0] * v[i][0] + v[i][1] * v[i][1]) + (v[i][2] * v[i][2] + v[i][3] * v[i][3]); }
        ss = wave_sum(ss); const float s = __builtin_amdgcn_rsqf(ss * (1.0f / DM) + EPS);
        f32x4* __restrict__ op = (f32x4*)(out + (size_t)r * DM);
#pragma unroll
        for (int i = 0; i < 4; ++i) { const f32x4 w = fwv[i]; op[lane + 64 * i] = (f32x4){v[i][0] * s * w.x, v[i][1] * s * w.y, v[i][2] * s * w.z, v[i][3] * s * w.w}; }
    }
}

constexpr int LDS_BYTES = 147456;
#ifndef MIXDIR
#define MIXDIR 0
#define MIXLAYER 0
#endif
#ifndef PHMASK
#define PHMASK 0xFFFFF
#endif
#ifndef REPMASK
#define REPMASK 0
#endif
#define REP(k) for (int r_ = 0; r_ <= ((REPMASK >> (k)) & 1); ++r_)
__global__ void __launch_bounds__(NTHREADS, 2) mega_fwd(Params p) {
    extern __shared__ __attribute__((aligned(16))) unsigned char lds_raw[];
    cg::grid_group grid = cg::this_grid();
#ifdef CODE_SHIFT
    asm volatile(".fill %0, 4, 0xBF800000" :: "n"(CODE_SHIFT));
#endif
    Ctx c0_; c0_.in = p.in; c0_.ws = p.ws; c0_.dout = (unsigned char*)p.out; c0_.lds = (LAS unsigned char*)lds_raw;
    c0_.wave = __builtin_amdgcn_readfirstlane((int)threadIdx.x >> 6); c0_.tid = opaque_tid(c0_.wave); c0_.lane = c0_.tid & 63; c0_.G = gridDim.x; c0_.bid = blockIdx.x;
    Ctx c = c0_;
    const int G = c.G, bid = c.bid;
#ifdef PROF_A
    if (blockIdx.x == 0 && threadIdx.x == 0) { for (int k = 0; k < 15; ++k) PROF_PTR[k] = 0; PROF_PTR[15] = __builtin_amdgcn_s_memrealtime(); }
#endif
    unsigned* barw = (unsigned*)(c.ws + WS_BAR);
    volatile LAS unsigned* bst = (volatile LAS unsigned*)(c.lds + LDS_BYTES - 64);
    if (bid == 0) for (int i = threadIdx.x; i < XCD_BAR_WORDS + 1024; i += NTHREADS) barw[i < XCD_BAR_WORDS ? i : 4096 + (i - XCD_BAR_WORDS)] = 0u;
    if (threadIdx.x < 2) bst[threadIdx.x] = 0u;
    __syncthreads();
    REP(14) if (PHMASK & 1) phase0(c);
    grid.sync(); STAMP(0);
    const XcdBarrier xbar = xcd_barrier_post(barw, bst);
#ifdef BAR_TWICE
#define GRID_BAR() do { xcd_barrier(xbar, c0_.wave); xcd_barrier(xbar, c0_.wave); c = relaunder(c0_); } while (0)
#else
#define GRID_BAR() do { xcd_barrier(xbar, c0_.wave); c = relaunder(c0_); } while (0)
#endif
#pragma unroll 1
    for (int l = 0; l < DEPTH; ++l) {
#define wb (c.wb(l))
        REP(0) if (PHMASK & 2) dt_job(c, l);
        REP(1) if (PHMASK & 4) { SchedPlain S{c.H(), wb + WB_IN, DM, DM, DM, MP / 256, 11, c.G, c.bid, 0};
          EpiInProj E{c.ssq(), (bf16_t*)(c.ws + WS_UH), (bf16_t*)(c.ws + WS_PZ), (bf16_t*)(c.ws + WS_PXBC), (bf16_t*)(c.ws + WS_PRKVX)};
          pg8::gemm_phase(c.lds, c.wave, S, E); }
        GRID_BAR(); STAMP(1);
        REP(2) if (PHMASK & 8) { SchedS5 S{(const bf16_t*)(c.ws + WS_UH), wb + WB_SX, 256, c.G, c.bid}; EpiS5X E{(float*)(c.ws + WS_X)}; pg8::gemm_phase(c.lds, c.wave, S, E); }
        REP(3) if (PHMASK & 16) rwkv_prep(c, l);
        REP(4) if (PHMASK & 32) ssd_prep(c, l);
        GRID_BAR(); STAMP(2);
        REP(7) if (PHMASK & 128) { SchedPlain S{(const bf16_t*)(c.ws + WS_L1IN), wb + WB_L1, 512, 512, 512, BATCH * SEQ / 256, 2, c.G, c.bid, 0}; EpiL1 E{(bf16_t*)(c.ws + WS_L1O)}; pg8::gemm_phase(c.lds, c.wave, S, E); }
        meta_l1(c, wb + WB_L1);
        GRID_BAR(); STAMP(3);
        REP(8) if (PHMASK & 256) { SchedL2 S{(const bf16_t*)(c.ws + WS_L1O), wb + WB_L2, c.G, c.bid, MP / 256, 0}; EpiL2 E{(bf16_t*)(c.ws + WS_L2O), c.in[I_W0] + (size_t)l * 512, c.in[I_A0] + (size_t)l * 512}; pg8::gemm_phase(c.lds, c.wave, S, E); }
        GRID_BAR(); STAMP(4);
        if (c.bid < 64) { REP(16) if (PHMASK & 1024) rwkv_chunked64(c, l); }
        else {
            const int nside = c.G - 64, iside = c.bid - 64;
            REP(5) if (PHMASK & 64) s5_scan(c, l, iside, nside);
            REP(6) if (PHMASK & 4096) ssd_states(c, l, iside, nside);
            sub_barrier(barw + 4096 + 64 * (2 * l), (unsigned)nside); c = relaunder(c0_);
            ssd_chunk_scan(c, l, iside, nside);
            REP(9) if (PHMASK & 512) { SchedS5 S{(const bf16_t*)(c.ws + WS_UH), wb + WB_SY, 512, c.G - 64, c.bid - 64}; EpiS5Y E{(bf16_t*)(c.ws + WS_YAPRE)}; pg8::gemm_phase(c.lds, c.wave, S, E); }
            sub_barrier(barw + 4096 + 64 * (2 * l + 1), (unsigned)nside); c = relaunder(c0_);
            REP(17) if (PHMASK & 2048) ssd_outputs(c, l, 64, c.G - 64);
            REP(18) if (PHMASK & 16384) { SchedPlain S{(const bf16_t*)(c.ws + WS_YAPRE), wb + WB_GLU, 256, 256, 256, MP / 256, 2, c.G - 64, c.bid - 64, 0}; EpiGLU E{(bf16_t*)(c.ws + WS_YA), c.in[I_GLUB] + (size_t)l * 512}; pg8::gemm_phase(c.lds, c.wave, S, E); }
        }
        STAMP(5);
        GRID_BAR(); STAMP(6);
#ifdef CODE_SHIFT2
        asm volatile(".fill %0, 4, 0xBF800000" :: "n"(CODE_SHIFT2));
#endif
        REP(11) if (PHMASK & 8192) rwkv_post(c, l);
        GRID_BAR(); STAMP(7);
        REP(12) if (PHMASK & 32768) { SchedProj S{c.H(), wb + WB_G, wb + WB_P, (const bf16_t*)(c.ws + WS_YA), (const bf16_t*)(c.ws + WS_YB), (const bf16_t*)(c.ws + WS_YC), BATCH * SEQ / 256, c.G, c.bid, 0};
          EpiProj E{c.ssq(), (const float*)(c.ws + WS_SSQB), c.ws + WS_PARK + (size_t)c.bid * 393216, (bf16_t*)(c.dout + DO_MERGED), opaque_tid(c.wave)}; pg8::gemm_phase(c.lds, c.wave, S, E); }
        if (l < DEPTH - 1) meta_gates(c, l);
        GRID_BAR(); STAMP(8);
        if (PHMASK & 65536) { SchedPlain S{(const bf16_t*)(c.dout + DO_MERGED), wb + WB_O, DM, DM, DM, BATCH * SEQ / 256, 4, c.G, c.bid, 0}; EpiResid E{c.H(), c.ssq()}; pg8::gemm_phase(c.lds, c.wave, S, E); }
        if (l < DEPTH - 1) meta_resid(c, (const bf16_t*)(c.dout + DO_MERGED), wb + WB_O, DM);
        GRID_BAR(); STAMP(9);
        REP(13) if (PHMASK & 131072) { SchedPlain S{c.H(), wb + WB_1, DM, DM, DM, BATCH * SEQ / 256, 16, c.G, c.bid, 0}; EpiUp E{c.ssq(), (bf16_t*)(c.ws + WS_ACT)}; pg8::gemm_phase(c.lds, c.wave, S, E); }
        if (l < DEPTH - 1) meta_up(c, wb + WB_1);
        GRID_BAR(); STAMP(10);
        if (PHMASK & 262144) { SchedPlain S{(const bf16_t*)(c.ws + WS_ACT), wb + WB_2, DFF, DFF, DFF, BATCH * SEQ / 256, 4, c.G, c.bid, 0}; EpiResid E{c.H(), c.ssq()}; pg8::gemm_phase(c.lds, c.wave, S, E); }
        if (l < DEPTH - 1) meta_resid(c, (const bf16_t*)(c.ws + WS_ACT), wb + WB_2, DFF);
        GRID_BAR(); STAMP(11);
    }
    REP(15) if (PHMASK & 524288) final_phase(c, p.out);
#ifdef PROF_A
    GRID_BAR(); STAMP(12);
    if (blockIdx.x == 0) {
        __syncthreads();
        float va = (float)(__hip_atomic_load(&PROF_PTR[PROF_A], __ATOMIC_RELAXED, __HIP_MEMORY_SCOPE_AGENT)) * 0.01f, vb = (float)(__hip_atomic_load(&PROF_PTR[PROF_B], __ATOMIC_RELAXED, __HIP_MEMORY_SCOPE_AGENT)) * 0.01f;
        va = exp2f(rintf(log2f(va * PROF_SHIFT) * 2.f) * 0.5f); vb = exp2f(rintf(log2f(vb * PROF_SHIFT) * 2.f) * 0.5f);
        for (int i = threadIdx.x; i < (1 << 20); i += NTHREADS) p.out[1 + i] = vb;
        if (threadIdx.x == 0) p.out[0] = 100.f * va;
    }
#endif
}

extern "C" void kernel_launch(void* const* d_in, const int* in_sizes, int n_in, void* d_out, int out_size, void* d_ws, size_t ws_size, hipStream_t stream) {
    static int grid = 0;
    if (grid == 0) {
        int dev = 0, cus = 0, per_cu = 0;
        if (n_in != N_INPUTS || out_size != BATCH * SEQ * DM || ws_size < WS_END) { fprintf(stderr, "kernel_launch: unexpected shapes (n_in %d out %d ws %zu)\n", n_in, out_size, ws_size); grid = -1; return; }
        (void)hipGetDevice(&dev); (void)hipDeviceGetAttribute(&cus, hipDeviceAttributeMultiprocessorCount, dev);
        (void)hipFuncSetAttribute((const void*)mega_fwd, hipFuncAttributeMaxDynamicSharedMemorySize, LDS_BYTES);
        (void)hipOccupancyMaxActiveBlocksPerMultiprocessor(&per_cu, (const void*)mega_fwd, NTHREADS, LDS_BYTES);
        if (per_cu < 1) { fprintf(stderr, "kernel_launch: occupancy query says %d blocks per CU\n", per_cu); per_cu = 1; }
        grid = cus * 1;
        if (grid != 256) fprintf(stderr, "kernel_launch: %d CUs (the scan phases are laid out for 256 workgroups)\n", grid);
    }
    if (grid < 0) return;
    Params p{};
    for (int i = 0; i < N_INPUTS; ++i) p.in[i] = (const float*)d_in[i];
    p.out = (float*)d_out; p.ws = (unsigned char*)d_ws; p.ph_lo = 0; p.ph_hi = 0;
    void* args[] = {&p};
    hipError_t e = hipLaunchCooperativeKernel((const void*)mega_fwd, dim3(grid), dim3(NTHREADS), args, LDS_BYTES, stream);
    if (e != hipSuccess) fprintf(stderr, "cooperative launch failed: %s (grid %d)\n", hipGetErrorString(e), grid);
}
```
